# Optimizing an MI355X kernel written in HIP

```python
import jax, jax.numpy as jnp
from jax import lax
import numpy as np

D_MODEL = 1024
BATCH = 4
SEQ = 4096
DEPTH = 1

CHUNK = 64
PLE_DIM = 256
EPS = 1e-6

GLA_HEADS = 4
GLA_DK = 128
GLA_DV = 256
GLA_GATE_RANK = 16
GLA_TAU = 16.0

SB_HEADS = 16
SB_DH = 64
SB_BLOCK = 128

PEER_HEADS = 8
PEER_NKEYS = 128
PEER_N = PEER_NKEYS * PEER_NKEYS
PEER_DKEY = 256
PEER_TOPK = 16
PEER_TOK_BLOCK = 128

GLA_QK = GLA_HEADS * GLA_DK
GLA_V = GLA_HEADS * GLA_DV
SB_W = SB_HEADS * SB_DH
IN_SPLITS = (GLA_QK, GLA_QK, GLA_V, GLA_V, GLA_GATE_RANK, SB_W, SB_W, SB_W, D_MODEL, D_MODEL)
IN_WIDTH = sum(IN_SPLITS)

kernel_name = "hybrid_gla_stickbreak_peer_block"


def rmsnorm(x, g):
    xf = x.astype(jnp.float32)
    y = xf * lax.rsqrt(jnp.mean(xf * xf, axis=-1, keepdims=True) + EPS)
    return (y * g.astype(jnp.float32)).astype(x.dtype)


def gla_branch(q, k, v, r, a_lo, w_a_up, b_a, g_o):
    B, S, _ = q.shape
    NC = S // CHUNK
    f32 = jnp.float32
    qf = q.astype(f32).reshape(B, NC, CHUNK, GLA_HEADS, GLA_DK) * (GLA_DK ** -0.5)
    kf = k.astype(f32).reshape(B, NC, CHUNK, GLA_HEADS, GLA_DK)
    vf = v.astype(f32).reshape(B, NC, CHUNK, GLA_HEADS, GLA_DV)
    log_a = jax.nn.log_sigmoid((a_lo @ w_a_up + b_a).astype(f32)) / GLA_TAU
    log_a = log_a.reshape(B, NC, CHUNK, GLA_HEADS, GLA_DK)
    logb = jnp.cumsum(log_a, axis=2)
    k_dec = kf * jnp.exp(logb[:, :, -1:] - logb)
    g_chunk = jnp.exp(logb[:, :, -1])

    def step(state, inp):
        qc, kc, vc, gc = inp
        state = gc[..., None] * state + jnp.einsum('bchk,bchv->bhkv', kc, vc)
        oc = jnp.einsum('bchk,bhkv->bchv', qc, state)
        return state, oc

    xs = (jnp.moveaxis(qf, 1, 0), jnp.moveaxis(k_dec, 1, 0),
          jnp.moveaxis(vf, 1, 0), jnp.moveaxis(g_chunk, 1, 0))
    state0 = jnp.zeros((B, GLA_HEADS, GLA_DK, GLA_DV), f32)
    _, o = lax.scan(step, state0, xs)
    o = jnp.moveaxis(o, 0, 1).reshape(B, S, GLA_HEADS, GLA_DV)
    o = o * lax.rsqrt(jnp.mean(o * o, axis=-1, keepdims=True) + EPS)
    o = o * g_o.astype(f32).reshape(GLA_HEADS, GLA_DV)
    o = o.reshape(B, S, GLA_V) * jax.nn.silu(r.astype(f32))
    return o.astype(q.dtype)


def stick_breaking_branch(q, k, v):
    B, S, _ = q.shape
    NB = S // SB_BLOCK
    f32 = jnp.float32
    qf = q.astype(f32).reshape(B, S, SB_HEADS, SB_DH).transpose(0, 2, 1, 3) * (SB_DH ** -0.5)
    kf = k.astype(f32).reshape(B, S, SB_HEADS, SB_DH).transpose(0, 2, 1, 3)
    vf = v.astype(f32).reshape(B, S, SB_HEADS, SB_DH).transpose(0, 2, 1, 3)
    qb = qf.reshape(B, SB_HEADS, NB, SB_BLOCK, SB_DH).transpose(2, 0, 1, 3, 4)
    starts = jnp.arange(NB, dtype=jnp.int32) * SB_BLOCK
    key_pos = jnp.arange(S, dtype=jnp.int32)

    def block(args):
        qblk, start = args
        z = jnp.einsum('bhqd,bhkd->bhqk', qblk, kf)
        q_pos = start + jnp.arange(SB_BLOCK, dtype=jnp.int32)
        mask = key_pos[None, :] < q_pos[:, None]
        log_beta = jax.nn.log_sigmoid(z)
        log_stay = jnp.where(mask, jax.nn.log_sigmoid(-z), 0.0)
        after = lax.cumsum(log_stay, axis=3, reverse=True) - log_stay
        w = jnp.where(mask, jnp.exp(log_beta + after), 0.0)
        return jnp.einsum('bhqk,bhkd->bhqd', w, vf)

    o = lax.map(block, (qb, starts))
    o = o.transpose(1, 0, 3, 2, 4).reshape(B, S, SB_W)
    return o.astype(q.dtype)


def peer_ffn(x, w_pq, sub_k1, sub_k2, u_emb, v_emb):
    B, S, D = x.shape
    T = B * S
    half = PEER_DKEY // 2
    xt = x.reshape(T, D)
    q = (xt @ w_pq).astype(jnp.float32).reshape(T, PEER_HEADS, PEER_DKEY)
    s1 = jnp.einsum('thd,hnd->thn', q[..., :half], sub_k1.astype(jnp.float32))
    s2 = jnp.einsum('thd,hnd->thn', q[..., half:], sub_k2.astype(jnp.float32))
    v1, i1 = lax.top_k(s1, PEER_TOPK)
    v2, i2 = lax.top_k(s2, PEER_TOPK)
    cand = (v1[..., :, None] + v2[..., None, :]).reshape(T, PEER_HEADS, PEER_TOPK * PEER_TOPK)
    cand_idx = (i1[..., :, None] * PEER_NKEYS + i2[..., None, :]).reshape(T, PEER_HEADS, PEER_TOPK * PEER_TOPK)
    top_s, top_c = lax.top_k(cand, PEER_TOPK)
    expert = jnp.take_along_axis(cand_idx, top_c, axis=-1)
    gate = jax.nn.softmax(top_s, axis=-1)

    NB = T // PEER_TOK_BLOCK
    K = PEER_HEADS * PEER_TOPK
    xb = xt.reshape(NB, PEER_TOK_BLOCK, D)
    eb = expert.reshape(NB, PEER_TOK_BLOCK, K)
    gb = gate.reshape(NB, PEER_TOK_BLOCK, K)

    def block(args):
        xblk, eblk, gblk = args
        u = jnp.take(u_emb, eblk, axis=0)
        h = jax.nn.gelu(jnp.einsum('tkd,td->tk', u, xblk).astype(jnp.float32))
        a = (h * gblk).astype(xblk.dtype)
        vv = jnp.take(v_emb, eblk, axis=0)
        return jnp.einsum('tk,tkd->td', a, vv).astype(xblk.dtype)

    out = lax.map(block, (xb, eb, gb))
    return out.reshape(B, S, D)


def setup_inputs(seed: int = 0) -> dict:
    key = jax.random.key(seed)
    ks = jax.random.split(key, 24)
    n = jax.random.normal
    f = jnp.float32
    L = DEPTH
    return {
        "x": n(ks[0], (BATCH, SEQ, D_MODEL), f),
        "p": n(ks[1], (L, BATCH, SEQ, PLE_DIM), f),
        "g_mix": 1.0 + 0.01 * n(ks[2], (L, D_MODEL), f),
        "w_in": n(ks[3], (L, D_MODEL, IN_WIDTH), f) * D_MODEL ** -0.5,
        "w_gla_a_up": n(ks[4], (L, GLA_GATE_RANK, GLA_QK), f) * GLA_GATE_RANK ** -0.5,
        "b_gla_a": 0.1 * n(ks[5], (L, GLA_QK), f),
        "g_gla_o": 1.0 + 0.01 * n(ks[6], (L, GLA_V), f),
        "w_gla_out": n(ks[7], (L, GLA_V, D_MODEL), f) * GLA_V ** -0.5,
        "w_sb_out": n(ks[8], (L, SB_W, D_MODEL), f) * SB_W ** -0.5,
        "w_o": n(ks[9], (L, D_MODEL, D_MODEL), f) * D_MODEL ** -0.5,
        "g_ffn": 1.0 + 0.01 * n(ks[10], (L, D_MODEL), f),
        "w_peer_q": n(ks[11], (L, D_MODEL, PEER_HEADS * PEER_DKEY), f) * D_MODEL ** -0.5,
        "peer_k1": n(ks[12], (L, PEER_HEADS, PEER_NKEYS, PEER_DKEY // 2), f) * (PEER_DKEY // 2) ** -0.5,
        "peer_k2": n(ks[13], (L, PEER_HEADS, PEER_NKEYS, PEER_DKEY // 2), f) * (PEER_DKEY // 2) ** -0.5,
        "peer_u": n(ks[14], (L, PEER_N, D_MODEL), f) * D_MODEL ** -0.5,
        "peer_v": n(ks[15], (L, PEER_N, D_MODEL), f) * PEER_HEADS ** -0.5,
        "g_ple": 1.0 + 0.01 * n(ks[16], (L, D_MODEL), f),
        "w_ple_gate": n(ks[17], (L, D_MODEL, D_MODEL), f) * D_MODEL ** -0.5,
        "w_ple": n(ks[18], (L, PLE_DIM, D_MODEL), f) * PLE_DIM ** -0.5,
        "g_final": 1.0 + 0.01 * n(ks[19], (D_MODEL,), f),
    }


def reference(x, p, g_mix, w_in, w_gla_a_up, b_gla_a, g_gla_o, w_gla_out, w_sb_out, w_o,
              g_ffn, w_peer_q, peer_k1, peer_k2, peer_u, peer_v, g_ple, w_ple_gate, w_ple, g_final):
    offsets = [int(o) for o in np.cumsum(IN_SPLITS)[:-1]]
    h = x
    for i in range(DEPTH):
        u = rmsnorm(h, g_mix[i])
        proj = u @ w_in[i]
        (gq, gk, gv, gr, ga, sq, sk, sv, gate_a, gate_b) = jnp.split(proj, offsets, axis=-1)
        y_a = gla_branch(gq, gk, gv, gr, ga, w_gla_a_up[i], b_gla_a[i], g_gla_o[i]) @ w_gla_out[i]
        y_b = stick_breaking_branch(sq, sk, sv) @ w_sb_out[i]
        mixed = jax.nn.sigmoid(gate_a) * y_a + jax.nn.sigmoid(gate_b) * y_b
        h = h + (mixed @ w_o[i]).astype(h.dtype)
        h = h + peer_ffn(rmsnorm(h, g_ffn[i]), w_peer_q[i], peer_k1[i], peer_k2[i],
                         peer_u[i], peer_v[i]).astype(h.dtype)
        ple = p[i] @ w_ple[i]
        ple_gate = jax.nn.sigmoid(rmsnorm(h, g_ple[i]) @ w_ple_gate[i])
        h = h + (ple * ple_gate).astype(h.dtype)
    return rmsnorm(h, g_final)
```

```cpp
#define MK_FUSED 1
#include <hip/hip_runtime.h>
#include <cstdio>
#include <cstdint>

#define LAS __attribute__((address_space(3)))
#define GAS __attribute__((address_space(1)))
typedef unsigned short bf16_t;
typedef short bf16x8 __attribute__((ext_vector_type(8)));
typedef short s16x4 __attribute__((ext_vector_type(4)));
typedef float f32x2 __attribute__((ext_vector_type(2)));
typedef float f32x4 __attribute__((ext_vector_type(4)));
typedef float f32x16 __attribute__((ext_vector_type(16)));
typedef unsigned u32x2 __attribute__((ext_vector_type(2)));
typedef unsigned u32x4 __attribute__((ext_vector_type(4)));
typedef __bf16 bf16x2_t __attribute__((ext_vector_type(2)));

__device__ __forceinline__ unsigned cvtpk(float lo, float hi) { f32x2 v = {lo, hi}; bf16x2_t b = __builtin_convertvector(v, bf16x2_t); return __builtin_bit_cast(unsigned, b); }
__device__ __forceinline__ float bf_lo(unsigned u) { return __uint_as_float(u << 16); }
__device__ __forceinline__ float bf_hi(unsigned u) { return __uint_as_float(u & 0xffff0000u); }
__device__ __forceinline__ float bf1(bf16_t u) { return __uint_as_float(((unsigned)u) << 16); }
__device__ __forceinline__ float fast_sigmoid(float x) { return __builtin_amdgcn_rcpf(1.0f + __expf(-x)); }

namespace pg8 {
constexpr int BM = 256, BK = 64, HALF = 128, HTB = HALF * BK * 2  , STAGE_BYTES = 8 * HTB, NXCD = 8, WGM = 8;

__host__ __device__ __forceinline__ int lds_byte(int r, int c) { const int st = (r >> 4) * 2 + (c >> 5), rr = r & 15, cc = c & 31, ob = rr * 64 + cc * 2; return st * 1024 + (ob ^ (((ob >> 9) & 1) << 5)); }
__host__ __device__ __forceinline__ void stage_rc(int b, int& R, int& C) { const int st = b / 1024, sb = b % 1024, swz = sb ^ (((sb >> 9) & 1) << 5); R = (st >> 1) * 16 + swz / 64; C = (st & 1) * 32 + (swz % 64) / 2; }
__host__ __device__ __forceinline__ int perm32(int rho) { const int n = rho >> 4, i = rho & 15; return 8 * (i >> 2) + 4 * n + (i & 3); }

struct Unit { int pm, pn; };
struct Gemm { const bf16_t* A; const bf16_t* Bt; int M, N, K, lda, a_pn_cols; };

struct StaticOrder {
    int nM, nN, nwg, G, c;
    __host__ __device__ void init(int M, int N, int G_, int c_) { nM = M / BM; nN = N / BM; nwg = nM * nN; G = G_; c = c_; }
    __host__ __device__ bool next(int i, Unit& u) const {
        const long L = (long)i * G + c; if (L >= nwg) return false;
        int wgid = (int)L; { const int q = nwg / NXCD, r = nwg % NXCD, xcd = wgid % NXCD, off = wgid / NXCD; wgid = (xcd < r ? xcd * (q + 1) : r * (q + 1) + (xcd - r) * q) + off; }
        const int nig = WGM * nN, gid = wgid / nig, fm = gid * WGM, gsz = (nM - fm) < WGM ? (nM - fm) : WGM;
        u.pm = fm + ((wgid % nig) % gsz); u.pn = (wgid % nig) / gsz; return true;
    }
};

template <class Epi, bool ALIGN_EPI = true, bool SP2 = true>
__device__ __forceinline__ void gemm_phase(LAS unsigned char* lds, const Gemm g, const StaticOrder& S, const Epi& E) {
    const int tid = threadIdx.x, wid = __builtin_amdgcn_readfirstlane(tid >> 6), lane = tid & 63, wr = wid >> 2, wc = wid & 3, fr = lane & 15, fq = lane >> 4;
    const int K = g.K, nt = K / BK, lda = g.lda;
    unsigned voffA[2], voffB[2];
#pragma unroll
    for (int i = 0; i < 2; ++i) { int R, C; stage_rc(tid * 16 + i * 8192, R, C); const int Rb = Epi::PERM ? ((R & ~31) + perm32(R & 31)) : R;
        voffA[i] = (unsigned)(R * lda + C) * 2u; voffB[i] = (unsigned)(Rb * K + C) * 2u; }
    const size_t kstep = (size_t)(BK * 2);
    const size_t hA = (size_t)HALF * lda * 2, hB = (size_t)HALF * K * 2;
    const size_t tA = 2 * hA, tB = 2 * hB;
    const size_t pnA = (size_t)g.a_pn_cols * 2;
    const unsigned ldsw = (unsigned)wid * 1024u;
    const int aoff = lds_byte(wr * 64 + fr, fq * 8), boff = lds_byte(wc * 32 + fr, fq * 8);
#define PG8_SA(b, h) (((b) * 2 + (h)) * HTB)
#define PG8_SB(b, h) ((4 + (b) * 2 + (h)) * HTB)
#define PG8_STAGE(bufoff, gbase, voff) do { _Pragma("unroll") for (int _i = 0; _i < 2; ++_i) \
        __builtin_amdgcn_global_load_lds((const unsigned*)((const char*)(gbase) + (voff)[_i]), (LAS unsigned*)(lds + (bufoff) + ldsw + _i * 8192), 16, 0, 0); } while (0)
#define PG8_LDA(dst, b, h) do { _Pragma("unroll") for (int m = 0; m < 4; ++m) _Pragma("unroll") for (int k = 0; k < 2; ++k) dst[m][k] = *(const LAS bf16x8*)(lds + PG8_SA(b, h) + aoff + m * 2048 + k * 1024); } while (0)
#define PG8_LDB(dst, b, h) do { _Pragma("unroll") for (int n = 0; n < 2; ++n) _Pragma("unroll") for (int k = 0; k < 2; ++k) dst[n][k] = *(const LAS bf16x8*)(lds + PG8_SB(b, h) + boff + n * 2048 + k * 1024); } while (0)
#define PG8_MMA(ai, bj, At, Bt) do { __builtin_amdgcn_s_setprio(1); _Pragma("unroll") for (int m = 0; m < 4; ++m) _Pragma("unroll") for (int n = 0; n < 2; ++n) _Pragma("unroll") for (int k = 0; k < 2; ++k) \
        acc[ai][bj][m][n] = __builtin_amdgcn_mfma_f32_16x16x32_bf16(Bt[n][k], At[m][k], acc[ai][bj][m][n], 0, 0, 0); __builtin_amdgcn_s_setprio(0); } while (0)
#define PG8_WAIT_V(n) asm volatile("s_waitcnt vmcnt(" #n ")" ::: "memory")
#define PG8_WAIT_L(n) asm volatile("s_waitcnt lgkmcnt(" #n ")" ::: "memory")
#define PG8_BAR __builtin_amdgcn_s_barrier()
#define PG8_SCHED __builtin_amdgcn_sched_barrier(0)
    Unit cur, nxt; int ui = 0;
    if (!S.next(0, cur)) return;
    f32x4 acc[2][2][4][2];
#pragma unroll
    for (int a = 0; a < 2; ++a)
#pragma unroll
        for (int b = 0; b < 2; ++b)
#pragma unroll
            for (int m = 0; m < 4; ++m)
#pragma unroll
                for (int n = 0; n < 2; ++n) acc[a][b][m][n] = (f32x4){0.f, 0.f, 0.f, 0.f};
    bf16x8 At[4][2], B0[2][2], B1[2][2];
    const char* cA = (const char*)g.A + (size_t)cur.pm * tA + (size_t)cur.pn * pnA; const char* cB = (const char*)g.Bt + (size_t)cur.pn * tB;
    if constexpr (SP2) {
        PG8_STAGE(PG8_SB(0, 0), cB, voffB); PG8_STAGE(PG8_SB(0, 1), cB + hB, voffB); PG8_STAGE(PG8_SA(0, 0), cA, voffA); PG8_STAGE(PG8_SA(0, 1), cA + hA, voffA);
        if (wr == 1) PG8_BAR;
        PG8_WAIT_V(2); PG8_BAR;
        PG8_STAGE(PG8_SB(1, 0), cB + kstep, voffB); PG8_STAGE(PG8_SA(1, 0), cA + kstep, voffA); PG8_STAGE(PG8_SB(1, 1), cB + hB + kstep, voffB);
        PG8_WAIT_V(6); PG8_BAR;
    } else {
        PG8_STAGE(PG8_SB(0, 0), cB, voffB); PG8_STAGE(PG8_SA(0, 0), cA, voffA); PG8_STAGE(PG8_SB(0, 1), cB + hB, voffB); PG8_STAGE(PG8_SA(0, 1), cA + hA, voffA);
        if (wr == 1) PG8_BAR;
        PG8_WAIT_V(4); PG8_BAR;
        PG8_STAGE(PG8_SB(1, 0), cB + kstep, voffB); PG8_STAGE(PG8_SA(1, 0), cA + kstep, voffA); PG8_STAGE(PG8_SB(1, 1), cB + hB + kstep, voffB);
        PG8_WAIT_V(6); PG8_BAR;
    }
    for (;;) {
        const bool has_next = S.next(ui + 1, nxt);
        const char* nA = has_next ? (const char*)g.A + (size_t)nxt.pm * tA + (size_t)nxt.pn * pnA : cA; const char* nB = has_next ? (const char*)g.Bt + (size_t)nxt.pn * tB : cB;
#pragma unroll 1
        for (int t = 0; t < nt; t += 2) {
            const bool last = (t == nt - 2);
            const char* a1 = cA + (size_t)(t + 1) * kstep;
            const char* a2 = last ? nA : cA + (size_t)(t + 2) * kstep; const char* b2 = last ? nB : cB + (size_t)(t + 2) * kstep;
            const char* a3 = a2 + kstep; const char* b3 = b2 + kstep;
            if constexpr (SP2) {
            PG8_LDB(B0, 0, 0); PG8_LDB(B1, 0, 1); PG8_SCHED; PG8_LDA(At, 0, 0); PG8_STAGE(PG8_SA(1, 1), a1 + hA, voffA);
            PG8_WAIT_V(8); PG8_WAIT_L(0); PG8_BAR; PG8_MMA(0, 0, At, B0); PG8_MMA(0, 1, At, B1); PG8_BAR; PG8_SCHED;
            PG8_LDA(At, 0, 1); PG8_STAGE(PG8_SB(0, 0), b2, voffB); PG8_STAGE(PG8_SB(0, 1), b2 + hB, voffB); PG8_STAGE(PG8_SA(0, 0), a2, voffA);
            PG8_WAIT_V(8); PG8_WAIT_L(0); PG8_BAR; PG8_MMA(1, 0, At, B0); PG8_MMA(1, 1, At, B1); PG8_BAR; PG8_SCHED;
            PG8_LDB(B0, 1, 0); PG8_LDB(B1, 1, 1); PG8_SCHED; PG8_LDA(At, 1, 0); PG8_STAGE(PG8_SA(0, 1), a2 + hA, voffA);
            PG8_WAIT_V(8); PG8_WAIT_L(0); PG8_BAR; PG8_MMA(0, 0, At, B0); PG8_MMA(0, 1, At, B1); PG8_BAR; PG8_SCHED;
            PG8_LDA(At, 1, 1); PG8_STAGE(PG8_SB(1, 0), b3, voffB); PG8_STAGE(PG8_SB(1, 1), b3 + hB, voffB); PG8_STAGE(PG8_SA(1, 0), a3, voffA);
            PG8_WAIT_V(8); PG8_WAIT_L(0); PG8_BAR; PG8_MMA(1, 0, At, B0); PG8_MMA(1, 1, At, B1); PG8_BAR; PG8_SCHED;
            } else {
            PG8_LDB(B0, 0, 0); PG8_SCHED; PG8_LDA(At, 0, 0); PG8_STAGE(PG8_SA(1, 1), a1 + hA, voffA);
            PG8_WAIT_L(8); PG8_BAR; PG8_WAIT_L(0); PG8_MMA(0, 0, At, B0); PG8_BAR; PG8_SCHED;
            PG8_LDB(B1, 0, 1); PG8_STAGE(PG8_SB(0, 0), b2, voffB);
            PG8_BAR; PG8_WAIT_L(0); PG8_MMA(0, 1, At, B1); PG8_BAR;
            PG8_LDA(At, 0, 1); PG8_STAGE(PG8_SA(0, 0), a2, voffA);
            PG8_BAR; PG8_WAIT_L(0); PG8_MMA(1, 0, At, B0); PG8_BAR; PG8_SCHED;
            PG8_STAGE(PG8_SB(0, 1), b2 + hB, voffB);
            PG8_WAIT_V(6); PG8_BAR; PG8_MMA(1, 1, At, B1); PG8_BAR;
            PG8_LDB(B0, 1, 0); PG8_SCHED; PG8_LDA(At, 1, 0); PG8_STAGE(PG8_SA(0, 1), a2 + hA, voffA);
            PG8_WAIT_L(8); PG8_BAR; PG8_WAIT_L(0); PG8_MMA(0, 0, At, B0); PG8_BAR; PG8_SCHED;
            PG8_LDB(B1, 1, 1); PG8_STAGE(PG8_SB(1, 0), b3, voffB);
            PG8_BAR; PG8_WAIT_L(0); PG8_MMA(0, 1, At, B1); PG8_BAR;
            PG8_LDA(At, 1, 1); PG8_STAGE(PG8_SA(1, 0), a3, voffA);
            PG8_BAR; PG8_WAIT_L(0); PG8_MMA(1, 0, At, B0); PG8_BAR; PG8_SCHED;
            PG8_STAGE(PG8_SB(1, 1), b3 + hB, voffB);
            PG8_WAIT_V(6); PG8_BAR; PG8_MMA(1, 1, At, B1); PG8_BAR;
            }
        }
        if constexpr (ALIGN_EPI) { if (wr == 0) PG8_BAR; }
        E(acc, cur, wr, wc, fr, fq);
        if (!has_next) break;
#pragma unroll
        for (int a = 0; a < 2; ++a)
#pragma unroll
            for (int b = 0; b < 2; ++b)
#pragma unroll
                for (int m = 0; m < 4; ++m)
#pragma unroll
                    for (int n = 0; n < 2; ++n) acc[a][b][m][n] = (f32x4){0.f, 0.f, 0.f, 0.f};
        cur = nxt; cA = nA; cB = nB; ++ui;
        if constexpr (ALIGN_EPI) { if (wr == 1) PG8_BAR; }
    }
    PG8_WAIT_V(0);
    if constexpr (!ALIGN_EPI) { if (wr == 0) PG8_BAR; }
    PG8_BAR;
#undef PG8_SA
#undef PG8_SB
#undef PG8_STAGE
#undef PG8_LDA
#undef PG8_LDB
#undef PG8_MMA
#undef PG8_WAIT_V
#undef PG8_WAIT_L
#undef PG8_BAR
#undef PG8_SCHED
}
}
constexpr int T_TOK = 16384, DM = 1024, SEQ = 4096, NB = 4;
constexpr float EPS = 1e-6f;
constexpr float LOG2E = 1.4426950408889634f;

namespace pg8 {
struct EpiProj {
    static constexpr bool PERM = true;
    bf16_t *GQ, *GK, *GV, *GR, *SQ, *SK, *SV, *SGA, *SGB;
    __device__ __forceinline__ void operator()(const f32x4 (&acc)[2][2][4][2], const Unit& u, int wr, int wc, int fr, int fq) const {
        const int pn = u.pn; bf16_t* base; int ldc = 1024, c0; int act = 0; float sc = 1.f;
        if (pn < 2) { base = GQ; ldc = 512; c0 = pn * 256; sc = 0.08838834764831845f; }
        else if (pn < 4) { base = GK; ldc = 512; c0 = (pn - 2) * 256; }
        else if (pn < 8) { base = GV; c0 = (pn - 4) * 256; }
        else if (pn < 12) { base = GR; c0 = (pn - 8) * 256; act = 1; }
        else if (pn < 16) { base = SQ; c0 = (pn - 12) * 256; sc = 0.125f * LOG2E; }
        else if (pn < 20) { base = SK; c0 = (pn - 16) * 256; }
        else if (pn < 24) { base = SV; c0 = (pn - 20) * 256; }
        else if (pn < 28) { base = SGA; c0 = (pn - 24) * 256; act = 2; }
        else { base = SGB; c0 = (pn - 28) * 256; act = 2; }
        const int row0 = u.pm * BM + wr * 64 + fr, col0 = c0 + wc * 32 + 8 * fq;
#pragma unroll
        for (int ai = 0; ai < 2; ++ai)
#pragma unroll
            for (int m = 0; m < 4; ++m) { bf16_t* rowp = base + (size_t)(row0 + ai * HALF + m * 16) * ldc + col0;
#pragma unroll
                for (int bj = 0; bj < 2; ++bj) { f32x4 v0 = acc[ai][bj][m][0], v1 = acc[ai][bj][m][1];
                    if (act == 1) {
#pragma unroll
                        for (int j = 0; j < 4; ++j) { v0[j] = v0[j] * fast_sigmoid(v0[j]); v1[j] = v1[j] * fast_sigmoid(v1[j]); } }
                    else if (act == 2) {
#pragma unroll
                        for (int j = 0; j < 4; ++j) { v0[j] = fast_sigmoid(v0[j]); v1[j] = fast_sigmoid(v1[j]); } }
                    else { v0 = v0 * sc; v1 = v1 * sc; }
                    u32x4 w; w.x = cvtpk(v0[0], v0[1]); w.y = cvtpk(v0[2], v0[3]); w.z = cvtpk(v1[0], v1[1]); w.w = cvtpk(v1[2], v1[3]);
                    *(u32x4*)(rowp + bj * HALF) = w; } }
    }
};
template <bool FIRST> struct EpiMix {
    static constexpr bool PERM = true;
    const bf16_t* gate; bf16_t* mixed;
    __device__ __forceinline__ void operator()(const f32x4 (&acc)[2][2][4][2], const Unit& u, int wr, int wc, int fr, int fq) const {
        const int row0 = u.pm * BM + wr * 64 + fr, col0 = u.pn * BM + wc * 32 + 8 * fq;
#pragma unroll
        for (int ai = 0; ai < 2; ++ai)
#pragma unroll
            for (int m = 0; m < 4; ++m) { const size_t off = (size_t)(row0 + ai * HALF + m * 16) * 1024 + col0;
#pragma unroll
                for (int bj = 0; bj < 2; ++bj) { const f32x4 a0 = acc[ai][bj][m][0], a1 = acc[ai][bj][m][1];
                    const u32x4 gv = *(const u32x4*)(gate + off + bj * HALF);
                    float r[8];
                    r[0] = a0[0] * bf_lo(gv.x); r[1] = a0[1] * bf_hi(gv.x); r[2] = a0[2] * bf_lo(gv.y); r[3] = a0[3] * bf_hi(gv.y);
                    r[4] = a1[0] * bf_lo(gv.z); r[5] = a1[1] * bf_hi(gv.z); r[6] = a1[2] * bf_lo(gv.w); r[7] = a1[3] * bf_hi(gv.w);
                    if (!FIRST) { const u32x4 mv = *(const u32x4*)(mixed + off + bj * HALF);
                        r[0] += bf_lo(mv.x); r[1] += bf_hi(mv.x); r[2] += bf_lo(mv.y); r[3] += bf_hi(mv.y); r[4] += bf_lo(mv.z); r[5] += bf_hi(mv.z); r[6] += bf_lo(mv.w); r[7] += bf_hi(mv.w); }
                    u32x4 w; w.x = cvtpk(r[0], r[1]); w.y = cvtpk(r[2], r[3]); w.z = cvtpk(r[4], r[5]); w.w = cvtpk(r[6], r[7]);
                    *(u32x4*)(mixed + off + bj * HALF) = w; } }
    }
};
struct EpiH1 {
    static constexpr bool PERM = false;
    const float* x; const float* g; float* H1; bf16_t* H1G; float* SSQ;
    __device__ __forceinline__ void operator()(const f32x4 (&acc)[2][2][4][2], const Unit& u, int wr, int wc, int fr, int fq) const {
        const int row0 = u.pm * BM + wr * 64 + fr, col0 = u.pn * BM + wc * 32 + 4 * fq;
        f32x4 gv[2][2];
#pragma unroll
        for (int bj = 0; bj < 2; ++bj)
#pragma unroll
            for (int n = 0; n < 2; ++n) gv[bj][n] = *(const f32x4*)(g + col0 + bj * HALF + n * 16);
#pragma unroll
        for (int ai = 0; ai < 2; ++ai)
#pragma unroll
            for (int m = 0; m < 4; ++m) { const int row = row0 + ai * HALF + m * 16; const size_t off = (size_t)row * 1024 + col0; float s = 0.f;
#pragma unroll
                for (int bj = 0; bj < 2; ++bj)
#pragma unroll
                    for (int n = 0; n < 2; ++n) { const f32x4 xv = *(const f32x4*)(x + off + bj * HALF + n * 16); const f32x4 h = xv + acc[ai][bj][m][n];
                        *(f32x4*)(H1 + off + bj * HALF + n * 16) = h; s += (h[0] * h[0] + h[1] * h[1]) + (h[2] * h[2] + h[3] * h[3]);
                        const f32x4 hg = h * gv[bj][n]; u32x2 w; w.x = cvtpk(hg[0], hg[1]); w.y = cvtpk(hg[2], hg[3]); *(u32x2*)(H1G + off + bj * HALF + n * 16) = w; }
                s += __shfl_xor(s, 16); s += __shfl_xor(s, 32);
                if (fq == 0) SSQ[(size_t)row * 16 + u.pn * 4 + wc] = s; }
    }
};
struct EpiQ {
    static constexpr bool PERM = true;
    const float* SSQ; bf16_t* Q; int ldc;
    __device__ __forceinline__ void operator()(const f32x4 (&acc)[2][2][4][2], const Unit& u, int wr, int wc, int fr, int fq) const {
        const int row0 = u.pm * BM + wr * 64 + fr, col0 = u.pn * BM + wc * 32 + 8 * fq;
#pragma unroll
        for (int ai = 0; ai < 2; ++ai)
#pragma unroll
            for (int m = 0; m < 4; ++m) { const int row = row0 + ai * HALF + m * 16; const f32x4* sp = (const f32x4*)(SSQ + (size_t)row * 16);
                const f32x4 s0 = sp[0], s1 = sp[1], s2 = sp[2], s3 = sp[3]; const f32x4 st = (s0 + s1) + (s2 + s3);
                const float rstd = __builtin_amdgcn_rsqf(((st[0] + st[1]) + (st[2] + st[3])) * (1.0f / 1024.0f) + EPS);
                bf16_t* rowp = Q + (size_t)row * ldc + col0;
#pragma unroll
                for (int bj = 0; bj < 2; ++bj) { const f32x4 v0 = acc[ai][bj][m][0] * rstd, v1 = acc[ai][bj][m][1] * rstd;
                    u32x4 w; w.x = cvtpk(v0[0], v0[1]); w.y = cvtpk(v0[2], v0[3]); w.z = cvtpk(v1[0], v1[1]); w.w = cvtpk(v1[2], v1[3]);
                    *(u32x4*)(rowp + bj * HALF) = w; } }
    }
};
struct EpiF32 {
    static constexpr bool PERM = false;
    float* O; int ldc;
    __device__ __forceinline__ void operator()(const f32x4 (&acc)[2][2][4][2], const Unit& u, int wr, int wc, int fr, int fq) const {
        const int row0 = u.pm * BM + wr * 64 + fr, col0 = u.pn * BM + wc * 32 + 4 * fq;
#pragma unroll
        for (int ai = 0; ai < 2; ++ai)
#pragma unroll
            for (int m = 0; m < 4; ++m) { float* rowp = O + (size_t)(row0 + ai * HALF + m * 16) * ldc + col0;
#pragma unroll
                for (int bj = 0; bj < 2; ++bj)
#pragma unroll
                    for (int n = 0; n < 2; ++n) *(f32x4*)(rowp + bj * HALF + n * 16) = acc[ai][bj][m][n]; }
    }
};
struct EpiBf {
    static constexpr bool PERM = true;
    bf16_t* O; int ldc;
    __device__ __forceinline__ void operator()(const f32x4 (&acc)[2][2][4][2], const Unit& u, int wr, int wc, int fr, int fq) const {
        const int row0 = u.pm * BM + wr * 64 + fr, col0 = u.pn * BM + wc * 32 + 8 * fq;
#pragma unroll
        for (int ai = 0; ai < 2; ++ai)
#pragma unroll
            for (int m = 0; m < 4; ++m) { bf16_t* rowp = O + (size_t)(row0 + ai * HALF + m * 16) * ldc + col0;
#pragma unroll
                for (int bj = 0; bj < 2; ++bj) { const f32x4 v0 = acc[ai][bj][m][0], v1 = acc[ai][bj][m][1];
                    u32x4 w; w.x = cvtpk(v0[0], v0[1]); w.y = cvtpk(v0[2], v0[3]); w.z = cvtpk(v1[0], v1[1]); w.w = cvtpk(v1[2], v1[3]);
                    *(u32x4*)(rowp + bj * HALF) = w; } }
    }
};
struct EpiH3 {
    static constexpr bool PERM = false;
    const float* H2; const bf16_t* PLE; float* OUT; float* SSQ;
    __device__ __forceinline__ void operator()(const f32x4 (&acc)[2][2][4][2], const Unit& u, int wr, int wc, int fr, int fq) const {
        const int row0 = u.pm * BM + wr * 64 + fr, col0 = u.pn * BM + wc * 32 + 4 * fq;
#pragma unroll
        for (int ai = 0; ai < 2; ++ai)
#pragma unroll
            for (int m = 0; m < 4; ++m) { const int row = row0 + ai * HALF + m * 16; const size_t off = (size_t)row * 1024 + col0; float s = 0.f;
#pragma unroll
                for (int bj = 0; bj < 2; ++bj)
#pragma unroll
                    for (int n = 0; n < 2; ++n) { const size_t o2 = off + bj * HALF + n * 16; const f32x4 hv = *(const f32x4*)(H2 + o2); const u32x2 pv = *(const u32x2*)(PLE + o2);
                        const f32x4 a = acc[ai][bj][m][n]; f32x4 h;
                        h[0] = hv[0] + bf_lo(pv.x) * fast_sigmoid(a[0]); h[1] = hv[1] + bf_hi(pv.x) * fast_sigmoid(a[1]);
                        h[2] = hv[2] + bf_lo(pv.y) * fast_sigmoid(a[2]); h[3] = hv[3] + bf_hi(pv.y) * fast_sigmoid(a[3]);
                        *(f32x4*)(OUT + o2) = h; s += (h[0] * h[0] + h[1] * h[1]) + (h[2] * h[2] + h[3] * h[3]); }
                s += __shfl_xor(s, 16); s += __shfl_xor(s, 32);
                if (fq == 0) SSQ[(size_t)row * 16 + u.pn * 4 + wc] = s;
                asm volatile("" ::: "memory"); }
    }
};
}
constexpr size_t MiB = 1u << 20;
constexpr size_t WS_CTL = 0, CTL_ZERO_BYTES = 64 * 1024;
constexpr size_t WS_WPLE = 1 * MiB;
constexpr size_t WS_KD = 1 * MiB + 512 * 1024;
constexpr size_t WS_WIN = 3 * MiB;
constexpr size_t WS_EXP = 3 * MiB;
constexpr size_t WS_GLAG = 11 * MiB;
constexpr size_t WS_SSQ1 = 13 * MiB;
constexpr size_t WS_SSQ3 = 14 * MiB;
constexpr size_t WS_WGA = 20 * MiB, WS_WSB = 22 * MiB, WS_WO = 24 * MiB, WS_WPG = 26 * MiB, WS_WPQ = 28 * MiB;
constexpr size_t WS_A = 32 * MiB;
constexpr size_t WS_GQ = WS_A, WS_GK = WS_A + 16 * MiB, WS_UB = WS_A;
constexpr size_t WS_B = 64 * MiB;
constexpr size_t WS_GV = WS_B, WS_VB = WS_B;
constexpr size_t WS_C = 96 * MiB;
constexpr size_t WS_GR = WS_C, WS_H1 = WS_C;
constexpr size_t WS_D = 128 * MiB;
constexpr size_t WS_SQ = WS_D;
constexpr size_t WS_E = 160 * MiB;
constexpr size_t WS_SK = WS_E, WS_MIX = WS_E, WS_Q = WS_E, WS_PLE = WS_E;
constexpr size_t WS_F = 192 * MiB;
constexpr size_t WS_SV = WS_F, WS_PB = WS_F;
constexpr size_t WS_G = 224 * MiB;
constexpr size_t WS_XN1 = WS_G, WS_GLAN = WS_G, WS_H1G = WS_G;
constexpr size_t WS_END = 256 * MiB;

constexpr int NWAVES = 8;
constexpr int RING_OFF = 0, RING_BYTES = 131072;
constexpr int MISC_OFF = RING_BYTES;
constexpr int LDS_BYTES = 147456;
constexpr int CW_BAR = 1024;

typedef GAS unsigned gu32;
#define RLX_AGENT __ATOMIC_RELAXED, __HIP_MEMORY_SCOPE_AGENT
#define LDS_WAIT() asm volatile("s_waitcnt lgkmcnt(0)" ::: "memory")
#define VM_WAIT() asm volatile("s_waitcnt vmcnt(0)" ::: "memory")

#define XB_TMO      128
#define XB_XCNT(j)  (256  + 64 * (j))
#define XB_XSUB(j)  (1280 + 64 * (j))
#define XB_XGEN(j)  (2304 + 64 * (j))
#define XB_TOP      3328
#define XB_TOPGEN   3392
#define XCD_BAR_WORDS 3456
#define XB_SPIN_CAP (1u << 22)
__device__ __forceinline__ unsigned xb_ld(unsigned* p)              { return __hip_atomic_load(p, __ATOMIC_RELAXED, __HIP_MEMORY_SCOPE_AGENT); }
__device__ __forceinline__ unsigned xb_add(unsigned* p, unsigned v) { return __hip_atomic_fetch_add(p, v, __ATOMIC_RELAXED, __HIP_MEMORY_SCOPE_AGENT); }
__device__ __forceinline__ unsigned xb_xcc_id() { return (unsigned)__builtin_amdgcn_s_getreg((3 << 11) | 20) & 0xFu; }
#define XB_SPIN(cond, bar) do { unsigned _sp = 0; while (cond) { __builtin_amdgcn_s_sleep(1); \
    if ((++_sp & 255u) == 0u) { if (xb_ld(&(bar)[XB_TMO])) break; if (_sp > XB_SPIN_CAP) { atomicAdd(&(bar)[XB_TMO], 1u); break; } } } } while (0)
struct XcdBarrier { unsigned* bar; unsigned x; volatile LAS unsigned* st; };
__device__ __forceinline__ XcdBarrier xcd_barrier_post(unsigned* bar, volatile LAS unsigned* st) {
    XcdBarrier b; b.bar = bar; b.x = xb_xcc_id(); b.st = st;
    if (threadIdx.x == 0) (void)xb_add(&bar[XB_XCNT(b.x)], 1u);
    return b;
}
__device__ __forceinline__ void xcd_barrier_complete(unsigned* bar, unsigned x, unsigned& nloc, unsigned& nx) {
    const unsigned G = gridDim.x * gridDim.y * gridDim.z;
    unsigned sum, cnt, mine, sp = 0u;
    for (;;) {
        sum = 0u; cnt = 0u; mine = 0u;
#pragma unroll
        for (unsigned j = 0; j < 16; ++j) { const unsigned c = xb_ld(&bar[XB_XCNT(j)]); sum += c; cnt += (c > 0u) ? 1u : 0u; mine = (j == x) ? c : mine; }
        if (sum == G) break;
        __builtin_amdgcn_s_sleep(1);
        if ((++sp & 255u) == 0u) { if (xb_ld(&bar[XB_TMO])) break; if (sp > XB_SPIN_CAP) { atomicAdd(&bar[XB_TMO], 1u); break; } }
    }
    nloc = mine > 0u ? mine : 1u; nx = cnt > 0u ? cnt : 1u;
}
__device__ __forceinline__ void xcd_barrier(const XcdBarrier& b) {
    asm volatile("s_waitcnt vmcnt(0)" ::: "memory");
    __syncthreads();
    if (threadIdx.x == 0) {
        unsigned* bar = b.bar;
        __builtin_amdgcn_s_waitcnt(0);
        unsigned nloc = b.st[0], nx = b.st[1];
        if (nloc == 0u) { xcd_barrier_complete(bar, b.x, nloc, nx); b.st[0] = nloc; b.st[1] = nx; }
        const unsigned old = xb_add(&bar[XB_XSUB(b.x)], 1u);
        const unsigned gen = old / nloc;
        if (old + 1u == (gen + 1u) * nloc) {
            __builtin_amdgcn_fence(__ATOMIC_RELEASE, "agent");
            asm volatile("s_waitcnt vmcnt(0)" ::: "memory");
            const unsigned og = xb_add(&bar[XB_TOP], 1u);
            const unsigned tg = og / nx;
            if (og + 1u == (tg + 1u) * nx) xb_add(&bar[XB_TOPGEN], 1u);
            else XB_SPIN(xb_ld(&bar[XB_TOPGEN]) == tg, bar);
            __builtin_amdgcn_fence(__ATOMIC_ACQUIRE, "agent");
            xb_add(&bar[XB_XGEN(b.x)], 1u);
            asm volatile("s_waitcnt vmcnt(0)" ::: "memory");
        } else {
            XB_SPIN(xb_ld(&bar[XB_XGEN(b.x)]) == gen, bar);
            __builtin_amdgcn_fence(__ATOMIC_ACQUIRE, "agent");
            asm volatile("s_waitcnt vmcnt(0)" ::: "memory");
        }
    }
    __syncthreads();
}

struct Frame {
    LAS unsigned char* lds;
    int tid, lane, wave, vcu, G;
    const float* const* in; float* out; unsigned char* ws;
};
#define WSP(T, off) ((T*)(F.ws + (off)))
__device__ __forceinline__ float wave_sum(float v) {
#pragma unroll
    for (int o = 1; o < 64; o <<= 1) v += __shfl_xor(v, o);
    return v;
}
template <class RowMap>
__device__ __forceinline__ void p0_transpose_item(const float* W, int K, int N, bf16_t* WT, RowMap rm, LAS float* scr, int item, int lane) {
    const int nblk = (N + 31) / 32, kb = item / nblk, nb = item % nblk, k0 = 64 * kb, n0 = 32 * nb;
    const int nl = n0 + (lane & 31);
#pragma unroll 8
    for (int i = 0; i < 32; ++i) { const int kk = 2 * i + (lane >> 5); scr[kk * 33 + (lane & 31)] = (nl < N) ? W[(size_t)(k0 + kk) * N + nl] : 0.f; }
    LDS_WAIT(); asm volatile("" ::: "memory");
    const int c = lane & 7;
#pragma unroll
    for (int j = 0; j < 4; ++j) { const int n = (lane >> 3) + 8 * j; const LAS float* s = scr + (8 * c) * 33 + n;
        u32x4 o; o.x = cvtpk(s[0 * 33], s[1 * 33]); o.y = cvtpk(s[2 * 33], s[3 * 33]); o.z = cvtpk(s[4 * 33], s[5 * 33]); o.w = cvtpk(s[6 * 33], s[7 * 33]);
        if (n0 + n < N) *(u32x4*)(WT + (size_t)rm(n0 + n) * K + k0 + 8 * c) = o; }
    LDS_WAIT(); asm volatile("" ::: "memory");
}
struct RmId { __device__ __forceinline__ int operator()(int n) const { return n; } };
struct RmWin { __device__ __forceinline__ int operator()(int n) const { return n < 3072 ? n : (n < 3088 ? 8192 + (n - 3072) : n - 16); } };

__device__ __forceinline__ void cvt_copy(Frame& F, const float* src, bf16_t* dst, size_t n) {
    const size_t nth = (size_t)F.G * 512, n8 = n / 8;
    for (size_t i = (size_t)F.vcu * 512 + F.tid; i < n8; i += nth) {
        const f32x4 a = *(const f32x4*)(src + i * 8), b = *(const f32x4*)(src + i * 8 + 4);
        u32x4 o; o.x = cvtpk(a[0], a[1]); o.y = cvtpk(a[2], a[3]); o.z = cvtpk(b[0], b[1]); o.w = cvtpk(b[2], b[3]);
        *(u32x4*)(dst + i * 8) = o; }
}
__device__ __forceinline__ void rms_row_to_bf16(const float* xrow, const float* g, bf16_t* orow, int lane) {
    f32x4 v[4]; float s = 0.f;
#pragma unroll
    for (int j = 0; j < 4; ++j) { v[j] = *((const f32x4*)xrow + lane + 64 * j); s += (v[j][0] * v[j][0] + v[j][1] * v[j][1]) + (v[j][2] * v[j][2] + v[j][3] * v[j][3]); }
    const float rstd = __builtin_amdgcn_rsqf(wave_sum(s) * (1.f / 1024.f) + EPS);
#pragma unroll
    for (int j = 0; j < 4; ++j) { const f32x4 gv = *((const f32x4*)g + lane + 64 * j); const f32x4 o = v[j] * rstd * gv;
        u32x2 w; w.x = cvtpk(o[0], o[1]); w.y = cvtpk(o[2], o[3]); *((u32x2*)orow + lane + 64 * j) = w; }
}
__device__ __forceinline__ void phase_prologue(Frame& F) {
    LAS float* scr = (LAS float*)(F.lds + RING_OFF + F.wave * 16384);
    const int gw = F.vcu * NWAVES + F.wave, NGW = F.G * NWAVES;
    constexpr int I_IN = 16 * 257, I_SQ = 16 * 32, I_PQ = 16 * 64, I_PLE = 4 * 32;
    constexpr int NITEMS = I_IN + 4 * I_SQ + I_PQ + I_PLE;
    for (int it = gw; it < NITEMS; it += NGW) {
        int r = it;
        if (r < I_IN) { p0_transpose_item(F.in[3], 1024, 8208, WSP(bf16_t, WS_WIN), RmWin(), scr, r, F.lane); continue; } r -= I_IN;
        if (r < I_SQ) { p0_transpose_item(F.in[7], 1024, 1024, WSP(bf16_t, WS_WGA), RmId(), scr, r, F.lane); continue; } r -= I_SQ;
        if (r < I_SQ) { p0_transpose_item(F.in[8], 1024, 1024, WSP(bf16_t, WS_WSB), RmId(), scr, r, F.lane); continue; } r -= I_SQ;
        if (r < I_SQ) { p0_transpose_item(F.in[9], 1024, 1024, WSP(bf16_t, WS_WO), RmId(), scr, r, F.lane); continue; } r -= I_SQ;
        if (r < I_SQ) { p0_transpose_item(F.in[17], 1024, 1024, WSP(bf16_t, WS_WPG), RmId(), scr, r, F.lane); continue; } r -= I_SQ;
        if (r < I_PQ) { p0_transpose_item(F.in[11], 1024, 2048, WSP(bf16_t, WS_WPQ), RmId(), scr, r, F.lane); continue; } r -= I_PQ;
        p0_transpose_item(F.in[18], 256, 1024, WSP(bf16_t, WS_WPLE), RmId(), scr, r, F.lane);
    }
    { const float* k1 = F.in[12]; const float* k2 = F.in[13]; bf16_t* KD = WSP(bf16_t, WS_KD);
      for (int i = F.vcu * 512 + F.tid; i < 8 * 256 * 32; i += F.G * 512) { const int h = i >> 13, n = (i >> 5) & 255, kc = (i & 31) * 8;
          u32x4 o = (u32x4){0u, 0u, 0u, 0u}; const float* s = nullptr;
          if (n < 128 && kc < 128) s = k1 + ((size_t)(h * 128 + n)) * 128 + kc;
          if (n >= 128 && kc >= 128) s = k2 + ((size_t)(h * 128 + n - 128)) * 128 + (kc - 128);
          if (s) { const f32x4 a = *(const f32x4*)s, b = *(const f32x4*)(s + 4); o.x = cvtpk(a[0], a[1]); o.y = cvtpk(a[2], a[3]); o.z = cvtpk(b[0], b[1]); o.w = cvtpk(b[2], b[3]); }
          *(u32x4*)(KD + (size_t)i * 8) = o; } }
    for (int m = gw; m < T_TOK; m += NGW) rms_row_to_bf16(F.in[0] + (size_t)m * 1024, F.in[2], WSP(bf16_t, WS_XN1) + (size_t)m * 1024, F.lane);
}

__device__ __forceinline__ void phase_gla_prep(Frame& F) {
    LAS float* alo = (LAS float*)(F.lds + RING_OFF);
    const bf16_t* XN1 = WSP(bf16_t, WS_XN1); const bf16_t* WGAT = WSP(bf16_t, WS_WIN) + (size_t)8192 * 1024;
    bf16_t* GK = WSP(bf16_t, WS_GK); bf16_t* GV = WSP(bf16_t, WS_GV); float* GLAG = WSP(float, WS_GLAG);
    const float* w_up = F.in[4]; const float* b_a = F.in[5];
    const int tid = F.tid, lane = F.lane, w = F.wave;
    for (int u = F.vcu; u < 256; u += F.G) {
        const size_t r0 = (size_t)u * 64;
        __syncthreads();
        if (w < 4) {
            f32x4 acc = (f32x4){0.f, 0.f, 0.f, 0.f};
            const bf16_t* ap = XN1 + (r0 + 16 * w + (lane & 15)) * 1024 + 8 * (lane >> 4);
            const bf16_t* bp = WGAT + (size_t)(lane & 15) * 1024 + 8 * (lane >> 4);
#pragma unroll 8
            for (int s = 0; s < 32; ++s) { const bf16x8 a = *(const bf16x8*)(ap + 32 * s), b = *(const bf16x8*)(bp + 32 * s); acc = __builtin_amdgcn_mfma_f32_16x16x32_bf16(a, b, acc, 0, 0, 0); }
#pragma unroll
            for (int r = 0; r < 4; ++r) alo[(16 * w + 4 * (lane >> 4) + r) * 16 + (lane & 15)] = acc[r];
        }
        const int kk = tid;
        float kv[64];
#pragma unroll
        for (int i = 0; i < 64; ++i) kv[i] = bf1(GK[(r0 + i) * 512 + kk]);
        float wv[16];
#pragma unroll
        for (int r = 0; r < 16; ++r) wv[r] = w_up[r * 512 + kk];
        const float bias = b_a[kk];
        __syncthreads();
        float suffix = 0.f;
        bf16_t* kdt = GK + r0 * 512 + (size_t)kk * 64;
#pragma unroll
        for (int i8 = 7; i8 >= 0; --i8) {
            float o[8];
#pragma unroll
            for (int j = 7; j >= 0; --j) { const int i = i8 * 8 + j;
                const f32x4 a0 = *(const LAS f32x4*)(alo + i * 16), a1 = *(const LAS f32x4*)(alo + i * 16 + 4), a2 = *(const LAS f32x4*)(alo + i * 16 + 8), a3 = *(const LAS f32x4*)(alo + i * 16 + 12);
                float x = bias;
                x += a0[0] * wv[0] + a0[1] * wv[1] + a0[2] * wv[2] + a0[3] * wv[3];
                x += a1[0] * wv[4] + a1[1] * wv[5] + a1[2] * wv[6] + a1[3] * wv[7];
                x += a2[0] * wv[8] + a2[1] * wv[9] + a2[2] * wv[10] + a2[3] * wv[11];
                x += a3[0] * wv[12] + a3[1] * wv[13] + a3[2] * wv[14] + a3[3] * wv[15];
                const float la = (fminf(x, 0.f) - log1pf(__expf(-fabsf(x)))) * (1.0f / 16.0f);
                o[j] = kv[i] * __expf(suffix);
                suffix += la; }
            u32x4 pk; pk.x = cvtpk(o[0], o[1]); pk.y = cvtpk(o[2], o[3]); pk.z = cvtpk(o[4], o[5]); pk.w = cvtpk(o[6], o[7]);
            *(u32x4*)(kdt + i8 * 8) = pk; }
        GLAG[(size_t)u * 512 + kk] = __expf(suffix);
        unsigned vv[64];
#pragma unroll
        for (int i = 0; i < 64; ++i) vv[i] = *(const unsigned*)(GV + (r0 + i) * 1024 + 2 * tid);
        __syncthreads();
        bf16_t* vt0 = GV + r0 * 1024 + (size_t)(2 * tid) * 64;
#pragma unroll
        for (int i8 = 0; i8 < 8; ++i8) { u32x4 lo, hi;
            lo.x = (vv[i8 * 8 + 0] & 0xffffu) | (vv[i8 * 8 + 1] << 16); hi.x = (vv[i8 * 8 + 0] >> 16) | (vv[i8 * 8 + 1] & 0xffff0000u);
            lo.y = (vv[i8 * 8 + 2] & 0xffffu) | (vv[i8 * 8 + 3] << 16); hi.y = (vv[i8 * 8 + 2] >> 16) | (vv[i8 * 8 + 3] & 0xffff0000u);
            lo.z = (vv[i8 * 8 + 4] & 0xffffu) | (vv[i8 * 8 + 5] << 16); hi.z = (vv[i8 * 8 + 4] >> 16) | (vv[i8 * 8 + 5] & 0xffff0000u);
            lo.w = (vv[i8 * 8 + 6] & 0xffffu) | (vv[i8 * 8 + 7] << 16); hi.w = (vv[i8 * 8 + 6] >> 16) | (vv[i8 * 8 + 7] & 0xffff0000u);
            *(u32x4*)(vt0 + i8 * 8) = lo; *(u32x4*)(vt0 + 64 + i8 * 8) = hi; }
    }
}

__device__ __forceinline__ void gla_scan(Frame& F, int bh) {
    const int b = bh >> 2, h = bh & 3, w = F.wave, l = F.lane, lq = l & 31, hh = l >> 5;
    const bf16_t* GQ = WSP(bf16_t, WS_GQ); const bf16_t* KDT = WSP(bf16_t, WS_GK); const bf16_t* VT = WSP(bf16_t, WS_GV); const bf16_t* GR = WSP(bf16_t, WS_GR);
    const float* GLAG = WSP(float, WS_GLAG); bf16_t* GLAN = WSP(bf16_t, WS_GLAN); const float* g_o = F.in[6];
    LAS float* red = (LAS float*)(F.lds + RING_OFF);
    f32x16 S[4];
#pragma unroll
    for (int kt = 0; kt < 4; ++kt)
#pragma unroll
        for (int r = 0; r < 16; ++r) S[kt][r] = 0.f;
    for (int c = 0; c < 64; ++c) {
        const int u = b * 64 + c; const size_t r0 = (size_t)u * 64;
        const float* Gp = GLAG + ((size_t)u * 4 + h) * 128;
#pragma unroll
        for (int kt = 0; kt < 4; ++kt)
#pragma unroll
            for (int g4 = 0; g4 < 4; ++g4) { const f32x4 g = *(const f32x4*)(Gp + 32 * kt + 8 * g4 + 4 * hh);
#pragma unroll
                for (int j = 0; j < 4; ++j) S[kt][4 * g4 + j] *= g[j]; }
        const bf16_t* kd = KDT + r0 * 512 + (size_t)h * 8192;
        const bf16_t* vt = VT + r0 * 1024 + (size_t)(h * 256 + 32 * w + lq) * 64;
#pragma unroll
        for (int ts = 0; ts < 4; ++ts) { const bf16x8 bfrag = *(const bf16x8*)(vt + 16 * ts + 8 * hh);
#pragma unroll
            for (int kt = 0; kt < 4; ++kt) { const bf16x8 afrag = *(const bf16x8*)(kd + (size_t)(32 * kt + lq) * 64 + 16 * ts + 8 * hh);
                S[kt] = __builtin_amdgcn_mfma_f32_32x32x16_bf16(afrag, bfrag, S[kt], 0, 0, 0); } }
        f32x16 oT[2];
#pragma unroll
        for (int tt = 0; tt < 2; ++tt) {
#pragma unroll
            for (int r = 0; r < 16; ++r) oT[tt][r] = 0.f;
            const bf16_t* qrow = GQ + (r0 + 32 * tt + lq) * 512 + h * 128;
#pragma unroll
            for (int kt = 0; kt < 4; ++kt)
#pragma unroll
                for (int s = 0; s < 2; ++s) {
                    u32x4 aw; aw.x = cvtpk(S[kt][8 * s + 0], S[kt][8 * s + 1]); aw.y = cvtpk(S[kt][8 * s + 2], S[kt][8 * s + 3]); aw.z = cvtpk(S[kt][8 * s + 4], S[kt][8 * s + 5]); aw.w = cvtpk(S[kt][8 * s + 6], S[kt][8 * s + 7]);
                    const u32x2 qlo = *(const u32x2*)(qrow + 32 * kt + 16 * s + 4 * hh), qhi = *(const u32x2*)(qrow + 32 * kt + 16 * s + 8 + 4 * hh);
                    const u32x4 bw = (u32x4){qlo.x, qlo.y, qhi.x, qhi.y};
                    oT[tt] = __builtin_amdgcn_mfma_f32_32x32x16_bf16(__builtin_bit_cast(bf16x8, aw), __builtin_bit_cast(bf16x8, bw), oT[tt], 0, 0, 0); }
        }
        LAS float* redc = red + (c & 1) * 512;
#pragma unroll
        for (int tt = 0; tt < 2; ++tt) { float s = 0.f;
#pragma unroll
            for (int r = 0; r < 16; ++r) s += oT[tt][r] * oT[tt][r];
            s += __shfl_xor(s, 32);
            if (hh == 0) redc[w * 64 + 32 * tt + lq] = s; }
        __syncthreads();
#pragma unroll
        for (int tt = 0; tt < 2; ++tt) { float tot = 0.f;
#pragma unroll
            for (int ww = 0; ww < 8; ++ww) tot += redc[ww * 64 + 32 * tt + lq];
            const float rstd = __builtin_amdgcn_rsqf(tot * (1.0f / 256.0f) + EPS);
            const size_t row = r0 + 32 * tt + lq;
#pragma unroll
            for (int g4 = 0; g4 < 4; ++g4) { const int v0 = h * 256 + 32 * w + 8 * g4 + 4 * hh;
                const f32x4 go = *(const f32x4*)(g_o + v0); const u32x2 sr = *(const u32x2*)(GR + row * 1024 + v0);
                const float o0 = oT[tt][4 * g4 + 0] * rstd * go[0] * bf_lo(sr.x), o1 = oT[tt][4 * g4 + 1] * rstd * go[1] * bf_hi(sr.x);
                const float o2 = oT[tt][4 * g4 + 2] * rstd * go[2] * bf_lo(sr.y), o3 = oT[tt][4 * g4 + 3] * rstd * go[3] * bf_hi(sr.y);
                u32x2 wv; wv.x = cvtpk(o0, o1); wv.y = cvtpk(o2, o3); *(u32x2*)(GLAN + row * 1024 + v0) = wv; } }
    }
    __syncthreads();
}

#ifndef SB_EARLY_EXIT
#define SB_EARLY_EXIT 0
#endif
constexpr int SBK_STRIDE = 144, SBV_STRIDE = 192;
constexpr int SB_LDS_K = 0, SB_LDS_V = 64 * SBK_STRIDE, SB_LDS_FLAG = SB_LDS_V + 64 * SBV_STRIDE;
typedef short v4i16_t __attribute__((ext_vector_type(4)));
__device__ __forceinline__ s16x4 vtr(const LAS unsigned char* p) { return __builtin_bit_cast(s16x4, __builtin_amdgcn_ds_read_tr16_b64_v4i16((LAS v4i16_t*)p)); }
__device__ __forceinline__ float partner32(float x, int hh) { auto rr = __builtin_amdgcn_permlane32_swap(__float_as_uint(x), __float_as_uint(x), false, false); return __uint_as_float(hh ? rr[0] : rr[1]); }

__device__ __forceinline__ void sb_attn_unit(Frame& F, int b, int h, int qb) {
    LAS unsigned char* lds = F.lds + RING_OFF;
    LAS unsigned* flags = (LAS unsigned*)(lds + SB_LDS_FLAG);
    const int tid = F.tid, w = F.wave, l = F.lane, lq = l & 31, hh = l >> 5;
    bf16_t* SQ = WSP(bf16_t, WS_SQ); const bf16_t* SK = WSP(bf16_t, WS_SK); const bf16_t* SV = WSP(bf16_t, WS_SV);
    const size_t rowbase = (size_t)b * SEQ;
    const int q0 = qb * 256 + 32 * w;
    const int qabs = q0 + lq;
    bf16x8 qf[4];
    { const bf16_t* qrow = SQ + (rowbase + qabs) * 1024 + h * 64;
#pragma unroll
      for (int s = 0; s < 4; ++s) qf[s] = *(const bf16x8*)(qrow + 16 * s + 8 * hh); }
    f32x16 o0, o1;
#pragma unroll
    for (int r = 0; r < 16; ++r) { o0[r] = 0.f; o1[r] = 0.f; }
    float carry = 0.f;
    const int skey = tid >> 3, sch = tid & 7;
    const bf16_t* kg = SK + (rowbase + skey) * 1024 + h * 64 + sch * 8;
    const bf16_t* vg = SV + (rowbase + skey) * 1024 + h * 64 + sch * 8;
    const int kt_hi = qb * 4 + 3;
    u32x4 kreg = *(const u32x4*)(kg + (size_t)kt_hi * 64 * 1024), vreg = *(const u32x4*)(vg + (size_t)kt_hi * 64 * 1024);
    const LAS unsigned char* kbase = lds + SB_LDS_K + lq * SBK_STRIDE + hh * 16;
    const LAS unsigned char* vbase = lds + SB_LDS_V + (4 * hh + ((l & 15) >> 2)) * SBV_STRIDE + (16 * ((l >> 4) & 1) + 4 * (l & 3)) * 2;
    for (int kt = kt_hi; ; --kt) {
        __syncthreads();
        if (SB_EARLY_EXIT && kt < kt_hi) { unsigned a = 1u;
#pragma unroll
            for (int i = 0; i < 8; ++i) a &= flags[i];
            if (a) break; }
        *(LAS u32x4*)(lds + SB_LDS_K + skey * SBK_STRIDE + sch * 16) = kreg;
        *(LAS u32x4*)(lds + SB_LDS_V + skey * SBV_STRIDE + sch * 16) = vreg;
        __syncthreads();
        if (kt > 0) { kreg = *(const u32x4*)(kg + (size_t)(kt - 1) * 64 * 1024); vreg = *(const u32x4*)(vg + (size_t)(kt - 1) * 64 * 1024); }
        if (64 * kt <= q0 + 30) {
            f32x16 p0, p1;
#pragma unroll
            for (int r = 0; r < 16; ++r) { p0[r] = 0.f; p1[r] = 0.f; }
#pragma unroll
            for (int s = 0; s < 4; ++s) { const bf16x8 a0 = *(const LAS bf16x8*)(kbase + s * 32), a1 = *(const LAS bf16x8*)(kbase + 32 * SBK_STRIDE + s * 32);
                p0 = __builtin_amdgcn_mfma_f32_32x32x16_bf16(a0, qf[s], p0, 0, 0, 0); p1 = __builtin_amdgcn_mfma_f32_32x32x16_bf16(a1, qf[s], p1, 0, 0, 0); }
            const bool diag = (64 * kt + 63 >= q0);
            float Lh[2][16];
#pragma unroll
            for (int half = 0; half < 2; ++half)
#pragma unroll
                for (int r = 0; r < 16; ++r) { const float z = half ? p1[r] : p0[r];
                    float L = fmaxf(z, 0.f) + __builtin_amdgcn_logf(1.0f + __builtin_amdgcn_exp2f(-fabsf(z)));
                    if (diag) { const int key = 64 * kt + 32 * half + (r & 3) + 8 * (r >> 2) + 4 * hh; if (key >= qabs) L = 0.f; }
                    Lh[half][r] = L; }
            float tot[8];
#pragma unroll
            for (int half = 0; half < 2; ++half)
#pragma unroll
                for (int g4 = 0; g4 < 4; ++g4) { float* Lg = &Lh[half][4 * g4]; Lg[2] += Lg[3]; Lg[1] += Lg[2]; Lg[0] += Lg[1]; tot[4 * half + g4] = Lg[0]; }
            float E[8]; float run = carry;
#pragma unroll
            for (int m = 7; m >= 0; --m) { const float tp = partner32(tot[m], hh);
                E[m] = run + (hh ? 0.f : tp);
                run += tot[m] + tp; }
            carry = run;
            u32x4 pw[2][2];
#pragma unroll
            for (int half = 0; half < 2; ++half)
#pragma unroll
                for (int s = 0; s < 2; ++s) { float wv[8];
#pragma unroll
                    for (int j = 0; j < 8; ++j) { const int r = 8 * s + j; const float z = half ? p1[r] : p0[r];
                        float wgt = __builtin_amdgcn_exp2f(z - (E[4 * half + (r >> 2)] + Lh[half][r]));
                        if (diag) { const int key = 64 * kt + 32 * half + (r & 3) + 8 * (r >> 2) + 4 * hh; if (key >= qabs) wgt = 0.f; }
                        wv[j] = wgt; }
                    pw[half][s] = (u32x4){cvtpk(wv[0], wv[1]), cvtpk(wv[2], wv[3]), cvtpk(wv[4], wv[5]), cvtpk(wv[6], wv[7])}; }
#pragma unroll
            for (int half = 0; half < 2; ++half)
#pragma unroll
                for (int s = 0; s < 2; ++s) { const bf16x8 pb = __builtin_bit_cast(bf16x8, pw[half][s]);
                    const LAS unsigned char* vp = vbase + (32 * half + 16 * s) * SBV_STRIDE;
                    { const s16x4 lo = vtr(vp), hi = vtr(vp + 8 * SBV_STRIDE); const bf16x8 a = (bf16x8){lo[0], lo[1], lo[2], lo[3], hi[0], hi[1], hi[2], hi[3]};
                      o0 = __builtin_amdgcn_mfma_f32_32x32x16_bf16(a, pb, o0, 0, 0, 0); }
                    { const s16x4 lo = vtr(vp + 64), hi = vtr(vp + 8 * SBV_STRIDE + 64); const bf16x8 a = (bf16x8){lo[0], lo[1], lo[2], lo[3], hi[0], hi[1], hi[2], hi[3]};
                      o1 = __builtin_amdgcn_mfma_f32_32x32x16_bf16(a, pb, o1, 0, 0, 0); } }
        }
        if (SB_EARLY_EXIT) { const bool done = __all(carry > 150.0f); if (l == 0) flags[w] = done ? 1u : 0u; }
        if (kt == 0) break;
    }
    { bf16_t* orow = SQ + (rowbase + qabs) * 1024 + h * 64;
#pragma unroll
      for (int g4 = 0; g4 < 4; ++g4) { u32x2 a, c2; a.x = cvtpk(o0[4 * g4], o0[4 * g4 + 1]); a.y = cvtpk(o0[4 * g4 + 2], o0[4 * g4 + 3]); c2.x = cvtpk(o1[4 * g4], o1[4 * g4 + 1]); c2.y = cvtpk(o1[4 * g4 + 2], o1[4 * g4 + 3]);
          *(u32x2*)(orow + 8 * g4 + 4 * hh) = a; *(u32x2*)(orow + 32 + 8 * g4 + 4 * hh) = c2; } }
}
__device__ __forceinline__ void phase_attn(Frame& F) {
    if (F.vcu < 16) gla_scan(F, F.vcu);
    const int bh = F.vcu >> 2, s = F.vcu & 3;
    for (int i = 0; i < 4; ++i) { const int qb = (i == 0) ? s : (i == 1) ? 7 - s : (i == 2) ? 8 + s : 15 - s; sb_attn_unit(F, bh >> 4, bh & 15, qb); }
    __syncthreads();
}
__device__ __forceinline__ int okey(float v, int tag, int mask) { int u = __float_as_int(v); u ^= (u >> 31) & 0x7fffffff; return (u & ~mask) | tag; }
__device__ __forceinline__ float okey_val(int key, int mask) { int u = key & ~mask; u ^= (u >> 31) & 0x7fffffff; return __int_as_float(u); }
#define INS16(Lst, xin) do { int _x = (xin); _Pragma("unroll") for (int _j = 0; _j < 16; ++_j) { const int _h = max(Lst[_j], _x); _x = min(Lst[_j], _x); Lst[_j] = _h; } } while (0)

__device__ __forceinline__ void phase_peer_select(Frame& F, int hsel) {
    const float* S12 = F.out; unsigned* EXPO = WSP(unsigned, WS_EXP);
    LAS unsigned char* idxb = F.lds + RING_OFF + F.wave * 1024;
    const int l = F.lane, tl = l >> 3, hl = (l >> 1) & 3, half = l & 1;
    const int gw = F.vcu * NWAVES + F.wave, NGW = F.G * NWAVES;
    for (int bt = gw; bt < T_TOK / 8; bt += NGW) {
        const int t = bt * 8 + tl;
        const float* src = S12 + (size_t)t * 1024 + hl * 256 + half * 128;
        int L[16];
#pragma unroll
        for (int j = 0; j < 16; ++j) L[j] = INT_MIN;
#pragma unroll 2
        for (int i = 0; i < 128; i += 4) { const f32x4 v = *(const f32x4*)(src + i);
#pragma unroll
            for (int e = 0; e < 4; ++e) INS16(L, okey(v[e], 127 - (i + e), 127)); }
        int P[16];
#pragma unroll
        for (int j = 0; j < 16; ++j) P[j] = __shfl_xor(L[j], 1);
        float X[16], Y[16];
#pragma unroll
        for (int j = 0; j < 16; ++j) { X[j] = okey_val(L[j], 127); Y[j] = okey_val(P[j], 127); }
        { u32x4 pk;
          pk.x = (unsigned)(127 - (L[0] & 127)) | ((unsigned)(127 - (L[1] & 127)) << 8) | ((unsigned)(127 - (L[2] & 127)) << 16) | ((unsigned)(127 - (L[3] & 127)) << 24);
          pk.y = (unsigned)(127 - (L[4] & 127)) | ((unsigned)(127 - (L[5] & 127)) << 8) | ((unsigned)(127 - (L[6] & 127)) << 16) | ((unsigned)(127 - (L[7] & 127)) << 24);
          pk.z = (unsigned)(127 - (L[8] & 127)) | ((unsigned)(127 - (L[9] & 127)) << 8) | ((unsigned)(127 - (L[10] & 127)) << 16) | ((unsigned)(127 - (L[11] & 127)) << 24);
          pk.w = (unsigned)(127 - (L[12] & 127)) | ((unsigned)(127 - (L[13] & 127)) << 8) | ((unsigned)(127 - (L[14] & 127)) << 16) | ((unsigned)(127 - (L[15] & 127)) << 24);
          *(LAS u32x4*)(idxb + l * 16) = pk; }
        int M[16];
#pragma unroll
        for (int j = 0; j < 16; ++j) M[j] = INT_MIN;
#define CAND(i, j) do { const float sm = X[i] + Y[j]; const int pos = half ? ((j) * 16 + (i)) : ((i) * 16 + (j)); int key = okey(sm, 255 - pos, 255); if ((i) == (j) && half) key = INT_MIN; INS16(M, key); } while (0)
        CAND(0, 0); CAND(0, 1); CAND(0, 2); CAND(0, 3); CAND(0, 4); CAND(0, 5); CAND(0, 6); CAND(0, 7); CAND(0, 8); CAND(0, 9); CAND(0, 10); CAND(0, 11); CAND(0, 12); CAND(0, 13); CAND(0, 14); CAND(0, 15);
        CAND(1, 1); CAND(1, 2); CAND(1, 3); CAND(1, 4); CAND(1, 5); CAND(1, 6); CAND(1, 7);
        CAND(2, 2); CAND(2, 3); CAND(2, 4);
        CAND(3, 3);
#undef CAND
        int TK[16];
#pragma unroll
        for (int k = 0; k < 16; ++k) TK[k] = max(M[k], __shfl_xor(M[15 - k], 1));
        float sv[16]; float mx = -INFINITY;
#pragma unroll
        for (int k = 0; k < 16; ++k) { sv[k] = okey_val(TK[k], 255); mx = fmaxf(mx, sv[k]); }
        float den = 0.f;
#pragma unroll
        for (int k = 0; k < 16; ++k) { sv[k] = __expf(sv[k] - mx); den += sv[k]; }
        const float rden = 1.0f / den;
        LDS_WAIT(); asm volatile("" ::: "memory");
        const LAS unsigned char* i1b = idxb + (l & ~1) * 16; const LAS unsigned char* i2b = idxb + (l | 1) * 16;
        unsigned* dst = EXPO + (size_t)t * 128 + (hsel * 4 + hl) * 16 + half * 8;
#pragma unroll
        for (int k = 0; k < 8; ++k) { const int pos = 255 - (TK[k] & 255); const unsigned i1 = i1b[pos >> 4], i2 = i2b[pos & 15];
            const float gate = sv[k] * rden;
            dst[k] = (__float_as_uint(gate) & ~0x3fffu) | (i1 * 128u + i2); }
        LDS_WAIT(); asm volatile("" ::: "memory");
    }
}

__device__ __forceinline__ float dot2bf(unsigned a, unsigned b, float acc) { return __builtin_amdgcn_fdot2_f32_bf16(__builtin_bit_cast(bf16x2_t, a), __builtin_bit_cast(bf16x2_t, b), acc, false); }
__device__ __forceinline__ float gelu_tanh(float x) { const float y = 0.7978845608028654f * (x + 0.044715f * x * x * x); return x * __builtin_amdgcn_rcpf(1.0f + __expf(-2.0f * y)); }
__device__ __forceinline__ void phase_peer_gather(Frame& F) {
    const bf16_t* UB = WSP(bf16_t, WS_UB); const bf16_t* VB = WSP(bf16_t, WS_VB); const unsigned* EXPO = WSP(unsigned, WS_EXP);
    bf16_t* H1G = WSP(bf16_t, WS_H1G); float* H1 = WSP(float, WS_H1); const float* SSQ1 = WSP(float, WS_SSQ1); const float* g_ple = F.in[16];
    const int l = F.lane; const int gw = F.vcu * NWAVES + F.wave, NGW = F.G * NWAVES;
    for (int t = gw; t < T_TOK; t += NGW) {
        const u32x4 xa = *(const u32x4*)(H1G + (size_t)t * 1024 + 8 * l), xb = *(const u32x4*)(H1G + (size_t)t * 1024 + 512 + 8 * l);
        float rstd1; { const f32x4* sp = (const f32x4*)(SSQ1 + (size_t)t * 16); const f32x4 st = (sp[0] + sp[1]) + (sp[2] + sp[3]); rstd1 = __builtin_amdgcn_rsqf(((st[0] + st[1]) + (st[2] + st[3])) * (1.0f / 1024.0f) + EPS); }
        const unsigned e0 = EXPO[(size_t)t * 128 + l], e1 = EXPO[(size_t)t * 128 + 64 + l];
        float acc[16];
#pragma unroll
        for (int i = 0; i < 16; ++i) acc[i] = 0.f;
        for (int eb = 0; eb < 128; eb += 8) {
            unsigned ent[8]; u32x4 ua[8], ub[8];
#pragma unroll
            for (int k = 0; k < 8; ++k) { const int e = eb + k; ent[k] = (e < 64) ? __builtin_amdgcn_readlane(e0, e & 63) : __builtin_amdgcn_readlane(e1, e & 63);
                const bf16_t* up = UB + (size_t)(ent[k] & 0x3fffu) * 1024 + 8 * l; ua[k] = *(const u32x4*)up; ub[k] = *(const u32x4*)(up + 512); }
            float d[8];
#pragma unroll
            for (int k = 0; k < 8; ++k) { float s = 0.f;
                s = dot2bf(ua[k].x, xa.x, s); s = dot2bf(ua[k].y, xa.y, s); s = dot2bf(ua[k].z, xa.z, s); s = dot2bf(ua[k].w, xa.w, s);
                s = dot2bf(ub[k].x, xb.x, s); s = dot2bf(ub[k].y, xb.y, s); s = dot2bf(ub[k].z, xb.z, s); s = dot2bf(ub[k].w, xb.w, s); d[k] = s; }
#pragma unroll
            for (int k = 0; k < 8; ++k) { const bf16_t* vp = VB + (size_t)(ent[k] & 0x3fffu) * 1024 + 8 * l; ua[k] = *(const u32x4*)vp; ub[k] = *(const u32x4*)(vp + 512); }
#pragma unroll
            for (int k = 0; k < 8; ++k) d[k] = wave_sum(d[k]);
#pragma unroll
            for (int k = 0; k < 8; ++k) { const float a = gelu_tanh(d[k] * rstd1) * __uint_as_float(ent[k] & ~0x3fffu);
                acc[0] += a * bf_lo(ua[k].x); acc[1] += a * bf_hi(ua[k].x); acc[2] += a * bf_lo(ua[k].y); acc[3] += a * bf_hi(ua[k].y);
                acc[4] += a * bf_lo(ua[k].z); acc[5] += a * bf_hi(ua[k].z); acc[6] += a * bf_lo(ua[k].w); acc[7] += a * bf_hi(ua[k].w);
                acc[8] += a * bf_lo(ub[k].x); acc[9] += a * bf_hi(ub[k].x); acc[10] += a * bf_lo(ub[k].y); acc[11] += a * bf_hi(ub[k].y);
                acc[12] += a * bf_lo(ub[k].z); acc[13] += a * bf_hi(ub[k].z); acc[14] += a * bf_lo(ub[k].w); acc[15] += a * bf_hi(ub[k].w); }
        }
        float* hrow = H1 + (size_t)t * 1024; float ss = 0.f; f32x4 h[4];
#pragma unroll
        for (int q = 0; q < 4; ++q) { const int col = (q >> 1) * 512 + 8 * l + 4 * (q & 1); h[q] = *(const f32x4*)(hrow + col);
#pragma unroll
            for (int j = 0; j < 4; ++j) { h[q][j] += acc[4 * q + j]; ss += h[q][j] * h[q][j]; }
            *(f32x4*)(hrow + col) = h[q]; }
        const float rstd3 = __builtin_amdgcn_rsqf(wave_sum(ss) * (1.0f / 1024.0f) + EPS);
#pragma unroll
        for (int q2 = 0; q2 < 2; ++q2) { const int col = q2 * 512 + 8 * l; const f32x4 g0 = *(const f32x4*)(g_ple + col), g1 = *(const f32x4*)(g_ple + col + 4);
            const f32x4 a = h[2 * q2] * rstd3 * g0, c = h[2 * q2 + 1] * rstd3 * g1;
            u32x4 o; o.x = cvtpk(a[0], a[1]); o.y = cvtpk(a[2], a[3]); o.z = cvtpk(c[0], c[1]); o.w = cvtpk(c[2], c[3]);
            *(u32x4*)(H1G + (size_t)t * 1024 + col) = o; }
    }
}

__device__ __forceinline__ void phase_final(Frame& F) {
    const float* SSQ3 = WSP(float, WS_SSQ3); const float* g = F.in[19];
    const int l = F.lane; const int gw = F.vcu * NWAVES + F.wave, NGW = F.G * NWAVES;
    for (int t = gw; t < T_TOK; t += NGW) {
        const f32x4* sp = (const f32x4*)(SSQ3 + (size_t)t * 16); const f32x4 st = (sp[0] + sp[1]) + (sp[2] + sp[3]);
        const float rstd = __builtin_amdgcn_rsqf(((st[0] + st[1]) + (st[2] + st[3])) * (1.0f / 1024.0f) + EPS);
        f32x4* row = (f32x4*)(F.out + (size_t)t * 1024);
#pragma unroll
        for (int j = 0; j < 4; ++j) { const f32x4 gv = *((const f32x4*)g + l + 64 * j); row[l + 64 * j] = row[l + 64 * j] * rstd * gv; }
    }
}
#ifndef MK_FUSED
#define MK_FUSED 1
#endif
constexpr int NPHASE = 14;
struct Args { const float* in[20]; float* out; unsigned char* ws; int ph_lo, ph_hi; };
static_assert(sizeof(Args) == 20 * 8 + 8 + 8 + 4 + 4, "Args has no padding");

__global__ void __launch_bounds__(NWAVES * 64, 2) mk_fwd(Args args) {
    extern __shared__ __attribute__((aligned(16))) unsigned char lds_raw[];
    Frame F;
    F.lds = (LAS unsigned char*)lds_raw;
    F.tid = threadIdx.x; F.lane = F.tid & 63; F.wave = __builtin_amdgcn_readfirstlane(F.tid >> 6);
    F.G = gridDim.x; { const int bx = blockIdx.x; F.vcu = (F.G % 8 == 0) ? (bx % 8) * (F.G / 8) + bx / 8 : bx; }
    F.in = args.in; F.out = args.out; F.ws = args.ws;
    volatile LAS unsigned* MISC = (volatile LAS unsigned*)(F.lds + MISC_OFF);
    if (F.tid < 64) MISC[F.tid] = 0u;
    __syncthreads();
    const int lo = args.ph_lo, hi = args.ph_hi;
    XcdBarrier bar; bar.bar = (unsigned*)(F.ws + WS_CTL) + CW_BAR; bar.x = 0; bar.st = nullptr;
    if (hi - lo > 1) bar = xcd_barrier_post((unsigned*)(F.ws + WS_CTL) + CW_BAR, MISC + 8);
#ifndef PH_MASK
#define PH_MASK 0xFFFFFFFFu
#endif
#define IN(k) (((PH_MASK >> (k)) & 1u) && lo <= (k) && (k) < hi)
#define SEAM(k) do { if (IN(k) && IN((k) + 1)) xcd_barrier(bar); } while (0)
    const int bx = (int)blockIdx.x;
    LAS unsigned char* ring = F.lds + RING_OFF;

    if (IN(0)) { phase_prologue(F); } SEAM(0);
    if (IN(1)) {
        pg8::Gemm g{WSP(bf16_t, WS_XN1), WSP(bf16_t, WS_WIN), T_TOK, 8192, 1024, 1024, 0}; pg8::StaticOrder S; S.init(T_TOK, 8192, F.G, bx);
        pg8::EpiProj E{WSP(bf16_t, WS_GQ), WSP(bf16_t, WS_GK), WSP(bf16_t, WS_GV), WSP(bf16_t, WS_GR), WSP(bf16_t, WS_SQ), WSP(bf16_t, WS_SK), WSP(bf16_t, WS_SV),
                       (bf16_t*)F.out, (bf16_t*)F.out + (size_t)T_TOK * 1024};
        pg8::gemm_phase<pg8::EpiProj>(ring, g, S, E);
    } SEAM(1);
    if (IN(2)) { phase_gla_prep(F); } SEAM(2);
    if (IN(3)) { phase_attn(F); } SEAM(3);
    if (IN(4)) {
        cvt_copy(F, F.in[14], WSP(bf16_t, WS_UB), (size_t)16384 * 1024);
        cvt_copy(F, F.in[15], WSP(bf16_t, WS_VB), (size_t)16384 * 1024);
        __syncthreads();
        pg8::StaticOrder S; S.init(T_TOK, 1024, F.G, bx);
        { pg8::Gemm g{WSP(bf16_t, WS_GLAN), WSP(bf16_t, WS_WGA), T_TOK, 1024, 1024, 1024, 0}; pg8::EpiMix<true> E{(const bf16_t*)F.out, WSP(bf16_t, WS_MIX)};
          pg8::gemm_phase<pg8::EpiMix<true>>(ring, g, S, E); }
        { pg8::Gemm g{WSP(bf16_t, WS_SQ), WSP(bf16_t, WS_WSB), T_TOK, 1024, 1024, 1024, 0}; pg8::EpiMix<false> E{(const bf16_t*)F.out + (size_t)T_TOK * 1024, WSP(bf16_t, WS_MIX)};
          pg8::gemm_phase<pg8::EpiMix<false>>(ring, g, S, E); }
    } SEAM(4);
    if (IN(5)) {
        pg8::Gemm g{WSP(bf16_t, WS_MIX), WSP(bf16_t, WS_WO), T_TOK, 1024, 1024, 1024, 0}; pg8::StaticOrder S; S.init(T_TOK, 1024, F.G, bx);
        pg8::EpiH1 E{F.in[0], F.in[10], WSP(float, WS_H1), WSP(bf16_t, WS_H1G), WSP(float, WS_SSQ1)};
        pg8::gemm_phase<pg8::EpiH1>(ring, g, S, E);
    } SEAM(5);
    if (IN(6)) {
        pg8::Gemm g{WSP(bf16_t, WS_H1G), WSP(bf16_t, WS_WPQ), T_TOK, 2048, 1024, 1024, 0}; pg8::StaticOrder S; S.init(T_TOK, 2048, F.G, bx);
        pg8::EpiQ E{WSP(float, WS_SSQ1), WSP(bf16_t, WS_Q), 2048};
        pg8::gemm_phase<pg8::EpiQ>(ring, g, S, E);
    } SEAM(6);
#define PEER_SCORES(hs) do { if (IN(7 + 2 * (hs))) { \
            pg8::Gemm g{WSP(bf16_t, WS_Q) + (hs) * 1024, WSP(bf16_t, WS_KD) + (size_t)(hs) * 1024 * 256, T_TOK, 1024, 256, 2048, 256}; pg8::StaticOrder S; S.init(T_TOK, 1024, F.G, bx); \
            pg8::EpiF32 E{F.out, 1024}; \
            pg8::gemm_phase<pg8::EpiF32>(ring, g, S, E); \
        } SEAM(7 + 2 * (hs)); \
        if (IN(8 + 2 * (hs))) { phase_peer_select(F, (hs)); } SEAM(8 + 2 * (hs)); } while (0)
    PEER_SCORES(0);
    PEER_SCORES(1);
#undef PEER_SCORES
    if (IN(11)) { cvt_copy(F, F.in[1], WSP(bf16_t, WS_PB), (size_t)T_TOK * 256); phase_peer_gather(F); } SEAM(11);
    if (IN(12)) {
        pg8::StaticOrder S; S.init(T_TOK, 1024, F.G, bx);
        { pg8::Gemm g{WSP(bf16_t, WS_PB), WSP(bf16_t, WS_WPLE), T_TOK, 1024, 256, 256, 0}; pg8::EpiBf E{WSP(bf16_t, WS_PLE), 1024};
          pg8::gemm_phase<pg8::EpiBf>(ring, g, S, E); }
        { pg8::Gemm g{WSP(bf16_t, WS_H1G), WSP(bf16_t, WS_WPG), T_TOK, 1024, 1024, 1024, 0}; pg8::EpiH3 E{WSP(float, WS_H1), WSP(bf16_t, WS_PLE), F.out, WSP(float, WS_SSQ3)};
          pg8::gemm_phase<pg8::EpiH3>(ring, g, S, E); }
    } SEAM(12);
    if (IN(13)) { phase_final(F); }
#undef IN
#undef SEAM
}

extern "C" void kernel_launch(void* const* d_in, const int* in_sizes, int n_in, void* d_out, int out_size, void* d_ws, size_t ws_size, hipStream_t stream) {
    static int grid = 0;
    if (grid == 0) {
        if (n_in != 20 || in_sizes[0] != T_TOK * 1024 || out_size != T_TOK * 1024 || ws_size < WS_END) {
            fprintf(stderr, "kernel_launch: unexpected shapes (n_in %d, in0 %d, out %d, ws %zu < %zu?); nothing launched\n", n_in, n_in > 0 ? in_sizes[0] : -1, out_size, ws_size, (size_t)WS_END); grid = -1; return; }
        int dev = 0, cus = 0, per_cu = 0;
        if (hipGetDevice(&dev) != hipSuccess || hipDeviceGetAttribute(&cus, hipDeviceAttributeMultiprocessorCount, dev) != hipSuccess) { grid = -1; return; }
        if (hipFuncSetAttribute((const void*)mk_fwd, hipFuncAttributeMaxDynamicSharedMemorySize, LDS_BYTES) != hipSuccess) { fprintf(stderr, "kernel_launch: hipFuncSetAttribute failed\n"); grid = -1; return; }
        if (hipOccupancyMaxActiveBlocksPerMultiprocessor(&per_cu, (const void*)mk_fwd, NWAVES * 64, LDS_BYTES) != hipSuccess || per_cu < 1)
            fprintf(stderr, "kernel_launch: note: occupancy query reports %d workgroups per CU\n", per_cu);
        (void)hipGetLastError();
        grid = cus;
        if (grid != 256) fprintf(stderr, "kernel_launch: note: %d CUs (kernel tuned for 256)\n", grid);
    }
    if (grid < 0) return;
    if (hipMemsetAsync((char*)d_ws + WS_CTL, 0, CTL_ZERO_BYTES, stream) != hipSuccess) { fprintf(stderr, "kernel_launch: hipMemsetAsync failed\n"); return; }
    Args a{};
    for (int i = 0; i < 20; ++i) a.in[i] = (const float*)d_in[i];
    a.out = (float*)d_out; a.ws = (unsigned char*)d_ws;
#if MK_FUSED
    a.ph_lo = 0; a.ph_hi = NPHASE;
    hipLaunchKernelGGL(mk_fwd, dim3(grid), dim3(NWAVES * 64), LDS_BYTES, stream, a);
#else
    for (int p = 0; p < NPHASE; ++p) { a.ph_lo = p; a.ph_hi = p + 1; hipLaunchKernelGGL(mk_fwd, dim3(grid), dim3(NWAVES * 64), LDS_BYTES, stream, a); }
#endif
}
```

```cpp
#define MK_FUSED 1
#include <hip/hip_runtime.h>
#include <cstdio>
#include <cstdint>

#define LAS __attribute__((address_space(3)))
#define GAS __attribute__((address_space(1)))
typedef unsigned short bf16_t;
typedef short bf16x8 __attribute__((ext_vector_type(8)));
typedef short s16x4 __attribute__((ext_vector_type(4)));
typedef float f32x2 __attribute__((ext_vector_type(2)));
typedef float f32x4 __attribute__((ext_vector_type(4)));
typedef float f32x16 __attribute__((ext_vector_type(16)));
typedef unsigned u32x2 __attribute__((ext_vector_type(2)));
typedef unsigned u32x4 __attribute__((ext_vector_type(4)));
typedef __bf16 bf16x2_t __attribute__((ext_vector_type(2)));

__device__ __forceinline__ unsigned cvtpk(float lo, float hi) { f32x2 v = {lo, hi}; bf16x2_t b = __builtin_convertvector(v, bf16x2_t); return __builtin_bit_cast(unsigned, b); }
__device__ __forceinline__ float bf_lo(unsigned u) { return __uint_as_float(u << 16); }
__device__ __forceinline__ float bf_hi(unsigned u) { return __uint_as_float(u & 0xffff0000u); }
__device__ __forceinline__ float bf1(bf16_t u) { return __uint_as_float(((unsigned)u) << 16); }
__device__ __forceinline__ float fast_sigmoid(float x) { return __builtin_amdgcn_rcpf(1.0f + __expf(-x)); }

namespace pg8 {
constexpr int BM = 256, BK = 64, HALF = 128, HTB = HALF * BK * 2  , STAGE_BYTES = 8 * HTB, NXCD = 8, WGM = 8;

__host__ __device__ __forceinline__ int lds_byte(int r, int c) { const int st = (r >> 4) * 2 + (c >> 5), rr = r & 15, cc = c & 31, ob = rr * 64 + cc * 2; return st * 1024 + (ob ^ (((ob >> 9) & 1) << 5)); }
__host__ __device__ __forceinline__ void stage_rc(int b, int& R, int& C) { const int st = b / 1024, sb = b % 1024, swz = sb ^ (((sb >> 9) & 1) << 5); R = (st >> 1) * 16 + swz / 64; C = (st & 1) * 32 + (swz % 64) / 2; }
__host__ __device__ __forceinline__ int perm32(int rho) { const int n = rho >> 4, i = rho & 15; return 8 * (i >> 2) + 4 * n + (i & 3); }

struct Unit { int pm, pn; };
struct Gemm { const bf16_t* A; const bf16_t* Bt; int M, N, K, lda, a_pn_cols; };

struct StaticOrder {
    int nM, nN, nwg, G, c;
    __host__ __device__ void init(int M, int N, int G_, int c_) { nM = M / BM; nN = N / BM; nwg = nM * nN; G = G_; c = c_; }
    __host__ __device__ bool next(int i, Unit& u) const {
        const long L = (long)i * G + c; if (L >= nwg) return false;
        int wgid = (int)L; { const int q = nwg / NXCD, r = nwg % NXCD, xcd = wgid % NXCD, off = wgid / NXCD; wgid = (xcd < r ? xcd * (q + 1) : r * (q + 1) + (xcd - r) * q) + off; }
        const int nig = WGM * nN, gid = wgid / nig, fm = gid * WGM, gsz = (nM - fm) < WGM ? (nM - fm) : WGM;
        u.pm = fm + ((wgid % nig) % gsz); u.pn = (wgid % nig) / gsz; return true;
    }
};

template <class Epi, bool ALIGN_EPI = true, bool SP2 = true>
__device__ __forceinline__ void gemm_phase(LAS unsigned char* lds, const Gemm g, const StaticOrder& S, const Epi& E, int tid) {
    const int wid = __builtin_amdgcn_readfirstlane(tid >> 6), lane = tid & 63, wr = wid >> 2, wc = wid & 3, fr = lane & 15, fq = lane >> 4;
    const int K = g.K, nt = K / BK, lda = g.lda;
    unsigned voffA[2], voffB[2];
#pragma unroll
    for (int i = 0; i < 2; ++i) { int R, C; stage_rc(tid * 16 + i * 8192, R, C); const int Rb = Epi::PERM ? ((R & ~31) + perm32(R & 31)) : R;
        voffA[i] = (unsigned)(R * lda + C) * 2u; voffB[i] = (unsigned)(Rb * K + C) * 2u; }
    const size_t kstep = (size_t)(BK * 2);
    const size_t hA = (size_t)HALF * lda * 2, hB = (size_t)HALF * K * 2;
    const size_t tA = 2 * hA, tB = 2 * hB;
    const size_t pnA = (size_t)g.a_pn_cols * 2;
    const unsigned ldsw = (unsigned)wid * 1024u;
    const int aoff = lds_byte(wr * 64 + fr, fq * 8), boff = lds_byte(wc * 32 + fr, fq * 8);
#define PG8_SA(b, h) (((b) * 2 + (h)) * HTB)
#define PG8_SB(b, h) ((4 + (b) * 2 + (h)) * HTB)
#define PG8_STAGE(bufoff, gbase, voff) do { _Pragma("unroll") for (int _i = 0; _i < 2; ++_i) \
        __builtin_amdgcn_global_load_lds((const unsigned*)((const char*)(gbase) + (voff)[_i]), (LAS unsigned*)(lds + (bufoff) + ldsw + _i * 8192), 16, 0, 0); } while (0)
#define PG8_LDA(dst, b, h) do { _Pragma("unroll") for (int m = 0; m < 4; ++m) _Pragma("unroll") for (int k = 0; k < 2; ++k) dst[m][k] = *(const LAS bf16x8*)(lds + PG8_SA(b, h) + aoff + m * 2048 + k * 1024); } while (0)
#define PG8_LDB(dst, b, h) do { _Pragma("unroll") for (int n = 0; n < 2; ++n) _Pragma("unroll") for (int k = 0; k < 2; ++k) dst[n][k] = *(const LAS bf16x8*)(lds + PG8_SB(b, h) + boff + n * 2048 + k * 1024); } while (0)
#define PG8_MMA(ai, bj, At, Bt) do { __builtin_amdgcn_s_setprio(1); _Pragma("unroll") for (int m = 0; m < 4; ++m) _Pragma("unroll") for (int n = 0; n < 2; ++n) _Pragma("unroll") for (int k = 0; k < 2; ++k) \
        acc[ai][bj][m][n] = __builtin_amdgcn_mfma_f32_16x16x32_bf16(Bt[n][k], At[m][k], acc[ai][bj][m][n], 0, 0, 0); __builtin_amdgcn_s_setprio(0); } while (0)
#define PG8_WAIT_V(n) asm volatile("s_waitcnt vmcnt(" #n ")" ::: "memory")
#define PG8_WAIT_L(n) asm volatile("s_waitcnt lgkmcnt(" #n ")" ::: "memory")
#define PG8_BAR __builtin_amdgcn_s_barrier()
#define PG8_SCHED __builtin_amdgcn_sched_barrier(0)
    Unit cur, nxt; int ui = 0;
    if (!S.next(0, cur)) return;
    f32x4 acc[2][2][4][2];
#pragma unroll
    for (int a = 0; a < 2; ++a)
#pragma unroll
        for (int b = 0; b < 2; ++b)
#pragma unroll
            for (int m = 0; m < 4; ++m)
#pragma unroll
                for (int n = 0; n < 2; ++n) acc[a][b][m][n] = (f32x4){0.f, 0.f, 0.f, 0.f};
    bf16x8 At[4][2], B0[2][2], B1[2][2];
    const char* cA = (const char*)g.A + (size_t)cur.pm * tA + (size_t)cur.pn * pnA; const char* cB = (const char*)g.Bt + (size_t)cur.pn * tB;
    if constexpr (SP2) {
        PG8_STAGE(PG8_SB(0, 0), cB, voffB); PG8_STAGE(PG8_SB(0, 1), cB + hB, voffB); PG8_STAGE(PG8_SA(0, 0), cA, voffA); PG8_STAGE(PG8_SA(0, 1), cA + hA, voffA);
        if (wr == 1) PG8_BAR;
        PG8_WAIT_V(2); PG8_BAR;
        PG8_STAGE(PG8_SB(1, 0), cB + kstep, voffB); PG8_STAGE(PG8_SA(1, 0), cA + kstep, voffA); PG8_STAGE(PG8_SB(1, 1), cB + hB + kstep, voffB);
        PG8_WAIT_V(6); PG8_BAR;
    } else {
        PG8_STAGE(PG8_SB(0, 0), cB, voffB); PG8_STAGE(PG8_SA(0, 0), cA, voffA); PG8_STAGE(PG8_SB(0, 1), cB + hB, voffB); PG8_STAGE(PG8_SA(0, 1), cA + hA, voffA);
        if (wr == 1) PG8_BAR;
        PG8_WAIT_V(4); PG8_BAR;
        PG8_STAGE(PG8_SB(1, 0), cB + kstep, voffB); PG8_STAGE(PG8_SA(1, 0), cA + kstep, voffA); PG8_STAGE(PG8_SB(1, 1), cB + hB + kstep, voffB);
        PG8_WAIT_V(6); PG8_BAR;
    }
    for (;;) {
        const bool has_next = S.next(ui + 1, nxt);
        const char* nA = has_next ? (const char*)g.A + (size_t)nxt.pm * tA + (size_t)nxt.pn * pnA : cA; const char* nB = has_next ? (const char*)g.Bt + (size_t)nxt.pn * tB : cB;
#pragma unroll 1
        for (int t = 0; t < nt; t += 2) {
            const bool last = (t == nt - 2);
            const char* a1 = cA + (size_t)(t + 1) * kstep;
            const char* a2 = last ? nA : cA + (size_t)(t + 2) * kstep; const char* b2 = last ? nB : cB + (size_t)(t + 2) * kstep;
            const char* a3 = a2 + kstep; const char* b3 = b2 + kstep;
            if constexpr (SP2) {
            PG8_LDB(B0, 0, 0); PG8_LDB(B1, 0, 1); PG8_SCHED; PG8_LDA(At, 0, 0); PG8_STAGE(PG8_SA(1, 1), a1 + hA, voffA);
            PG8_WAIT_V(8); PG8_WAIT_L(0); PG8_BAR; PG8_MMA(0, 0, At, B0); PG8_MMA(0, 1, At, B1); PG8_BAR; PG8_SCHED;
            PG8_LDA(At, 0, 1); PG8_STAGE(PG8_SB(0, 0), b2, voffB); PG8_STAGE(PG8_SB(0, 1), b2 + hB, voffB); PG8_STAGE(PG8_SA(0, 0), a2, voffA);
            PG8_WAIT_V(8); PG8_WAIT_L(0); PG8_BAR; PG8_MMA(1, 0, At, B0); PG8_MMA(1, 1, At, B1); PG8_BAR; PG8_SCHED;
            PG8_LDB(B0, 1, 0); PG8_LDB(B1, 1, 1); PG8_SCHED; PG8_LDA(At, 1, 0); PG8_STAGE(PG8_SA(0, 1), a2 + hA, voffA);
            PG8_WAIT_V(8); PG8_WAIT_L(0); PG8_BAR; PG8_MMA(0, 0, At, B0); PG8_MMA(0, 1, At, B1); PG8_BAR; PG8_SCHED;
            PG8_LDA(At, 1, 1); PG8_STAGE(PG8_SB(1, 0), b3, voffB); PG8_STAGE(PG8_SB(1, 1), b3 + hB, voffB); PG8_STAGE(PG8_SA(1, 0), a3, voffA);
            PG8_WAIT_V(8); PG8_WAIT_L(0); PG8_BAR; PG8_MMA(1, 0, At, B0); PG8_MMA(1, 1, At, B1); PG8_BAR; PG8_SCHED;
            } else {
            PG8_LDB(B0, 0, 0); PG8_SCHED; PG8_LDA(At, 0, 0); PG8_STAGE(PG8_SA(1, 1), a1 + hA, voffA);
            PG8_WAIT_L(8); PG8_BAR; PG8_WAIT_L(0); PG8_MMA(0, 0, At, B0); PG8_BAR; PG8_SCHED;
            PG8_LDB(B1, 0, 1); PG8_STAGE(PG8_SB(0, 0), b2, voffB);
            PG8_BAR; PG8_WAIT_L(0); PG8_MMA(0, 1, At, B1); PG8_BAR;
            PG8_LDA(At, 0, 1); PG8_STAGE(PG8_SA(0, 0), a2, voffA);
            PG8_BAR; PG8_WAIT_L(0); PG8_MMA(1, 0, At, B0); PG8_BAR; PG8_SCHED;
            PG8_STAGE(PG8_SB(0, 1), b2 + hB, voffB);
            PG8_WAIT_V(6); PG8_BAR; PG8_MMA(1, 1, At, B1); PG8_BAR;
            PG8_LDB(B0, 1, 0); PG8_SCHED; PG8_LDA(At, 1, 0); PG8_STAGE(PG8_SA(0, 1), a2 + hA, voffA);
            PG8_WAIT_L(8); PG8_BAR; PG8_WAIT_L(0); PG8_MMA(0, 0, At, B0); PG8_BAR; PG8_SCHED;
            PG8_LDB(B1, 1, 1); PG8_STAGE(PG8_SB(1, 0), b3, voffB);
            PG8_BAR; PG8_WAIT_L(0); PG8_MMA(0, 1, At, B1); PG8_BAR;
            PG8_LDA(At, 1, 1); PG8_STAGE(PG8_SA(1, 0), a3, voffA);
            PG8_BAR; PG8_WAIT_L(0); PG8_MMA(1, 0, At, B0); PG8_BAR; PG8_SCHED;
            PG8_STAGE(PG8_SB(1, 1), b3 + hB, voffB);
            PG8_WAIT_V(6); PG8_BAR; PG8_MMA(1, 1, At, B1); PG8_BAR;
            }
        }
        if constexpr (ALIGN_EPI) { if (wr == 0) PG8_BAR; }
        E(acc, cur, wr, wc, fr, fq);
        if (!has_next) break;
#pragma unroll
        for (int a = 0; a < 2; ++a)
#pragma unroll
            for (int b = 0; b < 2; ++b)
#pragma unroll
                for (int m = 0; m < 4; ++m)
#pragma unroll
                    for (int n = 0; n < 2; ++n) acc[a][b][m][n] = (f32x4){0.f, 0.f, 0.f, 0.f};
        cur = nxt; cA = nA; cB = nB; ++ui;
        if constexpr (ALIGN_EPI) { if (wr == 1) PG8_BAR; }
    }
    PG8_WAIT_V(0);
    if constexpr (!ALIGN_EPI) { if (wr == 0) PG8_BAR; }
    PG8_BAR;
#undef PG8_SA
#undef PG8_SB
#undef PG8_STAGE
#undef PG8_LDA
#undef PG8_LDB
#undef PG8_MMA
#undef PG8_WAIT_V
#undef PG8_WAIT_L
#undef PG8_BAR
#undef PG8_SCHED
}
}
constexpr int T_TOK = 16384, DM = 1024, SEQ = 4096, NB = 4;
constexpr float EPS = 1e-6f;
constexpr float LOG2E = 1.4426950408889634f;

namespace pg8 {
struct EpiProj {
    static constexpr bool PERM = true;
    bf16_t *GQ, *GK, *GV, *GR, *SQ, *SK, *SV, *SGA, *SGB;
    __device__ __forceinline__ void operator()(const f32x4 (&acc)[2][2][4][2], const Unit& u, int wr, int wc, int fr, int fq) const {
        const int pn = u.pn; bf16_t* base; int ldc = 1024, c0; int act = 0; float sc = 1.f;
        if (pn < 2) { base = GQ; ldc = 512; c0 = pn * 256; sc = 0.08838834764831845f; }
        else if (pn < 4) { base = GK; ldc = 512; c0 = (pn - 2) * 256; }
        else if (pn < 8) { base = GV; c0 = (pn - 4) * 256; }
        else if (pn < 12) { base = GR; c0 = (pn - 8) * 256; act = 1; }
        else if (pn < 16) { base = SQ; c0 = (pn - 12) * 256; sc = 0.125f * LOG2E; }
        else if (pn < 20) { base = SK; c0 = (pn - 16) * 256; }
        else if (pn < 24) { base = SV; c0 = (pn - 20) * 256; }
        else if (pn < 28) { base = SGA; c0 = (pn - 24) * 256; act = 2; }
        else { base = SGB; c0 = (pn - 28) * 256; act = 2; }
        const int row0 = u.pm * BM + wr * 64 + fr, col0 = c0 + wc * 32 + 8 * fq;
#pragma unroll
        for (int ai = 0; ai < 2; ++ai)
#pragma unroll
            for (int m = 0; m < 4; ++m) { bf16_t* rowp = base + (size_t)(row0 + ai * HALF + m * 16) * ldc + col0;
#pragma unroll
                for (int bj = 0; bj < 2; ++bj) { f32x4 v0 = acc[ai][bj][m][0], v1 = acc[ai][bj][m][1];
                    if (act == 1) {
#pragma unroll
                        for (int j = 0; j < 4; ++j) { v0[j] = v0[j] * fast_sigmoid(v0[j]); v1[j] = v1[j] * fast_sigmoid(v1[j]); } }
                    else if (act == 2) {
#pragma unroll
                        for (int j = 0; j < 4; ++j) { v0[j] = fast_sigmoid(v0[j]); v1[j] = fast_sigmoid(v1[j]); } }
                    else { v0 = v0 * sc; v1 = v1 * sc; }
                    u32x4 w; w.x = cvtpk(v0[0], v0[1]); w.y = cvtpk(v0[2], v0[3]); w.z = cvtpk(v1[0], v1[1]); w.w = cvtpk(v1[2], v1[3]);
                    *(u32x4*)(rowp + bj * HALF) = w; } }
    }
};
template <bool FIRST> struct EpiMix {
    static constexpr bool PERM = true;
    const bf16_t* gate; bf16_t* mixed;
    __device__ __forceinline__ void operator()(const f32x4 (&acc)[2][2][4][2], const Unit& u, int wr, int wc, int fr, int fq) const {
        const int row0 = u.pm * BM + wr * 64 + fr, col0 = u.pn * BM + wc * 32 + 8 * fq;
#pragma unroll
        for (int ai = 0; ai < 2; ++ai)
#pragma unroll
            for (int m = 0; m < 4; ++m) { const size_t off = (size_t)(row0 + ai * HALF + m * 16) * 1024 + col0;
#pragma unroll
                for (int bj = 0; bj < 2; ++bj) { const f32x4 a0 = acc[ai][bj][m][0], a1 = acc[ai][bj][m][1];
                    const u32x4 gv = *(const u32x4*)(gate + off + bj * HALF);
                    float r[8];
                    r[0] = a0[0] * bf_lo(gv.x); r[1] = a0[1] * bf_hi(gv.x); r[2] = a0[2] * bf_lo(gv.y); r[3] = a0[3] * bf_hi(gv.y);
                    r[4] = a1[0] * bf_lo(gv.z); r[5] = a1[1] * bf_hi(gv.z); r[6] = a1[2] * bf_lo(gv.w); r[7] = a1[3] * bf_hi(gv.w);
                    if (!FIRST) { const u32x4 mv = *(const u32x4*)(mixed + off + bj * HALF);
                        r[0] += bf_lo(mv.x); r[1] += bf_hi(mv.x); r[2] += bf_lo(mv.y); r[3] += bf_hi(mv.y); r[4] += bf_lo(mv.z); r[5] += bf_hi(mv.z); r[6] += bf_lo(mv.w); r[7] += bf_hi(mv.w); }
                    u32x4 w; w.x = cvtpk(r[0], r[1]); w.y = cvtpk(r[2], r[3]); w.z = cvtpk(r[4], r[5]); w.w = cvtpk(r[6], r[7]);
                    *(u32x4*)(mixed + off + bj * HALF) = w; } }
    }
};
struct EpiH1 {
    static constexpr bool PERM = false;
    const float* x; const float* g; float* H1; bf16_t* H1G; float* SSQ;
    __device__ __forceinline__ void operator()(const f32x4 (&acc)[2][2][4][2], const Unit& u, int wr, int wc, int fr, int fq) const {
        const int row0 = u.pm * BM + wr * 64 + fr, col0 = u.pn * BM + wc * 32 + 4 * fq;
        f32x4 gv[2][2];
#pragma unroll
        for (int bj = 0; bj < 2; ++bj)
#pragma unroll
            for (int n = 0; n < 2; ++n) gv[bj][n] = *(const f32x4*)(g + col0 + bj * HALF + n * 16);
#pragma unroll
        for (int ai = 0; ai < 2; ++ai)
#pragma unroll
            for (int m = 0; m < 4; ++m) { const int row = row0 + ai * HALF + m * 16; const size_t off = (size_t)row * 1024 + col0; float s = 0.f;
#pragma unroll
                for (int bj = 0; bj < 2; ++bj)
#pragma unroll
                    for (int n = 0; n < 2; ++n) { const f32x4 xv = *(const f32x4*)(x + off + bj * HALF + n * 16); const f32x4 h = xv + acc[ai][bj][m][n];
                        *(f32x4*)(H1 + off + bj * HALF + n * 16) = h; s += (h[0] * h[0] + h[1] * h[1]) + (h[2] * h[2] + h[3] * h[3]);
                        const f32x4 hg = h * gv[bj][n]; u32x2 w; w.x = cvtpk(hg[0], hg[1]); w.y = cvtpk(hg[2], hg[3]); *(u32x2*)(H1G + off + bj * HALF + n * 16) = w; }
                s += __shfl_xor(s, 16); s += __shfl_xor(s, 32);
                if (fq == 0) SSQ[(size_t)row * 16 + u.pn * 4 + wc] = s; }
    }
};
struct EpiQ {
    static constexpr bool PERM = true;
    const float* SSQ; bf16_t* Q; int ldc;
    __device__ __forceinline__ void operator()(const f32x4 (&acc)[2][2][4][2], const Unit& u, int wr, int wc, int fr, int fq) const {
        const int row0 = u.pm * BM + wr * 64 + fr, col0 = u.pn * BM + wc * 32 + 8 * fq;
#pragma unroll
        for (int ai = 0; ai < 2; ++ai)
#pragma unroll
            for (int m = 0; m < 4; ++m) { const int row = row0 + ai * HALF + m * 16; const f32x4* sp = (const f32x4*)(SSQ + (size_t)row * 16);
                const f32x4 s0 = sp[0], s1 = sp[1], s2 = sp[2], s3 = sp[3]; const f32x4 st = (s0 + s1) + (s2 + s3);
                const float rstd = __builtin_amdgcn_rsqf(((st[0] + st[1]) + (st[2] + st[3])) * (1.0f / 1024.0f) + EPS);
                bf16_t* rowp = Q + (size_t)row * ldc + col0;
#pragma unroll
                for (int bj = 0; bj < 2; ++bj) { const f32x4 v0 = acc[ai][bj][m][0] * rstd, v1 = acc[ai][bj][m][1] * rstd;
                    u32x4 w; w.x = cvtpk(v0[0], v0[1]); w.y = cvtpk(v0[2], v0[3]); w.z = cvtpk(v1[0], v1[1]); w.w = cvtpk(v1[2], v1[3]);
                    *(u32x4*)(rowp + bj * HALF) = w; } }
    }
};
struct EpiF32 {
    static constexpr bool PERM = false;
    float* O; int ldc;
    __device__ __forceinline__ void operator()(const f32x4 (&acc)[2][2][4][2], const Unit& u, int wr, int wc, int fr, int fq) const {
        const int row0 = u.pm * BM + wr * 64 + fr, col0 = u.pn * BM + wc * 32 + 4 * fq;
#pragma unroll
        for (int ai = 0; ai < 2; ++ai)
#pragma unroll
            for (int m = 0; m < 4; ++m) { float* rowp = O + (size_t)(row0 + ai * HALF + m * 16) * ldc + col0;
#pragma unroll
                for (int bj = 0; bj < 2; ++bj)
#pragma unroll
                    for (int n = 0; n < 2; ++n) *(f32x4*)(rowp + bj * HALF + n * 16) = acc[ai][bj][m][n]; }
    }
};
struct EpiBf {
    static constexpr bool PERM = true;
    bf16_t* O; int ldc;
    __device__ __forceinline__ void operator()(const f32x4 (&acc)[2][2][4][2], const Unit& u, int wr, int wc, int fr, int fq) const {
        const int row0 = u.pm * BM + wr * 64 + fr, col0 = u.pn * BM + wc * 32 + 8 * fq;
#pragma unroll
        for (int ai = 0; ai < 2; ++ai)
#pragma unroll
            for (int m = 0; m < 4; ++m) { bf16_t* rowp = O + (size_t)(row0 + ai * HALF + m * 16) * ldc + col0;
#pragma unroll
                for (int bj = 0; bj < 2; ++bj) { const f32x4 v0 = acc[ai][bj][m][0], v1 = acc[ai][bj][m][1];
                    u32x4 w; w.x = cvtpk(v0[0], v0[1]); w.y = cvtpk(v0[2], v0[3]); w.z = cvtpk(v1[0], v1[1]); w.w = cvtpk(v1[2], v1[3]);
                    *(u32x4*)(rowp + bj * HALF) = w; } }
    }
};
struct EpiH3 {
    static constexpr bool PERM = false;
    const float* H2; const bf16_t* PLE; float* OUT; float* SSQ;
    __device__ __forceinline__ void operator()(const f32x4 (&acc)[2][2][4][2], const Unit& u, int wr, int wc, int fr, int fq) const {
        const int row0 = u.pm * BM + wr * 64 + fr, col0 = u.pn * BM + wc * 32 + 4 * fq;
#pragma unroll
        for (int ai = 0; ai < 2; ++ai)
#pragma unroll
            for (int m = 0; m < 4; ++m) { const int row = row0 + ai * HALF + m * 16; const size_t off = (size_t)row * 1024 + col0; float s = 0.f;
#pragma unroll
                for (int bj = 0; bj < 2; ++bj)
#pragma unroll
                    for (int n = 0; n < 2; ++n) { const size_t o2 = off + bj * HALF + n * 16; const f32x4 hv = *(const f32x4*)(H2 + o2); const u32x2 pv = *(const u32x2*)(PLE + o2);
                        const f32x4 a = acc[ai][bj][m][n]; f32x4 h;
                        h[0] = hv[0] + bf_lo(pv.x) * fast_sigmoid(a[0]); h[1] = hv[1] + bf_hi(pv.x) * fast_sigmoid(a[1]);
                        h[2] = hv[2] + bf_lo(pv.y) * fast_sigmoid(a[2]); h[3] = hv[3] + bf_hi(pv.y) * fast_sigmoid(a[3]);
                        *(f32x4*)(OUT + o2) = h; s += (h[0] * h[0] + h[1] * h[1]) + (h[2] * h[2] + h[3] * h[3]); }
                s += __shfl_xor(s, 16); s += __shfl_xor(s, 32);
                if (fq == 0) SSQ[(size_t)row * 16 + u.pn * 4 + wc] = s;
                asm volatile("" ::: "memory"); }
    }
};
}
constexpr size_t MiB = 1u << 20;
constexpr size_t WS_CTL = 0, CTL_ZERO_BYTES = 64 * 1024;
constexpr size_t WS_PEND = 64 * 1024;
constexpr size_t WS_WPLE = 512 * 1024;
constexpr size_t WS_KD = 1 * MiB;
constexpr size_t WS_GLAG = 2 * MiB;
constexpr size_t WS_WIN = 3 * MiB;
constexpr size_t WS_SEND = 4 * MiB;
constexpr size_t WS_EXP = 4 * MiB;
constexpr size_t WS_SSQ1 = 13 * MiB;
constexpr size_t WS_SSQ3 = 14 * MiB;
constexpr size_t WS_WGA = 20 * MiB, WS_WSB = 22 * MiB, WS_WO = 24 * MiB, WS_WPG = 26 * MiB, WS_WPQ = 28 * MiB;
constexpr size_t WS_A = 32 * MiB;
constexpr size_t WS_GQ = WS_A, WS_GK = WS_A + 16 * MiB, WS_UB = WS_A;
constexpr size_t WS_B = 64 * MiB;
constexpr size_t WS_GV = WS_B, WS_VB = WS_B;
constexpr size_t WS_C = 96 * MiB;
constexpr size_t WS_GR = WS_C, WS_H1 = WS_C;
constexpr size_t WS_D = 128 * MiB;
constexpr size_t WS_SQ = WS_D;
constexpr size_t WS_E = 160 * MiB;
constexpr size_t WS_SK = WS_E, WS_MIX = WS_E, WS_Q = WS_E, WS_XN3 = WS_E;
constexpr size_t WS_F = 192 * MiB;
constexpr size_t WS_SV = WS_F, WS_PB = WS_F;
constexpr size_t WS_G = 224 * MiB;
constexpr size_t WS_XN1 = WS_G, WS_GLAN = WS_G, WS_H1G = WS_G, WS_PLE = WS_G;
constexpr size_t WS_END = 256 * MiB;

constexpr int NWAVES = 8;
constexpr int RING_OFF = 0, RING_BYTES = 131072;
constexpr int MISC_OFF = RING_BYTES;
constexpr int LDS_BYTES = 147456;
constexpr int CW_BAR = 1024;

typedef GAS unsigned gu32;
#define RLX_AGENT __ATOMIC_RELAXED, __HIP_MEMORY_SCOPE_AGENT
#define LDS_WAIT() asm volatile("s_waitcnt lgkmcnt(0)" ::: "memory")
#define VM_WAIT() asm volatile("s_waitcnt vmcnt(0)" ::: "memory")

#define XB_TMO      128
#define XB_XCNT(j)  (256  + 64 * (j))
#define XB_XSUB(j)  (1280 + 64 * (j))
#define XB_XGEN(j)  (2304 + 64 * (j))
#define XB_TOP      3328
#define XB_TOPGEN   3392
#define XCD_BAR_WORDS 3456
#define XB_SPIN_CAP (1u << 22)
__device__ __forceinline__ unsigned xb_ld(unsigned* p)              { return __hip_atomic_load(p, __ATOMIC_RELAXED, __HIP_MEMORY_SCOPE_AGENT); }
__device__ __forceinline__ unsigned xb_add(unsigned* p, unsigned v) { return __hip_atomic_fetch_add(p, v, __ATOMIC_RELAXED, __HIP_MEMORY_SCOPE_AGENT); }
__device__ __forceinline__ unsigned xb_xcc_id() { return (unsigned)__builtin_amdgcn_s_getreg((3 << 11) | 20) & 0xFu; }
#define XB_SPIN(cond, bar) do { unsigned _sp = 0; while (cond) { __builtin_amdgcn_s_sleep(1); \
    if ((++_sp & 255u) == 0u) { if (xb_ld(&(bar)[XB_TMO])) break; if (_sp > XB_SPIN_CAP) { atomicAdd(&(bar)[XB_TMO], 1u); break; } } } } while (0)
struct XcdBarrier { unsigned* bar; unsigned x; volatile LAS unsigned* st; };
__device__ __forceinline__ XcdBarrier xcd_barrier_post(unsigned* bar, volatile LAS unsigned* st) {
    XcdBarrier b; b.bar = bar; b.x = xb_xcc_id(); b.st = st;
    if (threadIdx.x == 0) (void)xb_add(&bar[XB_XCNT(b.x)], 1u);
    return b;
}
__device__ __forceinline__ void xcd_barrier_complete(unsigned* bar, unsigned x, unsigned& nloc, unsigned& nx) {
    const unsigned G = gridDim.x * gridDim.y * gridDim.z;
    unsigned sum, cnt, mine, sp = 0u;
    for (;;) {
        sum = 0u; cnt = 0u; mine = 0u;
#pragma unroll
        for (unsigned j = 0; j < 16; ++j) { const unsigned c = xb_ld(&bar[XB_XCNT(j)]); sum += c; cnt += (c > 0u) ? 1u : 0u; mine = (j == x) ? c : mine; }
        if (sum == G) break;
        __builtin_amdgcn_s_sleep(1);
        if ((++sp & 255u) == 0u) { if (xb_ld(&bar[XB_TMO])) break; if (sp > XB_SPIN_CAP) { atomicAdd(&bar[XB_TMO], 1u); break; } }
    }
    nloc = mine > 0u ? mine : 1u; nx = cnt > 0u ? cnt : 1u;
}
__device__ __forceinline__ void xcd_barrier(const XcdBarrier& b) {
    asm volatile("s_waitcnt vmcnt(0)" ::: "memory");
    __syncthreads();
    if (threadIdx.x == 0) {
        unsigned* bar = b.bar;
        __builtin_amdgcn_s_waitcnt(0);
        unsigned nloc = b.st[0], nx = b.st[1];
        if (nloc == 0u) { xcd_barrier_complete(bar, b.x, nloc, nx); b.st[0] = nloc; b.st[1] = nx; }
        const unsigned old = xb_add(&bar[XB_XSUB(b.x)], 1u);
        const unsigned gen = old / nloc;
        if (old + 1u == (gen + 1u) * nloc) {
            __builtin_amdgcn_fence(__ATOMIC_RELEASE, "agent");
            asm volatile("s_waitcnt vmcnt(0)" ::: "memory");
            const unsigned og = xb_add(&bar[XB_TOP], 1u);
            const unsigned tg = og / nx;
            if (og + 1u == (tg + 1u) * nx) xb_add(&bar[XB_TOPGEN], 1u);
            else XB_SPIN(xb_ld(&bar[XB_TOPGEN]) == tg, bar);
            __builtin_amdgcn_fence(__ATOMIC_ACQUIRE, "agent");
            xb_add(&bar[XB_XGEN(b.x)], 1u);
            asm volatile("s_waitcnt vmcnt(0)" ::: "memory");
        } else {
            XB_SPIN(xb_ld(&bar[XB_XGEN(b.x)]) == gen, bar);
            __builtin_amdgcn_fence(__ATOMIC_ACQUIRE, "agent");
            asm volatile("s_waitcnt vmcnt(0)" ::: "memory");
        }
    }
    __syncthreads();
}

struct Frame {
    LAS unsigned char* lds;
    int tid, lane, wave, vcu, G, dry;
    const float* const* in; float* out; unsigned char* ws;
};
__device__ __forceinline__ int lane_id() { int l; asm volatile("v_mbcnt_lo_u32_b32 %0, -1, 0\n\tv_mbcnt_hi_u32_b32 %0, -1, %0" : "=v"(l)); return l; }
#define WSP(T, off) ((T*)(F.ws + (off)))
__device__ __forceinline__ float wave_sum(float v) {
#pragma unroll
    for (int o = 1; o < 64; o <<= 1) v += __shfl_xor(v, o);
    return v;
}
template <class RowMap>
__device__ __forceinline__ void p0_transpose_item(const float* W, int K, int N, bf16_t* WT, RowMap rm, LAS float* scr, int item, int lane) {
    const int nblk = (N + 31) / 32, kb = item / nblk, nb = item % nblk, k0 = 64 * kb, n0 = 32 * nb;
    const int nl = n0 + (lane & 31);
#pragma unroll 8
    for (int i = 0; i < 32; ++i) { const int kk = 2 * i + (lane >> 5); scr[kk * 33 + (lane & 31)] = (nl < N) ? W[(size_t)(k0 + kk) * N + nl] : 0.f; }
    LDS_WAIT(); asm volatile("" ::: "memory");
    const int c = lane & 7;
#pragma unroll
    for (int j = 0; j < 4; ++j) { const int n = (lane >> 3) + 8 * j; const LAS float* s = scr + (8 * c) * 33 + n;
        u32x4 o; o.x = cvtpk(s[0 * 33], s[1 * 33]); o.y = cvtpk(s[2 * 33], s[3 * 33]); o.z = cvtpk(s[4 * 33], s[5 * 33]); o.w = cvtpk(s[6 * 33], s[7 * 33]);
        if (n0 + n < N) *(u32x4*)(WT + (size_t)rm(n0 + n) * K + k0 + 8 * c) = o; }
    LDS_WAIT(); asm volatile("" ::: "memory");
}
struct RmId { __device__ __forceinline__ int operator()(int n) const { return n; } };
struct RmWin { __device__ __forceinline__ int operator()(int n) const { return n < 3072 ? n : (n < 3088 ? 8192 + (n - 3072) : n - 16); } };

__device__ __forceinline__ void cvt_copy(Frame& F, const float* src, bf16_t* dst, size_t n) {
    const size_t nth = (size_t)F.G * 512, n8 = n / 8;
    for (size_t i = (size_t)F.vcu * 512 + F.tid; i < n8; i += nth) {
        const f32x4 a = *(const f32x4*)(src + i * 8), b = *(const f32x4*)(src + i * 8 + 4);
        u32x4 o; o.x = cvtpk(a[0], a[1]); o.y = cvtpk(a[2], a[3]); o.z = cvtpk(b[0], b[1]); o.w = cvtpk(b[2], b[3]);
        *(u32x4*)(dst + i * 8) = o; }
}
__device__ __forceinline__ void rms_row_to_bf16(const float* xrow, const float* g, bf16_t* orow, int lane) {
    f32x4 v[4]; float s = 0.f;
#pragma unroll
    for (int j = 0; j < 4; ++j) { v[j] = *((const f32x4*)xrow + lane + 64 * j); s += (v[j][0] * v[j][0] + v[j][1] * v[j][1]) + (v[j][2] * v[j][2] + v[j][3] * v[j][3]); }
    const float rstd = __builtin_amdgcn_rsqf(wave_sum(s) * (1.f / 1024.f) + EPS);
#pragma unroll
    for (int j = 0; j < 4; ++j) { const f32x4 gv = *((const f32x4*)g + lane + 64 * j); const f32x4 o = v[j] * rstd * gv;
        u32x2 w; w.x = cvtpk(o[0], o[1]); w.y = cvtpk(o[2], o[3]); *((u32x2*)orow + lane + 64 * j) = w; }
}
__device__ __forceinline__ void phase_prologue(Frame& F) {
    LAS float* scr = (LAS float*)(F.lds + RING_OFF + F.wave * 16384);
    const int gw = F.vcu * NWAVES + F.wave, NGW = F.G * NWAVES;
    constexpr int I_IN = 16 * 257, I_SQ = 16 * 32, I_PQ = 16 * 64, I_PLE = 4 * 32;
    constexpr int NITEMS = I_IN + 4 * I_SQ + I_PQ + I_PLE;
    for (int it = gw; it < NITEMS; it += NGW) {
        int r = it;
        if (r < I_IN) { p0_transpose_item(F.in[3], 1024, 8208, WSP(bf16_t, WS_WIN), RmWin(), scr, r, F.lane); continue; } r -= I_IN;
        if (r < I_SQ) { p0_transpose_item(F.in[7], 1024, 1024, WSP(bf16_t, WS_WGA), RmId(), scr, r, F.lane); continue; } r -= I_SQ;
        if (r < I_SQ) { p0_transpose_item(F.in[8], 1024, 1024, WSP(bf16_t, WS_WSB), RmId(), scr, r, F.lane); continue; } r -= I_SQ;
        if (r < I_SQ) { p0_transpose_item(F.in[9], 1024, 1024, WSP(bf16_t, WS_WO), RmId(), scr, r, F.lane); continue; } r -= I_SQ;
        if (r < I_SQ) { p0_transpose_item(F.in[17], 1024, 1024, WSP(bf16_t, WS_WPG), RmId(), scr, r, F.lane); continue; } r -= I_SQ;
        if (r < I_PQ) { p0_transpose_item(F.in[11], 1024, 2048, WSP(bf16_t, WS_WPQ), RmId(), scr, r, F.lane); continue; } r -= I_PQ;
        p0_transpose_item(F.in[18], 256, 1024, WSP(bf16_t, WS_WPLE), RmId(), scr, r, F.lane);
    }
    { const float* k1 = F.in[12]; const float* k2 = F.in[13]; bf16_t* KD = WSP(bf16_t, WS_KD);
      for (int i = F.vcu * 512 + F.tid; i < 8 * 256 * 32; i += F.G * 512) { const int h = i >> 13, n = (i >> 5) & 255, kc = (i & 31) * 8;
          u32x4 o = (u32x4){0u, 0u, 0u, 0u}; const float* s = nullptr;
          if (n < 128 && kc < 128) s = k1 + ((size_t)(h * 128 + n)) * 128 + kc;
          if (n >= 128 && kc >= 128) s = k2 + ((size_t)(h * 128 + n - 128)) * 128 + (kc - 128);
          if (s) { const f32x4 a = *(const f32x4*)s, b = *(const f32x4*)(s + 4); o.x = cvtpk(a[0], a[1]); o.y = cvtpk(a[2], a[3]); o.z = cvtpk(b[0], b[1]); o.w = cvtpk(b[2], b[3]); }
          *(u32x4*)(KD + (size_t)i * 8) = o; } }
    for (int m = gw; m < T_TOK; m += NGW) rms_row_to_bf16(F.in[0] + (size_t)m * 1024, F.in[2], WSP(bf16_t, WS_XN1) + (size_t)m * 1024, F.lane);
}

__device__ __forceinline__ void phase_gla_prep(Frame& F) {
    LAS float* alo = (LAS float*)(F.lds + RING_OFF);
    const bf16_t* XN1 = WSP(bf16_t, WS_XN1); const bf16_t* WGAT = WSP(bf16_t, WS_WIN) + (size_t)8192 * 1024;
    bf16_t* GK = WSP(bf16_t, WS_GK); bf16_t* GV = WSP(bf16_t, WS_GV); float* GLAG = WSP(float, WS_GLAG);
    const float* w_up = F.in[4]; const float* b_a = F.in[5];
    const int tid = F.tid, lane = F.lane, w = F.wave;
    for (int u = F.vcu; u < 256; u += F.G) {
        const size_t r0 = (size_t)u * 64;
        __syncthreads();
        if (w < 4) {
            f32x4 acc = (f32x4){0.f, 0.f, 0.f, 0.f};
            const bf16_t* ap = XN1 + (r0 + 16 * w + (lane & 15)) * 1024 + 8 * (lane >> 4);
            const bf16_t* bp = WGAT + (size_t)(lane & 15) * 1024 + 8 * (lane >> 4);
#pragma unroll 8
            for (int s = 0; s < 32; ++s) { const bf16x8 a = *(const bf16x8*)(ap + 32 * s), b = *(const bf16x8*)(bp + 32 * s); acc = __builtin_amdgcn_mfma_f32_16x16x32_bf16(a, b, acc, 0, 0, 0); }
#pragma unroll
            for (int r = 0; r < 4; ++r) alo[(16 * w + 4 * (lane >> 4) + r) * 16 + (lane & 15)] = acc[r];
        }
        const int kk = tid;
        float kv[64];
#pragma unroll
        for (int i = 0; i < 64; ++i) kv[i] = bf1(GK[(r0 + i) * 512 + kk]);
        float wv[16];
#pragma unroll
        for (int r = 0; r < 16; ++r) wv[r] = w_up[r * 512 + kk];
        const float bias = b_a[kk];
        __syncthreads();
        float suffix = 0.f;
        bf16_t* kdt = GK + r0 * 512 + (size_t)kk * 64;
#pragma unroll
        for (int i8 = 7; i8 >= 0; --i8) {
            float o[8];
#pragma unroll
            for (int j = 7; j >= 0; --j) { const int i = i8 * 8 + j;
                const f32x4 a0 = *(const LAS f32x4*)(alo + i * 16), a1 = *(const LAS f32x4*)(alo + i * 16 + 4), a2 = *(const LAS f32x4*)(alo + i * 16 + 8), a3 = *(const LAS f32x4*)(alo + i * 16 + 12);
                float x = bias;
                x += a0[0] * wv[0] + a0[1] * wv[1] + a0[2] * wv[2] + a0[3] * wv[3];
                x += a1[0] * wv[4] + a1[1] * wv[5] + a1[2] * wv[6] + a1[3] * wv[7];
                x += a2[0] * wv[8] + a2[1] * wv[9] + a2[2] * wv[10] + a2[3] * wv[11];
                x += a3[0] * wv[12] + a3[1] * wv[13] + a3[2] * wv[14] + a3[3] * wv[15];
                const float la = (fminf(x, 0.f) - log1pf(__expf(-fabsf(x)))) * (1.0f / 16.0f);
                o[j] = kv[i] * __expf(suffix);
                suffix += la; }
            u32x4 pk; pk.x = cvtpk(o[0], o[1]); pk.y = cvtpk(o[2], o[3]); pk.z = cvtpk(o[4], o[5]); pk.w = cvtpk(o[6], o[7]);
            if (!F.dry) *(u32x4*)(kdt + i8 * 8) = pk; }
        GLAG[(size_t)u * 512 + kk] = __expf(suffix);
        unsigned vv[64];
#pragma unroll
        for (int i = 0; i < 64; ++i) vv[i] = *(const unsigned*)(GV + (r0 + i) * 1024 + 2 * tid);
        __syncthreads();
        bf16_t* vt0 = GV + r0 * 1024 + (size_t)(2 * tid) * 64;
#pragma unroll
        for (int i8 = 0; i8 < 8; ++i8) { u32x4 lo, hi;
            lo.x = (vv[i8 * 8 + 0] & 0xffffu) | (vv[i8 * 8 + 1] << 16); hi.x = (vv[i8 * 8 + 0] >> 16) | (vv[i8 * 8 + 1] & 0xffff0000u);
            lo.y = (vv[i8 * 8 + 2] & 0xffffu) | (vv[i8 * 8 + 3] << 16); hi.y = (vv[i8 * 8 + 2] >> 16) | (vv[i8 * 8 + 3] & 0xffff0000u);
            lo.z = (vv[i8 * 8 + 4] & 0xffffu) | (vv[i8 * 8 + 5] << 16); hi.z = (vv[i8 * 8 + 4] >> 16) | (vv[i8 * 8 + 5] & 0xffff0000u);
            lo.w = (vv[i8 * 8 + 6] & 0xffffu) | (vv[i8 * 8 + 7] << 16); hi.w = (vv[i8 * 8 + 6] >> 16) | (vv[i8 * 8 + 7] & 0xffff0000u);
            if (!F.dry) { *(u32x4*)(vt0 + i8 * 8) = lo; *(u32x4*)(vt0 + 64 + i8 * 8) = hi; } }
    }
}

constexpr int GL_KD = 0, GL_Q = 32768, GL_G = 65536, GL_RED = 65536 + 1024;
__device__ __forceinline__ int gl_kd_off(int row, int chunk) { return row * 128 + ((chunk ^ ((row >> 1) & 7)) << 4); }
__device__ __forceinline__ int gl_q_off(int row, int chunk16) { return row * 256 + ((chunk16 ^ (row & 15)) << 4); }

struct GlaStage { u32x4 kd[2]; u32x4 q[2]; bf16x8 vt[4]; float g; };
__device__ __forceinline__ void gla_prefetch_vt(Frame& F, GlaStage& st, int b, int h, int c) {
    const int u = b * 64 + c; const size_t r0 = (size_t)u * 64; const int w = F.wave, lq = F.lane & 31, hh = F.lane >> 5;
    const bf16_t* vt = WSP(bf16_t, WS_GV) + r0 * 1024 + (size_t)(h * 256 + 32 * w + lq) * 64;
#pragma unroll
    for (int ts = 0; ts < 4; ++ts) st.vt[ts] = *(const bf16x8*)(vt + 16 * ts + 8 * hh);
}
template <bool WITH_Q>
__device__ __forceinline__ void gla_prefetch(Frame& F, GlaStage& st, int b, int h, int c) {
    const int u = b * 64 + c; const size_t r0 = (size_t)u * 64; const int tid = F.tid;
    const bf16_t* kd = WSP(bf16_t, WS_GK) + r0 * 512 + (size_t)h * 8192;
#pragma unroll
    for (int j = 0; j < 2; ++j) { const int pi = tid + 512 * j; st.kd[j] = *(const u32x4*)(kd + (pi >> 3) * 64 + (pi & 7) * 8); }
    if (WITH_Q) { const bf16_t* gq = WSP(bf16_t, WS_GQ) + r0 * 512 + h * 128;
#pragma unroll
        for (int j = 0; j < 2; ++j) { const int pi = tid + 512 * j; st.q[j] = *(const u32x4*)(gq + (size_t)(pi >> 4) * 512 + (pi & 15) * 8); } }
    st.g = (tid < 128) ? WSP(float, WS_GLAG)[((size_t)u * 4 + h) * 128 + tid] : 1.f;
}
template <bool WITH_Q>
__device__ __forceinline__ void gla_stage_write(Frame& F, const GlaStage& st, int buf) {
    LAS unsigned char* lds = F.lds + RING_OFF; const int tid = F.tid;
#pragma unroll
    for (int j = 0; j < 2; ++j) { const int pi = tid + 512 * j; *(LAS u32x4*)(lds + GL_KD + buf * 16384 + gl_kd_off(pi >> 3, pi & 7)) = st.kd[j]; }
    if (WITH_Q) {
#pragma unroll
        for (int j = 0; j < 2; ++j) { const int pi = tid + 512 * j; *(LAS u32x4*)(lds + GL_Q + buf * 16384 + gl_q_off(pi >> 4, pi & 15)) = st.q[j]; } }
    if (tid < 128) *(LAS float*)(lds + GL_G + buf * 512 + tid * 4) = st.g;
}
__device__ __forceinline__ void gla_update(Frame& F, f32x16 (&S)[4], const bf16x8 (&vt)[4], int buf) {
    const LAS unsigned char* lds = F.lds + RING_OFF; const int lq = F.lane & 31, hh = F.lane >> 5;
    const LAS float* G = (const LAS float*)(lds + GL_G + buf * 512);
#pragma unroll
    for (int kt = 0; kt < 4; ++kt)
#pragma unroll
        for (int g4 = 0; g4 < 4; ++g4) { const f32x4 g = *(const LAS f32x4*)(G + 32 * kt + 8 * g4 + 4 * hh);
#pragma unroll
            for (int j = 0; j < 4; ++j) S[kt][4 * g4 + j] *= g[j]; }
#pragma unroll
    for (int ts = 0; ts < 4; ++ts)
#pragma unroll
        for (int kt = 0; kt < 4; ++kt) { const bf16x8 a = *(const LAS bf16x8*)(lds + GL_KD + buf * 16384 + gl_kd_off(32 * kt + lq, 2 * ts + hh));
            S[kt] = __builtin_amdgcn_mfma_f32_32x32x16_bf16(a, vt[ts], S[kt], 0, 0, 0); if (kt == 3 && (ts & 1)) __builtin_amdgcn_sched_barrier(0); }
}
constexpr size_t SEND_WAVE_FLOATS = 4 * 4 * 64 * 4;
__device__ __forceinline__ void gla_stage1(Frame& F, int unit) {
    const int bh = unit >> 3, seg = unit & 7, b = bh >> 2, h = bh & 3, w = F.wave, l = F.lane;
    f32x16 S[4];
#pragma unroll
    for (int kt = 0; kt < 4; ++kt)
#pragma unroll
        for (int r = 0; r < 16; ++r) S[kt][r] = 0.f;
    float pend = 1.f;
    GlaStage st; gla_prefetch<false>(F, st, b, h, seg * 8); gla_prefetch_vt(F, st, b, h, seg * 8);
    for (int ci = 0; ci < 8; ++ci) {
        gla_stage_write<false>(F, st, ci & 1); pend *= st.g;
        __syncthreads();
        if (ci < 7) gla_prefetch<false>(F, st, b, h, seg * 8 + ci + 1);
        gla_update(F, S, st.vt, ci & 1);
        if (ci < 7) gla_prefetch_vt(F, st, b, h, seg * 8 + ci + 1);
    }
    float* se = WSP(float, WS_SEND) + ((size_t)unit * 8 + w) * SEND_WAVE_FLOATS;
#pragma unroll
    for (int kt = 0; kt < 4; ++kt)
#pragma unroll
        for (int g4 = 0; g4 < 4; ++g4) *(f32x4*)(se + ((kt * 4 + g4) * 64 + l) * 4) = (f32x4){S[kt][4 * g4], S[kt][4 * g4 + 1], S[kt][4 * g4 + 2], S[kt][4 * g4 + 3]};
    if (F.tid < 128) WSP(float, WS_PEND)[unit * 128 + F.tid] = pend;
    __syncthreads();
}
__device__ __forceinline__ void gla_stage3(Frame& F, int unit) {
    const int bh = unit >> 3, seg = unit & 7, b = bh >> 2, h = bh & 3, w = F.wave, l = F.lane, lq = l & 31, hh = l >> 5;
    LAS unsigned char* lds = F.lds + RING_OFF;
    const bf16_t* GR = WSP(bf16_t, WS_GR); bf16_t* GLAN = WSP(bf16_t, WS_GLAN); const float* g_o = F.in[6];
    f32x16 S[4];
#pragma unroll
    for (int kt = 0; kt < 4; ++kt)
#pragma unroll
        for (int r = 0; r < 16; ++r) S[kt][r] = 0.f;
    GlaStage st; gla_prefetch<true>(F, st, b, h, seg * 8); gla_prefetch_vt(F, st, b, h, seg * 8);
    for (int sp = 0; sp < seg; ++sp) {
        const int un = bh * 8 + sp; const float* se = WSP(float, WS_SEND) + ((size_t)un * 8 + w) * SEND_WAVE_FLOATS; const float* pe = WSP(float, WS_PEND) + un * 128;
#pragma unroll
        for (int kt = 0; kt < 4; ++kt)
#pragma unroll
            for (int g4 = 0; g4 < 4; ++g4) { const f32x4 p = *(const f32x4*)(pe + 32 * kt + 8 * g4 + 4 * hh); const f32x4 s = *(const f32x4*)(se + ((kt * 4 + g4) * 64 + l) * 4);
#pragma unroll
                for (int j = 0; j < 4; ++j) S[kt][4 * g4 + j] = S[kt][4 * g4 + j] * p[j] + s[j]; }
    }
    for (int ci = 0; ci < 8; ++ci) {
        const int c = seg * 8 + ci; const size_t r0 = (size_t)(b * 64 + c) * 64; const int buf = ci & 1;
        gla_stage_write<true>(F, st, buf);
        __syncthreads();
        if (ci < 7) gla_prefetch<true>(F, st, b, h, c + 1);
        gla_update(F, S, st.vt, buf);
        f32x16 oT[2];
#pragma unroll
        for (int tt = 0; tt < 2; ++tt) {
#pragma unroll
            for (int r = 0; r < 16; ++r) oT[tt][r] = 0.f;
            const int t = 32 * tt + lq;
#pragma unroll
            for (int kt = 0; kt < 4; ++kt)
#pragma unroll
                for (int s = 0; s < 2; ++s) {
                    u32x4 aw; aw.x = cvtpk(S[kt][8 * s + 0], S[kt][8 * s + 1]); aw.y = cvtpk(S[kt][8 * s + 2], S[kt][8 * s + 3]); aw.z = cvtpk(S[kt][8 * s + 4], S[kt][8 * s + 5]); aw.w = cvtpk(S[kt][8 * s + 6], S[kt][8 * s + 7]);
                    const u32x2 qlo = *(const LAS u32x2*)(lds + GL_Q + buf * 16384 + gl_q_off(t, 4 * kt + 2 * s) + 8 * hh), qhi = *(const LAS u32x2*)(lds + GL_Q + buf * 16384 + gl_q_off(t, 4 * kt + 2 * s + 1) + 8 * hh);
                    const u32x4 bw = (u32x4){qlo.x, qlo.y, qhi.x, qhi.y};
                    oT[tt] = __builtin_amdgcn_mfma_f32_32x32x16_bf16(__builtin_bit_cast(bf16x8, aw), __builtin_bit_cast(bf16x8, bw), oT[tt], 0, 0, 0);
                    if (s == 1 && (kt & 1)) __builtin_amdgcn_sched_barrier(0); }
        }
        LAS float* redc = (LAS float*)(lds + GL_RED) + buf * 512;
#pragma unroll
        for (int tt = 0; tt < 2; ++tt) { float s = 0.f;
#pragma unroll
            for (int r = 0; r < 16; ++r) s += oT[tt][r] * oT[tt][r];
            s += __shfl_xor(s, 32);
            if (hh == 0) redc[w * 64 + 32 * tt + lq] = s; }
        if (ci < 7) gla_prefetch_vt(F, st, b, h, c + 1);
        u32x2 sr[2][4];
#pragma unroll
        for (int tt = 0; tt < 2; ++tt)
#pragma unroll
            for (int g4 = 0; g4 < 4; ++g4) sr[tt][g4] = *(const u32x2*)(GR + (r0 + 32 * tt + lq) * 1024 + h * 256 + 32 * w + 8 * g4 + 4 * hh);
        __syncthreads();
#pragma unroll
        for (int tt = 0; tt < 2; ++tt) { float tot = 0.f;
#pragma unroll
            for (int ww = 0; ww < 8; ++ww) tot += redc[ww * 64 + 32 * tt + lq];
            const float rstd = __builtin_amdgcn_rsqf(tot * (1.0f / 256.0f) + EPS);
            const size_t row = r0 + 32 * tt + lq;
#pragma unroll
            for (int g4 = 0; g4 < 4; ++g4) { const int v0 = h * 256 + 32 * w + 8 * g4 + 4 * hh;
                const f32x4 go = *(const f32x4*)(g_o + v0);
                const float o0 = oT[tt][4 * g4 + 0] * rstd * go[0] * bf_lo(sr[tt][g4].x), o1 = oT[tt][4 * g4 + 1] * rstd * go[1] * bf_hi(sr[tt][g4].x);
                const float o2 = oT[tt][4 * g4 + 2] * rstd * go[2] * bf_lo(sr[tt][g4].y), o3 = oT[tt][4 * g4 + 3] * rstd * go[3] * bf_hi(sr[tt][g4].y);
                u32x2 wv; wv.x = cvtpk(o0, o1); wv.y = cvtpk(o2, o3); *(u32x2*)(GLAN + row * 1024 + v0) = wv; } }
    }
    __syncthreads();
}

constexpr int SB_TILE = 16384, SB_FLAG = 7 * SB_TILE;
typedef short v4i16_t __attribute__((ext_vector_type(4)));
__device__ __forceinline__ s16x4 vtr(const LAS unsigned char* p) { return __builtin_bit_cast(s16x4, __builtin_amdgcn_ds_read_tr16_b64_v4i16((LAS v4i16_t*)p)); }
__device__ __forceinline__ float partner32(float x, int hh) { auto rr = __builtin_amdgcn_permlane32_swap(__float_as_uint(x), __float_as_uint(x), false, false); return __uint_as_float(hh ? rr[0] : rr[1]); }
__device__ __forceinline__ int sbk_off(int key, int chunk) { return key * 128 + ((chunk ^ ((key >> 1) & 7)) << 4); }
__device__ __forceinline__ int sbv_off(int key, int chunk) { return 8192 + key * 128 + ((chunk ^ (((key >> 1) & 1) << 2)) << 4); }

__device__ __forceinline__ void sb_tile(const LAS unsigned char* tile, int kt, int q0, int qabs, int l, const bf16x8 (&qf)[4], f32x16& o0, f32x16& o1, float& carry) {
    const int lq = l & 31, hh = l >> 5;
    f32x16 p0, p1;
#pragma unroll
    for (int r = 0; r < 16; ++r) { p0[r] = 0.f; p1[r] = 0.f; }
#pragma unroll
    for (int s = 0; s < 4; ++s) { const bf16x8 a0 = *(const LAS bf16x8*)(tile + sbk_off(lq, 2 * s + hh)), a1 = *(const LAS bf16x8*)(tile + sbk_off(32 + lq, 2 * s + hh));
        p0 = __builtin_amdgcn_mfma_f32_32x32x16_bf16(a0, qf[s], p0, 0, 0, 0); p1 = __builtin_amdgcn_mfma_f32_32x32x16_bf16(a1, qf[s], p1, 0, 0, 0); }
    const bool diag = (64 * kt + 63 >= q0);
    float Lh[2][16];
#pragma unroll
    for (int half = 0; half < 2; ++half)
#pragma unroll
        for (int r = 0; r < 16; ++r) { const float z = half ? p1[r] : p0[r];
            float L = fmaxf(z, 0.f) + __builtin_amdgcn_logf(1.0f + __builtin_amdgcn_exp2f(-fabsf(z)));
            if (diag) { const int key = 64 * kt + 32 * half + (r & 3) + 8 * (r >> 2) + 4 * hh; if (key >= qabs) L = 0.f; }
            Lh[half][r] = L; }
    float tot[8];
#pragma unroll
    for (int half = 0; half < 2; ++half)
#pragma unroll
        for (int g4 = 0; g4 < 4; ++g4) { float* Lg = &Lh[half][4 * g4]; Lg[2] += Lg[3]; Lg[1] += Lg[2]; Lg[0] += Lg[1]; tot[4 * half + g4] = Lg[0]; }
    float E[8]; float run = carry;
#pragma unroll
    for (int m = 7; m >= 0; --m) { const float tp = partner32(tot[m], hh); E[m] = run + (hh ? 0.f : tp); run += tot[m] + tp; }
    carry = run;
    u32x4 pw[2][2];
#pragma unroll
    for (int half = 0; half < 2; ++half)
#pragma unroll
        for (int s = 0; s < 2; ++s) { float wv[8];
#pragma unroll
            for (int j = 0; j < 8; ++j) { const int r = 8 * s + j; const float z = half ? p1[r] : p0[r];
                float wgt = __builtin_amdgcn_exp2f(z - (E[4 * half + (r >> 2)] + Lh[half][r]));
                if (diag) { const int key = 64 * kt + 32 * half + (r & 3) + 8 * (r >> 2) + 4 * hh; if (key >= qabs) wgt = 0.f; }
                wv[j] = wgt; }
            pw[half][s] = (u32x4){cvtpk(wv[0], wv[1]), cvtpk(wv[2], wv[3]), cvtpk(wv[4], wv[5]), cvtpk(wv[6], wv[7])}; }
    const int g1 = (l >> 4) & 1, i = l & 15;
#pragma unroll
    for (int half = 0; half < 2; ++half)
#pragma unroll
        for (int s = 0; s < 2; ++s) { const bf16x8 pb = __builtin_bit_cast(bf16x8, pw[half][s]);
            const int k0 = 32 * half + 16 * s + 4 * hh + (i >> 2), k1 = k0 + 8;
#pragma unroll
            for (int dt = 0; dt < 2; ++dt) { const int ch = 4 * dt + 2 * g1 + ((i & 3) >> 1);
                const s16x4 lo = vtr(tile + sbv_off(k0, ch) + 8 * (i & 1)), hi = vtr(tile + sbv_off(k1, ch) + 8 * (i & 1));
                const bf16x8 a = (bf16x8){lo[0], lo[1], lo[2], lo[3], hi[0], hi[1], hi[2], hi[3]};
                if (dt == 0) o0 = __builtin_amdgcn_mfma_f32_32x32x16_bf16(a, pb, o0, 0, 0, 0); else o1 = __builtin_amdgcn_mfma_f32_32x32x16_bf16(a, pb, o1, 0, 0, 0); } }
}

__device__ __forceinline__ void sb_attn_unit(Frame& F, int uidx) {
    const int bh = uidx >> 4, qb = uidx & 15, b = bh >> 4, h = bh & 15;
    LAS unsigned char* lds = F.lds + RING_OFF;
    volatile LAS unsigned* flags = (volatile LAS unsigned*)(lds + SB_FLAG);
    const int tid = F.tid, w = F.wave, l = F.lane, lq = l & 31, hh = l >> 5;
    bf16_t* SQ = WSP(bf16_t, WS_SQ); const bf16_t* SK = WSP(bf16_t, WS_SK); const bf16_t* SV = WSP(bf16_t, WS_SV);
    const size_t rowbase = (size_t)b * SEQ;
    const int q0 = qb * 256 + 32 * w, qabs = q0 + lq;
    const int kt_hi = qb * 4 + 3, kt_lo = (qb * 4 - 3) > 0 ? (qb * 4 - 3) : 0, nwin = kt_hi - kt_lo + 1;
    const int skey = tid >> 3, sch = tid & 7;
    const bf16_t* kg = SK + (rowbase + skey) * 1024 + h * 64 + sch * 8;
    const bf16_t* vg = SV + (rowbase + skey) * 1024 + h * 64 + sch * 8;
    __syncthreads();
    { u32x4 kr[7], vr[7];
#pragma unroll
      for (int j = 0; j < 7; ++j) if (j < nwin) { kr[j] = *(const u32x4*)(kg + (size_t)(kt_lo + j) * 64 * 1024); vr[j] = *(const u32x4*)(vg + (size_t)(kt_lo + j) * 64 * 1024); }
#pragma unroll
      for (int j = 0; j < 7; ++j) if (j < nwin) { *(LAS u32x4*)(lds + j * SB_TILE + sbk_off(skey, sch)) = kr[j]; *(LAS u32x4*)(lds + j * SB_TILE + sbv_off(skey, sch)) = vr[j]; } }
    bf16x8 qf[4];
    { const bf16_t* qrow = SQ + (rowbase + qabs) * 1024 + h * 64;
#pragma unroll
      for (int s = 0; s < 4; ++s) qf[s] = *(const bf16x8*)(qrow + 16 * s + 8 * hh); }
    f32x16 o0, o1;
#pragma unroll
    for (int r = 0; r < 16; ++r) { o0[r] = 0.f; o1[r] = 0.f; }
    float carry = 0.f;
    __syncthreads();
    bool done = false;
    for (int kt = (q0 + 30) >> 6; kt >= kt_lo; --kt) {
        sb_tile(lds + (kt - kt_lo) * SB_TILE, kt, q0, qabs, l, qf, o0, o1, carry);
        if (__all(carry > 150.0f)) { done = true; break; }
    }
    if (kt_lo == 0) done = true;
    if (l == 0) flags[w] = done ? 1u : 0u;
    __syncthreads();
    bool alld = true;
#pragma unroll
    for (int i = 0; i < 8; ++i) alld = alld && (flags[i] != 0u);
    if (!alld) {
        for (int kt = kt_lo - 1; kt >= 0; --kt) {
            const u32x4 kr = *(const u32x4*)(kg + (size_t)kt * 64 * 1024), vr = *(const u32x4*)(vg + (size_t)kt * 64 * 1024);
            __syncthreads();
            { unsigned a = 1u;
#pragma unroll
              for (int i = 0; i < 8; ++i) a &= flags[i];
              if (a) break; }
            *(LAS u32x4*)(lds + sbk_off(skey, sch)) = kr; *(LAS u32x4*)(lds + sbv_off(skey, sch)) = vr;
            __syncthreads();
            if (!done) { sb_tile(lds, kt, q0, qabs, l, qf, o0, o1, carry); if (__all(carry > 150.0f) || kt == 0) done = true; }
            if (l == 0) flags[w] = done ? 1u : 0u;
        }
    }
    if (!F.dry) { bf16_t* orow = SQ + (rowbase + qabs) * 1024 + h * 64;
#pragma unroll
      for (int g4 = 0; g4 < 4; ++g4) { u32x2 a, c2; a.x = cvtpk(o0[4 * g4], o0[4 * g4 + 1]); a.y = cvtpk(o0[4 * g4 + 2], o0[4 * g4 + 3]); c2.x = cvtpk(o1[4 * g4], o1[4 * g4 + 1]); c2.y = cvtpk(o1[4 * g4 + 2], o1[4 * g4 + 3]);
          *(u32x2*)(orow + 8 * g4 + 4 * hh) = a; *(u32x2*)(orow + 32 + 8 * g4 + 4 * hh) = c2; } }
}
__device__ __forceinline__ void phase_attn_a(Frame& F) {
    if (F.vcu < 128) { gla_stage1(F, F.vcu); sb_attn_unit(F, F.vcu); }
    else { sb_attn_unit(F, 128 + (F.vcu - 128) * 2); sb_attn_unit(F, 128 + (F.vcu - 128) * 2 + 1); }
    __syncthreads();
}
__device__ __forceinline__ void phase_attn_b(Frame& F) {
    if (F.vcu < 128) { gla_stage3(F, F.vcu); sb_attn_unit(F, 384 + F.vcu * 2); sb_attn_unit(F, 384 + F.vcu * 2 + 1); }
    else { sb_attn_unit(F, 640 + (F.vcu - 128) * 3); sb_attn_unit(F, 640 + (F.vcu - 128) * 3 + 1); sb_attn_unit(F, 640 + (F.vcu - 128) * 3 + 2); }
    __syncthreads();
}
__device__ __forceinline__ int okey(float v, int tag, int mask) { int u = __float_as_int(v); u ^= (u >> 31) & 0x7fffffff; return (u & ~mask) | tag; }
__device__ __forceinline__ float okey_val(int key, int mask) { int u = key & ~mask; u ^= (u >> 31) & 0x7fffffff; return __int_as_float(u); }
#define INS16(Lst, xin) do { int _x = (xin); _Pragma("unroll") for (int _j = 0; _j < 16; ++_j) { const int _h = max(Lst[_j], _x); _x = min(Lst[_j], _x); Lst[_j] = _h; } } while (0)

__device__ __forceinline__ void phase_peer_select(Frame& F, int hsel) {
    const float* S12 = F.out; unsigned* EXPO = WSP(unsigned, WS_EXP);
    LAS unsigned char* idxb = F.lds + RING_OFF + F.wave * 1024;
    const int l = F.lane, tl = l >> 3, hl = (l >> 1) & 3, half = l & 1;
    const int gw = F.vcu * NWAVES + F.wave, NGW = F.G * NWAVES;
    for (int bt = gw; bt < T_TOK / 8; bt += NGW) {
        const int t = bt * 8 + tl;
        const float* src = S12 + (size_t)t * 1024 + hl * 256 + half * 128;
        int L[16];
#pragma unroll
        for (int j = 0; j < 16; ++j) L[j] = INT_MIN;
#pragma unroll 2
        for (int i = 0; i < 128; i += 4) { const f32x4 v = *(const f32x4*)(src + i);
#pragma unroll
            for (int e = 0; e < 4; ++e) INS16(L, okey(v[e], 127 - (i + e), 127)); }
        int P[16];
#pragma unroll
        for (int j = 0; j < 16; ++j) P[j] = __shfl_xor(L[j], 1);
        float X[16], Y[16];
#pragma unroll
        for (int j = 0; j < 16; ++j) { X[j] = okey_val(L[j], 127); Y[j] = okey_val(P[j], 127); }
        { u32x4 pk;
          pk.x = (unsigned)(127 - (L[0] & 127)) | ((unsigned)(127 - (L[1] & 127)) << 8) | ((unsigned)(127 - (L[2] & 127)) << 16) | ((unsigned)(127 - (L[3] & 127)) << 24);
          pk.y = (unsigned)(127 - (L[4] & 127)) | ((unsigned)(127 - (L[5] & 127)) << 8) | ((unsigned)(127 - (L[6] & 127)) << 16) | ((unsigned)(127 - (L[7] & 127)) << 24);
          pk.z = (unsigned)(127 - (L[8] & 127)) | ((unsigned)(127 - (L[9] & 127)) << 8) | ((unsigned)(127 - (L[10] & 127)) << 16) | ((unsigned)(127 - (L[11] & 127)) << 24);
          pk.w = (unsigned)(127 - (L[12] & 127)) | ((unsigned)(127 - (L[13] & 127)) << 8) | ((unsigned)(127 - (L[14] & 127)) << 16) | ((unsigned)(127 - (L[15] & 127)) << 24);
          *(LAS u32x4*)(idxb + l * 16) = pk; }
        int M[16];
#pragma unroll
        for (int j = 0; j < 16; ++j) M[j] = INT_MIN;
#define CAND(i, j) do { const float sm = X[i] + Y[j]; const int pos = half ? ((j) * 16 + (i)) : ((i) * 16 + (j)); int key = okey(sm, 255 - pos, 255); if ((i) == (j) && half) key = INT_MIN; INS16(M, key); } while (0)
        CAND(0, 0); CAND(0, 1); CAND(0, 2); CAND(0, 3); CAND(0, 4); CAND(0, 5); CAND(0, 6); CAND(0, 7); CAND(0, 8); CAND(0, 9); CAND(0, 10); CAND(0, 11); CAND(0, 12); CAND(0, 13); CAND(0, 14); CAND(0, 15);
        CAND(1, 1); CAND(1, 2); CAND(1, 3); CAND(1, 4); CAND(1, 5); CAND(1, 6); CAND(1, 7);
        CAND(2, 2); CAND(2, 3); CAND(2, 4);
        CAND(3, 3);
#undef CAND
        int TK[16];
#pragma unroll
        for (int k = 0; k < 16; ++k) TK[k] = max(M[k], __shfl_xor(M[15 - k], 1));
        float sv[16]; float mx = -INFINITY;
#pragma unroll
        for (int k = 0; k < 16; ++k) { sv[k] = okey_val(TK[k], 255); mx = fmaxf(mx, sv[k]); }
        float den = 0.f;
#pragma unroll
        for (int k = 0; k < 16; ++k) { sv[k] = __expf(sv[k] - mx); den += sv[k]; }
        const float rden = 1.0f / den;
        LDS_WAIT(); asm volatile("" ::: "memory");
        const LAS unsigned char* i1b = idxb + (l & ~1) * 16; const LAS unsigned char* i2b = idxb + (l | 1) * 16;
        unsigned* dst = EXPO + (size_t)t * 128 + (hsel * 4 + hl) * 16 + half * 8;
#pragma unroll
        for (int k = 0; k < 8; ++k) { const int pos = 255 - (TK[k] & 255); const unsigned i1 = i1b[pos >> 4], i2 = i2b[pos & 15];
            const float gate = sv[k] * rden;
            dst[k] = (__float_as_uint(gate) & ~0x3fffu) | (i1 * 128u + i2); }
        LDS_WAIT(); asm volatile("" ::: "memory");
    }
}

__device__ __forceinline__ float dot2bf(unsigned a, unsigned b, float acc) { return __builtin_amdgcn_fdot2_f32_bf16(__builtin_bit_cast(bf16x2_t, a), __builtin_bit_cast(bf16x2_t, b), acc, false); }
__device__ __forceinline__ float gelu_tanh(float x) { const float y = 0.7978845608028654f * (x + 0.044715f * x * x * x); return x * __builtin_amdgcn_rcpf(1.0f + __expf(-2.0f * y)); }
__device__ __forceinline__ void phase_peer_gather(Frame& F) {
    const bf16_t* UB = WSP(bf16_t, WS_UB); const bf16_t* VB = WSP(bf16_t, WS_VB); const unsigned* EXPO = WSP(unsigned, WS_EXP);
    const bf16_t* H1G = WSP(bf16_t, WS_H1G); bf16_t* XN3 = WSP(bf16_t, WS_XN3); const float* H1 = WSP(float, WS_H1); float* H2 = F.out; const float* SSQ1 = WSP(float, WS_SSQ1); const float* g_ple = F.in[16];
    const int l = F.lane; const int gw = F.vcu * NWAVES + F.wave, NGW = F.G * NWAVES;
    for (int t = gw; t < T_TOK; t += NGW) {
        const u32x4 xa = *(const u32x4*)(H1G + (size_t)t * 1024 + 8 * l), xb = *(const u32x4*)(H1G + (size_t)t * 1024 + 512 + 8 * l);
        float rstd1; { const f32x4* sp = (const f32x4*)(SSQ1 + (size_t)t * 16); const f32x4 st = (sp[0] + sp[1]) + (sp[2] + sp[3]); rstd1 = __builtin_amdgcn_rsqf(((st[0] + st[1]) + (st[2] + st[3])) * (1.0f / 1024.0f) + EPS); }
        const unsigned e0 = EXPO[(size_t)t * 128 + l], e1 = EXPO[(size_t)t * 128 + 64 + l];
        float acc[16];
#pragma unroll
        for (int i = 0; i < 16; ++i) acc[i] = 0.f;
        for (int eb = 0; eb < 128; eb += 8) {
            unsigned ent[8]; u32x4 ua[8], ub[8];
#pragma unroll
            for (int k = 0; k < 8; ++k) { const int e = eb + k; ent[k] = (e < 64) ? __builtin_amdgcn_readlane(e0, e & 63) : __builtin_amdgcn_readlane(e1, e & 63);
                const bf16_t* up = UB + (size_t)(ent[k] & 0x3fffu) * 1024 + 8 * l; ua[k] = *(const u32x4*)up; ub[k] = *(const u32x4*)(up + 512); }
            float d[8];
#pragma unroll
            for (int k = 0; k < 8; ++k) { float s = 0.f;
                s = dot2bf(ua[k].x, xa.x, s); s = dot2bf(ua[k].y, xa.y, s); s = dot2bf(ua[k].z, xa.z, s); s = dot2bf(ua[k].w, xa.w, s);
                s = dot2bf(ub[k].x, xb.x, s); s = dot2bf(ub[k].y, xb.y, s); s = dot2bf(ub[k].z, xb.z, s); s = dot2bf(ub[k].w, xb.w, s); d[k] = s; }
#pragma unroll
            for (int k = 0; k < 8; ++k) { const bf16_t* vp = VB + (size_t)(ent[k] & 0x3fffu) * 1024 + 8 * l; ua[k] = *(const u32x4*)vp; ub[k] = *(const u32x4*)(vp + 512); }
#pragma unroll
            for (int k = 0; k < 8; ++k) d[k] = wave_sum(d[k]);
#pragma unroll
            for (int k = 0; k < 8; ++k) { const float a = gelu_tanh(d[k] * rstd1) * __uint_as_float(ent[k] & ~0x3fffu);
                acc[0] += a * bf_lo(ua[k].x); acc[1] += a * bf_hi(ua[k].x); acc[2] += a * bf_lo(ua[k].y); acc[3] += a * bf_hi(ua[k].y);
                acc[4] += a * bf_lo(ua[k].z); acc[5] += a * bf_hi(ua[k].z); acc[6] += a * bf_lo(ua[k].w); acc[7] += a * bf_hi(ua[k].w);
                acc[8] += a * bf_lo(ub[k].x); acc[9] += a * bf_hi(ub[k].x); acc[10] += a * bf_lo(ub[k].y); acc[11] += a * bf_hi(ub[k].y);
                acc[12] += a * bf_lo(ub[k].z); acc[13] += a * bf_hi(ub[k].z); acc[14] += a * bf_lo(ub[k].w); acc[15] += a * bf_hi(ub[k].w); }
        }
        const float* hrow = H1 + (size_t)t * 1024; float* h2row = H2 + (size_t)t * 1024; float ss = 0.f; f32x4 h[4];
#pragma unroll
        for (int q = 0; q < 4; ++q) { const int col = (q >> 1) * 512 + 8 * l + 4 * (q & 1); h[q] = *(const f32x4*)(hrow + col);
#pragma unroll
            for (int j = 0; j < 4; ++j) { h[q][j] += acc[4 * q + j]; ss += h[q][j] * h[q][j]; }
            *(f32x4*)(h2row + col) = h[q]; }
        const float rstd3 = __builtin_amdgcn_rsqf(wave_sum(ss) * (1.0f / 1024.0f) + EPS);
#pragma unroll
        for (int q2 = 0; q2 < 2; ++q2) { const int col = q2 * 512 + 8 * l; const f32x4 g0 = *(const f32x4*)(g_ple + col), g1 = *(const f32x4*)(g_ple + col + 4);
            const f32x4 a = h[2 * q2] * rstd3 * g0, c = h[2 * q2 + 1] * rstd3 * g1;
            u32x4 o; o.x = cvtpk(a[0], a[1]); o.y = cvtpk(a[2], a[3]); o.z = cvtpk(c[0], c[1]); o.w = cvtpk(c[2], c[3]);
            *(u32x4*)(XN3 + (size_t)t * 1024 + col) = o; }
    }
}

__device__ __forceinline__ void phase_final(Frame& F) {
    const float* SSQ3 = WSP(float, WS_SSQ3); const float* g = F.in[19];
    const int l = F.lane; const int gw = F.vcu * NWAVES + F.wave, NGW = F.G * NWAVES;
    for (int t = gw; t < T_TOK; t += NGW) {
        const f32x4* sp = (const f32x4*)(SSQ3 + (size_t)t * 16); const f32x4 st = (sp[0] + sp[1]) + (sp[2] + sp[3]);
        const float rstd = __builtin_amdgcn_rsqf(((st[0] + st[1]) + (st[2] + st[3])) * (1.0f / 1024.0f) + EPS);
        f32x4* row = (f32x4*)(F.out + (size_t)t * 1024);
#pragma unroll
        for (int j = 0; j < 4; ++j) { const f32x4 gv = *((const f32x4*)g + l + 64 * j); const f32x4 o = row[l + 64 * j] * rstd * gv; if (!F.dry) row[l + 64 * j] = o; }
    }
}
#ifndef MK_FUSED
#define MK_FUSED 1
#endif
constexpr int NPHASE = 15;
struct Args { const float* in[20]; float* out; unsigned char* ws; int ph_lo, ph_hi, dry, pad; };
static_assert(sizeof(Args) == 20 * 8 + 8 + 8 + 4 * 4, "Args has no padding");

__global__ void __launch_bounds__(NWAVES * 64, 2) mk_fwd(Args args) {
    extern __shared__ __attribute__((aligned(16))) unsigned char lds_raw[];
    Frame F;
    F.lds = (LAS unsigned char*)lds_raw;
    F.wave = __builtin_amdgcn_readfirstlane(threadIdx.x >> 6); F.lane = lane_id(); F.tid = F.wave * 64 + F.lane;
    F.G = gridDim.x; { const int bx = blockIdx.x; F.vcu = (F.G % 8 == 0) ? (bx % 8) * (F.G / 8) + bx / 8 : bx; }
    F.in = args.in; F.out = args.out; F.ws = args.ws; F.dry = args.dry;
    volatile LAS unsigned* MISC = (volatile LAS unsigned*)(F.lds + MISC_OFF);
    if (F.tid < 64) MISC[F.tid] = 0u;
    __syncthreads();
    const int lo = args.ph_lo, hi = args.ph_hi;
    XcdBarrier bar; bar.bar = (unsigned*)(F.ws + WS_CTL) + CW_BAR; bar.x = 0; bar.st = nullptr;
    if (hi - lo > 1) bar = xcd_barrier_post((unsigned*)(F.ws + WS_CTL) + CW_BAR, MISC + 8);
#ifndef PH_MASK
#define PH_MASK 0xFFFFFFFFu
#endif
#define IN(k) (((PH_MASK >> (k)) & 1u) && lo <= (k) && (k) < hi)
#define LAUNDER(p, T) do { unsigned _lo = (unsigned)(unsigned long long)(p), _hi = (unsigned)((unsigned long long)(p) >> 32); asm volatile("" : "+v"(_lo), "+v"(_hi)); \
        _lo = __builtin_amdgcn_readfirstlane(_lo); _hi = __builtin_amdgcn_readfirstlane(_hi); (p) = (T)(((unsigned long long)_hi << 32) | _lo); } while (0)
#define SEAM(k) do { if (IN(k) && IN((k) + 1)) xcd_barrier(bar); LAUNDER(F.ws, unsigned char*); LAUNDER(F.out, float*); F.lane = lane_id(); F.tid = F.wave * 64 + F.lane; } while (0)
    const int bx = (int)blockIdx.x;
    LAS unsigned char* ring = F.lds + RING_OFF;

    if (IN(0)) { phase_prologue(F); } SEAM(0);
    if (IN(1)) {
        pg8::Gemm g{WSP(bf16_t, WS_XN1), WSP(bf16_t, WS_WIN), T_TOK, 8192, 1024, 1024, 0}; pg8::StaticOrder S; S.init(T_TOK, 8192, F.G, bx);
        pg8::EpiProj E{WSP(bf16_t, WS_GQ), WSP(bf16_t, WS_GK), WSP(bf16_t, WS_GV), WSP(bf16_t, WS_GR), WSP(bf16_t, WS_SQ), WSP(bf16_t, WS_SK), WSP(bf16_t, WS_SV),
                       (bf16_t*)F.out, (bf16_t*)F.out + (size_t)T_TOK * 1024};
        pg8::gemm_phase<pg8::EpiProj>(ring, g, S, E, F.tid);
    } SEAM(1);
    if (IN(2)) { phase_gla_prep(F); } SEAM(2);
    if (IN(3)) { phase_attn_a(F); } SEAM(3);
    if (IN(4)) { phase_attn_b(F); } SEAM(4);
    if (IN(5)) {
        cvt_copy(F, F.in[14], WSP(bf16_t, WS_UB), (size_t)16384 * 1024);
        cvt_copy(F, F.in[15], WSP(bf16_t, WS_VB), (size_t)16384 * 1024);
        VM_WAIT(); __syncthreads();
        pg8::StaticOrder S; S.init(T_TOK, 1024, F.G, bx);
        { pg8::Gemm g{WSP(bf16_t, WS_GLAN), WSP(bf16_t, WS_WGA), T_TOK, 1024, 1024, 1024, 0}; pg8::EpiMix<true> E{(const bf16_t*)F.out, WSP(bf16_t, WS_MIX)};
          pg8::gemm_phase<pg8::EpiMix<true>>(ring, g, S, E, F.tid); }
        { pg8::Gemm g{WSP(bf16_t, WS_SQ), WSP(bf16_t, WS_WSB), T_TOK, 1024, 1024, 1024, 0}; pg8::EpiMix<false> E{(const bf16_t*)F.out + (size_t)T_TOK * 1024, WSP(bf16_t, WS_MIX)};
          pg8::gemm_phase<pg8::EpiMix<false>>(ring, g, S, E, F.tid); }
    } SEAM(5);
    if (IN(6)) {
        pg8::Gemm g{WSP(bf16_t, WS_MIX), WSP(bf16_t, WS_WO), T_TOK, 1024, 1024, 1024, 0}; pg8::StaticOrder S; S.init(T_TOK, 1024, F.G, bx);
        pg8::EpiH1 E{F.in[0], F.in[10], WSP(float, WS_H1), WSP(bf16_t, WS_H1G), WSP(float, WS_SSQ1)};
        pg8::gemm_phase<pg8::EpiH1>(ring, g, S, E, F.tid);
    } SEAM(6);
    if (IN(7)) {
        pg8::Gemm g{WSP(bf16_t, WS_H1G), WSP(bf16_t, WS_WPQ), T_TOK, 2048, 1024, 1024, 0}; pg8::StaticOrder S; S.init(T_TOK, 2048, F.G, bx);
        pg8::EpiQ E{WSP(float, WS_SSQ1), WSP(bf16_t, WS_Q), 2048};
        pg8::gemm_phase<pg8::EpiQ>(ring, g, S, E, F.tid);
    } SEAM(7);
#define PEER_SCORES(hs) do { if (IN(8 + 2 * (hs))) { \
            pg8::Gemm g{WSP(bf16_t, WS_Q) + (hs) * 1024, WSP(bf16_t, WS_KD) + (size_t)(hs) * 1024 * 256, T_TOK, 1024, 256, 2048, 256}; pg8::StaticOrder S; S.init(T_TOK, 1024, F.G, bx); \
            pg8::EpiF32 E{F.out, 1024}; \
            pg8::gemm_phase<pg8::EpiF32>(ring, g, S, E, F.tid); \
        } SEAM(8 + 2 * (hs)); \
        if (IN(9 + 2 * (hs))) { phase_peer_select(F, (hs)); } SEAM(9 + 2 * (hs)); } while (0)
    PEER_SCORES(0);
    PEER_SCORES(1);
#undef PEER_SCORES
    if (IN(12)) { cvt_copy(F, F.in[1], WSP(bf16_t, WS_PB), (size_t)T_TOK * 256); phase_peer_gather(F); } SEAM(12);
    if (IN(13)) {
        pg8::StaticOrder S; S.init(T_TOK, 1024, F.G, bx);
        { pg8::Gemm g{WSP(bf16_t, WS_PB), WSP(bf16_t, WS_WPLE), T_TOK, 1024, 256, 256, 0}; pg8::EpiBf E{WSP(bf16_t, WS_PLE), 1024};
          pg8::gemm_phase<pg8::EpiBf>(ring, g, S, E, F.tid); }
        { pg8::Gemm g{WSP(bf16_t, WS_XN3), WSP(bf16_t, WS_WPG), T_TOK, 1024, 1024, 1024, 0}; pg8::EpiH3 E{F.out, WSP(bf16_t, WS_PLE), F.out, WSP(float, WS_SSQ3)};
          pg8::gemm_phase<pg8::EpiH3>(ring, g, S, E, F.tid); }
    } SEAM(13);
    if (IN(14)) { phase_final(F); }
#undef IN
#undef SEAM
}

extern "C" void kernel_launch(void* const* d_in, const int* in_sizes, int n_in, void* d_out, int out_size, void* d_ws, size_t ws_size, hipStream_t stream) {
    static int grid = 0;
    if (grid == 0) {
        if (n_in != 20 || in_sizes[0] != T_TOK * 1024 || out_size != T_TOK * 1024 || ws_size < WS_END) {
            fprintf(stderr, "kernel_launch: unexpected shapes (n_in %d, in0 %d, out %d, ws %zu < %zu?); nothing launched\n", n_in, n_in > 0 ? in_sizes[0] : -1, out_size, ws_size, (size_t)WS_END); grid = -1; return; }
        int dev = 0, cus = 0, per_cu = 0;
        if (hipGetDevice(&dev) != hipSuccess || hipDeviceGetAttribute(&cus, hipDeviceAttributeMultiprocessorCount, dev) != hipSuccess) { grid = -1; return; }
        if (hipFuncSetAttribute((const void*)mk_fwd, hipFuncAttributeMaxDynamicSharedMemorySize, LDS_BYTES) != hipSuccess) { fprintf(stderr, "kernel_launch: hipFuncSetAttribute failed\n"); grid = -1; return; }
        if (hipOccupancyMaxActiveBlocksPerMultiprocessor(&per_cu, (const void*)mk_fwd, NWAVES * 64, LDS_BYTES) != hipSuccess || per_cu < 1)
            fprintf(stderr, "kernel_launch: note: occupancy query reports %d workgroups per CU\n", per_cu);
        (void)hipGetLastError();
        grid = cus;
        if (grid != 256) fprintf(stderr, "kernel_launch: note: %d CUs (kernel tuned for 256)\n", grid);
    }
    if (grid < 0) return;
    if (hipMemsetAsync((char*)d_ws + WS_CTL, 0, CTL_ZERO_BYTES, stream) != hipSuccess) { fprintf(stderr, "kernel_launch: hipMemsetAsync failed\n"); return; }
    Args a{};
    for (int i = 0; i < 20; ++i) a.in[i] = (const float*)d_in[i];
    a.out = (float*)d_out; a.ws = (unsigned char*)d_ws;
#if MK_FUSED
    a.ph_lo = 0; a.ph_hi = NPHASE;
    hipLaunchKernelGGL(mk_fwd, dim3(grid), dim3(NWAVES * 64), LDS_BYTES, stream, a);
#else
#ifndef PROBE_PHASE
#define PROBE_PHASE -1
#define PROBE_REPS 0
#endif
    for (int p = 0; p < NPHASE; ++p) { a.ph_lo = p; a.ph_hi = p + 1;
        if (p == PROBE_PHASE) { a.dry = 1; for (int r = 0; r < PROBE_REPS; ++r) hipLaunchKernelGGL(mk_fwd, dim3(grid), dim3(NWAVES * 64), LDS_BYTES, stream, a); a.dry = 0; }
        hipLaunchKernelGGL(mk_fwd, dim3(grid), dim3(NWAVES * 64), LDS_BYTES, stream, a); }
#endif
}
```

```cpp
#define MK_FUSED 1
#include <hip/hip_runtime.h>
#include <cstdio>
#include <cstdint>

#define LAS __attribute__((address_space(3)))
#define GAS __attribute__((address_space(1)))
typedef unsigned short bf16_t;
typedef short bf16x8 __attribute__((ext_vector_type(8)));
typedef short s16x4 __attribute__((ext_vector_type(4)));
typedef float f32x2 __attribute__((ext_vector_type(2)));
typedef float f32x4 __attribute__((ext_vector_type(4)));
typedef float f32x16 __attribute__((ext_vector_type(16)));
typedef unsigned u32x2 __attribute__((ext_vector_type(2)));
typedef unsigned u32x4 __attribute__((ext_vector_type(4)));
typedef __bf16 bf16x2_t __attribute__((ext_vector_type(2)));

__device__ __forceinline__ unsigned cvtpk(float lo, float hi) { f32x2 v = {lo, hi}; bf16x2_t b = __builtin_convertvector(v, bf16x2_t); return __builtin_bit_cast(unsigned, b); }
__device__ __forceinline__ float bf_lo(unsigned u) { return __uint_as_float(u << 16); }
__device__ __forceinline__ float bf_hi(unsigned u) { return __uint_as_float(u & 0xffff0000u); }
__device__ __forceinline__ float bf1(bf16_t u) { return __uint_as_float(((unsigned)u) << 16); }
__device__ __forceinline__ float fast_sigmoid(float x) { return __builtin_amdgcn_rcpf(1.0f + __expf(-x)); }

namespace pg8 {
constexpr int BM = 256, BK = 64, HALF = 128, HTB = HALF * BK * 2  , STAGE_BYTES = 8 * HTB, NXCD = 8, WGM = 8;

__host__ __device__ __forceinline__ int lds_byte(int r, int c) { const int st = (r >> 4) * 2 + (c >> 5), rr = r & 15, cc = c & 31, ob = rr * 64 + cc * 2; return st * 1024 + (ob ^ (((ob >> 9) & 1) << 5)); }
__host__ __device__ __forceinline__ void stage_rc(int b, int& R, int& C) { const int st = b / 1024, sb = b % 1024, swz = sb ^ (((sb >> 9) & 1) << 5); R = (st >> 1) * 16 + swz / 64; C = (st & 1) * 32 + (swz % 64) / 2; }
__host__ __device__ __forceinline__ int perm32(int rho) { const int n = rho >> 4, i = rho & 15; return 8 * (i >> 2) + 4 * n + (i & 3); }

struct Unit { int pm, pn; };
struct Gemm { const bf16_t* A; const bf16_t* Bt; int M, N, K, lda, a_pn_cols; };

struct StaticOrder {
    int nM, nN, nwg, G, c;
    __host__ __device__ void init(int M, int N, int G_, int c_) { nM = M / BM; nN = N / BM; nwg = nM * nN; G = G_; c = c_; }
    __host__ __device__ bool next(int i, Unit& u) const {
        const long L = (long)i * G + c; if (L >= nwg) return false;
        int wgid = (int)L; { const int q = nwg / NXCD, r = nwg % NXCD, xcd = wgid % NXCD, off = wgid / NXCD; wgid = (xcd < r ? xcd * (q + 1) : r * (q + 1) + (xcd - r) * q) + off; }
        const int nig = WGM * nN, gid = wgid / nig, fm = gid * WGM, gsz = (nM - fm) < WGM ? (nM - fm) : WGM;
        u.pm = fm + ((wgid % nig) % gsz); u.pn = (wgid % nig) / gsz; return true;
    }
};

template <class Epi, bool ALIGN_EPI = true, bool SP2 = true>
__device__ __forceinline__ void gemm_phase(LAS unsigned char* lds, const Gemm g, const StaticOrder& S, const Epi& E, int tid) {
    const int wid = __builtin_amdgcn_readfirstlane(tid >> 6), lane = tid & 63, wr = wid >> 2, wc = wid & 3, fr = lane & 15, fq = lane >> 4;
    const int K = g.K, nt = K / BK, lda = g.lda;
    unsigned voffA[2], voffB[2];
#pragma unroll
    for (int i = 0; i < 2; ++i) { int R, C; stage_rc(tid * 16 + i * 8192, R, C); const int Rb = Epi::PERM ? ((R & ~31) + perm32(R & 31)) : R;
        voffA[i] = (unsigned)(R * lda + C) * 2u; voffB[i] = (unsigned)(Rb * K + C) * 2u; }
    const size_t kstep = (size_t)(BK * 2);
    const size_t hA = (size_t)HALF * lda * 2, hB = (size_t)HALF * K * 2;
    const size_t tA = 2 * hA, tB = 2 * hB;
    const size_t pnA = (size_t)g.a_pn_cols * 2;
    const unsigned ldsw = (unsigned)wid * 1024u;
    const int aoff = lds_byte(wr * 64 + fr, fq * 8), boff = lds_byte(wc * 32 + fr, fq * 8);
#define PG8_SA(b, h) (((b) * 2 + (h)) * HTB)
#define PG8_SB(b, h) ((4 + (b) * 2 + (h)) * HTB)
#define PG8_STAGE(bufoff, gbase, voff) do { _Pragma("unroll") for (int _i = 0; _i < 2; ++_i) \
        __builtin_amdgcn_global_load_lds((const unsigned*)((const char*)(gbase) + (voff)[_i]), (LAS unsigned*)(lds + (bufoff) + ldsw + _i * 8192), 16, 0, 0); } while (0)
#define PG8_LDA(dst, b, h) do { _Pragma("unroll") for (int m = 0; m < 4; ++m) _Pragma("unroll") for (int k = 0; k < 2; ++k) dst[m][k] = *(const LAS bf16x8*)(lds + PG8_SA(b, h) + aoff + m * 2048 + k * 1024); } while (0)
#define PG8_LDB(dst, b, h) do { _Pragma("unroll") for (int n = 0; n < 2; ++n) _Pragma("unroll") for (int k = 0; k < 2; ++k) dst[n][k] = *(const LAS bf16x8*)(lds + PG8_SB(b, h) + boff + n * 2048 + k * 1024); } while (0)
#define PG8_MMA(ai, bj, At, Bt) do { __builtin_amdgcn_s_setprio(1); _Pragma("unroll") for (int m = 0; m < 4; ++m) _Pragma("unroll") for (int n = 0; n < 2; ++n) _Pragma("unroll") for (int k = 0; k < 2; ++k) \
        acc[ai][bj][m][n] = __builtin_amdgcn_mfma_f32_16x16x32_bf16(Bt[n][k], At[m][k], acc[ai][bj][m][n], 0, 0, 0); __builtin_amdgcn_s_setprio(0); } while (0)
#define PG8_WAIT_V(n) asm volatile("s_waitcnt vmcnt(" #n ")" ::: "memory")
#define PG8_WAIT_L(n) asm volatile("s_waitcnt lgkmcnt(" #n ")" ::: "memory")
#define PG8_BAR __builtin_amdgcn_s_barrier()
#define PG8_SCHED __builtin_amdgcn_sched_barrier(0)
    Unit cur, nxt; int ui = 0;
    if (!S.next(0, cur)) return;
    f32x4 acc[2][2][4][2];
#pragma unroll
    for (int a = 0; a < 2; ++a)
#pragma unroll
        for (int b = 0; b < 2; ++b)
#pragma unroll
            for (int m = 0; m < 4; ++m)
#pragma unroll
                for (int n = 0; n < 2; ++n) acc[a][b][m][n] = (f32x4){0.f, 0.f, 0.f, 0.f};
    bf16x8 At[4][2], B0[2][2], B1[2][2];
    const char* cA = (const char*)g.A + (size_t)cur.pm * tA + (size_t)cur.pn * pnA; const char* cB = (const char*)g.Bt + (size_t)cur.pn * tB;
    if constexpr (SP2) {
        PG8_STAGE(PG8_SB(0, 0), cB, voffB); PG8_STAGE(PG8_SB(0, 1), cB + hB, voffB); PG8_STAGE(PG8_SA(0, 0), cA, voffA); PG8_STAGE(PG8_SA(0, 1), cA + hA, voffA);
        if (wr == 1) PG8_BAR;
        PG8_WAIT_V(2); PG8_BAR;
        PG8_STAGE(PG8_SB(1, 0), cB + kstep, voffB); PG8_STAGE(PG8_SA(1, 0), cA + kstep, voffA); PG8_STAGE(PG8_SB(1, 1), cB + hB + kstep, voffB);
        PG8_WAIT_V(6); PG8_BAR;
    } else {
        PG8_STAGE(PG8_SB(0, 0), cB, voffB); PG8_STAGE(PG8_SA(0, 0), cA, voffA); PG8_STAGE(PG8_SB(0, 1), cB + hB, voffB); PG8_STAGE(PG8_SA(0, 1), cA + hA, voffA);
        if (wr == 1) PG8_BAR;
        PG8_WAIT_V(4); PG8_BAR;
        PG8_STAGE(PG8_SB(1, 0), cB + kstep, voffB); PG8_STAGE(PG8_SA(1, 0), cA + kstep, voffA); PG8_STAGE(PG8_SB(1, 1), cB + hB + kstep, voffB);
        PG8_WAIT_V(6); PG8_BAR;
    }
    for (;;) {
        const bool has_next = S.next(ui + 1, nxt);
        const char* nA = has_next ? (const char*)g.A + (size_t)nxt.pm * tA + (size_t)nxt.pn * pnA : cA; const char* nB = has_next ? (const char*)g.Bt + (size_t)nxt.pn * tB : cB;
#pragma unroll 1
        for (int t = 0; t < nt; t += 2) {
            const bool last = (t == nt - 2);
            const char* a1 = cA + (size_t)(t + 1) * kstep;
            const char* a2 = last ? nA : cA + (size_t)(t + 2) * kstep; const char* b2 = last ? nB : cB + (size_t)(t + 2) * kstep;
            const char* a3 = a2 + kstep; const char* b3 = b2 + kstep;
            if constexpr (SP2) {
            PG8_LDB(B0, 0, 0); PG8_LDB(B1, 0, 1); PG8_SCHED; PG8_LDA(At, 0, 0); PG8_STAGE(PG8_SA(1, 1), a1 + hA, voffA);
            PG8_WAIT_V(8); PG8_WAIT_L(0); PG8_BAR; PG8_MMA(0, 0, At, B0); PG8_MMA(0, 1, At, B1); PG8_BAR; PG8_SCHED;
            PG8_LDA(At, 0, 1); PG8_STAGE(PG8_SB(0, 0), b2, voffB); PG8_STAGE(PG8_SB(0, 1), b2 + hB, voffB); PG8_STAGE(PG8_SA(0, 0), a2, voffA);
            PG8_WAIT_V(8); PG8_WAIT_L(0); PG8_BAR; PG8_MMA(1, 0, At, B0); PG8_MMA(1, 1, At, B1); PG8_BAR; PG8_SCHED;
            PG8_LDB(B0, 1, 0); PG8_LDB(B1, 1, 1); PG8_SCHED; PG8_LDA(At, 1, 0); PG8_STAGE(PG8_SA(0, 1), a2 + hA, voffA);
            PG8_WAIT_V(8); PG8_WAIT_L(0); PG8_BAR; PG8_MMA(0, 0, At, B0); PG8_MMA(0, 1, At, B1); PG8_BAR; PG8_SCHED;
            PG8_LDA(At, 1, 1); PG8_STAGE(PG8_SB(1, 0), b3, voffB); PG8_STAGE(PG8_SB(1, 1), b3 + hB, voffB); PG8_STAGE(PG8_SA(1, 0), a3, voffA);
            PG8_WAIT_V(8); PG8_WAIT_L(0); PG8_BAR; PG8_MMA(1, 0, At, B0); PG8_MMA(1, 1, At, B1); PG8_BAR; PG8_SCHED;
            } else {
            PG8_LDB(B0, 0, 0); PG8_SCHED; PG8_LDA(At, 0, 0); PG8_STAGE(PG8_SA(1, 1), a1 + hA, voffA);
            PG8_WAIT_L(8); PG8_BAR; PG8_WAIT_L(0); PG8_MMA(0, 0, At, B0); PG8_BAR; PG8_SCHED;
            PG8_LDB(B1, 0, 1); PG8_STAGE(PG8_SB(0, 0), b2, voffB);
            PG8_BAR; PG8_WAIT_L(0); PG8_MMA(0, 1, At, B1); PG8_BAR;
            PG8_LDA(At, 0, 1); PG8_STAGE(PG8_SA(0, 0), a2, voffA);
            PG8_BAR; PG8_WAIT_L(0); PG8_MMA(1, 0, At, B0); PG8_BAR; PG8_SCHED;
            PG8_STAGE(PG8_SB(0, 1), b2 + hB, voffB);
            PG8_WAIT_V(6); PG8_BAR; PG8_MMA(1, 1, At, B1); PG8_BAR;
            PG8_LDB(B0, 1, 0); PG8_SCHED; PG8_LDA(At, 1, 0); PG8_STAGE(PG8_SA(0, 1), a2 + hA, voffA);
            PG8_WAIT_L(8); PG8_BAR; PG8_WAIT_L(0); PG8_MMA(0, 0, At, B0); PG8_BAR; PG8_SCHED;
            PG8_LDB(B1, 1, 1); PG8_STAGE(PG8_SB(1, 0), b3, voffB);
            PG8_BAR; PG8_WAIT_L(0); PG8_MMA(0, 1, At, B1); PG8_BAR;
            PG8_LDA(At, 1, 1); PG8_STAGE(PG8_SA(1, 0), a3, voffA);
            PG8_BAR; PG8_WAIT_L(0); PG8_MMA(1, 0, At, B0); PG8_BAR; PG8_SCHED;
            PG8_STAGE(PG8_SB(1, 1), b3 + hB, voffB);
            PG8_WAIT_V(6); PG8_BAR; PG8_MMA(1, 1, At, B1); PG8_BAR;
            }
        }
        if constexpr (ALIGN_EPI) { if (wr == 0) PG8_BAR; }
        E(acc, cur, wr, wc, fr, fq);
        if (!has_next) break;
#pragma unroll
        for (int a = 0; a < 2; ++a)
#pragma unroll
            for (int b = 0; b < 2; ++b)
#pragma unroll
                for (int m = 0; m < 4; ++m)
#pragma unroll
                    for (int n = 0; n < 2; ++n) acc[a][b][m][n] = (f32x4){0.f, 0.f, 0.f, 0.f};
        cur = nxt; cA = nA; cB = nB; ++ui;
        if constexpr (ALIGN_EPI) { if (wr == 1) PG8_BAR; }
    }
    PG8_WAIT_V(0);
    if constexpr (!ALIGN_EPI) { if (wr == 0) PG8_BAR; }
    PG8_BAR;
#undef PG8_SA
#undef PG8_SB
#undef PG8_STAGE
#undef PG8_LDA
#undef PG8_LDB
#undef PG8_MMA
#undef PG8_WAIT_V
#undef PG8_WAIT_L
#undef PG8_BAR
#undef PG8_SCHED
}
}
constexpr int T_TOK = 16384, DM = 1024, SEQ = 4096, NB = 4;
constexpr float EPS = 1e-6f;
constexpr float LOG2E = 1.4426950408889634f;

namespace pg8 {
struct EpiProj {
    static constexpr bool PERM = true;
    bf16_t *GQ, *GK, *GV, *GR, *SQ, *SK, *SV, *SGA, *SGB;
    __device__ __forceinline__ void operator()(const f32x4 (&acc)[2][2][4][2], const Unit& u, int wr, int wc, int fr, int fq) const {
        const int pn = u.pn; bf16_t* base; int ldc = 1024, c0; int act = 0; float sc = 1.f;
        if (pn < 2) { base = GQ; ldc = 512; c0 = pn * 256; sc = 0.08838834764831845f; }
        else if (pn < 4) { base = GK; ldc = 512; c0 = (pn - 2) * 256; }
        else if (pn < 8) { base = GV; c0 = (pn - 4) * 256; }
        else if (pn < 12) { base = GR; c0 = (pn - 8) * 256; act = 1; }
        else if (pn < 16) { base = SQ; c0 = (pn - 12) * 256; sc = 0.125f * LOG2E; }
        else if (pn < 20) { base = SK; c0 = (pn - 16) * 256; }
        else if (pn < 24) { base = SV; c0 = (pn - 20) * 256; }
        else if (pn < 28) { base = SGA; c0 = (pn - 24) * 256; act = 2; }
        else { base = SGB; c0 = (pn - 28) * 256; act = 2; }
        const int row0 = u.pm * BM + wr * 64 + fr, col0 = c0 + wc * 32 + 8 * fq;
#pragma unroll
        for (int ai = 0; ai < 2; ++ai)
#pragma unroll
            for (int m = 0; m < 4; ++m) { bf16_t* rowp = base + (size_t)(row0 + ai * HALF + m * 16) * ldc + col0;
#pragma unroll
                for (int bj = 0; bj < 2; ++bj) { f32x4 v0 = acc[ai][bj][m][0], v1 = acc[ai][bj][m][1];
                    if (act == 1) {
#pragma unroll
                        for (int j = 0; j < 4; ++j) { v0[j] = v0[j] * fast_sigmoid(v0[j]); v1[j] = v1[j] * fast_sigmoid(v1[j]); } }
                    else if (act == 2) {
#pragma unroll
                        for (int j = 0; j < 4; ++j) { v0[j] = fast_sigmoid(v0[j]); v1[j] = fast_sigmoid(v1[j]); } }
                    else { v0 = v0 * sc; v1 = v1 * sc; }
                    u32x4 w; w.x = cvtpk(v0[0], v0[1]); w.y = cvtpk(v0[2], v0[3]); w.z = cvtpk(v1[0], v1[1]); w.w = cvtpk(v1[2], v1[3]);
                    *(u32x4*)(rowp + bj * HALF) = w; } }
    }
};
template <bool FIRST> struct EpiMix {
    static constexpr bool PERM = true;
    const bf16_t* gate; bf16_t* mixed;
    __device__ __forceinline__ void operator()(const f32x4 (&acc)[2][2][4][2], const Unit& u, int wr, int wc, int fr, int fq) const {
        const int row0 = u.pm * BM + wr * 64 + fr, col0 = u.pn * BM + wc * 32 + 8 * fq;
#pragma unroll
        for (int ai = 0; ai < 2; ++ai)
#pragma unroll
            for (int m = 0; m < 4; ++m) { const size_t off = (size_t)(row0 + ai * HALF + m * 16) * 1024 + col0;
#pragma unroll
                for (int bj = 0; bj < 2; ++bj) { const f32x4 a0 = acc[ai][bj][m][0], a1 = acc[ai][bj][m][1];
                    const u32x4 gv = *(const u32x4*)(gate + off + bj * HALF);
                    float r[8];
                    r[0] = a0[0] * bf_lo(gv.x); r[1] = a0[1] * bf_hi(gv.x); r[2] = a0[2] * bf_lo(gv.y); r[3] = a0[3] * bf_hi(gv.y);
                    r[4] = a1[0] * bf_lo(gv.z); r[5] = a1[1] * bf_hi(gv.z); r[6] = a1[2] * bf_lo(gv.w); r[7] = a1[3] * bf_hi(gv.w);
                    if (!FIRST) { const u32x4 mv = *(const u32x4*)(mixed + off + bj * HALF);
                        r[0] += bf_lo(mv.x); r[1] += bf_hi(mv.x); r[2] += bf_lo(mv.y); r[3] += bf_hi(mv.y); r[4] += bf_lo(mv.z); r[5] += bf_hi(mv.z); r[6] += bf_lo(mv.w); r[7] += bf_hi(mv.w); }
                    u32x4 w; w.x = cvtpk(r[0], r[1]); w.y = cvtpk(r[2], r[3]); w.z = cvtpk(r[4], r[5]); w.w = cvtpk(r[6], r[7]);
                    *(u32x4*)(mixed + off + bj * HALF) = w; } }
    }
};
struct EpiH1 {
    static constexpr bool PERM = false;
    const float* x; const float* g; float* H1; bf16_t* H1G; float* SSQ;
    __device__ __forceinline__ void operator()(const f32x4 (&acc)[2][2][4][2], const Unit& u, int wr, int wc, int fr, int fq) const {
        const int row0 = u.pm * BM + wr * 64 + fr, col0 = u.pn * BM + wc * 32 + 4 * fq;
        f32x4 gv[2][2];
#pragma unroll
        for (int bj = 0; bj < 2; ++bj)
#pragma unroll
            for (int n = 0; n < 2; ++n) gv[bj][n] = *(const f32x4*)(g + col0 + bj * HALF + n * 16);
#pragma unroll
        for (int ai = 0; ai < 2; ++ai)
#pragma unroll
            for (int m = 0; m < 4; ++m) { const int row = row0 + ai * HALF + m * 16; const size_t off = (size_t)row * 1024 + col0; float s = 0.f;
#pragma unroll
                for (int bj = 0; bj < 2; ++bj)
#pragma unroll
                    for (int n = 0; n < 2; ++n) { const f32x4 xv = *(const f32x4*)(x + off + bj * HALF + n * 16); const f32x4 h = xv + acc[ai][bj][m][n];
                        *(f32x4*)(H1 + off + bj * HALF + n * 16) = h; s += (h[0] * h[0] + h[1] * h[1]) + (h[2] * h[2] + h[3] * h[3]);
                        const f32x4 hg = h * gv[bj][n]; u32x2 w; w.x = cvtpk(hg[0], hg[1]); w.y = cvtpk(hg[2], hg[3]); *(u32x2*)(H1G + off + bj * HALF + n * 16) = w; }
                s += __shfl_xor(s, 16); s += __shfl_xor(s, 32);
                if (fq == 0) SSQ[(size_t)row * 16 + u.pn * 4 + wc] = s; }
    }
};
struct EpiQ {
    static constexpr bool PERM = true;
    const float* SSQ; bf16_t* Q; int ldc;
    __device__ __forceinline__ void operator()(const f32x4 (&acc)[2][2][4][2], const Unit& u, int wr, int wc, int fr, int fq) const {
        const int row0 = u.pm * BM + wr * 64 + fr, col0 = u.pn * BM + wc * 32 + 8 * fq;
#pragma unroll
        for (int ai = 0; ai < 2; ++ai)
#pragma unroll
            for (int m = 0; m < 4; ++m) { const int row = row0 + ai * HALF + m * 16; const f32x4* sp = (const f32x4*)(SSQ + (size_t)row * 16);
                const f32x4 s0 = sp[0], s1 = sp[1], s2 = sp[2], s3 = sp[3]; const f32x4 st = (s0 + s1) + (s2 + s3);
                const float rstd = __builtin_amdgcn_rsqf(((st[0] + st[1]) + (st[2] + st[3])) * (1.0f / 1024.0f) + EPS);
                bf16_t* rowp = Q + (size_t)row * ldc + col0;
#pragma unroll
                for (int bj = 0; bj < 2; ++bj) { const f32x4 v0 = acc[ai][bj][m][0] * rstd, v1 = acc[ai][bj][m][1] * rstd;
                    u32x4 w; w.x = cvtpk(v0[0], v0[1]); w.y = cvtpk(v0[2], v0[3]); w.z = cvtpk(v1[0], v1[1]); w.w = cvtpk(v1[2], v1[3]);
                    *(u32x4*)(rowp + bj * HALF) = w; } }
    }
};
struct EpiF32 {
    static constexpr bool PERM = false;
    float* O; int ldc;
    __device__ __forceinline__ void operator()(const f32x4 (&acc)[2][2][4][2], const Unit& u, int wr, int wc, int fr, int fq) const {
        const int row0 = u.pm * BM + wr * 64 + fr, col0 = u.pn * BM + wc * 32 + 4 * fq;
#pragma unroll
        for (int ai = 0; ai < 2; ++ai)
#pragma unroll
            for (int m = 0; m < 4; ++m) { float* rowp = O + (size_t)(row0 + ai * HALF + m * 16) * ldc + col0;
#pragma unroll
                for (int bj = 0; bj < 2; ++bj)
#pragma unroll
                    for (int n = 0; n < 2; ++n) *(f32x4*)(rowp + bj * HALF + n * 16) = acc[ai][bj][m][n]; }
    }
};
struct EpiBf {
    static constexpr bool PERM = true;
    bf16_t* O; int ldc;
    __device__ __forceinline__ void operator()(const f32x4 (&acc)[2][2][4][2], const Unit& u, int wr, int wc, int fr, int fq) const {
        const int row0 = u.pm * BM + wr * 64 + fr, col0 = u.pn * BM + wc * 32 + 8 * fq;
#pragma unroll
        for (int ai = 0; ai < 2; ++ai)
#pragma unroll
            for (int m = 0; m < 4; ++m) { bf16_t* rowp = O + (size_t)(row0 + ai * HALF + m * 16) * ldc + col0;
#pragma unroll
                for (int bj = 0; bj < 2; ++bj) { const f32x4 v0 = acc[ai][bj][m][0], v1 = acc[ai][bj][m][1];
                    u32x4 w; w.x = cvtpk(v0[0], v0[1]); w.y = cvtpk(v0[2], v0[3]); w.z = cvtpk(v1[0], v1[1]); w.w = cvtpk(v1[2], v1[3]);
                    *(u32x4*)(rowp + bj * HALF) = w; } }
    }
};
struct EpiH3 {
    static constexpr bool PERM = false;
    const float* H2; const bf16_t* PLE; float* OUT; float* SSQ;
    __device__ __forceinline__ void operator()(const f32x4 (&acc)[2][2][4][2], const Unit& u, int wr, int wc, int fr, int fq) const {
        const int row0 = u.pm * BM + wr * 64 + fr, col0 = u.pn * BM + wc * 32 + 4 * fq;
#pragma unroll
        for (int ai = 0; ai < 2; ++ai)
#pragma unroll
            for (int m = 0; m < 4; ++m) { const int row = row0 + ai * HALF + m * 16; const size_t off = (size_t)row * 1024 + col0; float s = 0.f;
#pragma unroll
                for (int bj = 0; bj < 2; ++bj)
#pragma unroll
                    for (int n = 0; n < 2; ++n) { const size_t o2 = off + bj * HALF + n * 16; const f32x4 hv = *(const f32x4*)(H2 + o2); const u32x2 pv = *(const u32x2*)(PLE + o2);
                        const f32x4 a = acc[ai][bj][m][n]; f32x4 h;
                        h[0] = hv[0] + bf_lo(pv.x) * fast_sigmoid(a[0]); h[1] = hv[1] + bf_hi(pv.x) * fast_sigmoid(a[1]);
                        h[2] = hv[2] + bf_lo(pv.y) * fast_sigmoid(a[2]); h[3] = hv[3] + bf_hi(pv.y) * fast_sigmoid(a[3]);
                        *(f32x4*)(OUT + o2) = h; s += (h[0] * h[0] + h[1] * h[1]) + (h[2] * h[2] + h[3] * h[3]); }
                s += __shfl_xor(s, 16); s += __shfl_xor(s, 32);
                if (fq == 0) SSQ[(size_t)row * 16 + u.pn * 4 + wc] = s;
                asm volatile("" ::: "memory"); }
    }
};
}
constexpr size_t MiB = 1u << 20;
constexpr size_t WS_CTL = 0, CTL_ZERO_BYTES = 64 * 1024;
constexpr size_t WS_PEND = 64 * 1024;
constexpr size_t WS_WPLE = 512 * 1024;
constexpr size_t WS_KD = 1 * MiB;
constexpr size_t WS_GLAG = 2 * MiB;
constexpr size_t WS_WIN = 3 * MiB;
constexpr size_t WS_SEND = 4 * MiB;
constexpr size_t WS_EXP = 4 * MiB;
constexpr size_t WS_SSQ1 = 13 * MiB;
constexpr size_t WS_SSQ3 = 14 * MiB;
constexpr size_t WS_RSU = 15 * MiB, WS_RSV = 15 * MiB + 64 * 1024;
constexpr size_t WS_WGA = 20 * MiB, WS_WSB = 22 * MiB, WS_WO = 24 * MiB, WS_WPG = 26 * MiB, WS_WPQ = 28 * MiB;
constexpr size_t WS_A = 32 * MiB;
constexpr size_t WS_GQ = WS_A, WS_GK = WS_A + 16 * MiB, WS_UB8 = WS_A, WS_VB8 = WS_A + 16 * MiB;
constexpr size_t WS_B = 64 * MiB;
constexpr size_t WS_GV = WS_B;
constexpr size_t WS_C = 96 * MiB;
constexpr size_t WS_GR = WS_C, WS_H1 = WS_C;
constexpr size_t WS_D = 128 * MiB;
constexpr size_t WS_SQ = WS_D;
constexpr size_t WS_E = 160 * MiB;
constexpr size_t WS_SK = WS_E, WS_MIX = WS_E, WS_Q = WS_E, WS_XN3 = WS_E;
constexpr size_t WS_F = 192 * MiB;
constexpr size_t WS_SV = WS_F, WS_PB = WS_F;
constexpr size_t WS_G = 224 * MiB;
constexpr size_t WS_XN1 = WS_G, WS_GLAN = WS_G, WS_H1G = WS_G, WS_PLE = WS_G;
constexpr size_t WS_END = 256 * MiB;

constexpr int NWAVES = 8;
constexpr int RING_OFF = 0, RING_BYTES = 131072;
constexpr int MISC_OFF = RING_BYTES;
constexpr int LDS_BYTES = 147456;
constexpr int CW_BAR = 1024;

typedef GAS unsigned gu32;
#define RLX_AGENT __ATOMIC_RELAXED, __HIP_MEMORY_SCOPE_AGENT
#define LDS_WAIT() asm volatile("s_waitcnt lgkmcnt(0)" ::: "memory")
#define VM_WAIT() asm volatile("s_waitcnt vmcnt(0)" ::: "memory")

#define XB_TMO      128
#define XB_XCNT(j)  (256  + 64 * (j))
#define XB_XSUB(j)  (1280 + 64 * (j))
#define XB_XGEN(j)  (2304 + 64 * (j))
#define XB_TOP      3328
#define XB_TOPGEN   3392
#define XCD_BAR_WORDS 3456
#define XB_SPIN_CAP (1u << 22)
__device__ __forceinline__ unsigned xb_ld(unsigned* p)              { return __hip_atomic_load(p, __ATOMIC_RELAXED, __HIP_MEMORY_SCOPE_AGENT); }
__device__ __forceinline__ unsigned xb_add(unsigned* p, unsigned v) { return __hip_atomic_fetch_add(p, v, __ATOMIC_RELAXED, __HIP_MEMORY_SCOPE_AGENT); }
__device__ __forceinline__ unsigned xb_xcc_id() { return (unsigned)__builtin_amdgcn_s_getreg((3 << 11) | 20) & 0xFu; }
#define XB_SPIN(cond, bar) do { unsigned _sp = 0; while (cond) { __builtin_amdgcn_s_sleep(1); \
    if ((++_sp & 255u) == 0u) { if (xb_ld(&(bar)[XB_TMO])) break; if (_sp > XB_SPIN_CAP) { atomicAdd(&(bar)[XB_TMO], 1u); break; } } } } while (0)
struct XcdBarrier { unsigned* bar; unsigned x; volatile LAS unsigned* st; };
__device__ __forceinline__ XcdBarrier xcd_barrier_post(unsigned* bar, volatile LAS unsigned* st) {
    XcdBarrier b; b.bar = bar; b.x = xb_xcc_id(); b.st = st;
    if (threadIdx.x == 0) (void)xb_add(&bar[XB_XCNT(b.x)], 1u);
    return b;
}
__device__ __forceinline__ void xcd_barrier_complete(unsigned* bar, unsigned x, unsigned& nloc, unsigned& nx) {
    const unsigned G = gridDim.x * gridDim.y * gridDim.z;
    unsigned sum, cnt, mine, sp = 0u;
    for (;;) {
        sum = 0u; cnt = 0u; mine = 0u;
#pragma unroll
        for (unsigned j = 0; j < 16; ++j) { const unsigned c = xb_ld(&bar[XB_XCNT(j)]); sum += c; cnt += (c > 0u) ? 1u : 0u; mine = (j == x) ? c : mine; }
        if (sum == G) break;
        __builtin_amdgcn_s_sleep(1);
        if ((++sp & 255u) == 0u) { if (xb_ld(&bar[XB_TMO])) break; if (sp > XB_SPIN_CAP) { atomicAdd(&bar[XB_TMO], 1u); break; } }
    }
    nloc = mine > 0u ? mine : 1u; nx = cnt > 0u ? cnt : 1u;
}
__device__ __forceinline__ void xcd_barrier(const XcdBarrier& b) {
    asm volatile("s_waitcnt vmcnt(0)" ::: "memory");
    __syncthreads();
    if (threadIdx.x == 0) {
        unsigned* bar = b.bar;
        __builtin_amdgcn_s_waitcnt(0);
        unsigned nloc = b.st[0], nx = b.st[1];
        if (nloc == 0u) { xcd_barrier_complete(bar, b.x, nloc, nx); b.st[0] = nloc; b.st[1] = nx; }
        const unsigned old = xb_add(&bar[XB_XSUB(b.x)], 1u);
        const unsigned gen = old / nloc;
        if (old + 1u == (gen + 1u) * nloc) {
            __builtin_amdgcn_fence(__ATOMIC_RELEASE, "agent");
            asm volatile("s_waitcnt vmcnt(0)" ::: "memory");
            const unsigned og = xb_add(&bar[XB_TOP], 1u);
            const unsigned tg = og / nx;
            if (og + 1u == (tg + 1u) * nx) xb_add(&bar[XB_TOPGEN], 1u);
            else XB_SPIN(xb_ld(&bar[XB_TOPGEN]) == tg, bar);
            __builtin_amdgcn_fence(__ATOMIC_ACQUIRE, "agent");
            xb_add(&bar[XB_XGEN(b.x)], 1u);
            asm volatile("s_waitcnt vmcnt(0)" ::: "memory");
        } else {
            XB_SPIN(xb_ld(&bar[XB_XGEN(b.x)]) == gen, bar);
            __builtin_amdgcn_fence(__ATOMIC_ACQUIRE, "agent");
            asm volatile("s_waitcnt vmcnt(0)" ::: "memory");
        }
    }
    __syncthreads();
}

struct Frame {
    LAS unsigned char* lds;
    int tid, lane, wave, vcu, G, dry;
    const float* const* in; float* out; unsigned char* ws;
};
__device__ __forceinline__ int lane_id() { int l; asm volatile("v_mbcnt_lo_u32_b32 %0, -1, 0\n\tv_mbcnt_hi_u32_b32 %0, -1, %0" : "=v"(l)); return l; }
#define WSP(T, off) ((T*)(F.ws + (off)))
__device__ __forceinline__ float wave_sum(float v) {
#pragma unroll
    for (int o = 1; o < 64; o <<= 1) v += __shfl_xor(v, o);
    return v;
}
template <class RowMap>
__device__ __forceinline__ void p0_transpose_item(const float* W, int K, int N, bf16_t* WT, RowMap rm, LAS float* scr, int item, int lane) {
    const int nblk = (N + 31) / 32, kb = item / nblk, nb = item % nblk, k0 = 64 * kb, n0 = 32 * nb;
    const int nl = n0 + (lane & 31);
#pragma unroll 8
    for (int i = 0; i < 32; ++i) { const int kk = 2 * i + (lane >> 5); scr[kk * 33 + (lane & 31)] = (nl < N) ? W[(size_t)(k0 + kk) * N + nl] : 0.f; }
    LDS_WAIT(); asm volatile("" ::: "memory");
    const int c = lane & 7;
#pragma unroll
    for (int j = 0; j < 4; ++j) { const int n = (lane >> 3) + 8 * j; const LAS float* s = scr + (8 * c) * 33 + n;
        u32x4 o; o.x = cvtpk(s[0 * 33], s[1 * 33]); o.y = cvtpk(s[2 * 33], s[3 * 33]); o.z = cvtpk(s[4 * 33], s[5 * 33]); o.w = cvtpk(s[6 * 33], s[7 * 33]);
        if (n0 + n < N) *(u32x4*)(WT + (size_t)rm(n0 + n) * K + k0 + 8 * c) = o; }
    LDS_WAIT(); asm volatile("" ::: "memory");
}
struct RmId { __device__ __forceinline__ int operator()(int n) const { return n; } };
struct RmWin { __device__ __forceinline__ int operator()(int n) const { return n < 3072 ? n : (n < 3088 ? 8192 + (n - 3072) : n - 16); } };

__device__ __forceinline__ void cvt_copy(Frame& F, const float* src, bf16_t* dst, size_t n) {
    const size_t nth = (size_t)F.G * 512, n8 = n / 8;
    for (size_t i = (size_t)F.vcu * 512 + F.tid; i < n8; i += nth) {
        const f32x4 a = *(const f32x4*)(src + i * 8), b = *(const f32x4*)(src + i * 8 + 4);
        u32x4 o; o.x = cvtpk(a[0], a[1]); o.y = cvtpk(a[2], a[3]); o.z = cvtpk(b[0], b[1]); o.w = cvtpk(b[2], b[3]);
        *(u32x4*)(dst + i * 8) = o; }
}
__device__ __forceinline__ void rms_row_to_bf16(const float* xrow, const float* g, bf16_t* orow, int lane) {
    f32x4 v[4]; float s = 0.f;
#pragma unroll
    for (int j = 0; j < 4; ++j) { v[j] = *((const f32x4*)xrow + lane + 64 * j); s += (v[j][0] * v[j][0] + v[j][1] * v[j][1]) + (v[j][2] * v[j][2] + v[j][3] * v[j][3]); }
    const float rstd = __builtin_amdgcn_rsqf(wave_sum(s) * (1.f / 1024.f) + EPS);
#pragma unroll
    for (int j = 0; j < 4; ++j) { const f32x4 gv = *((const f32x4*)g + lane + 64 * j); const f32x4 o = v[j] * rstd * gv;
        u32x2 w; w.x = cvtpk(o[0], o[1]); w.y = cvtpk(o[2], o[3]); *((u32x2*)orow + lane + 64 * j) = w; }
}
__device__ __forceinline__ void phase_prologue(Frame& F) {
    LAS float* scr = (LAS float*)(F.lds + RING_OFF + F.wave * 16384);
    const int gw = F.vcu * NWAVES + F.wave, NGW = F.G * NWAVES;
    constexpr int I_IN = 16 * 257, I_SQ = 16 * 32, I_PQ = 16 * 64, I_PLE = 4 * 32;
    constexpr int NITEMS = I_IN + 4 * I_SQ + I_PQ + I_PLE;
    for (int it = gw; it < NITEMS; it += NGW) {
        int r = it;
        if (r < I_IN) { p0_transpose_item(F.in[3], 1024, 8208, WSP(bf16_t, WS_WIN), RmWin(), scr, r, F.lane); continue; } r -= I_IN;
        if (r < I_SQ) { p0_transpose_item(F.in[7], 1024, 1024, WSP(bf16_t, WS_WGA), RmId(), scr, r, F.lane); continue; } r -= I_SQ;
        if (r < I_SQ) { p0_transpose_item(F.in[8], 1024, 1024, WSP(bf16_t, WS_WSB), RmId(), scr, r, F.lane); continue; } r -= I_SQ;
        if (r < I_SQ) { p0_transpose_item(F.in[9], 1024, 1024, WSP(bf16_t, WS_WO), RmId(), scr, r, F.lane); continue; } r -= I_SQ;
        if (r < I_SQ) { p0_transpose_item(F.in[17], 1024, 1024, WSP(bf16_t, WS_WPG), RmId(), scr, r, F.lane); continue; } r -= I_SQ;
        if (r < I_PQ) { p0_transpose_item(F.in[11], 1024, 2048, WSP(bf16_t, WS_WPQ), RmId(), scr, r, F.lane); continue; } r -= I_PQ;
        p0_transpose_item(F.in[18], 256, 1024, WSP(bf16_t, WS_WPLE), RmId(), scr, r, F.lane);
    }
    { const float* k1 = F.in[12]; const float* k2 = F.in[13]; bf16_t* KD = WSP(bf16_t, WS_KD);
      for (int i = F.vcu * 512 + F.tid; i < 8 * 256 * 32; i += F.G * 512) { const int h = i >> 13, n = (i >> 5) & 255, kc = (i & 31) * 8;
          u32x4 o = (u32x4){0u, 0u, 0u, 0u}; const float* s = nullptr;
          if (n < 128 && kc < 128) s = k1 + ((size_t)(h * 128 + n)) * 128 + kc;
          if (n >= 128 && kc >= 128) s = k2 + ((size_t)(h * 128 + n - 128)) * 128 + (kc - 128);
          if (s) { const f32x4 a = *(const f32x4*)s, b = *(const f32x4*)(s + 4); o.x = cvtpk(a[0], a[1]); o.y = cvtpk(a[2], a[3]); o.z = cvtpk(b[0], b[1]); o.w = cvtpk(b[2], b[3]); }
          *(u32x4*)(KD + (size_t)i * 8) = o; } }
    for (int m = gw; m < T_TOK; m += NGW) rms_row_to_bf16(F.in[0] + (size_t)m * 1024, F.in[2], WSP(bf16_t, WS_XN1) + (size_t)m * 1024, F.lane);
}

__device__ __forceinline__ void phase_gla_prep(Frame& F) {
    LAS float* alo = (LAS float*)(F.lds + RING_OFF);
    const bf16_t* XN1 = WSP(bf16_t, WS_XN1); const bf16_t* WGAT = WSP(bf16_t, WS_WIN) + (size_t)8192 * 1024;
    bf16_t* GK = WSP(bf16_t, WS_GK); bf16_t* GV = WSP(bf16_t, WS_GV); float* GLAG = WSP(float, WS_GLAG);
    const float* w_up = F.in[4]; const float* b_a = F.in[5];
    const int tid = F.tid, lane = F.lane, w = F.wave;
    for (int u = F.vcu; u < 256; u += F.G) {
        const size_t r0 = (size_t)u * 64;
        __syncthreads();
        if (w < 4) {
            f32x4 acc = (f32x4){0.f, 0.f, 0.f, 0.f};
            const bf16_t* ap = XN1 + (r0 + 16 * w + (lane & 15)) * 1024 + 8 * (lane >> 4);
            const bf16_t* bp = WGAT + (size_t)(lane & 15) * 1024 + 8 * (lane >> 4);
#pragma unroll 8
            for (int s = 0; s < 32; ++s) { const bf16x8 a = *(const bf16x8*)(ap + 32 * s), b = *(const bf16x8*)(bp + 32 * s); acc = __builtin_amdgcn_mfma_f32_16x16x32_bf16(a, b, acc, 0, 0, 0); }
#pragma unroll
            for (int r = 0; r < 4; ++r) alo[(16 * w + 4 * (lane >> 4) + r) * 16 + (lane & 15)] = acc[r];
        }
        const int kk = tid;
        float kv[64];
#pragma unroll
        for (int i = 0; i < 64; ++i) kv[i] = bf1(GK[(r0 + i) * 512 + kk]);
        float wv[16];
#pragma unroll
        for (int r = 0; r < 16; ++r) wv[r] = w_up[r * 512 + kk];
        const float bias = b_a[kk];
        __syncthreads();
        float suffix = 0.f;
        bf16_t* kdt = GK + r0 * 512 + (size_t)kk * 64;
#pragma unroll
        for (int i8 = 7; i8 >= 0; --i8) {
            float o[8];
#pragma unroll
            for (int j = 7; j >= 0; --j) { const int i = i8 * 8 + j;
                const f32x4 a0 = *(const LAS f32x4*)(alo + i * 16), a1 = *(const LAS f32x4*)(alo + i * 16 + 4), a2 = *(const LAS f32x4*)(alo + i * 16 + 8), a3 = *(const LAS f32x4*)(alo + i * 16 + 12);
                float x = bias;
                x += a0[0] * wv[0] + a0[1] * wv[1] + a0[2] * wv[2] + a0[3] * wv[3];
                x += a1[0] * wv[4] + a1[1] * wv[5] + a1[2] * wv[6] + a1[3] * wv[7];
                x += a2[0] * wv[8] + a2[1] * wv[9] + a2[2] * wv[10] + a2[3] * wv[11];
                x += a3[0] * wv[12] + a3[1] * wv[13] + a3[2] * wv[14] + a3[3] * wv[15];
                const float la = (fminf(x, 0.f) - log1pf(__expf(-fabsf(x)))) * (1.0f / 16.0f);
                o[j] = kv[i] * __expf(suffix);
                suffix += la; }
            u32x4 pk; pk.x = cvtpk(o[0], o[1]); pk.y = cvtpk(o[2], o[3]); pk.z = cvtpk(o[4], o[5]); pk.w = cvtpk(o[6], o[7]);
            if (!F.dry) *(u32x4*)(kdt + i8 * 8) = pk; }
        GLAG[(size_t)u * 512 + kk] = __expf(suffix);
        unsigned vv[64];
#pragma unroll
        for (int i = 0; i < 64; ++i) vv[i] = *(const unsigned*)(GV + (r0 + i) * 1024 + 2 * tid);
        __syncthreads();
        bf16_t* vt0 = GV + r0 * 1024 + (size_t)(2 * tid) * 64;
#pragma unroll
        for (int i8 = 0; i8 < 8; ++i8) { u32x4 lo, hi;
            lo.x = (vv[i8 * 8 + 0] & 0xffffu) | (vv[i8 * 8 + 1] << 16); hi.x = (vv[i8 * 8 + 0] >> 16) | (vv[i8 * 8 + 1] & 0xffff0000u);
            lo.y = (vv[i8 * 8 + 2] & 0xffffu) | (vv[i8 * 8 + 3] << 16); hi.y = (vv[i8 * 8 + 2] >> 16) | (vv[i8 * 8 + 3] & 0xffff0000u);
            lo.z = (vv[i8 * 8 + 4] & 0xffffu) | (vv[i8 * 8 + 5] << 16); hi.z = (vv[i8 * 8 + 4] >> 16) | (vv[i8 * 8 + 5] & 0xffff0000u);
            lo.w = (vv[i8 * 8 + 6] & 0xffffu) | (vv[i8 * 8 + 7] << 16); hi.w = (vv[i8 * 8 + 6] >> 16) | (vv[i8 * 8 + 7] & 0xffff0000u);
            if (!F.dry) { *(u32x4*)(vt0 + i8 * 8) = lo; *(u32x4*)(vt0 + 64 + i8 * 8) = hi; } }
    }
}

constexpr int GL_KD = 0, GL_Q = 32768, GL_G = 65536, GL_RED = 65536 + 1024;
__device__ __forceinline__ int gl_kd_off(int row, int chunk) { return row * 128 + ((chunk ^ ((row >> 1) & 7)) << 4); }
__device__ __forceinline__ int gl_q_off(int row, int chunk16) { return row * 256 + ((chunk16 ^ (row & 15)) << 4); }

struct GlaStage { u32x4 kd[2]; u32x4 q[2]; bf16x8 vt[4]; float g; };
__device__ __forceinline__ void gla_prefetch_vt(Frame& F, GlaStage& st, int b, int h, int c) {
    const int u = b * 64 + c; const size_t r0 = (size_t)u * 64; const int w = F.wave, lq = F.lane & 31, hh = F.lane >> 5;
    const bf16_t* vt = WSP(bf16_t, WS_GV) + r0 * 1024 + (size_t)(h * 256 + 32 * w + lq) * 64;
#pragma unroll
    for (int ts = 0; ts < 4; ++ts) st.vt[ts] = *(const bf16x8*)(vt + 16 * ts + 8 * hh);
}
template <bool WITH_Q>
__device__ __forceinline__ void gla_prefetch(Frame& F, GlaStage& st, int b, int h, int c) {
    const int u = b * 64 + c; const size_t r0 = (size_t)u * 64; const int tid = F.tid;
    const bf16_t* kd = WSP(bf16_t, WS_GK) + r0 * 512 + (size_t)h * 8192;
#pragma unroll
    for (int j = 0; j < 2; ++j) { const int pi = tid + 512 * j; st.kd[j] = *(const u32x4*)(kd + (pi >> 3) * 64 + (pi & 7) * 8); }
    if (WITH_Q) { const bf16_t* gq = WSP(bf16_t, WS_GQ) + r0 * 512 + h * 128;
#pragma unroll
        for (int j = 0; j < 2; ++j) { const int pi = tid + 512 * j; st.q[j] = *(const u32x4*)(gq + (size_t)(pi >> 4) * 512 + (pi & 15) * 8); } }
    st.g = (tid < 128) ? WSP(float, WS_GLAG)[((size_t)u * 4 + h) * 128 + tid] : 1.f;
}
template <bool WITH_Q>
__device__ __forceinline__ void gla_stage_write(Frame& F, const GlaStage& st, int buf) {
    LAS unsigned char* lds = F.lds + RING_OFF; const int tid = F.tid;
#pragma unroll
    for (int j = 0; j < 2; ++j) { const int pi = tid + 512 * j; *(LAS u32x4*)(lds + GL_KD + buf * 16384 + gl_kd_off(pi >> 3, pi & 7)) = st.kd[j]; }
    if (WITH_Q) {
#pragma unroll
        for (int j = 0; j < 2; ++j) { const int pi = tid + 512 * j; *(LAS u32x4*)(lds + GL_Q + buf * 16384 + gl_q_off(pi >> 4, pi & 15)) = st.q[j]; } }
    if (tid < 128) *(LAS float*)(lds + GL_G + buf * 512 + tid * 4) = st.g;
}
__device__ __forceinline__ void gla_update(Frame& F, f32x16 (&S)[4], const bf16x8 (&vt)[4], int buf) {
    const LAS unsigned char* lds = F.lds + RING_OFF; const int lq = F.lane & 31, hh = F.lane >> 5;
    const LAS float* G = (const LAS float*)(lds + GL_G + buf * 512);
#pragma unroll
    for (int kt = 0; kt < 4; ++kt)
#pragma unroll
        for (int g4 = 0; g4 < 4; ++g4) { const f32x4 g = *(const LAS f32x4*)(G + 32 * kt + 8 * g4 + 4 * hh);
#pragma unroll
            for (int j = 0; j < 4; ++j) S[kt][4 * g4 + j] *= g[j]; }
#pragma unroll
    for (int ts = 0; ts < 4; ++ts)
#pragma unroll
        for (int kt = 0; kt < 4; ++kt) { const bf16x8 a = *(const LAS bf16x8*)(lds + GL_KD + buf * 16384 + gl_kd_off(32 * kt + lq, 2 * ts + hh));
            S[kt] = __builtin_amdgcn_mfma_f32_32x32x16_bf16(a, vt[ts], S[kt], 0, 0, 0); if (kt == 3 && (ts & 1)) __builtin_amdgcn_sched_barrier(0); }
}
constexpr size_t SEND_WAVE_FLOATS = 4 * 4 * 64 * 4;
__device__ __forceinline__ void gla_stage1(Frame& F, int unit) {
    const int bh = unit >> 3, seg = unit & 7, b = bh >> 2, h = bh & 3, w = F.wave, l = F.lane;
    f32x16 S[4];
#pragma unroll
    for (int kt = 0; kt < 4; ++kt)
#pragma unroll
        for (int r = 0; r < 16; ++r) S[kt][r] = 0.f;
    float pend = 1.f;
    GlaStage st; gla_prefetch<false>(F, st, b, h, seg * 8); gla_prefetch_vt(F, st, b, h, seg * 8);
    for (int ci = 0; ci < 8; ++ci) {
        gla_stage_write<false>(F, st, ci & 1); pend *= st.g;
        __syncthreads();
        if (ci < 7) gla_prefetch<false>(F, st, b, h, seg * 8 + ci + 1);
        gla_update(F, S, st.vt, ci & 1);
        if (ci < 7) gla_prefetch_vt(F, st, b, h, seg * 8 + ci + 1);
    }
    float* se = WSP(float, WS_SEND) + ((size_t)unit * 8 + w) * SEND_WAVE_FLOATS;
#pragma unroll
    for (int kt = 0; kt < 4; ++kt)
#pragma unroll
        for (int g4 = 0; g4 < 4; ++g4) *(f32x4*)(se + ((kt * 4 + g4) * 64 + l) * 4) = (f32x4){S[kt][4 * g4], S[kt][4 * g4 + 1], S[kt][4 * g4 + 2], S[kt][4 * g4 + 3]};
    if (F.tid < 128) WSP(float, WS_PEND)[unit * 128 + F.tid] = pend;
    __syncthreads();
}
__device__ __forceinline__ void gla_stage3(Frame& F, int unit) {
    const int bh = unit >> 3, seg = unit & 7, b = bh >> 2, h = bh & 3, w = F.wave, l = F.lane, lq = l & 31, hh = l >> 5;
    LAS unsigned char* lds = F.lds + RING_OFF;
    const bf16_t* GR = WSP(bf16_t, WS_GR); bf16_t* GLAN = WSP(bf16_t, WS_GLAN); const float* g_o = F.in[6];
    f32x16 S[4];
#pragma unroll
    for (int kt = 0; kt < 4; ++kt)
#pragma unroll
        for (int r = 0; r < 16; ++r) S[kt][r] = 0.f;
    GlaStage st; gla_prefetch<true>(F, st, b, h, seg * 8); gla_prefetch_vt(F, st, b, h, seg * 8);
    for (int sp = 0; sp < seg; ++sp) {
        const int un = bh * 8 + sp; const float* se = WSP(float, WS_SEND) + ((size_t)un * 8 + w) * SEND_WAVE_FLOATS; const float* pe = WSP(float, WS_PEND) + un * 128;
#pragma unroll
        for (int kt = 0; kt < 4; ++kt)
#pragma unroll
            for (int g4 = 0; g4 < 4; ++g4) { const f32x4 p = *(const f32x4*)(pe + 32 * kt + 8 * g4 + 4 * hh); const f32x4 s = *(const f32x4*)(se + ((kt * 4 + g4) * 64 + l) * 4);
#pragma unroll
                for (int j = 0; j < 4; ++j) S[kt][4 * g4 + j] = S[kt][4 * g4 + j] * p[j] + s[j]; }
    }
    for (int ci = 0; ci < 8; ++ci) {
        const int c = seg * 8 + ci; const size_t r0 = (size_t)(b * 64 + c) * 64; const int buf = ci & 1;
        gla_stage_write<true>(F, st, buf);
        __syncthreads();
        if (ci < 7) gla_prefetch<true>(F, st, b, h, c + 1);
        gla_update(F, S, st.vt, buf);
        f32x16 oT[2];
#pragma unroll
        for (int tt = 0; tt < 2; ++tt) {
#pragma unroll
            for (int r = 0; r < 16; ++r) oT[tt][r] = 0.f;
            const int t = 32 * tt + lq;
#pragma unroll
            for (int kt = 0; kt < 4; ++kt)
#pragma unroll
                for (int s = 0; s < 2; ++s) {
                    u32x4 aw; aw.x = cvtpk(S[kt][8 * s + 0], S[kt][8 * s + 1]); aw.y = cvtpk(S[kt][8 * s + 2], S[kt][8 * s + 3]); aw.z = cvtpk(S[kt][8 * s + 4], S[kt][8 * s + 5]); aw.w = cvtpk(S[kt][8 * s + 6], S[kt][8 * s + 7]);
                    const u32x2 qlo = *(const LAS u32x2*)(lds + GL_Q + buf * 16384 + gl_q_off(t, 4 * kt + 2 * s) + 8 * hh), qhi = *(const LAS u32x2*)(lds + GL_Q + buf * 16384 + gl_q_off(t, 4 * kt + 2 * s + 1) + 8 * hh);
                    const u32x4 bw = (u32x4){qlo.x, qlo.y, qhi.x, qhi.y};
                    oT[tt] = __builtin_amdgcn_mfma_f32_32x32x16_bf16(__builtin_bit_cast(bf16x8, aw), __builtin_bit_cast(bf16x8, bw), oT[tt], 0, 0, 0);
                    if (s == 1 && (kt & 1)) __builtin_amdgcn_sched_barrier(0); }
        }
        LAS float* redc = (LAS float*)(lds + GL_RED) + buf * 512;
#pragma unroll
        for (int tt = 0; tt < 2; ++tt) { float s = 0.f;
#pragma unroll
            for (int r = 0; r < 16; ++r) s += oT[tt][r] * oT[tt][r];
            s += __shfl_xor(s, 32);
            if (hh == 0) redc[w * 64 + 32 * tt + lq] = s; }
        if (ci < 7) gla_prefetch_vt(F, st, b, h, c + 1);
        u32x2 sr[2][4];
#pragma unroll
        for (int tt = 0; tt < 2; ++tt)
#pragma unroll
            for (int g4 = 0; g4 < 4; ++g4) sr[tt][g4] = *(const u32x2*)(GR + (r0 + 32 * tt + lq) * 1024 + h * 256 + 32 * w + 8 * g4 + 4 * hh);
        __syncthreads();
#pragma unroll
        for (int tt = 0; tt < 2; ++tt) { float tot = 0.f;
#pragma unroll
            for (int ww = 0; ww < 8; ++ww) tot += redc[ww * 64 + 32 * tt + lq];
            const float rstd = __builtin_amdgcn_rsqf(tot * (1.0f / 256.0f) + EPS);
            const size_t row = r0 + 32 * tt + lq;
#pragma unroll
            for (int g4 = 0; g4 < 4; ++g4) { const int v0 = h * 256 + 32 * w + 8 * g4 + 4 * hh;
                const f32x4 go = *(const f32x4*)(g_o + v0);
                const float o0 = oT[tt][4 * g4 + 0] * rstd * go[0] * bf_lo(sr[tt][g4].x), o1 = oT[tt][4 * g4 + 1] * rstd * go[1] * bf_hi(sr[tt][g4].x);
                const float o2 = oT[tt][4 * g4 + 2] * rstd * go[2] * bf_lo(sr[tt][g4].y), o3 = oT[tt][4 * g4 + 3] * rstd * go[3] * bf_hi(sr[tt][g4].y);
                u32x2 wv; wv.x = cvtpk(o0, o1); wv.y = cvtpk(o2, o3); *(u32x2*)(GLAN + row * 1024 + v0) = wv; } }
    }
    __syncthreads();
}

constexpr int SB_TILE = 16384, SB_FLAG = 7 * SB_TILE;
typedef short v4i16_t __attribute__((ext_vector_type(4)));
__device__ __forceinline__ s16x4 vtr(const LAS unsigned char* p) { return __builtin_bit_cast(s16x4, __builtin_amdgcn_ds_read_tr16_b64_v4i16((LAS v4i16_t*)p)); }
__device__ __forceinline__ float partner32(float x, int hh) { auto rr = __builtin_amdgcn_permlane32_swap(__float_as_uint(x), __float_as_uint(x), false, false); return __uint_as_float(hh ? rr[0] : rr[1]); }
__device__ __forceinline__ int sbk_off(int key, int chunk) { return key * 128 + ((chunk ^ ((key >> 1) & 7)) << 4); }
__device__ __forceinline__ int sbv_off(int key, int chunk) { return 8192 + key * 128 + ((chunk ^ (((key >> 1) & 1) << 2)) << 4); }

__device__ __forceinline__ void sb_tile(const LAS unsigned char* tile, int kt, int q0, int qabs, int l, const bf16x8 (&qf)[4], f32x16& o0, f32x16& o1, float& carry) {
    const int lq = l & 31, hh = l >> 5;
    f32x16 p0, p1;
#pragma unroll
    for (int r = 0; r < 16; ++r) { p0[r] = 0.f; p1[r] = 0.f; }
#pragma unroll
    for (int s = 0; s < 4; ++s) { const bf16x8 a0 = *(const LAS bf16x8*)(tile + sbk_off(lq, 2 * s + hh)), a1 = *(const LAS bf16x8*)(tile + sbk_off(32 + lq, 2 * s + hh));
        p0 = __builtin_amdgcn_mfma_f32_32x32x16_bf16(a0, qf[s], p0, 0, 0, 0); p1 = __builtin_amdgcn_mfma_f32_32x32x16_bf16(a1, qf[s], p1, 0, 0, 0); }
    const bool diag = (64 * kt + 63 >= q0);
    float Lh[2][16];
#pragma unroll
    for (int half = 0; half < 2; ++half)
#pragma unroll
        for (int r = 0; r < 16; ++r) { const float z = half ? p1[r] : p0[r];
            float L = fmaxf(z, 0.f) + __builtin_amdgcn_logf(1.0f + __builtin_amdgcn_exp2f(-fabsf(z)));
            if (diag) { const int key = 64 * kt + 32 * half + (r & 3) + 8 * (r >> 2) + 4 * hh; if (key >= qabs) L = 0.f; }
            Lh[half][r] = L; }
    float tot[8];
#pragma unroll
    for (int half = 0; half < 2; ++half)
#pragma unroll
        for (int g4 = 0; g4 < 4; ++g4) { float* Lg = &Lh[half][4 * g4]; Lg[2] += Lg[3]; Lg[1] += Lg[2]; Lg[0] += Lg[1]; tot[4 * half + g4] = Lg[0]; }
    float E[8]; float run = carry;
#pragma unroll
    for (int m = 7; m >= 0; --m) { const float tp = partner32(tot[m], hh); E[m] = run + (hh ? 0.f : tp); run += tot[m] + tp; }
    carry = run;
    u32x4 pw[2][2];
#pragma unroll
    for (int half = 0; half < 2; ++half)
#pragma unroll
        for (int s = 0; s < 2; ++s) { float wv[8];
#pragma unroll
            for (int j = 0; j < 8; ++j) { const int r = 8 * s + j; const float z = half ? p1[r] : p0[r];
                float wgt = __builtin_amdgcn_exp2f(z - (E[4 * half + (r >> 2)] + Lh[half][r]));
                if (diag) { const int key = 64 * kt + 32 * half + (r & 3) + 8 * (r >> 2) + 4 * hh; if (key >= qabs) wgt = 0.f; }
                wv[j] = wgt; }
            pw[half][s] = (u32x4){cvtpk(wv[0], wv[1]), cvtpk(wv[2], wv[3]), cvtpk(wv[4], wv[5]), cvtpk(wv[6], wv[7])}; }
    const int g1 = (l >> 4) & 1, i = l & 15;
#pragma unroll
    for (int half = 0; half < 2; ++half)
#pragma unroll
        for (int s = 0; s < 2; ++s) { const bf16x8 pb = __builtin_bit_cast(bf16x8, pw[half][s]);
            const int k0 = 32 * half + 16 * s + 4 * hh + (i >> 2), k1 = k0 + 8;
#pragma unroll
            for (int dt = 0; dt < 2; ++dt) { const int ch = 4 * dt + 2 * g1 + ((i & 3) >> 1);
                const s16x4 lo = vtr(tile + sbv_off(k0, ch) + 8 * (i & 1)), hi = vtr(tile + sbv_off(k1, ch) + 8 * (i & 1));
                const bf16x8 a = (bf16x8){lo[0], lo[1], lo[2], lo[3], hi[0], hi[1], hi[2], hi[3]};
                if (dt == 0) o0 = __builtin_amdgcn_mfma_f32_32x32x16_bf16(a, pb, o0, 0, 0, 0); else o1 = __builtin_amdgcn_mfma_f32_32x32x16_bf16(a, pb, o1, 0, 0, 0); } }
}

__device__ __forceinline__ void sb_attn_unit(Frame& F, int uidx) {
    const int bh = uidx >> 4, qb = uidx & 15, b = bh >> 4, h = bh & 15;
    LAS unsigned char* lds = F.lds + RING_OFF;
    volatile LAS unsigned* flags = (volatile LAS unsigned*)(lds + SB_FLAG);
    const int tid = F.tid, w = F.wave, l = F.lane, lq = l & 31, hh = l >> 5;
    bf16_t* SQ = WSP(bf16_t, WS_SQ); const bf16_t* SK = WSP(bf16_t, WS_SK); const bf16_t* SV = WSP(bf16_t, WS_SV);
    const size_t rowbase = (size_t)b * SEQ;
    const int q0 = qb * 256 + 32 * w, qabs = q0 + lq;
    const int kt_hi = qb * 4 + 3, kt_lo = (qb * 4 - 3) > 0 ? (qb * 4 - 3) : 0, nwin = kt_hi - kt_lo + 1;
    const int skey = tid >> 3, sch = tid & 7;
    const bf16_t* kg = SK + (rowbase + skey) * 1024 + h * 64 + sch * 8;
    const bf16_t* vg = SV + (rowbase + skey) * 1024 + h * 64 + sch * 8;
    __syncthreads();
    { u32x4 kr[7], vr[7];
#pragma unroll
      for (int j = 0; j < 7; ++j) if (j < nwin) { kr[j] = *(const u32x4*)(kg + (size_t)(kt_lo + j) * 64 * 1024); vr[j] = *(const u32x4*)(vg + (size_t)(kt_lo + j) * 64 * 1024); }
#pragma unroll
      for (int j = 0; j < 7; ++j) if (j < nwin) { *(LAS u32x4*)(lds + j * SB_TILE + sbk_off(skey, sch)) = kr[j]; *(LAS u32x4*)(lds + j * SB_TILE + sbv_off(skey, sch)) = vr[j]; } }
    bf16x8 qf[4];
    { const bf16_t* qrow = SQ + (rowbase + qabs) * 1024 + h * 64;
#pragma unroll
      for (int s = 0; s < 4; ++s) qf[s] = *(const bf16x8*)(qrow + 16 * s + 8 * hh); }
    f32x16 o0, o1;
#pragma unroll
    for (int r = 0; r < 16; ++r) { o0[r] = 0.f; o1[r] = 0.f; }
    float carry = 0.f;
    __syncthreads();
    bool done = false;
    for (int kt = (q0 + 30) >> 6; kt >= kt_lo; --kt) {
        sb_tile(lds + (kt - kt_lo) * SB_TILE, kt, q0, qabs, l, qf, o0, o1, carry);
        if (__all(carry > 150.0f)) { done = true; break; }
    }
    if (kt_lo == 0) done = true;
    if (l == 0) flags[w] = done ? 1u : 0u;
    __syncthreads();
    bool alld = true;
#pragma unroll
    for (int i = 0; i < 8; ++i) alld = alld && (flags[i] != 0u);
    if (!alld) {
        for (int kt = kt_lo - 1; kt >= 0; --kt) {
            const u32x4 kr = *(const u32x4*)(kg + (size_t)kt * 64 * 1024), vr = *(const u32x4*)(vg + (size_t)kt * 64 * 1024);
            __syncthreads();
            { unsigned a = 1u;
#pragma unroll
              for (int i = 0; i < 8; ++i) a &= flags[i];
              if (a) break; }
            *(LAS u32x4*)(lds + sbk_off(skey, sch)) = kr; *(LAS u32x4*)(lds + sbv_off(skey, sch)) = vr;
            __syncthreads();
            if (!done) { sb_tile(lds, kt, q0, qabs, l, qf, o0, o1, carry); if (__all(carry > 150.0f) || kt == 0) done = true; }
            if (l == 0) flags[w] = done ? 1u : 0u;
        }
    }
    if (!F.dry) { bf16_t* orow = SQ + (rowbase + qabs) * 1024 + h * 64;
#pragma unroll
      for (int g4 = 0; g4 < 4; ++g4) { u32x2 a, c2; a.x = cvtpk(o0[4 * g4], o0[4 * g4 + 1]); a.y = cvtpk(o0[4 * g4 + 2], o0[4 * g4 + 3]); c2.x = cvtpk(o1[4 * g4], o1[4 * g4 + 1]); c2.y = cvtpk(o1[4 * g4 + 2], o1[4 * g4 + 3]);
          *(u32x2*)(orow + 8 * g4 + 4 * hh) = a; *(u32x2*)(orow + 32 + 8 * g4 + 4 * hh) = c2; } }
}
__device__ __forceinline__ void phase_attn_a(Frame& F) {
    if (F.vcu < 128) { gla_stage1(F, F.vcu); sb_attn_unit(F, F.vcu); }
    else { sb_attn_unit(F, 128 + (F.vcu - 128) * 2); sb_attn_unit(F, 128 + (F.vcu - 128) * 2 + 1); }
    __syncthreads();
}
__device__ __forceinline__ void phase_attn_b(Frame& F) {
    if (F.vcu < 128) { gla_stage3(F, F.vcu); sb_attn_unit(F, 384 + F.vcu * 2); sb_attn_unit(F, 384 + F.vcu * 2 + 1); }
    else { sb_attn_unit(F, 640 + (F.vcu - 128) * 3); sb_attn_unit(F, 640 + (F.vcu - 128) * 3 + 1); sb_attn_unit(F, 640 + (F.vcu - 128) * 3 + 2); }
    __syncthreads();
}
__device__ __forceinline__ int okey(float v, int tag, int mask) { int u = __float_as_int(v); u ^= (u >> 31) & 0x7fffffff; return (u & ~mask) | tag; }
__device__ __forceinline__ float okey_val(int key, int mask) { int u = key & ~mask; u ^= (u >> 31) & 0x7fffffff; return __int_as_float(u); }
#define INS16(Lst, xin) do { int _x = (xin); _Pragma("unroll") for (int _j = 0; _j < 16; ++_j) { const int _h = max(Lst[_j], _x); _x = min(Lst[_j], _x); Lst[_j] = _h; } } while (0)

__device__ __forceinline__ void phase_peer_select(Frame& F, int hsel) {
    const float* S12 = F.out; unsigned* EXPO = WSP(unsigned, WS_EXP);
    LAS unsigned char* idxb = F.lds + RING_OFF + F.wave * 1024;
    const int l = F.lane, tl = l >> 3, hl = (l >> 1) & 3, half = l & 1;
    const int gw = F.vcu * NWAVES + F.wave, NGW = F.G * NWAVES;
    for (int bt = gw; bt < T_TOK / 8; bt += NGW) {
        const int t = bt * 8 + tl;
        const float* src = S12 + (size_t)t * 1024 + hl * 256 + half * 128;
        int L[16];
#pragma unroll
        for (int j = 0; j < 16; ++j) L[j] = INT_MIN;
#pragma unroll 2
        for (int i = 0; i < 128; i += 4) { const f32x4 v = *(const f32x4*)(src + i);
#pragma unroll
            for (int e = 0; e < 4; ++e) INS16(L, okey(v[e], 127 - (i + e), 127)); }
        int P[16];
#pragma unroll
        for (int j = 0; j < 16; ++j) P[j] = __shfl_xor(L[j], 1);
        float X[16], Y[16];
#pragma unroll
        for (int j = 0; j < 16; ++j) { X[j] = okey_val(L[j], 127); Y[j] = okey_val(P[j], 127); }
        { u32x4 pk;
          pk.x = (unsigned)(127 - (L[0] & 127)) | ((unsigned)(127 - (L[1] & 127)) << 8) | ((unsigned)(127 - (L[2] & 127)) << 16) | ((unsigned)(127 - (L[3] & 127)) << 24);
          pk.y = (unsigned)(127 - (L[4] & 127)) | ((unsigned)(127 - (L[5] & 127)) << 8) | ((unsigned)(127 - (L[6] & 127)) << 16) | ((unsigned)(127 - (L[7] & 127)) << 24);
          pk.z = (unsigned)(127 - (L[8] & 127)) | ((unsigned)(127 - (L[9] & 127)) << 8) | ((unsigned)(127 - (L[10] & 127)) << 16) | ((unsigned)(127 - (L[11] & 127)) << 24);
          pk.w = (unsigned)(127 - (L[12] & 127)) | ((unsigned)(127 - (L[13] & 127)) << 8) | ((unsigned)(127 - (L[14] & 127)) << 16) | ((unsigned)(127 - (L[15] & 127)) << 24);
          *(LAS u32x4*)(idxb + l * 16) = pk; }
        int M[16];
#pragma unroll
        for (int j = 0; j < 16; ++j) M[j] = INT_MIN;
#define CAND(i, j) do { const float sm = X[i] + Y[j]; const int pos = half ? ((j) * 16 + (i)) : ((i) * 16 + (j)); int key = okey(sm, 255 - pos, 255); if ((i) == (j) && half) key = INT_MIN; INS16(M, key); } while (0)
        CAND(0, 0); CAND(0, 1); CAND(0, 2); CAND(0, 3); CAND(0, 4); CAND(0, 5); CAND(0, 6); CAND(0, 7); CAND(0, 8); CAND(0, 9); CAND(0, 10); CAND(0, 11); CAND(0, 12); CAND(0, 13); CAND(0, 14); CAND(0, 15);
        CAND(1, 1); CAND(1, 2); CAND(1, 3); CAND(1, 4); CAND(1, 5); CAND(1, 6); CAND(1, 7);
        CAND(2, 2); CAND(2, 3); CAND(2, 4);
        CAND(3, 3);
#undef CAND
        int TK[16];
#pragma unroll
        for (int k = 0; k < 16; ++k) TK[k] = max(M[k], __shfl_xor(M[15 - k], 1));
        float sv[16]; float mx = -INFINITY;
#pragma unroll
        for (int k = 0; k < 16; ++k) { sv[k] = okey_val(TK[k], 255); mx = fmaxf(mx, sv[k]); }
        float den = 0.f;
#pragma unroll
        for (int k = 0; k < 16; ++k) { sv[k] = __expf(sv[k] - mx); den += sv[k]; }
        const float rden = 1.0f / den;
        LDS_WAIT(); asm volatile("" ::: "memory");
        const LAS unsigned char* i1b = idxb + (l & ~1) * 16; const LAS unsigned char* i2b = idxb + (l | 1) * 16;
        unsigned* dst = EXPO + (size_t)t * 128 + (hsel * 4 + hl) * 16 + half * 8;
#pragma unroll
        for (int k = 0; k < 8; ++k) { const int pos = 255 - (TK[k] & 255); const unsigned i1 = i1b[pos >> 4], i2 = i2b[pos & 15];
            const float gate = sv[k] * rden;
            dst[k] = (__float_as_uint(gate) & ~0x3fffu) | (i1 * 128u + i2); }
        LDS_WAIT(); asm volatile("" ::: "memory");
    }
}

__device__ __forceinline__ void cvt_rows_fp8(Frame& F, const float* src, unsigned char* dst, float* rscale) {
    const int l = F.lane; const int gw = F.vcu * NWAVES + F.wave, NGW = F.G * NWAVES;
    for (int e = gw; e < 16384; e += NGW) {
        const f32x4* sp = (const f32x4*)(src + (size_t)e * 1024 + 16 * l);
        const f32x4 a = sp[0], b = sp[1], c = sp[2], d = sp[3];
        float m = fmaxf(fmaxf(fmaxf(fabsf(a[0]), fabsf(a[1])), fmaxf(fabsf(a[2]), fabsf(a[3]))), fmaxf(fmaxf(fabsf(b[0]), fabsf(b[1])), fmaxf(fabsf(b[2]), fabsf(b[3]))));
        m = fmaxf(m, fmaxf(fmaxf(fmaxf(fabsf(c[0]), fabsf(c[1])), fmaxf(fabsf(c[2]), fabsf(c[3]))), fmaxf(fmaxf(fabsf(d[0]), fabsf(d[1])), fmaxf(fabsf(d[2]), fabsf(d[3])))));
#pragma unroll
        for (int o = 1; o < 64; o <<= 1) m = fmaxf(m, __shfl_xor(m, o));
        const float t = 448.0f / fmaxf(m, 1e-30f); const float s = __uint_as_float(__float_as_uint(t) & 0x7f800000u);
        u32x4 w; int x;
        x = __builtin_amdgcn_cvt_pk_fp8_f32(a[0] * s, a[1] * s, 0, false); x = __builtin_amdgcn_cvt_pk_fp8_f32(a[2] * s, a[3] * s, x, true); w.x = (unsigned)x;
        x = __builtin_amdgcn_cvt_pk_fp8_f32(b[0] * s, b[1] * s, 0, false); x = __builtin_amdgcn_cvt_pk_fp8_f32(b[2] * s, b[3] * s, x, true); w.y = (unsigned)x;
        x = __builtin_amdgcn_cvt_pk_fp8_f32(c[0] * s, c[1] * s, 0, false); x = __builtin_amdgcn_cvt_pk_fp8_f32(c[2] * s, c[3] * s, x, true); w.z = (unsigned)x;
        x = __builtin_amdgcn_cvt_pk_fp8_f32(d[0] * s, d[1] * s, 0, false); x = __builtin_amdgcn_cvt_pk_fp8_f32(d[2] * s, d[3] * s, x, true); w.w = (unsigned)x;
        *(u32x4*)(dst + (size_t)e * 1024 + 16 * l) = w;
        if (l == 0) rscale[e] = 1.0f / s;
    }
}

__device__ __forceinline__ float gelu_tanh(float x) { const float y = 0.7978845608028654f * (x + 0.044715f * x * x * x); return x * __builtin_amdgcn_rcpf(1.0f + __expf(-2.0f * y)); }
#define FP8_UNPACK16(W, f) do { f32x2 _t; \
    _t = __builtin_amdgcn_cvt_pk_f32_fp8((int)(W).x, false); f[0] = _t[0]; f[1] = _t[1]; _t = __builtin_amdgcn_cvt_pk_f32_fp8((int)(W).x, true); f[2] = _t[0]; f[3] = _t[1]; \
    _t = __builtin_amdgcn_cvt_pk_f32_fp8((int)(W).y, false); f[4] = _t[0]; f[5] = _t[1]; _t = __builtin_amdgcn_cvt_pk_f32_fp8((int)(W).y, true); f[6] = _t[0]; f[7] = _t[1]; \
    _t = __builtin_amdgcn_cvt_pk_f32_fp8((int)(W).z, false); f[8] = _t[0]; f[9] = _t[1]; _t = __builtin_amdgcn_cvt_pk_f32_fp8((int)(W).z, true); f[10] = _t[0]; f[11] = _t[1]; \
    _t = __builtin_amdgcn_cvt_pk_f32_fp8((int)(W).w, false); f[12] = _t[0]; f[13] = _t[1]; _t = __builtin_amdgcn_cvt_pk_f32_fp8((int)(W).w, true); f[14] = _t[0]; f[15] = _t[1]; } while (0)
__device__ __forceinline__ float sum_swap32(float a, float b) { auto r = __builtin_amdgcn_permlane32_swap(__float_as_uint(a), __float_as_uint(b), false, false); return __uint_as_float(r[0]) + __uint_as_float(r[1]); }
__device__ __forceinline__ float sum_swap16(float a, float b) { auto r = __builtin_amdgcn_permlane16_swap(__float_as_uint(a), __float_as_uint(b), false, false); return __uint_as_float(r[0]) + __uint_as_float(r[1]); }
__device__ __forceinline__ void phase_peer_gather(Frame& F) {
    const unsigned char* UB = WSP(unsigned char, WS_UB8); const unsigned char* VB = WSP(unsigned char, WS_VB8); const float* RSU = WSP(float, WS_RSU); const float* RSV = WSP(float, WS_RSV);
    const unsigned* EXPO = WSP(unsigned, WS_EXP);
    const bf16_t* H1G = WSP(bf16_t, WS_H1G); bf16_t* XN3 = WSP(bf16_t, WS_XN3); const float* H1 = WSP(float, WS_H1); float* H2 = F.out; const float* SSQ1 = WSP(float, WS_SSQ1); const float* g_ple = F.in[16];
    const int l = F.lane; const int gw = F.vcu * NWAVES + F.wave, NGW = F.G * NWAVES;
    for (int t = gw; t < T_TOK; t += NGW) {
        float x[16];
        { const u32x4 xa = *(const u32x4*)(H1G + (size_t)t * 1024 + 16 * l), xb = *(const u32x4*)(H1G + (size_t)t * 1024 + 16 * l + 8);
          x[0] = bf_lo(xa.x); x[1] = bf_hi(xa.x); x[2] = bf_lo(xa.y); x[3] = bf_hi(xa.y); x[4] = bf_lo(xa.z); x[5] = bf_hi(xa.z); x[6] = bf_lo(xa.w); x[7] = bf_hi(xa.w);
          x[8] = bf_lo(xb.x); x[9] = bf_hi(xb.x); x[10] = bf_lo(xb.y); x[11] = bf_hi(xb.y); x[12] = bf_lo(xb.z); x[13] = bf_hi(xb.z); x[14] = bf_lo(xb.w); x[15] = bf_hi(xb.w); }
        float rstd1; { const f32x4* sp = (const f32x4*)(SSQ1 + (size_t)t * 16); const f32x4 st = (sp[0] + sp[1]) + (sp[2] + sp[3]); rstd1 = __builtin_amdgcn_rsqf(((st[0] + st[1]) + (st[2] + st[3])) * (1.0f / 1024.0f) + EPS); }
        const unsigned e0 = EXPO[(size_t)t * 128 + l], e1 = EXPO[(size_t)t * 128 + 64 + l];
        const float cu0 = RSU[e0 & 0x3fffu] * rstd1, cu1 = RSU[e1 & 0x3fffu] * rstd1;
        const float cv0 = RSV[e0 & 0x3fffu] * __uint_as_float(e0 & ~0x3fffu), cv1 = RSV[e1 & 0x3fffu] * __uint_as_float(e1 & ~0x3fffu);
        float acc[16];
#pragma unroll
        for (int i = 0; i < 16; ++i) acc[i] = 0.f;
#pragma unroll 1
        for (int eb = 0; eb < 128; eb += 16) {
            u32x4 uw[16], vw[16];
#pragma unroll
            for (int k = 0; k < 16; ++k) { const int e = eb + k; const unsigned ent = (e < 64) ? __builtin_amdgcn_readlane(e0, e & 63) : __builtin_amdgcn_readlane(e1, e & 63);
                const size_t ro = (size_t)(ent & 0x3fffu) * 1024 + 16 * l; uw[k] = *(const u32x4*)(UB + ro); vw[k] = *(const u32x4*)(VB + ro); }
            float p[16];
#pragma unroll
            for (int k = 0; k < 16; ++k) { float f[16]; FP8_UNPACK16(uw[k], f); float s = 0.f;
#pragma unroll
                for (int i = 0; i < 16; ++i) s += f[i] * x[i];
                p[k] = s; }
            float q8[8], q4[4], q2[2], q1;
#pragma unroll
            for (int j = 0; j < 8; ++j) q8[j] = sum_swap32(p[j], p[8 + j]);
#pragma unroll
            for (int j = 0; j < 4; ++j) q4[j] = sum_swap16(q8[j], q8[4 + j]);
            { const bool up = (l & 8) != 0;
#pragma unroll
              for (int j = 0; j < 2; ++j) { const float keep = up ? q4[2 + j] : q4[j], send = up ? q4[j] : q4[2 + j]; q2[j] = keep + __shfl_xor(send, 8); } }
            { const bool up = (l & 4) != 0; const float keep = up ? q2[1] : q2[0], send = up ? q2[0] : q2[1]; q1 = keep + __shfl_xor(send, 4); }
            q1 += __shfl_xor(q1, 2); q1 += __shfl_xor(q1, 1);
            const int ei = eb + (l >> 2);
            const float cu = (ei < 64) ? __shfl(cu0, ei & 63) : __shfl(cu1, ei & 63), cv = (ei < 64) ? __shfl(cv0, ei & 63) : __shfl(cv1, ei & 63);
            const float a = gelu_tanh(q1 * cu) * cv;
#pragma unroll
            for (int k = 0; k < 16; ++k) { const float ak = __uint_as_float(__builtin_amdgcn_readlane(__float_as_uint(a), 4 * k)); float f[16]; FP8_UNPACK16(vw[k], f);
#pragma unroll
                for (int i = 0; i < 16; ++i) acc[i] += ak * f[i]; }
        }
        const float* hrow = H1 + (size_t)t * 1024 + 16 * l; float* h2row = H2 + (size_t)t * 1024 + 16 * l; float ss = 0.f; f32x4 h[4];
#pragma unroll
        for (int q = 0; q < 4; ++q) { h[q] = *(const f32x4*)(hrow + 4 * q);
#pragma unroll
            for (int j = 0; j < 4; ++j) { h[q][j] += acc[4 * q + j]; ss += h[q][j] * h[q][j]; }
            *(f32x4*)(h2row + 4 * q) = h[q]; }
        const float rstd3 = __builtin_amdgcn_rsqf(wave_sum(ss) * (1.0f / 1024.0f) + EPS);
        u32x4 o[2];
#pragma unroll
        for (int q2 = 0; q2 < 2; ++q2) { const f32x4 g0 = *(const f32x4*)(g_ple + 16 * l + 8 * q2), g1 = *(const f32x4*)(g_ple + 16 * l + 8 * q2 + 4);
            const f32x4 a = h[2 * q2] * rstd3 * g0, c = h[2 * q2 + 1] * rstd3 * g1;
            o[q2].x = cvtpk(a[0], a[1]); o[q2].y = cvtpk(a[2], a[3]); o[q2].z = cvtpk(c[0], c[1]); o[q2].w = cvtpk(c[2], c[3]); }
        *(u32x4*)(XN3 + (size_t)t * 1024 + 16 * l) = o[0]; *(u32x4*)(XN3 + (size_t)t * 1024 + 16 * l + 8) = o[1];
    }
}

__device__ __forceinline__ void phase_final(Frame& F) {
    const float* SSQ3 = WSP(float, WS_SSQ3); const float* g = F.in[19];
    const int l = F.lane; const int gw = F.vcu * NWAVES + F.wave, NGW = F.G * NWAVES;
    for (int t = gw; t < T_TOK; t += NGW) {
        const f32x4* sp = (const f32x4*)(SSQ3 + (size_t)t * 16); const f32x4 st = (sp[0] + sp[1]) + (sp[2] + sp[3]);
        const float rstd = __builtin_amdgcn_rsqf(((st[0] + st[1]) + (st[2] + st[3])) * (1.0f / 1024.0f) + EPS);
        f32x4* row = (f32x4*)(F.out + (size_t)t * 1024);
#pragma unroll
        for (int j = 0; j < 4; ++j) { const f32x4 gv = *((const f32x4*)g + l + 64 * j); const f32x4 o = row[l + 64 * j] * rstd * gv; if (!F.dry) row[l + 64 * j] = o; }
    }
}
#ifndef MK_FUSED
#define MK_FUSED 1
#endif
constexpr int NPHASE = 15;
struct Args { const float* in[20]; float* out; unsigned char* ws; int ph_lo, ph_hi, dry, pad; };
static_assert(sizeof(Args) == 20 * 8 + 8 + 8 + 4 * 4, "Args has no padding");

__global__ void __launch_bounds__(NWAVES * 64, 2) mk_fwd(Args args) {
    extern __shared__ __attribute__((aligned(16))) unsigned char lds_raw[];
    Frame F;
    F.lds = (LAS unsigned char*)lds_raw;
    F.wave = __builtin_amdgcn_readfirstlane(threadIdx.x >> 6); F.lane = lane_id(); F.tid = F.wave * 64 + F.lane;
    F.G = gridDim.x; { const int bx = blockIdx.x; F.vcu = (F.G % 8 == 0) ? (bx % 8) * (F.G / 8) + bx / 8 : bx; }
    F.in = args.in; F.out = args.out; F.ws = args.ws; F.dry = args.dry;
    volatile LAS unsigned* MISC = (volatile LAS unsigned*)(F.lds + MISC_OFF);
    if (F.tid < 64) MISC[F.tid] = 0u;
    __syncthreads();
    const int lo = args.ph_lo, hi = args.ph_hi;
    XcdBarrier bar; bar.bar = (unsigned*)(F.ws + WS_CTL) + CW_BAR; bar.x = 0; bar.st = nullptr;
    if (hi - lo > 1) bar = xcd_barrier_post((unsigned*)(F.ws + WS_CTL) + CW_BAR, MISC + 8);
#ifndef PH_MASK
#define PH_MASK 0xFFFFFFFFu
#endif
#define IN(k) (((PH_MASK >> (k)) & 1u) && lo <= (k) && (k) < hi)
#define LAUNDER(p, T) do { unsigned _lo = (unsigned)(unsigned long long)(p), _hi = (unsigned)((unsigned long long)(p) >> 32); asm volatile("" : "+v"(_lo), "+v"(_hi)); \
        _lo = __builtin_amdgcn_readfirstlane(_lo); _hi = __builtin_amdgcn_readfirstlane(_hi); (p) = (T)(((unsigned long long)_hi << 32) | _lo); } while (0)
#define SEAM(k) do { if (IN(k) && IN((k) + 1)) xcd_barrier(bar); LAUNDER(F.ws, unsigned char*); LAUNDER(F.out, float*); F.lane = lane_id(); F.tid = F.wave * 64 + F.lane; } while (0)
    const int bx = (int)blockIdx.x;
    LAS unsigned char* ring = F.lds + RING_OFF;

    if (IN(0)) { phase_prologue(F); } SEAM(0);
    if (IN(1)) {
        pg8::Gemm g{WSP(bf16_t, WS_XN1), WSP(bf16_t, WS_WIN), T_TOK, 8192, 1024, 1024, 0}; pg8::StaticOrder S; S.init(T_TOK, 8192, F.G, bx);
        pg8::EpiProj E{WSP(bf16_t, WS_GQ), WSP(bf16_t, WS_GK), WSP(bf16_t, WS_GV), WSP(bf16_t, WS_GR), WSP(bf16_t, WS_SQ), WSP(bf16_t, WS_SK), WSP(bf16_t, WS_SV),
                       (bf16_t*)F.out, (bf16_t*)F.out + (size_t)T_TOK * 1024};
        pg8::gemm_phase<pg8::EpiProj>(ring, g, S, E, F.tid);
    } SEAM(1);
    if (IN(2)) { phase_gla_prep(F); } SEAM(2);
    if (IN(3)) { phase_attn_a(F); } SEAM(3);
    if (IN(4)) { phase_attn_b(F); } SEAM(4);
    if (IN(5)) {
        cvt_rows_fp8(F, F.in[14], WSP(unsigned char, WS_UB8), WSP(float, WS_RSU));
        cvt_rows_fp8(F, F.in[15], WSP(unsigned char, WS_VB8), WSP(float, WS_RSV));
        VM_WAIT(); __syncthreads();
        pg8::StaticOrder S; S.init(T_TOK, 1024, F.G, bx);
        { pg8::Gemm g{WSP(bf16_t, WS_GLAN), WSP(bf16_t, WS_WGA), T_TOK, 1024, 1024, 1024, 0}; pg8::EpiMix<true> E{(const bf16_t*)F.out, WSP(bf16_t, WS_MIX)};
          pg8::gemm_phase<pg8::EpiMix<true>>(ring, g, S, E, F.tid); }
        { pg8::Gemm g{WSP(bf16_t, WS_SQ), WSP(bf16_t, WS_WSB), T_TOK, 1024, 1024, 1024, 0}; pg8::EpiMix<false> E{(const bf16_t*)F.out + (size_t)T_TOK * 1024, WSP(bf16_t, WS_MIX)};
          pg8::gemm_phase<pg8::EpiMix<false>>(ring, g, S, E, F.tid); }
    } SEAM(5);
    if (IN(6)) {
        pg8::Gemm g{WSP(bf16_t, WS_MIX), WSP(bf16_t, WS_WO), T_TOK, 1024, 1024, 1024, 0}; pg8::StaticOrder S; S.init(T_TOK, 1024, F.G, bx);
        pg8::EpiH1 E{F.in[0], F.in[10], WSP(float, WS_H1), WSP(bf16_t, WS_H1G), WSP(float, WS_SSQ1)};
        pg8::gemm_phase<pg8::EpiH1>(ring, g, S, E, F.tid);
    } SEAM(6);
    if (IN(7)) {
        pg8::Gemm g{WSP(bf16_t, WS_H1G), WSP(bf16_t, WS_WPQ), T_TOK, 2048, 1024, 1024, 0}; pg8::StaticOrder S; S.init(T_TOK, 2048, F.G, bx);
        pg8::EpiQ E{WSP(float, WS_SSQ1), WSP(bf16_t, WS_Q), 2048};
        pg8::gemm_phase<pg8::EpiQ>(ring, g, S, E, F.tid);
    } SEAM(7);
#define PEER_SCORES(hs) do { if (IN(8 + 2 * (hs))) { \
            pg8::Gemm g{WSP(bf16_t, WS_Q) + (hs) * 1024, WSP(bf16_t, WS_KD) + (size_t)(hs) * 1024 * 256, T_TOK, 1024, 256, 2048, 256}; pg8::StaticOrder S; S.init(T_TOK, 1024, F.G, bx); \
            pg8::EpiF32 E{F.out, 1024}; \
            pg8::gemm_phase<pg8::EpiF32>(ring, g, S, E, F.tid); \
        } SEAM(8 + 2 * (hs)); \
        if (IN(9 + 2 * (hs))) { phase_peer_select(F, (hs)); } SEAM(9 + 2 * (hs)); } while (0)
    PEER_SCORES(0);
    PEER_SCORES(1);
#undef PEER_SCORES
    if (IN(12)) { cvt_copy(F, F.in[1], WSP(bf16_t, WS_PB), (size_t)T_TOK * 256); phase_peer_gather(F); } SEAM(12);
    if (IN(13)) {
        pg8::StaticOrder S; S.init(T_TOK, 1024, F.G, bx);
        { pg8::Gemm g{WSP(bf16_t, WS_PB), WSP(bf16_t, WS_WPLE), T_TOK, 1024, 256, 256, 0}; pg8::EpiBf E{WSP(bf16_t, WS_PLE), 1024};
          pg8::gemm_phase<pg8::EpiBf>(ring, g, S, E, F.tid); }
        { pg8::Gemm g{WSP(bf16_t, WS_XN3), WSP(bf16_t, WS_WPG), T_TOK, 1024, 1024, 1024, 0}; pg8::EpiH3 E{F.out, WSP(bf16_t, WS_PLE), F.out, WSP(float, WS_SSQ3)};
          pg8::gemm_phase<pg8::EpiH3>(ring, g, S, E, F.tid); }
    } SEAM(13);
    if (IN(14)) { phase_final(F); }
#undef IN
#undef SEAM
}

extern "C" void kernel_launch(void* const* d_in, const int* in_sizes, int n_in, void* d_out, int out_size, void* d_ws, size_t ws_size, hipStream_t stream) {
    static int grid = 0;
    if (grid == 0) {
        if (n_in != 20 || in_sizes[0] != T_TOK * 1024 || out_size != T_TOK * 1024 || ws_size < WS_END) {
            fprintf(stderr, "kernel_launch: unexpected shapes (n_in %d, in0 %d, out %d, ws %zu < %zu?); nothing launched\n", n_in, n_in > 0 ? in_sizes[0] : -1, out_size, ws_size, (size_t)WS_END); grid = -1; return; }
        int dev = 0, cus = 0, per_cu = 0;
        if (hipGetDevice(&dev) != hipSuccess || hipDeviceGetAttribute(&cus, hipDeviceAttributeMultiprocessorCount, dev) != hipSuccess) { grid = -1; return; }
        if (hipFuncSetAttribute((const void*)mk_fwd, hipFuncAttributeMaxDynamicSharedMemorySize, LDS_BYTES) != hipSuccess) { fprintf(stderr, "kernel_launch: hipFuncSetAttribute failed\n"); grid = -1; return; }
        if (hipOccupancyMaxActiveBlocksPerMultiprocessor(&per_cu, (const void*)mk_fwd, NWAVES * 64, LDS_BYTES) != hipSuccess || per_cu < 1)
            fprintf(stderr, "kernel_launch: note: occupancy query reports %d workgroups per CU\n", per_cu);
        (void)hipGetLastError();
        grid = cus;
        if (grid != 256) fprintf(stderr, "kernel_launch: note: %d CUs (kernel tuned for 256)\n", grid);
    }
    if (grid < 0) return;
    if (hipMemsetAsync((char*)d_ws + WS_CTL, 0, CTL_ZERO_BYTES, stream) != hipSuccess) { fprintf(stderr, "kernel_launch: hipMemsetAsync failed\n"); return; }
    Args a{};
    for (int i = 0; i < 20; ++i) a.in[i] = (const float*)d_in[i];
    a.out = (float*)d_out; a.ws = (unsigned char*)d_ws;
#if MK_FUSED
    a.ph_lo = 0; a.ph_hi = NPHASE;
    hipLaunchKernelGGL(mk_fwd, dim3(grid), dim3(NWAVES * 64), LDS_BYTES, stream, a);
#else
#ifndef PROBE_PHASE
#define PROBE_PHASE -1
#define PROBE_REPS 0
#endif
    for (int p = 0; p < NPHASE; ++p) { a.ph_lo = p; a.ph_hi = p + 1;
        if (p == PROBE_PHASE) { a.dry = 1; for (int r = 0; r < PROBE_REPS; ++r) hipLaunchKernelGGL(mk_fwd, dim3(grid), dim3(NWAVES * 64), LDS_BYTES, stream, a); a.dry = 0; }
        hipLaunchKernelGGL(mk_fwd, dim3(grid), dim3(NWAVES * 64), LDS_BYTES, stream, a); }
#endif
}
```

```cpp
#define MK_FUSED 1
#include <hip/hip_runtime.h>
#include <cstdio>
#include <cstdint>

#define LAS __attribute__((address_space(3)))
#define GAS __attribute__((address_space(1)))
typedef unsigned short bf16_t;
typedef short bf16x8 __attribute__((ext_vector_type(8)));
typedef short s16x4 __attribute__((ext_vector_type(4)));
typedef float f32x2 __attribute__((ext_vector_type(2)));
typedef float f32x4 __attribute__((ext_vector_type(4)));
typedef float f32x16 __attribute__((ext_vector_type(16)));
typedef unsigned u32x2 __attribute__((ext_vector_type(2)));
typedef unsigned u32x4 __attribute__((ext_vector_type(4)));
typedef __bf16 bf16x2_t __attribute__((ext_vector_type(2)));

__device__ __forceinline__ unsigned cvtpk(float lo, float hi) { f32x2 v = {lo, hi}; bf16x2_t b = __builtin_convertvector(v, bf16x2_t); return __builtin_bit_cast(unsigned, b); }
__device__ __forceinline__ float bf_lo(unsigned u) { return __uint_as_float(u << 16); }
__device__ __forceinline__ float bf_hi(unsigned u) { return __uint_as_float(u & 0xffff0000u); }
__device__ __forceinline__ float bf1(bf16_t u) { return __uint_as_float(((unsigned)u) << 16); }
__device__ __forceinline__ float fast_sigmoid(float x) { return __builtin_amdgcn_rcpf(1.0f + __expf(-x)); }

namespace pg8 {
constexpr int BM = 256, BK = 64, HALF = 128, HTB = HALF * BK * 2  , STAGE_BYTES = 8 * HTB, NXCD = 8, WGM = 8;

__host__ __device__ __forceinline__ int lds_byte(int r, int c) { const int st = (r >> 4) * 2 + (c >> 5), rr = r & 15, cc = c & 31, ob = rr * 64 + cc * 2; return st * 1024 + (ob ^ (((ob >> 9) & 1) << 5)); }
__host__ __device__ __forceinline__ void stage_rc(int b, int& R, int& C) { const int st = b / 1024, sb = b % 1024, swz = sb ^ (((sb >> 9) & 1) << 5); R = (st >> 1) * 16 + swz / 64; C = (st & 1) * 32 + (swz % 64) / 2; }
__host__ __device__ __forceinline__ int perm32(int rho) { const int n = rho >> 4, i = rho & 15; return 8 * (i >> 2) + 4 * n + (i & 3); }

struct Unit { int pm, pn; };
struct Gemm { const bf16_t* A; const bf16_t* Bt; int M, N, K, lda, a_pn_cols; };

struct StaticOrder {
    int nM, nN, nwg, G, c;
    __host__ __device__ void init(int M, int N, int G_, int c_) { nM = M / BM; nN = N / BM; nwg = nM * nN; G = G_; c = c_; }
    __host__ __device__ bool next(int i, Unit& u) const {
        const long L = (long)i * G + c; if (L >= nwg) return false;
        int wgid = (int)L; { const int q = nwg / NXCD, r = nwg % NXCD, xcd = wgid % NXCD, off = wgid / NXCD; wgid = (xcd < r ? xcd * (q + 1) : r * (q + 1) + (xcd - r) * q) + off; }
        const int nig = WGM * nN, gid = wgid / nig, fm = gid * WGM, gsz = (nM - fm) < WGM ? (nM - fm) : WGM;
        u.pm = fm + ((wgid % nig) % gsz); u.pn = (wgid % nig) / gsz; return true;
    }
};

template <class Epi, bool ALIGN_EPI = true, bool SP2 = true>
__device__ __forceinline__ void gemm_phase(LAS unsigned char* lds, const Gemm g, const StaticOrder& S, const Epi& E, int tid) {
    const int wid = __builtin_amdgcn_readfirstlane(tid >> 6), lane = tid & 63, wr = wid >> 2, wc = wid & 3, fr = lane & 15, fq = lane >> 4;
    const int K = g.K, nt = K / BK, lda = g.lda;
    unsigned voffA[2], voffB[2];
#pragma unroll
    for (int i = 0; i < 2; ++i) { int R, C; stage_rc(tid * 16 + i * 8192, R, C); const int Rb = Epi::PERM ? ((R & ~31) + perm32(R & 31)) : R;
        voffA[i] = (unsigned)(R * lda + C) * 2u; voffB[i] = (unsigned)(Rb * K + C) * 2u; }
    const size_t kstep = (size_t)(BK * 2);
    const size_t hA = (size_t)HALF * lda * 2, hB = (size_t)HALF * K * 2;
    const size_t tA = 2 * hA, tB = 2 * hB;
    const size_t pnA = (size_t)g.a_pn_cols * 2;
    const unsigned ldsw = (unsigned)wid * 1024u;
    const int aoff = lds_byte(wr * 64 + fr, fq * 8), boff = lds_byte(wc * 32 + fr, fq * 8);
#define PG8_SA(b, h) (((b) * 2 + (h)) * HTB)
#define PG8_SB(b, h) ((4 + (b) * 2 + (h)) * HTB)
#define PG8_STAGE(bufoff, gbase, voff) do { _Pragma("unroll") for (int _i = 0; _i < 2; ++_i) \
        __builtin_amdgcn_global_load_lds((const unsigned*)((const char*)(gbase) + (voff)[_i]), (LAS unsigned*)(lds + (bufoff) + ldsw + _i * 8192), 16, 0, 0); } while (0)
#define PG8_LDA(dst, b, h) do { _Pragma("unroll") for (int m = 0; m < 4; ++m) _Pragma("unroll") for (int k = 0; k < 2; ++k) dst[m][k] = *(const LAS bf16x8*)(lds + PG8_SA(b, h) + aoff + m * 2048 + k * 1024); } while (0)
#define PG8_LDB(dst, b, h) do { _Pragma("unroll") for (int n = 0; n < 2; ++n) _Pragma("unroll") for (int k = 0; k < 2; ++k) dst[n][k] = *(const LAS bf16x8*)(lds + PG8_SB(b, h) + boff + n * 2048 + k * 1024); } while (0)
#define PG8_MMA(ai, bj, At, Bt) do { __builtin_amdgcn_s_setprio(1); _Pragma("unroll") for (int m = 0; m < 4; ++m) _Pragma("unroll") for (int n = 0; n < 2; ++n) _Pragma("unroll") for (int k = 0; k < 2; ++k) \
        acc[ai][bj][m][n] = __builtin_amdgcn_mfma_f32_16x16x32_bf16(Bt[n][k], At[m][k], acc[ai][bj][m][n], 0, 0, 0); __builtin_amdgcn_s_setprio(0); } while (0)
#define PG8_WAIT_V(n) asm volatile("s_waitcnt vmcnt(" #n ")" ::: "memory")
#define PG8_WAIT_L(n) asm volatile("s_waitcnt lgkmcnt(" #n ")" ::: "memory")
#define PG8_BAR __builtin_amdgcn_s_barrier()
#define PG8_SCHED __builtin_amdgcn_sched_barrier(0)
    Unit cur, nxt; int ui = 0;
    if (!S.next(0, cur)) return;
    f32x4 acc[2][2][4][2];
#pragma unroll
    for (int a = 0; a < 2; ++a)
#pragma unroll
        for (int b = 0; b < 2; ++b)
#pragma unroll
            for (int m = 0; m < 4; ++m)
#pragma unroll
                for (int n = 0; n < 2; ++n) acc[a][b][m][n] = (f32x4){0.f, 0.f, 0.f, 0.f};
    bf16x8 At[4][2], B0[2][2], B1[2][2];
    const char* cA = (const char*)g.A + (size_t)cur.pm * tA + (size_t)cur.pn * pnA; const char* cB = (const char*)g.Bt + (size_t)cur.pn * tB;
    if constexpr (SP2) {
        PG8_STAGE(PG8_SB(0, 0), cB, voffB); PG8_STAGE(PG8_SB(0, 1), cB + hB, voffB); PG8_STAGE(PG8_SA(0, 0), cA, voffA); PG8_STAGE(PG8_SA(0, 1), cA + hA, voffA);
        if (wr == 1) PG8_BAR;
        PG8_WAIT_V(2); PG8_BAR;
        PG8_STAGE(PG8_SB(1, 0), cB + kstep, voffB); PG8_STAGE(PG8_SA(1, 0), cA + kstep, voffA); PG8_STAGE(PG8_SB(1, 1), cB + hB + kstep, voffB);
        PG8_WAIT_V(6); PG8_BAR;
    } else {
        PG8_STAGE(PG8_SB(0, 0), cB, voffB); PG8_STAGE(PG8_SA(0, 0), cA, voffA); PG8_STAGE(PG8_SB(0, 1), cB + hB, voffB); PG8_STAGE(PG8_SA(0, 1), cA + hA, voffA);
        if (wr == 1) PG8_BAR;
        PG8_WAIT_V(4); PG8_BAR;
        PG8_STAGE(PG8_SB(1, 0), cB + kstep, voffB); PG8_STAGE(PG8_SA(1, 0), cA + kstep, voffA); PG8_STAGE(PG8_SB(1, 1), cB + hB + kstep, voffB);
        PG8_WAIT_V(6); PG8_BAR;
    }
    for (;;) {
        const bool has_next = S.next(ui + 1, nxt);
        const char* nA = has_next ? (const char*)g.A + (size_t)nxt.pm * tA + (size_t)nxt.pn * pnA : cA; const char* nB = has_next ? (const char*)g.Bt + (size_t)nxt.pn * tB : cB;
#pragma unroll 1
        for (int t = 0; t < nt; t += 2) {
            const bool last = (t == nt - 2);
            const char* a1 = cA + (size_t)(t + 1) * kstep;
            const char* a2 = last ? nA : cA + (size_t)(t + 2) * kstep; const char* b2 = last ? nB : cB + (size_t)(t + 2) * kstep;
            const char* a3 = a2 + kstep; const char* b3 = b2 + kstep;
            if constexpr (SP2) {
            PG8_LDB(B0, 0, 0); PG8_LDB(B1, 0, 1); PG8_SCHED; PG8_LDA(At, 0, 0); PG8_STAGE(PG8_SA(1, 1), a1 + hA, voffA);
            PG8_WAIT_V(8); PG8_WAIT_L(0); PG8_BAR; PG8_MMA(0, 0, At, B0); PG8_MMA(0, 1, At, B1); PG8_BAR; PG8_SCHED;
            PG8_LDA(At, 0, 1); PG8_STAGE(PG8_SB(0, 0), b2, voffB); PG8_STAGE(PG8_SB(0, 1), b2 + hB, voffB); PG8_STAGE(PG8_SA(0, 0), a2, voffA);
            PG8_WAIT_V(8); PG8_WAIT_L(0); PG8_BAR; PG8_MMA(1, 0, At, B0); PG8_MMA(1, 1, At, B1); PG8_BAR; PG8_SCHED;
            PG8_LDB(B0, 1, 0); PG8_LDB(B1, 1, 1); PG8_SCHED; PG8_LDA(At, 1, 0); PG8_STAGE(PG8_SA(0, 1), a2 + hA, voffA);
            PG8_WAIT_V(8); PG8_WAIT_L(0); PG8_BAR; PG8_MMA(0, 0, At, B0); PG8_MMA(0, 1, At, B1); PG8_BAR; PG8_SCHED;
            PG8_LDA(At, 1, 1); PG8_STAGE(PG8_SB(1, 0), b3, voffB); PG8_STAGE(PG8_SB(1, 1), b3 + hB, voffB); PG8_STAGE(PG8_SA(1, 0), a3, voffA);
            PG8_WAIT_V(8); PG8_WAIT_L(0); PG8_BAR; PG8_MMA(1, 0, At, B0); PG8_MMA(1, 1, At, B1); PG8_BAR; PG8_SCHED;
            } else {
            PG8_LDB(B0, 0, 0); PG8_SCHED; PG8_LDA(At, 0, 0); PG8_STAGE(PG8_SA(1, 1), a1 + hA, voffA);
            PG8_WAIT_L(8); PG8_BAR; PG8_WAIT_L(0); PG8_MMA(0, 0, At, B0); PG8_BAR; PG8_SCHED;
            PG8_LDB(B1, 0, 1); PG8_STAGE(PG8_SB(0, 0), b2, voffB);
            PG8_BAR; PG8_WAIT_L(0); PG8_MMA(0, 1, At, B1); PG8_BAR;
            PG8_LDA(At, 0, 1); PG8_STAGE(PG8_SA(0, 0), a2, voffA);
            PG8_BAR; PG8_WAIT_L(0); PG8_MMA(1, 0, At, B0); PG8_BAR; PG8_SCHED;
            PG8_STAGE(PG8_SB(0, 1), b2 + hB, voffB);
            PG8_WAIT_V(6); PG8_BAR; PG8_MMA(1, 1, At, B1); PG8_BAR;
            PG8_LDB(B0, 1, 0); PG8_SCHED; PG8_LDA(At, 1, 0); PG8_STAGE(PG8_SA(0, 1), a2 + hA, voffA);
            PG8_WAIT_L(8); PG8_BAR; PG8_WAIT_L(0); PG8_MMA(0, 0, At, B0); PG8_BAR; PG8_SCHED;
            PG8_LDB(B1, 1, 1); PG8_STAGE(PG8_SB(1, 0), b3, voffB);
            PG8_BAR; PG8_WAIT_L(0); PG8_MMA(0, 1, At, B1); PG8_BAR;
            PG8_LDA(At, 1, 1); PG8_STAGE(PG8_SA(1, 0), a3, voffA);
            PG8_BAR; PG8_WAIT_L(0); PG8_MMA(1, 0, At, B0); PG8_BAR; PG8_SCHED;
            PG8_STAGE(PG8_SB(1, 1), b3 + hB, voffB);
            PG8_WAIT_V(6); PG8_BAR; PG8_MMA(1, 1, At, B1); PG8_BAR;
            }
        }
        if constexpr (ALIGN_EPI) { if (wr == 0) PG8_BAR; }
        E(acc, cur, wr, wc, fr, fq);
        if (!has_next) break;
#pragma unroll
        for (int a = 0; a < 2; ++a)
#pragma unroll
            for (int b = 0; b < 2; ++b)
#pragma unroll
                for (int m = 0; m < 4; ++m)
#pragma unroll
                    for (int n = 0; n < 2; ++n) acc[a][b][m][n] = (f32x4){0.f, 0.f, 0.f, 0.f};
        cur = nxt; cA = nA; cB = nB; ++ui;
        if constexpr (ALIGN_EPI) { if (wr == 1) PG8_BAR; }
    }
    PG8_WAIT_V(0);
    if constexpr (!ALIGN_EPI) { if (wr == 0) PG8_BAR; }
    PG8_BAR;
#undef PG8_SA
#undef PG8_SB
#undef PG8_STAGE
#undef PG8_LDA
#undef PG8_LDB
#undef PG8_MMA
#undef PG8_WAIT_V
#undef PG8_WAIT_L
#undef PG8_BAR
#undef PG8_SCHED
}
}
constexpr int T_TOK = 16384, DM = 1024, SEQ = 4096, NB = 4;
constexpr float EPS = 1e-6f;
constexpr float LOG2E = 1.4426950408889634f;

namespace pg8 {
struct EpiProj {
    static constexpr bool PERM = true;
    bf16_t *GQ, *GK, *GV, *GR, *SQ, *SK, *SV, *SGA, *SGB;
    __device__ __forceinline__ void operator()(const f32x4 (&acc)[2][2][4][2], const Unit& u, int wr, int wc, int fr, int fq) const {
        const int pn = u.pn; bf16_t* base; int ldc = 1024, c0; int act = 0; float sc = 1.f;
        if (pn < 2) { base = GQ; ldc = 512; c0 = pn * 256; sc = 0.08838834764831845f; }
        else if (pn < 4) { base = GK; ldc = 512; c0 = (pn - 2) * 256; }
        else if (pn < 8) { base = GV; c0 = (pn - 4) * 256; }
        else if (pn < 12) { base = GR; c0 = (pn - 8) * 256; act = 1; }
        else if (pn < 16) { base = SQ; c0 = (pn - 12) * 256; sc = 0.125f * LOG2E; }
        else if (pn < 20) { base = SK; c0 = (pn - 16) * 256; }
        else if (pn < 24) { base = SV; c0 = (pn - 20) * 256; }
        else if (pn < 28) { base = SGA; c0 = (pn - 24) * 256; act = 2; }
        else { base = SGB; c0 = (pn - 28) * 256; act = 2; }
        const int row0 = u.pm * BM + wr * 64 + fr, col0 = c0 + wc * 32 + 8 * fq;
#pragma unroll
        for (int ai = 0; ai < 2; ++ai)
#pragma unroll
            for (int m = 0; m < 4; ++m) { bf16_t* rowp = base + (size_t)(row0 + ai * HALF + m * 16) * ldc + col0;
#pragma unroll
                for (int bj = 0; bj < 2; ++bj) { f32x4 v0 = acc[ai][bj][m][0], v1 = acc[ai][bj][m][1];
                    if (act == 1) {
#pragma unroll
                        for (int j = 0; j < 4; ++j) { v0[j] = v0[j] * fast_sigmoid(v0[j]); v1[j] = v1[j] * fast_sigmoid(v1[j]); } }
                    else if (act == 2) {
#pragma unroll
                        for (int j = 0; j < 4; ++j) { v0[j] = fast_sigmoid(v0[j]); v1[j] = fast_sigmoid(v1[j]); } }
                    else { v0 = v0 * sc; v1 = v1 * sc; }
                    u32x4 w; w.x = cvtpk(v0[0], v0[1]); w.y = cvtpk(v0[2], v0[3]); w.z = cvtpk(v1[0], v1[1]); w.w = cvtpk(v1[2], v1[3]);
                    *(u32x4*)(rowp + bj * HALF) = w; } }
    }
};
template <bool FIRST> struct EpiMix {
    static constexpr bool PERM = true;
    const bf16_t* gate; bf16_t* mixed;
    __device__ __forceinline__ void operator()(const f32x4 (&acc)[2][2][4][2], const Unit& u, int wr, int wc, int fr, int fq) const {
        const int row0 = u.pm * BM + wr * 64 + fr, col0 = u.pn * BM + wc * 32 + 8 * fq;
#pragma unroll
        for (int ai = 0; ai < 2; ++ai)
#pragma unroll
            for (int m = 0; m < 4; ++m) { const size_t off = (size_t)(row0 + ai * HALF + m * 16) * 1024 + col0;
#pragma unroll
                for (int bj = 0; bj < 2; ++bj) { const f32x4 a0 = acc[ai][bj][m][0], a1 = acc[ai][bj][m][1];
                    const u32x4 gv = *(const u32x4*)(gate + off + bj * HALF);
                    float r[8];
                    r[0] = a0[0] * bf_lo(gv.x); r[1] = a0[1] * bf_hi(gv.x); r[2] = a0[2] * bf_lo(gv.y); r[3] = a0[3] * bf_hi(gv.y);
                    r[4] = a1[0] * bf_lo(gv.z); r[5] = a1[1] * bf_hi(gv.z); r[6] = a1[2] * bf_lo(gv.w); r[7] = a1[3] * bf_hi(gv.w);
                    if (!FIRST) { const u32x4 mv = *(const u32x4*)(mixed + off + bj * HALF);
                        r[0] += bf_lo(mv.x); r[1] += bf_hi(mv.x); r[2] += bf_lo(mv.y); r[3] += bf_hi(mv.y); r[4] += bf_lo(mv.z); r[5] += bf_hi(mv.z); r[6] += bf_lo(mv.w); r[7] += bf_hi(mv.w); }
                    u32x4 w; w.x = cvtpk(r[0], r[1]); w.y = cvtpk(r[2], r[3]); w.z = cvtpk(r[4], r[5]); w.w = cvtpk(r[6], r[7]);
                    *(u32x4*)(mixed + off + bj * HALF) = w; } }
    }
};
struct EpiH1 {
    static constexpr bool PERM = false;
    const float* x; const float* g; float* H1; bf16_t* H1G; float* SSQ;
    __device__ __forceinline__ void operator()(const f32x4 (&acc)[2][2][4][2], const Unit& u, int wr, int wc, int fr, int fq) const {
        const int row0 = u.pm * BM + wr * 64 + fr, col0 = u.pn * BM + wc * 32 + 4 * fq;
        f32x4 gv[2][2];
#pragma unroll
        for (int bj = 0; bj < 2; ++bj)
#pragma unroll
            for (int n = 0; n < 2; ++n) gv[bj][n] = *(const f32x4*)(g + col0 + bj * HALF + n * 16);
#pragma unroll
        for (int ai = 0; ai < 2; ++ai)
#pragma unroll
            for (int m = 0; m < 4; ++m) { const int row = row0 + ai * HALF + m * 16; const size_t off = (size_t)row * 1024 + col0; float s = 0.f;
#pragma unroll
                for (int bj = 0; bj < 2; ++bj)
#pragma unroll
                    for (int n = 0; n < 2; ++n) { const f32x4 xv = *(const f32x4*)(x + off + bj * HALF + n * 16); const f32x4 h = xv + acc[ai][bj][m][n];
                        *(f32x4*)(H1 + off + bj * HALF + n * 16) = h; s += (h[0] * h[0] + h[1] * h[1]) + (h[2] * h[2] + h[3] * h[3]);
                        const f32x4 hg = h * gv[bj][n]; u32x2 w; w.x = cvtpk(hg[0], hg[1]); w.y = cvtpk(hg[2], hg[3]); *(u32x2*)(H1G + off + bj * HALF + n * 16) = w; }
                s += __shfl_xor(s, 16); s += __shfl_xor(s, 32);
                if (fq == 0) SSQ[(size_t)row * 16 + u.pn * 4 + wc] = s; }
    }
};
struct EpiQ {
    static constexpr bool PERM = true;
    const float* SSQ; bf16_t* Q; int ldc;
    __device__ __forceinline__ void operator()(const f32x4 (&acc)[2][2][4][2], const Unit& u, int wr, int wc, int fr, int fq) const {
        const int row0 = u.pm * BM + wr * 64 + fr, col0 = u.pn * BM + wc * 32 + 8 * fq;
#pragma unroll
        for (int ai = 0; ai < 2; ++ai)
#pragma unroll
            for (int m = 0; m < 4; ++m) { const int row = row0 + ai * HALF + m * 16; const f32x4* sp = (const f32x4*)(SSQ + (size_t)row * 16);
                const f32x4 s0 = sp[0], s1 = sp[1], s2 = sp[2], s3 = sp[3]; const f32x4 st = (s0 + s1) + (s2 + s3);
                const float rstd = __builtin_amdgcn_rsqf(((st[0] + st[1]) + (st[2] + st[3])) * (1.0f / 1024.0f) + EPS);
                bf16_t* rowp = Q + (size_t)row * ldc + col0;
#pragma unroll
                for (int bj = 0; bj < 2; ++bj) { const f32x4 v0 = acc[ai][bj][m][0] * rstd, v1 = acc[ai][bj][m][1] * rstd;
                    u32x4 w; w.x = cvtpk(v0[0], v0[1]); w.y = cvtpk(v0[2], v0[3]); w.z = cvtpk(v1[0], v1[1]); w.w = cvtpk(v1[2], v1[3]);
                    *(u32x4*)(rowp + bj * HALF) = w; } }
    }
};
struct EpiF32 {
    static constexpr bool PERM = false;
    float* O; int ldc;
    __device__ __forceinline__ void operator()(const f32x4 (&acc)[2][2][4][2], const Unit& u, int wr, int wc, int fr, int fq) const {
        const int row0 = u.pm * BM + wr * 64 + fr, col0 = u.pn * BM + wc * 32 + 4 * fq;
#pragma unroll
        for (int ai = 0; ai < 2; ++ai)
#pragma unroll
            for (int m = 0; m < 4; ++m) { float* rowp = O + (size_t)(row0 + ai * HALF + m * 16) * ldc + col0;
#pragma unroll
                for (int bj = 0; bj < 2; ++bj)
#pragma unroll
                    for (int n = 0; n < 2; ++n) *(f32x4*)(rowp + bj * HALF + n * 16) = acc[ai][bj][m][n]; }
    }
};
struct EpiBf {
    static constexpr bool PERM = true;
    bf16_t* O; int ldc;
    __device__ __forceinline__ void operator()(const f32x4 (&acc)[2][2][4][2], const Unit& u, int wr, int wc, int fr, int fq) const {
        const int row0 = u.pm * BM + wr * 64 + fr, col0 = u.pn * BM + wc * 32 + 8 * fq;
#pragma unroll
        for (int ai = 0; ai < 2; ++ai)
#pragma unroll
            for (int m = 0; m < 4; ++m) { bf16_t* rowp = O + (size_t)(row0 + ai * HALF + m * 16) * ldc + col0;
#pragma unroll
                for (int bj = 0; bj < 2; ++bj) { const f32x4 v0 = acc[ai][bj][m][0], v1 = acc[ai][bj][m][1];
                    u32x4 w; w.x = cvtpk(v0[0], v0[1]); w.y = cvtpk(v0[2], v0[3]); w.z = cvtpk(v1[0], v1[1]); w.w = cvtpk(v1[2], v1[3]);
                    *(u32x4*)(rowp + bj * HALF) = w; } }
    }
};
struct EpiH3 {
    static constexpr bool PERM = false;
    const float* H2; const bf16_t* PLE; float* OUT; float* SSQ; int dry;
    __device__ __forceinline__ void operator()(const f32x4 (&acc)[2][2][4][2], const Unit& u, int wr, int wc, int fr, int fq) const {
        const int row0 = u.pm * BM + wr * 64 + fr, col0 = u.pn * BM + wc * 32 + 4 * fq;
#pragma unroll
        for (int ai = 0; ai < 2; ++ai)
#pragma unroll
            for (int m = 0; m < 4; ++m) { const int row = row0 + ai * HALF + m * 16; const size_t off = (size_t)row * 1024 + col0; float s = 0.f;
#pragma unroll
                for (int bj = 0; bj < 2; ++bj)
#pragma unroll
                    for (int n = 0; n < 2; ++n) { const size_t o2 = off + bj * HALF + n * 16; const f32x4 hv = *(const f32x4*)(H2 + o2); const u32x2 pv = *(const u32x2*)(PLE + o2);
                        const f32x4 a = acc[ai][bj][m][n]; f32x4 h;
                        h[0] = hv[0] + bf_lo(pv.x) * fast_sigmoid(a[0]); h[1] = hv[1] + bf_hi(pv.x) * fast_sigmoid(a[1]);
                        h[2] = hv[2] + bf_lo(pv.y) * fast_sigmoid(a[2]); h[3] = hv[3] + bf_hi(pv.y) * fast_sigmoid(a[3]);
                        if (!dry) *(f32x4*)(OUT + o2) = h; s += (h[0] * h[0] + h[1] * h[1]) + (h[2] * h[2] + h[3] * h[3]); }
                s += __shfl_xor(s, 16); s += __shfl_xor(s, 32);
                if (fq == 0) SSQ[(size_t)row * 16 + u.pn * 4 + wc] = s;
                asm volatile("" ::: "memory"); }
    }
};
}
constexpr size_t MiB = 1u << 20;
constexpr size_t WS_CTL = 0, CTL_ZERO_BYTES = 64 * 1024;
constexpr size_t WS_PEND = 64 * 1024;
constexpr size_t WS_WPLE = 512 * 1024;
constexpr size_t WS_KD = 1 * MiB;
constexpr size_t WS_GLAG = 2 * MiB;
constexpr size_t WS_WIN = 3 * MiB;
constexpr size_t WS_SEND = 4 * MiB;
constexpr size_t WS_EXP = 4 * MiB;
constexpr size_t WS_SSQ1 = 13 * MiB;
constexpr size_t WS_SSQ3 = 14 * MiB;
constexpr size_t WS_RSU = 15 * MiB, WS_RSV = 15 * MiB + 64 * 1024;
constexpr size_t WS_WGA = 20 * MiB, WS_WSB = 22 * MiB, WS_WO = 24 * MiB, WS_WPG = 26 * MiB, WS_WPQ = 28 * MiB;
constexpr size_t WS_A = 32 * MiB;
constexpr size_t WS_GQ = WS_A, WS_GK = WS_A + 16 * MiB, WS_UB8 = WS_A, WS_VB8 = WS_A + 16 * MiB;
constexpr size_t WS_B = 64 * MiB;
constexpr size_t WS_GV = WS_B, WS_PB = WS_B;
constexpr size_t WS_C = 96 * MiB;
constexpr size_t WS_GR = WS_C, WS_H1 = WS_C;
constexpr size_t WS_D = 128 * MiB;
constexpr size_t WS_SQ = WS_D;
constexpr size_t WS_E = 160 * MiB;
constexpr size_t WS_SK = WS_E, WS_MIX = WS_E, WS_Q = WS_E, WS_XN3 = WS_E;
constexpr size_t WS_F = 192 * MiB;
constexpr size_t WS_SV = WS_F;
constexpr size_t WS_G = 224 * MiB;
constexpr size_t WS_XN1 = WS_G, WS_GLAN = WS_G, WS_H1G = WS_G, WS_PLE = WS_G;
constexpr size_t WS_END = 256 * MiB;

constexpr int NWAVES = 8;
constexpr int RING_OFF = 0, RING_BYTES = 131072;
constexpr int MISC_OFF = RING_BYTES;
constexpr int LDS_BYTES = 147456;
constexpr int CW_BAR = 1024;

typedef GAS unsigned gu32;
#define RLX_AGENT __ATOMIC_RELAXED, __HIP_MEMORY_SCOPE_AGENT
#define LDS_WAIT() asm volatile("s_waitcnt lgkmcnt(0)" ::: "memory")
#define VM_WAIT() asm volatile("s_waitcnt vmcnt(0)" ::: "memory")

#define XB_TMO      128
#define XB_XCNT(j)  (256  + 64 * (j))
#define XB_XSUB(j)  (1280 + 64 * (j))
#define XB_XGEN(j)  (2304 + 64 * (j))
#define XB_TOP      3328
#define XB_TOPGEN   3392
#define XCD_BAR_WORDS 3456
#define XB_SPIN_CAP (1u << 22)
__device__ __forceinline__ unsigned xb_ld(unsigned* p)              { return __hip_atomic_load(p, __ATOMIC_RELAXED, __HIP_MEMORY_SCOPE_AGENT); }
__device__ __forceinline__ unsigned xb_add(unsigned* p, unsigned v) { return __hip_atomic_fetch_add(p, v, __ATOMIC_RELAXED, __HIP_MEMORY_SCOPE_AGENT); }
__device__ __forceinline__ unsigned xb_xcc_id() { return (unsigned)__builtin_amdgcn_s_getreg((3 << 11) | 20) & 0xFu; }
#define XB_SPIN(cond, bar) do { unsigned _sp = 0; while (cond) { __builtin_amdgcn_s_sleep(1); \
    if ((++_sp & 255u) == 0u) { if (xb_ld(&(bar)[XB_TMO])) break; if (_sp > XB_SPIN_CAP) { atomicAdd(&(bar)[XB_TMO], 1u); break; } } } } while (0)
struct XcdBarrier { unsigned* bar; unsigned x; volatile LAS unsigned* st; };
__device__ __forceinline__ XcdBarrier xcd_barrier_post(unsigned* bar, volatile LAS unsigned* st) {
    XcdBarrier b; b.bar = bar; b.x = xb_xcc_id(); b.st = st;
    if (threadIdx.x == 0) (void)xb_add(&bar[XB_XCNT(b.x)], 1u);
    return b;
}
__device__ __forceinline__ void xcd_barrier_complete(unsigned* bar, unsigned x, unsigned& nloc, unsigned& nx) {
    const unsigned G = gridDim.x * gridDim.y * gridDim.z;
    unsigned sum, cnt, mine, sp = 0u;
    for (;;) {
        sum = 0u; cnt = 0u; mine = 0u;
#pragma unroll
        for (unsigned j = 0; j < 16; ++j) { const unsigned c = xb_ld(&bar[XB_XCNT(j)]); sum += c; cnt += (c > 0u) ? 1u : 0u; mine = (j == x) ? c : mine; }
        if (sum == G) break;
        __builtin_amdgcn_s_sleep(1);
        if ((++sp & 255u) == 0u) { if (xb_ld(&bar[XB_TMO])) break; if (sp > XB_SPIN_CAP) { atomicAdd(&bar[XB_TMO], 1u); break; } }
    }
    nloc = mine > 0u ? mine : 1u; nx = cnt > 0u ? cnt : 1u;
}
__device__ __forceinline__ void xcd_barrier(const XcdBarrier& b) {
    asm volatile("s_waitcnt vmcnt(0)" ::: "memory");
    __syncthreads();
    if (threadIdx.x == 0) {
        unsigned* bar = b.bar;
        __builtin_amdgcn_s_waitcnt(0);
        unsigned nloc = b.st[0], nx = b.st[1];
        if (nloc == 0u) { xcd_barrier_complete(bar, b.x, nloc, nx); b.st[0] = nloc; b.st[1] = nx; }
        const unsigned old = xb_add(&bar[XB_XSUB(b.x)], 1u);
        const unsigned gen = old / nloc;
        if (old + 1u == (gen + 1u) * nloc) {
            __builtin_amdgcn_fence(__ATOMIC_RELEASE, "agent");
            asm volatile("s_waitcnt vmcnt(0)" ::: "memory");
            const unsigned og = xb_add(&bar[XB_TOP], 1u);
            const unsigned tg = og / nx;
            if (og + 1u == (tg + 1u) * nx) xb_add(&bar[XB_TOPGEN], 1u);
            else XB_SPIN(xb_ld(&bar[XB_TOPGEN]) == tg, bar);
            __builtin_amdgcn_fence(__ATOMIC_ACQUIRE, "agent");
            xb_add(&bar[XB_XGEN(b.x)], 1u);
            asm volatile("s_waitcnt vmcnt(0)" ::: "memory");
        } else {
            XB_SPIN(xb_ld(&bar[XB_XGEN(b.x)]) == gen, bar);
            __builtin_amdgcn_fence(__ATOMIC_ACQUIRE, "agent");
            asm volatile("s_waitcnt vmcnt(0)" ::: "memory");
        }
    }
    __syncthreads();
}

struct Frame {
    LAS unsigned char* lds;
    int tid, lane, wave, vcu, G, dry;
    const float* const* in; float* out; unsigned char* ws;
};
__device__ __forceinline__ int lane_id() { int l; asm volatile("v_mbcnt_lo_u32_b32 %0, -1, 0\n\tv_mbcnt_hi_u32_b32 %0, -1, %0" : "=v"(l)); return l; }
#define WSP(T, off) ((T*)(F.ws + (off)))
__device__ __forceinline__ float wave_sum(float v) {
#pragma unroll
    for (int o = 1; o < 64; o <<= 1) v += __shfl_xor(v, o);
    return v;
}
template <class RowMap>
__device__ __forceinline__ void p0_transpose_item(const float* W, int K, int N, bf16_t* WT, RowMap rm, LAS float* scr, int item, int lane) {
    const int nblk = (N + 31) / 32, kb = item / nblk, nb = item % nblk, k0 = 64 * kb, n0 = 32 * nb;
    const int nl = n0 + (lane & 31);
#pragma unroll 8
    for (int i = 0; i < 32; ++i) { const int kk = 2 * i + (lane >> 5); scr[kk * 33 + (lane & 31)] = (nl < N) ? W[(size_t)(k0 + kk) * N + nl] : 0.f; }
    LDS_WAIT(); asm volatile("" ::: "memory");
    const int c = lane & 7;
#pragma unroll
    for (int j = 0; j < 4; ++j) { const int n = (lane >> 3) + 8 * j; const LAS float* s = scr + (8 * c) * 33 + n;
        u32x4 o; o.x = cvtpk(s[0 * 33], s[1 * 33]); o.y = cvtpk(s[2 * 33], s[3 * 33]); o.z = cvtpk(s[4 * 33], s[5 * 33]); o.w = cvtpk(s[6 * 33], s[7 * 33]);
        if (n0 + n < N) *(u32x4*)(WT + (size_t)rm(n0 + n) * K + k0 + 8 * c) = o; }
    LDS_WAIT(); asm volatile("" ::: "memory");
}
struct RmId { __device__ __forceinline__ int operator()(int n) const { return n; } };
struct RmWin { __device__ __forceinline__ int operator()(int n) const { return n < 3072 ? n : (n < 3088 ? 8192 + (n - 3072) : n - 16); } };

__device__ __forceinline__ void cvt_copy(Frame& F, const float* src, bf16_t* dst, size_t n) {
    const size_t nth = (size_t)F.G * 512, n8 = n / 8;
    for (size_t i = (size_t)F.vcu * 512 + F.tid; i < n8; i += nth) {
        const f32x4 a = *(const f32x4*)(src + i * 8), b = *(const f32x4*)(src + i * 8 + 4);
        u32x4 o; o.x = cvtpk(a[0], a[1]); o.y = cvtpk(a[2], a[3]); o.z = cvtpk(b[0], b[1]); o.w = cvtpk(b[2], b[3]);
        *(u32x4*)(dst + i * 8) = o; }
}
__device__ __forceinline__ void rms_row_to_bf16(const float* xrow, const float* g, bf16_t* orow, int lane) {
    f32x4 v[4]; float s = 0.f;
#pragma unroll
    for (int j = 0; j < 4; ++j) { v[j] = *((const f32x4*)xrow + lane + 64 * j); s += (v[j][0] * v[j][0] + v[j][1] * v[j][1]) + (v[j][2] * v[j][2] + v[j][3] * v[j][3]); }
    const float rstd = __builtin_amdgcn_rsqf(wave_sum(s) * (1.f / 1024.f) + EPS);
#pragma unroll
    for (int j = 0; j < 4; ++j) { const f32x4 gv = *((const f32x4*)g + lane + 64 * j); const f32x4 o = v[j] * rstd * gv;
        u32x2 w; w.x = cvtpk(o[0], o[1]); w.y = cvtpk(o[2], o[3]); *((u32x2*)orow + lane + 64 * j) = w; }
}
__device__ __forceinline__ void phase_prologue(Frame& F) {
    LAS float* scr = (LAS float*)(F.lds + RING_OFF + F.wave * 16384);
    const int gw = F.vcu * NWAVES + F.wave, NGW = F.G * NWAVES;
    constexpr int I_IN = 16 * 257, I_SQ = 16 * 32, I_PQ = 16 * 64, I_PLE = 4 * 32;
    constexpr int NITEMS = I_IN + 4 * I_SQ + I_PQ + I_PLE;
    for (int it = gw; it < NITEMS; it += NGW) {
        int r = it;
        if (r < I_IN) { p0_transpose_item(F.in[3], 1024, 8208, WSP(bf16_t, WS_WIN), RmWin(), scr, r, F.lane); continue; } r -= I_IN;
        if (r < I_SQ) { p0_transpose_item(F.in[7], 1024, 1024, WSP(bf16_t, WS_WGA), RmId(), scr, r, F.lane); continue; } r -= I_SQ;
        if (r < I_SQ) { p0_transpose_item(F.in[8], 1024, 1024, WSP(bf16_t, WS_WSB), RmId(), scr, r, F.lane); continue; } r -= I_SQ;
        if (r < I_SQ) { p0_transpose_item(F.in[9], 1024, 1024, WSP(bf16_t, WS_WO), RmId(), scr, r, F.lane); continue; } r -= I_SQ;
        if (r < I_SQ) { p0_transpose_item(F.in[17], 1024, 1024, WSP(bf16_t, WS_WPG), RmId(), scr, r, F.lane); continue; } r -= I_SQ;
        if (r < I_PQ) { p0_transpose_item(F.in[11], 1024, 2048, WSP(bf16_t, WS_WPQ), RmId(), scr, r, F.lane); continue; } r -= I_PQ;
        p0_transpose_item(F.in[18], 256, 1024, WSP(bf16_t, WS_WPLE), RmId(), scr, r, F.lane);
    }
    { const float* k1 = F.in[12]; const float* k2 = F.in[13]; bf16_t* KB = WSP(bf16_t, WS_KD);
      for (int i = F.vcu * 512 + F.tid; i < 2 * 8 * 128 * 16; i += F.G * 512) { const int half = i >> 14, rem = i & 16383, h = rem >> 11, r8 = rem & 2047;
          const float* s = (half ? k2 : k1) + (size_t)h * 16384 + (size_t)r8 * 8; const f32x4 a = *(const f32x4*)s, b = *(const f32x4*)(s + 4);
          u32x4 o; o.x = cvtpk(a[0], a[1]); o.y = cvtpk(a[2], a[3]); o.z = cvtpk(b[0], b[1]); o.w = cvtpk(b[2], b[3]);
          *(u32x4*)(KB + (size_t)(h * 2 + half) * 16384 + (size_t)r8 * 8) = o; } }
    for (int m = gw; m < T_TOK; m += NGW) rms_row_to_bf16(F.in[0] + (size_t)m * 1024, F.in[2], WSP(bf16_t, WS_XN1) + (size_t)m * 1024, F.lane);
}

__device__ __forceinline__ void phase_gla_prep(Frame& F) {
    LAS float* alo = (LAS float*)(F.lds + RING_OFF);
    const bf16_t* XN1 = WSP(bf16_t, WS_XN1); const bf16_t* WGAT = WSP(bf16_t, WS_WIN) + (size_t)8192 * 1024;
    bf16_t* GK = WSP(bf16_t, WS_GK); bf16_t* GV = WSP(bf16_t, WS_GV); float* GLAG = WSP(float, WS_GLAG);
    const float* w_up = F.in[4]; const float* b_a = F.in[5];
    const int tid = F.tid, lane = F.lane, w = F.wave;
    for (int u = F.vcu; u < 256; u += F.G) {
        const size_t r0 = (size_t)u * 64;
        __syncthreads();
        if (w < 4) {
            f32x4 acc = (f32x4){0.f, 0.f, 0.f, 0.f};
            const bf16_t* ap = XN1 + (r0 + 16 * w + (lane & 15)) * 1024 + 8 * (lane >> 4);
            const bf16_t* bp = WGAT + (size_t)(lane & 15) * 1024 + 8 * (lane >> 4);
#pragma unroll 8
            for (int s = 0; s < 32; ++s) { const bf16x8 a = *(const bf16x8*)(ap + 32 * s), b = *(const bf16x8*)(bp + 32 * s); acc = __builtin_amdgcn_mfma_f32_16x16x32_bf16(a, b, acc, 0, 0, 0); }
#pragma unroll
            for (int r = 0; r < 4; ++r) alo[(16 * w + 4 * (lane >> 4) + r) * 16 + (lane & 15)] = acc[r];
        }
        const int kk = tid;
        float kv[64];
#pragma unroll
        for (int i = 0; i < 64; ++i) kv[i] = bf1(GK[(r0 + i) * 512 + kk]);
        float wv[16];
#pragma unroll
        for (int r = 0; r < 16; ++r) wv[r] = w_up[r * 512 + kk];
        const float bias = b_a[kk];
        __syncthreads();
        float suffix = 0.f;
        bf16_t* kdt = GK + r0 * 512 + (size_t)kk * 64;
#pragma unroll
        for (int i8 = 7; i8 >= 0; --i8) {
            float o[8];
#pragma unroll
            for (int j = 7; j >= 0; --j) { const int i = i8 * 8 + j;
                const f32x4 a0 = *(const LAS f32x4*)(alo + i * 16), a1 = *(const LAS f32x4*)(alo + i * 16 + 4), a2 = *(const LAS f32x4*)(alo + i * 16 + 8), a3 = *(const LAS f32x4*)(alo + i * 16 + 12);
                float x = bias;
                x += a0[0] * wv[0] + a0[1] * wv[1] + a0[2] * wv[2] + a0[3] * wv[3];
                x += a1[0] * wv[4] + a1[1] * wv[5] + a1[2] * wv[6] + a1[3] * wv[7];
                x += a2[0] * wv[8] + a2[1] * wv[9] + a2[2] * wv[10] + a2[3] * wv[11];
                x += a3[0] * wv[12] + a3[1] * wv[13] + a3[2] * wv[14] + a3[3] * wv[15];
                const float la = (fminf(x, 0.f) - log1pf(__expf(-fabsf(x)))) * (1.0f / 16.0f);
                o[j] = kv[i] * __expf(suffix);
                suffix += la; }
            u32x4 pk; pk.x = cvtpk(o[0], o[1]); pk.y = cvtpk(o[2], o[3]); pk.z = cvtpk(o[4], o[5]); pk.w = cvtpk(o[6], o[7]);
            if (!F.dry) *(u32x4*)(kdt + i8 * 8) = pk; }
        GLAG[(size_t)u * 512 + kk] = __expf(suffix);
        unsigned vv[64];
#pragma unroll
        for (int i = 0; i < 64; ++i) vv[i] = *(const unsigned*)(GV + (r0 + i) * 1024 + 2 * tid);
        __syncthreads();
        bf16_t* vt0 = GV + r0 * 1024 + (size_t)(2 * tid) * 64;
#pragma unroll
        for (int i8 = 0; i8 < 8; ++i8) { u32x4 lo, hi;
            lo.x = (vv[i8 * 8 + 0] & 0xffffu) | (vv[i8 * 8 + 1] << 16); hi.x = (vv[i8 * 8 + 0] >> 16) | (vv[i8 * 8 + 1] & 0xffff0000u);
            lo.y = (vv[i8 * 8 + 2] & 0xffffu) | (vv[i8 * 8 + 3] << 16); hi.y = (vv[i8 * 8 + 2] >> 16) | (vv[i8 * 8 + 3] & 0xffff0000u);
            lo.z = (vv[i8 * 8 + 4] & 0xffffu) | (vv[i8 * 8 + 5] << 16); hi.z = (vv[i8 * 8 + 4] >> 16) | (vv[i8 * 8 + 5] & 0xffff0000u);
            lo.w = (vv[i8 * 8 + 6] & 0xffffu) | (vv[i8 * 8 + 7] << 16); hi.w = (vv[i8 * 8 + 6] >> 16) | (vv[i8 * 8 + 7] & 0xffff0000u);
            if (!F.dry) { *(u32x4*)(vt0 + i8 * 8) = lo; *(u32x4*)(vt0 + 64 + i8 * 8) = hi; } }
    }
}

constexpr int GL_KD = 0, GL_Q = 32768, GL_G = 65536, GL_RED = 65536 + 1024;
__device__ __forceinline__ int gl_kd_off(int row, int chunk) { return row * 128 + ((chunk ^ ((row >> 1) & 7)) << 4); }
__device__ __forceinline__ int gl_q_off(int row, int chunk16) { return row * 256 + ((chunk16 ^ (row & 15)) << 4); }

struct GlaStage { u32x4 kd[2]; u32x4 q[2]; bf16x8 vt[4]; float g; };
__device__ __forceinline__ void gla_prefetch_vt(Frame& F, GlaStage& st, int b, int h, int c) {
    const int u = b * 64 + c; const size_t r0 = (size_t)u * 64; const int w = F.wave, lq = F.lane & 31, hh = F.lane >> 5;
    const bf16_t* vt = WSP(bf16_t, WS_GV) + r0 * 1024 + (size_t)(h * 256 + 32 * w + lq) * 64;
#pragma unroll
    for (int ts = 0; ts < 4; ++ts) st.vt[ts] = *(const bf16x8*)(vt + 16 * ts + 8 * hh);
}
template <bool WITH_Q>
__device__ __forceinline__ void gla_prefetch(Frame& F, GlaStage& st, int b, int h, int c) {
    const int u = b * 64 + c; const size_t r0 = (size_t)u * 64; const int tid = F.tid;
    const bf16_t* kd = WSP(bf16_t, WS_GK) + r0 * 512 + (size_t)h * 8192;
#pragma unroll
    for (int j = 0; j < 2; ++j) { const int pi = tid + 512 * j; st.kd[j] = *(const u32x4*)(kd + (pi >> 3) * 64 + (pi & 7) * 8); }
    if (WITH_Q) { const bf16_t* gq = WSP(bf16_t, WS_GQ) + r0 * 512 + h * 128;
#pragma unroll
        for (int j = 0; j < 2; ++j) { const int pi = tid + 512 * j; st.q[j] = *(const u32x4*)(gq + (size_t)(pi >> 4) * 512 + (pi & 15) * 8); } }
    st.g = (tid < 128) ? WSP(float, WS_GLAG)[((size_t)u * 4 + h) * 128 + tid] : 1.f;
}
template <bool WITH_Q>
__device__ __forceinline__ void gla_stage_write(Frame& F, const GlaStage& st, int buf) {
    LAS unsigned char* lds = F.lds + RING_OFF; const int tid = F.tid;
#pragma unroll
    for (int j = 0; j < 2; ++j) { const int pi = tid + 512 * j; *(LAS u32x4*)(lds + GL_KD + buf * 16384 + gl_kd_off(pi >> 3, pi & 7)) = st.kd[j]; }
    if (WITH_Q) {
#pragma unroll
        for (int j = 0; j < 2; ++j) { const int pi = tid + 512 * j; *(LAS u32x4*)(lds + GL_Q + buf * 16384 + gl_q_off(pi >> 4, pi & 15)) = st.q[j]; } }
    if (tid < 128) *(LAS float*)(lds + GL_G + buf * 512 + tid * 4) = st.g;
}
__device__ __forceinline__ void gla_update(Frame& F, f32x16 (&S)[4], const bf16x8 (&vt)[4], int buf) {
    const LAS unsigned char* lds = F.lds + RING_OFF; const int lq = F.lane & 31, hh = F.lane >> 5;
    const LAS float* G = (const LAS float*)(lds + GL_G + buf * 512);
#pragma unroll
    for (int kt = 0; kt < 4; ++kt)
#pragma unroll
        for (int g4 = 0; g4 < 4; ++g4) { const f32x4 g = *(const LAS f32x4*)(G + 32 * kt + 8 * g4 + 4 * hh);
#pragma unroll
            for (int j = 0; j < 4; ++j) S[kt][4 * g4 + j] *= g[j]; }
#pragma unroll
    for (int ts = 0; ts < 4; ++ts)
#pragma unroll
        for (int kt = 0; kt < 4; ++kt) { const bf16x8 a = *(const LAS bf16x8*)(lds + GL_KD + buf * 16384 + gl_kd_off(32 * kt + lq, 2 * ts + hh));
            S[kt] = __builtin_amdgcn_mfma_f32_32x32x16_bf16(a, vt[ts], S[kt], 0, 0, 0); if (kt == 3 && (ts & 1)) __builtin_amdgcn_sched_barrier(0); }
}
constexpr size_t SEND_WAVE_FLOATS = 4 * 4 * 64 * 4;
__device__ __forceinline__ void gla_stage1(Frame& F, int unit) {
    const int bh = unit >> 3, seg = unit & 7, b = bh >> 2, h = bh & 3, w = F.wave, l = F.lane;
    f32x16 S[4];
#pragma unroll
    for (int kt = 0; kt < 4; ++kt)
#pragma unroll
        for (int r = 0; r < 16; ++r) S[kt][r] = 0.f;
    float pend = 1.f;
    GlaStage st; gla_prefetch<false>(F, st, b, h, seg * 8); gla_prefetch_vt(F, st, b, h, seg * 8);
    for (int ci = 0; ci < 8; ++ci) {
        gla_stage_write<false>(F, st, ci & 1); pend *= st.g;
        __syncthreads();
        if (ci < 7) gla_prefetch<false>(F, st, b, h, seg * 8 + ci + 1);
        gla_update(F, S, st.vt, ci & 1);
        if (ci < 7) gla_prefetch_vt(F, st, b, h, seg * 8 + ci + 1);
    }
    float* se = WSP(float, WS_SEND) + ((size_t)unit * 8 + w) * SEND_WAVE_FLOATS;
#pragma unroll
    for (int kt = 0; kt < 4; ++kt)
#pragma unroll
        for (int g4 = 0; g4 < 4; ++g4) *(f32x4*)(se + ((kt * 4 + g4) * 64 + l) * 4) = (f32x4){S[kt][4 * g4], S[kt][4 * g4 + 1], S[kt][4 * g4 + 2], S[kt][4 * g4 + 3]};
    if (F.tid < 128) WSP(float, WS_PEND)[unit * 128 + F.tid] = pend;
    __syncthreads();
}
__device__ __forceinline__ void gla_stage3(Frame& F, int unit) {
    const int bh = unit >> 3, seg = unit & 7, b = bh >> 2, h = bh & 3, w = F.wave, l = F.lane, lq = l & 31, hh = l >> 5;
    LAS unsigned char* lds = F.lds + RING_OFF;
    const bf16_t* GR = WSP(bf16_t, WS_GR); bf16_t* GLAN = WSP(bf16_t, WS_GLAN); const float* g_o = F.in[6];
    f32x16 S[4];
#pragma unroll
    for (int kt = 0; kt < 4; ++kt)
#pragma unroll
        for (int r = 0; r < 16; ++r) S[kt][r] = 0.f;
    GlaStage st; gla_prefetch<true>(F, st, b, h, seg * 8); gla_prefetch_vt(F, st, b, h, seg * 8);
    for (int sp = 0; sp < seg; ++sp) {
        const int un = bh * 8 + sp; const float* se = WSP(float, WS_SEND) + ((size_t)un * 8 + w) * SEND_WAVE_FLOATS; const float* pe = WSP(float, WS_PEND) + un * 128;
#pragma unroll
        for (int kt = 0; kt < 4; ++kt)
#pragma unroll
            for (int g4 = 0; g4 < 4; ++g4) { const f32x4 p = *(const f32x4*)(pe + 32 * kt + 8 * g4 + 4 * hh); const f32x4 s = *(const f32x4*)(se + ((kt * 4 + g4) * 64 + l) * 4);
#pragma unroll
                for (int j = 0; j < 4; ++j) S[kt][4 * g4 + j] = S[kt][4 * g4 + j] * p[j] + s[j]; }
    }
    for (int ci = 0; ci < 8; ++ci) {
        const int c = seg * 8 + ci; const size_t r0 = (size_t)(b * 64 + c) * 64; const int buf = ci & 1;
        gla_stage_write<true>(F, st, buf);
        __syncthreads();
        if (ci < 7) gla_prefetch<true>(F, st, b, h, c + 1);
        gla_update(F, S, st.vt, buf);
        f32x16 oT[2];
#pragma unroll
        for (int tt = 0; tt < 2; ++tt) {
#pragma unroll
            for (int r = 0; r < 16; ++r) oT[tt][r] = 0.f;
            const int t = 32 * tt + lq;
#pragma unroll
            for (int kt = 0; kt < 4; ++kt)
#pragma unroll
                for (int s = 0; s < 2; ++s) {
                    u32x4 aw; aw.x = cvtpk(S[kt][8 * s + 0], S[kt][8 * s + 1]); aw.y = cvtpk(S[kt][8 * s + 2], S[kt][8 * s + 3]); aw.z = cvtpk(S[kt][8 * s + 4], S[kt][8 * s + 5]); aw.w = cvtpk(S[kt][8 * s + 6], S[kt][8 * s + 7]);
                    const u32x2 qlo = *(const LAS u32x2*)(lds + GL_Q + buf * 16384 + gl_q_off(t, 4 * kt + 2 * s) + 8 * hh), qhi = *(const LAS u32x2*)(lds + GL_Q + buf * 16384 + gl_q_off(t, 4 * kt + 2 * s + 1) + 8 * hh);
                    const u32x4 bw = (u32x4){qlo.x, qlo.y, qhi.x, qhi.y};
                    oT[tt] = __builtin_amdgcn_mfma_f32_32x32x16_bf16(__builtin_bit_cast(bf16x8, aw), __builtin_bit_cast(bf16x8, bw), oT[tt], 0, 0, 0);
                    if (s == 1 && (kt & 1)) __builtin_amdgcn_sched_barrier(0); }
        }
        LAS float* redc = (LAS float*)(lds + GL_RED) + buf * 512;
#pragma unroll
        for (int tt = 0; tt < 2; ++tt) { float s = 0.f;
#pragma unroll
            for (int r = 0; r < 16; ++r) s += oT[tt][r] * oT[tt][r];
            s += __shfl_xor(s, 32);
            if (hh == 0) redc[w * 64 + 32 * tt + lq] = s; }
        if (ci < 7) gla_prefetch_vt(F, st, b, h, c + 1);
        u32x2 sr[2][4];
#pragma unroll
        for (int tt = 0; tt < 2; ++tt)
#pragma unroll
            for (int g4 = 0; g4 < 4; ++g4) sr[tt][g4] = *(const u32x2*)(GR + (r0 + 32 * tt + lq) * 1024 + h * 256 + 32 * w + 8 * g4 + 4 * hh);
        __syncthreads();
#pragma unroll
        for (int tt = 0; tt < 2; ++tt) { float tot = 0.f;
#pragma unroll
            for (int ww = 0; ww < 8; ++ww) tot += redc[ww * 64 + 32 * tt + lq];
            const float rstd = __builtin_amdgcn_rsqf(tot * (1.0f / 256.0f) + EPS);
            const size_t row = r0 + 32 * tt + lq;
#pragma unroll
            for (int g4 = 0; g4 < 4; ++g4) { const int v0 = h * 256 + 32 * w + 8 * g4 + 4 * hh;
                const f32x4 go = *(const f32x4*)(g_o + v0);
                const float o0 = oT[tt][4 * g4 + 0] * rstd * go[0] * bf_lo(sr[tt][g4].x), o1 = oT[tt][4 * g4 + 1] * rstd * go[1] * bf_hi(sr[tt][g4].x);
                const float o2 = oT[tt][4 * g4 + 2] * rstd * go[2] * bf_lo(sr[tt][g4].y), o3 = oT[tt][4 * g4 + 3] * rstd * go[3] * bf_hi(sr[tt][g4].y);
                u32x2 wv; wv.x = cvtpk(o0, o1); wv.y = cvtpk(o2, o3); *(u32x2*)(GLAN + row * 1024 + v0) = wv; } }
    }
    __syncthreads();
}

constexpr int SB_TILE = 16384, SB_FLAG = 7 * SB_TILE;
typedef short v4i16_t __attribute__((ext_vector_type(4)));
__device__ __forceinline__ s16x4 vtr(const LAS unsigned char* p) { return __builtin_bit_cast(s16x4, __builtin_amdgcn_ds_read_tr16_b64_v4i16((LAS v4i16_t*)p)); }
__device__ __forceinline__ float partner32(float x, int hh) { auto rr = __builtin_amdgcn_permlane32_swap(__float_as_uint(x), __float_as_uint(x), false, false); return __uint_as_float(hh ? rr[0] : rr[1]); }
__device__ __forceinline__ int sbk_off(int key, int chunk) { return key * 128 + ((chunk ^ ((key >> 1) & 7)) << 4); }
__device__ __forceinline__ int sbv_off(int key, int chunk) { return 8192 + key * 128 + ((chunk ^ (((key >> 1) & 1) << 2)) << 4); }

__device__ __forceinline__ void sb_tile(const LAS unsigned char* tile, int kt, int q0, int qabs, int l, const bf16x8 (&qf)[4], f32x16& o0, f32x16& o1, float& carry) {
    const int lq = l & 31, hh = l >> 5;
    f32x16 p0, p1;
#pragma unroll
    for (int r = 0; r < 16; ++r) { p0[r] = 0.f; p1[r] = 0.f; }
#pragma unroll
    for (int s = 0; s < 4; ++s) { const bf16x8 a0 = *(const LAS bf16x8*)(tile + sbk_off(lq, 2 * s + hh)), a1 = *(const LAS bf16x8*)(tile + sbk_off(32 + lq, 2 * s + hh));
        p0 = __builtin_amdgcn_mfma_f32_32x32x16_bf16(a0, qf[s], p0, 0, 0, 0); p1 = __builtin_amdgcn_mfma_f32_32x32x16_bf16(a1, qf[s], p1, 0, 0, 0); }
    const bool diag = (64 * kt + 63 >= q0);
    float Lh[2][16];
#pragma unroll
    for (int half = 0; half < 2; ++half)
#pragma unroll
        for (int r = 0; r < 16; ++r) { const float z = half ? p1[r] : p0[r];
            float L = fmaxf(z, 0.f) + __builtin_amdgcn_logf(1.0f + __builtin_amdgcn_exp2f(-fabsf(z)));
            if (diag) { const int key = 64 * kt + 32 * half + (r & 3) + 8 * (r >> 2) + 4 * hh; if (key >= qabs) L = 0.f; }
            Lh[half][r] = L; }
    float tot[8];
#pragma unroll
    for (int half = 0; half < 2; ++half)
#pragma unroll
        for (int g4 = 0; g4 < 4; ++g4) { float* Lg = &Lh[half][4 * g4]; Lg[2] += Lg[3]; Lg[1] += Lg[2]; Lg[0] += Lg[1]; tot[4 * half + g4] = Lg[0]; }
    float E[8]; float run = carry;
#pragma unroll
    for (int m = 7; m >= 0; --m) { const float tp = partner32(tot[m], hh); E[m] = run + (hh ? 0.f : tp); run += tot[m] + tp; }
    carry = run;
    u32x4 pw[2][2];
#pragma unroll
    for (int half = 0; half < 2; ++half)
#pragma unroll
        for (int s = 0; s < 2; ++s) { float wv[8];
#pragma unroll
            for (int j = 0; j < 8; ++j) { const int r = 8 * s + j; const float z = half ? p1[r] : p0[r];
                float wgt = __builtin_amdgcn_exp2f(z - (E[4 * half + (r >> 2)] + Lh[half][r]));
                if (diag) { const int key = 64 * kt + 32 * half + (r & 3) + 8 * (r >> 2) + 4 * hh; if (key >= qabs) wgt = 0.f; }
                wv[j] = wgt; }
            pw[half][s] = (u32x4){cvtpk(wv[0], wv[1]), cvtpk(wv[2], wv[3]), cvtpk(wv[4], wv[5]), cvtpk(wv[6], wv[7])}; }
    const int g1 = (l >> 4) & 1, i = l & 15;
#pragma unroll
    for (int half = 0; half < 2; ++half)
#pragma unroll
        for (int s = 0; s < 2; ++s) { const bf16x8 pb = __builtin_bit_cast(bf16x8, pw[half][s]);
            const int k0 = 32 * half + 16 * s + 4 * hh + (i >> 2), k1 = k0 + 8;
#pragma unroll
            for (int dt = 0; dt < 2; ++dt) { const int ch = 4 * dt + 2 * g1 + ((i & 3) >> 1);
                const s16x4 lo = vtr(tile + sbv_off(k0, ch) + 8 * (i & 1)), hi = vtr(tile + sbv_off(k1, ch) + 8 * (i & 1));
                const bf16x8 a = (bf16x8){lo[0], lo[1], lo[2], lo[3], hi[0], hi[1], hi[2], hi[3]};
                if (dt == 0) o0 = __builtin_amdgcn_mfma_f32_32x32x16_bf16(a, pb, o0, 0, 0, 0); else o1 = __builtin_amdgcn_mfma_f32_32x32x16_bf16(a, pb, o1, 0, 0, 0); } }
}

__device__ __forceinline__ void sb_attn_unit(Frame& F, int uidx) {
    const int bh = uidx >> 4, qb = uidx & 15, b = bh >> 4, h = bh & 15;
    LAS unsigned char* lds = F.lds + RING_OFF;
    volatile LAS unsigned* flags = (volatile LAS unsigned*)(lds + SB_FLAG);
    const int tid = F.tid, w = F.wave, l = F.lane, lq = l & 31, hh = l >> 5;
    bf16_t* SQ = WSP(bf16_t, WS_SQ); const bf16_t* SK = WSP(bf16_t, WS_SK); const bf16_t* SV = WSP(bf16_t, WS_SV);
    const size_t rowbase = (size_t)b * SEQ;
    const int q0 = qb * 256 + 32 * w, qabs = q0 + lq;
    const int kt_hi = qb * 4 + 3, kt_lo = (qb * 4 - 3) > 0 ? (qb * 4 - 3) : 0, nwin = kt_hi - kt_lo + 1;
    const int skey = tid >> 3, sch = tid & 7;
    const bf16_t* kg = SK + (rowbase + skey) * 1024 + h * 64 + sch * 8;
    const bf16_t* vg = SV + (rowbase + skey) * 1024 + h * 64 + sch * 8;
    __syncthreads();
    { u32x4 kr[7], vr[7];
#pragma unroll
      for (int j = 0; j < 7; ++j) if (j < nwin) { kr[j] = *(const u32x4*)(kg + (size_t)(kt_lo + j) * 64 * 1024); vr[j] = *(const u32x4*)(vg + (size_t)(kt_lo + j) * 64 * 1024); }
#pragma unroll
      for (int j = 0; j < 7; ++j) if (j < nwin) { *(LAS u32x4*)(lds + j * SB_TILE + sbk_off(skey, sch)) = kr[j]; *(LAS u32x4*)(lds + j * SB_TILE + sbv_off(skey, sch)) = vr[j]; } }
    bf16x8 qf[4];
    { const bf16_t* qrow = SQ + (rowbase + qabs) * 1024 + h * 64;
#pragma unroll
      for (int s = 0; s < 4; ++s) qf[s] = *(const bf16x8*)(qrow + 16 * s + 8 * hh); }
    f32x16 o0, o1;
#pragma unroll
    for (int r = 0; r < 16; ++r) { o0[r] = 0.f; o1[r] = 0.f; }
    float carry = 0.f;
    __syncthreads();
    bool done = false;
    for (int kt = (q0 + 30) >> 6; kt >= kt_lo; --kt) {
        sb_tile(lds + (kt - kt_lo) * SB_TILE, kt, q0, qabs, l, qf, o0, o1, carry);
        if (__all(carry > 150.0f)) { done = true; break; }
    }
    if (kt_lo == 0) done = true;
    if (l == 0) flags[w] = done ? 1u : 0u;
    __syncthreads();
    bool alld = true;
#pragma unroll
    for (int i = 0; i < 8; ++i) alld = alld && (flags[i] != 0u);
    if (!alld) {
        for (int kt = kt_lo - 1; kt >= 0; --kt) {
            const u32x4 kr = *(const u32x4*)(kg + (size_t)kt * 64 * 1024), vr = *(const u32x4*)(vg + (size_t)kt * 64 * 1024);
            __syncthreads();
            { unsigned a = 1u;
#pragma unroll
              for (int i = 0; i < 8; ++i) a &= flags[i];
              if (a) break; }
            *(LAS u32x4*)(lds + sbk_off(skey, sch)) = kr; *(LAS u32x4*)(lds + sbv_off(skey, sch)) = vr;
            __syncthreads();
            if (!done) { sb_tile(lds, kt, q0, qabs, l, qf, o0, o1, carry); if (__all(carry > 150.0f) || kt == 0) done = true; }
            if (l == 0) flags[w] = done ? 1u : 0u;
        }
    }
    if (!F.dry) { bf16_t* orow = SQ + (rowbase + qabs) * 1024 + h * 64;
#pragma unroll
      for (int g4 = 0; g4 < 4; ++g4) { u32x2 a, c2; a.x = cvtpk(o0[4 * g4], o0[4 * g4 + 1]); a.y = cvtpk(o0[4 * g4 + 2], o0[4 * g4 + 3]); c2.x = cvtpk(o1[4 * g4], o1[4 * g4 + 1]); c2.y = cvtpk(o1[4 * g4 + 2], o1[4 * g4 + 3]);
          *(u32x2*)(orow + 8 * g4 + 4 * hh) = a; *(u32x2*)(orow + 32 + 8 * g4 + 4 * hh) = c2; } }
}
__device__ __forceinline__ void phase_attn_a(Frame& F) {
    if (F.vcu < 128) { gla_stage1(F, F.vcu); sb_attn_unit(F, F.vcu); }
    else { sb_attn_unit(F, 128 + (F.vcu - 128) * 2); sb_attn_unit(F, 128 + (F.vcu - 128) * 2 + 1); }
    __syncthreads();
}
__device__ __forceinline__ void phase_attn_b(Frame& F) {
    if (F.vcu < 128) { gla_stage3(F, F.vcu); sb_attn_unit(F, 384 + F.vcu * 2); sb_attn_unit(F, 384 + F.vcu * 2 + 1); }
    else { sb_attn_unit(F, 640 + (F.vcu - 128) * 3); sb_attn_unit(F, 640 + (F.vcu - 128) * 3 + 1); sb_attn_unit(F, 640 + (F.vcu - 128) * 3 + 2); }
    __syncthreads();
}
__device__ __forceinline__ int okey(float v, int tag, int mask) { int u = __float_as_int(v); u ^= (u >> 31) & 0x7fffffff; return (u & ~mask) | tag; }
__device__ __forceinline__ float okey_val(int key, int mask) { int u = key & ~mask; u ^= (u >> 31) & 0x7fffffff; return __int_as_float(u); }
#define INS16(Lst, xin) do { int _x = (xin); _Pragma("unroll") for (int _j = 0; _j < 16; ++_j) { const int _h = max(Lst[_j], _x); _x = min(Lst[_j], _x); Lst[_j] = _h; } } while (0)

#define CEX(a, b) do { const int _hi = max(a, b), _lo = min(a, b); a = _hi; b = _lo; } while (0)
#define BITONIC16(K) do { \
    _Pragma("unroll") for (int _i = 0; _i < 8; ++_i) CEX(K[_i], K[_i + 8]); \
    _Pragma("unroll") for (int _b = 0; _b < 16; _b += 8) _Pragma("unroll") for (int _i = 0; _i < 4; ++_i) CEX(K[_b + _i], K[_b + _i + 4]); \
    _Pragma("unroll") for (int _b = 0; _b < 16; _b += 4) _Pragma("unroll") for (int _i = 0; _i < 2; ++_i) CEX(K[_b + _i], K[_b + _i + 2]); \
    _Pragma("unroll") for (int _b = 0; _b < 16; _b += 2) CEX(K[_b], K[_b + 1]); } while (0)
__device__ __forceinline__ int swap32i(int x) { auto r = __builtin_amdgcn_permlane32_swap((unsigned)x, (unsigned)x, false, false); return (int)((__builtin_amdgcn_mbcnt_hi(~0u, __builtin_amdgcn_mbcnt_lo(~0u, 0u)) & 32) ? r[0] : r[1]); }

__device__ __forceinline__ void phase_peer_retrieve(Frame& F) {
    const bf16_t* Q = WSP(bf16_t, WS_Q); const bf16_t* KB = WSP(bf16_t, WS_KD); unsigned* EXPO = WSP(unsigned, WS_EXP);
    LAS unsigned char* idxb = F.lds + RING_OFF + F.wave * 2048;
    const int l = F.lane, lq = l & 31, hh = l >> 5;
    const int ntok_wg = T_TOK / F.G;
#pragma unroll 1
    for (int it = F.wave; it < (ntok_wg / 32) * 8; it += NWAVES) {
        const int tg = it >> 3, h = it & 7;
        const int t = F.vcu * ntok_wg + tg * 32 + lq;
        int XY[2][16];
#pragma unroll
        for (int half = 0; half < 2; ++half) {
            bf16x8 qf[8];
            { const bf16_t* qp = Q + (size_t)t * 2048 + h * 256 + half * 128 + 8 * hh;
#pragma unroll
              for (int s = 0; s < 8; ++s) qf[s] = *(const bf16x8*)(qp + 16 * s); }
            int L[16];
#pragma unroll
            for (int j = 0; j < 16; ++j) L[j] = INT_MIN;
            const bf16_t* kp = KB + (size_t)(h * 2 + half) * 16384 + (size_t)lq * 128 + 8 * hh;
#pragma unroll 1
            for (int tile = 0; tile < 4; ++tile) {
                f32x16 acc;
#pragma unroll
                for (int r = 0; r < 16; ++r) acc[r] = 0.f;
#pragma unroll
                for (int s = 0; s < 8; ++s) { const bf16x8 a = *(const bf16x8*)(kp + (size_t)tile * 32 * 128 + 16 * s); acc = __builtin_amdgcn_mfma_f32_32x32x16_bf16(a, qf[s], acc, 0, 0, 0); }
#pragma unroll
                for (int r = 0; r < 16; ++r) { const int key = 32 * tile + (r & 3) + 8 * (r >> 2) + 4 * hh; INS16(L, okey(acc[r], 127 - key, 127)); }
            }
#pragma unroll
            for (int k = 0; k < 8; ++k) { const int a = swap32i(L[15 - k]), b = swap32i(L[k]); L[k] = max(L[k], a); L[15 - k] = max(L[15 - k], b); }
            BITONIC16(L);
#pragma unroll
            for (int j = 0; j < 16; ++j) XY[half][j] = L[j];
        }
        { u32x4 pk[2];
#pragma unroll
          for (int half = 0; half < 2; ++half) { const int* L = XY[half];
            pk[half].x = (unsigned)(127 - (L[0] & 127)) | ((unsigned)(127 - (L[1] & 127)) << 8) | ((unsigned)(127 - (L[2] & 127)) << 16) | ((unsigned)(127 - (L[3] & 127)) << 24);
            pk[half].y = (unsigned)(127 - (L[4] & 127)) | ((unsigned)(127 - (L[5] & 127)) << 8) | ((unsigned)(127 - (L[6] & 127)) << 16) | ((unsigned)(127 - (L[7] & 127)) << 24);
            pk[half].z = (unsigned)(127 - (L[8] & 127)) | ((unsigned)(127 - (L[9] & 127)) << 8) | ((unsigned)(127 - (L[10] & 127)) << 16) | ((unsigned)(127 - (L[11] & 127)) << 24);
            pk[half].w = (unsigned)(127 - (L[12] & 127)) | ((unsigned)(127 - (L[13] & 127)) << 8) | ((unsigned)(127 - (L[14] & 127)) << 16) | ((unsigned)(127 - (L[15] & 127)) << 24); }
          *(LAS u32x4*)(idxb + l * 32) = pk[0]; *(LAS u32x4*)(idxb + l * 32 + 16) = pk[1]; }
        float X[16], Y[16];
#pragma unroll
        for (int j = 0; j < 16; ++j) { X[j] = okey_val(XY[0][j], 127); Y[j] = okey_val(XY[1][j], 127); }
        int M[16];
#pragma unroll
        for (int j = 0; j < 16; ++j) M[j] = INT_MIN;
#define CAND(i, j) do { const float sm = hh ? (X[j] + Y[i]) : (X[i] + Y[j]); const int pos = hh ? ((j) * 16 + (i)) : ((i) * 16 + (j)); int key = okey(sm, 255 - pos, 255); if ((i) == (j) && hh) key = INT_MIN; INS16(M, key); } while (0)
        CAND(0, 0); CAND(0, 1); CAND(0, 2); CAND(0, 3); CAND(0, 4); CAND(0, 5); CAND(0, 6); CAND(0, 7); CAND(0, 8); CAND(0, 9); CAND(0, 10); CAND(0, 11); CAND(0, 12); CAND(0, 13); CAND(0, 14); CAND(0, 15);
        CAND(1, 1); CAND(1, 2); CAND(1, 3); CAND(1, 4); CAND(1, 5); CAND(1, 6); CAND(1, 7);
        CAND(2, 2); CAND(2, 3); CAND(2, 4);
        CAND(3, 3);
#undef CAND
        int TK[16];
#pragma unroll
        for (int k = 0; k < 16; ++k) TK[k] = max(M[k], swap32i(M[15 - k]));
        float sv[16]; float mx = -INFINITY;
#pragma unroll
        for (int k = 0; k < 16; ++k) { sv[k] = okey_val(TK[k], 255); mx = fmaxf(mx, sv[k]); }
        float den = 0.f;
#pragma unroll
        for (int k = 0; k < 16; ++k) { sv[k] = __expf(sv[k] - mx); den += sv[k]; }
        const float rden = 1.0f / den;
        LDS_WAIT(); asm volatile("" ::: "memory");
        const LAS unsigned char* ib = idxb + l * 32;
        unsigned* dst = EXPO + (size_t)t * 128 + h * 16 + hh * 8;
        u32x4 o0, o1; unsigned ov[8];
#pragma unroll
        for (int k = 0; k < 8; ++k) { const int pos = 255 - (TK[k] & 255); const unsigned i1 = ib[pos >> 4], i2 = ib[16 + (pos & 15)];
            ov[k] = (__float_as_uint(sv[k] * rden) & ~0x3fffu) | (i1 * 128u + i2); }
        o0 = (u32x4){ov[0], ov[1], ov[2], ov[3]}; o1 = (u32x4){ov[4], ov[5], ov[6], ov[7]};
        *(u32x4*)dst = o0; *(u32x4*)(dst + 4) = o1;
        LDS_WAIT(); asm volatile("" ::: "memory");
    }
}

__device__ __forceinline__ void cvt_rows_fp8(Frame& F, const float* src, unsigned char* dst, float* rscale) {
    const int l = F.lane; const int gw = F.vcu * NWAVES + F.wave, NGW = F.G * NWAVES;
    for (int e = gw; e < 16384; e += NGW) {
        const f32x4* sp = (const f32x4*)(src + (size_t)e * 1024 + 16 * l);
        const f32x4 a = sp[0], b = sp[1], c = sp[2], d = sp[3];
        float m = fmaxf(fmaxf(fmaxf(fabsf(a[0]), fabsf(a[1])), fmaxf(fabsf(a[2]), fabsf(a[3]))), fmaxf(fmaxf(fabsf(b[0]), fabsf(b[1])), fmaxf(fabsf(b[2]), fabsf(b[3]))));
        m = fmaxf(m, fmaxf(fmaxf(fmaxf(fabsf(c[0]), fabsf(c[1])), fmaxf(fabsf(c[2]), fabsf(c[3]))), fmaxf(fmaxf(fabsf(d[0]), fabsf(d[1])), fmaxf(fabsf(d[2]), fabsf(d[3])))));
#pragma unroll
        for (int o = 1; o < 64; o <<= 1) m = fmaxf(m, __shfl_xor(m, o));
        const float t = 448.0f / fmaxf(m, 1e-30f); const float s = __uint_as_float(__float_as_uint(t) & 0x7f800000u);
        u32x4 w; int x;
        x = __builtin_amdgcn_cvt_pk_fp8_f32(a[0] * s, a[1] * s, 0, false); x = __builtin_amdgcn_cvt_pk_fp8_f32(a[2] * s, a[3] * s, x, true); w.x = (unsigned)x;
        x = __builtin_amdgcn_cvt_pk_fp8_f32(b[0] * s, b[1] * s, 0, false); x = __builtin_amdgcn_cvt_pk_fp8_f32(b[2] * s, b[3] * s, x, true); w.y = (unsigned)x;
        x = __builtin_amdgcn_cvt_pk_fp8_f32(c[0] * s, c[1] * s, 0, false); x = __builtin_amdgcn_cvt_pk_fp8_f32(c[2] * s, c[3] * s, x, true); w.z = (unsigned)x;
        x = __builtin_amdgcn_cvt_pk_fp8_f32(d[0] * s, d[1] * s, 0, false); x = __builtin_amdgcn_cvt_pk_fp8_f32(d[2] * s, d[3] * s, x, true); w.w = (unsigned)x;
        *(u32x4*)(dst + (size_t)e * 1024 + 16 * l) = w;
        if (l == 0) rscale[e] = 1.0f / s;
    }
}

__device__ __forceinline__ float gelu_tanh(float x) { const float y = 0.7978845608028654f * (x + 0.044715f * x * x * x); return x * __builtin_amdgcn_rcpf(1.0f + __expf(-2.0f * y)); }
#define FP8_UNPACK16(W, f) do { f32x2 _t; \
    _t = __builtin_amdgcn_cvt_pk_f32_fp8((int)(W).x, false); f[0] = _t[0]; f[1] = _t[1]; _t = __builtin_amdgcn_cvt_pk_f32_fp8((int)(W).x, true); f[2] = _t[0]; f[3] = _t[1]; \
    _t = __builtin_amdgcn_cvt_pk_f32_fp8((int)(W).y, false); f[4] = _t[0]; f[5] = _t[1]; _t = __builtin_amdgcn_cvt_pk_f32_fp8((int)(W).y, true); f[6] = _t[0]; f[7] = _t[1]; \
    _t = __builtin_amdgcn_cvt_pk_f32_fp8((int)(W).z, false); f[8] = _t[0]; f[9] = _t[1]; _t = __builtin_amdgcn_cvt_pk_f32_fp8((int)(W).z, true); f[10] = _t[0]; f[11] = _t[1]; \
    _t = __builtin_amdgcn_cvt_pk_f32_fp8((int)(W).w, false); f[12] = _t[0]; f[13] = _t[1]; _t = __builtin_amdgcn_cvt_pk_f32_fp8((int)(W).w, true); f[14] = _t[0]; f[15] = _t[1]; } while (0)
__device__ __forceinline__ float sum_swap32(float a, float b) { auto r = __builtin_amdgcn_permlane32_swap(__float_as_uint(a), __float_as_uint(b), false, false); return __uint_as_float(r[0]) + __uint_as_float(r[1]); }
__device__ __forceinline__ float sum_swap16(float a, float b) { auto r = __builtin_amdgcn_permlane16_swap(__float_as_uint(a), __float_as_uint(b), false, false); return __uint_as_float(r[0]) + __uint_as_float(r[1]); }
__device__ __forceinline__ void phase_peer_gather(Frame& F) {
    const unsigned char* UB = WSP(unsigned char, WS_UB8); const unsigned char* VB = WSP(unsigned char, WS_VB8); const float* RSU = WSP(float, WS_RSU); const float* RSV = WSP(float, WS_RSV);
    const unsigned* EXPO = WSP(unsigned, WS_EXP);
    const bf16_t* H1G = WSP(bf16_t, WS_H1G); bf16_t* XN3 = WSP(bf16_t, WS_XN3); const float* H1 = WSP(float, WS_H1); float* H2 = F.out; const float* SSQ1 = WSP(float, WS_SSQ1); const float* g_ple = F.in[16];
    const int l = F.lane; const int ntok_wg = T_TOK / F.G;
    for (int ti = F.wave; ti < ntok_wg; ti += NWAVES) { const int t = F.vcu * ntok_wg + ti;
        float x[16];
        { const u32x4 xa = *(const u32x4*)(H1G + (size_t)t * 1024 + 16 * l), xb = *(const u32x4*)(H1G + (size_t)t * 1024 + 16 * l + 8);
          x[0] = bf_lo(xa.x); x[1] = bf_hi(xa.x); x[2] = bf_lo(xa.y); x[3] = bf_hi(xa.y); x[4] = bf_lo(xa.z); x[5] = bf_hi(xa.z); x[6] = bf_lo(xa.w); x[7] = bf_hi(xa.w);
          x[8] = bf_lo(xb.x); x[9] = bf_hi(xb.x); x[10] = bf_lo(xb.y); x[11] = bf_hi(xb.y); x[12] = bf_lo(xb.z); x[13] = bf_hi(xb.z); x[14] = bf_lo(xb.w); x[15] = bf_hi(xb.w); }
        float rstd1; { const f32x4* sp = (const f32x4*)(SSQ1 + (size_t)t * 16); const f32x4 st = (sp[0] + sp[1]) + (sp[2] + sp[3]); rstd1 = __builtin_amdgcn_rsqf(((st[0] + st[1]) + (st[2] + st[3])) * (1.0f / 1024.0f) + EPS); }
        const unsigned e0 = EXPO[(size_t)t * 128 + l], e1 = EXPO[(size_t)t * 128 + 64 + l];
        const float cu0 = RSU[e0 & 0x3fffu] * rstd1, cu1 = RSU[e1 & 0x3fffu] * rstd1;
        const float cv0 = RSV[e0 & 0x3fffu] * __uint_as_float(e0 & ~0x3fffu), cv1 = RSV[e1 & 0x3fffu] * __uint_as_float(e1 & ~0x3fffu);
        float acc[16];
#pragma unroll
        for (int i = 0; i < 16; ++i) acc[i] = 0.f;
#pragma unroll 1
        for (int eb = 0; eb < 128; eb += 16) {
            u32x4 uw[16], vw[16];
#pragma unroll
            for (int k = 0; k < 16; ++k) { const int e = eb + k; const unsigned ent = (e < 64) ? __builtin_amdgcn_readlane(e0, e & 63) : __builtin_amdgcn_readlane(e1, e & 63);
                const size_t ro = (size_t)(ent & 0x3fffu) * 1024 + 16 * l; uw[k] = *(const u32x4*)(UB + ro); vw[k] = *(const u32x4*)(VB + ro); }
            float p[16];
#pragma unroll
            for (int k = 0; k < 16; ++k) { float f[16]; FP8_UNPACK16(uw[k], f); float s = 0.f;
#pragma unroll
                for (int i = 0; i < 16; ++i) s += f[i] * x[i];
                p[k] = s; }
            float q8[8], q4[4], q2[2], q1;
#pragma unroll
            for (int j = 0; j < 8; ++j) q8[j] = sum_swap32(p[j], p[8 + j]);
#pragma unroll
            for (int j = 0; j < 4; ++j) q4[j] = sum_swap16(q8[j], q8[4 + j]);
            { const bool up = (l & 8) != 0;
#pragma unroll
              for (int j = 0; j < 2; ++j) { const float keep = up ? q4[2 + j] : q4[j], send = up ? q4[j] : q4[2 + j]; q2[j] = keep + __shfl_xor(send, 8); } }
            { const bool up = (l & 4) != 0; const float keep = up ? q2[1] : q2[0], send = up ? q2[0] : q2[1]; q1 = keep + __shfl_xor(send, 4); }
            q1 += __shfl_xor(q1, 2); q1 += __shfl_xor(q1, 1);
            const int ei = eb + (l >> 2);
            const float cu = (ei < 64) ? __shfl(cu0, ei & 63) : __shfl(cu1, ei & 63), cv = (ei < 64) ? __shfl(cv0, ei & 63) : __shfl(cv1, ei & 63);
            const float a = gelu_tanh(q1 * cu) * cv;
#pragma unroll
            for (int k = 0; k < 16; ++k) { const float ak = __uint_as_float(__builtin_amdgcn_readlane(__float_as_uint(a), 4 * k)); float f[16]; FP8_UNPACK16(vw[k], f);
#pragma unroll
                for (int i = 0; i < 16; ++i) acc[i] += ak * f[i]; }
        }
        const float* hrow = H1 + (size_t)t * 1024 + 16 * l; float* h2row = H2 + (size_t)t * 1024 + 16 * l; float ss = 0.f; f32x4 h[4];
#pragma unroll
        for (int q = 0; q < 4; ++q) { h[q] = *(const f32x4*)(hrow + 4 * q);
#pragma unroll
            for (int j = 0; j < 4; ++j) { h[q][j] += acc[4 * q + j]; ss += h[q][j] * h[q][j]; }
            *(f32x4*)(h2row + 4 * q) = h[q]; }
        const float rstd3 = __builtin_amdgcn_rsqf(wave_sum(ss) * (1.0f / 1024.0f) + EPS);
        u32x4 o[2];
#pragma unroll
        for (int q2 = 0; q2 < 2; ++q2) { const f32x4 g0 = *(const f32x4*)(g_ple + 16 * l + 8 * q2), g1 = *(const f32x4*)(g_ple + 16 * l + 8 * q2 + 4);
            const f32x4 a = h[2 * q2] * rstd3 * g0, c = h[2 * q2 + 1] * rstd3 * g1;
            o[q2].x = cvtpk(a[0], a[1]); o[q2].y = cvtpk(a[2], a[3]); o[q2].z = cvtpk(c[0], c[1]); o[q2].w = cvtpk(c[2], c[3]); }
        *(u32x4*)(XN3 + (size_t)t * 1024 + 16 * l) = o[0]; *(u32x4*)(XN3 + (size_t)t * 1024 + 16 * l + 8) = o[1];
    }
}

__device__ __forceinline__ void phase_final(Frame& F) {
    const float* SSQ3 = WSP(float, WS_SSQ3); const float* g = F.in[19];
    const int l = F.lane; const int gw = F.vcu * NWAVES + F.wave, NGW = F.G * NWAVES;
    for (int t = gw; t < T_TOK; t += NGW) {
        const f32x4* sp = (const f32x4*)(SSQ3 + (size_t)t * 16); const f32x4 st = (sp[0] + sp[1]) + (sp[2] + sp[3]);
        const float rstd = __builtin_amdgcn_rsqf(((st[0] + st[1]) + (st[2] + st[3])) * (1.0f / 1024.0f) + EPS);
        f32x4* row = (f32x4*)(F.out + (size_t)t * 1024);
#pragma unroll
        for (int j = 0; j < 4; ++j) { const f32x4 gv = *((const f32x4*)g + l + 64 * j); const f32x4 o = row[l + 64 * j] * rstd * gv; if (!F.dry) row[l + 64 * j] = o; }
    }
}
#ifndef MK_FUSED
#define MK_FUSED 1
#endif
constexpr int NPHASE = 11;
struct Args { const float* in[20]; float* out; unsigned char* ws; int ph_lo, ph_hi, dry, pad; };
static_assert(sizeof(Args) == 20 * 8 + 8 + 8 + 4 * 4, "Args has no padding");

__global__ void __launch_bounds__(NWAVES * 64, 2) mk_fwd(Args args) {
    extern __shared__ __attribute__((aligned(16))) unsigned char lds_raw[];
    Frame F;
    F.lds = (LAS unsigned char*)lds_raw;
    F.wave = __builtin_amdgcn_readfirstlane(threadIdx.x >> 6); F.lane = lane_id(); F.tid = F.wave * 64 + F.lane;
    F.G = gridDim.x; { const int bx = blockIdx.x; F.vcu = (F.G % 8 == 0) ? (bx % 8) * (F.G / 8) + bx / 8 : bx; }
    F.in = args.in; F.out = args.out; F.ws = args.ws; F.dry = args.dry;
    volatile LAS unsigned* MISC = (volatile LAS unsigned*)(F.lds + MISC_OFF);
    if (F.tid < 64) MISC[F.tid] = 0u;
    __syncthreads();
    const int lo = args.ph_lo, hi = args.ph_hi;
    XcdBarrier bar; bar.bar = (unsigned*)(F.ws + WS_CTL) + CW_BAR; bar.x = 0; bar.st = nullptr;
    if (hi - lo > 1) bar = xcd_barrier_post((unsigned*)(F.ws + WS_CTL) + CW_BAR, MISC + 8);
#ifndef PH_MASK
#define PH_MASK 0xFFFFFFFFu
#endif
#define IN(k) (((PH_MASK >> (k)) & 1u) && lo <= (k) && (k) < hi)
#define LAUNDER(p, T) do { unsigned _lo = (unsigned)(unsigned long long)(p), _hi = (unsigned)((unsigned long long)(p) >> 32); asm volatile("" : "+v"(_lo), "+v"(_hi)); \
        _lo = __builtin_amdgcn_readfirstlane(_lo); _hi = __builtin_amdgcn_readfirstlane(_hi); (p) = (T)(((unsigned long long)_hi << 32) | _lo); } while (0)
#define SEAM(k) do { if (IN(k) && IN((k) + 1)) xcd_barrier(bar); LAUNDER(F.ws, unsigned char*); LAUNDER(F.out, float*); F.lane = lane_id(); F.tid = F.wave * 64 + F.lane; } while (0)
    const int bx = (int)blockIdx.x;
    LAS unsigned char* ring = F.lds + RING_OFF;

    if (IN(0)) { phase_prologue(F); } SEAM(0);
    if (IN(1)) {
        pg8::Gemm g{WSP(bf16_t, WS_XN1), WSP(bf16_t, WS_WIN), T_TOK, 8192, 1024, 1024, 0}; pg8::StaticOrder S; S.init(T_TOK, 8192, F.G, bx);
        pg8::EpiProj E{WSP(bf16_t, WS_GQ), WSP(bf16_t, WS_GK), WSP(bf16_t, WS_GV), WSP(bf16_t, WS_GR), WSP(bf16_t, WS_SQ), WSP(bf16_t, WS_SK), WSP(bf16_t, WS_SV),
                       (bf16_t*)F.out, (bf16_t*)F.out + (size_t)T_TOK * 1024};
        pg8::gemm_phase<pg8::EpiProj>(ring, g, S, E, F.tid);
    } SEAM(1);
    if (IN(2)) { phase_gla_prep(F); } SEAM(2);
    if (IN(3)) { phase_attn_a(F); } SEAM(3);
    if (IN(4)) { phase_attn_b(F); } SEAM(4);
    if (IN(5)) {
        cvt_rows_fp8(F, F.in[14], WSP(unsigned char, WS_UB8), WSP(float, WS_RSU));
        cvt_rows_fp8(F, F.in[15], WSP(unsigned char, WS_VB8), WSP(float, WS_RSV));
        VM_WAIT(); __syncthreads();
        pg8::StaticOrder S; S.init(T_TOK, 1024, F.G, bx);
        { pg8::Gemm g{WSP(bf16_t, WS_GLAN), WSP(bf16_t, WS_WGA), T_TOK, 1024, 1024, 1024, 0}; pg8::EpiMix<true> E{(const bf16_t*)F.out, WSP(bf16_t, WS_MIX)};
          pg8::gemm_phase<pg8::EpiMix<true>>(ring, g, S, E, F.tid); }
        { pg8::Gemm g{WSP(bf16_t, WS_SQ), WSP(bf16_t, WS_WSB), T_TOK, 1024, 1024, 1024, 0}; pg8::EpiMix<false> E{(const bf16_t*)F.out + (size_t)T_TOK * 1024, WSP(bf16_t, WS_MIX)};
          pg8::gemm_phase<pg8::EpiMix<false>>(ring, g, S, E, F.tid); }
    } SEAM(5);
    if (IN(6)) {
        pg8::Gemm g{WSP(bf16_t, WS_MIX), WSP(bf16_t, WS_WO), T_TOK, 1024, 1024, 1024, 0}; pg8::StaticOrder S; S.init(T_TOK, 1024, F.G, bx);
        pg8::EpiH1 E{F.in[0], F.in[10], WSP(float, WS_H1), WSP(bf16_t, WS_H1G), WSP(float, WS_SSQ1)};
        pg8::gemm_phase<pg8::EpiH1>(ring, g, S, E, F.tid);
    } SEAM(6);
    if (IN(7)) {
        pg8::Gemm g{WSP(bf16_t, WS_H1G), WSP(bf16_t, WS_WPQ), T_TOK, 2048, 1024, 1024, 0}; pg8::StaticOrder S; S.init(T_TOK, 2048, F.G, bx);
        pg8::EpiQ E{WSP(float, WS_SSQ1), WSP(bf16_t, WS_Q), 2048};
        pg8::gemm_phase<pg8::EpiQ>(ring, g, S, E, F.tid);
    } SEAM(7);
    if (IN(8)) {
        cvt_copy(F, F.in[1], WSP(bf16_t, WS_PB), (size_t)T_TOK * 256);
        phase_peer_retrieve(F);
        VM_WAIT(); __syncthreads();
        phase_peer_gather(F);
    } SEAM(8);
    if (IN(9)) {
        pg8::StaticOrder S; S.init(T_TOK, 1024, F.G, bx);
        { pg8::Gemm g{WSP(bf16_t, WS_PB), WSP(bf16_t, WS_WPLE), T_TOK, 1024, 256, 256, 0}; pg8::EpiBf E{WSP(bf16_t, WS_PLE), 1024};
          pg8::gemm_phase<pg8::EpiBf>(ring, g, S, E, F.tid); }
        { pg8::Gemm g{WSP(bf16_t, WS_XN3), WSP(bf16_t, WS_WPG), T_TOK, 1024, 1024, 1024, 0}; pg8::EpiH3 E{F.out, WSP(bf16_t, WS_PLE), F.out, WSP(float, WS_SSQ3), F.dry};
          pg8::gemm_phase<pg8::EpiH3>(ring, g, S, E, F.tid); }
    } SEAM(9);
    if (IN(10)) { phase_final(F); }
#undef IN
#undef SEAM
}

extern "C" void kernel_launch(void* const* d_in, const int* in_sizes, int n_in, void* d_out, int out_size, void* d_ws, size_t ws_size, hipStream_t stream) {
    static int grid = 0;
    if (grid == 0) {
        if (n_in != 20 || in_sizes[0] != T_TOK * 1024 || out_size != T_TOK * 1024 || ws_size < WS_END) {
            fprintf(stderr, "kernel_launch: unexpected shapes (n_in %d, in0 %d, out %d, ws %zu < %zu?); nothing launched\n", n_in, n_in > 0 ? in_sizes[0] : -1, out_size, ws_size, (size_t)WS_END); grid = -1; return; }
        int dev = 0, cus = 0, per_cu = 0;
        if (hipGetDevice(&dev) != hipSuccess || hipDeviceGetAttribute(&cus, hipDeviceAttributeMultiprocessorCount, dev) != hipSuccess) { grid = -1; return; }
        if (hipFuncSetAttribute((const void*)mk_fwd, hipFuncAttributeMaxDynamicSharedMemorySize, LDS_BYTES) != hipSuccess) { fprintf(stderr, "kernel_launch: hipFuncSetAttribute failed\n"); grid = -1; return; }
        if (hipOccupancyMaxActiveBlocksPerMultiprocessor(&per_cu, (const void*)mk_fwd, NWAVES * 64, LDS_BYTES) != hipSuccess || per_cu < 1)
            fprintf(stderr, "kernel_launch: note: occupancy query reports %d workgroups per CU\n", per_cu);
        (void)hipGetLastError();
        grid = cus;
        if (grid != 256) fprintf(stderr, "kernel_launch: note: %d CUs (kernel tuned for 256)\n", grid);
    }
    if (grid < 0) return;
    if (hipMemsetAsync((char*)d_ws + WS_CTL, 0, CTL_ZERO_BYTES, stream) != hipSuccess) { fprintf(stderr, "kernel_launch: hipMemsetAsync failed\n"); return; }
    Args a{};
    for (int i = 0; i < 20; ++i) a.in[i] = (const float*)d_in[i];
    a.out = (float*)d_out; a.ws = (unsigned char*)d_ws;
#if MK_FUSED
    a.ph_lo = 0; a.ph_hi = NPHASE;
    hipLaunchKernelGGL(mk_fwd, dim3(grid), dim3(NWAVES * 64), LDS_BYTES, stream, a);
#else
#ifndef PROBE_PHASE
#define PROBE_PHASE -1
#define PROBE_REPS 0
#endif
    for (int p = 0; p < NPHASE; ++p) { a.ph_lo = p; a.ph_hi = p + 1;
        if (p == PROBE_PHASE) { a.dry = 1; for (int r = 0; r < PROBE_REPS; ++r) hipLaunchKernelGGL(mk_fwd, dim3(grid), dim3(NWAVES * 64), LDS_BYTES, stream, a); a.dry = 0; }
        hipLaunchKernelGGL(mk_fwd, dim3(grid), dim3(NWAVES * 64), LDS_BYTES, stream, a); }
#endif
}
```

```cpp
#define MK_FUSED 1
#include <hip/hip_runtime.h>
#include <cstdio>
#include <cstdint>

#define LAS __attribute__((address_space(3)))
#define GAS __attribute__((address_space(1)))
typedef unsigned short bf16_t;
typedef short bf16x8 __attribute__((ext_vector_type(8)));
typedef short s16x4 __attribute__((ext_vector_type(4)));
typedef float f32x2 __attribute__((ext_vector_type(2)));
typedef float f32x4 __attribute__((ext_vector_type(4)));
typedef float f32x16 __attribute__((ext_vector_type(16)));
typedef unsigned u32x2 __attribute__((ext_vector_type(2)));
typedef unsigned u32x4 __attribute__((ext_vector_type(4)));
typedef __bf16 bf16x2_t __attribute__((ext_vector_type(2)));

__device__ __forceinline__ unsigned cvtpk(float lo, float hi) { f32x2 v = {lo, hi}; bf16x2_t b = __builtin_convertvector(v, bf16x2_t); return __builtin_bit_cast(unsigned, b); }
__device__ __forceinline__ float bf_lo(unsigned u) { return __uint_as_float(u << 16); }
__device__ __forceinline__ float bf_hi(unsigned u) { return __uint_as_float(u & 0xffff0000u); }
__device__ __forceinline__ float bf1(bf16_t u) { return __uint_as_float(((unsigned)u) << 16); }
__device__ __forceinline__ float fast_sigmoid(float x) { return __builtin_amdgcn_rcpf(1.0f + __expf(-x)); }

namespace pg8 {
constexpr int BM = 256, BK = 64, HALF = 128, HTB = HALF * BK * 2  , STAGE_BYTES = 8 * HTB, NXCD = 8, WGM = 8;

__host__ __device__ __forceinline__ int lds_byte(int r, int c) { const int st = (r >> 4) * 2 + (c >> 5), rr = r & 15, cc = c & 31, ob = rr * 64 + cc * 2; return st * 1024 + (ob ^ (((ob >> 9) & 1) << 5)); }
__host__ __device__ __forceinline__ void stage_rc(int b, int& R, int& C) { const int st = b / 1024, sb = b % 1024, swz = sb ^ (((sb >> 9) & 1) << 5); R = (st >> 1) * 16 + swz / 64; C = (st & 1) * 32 + (swz % 64) / 2; }
__host__ __device__ __forceinline__ int perm32(int rho) { const int n = rho >> 4, i = rho & 15; return 8 * (i >> 2) + 4 * n + (i & 3); }

struct Unit { int pm, pn; };
struct Gemm { const bf16_t* A; const bf16_t* Bt; int M, N, K, lda, a_pn_cols; };

struct StaticOrder {
    int nM, nN, nwg, G, c;
    __host__ __device__ void init(int M, int N, int G_, int c_) { nM = M / BM; nN = N / BM; nwg = nM * nN; G = G_; c = c_; }
    __host__ __device__ bool next(int i, Unit& u) const {
        const long L = (long)i * G + c; if (L >= nwg) return false;
        int wgid = (int)L; { const int q = nwg / NXCD, r = nwg % NXCD, xcd = wgid % NXCD, off = wgid / NXCD; wgid = (xcd < r ? xcd * (q + 1) : r * (q + 1) + (xcd - r) * q) + off; }
        const int nig = WGM * nN, gid = wgid / nig, fm = gid * WGM, gsz = (nM - fm) < WGM ? (nM - fm) : WGM;
        u.pm = fm + ((wgid % nig) % gsz); u.pn = (wgid % nig) / gsz; return true;
    }
};

template <class Epi, bool ALIGN_EPI = true, bool SP2 = true>
__device__ __forceinline__ void gemm_phase(LAS unsigned char* lds, const Gemm g, const StaticOrder& S, const Epi& E, int tid) {
    const int wid = __builtin_amdgcn_readfirstlane(tid >> 6), lane = tid & 63, wr = wid >> 2, wc = wid & 3, fr = lane & 15, fq = lane >> 4;
    const int K = g.K, nt = K / BK, lda = g.lda;
    unsigned voffA[2], voffB[2];
#pragma unroll
    for (int i = 0; i < 2; ++i) { int R, C; stage_rc(tid * 16 + i * 8192, R, C); const int Rb = Epi::PERM ? ((R & ~31) + perm32(R & 31)) : R;
        voffA[i] = (unsigned)(R * lda + C) * 2u; voffB[i] = (unsigned)(Rb * K + C) * 2u; }
    const size_t kstep = (size_t)(BK * 2);
    const size_t hA = (size_t)HALF * lda * 2, hB = (size_t)HALF * K * 2;
    const size_t tA = 2 * hA, tB = 2 * hB;
    const size_t pnA = (size_t)g.a_pn_cols * 2;
    const unsigned ldsw = (unsigned)wid * 1024u;
    const int aoff = lds_byte(wr * 64 + fr, fq * 8), boff = lds_byte(wc * 32 + fr, fq * 8);
#define PG8_SA(b, h) (((b) * 2 + (h)) * HTB)
#define PG8_SB(b, h) ((4 + (b) * 2 + (h)) * HTB)
#define PG8_STAGE(bufoff, gbase, voff) do { _Pragma("unroll") for (int _i = 0; _i < 2; ++_i) \
        __builtin_amdgcn_global_load_lds((const unsigned*)((const char*)(gbase) + (voff)[_i]), (LAS unsigned*)(lds + (bufoff) + ldsw + _i * 8192), 16, 0, 0); } while (0)
#define PG8_LDA(dst, b, h) do { _Pragma("unroll") for (int m = 0; m < 4; ++m) _Pragma("unroll") for (int k = 0; k < 2; ++k) dst[m][k] = *(const LAS bf16x8*)(lds + PG8_SA(b, h) + aoff + m * 2048 + k * 1024); } while (0)
#define PG8_LDB(dst, b, h) do { _Pragma("unroll") for (int n = 0; n < 2; ++n) _Pragma("unroll") for (int k = 0; k < 2; ++k) dst[n][k] = *(const LAS bf16x8*)(lds + PG8_SB(b, h) + boff + n * 2048 + k * 1024); } while (0)
#define PG8_MMA(ai, bj, At, Bt) do { __builtin_amdgcn_s_setprio(1); _Pragma("unroll") for (int m = 0; m < 4; ++m) _Pragma("unroll") for (int n = 0; n < 2; ++n) _Pragma("unroll") for (int k = 0; k < 2; ++k) \
        acc[ai][bj][m][n] = __builtin_amdgcn_mfma_f32_16x16x32_bf16(Bt[n][k], At[m][k], acc[ai][bj][m][n], 0, 0, 0); __builtin_amdgcn_s_setprio(0); } while (0)
#define PG8_WAIT_V(n) asm volatile("s_waitcnt vmcnt(" #n ")" ::: "memory")
#define PG8_WAIT_L(n) asm volatile("s_waitcnt lgkmcnt(" #n ")" ::: "memory")
#define PG8_BAR __builtin_amdgcn_s_barrier()
#define PG8_SCHED __builtin_amdgcn_sched_barrier(0)
    Unit cur, nxt; int ui = 0;
    if (!S.next(0, cur)) return;
    f32x4 acc[2][2][4][2];
#pragma unroll
    for (int a = 0; a < 2; ++a)
#pragma unroll
        for (int b = 0; b < 2; ++b)
#pragma unroll
            for (int m = 0; m < 4; ++m)
#pragma unroll
                for (int n = 0; n < 2; ++n) acc[a][b][m][n] = (f32x4){0.f, 0.f, 0.f, 0.f};
    bf16x8 At[4][2], B0[2][2], B1[2][2];
    const char* cA = (const char*)g.A + (size_t)cur.pm * tA + (size_t)cur.pn * pnA; const char* cB = (const char*)g.Bt + (size_t)cur.pn * tB;
    if constexpr (SP2) {
        PG8_STAGE(PG8_SB(0, 0), cB, voffB); PG8_STAGE(PG8_SB(0, 1), cB + hB, voffB); PG8_STAGE(PG8_SA(0, 0), cA, voffA); PG8_STAGE(PG8_SA(0, 1), cA + hA, voffA);
        if (wr == 1) PG8_BAR;
        PG8_WAIT_V(2); PG8_BAR;
        PG8_STAGE(PG8_SB(1, 0), cB + kstep, voffB); PG8_STAGE(PG8_SA(1, 0), cA + kstep, voffA); PG8_STAGE(PG8_SB(1, 1), cB + hB + kstep, voffB);
        PG8_WAIT_V(6); PG8_BAR;
    } else {
        PG8_STAGE(PG8_SB(0, 0), cB, voffB); PG8_STAGE(PG8_SA(0, 0), cA, voffA); PG8_STAGE(PG8_SB(0, 1), cB + hB, voffB); PG8_STAGE(PG8_SA(0, 1), cA + hA, voffA);
        if (wr == 1) PG8_BAR;
        PG8_WAIT_V(4); PG8_BAR;
        PG8_STAGE(PG8_SB(1, 0), cB + kstep, voffB); PG8_STAGE(PG8_SA(1, 0), cA + kstep, voffA); PG8_STAGE(PG8_SB(1, 1), cB + hB + kstep, voffB);
        PG8_WAIT_V(6); PG8_BAR;
    }
    for (;;) {
        const bool has_next = S.next(ui + 1, nxt);
        const char* nA = has_next ? (const char*)g.A + (size_t)nxt.pm * tA + (size_t)nxt.pn * pnA : cA; const char* nB = has_next ? (const char*)g.Bt + (size_t)nxt.pn * tB : cB;
#pragma unroll 1
        for (int t = 0; t < nt; t += 2) {
            const bool last = (t == nt - 2);
            const char* a1 = cA + (size_t)(t + 1) * kstep;
            const char* a2 = last ? nA : cA + (size_t)(t + 2) * kstep; const char* b2 = last ? nB : cB + (size_t)(t + 2) * kstep;
            const char* a3 = a2 + kstep; const char* b3 = b2 + kstep;
            if constexpr (SP2) {
            PG8_LDB(B0, 0, 0); PG8_LDB(B1, 0, 1); PG8_SCHED; PG8_LDA(At, 0, 0); PG8_STAGE(PG8_SA(1, 1), a1 + hA, voffA);
            PG8_WAIT_V(8); PG8_WAIT_L(0); PG8_BAR; PG8_MMA(0, 0, At, B0); PG8_MMA(0, 1, At, B1); PG8_BAR; PG8_SCHED;
            PG8_LDA(At, 0, 1); PG8_STAGE(PG8_SB(0, 0), b2, voffB); PG8_STAGE(PG8_SB(0, 1), b2 + hB, voffB); PG8_STAGE(PG8_SA(0, 0), a2, voffA);
            PG8_WAIT_V(8); PG8_WAIT_L(0); PG8_BAR; PG8_MMA(1, 0, At, B0); PG8_MMA(1, 1, At, B1); PG8_BAR; PG8_SCHED;
            PG8_LDB(B0, 1, 0); PG8_LDB(B1, 1, 1); PG8_SCHED; PG8_LDA(At, 1, 0); PG8_STAGE(PG8_SA(0, 1), a2 + hA, voffA);
            PG8_WAIT_V(8); PG8_WAIT_L(0); PG8_BAR; PG8_MMA(0, 0, At, B0); PG8_MMA(0, 1, At, B1); PG8_BAR; PG8_SCHED;
            PG8_LDA(At, 1, 1); PG8_STAGE(PG8_SB(1, 0), b3, voffB); PG8_STAGE(PG8_SB(1, 1), b3 + hB, voffB); PG8_STAGE(PG8_SA(1, 0), a3, voffA);
            PG8_WAIT_V(8); PG8_WAIT_L(0); PG8_BAR; PG8_MMA(1, 0, At, B0); PG8_MMA(1, 1, At, B1); PG8_BAR; PG8_SCHED;
            } else {
            PG8_LDB(B0, 0, 0); PG8_SCHED; PG8_LDA(At, 0, 0); PG8_STAGE(PG8_SA(1, 1), a1 + hA, voffA);
            PG8_WAIT_L(8); PG8_BAR; PG8_WAIT_L(0); PG8_MMA(0, 0, At, B0); PG8_BAR; PG8_SCHED;
            PG8_LDB(B1, 0, 1); PG8_STAGE(PG8_SB(0, 0), b2, voffB);
            PG8_BAR; PG8_WAIT_L(0); PG8_MMA(0, 1, At, B1); PG8_BAR;
            PG8_LDA(At, 0, 1); PG8_STAGE(PG8_SA(0, 0), a2, voffA);
            PG8_BAR; PG8_WAIT_L(0); PG8_MMA(1, 0, At, B0); PG8_BAR; PG8_SCHED;
            PG8_STAGE(PG8_SB(0, 1), b2 + hB, voffB);
            PG8_WAIT_V(6); PG8_BAR; PG8_MMA(1, 1, At, B1); PG8_BAR;
            PG8_LDB(B0, 1, 0); PG8_SCHED; PG8_LDA(At, 1, 0); PG8_STAGE(PG8_SA(0, 1), a2 + hA, voffA);
            PG8_WAIT_L(8); PG8_BAR; PG8_WAIT_L(0); PG8_MMA(0, 0, At, B0); PG8_BAR; PG8_SCHED;
            PG8_LDB(B1, 1, 1); PG8_STAGE(PG8_SB(1, 0), b3, voffB);
            PG8_BAR; PG8_WAIT_L(0); PG8_MMA(0, 1, At, B1); PG8_BAR;
            PG8_LDA(At, 1, 1); PG8_STAGE(PG8_SA(1, 0), a3, voffA);
            PG8_BAR; PG8_WAIT_L(0); PG8_MMA(1, 0, At, B0); PG8_BAR; PG8_SCHED;
            PG8_STAGE(PG8_SB(1, 1), b3 + hB, voffB);
            PG8_WAIT_V(6); PG8_BAR; PG8_MMA(1, 1, At, B1); PG8_BAR;
            }
        }
        if constexpr (ALIGN_EPI) { if (wr == 0) PG8_BAR; }
        E(acc, cur, wr, wc, fr, fq);
        if (!has_next) break;
#pragma unroll
        for (int a = 0; a < 2; ++a)
#pragma unroll
            for (int b = 0; b < 2; ++b)
#pragma unroll
                for (int m = 0; m < 4; ++m)
#pragma unroll
                    for (int n = 0; n < 2; ++n) acc[a][b][m][n] = (f32x4){0.f, 0.f, 0.f, 0.f};
        cur = nxt; cA = nA; cB = nB; ++ui;
        if constexpr (ALIGN_EPI) { if (wr == 1) PG8_BAR; }
    }
    PG8_WAIT_V(0);
    if constexpr (!ALIGN_EPI) { if (wr == 0) PG8_BAR; }
    PG8_BAR;
#undef PG8_SA
#undef PG8_SB
#undef PG8_STAGE
#undef PG8_LDA
#undef PG8_LDB
#undef PG8_MMA
#undef PG8_WAIT_V
#undef PG8_WAIT_L
#undef PG8_BAR
#undef PG8_SCHED
}
}
constexpr int T_TOK = 16384, DM = 1024, SEQ = 4096, NB = 4;
constexpr float EPS = 1e-6f;
constexpr float LOG2E = 1.4426950408889634f;

namespace pg8 {
struct EpiProj {
    static constexpr bool PERM = true;
    bf16_t *GQ, *GK, *GV, *GR, *SQ, *SK, *SV, *SGA, *SGB;
    __device__ __forceinline__ void operator()(const f32x4 (&acc)[2][2][4][2], const Unit& u, int wr, int wc, int fr, int fq) const {
        const int pn = u.pn; bf16_t* base; int ldc = 1024, c0; int act = 0; float sc = 1.f;
        if (pn < 2) { base = GQ; ldc = 512; c0 = pn * 256; sc = 0.08838834764831845f; }
        else if (pn < 4) { base = GK; ldc = 512; c0 = (pn - 2) * 256; }
        else if (pn < 8) { base = GV; c0 = (pn - 4) * 256; }
        else if (pn < 12) { base = GR; c0 = (pn - 8) * 256; act = 1; }
        else if (pn < 16) { base = SQ; c0 = (pn - 12) * 256; sc = 0.125f * LOG2E; }
        else if (pn < 20) { base = SK; c0 = (pn - 16) * 256; }
        else if (pn < 24) { base = SV; c0 = (pn - 20) * 256; }
        else if (pn < 28) { base = SGA; c0 = (pn - 24) * 256; act = 2; }
        else { base = SGB; c0 = (pn - 28) * 256; act = 2; }
        const int row0 = u.pm * BM + wr * 64 + fr, col0 = c0 + wc * 32 + 8 * fq;
#pragma unroll
        for (int ai = 0; ai < 2; ++ai)
#pragma unroll
            for (int m = 0; m < 4; ++m) { bf16_t* rowp = base + (size_t)(row0 + ai * HALF + m * 16) * ldc + col0;
#pragma unroll
                for (int bj = 0; bj < 2; ++bj) { f32x4 v0 = acc[ai][bj][m][0], v1 = acc[ai][bj][m][1];
                    if (act == 1) {
#pragma unroll
                        for (int j = 0; j < 4; ++j) { v0[j] = v0[j] * fast_sigmoid(v0[j]); v1[j] = v1[j] * fast_sigmoid(v1[j]); } }
                    else if (act == 2) {
#pragma unroll
                        for (int j = 0; j < 4; ++j) { v0[j] = fast_sigmoid(v0[j]); v1[j] = fast_sigmoid(v1[j]); } }
                    else { v0 = v0 * sc; v1 = v1 * sc; }
                    u32x4 w; w.x = cvtpk(v0[0], v0[1]); w.y = cvtpk(v0[2], v0[3]); w.z = cvtpk(v1[0], v1[1]); w.w = cvtpk(v1[2], v1[3]);
                    *(u32x4*)(rowp + bj * HALF) = w; } }
    }
};
template <bool FIRST> struct EpiMix {
    static constexpr bool PERM = true;
    const bf16_t* gate; bf16_t* mixed;
    __device__ __forceinline__ void operator()(const f32x4 (&acc)[2][2][4][2], const Unit& u, int wr, int wc, int fr, int fq) const {
        const int row0 = u.pm * BM + wr * 64 + fr, col0 = u.pn * BM + wc * 32 + 8 * fq;
#pragma unroll
        for (int ai = 0; ai < 2; ++ai)
#pragma unroll
            for (int m = 0; m < 4; ++m) { const size_t off = (size_t)(row0 + ai * HALF + m * 16) * 1024 + col0;
#pragma unroll
                for (int bj = 0; bj < 2; ++bj) { const f32x4 a0 = acc[ai][bj][m][0], a1 = acc[ai][bj][m][1];
                    const u32x4 gv = *(const u32x4*)(gate + off + bj * HALF);
                    float r[8];
                    r[0] = a0[0] * bf_lo(gv.x); r[1] = a0[1] * bf_hi(gv.x); r[2] = a0[2] * bf_lo(gv.y); r[3] = a0[3] * bf_hi(gv.y);
                    r[4] = a1[0] * bf_lo(gv.z); r[5] = a1[1] * bf_hi(gv.z); r[6] = a1[2] * bf_lo(gv.w); r[7] = a1[3] * bf_hi(gv.w);
                    if (!FIRST) { const u32x4 mv = *(const u32x4*)(mixed + off + bj * HALF);
                        r[0] += bf_lo(mv.x); r[1] += bf_hi(mv.x); r[2] += bf_lo(mv.y); r[3] += bf_hi(mv.y); r[4] += bf_lo(mv.z); r[5] += bf_hi(mv.z); r[6] += bf_lo(mv.w); r[7] += bf_hi(mv.w); }
                    u32x4 w; w.x = cvtpk(r[0], r[1]); w.y = cvtpk(r[2], r[3]); w.z = cvtpk(r[4], r[5]); w.w = cvtpk(r[6], r[7]);
                    *(u32x4*)(mixed + off + bj * HALF) = w; } }
    }
};
struct EpiH1 {
    static constexpr bool PERM = false;
    const float* x; const float* g; float* H1; bf16_t* H1G; float* SSQ;
    __device__ __forceinline__ void operator()(const f32x4 (&acc)[2][2][4][2], const Unit& u, int wr, int wc, int fr, int fq) const {
        const int row0 = u.pm * BM + wr * 64 + fr, col0 = u.pn * BM + wc * 32 + 4 * fq;
        f32x4 gv[2][2];
#pragma unroll
        for (int bj = 0; bj < 2; ++bj)
#pragma unroll
            for (int n = 0; n < 2; ++n) gv[bj][n] = *(const f32x4*)(g + col0 + bj * HALF + n * 16);
#pragma unroll
        for (int ai = 0; ai < 2; ++ai)
#pragma unroll
            for (int m = 0; m < 4; ++m) { const int row = row0 + ai * HALF + m * 16; const size_t off = (size_t)row * 1024 + col0; float s = 0.f;
#pragma unroll
                for (int bj = 0; bj < 2; ++bj)
#pragma unroll
                    for (int n = 0; n < 2; ++n) { const f32x4 xv = *(const f32x4*)(x + off + bj * HALF + n * 16); const f32x4 h = xv + acc[ai][bj][m][n];
                        *(f32x4*)(H1 + off + bj * HALF + n * 16) = h; s += (h[0] * h[0] + h[1] * h[1]) + (h[2] * h[2] + h[3] * h[3]);
                        const f32x4 hg = h * gv[bj][n]; u32x2 w; w.x = cvtpk(hg[0], hg[1]); w.y = cvtpk(hg[2], hg[3]); *(u32x2*)(H1G + off + bj * HALF + n * 16) = w; }
                s += __shfl_xor(s, 16); s += __shfl_xor(s, 32);
                if (fq == 0) SSQ[(size_t)row * 16 + u.pn * 4 + wc] = s; }
    }
};
struct EpiQ {
    static constexpr bool PERM = true;
    const float* SSQ; bf16_t* Q; int ldc;
    __device__ __forceinline__ void operator()(const f32x4 (&acc)[2][2][4][2], const Unit& u, int wr, int wc, int fr, int fq) const {
        const int row0 = u.pm * BM + wr * 64 + fr, col0 = u.pn * BM + wc * 32 + 8 * fq;
#pragma unroll
        for (int ai = 0; ai < 2; ++ai)
#pragma unroll
            for (int m = 0; m < 4; ++m) { const int row = row0 + ai * HALF + m * 16; const f32x4* sp = (const f32x4*)(SSQ + (size_t)row * 16);
                const f32x4 s0 = sp[0], s1 = sp[1], s2 = sp[2], s3 = sp[3]; const f32x4 st = (s0 + s1) + (s2 + s3);
                const float rstd = __builtin_amdgcn_rsqf(((st[0] + st[1]) + (st[2] + st[3])) * (1.0f / 1024.0f) + EPS);
                bf16_t* rowp = Q + (size_t)row * ldc + col0;
#pragma unroll
                for (int bj = 0; bj < 2; ++bj) { const f32x4 v0 = acc[ai][bj][m][0] * rstd, v1 = acc[ai][bj][m][1] * rstd;
                    u32x4 w; w.x = cvtpk(v0[0], v0[1]); w.y = cvtpk(v0[2], v0[3]); w.z = cvtpk(v1[0], v1[1]); w.w = cvtpk(v1[2], v1[3]);
                    *(u32x4*)(rowp + bj * HALF) = w; } }
    }
};
struct EpiF32 {
    static constexpr bool PERM = false;
    float* O; int ldc;
    __device__ __forceinline__ void operator()(const f32x4 (&acc)[2][2][4][2], const Unit& u, int wr, int wc, int fr, int fq) const {
        const int row0 = u.pm * BM + wr * 64 + fr, col0 = u.pn * BM + wc * 32 + 4 * fq;
#pragma unroll
        for (int ai = 0; ai < 2; ++ai)
#pragma unroll
            for (int m = 0; m < 4; ++m) { float* rowp = O + (size_t)(row0 + ai * HALF + m * 16) * ldc + col0;
#pragma unroll
                for (int bj = 0; bj < 2; ++bj)
#pragma unroll
                    for (int n = 0; n < 2; ++n) *(f32x4*)(rowp + bj * HALF + n * 16) = acc[ai][bj][m][n]; }
    }
};
struct EpiBf {
    static constexpr bool PERM = true;
    bf16_t* O; int ldc;
    __device__ __forceinline__ void operator()(const f32x4 (&acc)[2][2][4][2], const Unit& u, int wr, int wc, int fr, int fq) const {
        const int row0 = u.pm * BM + wr * 64 + fr, col0 = u.pn * BM + wc * 32 + 8 * fq;
#pragma unroll
        for (int ai = 0; ai < 2; ++ai)
#pragma unroll
            for (int m = 0; m < 4; ++m) { bf16_t* rowp = O + (size_t)(row0 + ai * HALF + m * 16) * ldc + col0;
#pragma unroll
                for (int bj = 0; bj < 2; ++bj) { const f32x4 v0 = acc[ai][bj][m][0], v1 = acc[ai][bj][m][1];
                    u32x4 w; w.x = cvtpk(v0[0], v0[1]); w.y = cvtpk(v0[2], v0[3]); w.z = cvtpk(v1[0], v1[1]); w.w = cvtpk(v1[2], v1[3]);
                    *(u32x4*)(rowp + bj * HALF) = w; } }
    }
};
struct EpiH3 {
    static constexpr bool PERM = false;
    const float* H2; const bf16_t* PLE; float* OUT; float* SSQ; int dry;
    __device__ __forceinline__ void operator()(const f32x4 (&acc)[2][2][4][2], const Unit& u, int wr, int wc, int fr, int fq) const {
        const int row0 = u.pm * BM + wr * 64 + fr, col0 = u.pn * BM + wc * 32 + 4 * fq;
#pragma unroll
        for (int ai = 0; ai < 2; ++ai)
#pragma unroll
            for (int m = 0; m < 4; ++m) { const int row = row0 + ai * HALF + m * 16; const size_t off = (size_t)row * 1024 + col0; float s = 0.f;
#pragma unroll
                for (int bj = 0; bj < 2; ++bj)
#pragma unroll
                    for (int n = 0; n < 2; ++n) { const size_t o2 = off + bj * HALF + n * 16; const f32x4 hv = *(const f32x4*)(H2 + o2); const u32x2 pv = *(const u32x2*)(PLE + o2);
                        const f32x4 a = acc[ai][bj][m][n]; f32x4 h;
                        h[0] = hv[0] + bf_lo(pv.x) * fast_sigmoid(a[0]); h[1] = hv[1] + bf_hi(pv.x) * fast_sigmoid(a[1]);
                        h[2] = hv[2] + bf_lo(pv.y) * fast_sigmoid(a[2]); h[3] = hv[3] + bf_hi(pv.y) * fast_sigmoid(a[3]);
                        if (!dry) *(f32x4*)(OUT + o2) = h; s += (h[0] * h[0] + h[1] * h[1]) + (h[2] * h[2] + h[3] * h[3]); }
                s += __shfl_xor(s, 16); s += __shfl_xor(s, 32);
                if (fq == 0) SSQ[(size_t)row * 16 + u.pn * 4 + wc] = s;
                asm volatile("" ::: "memory"); }
    }
};
}
constexpr size_t MiB = 1u << 20;
constexpr size_t WS_CTL = 0, CTL_ZERO_BYTES = 64 * 1024;
constexpr size_t WS_PEND = 64 * 1024;
constexpr size_t WS_WPLE = 512 * 1024;
constexpr size_t WS_KD = 1 * MiB;
constexpr size_t WS_GLAG = 2 * MiB;
constexpr size_t WS_WIN = 3 * MiB;
constexpr size_t WS_SEND = 4 * MiB;
constexpr size_t WS_EXP = 4 * MiB;
constexpr size_t WS_SSQ1 = 13 * MiB;
constexpr size_t WS_SSQ3 = 14 * MiB;
constexpr size_t WS_RSU = 15 * MiB, WS_RSV = 15 * MiB + 64 * 1024;
constexpr size_t WS_WGA = 20 * MiB, WS_WSB = 22 * MiB, WS_WO = 24 * MiB, WS_WPG = 26 * MiB, WS_WPQ = 28 * MiB;
constexpr size_t WS_A = 32 * MiB;
constexpr size_t WS_GQ = WS_A, WS_GK = WS_A + 16 * MiB, WS_UB8 = WS_A, WS_VB8 = WS_A + 16 * MiB;
constexpr size_t WS_B = 64 * MiB;
constexpr size_t WS_GV = WS_B, WS_PB = WS_B;
constexpr size_t WS_C = 96 * MiB;
constexpr size_t WS_GR = WS_C, WS_H1 = WS_C;
constexpr size_t WS_D = 128 * MiB;
constexpr size_t WS_SQ = WS_D;
constexpr size_t WS_E = 160 * MiB;
constexpr size_t WS_SK = WS_E, WS_MIX = WS_E, WS_Q = WS_E, WS_XN3 = WS_E;
constexpr size_t WS_F = 192 * MiB;
constexpr size_t WS_SV = WS_F;
constexpr size_t WS_G = 224 * MiB;
constexpr size_t WS_XN1 = WS_G, WS_GLAN = WS_G, WS_H1G = WS_G, WS_PLE = WS_G;
constexpr size_t WS_END = 256 * MiB;

constexpr int NWAVES = 8;
constexpr int RING_OFF = 0, RING_BYTES = 131072;
constexpr int MISC_OFF = RING_BYTES;
constexpr int LDS_BYTES = 147456;
constexpr int CW_BAR = 1024;

typedef GAS unsigned gu32;
#define RLX_AGENT __ATOMIC_RELAXED, __HIP_MEMORY_SCOPE_AGENT
#define LDS_WAIT() asm volatile("s_waitcnt lgkmcnt(0)" ::: "memory")
#define VM_WAIT() asm volatile("s_waitcnt vmcnt(0)" ::: "memory")

#define XB_TMO      128
#define XB_XCNT(j)  (256  + 64 * (j))
#define XB_XSUB(j)  (1280 + 64 * (j))
#define XB_XGEN(j)  (2304 + 64 * (j))
#define XB_TOP      3328
#define XB_TOPGEN   3392
#define XCD_BAR_WORDS 3456
#define XB_SPIN_CAP (1u << 22)
__device__ __forceinline__ unsigned xb_ld(unsigned* p)              { return __hip_atomic_load(p, __ATOMIC_RELAXED, __HIP_MEMORY_SCOPE_AGENT); }
__device__ __forceinline__ unsigned xb_add(unsigned* p, unsigned v) { return __hip_atomic_fetch_add(p, v, __ATOMIC_RELAXED, __HIP_MEMORY_SCOPE_AGENT); }
__device__ __forceinline__ unsigned xb_xcc_id() { return (unsigned)__builtin_amdgcn_s_getreg((3 << 11) | 20) & 0xFu; }
#define XB_SPIN(cond, bar) do { unsigned _sp = 0; while (cond) { __builtin_amdgcn_s_sleep(1); \
    if ((++_sp & 255u) == 0u) { if (xb_ld(&(bar)[XB_TMO])) break; if (_sp > XB_SPIN_CAP) { atomicAdd(&(bar)[XB_TMO], 1u); break; } } } } while (0)
struct XcdBarrier { unsigned* bar; unsigned x; volatile LAS unsigned* st; };
__device__ __forceinline__ XcdBarrier xcd_barrier_post(unsigned* bar, volatile LAS unsigned* st, int tid) {
    XcdBarrier b; b.bar = bar; b.x = xb_xcc_id(); b.st = st;
    if (tid == 0) (void)xb_add(&bar[XB_XCNT(b.x)], 1u);
    return b;
}
__device__ __forceinline__ void xcd_barrier_complete(unsigned* bar, unsigned x, unsigned& nloc, unsigned& nx) {
    const unsigned G = gridDim.x * gridDim.y * gridDim.z;
    unsigned sum, cnt, mine, sp = 0u;
    for (;;) {
        sum = 0u; cnt = 0u; mine = 0u;
#pragma unroll
        for (unsigned j = 0; j < 16; ++j) { const unsigned c = xb_ld(&bar[XB_XCNT(j)]); sum += c; cnt += (c > 0u) ? 1u : 0u; mine = (j == x) ? c : mine; }
        if (sum == G) break;
        __builtin_amdgcn_s_sleep(1);
        if ((++sp & 255u) == 0u) { if (xb_ld(&bar[XB_TMO])) break; if (sp > XB_SPIN_CAP) { atomicAdd(&bar[XB_TMO], 1u); break; } }
    }
    nloc = mine > 0u ? mine : 1u; nx = cnt > 0u ? cnt : 1u;
}
__device__ __forceinline__ void xcd_barrier(const XcdBarrier& b, int tid) {
    asm volatile("s_waitcnt vmcnt(0)" ::: "memory");
    __syncthreads();
    if (tid == 0) {
        unsigned* bar = b.bar;
        __builtin_amdgcn_s_waitcnt(0);
        unsigned nloc = b.st[0], nx = b.st[1];
        if (nloc == 0u) { xcd_barrier_complete(bar, b.x, nloc, nx); b.st[0] = nloc; b.st[1] = nx; }
        const unsigned old = xb_add(&bar[XB_XSUB(b.x)], 1u);
        const unsigned gen = old / nloc;
        if (old + 1u == (gen + 1u) * nloc) {
            __builtin_amdgcn_fence(__ATOMIC_RELEASE, "agent");
            asm volatile("s_waitcnt vmcnt(0)" ::: "memory");
            const unsigned og = xb_add(&bar[XB_TOP], 1u);
            const unsigned tg = og / nx;
            if (og + 1u == (tg + 1u) * nx) xb_add(&bar[XB_TOPGEN], 1u);
            else XB_SPIN(xb_ld(&bar[XB_TOPGEN]) == tg, bar);
            __builtin_amdgcn_fence(__ATOMIC_ACQUIRE, "agent");
            xb_add(&bar[XB_XGEN(b.x)], 1u);
            asm volatile("s_waitcnt vmcnt(0)" ::: "memory");
        } else {
            XB_SPIN(xb_ld(&bar[XB_XGEN(b.x)]) == gen, bar);
            __builtin_amdgcn_fence(__ATOMIC_ACQUIRE, "agent");
            asm volatile("s_waitcnt vmcnt(0)" ::: "memory");
        }
    }
    __syncthreads();
}

struct Frame {
    LAS unsigned char* lds;
    int tid, lane, wave, vcu, G, dry;
    const float* const* in; float* out; unsigned char* ws;
};
__device__ __forceinline__ int lane_id() { int l; asm volatile("v_mbcnt_lo_u32_b32 %0, -1, 0\n\tv_mbcnt_hi_u32_b32 %0, -1, %0" : "=v"(l)); return l; }
#define WSP(T, off) ((T*)(F.ws + (off)))
__device__ __forceinline__ float wave_sum(float v) {
#pragma unroll
    for (int o = 1; o < 64; o <<= 1) v += __shfl_xor(v, o);
    return v;
}
template <class RowMap>
__device__ __forceinline__ void p0_transpose_item(const float* W, int K, int N, bf16_t* WT, RowMap rm, LAS float* scr, int item, int lane) {
    const int nblk = (N + 31) / 32, kb = item / nblk, nb = item % nblk, k0 = 64 * kb, n0 = 32 * nb;
    const int nl = n0 + (lane & 31);
#pragma unroll 8
    for (int i = 0; i < 32; ++i) { const int kk = 2 * i + (lane >> 5); scr[kk * 33 + (lane & 31)] = (nl < N) ? W[(size_t)(k0 + kk) * N + nl] : 0.f; }
    LDS_WAIT(); asm volatile("" ::: "memory");
    const int c = lane & 7;
#pragma unroll
    for (int j = 0; j < 4; ++j) { const int n = (lane >> 3) + 8 * j; const LAS float* s = scr + (8 * c) * 33 + n;
        u32x4 o; o.x = cvtpk(s[0 * 33], s[1 * 33]); o.y = cvtpk(s[2 * 33], s[3 * 33]); o.z = cvtpk(s[4 * 33], s[5 * 33]); o.w = cvtpk(s[6 * 33], s[7 * 33]);
        if (n0 + n < N) *(u32x4*)(WT + (size_t)rm(n0 + n) * K + k0 + 8 * c) = o; }
    LDS_WAIT(); asm volatile("" ::: "memory");
}
struct RmId { __device__ __forceinline__ int operator()(int n) const { return n; } };
struct RmWin { __device__ __forceinline__ int operator()(int n) const { return n < 3072 ? n : (n < 3088 ? 8192 + (n - 3072) : n - 16); } };

__device__ __forceinline__ void cvt_copy(Frame& F, const float* src, bf16_t* dst, size_t n) {
    const size_t nth = (size_t)F.G * 512, n8 = n / 8;
    for (size_t i = (size_t)F.vcu * 512 + F.tid; i < n8; i += nth) {
        const f32x4 a = *(const f32x4*)(src + i * 8), b = *(const f32x4*)(src + i * 8 + 4);
        u32x4 o; o.x = cvtpk(a[0], a[1]); o.y = cvtpk(a[2], a[3]); o.z = cvtpk(b[0], b[1]); o.w = cvtpk(b[2], b[3]);
        *(u32x4*)(dst + i * 8) = o; }
}
__device__ __forceinline__ void rms_row_to_bf16(const float* xrow, const float* g, bf16_t* orow, int lane) {
    f32x4 v[4]; float s = 0.f;
#pragma unroll
    for (int j = 0; j < 4; ++j) { v[j] = *((const f32x4*)xrow + lane + 64 * j); s += (v[j][0] * v[j][0] + v[j][1] * v[j][1]) + (v[j][2] * v[j][2] + v[j][3] * v[j][3]); }
    const float rstd = __builtin_amdgcn_rsqf(wave_sum(s) * (1.f / 1024.f) + EPS);
#pragma unroll
    for (int j = 0; j < 4; ++j) { const f32x4 gv = *((const f32x4*)g + lane + 64 * j); const f32x4 o = v[j] * rstd * gv;
        u32x2 w; w.x = cvtpk(o[0], o[1]); w.y = cvtpk(o[2], o[3]); *((u32x2*)orow + lane + 64 * j) = w; }
}
__device__ __forceinline__ void phase_prologue(Frame& F) {
    LAS float* scr = (LAS float*)(F.lds + RING_OFF + F.wave * 16384);
    const int gw = F.vcu * NWAVES + F.wave, NGW = F.G * NWAVES;
    constexpr int I_IN = 16 * 257, I_SQ = 16 * 32, I_PQ = 16 * 64, I_PLE = 4 * 32;
    constexpr int NITEMS = I_IN + 4 * I_SQ + I_PQ + I_PLE;
    for (int it = gw; it < NITEMS; it += NGW) {
        int r = it;
        if (r < I_IN) { p0_transpose_item(F.in[3], 1024, 8208, WSP(bf16_t, WS_WIN), RmWin(), scr, r, F.lane); continue; } r -= I_IN;
        if (r < I_SQ) { p0_transpose_item(F.in[7], 1024, 1024, WSP(bf16_t, WS_WGA), RmId(), scr, r, F.lane); continue; } r -= I_SQ;
        if (r < I_SQ) { p0_transpose_item(F.in[8], 1024, 1024, WSP(bf16_t, WS_WSB), RmId(), scr, r, F.lane); continue; } r -= I_SQ;
        if (r < I_SQ) { p0_transpose_item(F.in[9], 1024, 1024, WSP(bf16_t, WS_WO), RmId(), scr, r, F.lane); continue; } r -= I_SQ;
        if (r < I_SQ) { p0_transpose_item(F.in[17], 1024, 1024, WSP(bf16_t, WS_WPG), RmId(), scr, r, F.lane); continue; } r -= I_SQ;
        if (r < I_PQ) { p0_transpose_item(F.in[11], 1024, 2048, WSP(bf16_t, WS_WPQ), RmId(), scr, r, F.lane); continue; } r -= I_PQ;
        p0_transpose_item(F.in[18], 256, 1024, WSP(bf16_t, WS_WPLE), RmId(), scr, r, F.lane);
    }
    { const float* k1 = F.in[12]; const float* k2 = F.in[13]; bf16_t* KB = WSP(bf16_t, WS_KD);
      for (int i = F.vcu * 512 + F.tid; i < 2 * 8 * 128 * 16; i += F.G * 512) { const int half = i >> 14, rem = i & 16383, h = rem >> 11, r8 = rem & 2047;
          const float* s = (half ? k2 : k1) + (size_t)h * 16384 + (size_t)r8 * 8; const f32x4 a = *(const f32x4*)s, b = *(const f32x4*)(s + 4);
          u32x4 o; o.x = cvtpk(a[0], a[1]); o.y = cvtpk(a[2], a[3]); o.z = cvtpk(b[0], b[1]); o.w = cvtpk(b[2], b[3]);
          *(u32x4*)(KB + (size_t)(h * 2 + half) * 16384 + (size_t)r8 * 8) = o; } }
    for (int m = gw; m < T_TOK; m += NGW) rms_row_to_bf16(F.in[0] + (size_t)m * 1024, F.in[2], WSP(bf16_t, WS_XN1) + (size_t)m * 1024, F.lane);
}

__device__ __forceinline__ void phase_gla_prep(Frame& F) {
    LAS float* alo = (LAS float*)(F.lds + RING_OFF);
    const bf16_t* XN1 = WSP(bf16_t, WS_XN1); const bf16_t* WGAT = WSP(bf16_t, WS_WIN) + (size_t)8192 * 1024;
    bf16_t* GK = WSP(bf16_t, WS_GK); bf16_t* GV = WSP(bf16_t, WS_GV); float* GLAG = WSP(float, WS_GLAG);
    const float* w_up = F.in[4]; const float* b_a = F.in[5];
    const int tid = F.tid, lane = F.lane, w = F.wave;
    for (int u = F.vcu; u < 256; u += F.G) {
        const size_t r0 = (size_t)u * 64;
        __syncthreads();
        if (w < 4) {
            f32x4 acc = (f32x4){0.f, 0.f, 0.f, 0.f};
            const bf16_t* ap = XN1 + (r0 + 16 * w + (lane & 15)) * 1024 + 8 * (lane >> 4);
            const bf16_t* bp = WGAT + (size_t)(lane & 15) * 1024 + 8 * (lane >> 4);
#pragma unroll 8
            for (int s = 0; s < 32; ++s) { const bf16x8 a = *(const bf16x8*)(ap + 32 * s), b = *(const bf16x8*)(bp + 32 * s); acc = __builtin_amdgcn_mfma_f32_16x16x32_bf16(a, b, acc, 0, 0, 0); }
#pragma unroll
            for (int r = 0; r < 4; ++r) alo[(16 * w + 4 * (lane >> 4) + r) * 16 + (lane & 15)] = acc[r];
        }
        const int kk = tid;
        float kv[64];
#pragma unroll
        for (int i = 0; i < 64; ++i) kv[i] = bf1(GK[(r0 + i) * 512 + kk]);
        float wv[16];
#pragma unroll
        for (int r = 0; r < 16; ++r) wv[r] = w_up[r * 512 + kk];
        const float bias = b_a[kk];
        __syncthreads();
        float suffix = 0.f;
        bf16_t* kdt = GK + r0 * 512 + (size_t)kk * 64;
#pragma unroll
        for (int i8 = 7; i8 >= 0; --i8) {
            float o[8];
#pragma unroll
            for (int j = 7; j >= 0; --j) { const int i = i8 * 8 + j;
                const f32x4 a0 = *(const LAS f32x4*)(alo + i * 16), a1 = *(const LAS f32x4*)(alo + i * 16 + 4), a2 = *(const LAS f32x4*)(alo + i * 16 + 8), a3 = *(const LAS f32x4*)(alo + i * 16 + 12);
                float x = bias;
                x += a0[0] * wv[0] + a0[1] * wv[1] + a0[2] * wv[2] + a0[3] * wv[3];
                x += a1[0] * wv[4] + a1[1] * wv[5] + a1[2] * wv[6] + a1[3] * wv[7];
                x += a2[0] * wv[8] + a2[1] * wv[9] + a2[2] * wv[10] + a2[3] * wv[11];
                x += a3[0] * wv[12] + a3[1] * wv[13] + a3[2] * wv[14] + a3[3] * wv[15];
                const float la = (fminf(x, 0.f) - log1pf(__expf(-fabsf(x)))) * (1.0f / 16.0f);
                o[j] = kv[i] * __expf(suffix);
                suffix += la; }
            u32x4 pk; pk.x = cvtpk(o[0], o[1]); pk.y = cvtpk(o[2], o[3]); pk.z = cvtpk(o[4], o[5]); pk.w = cvtpk(o[6], o[7]);
            if (!F.dry) *(u32x4*)(kdt + i8 * 8) = pk; }
        GLAG[(size_t)u * 512 + kk] = __expf(suffix);
        unsigned vv[64];
#pragma unroll
        for (int i = 0; i < 64; ++i) vv[i] = *(const unsigned*)(GV + (r0 + i) * 1024 + 2 * tid);
        __syncthreads();
        bf16_t* vt0 = GV + r0 * 1024 + (size_t)(2 * tid) * 64;
#pragma unroll
        for (int i8 = 0; i8 < 8; ++i8) { u32x4 lo, hi;
            lo.x = (vv[i8 * 8 + 0] & 0xffffu) | (vv[i8 * 8 + 1] << 16); hi.x = (vv[i8 * 8 + 0] >> 16) | (vv[i8 * 8 + 1] & 0xffff0000u);
            lo.y = (vv[i8 * 8 + 2] & 0xffffu) | (vv[i8 * 8 + 3] << 16); hi.y = (vv[i8 * 8 + 2] >> 16) | (vv[i8 * 8 + 3] & 0xffff0000u);
            lo.z = (vv[i8 * 8 + 4] & 0xffffu) | (vv[i8 * 8 + 5] << 16); hi.z = (vv[i8 * 8 + 4] >> 16) | (vv[i8 * 8 + 5] & 0xffff0000u);
            lo.w = (vv[i8 * 8 + 6] & 0xffffu) | (vv[i8 * 8 + 7] << 16); hi.w = (vv[i8 * 8 + 6] >> 16) | (vv[i8 * 8 + 7] & 0xffff0000u);
            if (!F.dry) { *(u32x4*)(vt0 + i8 * 8) = lo; *(u32x4*)(vt0 + 64 + i8 * 8) = hi; } }
    }
}

constexpr int GL_KD = 0, GL_Q = 32768, GL_G = 65536, GL_RED = 65536 + 1024;
__device__ __forceinline__ int gl_kd_off(int row, int chunk) { return row * 128 + ((chunk ^ ((row >> 1) & 7)) << 4); }
__device__ __forceinline__ int gl_q_off(int row, int chunk16) { return row * 256 + ((chunk16 ^ (row & 15)) << 4); }

struct GlaStage { u32x4 kd[2]; u32x4 q[2]; bf16x8 vt[4]; float g; };
__device__ __forceinline__ void gla_prefetch_vt(Frame& F, GlaStage& st, int b, int h, int c) {
    const int u = b * 64 + c; const size_t r0 = (size_t)u * 64; const int w = F.wave, lq = F.lane & 31, hh = F.lane >> 5;
    const bf16_t* vt = WSP(bf16_t, WS_GV) + r0 * 1024 + (size_t)(h * 256 + 32 * w + lq) * 64;
#pragma unroll
    for (int ts = 0; ts < 4; ++ts) st.vt[ts] = *(const bf16x8*)(vt + 16 * ts + 8 * hh);
}
template <bool WITH_Q>
__device__ __forceinline__ void gla_prefetch(Frame& F, GlaStage& st, int b, int h, int c) {
    const int u = b * 64 + c; const size_t r0 = (size_t)u * 64; const int tid = F.tid;
    const bf16_t* kd = WSP(bf16_t, WS_GK) + r0 * 512 + (size_t)h * 8192;
#pragma unroll
    for (int j = 0; j < 2; ++j) { const int pi = tid + 512 * j; st.kd[j] = *(const u32x4*)(kd + (pi >> 3) * 64 + (pi & 7) * 8); }
    if (WITH_Q) { const bf16_t* gq = WSP(bf16_t, WS_GQ) + r0 * 512 + h * 128;
#pragma unroll
        for (int j = 0; j < 2; ++j) { const int pi = tid + 512 * j; st.q[j] = *(const u32x4*)(gq + (size_t)(pi >> 4) * 512 + (pi & 15) * 8); } }
    st.g = (tid < 128) ? WSP(float, WS_GLAG)[((size_t)u * 4 + h) * 128 + tid] : 1.f;
}
template <bool WITH_Q>
__device__ __forceinline__ void gla_stage_write(Frame& F, const GlaStage& st, int buf) {
    LAS unsigned char* lds = F.lds + RING_OFF; const int tid = F.tid;
#pragma unroll
    for (int j = 0; j < 2; ++j) { const int pi = tid + 512 * j; *(LAS u32x4*)(lds + GL_KD + buf * 16384 + gl_kd_off(pi >> 3, pi & 7)) = st.kd[j]; }
    if (WITH_Q) {
#pragma unroll
        for (int j = 0; j < 2; ++j) { const int pi = tid + 512 * j; *(LAS u32x4*)(lds + GL_Q + buf * 16384 + gl_q_off(pi >> 4, pi & 15)) = st.q[j]; } }
    if (tid < 128) *(LAS float*)(lds + GL_G + buf * 512 + tid * 4) = st.g;
}
__device__ __forceinline__ void gla_update(Frame& F, f32x16 (&S)[4], const bf16x8 (&vt)[4], int buf) {
    const LAS unsigned char* lds = F.lds + RING_OFF; const int lq = F.lane & 31, hh = F.lane >> 5;
    const LAS float* G = (const LAS float*)(lds + GL_G + buf * 512);
#pragma unroll
    for (int kt = 0; kt < 4; ++kt)
#pragma unroll
        for (int g4 = 0; g4 < 4; ++g4) { const f32x4 g = *(const LAS f32x4*)(G + 32 * kt + 8 * g4 + 4 * hh);
#pragma unroll
            for (int j = 0; j < 4; ++j) S[kt][4 * g4 + j] *= g[j]; }
#pragma unroll
    for (int ts = 0; ts < 4; ++ts)
#pragma unroll
        for (int kt = 0; kt < 4; ++kt) { const bf16x8 a = *(const LAS bf16x8*)(lds + GL_KD + buf * 16384 + gl_kd_off(32 * kt + lq, 2 * ts + hh));
            S[kt] = __builtin_amdgcn_mfma_f32_32x32x16_bf16(a, vt[ts], S[kt], 0, 0, 0); if (kt == 3 && (ts & 1)) __builtin_amdgcn_sched_barrier(0); }
}
constexpr size_t SEND_WAVE_FLOATS = 4 * 4 * 64 * 4;
__device__ __forceinline__ void gla_stage1(Frame& F, int unit) {
    const int bh = unit >> 3, seg = unit & 7, b = bh >> 2, h = bh & 3, w = F.wave, l = F.lane;
    f32x16 S[4];
#pragma unroll
    for (int kt = 0; kt < 4; ++kt)
#pragma unroll
        for (int r = 0; r < 16; ++r) S[kt][r] = 0.f;
    float pend = 1.f;
    GlaStage st; gla_prefetch<false>(F, st, b, h, seg * 8); gla_prefetch_vt(F, st, b, h, seg * 8);
    for (int ci = 0; ci < 8; ++ci) {
        gla_stage_write<false>(F, st, ci & 1); pend *= st.g;
        __syncthreads();
        if (ci < 7) gla_prefetch<false>(F, st, b, h, seg * 8 + ci + 1);
        gla_update(F, S, st.vt, ci & 1);
        if (ci < 7) gla_prefetch_vt(F, st, b, h, seg * 8 + ci + 1);
    }
    float* se = WSP(float, WS_SEND) + ((size_t)unit * 8 + w) * SEND_WAVE_FLOATS;
#pragma unroll
    for (int kt = 0; kt < 4; ++kt)
#pragma unroll
        for (int g4 = 0; g4 < 4; ++g4) *(f32x4*)(se + ((kt * 4 + g4) * 64 + l) * 4) = (f32x4){S[kt][4 * g4], S[kt][4 * g4 + 1], S[kt][4 * g4 + 2], S[kt][4 * g4 + 3]};
    if (F.tid < 128) WSP(float, WS_PEND)[unit * 128 + F.tid] = pend;
    __syncthreads();
}
__device__ __forceinline__ void gla_stage3(Frame& F, int unit) {
    const int bh = unit >> 3, seg = unit & 7, b = bh >> 2, h = bh & 3, w = F.wave, l = F.lane, lq = l & 31, hh = l >> 5;
    LAS unsigned char* lds = F.lds + RING_OFF;
    const bf16_t* GR = WSP(bf16_t, WS_GR); bf16_t* GLAN = WSP(bf16_t, WS_GLAN); const float* g_o = F.in[6];
    f32x16 S[4];
#pragma unroll
    for (int kt = 0; kt < 4; ++kt)
#pragma unroll
        for (int r = 0; r < 16; ++r) S[kt][r] = 0.f;
    GlaStage st; gla_prefetch<true>(F, st, b, h, seg * 8); gla_prefetch_vt(F, st, b, h, seg * 8);
    for (int sp = 0; sp < seg; ++sp) {
        const int un = bh * 8 + sp; const float* se = WSP(float, WS_SEND) + ((size_t)un * 8 + w) * SEND_WAVE_FLOATS; const float* pe = WSP(float, WS_PEND) + un * 128;
#pragma unroll
        for (int kt = 0; kt < 4; ++kt)
#pragma unroll
            for (int g4 = 0; g4 < 4; ++g4) { const f32x4 p = *(const f32x4*)(pe + 32 * kt + 8 * g4 + 4 * hh); const f32x4 s = *(const f32x4*)(se + ((kt * 4 + g4) * 64 + l) * 4);
#pragma unroll
                for (int j = 0; j < 4; ++j) S[kt][4 * g4 + j] = S[kt][4 * g4 + j] * p[j] + s[j]; }
    }
    for (int ci = 0; ci < 8; ++ci) {
        const int c = seg * 8 + ci; const size_t r0 = (size_t)(b * 64 + c) * 64; const int buf = ci & 1;
        gla_stage_write<true>(F, st, buf);
        __syncthreads();
        if (ci < 7) gla_prefetch<true>(F, st, b, h, c + 1);
        gla_update(F, S, st.vt, buf);
        f32x16 oT[2];
#pragma unroll
        for (int tt = 0; tt < 2; ++tt) {
#pragma unroll
            for (int r = 0; r < 16; ++r) oT[tt][r] = 0.f;
            const int t = 32 * tt + lq;
#pragma unroll
            for (int kt = 0; kt < 4; ++kt)
#pragma unroll
                for (int s = 0; s < 2; ++s) {
                    u32x4 aw; aw.x = cvtpk(S[kt][8 * s + 0], S[kt][8 * s + 1]); aw.y = cvtpk(S[kt][8 * s + 2], S[kt][8 * s + 3]); aw.z = cvtpk(S[kt][8 * s + 4], S[kt][8 * s + 5]); aw.w = cvtpk(S[kt][8 * s + 6], S[kt][8 * s + 7]);
                    const u32x2 qlo = *(const LAS u32x2*)(lds + GL_Q + buf * 16384 + gl_q_off(t, 4 * kt + 2 * s) + 8 * hh), qhi = *(const LAS u32x2*)(lds + GL_Q + buf * 16384 + gl_q_off(t, 4 * kt + 2 * s + 1) + 8 * hh);
                    const u32x4 bw = (u32x4){qlo.x, qlo.y, qhi.x, qhi.y};
                    oT[tt] = __builtin_amdgcn_mfma_f32_32x32x16_bf16(__builtin_bit_cast(bf16x8, aw), __builtin_bit_cast(bf16x8, bw), oT[tt], 0, 0, 0);
                    if (s == 1 && (kt & 1)) __builtin_amdgcn_sched_barrier(0); }
        }
        LAS float* redc = (LAS float*)(lds + GL_RED) + buf * 512;
#pragma unroll
        for (int tt = 0; tt < 2; ++tt) { float s = 0.f;
#pragma unroll
            for (int r = 0; r < 16; ++r) s += oT[tt][r] * oT[tt][r];
            s += __shfl_xor(s, 32);
            if (hh == 0) redc[w * 64 + 32 * tt + lq] = s; }
        if (ci < 7) gla_prefetch_vt(F, st, b, h, c + 1);
        u32x2 sr[2][4];
#pragma unroll
        for (int tt = 0; tt < 2; ++tt)
#pragma unroll
            for (int g4 = 0; g4 < 4; ++g4) sr[tt][g4] = *(const u32x2*)(GR + (r0 + 32 * tt + lq) * 1024 + h * 256 + 32 * w + 8 * g4 + 4 * hh);
        __syncthreads();
#pragma unroll
        for (int tt = 0; tt < 2; ++tt) { float tot = 0.f;
#pragma unroll
            for (int ww = 0; ww < 8; ++ww) tot += redc[ww * 64 + 32 * tt + lq];
            const float rstd = __builtin_amdgcn_rsqf(tot * (1.0f / 256.0f) + EPS);
            const size_t row = r0 + 32 * tt + lq;
#pragma unroll
            for (int g4 = 0; g4 < 4; ++g4) { const int v0 = h * 256 + 32 * w + 8 * g4 + 4 * hh;
                const f32x4 go = *(const f32x4*)(g_o + v0);
                const float o0 = oT[tt][4 * g4 + 0] * rstd * go[0] * bf_lo(sr[tt][g4].x), o1 = oT[tt][4 * g4 + 1] * rstd * go[1] * bf_hi(sr[tt][g4].x);
                const float o2 = oT[tt][4 * g4 + 2] * rstd * go[2] * bf_lo(sr[tt][g4].y), o3 = oT[tt][4 * g4 + 3] * rstd * go[3] * bf_hi(sr[tt][g4].y);
                u32x2 wv; wv.x = cvtpk(o0, o1); wv.y = cvtpk(o2, o3); *(u32x2*)(GLAN + row * 1024 + v0) = wv; } }
    }
    __syncthreads();
}

constexpr int SB_TILE = 16384, SB_FLAG = 7 * SB_TILE;
typedef short v4i16_t __attribute__((ext_vector_type(4)));
__device__ __forceinline__ s16x4 vtr(const LAS unsigned char* p) { return __builtin_bit_cast(s16x4, __builtin_amdgcn_ds_read_tr16_b64_v4i16((LAS v4i16_t*)p)); }
__device__ __forceinline__ float partner32(float x, int hh) { auto rr = __builtin_amdgcn_permlane32_swap(__float_as_uint(x), __float_as_uint(x), false, false); return __uint_as_float(hh ? rr[0] : rr[1]); }
__device__ __forceinline__ int sbk_off(int key, int chunk) { return key * 128 + ((chunk ^ ((key >> 1) & 7)) << 4); }
__device__ __forceinline__ int sbv_off(int key, int chunk) { return 8192 + key * 128 + ((chunk ^ (((key >> 1) & 1) << 2)) << 4); }

template <bool DIAG>
__device__ __forceinline__ void sb_tile_t(const LAS unsigned char* tile, int kt, int qabs, int l, const bf16x8 (&qf)[4], f32x16& o0, f32x16& o1, float& carry) {
    const int lq = l & 31, hh = l >> 5, g1 = (l >> 4) & 1, i = l & 15;
    float run = carry;
#pragma unroll
    for (int half = 1; half >= 0; --half) {
        f32x16 p;
#pragma unroll
        for (int r = 0; r < 16; ++r) p[r] = 0.f;
#pragma unroll
        for (int s = 0; s < 4; ++s) { const bf16x8 a = *(const LAS bf16x8*)(tile + sbk_off(32 * half + lq, 2 * s + hh)); p = __builtin_amdgcn_mfma_f32_32x32x16_bf16(a, qf[s], p, 0, 0, 0); }
        float Lh[16];
#pragma unroll
        for (int r = 0; r < 16; ++r) { const float z = p[r];
            float L = fmaxf(z, 0.f) + __builtin_amdgcn_logf(1.0f + __builtin_amdgcn_exp2f(-fabsf(z)));
            if (DIAG) { const int key = 64 * kt + 32 * half + (r & 3) + 8 * (r >> 2) + 4 * hh; if (key >= qabs) L = 0.f; }
            Lh[r] = L; }
        float tot[4];
#pragma unroll
        for (int g4 = 0; g4 < 4; ++g4) { float* Lg = &Lh[4 * g4]; Lg[2] += Lg[3]; Lg[1] += Lg[2]; Lg[0] += Lg[1]; tot[g4] = Lg[0]; }
        float E[4];
#pragma unroll
        for (int m = 3; m >= 0; --m) { const float tp = partner32(tot[m], hh); E[m] = run + (hh ? 0.f : tp); run += tot[m] + tp; }
        u32x4 pw[2];
#pragma unroll
        for (int s = 0; s < 2; ++s) { float wv[8];
#pragma unroll
            for (int j = 0; j < 8; ++j) { const int r = 8 * s + j;
                float wgt = __builtin_amdgcn_exp2f(p[r] - (E[r >> 2] + Lh[r]));
                if (DIAG) { const int key = 64 * kt + 32 * half + (r & 3) + 8 * (r >> 2) + 4 * hh; if (key >= qabs) wgt = 0.f; }
                wv[j] = wgt; }
            pw[s] = (u32x4){cvtpk(wv[0], wv[1]), cvtpk(wv[2], wv[3]), cvtpk(wv[4], wv[5]), cvtpk(wv[6], wv[7])}; }
#pragma unroll
        for (int s = 0; s < 2; ++s) { const bf16x8 pb = __builtin_bit_cast(bf16x8, pw[s]);
            const int k0 = 32 * half + 16 * s + 4 * hh + (i >> 2), k1 = k0 + 8;
#pragma unroll
            for (int dt = 0; dt < 2; ++dt) { const int ch = 4 * dt + 2 * g1 + ((i & 3) >> 1);
                const s16x4 lo = vtr(tile + sbv_off(k0, ch) + 8 * (i & 1)), hi = vtr(tile + sbv_off(k1, ch) + 8 * (i & 1));
                const bf16x8 a = (bf16x8){lo[0], lo[1], lo[2], lo[3], hi[0], hi[1], hi[2], hi[3]};
                if (dt == 0) o0 = __builtin_amdgcn_mfma_f32_32x32x16_bf16(a, pb, o0, 0, 0, 0); else o1 = __builtin_amdgcn_mfma_f32_32x32x16_bf16(a, pb, o1, 0, 0, 0); } }
    }
    carry = run;
}
__device__ __forceinline__ void sb_tile(const LAS unsigned char* tile, int kt, int q0, int qabs, int l, const bf16x8 (&qf)[4], f32x16& o0, f32x16& o1, float& carry) {
    if (64 * kt + 63 >= q0) sb_tile_t<true>(tile, kt, qabs, l, qf, o0, o1, carry); else sb_tile_t<false>(tile, kt, qabs, l, qf, o0, o1, carry);
}
__device__ __forceinline__ void sb_attn_unit(Frame& F, int uidx) {
    const int bh = uidx >> 4, qb = uidx & 15, b = bh >> 4, h = bh & 15;
    LAS unsigned char* lds = F.lds + RING_OFF;
    volatile LAS unsigned* flags = (volatile LAS unsigned*)(lds + SB_FLAG);
    const int tid = F.tid, w = F.wave, l = F.lane, lq = l & 31, hh = l >> 5;
    bf16_t* SQ = WSP(bf16_t, WS_SQ); const bf16_t* SK = WSP(bf16_t, WS_SK); const bf16_t* SV = WSP(bf16_t, WS_SV);
    const size_t rowbase = (size_t)b * SEQ;
    const int q0 = qb * 256 + 32 * w, qabs = q0 + lq;
    const int kt_hi = qb * 4 + 3, kt_lo = (qb * 4 - 3) > 0 ? (qb * 4 - 3) : 0, nwin = kt_hi - kt_lo + 1;
    const int skey = tid >> 3, sch = tid & 7;
    const bf16_t* kgd = SK + (rowbase + skey) * 1024 + h * 64 + ((sch ^ ((skey >> 1) & 7)) * 8);
    const bf16_t* vgd = SV + (rowbase + skey) * 1024 + h * 64 + ((sch ^ (((skey >> 1) & 1) << 2)) * 8);
    __syncthreads();
#pragma unroll
    for (int j = 0; j < 7; ++j) if (j < nwin) {
        __builtin_amdgcn_global_load_lds((const unsigned*)(kgd + (size_t)(kt_lo + j) * 64 * 1024), (LAS unsigned*)(lds + j * SB_TILE + w * 1024), 16, 0, 0);
        __builtin_amdgcn_global_load_lds((const unsigned*)(vgd + (size_t)(kt_lo + j) * 64 * 1024), (LAS unsigned*)(lds + j * SB_TILE + 8192 + w * 1024), 16, 0, 0); }
    bf16x8 qf[4];
    { const bf16_t* qrow = SQ + (rowbase + qabs) * 1024 + h * 64;
#pragma unroll
      for (int s = 0; s < 4; ++s) qf[s] = *(const bf16x8*)(qrow + 16 * s + 8 * hh); }
    f32x16 o0, o1;
#pragma unroll
    for (int r = 0; r < 16; ++r) { o0[r] = 0.f; o1[r] = 0.f; }
    float carry = 0.f;
    VM_WAIT(); __syncthreads();
    bool done = false;
    for (int kt = (q0 + 30) >> 6; kt >= kt_lo; --kt) {
        sb_tile(lds + (kt - kt_lo) * SB_TILE, kt, q0, qabs, l, qf, o0, o1, carry);
        if (__all(carry > 150.0f)) { done = true; break; }
    }
    if (kt_lo == 0) done = true;
    if (l == 0) flags[w] = done ? 1u : 0u;
    __syncthreads();
    bool alld = true;
#pragma unroll
    for (int i = 0; i < 8; ++i) alld = alld && (flags[i] != 0u);
    if (!alld) {
        const bf16_t* kg = SK + (rowbase + skey) * 1024 + h * 64 + sch * 8;
        const bf16_t* vg = SV + (rowbase + skey) * 1024 + h * 64 + sch * 8;
        for (int kt = kt_lo - 1; kt >= 0; --kt) {
            const u32x4 kr = *(const u32x4*)(kg + (size_t)kt * 64 * 1024), vr = *(const u32x4*)(vg + (size_t)kt * 64 * 1024);
            __syncthreads();
            { unsigned a = 1u;
#pragma unroll
              for (int i = 0; i < 8; ++i) a &= flags[i];
              if (a) break; }
            *(LAS u32x4*)(lds + sbk_off(skey, sch)) = kr; *(LAS u32x4*)(lds + sbv_off(skey, sch)) = vr;
            __syncthreads();
            if (!done) { sb_tile(lds, kt, q0, qabs, l, qf, o0, o1, carry); if (__all(carry > 150.0f) || kt == 0) done = true; }
            if (l == 0) flags[w] = done ? 1u : 0u;
        }
    }
    if (!F.dry) { bf16_t* orow = SQ + (rowbase + qabs) * 1024 + h * 64;
#pragma unroll
      for (int g4 = 0; g4 < 4; ++g4) { u32x2 a, c2; a.x = cvtpk(o0[4 * g4], o0[4 * g4 + 1]); a.y = cvtpk(o0[4 * g4 + 2], o0[4 * g4 + 3]); c2.x = cvtpk(o1[4 * g4], o1[4 * g4 + 1]); c2.y = cvtpk(o1[4 * g4 + 2], o1[4 * g4 + 3]);
          *(u32x2*)(orow + 8 * g4 + 4 * hh) = a; *(u32x2*)(orow + 32 + 8 * g4 + 4 * hh) = c2; } }
}
__device__ __forceinline__ void sb_units_dyn(Frame& F, unsigned* ctr, int lo, int hi) {
    volatile LAS int* slot = (volatile LAS int*)(F.lds + MISC_OFF + 64);
    for (;;) {
        __syncthreads();
        if (F.tid == 0) *slot = lo + (int)__hip_atomic_fetch_add(ctr, 1u, __ATOMIC_RELAXED, __HIP_MEMORY_SCOPE_AGENT);
        __syncthreads();
        const int u = *slot;
        if (u >= hi) break;
        sb_attn_unit(F, u);
    }
}
__device__ __forceinline__ void phase_attn_a(Frame& F) {
    if (F.vcu < 128) gla_stage1(F, F.vcu);
    sb_units_dyn(F, (unsigned*)(F.ws + WS_CTL) + 64, 0, 384);
    __syncthreads();
}
__device__ __forceinline__ void phase_attn_b(Frame& F) {
    if (F.vcu < 128) gla_stage3(F, F.vcu);
    sb_units_dyn(F, (unsigned*)(F.ws + WS_CTL) + 128, 384, 1024);
    __syncthreads();
}
__device__ __forceinline__ int okey(float v, int tag, int mask) { int u = __float_as_int(v); u ^= (u >> 31) & 0x7fffffff; return (u & ~mask) | tag; }
__device__ __forceinline__ float okey_val(int key, int mask) { int u = key & ~mask; u ^= (u >> 31) & 0x7fffffff; return __int_as_float(u); }
#define INS16(Lst, xin) do { int _x = (xin); _Pragma("unroll") for (int _j = 0; _j < 16; ++_j) { const int _h = max(Lst[_j], _x); _x = min(Lst[_j], _x); Lst[_j] = _h; } } while (0)

#define CEX(a, b) do { const int _hi = max(a, b), _lo = min(a, b); a = _hi; b = _lo; } while (0)
#define BITONIC16(K) do { \
    _Pragma("unroll") for (int _i = 0; _i < 8; ++_i) CEX(K[_i], K[_i + 8]); \
    _Pragma("unroll") for (int _b = 0; _b < 16; _b += 8) _Pragma("unroll") for (int _i = 0; _i < 4; ++_i) CEX(K[_b + _i], K[_b + _i + 4]); \
    _Pragma("unroll") for (int _b = 0; _b < 16; _b += 4) _Pragma("unroll") for (int _i = 0; _i < 2; ++_i) CEX(K[_b + _i], K[_b + _i + 2]); \
    _Pragma("unroll") for (int _b = 0; _b < 16; _b += 2) CEX(K[_b], K[_b + 1]); } while (0)
__device__ __forceinline__ int swap32i(int x) { auto r = __builtin_amdgcn_permlane32_swap((unsigned)x, (unsigned)x, false, false); return (int)((__builtin_amdgcn_mbcnt_hi(~0u, __builtin_amdgcn_mbcnt_lo(~0u, 0u)) & 32) ? r[0] : r[1]); }

__device__ __forceinline__ void phase_peer_retrieve(Frame& F) {
    const bf16_t* Q = WSP(bf16_t, WS_Q); const bf16_t* KB = WSP(bf16_t, WS_KD); unsigned* EXPO = WSP(unsigned, WS_EXP);
    LAS unsigned char* idxb = F.lds + RING_OFF + F.wave * 2048;
    const int l = F.lane, lq = l & 31, hh = l >> 5;
    const int ntok_wg = T_TOK / F.G;
#pragma unroll 1
    for (int it = F.wave; it < (ntok_wg / 32) * 8; it += NWAVES) {
        const int tg = it >> 3, h = it & 7;
        const int t = F.vcu * ntok_wg + tg * 32 + lq;
        int XY[2][16];
#pragma unroll
        for (int half = 0; half < 2; ++half) {
            bf16x8 qf[8];
            { const bf16_t* qp = Q + (size_t)t * 2048 + h * 256 + half * 128 + 8 * hh;
#pragma unroll
              for (int s = 0; s < 8; ++s) qf[s] = *(const bf16x8*)(qp + 16 * s); }
            int L[16];
#pragma unroll
            for (int j = 0; j < 16; ++j) L[j] = INT_MIN;
            const bf16_t* kp = KB + (size_t)(h * 2 + half) * 16384 + (size_t)lq * 128 + 8 * hh;
#pragma unroll 1
            for (int tile = 0; tile < 4; ++tile) {
                f32x16 acc;
#pragma unroll
                for (int r = 0; r < 16; ++r) acc[r] = 0.f;
#pragma unroll
                for (int s = 0; s < 8; ++s) { const bf16x8 a = *(const bf16x8*)(kp + (size_t)tile * 32 * 128 + 16 * s); acc = __builtin_amdgcn_mfma_f32_32x32x16_bf16(a, qf[s], acc, 0, 0, 0); }
#pragma unroll
                for (int r = 0; r < 16; ++r) { const int key = 32 * tile + (r & 3) + 8 * (r >> 2) + 4 * hh; INS16(L, okey(acc[r], 127 - key, 127)); }
            }
#pragma unroll
            for (int k = 0; k < 8; ++k) { const int a = swap32i(L[15 - k]), b = swap32i(L[k]); L[k] = max(L[k], a); L[15 - k] = max(L[15 - k], b); }
            BITONIC16(L);
#pragma unroll
            for (int j = 0; j < 16; ++j) XY[half][j] = L[j];
        }
        { u32x4 pk[2];
#pragma unroll
          for (int half = 0; half < 2; ++half) { const int* L = XY[half];
            pk[half].x = (unsigned)(127 - (L[0] & 127)) | ((unsigned)(127 - (L[1] & 127)) << 8) | ((unsigned)(127 - (L[2] & 127)) << 16) | ((unsigned)(127 - (L[3] & 127)) << 24);
            pk[half].y = (unsigned)(127 - (L[4] & 127)) | ((unsigned)(127 - (L[5] & 127)) << 8) | ((unsigned)(127 - (L[6] & 127)) << 16) | ((unsigned)(127 - (L[7] & 127)) << 24);
            pk[half].z = (unsigned)(127 - (L[8] & 127)) | ((unsigned)(127 - (L[9] & 127)) << 8) | ((unsigned)(127 - (L[10] & 127)) << 16) | ((unsigned)(127 - (L[11] & 127)) << 24);
            pk[half].w = (unsigned)(127 - (L[12] & 127)) | ((unsigned)(127 - (L[13] & 127)) << 8) | ((unsigned)(127 - (L[14] & 127)) << 16) | ((unsigned)(127 - (L[15] & 127)) << 24); }
          *(LAS u32x4*)(idxb + l * 32) = pk[0]; *(LAS u32x4*)(idxb + l * 32 + 16) = pk[1]; }
        float X[16], Y[16];
#pragma unroll
        for (int j = 0; j < 16; ++j) { X[j] = okey_val(XY[0][j], 127); Y[j] = okey_val(XY[1][j], 127); }
        int M[16];
#pragma unroll
        for (int j = 0; j < 16; ++j) M[j] = INT_MIN;
#define CAND(i, j) do { const float sm = hh ? (X[j] + Y[i]) : (X[i] + Y[j]); const int pos = hh ? ((j) * 16 + (i)) : ((i) * 16 + (j)); int key = okey(sm, 255 - pos, 255); if ((i) == (j) && hh) key = INT_MIN; INS16(M, key); } while (0)
        CAND(0, 0); CAND(0, 1); CAND(0, 2); CAND(0, 3); CAND(0, 4); CAND(0, 5); CAND(0, 6); CAND(0, 7); CAND(0, 8); CAND(0, 9); CAND(0, 10); CAND(0, 11); CAND(0, 12); CAND(0, 13); CAND(0, 14); CAND(0, 15);
        CAND(1, 1); CAND(1, 2); CAND(1, 3); CAND(1, 4); CAND(1, 5); CAND(1, 6); CAND(1, 7);
        CAND(2, 2); CAND(2, 3); CAND(2, 4);
        CAND(3, 3);
#undef CAND
        int TK[16];
#pragma unroll
        for (int k = 0; k < 16; ++k) TK[k] = max(M[k], swap32i(M[15 - k]));
        float sv[16]; float mx = -INFINITY;
#pragma unroll
        for (int k = 0; k < 16; ++k) { sv[k] = okey_val(TK[k], 255); mx = fmaxf(mx, sv[k]); }
        float den = 0.f;
#pragma unroll
        for (int k = 0; k < 16; ++k) { sv[k] = __expf(sv[k] - mx); den += sv[k]; }
        const float rden = 1.0f / den;
        LDS_WAIT(); asm volatile("" ::: "memory");
        const LAS unsigned char* ib = idxb + l * 32;
        unsigned* dst = EXPO + (size_t)t * 128 + h * 16 + hh * 8;
        u32x4 o0, o1; unsigned ov[8];
#pragma unroll
        for (int k = 0; k < 8; ++k) { const int pos = 255 - (TK[k] & 255); const unsigned i1 = ib[pos >> 4], i2 = ib[16 + (pos & 15)];
            ov[k] = (__float_as_uint(sv[k] * rden) & ~0x3fffu) | (i1 * 128u + i2); }
        o0 = (u32x4){ov[0], ov[1], ov[2], ov[3]}; o1 = (u32x4){ov[4], ov[5], ov[6], ov[7]};
        *(u32x4*)dst = o0; *(u32x4*)(dst + 4) = o1;
        LDS_WAIT(); asm volatile("" ::: "memory");
    }
}

__device__ __forceinline__ void cvt_rows_fp8(Frame& F, const float* src, unsigned char* dst, float* rscale) {
    const int l = F.lane; const int gw = F.vcu * NWAVES + F.wave, NGW = F.G * NWAVES;
    for (int e = gw; e < 16384; e += NGW) {
        const f32x4* sp = (const f32x4*)(src + (size_t)e * 1024 + 16 * l);
        const f32x4 a = sp[0], b = sp[1], c = sp[2], d = sp[3];
        float m = fmaxf(fmaxf(fmaxf(fabsf(a[0]), fabsf(a[1])), fmaxf(fabsf(a[2]), fabsf(a[3]))), fmaxf(fmaxf(fabsf(b[0]), fabsf(b[1])), fmaxf(fabsf(b[2]), fabsf(b[3]))));
        m = fmaxf(m, fmaxf(fmaxf(fmaxf(fabsf(c[0]), fabsf(c[1])), fmaxf(fabsf(c[2]), fabsf(c[3]))), fmaxf(fmaxf(fabsf(d[0]), fabsf(d[1])), fmaxf(fabsf(d[2]), fabsf(d[3])))));
#pragma unroll
        for (int o = 1; o < 64; o <<= 1) m = fmaxf(m, __shfl_xor(m, o));
        const float t = 448.0f / fmaxf(m, 1e-30f); const float s = __uint_as_float(__float_as_uint(t) & 0x7f800000u);
        u32x4 w; int x;
        x = __builtin_amdgcn_cvt_pk_fp8_f32(a[0] * s, a[1] * s, 0, false); x = __builtin_amdgcn_cvt_pk_fp8_f32(a[2] * s, a[3] * s, x, true); w.x = (unsigned)x;
        x = __builtin_amdgcn_cvt_pk_fp8_f32(b[0] * s, b[1] * s, 0, false); x = __builtin_amdgcn_cvt_pk_fp8_f32(b[2] * s, b[3] * s, x, true); w.y = (unsigned)x;
        x = __builtin_amdgcn_cvt_pk_fp8_f32(c[0] * s, c[1] * s, 0, false); x = __builtin_amdgcn_cvt_pk_fp8_f32(c[2] * s, c[3] * s, x, true); w.z = (unsigned)x;
        x = __builtin_amdgcn_cvt_pk_fp8_f32(d[0] * s, d[1] * s, 0, false); x = __builtin_amdgcn_cvt_pk_fp8_f32(d[2] * s, d[3] * s, x, true); w.w = (unsigned)x;
        *(u32x4*)(dst + (size_t)e * 1024 + 16 * l) = w;
        if (l == 0) rscale[e] = 1.0f / s;
    }
}

__device__ __forceinline__ float gelu_tanh(float x) { const float y = 0.7978845608028654f * (x + 0.044715f * x * x * x); return x * __builtin_amdgcn_rcpf(1.0f + __expf(-2.0f * y)); }
#define FP8_UNPACK16(W, f) do { f32x2 _t; \
    _t = __builtin_amdgcn_cvt_pk_f32_fp8((int)(W).x, false); f[0] = _t[0]; f[1] = _t[1]; _t = __builtin_amdgcn_cvt_pk_f32_fp8((int)(W).x, true); f[2] = _t[0]; f[3] = _t[1]; \
    _t = __builtin_amdgcn_cvt_pk_f32_fp8((int)(W).y, false); f[4] = _t[0]; f[5] = _t[1]; _t = __builtin_amdgcn_cvt_pk_f32_fp8((int)(W).y, true); f[6] = _t[0]; f[7] = _t[1]; \
    _t = __builtin_amdgcn_cvt_pk_f32_fp8((int)(W).z, false); f[8] = _t[0]; f[9] = _t[1]; _t = __builtin_amdgcn_cvt_pk_f32_fp8((int)(W).z, true); f[10] = _t[0]; f[11] = _t[1]; \
    _t = __builtin_amdgcn_cvt_pk_f32_fp8((int)(W).w, false); f[12] = _t[0]; f[13] = _t[1]; _t = __builtin_amdgcn_cvt_pk_f32_fp8((int)(W).w, true); f[14] = _t[0]; f[15] = _t[1]; } while (0)
__device__ __forceinline__ float sum_swap32(float a, float b) { auto r = __builtin_amdgcn_permlane32_swap(__float_as_uint(a), __float_as_uint(b), false, false); return __uint_as_float(r[0]) + __uint_as_float(r[1]); }
__device__ __forceinline__ float sum_swap16(float a, float b) { auto r = __builtin_amdgcn_permlane16_swap(__float_as_uint(a), __float_as_uint(b), false, false); return __uint_as_float(r[0]) + __uint_as_float(r[1]); }
__device__ __forceinline__ void phase_peer_gather(Frame& F) {
    const unsigned char* UB = WSP(unsigned char, WS_UB8); const unsigned char* VB = WSP(unsigned char, WS_VB8); const float* RSU = WSP(float, WS_RSU); const float* RSV = WSP(float, WS_RSV);
    const unsigned* EXPO = WSP(unsigned, WS_EXP);
    const bf16_t* H1G = WSP(bf16_t, WS_H1G); bf16_t* XN3 = WSP(bf16_t, WS_XN3); const float* H1 = WSP(float, WS_H1); float* H2 = F.out; const float* SSQ1 = WSP(float, WS_SSQ1); const float* g_ple = F.in[16];
    const int l = F.lane; const int ntok_wg = T_TOK / F.G;
    for (int ti = F.wave; ti < ntok_wg; ti += NWAVES) { const int t = F.vcu * ntok_wg + ti;
        float x[16];
        { const u32x4 xa = *(const u32x4*)(H1G + (size_t)t * 1024 + 16 * l), xb = *(const u32x4*)(H1G + (size_t)t * 1024 + 16 * l + 8);
          x[0] = bf_lo(xa.x); x[1] = bf_hi(xa.x); x[2] = bf_lo(xa.y); x[3] = bf_hi(xa.y); x[4] = bf_lo(xa.z); x[5] = bf_hi(xa.z); x[6] = bf_lo(xa.w); x[7] = bf_hi(xa.w);
          x[8] = bf_lo(xb.x); x[9] = bf_hi(xb.x); x[10] = bf_lo(xb.y); x[11] = bf_hi(xb.y); x[12] = bf_lo(xb.z); x[13] = bf_hi(xb.z); x[14] = bf_lo(xb.w); x[15] = bf_hi(xb.w); }
        float rstd1; { const f32x4* sp = (const f32x4*)(SSQ1 + (size_t)t * 16); const f32x4 st = (sp[0] + sp[1]) + (sp[2] + sp[3]); rstd1 = __builtin_amdgcn_rsqf(((st[0] + st[1]) + (st[2] + st[3])) * (1.0f / 1024.0f) + EPS); }
        const unsigned e0 = EXPO[(size_t)t * 128 + l], e1 = EXPO[(size_t)t * 128 + 64 + l];
        const float cu0 = RSU[e0 & 0x3fffu] * rstd1, cu1 = RSU[e1 & 0x3fffu] * rstd1;
        const float cv0 = RSV[e0 & 0x3fffu] * __uint_as_float(e0 & ~0x3fffu), cv1 = RSV[e1 & 0x3fffu] * __uint_as_float(e1 & ~0x3fffu);
        float acc[16];
#pragma unroll
        for (int i = 0; i < 16; ++i) acc[i] = 0.f;
#pragma unroll 1
        for (int eb = 0; eb < 128; eb += 16) {
            u32x4 uw[16], vw[16];
#pragma unroll
            for (int k = 0; k < 16; ++k) { const int e = eb + k; const unsigned ent = (e < 64) ? __builtin_amdgcn_readlane(e0, e & 63) : __builtin_amdgcn_readlane(e1, e & 63);
                const size_t ro = (size_t)(ent & 0x3fffu) * 1024 + 16 * l; uw[k] = *(const u32x4*)(UB + ro); vw[k] = *(const u32x4*)(VB + ro); }
            float p[16];
#pragma unroll
            for (int k = 0; k < 16; ++k) { float f[16]; FP8_UNPACK16(uw[k], f); float s = 0.f;
#pragma unroll
                for (int i = 0; i < 16; ++i) s += f[i] * x[i];
                p[k] = s; }
            float q8[8], q4[4], q2[2], q1;
#pragma unroll
            for (int j = 0; j < 8; ++j) q8[j] = sum_swap32(p[j], p[8 + j]);
#pragma unroll
            for (int j = 0; j < 4; ++j) q4[j] = sum_swap16(q8[j], q8[4 + j]);
            { const bool up = (l & 8) != 0;
#pragma unroll
              for (int j = 0; j < 2; ++j) { const float keep = up ? q4[2 + j] : q4[j], send = up ? q4[j] : q4[2 + j]; q2[j] = keep + __shfl_xor(send, 8); } }
            { const bool up = (l & 4) != 0; const float keep = up ? q2[1] : q2[0], send = up ? q2[0] : q2[1]; q1 = keep + __shfl_xor(send, 4); }
            q1 += __shfl_xor(q1, 2); q1 += __shfl_xor(q1, 1);
            const int ei = eb + (l >> 2);
            const float cu = (ei < 64) ? __shfl(cu0, ei & 63) : __shfl(cu1, ei & 63), cv = (ei < 64) ? __shfl(cv0, ei & 63) : __shfl(cv1, ei & 63);
            const float a = gelu_tanh(q1 * cu) * cv;
#pragma unroll
            for (int k = 0; k < 16; ++k) { const float ak = __uint_as_float(__builtin_amdgcn_readlane(__float_as_uint(a), 4 * k)); float f[16]; FP8_UNPACK16(vw[k], f);
#pragma unroll
                for (int i = 0; i < 16; ++i) acc[i] += ak * f[i]; }
        }
        const float* hrow = H1 + (size_t)t * 1024 + 16 * l; float* h2row = H2 + (size_t)t * 1024 + 16 * l; float ss = 0.f; f32x4 h[4];
#pragma unroll
        for (int q = 0; q < 4; ++q) { h[q] = *(const f32x4*)(hrow + 4 * q);
#pragma unroll
            for (int j = 0; j < 4; ++j) { h[q][j] += acc[4 * q + j]; ss += h[q][j] * h[q][j]; }
            *(f32x4*)(h2row + 4 * q) = h[q]; }
        const float rstd3 = __builtin_amdgcn_rsqf(wave_sum(ss) * (1.0f / 1024.0f) + EPS);
        u32x4 o[2];
#pragma unroll
        for (int q2 = 0; q2 < 2; ++q2) { const f32x4 g0 = *(const f32x4*)(g_ple + 16 * l + 8 * q2), g1 = *(const f32x4*)(g_ple + 16 * l + 8 * q2 + 4);
            const f32x4 a = h[2 * q2] * rstd3 * g0, c = h[2 * q2 + 1] * rstd3 * g1;
            o[q2].x = cvtpk(a[0], a[1]); o[q2].y = cvtpk(a[2], a[3]); o[q2].z = cvtpk(c[0], c[1]); o[q2].w = cvtpk(c[2], c[3]); }
        *(u32x4*)(XN3 + (size_t)t * 1024 + 16 * l) = o[0]; *(u32x4*)(XN3 + (size_t)t * 1024 + 16 * l + 8) = o[1];
    }
}

__device__ __forceinline__ void phase_final(Frame& F) {
    const float* SSQ3 = WSP(float, WS_SSQ3); const float* g = F.in[19];
    const int l = F.lane; const int gw = F.vcu * NWAVES + F.wave, NGW = F.G * NWAVES;
    for (int t = gw; t < T_TOK; t += NGW) {
        const f32x4* sp = (const f32x4*)(SSQ3 + (size_t)t * 16); const f32x4 st = (sp[0] + sp[1]) + (sp[2] + sp[3]);
        const float rstd = __builtin_amdgcn_rsqf(((st[0] + st[1]) + (st[2] + st[3])) * (1.0f / 1024.0f) + EPS);
        f32x4* row = (f32x4*)(F.out + (size_t)t * 1024);
#pragma unroll
        for (int j = 0; j < 4; ++j) { const f32x4 gv = *((const f32x4*)g + l + 64 * j); const f32x4 o = row[l + 64 * j] * rstd * gv; if (!F.dry) row[l + 64 * j] = o; }
    }
}
#ifndef MK_FUSED
#define MK_FUSED 1
#endif
constexpr int NPHASE = 11;
struct Args { const float* in[20]; float* out; unsigned char* ws; int ph_lo, ph_hi, dry, pad; };
static_assert(sizeof(Args) == 20 * 8 + 8 + 8 + 4 * 4, "Args has no padding");

__global__ void __launch_bounds__(NWAVES * 64, 2) mk_fwd(Args args) {
    extern __shared__ __attribute__((aligned(16))) unsigned char lds_raw[];
    Frame F;
    F.lds = (LAS unsigned char*)lds_raw;
    F.wave = __builtin_amdgcn_readfirstlane(threadIdx.x >> 6); F.lane = lane_id(); F.tid = F.wave * 64 + F.lane;
    F.G = gridDim.x; { const int bx = blockIdx.x; F.vcu = (F.G % 8 == 0) ? (bx % 8) * (F.G / 8) + bx / 8 : bx; }
    F.in = args.in; F.out = args.out; F.ws = args.ws; F.dry = args.dry;
    volatile LAS unsigned* MISC = (volatile LAS unsigned*)(F.lds + MISC_OFF);
    if (F.tid < 64) MISC[F.tid] = 0u;
    __syncthreads();
    const int lo = args.ph_lo, hi = args.ph_hi;
    XcdBarrier bar; bar.bar = (unsigned*)(F.ws + WS_CTL) + CW_BAR; bar.x = 0; bar.st = nullptr;
    if (hi - lo > 1) bar = xcd_barrier_post((unsigned*)(F.ws + WS_CTL) + CW_BAR, MISC + 8, F.tid);
#ifndef PH_MASK
#define PH_MASK 0xFFFFFFFFu
#endif
#define IN(k) (((PH_MASK >> (k)) & 1u) && lo <= (k) && (k) < hi)
#define LAUNDER(p, T) do { unsigned _lo = (unsigned)(unsigned long long)(p), _hi = (unsigned)((unsigned long long)(p) >> 32); asm volatile("" : "+v"(_lo), "+v"(_hi)); \
        _lo = __builtin_amdgcn_readfirstlane(_lo); _hi = __builtin_amdgcn_readfirstlane(_hi); (p) = (T)(((unsigned long long)_hi << 32) | _lo); } while (0)
#define SEAM(k) do { if (IN(k) && IN((k) + 1)) xcd_barrier(bar, F.tid); LAUNDER(F.ws, unsigned char*); LAUNDER(F.out, float*); F.lane = lane_id(); F.tid = F.wave * 64 + F.lane; } while (0)
    const int bx = (int)blockIdx.x;
    LAS unsigned char* ring = F.lds + RING_OFF;

    if (IN(0)) { phase_prologue(F); } SEAM(0);
    if (IN(1)) {
        pg8::Gemm g{WSP(bf16_t, WS_XN1), WSP(bf16_t, WS_WIN), T_TOK, 8192, 1024, 1024, 0}; pg8::StaticOrder S; S.init(T_TOK, 8192, F.G, bx);
        pg8::EpiProj E{WSP(bf16_t, WS_GQ), WSP(bf16_t, WS_GK), WSP(bf16_t, WS_GV), WSP(bf16_t, WS_GR), WSP(bf16_t, WS_SQ), WSP(bf16_t, WS_SK), WSP(bf16_t, WS_SV),
                       (bf16_t*)F.out, (bf16_t*)F.out + (size_t)T_TOK * 1024};
        pg8::gemm_phase<pg8::EpiProj>(ring, g, S, E, F.tid);
    } SEAM(1);
    if (IN(2)) { phase_gla_prep(F); } SEAM(2);
    if (IN(3)) { phase_attn_a(F); } SEAM(3);
    if (IN(4)) { phase_attn_b(F); } SEAM(4);
    if (IN(5)) {
        cvt_rows_fp8(F, F.in[14], WSP(unsigned char, WS_UB8), WSP(float, WS_RSU));
        cvt_rows_fp8(F, F.in[15], WSP(unsigned char, WS_VB8), WSP(float, WS_RSV));
        VM_WAIT(); __syncthreads();
        pg8::StaticOrder S; S.init(T_TOK, 1024, F.G, bx);
        { pg8::Gemm g{WSP(bf16_t, WS_GLAN), WSP(bf16_t, WS_WGA), T_TOK, 1024, 1024, 1024, 0}; pg8::EpiMix<true> E{(const bf16_t*)F.out, WSP(bf16_t, WS_MIX)};
          pg8::gemm_phase<pg8::EpiMix<true>>(ring, g, S, E, F.tid); }
        { pg8::Gemm g{WSP(bf16_t, WS_SQ), WSP(bf16_t, WS_WSB), T_TOK, 1024, 1024, 1024, 0}; pg8::EpiMix<false> E{(const bf16_t*)F.out + (size_t)T_TOK * 1024, WSP(bf16_t, WS_MIX)};
          pg8::gemm_phase<pg8::EpiMix<false>>(ring, g, S, E, F.tid); }
    } SEAM(5);
    if (IN(6)) {
        pg8::Gemm g{WSP(bf16_t, WS_MIX), WSP(bf16_t, WS_WO), T_TOK, 1024, 1024, 1024, 0}; pg8::StaticOrder S; S.init(T_TOK, 1024, F.G, bx);
        pg8::EpiH1 E{F.in[0], F.in[10], WSP(float, WS_H1), WSP(bf16_t, WS_H1G), WSP(float, WS_SSQ1)};
        pg8::gemm_phase<pg8::EpiH1>(ring, g, S, E, F.tid);
    } SEAM(6);
    if (IN(7)) {
        pg8::Gemm g{WSP(bf16_t, WS_H1G), WSP(bf16_t, WS_WPQ), T_TOK, 2048, 1024, 1024, 0}; pg8::StaticOrder S; S.init(T_TOK, 2048, F.G, bx);
        pg8::EpiQ E{WSP(float, WS_SSQ1), WSP(bf16_t, WS_Q), 2048};
        pg8::gemm_phase<pg8::EpiQ>(ring, g, S, E, F.tid);
    } SEAM(7);
    if (IN(8)) {
        cvt_copy(F, F.in[1], WSP(bf16_t, WS_PB), (size_t)T_TOK * 256);
        phase_peer_retrieve(F);
        VM_WAIT(); __syncthreads();
        phase_peer_gather(F);
    } SEAM(8);
    if (IN(9)) {
        pg8::StaticOrder S; S.init(T_TOK, 1024, F.G, bx);
        { pg8::Gemm g{WSP(bf16_t, WS_PB), WSP(bf16_t, WS_WPLE), T_TOK, 1024, 256, 256, 0}; pg8::EpiBf E{WSP(bf16_t, WS_PLE), 1024};
          pg8::gemm_phase<pg8::EpiBf>(ring, g, S, E, F.tid); }
        { pg8::Gemm g{WSP(bf16_t, WS_XN3), WSP(bf16_t, WS_WPG), T_TOK, 1024, 1024, 1024, 0}; pg8::EpiH3 E{F.out, WSP(bf16_t, WS_PLE), F.out, WSP(float, WS_SSQ3), F.dry};
          pg8::gemm_phase<pg8::EpiH3>(ring, g, S, E, F.tid); }
    } SEAM(9);
    if (IN(10)) { phase_final(F); }
#undef IN
#undef SEAM
}

extern "C" void kernel_launch(void* const* d_in, const int* in_sizes, int n_in, void* d_out, int out_size, void* d_ws, size_t ws_size, hipStream_t stream) {
    static int grid = 0;
    if (grid == 0) {
        if (n_in != 20 || in_sizes[0] != T_TOK * 1024 || out_size != T_TOK * 1024 || ws_size < WS_END) {
            fprintf(stderr, "kernel_launch: unexpected shapes (n_in %d, in0 %d, out %d, ws %zu < %zu?); nothing launched\n", n_in, n_in > 0 ? in_sizes[0] : -1, out_size, ws_size, (size_t)WS_END); grid = -1; return; }
        int dev = 0, cus = 0, per_cu = 0;
        if (hipGetDevice(&dev) != hipSuccess || hipDeviceGetAttribute(&cus, hipDeviceAttributeMultiprocessorCount, dev) != hipSuccess) { grid = -1; return; }
        if (hipFuncSetAttribute((const void*)mk_fwd, hipFuncAttributeMaxDynamicSharedMemorySize, LDS_BYTES) != hipSuccess) { fprintf(stderr, "kernel_launch: hipFuncSetAttribute failed\n"); grid = -1; return; }
        if (hipOccupancyMaxActiveBlocksPerMultiprocessor(&per_cu, (const void*)mk_fwd, NWAVES * 64, LDS_BYTES) != hipSuccess || per_cu < 1)
            fprintf(stderr, "kernel_launch: note: occupancy query reports %d workgroups per CU\n", per_cu);
        (void)hipGetLastError();
        grid = cus;
        if (grid != 256) fprintf(stderr, "kernel_launch: note: %d CUs (kernel tuned for 256)\n", grid);
    }
    if (grid < 0) return;
    if (hipMemsetAsync((char*)d_ws + WS_CTL, 0, CTL_ZERO_BYTES, stream) != hipSuccess) { fprintf(stderr, "kernel_launch: hipMemsetAsync failed\n"); return; }
    Args a{};
    for (int i = 0; i < 20; ++i) a.in[i] = (const float*)d_in[i];
    a.out = (float*)d_out; a.ws = (unsigned char*)d_ws;
#if MK_FUSED
    a.ph_lo = 0; a.ph_hi = NPHASE;
    hipLaunchKernelGGL(mk_fwd, dim3(grid), dim3(NWAVES * 64), LDS_BYTES, stream, a);
#else
#ifndef PROBE_PHASE
#define PROBE_PHASE -1
#define PROBE_REPS 0
#endif
    for (int p = 0; p < NPHASE; ++p) { a.ph_lo = p; a.ph_hi = p + 1;
        if (p == PROBE_PHASE) { a.dry = 1; for (int r = 0; r < PROBE_REPS; ++r) hipLaunchKernelGGL(mk_fwd, dim3(grid), dim3(NWAVES * 64), LDS_BYTES, stream, a); a.dry = 0; }
        hipLaunchKernelGGL(mk_fwd, dim3(grid), dim3(NWAVES * 64), LDS_BYTES, stream, a); }
#endif
}
```

```cpp
#define MK_FUSED 1
#include <hip/hip_runtime.h>
#include <cstdio>
#include <cstdint>

#define LAS __attribute__((address_space(3)))
#define GAS __attribute__((address_space(1)))
typedef unsigned short bf16_t;
typedef short bf16x8 __attribute__((ext_vector_type(8)));
typedef short s16x4 __attribute__((ext_vector_type(4)));
typedef float f32x2 __attribute__((ext_vector_type(2)));
typedef float f32x4 __attribute__((ext_vector_type(4)));
typedef float f32x16 __attribute__((ext_vector_type(16)));
typedef unsigned u32x2 __attribute__((ext_vector_type(2)));
typedef unsigned u32x4 __attribute__((ext_vector_type(4)));
typedef __bf16 bf16x2_t __attribute__((ext_vector_type(2)));

__device__ __forceinline__ unsigned cvtpk(float lo, float hi) { f32x2 v = {lo, hi}; bf16x2_t b = __builtin_convertvector(v, bf16x2_t); return __builtin_bit_cast(unsigned, b); }
__device__ __forceinline__ float bf_lo(unsigned u) { return __uint_as_float(u << 16); }
__device__ __forceinline__ float bf_hi(unsigned u) { return __uint_as_float(u & 0xffff0000u); }
__device__ __forceinline__ float bf1(bf16_t u) { return __uint_as_float(((unsigned)u) << 16); }
__device__ __forceinline__ float fast_sigmoid(float x) { return __builtin_amdgcn_rcpf(1.0f + __expf(-x)); }

namespace pg8 {
constexpr int BM = 256, BK = 64, HALF = 128, HTB = HALF * BK * 2  , STAGE_BYTES = 8 * HTB, NXCD = 8, WGM = 8;

__host__ __device__ __forceinline__ int lds_byte(int r, int c) { const int st = (r >> 4) * 2 + (c >> 5), rr = r & 15, cc = c & 31, ob = rr * 64 + cc * 2; return st * 1024 + (ob ^ (((ob >> 9) & 1) << 5)); }
__host__ __device__ __forceinline__ void stage_rc(int b, int& R, int& C) { const int st = b / 1024, sb = b % 1024, swz = sb ^ (((sb >> 9) & 1) << 5); R = (st >> 1) * 16 + swz / 64; C = (st & 1) * 32 + (swz % 64) / 2; }
__host__ __device__ __forceinline__ int perm32(int rho) { const int n = rho >> 4, i = rho & 15; return 8 * (i >> 2) + 4 * n + (i & 3); }

struct Unit { int pm, pn; };
struct Gemm { const bf16_t* A; const bf16_t* Bt; int M, N, K, lda, a_pn_cols; };

struct StaticOrder {
    int nM, nN, nwg, G, c;
    __host__ __device__ void init(int M, int N, int G_, int c_) { nM = M / BM; nN = N / BM; nwg = nM * nN; G = G_; c = c_; }
    __host__ __device__ bool next(int i, Unit& u) const {
        const long L = (long)i * G + c; if (L >= nwg) return false;
        int wgid = (int)L; { const int q = nwg / NXCD, r = nwg % NXCD, xcd = wgid % NXCD, off = wgid / NXCD; wgid = (xcd < r ? xcd * (q + 1) : r * (q + 1) + (xcd - r) * q) + off; }
        const int nig = WGM * nN, gid = wgid / nig, fm = gid * WGM, gsz = (nM - fm) < WGM ? (nM - fm) : WGM;
        u.pm = fm + ((wgid % nig) % gsz); u.pn = (wgid % nig) / gsz; return true;
    }
};

template <class Epi, bool ALIGN_EPI = true, bool SP2 = true>
__device__ __forceinline__ void gemm_phase(LAS unsigned char* lds, const Gemm g, const StaticOrder& S, const Epi& E, int tid) {
    const int wid = __builtin_amdgcn_readfirstlane(tid >> 6), lane = tid & 63, wr = wid >> 2, wc = wid & 3, fr = lane & 15, fq = lane >> 4;
    const int K = g.K, nt = K / BK, lda = g.lda;
    unsigned voffA[2], voffB[2];
#pragma unroll
    for (int i = 0; i < 2; ++i) { int R, C; stage_rc(tid * 16 + i * 8192, R, C); const int Rb = Epi::PERM ? ((R & ~31) + perm32(R & 31)) : R;
        voffA[i] = (unsigned)(R * lda + C) * 2u; voffB[i] = (unsigned)(Rb * K + C) * 2u; }
    const size_t kstep = (size_t)(BK * 2);
    const size_t hA = (size_t)HALF * lda * 2, hB = (size_t)HALF * K * 2;
    const size_t tA = 2 * hA, tB = 2 * hB;
    const size_t pnA = (size_t)g.a_pn_cols * 2;
    const unsigned ldsw = (unsigned)wid * 1024u;
    const int aoff = lds_byte(wr * 64 + fr, fq * 8), boff = lds_byte(wc * 32 + fr, fq * 8);
#define PG8_SA(b, h) (((b) * 2 + (h)) * HTB)
#define PG8_SB(b, h) ((4 + (b) * 2 + (h)) * HTB)
#define PG8_STAGE(bufoff, gbase, voff) do { _Pragma("unroll") for (int _i = 0; _i < 2; ++_i) \
        __builtin_amdgcn_global_load_lds((const unsigned*)((const char*)(gbase) + (voff)[_i]), (LAS unsigned*)(lds + (bufoff) + ldsw + _i * 8192), 16, 0, 0); } while (0)
#define PG8_LDA(dst, b, h) do { _Pragma("unroll") for (int m = 0; m < 4; ++m) _Pragma("unroll") for (int k = 0; k < 2; ++k) dst[m][k] = *(const LAS bf16x8*)(lds + PG8_SA(b, h) + aoff + m * 2048 + k * 1024); } while (0)
#define PG8_LDB(dst, b, h) do { _Pragma("unroll") for (int n = 0; n < 2; ++n) _Pragma("unroll") for (int k = 0; k < 2; ++k) dst[n][k] = *(const LAS bf16x8*)(lds + PG8_SB(b, h) + boff + n * 2048 + k * 1024); } while (0)
#define PG8_MMA(ai, bj, At, Bt) do { __builtin_amdgcn_s_setprio(1); _Pragma("unroll") for (int m = 0; m < 4; ++m) _Pragma("unroll") for (int n = 0; n < 2; ++n) _Pragma("unroll") for (int k = 0; k < 2; ++k) \
        acc[ai][bj][m][n] = __builtin_amdgcn_mfma_f32_16x16x32_bf16(Bt[n][k], At[m][k], acc[ai][bj][m][n], 0, 0, 0); __builtin_amdgcn_s_setprio(0); } while (0)
#define PG8_WAIT_V(n) asm volatile("s_waitcnt vmcnt(" #n ")" ::: "memory")
#define PG8_WAIT_L(n) asm volatile("s_waitcnt lgkmcnt(" #n ")" ::: "memory")
#define PG8_BAR __builtin_amdgcn_s_barrier()
#define PG8_SCHED __builtin_amdgcn_sched_barrier(0)
    Unit cur, nxt; int ui = 0;
    if (!S.next(0, cur)) return;
    f32x4 acc[2][2][4][2];
#pragma unroll
    for (int a = 0; a < 2; ++a)
#pragma unroll
        for (int b = 0; b < 2; ++b)
#pragma unroll
            for (int m = 0; m < 4; ++m)
#pragma unroll
                for (int n = 0; n < 2; ++n) acc[a][b][m][n] = (f32x4){0.f, 0.f, 0.f, 0.f};
    bf16x8 At[4][2], B0[2][2], B1[2][2];
    const char* cA = (const char*)g.A + (size_t)cur.pm * tA + (size_t)cur.pn * pnA; const char* cB = (const char*)g.Bt + (size_t)cur.pn * tB;
    if constexpr (SP2) {
        PG8_STAGE(PG8_SB(0, 0), cB, voffB); PG8_STAGE(PG8_SB(0, 1), cB + hB, voffB); PG8_STAGE(PG8_SA(0, 0), cA, voffA); PG8_STAGE(PG8_SA(0, 1), cA + hA, voffA);
        if (wr == 1) PG8_BAR;
        PG8_WAIT_V(2); PG8_BAR;
        PG8_STAGE(PG8_SB(1, 0), cB + kstep, voffB); PG8_STAGE(PG8_SA(1, 0), cA + kstep, voffA); PG8_STAGE(PG8_SB(1, 1), cB + hB + kstep, voffB);
        PG8_WAIT_V(6); PG8_BAR;
    } else {
        PG8_STAGE(PG8_SB(0, 0), cB, voffB); PG8_STAGE(PG8_SA(0, 0), cA, voffA); PG8_STAGE(PG8_SB(0, 1), cB + hB, voffB); PG8_STAGE(PG8_SA(0, 1), cA + hA, voffA);
        if (wr == 1) PG8_BAR;
        PG8_WAIT_V(4); PG8_BAR;
        PG8_STAGE(PG8_SB(1, 0), cB + kstep, voffB); PG8_STAGE(PG8_SA(1, 0), cA + kstep, voffA); PG8_STAGE(PG8_SB(1, 1), cB + hB + kstep, voffB);
        PG8_WAIT_V(6); PG8_BAR;
    }
    for (;;) {
        const bool has_next = S.next(ui + 1, nxt);
        const char* nA = has_next ? (const char*)g.A + (size_t)nxt.pm * tA + (size_t)nxt.pn * pnA : cA; const char* nB = has_next ? (const char*)g.Bt + (size_t)nxt.pn * tB : cB;
#pragma unroll 1
        for (int t = 0; t < nt; t += 2) {
            const bool last = (t == nt - 2);
            const char* a1 = cA + (size_t)(t + 1) * kstep;
            const char* a2 = last ? nA : cA + (size_t)(t + 2) * kstep; const char* b2 = last ? nB : cB + (size_t)(t + 2) * kstep;
            const char* a3 = a2 + kstep; const char* b3 = b2 + kstep;
            if constexpr (SP2) {
            PG8_LDB(B0, 0, 0); PG8_LDB(B1, 0, 1); PG8_SCHED; PG8_LDA(At, 0, 0); PG8_STAGE(PG8_SA(1, 1), a1 + hA, voffA);
            PG8_WAIT_V(8); PG8_WAIT_L(0); PG8_BAR; PG8_MMA(0, 0, At, B0); PG8_MMA(0, 1, At, B1); PG8_BAR; PG8_SCHED;
            PG8_LDA(At, 0, 1); PG8_STAGE(PG8_SB(0, 0), b2, voffB); PG8_STAGE(PG8_SB(0, 1), b2 + hB, voffB); PG8_STAGE(PG8_SA(0, 0), a2, voffA);
            PG8_WAIT_V(8); PG8_WAIT_L(0); PG8_BAR; PG8_MMA(1, 0, At, B0); PG8_MMA(1, 1, At, B1); PG8_BAR; PG8_SCHED;
            PG8_LDB(B0, 1, 0); PG8_LDB(B1, 1, 1); PG8_SCHED; PG8_LDA(At, 1, 0); PG8_STAGE(PG8_SA(0, 1), a2 + hA, voffA);
            PG8_WAIT_V(8); PG8_WAIT_L(0); PG8_BAR; PG8_MMA(0, 0, At, B0); PG8_MMA(0, 1, At, B1); PG8_BAR; PG8_SCHED;
            PG8_LDA(At, 1, 1); PG8_STAGE(PG8_SB(1, 0), b3, voffB); PG8_STAGE(PG8_SB(1, 1), b3 + hB, voffB); PG8_STAGE(PG8_SA(1, 0), a3, voffA);
            PG8_WAIT_V(8); PG8_WAIT_L(0); PG8_BAR; PG8_MMA(1, 0, At, B0); PG8_MMA(1, 1, At, B1); PG8_BAR; PG8_SCHED;
            } else {
            PG8_LDB(B0, 0, 0); PG8_SCHED; PG8_LDA(At, 0, 0); PG8_STAGE(PG8_SA(1, 1), a1 + hA, voffA);
            PG8_WAIT_L(8); PG8_BAR; PG8_WAIT_L(0); PG8_MMA(0, 0, At, B0); PG8_BAR; PG8_SCHED;
            PG8_LDB(B1, 0, 1); PG8_STAGE(PG8_SB(0, 0), b2, voffB);
            PG8_BAR; PG8_WAIT_L(0); PG8_MMA(0, 1, At, B1); PG8_BAR;
            PG8_LDA(At, 0, 1); PG8_STAGE(PG8_SA(0, 0), a2, voffA);
            PG8_BAR; PG8_WAIT_L(0); PG8_MMA(1, 0, At, B0); PG8_BAR; PG8_SCHED;
            PG8_STAGE(PG8_SB(0, 1), b2 + hB, voffB);
            PG8_WAIT_V(6); PG8_BAR; PG8_MMA(1, 1, At, B1); PG8_BAR;
            PG8_LDB(B0, 1, 0); PG8_SCHED; PG8_LDA(At, 1, 0); PG8_STAGE(PG8_SA(0, 1), a2 + hA, voffA);
            PG8_WAIT_L(8); PG8_BAR; PG8_WAIT_L(0); PG8_MMA(0, 0, At, B0); PG8_BAR; PG8_SCHED;
            PG8_LDB(B1, 1, 1); PG8_STAGE(PG8_SB(1, 0), b3, voffB);
            PG8_BAR; PG8_WAIT_L(0); PG8_MMA(0, 1, At, B1); PG8_BAR;
            PG8_LDA(At, 1, 1); PG8_STAGE(PG8_SA(1, 0), a3, voffA);
            PG8_BAR; PG8_WAIT_L(0); PG8_MMA(1, 0, At, B0); PG8_BAR; PG8_SCHED;
            PG8_STAGE(PG8_SB(1, 1), b3 + hB, voffB);
            PG8_WAIT_V(6); PG8_BAR; PG8_MMA(1, 1, At, B1); PG8_BAR;
            }
        }
        if constexpr (ALIGN_EPI) { if (wr == 0) PG8_BAR; }
        E(acc, cur, wr, wc, fr, fq);
        if (!has_next) break;
#pragma unroll
        for (int a = 0; a < 2; ++a)
#pragma unroll
            for (int b = 0; b < 2; ++b)
#pragma unroll
                for (int m = 0; m < 4; ++m)
#pragma unroll
                    for (int n = 0; n < 2; ++n) acc[a][b][m][n] = (f32x4){0.f, 0.f, 0.f, 0.f};
        cur = nxt; cA = nA; cB = nB; ++ui;
        if constexpr (ALIGN_EPI) { if (wr == 1) PG8_BAR; }
    }
    PG8_WAIT_V(0);
    if constexpr (!ALIGN_EPI) { if (wr == 0) PG8_BAR; }
    PG8_BAR;
#undef PG8_SA
#undef PG8_SB
#undef PG8_STAGE
#undef PG8_LDA
#undef PG8_LDB
#undef PG8_MMA
#undef PG8_WAIT_V
#undef PG8_WAIT_L
#undef PG8_BAR
#undef PG8_SCHED
}
}
constexpr int T_TOK = 16384, DM = 1024, SEQ = 4096, NB = 4;
constexpr float EPS = 1e-6f;
constexpr float LOG2E = 1.4426950408889634f;

namespace pg8 {
struct EpiProj {
    static constexpr bool PERM = true;
    bf16_t *GQ, *GK, *GV, *GR, *SQ, *SK, *SV, *SGA, *SGB;
    __device__ __forceinline__ void operator()(const f32x4 (&acc)[2][2][4][2], const Unit& u, int wr, int wc, int fr, int fq) const {
        const int pn = u.pn; bf16_t* base; int ldc = 1024, c0; int act = 0; float sc = 1.f;
        if (pn < 2) { base = GQ; ldc = 512; c0 = pn * 256; sc = 0.08838834764831845f; }
        else if (pn < 4) { base = GK; ldc = 512; c0 = (pn - 2) * 256; }
        else if (pn < 8) { base = GV; c0 = (pn - 4) * 256; }
        else if (pn < 12) { base = GR; c0 = (pn - 8) * 256; act = 1; }
        else if (pn < 16) { base = SQ; c0 = (pn - 12) * 256; sc = 0.125f * LOG2E; }
        else if (pn < 20) { base = SK; c0 = (pn - 16) * 256; }
        else if (pn < 24) { base = SV; c0 = (pn - 20) * 256; }
        else if (pn < 28) { base = SGA; c0 = (pn - 24) * 256; act = 2; }
        else { base = SGB; c0 = (pn - 28) * 256; act = 2; }
        const int row0 = u.pm * BM + wr * 64 + fr, col0 = c0 + wc * 32 + 8 * fq;
#pragma unroll
        for (int ai = 0; ai < 2; ++ai)
#pragma unroll
            for (int m = 0; m < 4; ++m) { bf16_t* rowp = base + (size_t)(row0 + ai * HALF + m * 16) * ldc + col0;
#pragma unroll
                for (int bj = 0; bj < 2; ++bj) { f32x4 v0 = acc[ai][bj][m][0], v1 = acc[ai][bj][m][1];
                    if (act == 1) {
#pragma unroll
                        for (int j = 0; j < 4; ++j) { v0[j] = v0[j] * fast_sigmoid(v0[j]); v1[j] = v1[j] * fast_sigmoid(v1[j]); } }
                    else if (act == 2) {
#pragma unroll
                        for (int j = 0; j < 4; ++j) { v0[j] = fast_sigmoid(v0[j]); v1[j] = fast_sigmoid(v1[j]); } }
                    else { v0 = v0 * sc; v1 = v1 * sc; }
                    u32x4 w; w.x = cvtpk(v0[0], v0[1]); w.y = cvtpk(v0[2], v0[3]); w.z = cvtpk(v1[0], v1[1]); w.w = cvtpk(v1[2], v1[3]);
                    *(u32x4*)(rowp + bj * HALF) = w; } }
    }
};
template <bool FIRST> struct EpiMix {
    static constexpr bool PERM = true;
    const bf16_t* gate; bf16_t* mixed;
    __device__ __forceinline__ void operator()(const f32x4 (&acc)[2][2][4][2], const Unit& u, int wr, int wc, int fr, int fq) const {
        const int row0 = u.pm * BM + wr * 64 + fr, col0 = u.pn * BM + wc * 32 + 8 * fq;
#pragma unroll
        for (int ai = 0; ai < 2; ++ai)
#pragma unroll
            for (int m = 0; m < 4; ++m) { const size_t off = (size_t)(row0 + ai * HALF + m * 16) * 1024 + col0;
#pragma unroll
                for (int bj = 0; bj < 2; ++bj) { const f32x4 a0 = acc[ai][bj][m][0], a1 = acc[ai][bj][m][1];
                    const u32x4 gv = *(const u32x4*)(gate + off + bj * HALF);
                    float r[8];
                    r[0] = a0[0] * bf_lo(gv.x); r[1] = a0[1] * bf_hi(gv.x); r[2] = a0[2] * bf_lo(gv.y); r[3] = a0[3] * bf_hi(gv.y);
                    r[4] = a1[0] * bf_lo(gv.z); r[5] = a1[1] * bf_hi(gv.z); r[6] = a1[2] * bf_lo(gv.w); r[7] = a1[3] * bf_hi(gv.w);
                    if (!FIRST) { const u32x4 mv = *(const u32x4*)(mixed + off + bj * HALF);
                        r[0] += bf_lo(mv.x); r[1] += bf_hi(mv.x); r[2] += bf_lo(mv.y); r[3] += bf_hi(mv.y); r[4] += bf_lo(mv.z); r[5] += bf_hi(mv.z); r[6] += bf_lo(mv.w); r[7] += bf_hi(mv.w); }
                    u32x4 w; w.x = cvtpk(r[0], r[1]); w.y = cvtpk(r[2], r[3]); w.z = cvtpk(r[4], r[5]); w.w = cvtpk(r[6], r[7]);
                    *(u32x4*)(mixed + off + bj * HALF) = w; } }
    }
};
struct EpiH1 {
    static constexpr bool PERM = false;
    const float* x; const float* g; float* H1; bf16_t* H1G; float* SSQ;
    __device__ __forceinline__ void operator()(const f32x4 (&acc)[2][2][4][2], const Unit& u, int wr, int wc, int fr, int fq) const {
        const int row0 = u.pm * BM + wr * 64 + fr, col0 = u.pn * BM + wc * 32 + 4 * fq;
        f32x4 gv[2][2];
#pragma unroll
        for (int bj = 0; bj < 2; ++bj)
#pragma unroll
            for (int n = 0; n < 2; ++n) gv[bj][n] = *(const f32x4*)(g + col0 + bj * HALF + n * 16);
#pragma unroll
        for (int ai = 0; ai < 2; ++ai)
#pragma unroll
            for (int m = 0; m < 4; ++m) { const int row = row0 + ai * HALF + m * 16; const size_t off = (size_t)row * 1024 + col0; float s = 0.f;
#pragma unroll
                for (int bj = 0; bj < 2; ++bj)
#pragma unroll
                    for (int n = 0; n < 2; ++n) { const f32x4 xv = *(const f32x4*)(x + off + bj * HALF + n * 16); const f32x4 h = xv + acc[ai][bj][m][n];
                        *(f32x4*)(H1 + off + bj * HALF + n * 16) = h; s += (h[0] * h[0] + h[1] * h[1]) + (h[2] * h[2] + h[3] * h[3]);
                        const f32x4 hg = h * gv[bj][n]; u32x2 w; w.x = cvtpk(hg[0], hg[1]); w.y = cvtpk(hg[2], hg[3]); *(u32x2*)(H1G + off + bj * HALF + n * 16) = w; }
                s += __shfl_xor(s, 16); s += __shfl_xor(s, 32);
                if (fq == 0) SSQ[(size_t)row * 16 + u.pn * 4 + wc] = s; }
    }
};
struct EpiQ {
    static constexpr bool PERM = true;
    const float* SSQ; bf16_t* Q; int ldc;
    __device__ __forceinline__ void operator()(const f32x4 (&acc)[2][2][4][2], const Unit& u, int wr, int wc, int fr, int fq) const {
        const int row0 = u.pm * BM + wr * 64 + fr, col0 = u.pn * BM + wc * 32 + 8 * fq;
#pragma unroll
        for (int ai = 0; ai < 2; ++ai)
#pragma unroll
            for (int m = 0; m < 4; ++m) { const int row = row0 + ai * HALF + m * 16; const f32x4* sp = (const f32x4*)(SSQ + (size_t)row * 16);
                const f32x4 s0 = sp[0], s1 = sp[1], s2 = sp[2], s3 = sp[3]; const f32x4 st = (s0 + s1) + (s2 + s3);
                const float rstd = __builtin_amdgcn_rsqf(((st[0] + st[1]) + (st[2] + st[3])) * (1.0f / 1024.0f) + EPS);
                bf16_t* rowp = Q + (size_t)row * ldc + col0;
#pragma unroll
                for (int bj = 0; bj < 2; ++bj) { const f32x4 v0 = acc[ai][bj][m][0] * rstd, v1 = acc[ai][bj][m][1] * rstd;
                    u32x4 w; w.x = cvtpk(v0[0], v0[1]); w.y = cvtpk(v0[2], v0[3]); w.z = cvtpk(v1[0], v1[1]); w.w = cvtpk(v1[2], v1[3]);
                    *(u32x4*)(rowp + bj * HALF) = w; } }
    }
};
struct EpiF32 {
    static constexpr bool PERM = false;
    float* O; int ldc;
    __device__ __forceinline__ void operator()(const f32x4 (&acc)[2][2][4][2], const Unit& u, int wr, int wc, int fr, int fq) const {
        const int row0 = u.pm * BM + wr * 64 + fr, col0 = u.pn * BM + wc * 32 + 4 * fq;
#pragma unroll
        for (int ai = 0; ai < 2; ++ai)
#pragma unroll
            for (int m = 0; m < 4; ++m) { float* rowp = O + (size_t)(row0 + ai * HALF + m * 16) * ldc + col0;
#pragma unroll
                for (int bj = 0; bj < 2; ++bj)
#pragma unroll
                    for (int n = 0; n < 2; ++n) *(f32x4*)(rowp + bj * HALF + n * 16) = acc[ai][bj][m][n]; }
    }
};
struct EpiBf {
    static constexpr bool PERM = true;
    bf16_t* O; int ldc;
    __device__ __forceinline__ void operator()(const f32x4 (&acc)[2][2][4][2], const Unit& u, int wr, int wc, int fr, int fq) const {
        const int row0 = u.pm * BM + wr * 64 + fr, col0 = u.pn * BM + wc * 32 + 8 * fq;
#pragma unroll
        for (int ai = 0; ai < 2; ++ai)
#pragma unroll
            for (int m = 0; m < 4; ++m) { bf16_t* rowp = O + (size_t)(row0 + ai * HALF + m * 16) * ldc + col0;
#pragma unroll
                for (int bj = 0; bj < 2; ++bj) { const f32x4 v0 = acc[ai][bj][m][0], v1 = acc[ai][bj][m][1];
                    u32x4 w; w.x = cvtpk(v0[0], v0[1]); w.y = cvtpk(v0[2], v0[3]); w.z = cvtpk(v1[0], v1[1]); w.w = cvtpk(v1[2], v1[3]);
                    *(u32x4*)(rowp + bj * HALF) = w; } }
    }
};
struct EpiH3 {
    static constexpr bool PERM = false;
    const float* H2; const bf16_t* PLE; float* OUT; float* SSQ; int dry;
    __device__ __forceinline__ void operator()(const f32x4 (&acc)[2][2][4][2], const Unit& u, int wr, int wc, int fr, int fq) const {
        const int row0 = u.pm * BM + wr * 64 + fr, col0 = u.pn * BM + wc * 32 + 4 * fq;
#pragma unroll
        for (int ai = 0; ai < 2; ++ai)
#pragma unroll
            for (int m = 0; m < 4; ++m) { const int row = row0 + ai * HALF + m * 16; const size_t off = (size_t)row * 1024 + col0; float s = 0.f;
#pragma unroll
                for (int bj = 0; bj < 2; ++bj)
#pragma unroll
                    for (int n = 0; n < 2; ++n) { const size_t o2 = off + bj * HALF + n * 16; const f32x4 hv = *(const f32x4*)(H2 + o2); const u32x2 pv = *(const u32x2*)(PLE + o2);
                        const f32x4 a = acc[ai][bj][m][n]; f32x4 h;
                        h[0] = hv[0] + bf_lo(pv.x) * fast_sigmoid(a[0]); h[1] = hv[1] + bf_hi(pv.x) * fast_sigmoid(a[1]);
                        h[2] = hv[2] + bf_lo(pv.y) * fast_sigmoid(a[2]); h[3] = hv[3] + bf_hi(pv.y) * fast_sigmoid(a[3]);
                        if (!dry) *(f32x4*)(OUT + o2) = h; s += (h[0] * h[0] + h[1] * h[1]) + (h[2] * h[2] + h[3] * h[3]); }
                s += __shfl_xor(s, 16); s += __shfl_xor(s, 32);
                if (fq == 0) SSQ[(size_t)row * 16 + u.pn * 4 + wc] = s;
                asm volatile("" ::: "memory"); }
    }
};
}
constexpr size_t MiB = 1u << 20;
constexpr size_t WS_CTL = 0, CTL_ZERO_BYTES = 64 * 1024;
constexpr size_t WS_PEND = 64 * 1024;
constexpr size_t WS_WPLE = 512 * 1024;
constexpr size_t WS_KD = 1 * MiB;
constexpr size_t WS_GLAG = 2 * MiB;
constexpr size_t WS_WIN = 3 * MiB;
constexpr size_t WS_SEND = 4 * MiB;
constexpr size_t WS_EXP = 4 * MiB;
constexpr size_t WS_SSQ1 = 13 * MiB;
constexpr size_t WS_SSQ3 = 14 * MiB;
constexpr size_t WS_RSU = 15 * MiB, WS_RSV = 15 * MiB + 64 * 1024;
constexpr size_t WS_WGA = 20 * MiB, WS_WSB = 22 * MiB, WS_WO = 24 * MiB, WS_WPG = 26 * MiB, WS_WPQ = 28 * MiB;
constexpr size_t WS_A = 32 * MiB;
constexpr size_t WS_GQ = WS_A, WS_GK = WS_A + 16 * MiB, WS_UB8 = WS_A, WS_VB8 = WS_A + 16 * MiB;
constexpr size_t WS_B = 64 * MiB;
constexpr size_t WS_GV = WS_B, WS_PB = WS_B;
constexpr size_t WS_C = 96 * MiB;
constexpr size_t WS_GR = WS_C, WS_H1 = WS_C;
constexpr size_t WS_D = 128 * MiB;
constexpr size_t WS_SQ = WS_D;
constexpr size_t WS_E = 160 * MiB;
constexpr size_t WS_SK = WS_E, WS_MIX = WS_E, WS_Q = WS_E, WS_XN3 = WS_E;
constexpr size_t WS_F = 192 * MiB;
constexpr size_t WS_SV = WS_F;
constexpr size_t WS_G = 224 * MiB;
constexpr size_t WS_XN1 = WS_G, WS_GLAN = WS_G, WS_H1G = WS_G, WS_PLE = WS_G;
constexpr size_t WS_END = 256 * MiB;

constexpr int NWAVES = 8;
constexpr int RING_OFF = 0, RING_BYTES = 131072;
constexpr int MISC_OFF = RING_BYTES;
constexpr int LDS_BYTES = 147456;
constexpr int CW_BAR = 1024;

typedef GAS unsigned gu32;
#define RLX_AGENT __ATOMIC_RELAXED, __HIP_MEMORY_SCOPE_AGENT
#define LDS_WAIT() asm volatile("s_waitcnt lgkmcnt(0)" ::: "memory")
#define VM_WAIT() asm volatile("s_waitcnt vmcnt(0)" ::: "memory")

#define XB_TMO      128
#define XB_XCNT(j)  (256  + 64 * (j))
#define XB_XSUB(j)  (1280 + 64 * (j))
#define XB_XGEN(j)  (2304 + 64 * (j))
#define XB_TOP      3328
#define XB_TOPGEN   3392
#define XCD_BAR_WORDS 3456
#define XB_SPIN_CAP (1u << 22)
__device__ __forceinline__ unsigned xb_ld(unsigned* p)              { return __hip_atomic_load(p, __ATOMIC_RELAXED, __HIP_MEMORY_SCOPE_AGENT); }
__device__ __forceinline__ unsigned xb_add(unsigned* p, unsigned v) { return __hip_atomic_fetch_add(p, v, __ATOMIC_RELAXED, __HIP_MEMORY_SCOPE_AGENT); }
__device__ __forceinline__ unsigned xb_xcc_id() { return (unsigned)__builtin_amdgcn_s_getreg((3 << 11) | 20) & 0xFu; }
#define XB_SPIN(cond, bar) do { unsigned _sp = 0; while (cond) { __builtin_amdgcn_s_sleep(1); \
    if ((++_sp & 255u) == 0u) { if (xb_ld(&(bar)[XB_TMO])) break; if (_sp > XB_SPIN_CAP) { atomicAdd(&(bar)[XB_TMO], 1u); break; } } } } while (0)
struct XcdBarrier { unsigned* bar; unsigned x; volatile LAS unsigned* st; };
__device__ __forceinline__ XcdBarrier xcd_barrier_post(unsigned* bar, volatile LAS unsigned* st, int tid) {
    XcdBarrier b; b.bar = bar; b.x = xb_xcc_id(); b.st = st;
    if (tid == 0) (void)xb_add(&bar[XB_XCNT(b.x)], 1u);
    return b;
}
__device__ __forceinline__ void xcd_barrier_complete(unsigned* bar, unsigned x, unsigned& nloc, unsigned& nx) {
    const unsigned G = gridDim.x * gridDim.y * gridDim.z;
    unsigned sum, cnt, mine, sp = 0u;
    for (;;) {
        sum = 0u; cnt = 0u; mine = 0u;
#pragma unroll
        for (unsigned j = 0; j < 16; ++j) { const unsigned c = xb_ld(&bar[XB_XCNT(j)]); sum += c; cnt += (c > 0u) ? 1u : 0u; mine = (j == x) ? c : mine; }
        if (sum == G) break;
        __builtin_amdgcn_s_sleep(1);
        if ((++sp & 255u) == 0u) { if (xb_ld(&bar[XB_TMO])) break; if (sp > XB_SPIN_CAP) { atomicAdd(&bar[XB_TMO], 1u); break; } }
    }
    nloc = mine > 0u ? mine : 1u; nx = cnt > 0u ? cnt : 1u;
}
__device__ __forceinline__ void xcd_barrier(const XcdBarrier& b, int tid) {
    asm volatile("s_waitcnt vmcnt(0)" ::: "memory");
    __syncthreads();
    if (tid == 0) {
        unsigned* bar = b.bar;
        __builtin_amdgcn_s_waitcnt(0);
        unsigned nloc = b.st[0], nx = b.st[1];
        if (nloc == 0u) { xcd_barrier_complete(bar, b.x, nloc, nx); b.st[0] = nloc; b.st[1] = nx; }
        const unsigned old = xb_add(&bar[XB_XSUB(b.x)], 1u);
        const unsigned gen = old / nloc;
        if (old + 1u == (gen + 1u) * nloc) {
            __builtin_amdgcn_fence(__ATOMIC_RELEASE, "agent");
            asm volatile("s_waitcnt vmcnt(0)" ::: "memory");
            const unsigned og = xb_add(&bar[XB_TOP], 1u);
            const unsigned tg = og / nx;
            if (og + 1u == (tg + 1u) * nx) xb_add(&bar[XB_TOPGEN], 1u);
            else XB_SPIN(xb_ld(&bar[XB_TOPGEN]) == tg, bar);
            __builtin_amdgcn_fence(__ATOMIC_ACQUIRE, "agent");
            xb_add(&bar[XB_XGEN(b.x)], 1u);
            asm volatile("s_waitcnt vmcnt(0)" ::: "memory");
        } else {
            XB_SPIN(xb_ld(&bar[XB_XGEN(b.x)]) == gen, bar);
            __builtin_amdgcn_fence(__ATOMIC_ACQUIRE, "agent");
            asm volatile("s_waitcnt vmcnt(0)" ::: "memory");
        }
    }
    __syncthreads();
}

struct Frame {
    LAS unsigned char* lds;
    int tid, lane, wave, vcu, G, dry;
    const float* const* in; float* out; unsigned char* ws;
};
__device__ __forceinline__ int lane_id() { int l; asm volatile("v_mbcnt_lo_u32_b32 %0, -1, 0\n\tv_mbcnt_hi_u32_b32 %0, -1, %0" : "=v"(l)); return l; }
#define WSP(T, off) ((T*)(F.ws + (off)))
__device__ __forceinline__ float wave_sum(float v) {
#pragma unroll
    for (int o = 1; o < 64; o <<= 1) v += __shfl_xor(v, o);
    return v;
}
template <class RowMap>
__device__ __forceinline__ void p0_transpose_item(const float* W, int K, int N, bf16_t* WT, RowMap rm, LAS float* scr, int item, int lane) {
    const int nblk = (N + 31) / 32, kb = item / nblk, nb = item % nblk, k0 = 64 * kb, n0 = 32 * nb;
    const int nl = n0 + (lane & 31);
#pragma unroll 8
    for (int i = 0; i < 32; ++i) { const int kk = 2 * i + (lane >> 5); scr[kk * 33 + (lane & 31)] = (nl < N) ? W[(size_t)(k0 + kk) * N + nl] : 0.f; }
    LDS_WAIT(); asm volatile("" ::: "memory");
    const int c = lane & 7;
#pragma unroll
    for (int j = 0; j < 4; ++j) { const int n = (lane >> 3) + 8 * j; const LAS float* s = scr + (8 * c) * 33 + n;
        u32x4 o; o.x = cvtpk(s[0 * 33], s[1 * 33]); o.y = cvtpk(s[2 * 33], s[3 * 33]); o.z = cvtpk(s[4 * 33], s[5 * 33]); o.w = cvtpk(s[6 * 33], s[7 * 33]);
        if (n0 + n < N) *(u32x4*)(WT + (size_t)rm(n0 + n) * K + k0 + 8 * c) = o; }
    LDS_WAIT(); asm volatile("" ::: "memory");
}
struct RmId { __device__ __forceinline__ int operator()(int n) const { return n; } };
struct RmWin { __device__ __forceinline__ int operator()(int n) const { return n < 3072 ? n : (n < 3088 ? 8192 + (n - 3072) : n - 16); } };

__device__ __forceinline__ void cvt_copy(Frame& F, const float* src, bf16_t* dst, size_t n) {
    const size_t nth = (size_t)F.G * 512, n8 = n / 8;
    for (size_t i = (size_t)F.vcu * 512 + F.tid; i < n8; i += nth) {
        const f32x4 a = *(const f32x4*)(src + i * 8), b = *(const f32x4*)(src + i * 8 + 4);
        u32x4 o; o.x = cvtpk(a[0], a[1]); o.y = cvtpk(a[2], a[3]); o.z = cvtpk(b[0], b[1]); o.w = cvtpk(b[2], b[3]);
        *(u32x4*)(dst + i * 8) = o; }
}
__device__ __forceinline__ void rms_row_to_bf16(const float* xrow, const float* g, bf16_t* orow, int lane) {
    f32x4 v[4]; float s = 0.f;
#pragma unroll
    for (int j = 0; j < 4; ++j) { v[j] = *((const f32x4*)xrow + lane + 64 * j); s += (v[j][0] * v[j][0] + v[j][1] * v[j][1]) + (v[j][2] * v[j][2] + v[j][3] * v[j][3]); }
    const float rstd = __builtin_amdgcn_rsqf(wave_sum(s) * (1.f / 1024.f) + EPS);
#pragma unroll
    for (int j = 0; j < 4; ++j) { const f32x4 gv = *((const f32x4*)g + lane + 64 * j); const f32x4 o = v[j] * rstd * gv;
        u32x2 w; w.x = cvtpk(o[0], o[1]); w.y = cvtpk(o[2], o[3]); *((u32x2*)orow + lane + 64 * j) = w; }
}
__device__ __forceinline__ void phase_prologue(Frame& F) {
    LAS float* scr = (LAS float*)(F.lds + RING_OFF + F.wave * 16384);
    const int gw = F.vcu * NWAVES + F.wave, NGW = F.G * NWAVES;
    constexpr int I_IN = 16 * 257, I_SQ = 16 * 32, I_PQ = 16 * 64, I_PLE = 4 * 32;
    constexpr int NITEMS = I_IN + 4 * I_SQ + I_PQ + I_PLE;
    for (int it = gw; it < NITEMS; it += NGW) {
        int r = it;
        if (r < I_IN) { p0_transpose_item(F.in[3], 1024, 8208, WSP(bf16_t, WS_WIN), RmWin(), scr, r, F.lane); continue; } r -= I_IN;
        if (r < I_SQ) { p0_transpose_item(F.in[7], 1024, 1024, WSP(bf16_t, WS_WGA), RmId(), scr, r, F.lane); continue; } r -= I_SQ;
        if (r < I_SQ) { p0_transpose_item(F.in[8], 1024, 1024, WSP(bf16_t, WS_WSB), RmId(), scr, r, F.lane); continue; } r -= I_SQ;
        if (r < I_SQ) { p0_transpose_item(F.in[9], 1024, 1024, WSP(bf16_t, WS_WO), RmId(), scr, r, F.lane); continue; } r -= I_SQ;
        if (r < I_SQ) { p0_transpose_item(F.in[17], 1024, 1024, WSP(bf16_t, WS_WPG), RmId(), scr, r, F.lane); continue; } r -= I_SQ;
        if (r < I_PQ) { p0_transpose_item(F.in[11], 1024, 2048, WSP(bf16_t, WS_WPQ), RmId(), scr, r, F.lane); continue; } r -= I_PQ;
        p0_transpose_item(F.in[18], 256, 1024, WSP(bf16_t, WS_WPLE), RmId(), scr, r, F.lane);
    }
    { const float* k1 = F.in[12]; const float* k2 = F.in[13]; bf16_t* KB = WSP(bf16_t, WS_KD);
      for (int i = F.vcu * 512 + F.tid; i < 2 * 8 * 128 * 16; i += F.G * 512) { const int half = i >> 14, rem = i & 16383, h = rem >> 11, r8 = rem & 2047;
          const float* s = (half ? k2 : k1) + (size_t)h * 16384 + (size_t)r8 * 8; const f32x4 a = *(const f32x4*)s, b = *(const f32x4*)(s + 4);
          u32x4 o; o.x = cvtpk(a[0], a[1]); o.y = cvtpk(a[2], a[3]); o.z = cvtpk(b[0], b[1]); o.w = cvtpk(b[2], b[3]);
          *(u32x4*)(KB + (size_t)(h * 2 + half) * 16384 + (size_t)r8 * 8) = o; } }
    for (int m = gw; m < T_TOK; m += NGW) rms_row_to_bf16(F.in[0] + (size_t)m * 1024, F.in[2], WSP(bf16_t, WS_XN1) + (size_t)m * 1024, F.lane);
}

__device__ __forceinline__ void phase_gla_prep(Frame& F) {
    LAS float* alo = (LAS float*)(F.lds + RING_OFF);
    const bf16_t* XN1 = WSP(bf16_t, WS_XN1); const bf16_t* WGAT = WSP(bf16_t, WS_WIN) + (size_t)8192 * 1024;
    bf16_t* GK = WSP(bf16_t, WS_GK); bf16_t* GV = WSP(bf16_t, WS_GV); float* GLAG = WSP(float, WS_GLAG);
    const float* w_up = F.in[4]; const float* b_a = F.in[5];
    const int tid = F.tid, lane = F.lane, w = F.wave;
    for (int u = F.vcu; u < 256; u += F.G) {
        const size_t r0 = (size_t)u * 64;
        __syncthreads();
        if (w < 4) {
            f32x4 acc = (f32x4){0.f, 0.f, 0.f, 0.f};
            const bf16_t* ap = XN1 + (r0 + 16 * w + (lane & 15)) * 1024 + 8 * (lane >> 4);
            const bf16_t* bp = WGAT + (size_t)(lane & 15) * 1024 + 8 * (lane >> 4);
#pragma unroll 8
            for (int s = 0; s < 32; ++s) { const bf16x8 a = *(const bf16x8*)(ap + 32 * s), b = *(const bf16x8*)(bp + 32 * s); acc = __builtin_amdgcn_mfma_f32_16x16x32_bf16(a, b, acc, 0, 0, 0); }
#pragma unroll
            for (int r = 0; r < 4; ++r) alo[(16 * w + 4 * (lane >> 4) + r) * 16 + (lane & 15)] = acc[r];
        }
        const int kk = tid;
        float kv[64];
#pragma unroll
        for (int i = 0; i < 64; ++i) kv[i] = bf1(GK[(r0 + i) * 512 + kk]);
        float wv[16];
#pragma unroll
        for (int r = 0; r < 16; ++r) wv[r] = w_up[r * 512 + kk];
        const float bias = b_a[kk];
        __syncthreads();
        float suffix = 0.f;
        bf16_t* kdt = GK + r0 * 512 + (size_t)kk * 64;
#pragma unroll
        for (int i8 = 7; i8 >= 0; --i8) {
            float o[8];
#pragma unroll
            for (int j = 7; j >= 0; --j) { const int i = i8 * 8 + j;
                const f32x4 a0 = *(const LAS f32x4*)(alo + i * 16), a1 = *(const LAS f32x4*)(alo + i * 16 + 4), a2 = *(const LAS f32x4*)(alo + i * 16 + 8), a3 = *(const LAS f32x4*)(alo + i * 16 + 12);
                float x = bias;
                x += a0[0] * wv[0] + a0[1] * wv[1] + a0[2] * wv[2] + a0[3] * wv[3];
                x += a1[0] * wv[4] + a1[1] * wv[5] + a1[2] * wv[6] + a1[3] * wv[7];
                x += a2[0] * wv[8] + a2[1] * wv[9] + a2[2] * wv[10] + a2[3] * wv[11];
                x += a3[0] * wv[12] + a3[1] * wv[13] + a3[2] * wv[14] + a3[3] * wv[15];
                const float la = (fminf(x, 0.f) - log1pf(__expf(-fabsf(x)))) * (1.0f / 16.0f);
                o[j] = kv[i] * __expf(suffix);
                suffix += la; }
            u32x4 pk; pk.x = cvtpk(o[0], o[1]); pk.y = cvtpk(o[2], o[3]); pk.z = cvtpk(o[4], o[5]); pk.w = cvtpk(o[6], o[7]);
            if (!F.dry) *(u32x4*)(kdt + i8 * 8) = pk; }
        GLAG[(size_t)u * 512 + kk] = __expf(suffix);
        unsigned vv[64];
#pragma unroll
        for (int i = 0; i < 64; ++i) vv[i] = *(const unsigned*)(GV + (r0 + i) * 1024 + 2 * tid);
        __syncthreads();
        bf16_t* vt0 = GV + r0 * 1024 + (size_t)(2 * tid) * 64;
#pragma unroll
        for (int i8 = 0; i8 < 8; ++i8) { u32x4 lo, hi;
            lo.x = (vv[i8 * 8 + 0] & 0xffffu) | (vv[i8 * 8 + 1] << 16); hi.x = (vv[i8 * 8 + 0] >> 16) | (vv[i8 * 8 + 1] & 0xffff0000u);
            lo.y = (vv[i8 * 8 + 2] & 0xffffu) | (vv[i8 * 8 + 3] << 16); hi.y = (vv[i8 * 8 + 2] >> 16) | (vv[i8 * 8 + 3] & 0xffff0000u);
            lo.z = (vv[i8 * 8 + 4] & 0xffffu) | (vv[i8 * 8 + 5] << 16); hi.z = (vv[i8 * 8 + 4] >> 16) | (vv[i8 * 8 + 5] & 0xffff0000u);
            lo.w = (vv[i8 * 8 + 6] & 0xffffu) | (vv[i8 * 8 + 7] << 16); hi.w = (vv[i8 * 8 + 6] >> 16) | (vv[i8 * 8 + 7] & 0xffff0000u);
            if (!F.dry) { *(u32x4*)(vt0 + i8 * 8) = lo; *(u32x4*)(vt0 + 64 + i8 * 8) = hi; } }
    }
}

constexpr int GL_KD = 0, GL_Q = 32768, GL_G = 65536, GL_RED = 65536 + 1024;
__device__ __forceinline__ int gl_kd_off(int row, int chunk) { return row * 128 + ((chunk ^ ((row >> 1) & 7)) << 4); }
__device__ __forceinline__ int gl_q_off(int row, int chunk16) { return row * 256 + ((chunk16 ^ (row & 15)) << 4); }

struct GlaStage { u32x4 kd[2]; u32x4 q[2]; bf16x8 vt[4]; float g; };
__device__ __forceinline__ void gla_prefetch_vt(Frame& F, GlaStage& st, int b, int h, int c) {
    const int u = b * 64 + c; const size_t r0 = (size_t)u * 64; const int w = F.wave, lq = F.lane & 31, hh = F.lane >> 5;
    const bf16_t* vt = WSP(bf16_t, WS_GV) + r0 * 1024 + (size_t)(h * 256 + 32 * w + lq) * 64;
#pragma unroll
    for (int ts = 0; ts < 4; ++ts) st.vt[ts] = *(const bf16x8*)(vt + 16 * ts + 8 * hh);
}
template <bool WITH_Q>
__device__ __forceinline__ void gla_prefetch(Frame& F, GlaStage& st, int b, int h, int c) {
    const int u = b * 64 + c; const size_t r0 = (size_t)u * 64; const int tid = F.tid;
    const bf16_t* kd = WSP(bf16_t, WS_GK) + r0 * 512 + (size_t)h * 8192;
#pragma unroll
    for (int j = 0; j < 2; ++j) { const int pi = tid + 512 * j; st.kd[j] = *(const u32x4*)(kd + (pi >> 3) * 64 + (pi & 7) * 8); }
    if (WITH_Q) { const bf16_t* gq = WSP(bf16_t, WS_GQ) + r0 * 512 + h * 128;
#pragma unroll
        for (int j = 0; j < 2; ++j) { const int pi = tid + 512 * j; st.q[j] = *(const u32x4*)(gq + (size_t)(pi >> 4) * 512 + (pi & 15) * 8); } }
    st.g = (tid < 128) ? WSP(float, WS_GLAG)[((size_t)u * 4 + h) * 128 + tid] : 1.f;
}
template <bool WITH_Q>
__device__ __forceinline__ void gla_stage_write(Frame& F, const GlaStage& st, int buf) {
    LAS unsigned char* lds = F.lds + RING_OFF; const int tid = F.tid;
#pragma unroll
    for (int j = 0; j < 2; ++j) { const int pi = tid + 512 * j; *(LAS u32x4*)(lds + GL_KD + buf * 16384 + gl_kd_off(pi >> 3, pi & 7)) = st.kd[j]; }
    if (WITH_Q) {
#pragma unroll
        for (int j = 0; j < 2; ++j) { const int pi = tid + 512 * j; *(LAS u32x4*)(lds + GL_Q + buf * 16384 + gl_q_off(pi >> 4, pi & 15)) = st.q[j]; } }
    if (tid < 128) *(LAS float*)(lds + GL_G + buf * 512 + tid * 4) = st.g;
}
__device__ __forceinline__ void gla_update(Frame& F, f32x16 (&S)[4], const bf16x8 (&vt)[4], int buf) {
    const LAS unsigned char* lds = F.lds + RING_OFF; const int lq = F.lane & 31, hh = F.lane >> 5;
    const LAS float* G = (const LAS float*)(lds + GL_G + buf * 512);
#pragma unroll
    for (int kt = 0; kt < 4; ++kt)
#pragma unroll
        for (int g4 = 0; g4 < 4; ++g4) { const f32x4 g = *(const LAS f32x4*)(G + 32 * kt + 8 * g4 + 4 * hh);
#pragma unroll
            for (int j = 0; j < 4; ++j) S[kt][4 * g4 + j] *= g[j]; }
#pragma unroll
    for (int ts = 0; ts < 4; ++ts)
#pragma unroll
        for (int kt = 0; kt < 4; ++kt) { const bf16x8 a = *(const LAS bf16x8*)(lds + GL_KD + buf * 16384 + gl_kd_off(32 * kt + lq, 2 * ts + hh));
            S[kt] = __builtin_amdgcn_mfma_f32_32x32x16_bf16(a, vt[ts], S[kt], 0, 0, 0); if (kt == 3 && (ts & 1)) __builtin_amdgcn_sched_barrier(0); }
}
constexpr size_t SEND_WAVE_FLOATS = 4 * 4 * 64 * 4;
__device__ __forceinline__ void gla_stage1(Frame& F, int unit) {
    const int bh = unit >> 3, seg = unit & 7, b = bh >> 2, h = bh & 3, w = F.wave, l = F.lane;
    f32x16 S[4];
#pragma unroll
    for (int kt = 0; kt < 4; ++kt)
#pragma unroll
        for (int r = 0; r < 16; ++r) S[kt][r] = 0.f;
    float pend = 1.f;
    GlaStage st; gla_prefetch<false>(F, st, b, h, seg * 8); gla_prefetch_vt(F, st, b, h, seg * 8);
    for (int ci = 0; ci < 8; ++ci) {
        gla_stage_write<false>(F, st, ci & 1); pend *= st.g;
        __syncthreads();
        if (ci < 7) gla_prefetch<false>(F, st, b, h, seg * 8 + ci + 1);
        gla_update(F, S, st.vt, ci & 1);
        if (ci < 7) gla_prefetch_vt(F, st, b, h, seg * 8 + ci + 1);
    }
    float* se = WSP(float, WS_SEND) + ((size_t)unit * 8 + w) * SEND_WAVE_FLOATS;
#pragma unroll
    for (int kt = 0; kt < 4; ++kt)
#pragma unroll
        for (int g4 = 0; g4 < 4; ++g4) *(f32x4*)(se + ((kt * 4 + g4) * 64 + l) * 4) = (f32x4){S[kt][4 * g4], S[kt][4 * g4 + 1], S[kt][4 * g4 + 2], S[kt][4 * g4 + 3]};
    if (F.tid < 128) WSP(float, WS_PEND)[unit * 128 + F.tid] = pend;
    __syncthreads();
}
__device__ __forceinline__ void gla_stage3(Frame& F, int unit) {
    const int bh = unit >> 3, seg = unit & 7, b = bh >> 2, h = bh & 3, w = F.wave, l = F.lane, lq = l & 31, hh = l >> 5;
    LAS unsigned char* lds = F.lds + RING_OFF;
    const bf16_t* GR = WSP(bf16_t, WS_GR); bf16_t* GLAN = WSP(bf16_t, WS_GLAN); const float* g_o = F.in[6];
    f32x16 S[4];
#pragma unroll
    for (int kt = 0; kt < 4; ++kt)
#pragma unroll
        for (int r = 0; r < 16; ++r) S[kt][r] = 0.f;
    GlaStage st; gla_prefetch<true>(F, st, b, h, seg * 8); gla_prefetch_vt(F, st, b, h, seg * 8);
    for (int sp = 0; sp < seg; ++sp) {
        const int un = bh * 8 + sp; const float* se = WSP(float, WS_SEND) + ((size_t)un * 8 + w) * SEND_WAVE_FLOATS; const float* pe = WSP(float, WS_PEND) + un * 128;
#pragma unroll
        for (int kt = 0; kt < 4; ++kt)
#pragma unroll
            for (int g4 = 0; g4 < 4; ++g4) { const f32x4 p = *(const f32x4*)(pe + 32 * kt + 8 * g4 + 4 * hh); const f32x4 s = *(const f32x4*)(se + ((kt * 4 + g4) * 64 + l) * 4);
#pragma unroll
                for (int j = 0; j < 4; ++j) S[kt][4 * g4 + j] = S[kt][4 * g4 + j] * p[j] + s[j]; }
    }
    for (int ci = 0; ci < 8; ++ci) {
        const int c = seg * 8 + ci; const size_t r0 = (size_t)(b * 64 + c) * 64; const int buf = ci & 1;
        gla_stage_write<true>(F, st, buf);
        __syncthreads();
        if (ci < 7) gla_prefetch<true>(F, st, b, h, c + 1);
        gla_update(F, S, st.vt, buf);
        f32x16 oT[2];
#pragma unroll
        for (int tt = 0; tt < 2; ++tt) {
#pragma unroll
            for (int r = 0; r < 16; ++r) oT[tt][r] = 0.f;
            const int t = 32 * tt + lq;
#pragma unroll
            for (int kt = 0; kt < 4; ++kt)
#pragma unroll
                for (int s = 0; s < 2; ++s) {
                    u32x4 aw; aw.x = cvtpk(S[kt][8 * s + 0], S[kt][8 * s + 1]); aw.y = cvtpk(S[kt][8 * s + 2], S[kt][8 * s + 3]); aw.z = cvtpk(S[kt][8 * s + 4], S[kt][8 * s + 5]); aw.w = cvtpk(S[kt][8 * s + 6], S[kt][8 * s + 7]);
                    const u32x2 qlo = *(const LAS u32x2*)(lds + GL_Q + buf * 16384 + gl_q_off(t, 4 * kt + 2 * s) + 8 * hh), qhi = *(const LAS u32x2*)(lds + GL_Q + buf * 16384 + gl_q_off(t, 4 * kt + 2 * s + 1) + 8 * hh);
                    const u32x4 bw = (u32x4){qlo.x, qlo.y, qhi.x, qhi.y};
                    oT[tt] = __builtin_amdgcn_mfma_f32_32x32x16_bf16(__builtin_bit_cast(bf16x8, aw), __builtin_bit_cast(bf16x8, bw), oT[tt], 0, 0, 0);
                    if (s == 1 && (kt & 1)) __builtin_amdgcn_sched_barrier(0); }
        }
        LAS float* redc = (LAS float*)(lds + GL_RED) + buf * 512;
#pragma unroll
        for (int tt = 0; tt < 2; ++tt) { float s = 0.f;
#pragma unroll
            for (int r = 0; r < 16; ++r) s += oT[tt][r] * oT[tt][r];
            s += __shfl_xor(s, 32);
            if (hh == 0) redc[w * 64 + 32 * tt + lq] = s; }
        if (ci < 7) gla_prefetch_vt(F, st, b, h, c + 1);
        u32x2 sr[2][4];
#pragma unroll
        for (int tt = 0; tt < 2; ++tt)
#pragma unroll
            for (int g4 = 0; g4 < 4; ++g4) sr[tt][g4] = *(const u32x2*)(GR + (r0 + 32 * tt + lq) * 1024 + h * 256 + 32 * w + 8 * g4 + 4 * hh);
        __syncthreads();
#pragma unroll
        for (int tt = 0; tt < 2; ++tt) { float tot = 0.f;
#pragma unroll
            for (int ww = 0; ww < 8; ++ww) tot += redc[ww * 64 + 32 * tt + lq];
            const float rstd = __builtin_amdgcn_rsqf(tot * (1.0f / 256.0f) + EPS);
            const size_t row = r0 + 32 * tt + lq;
#pragma unroll
            for (int g4 = 0; g4 < 4; ++g4) { const int v0 = h * 256 + 32 * w + 8 * g4 + 4 * hh;
                const f32x4 go = *(const f32x4*)(g_o + v0);
                const float o0 = oT[tt][4 * g4 + 0] * rstd * go[0] * bf_lo(sr[tt][g4].x), o1 = oT[tt][4 * g4 + 1] * rstd * go[1] * bf_hi(sr[tt][g4].x);
                const float o2 = oT[tt][4 * g4 + 2] * rstd * go[2] * bf_lo(sr[tt][g4].y), o3 = oT[tt][4 * g4 + 3] * rstd * go[3] * bf_hi(sr[tt][g4].y);
                u32x2 wv; wv.x = cvtpk(o0, o1); wv.y = cvtpk(o2, o3); *(u32x2*)(GLAN + row * 1024 + v0) = wv; } }
    }
    __syncthreads();
}

constexpr int SB_TILE = 16384, SB_FLAG = 7 * SB_TILE;
typedef short v4i16_t __attribute__((ext_vector_type(4)));
__device__ __forceinline__ s16x4 vtr(const LAS unsigned char* p) { return __builtin_bit_cast(s16x4, __builtin_amdgcn_ds_read_tr16_b64_v4i16((LAS v4i16_t*)p)); }
__device__ __forceinline__ float partner32(float x, int hh) { auto rr = __builtin_amdgcn_permlane32_swap(__float_as_uint(x), __float_as_uint(x), false, false); return __uint_as_float(hh ? rr[0] : rr[1]); }
__device__ __forceinline__ int sbk_off(int key, int chunk) { return key * 128 + ((chunk ^ ((key >> 1) & 7)) << 4); }
__device__ __forceinline__ int sbv_off(int key, int chunk) { return 8192 + key * 128 + ((chunk ^ (((key >> 1) & 1) << 2)) << 4); }

template <bool DIAG>
__device__ __forceinline__ void sb_tile_t(const LAS unsigned char* tile, int kt, int qabs, int l, const bf16x8 (&qf)[4], f32x16& o0, f32x16& o1, float& carry) {
    const int lq = l & 31, hh = l >> 5, g1 = (l >> 4) & 1, i = l & 15;
    float run = carry;
#pragma unroll
    for (int half = 1; half >= 0; --half) {
        f32x16 p;
#pragma unroll
        for (int r = 0; r < 16; ++r) p[r] = 0.f;
#pragma unroll
        for (int s = 0; s < 4; ++s) { const bf16x8 a = *(const LAS bf16x8*)(tile + sbk_off(32 * half + lq, 2 * s + hh)); p = __builtin_amdgcn_mfma_f32_32x32x16_bf16(a, qf[s], p, 0, 0, 0); }
        float Lh[16];
#pragma unroll
        for (int r = 0; r < 16; ++r) { const float z = p[r];
            float L = fmaxf(z, 0.f) + __builtin_amdgcn_logf(1.0f + __builtin_amdgcn_exp2f(-fabsf(z)));
            if (DIAG) { const int key = 64 * kt + 32 * half + (r & 3) + 8 * (r >> 2) + 4 * hh; if (key >= qabs) L = 0.f; }
            Lh[r] = L; }
        float tot[4];
#pragma unroll
        for (int g4 = 0; g4 < 4; ++g4) { float* Lg = &Lh[4 * g4]; Lg[2] += Lg[3]; Lg[1] += Lg[2]; Lg[0] += Lg[1]; tot[g4] = Lg[0]; }
        float E[4];
#pragma unroll
        for (int m = 3; m >= 0; --m) { const float tp = partner32(tot[m], hh); E[m] = run + (hh ? 0.f : tp); run += tot[m] + tp; }
        u32x4 pw[2];
#pragma unroll
        for (int s = 0; s < 2; ++s) { float wv[8];
#pragma unroll
            for (int j = 0; j < 8; ++j) { const int r = 8 * s + j;
                float wgt = __builtin_amdgcn_exp2f(p[r] - (E[r >> 2] + Lh[r]));
                if (DIAG) { const int key = 64 * kt + 32 * half + (r & 3) + 8 * (r >> 2) + 4 * hh; if (key >= qabs) wgt = 0.f; }
                wv[j] = wgt; }
            pw[s] = (u32x4){cvtpk(wv[0], wv[1]), cvtpk(wv[2], wv[3]), cvtpk(wv[4], wv[5]), cvtpk(wv[6], wv[7])}; }
#pragma unroll
        for (int s = 0; s < 2; ++s) { const bf16x8 pb = __builtin_bit_cast(bf16x8, pw[s]);
            const int k0 = 32 * half + 16 * s + 4 * hh + (i >> 2), k1 = k0 + 8;
#pragma unroll
            for (int dt = 0; dt < 2; ++dt) { const int ch = 4 * dt + 2 * g1 + ((i & 3) >> 1);
                const s16x4 lo = vtr(tile + sbv_off(k0, ch) + 8 * (i & 1)), hi = vtr(tile + sbv_off(k1, ch) + 8 * (i & 1));
                const bf16x8 a = (bf16x8){lo[0], lo[1], lo[2], lo[3], hi[0], hi[1], hi[2], hi[3]};
                if (dt == 0) o0 = __builtin_amdgcn_mfma_f32_32x32x16_bf16(a, pb, o0, 0, 0, 0); else o1 = __builtin_amdgcn_mfma_f32_32x32x16_bf16(a, pb, o1, 0, 0, 0); } }
    }
    carry = run;
}
__device__ __forceinline__ void sb_tile(const LAS unsigned char* tile, int kt, int q0, int qabs, int l, const bf16x8 (&qf)[4], f32x16& o0, f32x16& o1, float& carry) {
    if (64 * kt + 63 >= q0) sb_tile_t<true>(tile, kt, qabs, l, qf, o0, o1, carry); else sb_tile_t<false>(tile, kt, qabs, l, qf, o0, o1, carry);
}
__device__ __forceinline__ void sb_attn_unit(Frame& F, int uidx) {
    const int bh = uidx >> 4, qb = uidx & 15, b = bh >> 4, h = bh & 15;
    LAS unsigned char* lds = F.lds + RING_OFF;
    volatile LAS unsigned* flags = (volatile LAS unsigned*)(lds + SB_FLAG);
    const int tid = F.tid, w = F.wave, l = F.lane, lq = l & 31, hh = l >> 5;
    bf16_t* SQ = WSP(bf16_t, WS_SQ); const bf16_t* SK = WSP(bf16_t, WS_SK); const bf16_t* SV = WSP(bf16_t, WS_SV);
    const size_t rowbase = (size_t)b * SEQ;
    const int q0 = qb * 256 + 32 * w, qabs = q0 + lq;
    const int kt_hi = qb * 4 + 3, kt_lo = (qb * 4 - 3) > 0 ? (qb * 4 - 3) : 0, nwin = kt_hi - kt_lo + 1;
    const int skey = tid >> 3, sch = tid & 7;
    const bf16_t* kgd = SK + (rowbase + skey) * 1024 + h * 64 + ((sch ^ ((skey >> 1) & 7)) * 8);
    const bf16_t* vgd = SV + (rowbase + skey) * 1024 + h * 64 + ((sch ^ (((skey >> 1) & 1) << 2)) * 8);
    __syncthreads();
#pragma unroll
    for (int j = 0; j < 7; ++j) if (j < nwin) {
        __builtin_amdgcn_global_load_lds((const unsigned*)(kgd + (size_t)(kt_lo + j) * 64 * 1024), (LAS unsigned*)(lds + j * SB_TILE + w * 1024), 16, 0, 0);
        __builtin_amdgcn_global_load_lds((const unsigned*)(vgd + (size_t)(kt_lo + j) * 64 * 1024), (LAS unsigned*)(lds + j * SB_TILE + 8192 + w * 1024), 16, 0, 0); }
    bf16x8 qf[4];
    { const bf16_t* qrow = SQ + (rowbase + qabs) * 1024 + h * 64;
#pragma unroll
      for (int s = 0; s < 4; ++s) qf[s] = *(const bf16x8*)(qrow + 16 * s + 8 * hh); }
    f32x16 o0, o1;
#pragma unroll
    for (int r = 0; r < 16; ++r) { o0[r] = 0.f; o1[r] = 0.f; }
    float carry = 0.f;
    VM_WAIT(); __syncthreads();
    bool done = false;
    for (int kt = (q0 + 30) >> 6; kt >= kt_lo; --kt) {
        sb_tile(lds + (kt - kt_lo) * SB_TILE, kt, q0, qabs, l, qf, o0, o1, carry);
        if (__all(carry > 150.0f)) { done = true; break; }
    }
    if (kt_lo == 0) done = true;
    if (l == 0) flags[w] = done ? 1u : 0u;
    __syncthreads();
    bool alld = true;
#pragma unroll
    for (int i = 0; i < 8; ++i) alld = alld && (flags[i] != 0u);
    if (!alld) {
        const bf16_t* kg = SK + (rowbase + skey) * 1024 + h * 64 + sch * 8;
        const bf16_t* vg = SV + (rowbase + skey) * 1024 + h * 64 + sch * 8;
        for (int kt = kt_lo - 1; kt >= 0; --kt) {
            const u32x4 kr = *(const u32x4*)(kg + (size_t)kt * 64 * 1024), vr = *(const u32x4*)(vg + (size_t)kt * 64 * 1024);
            __syncthreads();
            { unsigned a = 1u;
#pragma unroll
              for (int i = 0; i < 8; ++i) a &= flags[i];
              if (a) break; }
            *(LAS u32x4*)(lds + sbk_off(skey, sch)) = kr; *(LAS u32x4*)(lds + sbv_off(skey, sch)) = vr;
            __syncthreads();
            if (!done) { sb_tile(lds, kt, q0, qabs, l, qf, o0, o1, carry); if (__all(carry > 150.0f) || kt == 0) done = true; }
            if (l == 0) flags[w] = done ? 1u : 0u;
        }
    }
    if (!F.dry) { bf16_t* orow = SQ + (rowbase + qabs) * 1024 + h * 64;
#pragma unroll
      for (int g4 = 0; g4 < 4; ++g4) { u32x2 a, c2; a.x = cvtpk(o0[4 * g4], o0[4 * g4 + 1]); a.y = cvtpk(o0[4 * g4 + 2], o0[4 * g4 + 3]); c2.x = cvtpk(o1[4 * g4], o1[4 * g4 + 1]); c2.y = cvtpk(o1[4 * g4 + 2], o1[4 * g4 + 3]);
          *(u32x2*)(orow + 8 * g4 + 4 * hh) = a; *(u32x2*)(orow + 32 + 8 * g4 + 4 * hh) = c2; } }
}
__device__ __forceinline__ void sb_units_dyn(Frame& F, unsigned* ctr, int lo, int hi) {
    volatile LAS int* slot = (volatile LAS int*)(F.lds + MISC_OFF + 64);
    for (;;) {
        __syncthreads();
        if (F.tid == 0) *slot = lo + (int)__hip_atomic_fetch_add(ctr, 1u, __ATOMIC_RELAXED, __HIP_MEMORY_SCOPE_AGENT);
        __syncthreads();
        const int u = *slot;
        if (u >= hi) break;
        sb_attn_unit(F, u);
    }
}
__device__ __forceinline__ void phase_attn_a(Frame& F) {
    if (F.vcu < 128) gla_stage1(F, F.vcu);
    sb_units_dyn(F, (unsigned*)(F.ws + WS_CTL) + 64, 0, 384);
    __syncthreads();
}
__device__ __forceinline__ void phase_attn_b(Frame& F) {
    if (F.vcu < 128) gla_stage3(F, F.vcu);
    sb_units_dyn(F, (unsigned*)(F.ws + WS_CTL) + 128, 384, 1024);
    __syncthreads();
}
__device__ __forceinline__ int okey(float v, int tag, int mask) { int u = __float_as_int(v); u ^= (u >> 31) & 0x7fffffff; return (u & ~mask) | tag; }
__device__ __forceinline__ float okey_val(int key, int mask) { int u = key & ~mask; u ^= (u >> 31) & 0x7fffffff; return __int_as_float(u); }
#define INS16(Lst, xin) do { int _x = (xin); _Pragma("unroll") for (int _j = 0; _j < 16; ++_j) { const int _h = max(Lst[_j], _x); _x = min(Lst[_j], _x); Lst[_j] = _h; } } while (0)

#define CEX(a, b) do { const int _hi = max(a, b), _lo = min(a, b); a = _hi; b = _lo; } while (0)
#define BITONIC16(K) do { \
    _Pragma("unroll") for (int _i = 0; _i < 8; ++_i) CEX(K[_i], K[_i + 8]); \
    _Pragma("unroll") for (int _b = 0; _b < 16; _b += 8) _Pragma("unroll") for (int _i = 0; _i < 4; ++_i) CEX(K[_b + _i], K[_b + _i + 4]); \
    _Pragma("unroll") for (int _b = 0; _b < 16; _b += 4) _Pragma("unroll") for (int _i = 0; _i < 2; ++_i) CEX(K[_b + _i], K[_b + _i + 2]); \
    _Pragma("unroll") for (int _b = 0; _b < 16; _b += 2) CEX(K[_b], K[_b + 1]); } while (0)
__device__ __forceinline__ int swap32i(int x) { auto r = __builtin_amdgcn_permlane32_swap((unsigned)x, (unsigned)x, false, false); return (int)((__builtin_amdgcn_mbcnt_hi(~0u, __builtin_amdgcn_mbcnt_lo(~0u, 0u)) & 32) ? r[0] : r[1]); }

__device__ __forceinline__ void phase_peer_retrieve(Frame& F) {
    const bf16_t* Q = WSP(bf16_t, WS_Q); const bf16_t* KB = WSP(bf16_t, WS_KD); unsigned* EXPO = WSP(unsigned, WS_EXP);
    LAS unsigned char* idxb = F.lds + RING_OFF + F.wave * 2048;
    const int l = F.lane, lq = l & 31, hh = l >> 5;
    const int ntok_wg = T_TOK / F.G;
#pragma unroll 1
    for (int it = F.wave; it < (ntok_wg / 32) * 8; it += NWAVES) {
        const int tg = it >> 3, h = it & 7;
        const int t = F.vcu * ntok_wg + tg * 32 + lq;
        int XY[2][16];
#pragma unroll
        for (int half = 0; half < 2; ++half) {
            bf16x8 qf[8];
            { const bf16_t* qp = Q + (size_t)t * 2048 + h * 256 + half * 128 + 8 * hh;
#pragma unroll
              for (int s = 0; s < 8; ++s) qf[s] = *(const bf16x8*)(qp + 16 * s); }
            int L[16];
#pragma unroll
            for (int j = 0; j < 16; ++j) L[j] = INT_MIN;
            const bf16_t* kp = KB + (size_t)(h * 2 + half) * 16384 + (size_t)lq * 128 + 8 * hh;
#pragma unroll 1
            for (int tile = 0; tile < 4; ++tile) {
                f32x16 acc;
#pragma unroll
                for (int r = 0; r < 16; ++r) acc[r] = 0.f;
#pragma unroll
                for (int s = 0; s < 8; ++s) { const bf16x8 a = *(const bf16x8*)(kp + (size_t)tile * 32 * 128 + 16 * s); acc = __builtin_amdgcn_mfma_f32_32x32x16_bf16(a, qf[s], acc, 0, 0, 0); }
#pragma unroll
                for (int r = 0; r < 16; ++r) { const int key = 32 * tile + (r & 3) + 8 * (r >> 2) + 4 * hh; INS16(L, okey(acc[r], 127 - key, 127)); }
            }
#pragma unroll
            for (int k = 0; k < 8; ++k) { const int a = swap32i(L[15 - k]), b = swap32i(L[k]); L[k] = max(L[k], a); L[15 - k] = max(L[15 - k], b); }
            BITONIC16(L);
#pragma unroll
            for (int j = 0; j < 16; ++j) XY[half][j] = L[j];
        }
        { u32x4 pk[2];
#pragma unroll
          for (int half = 0; half < 2; ++half) { const int* L = XY[half];
            pk[half].x = (unsigned)(127 - (L[0] & 127)) | ((unsigned)(127 - (L[1] & 127)) << 8) | ((unsigned)(127 - (L[2] & 127)) << 16) | ((unsigned)(127 - (L[3] & 127)) << 24);
            pk[half].y = (unsigned)(127 - (L[4] & 127)) | ((unsigned)(127 - (L[5] & 127)) << 8) | ((unsigned)(127 - (L[6] & 127)) << 16) | ((unsigned)(127 - (L[7] & 127)) << 24);
            pk[half].z = (unsigned)(127 - (L[8] & 127)) | ((unsigned)(127 - (L[9] & 127)) << 8) | ((unsigned)(127 - (L[10] & 127)) << 16) | ((unsigned)(127 - (L[11] & 127)) << 24);
            pk[half].w = (unsigned)(127 - (L[12] & 127)) | ((unsigned)(127 - (L[13] & 127)) << 8) | ((unsigned)(127 - (L[14] & 127)) << 16) | ((unsigned)(127 - (L[15] & 127)) << 24); }
          *(LAS u32x4*)(idxb + l * 32) = pk[0]; *(LAS u32x4*)(idxb + l * 32 + 16) = pk[1]; }
        float X[16], Y[16];
#pragma unroll
        for (int j = 0; j < 16; ++j) { X[j] = okey_val(XY[0][j], 127); Y[j] = okey_val(XY[1][j], 127); }
        int M[16];
#pragma unroll
        for (int j = 0; j < 16; ++j) M[j] = INT_MIN;
#define CAND(i, j) do { const float sm = hh ? (X[j] + Y[i]) : (X[i] + Y[j]); const int pos = hh ? ((j) * 16 + (i)) : ((i) * 16 + (j)); int key = okey(sm, 255 - pos, 255); if ((i) == (j) && hh) key = INT_MIN; INS16(M, key); } while (0)
        CAND(0, 0); CAND(0, 1); CAND(0, 2); CAND(0, 3); CAND(0, 4); CAND(0, 5); CAND(0, 6); CAND(0, 7); CAND(0, 8); CAND(0, 9); CAND(0, 10); CAND(0, 11); CAND(0, 12); CAND(0, 13); CAND(0, 14); CAND(0, 15);
        CAND(1, 1); CAND(1, 2); CAND(1, 3); CAND(1, 4); CAND(1, 5); CAND(1, 6); CAND(1, 7);
        CAND(2, 2); CAND(2, 3); CAND(2, 4);
        CAND(3, 3);
#undef CAND
        int TK[16];
#pragma unroll
        for (int k = 0; k < 16; ++k) TK[k] = max(M[k], swap32i(M[15 - k]));
        float sv[16]; float mx = -INFINITY;
#pragma unroll
        for (int k = 0; k < 16; ++k) { sv[k] = okey_val(TK[k], 255); mx = fmaxf(mx, sv[k]); }
        float den = 0.f;
#pragma unroll
        for (int k = 0; k < 16; ++k) { sv[k] = __expf(sv[k] - mx); den += sv[k]; }
        const float rden = 1.0f / den;
        LDS_WAIT(); asm volatile("" ::: "memory");
        const LAS unsigned char* ib = idxb + l * 32;
        unsigned* dst = EXPO + (size_t)t * 128 + h * 16 + hh * 8;
        u32x4 o0, o1; unsigned ov[8];
#pragma unroll
        for (int k = 0; k < 8; ++k) { const int pos = 255 - (TK[k] & 255); const unsigned i1 = ib[pos >> 4], i2 = ib[16 + (pos & 15)];
            ov[k] = (__float_as_uint(sv[k] * rden) & ~0x3fffu) | (i1 * 128u + i2); }
        o0 = (u32x4){ov[0], ov[1], ov[2], ov[3]}; o1 = (u32x4){ov[4], ov[5], ov[6], ov[7]};
        *(u32x4*)dst = o0; *(u32x4*)(dst + 4) = o1;
        LDS_WAIT(); asm volatile("" ::: "memory");
    }
}

__device__ __forceinline__ void cvt_rows_fp8(Frame& F, const float* src, unsigned char* dst, float* rscale) {
    const int l = F.lane; const int gw = F.vcu * NWAVES + F.wave, NGW = F.G * NWAVES;
    for (int e = gw; e < 16384; e += NGW) {
        const f32x4* sp = (const f32x4*)(src + (size_t)e * 1024 + 16 * l);
        const f32x4 a = sp[0], b = sp[1], c = sp[2], d = sp[3];
        float m = fmaxf(fmaxf(fmaxf(fabsf(a[0]), fabsf(a[1])), fmaxf(fabsf(a[2]), fabsf(a[3]))), fmaxf(fmaxf(fabsf(b[0]), fabsf(b[1])), fmaxf(fabsf(b[2]), fabsf(b[3]))));
        m = fmaxf(m, fmaxf(fmaxf(fmaxf(fabsf(c[0]), fabsf(c[1])), fmaxf(fabsf(c[2]), fabsf(c[3]))), fmaxf(fmaxf(fabsf(d[0]), fabsf(d[1])), fmaxf(fabsf(d[2]), fabsf(d[3])))));
#pragma unroll
        for (int o = 1; o < 64; o <<= 1) m = fmaxf(m, __shfl_xor(m, o));
        const float t = 448.0f / fmaxf(m, 1e-30f); const float s = __uint_as_float(__float_as_uint(t) & 0x7f800000u);
        u32x4 w; int x;
        x = __builtin_amdgcn_cvt_pk_fp8_f32(a[0] * s, a[1] * s, 0, false); x = __builtin_amdgcn_cvt_pk_fp8_f32(a[2] * s, a[3] * s, x, true); w.x = (unsigned)x;
        x = __builtin_amdgcn_cvt_pk_fp8_f32(b[0] * s, b[1] * s, 0, false); x = __builtin_amdgcn_cvt_pk_fp8_f32(b[2] * s, b[3] * s, x, true); w.y = (unsigned)x;
        x = __builtin_amdgcn_cvt_pk_fp8_f32(c[0] * s, c[1] * s, 0, false); x = __builtin_amdgcn_cvt_pk_fp8_f32(c[2] * s, c[3] * s, x, true); w.z = (unsigned)x;
        x = __builtin_amdgcn_cvt_pk_fp8_f32(d[0] * s, d[1] * s, 0, false); x = __builtin_amdgcn_cvt_pk_fp8_f32(d[2] * s, d[3] * s, x, true); w.w = (unsigned)x;
        *(u32x4*)(dst + (size_t)e * 1024 + 16 * l) = w;
        if (l == 0) rscale[e] = 1.0f / s;
    }
}

__device__ __forceinline__ float gelu_tanh(float x) { const float y = 0.7978845608028654f * (x + 0.044715f * x * x * x); return x * __builtin_amdgcn_rcpf(1.0f + __expf(-2.0f * y)); }
#define FP8_UNPACK16(W, f) do { f32x2 _t; \
    _t = __builtin_amdgcn_cvt_pk_f32_fp8((int)(W).x, false); f[0] = _t[0]; f[1] = _t[1]; _t = __builtin_amdgcn_cvt_pk_f32_fp8((int)(W).x, true); f[2] = _t[0]; f[3] = _t[1]; \
    _t = __builtin_amdgcn_cvt_pk_f32_fp8((int)(W).y, false); f[4] = _t[0]; f[5] = _t[1]; _t = __builtin_amdgcn_cvt_pk_f32_fp8((int)(W).y, true); f[6] = _t[0]; f[7] = _t[1]; \
    _t = __builtin_amdgcn_cvt_pk_f32_fp8((int)(W).z, false); f[8] = _t[0]; f[9] = _t[1]; _t = __builtin_amdgcn_cvt_pk_f32_fp8((int)(W).z, true); f[10] = _t[0]; f[11] = _t[1]; \
    _t = __builtin_amdgcn_cvt_pk_f32_fp8((int)(W).w, false); f[12] = _t[0]; f[13] = _t[1]; _t = __builtin_amdgcn_cvt_pk_f32_fp8((int)(W).w, true); f[14] = _t[0]; f[15] = _t[1]; } while (0)
__device__ __forceinline__ float sum_swap32(float a, float b) { auto r = __builtin_amdgcn_permlane32_swap(__float_as_uint(a), __float_as_uint(b), false, false); return __uint_as_float(r[0]) + __uint_as_float(r[1]); }
__device__ __forceinline__ float sum_swap16(float a, float b) { auto r = __builtin_amdgcn_permlane16_swap(__float_as_uint(a), __float_as_uint(b), false, false); return __uint_as_float(r[0]) + __uint_as_float(r[1]); }
__device__ __forceinline__ void phase_peer_gather(Frame& F) {
    const unsigned char* UB = WSP(unsigned char, WS_UB8); const unsigned char* VB = WSP(unsigned char, WS_VB8); const float* RSU = WSP(float, WS_RSU); const float* RSV = WSP(float, WS_RSV);
    const unsigned* EXPO = WSP(unsigned, WS_EXP);
    const bf16_t* H1G = WSP(bf16_t, WS_H1G); bf16_t* XN3 = WSP(bf16_t, WS_XN3); const float* H1 = WSP(float, WS_H1); float* H2 = F.out; const float* SSQ1 = WSP(float, WS_SSQ1); const float* g_ple = F.in[16];
    const int l = F.lane; const int ntok_wg = T_TOK / F.G;
    for (int ti = F.wave; ti < ntok_wg; ti += NWAVES) { const int t = F.vcu * ntok_wg + ti;
        __syncthreads();
        float x[16];
        { const u32x4 xa = *(const u32x4*)(H1G + (size_t)t * 1024 + 16 * l), xb = *(const u32x4*)(H1G + (size_t)t * 1024 + 16 * l + 8);
          x[0] = bf_lo(xa.x); x[1] = bf_hi(xa.x); x[2] = bf_lo(xa.y); x[3] = bf_hi(xa.y); x[4] = bf_lo(xa.z); x[5] = bf_hi(xa.z); x[6] = bf_lo(xa.w); x[7] = bf_hi(xa.w);
          x[8] = bf_lo(xb.x); x[9] = bf_hi(xb.x); x[10] = bf_lo(xb.y); x[11] = bf_hi(xb.y); x[12] = bf_lo(xb.z); x[13] = bf_hi(xb.z); x[14] = bf_lo(xb.w); x[15] = bf_hi(xb.w); }
        float rstd1; { const f32x4* sp = (const f32x4*)(SSQ1 + (size_t)t * 16); const f32x4 st = (sp[0] + sp[1]) + (sp[2] + sp[3]); rstd1 = __builtin_amdgcn_rsqf(((st[0] + st[1]) + (st[2] + st[3])) * (1.0f / 1024.0f) + EPS); }
        unsigned e0 = EXPO[(size_t)t * 128 + l], e1 = EXPO[(size_t)t * 128 + 64 + l];
        { unsigned s0 = (e0 << 18) | (e0 >> 14), s1 = (e1 << 18) | (e1 >> 14);
#pragma unroll
          for (int k = 2; k <= 128; k <<= 1) {
#pragma unroll
              for (int j = k >> 1; j >= 1; j >>= 1) {
                  if (j == 64) { const unsigned lo = min(s0, s1), hi = max(s0, s1); s0 = lo; s1 = hi; }
                  else { const bool up = (l & j) != 0;
                      const unsigned p0 = __shfl_xor(s0, j), p1 = __shfl_xor(s1, j);
                      const bool asc0 = (l & k) == 0, asc1 = ((l + 64) & k) == 0;
                      s0 = (up == asc0) ? max(s0, p0) : min(s0, p0);
                      s1 = (up == asc1) ? max(s1, p1) : min(s1, p1); } } }
          e0 = (s0 >> 18) | (s0 << 14); e1 = (s1 >> 18) | (s1 << 14); }
        const float cu0 = RSU[e0 & 0x3fffu] * rstd1, cu1 = RSU[e1 & 0x3fffu] * rstd1;
        const float cv0 = RSV[e0 & 0x3fffu] * __uint_as_float(e0 & ~0x3fffu), cv1 = RSV[e1 & 0x3fffu] * __uint_as_float(e1 & ~0x3fffu);
        float acc[16];
#pragma unroll
        for (int i = 0; i < 16; ++i) acc[i] = 0.f;
#pragma unroll 1
        for (int eb = 0; eb < 128; eb += 16) {
            u32x4 uw[16], vw[16];
#pragma unroll
            for (int k = 0; k < 16; ++k) { const int e = eb + k; const unsigned ent = (e < 64) ? __builtin_amdgcn_readlane(e0, e & 63) : __builtin_amdgcn_readlane(e1, e & 63);
                const size_t ro = (size_t)(ent & 0x3fffu) * 1024 + 16 * l; uw[k] = *(const u32x4*)(UB + ro); vw[k] = *(const u32x4*)(VB + ro); }
            float p[16];
#pragma unroll
            for (int k = 0; k < 16; ++k) { float f[16]; FP8_UNPACK16(uw[k], f); float s = 0.f;
#pragma unroll
                for (int i = 0; i < 16; ++i) s += f[i] * x[i];
                p[k] = s; }
            float q8[8], q4[4], q2[2], q1;
#pragma unroll
            for (int j = 0; j < 8; ++j) q8[j] = sum_swap32(p[j], p[8 + j]);
#pragma unroll
            for (int j = 0; j < 4; ++j) q4[j] = sum_swap16(q8[j], q8[4 + j]);
            { const bool up = (l & 8) != 0;
#pragma unroll
              for (int j = 0; j < 2; ++j) { const float keep = up ? q4[2 + j] : q4[j], send = up ? q4[j] : q4[2 + j]; q2[j] = keep + __shfl_xor(send, 8); } }
            { const bool up = (l & 4) != 0; const float keep = up ? q2[1] : q2[0], send = up ? q2[0] : q2[1]; q1 = keep + __shfl_xor(send, 4); }
            q1 += __shfl_xor(q1, 2); q1 += __shfl_xor(q1, 1);
            const int ei = eb + (l >> 2);
            const float cu = (ei < 64) ? __shfl(cu0, ei & 63) : __shfl(cu1, ei & 63), cv = (ei < 64) ? __shfl(cv0, ei & 63) : __shfl(cv1, ei & 63);
            const float a = gelu_tanh(q1 * cu) * cv;
#pragma unroll
            for (int k = 0; k < 16; ++k) { const float ak = __uint_as_float(__builtin_amdgcn_readlane(__float_as_uint(a), 4 * k)); float f[16]; FP8_UNPACK16(vw[k], f);
#pragma unroll
                for (int i = 0; i < 16; ++i) acc[i] += ak * f[i]; }
        }
        const float* hrow = H1 + (size_t)t * 1024 + 16 * l; float* h2row = H2 + (size_t)t * 1024 + 16 * l; float ss = 0.f; f32x4 h[4];
#pragma unroll
        for (int q = 0; q < 4; ++q) { h[q] = *(const f32x4*)(hrow + 4 * q);
#pragma unroll
            for (int j = 0; j < 4; ++j) { h[q][j] += acc[4 * q + j]; ss += h[q][j] * h[q][j]; }
            *(f32x4*)(h2row + 4 * q) = h[q]; }
        const float rstd3 = __builtin_amdgcn_rsqf(wave_sum(ss) * (1.0f / 1024.0f) + EPS);
        u32x4 o[2];
#pragma unroll
        for (int q2 = 0; q2 < 2; ++q2) { const f32x4 g0 = *(const f32x4*)(g_ple + 16 * l + 8 * q2), g1 = *(const f32x4*)(g_ple + 16 * l + 8 * q2 + 4);
            const f32x4 a = h[2 * q2] * rstd3 * g0, c = h[2 * q2 + 1] * rstd3 * g1;
            o[q2].x = cvtpk(a[0], a[1]); o[q2].y = cvtpk(a[2], a[3]); o[q2].z = cvtpk(c[0], c[1]); o[q2].w = cvtpk(c[2], c[3]); }
        *(u32x4*)(XN3 + (size_t)t * 1024 + 16 * l) = o[0]; *(u32x4*)(XN3 + (size_t)t * 1024 + 16 * l + 8) = o[1];
    }
}

__device__ __forceinline__ void phase_final(Frame& F) {
    const float* SSQ3 = WSP(float, WS_SSQ3); const float* g = F.in[19];
    const int l = F.lane; const int gw = F.vcu * NWAVES + F.wave, NGW = F.G * NWAVES;
    for (int t = gw; t < T_TOK; t += NGW) {
        const f32x4* sp = (const f32x4*)(SSQ3 + (size_t)t * 16); const f32x4 st = (sp[0] + sp[1]) + (sp[2] + sp[3]);
        const float rstd = __builtin_amdgcn_rsqf(((st[0] + st[1]) + (st[2] + st[3])) * (1.0f / 1024.0f) + EPS);
        f32x4* row = (f32x4*)(F.out + (size_t)t * 1024);
#pragma unroll
        for (int j = 0; j < 4; ++j) { const f32x4 gv = *((const f32x4*)g + l + 64 * j); const f32x4 o = row[l + 64 * j] * rstd * gv; if (!F.dry) row[l + 64 * j] = o; }
    }
}
#ifndef MK_FUSED
#define MK_FUSED 1
#endif
constexpr int NPHASE = 11;
struct Args { const float* in[20]; float* out; unsigned char* ws; int ph_lo, ph_hi, dry, pad; };
static_assert(sizeof(Args) == 20 * 8 + 8 + 8 + 4 * 4, "Args has no padding");

__global__ void __launch_bounds__(NWAVES * 64, 2) mk_fwd(Args args) {
    extern __shared__ __attribute__((aligned(16))) unsigned char lds_raw[];
    Frame F;
    F.lds = (LAS unsigned char*)lds_raw;
    F.wave = __builtin_amdgcn_readfirstlane(threadIdx.x >> 6); F.lane = lane_id(); F.tid = F.wave * 64 + F.lane;
    F.G = gridDim.x; { const int bx = blockIdx.x; F.vcu = (F.G % 8 == 0) ? (bx % 8) * (F.G / 8) + bx / 8 : bx; }
    F.in = args.in; F.out = args.out; F.ws = args.ws; F.dry = args.dry;
    volatile LAS unsigned* MISC = (volatile LAS unsigned*)(F.lds + MISC_OFF);
    if (F.tid < 64) MISC[F.tid] = 0u;
    __syncthreads();
    const int lo = args.ph_lo, hi = args.ph_hi;
    XcdBarrier bar; bar.bar = (unsigned*)(F.ws + WS_CTL) + CW_BAR; bar.x = 0; bar.st = nullptr;
    if (hi - lo > 1) bar = xcd_barrier_post((unsigned*)(F.ws + WS_CTL) + CW_BAR, MISC + 8, F.tid);
#ifndef PH_MASK
#define PH_MASK 0xFFFFFFFFu
#endif
#define IN(k) (((PH_MASK >> (k)) & 1u) && lo <= (k) && (k) < hi)
#define LAUNDER(p, T) do { unsigned _lo = (unsigned)(unsigned long long)(p), _hi = (unsigned)((unsigned long long)(p) >> 32); asm volatile("" : "+v"(_lo), "+v"(_hi)); \
        _lo = __builtin_amdgcn_readfirstlane(_lo); _hi = __builtin_amdgcn_readfirstlane(_hi); (p) = (T)(((unsigned long long)_hi << 32) | _lo); } while (0)
#define SEAM(k) do { if (IN(k) && IN((k) + 1)) xcd_barrier(bar, F.tid); LAUNDER(F.ws, unsigned char*); LAUNDER(F.out, float*); F.lane = lane_id(); F.tid = F.wave * 64 + F.lane; } while (0)
    const int bx = (int)blockIdx.x;
    LAS unsigned char* ring = F.lds + RING_OFF;

    if (IN(0)) { phase_prologue(F); } SEAM(0);
    if (IN(1)) {
        pg8::Gemm g{WSP(bf16_t, WS_XN1), WSP(bf16_t, WS_WIN), T_TOK, 8192, 1024, 1024, 0}; pg8::StaticOrder S; S.init(T_TOK, 8192, F.G, bx);
        pg8::EpiProj E{WSP(bf16_t, WS_GQ), WSP(bf16_t, WS_GK), WSP(bf16_t, WS_GV), WSP(bf16_t, WS_GR), WSP(bf16_t, WS_SQ), WSP(bf16_t, WS_SK), WSP(bf16_t, WS_SV),
                       (bf16_t*)F.out, (bf16_t*)F.out + (size_t)T_TOK * 1024};
        pg8::gemm_phase<pg8::EpiProj>(ring, g, S, E, F.tid);
    } SEAM(1);
    if (IN(2)) { phase_gla_prep(F); } SEAM(2);
    if (IN(3)) { phase_attn_a(F); } SEAM(3);
    if (IN(4)) { phase_attn_b(F); } SEAM(4);
    if (IN(5)) {
        cvt_rows_fp8(F, F.in[14], WSP(unsigned char, WS_UB8), WSP(float, WS_RSU));
        cvt_rows_fp8(F, F.in[15], WSP(unsigned char, WS_VB8), WSP(float, WS_RSV));
        VM_WAIT(); __syncthreads();
        pg8::StaticOrder S; S.init(T_TOK, 1024, F.G, bx);
        { pg8::Gemm g{WSP(bf16_t, WS_GLAN), WSP(bf16_t, WS_WGA), T_TOK, 1024, 1024, 1024, 0}; pg8::EpiMix<true> E{(const bf16_t*)F.out, WSP(bf16_t, WS_MIX)};
          pg8::gemm_phase<pg8::EpiMix<true>>(ring, g, S, E, F.tid); }
        { pg8::Gemm g{WSP(bf16_t, WS_SQ), WSP(bf16_t, WS_WSB), T_TOK, 1024, 1024, 1024, 0}; pg8::EpiMix<false> E{(const bf16_t*)F.out + (size_t)T_TOK * 1024, WSP(bf16_t, WS_MIX)};
          pg8::gemm_phase<pg8::EpiMix<false>>(ring, g, S, E, F.tid); }
    } SEAM(5);
    if (IN(6)) {
        pg8::Gemm g{WSP(bf16_t, WS_MIX), WSP(bf16_t, WS_WO), T_TOK, 1024, 1024, 1024, 0}; pg8::StaticOrder S; S.init(T_TOK, 1024, F.G, bx);
        pg8::EpiH1 E{F.in[0], F.in[10], WSP(float, WS_H1), WSP(bf16_t, WS_H1G), WSP(float, WS_SSQ1)};
        pg8::gemm_phase<pg8::EpiH1>(ring, g, S, E, F.tid);
    } SEAM(6);
    if (IN(7)) {
        pg8::Gemm g{WSP(bf16_t, WS_H1G), WSP(bf16_t, WS_WPQ), T_TOK, 2048, 1024, 1024, 0}; pg8::StaticOrder S; S.init(T_TOK, 2048, F.G, bx);
        pg8::EpiQ E{WSP(float, WS_SSQ1), WSP(bf16_t, WS_Q), 2048};
        pg8::gemm_phase<pg8::EpiQ>(ring, g, S, E, F.tid);
    } SEAM(7);
    if (IN(8)) {
        cvt_copy(F, F.in[1], WSP(bf16_t, WS_PB), (size_t)T_TOK * 256);
        phase_peer_retrieve(F);
        VM_WAIT(); __syncthreads();
        phase_peer_gather(F);
    } SEAM(8);
    if (IN(9)) {
        pg8::StaticOrder S; S.init(T_TOK, 1024, F.G, bx);
        { pg8::Gemm g{WSP(bf16_t, WS_PB), WSP(bf16_t, WS_WPLE), T_TOK, 1024, 256, 256, 0}; pg8::EpiBf E{WSP(bf16_t, WS_PLE), 1024};
          pg8::gemm_phase<pg8::EpiBf>(ring, g, S, E, F.tid); }
        { pg8::Gemm g{WSP(bf16_t, WS_XN3), WSP(bf16_t, WS_WPG), T_TOK, 1024, 1024, 1024, 0}; pg8::EpiH3 E{F.out, WSP(bf16_t, WS_PLE), F.out, WSP(float, WS_SSQ3), F.dry};
          pg8::gemm_phase<pg8::EpiH3>(ring, g, S, E, F.tid); }
    } SEAM(9);
    if (IN(10)) { phase_final(F); }
#undef IN
#undef SEAM
}

extern "C" void kernel_launch(void* const* d_in, const int* in_sizes, int n_in, void* d_out, int out_size, void* d_ws, size_t ws_size, hipStream_t stream) {
    static int grid = 0;
    if (grid == 0) {
        if (n_in != 20 || in_sizes[0] != T_TOK * 1024 || out_size != T_TOK * 1024 || ws_size < WS_END) {
            fprintf(stderr, "kernel_launch: unexpected shapes (n_in %d, in0 %d, out %d, ws %zu < %zu?); nothing launched\n", n_in, n_in > 0 ? in_sizes[0] : -1, out_size, ws_size, (size_t)WS_END); grid = -1; return; }
        int dev = 0, cus = 0, per_cu = 0;
        if (hipGetDevice(&dev) != hipSuccess || hipDeviceGetAttribute(&cus, hipDeviceAttributeMultiprocessorCount, dev) != hipSuccess) { grid = -1; return; }
        if (hipFuncSetAttribute((const void*)mk_fwd, hipFuncAttributeMaxDynamicSharedMemorySize, LDS_BYTES) != hipSuccess) { fprintf(stderr, "kernel_launch: hipFuncSetAttribute failed\n"); grid = -1; return; }
        if (hipOccupancyMaxActiveBlocksPerMultiprocessor(&per_cu, (const void*)mk_fwd, NWAVES * 64, LDS_BYTES) != hipSuccess || per_cu < 1)
            fprintf(stderr, "kernel_launch: note: occupancy query reports %d workgroups per CU\n", per_cu);
        (void)hipGetLastError();
        grid = cus;
        if (grid != 256) fprintf(stderr, "kernel_launch: note: %d CUs (kernel tuned for 256)\n", grid);
    }
    if (grid < 0) return;
    if (hipMemsetAsync((char*)d_ws + WS_CTL, 0, CTL_ZERO_BYTES, stream) != hipSuccess) { fprintf(stderr, "kernel_launch: hipMemsetAsync failed\n"); return; }
    Args a{};
    for (int i = 0; i < 20; ++i) a.in[i] = (const float*)d_in[i];
    a.out = (float*)d_out; a.ws = (unsigned char*)d_ws;
#if MK_FUSED
    a.ph_lo = 0; a.ph_hi = NPHASE;
    hipLaunchKernelGGL(mk_fwd, dim3(grid), dim3(NWAVES * 64), LDS_BYTES, stream, a);
#else
#ifndef PROBE_PHASE
#define PROBE_PHASE -1
#define PROBE_REPS 0
#endif
    for (int p = 0; p < NPHASE; ++p) { a.ph_lo = p; a.ph_hi = p + 1;
        if (p == PROBE_PHASE) { a.dry = 1; for (int r = 0; r < PROBE_REPS; ++r) hipLaunchKernelGGL(mk_fwd, dim3(grid), dim3(NWAVES * 64), LDS_BYTES, stream, a); a.dry = 0; }
        hipLaunchKernelGGL(mk_fwd, dim3(grid), dim3(NWAVES * 64), LDS_BYTES, stream, a); }
#endif
}
```

```cpp
#define MK_FUSED 1
#include <hip/hip_runtime.h>
#include <cstdio>
#include <cstdint>

#define LAS __attribute__((address_space(3)))
#define GAS __attribute__((address_space(1)))
typedef unsigned short bf16_t;
typedef short bf16x8 __attribute__((ext_vector_type(8)));
typedef short s16x4 __attribute__((ext_vector_type(4)));
typedef float f32x2 __attribute__((ext_vector_type(2)));
typedef float f32x4 __attribute__((ext_vector_type(4)));
typedef float f32x16 __attribute__((ext_vector_type(16)));
typedef unsigned u32x2 __attribute__((ext_vector_type(2)));
typedef unsigned u32x4 __attribute__((ext_vector_type(4)));
typedef __bf16 bf16x2_t __attribute__((ext_vector_type(2)));

__device__ __forceinline__ unsigned cvtpk(float lo, float hi) { f32x2 v = {lo, hi}; bf16x2_t b = __builtin_convertvector(v, bf16x2_t); return __builtin_bit_cast(unsigned, b); }
__device__ __forceinline__ float bf_lo(unsigned u) { return __uint_as_float(u << 16); }
__device__ __forceinline__ float bf_hi(unsigned u) { return __uint_as_float(u & 0xffff0000u); }
__device__ __forceinline__ float bf1(bf16_t u) { return __uint_as_float(((unsigned)u) << 16); }
__device__ __forceinline__ float fast_sigmoid(float x) { return __builtin_amdgcn_rcpf(1.0f + __expf(-x)); }

namespace pg8 {
constexpr int BM = 256, BK = 64, HALF = 128, HTB = HALF * BK * 2  , STAGE_BYTES = 8 * HTB, NXCD = 8, WGM = 8;

__host__ __device__ __forceinline__ int lds_byte(int r, int c) { const int st = (r >> 4) * 2 + (c >> 5), rr = r & 15, cc = c & 31, ob = rr * 64 + cc * 2; return st * 1024 + (ob ^ (((ob >> 9) & 1) << 5)); }
__host__ __device__ __forceinline__ void stage_rc(int b, int& R, int& C) { const int st = b / 1024, sb = b % 1024, swz = sb ^ (((sb >> 9) & 1) << 5); R = (st >> 1) * 16 + swz / 64; C = (st & 1) * 32 + (swz % 64) / 2; }
__host__ __device__ __forceinline__ int perm32(int rho) { const int n = rho >> 4, i = rho & 15; return 8 * (i >> 2) + 4 * n + (i & 3); }

struct Unit { int pm, pn; };
struct Gemm { const bf16_t* A; const bf16_t* Bt; int M, N, K, lda, a_pn_cols; };

struct StaticOrder {
    int nM, nN, nwg, G, c;
    __host__ __device__ void init(int M, int N, int G_, int c_) { nM = M / BM; nN = N / BM; nwg = nM * nN; G = G_; c = c_; }
    __host__ __device__ bool next(int i, Unit& u) const {
        const long L = (long)i * G + c; if (L >= nwg) return false;
        int wgid = (int)L; { const int q = nwg / NXCD, r = nwg % NXCD, xcd = wgid % NXCD, off = wgid / NXCD; wgid = (xcd < r ? xcd * (q + 1) : r * (q + 1) + (xcd - r) * q) + off; }
        const int nig = WGM * nN, gid = wgid / nig, fm = gid * WGM, gsz = (nM - fm) < WGM ? (nM - fm) : WGM;
        u.pm = fm + ((wgid % nig) % gsz); u.pn = (wgid % nig) / gsz; return true;
    }
};

template <class Epi, bool ALIGN_EPI = true, bool SP2 = true>
__device__ __forceinline__ void gemm_phase(LAS unsigned char* lds, const Gemm g, const StaticOrder& S, const Epi& E, int tid) {
    const int wid = __builtin_amdgcn_readfirstlane(tid >> 6), lane = tid & 63, wr = wid >> 2, wc = wid & 3, fr = lane & 15, fq = lane >> 4;
    const int K = g.K, nt = K / BK, lda = g.lda;
    unsigned voffA[2], voffB[2];
#pragma unroll
    for (int i = 0; i < 2; ++i) { int R, C; stage_rc(tid * 16 + i * 8192, R, C); const int Rb = Epi::PERM ? ((R & ~31) + perm32(R & 31)) : R;
        voffA[i] = (unsigned)(R * lda + C) * 2u; voffB[i] = (unsigned)(Rb * K + C) * 2u; }
    const size_t kstep = (size_t)(BK * 2);
    const size_t hA = (size_t)HALF * lda * 2, hB = (size_t)HALF * K * 2;
    const size_t tA = 2 * hA, tB = 2 * hB;
    const size_t pnA = (size_t)g.a_pn_cols * 2;
    const unsigned ldsw = (unsigned)wid * 1024u;
    const int aoff = lds_byte(wr * 64 + fr, fq * 8), boff = lds_byte(wc * 32 + fr, fq * 8);
#define PG8_SA(b, h) (((b) * 2 + (h)) * HTB)
#define PG8_SB(b, h) ((4 + (b) * 2 + (h)) * HTB)
#define PG8_STAGE(bufoff, gbase, voff) do { _Pragma("unroll") for (int _i = 0; _i < 2; ++_i) \
        __builtin_amdgcn_global_load_lds((const unsigned*)((const char*)(gbase) + (voff)[_i]), (LAS unsigned*)(lds + (bufoff) + ldsw + _i * 8192), 16, 0, 0); } while (0)
#define PG8_LDA(dst, b, h) do { _Pragma("unroll") for (int m = 0; m < 4; ++m) _Pragma("unroll") for (int k = 0; k < 2; ++k) dst[m][k] = *(const LAS bf16x8*)(lds + PG8_SA(b, h) + aoff + m * 2048 + k * 1024); } while (0)
#define PG8_LDB(dst, b, h) do { _Pragma("unroll") for (int n = 0; n < 2; ++n) _Pragma("unroll") for (int k = 0; k < 2; ++k) dst[n][k] = *(const LAS bf16x8*)(lds + PG8_SB(b, h) + boff + n * 2048 + k * 1024); } while (0)
#define PG8_MMA(ai, bj, At, Bt) do { __builtin_amdgcn_s_setprio(1); _Pragma("unroll") for (int m = 0; m < 4; ++m) _Pragma("unroll") for (int n = 0; n < 2; ++n) _Pragma("unroll") for (int k = 0; k < 2; ++k) \
        acc[ai][bj][m][n] = __builtin_amdgcn_mfma_f32_16x16x32_bf16(Bt[n][k], At[m][k], acc[ai][bj][m][n], 0, 0, 0); __builtin_amdgcn_s_setprio(0); } while (0)
#define PG8_WAIT_V(n) asm volatile("s_waitcnt vmcnt(" #n ")" ::: "memory")
#define PG8_WAIT_L(n) asm volatile("s_waitcnt lgkmcnt(" #n ")" ::: "memory")
#define PG8_BAR __builtin_amdgcn_s_barrier()
#define PG8_SCHED __builtin_amdgcn_sched_barrier(0)
    Unit cur, nxt; int ui = 0;
    if (!S.next(0, cur)) return;
    f32x4 acc[2][2][4][2];
#pragma unroll
    for (int a = 0; a < 2; ++a)
#pragma unroll
        for (int b = 0; b < 2; ++b)
#pragma unroll
            for (int m = 0; m < 4; ++m)
#pragma unroll
                for (int n = 0; n < 2; ++n) acc[a][b][m][n] = (f32x4){0.f, 0.f, 0.f, 0.f};
    bf16x8 At[4][2], B0[2][2], B1[2][2];
    const char* cA = (const char*)g.A + (size_t)cur.pm * tA + (size_t)cur.pn * pnA; const char* cB = (const char*)g.Bt + (size_t)cur.pn * tB;
    if constexpr (SP2) {
        PG8_STAGE(PG8_SB(0, 0), cB, voffB); PG8_STAGE(PG8_SB(0, 1), cB + hB, voffB); PG8_STAGE(PG8_SA(0, 0), cA, voffA); PG8_STAGE(PG8_SA(0, 1), cA + hA, voffA);
        if (wr == 1) PG8_BAR;
        PG8_WAIT_V(2); PG8_BAR;
        PG8_STAGE(PG8_SB(1, 0), cB + kstep, voffB); PG8_STAGE(PG8_SA(1, 0), cA + kstep, voffA); PG8_STAGE(PG8_SB(1, 1), cB + hB + kstep, voffB);
        PG8_WAIT_V(6); PG8_BAR;
    } else {
        PG8_STAGE(PG8_SB(0, 0), cB, voffB); PG8_STAGE(PG8_SA(0, 0), cA, voffA); PG8_STAGE(PG8_SB(0, 1), cB + hB, voffB); PG8_STAGE(PG8_SA(0, 1), cA + hA, voffA);
        if (wr == 1) PG8_BAR;
        PG8_WAIT_V(4); PG8_BAR;
        PG8_STAGE(PG8_SB(1, 0), cB + kstep, voffB); PG8_STAGE(PG8_SA(1, 0), cA + kstep, voffA); PG8_STAGE(PG8_SB(1, 1), cB + hB + kstep, voffB);
        PG8_WAIT_V(6); PG8_BAR;
    }
    for (;;) {
        const bool has_next = S.next(ui + 1, nxt);
        const char* nA = has_next ? (const char*)g.A + (size_t)nxt.pm * tA + (size_t)nxt.pn * pnA : cA; const char* nB = has_next ? (const char*)g.Bt + (size_t)nxt.pn * tB : cB;
#pragma unroll 1
        for (int t = 0; t < nt; t += 2) {
            const bool last = (t == nt - 2);
            const char* a1 = cA + (size_t)(t + 1) * kstep;
            const char* a2 = last ? nA : cA + (size_t)(t + 2) * kstep; const char* b2 = last ? nB : cB + (size_t)(t + 2) * kstep;
            const char* a3 = a2 + kstep; const char* b3 = b2 + kstep;
            if constexpr (SP2) {
            PG8_LDB(B0, 0, 0); PG8_LDB(B1, 0, 1); PG8_SCHED; PG8_LDA(At, 0, 0); PG8_STAGE(PG8_SA(1, 1), a1 + hA, voffA);
            PG8_WAIT_V(8); PG8_WAIT_L(0); PG8_BAR; PG8_MMA(0, 0, At, B0); PG8_MMA(0, 1, At, B1); PG8_BAR; PG8_SCHED;
            PG8_LDA(At, 0, 1); PG8_STAGE(PG8_SB(0, 0), b2, voffB); PG8_STAGE(PG8_SB(0, 1), b2 + hB, voffB); PG8_STAGE(PG8_SA(0, 0), a2, voffA);
            PG8_WAIT_V(8); PG8_WAIT_L(0); PG8_BAR; PG8_MMA(1, 0, At, B0); PG8_MMA(1, 1, At, B1); PG8_BAR; PG8_SCHED;
            PG8_LDB(B0, 1, 0); PG8_LDB(B1, 1, 1); PG8_SCHED; PG8_LDA(At, 1, 0); PG8_STAGE(PG8_SA(0, 1), a2 + hA, voffA);
            PG8_WAIT_V(8); PG8_WAIT_L(0); PG8_BAR; PG8_MMA(0, 0, At, B0); PG8_MMA(0, 1, At, B1); PG8_BAR; PG8_SCHED;
            PG8_LDA(At, 1, 1); PG8_STAGE(PG8_SB(1, 0), b3, voffB); PG8_STAGE(PG8_SB(1, 1), b3 + hB, voffB); PG8_STAGE(PG8_SA(1, 0), a3, voffA);
            PG8_WAIT_V(8); PG8_WAIT_L(0); PG8_BAR; PG8_MMA(1, 0, At, B0); PG8_MMA(1, 1, At, B1); PG8_BAR; PG8_SCHED;
            } else {
            PG8_LDB(B0, 0, 0); PG8_SCHED; PG8_LDA(At, 0, 0); PG8_STAGE(PG8_SA(1, 1), a1 + hA, voffA);
            PG8_WAIT_L(8); PG8_BAR; PG8_WAIT_L(0); PG8_MMA(0, 0, At, B0); PG8_BAR; PG8_SCHED;
            PG8_LDB(B1, 0, 1); PG8_STAGE(PG8_SB(0, 0), b2, voffB);
            PG8_BAR; PG8_WAIT_L(0); PG8_MMA(0, 1, At, B1); PG8_BAR;
            PG8_LDA(At, 0, 1); PG8_STAGE(PG8_SA(0, 0), a2, voffA);
            PG8_BAR; PG8_WAIT_L(0); PG8_MMA(1, 0, At, B0); PG8_BAR; PG8_SCHED;
            PG8_STAGE(PG8_SB(0, 1), b2 + hB, voffB);
            PG8_WAIT_V(6); PG8_BAR; PG8_MMA(1, 1, At, B1); PG8_BAR;
            PG8_LDB(B0, 1, 0); PG8_SCHED; PG8_LDA(At, 1, 0); PG8_STAGE(PG8_SA(0, 1), a2 + hA, voffA);
            PG8_WAIT_L(8); PG8_BAR; PG8_WAIT_L(0); PG8_MMA(0, 0, At, B0); PG8_BAR; PG8_SCHED;
            PG8_LDB(B1, 1, 1); PG8_STAGE(PG8_SB(1, 0), b3, voffB);
            PG8_BAR; PG8_WAIT_L(0); PG8_MMA(0, 1, At, B1); PG8_BAR;
            PG8_LDA(At, 1, 1); PG8_STAGE(PG8_SA(1, 0), a3, voffA);
            PG8_BAR; PG8_WAIT_L(0); PG8_MMA(1, 0, At, B0); PG8_BAR; PG8_SCHED;
            PG8_STAGE(PG8_SB(1, 1), b3 + hB, voffB);
            PG8_WAIT_V(6); PG8_BAR; PG8_MMA(1, 1, At, B1); PG8_BAR;
            }
        }
        if constexpr (ALIGN_EPI) { if (wr == 0) PG8_BAR; }
        E(acc, cur, wr, wc, fr, fq);
        if (!has_next) break;
#pragma unroll
        for (int a = 0; a < 2; ++a)
#pragma unroll
            for (int b = 0; b < 2; ++b)
#pragma unroll
                for (int m = 0; m < 4; ++m)
#pragma unroll
                    for (int n = 0; n < 2; ++n) acc[a][b][m][n] = (f32x4){0.f, 0.f, 0.f, 0.f};
        cur = nxt; cA = nA; cB = nB; ++ui;
        if constexpr (ALIGN_EPI) { if (wr == 1) PG8_BAR; }
    }
    PG8_WAIT_V(0);
    if constexpr (!ALIGN_EPI) { if (wr == 0) PG8_BAR; }
    PG8_BAR;
#undef PG8_SA
#undef PG8_SB
#undef PG8_STAGE
#undef PG8_LDA
#undef PG8_LDB
#undef PG8_MMA
#undef PG8_WAIT_V
#undef PG8_WAIT_L
#undef PG8_BAR
#undef PG8_SCHED
}
}
constexpr int T_TOK = 16384, DM = 1024, SEQ = 4096, NB = 4;
constexpr float EPS = 1e-6f;
constexpr float LOG2E = 1.4426950408889634f;

namespace pg8 {
struct EpiProj {
    static constexpr bool PERM = true;
    bf16_t *GQ, *GK, *GV, *GR, *SQ, *SK, *SV, *SGA, *SGB;
    __device__ __forceinline__ void operator()(const f32x4 (&acc)[2][2][4][2], const Unit& u, int wr, int wc, int fr, int fq) const {
        const int pn = u.pn; bf16_t* base; int ldc = 1024, c0; int act = 0; float sc = 1.f;
        if (pn < 2) { base = GQ; ldc = 512; c0 = pn * 256; sc = 0.08838834764831845f; }
        else if (pn < 4) { base = GK; ldc = 512; c0 = (pn - 2) * 256; }
        else if (pn < 8) { base = GV; c0 = (pn - 4) * 256; }
        else if (pn < 12) { base = GR; c0 = (pn - 8) * 256; act = 1; }
        else if (pn < 16) { base = SQ; c0 = (pn - 12) * 256; sc = 0.125f * LOG2E; }
        else if (pn < 20) { base = SK; c0 = (pn - 16) * 256; }
        else if (pn < 24) { base = SV; c0 = (pn - 20) * 256; }
        else if (pn < 28) { base = SGA; c0 = (pn - 24) * 256; act = 2; }
        else { base = SGB; c0 = (pn - 28) * 256; act = 2; }
        const int row0 = u.pm * BM + wr * 64 + fr, col0 = c0 + wc * 32 + 8 * fq;
#pragma unroll
        for (int ai = 0; ai < 2; ++ai)
#pragma unroll
            for (int m = 0; m < 4; ++m) { bf16_t* rowp = base + (size_t)(row0 + ai * HALF + m * 16) * ldc + col0;
#pragma unroll
                for (int bj = 0; bj < 2; ++bj) { f32x4 v0 = acc[ai][bj][m][0], v1 = acc[ai][bj][m][1];
                    if (act == 1) {
#pragma unroll
                        for (int j = 0; j < 4; ++j) { v0[j] = v0[j] * fast_sigmoid(v0[j]); v1[j] = v1[j] * fast_sigmoid(v1[j]); } }
                    else if (act == 2) {
#pragma unroll
                        for (int j = 0; j < 4; ++j) { v0[j] = fast_sigmoid(v0[j]); v1[j] = fast_sigmoid(v1[j]); } }
                    else { v0 = v0 * sc; v1 = v1 * sc; }
                    u32x4 w; w.x = cvtpk(v0[0], v0[1]); w.y = cvtpk(v0[2], v0[3]); w.z = cvtpk(v1[0], v1[1]); w.w = cvtpk(v1[2], v1[3]);
                    *(u32x4*)(rowp + bj * HALF) = w; } }
    }
};
template <bool FIRST> struct EpiMix {
    static constexpr bool PERM = true;
    const bf16_t* gate; bf16_t* mixed;
    __device__ __forceinline__ void operator()(const f32x4 (&acc)[2][2][4][2], const Unit& u, int wr, int wc, int fr, int fq) const {
        const int row0 = u.pm * BM + wr * 64 + fr, col0 = u.pn * BM + wc * 32 + 8 * fq;
#pragma unroll
        for (int ai = 0; ai < 2; ++ai)
#pragma unroll
            for (int m = 0; m < 4; ++m) { const size_t off = (size_t)(row0 + ai * HALF + m * 16) * 1024 + col0;
#pragma unroll
                for (int bj = 0; bj < 2; ++bj) { const f32x4 a0 = acc[ai][bj][m][0], a1 = acc[ai][bj][m][1];
                    const u32x4 gv = *(const u32x4*)(gate + off + bj * HALF);
                    float r[8];
                    r[0] = a0[0] * bf_lo(gv.x); r[1] = a0[1] * bf_hi(gv.x); r[2] = a0[2] * bf_lo(gv.y); r[3] = a0[3] * bf_hi(gv.y);
                    r[4] = a1[0] * bf_lo(gv.z); r[5] = a1[1] * bf_hi(gv.z); r[6] = a1[2] * bf_lo(gv.w); r[7] = a1[3] * bf_hi(gv.w);
                    if (!FIRST) { const u32x4 mv = *(const u32x4*)(mixed + off + bj * HALF);
                        r[0] += bf_lo(mv.x); r[1] += bf_hi(mv.x); r[2] += bf_lo(mv.y); r[3] += bf_hi(mv.y); r[4] += bf_lo(mv.z); r[5] += bf_hi(mv.z); r[6] += bf_lo(mv.w); r[7] += bf_hi(mv.w); }
                    u32x4 w; w.x = cvtpk(r[0], r[1]); w.y = cvtpk(r[2], r[3]); w.z = cvtpk(r[4], r[5]); w.w = cvtpk(r[6], r[7]);
                    *(u32x4*)(mixed + off + bj * HALF) = w; } }
    }
};
struct EpiH1 {
    static constexpr bool PERM = false;
    const float* x; const float* g; float* H1; bf16_t* H1G; float* SSQ;
    __device__ __forceinline__ void operator()(const f32x4 (&acc)[2][2][4][2], const Unit& u, int wr, int wc, int fr, int fq) const {
        const int row0 = u.pm * BM + wr * 64 + fr, col0 = u.pn * BM + wc * 32 + 4 * fq;
        f32x4 gv[2][2];
#pragma unroll
        for (int bj = 0; bj < 2; ++bj)
#pragma unroll
            for (int n = 0; n < 2; ++n) gv[bj][n] = *(const f32x4*)(g + col0 + bj * HALF + n * 16);
#pragma unroll
        for (int ai = 0; ai < 2; ++ai)
#pragma unroll
            for (int m = 0; m < 4; ++m) { const int row = row0 + ai * HALF + m * 16; const size_t off = (size_t)row * 1024 + col0; float s = 0.f;
#pragma unroll
                for (int bj = 0; bj < 2; ++bj)
#pragma unroll
                    for (int n = 0; n < 2; ++n) { const f32x4 xv = *(const f32x4*)(x + off + bj * HALF + n * 16); const f32x4 h = xv + acc[ai][bj][m][n];
                        *(f32x4*)(H1 + off + bj * HALF + n * 16) = h; s += (h[0] * h[0] + h[1] * h[1]) + (h[2] * h[2] + h[3] * h[3]);
                        const f32x4 hg = h * gv[bj][n]; u32x2 w; w.x = cvtpk(hg[0], hg[1]); w.y = cvtpk(hg[2], hg[3]); *(u32x2*)(H1G + off + bj * HALF + n * 16) = w; }
                s += __shfl_xor(s, 16); s += __shfl_xor(s, 32);
                if (fq == 0) SSQ[(size_t)row * 16 + u.pn * 4 + wc] = s; }
    }
};
struct EpiQ {
    static constexpr bool PERM = true;
    const float* SSQ; bf16_t* Q; int ldc;
    __device__ __forceinline__ void operator()(const f32x4 (&acc)[2][2][4][2], const Unit& u, int wr, int wc, int fr, int fq) const {
        const int row0 = u.pm * BM + wr * 64 + fr, col0 = u.pn * BM + wc * 32 + 8 * fq;
#pragma unroll
        for (int ai = 0; ai < 2; ++ai)
#pragma unroll
            for (int m = 0; m < 4; ++m) { const int row = row0 + ai * HALF + m * 16; const f32x4* sp = (const f32x4*)(SSQ + (size_t)row * 16);
                const f32x4 s0 = sp[0], s1 = sp[1], s2 = sp[2], s3 = sp[3]; const f32x4 st = (s0 + s1) + (s2 + s3);
                const float rstd = __builtin_amdgcn_rsqf(((st[0] + st[1]) + (st[2] + st[3])) * (1.0f / 1024.0f) + EPS);
                bf16_t* rowp = Q + (size_t)row * ldc + col0;
#pragma unroll
                for (int bj = 0; bj < 2; ++bj) { const f32x4 v0 = acc[ai][bj][m][0] * rstd, v1 = acc[ai][bj][m][1] * rstd;
                    u32x4 w; w.x = cvtpk(v0[0], v0[1]); w.y = cvtpk(v0[2], v0[3]); w.z = cvtpk(v1[0], v1[1]); w.w = cvtpk(v1[2], v1[3]);
                    *(u32x4*)(rowp + bj * HALF) = w; } }
    }
};
struct EpiF32 {
    static constexpr bool PERM = false;
    float* O; int ldc;
    __device__ __forceinline__ void operator()(const f32x4 (&acc)[2][2][4][2], const Unit& u, int wr, int wc, int fr, int fq) const {
        const int row0 = u.pm * BM + wr * 64 + fr, col0 = u.pn * BM + wc * 32 + 4 * fq;
#pragma unroll
        for (int ai = 0; ai < 2; ++ai)
#pragma unroll
            for (int m = 0; m < 4; ++m) { float* rowp = O + (size_t)(row0 + ai * HALF + m * 16) * ldc + col0;
#pragma unroll
                for (int bj = 0; bj < 2; ++bj)
#pragma unroll
                    for (int n = 0; n < 2; ++n) *(f32x4*)(rowp + bj * HALF + n * 16) = acc[ai][bj][m][n]; }
    }
};
struct EpiBf {
    static constexpr bool PERM = true;
    bf16_t* O; int ldc;
    __device__ __forceinline__ void operator()(const f32x4 (&acc)[2][2][4][2], const Unit& u, int wr, int wc, int fr, int fq) const {
        const int row0 = u.pm * BM + wr * 64 + fr, col0 = u.pn * BM + wc * 32 + 8 * fq;
#pragma unroll
        for (int ai = 0; ai < 2; ++ai)
#pragma unroll
            for (int m = 0; m < 4; ++m) { bf16_t* rowp = O + (size_t)(row0 + ai * HALF + m * 16) * ldc + col0;
#pragma unroll
                for (int bj = 0; bj < 2; ++bj) { const f32x4 v0 = acc[ai][bj][m][0], v1 = acc[ai][bj][m][1];
                    u32x4 w; w.x = cvtpk(v0[0], v0[1]); w.y = cvtpk(v0[2], v0[3]); w.z = cvtpk(v1[0], v1[1]); w.w = cvtpk(v1[2], v1[3]);
                    *(u32x4*)(rowp + bj * HALF) = w; } }
    }
};
struct EpiH3 {
    static constexpr bool PERM = false;
    const float* H2; const bf16_t* PLE; float* OUT; float* SSQ; int dry;
    __device__ __forceinline__ void operator()(const f32x4 (&acc)[2][2][4][2], const Unit& u, int wr, int wc, int fr, int fq) const {
        const int row0 = u.pm * BM + wr * 64 + fr, col0 = u.pn * BM + wc * 32 + 4 * fq;
#pragma unroll
        for (int ai = 0; ai < 2; ++ai)
#pragma unroll
            for (int m = 0; m < 4; ++m) { const int row = row0 + ai * HALF + m * 16; const size_t off = (size_t)row * 1024 + col0; float s = 0.f;
#pragma unroll
                for (int bj = 0; bj < 2; ++bj)
#pragma unroll
                    for (int n = 0; n < 2; ++n) { const size_t o2 = off + bj * HALF + n * 16; const f32x4 hv = *(const f32x4*)(H2 + o2); const u32x2 pv = *(const u32x2*)(PLE + o2);
                        const f32x4 a = acc[ai][bj][m][n]; f32x4 h;
                        h[0] = hv[0] + bf_lo(pv.x) * fast_sigmoid(a[0]); h[1] = hv[1] + bf_hi(pv.x) * fast_sigmoid(a[1]);
                        h[2] = hv[2] + bf_lo(pv.y) * fast_sigmoid(a[2]); h[3] = hv[3] + bf_hi(pv.y) * fast_sigmoid(a[3]);
                        if (!dry) *(f32x4*)(OUT + o2) = h; s += (h[0] * h[0] + h[1] * h[1]) + (h[2] * h[2] + h[3] * h[3]); }
                s += __shfl_xor(s, 16); s += __shfl_xor(s, 32);
                if (fq == 0) SSQ[(size_t)row * 16 + u.pn * 4 + wc] = s;
                asm volatile("" ::: "memory"); }
    }
};
}
constexpr size_t MiB = 1u << 20;
constexpr size_t WS_CTL = 0, CTL_ZERO_BYTES = 64 * 1024;
constexpr size_t WS_PEND = 64 * 1024;
constexpr size_t WS_WPLE = 512 * 1024;
constexpr size_t WS_KD = 1 * MiB;
constexpr size_t WS_GLAG = 2 * MiB;
constexpr size_t WS_WIN = 3 * MiB;
constexpr size_t WS_SEND = 4 * MiB;
constexpr size_t WS_EXP = 4 * MiB;
constexpr size_t WS_SSQ1 = 13 * MiB;
constexpr size_t WS_SSQ3 = 14 * MiB;
constexpr size_t WS_RSU = 15 * MiB, WS_RSV = 15 * MiB + 64 * 1024;
constexpr size_t WS_WGA = 20 * MiB, WS_WSB = 22 * MiB, WS_WO = 24 * MiB, WS_WPG = 26 * MiB, WS_WPQ = 28 * MiB;
constexpr size_t WS_A = 32 * MiB;
constexpr size_t WS_GQ = WS_A, WS_GK = WS_A + 16 * MiB, WS_UB8 = WS_A, WS_VB8 = WS_A + 16 * MiB;
constexpr size_t WS_B = 64 * MiB;
constexpr size_t WS_GV = WS_B, WS_PB = WS_B;
constexpr size_t WS_C = 96 * MiB;
constexpr size_t WS_GR = WS_C, WS_H1 = WS_C;
constexpr size_t WS_D = 128 * MiB;
constexpr size_t WS_SQ = WS_D;
constexpr size_t WS_E = 160 * MiB;
constexpr size_t WS_SK = WS_E, WS_MIX = WS_E, WS_Q = WS_E, WS_XN3 = WS_E;
constexpr size_t WS_F = 192 * MiB;
constexpr size_t WS_SV = WS_F;
constexpr size_t WS_G = 224 * MiB;
constexpr size_t WS_XN1 = WS_G, WS_GLAN = WS_G, WS_H1G = WS_G, WS_PLE = WS_G;
constexpr size_t WS_END = 256 * MiB;

constexpr int NWAVES = 8;
constexpr int RING_OFF = 0, RING_BYTES = 131072;
constexpr int MISC_OFF = RING_BYTES;
constexpr int LDS_BYTES = 147456;
constexpr int CW_BAR = 1024;

typedef GAS unsigned gu32;
#define RLX_AGENT __ATOMIC_RELAXED, __HIP_MEMORY_SCOPE_AGENT
#define LDS_WAIT() asm volatile("s_waitcnt lgkmcnt(0)" ::: "memory")
#define VM_WAIT() asm volatile("s_waitcnt vmcnt(0)" ::: "memory")

#define XB_TMO      128
#define XB_XCNT(j)  (256  + 64 * (j))
#define XB_XSUB(j)  (1280 + 64 * (j))
#define XB_XGEN(j)  (2304 + 64 * (j))
#define XB_TOP      3328
#define XB_TOPGEN   3392
#define XCD_BAR_WORDS 3456
#define XB_SPIN_CAP (1u << 22)
__device__ __forceinline__ unsigned xb_ld(unsigned* p)              { return __hip_atomic_load(p, __ATOMIC_RELAXED, __HIP_MEMORY_SCOPE_AGENT); }
__device__ __forceinline__ unsigned xb_add(unsigned* p, unsigned v) { return __hip_atomic_fetch_add(p, v, __ATOMIC_RELAXED, __HIP_MEMORY_SCOPE_AGENT); }
__device__ __forceinline__ unsigned xb_xcc_id() { return (unsigned)__builtin_amdgcn_s_getreg((3 << 11) | 20) & 0xFu; }
#define XB_SPIN(cond, bar) do { unsigned _sp = 0; while (cond) { __builtin_amdgcn_s_sleep(1); \
    if ((++_sp & 255u) == 0u) { if (xb_ld(&(bar)[XB_TMO])) break; if (_sp > XB_SPIN_CAP) { atomicAdd(&(bar)[XB_TMO], 1u); break; } } } } while (0)
struct XcdBarrier { unsigned* bar; unsigned x; volatile LAS unsigned* st; };
__device__ __forceinline__ XcdBarrier xcd_barrier_post(unsigned* bar, volatile LAS unsigned* st, int tid) {
    XcdBarrier b; b.bar = bar; b.x = xb_xcc_id(); b.st = st;
    if (tid == 0) (void)xb_add(&bar[XB_XCNT(b.x)], 1u);
    return b;
}
__device__ __forceinline__ void xcd_barrier_complete(unsigned* bar, unsigned x, unsigned& nloc, unsigned& nx) {
    const unsigned G = gridDim.x * gridDim.y * gridDim.z;
    unsigned sum, cnt, mine, sp = 0u;
    for (;;) {
        sum = 0u; cnt = 0u; mine = 0u;
#pragma unroll
        for (unsigned j = 0; j < 16; ++j) { const unsigned c = xb_ld(&bar[XB_XCNT(j)]); sum += c; cnt += (c > 0u) ? 1u : 0u; mine = (j == x) ? c : mine; }
        if (sum == G) break;
        __builtin_amdgcn_s_sleep(1);
        if ((++sp & 255u) == 0u) { if (xb_ld(&bar[XB_TMO])) break; if (sp > XB_SPIN_CAP) { atomicAdd(&bar[XB_TMO], 1u); break; } }
    }
    nloc = mine > 0u ? mine : 1u; nx = cnt > 0u ? cnt : 1u;
}
__device__ __forceinline__ void xcd_barrier(const XcdBarrier& b, int tid) {
    asm volatile("s_waitcnt vmcnt(0)" ::: "memory");
    __syncthreads();
    if (tid == 0) {
        unsigned* bar = b.bar;
        __builtin_amdgcn_s_waitcnt(0);
        unsigned nloc = b.st[0], nx = b.st[1];
        if (nloc == 0u) { xcd_barrier_complete(bar, b.x, nloc, nx); b.st[0] = nloc; b.st[1] = nx; }
        const unsigned old = xb_add(&bar[XB_XSUB(b.x)], 1u);
        const unsigned gen = old / nloc;
        if (old + 1u == (gen + 1u) * nloc) {
            __builtin_amdgcn_fence(__ATOMIC_RELEASE, "agent");
            asm volatile("s_waitcnt vmcnt(0)" ::: "memory");
            const unsigned og = xb_add(&bar[XB_TOP], 1u);
            const unsigned tg = og / nx;
            if (og + 1u == (tg + 1u) * nx) xb_add(&bar[XB_TOPGEN], 1u);
            else XB_SPIN(xb_ld(&bar[XB_TOPGEN]) == tg, bar);
            __builtin_amdgcn_fence(__ATOMIC_ACQUIRE, "agent");
            xb_add(&bar[XB_XGEN(b.x)], 1u);
            asm volatile("s_waitcnt vmcnt(0)" ::: "memory");
        } else {
            XB_SPIN(xb_ld(&bar[XB_XGEN(b.x)]) == gen, bar);
            __builtin_amdgcn_fence(__ATOMIC_ACQUIRE, "agent");
            asm volatile("s_waitcnt vmcnt(0)" ::: "memory");
        }
    }
    __syncthreads();
}

struct Frame {
    LAS unsigned char* lds;
    int tid, lane, wave, vcu, G, dry;
    const float* const* in; float* out; unsigned char* ws;
};
__device__ __forceinline__ int lane_id() { int l; asm volatile("v_mbcnt_lo_u32_b32 %0, -1, 0\n\tv_mbcnt_hi_u32_b32 %0, -1, %0" : "=v"(l)); return l; }
#define WSP(T, off) ((T*)(F.ws + (off)))
__device__ __forceinline__ float wave_sum(float v) {
#pragma unroll
    for (int o = 1; o < 64; o <<= 1) v += __shfl_xor(v, o);
    return v;
}
template <class RowMap>
__device__ __forceinline__ void p0_transpose_item(const float* W, int K, int N, bf16_t* WT, RowMap rm, LAS float* scr, int item, int lane) {
    const int nblk = (N + 31) / 32, kb = item / nblk, nb = item % nblk, k0 = 64 * kb, n0 = 32 * nb;
    const int nl = n0 + (lane & 31);
#pragma unroll 8
    for (int i = 0; i < 32; ++i) { const int kk = 2 * i + (lane >> 5); scr[kk * 33 + (lane & 31)] = (nl < N) ? W[(size_t)(k0 + kk) * N + nl] : 0.f; }
    LDS_WAIT(); asm volatile("" ::: "memory");
    const int c = lane & 7;
#pragma unroll
    for (int j = 0; j < 4; ++j) { const int n = (lane >> 3) + 8 * j; const LAS float* s = scr + (8 * c) * 33 + n;
        u32x4 o; o.x = cvtpk(s[0 * 33], s[1 * 33]); o.y = cvtpk(s[2 * 33], s[3 * 33]); o.z = cvtpk(s[4 * 33], s[5 * 33]); o.w = cvtpk(s[6 * 33], s[7 * 33]);
        if (n0 + n < N) *(u32x4*)(WT + (size_t)rm(n0 + n) * K + k0 + 8 * c) = o; }
    LDS_WAIT(); asm volatile("" ::: "memory");
}
struct RmId { __device__ __forceinline__ int operator()(int n) const { return n; } };
struct RmWin { __device__ __forceinline__ int operator()(int n) const { return n < 3072 ? n : (n < 3088 ? 8192 + (n - 3072) : n - 16); } };

__device__ __forceinline__ void cvt_copy(Frame& F, const float* src, bf16_t* dst, size_t n) {
    const size_t nth = (size_t)F.G * 512, n8 = n / 8;
    for (size_t i = (size_t)F.vcu * 512 + F.tid; i < n8; i += nth) {
        const f32x4 a = *(const f32x4*)(src + i * 8), b = *(const f32x4*)(src + i * 8 + 4);
        u32x4 o; o.x = cvtpk(a[0], a[1]); o.y = cvtpk(a[2], a[3]); o.z = cvtpk(b[0], b[1]); o.w = cvtpk(b[2], b[3]);
        *(u32x4*)(dst + i * 8) = o; }
}
__device__ __forceinline__ void rms_row_to_bf16(const float* xrow, const float* g, bf16_t* orow, int lane) {
    f32x4 v[4]; float s = 0.f;
#pragma unroll
    for (int j = 0; j < 4; ++j) { v[j] = *((const f32x4*)xrow + lane + 64 * j); s += (v[j][0] * v[j][0] + v[j][1] * v[j][1]) + (v[j][2] * v[j][2] + v[j][3] * v[j][3]); }
    const float rstd = __builtin_amdgcn_rsqf(wave_sum(s) * (1.f / 1024.f) + EPS);
#pragma unroll
    for (int j = 0; j < 4; ++j) { const f32x4 gv = *((const f32x4*)g + lane + 64 * j); const f32x4 o = v[j] * rstd * gv;
        u32x2 w; w.x = cvtpk(o[0], o[1]); w.y = cvtpk(o[2], o[3]); *((u32x2*)orow + lane + 64 * j) = w; }
}
__device__ __forceinline__ void phase_prologue(Frame& F) {
    LAS float* scr = (LAS float*)(F.lds + RING_OFF + F.wave * 16384);
    const int gw = F.vcu * NWAVES + F.wave, NGW = F.G * NWAVES;
    constexpr int I_IN = 16 * 257, I_SQ = 16 * 32, I_PQ = 16 * 64, I_PLE = 4 * 32;
    constexpr int NITEMS = I_IN + 4 * I_SQ + I_PQ + I_PLE;
    for (int it = gw; it < NITEMS; it += NGW) {
        int r = it;
        if (r < I_IN) { p0_transpose_item(F.in[3], 1024, 8208, WSP(bf16_t, WS_WIN), RmWin(), scr, r, F.lane); continue; } r -= I_IN;
        if (r < I_SQ) { p0_transpose_item(F.in[7], 1024, 1024, WSP(bf16_t, WS_WGA), RmId(), scr, r, F.lane); continue; } r -= I_SQ;
        if (r < I_SQ) { p0_transpose_item(F.in[8], 1024, 1024, WSP(bf16_t, WS_WSB), RmId(), scr, r, F.lane); continue; } r -= I_SQ;
        if (r < I_SQ) { p0_transpose_item(F.in[9], 1024, 1024, WSP(bf16_t, WS_WO), RmId(), scr, r, F.lane); continue; } r -= I_SQ;
        if (r < I_SQ) { p0_transpose_item(F.in[17], 1024, 1024, WSP(bf16_t, WS_WPG), RmId(), scr, r, F.lane); continue; } r -= I_SQ;
        if (r < I_PQ) { p0_transpose_item(F.in[11], 1024, 2048, WSP(bf16_t, WS_WPQ), RmId(), scr, r, F.lane); continue; } r -= I_PQ;
        p0_transpose_item(F.in[18], 256, 1024, WSP(bf16_t, WS_WPLE), RmId(), scr, r, F.lane);
    }
    { const float* k1 = F.in[12]; const float* k2 = F.in[13]; bf16_t* KB = WSP(bf16_t, WS_KD);
      for (int i = F.vcu * 512 + F.tid; i < 2 * 8 * 128 * 16; i += F.G * 512) { const int half = i >> 14, rem = i & 16383, h = rem >> 11, r8 = rem & 2047;
          const float* s = (half ? k2 : k1) + (size_t)h * 16384 + (size_t)r8 * 8; const f32x4 a = *(const f32x4*)s, b = *(const f32x4*)(s + 4);
          u32x4 o; o.x = cvtpk(a[0], a[1]); o.y = cvtpk(a[2], a[3]); o.z = cvtpk(b[0], b[1]); o.w = cvtpk(b[2], b[3]);
          *(u32x4*)(KB + (size_t)(h * 2 + half) * 16384 + (size_t)r8 * 8) = o; } }
    for (int m = gw; m < T_TOK; m += NGW) rms_row_to_bf16(F.in[0] + (size_t)m * 1024, F.in[2], WSP(bf16_t, WS_XN1) + (size_t)m * 1024, F.lane);
}

__device__ __forceinline__ void phase_gla_prep(Frame& F) {
    LAS float* alo = (LAS float*)(F.lds + RING_OFF);
    const bf16_t* XN1 = WSP(bf16_t, WS_XN1); const bf16_t* WGAT = WSP(bf16_t, WS_WIN) + (size_t)8192 * 1024;
    bf16_t* GK = WSP(bf16_t, WS_GK); bf16_t* GV = WSP(bf16_t, WS_GV); float* GLAG = WSP(float, WS_GLAG);
    const float* w_up = F.in[4]; const float* b_a = F.in[5];
    const int tid = F.tid, lane = F.lane, w = F.wave;
    for (int u = F.vcu; u < 256; u += F.G) {
        const size_t r0 = (size_t)u * 64;
        __syncthreads();
        if (w < 4) {
            f32x4 acc = (f32x4){0.f, 0.f, 0.f, 0.f};
            const bf16_t* ap = XN1 + (r0 + 16 * w + (lane & 15)) * 1024 + 8 * (lane >> 4);
            const bf16_t* bp = WGAT + (size_t)(lane & 15) * 1024 + 8 * (lane >> 4);
#pragma unroll 8
            for (int s = 0; s < 32; ++s) { const bf16x8 a = *(const bf16x8*)(ap + 32 * s), b = *(const bf16x8*)(bp + 32 * s); acc = __builtin_amdgcn_mfma_f32_16x16x32_bf16(a, b, acc, 0, 0, 0); }
#pragma unroll
            for (int r = 0; r < 4; ++r) alo[(16 * w + 4 * (lane >> 4) + r) * 16 + (lane & 15)] = acc[r];
        }
        const int kk = tid;
        float kv[64];
#pragma unroll
        for (int i = 0; i < 64; ++i) kv[i] = bf1(GK[(r0 + i) * 512 + kk]);
        float wv[16];
#pragma unroll
        for (int r = 0; r < 16; ++r) wv[r] = w_up[r * 512 + kk];
        const float bias = b_a[kk];
        __syncthreads();
        float suffix = 0.f;
        bf16_t* kdt = GK + r0 * 512 + (size_t)kk * 64;
#pragma unroll
        for (int i8 = 7; i8 >= 0; --i8) {
            float o[8];
#pragma unroll
            for (int j = 7; j >= 0; --j) { const int i = i8 * 8 + j;
                const f32x4 a0 = *(const LAS f32x4*)(alo + i * 16), a1 = *(const LAS f32x4*)(alo + i * 16 + 4), a2 = *(const LAS f32x4*)(alo + i * 16 + 8), a3 = *(const LAS f32x4*)(alo + i * 16 + 12);
                float x = bias;
                x += a0[0] * wv[0] + a0[1] * wv[1] + a0[2] * wv[2] + a0[3] * wv[3];
                x += a1[0] * wv[4] + a1[1] * wv[5] + a1[2] * wv[6] + a1[3] * wv[7];
                x += a2[0] * wv[8] + a2[1] * wv[9] + a2[2] * wv[10] + a2[3] * wv[11];
                x += a3[0] * wv[12] + a3[1] * wv[13] + a3[2] * wv[14] + a3[3] * wv[15];
                const float la = (fminf(x, 0.f) - log1pf(__expf(-fabsf(x)))) * (1.0f / 16.0f);
                o[j] = kv[i] * __expf(suffix);
                suffix += la; }
            u32x4 pk; pk.x = cvtpk(o[0], o[1]); pk.y = cvtpk(o[2], o[3]); pk.z = cvtpk(o[4], o[5]); pk.w = cvtpk(o[6], o[7]);
            if (!F.dry) *(u32x4*)(kdt + i8 * 8) = pk; }
        GLAG[(size_t)u * 512 + kk] = __expf(suffix);
        unsigned vv[64];
#pragma unroll
        for (int i = 0; i < 64; ++i) vv[i] = *(const unsigned*)(GV + (r0 + i) * 1024 + 2 * tid);
        __syncthreads();
        bf16_t* vt0 = GV + r0 * 1024 + (size_t)(2 * tid) * 64;
#pragma unroll
        for (int i8 = 0; i8 < 8; ++i8) { u32x4 lo, hi;
            lo.x = (vv[i8 * 8 + 0] & 0xffffu) | (vv[i8 * 8 + 1] << 16); hi.x = (vv[i8 * 8 + 0] >> 16) | (vv[i8 * 8 + 1] & 0xffff0000u);
            lo.y = (vv[i8 * 8 + 2] & 0xffffu) | (vv[i8 * 8 + 3] << 16); hi.y = (vv[i8 * 8 + 2] >> 16) | (vv[i8 * 8 + 3] & 0xffff0000u);
            lo.z = (vv[i8 * 8 + 4] & 0xffffu) | (vv[i8 * 8 + 5] << 16); hi.z = (vv[i8 * 8 + 4] >> 16) | (vv[i8 * 8 + 5] & 0xffff0000u);
            lo.w = (vv[i8 * 8 + 6] & 0xffffu) | (vv[i8 * 8 + 7] << 16); hi.w = (vv[i8 * 8 + 6] >> 16) | (vv[i8 * 8 + 7] & 0xffff0000u);
            if (!F.dry) { *(u32x4*)(vt0 + i8 * 8) = lo; *(u32x4*)(vt0 + 64 + i8 * 8) = hi; } }
    }
}

constexpr int GL_KD = 0, GL_Q = 32768, GL_G = 65536, GL_RED = 65536 + 1024;
__device__ __forceinline__ int gl_kd_off(int row, int chunk) { return row * 128 + ((chunk ^ ((row >> 1) & 7)) << 4); }
__device__ __forceinline__ int gl_q_off(int row, int chunk16) { return row * 256 + ((chunk16 ^ (row & 15)) << 4); }

struct GlaStage { u32x4 kd[2]; u32x4 q[2]; bf16x8 vt[4]; float g; };
__device__ __forceinline__ void gla_prefetch_vt(Frame& F, GlaStage& st, int b, int h, int c) {
    const int u = b * 64 + c; const size_t r0 = (size_t)u * 64; const int w = F.wave, lq = F.lane & 31, hh = F.lane >> 5;
    const bf16_t* vt = WSP(bf16_t, WS_GV) + r0 * 1024 + (size_t)(h * 256 + 32 * w + lq) * 64;
#pragma unroll
    for (int ts = 0; ts < 4; ++ts) st.vt[ts] = *(const bf16x8*)(vt + 16 * ts + 8 * hh);
}
template <bool WITH_Q>
__device__ __forceinline__ void gla_prefetch(Frame& F, GlaStage& st, int b, int h, int c) {
    const int u = b * 64 + c; const size_t r0 = (size_t)u * 64; const int tid = F.tid;
    const bf16_t* kd = WSP(bf16_t, WS_GK) + r0 * 512 + (size_t)h * 8192;
#pragma unroll
    for (int j = 0; j < 2; ++j) { const int pi = tid + 512 * j; st.kd[j] = *(const u32x4*)(kd + (pi >> 3) * 64 + (pi & 7) * 8); }
    if (WITH_Q) { const bf16_t* gq = WSP(bf16_t, WS_GQ) + r0 * 512 + h * 128;
#pragma unroll
        for (int j = 0; j < 2; ++j) { const int pi = tid + 512 * j; st.q[j] = *(const u32x4*)(gq + (size_t)(pi >> 4) * 512 + (pi & 15) * 8); } }
    st.g = (tid < 128) ? WSP(float, WS_GLAG)[((size_t)u * 4 + h) * 128 + tid] : 1.f;
}
template <bool WITH_Q>
__device__ __forceinline__ void gla_stage_write(Frame& F, const GlaStage& st, int buf) {
    LAS unsigned char* lds = F.lds + RING_OFF; const int tid = F.tid;
#pragma unroll
    for (int j = 0; j < 2; ++j) { const int pi = tid + 512 * j; *(LAS u32x4*)(lds + GL_KD + buf * 16384 + gl_kd_off(pi >> 3, pi & 7)) = st.kd[j]; }
    if (WITH_Q) {
#pragma unroll
        for (int j = 0; j < 2; ++j) { const int pi = tid + 512 * j; *(LAS u32x4*)(lds + GL_Q + buf * 16384 + gl_q_off(pi >> 4, pi & 15)) = st.q[j]; } }
    if (tid < 128) *(LAS float*)(lds + GL_G + buf * 512 + tid * 4) = st.g;
}
__device__ __forceinline__ void gla_update(Frame& F, f32x16 (&S)[4], const bf16x8 (&vt)[4], int buf) {
    const LAS unsigned char* lds = F.lds + RING_OFF; const int lq = F.lane & 31, hh = F.lane >> 5;
    const LAS float* G = (const LAS float*)(lds + GL_G + buf * 512);
#pragma unroll
    for (int kt = 0; kt < 4; ++kt)
#pragma unroll
        for (int g4 = 0; g4 < 4; ++g4) { const f32x4 g = *(const LAS f32x4*)(G + 32 * kt + 8 * g4 + 4 * hh);
#pragma unroll
            for (int j = 0; j < 4; ++j) S[kt][4 * g4 + j] *= g[j]; }
#pragma unroll
    for (int ts = 0; ts < 4; ++ts)
#pragma unroll
        for (int kt = 0; kt < 4; ++kt) { const bf16x8 a = *(const LAS bf16x8*)(lds + GL_KD + buf * 16384 + gl_kd_off(32 * kt + lq, 2 * ts + hh));
            S[kt] = __builtin_amdgcn_mfma_f32_32x32x16_bf16(a, vt[ts], S[kt], 0, 0, 0); if (kt == 3 && (ts & 1)) __builtin_amdgcn_sched_barrier(0); }
}
constexpr size_t SEND_WAVE_FLOATS = 4 * 4 * 64 * 4;
__device__ __forceinline__ void gla_stage1(Frame& F, int unit) {
    const int bh = unit >> 3, seg = unit & 7, b = bh >> 2, h = bh & 3, w = F.wave, l = F.lane;
    f32x16 S[4];
#pragma unroll
    for (int kt = 0; kt < 4; ++kt)
#pragma unroll
        for (int r = 0; r < 16; ++r) S[kt][r] = 0.f;
    float pend = 1.f;
    GlaStage st; gla_prefetch<false>(F, st, b, h, seg * 8); gla_prefetch_vt(F, st, b, h, seg * 8);
    for (int ci = 0; ci < 8; ++ci) {
        gla_stage_write<false>(F, st, ci & 1); pend *= st.g;
        __syncthreads();
        if (ci < 7) gla_prefetch<false>(F, st, b, h, seg * 8 + ci + 1);
        gla_update(F, S, st.vt, ci & 1);
        if (ci < 7) gla_prefetch_vt(F, st, b, h, seg * 8 + ci + 1);
    }
    float* se = WSP(float, WS_SEND) + ((size_t)unit * 8 + w) * SEND_WAVE_FLOATS;
#pragma unroll
    for (int kt = 0; kt < 4; ++kt)
#pragma unroll
        for (int g4 = 0; g4 < 4; ++g4) *(f32x4*)(se + ((kt * 4 + g4) * 64 + l) * 4) = (f32x4){S[kt][4 * g4], S[kt][4 * g4 + 1], S[kt][4 * g4 + 2], S[kt][4 * g4 + 3]};
    if (F.tid < 128) WSP(float, WS_PEND)[unit * 128 + F.tid] = pend;
    __syncthreads();
}
__device__ __forceinline__ void gla_stage3(Frame& F, int unit) {
    const int bh = unit >> 3, seg = unit & 7, b = bh >> 2, h = bh & 3, w = F.wave, l = F.lane, lq = l & 31, hh = l >> 5;
    LAS unsigned char* lds = F.lds + RING_OFF;
    const bf16_t* GR = WSP(bf16_t, WS_GR); bf16_t* GLAN = WSP(bf16_t, WS_GLAN); const float* g_o = F.in[6];
    f32x16 S[4];
#pragma unroll
    for (int kt = 0; kt < 4; ++kt)
#pragma unroll
        for (int r = 0; r < 16; ++r) S[kt][r] = 0.f;
    GlaStage st; gla_prefetch<true>(F, st, b, h, seg * 8); gla_prefetch_vt(F, st, b, h, seg * 8);
    for (int sp = 0; sp < seg; ++sp) {
        const int un = bh * 8 + sp; const float* se = WSP(float, WS_SEND) + ((size_t)un * 8 + w) * SEND_WAVE_FLOATS; const float* pe = WSP(float, WS_PEND) + un * 128;
#pragma unroll
        for (int kt = 0; kt < 4; ++kt)
#pragma unroll
            for (int g4 = 0; g4 < 4; ++g4) { const f32x4 p = *(const f32x4*)(pe + 32 * kt + 8 * g4 + 4 * hh); const f32x4 s = *(const f32x4*)(se + ((kt * 4 + g4) * 64 + l) * 4);
#pragma unroll
                for (int j = 0; j < 4; ++j) S[kt][4 * g4 + j] = S[kt][4 * g4 + j] * p[j] + s[j]; }
    }
    for (int ci = 0; ci < 8; ++ci) {
        const int c = seg * 8 + ci; const size_t r0 = (size_t)(b * 64 + c) * 64; const int buf = ci & 1;
        gla_stage_write<true>(F, st, buf);
        __syncthreads();
        if (ci < 7) gla_prefetch<true>(F, st, b, h, c + 1);
        gla_update(F, S, st.vt, buf);
        f32x16 oT[2];
#pragma unroll
        for (int tt = 0; tt < 2; ++tt) {
#pragma unroll
            for (int r = 0; r < 16; ++r) oT[tt][r] = 0.f;
            const int t = 32 * tt + lq;
#pragma unroll
            for (int kt = 0; kt < 4; ++kt)
#pragma unroll
                for (int s = 0; s < 2; ++s) {
                    u32x4 aw; aw.x = cvtpk(S[kt][8 * s + 0], S[kt][8 * s + 1]); aw.y = cvtpk(S[kt][8 * s + 2], S[kt][8 * s + 3]); aw.z = cvtpk(S[kt][8 * s + 4], S[kt][8 * s + 5]); aw.w = cvtpk(S[kt][8 * s + 6], S[kt][8 * s + 7]);
                    const u32x2 qlo = *(const LAS u32x2*)(lds + GL_Q + buf * 16384 + gl_q_off(t, 4 * kt + 2 * s) + 8 * hh), qhi = *(const LAS u32x2*)(lds + GL_Q + buf * 16384 + gl_q_off(t, 4 * kt + 2 * s + 1) + 8 * hh);
                    const u32x4 bw = (u32x4){qlo.x, qlo.y, qhi.x, qhi.y};
                    oT[tt] = __builtin_amdgcn_mfma_f32_32x32x16_bf16(__builtin_bit_cast(bf16x8, aw), __builtin_bit_cast(bf16x8, bw), oT[tt], 0, 0, 0);
                    if (s == 1 && (kt & 1)) __builtin_amdgcn_sched_barrier(0); }
        }
        LAS float* redc = (LAS float*)(lds + GL_RED) + buf * 512;
#pragma unroll
        for (int tt = 0; tt < 2; ++tt) { float s = 0.f;
#pragma unroll
            for (int r = 0; r < 16; ++r) s += oT[tt][r] * oT[tt][r];
            s += __shfl_xor(s, 32);
            if (hh == 0) redc[w * 64 + 32 * tt + lq] = s; }
        if (ci < 7) gla_prefetch_vt(F, st, b, h, c + 1);
        u32x2 sr[2][4];
#pragma unroll
        for (int tt = 0; tt < 2; ++tt)
#pragma unroll
            for (int g4 = 0; g4 < 4; ++g4) sr[tt][g4] = *(const u32x2*)(GR + (r0 + 32 * tt + lq) * 1024 + h * 256 + 32 * w + 8 * g4 + 4 * hh);
        __syncthreads();
#pragma unroll
        for (int tt = 0; tt < 2; ++tt) { float tot = 0.f;
#pragma unroll
            for (int ww = 0; ww < 8; ++ww) tot += redc[ww * 64 + 32 * tt + lq];
            const float rstd = __builtin_amdgcn_rsqf(tot * (1.0f / 256.0f) + EPS);
            const size_t row = r0 + 32 * tt + lq;
#pragma unroll
            for (int g4 = 0; g4 < 4; ++g4) { const int v0 = h * 256 + 32 * w + 8 * g4 + 4 * hh;
                const f32x4 go = *(const f32x4*)(g_o + v0);
                const float o0 = oT[tt][4 * g4 + 0] * rstd * go[0] * bf_lo(sr[tt][g4].x), o1 = oT[tt][4 * g4 + 1] * rstd * go[1] * bf_hi(sr[tt][g4].x);
                const float o2 = oT[tt][4 * g4 + 2] * rstd * go[2] * bf_lo(sr[tt][g4].y), o3 = oT[tt][4 * g4 + 3] * rstd * go[3] * bf_hi(sr[tt][g4].y);
                u32x2 wv; wv.x = cvtpk(o0, o1); wv.y = cvtpk(o2, o3); *(u32x2*)(GLAN + row * 1024 + v0) = wv; } }
    }
    __syncthreads();
}

constexpr int SB_TILE = 16384, SB_FLAG = 7 * SB_TILE;
typedef short v4i16_t __attribute__((ext_vector_type(4)));
__device__ __forceinline__ s16x4 vtr(const LAS unsigned char* p) { return __builtin_bit_cast(s16x4, __builtin_amdgcn_ds_read_tr16_b64_v4i16((LAS v4i16_t*)p)); }
__device__ __forceinline__ float partner32(float x, int hh) { auto rr = __builtin_amdgcn_permlane32_swap(__float_as_uint(x), __float_as_uint(x), false, false); return __uint_as_float(hh ? rr[0] : rr[1]); }
__device__ __forceinline__ int sbk_off(int key, int chunk) { return key * 128 + ((chunk ^ ((key >> 1) & 7)) << 4); }
__device__ __forceinline__ int sbv_off(int key, int chunk) { return 8192 + key * 128 + ((chunk ^ (((key >> 1) & 1) << 2)) << 4); }

template <bool DIAG>
__device__ __forceinline__ void sb_tile_t(const LAS unsigned char* tile, int kt, int qabs, int l, const bf16x8 (&qf)[4], f32x16& o0, f32x16& o1, float& carry) {
    const int lq = l & 31, hh = l >> 5, g1 = (l >> 4) & 1, i = l & 15;
    float run = carry;
#pragma unroll
    for (int half = 1; half >= 0; --half) {
        f32x16 p;
#pragma unroll
        for (int r = 0; r < 16; ++r) p[r] = 0.f;
#pragma unroll
        for (int s = 0; s < 4; ++s) { const bf16x8 a = *(const LAS bf16x8*)(tile + sbk_off(32 * half + lq, 2 * s + hh)); p = __builtin_amdgcn_mfma_f32_32x32x16_bf16(a, qf[s], p, 0, 0, 0); }
        float Lh[16];
#pragma unroll
        for (int r = 0; r < 16; ++r) { const float z = p[r];
            float L = fmaxf(z, 0.f) + __builtin_amdgcn_logf(1.0f + __builtin_amdgcn_exp2f(-fabsf(z)));
            if (DIAG) { const int key = 64 * kt + 32 * half + (r & 3) + 8 * (r >> 2) + 4 * hh; if (key >= qabs) L = 0.f; }
            Lh[r] = L; }
        float tot[4];
#pragma unroll
        for (int g4 = 0; g4 < 4; ++g4) { float* Lg = &Lh[4 * g4]; Lg[2] += Lg[3]; Lg[1] += Lg[2]; Lg[0] += Lg[1]; tot[g4] = Lg[0]; }
        float E[4];
#pragma unroll
        for (int m = 3; m >= 0; --m) { const float tp = partner32(tot[m], hh); E[m] = run + (hh ? 0.f : tp); run += tot[m] + tp; }
        u32x4 pw[2];
#pragma unroll
        for (int s = 0; s < 2; ++s) { float wv[8];
#pragma unroll
            for (int j = 0; j < 8; ++j) { const int r = 8 * s + j;
                float wgt = __builtin_amdgcn_exp2f(p[r] - (E[r >> 2] + Lh[r]));
                if (DIAG) { const int key = 64 * kt + 32 * half + (r & 3) + 8 * (r >> 2) + 4 * hh; if (key >= qabs) wgt = 0.f; }
                wv[j] = wgt; }
            pw[s] = (u32x4){cvtpk(wv[0], wv[1]), cvtpk(wv[2], wv[3]), cvtpk(wv[4], wv[5]), cvtpk(wv[6], wv[7])}; }
#pragma unroll
        for (int s = 0; s < 2; ++s) { const bf16x8 pb = __builtin_bit_cast(bf16x8, pw[s]);
            const int k0 = 32 * half + 16 * s + 4 * hh + (i >> 2), k1 = k0 + 8;
#pragma unroll
            for (int dt = 0; dt < 2; ++dt) { const int ch = 4 * dt + 2 * g1 + ((i & 3) >> 1);
                const s16x4 lo = vtr(tile + sbv_off(k0, ch) + 8 * (i & 1)), hi = vtr(tile + sbv_off(k1, ch) + 8 * (i & 1));
                const bf16x8 a = (bf16x8){lo[0], lo[1], lo[2], lo[3], hi[0], hi[1], hi[2], hi[3]};
                if (dt == 0) o0 = __builtin_amdgcn_mfma_f32_32x32x16_bf16(a, pb, o0, 0, 0, 0); else o1 = __builtin_amdgcn_mfma_f32_32x32x16_bf16(a, pb, o1, 0, 0, 0); } }
    }
    carry = run;
}
__device__ __forceinline__ void sb_tile(const LAS unsigned char* tile, int kt, int q0, int qabs, int l, const bf16x8 (&qf)[4], f32x16& o0, f32x16& o1, float& carry) {
    if (64 * kt + 63 >= q0) sb_tile_t<true>(tile, kt, qabs, l, qf, o0, o1, carry); else sb_tile_t<false>(tile, kt, qabs, l, qf, o0, o1, carry);
}
__device__ __forceinline__ void sb_attn_unit(Frame& F, int uidx) {
    const int bh = uidx >> 4, qb = uidx & 15, b = bh >> 4, h = bh & 15;
    LAS unsigned char* lds = F.lds + RING_OFF;
    volatile LAS unsigned* flags = (volatile LAS unsigned*)(lds + SB_FLAG);
    const int tid = F.tid, w = F.wave, l = F.lane, lq = l & 31, hh = l >> 5;
    bf16_t* SQ = WSP(bf16_t, WS_SQ); const bf16_t* SK = WSP(bf16_t, WS_SK); const bf16_t* SV = WSP(bf16_t, WS_SV);
    const size_t rowbase = (size_t)b * SEQ;
    const int q0 = qb * 256 + 32 * w, qabs = q0 + lq;
    const int kt_hi = qb * 4 + 3, kt_lo = (qb * 4 - 3) > 0 ? (qb * 4 - 3) : 0, nwin = kt_hi - kt_lo + 1;
    const int skey = tid >> 3, sch = tid & 7;
    const bf16_t* kgd = SK + (rowbase + skey) * 1024 + h * 64 + ((sch ^ ((skey >> 1) & 7)) * 8);
    const bf16_t* vgd = SV + (rowbase + skey) * 1024 + h * 64 + ((sch ^ (((skey >> 1) & 1) << 2)) * 8);
    __syncthreads();
#pragma unroll
    for (int j = 0; j < 7; ++j) if (j < nwin) {
        __builtin_amdgcn_global_load_lds((const unsigned*)(kgd + (size_t)(kt_lo + j) * 64 * 1024), (LAS unsigned*)(lds + j * SB_TILE + w * 1024), 16, 0, 0);
        __builtin_amdgcn_global_load_lds((const unsigned*)(vgd + (size_t)(kt_lo + j) * 64 * 1024), (LAS unsigned*)(lds + j * SB_TILE + 8192 + w * 1024), 16, 0, 0); }
    bf16x8 qf[4];
    { const bf16_t* qrow = SQ + (rowbase + qabs) * 1024 + h * 64;
#pragma unroll
      for (int s = 0; s < 4; ++s) qf[s] = *(const bf16x8*)(qrow + 16 * s + 8 * hh); }
    f32x16 o0, o1;
#pragma unroll
    for (int r = 0; r < 16; ++r) { o0[r] = 0.f; o1[r] = 0.f; }
    float carry = 0.f;
    VM_WAIT(); __syncthreads();
    bool done = false;
    for (int kt = (q0 + 30) >> 6; kt >= kt_lo; --kt) {
        sb_tile(lds + (kt - kt_lo) * SB_TILE, kt, q0, qabs, l, qf, o0, o1, carry);
        if (__all(carry > 150.0f)) { done = true; break; }
    }
    if (kt_lo == 0) done = true;
    if (l == 0) flags[w] = done ? 1u : 0u;
    __syncthreads();
    bool alld = true;
#pragma unroll
    for (int i = 0; i < 8; ++i) alld = alld && (flags[i] != 0u);
    if (!alld) {
        const bf16_t* kg = SK + (rowbase + skey) * 1024 + h * 64 + sch * 8;
        const bf16_t* vg = SV + (rowbase + skey) * 1024 + h * 64 + sch * 8;
        for (int kt = kt_lo - 1; kt >= 0; --kt) {
            const u32x4 kr = *(const u32x4*)(kg + (size_t)kt * 64 * 1024), vr = *(const u32x4*)(vg + (size_t)kt * 64 * 1024);
            __syncthreads();
            { unsigned a = 1u;
#pragma unroll
              for (int i = 0; i < 8; ++i) a &= flags[i];
              if (a) break; }
            *(LAS u32x4*)(lds + sbk_off(skey, sch)) = kr; *(LAS u32x4*)(lds + sbv_off(skey, sch)) = vr;
            __syncthreads();
            if (!done) { sb_tile(lds, kt, q0, qabs, l, qf, o0, o1, carry); if (__all(carry > 150.0f) || kt == 0) done = true; }
            if (l == 0) flags[w] = done ? 1u : 0u;
        }
    }
    if (!F.dry) { bf16_t* orow = SQ + (rowbase + qabs) * 1024 + h * 64;
#pragma unroll
      for (int g4 = 0; g4 < 4; ++g4) { u32x2 a, c2; a.x = cvtpk(o0[4 * g4], o0[4 * g4 + 1]); a.y = cvtpk(o0[4 * g4 + 2], o0[4 * g4 + 3]); c2.x = cvtpk(o1[4 * g4], o1[4 * g4 + 1]); c2.y = cvtpk(o1[4 * g4 + 2], o1[4 * g4 + 3]);
          *(u32x2*)(orow + 8 * g4 + 4 * hh) = a; *(u32x2*)(orow + 32 + 8 * g4 + 4 * hh) = c2; } }
}
__device__ __forceinline__ void sb_units_dyn(Frame& F, unsigned* ctr, int lo, int hi) {
    volatile LAS int* slot = (volatile LAS int*)(F.lds + MISC_OFF + 64);
    for (;;) {
        __syncthreads();
        if (F.tid == 0) *slot = lo + (int)__hip_atomic_fetch_add(ctr, 1u, __ATOMIC_RELAXED, __HIP_MEMORY_SCOPE_AGENT);
        __syncthreads();
        const int u = *slot;
        if (u >= hi) break;
        sb_attn_unit(F, u);
    }
}
__device__ __forceinline__ void phase_attn_a(Frame& F) {
    if (F.vcu < 128) gla_stage1(F, F.vcu);
    sb_units_dyn(F, (unsigned*)(F.ws + WS_CTL) + 64, 0, 384);
    __syncthreads();
}
__device__ __forceinline__ void phase_attn_b(Frame& F) {
    if (F.vcu < 128) gla_stage3(F, F.vcu);
    sb_units_dyn(F, (unsigned*)(F.ws + WS_CTL) + 128, 384, 1024);
    __syncthreads();
}
__device__ __forceinline__ int okey(float v, int tag, int mask) { int u = __float_as_int(v); u ^= (u >> 31) & 0x7fffffff; return (u & ~mask) | tag; }
__device__ __forceinline__ float okey_val(int key, int mask) { int u = key & ~mask; u ^= (u >> 31) & 0x7fffffff; return __int_as_float(u); }
#define INS16(Lst, xin) do { int _x = (xin); _Pragma("unroll") for (int _j = 0; _j < 16; ++_j) { const int _h = max(Lst[_j], _x); _x = min(Lst[_j], _x); Lst[_j] = _h; } } while (0)

#define CEX(a, b) do { const int _hi = max(a, b), _lo = min(a, b); a = _hi; b = _lo; } while (0)
#define BITONIC16(K) do { \
    _Pragma("unroll") for (int _i = 0; _i < 8; ++_i) CEX(K[_i], K[_i + 8]); \
    _Pragma("unroll") for (int _b = 0; _b < 16; _b += 8) _Pragma("unroll") for (int _i = 0; _i < 4; ++_i) CEX(K[_b + _i], K[_b + _i + 4]); \
    _Pragma("unroll") for (int _b = 0; _b < 16; _b += 4) _Pragma("unroll") for (int _i = 0; _i < 2; ++_i) CEX(K[_b + _i], K[_b + _i + 2]); \
    _Pragma("unroll") for (int _b = 0; _b < 16; _b += 2) CEX(K[_b], K[_b + 1]); } while (0)
__device__ __forceinline__ int swap32i(int x) { auto r = __builtin_amdgcn_permlane32_swap((unsigned)x, (unsigned)x, false, false); return (int)((__builtin_amdgcn_mbcnt_hi(~0u, __builtin_amdgcn_mbcnt_lo(~0u, 0u)) & 32) ? r[0] : r[1]); }

__device__ __forceinline__ void phase_peer_retrieve(Frame& F) {
    const bf16_t* Q = WSP(bf16_t, WS_Q); const bf16_t* KB = WSP(bf16_t, WS_KD); unsigned* EXPO = WSP(unsigned, WS_EXP);
    LAS unsigned char* idxb = F.lds + RING_OFF + F.wave * 2048;
    const int l = F.lane, lq = l & 31, hh = l >> 5;
    const int ntok_wg = T_TOK / F.G;
#pragma unroll 1
    for (int it = F.wave; it < (ntok_wg / 32) * 8; it += NWAVES) {
        const int tg = it >> 3, h = it & 7;
        const int t = F.vcu * ntok_wg + tg * 32 + lq;
        int XY[2][16];
#pragma unroll
        for (int half = 0; half < 2; ++half) {
            bf16x8 qf[8];
            { const bf16_t* qp = Q + (size_t)t * 2048 + h * 256 + half * 128 + 8 * hh;
#pragma unroll
              for (int s = 0; s < 8; ++s) qf[s] = *(const bf16x8*)(qp + 16 * s); }
            int L[16];
#pragma unroll
            for (int j = 0; j < 16; ++j) L[j] = INT_MIN;
            const bf16_t* kp = KB + (size_t)(h * 2 + half) * 16384 + (size_t)lq * 128 + 8 * hh;
#pragma unroll 1
            for (int tile = 0; tile < 4; ++tile) {
                f32x16 acc;
#pragma unroll
                for (int r = 0; r < 16; ++r) acc[r] = 0.f;
#pragma unroll
                for (int s = 0; s < 8; ++s) { const bf16x8 a = *(const bf16x8*)(kp + (size_t)tile * 32 * 128 + 16 * s); acc = __builtin_amdgcn_mfma_f32_32x32x16_bf16(a, qf[s], acc, 0, 0, 0); }
#pragma unroll
                for (int r = 0; r < 16; ++r) { const int key = 32 * tile + (r & 3) + 8 * (r >> 2) + 4 * hh; INS16(L, okey(acc[r], 127 - key, 127)); }
            }
#pragma unroll
            for (int k = 0; k < 8; ++k) { const int a = swap32i(L[15 - k]), b = swap32i(L[k]); L[k] = max(L[k], a); L[15 - k] = max(L[15 - k], b); }
            BITONIC16(L);
#pragma unroll
            for (int j = 0; j < 16; ++j) XY[half][j] = L[j];
        }
        { u32x4 pk[2];
#pragma unroll
          for (int half = 0; half < 2; ++half) { const int* L = XY[half];
            pk[half].x = (unsigned)(127 - (L[0] & 127)) | ((unsigned)(127 - (L[1] & 127)) << 8) | ((unsigned)(127 - (L[2] & 127)) << 16) | ((unsigned)(127 - (L[3] & 127)) << 24);
            pk[half].y = (unsigned)(127 - (L[4] & 127)) | ((unsigned)(127 - (L[5] & 127)) << 8) | ((unsigned)(127 - (L[6] & 127)) << 16) | ((unsigned)(127 - (L[7] & 127)) << 24);
            pk[half].z = (unsigned)(127 - (L[8] & 127)) | ((unsigned)(127 - (L[9] & 127)) << 8) | ((unsigned)(127 - (L[10] & 127)) << 16) | ((unsigned)(127 - (L[11] & 127)) << 24);
            pk[half].w = (unsigned)(127 - (L[12] & 127)) | ((unsigned)(127 - (L[13] & 127)) << 8) | ((unsigned)(127 - (L[14] & 127)) << 16) | ((unsigned)(127 - (L[15] & 127)) << 24); }
          *(LAS u32x4*)(idxb + l * 32) = pk[0]; *(LAS u32x4*)(idxb + l * 32 + 16) = pk[1]; }
        float X[16], Y[16];
#pragma unroll
        for (int j = 0; j < 16; ++j) { X[j] = okey_val(XY[0][j], 127); Y[j] = okey_val(XY[1][j], 127); }
        int M[16];
#pragma unroll
        for (int j = 0; j < 16; ++j) M[j] = INT_MIN;
#define CAND(i, j) do { const float sm = hh ? (X[j] + Y[i]) : (X[i] + Y[j]); const int pos = hh ? ((j) * 16 + (i)) : ((i) * 16 + (j)); int key = okey(sm, 255 - pos, 255); if ((i) == (j) && hh) key = INT_MIN; INS16(M, key); } while (0)
        CAND(0, 0); CAND(0, 1); CAND(0, 2); CAND(0, 3); CAND(0, 4); CAND(0, 5); CAND(0, 6); CAND(0, 7); CAND(0, 8); CAND(0, 9); CAND(0, 10); CAND(0, 11); CAND(0, 12); CAND(0, 13); CAND(0, 14); CAND(0, 15);
        CAND(1, 1); CAND(1, 2); CAND(1, 3); CAND(1, 4); CAND(1, 5); CAND(1, 6); CAND(1, 7);
        CAND(2, 2); CAND(2, 3); CAND(2, 4);
        CAND(3, 3);
#undef CAND
        int TK[16];
#pragma unroll
        for (int k = 0; k < 16; ++k) TK[k] = max(M[k], swap32i(M[15 - k]));
        float sv[16]; float mx = -INFINITY;
#pragma unroll
        for (int k = 0; k < 16; ++k) { sv[k] = okey_val(TK[k], 255); mx = fmaxf(mx, sv[k]); }
        float den = 0.f;
#pragma unroll
        for (int k = 0; k < 16; ++k) { sv[k] = __expf(sv[k] - mx); den += sv[k]; }
        const float rden = 1.0f / den;
        LDS_WAIT(); asm volatile("" ::: "memory");
        const LAS unsigned char* ib = idxb + l * 32;
        unsigned* dst = EXPO + (size_t)t * 128 + h * 16 + hh * 8;
        u32x4 o0, o1; unsigned ov[8];
#pragma unroll
        for (int k = 0; k < 8; ++k) { const int pos = 255 - (TK[k] & 255); const unsigned i1 = ib[pos >> 4], i2 = ib[16 + (pos & 15)];
            ov[k] = (__float_as_uint(sv[k] * rden) & ~0x3fffu) | (i1 * 128u + i2); }
        o0 = (u32x4){ov[0], ov[1], ov[2], ov[3]}; o1 = (u32x4){ov[4], ov[5], ov[6], ov[7]};
        *(u32x4*)dst = o0; *(u32x4*)(dst + 4) = o1;
        LDS_WAIT(); asm volatile("" ::: "memory");
    }
}

__device__ __forceinline__ void cvt_rows_fp8(Frame& F, const float* src, unsigned char* dst, float* rscale) {
    const int l = F.lane; const int gw = F.vcu * NWAVES + F.wave, NGW = F.G * NWAVES;
    for (int e = gw; e < 16384; e += NGW) {
        const f32x4* sp = (const f32x4*)(src + (size_t)e * 1024 + 16 * l);
        const f32x4 a = sp[0], b = sp[1], c = sp[2], d = sp[3];
        float m = fmaxf(fmaxf(fmaxf(fabsf(a[0]), fabsf(a[1])), fmaxf(fabsf(a[2]), fabsf(a[3]))), fmaxf(fmaxf(fabsf(b[0]), fabsf(b[1])), fmaxf(fabsf(b[2]), fabsf(b[3]))));
        m = fmaxf(m, fmaxf(fmaxf(fmaxf(fabsf(c[0]), fabsf(c[1])), fmaxf(fabsf(c[2]), fabsf(c[3]))), fmaxf(fmaxf(fabsf(d[0]), fabsf(d[1])), fmaxf(fabsf(d[2]), fabsf(d[3])))));
#pragma unroll
        for (int o = 1; o < 64; o <<= 1) m = fmaxf(m, __shfl_xor(m, o));
        const float t = 448.0f / fmaxf(m, 1e-30f); const float s = __uint_as_float(__float_as_uint(t) & 0x7f800000u);
        u32x4 w; int x;
        x = __builtin_amdgcn_cvt_pk_fp8_f32(a[0] * s, a[1] * s, 0, false); x = __builtin_amdgcn_cvt_pk_fp8_f32(a[2] * s, a[3] * s, x, true); w.x = (unsigned)x;
        x = __builtin_amdgcn_cvt_pk_fp8_f32(b[0] * s, b[1] * s, 0, false); x = __builtin_amdgcn_cvt_pk_fp8_f32(b[2] * s, b[3] * s, x, true); w.y = (unsigned)x;
        x = __builtin_amdgcn_cvt_pk_fp8_f32(c[0] * s, c[1] * s, 0, false); x = __builtin_amdgcn_cvt_pk_fp8_f32(c[2] * s, c[3] * s, x, true); w.z = (unsigned)x;
        x = __builtin_amdgcn_cvt_pk_fp8_f32(d[0] * s, d[1] * s, 0, false); x = __builtin_amdgcn_cvt_pk_fp8_f32(d[2] * s, d[3] * s, x, true); w.w = (unsigned)x;
        *(u32x4*)(dst + (size_t)e * 1024 + 16 * l) = w;
        if (l == 0) rscale[e] = 1.0f / s;
    }
}

__device__ __forceinline__ float gelu_tanh(float x) { const float y = 0.7978845608028654f * (x + 0.044715f * x * x * x); return x * __builtin_amdgcn_rcpf(1.0f + __expf(-2.0f * y)); }
#define FP8_UNPACK16(W, f) do { f32x2 _t; \
    _t = __builtin_amdgcn_cvt_pk_f32_fp8((int)(W).x, false); f[0] = _t[0]; f[1] = _t[1]; _t = __builtin_amdgcn_cvt_pk_f32_fp8((int)(W).x, true); f[2] = _t[0]; f[3] = _t[1]; \
    _t = __builtin_amdgcn_cvt_pk_f32_fp8((int)(W).y, false); f[4] = _t[0]; f[5] = _t[1]; _t = __builtin_amdgcn_cvt_pk_f32_fp8((int)(W).y, true); f[6] = _t[0]; f[7] = _t[1]; \
    _t = __builtin_amdgcn_cvt_pk_f32_fp8((int)(W).z, false); f[8] = _t[0]; f[9] = _t[1]; _t = __builtin_amdgcn_cvt_pk_f32_fp8((int)(W).z, true); f[10] = _t[0]; f[11] = _t[1]; \
    _t = __builtin_amdgcn_cvt_pk_f32_fp8((int)(W).w, false); f[12] = _t[0]; f[13] = _t[1]; _t = __builtin_amdgcn_cvt_pk_f32_fp8((int)(W).w, true); f[14] = _t[0]; f[15] = _t[1]; } while (0)
__device__ __forceinline__ float sum_swap32(float a, float b) { auto r = __builtin_amdgcn_permlane32_swap(__float_as_uint(a), __float_as_uint(b), false, false); return __uint_as_float(r[0]) + __uint_as_float(r[1]); }
__device__ __forceinline__ float sum_swap16(float a, float b) { auto r = __builtin_amdgcn_permlane16_swap(__float_as_uint(a), __float_as_uint(b), false, false); return __uint_as_float(r[0]) + __uint_as_float(r[1]); }
#ifndef PG_TOK
#define PG_TOK 2
#endif
__device__ __forceinline__ void phase_peer_gather(Frame& F) {
    const unsigned char* UB = WSP(unsigned char, WS_UB8); const unsigned char* VB = WSP(unsigned char, WS_VB8); const float* RSU = WSP(float, WS_RSU); const float* RSV = WSP(float, WS_RSV);
    const unsigned* EXPO = WSP(unsigned, WS_EXP);
    const bf16_t* H1G = WSP(bf16_t, WS_H1G); bf16_t* XN3 = WSP(bf16_t, WS_XN3); const float* H1 = WSP(float, WS_H1); float* H2 = F.out; const float* SSQ1 = WSP(float, WS_SSQ1); const float* g_ple = F.in[16];
    const int l = F.lane; const int ntok_wg = T_TOK / F.G;
#pragma unroll 1
    for (int ti = F.wave * PG_TOK; ti < ntok_wg; ti += NWAVES * PG_TOK) {
        __syncthreads();
        unsigned x[PG_TOK][8]; float acc[PG_TOK][16]; unsigned e0[PG_TOK], e1[PG_TOK]; float cu0[PG_TOK], cu1[PG_TOK], cv0[PG_TOK], cv1[PG_TOK];
#pragma unroll
        for (int tk = 0; tk < PG_TOK; ++tk) { const int t = F.vcu * ntok_wg + ti + tk;
            const u32x4 xa = *(const u32x4*)(H1G + (size_t)t * 1024 + 16 * l), xb = *(const u32x4*)(H1G + (size_t)t * 1024 + 16 * l + 8);
            x[tk][0] = xa.x; x[tk][1] = xa.y; x[tk][2] = xa.z; x[tk][3] = xa.w; x[tk][4] = xb.x; x[tk][5] = xb.y; x[tk][6] = xb.z; x[tk][7] = xb.w;
            const f32x4* sp = (const f32x4*)(SSQ1 + (size_t)t * 16); const f32x4 st = (sp[0] + sp[1]) + (sp[2] + sp[3]); const float rstd1 = __builtin_amdgcn_rsqf(((st[0] + st[1]) + (st[2] + st[3])) * (1.0f / 1024.0f) + EPS);
            unsigned a0 = EXPO[(size_t)t * 128 + l], a1 = EXPO[(size_t)t * 128 + 64 + l];
            { unsigned s0 = (a0 << 18) | (a0 >> 14), s1 = (a1 << 18) | (a1 >> 14);
#pragma unroll
              for (int k = 2; k <= 128; k <<= 1) {
#pragma unroll
                  for (int j = k >> 1; j >= 1; j >>= 1) {
                      if (j == 64) { const unsigned lo = min(s0, s1), hi = max(s0, s1); s0 = lo; s1 = hi; }
                      else { const bool up = (l & j) != 0;
                          const unsigned p0 = __shfl_xor(s0, j), p1 = __shfl_xor(s1, j);
                          const bool asc0 = (l & k) == 0, asc1 = ((l + 64) & k) == 0;
                          s0 = (up == asc0) ? max(s0, p0) : min(s0, p0);
                          s1 = (up == asc1) ? max(s1, p1) : min(s1, p1); } } }
              a0 = (s0 >> 18) | (s0 << 14); a1 = (s1 >> 18) | (s1 << 14); }
            e0[tk] = a0; e1[tk] = a1;
            cu0[tk] = RSU[a0 & 0x3fffu] * rstd1; cu1[tk] = RSU[a1 & 0x3fffu] * rstd1;
            cv0[tk] = RSV[a0 & 0x3fffu] * __uint_as_float(a0 & ~0x3fffu); cv1[tk] = RSV[a1 & 0x3fffu] * __uint_as_float(a1 & ~0x3fffu);
#pragma unroll
            for (int i = 0; i < 16; ++i) acc[tk][i] = 0.f; }
        LAS float* acl = (LAS float*)(F.lds + RING_OFF + F.wave * (512 * PG_TOK));
#pragma unroll 1
        for (int eb = 0; eb < 128; eb += 16) {
#pragma unroll
          for (int tk = 0; tk < PG_TOK; ++tk) {
            u32x4 uw[16];
            const unsigned esel = (eb < 64) ? e0[tk] : e1[tk];
#pragma unroll
            for (int k = 0; k < 16; ++k) { const unsigned ent = __builtin_amdgcn_readlane(esel, (eb + k) & 63); uw[k] = *(const u32x4*)(UB + (size_t)(ent & 0x3fffu) * 1024 + 16 * l); }
            float p[16];
#pragma unroll
            for (int k = 0; k < 16; ++k) { float f[16]; FP8_UNPACK16(uw[k], f); float s = 0.f;
#pragma unroll
                for (int i = 0; i < 8; ++i) s = __builtin_amdgcn_fdot2_f32_bf16(__builtin_bit_cast(bf16x2_t, cvtpk(f[2 * i], f[2 * i + 1])), __builtin_bit_cast(bf16x2_t, x[tk][i]), s, false);
                p[k] = s; }
            float q8[8], q4[4], q2[2], q1;
#pragma unroll
            for (int j = 0; j < 8; ++j) q8[j] = sum_swap32(p[j], p[8 + j]);
#pragma unroll
            for (int j = 0; j < 4; ++j) q4[j] = sum_swap16(q8[j], q8[4 + j]);
            { const bool up = (l & 8) != 0;
#pragma unroll
              for (int j = 0; j < 2; ++j) { const float keep = up ? q4[2 + j] : q4[j], send = up ? q4[j] : q4[2 + j]; q2[j] = keep + __shfl_xor(send, 8); } }
            { const bool up = (l & 4) != 0; const float keep = up ? q2[1] : q2[0], send = up ? q2[0] : q2[1]; q1 = keep + __shfl_xor(send, 4); }
            q1 += __shfl_xor(q1, 2); q1 += __shfl_xor(q1, 1);
            const int ei = (eb + (l >> 2)) & 63;
            const float cus = (eb < 64) ? cu0[tk] : cu1[tk], cvs = (eb < 64) ? cv0[tk] : cv1[tk];
            const float cu = __shfl(cus, ei), cv = __shfl(cvs, ei);
            const float a = gelu_tanh(q1 * cu) * cv;
            if ((l & 3) == 0) acl[tk * 128 + eb + (l >> 2)] = a;
          }
        }
        LDS_WAIT(); asm volatile("" ::: "memory");
#pragma unroll 1
        for (int eb = 0; eb < 128; eb += 16) {
#pragma unroll
          for (int tk = 0; tk < PG_TOK; ++tk) {
            u32x4 vw[16];
            const unsigned esel = (eb < 64) ? e0[tk] : e1[tk];
#pragma unroll
            for (int k = 0; k < 16; ++k) { const unsigned ent = __builtin_amdgcn_readlane(esel, (eb + k) & 63); vw[k] = *(const u32x4*)(VB + (size_t)(ent & 0x3fffu) * 1024 + 16 * l); }
            const float av = acl[tk * 128 + eb + (l & 15)];
#pragma unroll
            for (int k = 0; k < 16; ++k) { const float ak = __uint_as_float(__builtin_amdgcn_readlane(__float_as_uint(av), k)); float f[16]; FP8_UNPACK16(vw[k], f);
#pragma unroll
                for (int i = 0; i < 16; ++i) acc[tk][i] += ak * f[i]; }
          }
        }
#pragma unroll
        for (int tk = 0; tk < PG_TOK; ++tk) { const int t = F.vcu * ntok_wg + ti + tk;
            const float* hrow = H1 + (size_t)t * 1024 + 16 * l; float* h2row = H2 + (size_t)t * 1024 + 16 * l; float ss = 0.f; f32x4 h[4];
#pragma unroll
            for (int q = 0; q < 4; ++q) { h[q] = *(const f32x4*)(hrow + 4 * q);
#pragma unroll
                for (int j = 0; j < 4; ++j) { h[q][j] += acc[tk][4 * q + j]; ss += h[q][j] * h[q][j]; }
                *(f32x4*)(h2row + 4 * q) = h[q]; }
            const float rstd3 = __builtin_amdgcn_rsqf(wave_sum(ss) * (1.0f / 1024.0f) + EPS);
            u32x4 o[2];
#pragma unroll
            for (int q2 = 0; q2 < 2; ++q2) { const f32x4 g0 = *(const f32x4*)(g_ple + 16 * l + 8 * q2), g1 = *(const f32x4*)(g_ple + 16 * l + 8 * q2 + 4);
                const f32x4 a = h[2 * q2] * rstd3 * g0, c = h[2 * q2 + 1] * rstd3 * g1;
                o[q2].x = cvtpk(a[0], a[1]); o[q2].y = cvtpk(a[2], a[3]); o[q2].z = cvtpk(c[0], c[1]); o[q2].w = cvtpk(c[2], c[3]); }
            *(u32x4*)(XN3 + (size_t)t * 1024 + 16 * l) = o[0]; *(u32x4*)(XN3 + (size_t)t * 1024 + 16 * l + 8) = o[1]; }
    }
}

__device__ __forceinline__ void phase_final(Frame& F) {
    const float* SSQ3 = WSP(float, WS_SSQ3); const float* g = F.in[19];
    const int l = F.lane; const int gw = F.vcu * NWAVES + F.wave, NGW = F.G * NWAVES;
    for (int t = gw; t < T_TOK; t += NGW) {
        const f32x4* sp = (const f32x4*)(SSQ3 + (size_t)t * 16); const f32x4 st = (sp[0] + sp[1]) + (sp[2] + sp[3]);
        const float rstd = __builtin_amdgcn_rsqf(((st[0] + st[1]) + (st[2] + st[3])) * (1.0f / 1024.0f) + EPS);
        f32x4* row = (f32x4*)(F.out + (size_t)t * 1024);
#pragma unroll
        for (int j = 0; j < 4; ++j) { const f32x4 gv = *((const f32x4*)g + l + 64 * j); const f32x4 o = row[l + 64 * j] * rstd * gv; if (!F.dry) row[l + 64 * j] = o; }
    }
}
#ifndef MK_FUSED
#define MK_FUSED 1
#endif
constexpr int NPHASE = 11;
struct Args { const float* in[20]; float* out; unsigned char* ws; int ph_lo, ph_hi, dry, pad; };
static_assert(sizeof(Args) == 20 * 8 + 8 + 8 + 4 * 4, "Args has no padding");

__global__ void __launch_bounds__(NWAVES * 64, 2) mk_fwd(Args args) {
    extern __shared__ __attribute__((aligned(16))) unsigned char lds_raw[];
    Frame F;
    F.lds = (LAS unsigned char*)lds_raw;
    F.wave = __builtin_amdgcn_readfirstlane(threadIdx.x >> 6); F.lane = lane_id(); F.tid = F.wave * 64 + F.lane;
    F.G = gridDim.x; { const int bx = blockIdx.x; F.vcu = (F.G % 8 == 0) ? (bx % 8) * (F.G / 8) + bx / 8 : bx; }
    F.in = args.in; F.out = args.out; F.ws = args.ws; F.dry = args.dry;
    volatile LAS unsigned* MISC = (volatile LAS unsigned*)(F.lds + MISC_OFF);
    if (F.tid < 64) MISC[F.tid] = 0u;
    __syncthreads();
    const int lo = args.ph_lo, hi = args.ph_hi;
    XcdBarrier bar; bar.bar = (unsigned*)(F.ws + WS_CTL) + CW_BAR; bar.x = 0; bar.st = nullptr;
    if (hi - lo > 1) bar = xcd_barrier_post((unsigned*)(F.ws + WS_CTL) + CW_BAR, MISC + 8, F.tid);
#ifndef PH_MASK
#define PH_MASK 0xFFFFFFFFu
#endif
#define IN(k) (((PH_MASK >> (k)) & 1u) && lo <= (k) && (k) < hi)
#define LAUNDER(p, T) do { unsigned _lo = (unsigned)(unsigned long long)(p), _hi = (unsigned)((unsigned long long)(p) >> 32); asm volatile("" : "+v"(_lo), "+v"(_hi)); \
        _lo = __builtin_amdgcn_readfirstlane(_lo); _hi = __builtin_amdgcn_readfirstlane(_hi); (p) = (T)(((unsigned long long)_hi << 32) | _lo); } while (0)
#define SEAM(k) do { if (IN(k) && IN((k) + 1)) xcd_barrier(bar, F.tid); LAUNDER(F.ws, unsigned char*); LAUNDER(F.out, float*); F.lane = lane_id(); F.tid = F.wave * 64 + F.lane; } while (0)
    const int bx = (int)blockIdx.x;
    LAS unsigned char* ring = F.lds + RING_OFF;

    if (IN(0)) { phase_prologue(F); } SEAM(0);
    if (IN(1)) {
        pg8::Gemm g{WSP(bf16_t, WS_XN1), WSP(bf16_t, WS_WIN), T_TOK, 8192, 1024, 1024, 0}; pg8::StaticOrder S; S.init(T_TOK, 8192, F.G, bx);
        pg8::EpiProj E{WSP(bf16_t, WS_GQ), WSP(bf16_t, WS_GK), WSP(bf16_t, WS_GV), WSP(bf16_t, WS_GR), WSP(bf16_t, WS_SQ), WSP(bf16_t, WS_SK), WSP(bf16_t, WS_SV),
                       (bf16_t*)F.out, (bf16_t*)F.out + (size_t)T_TOK * 1024};
        pg8::gemm_phase<pg8::EpiProj>(ring, g, S, E, F.tid);
    } SEAM(1);
    if (IN(2)) { phase_gla_prep(F); } SEAM(2);
    if (IN(3)) { phase_attn_a(F); } SEAM(3);
    if (IN(4)) { phase_attn_b(F); } SEAM(4);
    if (IN(5)) {
        cvt_rows_fp8(F, F.in[14], WSP(unsigned char, WS_UB8), WSP(float, WS_RSU));
        cvt_rows_fp8(F, F.in[15], WSP(unsigned char, WS_VB8), WSP(float, WS_RSV));
        VM_WAIT(); __syncthreads();
        pg8::StaticOrder S; S.init(T_TOK, 1024, F.G, bx);
        { pg8::Gemm g{WSP(bf16_t, WS_GLAN), WSP(bf16_t, WS_WGA), T_TOK, 1024, 1024, 1024, 0}; pg8::EpiMix<true> E{(const bf16_t*)F.out, WSP(bf16_t, WS_MIX)};
          pg8::gemm_phase<pg8::EpiMix<true>>(ring, g, S, E, F.tid); }
        { pg8::Gemm g{WSP(bf16_t, WS_SQ), WSP(bf16_t, WS_WSB), T_TOK, 1024, 1024, 1024, 0}; pg8::EpiMix<false> E{(const bf16_t*)F.out + (size_t)T_TOK * 1024, WSP(bf16_t, WS_MIX)};
          pg8::gemm_phase<pg8::EpiMix<false>>(ring, g, S, E, F.tid); }
    } SEAM(5);
    if (IN(6)) {
        pg8::Gemm g{WSP(bf16_t, WS_MIX), WSP(bf16_t, WS_WO), T_TOK, 1024, 1024, 1024, 0}; pg8::StaticOrder S; S.init(T_TOK, 1024, F.G, bx);
        pg8::EpiH1 E{F.in[0], F.in[10], WSP(float, WS_H1), WSP(bf16_t, WS_H1G), WSP(float, WS_SSQ1)};
        pg8::gemm_phase<pg8::EpiH1>(ring, g, S, E, F.tid);
    } SEAM(6);
    if (IN(7)) {
        pg8::Gemm g{WSP(bf16_t, WS_H1G), WSP(bf16_t, WS_WPQ), T_TOK, 2048, 1024, 1024, 0}; pg8::StaticOrder S; S.init(T_TOK, 2048, F.G, bx);
        pg8::EpiQ E{WSP(float, WS_SSQ1), WSP(bf16_t, WS_Q), 2048};
        pg8::gemm_phase<pg8::EpiQ>(ring, g, S, E, F.tid);
    } SEAM(7);
    if (IN(8)) {
        cvt_copy(F, F.in[1], WSP(bf16_t, WS_PB), (size_t)T_TOK * 256);
        phase_peer_retrieve(F);
        VM_WAIT(); __syncthreads();
        phase_peer_gather(F);
    } SEAM(8);
    if (IN(9)) {
        pg8::StaticOrder S; S.init(T_TOK, 1024, F.G, bx);
        { pg8::Gemm g{WSP(bf16_t, WS_PB), WSP(bf16_t, WS_WPLE), T_TOK, 1024, 256, 256, 0}; pg8::EpiBf E{WSP(bf16_t, WS_PLE), 1024};
          pg8::gemm_phase<pg8::EpiBf>(ring, g, S, E, F.tid); }
        { pg8::Gemm g{WSP(bf16_t, WS_XN3), WSP(bf16_t, WS_WPG), T_TOK, 1024, 1024, 1024, 0}; pg8::EpiH3 E{F.out, WSP(bf16_t, WS_PLE), F.out, WSP(float, WS_SSQ3), F.dry};
          pg8::gemm_phase<pg8::EpiH3>(ring, g, S, E, F.tid); }
    } SEAM(9);
    if (IN(10)) { phase_final(F); }
#undef IN
#undef SEAM
}

extern "C" void kernel_launch(void* const* d_in, const int* in_sizes, int n_in, void* d_out, int out_size, void* d_ws, size_t ws_size, hipStream_t stream) {
    static int grid = 0;
    if (grid == 0) {
        if (n_in != 20 || in_sizes[0] != T_TOK * 1024 || out_size != T_TOK * 1024 || ws_size < WS_END) {
            fprintf(stderr, "kernel_launch: unexpected shapes (n_in %d, in0 %d, out %d, ws %zu < %zu?); nothing launched\n", n_in, n_in > 0 ? in_sizes[0] : -1, out_size, ws_size, (size_t)WS_END); grid = -1; return; }
        int dev = 0, cus = 0, per_cu = 0;
        if (hipGetDevice(&dev) != hipSuccess || hipDeviceGetAttribute(&cus, hipDeviceAttributeMultiprocessorCount, dev) != hipSuccess) { grid = -1; return; }
        if (hipFuncSetAttribute((const void*)mk_fwd, hipFuncAttributeMaxDynamicSharedMemorySize, LDS_BYTES) != hipSuccess) { fprintf(stderr, "kernel_launch: hipFuncSetAttribute failed\n"); grid = -1; return; }
        if (hipOccupancyMaxActiveBlocksPerMultiprocessor(&per_cu, (const void*)mk_fwd, NWAVES * 64, LDS_BYTES) != hipSuccess || per_cu < 1)
            fprintf(stderr, "kernel_launch: note: occupancy query reports %d workgroups per CU\n", per_cu);
        (void)hipGetLastError();
        grid = cus;
        if (grid != 256) fprintf(stderr, "kernel_launch: note: %d CUs (kernel tuned for 256)\n", grid);
    }
    if (grid < 0) return;
    if (hipMemsetAsync((char*)d_ws + WS_CTL, 0, CTL_ZERO_BYTES, stream) != hipSuccess) { fprintf(stderr, "kernel_launch: hipMemsetAsync failed\n"); return; }
    Args a{};
    for (int i = 0; i < 20; ++i) a.in[i] = (const float*)d_in[i];
    a.out = (float*)d_out; a.ws = (unsigned char*)d_ws;
#if MK_FUSED
    a.ph_lo = 0; a.ph_hi = NPHASE;
    hipLaunchKernelGGL(mk_fwd, dim3(grid), dim3(NWAVES * 64), LDS_BYTES, stream, a);
#else
#ifndef PROBE_PHASE
#define PROBE_PHASE -1
#define PROBE_REPS 0
#endif
    for (int p = 0; p < NPHASE; ++p) { a.ph_lo = p; a.ph_hi = p + 1;
        if (p == PROBE_PHASE) { a.dry = 1; for (int r = 0; r < PROBE_REPS; ++r) hipLaunchKernelGGL(mk_fwd, dim3(grid), dim3(NWAVES * 64), LDS_BYTES, stream, a); a.dry = 0; }
        hipLaunchKernelGGL(mk_fwd, dim3(grid), dim3(NWAVES * 64), LDS_BYTES, stream, a); }
#endif
}
```

```cpp
#define MK_FUSED 1
#define PG_TOK 2
#include <hip/hip_runtime.h>
#include <cstdio>
#include <cstdint>

#define LAS __attribute__((address_space(3)))
#define GAS __attribute__((address_space(1)))
typedef unsigned short bf16_t;
typedef short bf16x8 __attribute__((ext_vector_type(8)));
typedef short s16x4 __attribute__((ext_vector_type(4)));
typedef float f32x2 __attribute__((ext_vector_type(2)));
typedef float f32x4 __attribute__((ext_vector_type(4)));
typedef float f32x16 __attribute__((ext_vector_type(16)));
typedef unsigned u32x2 __attribute__((ext_vector_type(2)));
typedef unsigned u32x4 __attribute__((ext_vector_type(4)));
typedef __bf16 bf16x2_t __attribute__((ext_vector_type(2)));

__device__ __forceinline__ unsigned cvtpk(float lo, float hi) { f32x2 v = {lo, hi}; bf16x2_t b = __builtin_convertvector(v, bf16x2_t); return __builtin_bit_cast(unsigned, b); }
__device__ __forceinline__ float bf_lo(unsigned u) { return __uint_as_float(u << 16); }
__device__ __forceinline__ float bf_hi(unsigned u) { return __uint_as_float(u & 0xffff0000u); }
__device__ __forceinline__ float bf1(bf16_t u) { return __uint_as_float(((unsigned)u) << 16); }
__device__ __forceinline__ float fast_sigmoid(float x) { return __builtin_amdgcn_rcpf(1.0f + __expf(-x)); }

namespace pg8 {
constexpr int BM = 256, BK = 64, HALF = 128, HTB = HALF * BK * 2  , STAGE_BYTES = 8 * HTB, NXCD = 8, WGM = 8;

__host__ __device__ __forceinline__ int lds_byte(int r, int c) { const int st = (r >> 4) * 2 + (c >> 5), rr = r & 15, cc = c & 31, ob = rr * 64 + cc * 2; return st * 1024 + (ob ^ (((ob >> 9) & 1) << 5)); }
__host__ __device__ __forceinline__ void stage_rc(int b, int& R, int& C) { const int st = b / 1024, sb = b % 1024, swz = sb ^ (((sb >> 9) & 1) << 5); R = (st >> 1) * 16 + swz / 64; C = (st & 1) * 32 + (swz % 64) / 2; }
__host__ __device__ __forceinline__ int perm32(int rho) { const int n = rho >> 4, i = rho & 15; return 8 * (i >> 2) + 4 * n + (i & 3); }

struct Unit { int pm, pn; };
struct Gemm { const bf16_t* A; const bf16_t* Bt; int M, N, K, lda, a_pn_cols; int swap_lo, swap_hi; };

struct StaticOrder {
    int nM, nN, nwg, G, c;
    __host__ __device__ void init(int M, int N, int G_, int c_) { nM = M / BM; nN = N / BM; nwg = nM * nN; G = G_; c = c_; }
    __host__ __device__ bool next(int i, Unit& u) const {
        const long L = (long)i * G + c; if (L >= nwg) return false;
        int wgid = (int)L; { const int q = nwg / NXCD, r = nwg % NXCD, xcd = wgid % NXCD, off = wgid / NXCD; wgid = (xcd < r ? xcd * (q + 1) : r * (q + 1) + (xcd - r) * q) + off; }
        const int nig = WGM * nN, gid = wgid / nig, fm = gid * WGM, gsz = (nM - fm) < WGM ? (nM - fm) : WGM;
        u.pm = fm + ((wgid % nig) % gsz); u.pn = (wgid % nig) / gsz; return true;
    }
};

template <class Epi, bool ALIGN_EPI = true, bool SP2 = true>
__device__ __forceinline__ void gemm_phase(LAS unsigned char* lds, const Gemm g, const StaticOrder& S, const Epi& E, int tid) {
    const int wid = __builtin_amdgcn_readfirstlane(tid >> 6), lane = tid & 63, wr = wid >> 2, wc = wid & 3, fr = lane & 15, fq = lane >> 4;
    const int K = g.K, nt = K / BK, lda = g.lda;
    unsigned voffA[2], voffB[2];
#pragma unroll
    for (int i = 0; i < 2; ++i) { int R, C; stage_rc(tid * 16 + i * 8192, R, C); const int Rb = Epi::PERM ? ((R & ~31) + perm32(R & 31)) : R;
        voffA[i] = (unsigned)(R * lda + C) * 2u; voffB[i] = (unsigned)(Rb * K + C) * 2u; }
    const size_t kstep = (size_t)(BK * 2);
    const size_t hA = (size_t)HALF * lda * 2, hB = (size_t)HALF * K * 2;
    const size_t tA = 2 * hA, tB = 2 * hB;
    const size_t pnA = (size_t)g.a_pn_cols * 2;
    const unsigned ldsw = (unsigned)wid * 1024u;
    const int aoff = lds_byte(wr * 64 + fr, fq * 8), boff = lds_byte(wc * 32 + fr, fq * 8);
#define PG8_SA(b, h) (((b) * 2 + (h)) * HTB)
#define PG8_SB(b, h) ((4 + (b) * 2 + (h)) * HTB)
#define PG8_STAGE(bufoff, gbase, voff) do { _Pragma("unroll") for (int _i = 0; _i < 2; ++_i) \
        __builtin_amdgcn_global_load_lds((const unsigned*)((const char*)(gbase) + (voff)[_i]), (LAS unsigned*)(lds + (bufoff) + ldsw + _i * 8192), 16, 0, 0); } while (0)
#define PG8_LDA(dst, b, h) do { _Pragma("unroll") for (int m = 0; m < 4; ++m) _Pragma("unroll") for (int k = 0; k < 2; ++k) dst[m][k] = *(const LAS bf16x8*)(lds + PG8_SA(b, h) + aoff + m * 2048 + k * 1024); } while (0)
#define PG8_LDB(dst, b, h) do { _Pragma("unroll") for (int n = 0; n < 2; ++n) _Pragma("unroll") for (int k = 0; k < 2; ++k) dst[n][k] = *(const LAS bf16x8*)(lds + PG8_SB(b, h) + boff + n * 2048 + k * 1024); } while (0)
#define PG8_MMA(ai, bj, At, Bt) do { __builtin_amdgcn_s_setprio(1); _Pragma("unroll") for (int m = 0; m < 4; ++m) _Pragma("unroll") for (int n = 0; n < 2; ++n) _Pragma("unroll") for (int k = 0; k < 2; ++k) \
        acc[ai][bj][m][n] = __builtin_amdgcn_mfma_f32_16x16x32_bf16(Bt[n][k], At[m][k], acc[ai][bj][m][n], 0, 0, 0); __builtin_amdgcn_s_setprio(0); } while (0)
#define PG8_WAIT_V(n) asm volatile("s_waitcnt vmcnt(" #n ")" ::: "memory")
#define PG8_WAIT_L(n) asm volatile("s_waitcnt lgkmcnt(" #n ")" ::: "memory")
#define PG8_BAR __builtin_amdgcn_s_barrier()
#define PG8_SCHED __builtin_amdgcn_sched_barrier(0)
    Unit cur, nxt; int ui = 0;
    if (!S.next(0, cur)) return;
    f32x4 acc[2][2][4][2];
#pragma unroll
    for (int a = 0; a < 2; ++a)
#pragma unroll
        for (int b = 0; b < 2; ++b)
#pragma unroll
            for (int m = 0; m < 4; ++m)
#pragma unroll
                for (int n = 0; n < 2; ++n) acc[a][b][m][n] = (f32x4){0.f, 0.f, 0.f, 0.f};
    bf16x8 At[4][2], B0[2][2], B1[2][2];
#define PG8_APTR(u) (((u).pn >= g.swap_lo && (u).pn < g.swap_hi) ? (const char*)g.Bt + (size_t)(u).pn * tB : (const char*)g.A + (size_t)(u).pm * tA + (size_t)(u).pn * pnA)
#define PG8_BPTR(u) (((u).pn >= g.swap_lo && (u).pn < g.swap_hi) ? (const char*)g.A + (size_t)(u).pm * tA : (const char*)g.Bt + (size_t)(u).pn * tB)
    const char* cA = PG8_APTR(cur); const char* cB = PG8_BPTR(cur);
    if constexpr (SP2) {
        PG8_STAGE(PG8_SB(0, 0), cB, voffB); PG8_STAGE(PG8_SB(0, 1), cB + hB, voffB); PG8_STAGE(PG8_SA(0, 0), cA, voffA); PG8_STAGE(PG8_SA(0, 1), cA + hA, voffA);
        if (wr == 1) PG8_BAR;
        PG8_WAIT_V(2); PG8_BAR;
        PG8_STAGE(PG8_SB(1, 0), cB + kstep, voffB); PG8_STAGE(PG8_SA(1, 0), cA + kstep, voffA); PG8_STAGE(PG8_SB(1, 1), cB + hB + kstep, voffB);
        PG8_WAIT_V(6); PG8_BAR;
    } else {
        PG8_STAGE(PG8_SB(0, 0), cB, voffB); PG8_STAGE(PG8_SA(0, 0), cA, voffA); PG8_STAGE(PG8_SB(0, 1), cB + hB, voffB); PG8_STAGE(PG8_SA(0, 1), cA + hA, voffA);
        if (wr == 1) PG8_BAR;
        PG8_WAIT_V(4); PG8_BAR;
        PG8_STAGE(PG8_SB(1, 0), cB + kstep, voffB); PG8_STAGE(PG8_SA(1, 0), cA + kstep, voffA); PG8_STAGE(PG8_SB(1, 1), cB + hB + kstep, voffB);
        PG8_WAIT_V(6); PG8_BAR;
    }
    for (;;) {
        const bool has_next = S.next(ui + 1, nxt);
        const char* nA = has_next ? PG8_APTR(nxt) : cA; const char* nB = has_next ? PG8_BPTR(nxt) : cB;
#pragma unroll 1
        for (int t = 0; t < nt; t += 2) {
            const bool last = (t == nt - 2);
            const char* a1 = cA + (size_t)(t + 1) * kstep;
            const char* a2 = last ? nA : cA + (size_t)(t + 2) * kstep; const char* b2 = last ? nB : cB + (size_t)(t + 2) * kstep;
            const char* a3 = a2 + kstep; const char* b3 = b2 + kstep;
            if constexpr (SP2) {
            PG8_LDB(B0, 0, 0); PG8_LDB(B1, 0, 1); PG8_SCHED; PG8_LDA(At, 0, 0); PG8_STAGE(PG8_SA(1, 1), a1 + hA, voffA);
            PG8_WAIT_V(8); PG8_WAIT_L(0); PG8_BAR; PG8_MMA(0, 0, At, B0); PG8_MMA(0, 1, At, B1); PG8_BAR; PG8_SCHED;
            PG8_LDA(At, 0, 1); PG8_STAGE(PG8_SB(0, 0), b2, voffB); PG8_STAGE(PG8_SB(0, 1), b2 + hB, voffB); PG8_STAGE(PG8_SA(0, 0), a2, voffA);
            PG8_WAIT_V(8); PG8_WAIT_L(0); PG8_BAR; PG8_MMA(1, 0, At, B0); PG8_MMA(1, 1, At, B1); PG8_BAR; PG8_SCHED;
            PG8_LDB(B0, 1, 0); PG8_LDB(B1, 1, 1); PG8_SCHED; PG8_LDA(At, 1, 0); PG8_STAGE(PG8_SA(0, 1), a2 + hA, voffA);
            PG8_WAIT_V(8); PG8_WAIT_L(0); PG8_BAR; PG8_MMA(0, 0, At, B0); PG8_MMA(0, 1, At, B1); PG8_BAR; PG8_SCHED;
            PG8_LDA(At, 1, 1); PG8_STAGE(PG8_SB(1, 0), b3, voffB); PG8_STAGE(PG8_SB(1, 1), b3 + hB, voffB); PG8_STAGE(PG8_SA(1, 0), a3, voffA);
            PG8_WAIT_V(8); PG8_WAIT_L(0); PG8_BAR; PG8_MMA(1, 0, At, B0); PG8_MMA(1, 1, At, B1); PG8_BAR; PG8_SCHED;
            } else {
            PG8_LDB(B0, 0, 0); PG8_SCHED; PG8_LDA(At, 0, 0); PG8_STAGE(PG8_SA(1, 1), a1 + hA, voffA);
            PG8_WAIT_L(8); PG8_BAR; PG8_WAIT_L(0); PG8_MMA(0, 0, At, B0); PG8_BAR; PG8_SCHED;
            PG8_LDB(B1, 0, 1); PG8_STAGE(PG8_SB(0, 0), b2, voffB);
            PG8_BAR; PG8_WAIT_L(0); PG8_MMA(0, 1, At, B1); PG8_BAR;
            PG8_LDA(At, 0, 1); PG8_STAGE(PG8_SA(0, 0), a2, voffA);
            PG8_BAR; PG8_WAIT_L(0); PG8_MMA(1, 0, At, B0); PG8_BAR; PG8_SCHED;
            PG8_STAGE(PG8_SB(0, 1), b2 + hB, voffB);
            PG8_WAIT_V(6); PG8_BAR; PG8_MMA(1, 1, At, B1); PG8_BAR;
            PG8_LDB(B0, 1, 0); PG8_SCHED; PG8_LDA(At, 1, 0); PG8_STAGE(PG8_SA(0, 1), a2 + hA, voffA);
            PG8_WAIT_L(8); PG8_BAR; PG8_WAIT_L(0); PG8_MMA(0, 0, At, B0); PG8_BAR; PG8_SCHED;
            PG8_LDB(B1, 1, 1); PG8_STAGE(PG8_SB(1, 0), b3, voffB);
            PG8_BAR; PG8_WAIT_L(0); PG8_MMA(0, 1, At, B1); PG8_BAR;
            PG8_LDA(At, 1, 1); PG8_STAGE(PG8_SA(1, 0), a3, voffA);
            PG8_BAR; PG8_WAIT_L(0); PG8_MMA(1, 0, At, B0); PG8_BAR; PG8_SCHED;
            PG8_STAGE(PG8_SB(1, 1), b3 + hB, voffB);
            PG8_WAIT_V(6); PG8_BAR; PG8_MMA(1, 1, At, B1); PG8_BAR;
            }
        }
        if constexpr (ALIGN_EPI) { if (wr == 0) PG8_BAR; }
        E(acc, cur, wr, wc, fr, fq);
        if (!has_next) break;
#pragma unroll
        for (int a = 0; a < 2; ++a)
#pragma unroll
            for (int b = 0; b < 2; ++b)
#pragma unroll
                for (int m = 0; m < 4; ++m)
#pragma unroll
                    for (int n = 0; n < 2; ++n) acc[a][b][m][n] = (f32x4){0.f, 0.f, 0.f, 0.f};
        cur = nxt; cA = nA; cB = nB; ++ui;
        if constexpr (ALIGN_EPI) { if (wr == 1) PG8_BAR; }
    }
    PG8_WAIT_V(0);
    if constexpr (!ALIGN_EPI) { if (wr == 0) PG8_BAR; }
    PG8_BAR;
#undef PG8_APTR
#undef PG8_BPTR
#undef PG8_SA
#undef PG8_SB
#undef PG8_STAGE
#undef PG8_LDA
#undef PG8_LDB
#undef PG8_MMA
#undef PG8_WAIT_V
#undef PG8_WAIT_L
#undef PG8_BAR
#undef PG8_SCHED
}
}
constexpr int T_TOK = 16384, DM = 1024, SEQ = 4096, NB = 4;
constexpr float EPS = 1e-6f;
constexpr float LOG2E = 1.4426950408889634f;

namespace pg8 {
struct EpiProj {
    static constexpr bool PERM = true;
    bf16_t *GQ, *GK, *GV, *GR, *SQ, *SK, *SV, *SGA, *SGB;
    __device__ __forceinline__ void operator()(const f32x4 (&acc)[2][2][4][2], const Unit& u, int wr, int wc, int fr, int fq) const {
        const int pn = u.pn; bf16_t* base; int ldc = 1024, c0; int act = 0; float sc = 1.f;
        if (pn >= 2 && pn < 8) {
            bf16_t* tb = (pn < 4) ? GK : GV; const int f0 = ((pn < 4) ? (pn - 2) : (pn - 4)) * 256 + wr * 64 + fr, t0 = u.pm * BM + wc * 32 + 8 * fq;
#pragma unroll
            for (int ai = 0; ai < 2; ++ai)
#pragma unroll
                for (int m = 0; m < 4; ++m) { bf16_t* rowp = tb + (size_t)(f0 + ai * HALF + m * 16) * T_TOK + t0;
#pragma unroll
                    for (int bj = 0; bj < 2; ++bj) { const f32x4 v0 = acc[ai][bj][m][0], v1 = acc[ai][bj][m][1];
                        u32x4 w; w.x = cvtpk(v0[0], v0[1]); w.y = cvtpk(v0[2], v0[3]); w.z = cvtpk(v1[0], v1[1]); w.w = cvtpk(v1[2], v1[3]);
                        *(u32x4*)(rowp + bj * HALF) = w; } }
            return; }
        if (pn < 2) { base = GQ; ldc = 512; c0 = pn * 256; sc = 0.08838834764831845f; }
        else if (pn < 4) { base = GK; ldc = 512; c0 = (pn - 2) * 256; }
        else if (pn < 8) { base = GV; c0 = (pn - 4) * 256; }
        else if (pn < 12) { base = GR; c0 = (pn - 8) * 256; act = 1; }
        else if (pn < 16) { base = SQ; c0 = (pn - 12) * 256; sc = 0.125f * LOG2E; }
        else if (pn < 20) { base = SK; c0 = (pn - 16) * 256; }
        else if (pn < 24) { base = SV; c0 = (pn - 20) * 256; }
        else if (pn < 28) { base = SGA; c0 = (pn - 24) * 256; act = 2; }
        else { base = SGB; c0 = (pn - 28) * 256; act = 2; }
        const int row0 = u.pm * BM + wr * 64 + fr, col0 = c0 + wc * 32 + 8 * fq;
#pragma unroll
        for (int ai = 0; ai < 2; ++ai)
#pragma unroll
            for (int m = 0; m < 4; ++m) { bf16_t* rowp = base + (size_t)(row0 + ai * HALF + m * 16) * ldc + col0;
#pragma unroll
                for (int bj = 0; bj < 2; ++bj) { f32x4 v0 = acc[ai][bj][m][0], v1 = acc[ai][bj][m][1];
                    if (act == 1) {
#pragma unroll
                        for (int j = 0; j < 4; ++j) { v0[j] = v0[j] * fast_sigmoid(v0[j]); v1[j] = v1[j] * fast_sigmoid(v1[j]); } }
                    else if (act == 2) {
#pragma unroll
                        for (int j = 0; j < 4; ++j) { v0[j] = fast_sigmoid(v0[j]); v1[j] = fast_sigmoid(v1[j]); } }
                    else { v0 = v0 * sc; v1 = v1 * sc; }
                    u32x4 w; w.x = cvtpk(v0[0], v0[1]); w.y = cvtpk(v0[2], v0[3]); w.z = cvtpk(v1[0], v1[1]); w.w = cvtpk(v1[2], v1[3]);
                    *(u32x4*)(rowp + bj * HALF) = w; } }
    }
};
template <bool FIRST> struct EpiMix {
    static constexpr bool PERM = true;
    const bf16_t* gate; bf16_t* mixed;
    __device__ __forceinline__ void operator()(const f32x4 (&acc)[2][2][4][2], const Unit& u, int wr, int wc, int fr, int fq) const {
        const int row0 = u.pm * BM + wr * 64 + fr, col0 = u.pn * BM + wc * 32 + 8 * fq;
#pragma unroll
        for (int ai = 0; ai < 2; ++ai)
#pragma unroll
            for (int m = 0; m < 4; ++m) { const size_t off = (size_t)(row0 + ai * HALF + m * 16) * 1024 + col0;
#pragma unroll
                for (int bj = 0; bj < 2; ++bj) { const f32x4 a0 = acc[ai][bj][m][0], a1 = acc[ai][bj][m][1];
                    const u32x4 gv = *(const u32x4*)(gate + off + bj * HALF);
                    float r[8];
                    r[0] = a0[0] * bf_lo(gv.x); r[1] = a0[1] * bf_hi(gv.x); r[2] = a0[2] * bf_lo(gv.y); r[3] = a0[3] * bf_hi(gv.y);
                    r[4] = a1[0] * bf_lo(gv.z); r[5] = a1[1] * bf_hi(gv.z); r[6] = a1[2] * bf_lo(gv.w); r[7] = a1[3] * bf_hi(gv.w);
                    if (!FIRST) { const u32x4 mv = *(const u32x4*)(mixed + off + bj * HALF);
                        r[0] += bf_lo(mv.x); r[1] += bf_hi(mv.x); r[2] += bf_lo(mv.y); r[3] += bf_hi(mv.y); r[4] += bf_lo(mv.z); r[5] += bf_hi(mv.z); r[6] += bf_lo(mv.w); r[7] += bf_hi(mv.w); }
                    u32x4 w; w.x = cvtpk(r[0], r[1]); w.y = cvtpk(r[2], r[3]); w.z = cvtpk(r[4], r[5]); w.w = cvtpk(r[6], r[7]);
                    *(u32x4*)(mixed + off + bj * HALF) = w; } }
    }
};
struct EpiH1 {
    static constexpr bool PERM = false;
    const float* x; const float* g; float* H1; bf16_t* H1G; float* SSQ;
    __device__ __forceinline__ void operator()(const f32x4 (&acc)[2][2][4][2], const Unit& u, int wr, int wc, int fr, int fq) const {
        const int row0 = u.pm * BM + wr * 64 + fr, col0 = u.pn * BM + wc * 32 + 4 * fq;
        f32x4 gv[2][2];
#pragma unroll
        for (int bj = 0; bj < 2; ++bj)
#pragma unroll
            for (int n = 0; n < 2; ++n) gv[bj][n] = *(const f32x4*)(g + col0 + bj * HALF + n * 16);
#pragma unroll
        for (int ai = 0; ai < 2; ++ai)
#pragma unroll
            for (int m = 0; m < 4; ++m) { const int row = row0 + ai * HALF + m * 16; const size_t off = (size_t)row * 1024 + col0; float s = 0.f;
#pragma unroll
                for (int bj = 0; bj < 2; ++bj)
#pragma unroll
                    for (int n = 0; n < 2; ++n) { const f32x4 xv = *(const f32x4*)(x + off + bj * HALF + n * 16); const f32x4 h = xv + acc[ai][bj][m][n];
                        *(f32x4*)(H1 + off + bj * HALF + n * 16) = h; s += (h[0] * h[0] + h[1] * h[1]) + (h[2] * h[2] + h[3] * h[3]);
                        const f32x4 hg = h * gv[bj][n]; u32x2 w; w.x = cvtpk(hg[0], hg[1]); w.y = cvtpk(hg[2], hg[3]); *(u32x2*)(H1G + off + bj * HALF + n * 16) = w; }
                s += __shfl_xor(s, 16); s += __shfl_xor(s, 32);
                if (fq == 0) SSQ[(size_t)row * 16 + u.pn * 4 + wc] = s; }
    }
};
struct EpiQ {
    static constexpr bool PERM = true;
    const float* SSQ; bf16_t* Q; int ldc;
    __device__ __forceinline__ void operator()(const f32x4 (&acc)[2][2][4][2], const Unit& u, int wr, int wc, int fr, int fq) const {
        const int row0 = u.pm * BM + wr * 64 + fr, col0 = u.pn * BM + wc * 32 + 8 * fq;
#pragma unroll
        for (int ai = 0; ai < 2; ++ai)
#pragma unroll
            for (int m = 0; m < 4; ++m) { const int row = row0 + ai * HALF + m * 16; const f32x4* sp = (const f32x4*)(SSQ + (size_t)row * 16);
                const f32x4 s0 = sp[0], s1 = sp[1], s2 = sp[2], s3 = sp[3]; const f32x4 st = (s0 + s1) + (s2 + s3);
                const float rstd = __builtin_amdgcn_rsqf(((st[0] + st[1]) + (st[2] + st[3])) * (1.0f / 1024.0f) + EPS);
                bf16_t* rowp = Q + (size_t)row * ldc + col0;
#pragma unroll
                for (int bj = 0; bj < 2; ++bj) { const f32x4 v0 = acc[ai][bj][m][0] * rstd, v1 = acc[ai][bj][m][1] * rstd;
                    u32x4 w; w.x = cvtpk(v0[0], v0[1]); w.y = cvtpk(v0[2], v0[3]); w.z = cvtpk(v1[0], v1[1]); w.w = cvtpk(v1[2], v1[3]);
                    *(u32x4*)(rowp + bj * HALF) = w; } }
    }
};
struct EpiF32 {
    static constexpr bool PERM = false;
    float* O; int ldc;
    __device__ __forceinline__ void operator()(const f32x4 (&acc)[2][2][4][2], const Unit& u, int wr, int wc, int fr, int fq) const {
        const int row0 = u.pm * BM + wr * 64 + fr, col0 = u.pn * BM + wc * 32 + 4 * fq;
#pragma unroll
        for (int ai = 0; ai < 2; ++ai)
#pragma unroll
            for (int m = 0; m < 4; ++m) { float* rowp = O + (size_t)(row0 + ai * HALF + m * 16) * ldc + col0;
#pragma unroll
                for (int bj = 0; bj < 2; ++bj)
#pragma unroll
                    for (int n = 0; n < 2; ++n) *(f32x4*)(rowp + bj * HALF + n * 16) = acc[ai][bj][m][n]; }
    }
};
struct EpiBf {
    static constexpr bool PERM = true;
    bf16_t* O; int ldc;
    __device__ __forceinline__ void operator()(const f32x4 (&acc)[2][2][4][2], const Unit& u, int wr, int wc, int fr, int fq) const {
        const int row0 = u.pm * BM + wr * 64 + fr, col0 = u.pn * BM + wc * 32 + 8 * fq;
#pragma unroll
        for (int ai = 0; ai < 2; ++ai)
#pragma unroll
            for (int m = 0; m < 4; ++m) { bf16_t* rowp = O + (size_t)(row0 + ai * HALF + m * 16) * ldc + col0;
#pragma unroll
                for (int bj = 0; bj < 2; ++bj) { const f32x4 v0 = acc[ai][bj][m][0], v1 = acc[ai][bj][m][1];
                    u32x4 w; w.x = cvtpk(v0[0], v0[1]); w.y = cvtpk(v0[2], v0[3]); w.z = cvtpk(v1[0], v1[1]); w.w = cvtpk(v1[2], v1[3]);
                    *(u32x4*)(rowp + bj * HALF) = w; } }
    }
};
struct EpiH3 {
    static constexpr bool PERM = false;
    const float* H2; const bf16_t* PLE; float* OUT; float* SSQ; int dry;
    __device__ __forceinline__ void operator()(const f32x4 (&acc)[2][2][4][2], const Unit& u, int wr, int wc, int fr, int fq) const {
        const int row0 = u.pm * BM + wr * 64 + fr, col0 = u.pn * BM + wc * 32 + 4 * fq;
#pragma unroll
        for (int ai = 0; ai < 2; ++ai)
#pragma unroll
            for (int m = 0; m < 4; ++m) { const int row = row0 + ai * HALF + m * 16; const size_t off = (size_t)row * 1024 + col0; float s = 0.f;
#pragma unroll
                for (int bj = 0; bj < 2; ++bj)
#pragma unroll
                    for (int n = 0; n < 2; ++n) { const size_t o2 = off + bj * HALF + n * 16; const f32x4 hv = *(const f32x4*)(H2 + o2); const u32x2 pv = *(const u32x2*)(PLE + o2);
                        const f32x4 a = acc[ai][bj][m][n]; f32x4 h;
                        h[0] = hv[0] + bf_lo(pv.x) * fast_sigmoid(a[0]); h[1] = hv[1] + bf_hi(pv.x) * fast_sigmoid(a[1]);
                        h[2] = hv[2] + bf_lo(pv.y) * fast_sigmoid(a[2]); h[3] = hv[3] + bf_hi(pv.y) * fast_sigmoid(a[3]);
                        if (!dry) *(f32x4*)(OUT + o2) = h; s += (h[0] * h[0] + h[1] * h[1]) + (h[2] * h[2] + h[3] * h[3]); }
                s += __shfl_xor(s, 16); s += __shfl_xor(s, 32);
                if (fq == 0) SSQ[(size_t)row * 16 + u.pn * 4 + wc] = s;
                asm volatile("" ::: "memory"); }
    }
};
}
constexpr size_t MiB = 1u << 20;
constexpr size_t WS_CTL = 0, CTL_ZERO_BYTES = 64 * 1024;
constexpr size_t WS_PEND = 64 * 1024;
constexpr size_t WS_WPLE = 512 * 1024;
constexpr size_t WS_KD = 1 * MiB;
constexpr size_t WS_GLAG = 2 * MiB;
constexpr size_t WS_WIN = 3 * MiB;
constexpr size_t WS_SEND = 4 * MiB;
constexpr size_t WS_EXP = 4 * MiB;
constexpr size_t WS_SSQ1 = 13 * MiB;
constexpr size_t WS_SSQ3 = 14 * MiB;
constexpr size_t WS_RSU = 15 * MiB, WS_RSV = 15 * MiB + 64 * 1024;
constexpr size_t WS_WGA = 20 * MiB, WS_WSB = 22 * MiB, WS_WO = 24 * MiB, WS_WPG = 26 * MiB, WS_WPQ = 28 * MiB;
constexpr size_t WS_A = 32 * MiB;
constexpr size_t WS_GQ = WS_A, WS_GK = WS_A + 16 * MiB, WS_UB8 = WS_A, WS_VB8 = WS_A + 16 * MiB;
constexpr size_t WS_B = 64 * MiB;
constexpr size_t WS_GV = WS_B, WS_PB = WS_B;
constexpr size_t WS_C = 96 * MiB;
constexpr size_t WS_GR = WS_C, WS_H1 = WS_C;
constexpr size_t WS_D = 128 * MiB;
constexpr size_t WS_SQ = WS_D;
constexpr size_t WS_E = 160 * MiB;
constexpr size_t WS_SK = WS_E, WS_MIX = WS_E, WS_Q = WS_E, WS_PLE = WS_E;
constexpr size_t WS_F = 192 * MiB;
constexpr size_t WS_SV = WS_F;
constexpr size_t WS_G = 224 * MiB;
constexpr size_t WS_XN1 = WS_G, WS_GLAN = WS_G, WS_H1G = WS_G, WS_XN3 = WS_G;
constexpr size_t WS_END = 256 * MiB;

constexpr int NWAVES = 8;
constexpr int RING_OFF = 0, RING_BYTES = 131072;
constexpr int MISC_OFF = RING_BYTES;
constexpr int LDS_BYTES = 147456;
constexpr int CW_BAR = 1024;

typedef GAS unsigned gu32;
#define RLX_AGENT __ATOMIC_RELAXED, __HIP_MEMORY_SCOPE_AGENT
#define LDS_WAIT() asm volatile("s_waitcnt lgkmcnt(0)" ::: "memory")
#define VM_WAIT() asm volatile("s_waitcnt vmcnt(0)" ::: "memory")

#define XB_TMO      128
#define XB_XCNT(j)  (256  + 64 * (j))
#define XB_XSUB(j)  (1280 + 64 * (j))
#define XB_XGEN(j)  (2304 + 64 * (j))
#define XB_TOP      3328
#define XB_TOPGEN   3392
#define XCD_BAR_WORDS 3456
#define XB_SPIN_CAP (1u << 22)
__device__ __forceinline__ unsigned xb_ld(unsigned* p)              { return __hip_atomic_load(p, __ATOMIC_RELAXED, __HIP_MEMORY_SCOPE_AGENT); }
__device__ __forceinline__ unsigned xb_add(unsigned* p, unsigned v) { return __hip_atomic_fetch_add(p, v, __ATOMIC_RELAXED, __HIP_MEMORY_SCOPE_AGENT); }
__device__ __forceinline__ unsigned xb_xcc_id() { return (unsigned)__builtin_amdgcn_s_getreg((3 << 11) | 20) & 0xFu; }
#define XB_SPIN(cond, bar) do { unsigned _sp = 0; while (cond) { __builtin_amdgcn_s_sleep(1); \
    if ((++_sp & 255u) == 0u) { if (xb_ld(&(bar)[XB_TMO])) break; if (_sp > XB_SPIN_CAP) { atomicAdd(&(bar)[XB_TMO], 1u); break; } } } } while (0)
struct XcdBarrier { unsigned* bar; unsigned x; volatile LAS unsigned* st; };
__device__ __forceinline__ XcdBarrier xcd_barrier_post(unsigned* bar, volatile LAS unsigned* st, int tid) {
    XcdBarrier b; b.bar = bar; b.x = xb_xcc_id(); b.st = st;
    if (tid == 0) (void)xb_add(&bar[XB_XCNT(b.x)], 1u);
    return b;
}
__device__ __forceinline__ void xcd_barrier_complete(unsigned* bar, unsigned x, unsigned& nloc, unsigned& nx) {
    const unsigned G = gridDim.x * gridDim.y * gridDim.z;
    unsigned sum, cnt, mine, sp = 0u;
    for (;;) {
        sum = 0u; cnt = 0u; mine = 0u;
#pragma unroll
        for (unsigned j = 0; j < 16; ++j) { const unsigned c = xb_ld(&bar[XB_XCNT(j)]); sum += c; cnt += (c > 0u) ? 1u : 0u; mine = (j == x) ? c : mine; }
        if (sum == G) break;
        __builtin_amdgcn_s_sleep(1);
        if ((++sp & 255u) == 0u) { if (xb_ld(&bar[XB_TMO])) break; if (sp > XB_SPIN_CAP) { atomicAdd(&bar[XB_TMO], 1u); break; } }
    }
    nloc = mine > 0u ? mine : 1u; nx = cnt > 0u ? cnt : 1u;
}
__device__ __forceinline__ void xcd_barrier(const XcdBarrier& b, int tid) {
    asm volatile("s_waitcnt vmcnt(0)" ::: "memory");
    __syncthreads();
    if (tid == 0) {
        unsigned* bar = b.bar;
        __builtin_amdgcn_s_waitcnt(0);
        unsigned nloc = b.st[0], nx = b.st[1];
        if (nloc == 0u) { xcd_barrier_complete(bar, b.x, nloc, nx); b.st[0] = nloc; b.st[1] = nx; }
        const unsigned old = xb_add(&bar[XB_XSUB(b.x)], 1u);
        const unsigned gen = old / nloc;
        if (old + 1u == (gen + 1u) * nloc) {
            __builtin_amdgcn_fence(__ATOMIC_RELEASE, "agent");
            asm volatile("s_waitcnt vmcnt(0)" ::: "memory");
            const unsigned og = xb_add(&bar[XB_TOP], 1u);
            const unsigned tg = og / nx;
            if (og + 1u == (tg + 1u) * nx) xb_add(&bar[XB_TOPGEN], 1u);
            else XB_SPIN(xb_ld(&bar[XB_TOPGEN]) == tg, bar);
            __builtin_amdgcn_fence(__ATOMIC_ACQUIRE, "agent");
            xb_add(&bar[XB_XGEN(b.x)], 1u);
            asm volatile("s_waitcnt vmcnt(0)" ::: "memory");
        } else {
            XB_SPIN(xb_ld(&bar[XB_XGEN(b.x)]) == gen, bar);
            __builtin_amdgcn_fence(__ATOMIC_ACQUIRE, "agent");
            asm volatile("s_waitcnt vmcnt(0)" ::: "memory");
        }
    }
    __syncthreads();
}

struct Frame {
    LAS unsigned char* lds;
    int tid, lane, wave, vcu, G, dry;
    const float* const* in; float* out; unsigned char* ws;
};
__device__ __forceinline__ int lane_id() { int l; asm volatile("v_mbcnt_lo_u32_b32 %0, -1, 0\n\tv_mbcnt_hi_u32_b32 %0, -1, %0" : "=v"(l)); return l; }
#define WSP(T, off) ((T*)(F.ws + (off)))
__device__ __forceinline__ float wave_sum(float v) {
#pragma unroll
    for (int o = 1; o < 64; o <<= 1) v += __shfl_xor(v, o);
    return v;
}
template <class RowMap>
__device__ __forceinline__ void p0_transpose_item(const float* W, int K, int N, bf16_t* WT, RowMap rm, LAS float* scr, int item, int lane) {
    const int nblk = (N + 31) / 32, kb = item / nblk, nb = item % nblk, k0 = 64 * kb, n0 = 32 * nb;
    { const int kr = lane >> 3, c4 = lane & 7, nl = n0 + 4 * c4; f32x4 v[8];
#pragma unroll
      for (int i = 0; i < 8; ++i) v[i] = (nl < N) ? *(const f32x4*)(W + (size_t)(k0 + 8 * i + kr) * N + nl) : (f32x4){0.f, 0.f, 0.f, 0.f};
#pragma unroll
      for (int i = 0; i < 8; ++i) { LAS float* d = scr + (8 * i + kr) * 33 + 4 * c4; d[0] = v[i][0]; d[1] = v[i][1]; d[2] = v[i][2]; d[3] = v[i][3]; } }
    LDS_WAIT(); asm volatile("" ::: "memory");
    const int c = lane & 7;
#pragma unroll
    for (int j = 0; j < 4; ++j) { const int n = (lane >> 3) + 8 * j; const LAS float* s = scr + (8 * c) * 33 + n;
        u32x4 o; o.x = cvtpk(s[0 * 33], s[1 * 33]); o.y = cvtpk(s[2 * 33], s[3 * 33]); o.z = cvtpk(s[4 * 33], s[5 * 33]); o.w = cvtpk(s[6 * 33], s[7 * 33]);
        if (n0 + n < N) *(u32x4*)(WT + (size_t)rm(n0 + n) * K + k0 + 8 * c) = o; }
    LDS_WAIT(); asm volatile("" ::: "memory");
}
struct RmId { __device__ __forceinline__ int operator()(int n) const { return n; } };
struct RmWin { __device__ __forceinline__ int operator()(int n) const { return n < 3072 ? n : (n < 3088 ? 8192 + (n - 3072) : n - 16); } };

__device__ __forceinline__ void cvt_copy(Frame& F, const float* src, bf16_t* dst, size_t n) {
    const size_t nth = (size_t)F.G * 512, n8 = n / 8;
    for (size_t i = (size_t)F.vcu * 512 + F.tid; i < n8; i += nth) {
        const f32x4 a = *(const f32x4*)(src + i * 8), b = *(const f32x4*)(src + i * 8 + 4);
        u32x4 o; o.x = cvtpk(a[0], a[1]); o.y = cvtpk(a[2], a[3]); o.z = cvtpk(b[0], b[1]); o.w = cvtpk(b[2], b[3]);
        *(u32x4*)(dst + i * 8) = o; }
}
__device__ __forceinline__ void rms_row_to_bf16(const float* xrow, const float* g, bf16_t* orow, int lane) {
    f32x4 v[4]; float s = 0.f;
#pragma unroll
    for (int j = 0; j < 4; ++j) { v[j] = *((const f32x4*)xrow + lane + 64 * j); s += (v[j][0] * v[j][0] + v[j][1] * v[j][1]) + (v[j][2] * v[j][2] + v[j][3] * v[j][3]); }
    const float rstd = __builtin_amdgcn_rsqf(wave_sum(s) * (1.f / 1024.f) + EPS);
#pragma unroll
    for (int j = 0; j < 4; ++j) { const f32x4 gv = *((const f32x4*)g + lane + 64 * j); const f32x4 o = v[j] * rstd * gv;
        u32x2 w; w.x = cvtpk(o[0], o[1]); w.y = cvtpk(o[2], o[3]); *((u32x2*)orow + lane + 64 * j) = w; }
}
__device__ __forceinline__ void phase_prologue(Frame& F) {
    LAS float* scr = (LAS float*)(F.lds + RING_OFF + F.wave * 16384);
    const int gw = F.vcu * NWAVES + F.wave, NGW = F.G * NWAVES;
    constexpr int I_IN = 16 * 257, I_SQ = 16 * 32, I_PQ = 16 * 64, I_PLE = 4 * 32;
    constexpr int NITEMS = I_IN + 4 * I_SQ + I_PQ + I_PLE;
    for (int it = gw; it < NITEMS; it += NGW) {
        int r = it;
        if (r < I_IN) { p0_transpose_item(F.in[3], 1024, 8208, WSP(bf16_t, WS_WIN), RmWin(), scr, r, F.lane); continue; } r -= I_IN;
        if (r < I_SQ) { p0_transpose_item(F.in[7], 1024, 1024, WSP(bf16_t, WS_WGA), RmId(), scr, r, F.lane); continue; } r -= I_SQ;
        if (r < I_SQ) { p0_transpose_item(F.in[8], 1024, 1024, WSP(bf16_t, WS_WSB), RmId(), scr, r, F.lane); continue; } r -= I_SQ;
        if (r < I_SQ) { p0_transpose_item(F.in[9], 1024, 1024, WSP(bf16_t, WS_WO), RmId(), scr, r, F.lane); continue; } r -= I_SQ;
        if (r < I_SQ) { p0_transpose_item(F.in[17], 1024, 1024, WSP(bf16_t, WS_WPG), RmId(), scr, r, F.lane); continue; } r -= I_SQ;
        if (r < I_PQ) { p0_transpose_item(F.in[11], 1024, 2048, WSP(bf16_t, WS_WPQ), RmId(), scr, r, F.lane); continue; } r -= I_PQ;
        p0_transpose_item(F.in[18], 256, 1024, WSP(bf16_t, WS_WPLE), RmId(), scr, r, F.lane);
    }
    { const float* k1 = F.in[12]; const float* k2 = F.in[13]; bf16_t* KB = WSP(bf16_t, WS_KD);
      for (int i = F.vcu * 512 + F.tid; i < 2 * 8 * 128 * 16; i += F.G * 512) { const int half = i >> 14, rem = i & 16383, h = rem >> 11, r8 = rem & 2047;
          const float* s = (half ? k2 : k1) + (size_t)h * 16384 + (size_t)r8 * 8; const f32x4 a = *(const f32x4*)s, b = *(const f32x4*)(s + 4);
          u32x4 o; o.x = cvtpk(a[0], a[1]); o.y = cvtpk(a[2], a[3]); o.z = cvtpk(b[0], b[1]); o.w = cvtpk(b[2], b[3]);
          *(u32x4*)(KB + (size_t)(h * 2 + half) * 16384 + (size_t)r8 * 8) = o; } }
    for (int m = gw; m < T_TOK; m += 4 * NGW) {
        f32x4 v[4][4]; float s[4];
#pragma unroll
        for (int q = 0; q < 4; ++q) { const float* xr = F.in[0] + (size_t)(m + q * NGW) * 1024; s[q] = 0.f;
#pragma unroll
            for (int j = 0; j < 4; ++j) { v[q][j] = *((const f32x4*)xr + F.lane + 64 * j); s[q] += (v[q][j][0] * v[q][j][0] + v[q][j][1] * v[q][j][1]) + (v[q][j][2] * v[q][j][2] + v[q][j][3] * v[q][j][3]); } }
#pragma unroll
        for (int o = 1; o < 64; o <<= 1) {
#pragma unroll
            for (int q = 0; q < 4; ++q) s[q] += __shfl_xor(s[q], o); }
#pragma unroll
        for (int q = 0; q < 4; ++q) { const float rstd = __builtin_amdgcn_rsqf(s[q] * (1.f / 1024.f) + EPS); bf16_t* orow = WSP(bf16_t, WS_XN1) + (size_t)(m + q * NGW) * 1024;
#pragma unroll
            for (int j = 0; j < 4; ++j) { const f32x4 gv = *((const f32x4*)F.in[2] + F.lane + 64 * j); const f32x4 o = v[q][j] * rstd * gv;
                u32x2 wq; wq.x = cvtpk(o[0], o[1]); wq.y = cvtpk(o[2], o[3]); *((u32x2*)orow + F.lane + 64 * j) = wq; } }
    }
}

__device__ __forceinline__ void phase_gla_prep(Frame& F) {
    LAS float* alo = (LAS float*)(F.lds + RING_OFF);
    const bf16_t* XN1 = WSP(bf16_t, WS_XN1); const bf16_t* WGAT = WSP(bf16_t, WS_WIN) + (size_t)8192 * 1024;
    bf16_t* GKT = WSP(bf16_t, WS_GK); float* GLAG = WSP(float, WS_GLAG);
    const float* w_up = F.in[4]; const float* b_a = F.in[5];
    const int tid = F.tid, lane = F.lane, w = F.wave;
    for (int u = F.vcu; u < 256; u += F.G) {
        const size_t r0 = (size_t)u * 64;
        __syncthreads();
        const int kk = tid;
        bf16_t* krow = GKT + (size_t)kk * T_TOK + r0;
        u32x4 kq[8];
#pragma unroll
        for (int j = 0; j < 8; ++j) kq[j] = *(const u32x4*)(krow + 8 * j);
        {
            LAS float* part = alo + 1024;
            const bf16_t* bp = WGAT + (size_t)(lane & 15) * 1024 + 8 * (lane >> 4) + 128 * w;
            bf16x8 bq[4];
#pragma unroll
            for (int s = 0; s < 4; ++s) bq[s] = *(const bf16x8*)(bp + 32 * s);
#pragma unroll
            for (int rt = 0; rt < 4; ++rt) { f32x4 acc = (f32x4){0.f, 0.f, 0.f, 0.f};
                const bf16_t* ap = XN1 + (r0 + 16 * rt + (lane & 15)) * 1024 + 8 * (lane >> 4) + 128 * w;
#pragma unroll
                for (int s = 0; s < 4; ++s) { const bf16x8 a = *(const bf16x8*)(ap + 32 * s); acc = __builtin_amdgcn_mfma_f32_16x16x32_bf16(a, bq[s], acc, 0, 0, 0); }
#pragma unroll
                for (int r = 0; r < 4; ++r) part[w * 1024 + (16 * rt + 4 * (lane >> 4) + r) * 16 + (lane & 15)] = acc[r]; }
            __syncthreads();
#pragma unroll
            for (int q = 0; q < 2; ++q) { const int e = tid + 512 * q; float s = 0.f;
#pragma unroll
                for (int ww = 0; ww < 8; ++ww) s += part[ww * 1024 + e];
                alo[e] = s; }
        }
        float wv[16];
#pragma unroll
        for (int r = 0; r < 16; ++r) wv[r] = w_up[r * 512 + kk];
        const float bias = b_a[kk];
        __syncthreads();
        float suffix = 0.f;
#pragma unroll
        for (int i8 = 7; i8 >= 0; --i8) {
            const unsigned kw[4] = {kq[i8].x, kq[i8].y, kq[i8].z, kq[i8].w};
            float o[8];
#pragma unroll
            for (int j = 7; j >= 0; --j) { const int i = i8 * 8 + j;
                const f32x4 a0 = *(const LAS f32x4*)(alo + i * 16), a1 = *(const LAS f32x4*)(alo + i * 16 + 4), a2 = *(const LAS f32x4*)(alo + i * 16 + 8), a3 = *(const LAS f32x4*)(alo + i * 16 + 12);
                float x = bias;
                x += a0[0] * wv[0] + a0[1] * wv[1] + a0[2] * wv[2] + a0[3] * wv[3];
                x += a1[0] * wv[4] + a1[1] * wv[5] + a1[2] * wv[6] + a1[3] * wv[7];
                x += a2[0] * wv[8] + a2[1] * wv[9] + a2[2] * wv[10] + a2[3] * wv[11];
                x += a3[0] * wv[12] + a3[1] * wv[13] + a3[2] * wv[14] + a3[3] * wv[15];
                const float la = (fminf(x, 0.f) - __logf(1.0f + __expf(-fabsf(x)))) * (1.0f / 16.0f);
                const float kvv = (j & 1) ? bf_hi(kw[j >> 1]) : bf_lo(kw[j >> 1]);
                o[j] = kvv * __expf(suffix);
                suffix += la; }
            u32x4 pk; pk.x = cvtpk(o[0], o[1]); pk.y = cvtpk(o[2], o[3]); pk.z = cvtpk(o[4], o[5]); pk.w = cvtpk(o[6], o[7]);
            if (!F.dry) *(u32x4*)(krow + i8 * 8) = pk; }
        GLAG[(size_t)u * 512 + kk] = __expf(suffix);
    }
}
constexpr int GL_KD = 0, GL_Q = 32768, GL_G = 65536, GL_RED = 65536 + 1024;
__device__ __forceinline__ int gl_kd_off(int row, int chunk) { return row * 128 + ((chunk ^ ((row >> 1) & 7)) << 4); }
__device__ __forceinline__ int gl_q_off(int row, int chunk16) { return row * 256 + ((chunk16 ^ (row & 15)) << 4); }

struct GlaStage { u32x4 kd[2]; u32x4 q[2]; bf16x8 vt[4]; float g; };
__device__ __forceinline__ void gla_prefetch_vt(Frame& F, GlaStage& st, int b, int h, int c) {
    const int u = b * 64 + c; const size_t r0 = (size_t)u * 64; const int w = F.wave, lq = F.lane & 31, hh = F.lane >> 5;
    const bf16_t* vt = WSP(bf16_t, WS_GV) + (size_t)(h * 256 + 32 * w + lq) * T_TOK + r0;
#pragma unroll
    for (int ts = 0; ts < 4; ++ts) st.vt[ts] = *(const bf16x8*)(vt + 16 * ts + 8 * hh);
}
template <bool WITH_Q>
__device__ __forceinline__ void gla_prefetch(Frame& F, GlaStage& st, int b, int h, int c) {
    const int u = b * 64 + c; const size_t r0 = (size_t)u * 64; const int tid = F.tid;
    const bf16_t* kd = WSP(bf16_t, WS_GK) + (size_t)(h * 128) * T_TOK + r0;
#pragma unroll
    for (int j = 0; j < 2; ++j) { const int pi = tid + 512 * j; st.kd[j] = *(const u32x4*)(kd + (size_t)(pi >> 3) * T_TOK + (pi & 7) * 8); }
    if (WITH_Q) { const bf16_t* gq = WSP(bf16_t, WS_GQ) + r0 * 512 + h * 128;
#pragma unroll
        for (int j = 0; j < 2; ++j) { const int pi = tid + 512 * j; st.q[j] = *(const u32x4*)(gq + (size_t)(pi >> 4) * 512 + (pi & 15) * 8); } }
    st.g = (tid < 128) ? WSP(float, WS_GLAG)[((size_t)u * 4 + h) * 128 + tid] : 1.f;
}
template <bool WITH_Q>
__device__ __forceinline__ void gla_stage_write(Frame& F, const GlaStage& st, int buf) {
    LAS unsigned char* lds = F.lds + RING_OFF; const int tid = F.tid;
#pragma unroll
    for (int j = 0; j < 2; ++j) { const int pi = tid + 512 * j; *(LAS u32x4*)(lds + GL_KD + buf * 16384 + gl_kd_off(pi >> 3, pi & 7)) = st.kd[j]; }
    if (WITH_Q) {
#pragma unroll
        for (int j = 0; j < 2; ++j) { const int pi = tid + 512 * j; *(LAS u32x4*)(lds + GL_Q + buf * 16384 + gl_q_off(pi >> 4, pi & 15)) = st.q[j]; } }
    if (tid < 128) *(LAS float*)(lds + GL_G + buf * 512 + tid * 4) = st.g;
}
__device__ __forceinline__ void gla_update(Frame& F, f32x16 (&S)[4], const bf16x8 (&vt)[4], int buf) {
    const LAS unsigned char* lds = F.lds + RING_OFF; const int lq = F.lane & 31, hh = F.lane >> 5;
    const LAS float* G = (const LAS float*)(lds + GL_G + buf * 512);
#pragma unroll
    for (int kt = 0; kt < 4; ++kt)
#pragma unroll
        for (int g4 = 0; g4 < 4; ++g4) { const f32x4 g = *(const LAS f32x4*)(G + 32 * kt + 8 * g4 + 4 * hh);
#pragma unroll
            for (int j = 0; j < 4; ++j) S[kt][4 * g4 + j] *= g[j]; }
#pragma unroll
    for (int ts = 0; ts < 4; ++ts)
#pragma unroll
        for (int kt = 0; kt < 4; ++kt) { const bf16x8 a = *(const LAS bf16x8*)(lds + GL_KD + buf * 16384 + gl_kd_off(32 * kt + lq, 2 * ts + hh));
            S[kt] = __builtin_amdgcn_mfma_f32_32x32x16_bf16(a, vt[ts], S[kt], 0, 0, 0); if (kt == 3 && (ts & 1)) __builtin_amdgcn_sched_barrier(0); }
}
constexpr size_t SEND_WAVE_FLOATS = 4 * 4 * 64 * 4;
__device__ __forceinline__ void gla_stage1(Frame& F, int unit) {
    const int bh = unit >> 3, seg = unit & 7, b = bh >> 2, h = bh & 3, w = F.wave, l = F.lane;
    f32x16 S[4];
#pragma unroll
    for (int kt = 0; kt < 4; ++kt)
#pragma unroll
        for (int r = 0; r < 16; ++r) S[kt][r] = 0.f;
    float pend = 1.f;
    GlaStage st; gla_prefetch<false>(F, st, b, h, seg * 8); gla_prefetch_vt(F, st, b, h, seg * 8);
    for (int ci = 0; ci < 8; ++ci) {
        gla_stage_write<false>(F, st, ci & 1); pend *= st.g;
        __syncthreads();
        if (ci < 7) gla_prefetch<false>(F, st, b, h, seg * 8 + ci + 1);
        gla_update(F, S, st.vt, ci & 1);
        if (ci < 7) gla_prefetch_vt(F, st, b, h, seg * 8 + ci + 1);
    }
    float* se = WSP(float, WS_SEND) + ((size_t)unit * 8 + w) * SEND_WAVE_FLOATS;
#pragma unroll
    for (int kt = 0; kt < 4; ++kt)
#pragma unroll
        for (int g4 = 0; g4 < 4; ++g4) *(f32x4*)(se + ((kt * 4 + g4) * 64 + l) * 4) = (f32x4){S[kt][4 * g4], S[kt][4 * g4 + 1], S[kt][4 * g4 + 2], S[kt][4 * g4 + 3]};
    if (F.tid < 128) WSP(float, WS_PEND)[unit * 128 + F.tid] = pend;
    __syncthreads();
}
__device__ __forceinline__ void gla_stage3(Frame& F, int unit) {
    const int bh = unit >> 3, seg = unit & 7, b = bh >> 2, h = bh & 3, w = F.wave, l = F.lane, lq = l & 31, hh = l >> 5;
    LAS unsigned char* lds = F.lds + RING_OFF;
    const bf16_t* GR = WSP(bf16_t, WS_GR); bf16_t* GLAN = WSP(bf16_t, WS_GLAN); const float* g_o = F.in[6];
    f32x16 S[4];
#pragma unroll
    for (int kt = 0; kt < 4; ++kt)
#pragma unroll
        for (int r = 0; r < 16; ++r) S[kt][r] = 0.f;
    GlaStage st; gla_prefetch<true>(F, st, b, h, seg * 8); gla_prefetch_vt(F, st, b, h, seg * 8);
    for (int sp = 0; sp < seg; ++sp) {
        const int un = bh * 8 + sp; const float* se = WSP(float, WS_SEND) + ((size_t)un * 8 + w) * SEND_WAVE_FLOATS; const float* pe = WSP(float, WS_PEND) + un * 128;
#pragma unroll
        for (int kt = 0; kt < 4; ++kt)
#pragma unroll
            for (int g4 = 0; g4 < 4; ++g4) { const f32x4 p = *(const f32x4*)(pe + 32 * kt + 8 * g4 + 4 * hh); const f32x4 s = *(const f32x4*)(se + ((kt * 4 + g4) * 64 + l) * 4);
#pragma unroll
                for (int j = 0; j < 4; ++j) S[kt][4 * g4 + j] = S[kt][4 * g4 + j] * p[j] + s[j]; }
    }
    for (int ci = 0; ci < 8; ++ci) {
        const int c = seg * 8 + ci; const size_t r0 = (size_t)(b * 64 + c) * 64; const int buf = ci & 1;
        gla_stage_write<true>(F, st, buf);
        __syncthreads();
        if (ci < 7) gla_prefetch<true>(F, st, b, h, c + 1);
        gla_update(F, S, st.vt, buf);
        f32x16 oT[2];
#pragma unroll
        for (int tt = 0; tt < 2; ++tt) {
#pragma unroll
            for (int r = 0; r < 16; ++r) oT[tt][r] = 0.f;
            const int t = 32 * tt + lq;
#pragma unroll
            for (int kt = 0; kt < 4; ++kt)
#pragma unroll
                for (int s = 0; s < 2; ++s) {
                    u32x4 aw; aw.x = cvtpk(S[kt][8 * s + 0], S[kt][8 * s + 1]); aw.y = cvtpk(S[kt][8 * s + 2], S[kt][8 * s + 3]); aw.z = cvtpk(S[kt][8 * s + 4], S[kt][8 * s + 5]); aw.w = cvtpk(S[kt][8 * s + 6], S[kt][8 * s + 7]);
                    const u32x2 qlo = *(const LAS u32x2*)(lds + GL_Q + buf * 16384 + gl_q_off(t, 4 * kt + 2 * s) + 8 * hh), qhi = *(const LAS u32x2*)(lds + GL_Q + buf * 16384 + gl_q_off(t, 4 * kt + 2 * s + 1) + 8 * hh);
                    const u32x4 bw = (u32x4){qlo.x, qlo.y, qhi.x, qhi.y};
                    oT[tt] = __builtin_amdgcn_mfma_f32_32x32x16_bf16(__builtin_bit_cast(bf16x8, aw), __builtin_bit_cast(bf16x8, bw), oT[tt], 0, 0, 0);
                    if (s == 1 && (kt & 1)) __builtin_amdgcn_sched_barrier(0); }
        }
        LAS float* redc = (LAS float*)(lds + GL_RED) + buf * 512;
#pragma unroll
        for (int tt = 0; tt < 2; ++tt) { float s = 0.f;
#pragma unroll
            for (int r = 0; r < 16; ++r) s += oT[tt][r] * oT[tt][r];
            s += __shfl_xor(s, 32);
            if (hh == 0) redc[w * 64 + 32 * tt + lq] = s; }
        if (ci < 7) gla_prefetch_vt(F, st, b, h, c + 1);
        u32x2 sr[2][4];
#pragma unroll
        for (int tt = 0; tt < 2; ++tt)
#pragma unroll
            for (int g4 = 0; g4 < 4; ++g4) sr[tt][g4] = *(const u32x2*)(GR + (r0 + 32 * tt + lq) * 1024 + h * 256 + 32 * w + 8 * g4 + 4 * hh);
        __syncthreads();
#pragma unroll
        for (int tt = 0; tt < 2; ++tt) { float tot = 0.f;
#pragma unroll
            for (int ww = 0; ww < 8; ++ww) tot += redc[ww * 64 + 32 * tt + lq];
            const float rstd = __builtin_amdgcn_rsqf(tot * (1.0f / 256.0f) + EPS);
            const size_t row = r0 + 32 * tt + lq;
#pragma unroll
            for (int g4 = 0; g4 < 4; ++g4) { const int v0 = h * 256 + 32 * w + 8 * g4 + 4 * hh;
                const f32x4 go = *(const f32x4*)(g_o + v0);
                const float o0 = oT[tt][4 * g4 + 0] * rstd * go[0] * bf_lo(sr[tt][g4].x), o1 = oT[tt][4 * g4 + 1] * rstd * go[1] * bf_hi(sr[tt][g4].x);
                const float o2 = oT[tt][4 * g4 + 2] * rstd * go[2] * bf_lo(sr[tt][g4].y), o3 = oT[tt][4 * g4 + 3] * rstd * go[3] * bf_hi(sr[tt][g4].y);
                u32x2 wv; wv.x = cvtpk(o0, o1); wv.y = cvtpk(o2, o3); *(u32x2*)(GLAN + row * 1024 + v0) = wv; } }
    }
    __syncthreads();
}

constexpr int SB_TILE = 16384, SB_FLAG = 7 * SB_TILE;
typedef short v4i16_t __attribute__((ext_vector_type(4)));
__device__ __forceinline__ s16x4 vtr(const LAS unsigned char* p) { return __builtin_bit_cast(s16x4, __builtin_amdgcn_ds_read_tr16_b64_v4i16((LAS v4i16_t*)p)); }
__device__ __forceinline__ float partner32(float x, int hh) { auto rr = __builtin_amdgcn_permlane32_swap(__float_as_uint(x), __float_as_uint(x), false, false); return __uint_as_float(hh ? rr[0] : rr[1]); }
__device__ __forceinline__ int sbk_off(int key, int chunk) { return key * 128 + ((chunk ^ ((key >> 1) & 7)) << 4); }
__device__ __forceinline__ int sbv_off(int key, int chunk) { return 8192 + key * 128 + ((chunk ^ (((key >> 1) & 1) << 2)) << 4); }

template <bool DIAG>
__device__ __forceinline__ void sb_tile_t(const LAS unsigned char* tile, int kt, int qabs, int l, const bf16x8 (&qf)[4], f32x16& o0, f32x16& o1, float& carry) {
    const int lq = l & 31, hh = l >> 5, g1 = (l >> 4) & 1, i = l & 15;
    float run = carry;
#pragma unroll
    for (int half = 1; half >= 0; --half) {
        f32x16 p;
#pragma unroll
        for (int r = 0; r < 16; ++r) p[r] = 0.f;
#pragma unroll
        for (int s = 0; s < 4; ++s) { const bf16x8 a = *(const LAS bf16x8*)(tile + sbk_off(32 * half + lq, 2 * s + hh)); p = __builtin_amdgcn_mfma_f32_32x32x16_bf16(a, qf[s], p, 0, 0, 0); }
        float Lh[16];
#pragma unroll
        for (int r = 0; r < 16; ++r) { const float z = p[r];
            float L = fmaxf(z, 0.f) + __builtin_amdgcn_logf(1.0f + __builtin_amdgcn_exp2f(-fabsf(z)));
            if (DIAG) { const int key = 64 * kt + 32 * half + (r & 3) + 8 * (r >> 2) + 4 * hh; if (key >= qabs) L = 0.f; }
            Lh[r] = L; }
        float tot[4];
#pragma unroll
        for (int g4 = 0; g4 < 4; ++g4) { float* Lg = &Lh[4 * g4]; Lg[2] += Lg[3]; Lg[1] += Lg[2]; Lg[0] += Lg[1]; tot[g4] = Lg[0]; }
        float E[4];
#pragma unroll
        for (int m = 3; m >= 0; --m) { const float tp = partner32(tot[m], hh); E[m] = run + (hh ? 0.f : tp); run += tot[m] + tp; }
        u32x4 pw[2];
#pragma unroll
        for (int s = 0; s < 2; ++s) { float wv[8];
#pragma unroll
            for (int j = 0; j < 8; ++j) { const int r = 8 * s + j;
                float wgt = __builtin_amdgcn_exp2f(p[r] - (E[r >> 2] + Lh[r]));
                if (DIAG) { const int key = 64 * kt + 32 * half + (r & 3) + 8 * (r >> 2) + 4 * hh; if (key >= qabs) wgt = 0.f; }
                wv[j] = wgt; }
            pw[s] = (u32x4){cvtpk(wv[0], wv[1]), cvtpk(wv[2], wv[3]), cvtpk(wv[4], wv[5]), cvtpk(wv[6], wv[7])}; }
#pragma unroll
        for (int s = 0; s < 2; ++s) { const bf16x8 pb = __builtin_bit_cast(bf16x8, pw[s]);
            const int k0 = 32 * half + 16 * s + 4 * hh + (i >> 2), k1 = k0 + 8;
#pragma unroll
            for (int dt = 0; dt < 2; ++dt) { const int ch = 4 * dt + 2 * g1 + ((i & 3) >> 1);
                const s16x4 lo = vtr(tile + sbv_off(k0, ch) + 8 * (i & 1)), hi = vtr(tile + sbv_off(k1, ch) + 8 * (i & 1));
                const bf16x8 a = (bf16x8){lo[0], lo[1], lo[2], lo[3], hi[0], hi[1], hi[2], hi[3]};
                if (dt == 0) o0 = __builtin_amdgcn_mfma_f32_32x32x16_bf16(a, pb, o0, 0, 0, 0); else o1 = __builtin_amdgcn_mfma_f32_32x32x16_bf16(a, pb, o1, 0, 0, 0); } }
    }
    carry = run;
}
__device__ __forceinline__ void sb_tile(const LAS unsigned char* tile, int kt, int q0, int qabs, int l, const bf16x8 (&qf)[4], f32x16& o0, f32x16& o1, float& carry) {
    if (64 * kt + 63 >= q0) sb_tile_t<true>(tile, kt, qabs, l, qf, o0, o1, carry); else sb_tile_t<false>(tile, kt, qabs, l, qf, o0, o1, carry);
}
__device__ __forceinline__ void sb_attn_unit(Frame& F, int uidx) {
    const int bh = uidx >> 4, qb = uidx & 15, b = bh >> 4, h = bh & 15;
    LAS unsigned char* lds = F.lds + RING_OFF;
    volatile LAS unsigned* flags = (volatile LAS unsigned*)(lds + SB_FLAG);
    const int tid = F.tid, w = F.wave, l = F.lane, lq = l & 31, hh = l >> 5;
    bf16_t* SQ = WSP(bf16_t, WS_SQ); const bf16_t* SK = WSP(bf16_t, WS_SK); const bf16_t* SV = WSP(bf16_t, WS_SV);
    const size_t rowbase = (size_t)b * SEQ;
    const int q0 = qb * 256 + 32 * w, qabs = q0 + lq;
    const int kt_hi = qb * 4 + 3, kt_lo = (qb * 4 - 3) > 0 ? (qb * 4 - 3) : 0, nwin = kt_hi - kt_lo + 1;
    const int skey = tid >> 3, sch = tid & 7;
    const bf16_t* kgd = SK + (rowbase + skey) * 1024 + h * 64 + ((sch ^ ((skey >> 1) & 7)) * 8);
    const bf16_t* vgd = SV + (rowbase + skey) * 1024 + h * 64 + ((sch ^ (((skey >> 1) & 1) << 2)) * 8);
    __syncthreads();
#pragma unroll
    for (int j = 0; j < 7; ++j) if (j < nwin) {
        __builtin_amdgcn_global_load_lds((const unsigned*)(kgd + (size_t)(kt_lo + j) * 64 * 1024), (LAS unsigned*)(lds + j * SB_TILE + w * 1024), 16, 0, 0);
        __builtin_amdgcn_global_load_lds((const unsigned*)(vgd + (size_t)(kt_lo + j) * 64 * 1024), (LAS unsigned*)(lds + j * SB_TILE + 8192 + w * 1024), 16, 0, 0); }
    bf16x8 qf[4];
    { const bf16_t* qrow = SQ + (rowbase + qabs) * 1024 + h * 64;
#pragma unroll
      for (int s = 0; s < 4; ++s) qf[s] = *(const bf16x8*)(qrow + 16 * s + 8 * hh); }
    f32x16 o0, o1;
#pragma unroll
    for (int r = 0; r < 16; ++r) { o0[r] = 0.f; o1[r] = 0.f; }
    float carry = 0.f;
    VM_WAIT(); __syncthreads();
    bool done = false;
    for (int kt = (q0 + 30) >> 6; kt >= kt_lo; --kt) {
        sb_tile(lds + (kt - kt_lo) * SB_TILE, kt, q0, qabs, l, qf, o0, o1, carry);
        if (__all(carry > 150.0f)) { done = true; break; }
    }
    if (kt_lo == 0) done = true;
    if (l == 0) flags[w] = done ? 1u : 0u;
    __syncthreads();
    bool alld = true;
#pragma unroll
    for (int i = 0; i < 8; ++i) alld = alld && (flags[i] != 0u);
    if (!alld) {
        const bf16_t* kg = SK + (rowbase + skey) * 1024 + h * 64 + sch * 8;
        const bf16_t* vg = SV + (rowbase + skey) * 1024 + h * 64 + sch * 8;
        for (int kt = kt_lo - 1; kt >= 0; --kt) {
            const u32x4 kr = *(const u32x4*)(kg + (size_t)kt * 64 * 1024), vr = *(const u32x4*)(vg + (size_t)kt * 64 * 1024);
            __syncthreads();
            { unsigned a = 1u;
#pragma unroll
              for (int i = 0; i < 8; ++i) a &= flags[i];
              if (a) break; }
            *(LAS u32x4*)(lds + sbk_off(skey, sch)) = kr; *(LAS u32x4*)(lds + sbv_off(skey, sch)) = vr;
            __syncthreads();
            if (!done) { sb_tile(lds, kt, q0, qabs, l, qf, o0, o1, carry); if (__all(carry > 150.0f) || kt == 0) done = true; }
            if (l == 0) flags[w] = done ? 1u : 0u;
        }
    }
    if (!F.dry) { bf16_t* orow = SQ + (rowbase + qabs) * 1024 + h * 64;
#pragma unroll
      for (int g4 = 0; g4 < 4; ++g4) { u32x2 a, c2; a.x = cvtpk(o0[4 * g4], o0[4 * g4 + 1]); a.y = cvtpk(o0[4 * g4 + 2], o0[4 * g4 + 3]); c2.x = cvtpk(o1[4 * g4], o1[4 * g4 + 1]); c2.y = cvtpk(o1[4 * g4 + 2], o1[4 * g4 + 3]);
          *(u32x2*)(orow + 8 * g4 + 4 * hh) = a; *(u32x2*)(orow + 32 + 8 * g4 + 4 * hh) = c2; } }
}
__device__ __forceinline__ void sb_units_dyn(Frame& F, unsigned* ctr, int lo, int hi) {
    volatile LAS int* slot = (volatile LAS int*)(F.lds + MISC_OFF + 64);
    for (;;) {
        __syncthreads();
        if (F.tid == 0) *slot = lo + (int)__hip_atomic_fetch_add(ctr, 1u, __ATOMIC_RELAXED, __HIP_MEMORY_SCOPE_AGENT);
        __syncthreads();
        const int u = *slot;
        if (u >= hi) break;
        sb_attn_unit(F, u);
    }
}
__device__ __forceinline__ void phase_attn_a(Frame& F) {
    if (F.vcu < 128) gla_stage1(F, F.vcu);
    sb_units_dyn(F, (unsigned*)(F.ws + WS_CTL) + 64, 0, 384);
    __syncthreads();
}
__device__ __forceinline__ void phase_attn_b(Frame& F) {
    if (F.vcu < 128) gla_stage3(F, F.vcu);
    sb_units_dyn(F, (unsigned*)(F.ws + WS_CTL) + 128, 384, 1024);
    __syncthreads();
}
__device__ __forceinline__ int okey(float v, int tag, int mask) { int u = __float_as_int(v); u ^= (u >> 31) & 0x7fffffff; return (u & ~mask) | tag; }
__device__ __forceinline__ float okey_val(int key, int mask) { int u = key & ~mask; u ^= (u >> 31) & 0x7fffffff; return __int_as_float(u); }
#define INS16(Lst, xin) do { int _x = (xin); _Pragma("unroll") for (int _j = 0; _j < 16; ++_j) { const int _h = max(Lst[_j], _x); _x = min(Lst[_j], _x); Lst[_j] = _h; } } while (0)

#define CEX(a, b) do { const int _hi = max(a, b), _lo = min(a, b); a = _hi; b = _lo; } while (0)
#define BITONIC16(K) do { \
    _Pragma("unroll") for (int _i = 0; _i < 8; ++_i) CEX(K[_i], K[_i + 8]); \
    _Pragma("unroll") for (int _b = 0; _b < 16; _b += 8) _Pragma("unroll") for (int _i = 0; _i < 4; ++_i) CEX(K[_b + _i], K[_b + _i + 4]); \
    _Pragma("unroll") for (int _b = 0; _b < 16; _b += 4) _Pragma("unroll") for (int _i = 0; _i < 2; ++_i) CEX(K[_b + _i], K[_b + _i + 2]); \
    _Pragma("unroll") for (int _b = 0; _b < 16; _b += 2) CEX(K[_b], K[_b + 1]); } while (0)
__device__ __forceinline__ int swap32i(int x) { auto r = __builtin_amdgcn_permlane32_swap((unsigned)x, (unsigned)x, false, false); return (int)((__builtin_amdgcn_mbcnt_hi(~0u, __builtin_amdgcn_mbcnt_lo(~0u, 0u)) & 32) ? r[0] : r[1]); }

__device__ __forceinline__ void phase_peer_retrieve(Frame& F) {
    const bf16_t* Q = WSP(bf16_t, WS_Q); const bf16_t* KB = WSP(bf16_t, WS_KD); unsigned* EXPO = WSP(unsigned, WS_EXP);
    LAS unsigned char* idxb = F.lds + RING_OFF + F.wave * 2048;
    const int l = F.lane, lq = l & 31, hh = l >> 5;
    const int ntok_wg = T_TOK / F.G;
#pragma unroll 1
    for (int it = F.wave; it < (ntok_wg / 32) * 8; it += NWAVES) {
        const int tg = it >> 3, h = it & 7;
        const int t = F.vcu * ntok_wg + tg * 32 + lq;
        int XY[2][16];
#pragma unroll
        for (int half = 0; half < 2; ++half) {
            bf16x8 qf[8];
            { const bf16_t* qp = Q + (size_t)t * 2048 + h * 256 + half * 128 + 8 * hh;
#pragma unroll
              for (int s = 0; s < 8; ++s) qf[s] = *(const bf16x8*)(qp + 16 * s); }
            int L[16];
#pragma unroll
            for (int j = 0; j < 16; ++j) L[j] = INT_MIN;
            const bf16_t* kp = KB + (size_t)(h * 2 + half) * 16384 + (size_t)lq * 128 + 8 * hh;
#pragma unroll 1
            for (int tile = 0; tile < 4; ++tile) {
                f32x16 acc;
#pragma unroll
                for (int r = 0; r < 16; ++r) acc[r] = 0.f;
#pragma unroll
                for (int s = 0; s < 8; ++s) { const bf16x8 a = *(const bf16x8*)(kp + (size_t)tile * 32 * 128 + 16 * s); acc = __builtin_amdgcn_mfma_f32_32x32x16_bf16(a, qf[s], acc, 0, 0, 0); }
#pragma unroll
                for (int r = 0; r < 16; ++r) { const int key = 32 * tile + (r & 3) + 8 * (r >> 2) + 4 * hh; INS16(L, okey(acc[r], 127 - key, 127)); }
            }
#pragma unroll
            for (int k = 0; k < 8; ++k) { const int a = swap32i(L[15 - k]), b = swap32i(L[k]); L[k] = max(L[k], a); L[15 - k] = max(L[15 - k], b); }
            BITONIC16(L);
#pragma unroll
            for (int j = 0; j < 16; ++j) XY[half][j] = L[j];
        }
        { u32x4 pk[2];
#pragma unroll
          for (int half = 0; half < 2; ++half) { const int* L = XY[half];
            pk[half].x = (unsigned)(127 - (L[0] & 127)) | ((unsigned)(127 - (L[1] & 127)) << 8) | ((unsigned)(127 - (L[2] & 127)) << 16) | ((unsigned)(127 - (L[3] & 127)) << 24);
            pk[half].y = (unsigned)(127 - (L[4] & 127)) | ((unsigned)(127 - (L[5] & 127)) << 8) | ((unsigned)(127 - (L[6] & 127)) << 16) | ((unsigned)(127 - (L[7] & 127)) << 24);
            pk[half].z = (unsigned)(127 - (L[8] & 127)) | ((unsigned)(127 - (L[9] & 127)) << 8) | ((unsigned)(127 - (L[10] & 127)) << 16) | ((unsigned)(127 - (L[11] & 127)) << 24);
            pk[half].w = (unsigned)(127 - (L[12] & 127)) | ((unsigned)(127 - (L[13] & 127)) << 8) | ((unsigned)(127 - (L[14] & 127)) << 16) | ((unsigned)(127 - (L[15] & 127)) << 24); }
          *(LAS u32x4*)(idxb + l * 32) = pk[0]; *(LAS u32x4*)(idxb + l * 32 + 16) = pk[1]; }
        float X[16], Y[16];
#pragma unroll
        for (int j = 0; j < 16; ++j) { X[j] = okey_val(XY[0][j], 127); Y[j] = okey_val(XY[1][j], 127); }
        int M[16];
#pragma unroll
        for (int j = 0; j < 16; ++j) M[j] = INT_MIN;
#define CAND(i, j) do { const float sm = hh ? (X[j] + Y[i]) : (X[i] + Y[j]); const int pos = hh ? ((j) * 16 + (i)) : ((i) * 16 + (j)); int key = okey(sm, 255 - pos, 255); if ((i) == (j) && hh) key = INT_MIN; INS16(M, key); } while (0)
        CAND(0, 0); CAND(0, 1); CAND(0, 2); CAND(0, 3); CAND(0, 4); CAND(0, 5); CAND(0, 6); CAND(0, 7); CAND(0, 8); CAND(0, 9); CAND(0, 10); CAND(0, 11); CAND(0, 12); CAND(0, 13); CAND(0, 14); CAND(0, 15);
        CAND(1, 1); CAND(1, 2); CAND(1, 3); CAND(1, 4); CAND(1, 5); CAND(1, 6); CAND(1, 7);
        CAND(2, 2); CAND(2, 3); CAND(2, 4);
        CAND(3, 3);
#undef CAND
        int TK[16];
#pragma unroll
        for (int k = 0; k < 16; ++k) TK[k] = max(M[k], swap32i(M[15 - k]));
        float sv[16]; float mx = -INFINITY;
#pragma unroll
        for (int k = 0; k < 16; ++k) { sv[k] = okey_val(TK[k], 255); mx = fmaxf(mx, sv[k]); }
        float den = 0.f;
#pragma unroll
        for (int k = 0; k < 16; ++k) { sv[k] = __expf(sv[k] - mx); den += sv[k]; }
        const float rden = 1.0f / den;
        LDS_WAIT(); asm volatile("" ::: "memory");
        const LAS unsigned char* ib = idxb + l * 32;
        unsigned* dst = EXPO + (size_t)t * 128 + h * 16 + hh * 8;
        u32x4 o0, o1; unsigned ov[8];
#pragma unroll
        for (int k = 0; k < 8; ++k) { const int pos = 255 - (TK[k] & 255); const unsigned i1 = ib[pos >> 4], i2 = ib[16 + (pos & 15)];
            ov[k] = (__float_as_uint(sv[k] * rden) & ~0x3fffu) | (i1 * 128u + i2); }
        o0 = (u32x4){ov[0], ov[1], ov[2], ov[3]}; o1 = (u32x4){ov[4], ov[5], ov[6], ov[7]};
        *(u32x4*)dst = o0; *(u32x4*)(dst + 4) = o1;
        LDS_WAIT(); asm volatile("" ::: "memory");
    }
}

__device__ __forceinline__ void cvt_rows_fp8(Frame& F, const float* src, unsigned char* dst, float* rscale) {
    const int l = F.lane; const int gw = F.vcu * NWAVES + F.wave, NGW = F.G * NWAVES;
    for (int e = gw; e < 16384; e += NGW) {
        const f32x4* sp = (const f32x4*)(src + (size_t)e * 1024 + 16 * l);
        const f32x4 a = sp[0], b = sp[1], c = sp[2], d = sp[3];
        float m = fmaxf(fmaxf(fmaxf(fabsf(a[0]), fabsf(a[1])), fmaxf(fabsf(a[2]), fabsf(a[3]))), fmaxf(fmaxf(fabsf(b[0]), fabsf(b[1])), fmaxf(fabsf(b[2]), fabsf(b[3]))));
        m = fmaxf(m, fmaxf(fmaxf(fmaxf(fabsf(c[0]), fabsf(c[1])), fmaxf(fabsf(c[2]), fabsf(c[3]))), fmaxf(fmaxf(fabsf(d[0]), fabsf(d[1])), fmaxf(fabsf(d[2]), fabsf(d[3])))));
#pragma unroll
        for (int o = 1; o < 64; o <<= 1) m = fmaxf(m, __shfl_xor(m, o));
        const float t = 448.0f / fmaxf(m, 1e-30f); const float s = __uint_as_float(__float_as_uint(t) & 0x7f800000u);
        u32x4 w; int x;
        x = __builtin_amdgcn_cvt_pk_fp8_f32(a[0] * s, a[1] * s, 0, false); x = __builtin_amdgcn_cvt_pk_fp8_f32(a[2] * s, a[3] * s, x, true); w.x = (unsigned)x;
        x = __builtin_amdgcn_cvt_pk_fp8_f32(b[0] * s, b[1] * s, 0, false); x = __builtin_amdgcn_cvt_pk_fp8_f32(b[2] * s, b[3] * s, x, true); w.y = (unsigned)x;
        x = __builtin_amdgcn_cvt_pk_fp8_f32(c[0] * s, c[1] * s, 0, false); x = __builtin_amdgcn_cvt_pk_fp8_f32(c[2] * s, c[3] * s, x, true); w.z = (unsigned)x;
        x = __builtin_amdgcn_cvt_pk_fp8_f32(d[0] * s, d[1] * s, 0, false); x = __builtin_amdgcn_cvt_pk_fp8_f32(d[2] * s, d[3] * s, x, true); w.w = (unsigned)x;
        *(u32x4*)(dst + (size_t)e * 1024 + 16 * l) = w;
        if (l == 0) rscale[e] = 1.0f / s;
    }
}

__device__ __forceinline__ float gelu_tanh(float x) { const float y = 0.7978845608028654f * (x + 0.044715f * x * x * x); return x * __builtin_amdgcn_rcpf(1.0f + __expf(-2.0f * y)); }
#define FP8_UNPACK16(W, f) do { f32x2 _t; \
    _t = __builtin_amdgcn_cvt_pk_f32_fp8((int)(W).x, false); f[0] = _t[0]; f[1] = _t[1]; _t = __builtin_amdgcn_cvt_pk_f32_fp8((int)(W).x, true); f[2] = _t[0]; f[3] = _t[1]; \
    _t = __builtin_amdgcn_cvt_pk_f32_fp8((int)(W).y, false); f[4] = _t[0]; f[5] = _t[1]; _t = __builtin_amdgcn_cvt_pk_f32_fp8((int)(W).y, true); f[6] = _t[0]; f[7] = _t[1]; \
    _t = __builtin_amdgcn_cvt_pk_f32_fp8((int)(W).z, false); f[8] = _t[0]; f[9] = _t[1]; _t = __builtin_amdgcn_cvt_pk_f32_fp8((int)(W).z, true); f[10] = _t[0]; f[11] = _t[1]; \
    _t = __builtin_amdgcn_cvt_pk_f32_fp8((int)(W).w, false); f[12] = _t[0]; f[13] = _t[1]; _t = __builtin_amdgcn_cvt_pk_f32_fp8((int)(W).w, true); f[14] = _t[0]; f[15] = _t[1]; } while (0)
__device__ __forceinline__ float sum_swap32(float a, float b) { auto r = __builtin_amdgcn_permlane32_swap(__float_as_uint(a), __float_as_uint(b), false, false); return __uint_as_float(r[0]) + __uint_as_float(r[1]); }
__device__ __forceinline__ float sum_swap16(float a, float b) { auto r = __builtin_amdgcn_permlane16_swap(__float_as_uint(a), __float_as_uint(b), false, false); return __uint_as_float(r[0]) + __uint_as_float(r[1]); }
template <int M> __device__ __forceinline__ unsigned sxu(unsigned v, int lane) {
    if constexpr (M == 32) { auto r = __builtin_amdgcn_permlane32_swap(v, v, false, false); return (lane & 32) ? r[0] : r[1]; }
    else return (unsigned)__builtin_amdgcn_ds_swizzle((int)v, (M << 10) | 0x1f);
}
template <int M> __device__ __forceinline__ float sxf(float v, int lane) { return __uint_as_float(sxu<M>(__float_as_uint(v), lane)); }
__device__ __forceinline__ float wave_sum_sx(float v, int lane) { v += sxf<1>(v, lane); v += sxf<2>(v, lane); v += sxf<4>(v, lane); v += sxf<8>(v, lane); v += sxf<16>(v, lane); v += sxf<32>(v, lane); return v; }
#ifndef PG_TOK
#define PG_TOK 4
#endif
template <class Bar>
__device__ __forceinline__ void phase_peer_gather(Frame& F, const Bar& bar, bool use_bar) {
    const unsigned char* UB = WSP(unsigned char, WS_UB8); const unsigned char* VB = WSP(unsigned char, WS_VB8); const float* RSU = WSP(float, WS_RSU); const float* RSV = WSP(float, WS_RSV);
    const unsigned* EXPO = WSP(unsigned, WS_EXP);
    const bf16_t* H1G = WSP(bf16_t, WS_H1G); bf16_t* XN3 = WSP(bf16_t, WS_XN3); const float* H1 = WSP(float, WS_H1); float* H2 = F.out; const float* SSQ1 = WSP(float, WS_SSQ1); const float* g_ple = F.in[16];
    const int l = F.lane; const int ntok_wg = T_TOK / F.G;
#pragma unroll 1
    for (int ti = F.wave * PG_TOK; ti < ntok_wg; ti += NWAVES * PG_TOK) {
        if (use_bar && ti >= NWAVES * PG_TOK) xcd_barrier(bar, F.tid); else __syncthreads();
        float acc[PG_TOK][16];
        LAS unsigned* lent = (LAS unsigned*)(F.lds + RING_OFF + F.wave * (2048 * PG_TOK)); LAS float* lcu = (LAS float*)(lent + 128 * PG_TOK); LAS float* lcv = lcu + 128 * PG_TOK; LAS float* acl = lcv + 128 * PG_TOK;
        LAS unsigned* lx = (LAS unsigned*)(F.lds + RING_OFF + NWAVES * 2048 * PG_TOK + F.wave * (2048 * PG_TOK));
#pragma unroll
        for (int tk = 0; tk < PG_TOK; ++tk) { const int t = F.vcu * ntok_wg + ti + tk;
            const u32x4 xa = *(const u32x4*)(H1G + (size_t)t * 1024 + 16 * l), xb = *(const u32x4*)(H1G + (size_t)t * 1024 + 16 * l + 8);
            *(LAS u32x4*)(lx + tk * 512 + l * 8) = xa; *(LAS u32x4*)(lx + tk * 512 + l * 8 + 4) = xb;
#pragma unroll
            for (int i = 0; i < 16; ++i) acc[tk][i] = 0.f; }
#pragma unroll 1
        for (int tk = 0; tk < PG_TOK; ++tk) { const int t = F.vcu * ntok_wg + ti + tk;
            const f32x4* sp = (const f32x4*)(SSQ1 + (size_t)t * 16); const f32x4 st = (sp[0] + sp[1]) + (sp[2] + sp[3]); const float rstd1 = __builtin_amdgcn_rsqf(((st[0] + st[1]) + (st[2] + st[3])) * (1.0f / 1024.0f) + EPS);
            unsigned a0 = EXPO[(size_t)t * 128 + l], a1 = EXPO[(size_t)t * 128 + 64 + l];
            { unsigned s0 = (a0 << 18) | (a0 >> 14), s1 = (a1 << 18) | (a1 >> 14);
              int ls = l; asm volatile("" : "+v"(ls));
#define BSTEP(K, J) do { const bool up = (ls & (J)) != 0; const unsigned p0 = sxu<J>(s0, ls), p1 = sxu<J>(s1, ls); \
                  const bool asc0 = (ls & (K)) == 0, asc1 = ((ls + 64) & (K)) == 0; \
                  s0 = (up == asc0) ? max(s0, p0) : min(s0, p0); s1 = (up == asc1) ? max(s1, p1) : min(s1, p1); } while (0)
              BSTEP(2, 1);
              BSTEP(4, 2); BSTEP(4, 1);
              BSTEP(8, 4); BSTEP(8, 2); BSTEP(8, 1);
              BSTEP(16, 8); BSTEP(16, 4); BSTEP(16, 2); BSTEP(16, 1);
              BSTEP(32, 16); BSTEP(32, 8); BSTEP(32, 4); BSTEP(32, 2); BSTEP(32, 1);
              BSTEP(64, 32); BSTEP(64, 16); BSTEP(64, 8); BSTEP(64, 4); BSTEP(64, 2); BSTEP(64, 1);
              { const unsigned lo = min(s0, s1), hi = max(s0, s1); s0 = lo; s1 = hi; }
              BSTEP(128, 32); BSTEP(128, 16); BSTEP(128, 8); BSTEP(128, 4); BSTEP(128, 2); BSTEP(128, 1);
#undef BSTEP
              a0 = (s0 >> 18) | (s0 << 14); a1 = (s1 >> 18) | (s1 << 14); }
            lent[tk * 128 + l] = a0; lent[tk * 128 + 64 + l] = a1;
            lcu[tk * 128 + l] = RSU[a0 & 0x3fffu] * rstd1; lcu[tk * 128 + 64 + l] = RSU[a1 & 0x3fffu] * rstd1;
            lcv[tk * 128 + l] = RSV[a0 & 0x3fffu] * __uint_as_float(a0 & ~0x3fffu); lcv[tk * 128 + 64 + l] = RSV[a1 & 0x3fffu] * __uint_as_float(a1 & ~0x3fffu); }
        LDS_WAIT(); asm volatile("" ::: "memory");
        u32x4 buf0[8], buf1[8];
#define ROWS8(BUF, TAB, tk, eb) do { const u32x4 ea_ = *(const LAS u32x4*)(lent + (tk) * 128 + (eb)), eb_ = *(const LAS u32x4*)(lent + (tk) * 128 + (eb) + 4); \
            const unsigned en_[8] = {ea_.x, ea_.y, ea_.z, ea_.w, eb_.x, eb_.y, eb_.z, eb_.w}; \
            _Pragma("unroll") for (int k = 0; k < 8; ++k) BUF[k] = *(const u32x4*)((TAB) + ((en_[k] & 0x3fffu) * 1024u + 16u * (unsigned)l)); } while (0)
#define U8(BUF, tk, eb) do { float p[8]; const u32x4 xa_ = *(const LAS u32x4*)(lx + (tk) * 512 + l * 8), xb_ = *(const LAS u32x4*)(lx + (tk) * 512 + l * 8 + 4); \
            const unsigned xq[8] = {xa_.x, xa_.y, xa_.z, xa_.w, xb_.x, xb_.y, xb_.z, xb_.w}; \
            _Pragma("unroll") for (int k = 0; k < 8; ++k) { float f[16]; FP8_UNPACK16(BUF[k], f); float s = 0.f; \
                _Pragma("unroll") for (int i = 0; i < 8; ++i) s = __builtin_amdgcn_fdot2_f32_bf16(__builtin_bit_cast(bf16x2_t, cvtpk(f[2 * i], f[2 * i + 1])), __builtin_bit_cast(bf16x2_t, xq[i]), s, false); \
                p[k] = s; if (k & 1) __builtin_amdgcn_sched_barrier(0); } \
            float q4[4], q2[2], q1; \
            _Pragma("unroll") for (int j = 0; j < 4; ++j) q4[j] = sum_swap32(p[j], p[4 + j]); \
            _Pragma("unroll") for (int j = 0; j < 2; ++j) q2[j] = sum_swap16(q4[j], q4[2 + j]); \
            { const bool up = (l & 8) != 0; const float keep = up ? q2[1] : q2[0], send = up ? q2[0] : q2[1]; q1 = keep + sxf<8>(send, l); } \
            q1 += sxf<4>(q1, l); q1 += sxf<2>(q1, l); q1 += sxf<1>(q1, l); \
            const float cu = lcu[(tk) * 128 + (eb) + (l >> 3)], cv = lcv[(tk) * 128 + (eb) + (l >> 3)]; \
            const float a_ = gelu_tanh(q1 * cu) * cv; if ((l & 7) == 0) acl[(tk) * 128 + (eb) + (l >> 3)] = a_; __builtin_amdgcn_sched_barrier(0); } while (0)
#define V8(BUF, tk, eb) do { const float av = acl[(tk) * 128 + (eb) + (l & 7)]; \
            _Pragma("unroll") for (int k = 0; k < 8; ++k) { const float ak = __uint_as_float(__builtin_amdgcn_readlane(__float_as_uint(av), k)); float f[16]; FP8_UNPACK16(BUF[k], f); \
                _Pragma("unroll") for (int i = 0; i < 16; ++i) acc[tk][i] += ak * f[i]; if (k & 1) __builtin_amdgcn_sched_barrier(0); } } while (0)
        ROWS8(buf0, UB, 0, 0);
#if PG_TOK == 4
#pragma unroll 1
        for (int eb = 0; eb < 128; eb += 8) {
            ROWS8(buf1, UB, 1, eb); U8(buf0, 0, eb);
            ROWS8(buf0, UB, 2, eb); U8(buf1, 1, eb);
            ROWS8(buf1, UB, 3, eb); U8(buf0, 2, eb);
            if (eb + 8 < 128) ROWS8(buf0, UB, 0, eb + 8); else ROWS8(buf0, VB, 0, 0);
            U8(buf1, 3, eb);
        }
        LDS_WAIT(); asm volatile("" ::: "memory");
#pragma unroll 1
        for (int eb = 0; eb < 128; eb += 8) {
            ROWS8(buf1, VB, 1, eb); V8(buf0, 0, eb);
            ROWS8(buf0, VB, 2, eb); V8(buf1, 1, eb);
            ROWS8(buf1, VB, 3, eb); V8(buf0, 2, eb);
            if (eb + 8 < 128) ROWS8(buf0, VB, 0, eb + 8);
            V8(buf1, 3, eb);
        }
#elif PG_TOK == 2
#pragma unroll 1
        for (int eb = 0; eb < 128; eb += 8) {
            ROWS8(buf1, UB, 1, eb); U8(buf0, 0, eb);
            if (eb + 8 < 128) ROWS8(buf0, UB, 0, eb + 8); else ROWS8(buf0, VB, 0, 0);
            U8(buf1, 1, eb);
        }
        LDS_WAIT(); asm volatile("" ::: "memory");
#pragma unroll 1
        for (int eb = 0; eb < 128; eb += 8) {
            ROWS8(buf1, VB, 1, eb); V8(buf0, 0, eb);
            if (eb + 8 < 128) ROWS8(buf0, VB, 0, eb + 8);
            V8(buf1, 1, eb);
        }
#else
#error PG_TOK must be 2 or 4
#endif
#undef ROWS8
#undef U8
#undef V8
#pragma unroll
        for (int tk = 0; tk < PG_TOK; ++tk) { const int t = F.vcu * ntok_wg + ti + tk;
            const float* hrow = H1 + (size_t)t * 1024 + 16 * l; float* h2row = H2 + (size_t)t * 1024 + 16 * l; float ss = 0.f; f32x4 h[4];
#pragma unroll
            for (int q = 0; q < 4; ++q) { h[q] = *(const f32x4*)(hrow + 4 * q);
#pragma unroll
                for (int j = 0; j < 4; ++j) { h[q][j] += acc[tk][4 * q + j]; ss += h[q][j] * h[q][j]; }
                *(f32x4*)(h2row + 4 * q) = h[q]; }
            const float rstd3 = __builtin_amdgcn_rsqf(wave_sum_sx(ss, l) * (1.0f / 1024.0f) + EPS);
            u32x4 o[2];
#pragma unroll
            for (int q2 = 0; q2 < 2; ++q2) { const f32x4 g0 = *(const f32x4*)(g_ple + 16 * l + 8 * q2), g1 = *(const f32x4*)(g_ple + 16 * l + 8 * q2 + 4);
                const f32x4 a = h[2 * q2] * rstd3 * g0, c = h[2 * q2 + 1] * rstd3 * g1;
                o[q2].x = cvtpk(a[0], a[1]); o[q2].y = cvtpk(a[2], a[3]); o[q2].z = cvtpk(c[0], c[1]); o[q2].w = cvtpk(c[2], c[3]); }
            *(u32x4*)(XN3 + (size_t)t * 1024 + 16 * l) = o[0]; *(u32x4*)(XN3 + (size_t)t * 1024 + 16 * l + 8) = o[1]; }
    }
}

__device__ __forceinline__ void phase_final(Frame& F) {
    const float* SSQ3 = WSP(float, WS_SSQ3); const float* g = F.in[19];
    const int l = F.lane; const int gw = F.vcu * NWAVES + F.wave, NGW = F.G * NWAVES;
    for (int t = gw; t < T_TOK; t += NGW) {
        const f32x4* sp = (const f32x4*)(SSQ3 + (size_t)t * 16); const f32x4 st = (sp[0] + sp[1]) + (sp[2] + sp[3]);
        const float rstd = __builtin_amdgcn_rsqf(((st[0] + st[1]) + (st[2] + st[3])) * (1.0f / 1024.0f) + EPS);
        f32x4* row = (f32x4*)(F.out + (size_t)t * 1024);
#pragma unroll
        for (int j = 0; j < 4; ++j) { const f32x4 gv = *((const f32x4*)g + l + 64 * j); const f32x4 o = row[l + 64 * j] * rstd * gv; if (!F.dry) row[l + 64 * j] = o; }
    }
}
#ifndef MK_FUSED
#define MK_FUSED 1
#endif
constexpr int NPHASE = 11;
struct Args { const float* in[20]; float* out; unsigned char* ws; int ph_lo, ph_hi, dry, pad; };
static_assert(sizeof(Args) == 20 * 8 + 8 + 8 + 4 * 4, "Args has no padding");

__global__ void __launch_bounds__(NWAVES * 64, 2) mk_fwd(Args args) {
    extern __shared__ __attribute__((aligned(16))) unsigned char lds_raw[];
    Frame F;
    F.lds = (LAS unsigned char*)lds_raw;
    F.wave = __builtin_amdgcn_readfirstlane(threadIdx.x >> 6); F.lane = lane_id(); F.tid = F.wave * 64 + F.lane;
    F.G = gridDim.x; { const int bx = blockIdx.x; F.vcu = (F.G % 8 == 0) ? (bx % 8) * (F.G / 8) + bx / 8 : bx; }
    F.in = args.in; F.out = args.out; F.ws = args.ws; F.dry = args.dry;
    volatile LAS unsigned* MISC = (volatile LAS unsigned*)(F.lds + MISC_OFF);
    if (F.tid < 64) MISC[F.tid] = 0u;
    __syncthreads();
    const int lo = args.ph_lo, hi = args.ph_hi;
    XcdBarrier bar; bar.bar = (unsigned*)(F.ws + WS_CTL) + CW_BAR; bar.x = 0; bar.st = nullptr;
    if (hi - lo > 1) bar = xcd_barrier_post((unsigned*)(F.ws + WS_CTL) + CW_BAR, MISC + 8, F.tid);
#ifndef PH_MASK
#define PH_MASK 0xFFFFFFFFu
#endif
#define IN(k) (((PH_MASK >> (k)) & 1u) && lo <= (k) && (k) < hi)
#define LAUNDER(p, T) do { unsigned _lo = (unsigned)(unsigned long long)(p), _hi = (unsigned)((unsigned long long)(p) >> 32); asm volatile("" : "+v"(_lo), "+v"(_hi)); \
        _lo = __builtin_amdgcn_readfirstlane(_lo); _hi = __builtin_amdgcn_readfirstlane(_hi); (p) = (T)(((unsigned long long)_hi << 32) | _lo); } while (0)
#define SEAM(k) do { if (IN(k) && IN((k) + 1)) xcd_barrier(bar, F.tid); LAUNDER(F.ws, unsigned char*); LAUNDER(F.out, float*); F.lane = lane_id(); F.tid = F.wave * 64 + F.lane; } while (0)
    const int bx = (int)blockIdx.x;
    LAS unsigned char* ring = F.lds + RING_OFF;

    if (IN(0)) { phase_prologue(F); } SEAM(0);
    if (IN(1)) {
        pg8::Gemm g{WSP(bf16_t, WS_XN1), WSP(bf16_t, WS_WIN), T_TOK, 8192, 1024, 1024, 0, 2, 8}; pg8::StaticOrder S; S.init(T_TOK, 8192, F.G, bx);
        pg8::EpiProj E{WSP(bf16_t, WS_GQ), WSP(bf16_t, WS_GK), WSP(bf16_t, WS_GV), WSP(bf16_t, WS_GR), WSP(bf16_t, WS_SQ), WSP(bf16_t, WS_SK), WSP(bf16_t, WS_SV),
                       (bf16_t*)F.out, (bf16_t*)F.out + (size_t)T_TOK * 1024};
        pg8::gemm_phase<pg8::EpiProj>(ring, g, S, E, F.tid);
    } SEAM(1);
    if (IN(2)) { phase_gla_prep(F); } SEAM(2);
    if (IN(3)) { phase_attn_a(F); } SEAM(3);
    if (IN(4)) { phase_attn_b(F); } SEAM(4);
    if (IN(5)) {
        cvt_rows_fp8(F, F.in[14], WSP(unsigned char, WS_UB8), WSP(float, WS_RSU));
        cvt_rows_fp8(F, F.in[15], WSP(unsigned char, WS_VB8), WSP(float, WS_RSV));
        VM_WAIT(); __syncthreads();
        pg8::StaticOrder S; S.init(T_TOK, 1024, F.G, bx);
        { pg8::Gemm g{WSP(bf16_t, WS_GLAN), WSP(bf16_t, WS_WGA), T_TOK, 1024, 1024, 1024, 0, 0, 0}; pg8::EpiMix<true> E{(const bf16_t*)F.out, WSP(bf16_t, WS_MIX)};
          pg8::gemm_phase<pg8::EpiMix<true>>(ring, g, S, E, F.tid); }
        { pg8::Gemm g{WSP(bf16_t, WS_SQ), WSP(bf16_t, WS_WSB), T_TOK, 1024, 1024, 1024, 0, 0, 0}; pg8::EpiMix<false> E{(const bf16_t*)F.out + (size_t)T_TOK * 1024, WSP(bf16_t, WS_MIX)};
          pg8::gemm_phase<pg8::EpiMix<false>>(ring, g, S, E, F.tid); }
    } SEAM(5);
    if (IN(6)) {
        pg8::Gemm g{WSP(bf16_t, WS_MIX), WSP(bf16_t, WS_WO), T_TOK, 1024, 1024, 1024, 0, 0, 0}; pg8::StaticOrder S; S.init(T_TOK, 1024, F.G, bx);
        pg8::EpiH1 E{F.in[0], F.in[10], WSP(float, WS_H1), WSP(bf16_t, WS_H1G), WSP(float, WS_SSQ1)};
        pg8::gemm_phase<pg8::EpiH1>(ring, g, S, E, F.tid);
    } SEAM(6);
    if (IN(7)) {
        pg8::Gemm g{WSP(bf16_t, WS_H1G), WSP(bf16_t, WS_WPQ), T_TOK, 2048, 1024, 1024, 0, 0, 0}; pg8::StaticOrder S; S.init(T_TOK, 2048, F.G, bx);
        pg8::EpiQ E{WSP(float, WS_SSQ1), WSP(bf16_t, WS_Q), 2048};
        pg8::gemm_phase<pg8::EpiQ>(ring, g, S, E, F.tid);
    } SEAM(7);
    if (IN(8)) {
        cvt_copy(F, F.in[1], WSP(bf16_t, WS_PB), (size_t)T_TOK * 256);
        phase_peer_retrieve(F);
        VM_WAIT(); __syncthreads();
        phase_peer_gather(F, bar, false);
    } SEAM(8);
    if (IN(9)) {
        pg8::StaticOrder S; S.init(T_TOK, 1024, F.G, bx);
        { pg8::Gemm g{WSP(bf16_t, WS_PB), WSP(bf16_t, WS_WPLE), T_TOK, 1024, 256, 256, 0, 0, 0}; pg8::EpiBf E{WSP(bf16_t, WS_PLE), 1024};
          pg8::gemm_phase<pg8::EpiBf>(ring, g, S, E, F.tid); }
        { pg8::Gemm g{WSP(bf16_t, WS_XN3), WSP(bf16_t, WS_WPG), T_TOK, 1024, 1024, 1024, 0, 0, 0}; pg8::EpiH3 E{F.out, WSP(bf16_t, WS_PLE), F.out, WSP(float, WS_SSQ3), F.dry};
          pg8::gemm_phase<pg8::EpiH3>(ring, g, S, E, F.tid); }
    } SEAM(9);
    if (IN(10)) { phase_final(F); }
#undef IN
#undef SEAM
}

extern "C" void kernel_launch(void* const* d_in, const int* in_sizes, int n_in, void* d_out, int out_size, void* d_ws, size_t ws_size, hipStream_t stream) {
    static int grid = 0;
    if (grid == 0) {
        if (n_in != 20 || in_sizes[0] != T_TOK * 1024 || out_size != T_TOK * 1024 || ws_size < WS_END) {
            fprintf(stderr, "kernel_launch: unexpected shapes (n_in %d, in0 %d, out %d, ws %zu < %zu?); nothing launched\n", n_in, n_in > 0 ? in_sizes[0] : -1, out_size, ws_size, (size_t)WS_END); grid = -1; return; }
        int dev = 0, cus = 0, per_cu = 0;
        if (hipGetDevice(&dev) != hipSuccess || hipDeviceGetAttribute(&cus, hipDeviceAttributeMultiprocessorCount, dev) != hipSuccess) { grid = -1; return; }
        if (hipFuncSetAttribute((const void*)mk_fwd, hipFuncAttributeMaxDynamicSharedMemorySize, LDS_BYTES) != hipSuccess) { fprintf(stderr, "kernel_launch: hipFuncSetAttribute failed\n"); grid = -1; return; }
        if (hipOccupancyMaxActiveBlocksPerMultiprocessor(&per_cu, (const void*)mk_fwd, NWAVES * 64, LDS_BYTES) != hipSuccess || per_cu < 1)
            fprintf(stderr, "kernel_launch: note: occupancy query reports %d workgroups per CU\n", per_cu);
        (void)hipGetLastError();
        grid = cus;
        if (grid != 256) fprintf(stderr, "kernel_launch: note: %d CUs (kernel tuned for 256)\n", grid);
    }
    if (grid < 0) return;
    if (hipMemsetAsync((char*)d_ws + WS_CTL, 0, CTL_ZERO_BYTES, stream) != hipSuccess) { fprintf(stderr, "kernel_launch: hipMemsetAsync failed\n"); return; }
    Args a{};
    for (int i = 0; i < 20; ++i) a.in[i] = (const float*)d_in[i];
    a.out = (float*)d_out; a.ws = (unsigned char*)d_ws;
#if MK_FUSED
    a.ph_lo = 0; a.ph_hi = NPHASE;
    hipLaunchKernelGGL(mk_fwd, dim3(grid), dim3(NWAVES * 64), LDS_BYTES, stream, a);
#else
#ifndef PROBE_PHASE
#define PROBE_PHASE -1
#define PROBE_REPS 0
#endif
    for (int p = 0; p < NPHASE; ++p) { a.ph_lo = p; a.ph_hi = p + 1;
        if (p == PROBE_PHASE) { a.dry = 1; for (int r = 0; r < PROBE_REPS; ++r) hipLaunchKernelGGL(mk_fwd, dim3(grid), dim3(NWAVES * 64), LDS_BYTES, stream, a); a.dry = 0; }
        hipLaunchKernelGGL(mk_fwd, dim3(grid), dim3(NWAVES * 64), LDS_BYTES, stream, a); }
#endif
}
```

```cpp
#define MK_FUSED 1
#define PG_TOK 4
#include <hip/hip_runtime.h>
#include <cstdio>
#include <cstdint>

#define LAS __attribute__((address_space(3)))
#define GAS __attribute__((address_space(1)))
typedef unsigned short bf16_t;
typedef short bf16x8 __attribute__((ext_vector_type(8)));
typedef short s16x4 __attribute__((ext_vector_type(4)));
typedef float f32x2 __attribute__((ext_vector_type(2)));
typedef float f32x4 __attribute__((ext_vector_type(4)));
typedef float f32x16 __attribute__((ext_vector_type(16)));
typedef unsigned u32x2 __attribute__((ext_vector_type(2)));
typedef unsigned u32x4 __attribute__((ext_vector_type(4)));
typedef __bf16 bf16x2_t __attribute__((ext_vector_type(2)));

__device__ __forceinline__ unsigned cvtpk(float lo, float hi) { f32x2 v = {lo, hi}; bf16x2_t b = __builtin_convertvector(v, bf16x2_t); return __builtin_bit_cast(unsigned, b); }
__device__ __forceinline__ float bf_lo(unsigned u) { return __uint_as_float(u << 16); }
__device__ __forceinline__ float bf_hi(unsigned u) { return __uint_as_float(u & 0xffff0000u); }
__device__ __forceinline__ float bf1(bf16_t u) { return __uint_as_float(((unsigned)u) << 16); }
__device__ __forceinline__ float fast_sigmoid(float x) { return __builtin_amdgcn_rcpf(1.0f + __expf(-x)); }

namespace pg8 {
constexpr int BM = 256, BK = 64, HALF = 128, HTB = HALF * BK * 2  , STAGE_BYTES = 8 * HTB, NXCD = 8, WGM = 8;

__host__ __device__ __forceinline__ int lds_byte(int r, int c) { const int st = (r >> 4) * 2 + (c >> 5), rr = r & 15, cc = c & 31, ob = rr * 64 + cc * 2; return st * 1024 + (ob ^ (((ob >> 9) & 1) << 5)); }
__host__ __device__ __forceinline__ void stage_rc(int b, int& R, int& C) { const int st = b / 1024, sb = b % 1024, swz = sb ^ (((sb >> 9) & 1) << 5); R = (st >> 1) * 16 + swz / 64; C = (st & 1) * 32 + (swz % 64) / 2; }
__host__ __device__ __forceinline__ int perm32(int rho) { const int n = rho >> 4, i = rho & 15; return 8 * (i >> 2) + 4 * n + (i & 3); }

struct Unit { int pm, pn; };
struct Gemm { const bf16_t* A; const bf16_t* Bt; int M, N, K, lda, a_pn_cols; int swap_lo, swap_hi; };

struct StaticOrder {
    int nM, nN, nwg, G, c;
    __host__ __device__ void init(int M, int N, int G_, int c_) { nM = M / BM; nN = N / BM; nwg = nM * nN; G = G_; c = c_; }
    __host__ __device__ bool next(int i, Unit& u) const {
        const long L = (long)i * G + c; if (L >= nwg) return false;
        int wgid = (int)L; { const int q = nwg / NXCD, r = nwg % NXCD, xcd = wgid % NXCD, off = wgid / NXCD; wgid = (xcd < r ? xcd * (q + 1) : r * (q + 1) + (xcd - r) * q) + off; }
        const int nig = WGM * nN, gid = wgid / nig, fm = gid * WGM, gsz = (nM - fm) < WGM ? (nM - fm) : WGM;
        u.pm = fm + ((wgid % nig) % gsz); u.pn = (wgid % nig) / gsz; return true;
    }
};

template <class Epi, bool ALIGN_EPI = true, bool SP2 = true>
__device__ __forceinline__ void gemm_phase(LAS unsigned char* lds, const Gemm g, const StaticOrder& S, const Epi& E, int tid) {
    const int wid = __builtin_amdgcn_readfirstlane(tid >> 6), lane = tid & 63, wr = wid >> 2, wc = wid & 3, fr = lane & 15, fq = lane >> 4;
    const int K = g.K, nt = K / BK, lda = g.lda;
    unsigned voffA[2], voffB[2];
#pragma unroll
    for (int i = 0; i < 2; ++i) { int R, C; stage_rc(tid * 16 + i * 8192, R, C); const int Rb = Epi::PERM ? ((R & ~31) + perm32(R & 31)) : R;
        voffA[i] = (unsigned)(R * lda + C) * 2u; voffB[i] = (unsigned)(Rb * K + C) * 2u; }
    const size_t kstep = (size_t)(BK * 2);
    const size_t hA = (size_t)HALF * lda * 2, hB = (size_t)HALF * K * 2;
    const size_t tA = 2 * hA, tB = 2 * hB;
    const size_t pnA = (size_t)g.a_pn_cols * 2;
    const unsigned ldsw = (unsigned)wid * 1024u;
    const int aoff = lds_byte(wr * 64 + fr, fq * 8), boff = lds_byte(wc * 32 + fr, fq * 8);
#define PG8_SA(b, h) (((b) * 2 + (h)) * HTB)
#define PG8_SB(b, h) ((4 + (b) * 2 + (h)) * HTB)
#define PG8_STAGE(bufoff, gbase, voff) do { _Pragma("unroll") for (int _i = 0; _i < 2; ++_i) \
        __builtin_amdgcn_global_load_lds((const unsigned*)((const char*)(gbase) + (voff)[_i]), (LAS unsigned*)(lds + (bufoff) + ldsw + _i * 8192), 16, 0, 0); } while (0)
#define PG8_LDA(dst, b, h) do { _Pragma("unroll") for (int m = 0; m < 4; ++m) _Pragma("unroll") for (int k = 0; k < 2; ++k) dst[m][k] = *(const LAS bf16x8*)(lds + PG8_SA(b, h) + aoff + m * 2048 + k * 1024); } while (0)
#define PG8_LDB(dst, b, h) do { _Pragma("unroll") for (int n = 0; n < 2; ++n) _Pragma("unroll") for (int k = 0; k < 2; ++k) dst[n][k] = *(const LAS bf16x8*)(lds + PG8_SB(b, h) + boff + n * 2048 + k * 1024); } while (0)
#define PG8_MMA(ai, bj, At, Bt) do { __builtin_amdgcn_s_setprio(1); _Pragma("unroll") for (int m = 0; m < 4; ++m) _Pragma("unroll") for (int n = 0; n < 2; ++n) _Pragma("unroll") for (int k = 0; k < 2; ++k) \
        acc[ai][bj][m][n] = __builtin_amdgcn_mfma_f32_16x16x32_bf16(Bt[n][k], At[m][k], acc[ai][bj][m][n], 0, 0, 0); __builtin_amdgcn_s_setprio(0); } while (0)
#define PG8_WAIT_V(n) asm volatile("s_waitcnt vmcnt(" #n ")" ::: "memory")
#define PG8_WAIT_L(n) asm volatile("s_waitcnt lgkmcnt(" #n ")" ::: "memory")
#define PG8_BAR __builtin_amdgcn_s_barrier()
#define PG8_SCHED __builtin_amdgcn_sched_barrier(0)
    Unit cur, nxt; int ui = 0;
    if (!S.next(0, cur)) return;
    f32x4 acc[2][2][4][2];
#pragma unroll
    for (int a = 0; a < 2; ++a)
#pragma unroll
        for (int b = 0; b < 2; ++b)
#pragma unroll
            for (int m = 0; m < 4; ++m)
#pragma unroll
                for (int n = 0; n < 2; ++n) acc[a][b][m][n] = (f32x4){0.f, 0.f, 0.f, 0.f};
    bf16x8 At[4][2], B0[2][2], B1[2][2];
#define PG8_APTR(u) (((u).pn >= g.swap_lo && (u).pn < g.swap_hi) ? (const char*)g.Bt + (size_t)(u).pn * tB : (const char*)g.A + (size_t)(u).pm * tA + (size_t)(u).pn * pnA)
#define PG8_BPTR(u) (((u).pn >= g.swap_lo && (u).pn < g.swap_hi) ? (const char*)g.A + (size_t)(u).pm * tA : (const char*)g.Bt + (size_t)(u).pn * tB)
    const char* cA = PG8_APTR(cur); const char* cB = PG8_BPTR(cur);
    if constexpr (SP2) {
        PG8_STAGE(PG8_SB(0, 0), cB, voffB); PG8_STAGE(PG8_SB(0, 1), cB + hB, voffB); PG8_STAGE(PG8_SA(0, 0), cA, voffA); PG8_STAGE(PG8_SA(0, 1), cA + hA, voffA);
        if (wr == 1) PG8_BAR;
        PG8_WAIT_V(2); PG8_BAR;
        PG8_STAGE(PG8_SB(1, 0), cB + kstep, voffB); PG8_STAGE(PG8_SA(1, 0), cA + kstep, voffA); PG8_STAGE(PG8_SB(1, 1), cB + hB + kstep, voffB);
        PG8_WAIT_V(6); PG8_BAR;
    } else {
        PG8_STAGE(PG8_SB(0, 0), cB, voffB); PG8_STAGE(PG8_SA(0, 0), cA, voffA); PG8_STAGE(PG8_SB(0, 1), cB + hB, voffB); PG8_STAGE(PG8_SA(0, 1), cA + hA, voffA);
        if (wr == 1) PG8_BAR;
        PG8_WAIT_V(4); PG8_BAR;
        PG8_STAGE(PG8_SB(1, 0), cB + kstep, voffB); PG8_STAGE(PG8_SA(1, 0), cA + kstep, voffA); PG8_STAGE(PG8_SB(1, 1), cB + hB + kstep, voffB);
        PG8_WAIT_V(6); PG8_BAR;
    }
    for (;;) {
        const bool has_next = S.next(ui + 1, nxt);
        const char* nA = has_next ? PG8_APTR(nxt) : cA; const char* nB = has_next ? PG8_BPTR(nxt) : cB;
#pragma unroll 1
        for (int t = 0; t < nt; t += 2) {
            const bool last = (t == nt - 2);
            const char* a1 = cA + (size_t)(t + 1) * kstep;
            const char* a2 = last ? nA : cA + (size_t)(t + 2) * kstep; const char* b2 = last ? nB : cB + (size_t)(t + 2) * kstep;
            const char* a3 = a2 + kstep; const char* b3 = b2 + kstep;
            if constexpr (SP2) {
            PG8_LDB(B0, 0, 0); PG8_LDB(B1, 0, 1); PG8_SCHED; PG8_LDA(At, 0, 0); PG8_STAGE(PG8_SA(1, 1), a1 + hA, voffA);
            PG8_WAIT_V(8); PG8_WAIT_L(0); PG8_BAR; PG8_MMA(0, 0, At, B0); PG8_MMA(0, 1, At, B1); PG8_BAR; PG8_SCHED;
            PG8_LDA(At, 0, 1); PG8_STAGE(PG8_SB(0, 0), b2, voffB); PG8_STAGE(PG8_SB(0, 1), b2 + hB, voffB); PG8_STAGE(PG8_SA(0, 0), a2, voffA);
            PG8_WAIT_V(8); PG8_WAIT_L(0); PG8_BAR; PG8_MMA(1, 0, At, B0); PG8_MMA(1, 1, At, B1); PG8_BAR; PG8_SCHED;
            PG8_LDB(B0, 1, 0); PG8_LDB(B1, 1, 1); PG8_SCHED; PG8_LDA(At, 1, 0); PG8_STAGE(PG8_SA(0, 1), a2 + hA, voffA);
            PG8_WAIT_V(8); PG8_WAIT_L(0); PG8_BAR; PG8_MMA(0, 0, At, B0); PG8_MMA(0, 1, At, B1); PG8_BAR; PG8_SCHED;
            PG8_LDA(At, 1, 1); PG8_STAGE(PG8_SB(1, 0), b3, voffB); PG8_STAGE(PG8_SB(1, 1), b3 + hB, voffB); PG8_STAGE(PG8_SA(1, 0), a3, voffA);
            PG8_WAIT_V(8); PG8_WAIT_L(0); PG8_BAR; PG8_MMA(1, 0, At, B0); PG8_MMA(1, 1, At, B1); PG8_BAR; PG8_SCHED;
            } else {
            PG8_LDB(B0, 0, 0); PG8_SCHED; PG8_LDA(At, 0, 0); PG8_STAGE(PG8_SA(1, 1), a1 + hA, voffA);
            PG8_WAIT_L(8); PG8_BAR; PG8_WAIT_L(0); PG8_MMA(0, 0, At, B0); PG8_BAR; PG8_SCHED;
            PG8_LDB(B1, 0, 1); PG8_STAGE(PG8_SB(0, 0), b2, voffB);
            PG8_BAR; PG8_WAIT_L(0); PG8_MMA(0, 1, At, B1); PG8_BAR;
            PG8_LDA(At, 0, 1); PG8_STAGE(PG8_SA(0, 0), a2, voffA);
            PG8_BAR; PG8_WAIT_L(0); PG8_MMA(1, 0, At, B0); PG8_BAR; PG8_SCHED;
            PG8_STAGE(PG8_SB(0, 1), b2 + hB, voffB);
            PG8_WAIT_V(6); PG8_BAR; PG8_MMA(1, 1, At, B1); PG8_BAR;
            PG8_LDB(B0, 1, 0); PG8_SCHED; PG8_LDA(At, 1, 0); PG8_STAGE(PG8_SA(0, 1), a2 + hA, voffA);
            PG8_WAIT_L(8); PG8_BAR; PG8_WAIT_L(0); PG8_MMA(0, 0, At, B0); PG8_BAR; PG8_SCHED;
            PG8_LDB(B1, 1, 1); PG8_STAGE(PG8_SB(1, 0), b3, voffB);
            PG8_BAR; PG8_WAIT_L(0); PG8_MMA(0, 1, At, B1); PG8_BAR;
            PG8_LDA(At, 1, 1); PG8_STAGE(PG8_SA(1, 0), a3, voffA);
            PG8_BAR; PG8_WAIT_L(0); PG8_MMA(1, 0, At, B0); PG8_BAR; PG8_SCHED;
            PG8_STAGE(PG8_SB(1, 1), b3 + hB, voffB);
            PG8_WAIT_V(6); PG8_BAR; PG8_MMA(1, 1, At, B1); PG8_BAR;
            }
        }
        if constexpr (ALIGN_EPI) { if (wr == 0) PG8_BAR; }
        E(acc, cur, wr, wc, fr, fq);
        if (!has_next) break;
#pragma unroll
        for (int a = 0; a < 2; ++a)
#pragma unroll
            for (int b = 0; b < 2; ++b)
#pragma unroll
                for (int m = 0; m < 4; ++m)
#pragma unroll
                    for (int n = 0; n < 2; ++n) acc[a][b][m][n] = (f32x4){0.f, 0.f, 0.f, 0.f};
        cur = nxt; cA = nA; cB = nB; ++ui;
        if constexpr (ALIGN_EPI) { if (wr == 1) PG8_BAR; }
    }
    PG8_WAIT_V(0);
    if constexpr (!ALIGN_EPI) { if (wr == 0) PG8_BAR; }
    PG8_BAR;
#undef PG8_APTR
#undef PG8_BPTR
#undef PG8_SA
#undef PG8_SB
#undef PG8_STAGE
#undef PG8_LDA
#undef PG8_LDB
#undef PG8_MMA
#undef PG8_WAIT_V
#undef PG8_WAIT_L
#undef PG8_BAR
#undef PG8_SCHED
}
}
constexpr int T_TOK = 16384, DM = 1024, SEQ = 4096, NB = 4;
constexpr float EPS = 1e-6f;
constexpr float LOG2E = 1.4426950408889634f;

namespace pg8 {
struct EpiProj {
    static constexpr bool PERM = true;
    bf16_t *GQ, *GK, *GV, *GR, *SQ, *SK, *SV, *SGA, *SGB;
    __device__ __forceinline__ void operator()(const f32x4 (&acc)[2][2][4][2], const Unit& u, int wr, int wc, int fr, int fq) const {
        const int pn = u.pn; bf16_t* base; int ldc = 1024, c0; int act = 0; float sc = 1.f;
        if (pn >= 2 && pn < 8) {
            bf16_t* tb = (pn < 4) ? GK : GV; const int f0 = ((pn < 4) ? (pn - 2) : (pn - 4)) * 256 + wr * 64 + fr, t0 = u.pm * BM + wc * 32 + 8 * fq;
#pragma unroll
            for (int ai = 0; ai < 2; ++ai)
#pragma unroll
                for (int m = 0; m < 4; ++m) { bf16_t* rowp = tb + (size_t)(f0 + ai * HALF + m * 16) * T_TOK + t0;
#pragma unroll
                    for (int bj = 0; bj < 2; ++bj) { const f32x4 v0 = acc[ai][bj][m][0], v1 = acc[ai][bj][m][1];
                        u32x4 w; w.x = cvtpk(v0[0], v0[1]); w.y = cvtpk(v0[2], v0[3]); w.z = cvtpk(v1[0], v1[1]); w.w = cvtpk(v1[2], v1[3]);
                        *(u32x4*)(rowp + bj * HALF) = w; } }
            return; }
        if (pn < 2) { base = GQ; ldc = 512; c0 = pn * 256; sc = 0.08838834764831845f; }
        else if (pn < 4) { base = GK; ldc = 512; c0 = (pn - 2) * 256; }
        else if (pn < 8) { base = GV; c0 = (pn - 4) * 256; }
        else if (pn < 12) { base = GR; c0 = (pn - 8) * 256; act = 1; }
        else if (pn < 16) { base = SQ; c0 = (pn - 12) * 256; sc = 0.125f * LOG2E; }
        else if (pn < 20) { base = SK; c0 = (pn - 16) * 256; }
        else if (pn < 24) { base = SV; c0 = (pn - 20) * 256; }
        else if (pn < 28) { base = SGA; c0 = (pn - 24) * 256; act = 2; }
        else { base = SGB; c0 = (pn - 28) * 256; act = 2; }
        const int row0 = u.pm * BM + wr * 64 + fr, col0 = c0 + wc * 32 + 8 * fq;
#pragma unroll
        for (int ai = 0; ai < 2; ++ai)
#pragma unroll
            for (int m = 0; m < 4; ++m) { bf16_t* rowp = base + (size_t)(row0 + ai * HALF + m * 16) * ldc + col0;
#pragma unroll
                for (int bj = 0; bj < 2; ++bj) { f32x4 v0 = acc[ai][bj][m][0], v1 = acc[ai][bj][m][1];
                    if (act == 1) {
#pragma unroll
                        for (int j = 0; j < 4; ++j) { v0[j] = v0[j] * fast_sigmoid(v0[j]); v1[j] = v1[j] * fast_sigmoid(v1[j]); } }
                    else if (act == 2) {
#pragma unroll
                        for (int j = 0; j < 4; ++j) { v0[j] = fast_sigmoid(v0[j]); v1[j] = fast_sigmoid(v1[j]); } }
                    else { v0 = v0 * sc; v1 = v1 * sc; }
                    u32x4 w; w.x = cvtpk(v0[0], v0[1]); w.y = cvtpk(v0[2], v0[3]); w.z = cvtpk(v1[0], v1[1]); w.w = cvtpk(v1[2], v1[3]);
                    *(u32x4*)(rowp + bj * HALF) = w; } }
    }
};
template <bool FIRST> struct EpiMix {
    static constexpr bool PERM = true;
    const bf16_t* gate; bf16_t* mixed;
    __device__ __forceinline__ void operator()(const f32x4 (&acc)[2][2][4][2], const Unit& u, int wr, int wc, int fr, int fq) const {
        const int row0 = u.pm * BM + wr * 64 + fr, col0 = u.pn * BM + wc * 32 + 8 * fq;
#pragma unroll
        for (int ai = 0; ai < 2; ++ai)
#pragma unroll
            for (int m = 0; m < 4; ++m) { const size_t off = (size_t)(row0 + ai * HALF + m * 16) * 1024 + col0;
#pragma unroll
                for (int bj = 0; bj < 2; ++bj) { const f32x4 a0 = acc[ai][bj][m][0], a1 = acc[ai][bj][m][1];
                    const u32x4 gv = *(const u32x4*)(gate + off + bj * HALF);
                    float r[8];
                    r[0] = a0[0] * bf_lo(gv.x); r[1] = a0[1] * bf_hi(gv.x); r[2] = a0[2] * bf_lo(gv.y); r[3] = a0[3] * bf_hi(gv.y);
                    r[4] = a1[0] * bf_lo(gv.z); r[5] = a1[1] * bf_hi(gv.z); r[6] = a1[2] * bf_lo(gv.w); r[7] = a1[3] * bf_hi(gv.w);
                    if (!FIRST) { const u32x4 mv = *(const u32x4*)(mixed + off + bj * HALF);
                        r[0] += bf_lo(mv.x); r[1] += bf_hi(mv.x); r[2] += bf_lo(mv.y); r[3] += bf_hi(mv.y); r[4] += bf_lo(mv.z); r[5] += bf_hi(mv.z); r[6] += bf_lo(mv.w); r[7] += bf_hi(mv.w); }
                    u32x4 w; w.x = cvtpk(r[0], r[1]); w.y = cvtpk(r[2], r[3]); w.z = cvtpk(r[4], r[5]); w.w = cvtpk(r[6], r[7]);
                    *(u32x4*)(mixed + off + bj * HALF) = w; } }
    }
};
struct EpiH1 {
    static constexpr bool PERM = false;
    const float* x; const float* g; float* H1; bf16_t* H1G; float* SSQ;
    __device__ __forceinline__ void operator()(const f32x4 (&acc)[2][2][4][2], const Unit& u, int wr, int wc, int fr, int fq) const {
        const int row0 = u.pm * BM + wr * 64 + fr, col0 = u.pn * BM + wc * 32 + 4 * fq;
        f32x4 gv[2][2];
#pragma unroll
        for (int bj = 0; bj < 2; ++bj)
#pragma unroll
            for (int n = 0; n < 2; ++n) gv[bj][n] = *(const f32x4*)(g + col0 + bj * HALF + n * 16);
#pragma unroll
        for (int ai = 0; ai < 2; ++ai)
#pragma unroll
            for (int m = 0; m < 4; ++m) { const int row = row0 + ai * HALF + m * 16; const size_t off = (size_t)row * 1024 + col0; float s = 0.f;
#pragma unroll
                for (int bj = 0; bj < 2; ++bj)
#pragma unroll
                    for (int n = 0; n < 2; ++n) { const f32x4 xv = *(const f32x4*)(x + off + bj * HALF + n * 16); const f32x4 h = xv + acc[ai][bj][m][n];
                        *(f32x4*)(H1 + off + bj * HALF + n * 16) = h; s += (h[0] * h[0] + h[1] * h[1]) + (h[2] * h[2] + h[3] * h[3]);
                        const f32x4 hg = h * gv[bj][n]; u32x2 w; w.x = cvtpk(hg[0], hg[1]); w.y = cvtpk(hg[2], hg[3]); *(u32x2*)(H1G + off + bj * HALF + n * 16) = w; }
                s += __shfl_xor(s, 16); s += __shfl_xor(s, 32);
                if (fq == 0) SSQ[(size_t)row * 16 + u.pn * 4 + wc] = s; }
    }
};
struct EpiQ {
    static constexpr bool PERM = true;
    const float* SSQ; bf16_t* Q; int ldc;
    __device__ __forceinline__ void operator()(const f32x4 (&acc)[2][2][4][2], const Unit& u, int wr, int wc, int fr, int fq) const {
        const int row0 = u.pm * BM + wr * 64 + fr, col0 = u.pn * BM + wc * 32 + 8 * fq;
#pragma unroll
        for (int ai = 0; ai < 2; ++ai)
#pragma unroll
            for (int m = 0; m < 4; ++m) { const int row = row0 + ai * HALF + m * 16; const f32x4* sp = (const f32x4*)(SSQ + (size_t)row * 16);
                const f32x4 s0 = sp[0], s1 = sp[1], s2 = sp[2], s3 = sp[3]; const f32x4 st = (s0 + s1) + (s2 + s3);
                const float rstd = __builtin_amdgcn_rsqf(((st[0] + st[1]) + (st[2] + st[3])) * (1.0f / 1024.0f) + EPS);
                bf16_t* rowp = Q + (size_t)row * ldc + col0;
#pragma unroll
                for (int bj = 0; bj < 2; ++bj) { const f32x4 v0 = acc[ai][bj][m][0] * rstd, v1 = acc[ai][bj][m][1] * rstd;
                    u32x4 w; w.x = cvtpk(v0[0], v0[1]); w.y = cvtpk(v0[2], v0[3]); w.z = cvtpk(v1[0], v1[1]); w.w = cvtpk(v1[2], v1[3]);
                    *(u32x4*)(rowp + bj * HALF) = w; } }
    }
};
struct EpiF32 {
    static constexpr bool PERM = false;
    float* O; int ldc;
    __device__ __forceinline__ void operator()(const f32x4 (&acc)[2][2][4][2], const Unit& u, int wr, int wc, int fr, int fq) const {
        const int row0 = u.pm * BM + wr * 64 + fr, col0 = u.pn * BM + wc * 32 + 4 * fq;
#pragma unroll
        for (int ai = 0; ai < 2; ++ai)
#pragma unroll
            for (int m = 0; m < 4; ++m) { float* rowp = O + (size_t)(row0 + ai * HALF + m * 16) * ldc + col0;
#pragma unroll
                for (int bj = 0; bj < 2; ++bj)
#pragma unroll
                    for (int n = 0; n < 2; ++n) *(f32x4*)(rowp + bj * HALF + n * 16) = acc[ai][bj][m][n]; }
    }
};
struct EpiBf {
    static constexpr bool PERM = true;
    bf16_t* O; int ldc;
    __device__ __forceinline__ void operator()(const f32x4 (&acc)[2][2][4][2], const Unit& u, int wr, int wc, int fr, int fq) const {
        const int row0 = u.pm * BM + wr * 64 + fr, col0 = u.pn * BM + wc * 32 + 8 * fq;
#pragma unroll
        for (int ai = 0; ai < 2; ++ai)
#pragma unroll
            for (int m = 0; m < 4; ++m) { bf16_t* rowp = O + (size_t)(row0 + ai * HALF + m * 16) * ldc + col0;
#pragma unroll
                for (int bj = 0; bj < 2; ++bj) { const f32x4 v0 = acc[ai][bj][m][0], v1 = acc[ai][bj][m][1];
                    u32x4 w; w.x = cvtpk(v0[0], v0[1]); w.y = cvtpk(v0[2], v0[3]); w.z = cvtpk(v1[0], v1[1]); w.w = cvtpk(v1[2], v1[3]);
                    *(u32x4*)(rowp + bj * HALF) = w; } }
    }
};
struct EpiH3 {
    static constexpr bool PERM = false;
    const float* H2; const bf16_t* PLE; float* OUT; float* SSQ; int dry;
    __device__ __forceinline__ void operator()(const f32x4 (&acc)[2][2][4][2], const Unit& u, int wr, int wc, int fr, int fq) const {
        const int row0 = u.pm * BM + wr * 64 + fr, col0 = u.pn * BM + wc * 32 + 4 * fq;
#pragma unroll
        for (int ai = 0; ai < 2; ++ai)
#pragma unroll
            for (int m = 0; m < 4; ++m) { const int row = row0 + ai * HALF + m * 16; const size_t off = (size_t)row * 1024 + col0; float s = 0.f;
#pragma unroll
                for (int bj = 0; bj < 2; ++bj)
#pragma unroll
                    for (int n = 0; n < 2; ++n) { const size_t o2 = off + bj * HALF + n * 16; const f32x4 hv = *(const f32x4*)(H2 + o2); const u32x2 pv = *(const u32x2*)(PLE + o2);
                        const f32x4 a = acc[ai][bj][m][n]; f32x4 h;
                        h[0] = hv[0] + bf_lo(pv.x) * fast_sigmoid(a[0]); h[1] = hv[1] + bf_hi(pv.x) * fast_sigmoid(a[1]);
                        h[2] = hv[2] + bf_lo(pv.y) * fast_sigmoid(a[2]); h[3] = hv[3] + bf_hi(pv.y) * fast_sigmoid(a[3]);
                        if (!dry) *(f32x4*)(OUT + o2) = h; s += (h[0] * h[0] + h[1] * h[1]) + (h[2] * h[2] + h[3] * h[3]); }
                s += __shfl_xor(s, 16); s += __shfl_xor(s, 32);
                if (fq == 0) SSQ[(size_t)row * 16 + u.pn * 4 + wc] = s;
                asm volatile("" ::: "memory"); }
    }
};
}
constexpr size_t MiB = 1u << 20;
constexpr size_t WS_CTL = 0, CTL_ZERO_BYTES = 64 * 1024;
constexpr size_t WS_PEND = 64 * 1024;
constexpr size_t WS_WPLE = 512 * 1024;
constexpr size_t WS_KD = 1 * MiB;
constexpr size_t WS_GLAG = 2 * MiB;
constexpr size_t WS_WIN = 3 * MiB;
constexpr size_t WS_SEND = 4 * MiB;
constexpr size_t WS_EXP = 4 * MiB;
constexpr size_t WS_SSQ1 = 13 * MiB;
constexpr size_t WS_SSQ3 = 14 * MiB;
constexpr size_t WS_RSU = 15 * MiB, WS_RSV = 15 * MiB + 64 * 1024;
constexpr size_t WS_WGA = 20 * MiB, WS_WSB = 22 * MiB, WS_WO = 24 * MiB, WS_WPG = 26 * MiB, WS_WPQ = 28 * MiB;
constexpr size_t WS_A = 32 * MiB;
constexpr size_t WS_GQ = WS_A, WS_GK = WS_A + 16 * MiB, WS_UB8 = WS_A, WS_VB8 = WS_A + 16 * MiB;
constexpr size_t WS_B = 64 * MiB;
constexpr size_t WS_GV = WS_B, WS_PB = WS_B;
constexpr size_t WS_C = 96 * MiB;
constexpr size_t WS_GR = WS_C, WS_H1 = WS_C;
constexpr size_t WS_D = 128 * MiB;
constexpr size_t WS_SQ = WS_D;
constexpr size_t WS_E = 160 * MiB;
constexpr size_t WS_SK = WS_E, WS_MIX = WS_E, WS_Q = WS_E, WS_PLE = WS_E;
constexpr size_t WS_F = 192 * MiB;
constexpr size_t WS_SV = WS_F;
constexpr size_t WS_G = 224 * MiB;
constexpr size_t WS_XN1 = WS_G, WS_GLAN = WS_G, WS_H1G = WS_G, WS_XN3 = WS_G;
constexpr size_t WS_END = 256 * MiB;

constexpr int NWAVES = 8;
constexpr int RING_OFF = 0, RING_BYTES = 131072;
constexpr int MISC_OFF = RING_BYTES;
constexpr int LDS_BYTES = 147456;
constexpr int CW_BAR = 1024;

typedef GAS unsigned gu32;
#define RLX_AGENT __ATOMIC_RELAXED, __HIP_MEMORY_SCOPE_AGENT
#define LDS_WAIT() asm volatile("s_waitcnt lgkmcnt(0)" ::: "memory")
#define VM_WAIT() asm volatile("s_waitcnt vmcnt(0)" ::: "memory")

#define XB_TMO      128
#define XB_XCNT(j)  (256  + 64 * (j))
#define XB_XSUB(j)  (1280 + 64 * (j))
#define XB_XGEN(j)  (2304 + 64 * (j))
#define XB_TOP      3328
#define XB_TOPGEN   3392
#define XCD_BAR_WORDS 3456
#define XB_SPIN_CAP (1u << 22)
__device__ __forceinline__ unsigned xb_ld(unsigned* p)              { return __hip_atomic_load(p, __ATOMIC_RELAXED, __HIP_MEMORY_SCOPE_AGENT); }
__device__ __forceinline__ unsigned xb_add(unsigned* p, unsigned v) { return __hip_atomic_fetch_add(p, v, __ATOMIC_RELAXED, __HIP_MEMORY_SCOPE_AGENT); }
__device__ __forceinline__ unsigned xb_xcc_id() { return (unsigned)__builtin_amdgcn_s_getreg((3 << 11) | 20) & 0xFu; }
#define XB_SPIN(cond, bar) do { unsigned _sp = 0; while (cond) { __builtin_amdgcn_s_sleep(1); \
    if ((++_sp & 255u) == 0u) { if (xb_ld(&(bar)[XB_TMO])) break; if (_sp > XB_SPIN_CAP) { atomicAdd(&(bar)[XB_TMO], 1u); break; } } } } while (0)
struct XcdBarrier { unsigned* bar; unsigned x; volatile LAS unsigned* st; };
__device__ __forceinline__ XcdBarrier xcd_barrier_post(unsigned* bar, volatile LAS unsigned* st, int tid) {
    XcdBarrier b; b.bar = bar; b.x = xb_xcc_id(); b.st = st;
    if (tid == 0) (void)xb_add(&bar[XB_XCNT(b.x)], 1u);
    return b;
}
__device__ __forceinline__ void xcd_barrier_complete(unsigned* bar, unsigned x, unsigned& nloc, unsigned& nx) {
    const unsigned G = gridDim.x * gridDim.y * gridDim.z;
    unsigned sum, cnt, mine, sp = 0u;
    for (;;) {
        sum = 0u; cnt = 0u; mine = 0u;
#pragma unroll
        for (unsigned j = 0; j < 16; ++j) { const unsigned c = xb_ld(&bar[XB_XCNT(j)]); sum += c; cnt += (c > 0u) ? 1u : 0u; mine = (j == x) ? c : mine; }
        if (sum == G) break;
        __builtin_amdgcn_s_sleep(1);
        if ((++sp & 255u) == 0u) { if (xb_ld(&bar[XB_TMO])) break; if (sp > XB_SPIN_CAP) { atomicAdd(&bar[XB_TMO], 1u); break; } }
    }
    nloc = mine > 0u ? mine : 1u; nx = cnt > 0u ? cnt : 1u;
}
__device__ __forceinline__ void xcd_barrier(const XcdBarrier& b, int tid) {
    asm volatile("s_waitcnt vmcnt(0)" ::: "memory");
    __syncthreads();
    if (tid == 0) {
        unsigned* bar = b.bar;
        __builtin_amdgcn_s_waitcnt(0);
        unsigned nloc = b.st[0], nx = b.st[1];
        if (nloc == 0u) { xcd_barrier_complete(bar, b.x, nloc, nx); b.st[0] = nloc; b.st[1] = nx; }
        const unsigned old = xb_add(&bar[XB_XSUB(b.x)], 1u);
        const unsigned gen = old / nloc;
        if (old + 1u == (gen + 1u) * nloc) {
            __builtin_amdgcn_fence(__ATOMIC_RELEASE, "agent");
            asm volatile("s_waitcnt vmcnt(0)" ::: "memory");
            const unsigned og = xb_add(&bar[XB_TOP], 1u);
            const unsigned tg = og / nx;
            if (og + 1u == (tg + 1u) * nx) xb_add(&bar[XB_TOPGEN], 1u);
            else XB_SPIN(xb_ld(&bar[XB_TOPGEN]) == tg, bar);
            __builtin_amdgcn_fence(__ATOMIC_ACQUIRE, "agent");
            xb_add(&bar[XB_XGEN(b.x)], 1u);
            asm volatile("s_waitcnt vmcnt(0)" ::: "memory");
        } else {
            XB_SPIN(xb_ld(&bar[XB_XGEN(b.x)]) == gen, bar);
            __builtin_amdgcn_fence(__ATOMIC_ACQUIRE, "agent");
            asm volatile("s_waitcnt vmcnt(0)" ::: "memory");
        }
    }
    __syncthreads();
}

struct Frame {
    LAS unsigned char* lds;
    int tid, lane, wave, vcu, G, dry;
    const float* const* in; float* out; unsigned char* ws;
};
__device__ __forceinline__ int lane_id() { int l; asm volatile("v_mbcnt_lo_u32_b32 %0, -1, 0\n\tv_mbcnt_hi_u32_b32 %0, -1, %0" : "=v"(l)); return l; }
#define WSP(T, off) ((T*)(F.ws + (off)))
__device__ __forceinline__ float wave_sum(float v) {
#pragma unroll
    for (int o = 1; o < 64; o <<= 1) v += __shfl_xor(v, o);
    return v;
}
template <class RowMap>
__device__ __forceinline__ void p0_transpose_item(const float* W, int K, int N, bf16_t* WT, RowMap rm, LAS float* scr, int item, int lane) {
    const int nblk = (N + 31) / 32, kb = item / nblk, nb = item % nblk, k0 = 64 * kb, n0 = 32 * nb;
    { const int kr = lane >> 3, c4 = lane & 7, nl = n0 + 4 * c4; f32x4 v[8];
#pragma unroll
      for (int i = 0; i < 8; ++i) v[i] = (nl < N) ? *(const f32x4*)(W + (size_t)(k0 + 8 * i + kr) * N + nl) : (f32x4){0.f, 0.f, 0.f, 0.f};
#pragma unroll
      for (int i = 0; i < 8; ++i) { LAS float* d = scr + (8 * i + kr) * 33 + 4 * c4; d[0] = v[i][0]; d[1] = v[i][1]; d[2] = v[i][2]; d[3] = v[i][3]; } }
    LDS_WAIT(); asm volatile("" ::: "memory");
    const int c = lane & 7;
#pragma unroll
    for (int j = 0; j < 4; ++j) { const int n = (lane >> 3) + 8 * j; const LAS float* s = scr + (8 * c) * 33 + n;
        u32x4 o; o.x = cvtpk(s[0 * 33], s[1 * 33]); o.y = cvtpk(s[2 * 33], s[3 * 33]); o.z = cvtpk(s[4 * 33], s[5 * 33]); o.w = cvtpk(s[6 * 33], s[7 * 33]);
        if (n0 + n < N) *(u32x4*)(WT + (size_t)rm(n0 + n) * K + k0 + 8 * c) = o; }
    LDS_WAIT(); asm volatile("" ::: "memory");
}
struct RmId { __device__ __forceinline__ int operator()(int n) const { return n; } };
struct RmWin { __device__ __forceinline__ int operator()(int n) const { return n < 3072 ? n : (n < 3088 ? 8192 + (n - 3072) : n - 16); } };

__device__ __forceinline__ void cvt_copy(Frame& F, const float* src, bf16_t* dst, size_t n) {
    const size_t nth = (size_t)F.G * 512, n8 = n / 8;
    for (size_t i = (size_t)F.vcu * 512 + F.tid; i < n8; i += nth) {
        const f32x4 a = *(const f32x4*)(src + i * 8), b = *(const f32x4*)(src + i * 8 + 4);
        u32x4 o; o.x = cvtpk(a[0], a[1]); o.y = cvtpk(a[2], a[3]); o.z = cvtpk(b[0], b[1]); o.w = cvtpk(b[2], b[3]);
        *(u32x4*)(dst + i * 8) = o; }
}
__device__ __forceinline__ void rms_row_to_bf16(const float* xrow, const float* g, bf16_t* orow, int lane) {
    f32x4 v[4]; float s = 0.f;
#pragma unroll
    for (int j = 0; j < 4; ++j) { v[j] = *((const f32x4*)xrow + lane + 64 * j); s += (v[j][0] * v[j][0] + v[j][1] * v[j][1]) + (v[j][2] * v[j][2] + v[j][3] * v[j][3]); }
    const float rstd = __builtin_amdgcn_rsqf(wave_sum(s) * (1.f / 1024.f) + EPS);
#pragma unroll
    for (int j = 0; j < 4; ++j) { const f32x4 gv = *((const f32x4*)g + lane + 64 * j); const f32x4 o = v[j] * rstd * gv;
        u32x2 w; w.x = cvtpk(o[0], o[1]); w.y = cvtpk(o[2], o[3]); *((u32x2*)orow + lane + 64 * j) = w; }
}
__device__ __forceinline__ void phase_prologue(Frame& F) {
    LAS float* scr = (LAS float*)(F.lds + RING_OFF + F.wave * 16384);
    const int gw = F.vcu * NWAVES + F.wave, NGW = F.G * NWAVES;
    constexpr int I_IN = 16 * 257, I_SQ = 16 * 32, I_PQ = 16 * 64, I_PLE = 4 * 32;
    constexpr int NITEMS = I_IN + 4 * I_SQ + I_PQ + I_PLE;
    for (int it = gw; it < NITEMS; it += NGW) {
        int r = it;
        if (r < I_IN) { p0_transpose_item(F.in[3], 1024, 8208, WSP(bf16_t, WS_WIN), RmWin(), scr, r, F.lane); continue; } r -= I_IN;
        if (r < I_SQ) { p0_transpose_item(F.in[7], 1024, 1024, WSP(bf16_t, WS_WGA), RmId(), scr, r, F.lane); continue; } r -= I_SQ;
        if (r < I_SQ) { p0_transpose_item(F.in[8], 1024, 1024, WSP(bf16_t, WS_WSB), RmId(), scr, r, F.lane); continue; } r -= I_SQ;
        if (r < I_SQ) { p0_transpose_item(F.in[9], 1024, 1024, WSP(bf16_t, WS_WO), RmId(), scr, r, F.lane); continue; } r -= I_SQ;
        if (r < I_SQ) { p0_transpose_item(F.in[17], 1024, 1024, WSP(bf16_t, WS_WPG), RmId(), scr, r, F.lane); continue; } r -= I_SQ;
        if (r < I_PQ) { p0_transpose_item(F.in[11], 1024, 2048, WSP(bf16_t, WS_WPQ), RmId(), scr, r, F.lane); continue; } r -= I_PQ;
        p0_transpose_item(F.in[18], 256, 1024, WSP(bf16_t, WS_WPLE), RmId(), scr, r, F.lane);
    }
    { const float* k1 = F.in[12]; const float* k2 = F.in[13]; bf16_t* KB = WSP(bf16_t, WS_KD);
      for (int i = F.vcu * 512 + F.tid; i < 2 * 8 * 128 * 16; i += F.G * 512) { const int half = i >> 14, rem = i & 16383, h = rem >> 11, r8 = rem & 2047;
          const float* s = (half ? k2 : k1) + (size_t)h * 16384 + (size_t)r8 * 8; const f32x4 a = *(const f32x4*)s, b = *(const f32x4*)(s + 4);
          u32x4 o; o.x = cvtpk(a[0], a[1]); o.y = cvtpk(a[2], a[3]); o.z = cvtpk(b[0], b[1]); o.w = cvtpk(b[2], b[3]);
          *(u32x4*)(KB + (size_t)(h * 2 + half) * 16384 + (size_t)r8 * 8) = o; } }
    for (int m = gw; m < T_TOK; m += 4 * NGW) {
        f32x4 v[4][4]; float s[4];
#pragma unroll
        for (int q = 0; q < 4; ++q) { const float* xr = F.in[0] + (size_t)(m + q * NGW) * 1024; s[q] = 0.f;
#pragma unroll
            for (int j = 0; j < 4; ++j) { v[q][j] = *((const f32x4*)xr + F.lane + 64 * j); s[q] += (v[q][j][0] * v[q][j][0] + v[q][j][1] * v[q][j][1]) + (v[q][j][2] * v[q][j][2] + v[q][j][3] * v[q][j][3]); } }
#pragma unroll
        for (int o = 1; o < 64; o <<= 1) {
#pragma unroll
            for (int q = 0; q < 4; ++q) s[q] += __shfl_xor(s[q], o); }
#pragma unroll
        for (int q = 0; q < 4; ++q) { const float rstd = __builtin_amdgcn_rsqf(s[q] * (1.f / 1024.f) + EPS); bf16_t* orow = WSP(bf16_t, WS_XN1) + (size_t)(m + q * NGW) * 1024;
#pragma unroll
            for (int j = 0; j < 4; ++j) { const f32x4 gv = *((const f32x4*)F.in[2] + F.lane + 64 * j); const f32x4 o = v[q][j] * rstd * gv;
                u32x2 wq; wq.x = cvtpk(o[0], o[1]); wq.y = cvtpk(o[2], o[3]); *((u32x2*)orow + F.lane + 64 * j) = wq; } }
    }
}

__device__ __forceinline__ void phase_gla_prep(Frame& F) {
    LAS float* alo = (LAS float*)(F.lds + RING_OFF);
    const bf16_t* XN1 = WSP(bf16_t, WS_XN1); const bf16_t* WGAT = WSP(bf16_t, WS_WIN) + (size_t)8192 * 1024;
    bf16_t* GKT = WSP(bf16_t, WS_GK); float* GLAG = WSP(float, WS_GLAG);
    const float* w_up = F.in[4]; const float* b_a = F.in[5];
    const int tid = F.tid, lane = F.lane, w = F.wave;
    for (int u = F.vcu; u < 256; u += F.G) {
        const size_t r0 = (size_t)u * 64;
        __syncthreads();
        const int kk = tid;
        bf16_t* krow = GKT + (size_t)kk * T_TOK + r0;
        u32x4 kq[8];
#pragma unroll
        for (int j = 0; j < 8; ++j) kq[j] = *(const u32x4*)(krow + 8 * j);
        {
            LAS float* part = alo + 1024;
            const bf16_t* bp = WGAT + (size_t)(lane & 15) * 1024 + 8 * (lane >> 4) + 128 * w;
            bf16x8 bq[4];
#pragma unroll
            for (int s = 0; s < 4; ++s) bq[s] = *(const bf16x8*)(bp + 32 * s);
#pragma unroll
            for (int rt = 0; rt < 4; ++rt) { f32x4 acc = (f32x4){0.f, 0.f, 0.f, 0.f};
                const bf16_t* ap = XN1 + (r0 + 16 * rt + (lane & 15)) * 1024 + 8 * (lane >> 4) + 128 * w;
#pragma unroll
                for (int s = 0; s < 4; ++s) { const bf16x8 a = *(const bf16x8*)(ap + 32 * s); acc = __builtin_amdgcn_mfma_f32_16x16x32_bf16(a, bq[s], acc, 0, 0, 0); }
#pragma unroll
                for (int r = 0; r < 4; ++r) part[w * 1024 + (16 * rt + 4 * (lane >> 4) + r) * 16 + (lane & 15)] = acc[r]; }
            __syncthreads();
#pragma unroll
            for (int q = 0; q < 2; ++q) { const int e = tid + 512 * q; float s = 0.f;
#pragma unroll
                for (int ww = 0; ww < 8; ++ww) s += part[ww * 1024 + e];
                alo[e] = s; }
        }
        float wv[16];
#pragma unroll
        for (int r = 0; r < 16; ++r) wv[r] = w_up[r * 512 + kk];
        const float bias = b_a[kk];
        __syncthreads();
        float suffix = 0.f;
#pragma unroll
        for (int i8 = 7; i8 >= 0; --i8) {
            const unsigned kw[4] = {kq[i8].x, kq[i8].y, kq[i8].z, kq[i8].w};
            float o[8];
#pragma unroll
            for (int j = 7; j >= 0; --j) { const int i = i8 * 8 + j;
                const f32x4 a0 = *(const LAS f32x4*)(alo + i * 16), a1 = *(const LAS f32x4*)(alo + i * 16 + 4), a2 = *(const LAS f32x4*)(alo + i * 16 + 8), a3 = *(const LAS f32x4*)(alo + i * 16 + 12);
                float x = bias;
                x += a0[0] * wv[0] + a0[1] * wv[1] + a0[2] * wv[2] + a0[3] * wv[3];
                x += a1[0] * wv[4] + a1[1] * wv[5] + a1[2] * wv[6] + a1[3] * wv[7];
                x += a2[0] * wv[8] + a2[1] * wv[9] + a2[2] * wv[10] + a2[3] * wv[11];
                x += a3[0] * wv[12] + a3[1] * wv[13] + a3[2] * wv[14] + a3[3] * wv[15];
                const float la = (fminf(x, 0.f) - __logf(1.0f + __expf(-fabsf(x)))) * (1.0f / 16.0f);
                const float kvv = (j & 1) ? bf_hi(kw[j >> 1]) : bf_lo(kw[j >> 1]);
                o[j] = kvv * __expf(suffix);
                suffix += la; }
            u32x4 pk; pk.x = cvtpk(o[0], o[1]); pk.y = cvtpk(o[2], o[3]); pk.z = cvtpk(o[4], o[5]); pk.w = cvtpk(o[6], o[7]);
            if (!F.dry) *(u32x4*)(krow + i8 * 8) = pk; }
        GLAG[(size_t)u * 512 + kk] = __expf(suffix);
    }
}
constexpr int GL_KD = 0, GL_Q = 32768, GL_G = 65536, GL_RED = 65536 + 1024;
__device__ __forceinline__ int gl_kd_off(int row, int chunk) { return row * 128 + ((chunk ^ ((row >> 1) & 7)) << 4); }
__device__ __forceinline__ int gl_q_off(int row, int chunk16) { return row * 256 + ((chunk16 ^ (row & 15)) << 4); }

struct GlaStage { u32x4 kd[2]; u32x4 q[2]; bf16x8 vt[4]; float g; };
__device__ __forceinline__ void gla_prefetch_vt(Frame& F, GlaStage& st, int b, int h, int c) {
    const int u = b * 64 + c; const size_t r0 = (size_t)u * 64; const int w = F.wave, lq = F.lane & 31, hh = F.lane >> 5;
    const bf16_t* vt = WSP(bf16_t, WS_GV) + (size_t)(h * 256 + 32 * w + lq) * T_TOK + r0;
#pragma unroll
    for (int ts = 0; ts < 4; ++ts) st.vt[ts] = *(const bf16x8*)(vt + 16 * ts + 8 * hh);
}
template <bool WITH_Q>
__device__ __forceinline__ void gla_prefetch(Frame& F, GlaStage& st, int b, int h, int c) {
    const int u = b * 64 + c; const size_t r0 = (size_t)u * 64; const int tid = F.tid;
    const bf16_t* kd = WSP(bf16_t, WS_GK) + (size_t)(h * 128) * T_TOK + r0;
#pragma unroll
    for (int j = 0; j < 2; ++j) { const int pi = tid + 512 * j; st.kd[j] = *(const u32x4*)(kd + (size_t)(pi >> 3) * T_TOK + (pi & 7) * 8); }
    if (WITH_Q) { const bf16_t* gq = WSP(bf16_t, WS_GQ) + r0 * 512 + h * 128;
#pragma unroll
        for (int j = 0; j < 2; ++j) { const int pi = tid + 512 * j; st.q[j] = *(const u32x4*)(gq + (size_t)(pi >> 4) * 512 + (pi & 15) * 8); } }
    st.g = (tid < 128) ? WSP(float, WS_GLAG)[((size_t)u * 4 + h) * 128 + tid] : 1.f;
}
template <bool WITH_Q>
__device__ __forceinline__ void gla_stage_write(Frame& F, const GlaStage& st, int buf) {
    LAS unsigned char* lds = F.lds + RING_OFF; const int tid = F.tid;
#pragma unroll
    for (int j = 0; j < 2; ++j) { const int pi = tid + 512 * j; *(LAS u32x4*)(lds + GL_KD + buf * 16384 + gl_kd_off(pi >> 3, pi & 7)) = st.kd[j]; }
    if (WITH_Q) {
#pragma unroll
        for (int j = 0; j < 2; ++j) { const int pi = tid + 512 * j; *(LAS u32x4*)(lds + GL_Q + buf * 16384 + gl_q_off(pi >> 4, pi & 15)) = st.q[j]; } }
    if (tid < 128) *(LAS float*)(lds + GL_G + buf * 512 + tid * 4) = st.g;
}
__device__ __forceinline__ void gla_update(Frame& F, f32x16 (&S)[4], const bf16x8 (&vt)[4], int buf) {
    const LAS unsigned char* lds = F.lds + RING_OFF; const int lq = F.lane & 31, hh = F.lane >> 5;
    const LAS float* G = (const LAS float*)(lds + GL_G + buf * 512);
#pragma unroll
    for (int kt = 0; kt < 4; ++kt)
#pragma unroll
        for (int g4 = 0; g4 < 4; ++g4) { const f32x4 g = *(const LAS f32x4*)(G + 32 * kt + 8 * g4 + 4 * hh);
#pragma unroll
            for (int j = 0; j < 4; ++j) S[kt][4 * g4 + j] *= g[j]; }
#pragma unroll
    for (int ts = 0; ts < 4; ++ts)
#pragma unroll
        for (int kt = 0; kt < 4; ++kt) { const bf16x8 a = *(const LAS bf16x8*)(lds + GL_KD + buf * 16384 + gl_kd_off(32 * kt + lq, 2 * ts + hh));
            S[kt] = __builtin_amdgcn_mfma_f32_32x32x16_bf16(a, vt[ts], S[kt], 0, 0, 0); if (kt == 3 && (ts & 1)) __builtin_amdgcn_sched_barrier(0); }
}
constexpr size_t SEND_WAVE_FLOATS = 4 * 4 * 64 * 4;
__device__ __forceinline__ void gla_stage1(Frame& F, int unit) {
    const int bh = unit >> 3, seg = unit & 7, b = bh >> 2, h = bh & 3, w = F.wave, l = F.lane;
    f32x16 S[4];
#pragma unroll
    for (int kt = 0; kt < 4; ++kt)
#pragma unroll
        for (int r = 0; r < 16; ++r) S[kt][r] = 0.f;
    float pend = 1.f;
    GlaStage st; gla_prefetch<false>(F, st, b, h, seg * 8); gla_prefetch_vt(F, st, b, h, seg * 8);
    for (int ci = 0; ci < 8; ++ci) {
        gla_stage_write<false>(F, st, ci & 1); pend *= st.g;
        __syncthreads();
        if (ci < 7) gla_prefetch<false>(F, st, b, h, seg * 8 + ci + 1);
        gla_update(F, S, st.vt, ci & 1);
        if (ci < 7) gla_prefetch_vt(F, st, b, h, seg * 8 + ci + 1);
    }
    float* se = WSP(float, WS_SEND) + ((size_t)unit * 8 + w) * SEND_WAVE_FLOATS;
#pragma unroll
    for (int kt = 0; kt < 4; ++kt)
#pragma unroll
        for (int g4 = 0; g4 < 4; ++g4) *(f32x4*)(se + ((kt * 4 + g4) * 64 + l) * 4) = (f32x4){S[kt][4 * g4], S[kt][4 * g4 + 1], S[kt][4 * g4 + 2], S[kt][4 * g4 + 3]};
    if (F.tid < 128) WSP(float, WS_PEND)[unit * 128 + F.tid] = pend;
    __syncthreads();
}
__device__ __forceinline__ void gla_stage3(Frame& F, int unit) {
    const int bh = unit >> 3, seg = unit & 7, b = bh >> 2, h = bh & 3, w = F.wave, l = F.lane, lq = l & 31, hh = l >> 5;
    LAS unsigned char* lds = F.lds + RING_OFF;
    const bf16_t* GR = WSP(bf16_t, WS_GR); bf16_t* GLAN = WSP(bf16_t, WS_GLAN); const float* g_o = F.in[6];
    f32x16 S[4];
#pragma unroll
    for (int kt = 0; kt < 4; ++kt)
#pragma unroll
        for (int r = 0; r < 16; ++r) S[kt][r] = 0.f;
    GlaStage st; gla_prefetch<true>(F, st, b, h, seg * 8); gla_prefetch_vt(F, st, b, h, seg * 8);
    for (int sp = 0; sp < seg; ++sp) {
        const int un = bh * 8 + sp; const float* se = WSP(float, WS_SEND) + ((size_t)un * 8 + w) * SEND_WAVE_FLOATS; const float* pe = WSP(float, WS_PEND) + un * 128;
#pragma unroll
        for (int kt = 0; kt < 4; ++kt)
#pragma unroll
            for (int g4 = 0; g4 < 4; ++g4) { const f32x4 p = *(const f32x4*)(pe + 32 * kt + 8 * g4 + 4 * hh); const f32x4 s = *(const f32x4*)(se + ((kt * 4 + g4) * 64 + l) * 4);
#pragma unroll
                for (int j = 0; j < 4; ++j) S[kt][4 * g4 + j] = S[kt][4 * g4 + j] * p[j] + s[j]; }
    }
    for (int ci = 0; ci < 8; ++ci) {
        const int c = seg * 8 + ci; const size_t r0 = (size_t)(b * 64 + c) * 64; const int buf = ci & 1;
        gla_stage_write<true>(F, st, buf);
        __syncthreads();
        if (ci < 7) gla_prefetch<true>(F, st, b, h, c + 1);
        gla_update(F, S, st.vt, buf);
        f32x16 oT[2];
#pragma unroll
        for (int tt = 0; tt < 2; ++tt) {
#pragma unroll
            for (int r = 0; r < 16; ++r) oT[tt][r] = 0.f;
            const int t = 32 * tt + lq;
#pragma unroll
            for (int kt = 0; kt < 4; ++kt)
#pragma unroll
                for (int s = 0; s < 2; ++s) {
                    u32x4 aw; aw.x = cvtpk(S[kt][8 * s + 0], S[kt][8 * s + 1]); aw.y = cvtpk(S[kt][8 * s + 2], S[kt][8 * s + 3]); aw.z = cvtpk(S[kt][8 * s + 4], S[kt][8 * s + 5]); aw.w = cvtpk(S[kt][8 * s + 6], S[kt][8 * s + 7]);
                    const u32x2 qlo = *(const LAS u32x2*)(lds + GL_Q + buf * 16384 + gl_q_off(t, 4 * kt + 2 * s) + 8 * hh), qhi = *(const LAS u32x2*)(lds + GL_Q + buf * 16384 + gl_q_off(t, 4 * kt + 2 * s + 1) + 8 * hh);
                    const u32x4 bw = (u32x4){qlo.x, qlo.y, qhi.x, qhi.y};
                    oT[tt] = __builtin_amdgcn_mfma_f32_32x32x16_bf16(__builtin_bit_cast(bf16x8, aw), __builtin_bit_cast(bf16x8, bw), oT[tt], 0, 0, 0);
                    if (s == 1 && (kt & 1)) __builtin_amdgcn_sched_barrier(0); }
        }
        LAS float* redc = (LAS float*)(lds + GL_RED) + buf * 512;
#pragma unroll
        for (int tt = 0; tt < 2; ++tt) { float s = 0.f;
#pragma unroll
            for (int r = 0; r < 16; ++r) s += oT[tt][r] * oT[tt][r];
            s += __shfl_xor(s, 32);
            if (hh == 0) redc[w * 64 + 32 * tt + lq] = s; }
        if (ci < 7) gla_prefetch_vt(F, st, b, h, c + 1);
        u32x2 sr[2][4];
#pragma unroll
        for (int tt = 0; tt < 2; ++tt)
#pragma unroll
            for (int g4 = 0; g4 < 4; ++g4) sr[tt][g4] = *(const u32x2*)(GR + (r0 + 32 * tt + lq) * 1024 + h * 256 + 32 * w + 8 * g4 + 4 * hh);
        __syncthreads();
#pragma unroll
        for (int tt = 0; tt < 2; ++tt) { float tot = 0.f;
#pragma unroll
            for (int ww = 0; ww < 8; ++ww) tot += redc[ww * 64 + 32 * tt + lq];
            const float rstd = __builtin_amdgcn_rsqf(tot * (1.0f / 256.0f) + EPS);
            const size_t row = r0 + 32 * tt + lq;
#pragma unroll
            for (int g4 = 0; g4 < 4; ++g4) { const int v0 = h * 256 + 32 * w + 8 * g4 + 4 * hh;
                const f32x4 go = *(const f32x4*)(g_o + v0);
                const float o0 = oT[tt][4 * g4 + 0] * rstd * go[0] * bf_lo(sr[tt][g4].x), o1 = oT[tt][4 * g4 + 1] * rstd * go[1] * bf_hi(sr[tt][g4].x);
                const float o2 = oT[tt][4 * g4 + 2] * rstd * go[2] * bf_lo(sr[tt][g4].y), o3 = oT[tt][4 * g4 + 3] * rstd * go[3] * bf_hi(sr[tt][g4].y);
                u32x2 wv; wv.x = cvtpk(o0, o1); wv.y = cvtpk(o2, o3); *(u32x2*)(GLAN + row * 1024 + v0) = wv; } }
    }
    __syncthreads();
}

constexpr int SB_TILE = 16384, SB_FLAG = 7 * SB_TILE;
typedef short v4i16_t __attribute__((ext_vector_type(4)));
__device__ __forceinline__ s16x4 vtr(const LAS unsigned char* p) { return __builtin_bit_cast(s16x4, __builtin_amdgcn_ds_read_tr16_b64_v4i16((LAS v4i16_t*)p)); }
__device__ __forceinline__ float partner32(float x, int hh) { auto rr = __builtin_amdgcn_permlane32_swap(__float_as_uint(x), __float_as_uint(x), false, false); return __uint_as_float(hh ? rr[0] : rr[1]); }
__device__ __forceinline__ int sbk_off(int key, int chunk) { return key * 128 + ((chunk ^ ((key >> 1) & 7)) << 4); }
__device__ __forceinline__ int sbv_off(int key, int chunk) { return 8192 + key * 128 + ((chunk ^ (((key >> 1) & 1) << 2)) << 4); }

template <bool DIAG>
__device__ __forceinline__ void sb_tile_t(const LAS unsigned char* tile, int kt, int qabs, int l, const bf16x8 (&qf)[4], f32x16& o0, f32x16& o1, float& carry) {
    const int lq = l & 31, hh = l >> 5, g1 = (l >> 4) & 1, i = l & 15;
    float run = carry;
#pragma unroll
    for (int half = 1; half >= 0; --half) {
        f32x16 p;
#pragma unroll
        for (int r = 0; r < 16; ++r) p[r] = 0.f;
#pragma unroll
        for (int s = 0; s < 4; ++s) { const bf16x8 a = *(const LAS bf16x8*)(tile + sbk_off(32 * half + lq, 2 * s + hh)); p = __builtin_amdgcn_mfma_f32_32x32x16_bf16(a, qf[s], p, 0, 0, 0); }
        float Lh[16];
#pragma unroll
        for (int r = 0; r < 16; ++r) { const float z = p[r];
            float L = fmaxf(z, 0.f) + __builtin_amdgcn_logf(1.0f + __builtin_amdgcn_exp2f(-fabsf(z)));
            if (DIAG) { const int key = 64 * kt + 32 * half + (r & 3) + 8 * (r >> 2) + 4 * hh; if (key >= qabs) L = 0.f; }
            Lh[r] = L; }
        float tot[4];
#pragma unroll
        for (int g4 = 0; g4 < 4; ++g4) { float* Lg = &Lh[4 * g4]; Lg[2] += Lg[3]; Lg[1] += Lg[2]; Lg[0] += Lg[1]; tot[g4] = Lg[0]; }
        float E[4];
#pragma unroll
        for (int m = 3; m >= 0; --m) { const float tp = partner32(tot[m], hh); E[m] = run + (hh ? 0.f : tp); run += tot[m] + tp; }
        u32x4 pw[2];
#pragma unroll
        for (int s = 0; s < 2; ++s) { float wv[8];
#pragma unroll
            for (int j = 0; j < 8; ++j) { const int r = 8 * s + j;
                float wgt = __builtin_amdgcn_exp2f(p[r] - (E[r >> 2] + Lh[r]));
                if (DIAG) { const int key = 64 * kt + 32 * half + (r & 3) + 8 * (r >> 2) + 4 * hh; if (key >= qabs) wgt = 0.f; }
                wv[j] = wgt; }
            pw[s] = (u32x4){cvtpk(wv[0], wv[1]), cvtpk(wv[2], wv[3]), cvtpk(wv[4], wv[5]), cvtpk(wv[6], wv[7])}; }
#pragma unroll
        for (int s = 0; s < 2; ++s) { const bf16x8 pb = __builtin_bit_cast(bf16x8, pw[s]);
            const int k0 = 32 * half + 16 * s + 4 * hh + (i >> 2), k1 = k0 + 8;
#pragma unroll
            for (int dt = 0; dt < 2; ++dt) { const int ch = 4 * dt + 2 * g1 + ((i & 3) >> 1);
                const s16x4 lo = vtr(tile + sbv_off(k0, ch) + 8 * (i & 1)), hi = vtr(tile + sbv_off(k1, ch) + 8 * (i & 1));
                const bf16x8 a = (bf16x8){lo[0], lo[1], lo[2], lo[3], hi[0], hi[1], hi[2], hi[3]};
                if (dt == 0) o0 = __builtin_amdgcn_mfma_f32_32x32x16_bf16(a, pb, o0, 0, 0, 0); else o1 = __builtin_amdgcn_mfma_f32_32x32x16_bf16(a, pb, o1, 0, 0, 0); } }
    }
    carry = run;
}
__device__ __forceinline__ void sb_tile(const LAS unsigned char* tile, int kt, int q0, int qabs, int l, const bf16x8 (&qf)[4], f32x16& o0, f32x16& o1, float& carry) {
    if (64 * kt + 63 >= q0) sb_tile_t<true>(tile, kt, qabs, l, qf, o0, o1, carry); else sb_tile_t<false>(tile, kt, qabs, l, qf, o0, o1, carry);
}
__device__ __forceinline__ void sb_attn_unit(Frame& F, int uidx) {
    const int bh = uidx >> 4, qb = uidx & 15, b = bh >> 4, h = bh & 15;
    LAS unsigned char* lds = F.lds + RING_OFF;
    volatile LAS unsigned* flags = (volatile LAS unsigned*)(lds + SB_FLAG);
    const int tid = F.tid, w = F.wave, l = F.lane, lq = l & 31, hh = l >> 5;
    bf16_t* SQ = WSP(bf16_t, WS_SQ); const bf16_t* SK = WSP(bf16_t, WS_SK); const bf16_t* SV = WSP(bf16_t, WS_SV);
    const size_t rowbase = (size_t)b * SEQ;
    const int q0 = qb * 256 + 32 * w, qabs = q0 + lq;
    const int kt_hi = qb * 4 + 3, kt_lo = (qb * 4 - 3) > 0 ? (qb * 4 - 3) : 0, nwin = kt_hi - kt_lo + 1;
    const int skey = tid >> 3, sch = tid & 7;
    const bf16_t* kgd = SK + (rowbase + skey) * 1024 + h * 64 + ((sch ^ ((skey >> 1) & 7)) * 8);
    const bf16_t* vgd = SV + (rowbase + skey) * 1024 + h * 64 + ((sch ^ (((skey >> 1) & 1) << 2)) * 8);
    __syncthreads();
#pragma unroll
    for (int j = 0; j < 7; ++j) if (j < nwin) {
        __builtin_amdgcn_global_load_lds((const unsigned*)(kgd + (size_t)(kt_lo + j) * 64 * 1024), (LAS unsigned*)(lds + j * SB_TILE + w * 1024), 16, 0, 0);
        __builtin_amdgcn_global_load_lds((const unsigned*)(vgd + (size_t)(kt_lo + j) * 64 * 1024), (LAS unsigned*)(lds + j * SB_TILE + 8192 + w * 1024), 16, 0, 0); }
    bf16x8 qf[4];
    { const bf16_t* qrow = SQ + (rowbase + qabs) * 1024 + h * 64;
#pragma unroll
      for (int s = 0; s < 4; ++s) qf[s] = *(const bf16x8*)(qrow + 16 * s + 8 * hh); }
    f32x16 o0, o1;
#pragma unroll
    for (int r = 0; r < 16; ++r) { o0[r] = 0.f; o1[r] = 0.f; }
    float carry = 0.f;
    VM_WAIT(); __syncthreads();
    bool done = false;
    for (int kt = (q0 + 30) >> 6; kt >= kt_lo; --kt) {
        sb_tile(lds + (kt - kt_lo) * SB_TILE, kt, q0, qabs, l, qf, o0, o1, carry);
        if (__all(carry > 150.0f)) { done = true; break; }
    }
    if (kt_lo == 0) done = true;
    if (l == 0) flags[w] = done ? 1u : 0u;
    __syncthreads();
    bool alld = true;
#pragma unroll
    for (int i = 0; i < 8; ++i) alld = alld && (flags[i] != 0u);
    if (!alld) {
        const bf16_t* kg = SK + (rowbase + skey) * 1024 + h * 64 + sch * 8;
        const bf16_t* vg = SV + (rowbase + skey) * 1024 + h * 64 + sch * 8;
        for (int kt = kt_lo - 1; kt >= 0; --kt) {
            const u32x4 kr = *(const u32x4*)(kg + (size_t)kt * 64 * 1024), vr = *(const u32x4*)(vg + (size_t)kt * 64 * 1024);
            __syncthreads();
            { unsigned a = 1u;
#pragma unroll
              for (int i = 0; i < 8; ++i) a &= flags[i];
              if (a) break; }
            *(LAS u32x4*)(lds + sbk_off(skey, sch)) = kr; *(LAS u32x4*)(lds + sbv_off(skey, sch)) = vr;
            __syncthreads();
            if (!done) { sb_tile(lds, kt, q0, qabs, l, qf, o0, o1, carry); if (__all(carry > 150.0f) || kt == 0) done = true; }
            if (l == 0) flags[w] = done ? 1u : 0u;
        }
    }
    if (!F.dry) { bf16_t* orow = SQ + (rowbase + qabs) * 1024 + h * 64;
#pragma unroll
      for (int g4 = 0; g4 < 4; ++g4) { u32x2 a, c2; a.x = cvtpk(o0[4 * g4], o0[4 * g4 + 1]); a.y = cvtpk(o0[4 * g4 + 2], o0[4 * g4 + 3]); c2.x = cvtpk(o1[4 * g4], o1[4 * g4 + 1]); c2.y = cvtpk(o1[4 * g4 + 2], o1[4 * g4 + 3]);
          *(u32x2*)(orow + 8 * g4 + 4 * hh) = a; *(u32x2*)(orow + 32 + 8 * g4 + 4 * hh) = c2; } }
}
__device__ __forceinline__ void sb_units_dyn(Frame& F, unsigned* ctr, int lo, int hi) {
    volatile LAS int* slot = (volatile LAS int*)(F.lds + MISC_OFF + 64);
    for (;;) {
        __syncthreads();
        if (F.tid == 0) *slot = lo + (int)__hip_atomic_fetch_add(ctr, 1u, __ATOMIC_RELAXED, __HIP_MEMORY_SCOPE_AGENT);
        __syncthreads();
        const int u = *slot;
        if (u >= hi) break;
        sb_attn_unit(F, u);
    }
}
__device__ __forceinline__ void phase_attn_a(Frame& F) {
    if (F.vcu < 128) gla_stage1(F, F.vcu);
    sb_units_dyn(F, (unsigned*)(F.ws + WS_CTL) + 64 + 16 * F.dry, 0, 384);
    __syncthreads();
}
__device__ __forceinline__ void phase_attn_b(Frame& F) {
    if (F.vcu < 128) gla_stage3(F, F.vcu);
    sb_units_dyn(F, (unsigned*)(F.ws + WS_CTL) + 128 + 16 * F.dry, 384, 1024);
    __syncthreads();
}
__device__ __forceinline__ int okey(float v, int tag, int mask) { int u = __float_as_int(v); u ^= (u >> 31) & 0x7fffffff; return (u & ~mask) | tag; }
__device__ __forceinline__ float okey_val(int key, int mask) { int u = key & ~mask; u ^= (u >> 31) & 0x7fffffff; return __int_as_float(u); }
#define INS16(Lst, xin) do { int _x = (xin); _Pragma("unroll") for (int _j = 0; _j < 16; ++_j) { const int _h = max(Lst[_j], _x); _x = min(Lst[_j], _x); Lst[_j] = _h; } } while (0)

#define CEX(a, b) do { const int _hi = max(a, b), _lo = min(a, b); a = _hi; b = _lo; } while (0)
#define BITONIC16(K) do { \
    _Pragma("unroll") for (int _i = 0; _i < 8; ++_i) CEX(K[_i], K[_i + 8]); \
    _Pragma("unroll") for (int _b = 0; _b < 16; _b += 8) _Pragma("unroll") for (int _i = 0; _i < 4; ++_i) CEX(K[_b + _i], K[_b + _i + 4]); \
    _Pragma("unroll") for (int _b = 0; _b < 16; _b += 4) _Pragma("unroll") for (int _i = 0; _i < 2; ++_i) CEX(K[_b + _i], K[_b + _i + 2]); \
    _Pragma("unroll") for (int _b = 0; _b < 16; _b += 2) CEX(K[_b], K[_b + 1]); } while (0)
__device__ __forceinline__ int swap32i(int x) { auto r = __builtin_amdgcn_permlane32_swap((unsigned)x, (unsigned)x, false, false); return (int)((__builtin_amdgcn_mbcnt_hi(~0u, __builtin_amdgcn_mbcnt_lo(~0u, 0u)) & 32) ? r[0] : r[1]); }

__device__ __forceinline__ void phase_peer_retrieve(Frame& F) {
    const bf16_t* Q = WSP(bf16_t, WS_Q); const bf16_t* KB = WSP(bf16_t, WS_KD); unsigned* EXPO = WSP(unsigned, WS_EXP);
    LAS unsigned char* idxb = F.lds + RING_OFF + F.wave * 2048;
    const int l = F.lane, lq = l & 31, hh = l >> 5;
    const int ntok_wg = T_TOK / F.G;
#pragma unroll 1
    for (int it = F.wave; it < (ntok_wg / 32) * 8; it += NWAVES) {
        const int tg = it >> 3, h = it & 7;
        const int t = F.vcu * ntok_wg + tg * 32 + lq;
        int XY[2][16];
#pragma unroll
        for (int half = 0; half < 2; ++half) {
            bf16x8 qf[8];
            { const bf16_t* qp = Q + (size_t)t * 2048 + h * 256 + half * 128 + 8 * hh;
#pragma unroll
              for (int s = 0; s < 8; ++s) qf[s] = *(const bf16x8*)(qp + 16 * s); }
            int L[16];
#pragma unroll
            for (int j = 0; j < 16; ++j) L[j] = INT_MIN;
            const bf16_t* kp = KB + (size_t)(h * 2 + half) * 16384 + (size_t)lq * 128 + 8 * hh;
#pragma unroll 1
            for (int tile = 0; tile < 4; ++tile) {
                f32x16 acc;
#pragma unroll
                for (int r = 0; r < 16; ++r) acc[r] = 0.f;
#pragma unroll
                for (int s = 0; s < 8; ++s) { const bf16x8 a = *(const bf16x8*)(kp + (size_t)tile * 32 * 128 + 16 * s); acc = __builtin_amdgcn_mfma_f32_32x32x16_bf16(a, qf[s], acc, 0, 0, 0); }
#pragma unroll
                for (int r = 0; r < 16; ++r) { const int key = 32 * tile + (r & 3) + 8 * (r >> 2) + 4 * hh; INS16(L, okey(acc[r], 127 - key, 127)); }
            }
#pragma unroll
            for (int k = 0; k < 8; ++k) { const int a = swap32i(L[15 - k]), b = swap32i(L[k]); L[k] = max(L[k], a); L[15 - k] = max(L[15 - k], b); }
            BITONIC16(L);
#pragma unroll
            for (int j = 0; j < 16; ++j) XY[half][j] = L[j];
        }
        { u32x4 pk[2];
#pragma unroll
          for (int half = 0; half < 2; ++half) { const int* L = XY[half];
            pk[half].x = (unsigned)(127 - (L[0] & 127)) | ((unsigned)(127 - (L[1] & 127)) << 8) | ((unsigned)(127 - (L[2] & 127)) << 16) | ((unsigned)(127 - (L[3] & 127)) << 24);
            pk[half].y = (unsigned)(127 - (L[4] & 127)) | ((unsigned)(127 - (L[5] & 127)) << 8) | ((unsigned)(127 - (L[6] & 127)) << 16) | ((unsigned)(127 - (L[7] & 127)) << 24);
            pk[half].z = (unsigned)(127 - (L[8] & 127)) | ((unsigned)(127 - (L[9] & 127)) << 8) | ((unsigned)(127 - (L[10] & 127)) << 16) | ((unsigned)(127 - (L[11] & 127)) << 24);
            pk[half].w = (unsigned)(127 - (L[12] & 127)) | ((unsigned)(127 - (L[13] & 127)) << 8) | ((unsigned)(127 - (L[14] & 127)) << 16) | ((unsigned)(127 - (L[15] & 127)) << 24); }
          *(LAS u32x4*)(idxb + l * 32) = pk[0]; *(LAS u32x4*)(idxb + l * 32 + 16) = pk[1]; }
        float X[16], Y[16];
#pragma unroll
        for (int j = 0; j < 16; ++j) { X[j] = okey_val(XY[0][j], 127); Y[j] = okey_val(XY[1][j], 127); }
        int M[16];
#pragma unroll
        for (int j = 0; j < 16; ++j) M[j] = INT_MIN;
#define CAND(i, j) do { const float sm = hh ? (X[j] + Y[i]) : (X[i] + Y[j]); const int pos = hh ? ((j) * 16 + (i)) : ((i) * 16 + (j)); int key = okey(sm, 255 - pos, 255); if ((i) == (j) && hh) key = INT_MIN; INS16(M, key); } while (0)
        CAND(0, 0); CAND(0, 1); CAND(0, 2); CAND(0, 3); CAND(0, 4); CAND(0, 5); CAND(0, 6); CAND(0, 7); CAND(0, 8); CAND(0, 9); CAND(0, 10); CAND(0, 11); CAND(0, 12); CAND(0, 13); CAND(0, 14); CAND(0, 15);
        CAND(1, 1); CAND(1, 2); CAND(1, 3); CAND(1, 4); CAND(1, 5); CAND(1, 6); CAND(1, 7);
        CAND(2, 2); CAND(2, 3); CAND(2, 4);
        CAND(3, 3);
#undef CAND
        int TK[16];
#pragma unroll
        for (int k = 0; k < 16; ++k) TK[k] = max(M[k], swap32i(M[15 - k]));
        float sv[16]; float mx = -INFINITY;
#pragma unroll
        for (int k = 0; k < 16; ++k) { sv[k] = okey_val(TK[k], 255); mx = fmaxf(mx, sv[k]); }
        float den = 0.f;
#pragma unroll
        for (int k = 0; k < 16; ++k) { sv[k] = __expf(sv[k] - mx); den += sv[k]; }
        const float rden = 1.0f / den;
        LDS_WAIT(); asm volatile("" ::: "memory");
        const LAS unsigned char* ib = idxb + l * 32;
        unsigned* dst = EXPO + (size_t)t * 128 + h * 16 + hh * 8;
        u32x4 o0, o1; unsigned ov[8];
#pragma unroll
        for (int k = 0; k < 8; ++k) { const int pos = 255 - (TK[k] & 255); const unsigned i1 = ib[pos >> 4], i2 = ib[16 + (pos & 15)];
            ov[k] = (__float_as_uint(sv[k] * rden) & ~0x3fffu) | (i1 * 128u + i2); }
        o0 = (u32x4){ov[0], ov[1], ov[2], ov[3]}; o1 = (u32x4){ov[4], ov[5], ov[6], ov[7]};
        *(u32x4*)dst = o0; *(u32x4*)(dst + 4) = o1;
        LDS_WAIT(); asm volatile("" ::: "memory");
    }
}

__device__ __forceinline__ void cvt_rows_fp8(Frame& F, const float* src, unsigned char* dst, float* rscale) {
    const int l = F.lane; const int gw = F.vcu * NWAVES + F.wave, NGW = F.G * NWAVES;
    for (int e = gw; e < 16384; e += NGW) {
        const f32x4* sp = (const f32x4*)(src + (size_t)e * 1024 + 16 * l);
        const f32x4 a = sp[0], b = sp[1], c = sp[2], d = sp[3];
        float m = fmaxf(fmaxf(fmaxf(fabsf(a[0]), fabsf(a[1])), fmaxf(fabsf(a[2]), fabsf(a[3]))), fmaxf(fmaxf(fabsf(b[0]), fabsf(b[1])), fmaxf(fabsf(b[2]), fabsf(b[3]))));
        m = fmaxf(m, fmaxf(fmaxf(fmaxf(fabsf(c[0]), fabsf(c[1])), fmaxf(fabsf(c[2]), fabsf(c[3]))), fmaxf(fmaxf(fabsf(d[0]), fabsf(d[1])), fmaxf(fabsf(d[2]), fabsf(d[3])))));
#pragma unroll
        for (int o = 1; o < 64; o <<= 1) m = fmaxf(m, __shfl_xor(m, o));
        const float t = 448.0f / fmaxf(m, 1e-30f); const float s = __uint_as_float(__float_as_uint(t) & 0x7f800000u);
        u32x4 w; int x;
        x = __builtin_amdgcn_cvt_pk_fp8_f32(a[0] * s, a[1] * s, 0, false); x = __builtin_amdgcn_cvt_pk_fp8_f32(a[2] * s, a[3] * s, x, true); w.x = (unsigned)x;
        x = __builtin_amdgcn_cvt_pk_fp8_f32(b[0] * s, b[1] * s, 0, false); x = __builtin_amdgcn_cvt_pk_fp8_f32(b[2] * s, b[3] * s, x, true); w.y = (unsigned)x;
        x = __builtin_amdgcn_cvt_pk_fp8_f32(c[0] * s, c[1] * s, 0, false); x = __builtin_amdgcn_cvt_pk_fp8_f32(c[2] * s, c[3] * s, x, true); w.z = (unsigned)x;
        x = __builtin_amdgcn_cvt_pk_fp8_f32(d[0] * s, d[1] * s, 0, false); x = __builtin_amdgcn_cvt_pk_fp8_f32(d[2] * s, d[3] * s, x, true); w.w = (unsigned)x;
        *(u32x4*)(dst + (size_t)e * 1024 + 16 * l) = w;
        if (l == 0) rscale[e] = 1.0f / s;
    }
}

__device__ __forceinline__ float gelu_tanh(float x) { const float y = 0.7978845608028654f * (x + 0.044715f * x * x * x); return x * __builtin_amdgcn_rcpf(1.0f + __expf(-2.0f * y)); }
#define FP8_UNPACK16(W, f) do { f32x2 _t; \
    _t = __builtin_amdgcn_cvt_pk_f32_fp8((int)(W).x, false); f[0] = _t[0]; f[1] = _t[1]; _t = __builtin_amdgcn_cvt_pk_f32_fp8((int)(W).x, true); f[2] = _t[0]; f[3] = _t[1]; \
    _t = __builtin_amdgcn_cvt_pk_f32_fp8((int)(W).y, false); f[4] = _t[0]; f[5] = _t[1]; _t = __builtin_amdgcn_cvt_pk_f32_fp8((int)(W).y, true); f[6] = _t[0]; f[7] = _t[1]; \
    _t = __builtin_amdgcn_cvt_pk_f32_fp8((int)(W).z, false); f[8] = _t[0]; f[9] = _t[1]; _t = __builtin_amdgcn_cvt_pk_f32_fp8((int)(W).z, true); f[10] = _t[0]; f[11] = _t[1]; \
    _t = __builtin_amdgcn_cvt_pk_f32_fp8((int)(W).w, false); f[12] = _t[0]; f[13] = _t[1]; _t = __builtin_amdgcn_cvt_pk_f32_fp8((int)(W).w, true); f[14] = _t[0]; f[15] = _t[1]; } while (0)
__device__ __forceinline__ float sum_swap32(float a, float b) { auto r = __builtin_amdgcn_permlane32_swap(__float_as_uint(a), __float_as_uint(b), false, false); return __uint_as_float(r[0]) + __uint_as_float(r[1]); }
__device__ __forceinline__ float sum_swap16(float a, float b) { auto r = __builtin_amdgcn_permlane16_swap(__float_as_uint(a), __float_as_uint(b), false, false); return __uint_as_float(r[0]) + __uint_as_float(r[1]); }
template <int M> __device__ __forceinline__ unsigned sxu(unsigned v, int lane) {
    if constexpr (M == 32) { auto r = __builtin_amdgcn_permlane32_swap(v, v, false, false); return (lane & 32) ? r[0] : r[1]; }
    else return (unsigned)__builtin_amdgcn_ds_swizzle((int)v, (M << 10) | 0x1f);
}
template <int M> __device__ __forceinline__ float sxf(float v, int lane) { return __uint_as_float(sxu<M>(__float_as_uint(v), lane)); }
__device__ __forceinline__ float wave_sum_sx(float v, int lane) { v += sxf<1>(v, lane); v += sxf<2>(v, lane); v += sxf<4>(v, lane); v += sxf<8>(v, lane); v += sxf<16>(v, lane); v += sxf<32>(v, lane); return v; }
#ifndef PG_TOK
#define PG_TOK 4
#endif
template <class Bar>
__device__ __forceinline__ void phase_peer_gather(Frame& F, const Bar& bar, bool use_bar) {
    const unsigned char* UB = WSP(unsigned char, WS_UB8); const unsigned char* VB = WSP(unsigned char, WS_VB8); const float* RSU = WSP(float, WS_RSU); const float* RSV = WSP(float, WS_RSV);
    const unsigned* EXPO = WSP(unsigned, WS_EXP);
    const bf16_t* H1G = WSP(bf16_t, WS_H1G); bf16_t* XN3 = WSP(bf16_t, WS_XN3); const float* H1 = WSP(float, WS_H1); float* H2 = F.out; const float* SSQ1 = WSP(float, WS_SSQ1); const float* g_ple = F.in[16];
    const int l = F.lane; const int ntok_wg = T_TOK / F.G;
#pragma unroll 1
    for (int ti = F.wave * PG_TOK; ti < ntok_wg; ti += NWAVES * PG_TOK) {
        if (use_bar && ti >= NWAVES * PG_TOK) xcd_barrier(bar, F.tid); else __syncthreads();
        float acc[PG_TOK][16];
        LAS unsigned* lent = (LAS unsigned*)(F.lds + RING_OFF + F.wave * (2048 * PG_TOK)); LAS float* lcu = (LAS float*)(lent + 128 * PG_TOK); LAS float* lcv = lcu + 128 * PG_TOK; LAS float* acl = lcv + 128 * PG_TOK;
        LAS unsigned* lx = (LAS unsigned*)(F.lds + RING_OFF + NWAVES * 2048 * PG_TOK + F.wave * (2048 * PG_TOK));
#pragma unroll
        for (int tk = 0; tk < PG_TOK; ++tk) { const int t = F.vcu * ntok_wg + ti + tk;
            const u32x4 xa = *(const u32x4*)(H1G + (size_t)t * 1024 + 16 * l), xb = *(const u32x4*)(H1G + (size_t)t * 1024 + 16 * l + 8);
            *(LAS u32x4*)(lx + tk * 512 + l * 8) = xa; *(LAS u32x4*)(lx + tk * 512 + l * 8 + 4) = xb;
#pragma unroll
            for (int i = 0; i < 16; ++i) acc[tk][i] = 0.f; }
#pragma unroll 1
        for (int tk = 0; tk < PG_TOK; ++tk) { const int t = F.vcu * ntok_wg + ti + tk;
            const f32x4* sp = (const f32x4*)(SSQ1 + (size_t)t * 16); const f32x4 st = (sp[0] + sp[1]) + (sp[2] + sp[3]); const float rstd1 = __builtin_amdgcn_rsqf(((st[0] + st[1]) + (st[2] + st[3])) * (1.0f / 1024.0f) + EPS);
            unsigned a0 = EXPO[(size_t)t * 128 + l], a1 = EXPO[(size_t)t * 128 + 64 + l];
            { unsigned s0 = (a0 << 18) | (a0 >> 14), s1 = (a1 << 18) | (a1 >> 14);
              int ls = l; asm volatile("" : "+v"(ls));
#define BSTEP(K, J) do { const bool up = (ls & (J)) != 0; const unsigned p0 = sxu<J>(s0, ls), p1 = sxu<J>(s1, ls); \
                  const bool asc0 = (ls & (K)) == 0, asc1 = ((ls + 64) & (K)) == 0; \
                  s0 = (up == asc0) ? max(s0, p0) : min(s0, p0); s1 = (up == asc1) ? max(s1, p1) : min(s1, p1); } while (0)
              BSTEP(2, 1);
              BSTEP(4, 2); BSTEP(4, 1);
              BSTEP(8, 4); BSTEP(8, 2); BSTEP(8, 1);
              BSTEP(16, 8); BSTEP(16, 4); BSTEP(16, 2); BSTEP(16, 1);
              BSTEP(32, 16); BSTEP(32, 8); BSTEP(32, 4); BSTEP(32, 2); BSTEP(32, 1);
              BSTEP(64, 32); BSTEP(64, 16); BSTEP(64, 8); BSTEP(64, 4); BSTEP(64, 2); BSTEP(64, 1);
              { const unsigned lo = min(s0, s1), hi = max(s0, s1); s0 = lo; s1 = hi; }
              BSTEP(128, 32); BSTEP(128, 16); BSTEP(128, 8); BSTEP(128, 4); BSTEP(128, 2); BSTEP(128, 1);
#undef BSTEP
              a0 = (s0 >> 18) | (s0 << 14); a1 = (s1 >> 18) | (s1 << 14); }
            lent[tk * 128 + l] = a0; lent[tk * 128 + 64 + l] = a1;
            lcu[tk * 128 + l] = RSU[a0 & 0x3fffu] * rstd1; lcu[tk * 128 + 64 + l] = RSU[a1 & 0x3fffu] * rstd1;
            lcv[tk * 128 + l] = RSV[a0 & 0x3fffu] * __uint_as_float(a0 & ~0x3fffu); lcv[tk * 128 + 64 + l] = RSV[a1 & 0x3fffu] * __uint_as_float(a1 & ~0x3fffu); }
        LDS_WAIT(); asm volatile("" ::: "memory");
        u32x4 buf0[8], buf1[8];
#define ROWS8(BUF, TAB, tk, eb) do { const u32x4 ea_ = *(const LAS u32x4*)(lent + (tk) * 128 + (eb)), eb_ = *(const LAS u32x4*)(lent + (tk) * 128 + (eb) + 4); \
            const unsigned en_[8] = {ea_.x, ea_.y, ea_.z, ea_.w, eb_.x, eb_.y, eb_.z, eb_.w}; \
            _Pragma("unroll") for (int k = 0; k < 8; ++k) BUF[k] = *(const u32x4*)((TAB) + ((en_[k] & 0x3fffu) * 1024u + 16u * (unsigned)l)); } while (0)
#define U8(BUF, tk, eb) do { float p[8]; const u32x4 xa_ = *(const LAS u32x4*)(lx + (tk) * 512 + l * 8), xb_ = *(const LAS u32x4*)(lx + (tk) * 512 + l * 8 + 4); \
            const unsigned xq[8] = {xa_.x, xa_.y, xa_.z, xa_.w, xb_.x, xb_.y, xb_.z, xb_.w}; \
            _Pragma("unroll") for (int k = 0; k < 8; ++k) { float f[16]; FP8_UNPACK16(BUF[k], f); float s = 0.f; \
                _Pragma("unroll") for (int i = 0; i < 8; ++i) s = __builtin_amdgcn_fdot2_f32_bf16(__builtin_bit_cast(bf16x2_t, cvtpk(f[2 * i], f[2 * i + 1])), __builtin_bit_cast(bf16x2_t, xq[i]), s, false); \
                p[k] = s; if (k & 1) __builtin_amdgcn_sched_barrier(0); } \
            float q4[4], q2[2], q1; \
            _Pragma("unroll") for (int j = 0; j < 4; ++j) q4[j] = sum_swap32(p[j], p[4 + j]); \
            _Pragma("unroll") for (int j = 0; j < 2; ++j) q2[j] = sum_swap16(q4[j], q4[2 + j]); \
            { const bool up = (l & 8) != 0; const float keep = up ? q2[1] : q2[0], send = up ? q2[0] : q2[1]; q1 = keep + sxf<8>(send, l); } \
            q1 += sxf<4>(q1, l); q1 += sxf<2>(q1, l); q1 += sxf<1>(q1, l); \
            const float cu = lcu[(tk) * 128 + (eb) + (l >> 3)], cv = lcv[(tk) * 128 + (eb) + (l >> 3)]; \
            const float a_ = gelu_tanh(q1 * cu) * cv; if ((l & 7) == 0) acl[(tk) * 128 + (eb) + (l >> 3)] = a_; __builtin_amdgcn_sched_barrier(0); } while (0)
#define V8(BUF, tk, eb) do { const float av = acl[(tk) * 128 + (eb) + (l & 7)]; \
            _Pragma("unroll") for (int k = 0; k < 8; ++k) { const float ak = __uint_as_float(__builtin_amdgcn_readlane(__float_as_uint(av), k)); float f[16]; FP8_UNPACK16(BUF[k], f); \
                _Pragma("unroll") for (int i = 0; i < 16; ++i) acc[tk][i] += ak * f[i]; if (k & 1) __builtin_amdgcn_sched_barrier(0); } } while (0)
        ROWS8(buf0, UB, 0, 0);
#if PG_TOK == 4
#define TURNS4(CONS, TAB, eb, NEXT) do { ROWS8(buf1, TAB, 1, eb); CONS(buf0, 0, eb); ROWS8(buf0, TAB, 2, eb); CONS(buf1, 1, eb); ROWS8(buf1, TAB, 3, eb); CONS(buf0, 2, eb); NEXT; CONS(buf1, 3, eb); } while (0)
#pragma unroll 1
        for (int eb = 0; eb < 120; eb += 8) TURNS4(U8, UB, eb, ROWS8(buf0, UB, 0, eb + 8));
        TURNS4(U8, UB, 120, ROWS8(buf0, VB, 0, 0));
        LDS_WAIT(); asm volatile("" ::: "memory");
#pragma unroll 1
        for (int eb = 0; eb < 120; eb += 8) TURNS4(V8, VB, eb, ROWS8(buf0, VB, 0, eb + 8));
        TURNS4(V8, VB, 120, (void)0);
#undef TURNS4
#elif PG_TOK == 2
#define TURNS2(CONS, TAB, eb, NEXT) do { ROWS8(buf1, TAB, 1, eb); CONS(buf0, 0, eb); NEXT; CONS(buf1, 1, eb); } while (0)
#pragma unroll 1
        for (int eb = 0; eb < 120; eb += 8) TURNS2(U8, UB, eb, ROWS8(buf0, UB, 0, eb + 8));
        TURNS2(U8, UB, 120, ROWS8(buf0, VB, 0, 0));
        LDS_WAIT(); asm volatile("" ::: "memory");
#pragma unroll 1
        for (int eb = 0; eb < 120; eb += 8) TURNS2(V8, VB, eb, ROWS8(buf0, VB, 0, eb + 8));
        TURNS2(V8, VB, 120, (void)0);
#undef TURNS2
#else
#error PG_TOK must be 2 or 4
#endif
#undef ROWS8
#undef U8
#undef V8
#pragma unroll
        for (int tk = 0; tk < PG_TOK; ++tk) { const int t = F.vcu * ntok_wg + ti + tk;
            const float* hrow = H1 + (size_t)t * 1024 + 16 * l; float* h2row = H2 + (size_t)t * 1024 + 16 * l; float ss = 0.f; f32x4 h[4];
#pragma unroll
            for (int q = 0; q < 4; ++q) { h[q] = *(const f32x4*)(hrow + 4 * q);
#pragma unroll
                for (int j = 0; j < 4; ++j) { h[q][j] += acc[tk][4 * q + j]; ss += h[q][j] * h[q][j]; }
                if (!F.dry) *(f32x4*)(h2row + 4 * q) = h[q]; }
            const float rstd3 = __builtin_amdgcn_rsqf(wave_sum_sx(ss, l) * (1.0f / 1024.0f) + EPS);
            u32x4 o[2];
#pragma unroll
            for (int q2 = 0; q2 < 2; ++q2) { const f32x4 g0 = *(const f32x4*)(g_ple + 16 * l + 8 * q2), g1 = *(const f32x4*)(g_ple + 16 * l + 8 * q2 + 4);
                const f32x4 a = h[2 * q2] * rstd3 * g0, c = h[2 * q2 + 1] * rstd3 * g1;
                o[q2].x = cvtpk(a[0], a[1]); o[q2].y = cvtpk(a[2], a[3]); o[q2].z = cvtpk(c[0], c[1]); o[q2].w = cvtpk(c[2], c[3]); }
            if (!F.dry) { *(u32x4*)(XN3 + (size_t)t * 1024 + 16 * l) = o[0]; *(u32x4*)(XN3 + (size_t)t * 1024 + 16 * l + 8) = o[1]; } }
    }
}

__device__ __forceinline__ void phase_final(Frame& F) {
    const float* SSQ3 = WSP(float, WS_SSQ3); const float* g = F.in[19];
    const int l = F.lane; const int gw = F.vcu * NWAVES + F.wave, NGW = F.G * NWAVES;
    for (int t = gw; t < T_TOK; t += NGW) {
        const f32x4* sp = (const f32x4*)(SSQ3 + (size_t)t * 16); const f32x4 st = (sp[0] + sp[1]) + (sp[2] + sp[3]);
        const float rstd = __builtin_amdgcn_rsqf(((st[0] + st[1]) + (st[2] + st[3])) * (1.0f / 1024.0f) + EPS);
        f32x4* row = (f32x4*)(F.out + (size_t)t * 1024);
#pragma unroll
        for (int j = 0; j < 4; ++j) { const f32x4 gv = *((const f32x4*)g + l + 64 * j); const f32x4 o = row[l + 64 * j] * rstd * gv; if (!F.dry) row[l + 64 * j] = o; }
    }
}
#ifndef MK_FUSED
#define MK_FUSED 1
#endif
constexpr int NPHASE = 11;
struct Args { const float* in[20]; float* out; unsigned char* ws; int ph_lo, ph_hi, dry, pad; };
static_assert(sizeof(Args) == 20 * 8 + 8 + 8 + 4 * 4, "Args has no padding");

__global__ void __launch_bounds__(NWAVES * 64, 2) mk_fwd(Args args) {
    extern __shared__ __attribute__((aligned(16))) unsigned char lds_raw[];
    Frame F;
    F.lds = (LAS unsigned char*)lds_raw;
    F.wave = __builtin_amdgcn_readfirstlane(threadIdx.x >> 6); F.lane = lane_id(); F.tid = F.wave * 64 + F.lane;
    F.G = gridDim.x; { const int bx = blockIdx.x; F.vcu = (F.G % 8 == 0) ? (bx % 8) * (F.G / 8) + bx / 8 : bx; }
    F.in = args.in; F.out = args.out; F.ws = args.ws; F.dry = args.dry;
    volatile LAS unsigned* MISC = (volatile LAS unsigned*)(F.lds + MISC_OFF);
    if (F.tid < 64) MISC[F.tid] = 0u;
    __syncthreads();
    const int lo = args.ph_lo, hi = args.ph_hi;
    XcdBarrier bar; bar.bar = (unsigned*)(F.ws + WS_CTL) + CW_BAR; bar.x = 0; bar.st = nullptr;
    if (hi - lo > 1) bar = xcd_barrier_post((unsigned*)(F.ws + WS_CTL) + CW_BAR, MISC + 8, F.tid);
#ifndef PH_MASK
#define PH_MASK 0xFFFFFFFFu
#endif
#define IN(k) (((PH_MASK >> (k)) & 1u) && lo <= (k) && (k) < hi)
#define LAUNDER(p, T) do { unsigned _lo = (unsigned)(unsigned long long)(p), _hi = (unsigned)((unsigned long long)(p) >> 32); asm volatile("" : "+v"(_lo), "+v"(_hi)); \
        _lo = __builtin_amdgcn_readfirstlane(_lo); _hi = __builtin_amdgcn_readfirstlane(_hi); (p) = (T)(((unsigned long long)_hi << 32) | _lo); } while (0)
#define SEAM(k) do { if (IN(k) && IN((k) + 1)) xcd_barrier(bar, F.tid); LAUNDER(F.ws, unsigned char*); LAUNDER(F.out, float*); F.lane = lane_id(); F.tid = F.wave * 64 + F.lane; } while (0)
    const int bx = (int)blockIdx.x;
    LAS unsigned char* ring = F.lds + RING_OFF;

    if (IN(0)) { phase_prologue(F); } SEAM(0);
    if (IN(1)) {
        pg8::Gemm g{WSP(bf16_t, WS_XN1), WSP(bf16_t, WS_WIN), T_TOK, 8192, 1024, 1024, 0, 2, 8}; pg8::StaticOrder S; S.init(T_TOK, 8192, F.G, bx);
        pg8::EpiProj E{WSP(bf16_t, WS_GQ), WSP(bf16_t, WS_GK), WSP(bf16_t, WS_GV), WSP(bf16_t, WS_GR), WSP(bf16_t, WS_SQ), WSP(bf16_t, WS_SK), WSP(bf16_t, WS_SV),
                       (bf16_t*)F.out, (bf16_t*)F.out + (size_t)T_TOK * 1024};
        pg8::gemm_phase<pg8::EpiProj>(ring, g, S, E, F.tid);
    } SEAM(1);
    if (IN(2)) { phase_gla_prep(F); } SEAM(2);
    if (IN(3)) { phase_attn_a(F); } SEAM(3);
    if (IN(4)) { phase_attn_b(F); } SEAM(4);
    if (IN(5)) {
        cvt_rows_fp8(F, F.in[14], WSP(unsigned char, WS_UB8), WSP(float, WS_RSU));
        cvt_rows_fp8(F, F.in[15], WSP(unsigned char, WS_VB8), WSP(float, WS_RSV));
        VM_WAIT(); __syncthreads();
        pg8::StaticOrder S; S.init(T_TOK, 1024, F.G, bx);
        { pg8::Gemm g{WSP(bf16_t, WS_GLAN), WSP(bf16_t, WS_WGA), T_TOK, 1024, 1024, 1024, 0, 0, 0}; pg8::EpiMix<true> E{(const bf16_t*)F.out, WSP(bf16_t, WS_MIX)};
          pg8::gemm_phase<pg8::EpiMix<true>>(ring, g, S, E, F.tid); }
        { pg8::Gemm g{WSP(bf16_t, WS_SQ), WSP(bf16_t, WS_WSB), T_TOK, 1024, 1024, 1024, 0, 0, 0}; pg8::EpiMix<false> E{(const bf16_t*)F.out + (size_t)T_TOK * 1024, WSP(bf16_t, WS_MIX)};
          pg8::gemm_phase<pg8::EpiMix<false>>(ring, g, S, E, F.tid); }
    } SEAM(5);
    if (IN(6)) {
        pg8::Gemm g{WSP(bf16_t, WS_MIX), WSP(bf16_t, WS_WO), T_TOK, 1024, 1024, 1024, 0, 0, 0}; pg8::StaticOrder S; S.init(T_TOK, 1024, F.G, bx);
        pg8::EpiH1 E{F.in[0], F.in[10], WSP(float, WS_H1), WSP(bf16_t, WS_H1G), WSP(float, WS_SSQ1)};
        pg8::gemm_phase<pg8::EpiH1>(ring, g, S, E, F.tid);
    } SEAM(6);
    if (IN(7)) {
        pg8::Gemm g{WSP(bf16_t, WS_H1G), WSP(bf16_t, WS_WPQ), T_TOK, 2048, 1024, 1024, 0, 0, 0}; pg8::StaticOrder S; S.init(T_TOK, 2048, F.G, bx);
        pg8::EpiQ E{WSP(float, WS_SSQ1), WSP(bf16_t, WS_Q), 2048};
        pg8::gemm_phase<pg8::EpiQ>(ring, g, S, E, F.tid);
    } SEAM(7);
    if (IN(8)) {
        cvt_copy(F, F.in[1], WSP(bf16_t, WS_PB), (size_t)T_TOK * 256);
        phase_peer_retrieve(F);
        VM_WAIT(); __syncthreads();
        phase_peer_gather(F, bar, false);
    } SEAM(8);
    if (IN(9)) {
        pg8::StaticOrder S; S.init(T_TOK, 1024, F.G, bx);
        { pg8::Gemm g{WSP(bf16_t, WS_PB), WSP(bf16_t, WS_WPLE), T_TOK, 1024, 256, 256, 0, 0, 0}; pg8::EpiBf E{WSP(bf16_t, WS_PLE), 1024};
          pg8::gemm_phase<pg8::EpiBf>(ring, g, S, E, F.tid); }
        { pg8::Gemm g{WSP(bf16_t, WS_XN3), WSP(bf16_t, WS_WPG), T_TOK, 1024, 1024, 1024, 0, 0, 0}; pg8::EpiH3 E{F.out, WSP(bf16_t, WS_PLE), F.out, WSP(float, WS_SSQ3), F.dry};
          pg8::gemm_phase<pg8::EpiH3>(ring, g, S, E, F.tid); }
    } SEAM(9);
    if (IN(10)) { phase_final(F); }
#undef IN
#undef SEAM
}

extern "C" void kernel_launch(void* const* d_in, const int* in_sizes, int n_in, void* d_out, int out_size, void* d_ws, size_t ws_size, hipStream_t stream) {
    static int grid = 0;
    if (grid == 0) {
        if (n_in != 20 || in_sizes[0] != T_TOK * 1024 || out_size != T_TOK * 1024 || ws_size < WS_END) {
            fprintf(stderr, "kernel_launch: unexpected shapes (n_in %d, in0 %d, out %d, ws %zu < %zu?); nothing launched\n", n_in, n_in > 0 ? in_sizes[0] : -1, out_size, ws_size, (size_t)WS_END); grid = -1; return; }
        int dev = 0, cus = 0, per_cu = 0;
        if (hipGetDevice(&dev) != hipSuccess || hipDeviceGetAttribute(&cus, hipDeviceAttributeMultiprocessorCount, dev) != hipSuccess) { grid = -1; return; }
        if (hipFuncSetAttribute((const void*)mk_fwd, hipFuncAttributeMaxDynamicSharedMemorySize, LDS_BYTES) != hipSuccess) { fprintf(stderr, "kernel_launch: hipFuncSetAttribute failed\n"); grid = -1; return; }
        if (hipOccupancyMaxActiveBlocksPerMultiprocessor(&per_cu, (const void*)mk_fwd, NWAVES * 64, LDS_BYTES) != hipSuccess || per_cu < 1)
            fprintf(stderr, "kernel_launch: note: occupancy query reports %d workgroups per CU\n", per_cu);
        (void)hipGetLastError();
        grid = cus;
        if (grid != 256) fprintf(stderr, "kernel_launch: note: %d CUs (kernel tuned for 256)\n", grid);
    }
    if (grid < 0) return;
    if (hipMemsetAsync((char*)d_ws + WS_CTL, 0, CTL_ZERO_BYTES, stream) != hipSuccess) { fprintf(stderr, "kernel_launch: hipMemsetAsync failed\n"); return; }
    Args a{};
    for (int i = 0; i < 20; ++i) a.in[i] = (const float*)d_in[i];
    a.out = (float*)d_out; a.ws = (unsigned char*)d_ws;
#if MK_FUSED
    a.ph_lo = 0; a.ph_hi = NPHASE;
    hipLaunchKernelGGL(mk_fwd, dim3(grid), dim3(NWAVES * 64), LDS_BYTES, stream, a);
#else
#ifndef PROBE_PHASE
#define PROBE_PHASE -1
#define PROBE_REPS 0
#endif
    for (int p = 0; p < NPHASE; ++p) { a.ph_lo = p; a.ph_hi = p + 1;
        if (p == PROBE_PHASE) { a.dry = 1; for (int r = 0; r < PROBE_REPS; ++r) hipLaunchKernelGGL(mk_fwd, dim3(grid), dim3(NWAVES * 64), LDS_BYTES, stream, a); a.dry = 0; }
        hipLaunchKernelGGL(mk_fwd, dim3(grid), dim3(NWAVES * 64), LDS_BYTES, stream, a); }
#endif
}
```

```cpp
#define MK_FUSED 1
#define PG_TOK 4
#include <hip/hip_runtime.h>
#include <cstdio>
#include <cstdint>

#define LAS __attribute__((address_space(3)))
#define GAS __attribute__((address_space(1)))
typedef unsigned short bf16_t;
typedef short bf16x8 __attribute__((ext_vector_type(8)));
typedef short s16x4 __attribute__((ext_vector_type(4)));
typedef float f32x2 __attribute__((ext_vector_type(2)));
typedef float f32x4 __attribute__((ext_vector_type(4)));
typedef float f32x16 __attribute__((ext_vector_type(16)));
typedef unsigned u32x2 __attribute__((ext_vector_type(2)));
typedef unsigned u32x4 __attribute__((ext_vector_type(4)));
typedef __bf16 bf16x2_t __attribute__((ext_vector_type(2)));

__device__ __forceinline__ unsigned cvtpk(float lo, float hi) { f32x2 v = {lo, hi}; bf16x2_t b = __builtin_convertvector(v, bf16x2_t); return __builtin_bit_cast(unsigned, b); }
__device__ __forceinline__ float bf_lo(unsigned u) { return __uint_as_float(u << 16); }
__device__ __forceinline__ float bf_hi(unsigned u) { return __uint_as_float(u & 0xffff0000u); }
__device__ __forceinline__ float bf1(bf16_t u) { return __uint_as_float(((unsigned)u) << 16); }
__device__ __forceinline__ float fast_sigmoid(float x) { return __builtin_amdgcn_rcpf(1.0f + __expf(-x)); }

namespace pg8 {
constexpr int BM = 256, BK = 64, HALF = 128, HTB = HALF * BK * 2  , STAGE_BYTES = 8 * HTB, NXCD = 8, WGM = 8;

__host__ __device__ __forceinline__ int lds_byte(int r, int c) { const int st = (r >> 4) * 2 + (c >> 5), rr = r & 15, cc = c & 31, ob = rr * 64 + cc * 2; return st * 1024 + (ob ^ (((ob >> 9) & 1) << 5)); }
__host__ __device__ __forceinline__ void stage_rc(int b, int& R, int& C) { const int st = b / 1024, sb = b % 1024, swz = sb ^ (((sb >> 9) & 1) << 5); R = (st >> 1) * 16 + swz / 64; C = (st & 1) * 32 + (swz % 64) / 2; }
__host__ __device__ __forceinline__ int perm32(int rho) { const int n = rho >> 4, i = rho & 15; return 8 * (i >> 2) + 4 * n + (i & 3); }

struct Unit { int pm, pn; };
struct Gemm { const bf16_t* A; const bf16_t* Bt; int M, N, K, lda, a_pn_cols; int swap_lo, swap_hi; };

struct StaticOrder {
    int nM, nN, nwg, G, c;
    __host__ __device__ void init(int M, int N, int G_, int c_) { nM = M / BM; nN = N / BM; nwg = nM * nN; G = G_; c = c_; }
    __host__ __device__ bool next(int i, Unit& u) const {
        const long L = (long)i * G + c; if (L >= nwg) return false;
        int wgid = (int)L; { const int q = nwg / NXCD, r = nwg % NXCD, xcd = wgid % NXCD, off = wgid / NXCD; wgid = (xcd < r ? xcd * (q + 1) : r * (q + 1) + (xcd - r) * q) + off; }
        const int nig = WGM * nN, gid = wgid / nig, fm = gid * WGM, gsz = (nM - fm) < WGM ? (nM - fm) : WGM;
        u.pm = fm + ((wgid % nig) % gsz); u.pn = (wgid % nig) / gsz; return true;
    }
};

template <class Epi, bool ALIGN_EPI = true, bool SP2 = true>
__device__ __forceinline__ void gemm_phase(LAS unsigned char* lds, const Gemm g, const StaticOrder& S, const Epi& E, int tid) {
    const int wid = __builtin_amdgcn_readfirstlane(tid >> 6), lane = tid & 63, wr = wid >> 2, wc = wid & 3, fr = lane & 15, fq = lane >> 4;
    const int K = g.K, nt = K / BK, lda = g.lda;
    unsigned voffA[2], voffB[2];
#pragma unroll
    for (int i = 0; i < 2; ++i) { int R, C; stage_rc(tid * 16 + i * 8192, R, C); const int Rb = Epi::PERM ? ((R & ~31) + perm32(R & 31)) : R;
        voffA[i] = (unsigned)(R * lda + C) * 2u; voffB[i] = (unsigned)(Rb * K + C) * 2u; }
    const size_t kstep = (size_t)(BK * 2);
    const size_t hA = (size_t)HALF * lda * 2, hB = (size_t)HALF * K * 2;
    const size_t tA = 2 * hA, tB = 2 * hB;
    const size_t pnA = (size_t)g.a_pn_cols * 2;
    const unsigned ldsw = (unsigned)wid * 1024u;
    const int aoff = lds_byte(wr * 64 + fr, fq * 8), boff = lds_byte(wc * 32 + fr, fq * 8);
#define PG8_SA(b, h) (((b) * 2 + (h)) * HTB)
#define PG8_SB(b, h) ((4 + (b) * 2 + (h)) * HTB)
#define PG8_STAGE(bufoff, gbase, voff) do { _Pragma("unroll") for (int _i = 0; _i < 2; ++_i) \
        __builtin_amdgcn_global_load_lds((const unsigned*)((const char*)(gbase) + (voff)[_i]), (LAS unsigned*)(lds + (bufoff) + ldsw + _i * 8192), 16, 0, 0); } while (0)
#define PG8_LDA(dst, b, h) do { _Pragma("unroll") for (int m = 0; m < 4; ++m) _Pragma("unroll") for (int k = 0; k < 2; ++k) dst[m][k] = *(const LAS bf16x8*)(lds + PG8_SA(b, h) + aoff + m * 2048 + k * 1024); } while (0)
#define PG8_LDB(dst, b, h) do { _Pragma("unroll") for (int n = 0; n < 2; ++n) _Pragma("unroll") for (int k = 0; k < 2; ++k) dst[n][k] = *(const LAS bf16x8*)(lds + PG8_SB(b, h) + boff + n * 2048 + k * 1024); } while (0)
#define PG8_MMA(ai, bj, At, Bt) do { __builtin_amdgcn_s_setprio(1); _Pragma("unroll") for (int m = 0; m < 4; ++m) _Pragma("unroll") for (int n = 0; n < 2; ++n) _Pragma("unroll") for (int k = 0; k < 2; ++k) \
        acc[ai][bj][m][n] = __builtin_amdgcn_mfma_f32_16x16x32_bf16(Bt[n][k], At[m][k], acc[ai][bj][m][n], 0, 0, 0); __builtin_amdgcn_s_setprio(0); } while (0)
#define PG8_WAIT_V(n) asm volatile("s_waitcnt vmcnt(" #n ")" ::: "memory")
#define PG8_WAIT_L(n) asm volatile("s_waitcnt lgkmcnt(" #n ")" ::: "memory")
#define PG8_BAR __builtin_amdgcn_s_barrier()
#define PG8_SCHED __builtin_amdgcn_sched_barrier(0)
    Unit cur, nxt; int ui = 0;
    if (!S.next(0, cur)) return;
    f32x4 acc[2][2][4][2];
#pragma unroll
    for (int a = 0; a < 2; ++a)
#pragma unroll
        for (int b = 0; b < 2; ++b)
#pragma unroll
            for (int m = 0; m < 4; ++m)
#pragma unroll
                for (int n = 0; n < 2; ++n) acc[a][b][m][n] = (f32x4){0.f, 0.f, 0.f, 0.f};
    bf16x8 At[4][2], B0[2][2], B1[2][2];
#define PG8_APTR(u) (((u).pn >= g.swap_lo && (u).pn < g.swap_hi) ? (const char*)g.Bt + (size_t)(u).pn * tB : (const char*)g.A + (size_t)(u).pm * tA + (size_t)(u).pn * pnA)
#define PG8_BPTR(u) (((u).pn >= g.swap_lo && (u).pn < g.swap_hi) ? (const char*)g.A + (size_t)(u).pm * tA : (const char*)g.Bt + (size_t)(u).pn * tB)
    const char* cA = PG8_APTR(cur); const char* cB = PG8_BPTR(cur);
    if constexpr (SP2) {
        PG8_STAGE(PG8_SB(0, 0), cB, voffB); PG8_STAGE(PG8_SB(0, 1), cB + hB, voffB); PG8_STAGE(PG8_SA(0, 0), cA, voffA); PG8_STAGE(PG8_SA(0, 1), cA + hA, voffA);
        if (wr == 1) PG8_BAR;
        PG8_WAIT_V(2); PG8_BAR;
        PG8_STAGE(PG8_SB(1, 0), cB + kstep, voffB); PG8_STAGE(PG8_SA(1, 0), cA + kstep, voffA); PG8_STAGE(PG8_SB(1, 1), cB + hB + kstep, voffB);
        PG8_WAIT_V(6); PG8_BAR;
    } else {
        PG8_STAGE(PG8_SB(0, 0), cB, voffB); PG8_STAGE(PG8_SA(0, 0), cA, voffA); PG8_STAGE(PG8_SB(0, 1), cB + hB, voffB); PG8_STAGE(PG8_SA(0, 1), cA + hA, voffA);
        if (wr == 1) PG8_BAR;
        PG8_WAIT_V(4); PG8_BAR;
        PG8_STAGE(PG8_SB(1, 0), cB + kstep, voffB); PG8_STAGE(PG8_SA(1, 0), cA + kstep, voffA); PG8_STAGE(PG8_SB(1, 1), cB + hB + kstep, voffB);
        PG8_WAIT_V(6); PG8_BAR;
    }
    for (;;) {
        const bool has_next = S.next(ui + 1, nxt);
        const char* nA = has_next ? PG8_APTR(nxt) : cA; const char* nB = has_next ? PG8_BPTR(nxt) : cB;
#pragma unroll 1
        for (int t = 0; t < nt; t += 2) {
            const bool last = (t == nt - 2);
            const char* a1 = cA + (size_t)(t + 1) * kstep;
            const char* a2 = last ? nA : cA + (size_t)(t + 2) * kstep; const char* b2 = last ? nB : cB + (size_t)(t + 2) * kstep;
            const char* a3 = a2 + kstep; const char* b3 = b2 + kstep;
            if constexpr (SP2) {
            PG8_LDB(B0, 0, 0); PG8_LDB(B1, 0, 1); PG8_SCHED; PG8_LDA(At, 0, 0); PG8_STAGE(PG8_SA(1, 1), a1 + hA, voffA);
            PG8_WAIT_V(8); PG8_WAIT_L(0); PG8_BAR; PG8_MMA(0, 0, At, B0); PG8_MMA(0, 1, At, B1); PG8_BAR; PG8_SCHED;
            PG8_LDA(At, 0, 1); PG8_STAGE(PG8_SB(0, 0), b2, voffB); PG8_STAGE(PG8_SB(0, 1), b2 + hB, voffB); PG8_STAGE(PG8_SA(0, 0), a2, voffA);
            PG8_WAIT_V(8); PG8_WAIT_L(0); PG8_BAR; PG8_MMA(1, 0, At, B0); PG8_MMA(1, 1, At, B1); PG8_BAR; PG8_SCHED;
            PG8_LDB(B0, 1, 0); PG8_LDB(B1, 1, 1); PG8_SCHED; PG8_LDA(At, 1, 0); PG8_STAGE(PG8_SA(0, 1), a2 + hA, voffA);
            PG8_WAIT_V(8); PG8_WAIT_L(0); PG8_BAR; PG8_MMA(0, 0, At, B0); PG8_MMA(0, 1, At, B1); PG8_BAR; PG8_SCHED;
            PG8_LDA(At, 1, 1); PG8_STAGE(PG8_SB(1, 0), b3, voffB); PG8_STAGE(PG8_SB(1, 1), b3 + hB, voffB); PG8_STAGE(PG8_SA(1, 0), a3, voffA);
            PG8_WAIT_V(8); PG8_WAIT_L(0); PG8_BAR; PG8_MMA(1, 0, At, B0); PG8_MMA(1, 1, At, B1); PG8_BAR; PG8_SCHED;
            } else {
            PG8_LDB(B0, 0, 0); PG8_SCHED; PG8_LDA(At, 0, 0); PG8_STAGE(PG8_SA(1, 1), a1 + hA, voffA);
            PG8_WAIT_L(8); PG8_BAR; PG8_WAIT_L(0); PG8_MMA(0, 0, At, B0); PG8_BAR; PG8_SCHED;
            PG8_LDB(B1, 0, 1); PG8_STAGE(PG8_SB(0, 0), b2, voffB);
            PG8_BAR; PG8_WAIT_L(0); PG8_MMA(0, 1, At, B1); PG8_BAR;
            PG8_LDA(At, 0, 1); PG8_STAGE(PG8_SA(0, 0), a2, voffA);
            PG8_BAR; PG8_WAIT_L(0); PG8_MMA(1, 0, At, B0); PG8_BAR; PG8_SCHED;
            PG8_STAGE(PG8_SB(0, 1), b2 + hB, voffB);
            PG8_WAIT_V(6); PG8_BAR; PG8_MMA(1, 1, At, B1); PG8_BAR;
            PG8_LDB(B0, 1, 0); PG8_SCHED; PG8_LDA(At, 1, 0); PG8_STAGE(PG8_SA(0, 1), a2 + hA, voffA);
            PG8_WAIT_L(8); PG8_BAR; PG8_WAIT_L(0); PG8_MMA(0, 0, At, B0); PG8_BAR; PG8_SCHED;
            PG8_LDB(B1, 1, 1); PG8_STAGE(PG8_SB(1, 0), b3, voffB);
            PG8_BAR; PG8_WAIT_L(0); PG8_MMA(0, 1, At, B1); PG8_BAR;
            PG8_LDA(At, 1, 1); PG8_STAGE(PG8_SA(1, 0), a3, voffA);
            PG8_BAR; PG8_WAIT_L(0); PG8_MMA(1, 0, At, B0); PG8_BAR; PG8_SCHED;
            PG8_STAGE(PG8_SB(1, 1), b3 + hB, voffB);
            PG8_WAIT_V(6); PG8_BAR; PG8_MMA(1, 1, At, B1); PG8_BAR;
            }
        }
        if constexpr (ALIGN_EPI) { if (wr == 0) PG8_BAR; }
        E(acc, cur, wr, wc, fr, fq);
        if (!has_next) break;
#pragma unroll
        for (int a = 0; a < 2; ++a)
#pragma unroll
            for (int b = 0; b < 2; ++b)
#pragma unroll
                for (int m = 0; m < 4; ++m)
#pragma unroll
                    for (int n = 0; n < 2; ++n) acc[a][b][m][n] = (f32x4){0.f, 0.f, 0.f, 0.f};
        cur = nxt; cA = nA; cB = nB; ++ui;
        if constexpr (ALIGN_EPI) { if (wr == 1) PG8_BAR; }
    }
    PG8_WAIT_V(0);
    if constexpr (!ALIGN_EPI) { if (wr == 0) PG8_BAR; }
    PG8_BAR;
#undef PG8_APTR
#undef PG8_BPTR
#undef PG8_SA
#undef PG8_SB
#undef PG8_STAGE
#undef PG8_LDA
#undef PG8_LDB
#undef PG8_MMA
#undef PG8_WAIT_V
#undef PG8_WAIT_L
#undef PG8_BAR
#undef PG8_SCHED
}
}
constexpr int T_TOK = 16384, DM = 1024, SEQ = 4096, NB = 4;
constexpr float EPS = 1e-6f;
constexpr float LOG2E = 1.4426950408889634f;

namespace pg8 {
struct EpiProj {
    static constexpr bool PERM = true;
    bf16_t *GQ, *GK, *GV, *GR, *SQ, *SK, *SV, *SGA, *SGB;
    __device__ __forceinline__ void operator()(const f32x4 (&acc)[2][2][4][2], const Unit& u, int wr, int wc, int fr, int fq) const {
        const int pn = u.pn; bf16_t* base; int ldc = 1024, c0; int act = 0; float sc = 1.f;
        if (pn >= 2 && pn < 8) {
            bf16_t* tb = (pn < 4) ? GK : GV; const int f0 = ((pn < 4) ? (pn - 2) : (pn - 4)) * 256 + wr * 64 + fr, t0 = u.pm * BM + wc * 32 + 8 * fq;
#pragma unroll
            for (int ai = 0; ai < 2; ++ai)
#pragma unroll
                for (int m = 0; m < 4; ++m) { bf16_t* rowp = tb + (size_t)(f0 + ai * HALF + m * 16) * T_TOK + t0;
#pragma unroll
                    for (int bj = 0; bj < 2; ++bj) { const f32x4 v0 = acc[ai][bj][m][0], v1 = acc[ai][bj][m][1];
                        u32x4 w; w.x = cvtpk(v0[0], v0[1]); w.y = cvtpk(v0[2], v0[3]); w.z = cvtpk(v1[0], v1[1]); w.w = cvtpk(v1[2], v1[3]);
                        *(u32x4*)(rowp + bj * HALF) = w; } }
            return; }
        if (pn < 2) { base = GQ; ldc = 512; c0 = pn * 256; sc = 0.08838834764831845f; }
        else if (pn < 4) { base = GK; ldc = 512; c0 = (pn - 2) * 256; }
        else if (pn < 8) { base = GV; c0 = (pn - 4) * 256; }
        else if (pn < 12) { base = GR; c0 = (pn - 8) * 256; act = 1; }
        else if (pn < 16) { base = SQ; c0 = (pn - 12) * 256; sc = 0.125f * LOG2E; }
        else if (pn < 20) { base = SK; c0 = (pn - 16) * 256; }
        else if (pn < 24) { base = SV; c0 = (pn - 20) * 256; }
        else if (pn < 28) { base = SGA; c0 = (pn - 24) * 256; act = 2; }
        else { base = SGB; c0 = (pn - 28) * 256; act = 2; }
        const int row0 = u.pm * BM + wr * 64 + fr, col0 = c0 + wc * 32 + 8 * fq;
#pragma unroll
        for (int ai = 0; ai < 2; ++ai)
#pragma unroll
            for (int m = 0; m < 4; ++m) { bf16_t* rowp = base + (size_t)(row0 + ai * HALF + m * 16) * ldc + col0;
#pragma unroll
                for (int bj = 0; bj < 2; ++bj) { f32x4 v0 = acc[ai][bj][m][0], v1 = acc[ai][bj][m][1];
                    if (act == 1) {
#pragma unroll
                        for (int j = 0; j < 4; ++j) { v0[j] = v0[j] * fast_sigmoid(v0[j]); v1[j] = v1[j] * fast_sigmoid(v1[j]); } }
                    else if (act == 2) {
#pragma unroll
                        for (int j = 0; j < 4; ++j) { v0[j] = fast_sigmoid(v0[j]); v1[j] = fast_sigmoid(v1[j]); } }
                    else { v0 = v0 * sc; v1 = v1 * sc; }
                    u32x4 w; w.x = cvtpk(v0[0], v0[1]); w.y = cvtpk(v0[2], v0[3]); w.z = cvtpk(v1[0], v1[1]); w.w = cvtpk(v1[2], v1[3]);
                    *(u32x4*)(rowp + bj * HALF) = w; } }
    }
};
template <bool FIRST> struct EpiMix {
    static constexpr bool PERM = true;
    const bf16_t* gate; bf16_t* mixed;
    __device__ __forceinline__ void operator()(const f32x4 (&acc)[2][2][4][2], const Unit& u, int wr, int wc, int fr, int fq) const {
        const int row0 = u.pm * BM + wr * 64 + fr, col0 = u.pn * BM + wc * 32 + 8 * fq;
#pragma unroll
        for (int ai = 0; ai < 2; ++ai)
#pragma unroll
            for (int m = 0; m < 4; ++m) { const size_t off = (size_t)(row0 + ai * HALF + m * 16) * 1024 + col0;
#pragma unroll
                for (int bj = 0; bj < 2; ++bj) { const f32x4 a0 = acc[ai][bj][m][0], a1 = acc[ai][bj][m][1];
                    const u32x4 gv = *(const u32x4*)(gate + off + bj * HALF);
                    float r[8];
                    r[0] = a0[0] * bf_lo(gv.x); r[1] = a0[1] * bf_hi(gv.x); r[2] = a0[2] * bf_lo(gv.y); r[3] = a0[3] * bf_hi(gv.y);
                    r[4] = a1[0] * bf_lo(gv.z); r[5] = a1[1] * bf_hi(gv.z); r[6] = a1[2] * bf_lo(gv.w); r[7] = a1[3] * bf_hi(gv.w);
                    if (!FIRST) { const u32x4 mv = *(const u32x4*)(mixed + off + bj * HALF);
                        r[0] += bf_lo(mv.x); r[1] += bf_hi(mv.x); r[2] += bf_lo(mv.y); r[3] += bf_hi(mv.y); r[4] += bf_lo(mv.z); r[5] += bf_hi(mv.z); r[6] += bf_lo(mv.w); r[7] += bf_hi(mv.w); }
                    u32x4 w; w.x = cvtpk(r[0], r[1]); w.y = cvtpk(r[2], r[3]); w.z = cvtpk(r[4], r[5]); w.w = cvtpk(r[6], r[7]);
                    *(u32x4*)(mixed + off + bj * HALF) = w; } }
    }
};
struct EpiH1 {
    static constexpr bool PERM = false;
    const float* x; const float* g; float* H1; bf16_t* H1G; float* SSQ;
    __device__ __forceinline__ void operator()(const f32x4 (&acc)[2][2][4][2], const Unit& u, int wr, int wc, int fr, int fq) const {
        const int row0 = u.pm * BM + wr * 64 + fr, col0 = u.pn * BM + wc * 32 + 4 * fq;
        f32x4 gv[2][2];
#pragma unroll
        for (int bj = 0; bj < 2; ++bj)
#pragma unroll
            for (int n = 0; n < 2; ++n) gv[bj][n] = *(const f32x4*)(g + col0 + bj * HALF + n * 16);
#pragma unroll
        for (int ai = 0; ai < 2; ++ai)
#pragma unroll
            for (int m = 0; m < 4; ++m) { const int row = row0 + ai * HALF + m * 16; const size_t off = (size_t)row * 1024 + col0; float s = 0.f;
#pragma unroll
                for (int bj = 0; bj < 2; ++bj)
#pragma unroll
                    for (int n = 0; n < 2; ++n) { const f32x4 xv = *(const f32x4*)(x + off + bj * HALF + n * 16); const f32x4 h = xv + acc[ai][bj][m][n];
                        *(f32x4*)(H1 + off + bj * HALF + n * 16) = h; s += (h[0] * h[0] + h[1] * h[1]) + (h[2] * h[2] + h[3] * h[3]);
                        const f32x4 hg = h * gv[bj][n]; u32x2 w; w.x = cvtpk(hg[0], hg[1]); w.y = cvtpk(hg[2], hg[3]); *(u32x2*)(H1G + off + bj * HALF + n * 16) = w; }
                s += __shfl_xor(s, 16); s += __shfl_xor(s, 32);
                if (fq == 0) SSQ[(size_t)row * 16 + u.pn * 4 + wc] = s; }
    }
};
struct EpiQ {
    static constexpr bool PERM = true;
    const float* SSQ; bf16_t* Q; int ldc;
    __device__ __forceinline__ void operator()(const f32x4 (&acc)[2][2][4][2], const Unit& u, int wr, int wc, int fr, int fq) const {
        const int row0 = u.pm * BM + wr * 64 + fr, col0 = u.pn * BM + wc * 32 + 8 * fq;
#pragma unroll
        for (int ai = 0; ai < 2; ++ai)
#pragma unroll
            for (int m = 0; m < 4; ++m) { const int row = row0 + ai * HALF + m * 16; const f32x4* sp = (const f32x4*)(SSQ + (size_t)row * 16);
                const f32x4 s0 = sp[0], s1 = sp[1], s2 = sp[2], s3 = sp[3]; const f32x4 st = (s0 + s1) + (s2 + s3);
                const float rstd = __builtin_amdgcn_rsqf(((st[0] + st[1]) + (st[2] + st[3])) * (1.0f / 1024.0f) + EPS);
                bf16_t* rowp = Q + (size_t)row * ldc + col0;
#pragma unroll
                for (int bj = 0; bj < 2; ++bj) { const f32x4 v0 = acc[ai][bj][m][0] * rstd, v1 = acc[ai][bj][m][1] * rstd;
                    u32x4 w; w.x = cvtpk(v0[0], v0[1]); w.y = cvtpk(v0[2], v0[3]); w.z = cvtpk(v1[0], v1[1]); w.w = cvtpk(v1[2], v1[3]);
                    *(u32x4*)(rowp + bj * HALF) = w; } }
    }
};
struct EpiF32 {
    static constexpr bool PERM = false;
    float* O; int ldc;
    __device__ __forceinline__ void operator()(const f32x4 (&acc)[2][2][4][2], const Unit& u, int wr, int wc, int fr, int fq) const {
        const int row0 = u.pm * BM + wr * 64 + fr, col0 = u.pn * BM + wc * 32 + 4 * fq;
#pragma unroll
        for (int ai = 0; ai < 2; ++ai)
#pragma unroll
            for (int m = 0; m < 4; ++m) { float* rowp = O + (size_t)(row0 + ai * HALF + m * 16) * ldc + col0;
#pragma unroll
                for (int bj = 0; bj < 2; ++bj)
#pragma unroll
                    for (int n = 0; n < 2; ++n) *(f32x4*)(rowp + bj * HALF + n * 16) = acc[ai][bj][m][n]; }
    }
};
struct EpiBf {
    static constexpr bool PERM = true;
    bf16_t* O; int ldc;
    __device__ __forceinline__ void operator()(const f32x4 (&acc)[2][2][4][2], const Unit& u, int wr, int wc, int fr, int fq) const {
        const int row0 = u.pm * BM + wr * 64 + fr, col0 = u.pn * BM + wc * 32 + 8 * fq;
#pragma unroll
        for (int ai = 0; ai < 2; ++ai)
#pragma unroll
            for (int m = 0; m < 4; ++m) { bf16_t* rowp = O + (size_t)(row0 + ai * HALF + m * 16) * ldc + col0;
#pragma unroll
                for (int bj = 0; bj < 2; ++bj) { const f32x4 v0 = acc[ai][bj][m][0], v1 = acc[ai][bj][m][1];
                    u32x4 w; w.x = cvtpk(v0[0], v0[1]); w.y = cvtpk(v0[2], v0[3]); w.z = cvtpk(v1[0], v1[1]); w.w = cvtpk(v1[2], v1[3]);
                    *(u32x4*)(rowp + bj * HALF) = w; } }
    }
};
struct EpiH3 {
    static constexpr bool PERM = false;
    const float* H2; const bf16_t* PLE; float* OUT; float* SSQ; int dry;
    __device__ __forceinline__ void operator()(const f32x4 (&acc)[2][2][4][2], const Unit& u, int wr, int wc, int fr, int fq) const {
        const int row0 = u.pm * BM + wr * 64 + fr, col0 = u.pn * BM + wc * 32 + 4 * fq;
#pragma unroll
        for (int ai = 0; ai < 2; ++ai)
#pragma unroll
            for (int m = 0; m < 4; ++m) { const int row = row0 + ai * HALF + m * 16; const size_t off = (size_t)row * 1024 + col0; float s = 0.f;
#pragma unroll
                for (int bj = 0; bj < 2; ++bj)
#pragma unroll
                    for (int n = 0; n < 2; ++n) { const size_t o2 = off + bj * HALF + n * 16; const f32x4 hv = *(const f32x4*)(H2 + o2); const u32x2 pv = *(const u32x2*)(PLE + o2);
                        const f32x4 a = acc[ai][bj][m][n]; f32x4 h;
                        h[0] = hv[0] + bf_lo(pv.x) * fast_sigmoid(a[0]); h[1] = hv[1] + bf_hi(pv.x) * fast_sigmoid(a[1]);
                        h[2] = hv[2] + bf_lo(pv.y) * fast_sigmoid(a[2]); h[3] = hv[3] + bf_hi(pv.y) * fast_sigmoid(a[3]);
                        if (!dry) *(f32x4*)(OUT + o2) = h; s += (h[0] * h[0] + h[1] * h[1]) + (h[2] * h[2] + h[3] * h[3]); }
                s += __shfl_xor(s, 16); s += __shfl_xor(s, 32);
                if (fq == 0) SSQ[(size_t)row * 16 + u.pn * 4 + wc] = s;
                asm volatile("" ::: "memory"); }
    }
};
}
constexpr size_t MiB = 1u << 20;
constexpr size_t WS_CTL = 0, CTL_ZERO_BYTES = 64 * 1024;
constexpr size_t WS_PEND = 64 * 1024;
constexpr size_t WS_WPLE = 512 * 1024;
constexpr size_t WS_KD = 1 * MiB;
constexpr size_t WS_GLAG = 2 * MiB;
constexpr size_t WS_WIN = 3 * MiB;
constexpr size_t WS_SEND = 4 * MiB;
constexpr size_t WS_EXP = 4 * MiB;
constexpr size_t WS_SSQ1 = 13 * MiB;
constexpr size_t WS_SSQ3 = 14 * MiB;
constexpr size_t WS_RSU = 15 * MiB, WS_RSV = 15 * MiB + 64 * 1024;
constexpr size_t WS_WGA = 20 * MiB, WS_WSB = 22 * MiB, WS_WO = 24 * MiB, WS_WPG = 26 * MiB, WS_WPQ = 28 * MiB;
constexpr size_t WS_A = 32 * MiB;
constexpr size_t WS_GQ = WS_A, WS_GK = WS_A + 16 * MiB, WS_UB8 = WS_A, WS_VB8 = WS_A + 16 * MiB;
constexpr size_t WS_B = 64 * MiB;
constexpr size_t WS_GV = WS_B, WS_PB = WS_B;
constexpr size_t WS_C = 96 * MiB;
constexpr size_t WS_GR = WS_C, WS_H1 = WS_C;
constexpr size_t WS_D = 128 * MiB;
constexpr size_t WS_SQ = WS_D;
constexpr size_t WS_E = 160 * MiB;
constexpr size_t WS_SK = WS_E, WS_MIX = WS_E, WS_Q = WS_E, WS_PLE = WS_E;
constexpr size_t WS_F = 192 * MiB;
constexpr size_t WS_SV = WS_F;
constexpr size_t WS_G = 224 * MiB;
constexpr size_t WS_XN1 = WS_G, WS_GLAN = WS_G, WS_H1G = WS_G, WS_XN3 = WS_G;
constexpr size_t WS_END = 256 * MiB;

constexpr int NWAVES = 8;
constexpr int RING_OFF = 0, RING_BYTES = 131072;
constexpr int MISC_OFF = RING_BYTES;
constexpr int LDS_BYTES = 147456;
constexpr int CW_BAR = 1024;

typedef GAS unsigned gu32;
#define RLX_AGENT __ATOMIC_RELAXED, __HIP_MEMORY_SCOPE_AGENT
#define LDS_WAIT() asm volatile("s_waitcnt lgkmcnt(0)" ::: "memory")
#define VM_WAIT() asm volatile("s_waitcnt vmcnt(0)" ::: "memory")

#define XB_TMO      128
#define XB_XCNT(j)  (256  + 64 * (j))
#define XB_XSUB(j)  (1280 + 64 * (j))
#define XB_XGEN(j)  (2304 + 64 * (j))
#define XB_TOP      3328
#define XB_TOPGEN   3392
#define XCD_BAR_WORDS 3456
#define XB_SPIN_CAP (1u << 22)
__device__ __forceinline__ unsigned xb_ld(unsigned* p)              { return __hip_atomic_load(p, __ATOMIC_RELAXED, __HIP_MEMORY_SCOPE_AGENT); }
__device__ __forceinline__ unsigned xb_add(unsigned* p, unsigned v) { return __hip_atomic_fetch_add(p, v, __ATOMIC_RELAXED, __HIP_MEMORY_SCOPE_AGENT); }
__device__ __forceinline__ unsigned xb_xcc_id() { return (unsigned)__builtin_amdgcn_s_getreg((3 << 11) | 20) & 0xFu; }
#define XB_SPIN(cond, bar) do { unsigned _sp = 0; while (cond) { __builtin_amdgcn_s_sleep(1); \
    if ((++_sp & 255u) == 0u) { if (xb_ld(&(bar)[XB_TMO])) break; if (_sp > XB_SPIN_CAP) { atomicAdd(&(bar)[XB_TMO], 1u); break; } } } } while (0)
struct XcdBarrier { unsigned* bar; unsigned x; volatile LAS unsigned* st; };
__device__ __forceinline__ XcdBarrier xcd_barrier_post(unsigned* bar, volatile LAS unsigned* st, int tid) {
    XcdBarrier b; b.bar = bar; b.x = xb_xcc_id(); b.st = st;
    if (tid == 0) (void)xb_add(&bar[XB_XCNT(b.x)], 1u);
    return b;
}
__device__ __forceinline__ void xcd_barrier_complete(unsigned* bar, unsigned x, unsigned& nloc, unsigned& nx) {
    const unsigned G = gridDim.x * gridDim.y * gridDim.z;
    unsigned sum, cnt, mine, sp = 0u;
    for (;;) {
        sum = 0u; cnt = 0u; mine = 0u;
#pragma unroll
        for (unsigned j = 0; j < 16; ++j) { const unsigned c = xb_ld(&bar[XB_XCNT(j)]); sum += c; cnt += (c > 0u) ? 1u : 0u; mine = (j == x) ? c : mine; }
        if (sum == G) break;
        __builtin_amdgcn_s_sleep(1);
        if ((++sp & 255u) == 0u) { if (xb_ld(&bar[XB_TMO])) break; if (sp > XB_SPIN_CAP) { atomicAdd(&bar[XB_TMO], 1u); break; } }
    }
    nloc = mine > 0u ? mine : 1u; nx = cnt > 0u ? cnt : 1u;
}
__device__ __forceinline__ void xcd_barrier(const XcdBarrier& b, int tid) {
    asm volatile("s_waitcnt vmcnt(0)" ::: "memory");
    __syncthreads();
    if (tid == 0) {
        unsigned* bar = b.bar;
        __builtin_amdgcn_s_waitcnt(0);
        unsigned nloc = b.st[0], nx = b.st[1];
        if (nloc == 0u) { xcd_barrier_complete(bar, b.x, nloc, nx); b.st[0] = nloc; b.st[1] = nx; }
        const unsigned old = xb_add(&bar[XB_XSUB(b.x)], 1u);
        const unsigned gen = old / nloc;
        if (old + 1u == (gen + 1u) * nloc) {
            __builtin_amdgcn_fence(__ATOMIC_RELEASE, "agent");
            asm volatile("s_waitcnt vmcnt(0)" ::: "memory");
            const unsigned og = xb_add(&bar[XB_TOP], 1u);
            const unsigned tg = og / nx;
            if (og + 1u == (tg + 1u) * nx) xb_add(&bar[XB_TOPGEN], 1u);
            else XB_SPIN(xb_ld(&bar[XB_TOPGEN]) == tg, bar);
            __builtin_amdgcn_fence(__ATOMIC_ACQUIRE, "agent");
            xb_add(&bar[XB_XGEN(b.x)], 1u);
            asm volatile("s_waitcnt vmcnt(0)" ::: "memory");
        } else {
            XB_SPIN(xb_ld(&bar[XB_XGEN(b.x)]) == gen, bar);
            __builtin_amdgcn_fence(__ATOMIC_ACQUIRE, "agent");
            asm volatile("s_waitcnt vmcnt(0)" ::: "memory");
        }
    }
    __syncthreads();
}

struct Frame {
    LAS unsigned char* lds;
    int tid, lane, wave, vcu, G, dry;
    const float* const* in; float* out; unsigned char* ws;
};
__device__ __forceinline__ int lane_id() { int l; asm volatile("v_mbcnt_lo_u32_b32 %0, -1, 0\n\tv_mbcnt_hi_u32_b32 %0, -1, %0" : "=v"(l)); return l; }
#define WSP(T, off) ((T*)(F.ws + (off)))
__device__ __forceinline__ float wave_sum(float v) {
#pragma unroll
    for (int o = 1; o < 64; o <<= 1) v += __shfl_xor(v, o);
    return v;
}
template <class RowMap>
__device__ __forceinline__ void p0_transpose_item(const float* W, int K, int N, bf16_t* WT, RowMap rm, LAS float* scr, int item, int lane) {
    const int nblk = (N + 31) / 32, kb = item / nblk, nb = item % nblk, k0 = 64 * kb, n0 = 32 * nb;
    { const int kr = lane >> 3, c4 = lane & 7, nl = n0 + 4 * c4; f32x4 v[8];
#pragma unroll
      for (int i = 0; i < 8; ++i) v[i] = (nl < N) ? *(const f32x4*)(W + (size_t)(k0 + 8 * i + kr) * N + nl) : (f32x4){0.f, 0.f, 0.f, 0.f};
#pragma unroll
      for (int i = 0; i < 8; ++i) { LAS float* d = scr + (8 * i + kr) * 33 + 4 * c4; d[0] = v[i][0]; d[1] = v[i][1]; d[2] = v[i][2]; d[3] = v[i][3]; } }
    LDS_WAIT(); asm volatile("" ::: "memory");
    const int c = lane & 7;
#pragma unroll
    for (int j = 0; j < 4; ++j) { const int n = (lane >> 3) + 8 * j; const LAS float* s = scr + (8 * c) * 33 + n;
        u32x4 o; o.x = cvtpk(s[0 * 33], s[1 * 33]); o.y = cvtpk(s[2 * 33], s[3 * 33]); o.z = cvtpk(s[4 * 33], s[5 * 33]); o.w = cvtpk(s[6 * 33], s[7 * 33]);
        if (n0 + n < N) *(u32x4*)(WT + (size_t)rm(n0 + n) * K + k0 + 8 * c) = o; }
    LDS_WAIT(); asm volatile("" ::: "memory");
}
struct RmId { __device__ __forceinline__ int operator()(int n) const { return n; } };
struct RmWin { __device__ __forceinline__ int operator()(int n) const { return n < 3072 ? n : (n < 3088 ? 8192 + (n - 3072) : n - 16); } };

__device__ __forceinline__ void cvt_copy(Frame& F, const float* src, bf16_t* dst, size_t n) {
    const size_t nth = (size_t)F.G * 512, n8 = n / 8;
    for (size_t i = (size_t)F.vcu * 512 + F.tid; i < n8; i += nth) {
        const f32x4 a = *(const f32x4*)(src + i * 8), b = *(const f32x4*)(src + i * 8 + 4);
        u32x4 o; o.x = cvtpk(a[0], a[1]); o.y = cvtpk(a[2], a[3]); o.z = cvtpk(b[0], b[1]); o.w = cvtpk(b[2], b[3]);
        *(u32x4*)(dst + i * 8) = o; }
}
__device__ __forceinline__ void rms_row_to_bf16(const float* xrow, const float* g, bf16_t* orow, int lane) {
    f32x4 v[4]; float s = 0.f;
#pragma unroll
    for (int j = 0; j < 4; ++j) { v[j] = *((const f32x4*)xrow + lane + 64 * j); s += (v[j][0] * v[j][0] + v[j][1] * v[j][1]) + (v[j][2] * v[j][2] + v[j][3] * v[j][3]); }
    const float rstd = __builtin_amdgcn_rsqf(wave_sum(s) * (1.f / 1024.f) + EPS);
#pragma unroll
    for (int j = 0; j < 4; ++j) { const f32x4 gv = *((const f32x4*)g + lane + 64 * j); const f32x4 o = v[j] * rstd * gv;
        u32x2 w; w.x = cvtpk(o[0], o[1]); w.y = cvtpk(o[2], o[3]); *((u32x2*)orow + lane + 64 * j) = w; }
}
__device__ __forceinline__ void phase_prologue(Frame& F) {
    LAS float* scr = (LAS float*)(F.lds + RING_OFF + F.wave * 16384);
    const int gw = F.vcu * NWAVES + F.wave, NGW = F.G * NWAVES;
    constexpr int I_IN = 16 * 257, I_SQ = 16 * 32, I_PQ = 16 * 64, I_PLE = 4 * 32;
    constexpr int NITEMS = I_IN + 4 * I_SQ + I_PQ + I_PLE;
    for (int it = gw; it < NITEMS; it += NGW) {
        int r = it;
        if (r < I_IN) { p0_transpose_item(F.in[3], 1024, 8208, WSP(bf16_t, WS_WIN), RmWin(), scr, r, F.lane); continue; } r -= I_IN;
        if (r < I_SQ) { p0_transpose_item(F.in[7], 1024, 1024, WSP(bf16_t, WS_WGA), RmId(), scr, r, F.lane); continue; } r -= I_SQ;
        if (r < I_SQ) { p0_transpose_item(F.in[8], 1024, 1024, WSP(bf16_t, WS_WSB), RmId(), scr, r, F.lane); continue; } r -= I_SQ;
        if (r < I_SQ) { p0_transpose_item(F.in[9], 1024, 1024, WSP(bf16_t, WS_WO), RmId(), scr, r, F.lane); continue; } r -= I_SQ;
        if (r < I_SQ) { p0_transpose_item(F.in[17], 1024, 1024, WSP(bf16_t, WS_WPG), RmId(), scr, r, F.lane); continue; } r -= I_SQ;
        if (r < I_PQ) { p0_transpose_item(F.in[11], 1024, 2048, WSP(bf16_t, WS_WPQ), RmId(), scr, r, F.lane); continue; } r -= I_PQ;
        p0_transpose_item(F.in[18], 256, 1024, WSP(bf16_t, WS_WPLE), RmId(), scr, r, F.lane);
    }
    { const float* k1 = F.in[12]; const float* k2 = F.in[13]; bf16_t* KB = WSP(bf16_t, WS_KD);
      for (int i = F.vcu * 512 + F.tid; i < 2 * 8 * 128 * 16; i += F.G * 512) { const int half = i >> 14, rem = i & 16383, h = rem >> 11, r8 = rem & 2047;
          const float* s = (half ? k2 : k1) + (size_t)h * 16384 + (size_t)r8 * 8; const f32x4 a = *(const f32x4*)s, b = *(const f32x4*)(s + 4);
          u32x4 o; o.x = cvtpk(a[0], a[1]); o.y = cvtpk(a[2], a[3]); o.z = cvtpk(b[0], b[1]); o.w = cvtpk(b[2], b[3]);
          *(u32x4*)(KB + (size_t)(h * 2 + half) * 16384 + (size_t)r8 * 8) = o; } }
    for (int m = gw; m < T_TOK; m += 4 * NGW) {
        f32x4 v[4][4]; float s[4];
#pragma unroll
        for (int q = 0; q < 4; ++q) { const float* xr = F.in[0] + (size_t)(m + q * NGW) * 1024; s[q] = 0.f;
#pragma unroll
            for (int j = 0; j < 4; ++j) { v[q][j] = *((const f32x4*)xr + F.lane + 64 * j); s[q] += (v[q][j][0] * v[q][j][0] + v[q][j][1] * v[q][j][1]) + (v[q][j][2] * v[q][j][2] + v[q][j][3] * v[q][j][3]); } }
#pragma unroll
        for (int o = 1; o < 64; o <<= 1) {
#pragma unroll
            for (int q = 0; q < 4; ++q) s[q] += __shfl_xor(s[q], o); }
#pragma unroll
        for (int q = 0; q < 4; ++q) { const float rstd = __builtin_amdgcn_rsqf(s[q] * (1.f / 1024.f) + EPS); bf16_t* orow = WSP(bf16_t, WS_XN1) + (size_t)(m + q * NGW) * 1024;
#pragma unroll
            for (int j = 0; j < 4; ++j) { const f32x4 gv = *((const f32x4*)F.in[2] + F.lane + 64 * j); const f32x4 o = v[q][j] * rstd * gv;
                u32x2 wq; wq.x = cvtpk(o[0], o[1]); wq.y = cvtpk(o[2], o[3]); *((u32x2*)orow + F.lane + 64 * j) = wq; } }
    }
}

__device__ __forceinline__ void phase_gla_prep(Frame& F) {
    LAS float* alo = (LAS float*)(F.lds + RING_OFF);
    const bf16_t* XN1 = WSP(bf16_t, WS_XN1); const bf16_t* WGAT = WSP(bf16_t, WS_WIN) + (size_t)8192 * 1024;
    bf16_t* GKT = WSP(bf16_t, WS_GK); float* GLAG = WSP(float, WS_GLAG);
    const float* w_up = F.in[4]; const float* b_a = F.in[5];
    const int tid = F.tid, lane = F.lane, w = F.wave;
    for (int u = F.vcu; u < 256; u += F.G) {
        const size_t r0 = (size_t)u * 64;
        __syncthreads();
        const int kk = tid;
        bf16_t* krow = GKT + (size_t)kk * T_TOK + r0;
        u32x4 kq[8];
#pragma unroll
        for (int j = 0; j < 8; ++j) kq[j] = *(const u32x4*)(krow + 8 * j);
        {
            LAS float* part = alo + 1024;
            const bf16_t* bp = WGAT + (size_t)(lane & 15) * 1024 + 8 * (lane >> 4) + 128 * w;
            bf16x8 bq[4];
#pragma unroll
            for (int s = 0; s < 4; ++s) bq[s] = *(const bf16x8*)(bp + 32 * s);
#pragma unroll
            for (int rt = 0; rt < 4; ++rt) { f32x4 acc = (f32x4){0.f, 0.f, 0.f, 0.f};
                const bf16_t* ap = XN1 + (r0 + 16 * rt + (lane & 15)) * 1024 + 8 * (lane >> 4) + 128 * w;
#pragma unroll
                for (int s = 0; s < 4; ++s) { const bf16x8 a = *(const bf16x8*)(ap + 32 * s); acc = __builtin_amdgcn_mfma_f32_16x16x32_bf16(a, bq[s], acc, 0, 0, 0); }
#pragma unroll
                for (int r = 0; r < 4; ++r) part[w * 1024 + (16 * rt + 4 * (lane >> 4) + r) * 16 + (lane & 15)] = acc[r]; }
            __syncthreads();
#pragma unroll
            for (int q = 0; q < 2; ++q) { const int e = tid + 512 * q; float s = 0.f;
#pragma unroll
                for (int ww = 0; ww < 8; ++ww) s += part[ww * 1024 + e];
                alo[e] = s; }
        }
        float wv[16];
#pragma unroll
        for (int r = 0; r < 16; ++r) wv[r] = w_up[r * 512 + kk];
        const float bias = b_a[kk];
        __syncthreads();
        float suffix = 0.f;
#pragma unroll
        for (int i8 = 7; i8 >= 0; --i8) {
            const unsigned kw[4] = {kq[i8].x, kq[i8].y, kq[i8].z, kq[i8].w};
            float o[8];
#pragma unroll
            for (int j = 7; j >= 0; --j) { const int i = i8 * 8 + j;
                const f32x4 a0 = *(const LAS f32x4*)(alo + i * 16), a1 = *(const LAS f32x4*)(alo + i * 16 + 4), a2 = *(const LAS f32x4*)(alo + i * 16 + 8), a3 = *(const LAS f32x4*)(alo + i * 16 + 12);
                float x = bias;
                x += a0[0] * wv[0] + a0[1] * wv[1] + a0[2] * wv[2] + a0[3] * wv[3];
                x += a1[0] * wv[4] + a1[1] * wv[5] + a1[2] * wv[6] + a1[3] * wv[7];
                x += a2[0] * wv[8] + a2[1] * wv[9] + a2[2] * wv[10] + a2[3] * wv[11];
                x += a3[0] * wv[12] + a3[1] * wv[13] + a3[2] * wv[14] + a3[3] * wv[15];
                const float la = (fminf(x, 0.f) - __logf(1.0f + __expf(-fabsf(x)))) * (1.0f / 16.0f);
                const float kvv = (j & 1) ? bf_hi(kw[j >> 1]) : bf_lo(kw[j >> 1]);
                o[j] = kvv * __expf(suffix);
                suffix += la; }
            u32x4 pk; pk.x = cvtpk(o[0], o[1]); pk.y = cvtpk(o[2], o[3]); pk.z = cvtpk(o[4], o[5]); pk.w = cvtpk(o[6], o[7]);
            if (!F.dry) *(u32x4*)(krow + i8 * 8) = pk; }
        GLAG[(size_t)u * 512 + kk] = __expf(suffix);
    }
}
constexpr int GL_KD = 0, GL_Q = 32768, GL_G = 65536, GL_RED = 65536 + 1024;
__device__ __forceinline__ int gl_kd_off(int row, int chunk) { return row * 128 + ((chunk ^ ((row >> 1) & 7)) << 4); }
__device__ __forceinline__ int gl_q_off(int row, int chunk16) { return row * 256 + ((chunk16 ^ (row & 15)) << 4); }

struct GlaStage { u32x4 kd[2]; u32x4 q[2]; bf16x8 vt[4]; float g; };
__device__ __forceinline__ void gla_prefetch_vt(Frame& F, GlaStage& st, int b, int h, int c) {
    const int u = b * 64 + c; const size_t r0 = (size_t)u * 64; const int w = F.wave, lq = F.lane & 31, hh = F.lane >> 5;
    const bf16_t* vt = WSP(bf16_t, WS_GV) + (size_t)(h * 256 + 32 * w + lq) * T_TOK + r0;
#pragma unroll
    for (int ts = 0; ts < 4; ++ts) st.vt[ts] = *(const bf16x8*)(vt + 16 * ts + 8 * hh);
}
template <bool WITH_Q>
__device__ __forceinline__ void gla_prefetch(Frame& F, GlaStage& st, int b, int h, int c) {
    const int u = b * 64 + c; const size_t r0 = (size_t)u * 64; const int tid = F.tid;
    const bf16_t* kd = WSP(bf16_t, WS_GK) + (size_t)(h * 128) * T_TOK + r0;
#pragma unroll
    for (int j = 0; j < 2; ++j) { const int pi = tid + 512 * j; st.kd[j] = *(const u32x4*)(kd + (size_t)(pi >> 3) * T_TOK + (pi & 7) * 8); }
    if (WITH_Q) { const bf16_t* gq = WSP(bf16_t, WS_GQ) + r0 * 512 + h * 128;
#pragma unroll
        for (int j = 0; j < 2; ++j) { const int pi = tid + 512 * j; st.q[j] = *(const u32x4*)(gq + (size_t)(pi >> 4) * 512 + (pi & 15) * 8); } }
    st.g = (tid < 128) ? WSP(float, WS_GLAG)[((size_t)u * 4 + h) * 128 + tid] : 1.f;
}
template <bool WITH_Q>
__device__ __forceinline__ void gla_stage_write(Frame& F, const GlaStage& st, int buf) {
    LAS unsigned char* lds = F.lds + RING_OFF; const int tid = F.tid;
#pragma unroll
    for (int j = 0; j < 2; ++j) { const int pi = tid + 512 * j; *(LAS u32x4*)(lds + GL_KD + buf * 16384 + gl_kd_off(pi >> 3, pi & 7)) = st.kd[j]; }
    if (WITH_Q) {
#pragma unroll
        for (int j = 0; j < 2; ++j) { const int pi = tid + 512 * j; *(LAS u32x4*)(lds + GL_Q + buf * 16384 + gl_q_off(pi >> 4, pi & 15)) = st.q[j]; } }
    if (tid < 128) *(LAS float*)(lds + GL_G + buf * 512 + tid * 4) = st.g;
}
__device__ __forceinline__ void gla_update(Frame& F, f32x16 (&S)[4], const bf16x8 (&vt)[4], int buf) {
    const LAS unsigned char* lds = F.lds + RING_OFF; const int lq = F.lane & 31, hh = F.lane >> 5;
    const LAS float* G = (const LAS float*)(lds + GL_G + buf * 512);
#pragma unroll
    for (int kt = 0; kt < 4; ++kt)
#pragma unroll
        for (int g4 = 0; g4 < 4; ++g4) { const f32x4 g = *(const LAS f32x4*)(G + 32 * kt + 8 * g4 + 4 * hh);
#pragma unroll
            for (int j = 0; j < 4; ++j) S[kt][4 * g4 + j] *= g[j]; }
#pragma unroll
    for (int ts = 0; ts < 4; ++ts)
#pragma unroll
        for (int kt = 0; kt < 4; ++kt) { const bf16x8 a = *(const LAS bf16x8*)(lds + GL_KD + buf * 16384 + gl_kd_off(32 * kt + lq, 2 * ts + hh));
            S[kt] = __builtin_amdgcn_mfma_f32_32x32x16_bf16(a, vt[ts], S[kt], 0, 0, 0); if (kt == 3 && (ts & 1)) __builtin_amdgcn_sched_barrier(0); }
}
constexpr size_t SEND_WAVE_FLOATS = 4 * 4 * 64 * 4;
__device__ __forceinline__ void gla_stage1(Frame& F, int unit) {
    const int bh = unit >> 3, seg = unit & 7, b = bh >> 2, h = bh & 3, w = F.wave, l = F.lane;
    f32x16 S[4];
#pragma unroll
    for (int kt = 0; kt < 4; ++kt)
#pragma unroll
        for (int r = 0; r < 16; ++r) S[kt][r] = 0.f;
    float pend = 1.f;
    GlaStage st; gla_prefetch<false>(F, st, b, h, seg * 8); gla_prefetch_vt(F, st, b, h, seg * 8);
    for (int ci = 0; ci < 8; ++ci) {
        gla_stage_write<false>(F, st, ci & 1); pend *= st.g;
        __syncthreads();
        if (ci < 7) gla_prefetch<false>(F, st, b, h, seg * 8 + ci + 1);
        gla_update(F, S, st.vt, ci & 1);
        if (ci < 7) gla_prefetch_vt(F, st, b, h, seg * 8 + ci + 1);
    }
    float* se = WSP(float, WS_SEND) + ((size_t)unit * 8 + w) * SEND_WAVE_FLOATS;
#pragma unroll
    for (int kt = 0; kt < 4; ++kt)
#pragma unroll
        for (int g4 = 0; g4 < 4; ++g4) *(f32x4*)(se + ((kt * 4 + g4) * 64 + l) * 4) = (f32x4){S[kt][4 * g4], S[kt][4 * g4 + 1], S[kt][4 * g4 + 2], S[kt][4 * g4 + 3]};
    if (F.tid < 128) WSP(float, WS_PEND)[unit * 128 + F.tid] = pend;
    __syncthreads();
}
__device__ __forceinline__ void gla_stage3(Frame& F, int unit) {
    const int bh = unit >> 3, seg = unit & 7, b = bh >> 2, h = bh & 3, w = F.wave, l = F.lane, lq = l & 31, hh = l >> 5;
    LAS unsigned char* lds = F.lds + RING_OFF;
    const bf16_t* GR = WSP(bf16_t, WS_GR); bf16_t* GLAN = WSP(bf16_t, WS_GLAN); const float* g_o = F.in[6];
    f32x16 S[4];
#pragma unroll
    for (int kt = 0; kt < 4; ++kt)
#pragma unroll
        for (int r = 0; r < 16; ++r) S[kt][r] = 0.f;
    GlaStage st; gla_prefetch<true>(F, st, b, h, seg * 8); gla_prefetch_vt(F, st, b, h, seg * 8);
    for (int sp = 0; sp < seg; ++sp) {
        const int un = bh * 8 + sp; const float* se = WSP(float, WS_SEND) + ((size_t)un * 8 + w) * SEND_WAVE_FLOATS; const float* pe = WSP(float, WS_PEND) + un * 128;
#pragma unroll
        for (int kt = 0; kt < 4; ++kt)
#pragma unroll
            for (int g4 = 0; g4 < 4; ++g4) { const f32x4 p = *(const f32x4*)(pe + 32 * kt + 8 * g4 + 4 * hh); const f32x4 s = *(const f32x4*)(se + ((kt * 4 + g4) * 64 + l) * 4);
#pragma unroll
                for (int j = 0; j < 4; ++j) S[kt][4 * g4 + j] = S[kt][4 * g4 + j] * p[j] + s[j]; }
    }
    for (int ci = 0; ci < 8; ++ci) {
        const int c = seg * 8 + ci; const size_t r0 = (size_t)(b * 64 + c) * 64; const int buf = ci & 1;
        gla_stage_write<true>(F, st, buf);
        __syncthreads();
        if (ci < 7) gla_prefetch<true>(F, st, b, h, c + 1);
        gla_update(F, S, st.vt, buf);
        f32x16 oT[2];
#pragma unroll
        for (int tt = 0; tt < 2; ++tt) {
#pragma unroll
            for (int r = 0; r < 16; ++r) oT[tt][r] = 0.f;
            const int t = 32 * tt + lq;
#pragma unroll
            for (int kt = 0; kt < 4; ++kt)
#pragma unroll
                for (int s = 0; s < 2; ++s) {
                    u32x4 aw; aw.x = cvtpk(S[kt][8 * s + 0], S[kt][8 * s + 1]); aw.y = cvtpk(S[kt][8 * s + 2], S[kt][8 * s + 3]); aw.z = cvtpk(S[kt][8 * s + 4], S[kt][8 * s + 5]); aw.w = cvtpk(S[kt][8 * s + 6], S[kt][8 * s + 7]);
                    const u32x2 qlo = *(const LAS u32x2*)(lds + GL_Q + buf * 16384 + gl_q_off(t, 4 * kt + 2 * s) + 8 * hh), qhi = *(const LAS u32x2*)(lds + GL_Q + buf * 16384 + gl_q_off(t, 4 * kt + 2 * s + 1) + 8 * hh);
                    const u32x4 bw = (u32x4){qlo.x, qlo.y, qhi.x, qhi.y};
                    oT[tt] = __builtin_amdgcn_mfma_f32_32x32x16_bf16(__builtin_bit_cast(bf16x8, aw), __builtin_bit_cast(bf16x8, bw), oT[tt], 0, 0, 0);
                    if (s == 1 && (kt & 1)) __builtin_amdgcn_sched_barrier(0); }
        }
        LAS float* redc = (LAS float*)(lds + GL_RED) + buf * 512;
#pragma unroll
        for (int tt = 0; tt < 2; ++tt) { float s = 0.f;
#pragma unroll
            for (int r = 0; r < 16; ++r) s += oT[tt][r] * oT[tt][r];
            s += __shfl_xor(s, 32);
            if (hh == 0) redc[w * 64 + 32 * tt + lq] = s; }
        if (ci < 7) gla_prefetch_vt(F, st, b, h, c + 1);
        u32x2 sr[2][4];
#pragma unroll
        for (int tt = 0; tt < 2; ++tt)
#pragma unroll
            for (int g4 = 0; g4 < 4; ++g4) sr[tt][g4] = *(const u32x2*)(GR + (r0 + 32 * tt + lq) * 1024 + h * 256 + 32 * w + 8 * g4 + 4 * hh);
        __syncthreads();
#pragma unroll
        for (int tt = 0; tt < 2; ++tt) { float tot = 0.f;
#pragma unroll
            for (int ww = 0; ww < 8; ++ww) tot += redc[ww * 64 + 32 * tt + lq];
            const float rstd = __builtin_amdgcn_rsqf(tot * (1.0f / 256.0f) + EPS);
            const size_t row = r0 + 32 * tt + lq;
#pragma unroll
            for (int g4 = 0; g4 < 4; ++g4) { const int v0 = h * 256 + 32 * w + 8 * g4 + 4 * hh;
                const f32x4 go = *(const f32x4*)(g_o + v0);
                const float o0 = oT[tt][4 * g4 + 0] * rstd * go[0] * bf_lo(sr[tt][g4].x), o1 = oT[tt][4 * g4 + 1] * rstd * go[1] * bf_hi(sr[tt][g4].x);
                const float o2 = oT[tt][4 * g4 + 2] * rstd * go[2] * bf_lo(sr[tt][g4].y), o3 = oT[tt][4 * g4 + 3] * rstd * go[3] * bf_hi(sr[tt][g4].y);
                u32x2 wv; wv.x = cvtpk(o0, o1); wv.y = cvtpk(o2, o3); *(u32x2*)(GLAN + row * 1024 + v0) = wv; } }
    }
    __syncthreads();
}

constexpr int SB_TILE = 16384, SB_FLAG = 7 * SB_TILE;
typedef short v4i16_t __attribute__((ext_vector_type(4)));
__device__ __forceinline__ s16x4 vtr(const LAS unsigned char* p) { return __builtin_bit_cast(s16x4, __builtin_amdgcn_ds_read_tr16_b64_v4i16((LAS v4i16_t*)p)); }
__device__ __forceinline__ float partner32(float x, int hh) { auto rr = __builtin_amdgcn_permlane32_swap(__float_as_uint(x), __float_as_uint(x), false, false); return __uint_as_float(hh ? rr[0] : rr[1]); }
__device__ __forceinline__ int sbk_off(int key, int chunk) { return key * 128 + ((chunk ^ ((key >> 1) & 7)) << 4); }
__device__ __forceinline__ int sbv_off(int key, int chunk) { return 8192 + key * 128 + ((chunk ^ (((key >> 1) & 1) << 2)) << 4); }

template <bool DIAG>
__device__ __forceinline__ void sb_tile_t(const LAS unsigned char* tile, int kt, int qabs, int l, const bf16x8 (&qf)[4], f32x16& o0, f32x16& o1, float& carry) {
    const int lq = l & 31, hh = l >> 5, g1 = (l >> 4) & 1, i = l & 15;
    float run = carry;
#pragma unroll
    for (int half = 1; half >= 0; --half) {
        f32x16 p;
#pragma unroll
        for (int r = 0; r < 16; ++r) p[r] = 0.f;
#pragma unroll
        for (int s = 0; s < 4; ++s) { const bf16x8 a = *(const LAS bf16x8*)(tile + sbk_off(32 * half + lq, 2 * s + hh)); p = __builtin_amdgcn_mfma_f32_32x32x16_bf16(a, qf[s], p, 0, 0, 0); }
        float Lh[16];
#pragma unroll
        for (int r = 0; r < 16; ++r) { const float z = p[r];
            float L = fmaxf(z, 0.f) + __builtin_amdgcn_logf(1.0f + __builtin_amdgcn_exp2f(-fabsf(z)));
            if (DIAG) { const int key = 64 * kt + 32 * half + (r & 3) + 8 * (r >> 2) + 4 * hh; if (key >= qabs) L = 0.f; }
            Lh[r] = L; }
        float tot[4];
#pragma unroll
        for (int g4 = 0; g4 < 4; ++g4) { float* Lg = &Lh[4 * g4]; Lg[2] += Lg[3]; Lg[1] += Lg[2]; Lg[0] += Lg[1]; tot[g4] = Lg[0]; }
        float E[4];
#pragma unroll
        for (int m = 3; m >= 0; --m) { const float tp = partner32(tot[m], hh); E[m] = run + (hh ? 0.f : tp); run += tot[m] + tp; }
        u32x4 pw[2];
#pragma unroll
        for (int s = 0; s < 2; ++s) { float wv[8];
#pragma unroll
            for (int j = 0; j < 8; ++j) { const int r = 8 * s + j;
                float wgt = __builtin_amdgcn_exp2f(p[r] - (E[r >> 2] + Lh[r]));
                if (DIAG) { const int key = 64 * kt + 32 * half + (r & 3) + 8 * (r >> 2) + 4 * hh; if (key >= qabs) wgt = 0.f; }
                wv[j] = wgt; }
            pw[s] = (u32x4){cvtpk(wv[0], wv[1]), cvtpk(wv[2], wv[3]), cvtpk(wv[4], wv[5]), cvtpk(wv[6], wv[7])}; }
#pragma unroll
        for (int s = 0; s < 2; ++s) { const bf16x8 pb = __builtin_bit_cast(bf16x8, pw[s]);
            const int k0 = 32 * half + 16 * s + 4 * hh + (i >> 2), k1 = k0 + 8;
#pragma unroll
            for (int dt = 0; dt < 2; ++dt) { const int ch = 4 * dt + 2 * g1 + ((i & 3) >> 1);
                const s16x4 lo = vtr(tile + sbv_off(k0, ch) + 8 * (i & 1)), hi = vtr(tile + sbv_off(k1, ch) + 8 * (i & 1));
                const bf16x8 a = (bf16x8){lo[0], lo[1], lo[2], lo[3], hi[0], hi[1], hi[2], hi[3]};
                if (dt == 0) o0 = __builtin_amdgcn_mfma_f32_32x32x16_bf16(a, pb, o0, 0, 0, 0); else o1 = __builtin_amdgcn_mfma_f32_32x32x16_bf16(a, pb, o1, 0, 0, 0); } }
    }
    carry = run;
}
__device__ __forceinline__ void sb_tile(const LAS unsigned char* tile, int kt, int q0, int qabs, int l, const bf16x8 (&qf)[4], f32x16& o0, f32x16& o1, float& carry) {
    if (64 * kt + 63 >= q0) sb_tile_t<true>(tile, kt, qabs, l, qf, o0, o1, carry); else sb_tile_t<false>(tile, kt, qabs, l, qf, o0, o1, carry);
}
__device__ __forceinline__ void sb_attn_unit(Frame& F, int uidx) {
    const int bh = uidx >> 4, qb = uidx & 15, b = bh >> 4, h = bh & 15;
    LAS unsigned char* lds = F.lds + RING_OFF;
    volatile LAS unsigned* flags = (volatile LAS unsigned*)(lds + SB_FLAG);
    const int tid = F.tid, w = F.wave, l = F.lane, lq = l & 31, hh = l >> 5;
    bf16_t* SQ = WSP(bf16_t, WS_SQ); const bf16_t* SK = WSP(bf16_t, WS_SK); const bf16_t* SV = WSP(bf16_t, WS_SV);
    const size_t rowbase = (size_t)b * SEQ;
    const int q0 = qb * 256 + 32 * w, qabs = q0 + lq;
    const int kt_hi = qb * 4 + 3, kt_lo = (qb * 4 - 3) > 0 ? (qb * 4 - 3) : 0, nwin = kt_hi - kt_lo + 1;
    const int skey = tid >> 3, sch = tid & 7;
    const bf16_t* kgd = SK + (rowbase + skey) * 1024 + h * 64 + ((sch ^ ((skey >> 1) & 7)) * 8);
    const bf16_t* vgd = SV + (rowbase + skey) * 1024 + h * 64 + ((sch ^ (((skey >> 1) & 1) << 2)) * 8);
    __syncthreads();
#pragma unroll
    for (int j = 0; j < 7; ++j) if (j < nwin) {
        __builtin_amdgcn_global_load_lds((const unsigned*)(kgd + (size_t)(kt_lo + j) * 64 * 1024), (LAS unsigned*)(lds + j * SB_TILE + w * 1024), 16, 0, 0);
        __builtin_amdgcn_global_load_lds((const unsigned*)(vgd + (size_t)(kt_lo + j) * 64 * 1024), (LAS unsigned*)(lds + j * SB_TILE + 8192 + w * 1024), 16, 0, 0); }
    bf16x8 qf[4];
    { const bf16_t* qrow = SQ + (rowbase + qabs) * 1024 + h * 64;
#pragma unroll
      for (int s = 0; s < 4; ++s) qf[s] = *(const bf16x8*)(qrow + 16 * s + 8 * hh); }
    f32x16 o0, o1;
#pragma unroll
    for (int r = 0; r < 16; ++r) { o0[r] = 0.f; o1[r] = 0.f; }
    float carry = 0.f;
    VM_WAIT(); __syncthreads();
    bool done = false;
    for (int kt = (q0 + 30) >> 6; kt >= kt_lo; --kt) {
        sb_tile(lds + (kt - kt_lo) * SB_TILE, kt, q0, qabs, l, qf, o0, o1, carry);
        if (__all(carry > 150.0f)) { done = true; break; }
    }
    if (kt_lo == 0) done = true;
    if (l == 0) flags[w] = done ? 1u : 0u;
    __syncthreads();
    bool alld = true;
#pragma unroll
    for (int i = 0; i < 8; ++i) alld = alld && (flags[i] != 0u);
    if (!alld) {
        const bf16_t* kg = SK + (rowbase + skey) * 1024 + h * 64 + sch * 8;
        const bf16_t* vg = SV + (rowbase + skey) * 1024 + h * 64 + sch * 8;
        for (int kt = kt_lo - 1; kt >= 0; --kt) {
            const u32x4 kr = *(const u32x4*)(kg + (size_t)kt * 64 * 1024), vr = *(const u32x4*)(vg + (size_t)kt * 64 * 1024);
            __syncthreads();
            { unsigned a = 1u;
#pragma unroll
              for (int i = 0; i < 8; ++i) a &= flags[i];
              if (a) break; }
            *(LAS u32x4*)(lds + sbk_off(skey, sch)) = kr; *(LAS u32x4*)(lds + sbv_off(skey, sch)) = vr;
            __syncthreads();
            if (!done) { sb_tile(lds, kt, q0, qabs, l, qf, o0, o1, carry); if (__all(carry > 150.0f) || kt == 0) done = true; }
            if (l == 0) flags[w] = done ? 1u : 0u;
        }
    }
    if (!F.dry) { bf16_t* orow = SQ + (rowbase + qabs) * 1024 + h * 64;
#pragma unroll
      for (int g4 = 0; g4 < 4; ++g4) { u32x2 a, c2; a.x = cvtpk(o0[4 * g4], o0[4 * g4 + 1]); a.y = cvtpk(o0[4 * g4 + 2], o0[4 * g4 + 3]); c2.x = cvtpk(o1[4 * g4], o1[4 * g4 + 1]); c2.y = cvtpk(o1[4 * g4 + 2], o1[4 * g4 + 3]);
          *(u32x2*)(orow + 8 * g4 + 4 * hh) = a; *(u32x2*)(orow + 32 + 8 * g4 + 4 * hh) = c2; } }
}
__device__ __forceinline__ void sb_units_dyn(Frame& F, unsigned* ctr, int lo, int hi) {
    volatile LAS int* slot = (volatile LAS int*)(F.lds + MISC_OFF + 64);
    for (;;) {
        __syncthreads();
        if (F.tid == 0) *slot = lo + (int)__hip_atomic_fetch_add(ctr, 1u, __ATOMIC_RELAXED, __HIP_MEMORY_SCOPE_AGENT);
        __syncthreads();
        const int u = *slot;
        if (u >= hi) break;
        sb_attn_unit(F, u);
    }
}
__device__ __forceinline__ void phase_attn_a(Frame& F) {
    if (F.vcu < 128) gla_stage1(F, F.vcu);
    sb_units_dyn(F, (unsigned*)(F.ws + WS_CTL) + 64 + 16 * F.dry, 0, 384);
    __syncthreads();
}
__device__ __forceinline__ void phase_attn_b(Frame& F) {
    if (F.vcu < 128) gla_stage3(F, F.vcu);
    sb_units_dyn(F, (unsigned*)(F.ws + WS_CTL) + 128 + 16 * F.dry, 384, 1024);
    __syncthreads();
}
__device__ __forceinline__ int okey(float v, int tag, int mask) { int u = __float_as_int(v); u ^= (u >> 31) & 0x7fffffff; return (u & ~mask) | tag; }
__device__ __forceinline__ float okey_val(int key, int mask) { int u = key & ~mask; u ^= (u >> 31) & 0x7fffffff; return __int_as_float(u); }
#define INS16(Lst, xin) do { int _x = (xin); _Pragma("unroll") for (int _j = 0; _j < 16; ++_j) { const int _h = max(Lst[_j], _x); _x = min(Lst[_j], _x); Lst[_j] = _h; } } while (0)

#define CEX(a, b) do { const int _hi = max(a, b), _lo = min(a, b); a = _hi; b = _lo; } while (0)
#define BITONIC16(K) do { \
    _Pragma("unroll") for (int _i = 0; _i < 8; ++_i) CEX(K[_i], K[_i + 8]); \
    _Pragma("unroll") for (int _b = 0; _b < 16; _b += 8) _Pragma("unroll") for (int _i = 0; _i < 4; ++_i) CEX(K[_b + _i], K[_b + _i + 4]); \
    _Pragma("unroll") for (int _b = 0; _b < 16; _b += 4) _Pragma("unroll") for (int _i = 0; _i < 2; ++_i) CEX(K[_b + _i], K[_b + _i + 2]); \
    _Pragma("unroll") for (int _b = 0; _b < 16; _b += 2) CEX(K[_b], K[_b + 1]); } while (0)
#define CEXD(a, b, d) do { const int _hi = max(a, b), _lo = min(a, b); a = (d) ? _hi : _lo; b = (d) ? _lo : _hi; } while (0)
#define FULLSORT16(K) do { \
    _Pragma("unroll") for (int _k = 2; _k <= 16; _k <<= 1) _Pragma("unroll") for (int _j = _k >> 1; _j >= 1; _j >>= 1) _Pragma("unroll") for (int _i = 0; _i < 16; ++_i) { \
        const int _p = _i ^ _j; if (_p > _i) { const bool _desc = ((_i & _k) == 0); CEXD(K[_i], K[_p], _desc); } } } while (0)
__device__ __forceinline__ int swap32i(int x) { auto r = __builtin_amdgcn_permlane32_swap((unsigned)x, (unsigned)x, false, false); return (int)((__builtin_amdgcn_mbcnt_hi(~0u, __builtin_amdgcn_mbcnt_lo(~0u, 0u)) & 32) ? r[0] : r[1]); }

__device__ __forceinline__ void phase_peer_retrieve(Frame& F) {
    const bf16_t* Q = WSP(bf16_t, WS_Q); const bf16_t* KB = WSP(bf16_t, WS_KD); unsigned* EXPO = WSP(unsigned, WS_EXP);
    LAS unsigned char* idxb = F.lds + RING_OFF + F.wave * 2048;
    const int l = F.lane, lq = l & 31, hh = l >> 5;
    const int ntok_wg = T_TOK / F.G;
#pragma unroll 1
    for (int it = F.wave; it < (ntok_wg / 32) * 8; it += NWAVES) {
        const int tg = it >> 3, h = it & 7;
        const int t = F.vcu * ntok_wg + tg * 32 + lq;
        int XY[2][16];
#pragma unroll
        for (int half = 0; half < 2; ++half) {
            bf16x8 qf[8];
            { const bf16_t* qp = Q + (size_t)t * 2048 + h * 256 + half * 128 + 8 * hh;
#pragma unroll
              for (int s = 0; s < 8; ++s) qf[s] = *(const bf16x8*)(qp + 16 * s); }
            int L[16];
#pragma unroll
            for (int j = 0; j < 16; ++j) L[j] = INT_MIN;
            const bf16_t* kp = KB + (size_t)(h * 2 + half) * 16384 + (size_t)lq * 128 + 8 * hh;
#pragma unroll 1
            for (int tile = 0; tile < 4; ++tile) {
                f32x16 acc; int Tk[16];
#pragma unroll
                for (int r = 0; r < 16; ++r) acc[r] = 0.f;
#pragma unroll
                for (int s = 0; s < 8; ++s) { const bf16x8 a = *(const bf16x8*)(kp + (size_t)tile * 32 * 128 + 16 * s); acc = __builtin_amdgcn_mfma_f32_32x32x16_bf16(a, qf[s], acc, 0, 0, 0); }
#pragma unroll
                for (int r = 0; r < 16; ++r) { const int key = 32 * tile + (r & 3) + 8 * (r >> 2) + 4 * hh; Tk[r] = okey(acc[r], 127 - key, 127); }
                FULLSORT16(Tk);
#pragma unroll
                for (int k = 0; k < 16; ++k) L[k] = max(L[k], Tk[15 - k]);
                BITONIC16(L);
            }
#pragma unroll
            for (int k = 0; k < 8; ++k) { const int a = swap32i(L[15 - k]), b = swap32i(L[k]); L[k] = max(L[k], a); L[15 - k] = max(L[15 - k], b); }
            BITONIC16(L);
#pragma unroll
            for (int j = 0; j < 16; ++j) XY[half][j] = L[j];
        }
        { u32x4 pk[2];
#pragma unroll
          for (int half = 0; half < 2; ++half) { const int* L = XY[half];
            pk[half].x = (unsigned)(127 - (L[0] & 127)) | ((unsigned)(127 - (L[1] & 127)) << 8) | ((unsigned)(127 - (L[2] & 127)) << 16) | ((unsigned)(127 - (L[3] & 127)) << 24);
            pk[half].y = (unsigned)(127 - (L[4] & 127)) | ((unsigned)(127 - (L[5] & 127)) << 8) | ((unsigned)(127 - (L[6] & 127)) << 16) | ((unsigned)(127 - (L[7] & 127)) << 24);
            pk[half].z = (unsigned)(127 - (L[8] & 127)) | ((unsigned)(127 - (L[9] & 127)) << 8) | ((unsigned)(127 - (L[10] & 127)) << 16) | ((unsigned)(127 - (L[11] & 127)) << 24);
            pk[half].w = (unsigned)(127 - (L[12] & 127)) | ((unsigned)(127 - (L[13] & 127)) << 8) | ((unsigned)(127 - (L[14] & 127)) << 16) | ((unsigned)(127 - (L[15] & 127)) << 24); }
          *(LAS u32x4*)(idxb + l * 32) = pk[0]; *(LAS u32x4*)(idxb + l * 32 + 16) = pk[1]; }
        float X[16], Y[16];
#pragma unroll
        for (int j = 0; j < 16; ++j) { X[j] = okey_val(XY[0][j], 127); Y[j] = okey_val(XY[1][j], 127); }
        int M[16];
#pragma unroll
        for (int j = 0; j < 16; ++j) M[j] = INT_MIN;
#define CAND(i, j) do { const float sm = hh ? (X[j] + Y[i]) : (X[i] + Y[j]); const int pos = hh ? ((j) * 16 + (i)) : ((i) * 16 + (j)); int key = okey(sm, 255 - pos, 255); if ((i) == (j) && hh) key = INT_MIN; INS16(M, key); } while (0)
        CAND(0, 0); CAND(0, 1); CAND(0, 2); CAND(0, 3); CAND(0, 4); CAND(0, 5); CAND(0, 6); CAND(0, 7); CAND(0, 8); CAND(0, 9); CAND(0, 10); CAND(0, 11); CAND(0, 12); CAND(0, 13); CAND(0, 14); CAND(0, 15);
        CAND(1, 1); CAND(1, 2); CAND(1, 3); CAND(1, 4); CAND(1, 5); CAND(1, 6); CAND(1, 7);
        CAND(2, 2); CAND(2, 3); CAND(2, 4);
        CAND(3, 3);
#undef CAND
        int TK[16];
#pragma unroll
        for (int k = 0; k < 16; ++k) TK[k] = max(M[k], swap32i(M[15 - k]));
        float sv[16]; float mx = -INFINITY;
#pragma unroll
        for (int k = 0; k < 16; ++k) { sv[k] = okey_val(TK[k], 255); mx = fmaxf(mx, sv[k]); }
        float den = 0.f;
#pragma unroll
        for (int k = 0; k < 16; ++k) { sv[k] = __expf(sv[k] - mx); den += sv[k]; }
        const float rden = 1.0f / den;
        LDS_WAIT(); asm volatile("" ::: "memory");
        const LAS unsigned char* ib = idxb + l * 32;
        unsigned* dst = EXPO + (size_t)t * 128 + h * 16 + hh * 8;
        u32x4 o0, o1; unsigned ov[8];
#pragma unroll
        for (int k = 0; k < 8; ++k) { const int pos = 255 - (TK[k] & 255); const unsigned i1 = ib[pos >> 4], i2 = ib[16 + (pos & 15)];
            ov[k] = (__float_as_uint(sv[k] * rden) & ~0x3fffu) | (i1 * 128u + i2); }
        o0 = (u32x4){ov[0], ov[1], ov[2], ov[3]}; o1 = (u32x4){ov[4], ov[5], ov[6], ov[7]};
        *(u32x4*)dst = o0; *(u32x4*)(dst + 4) = o1;
        LDS_WAIT(); asm volatile("" ::: "memory");
    }
}

__device__ __forceinline__ void cvt_rows_fp8(Frame& F, const float* src, unsigned char* dst, float* rscale) {
    const int l = F.lane; const int gw = F.vcu * NWAVES + F.wave, NGW = F.G * NWAVES;
    for (int e = gw; e < 16384; e += NGW) {
        const f32x4* sp = (const f32x4*)(src + (size_t)e * 1024 + 16 * l);
        const f32x4 a = sp[0], b = sp[1], c = sp[2], d = sp[3];
        float m = fmaxf(fmaxf(fmaxf(fabsf(a[0]), fabsf(a[1])), fmaxf(fabsf(a[2]), fabsf(a[3]))), fmaxf(fmaxf(fabsf(b[0]), fabsf(b[1])), fmaxf(fabsf(b[2]), fabsf(b[3]))));
        m = fmaxf(m, fmaxf(fmaxf(fmaxf(fabsf(c[0]), fabsf(c[1])), fmaxf(fabsf(c[2]), fabsf(c[3]))), fmaxf(fmaxf(fabsf(d[0]), fabsf(d[1])), fmaxf(fabsf(d[2]), fabsf(d[3])))));
#pragma unroll
        for (int o = 1; o < 64; o <<= 1) m = fmaxf(m, __shfl_xor(m, o));
        const float t = 448.0f / fmaxf(m, 1e-30f); const float s = __uint_as_float(__float_as_uint(t) & 0x7f800000u);
        u32x4 w; int x;
        x = __builtin_amdgcn_cvt_pk_fp8_f32(a[0] * s, a[1] * s, 0, false); x = __builtin_amdgcn_cvt_pk_fp8_f32(a[2] * s, a[3] * s, x, true); w.x = (unsigned)x;
        x = __builtin_amdgcn_cvt_pk_fp8_f32(b[0] * s, b[1] * s, 0, false); x = __builtin_amdgcn_cvt_pk_fp8_f32(b[2] * s, b[3] * s, x, true); w.y = (unsigned)x;
        x = __builtin_amdgcn_cvt_pk_fp8_f32(c[0] * s, c[1] * s, 0, false); x = __builtin_amdgcn_cvt_pk_fp8_f32(c[2] * s, c[3] * s, x, true); w.z = (unsigned)x;
        x = __builtin_amdgcn_cvt_pk_fp8_f32(d[0] * s, d[1] * s, 0, false); x = __builtin_amdgcn_cvt_pk_fp8_f32(d[2] * s, d[3] * s, x, true); w.w = (unsigned)x;
        *(u32x4*)(dst + (size_t)e * 1024 + 16 * l) = w;
        if (l == 0) rscale[e] = 1.0f / s;
    }
}

__device__ __forceinline__ float gelu_tanh(float x) { const float y = 0.7978845608028654f * (x + 0.044715f * x * x * x); return x * __builtin_amdgcn_rcpf(1.0f + __expf(-2.0f * y)); }
#define FP8_UNPACK16(W, f) do { f32x2 _t; \
    _t = __builtin_amdgcn_cvt_pk_f32_fp8((int)(W).x, false); f[0] = _t[0]; f[1] = _t[1]; _t = __builtin_amdgcn_cvt_pk_f32_fp8((int)(W).x, true); f[2] = _t[0]; f[3] = _t[1]; \
    _t = __builtin_amdgcn_cvt_pk_f32_fp8((int)(W).y, false); f[4] = _t[0]; f[5] = _t[1]; _t = __builtin_amdgcn_cvt_pk_f32_fp8((int)(W).y, true); f[6] = _t[0]; f[7] = _t[1]; \
    _t = __builtin_amdgcn_cvt_pk_f32_fp8((int)(W).z, false); f[8] = _t[0]; f[9] = _t[1]; _t = __builtin_amdgcn_cvt_pk_f32_fp8((int)(W).z, true); f[10] = _t[0]; f[11] = _t[1]; \
    _t = __builtin_amdgcn_cvt_pk_f32_fp8((int)(W).w, false); f[12] = _t[0]; f[13] = _t[1]; _t = __builtin_amdgcn_cvt_pk_f32_fp8((int)(W).w, true); f[14] = _t[0]; f[15] = _t[1]; } while (0)
__device__ __forceinline__ float sum_swap32(float a, float b) { auto r = __builtin_amdgcn_permlane32_swap(__float_as_uint(a), __float_as_uint(b), false, false); return __uint_as_float(r[0]) + __uint_as_float(r[1]); }
__device__ __forceinline__ float sum_swap16(float a, float b) { auto r = __builtin_amdgcn_permlane16_swap(__float_as_uint(a), __float_as_uint(b), false, false); return __uint_as_float(r[0]) + __uint_as_float(r[1]); }
template <int M> __device__ __forceinline__ unsigned sxu(unsigned v, int lane) {
    if constexpr (M == 32) { auto r = __builtin_amdgcn_permlane32_swap(v, v, false, false); return (lane & 32) ? r[0] : r[1]; }
    else return (unsigned)__builtin_amdgcn_ds_swizzle((int)v, (M << 10) | 0x1f);
}
template <int M> __device__ __forceinline__ float sxf(float v, int lane) { return __uint_as_float(sxu<M>(__float_as_uint(v), lane)); }
__device__ __forceinline__ float wave_sum_sx(float v, int lane) { v += sxf<1>(v, lane); v += sxf<2>(v, lane); v += sxf<4>(v, lane); v += sxf<8>(v, lane); v += sxf<16>(v, lane); v += sxf<32>(v, lane); return v; }
#ifndef PG_TOK
#define PG_TOK 4
#endif
template <class Bar>
__device__ __forceinline__ void phase_peer_gather(Frame& F, const Bar& bar, bool use_bar) {
    const unsigned char* UB = WSP(unsigned char, WS_UB8); const unsigned char* VB = WSP(unsigned char, WS_VB8); const float* RSU = WSP(float, WS_RSU); const float* RSV = WSP(float, WS_RSV);
    const unsigned* EXPO = WSP(unsigned, WS_EXP);
    const bf16_t* H1G = WSP(bf16_t, WS_H1G); bf16_t* XN3 = WSP(bf16_t, WS_XN3); const float* H1 = WSP(float, WS_H1); float* H2 = F.out; const float* SSQ1 = WSP(float, WS_SSQ1); const float* g_ple = F.in[16];
    const int l = F.lane; const int ntok_wg = T_TOK / F.G;
#pragma unroll 1
    for (int ti = F.wave * PG_TOK; ti < ntok_wg; ti += NWAVES * PG_TOK) {
        if (use_bar && ti >= NWAVES * PG_TOK) xcd_barrier(bar, F.tid); else __syncthreads();
        float acc[PG_TOK][16];
        LAS unsigned* lent = (LAS unsigned*)(F.lds + RING_OFF + F.wave * (2048 * PG_TOK)); LAS float* lcu = (LAS float*)(lent + 128 * PG_TOK); LAS float* lcv = lcu + 128 * PG_TOK; LAS float* acl = lcv + 128 * PG_TOK;
        LAS unsigned* lx = (LAS unsigned*)(F.lds + RING_OFF + NWAVES * 2048 * PG_TOK + F.wave * (2048 * PG_TOK));
#pragma unroll
        for (int tk = 0; tk < PG_TOK; ++tk) { const int t = F.vcu * ntok_wg + ti + tk;
            const u32x4 xa = *(const u32x4*)(H1G + (size_t)t * 1024 + 16 * l), xb = *(const u32x4*)(H1G + (size_t)t * 1024 + 16 * l + 8);
            *(LAS u32x4*)(lx + tk * 512 + l * 8) = xa; *(LAS u32x4*)(lx + tk * 512 + l * 8 + 4) = xb;
#pragma unroll
            for (int i = 0; i < 16; ++i) acc[tk][i] = 0.f; }
#pragma unroll 1
        for (int tk = 0; tk < PG_TOK; ++tk) { const int t = F.vcu * ntok_wg + ti + tk;
            const f32x4* sp = (const f32x4*)(SSQ1 + (size_t)t * 16); const f32x4 st = (sp[0] + sp[1]) + (sp[2] + sp[3]); const float rstd1 = __builtin_amdgcn_rsqf(((st[0] + st[1]) + (st[2] + st[3])) * (1.0f / 1024.0f) + EPS);
            unsigned a0 = EXPO[(size_t)t * 128 + l], a1 = EXPO[(size_t)t * 128 + 64 + l];
            { unsigned s0 = (a0 << 18) | (a0 >> 14), s1 = (a1 << 18) | (a1 >> 14);
              int ls = l; asm volatile("" : "+v"(ls));
#define BSTEP(K, J) do { const bool up = (ls & (J)) != 0; const unsigned p0 = sxu<J>(s0, ls), p1 = sxu<J>(s1, ls); \
                  const bool asc0 = (ls & (K)) == 0, asc1 = ((ls + 64) & (K)) == 0; \
                  s0 = (up == asc0) ? max(s0, p0) : min(s0, p0); s1 = (up == asc1) ? max(s1, p1) : min(s1, p1); } while (0)
              BSTEP(2, 1);
              BSTEP(4, 2); BSTEP(4, 1);
              BSTEP(8, 4); BSTEP(8, 2); BSTEP(8, 1);
              BSTEP(16, 8); BSTEP(16, 4); BSTEP(16, 2); BSTEP(16, 1);
              BSTEP(32, 16); BSTEP(32, 8); BSTEP(32, 4); BSTEP(32, 2); BSTEP(32, 1);
              BSTEP(64, 32); BSTEP(64, 16); BSTEP(64, 8); BSTEP(64, 4); BSTEP(64, 2); BSTEP(64, 1);
              { const unsigned lo = min(s0, s1), hi = max(s0, s1); s0 = lo; s1 = hi; }
              BSTEP(128, 32); BSTEP(128, 16); BSTEP(128, 8); BSTEP(128, 4); BSTEP(128, 2); BSTEP(128, 1);
#undef BSTEP
              a0 = (s0 >> 18) | (s0 << 14); a1 = (s1 >> 18) | (s1 << 14); }
            lent[tk * 128 + l] = a0; lent[tk * 128 + 64 + l] = a1;
            lcu[tk * 128 + l] = RSU[a0 & 0x3fffu] * rstd1; lcu[tk * 128 + 64 + l] = RSU[a1 & 0x3fffu] * rstd1;
            lcv[tk * 128 + l] = RSV[a0 & 0x3fffu] * __uint_as_float(a0 & ~0x3fffu); lcv[tk * 128 + 64 + l] = RSV[a1 & 0x3fffu] * __uint_as_float(a1 & ~0x3fffu); }
        LDS_WAIT(); asm volatile("" ::: "memory");
        u32x4 buf0[8], buf1[8];
#define ROWS8(BUF, TAB, tk, eb) do { const u32x4 ea_ = *(const LAS u32x4*)(lent + (tk) * 128 + (eb)), eb_ = *(const LAS u32x4*)(lent + (tk) * 128 + (eb) + 4); \
            const unsigned en_[8] = {ea_.x, ea_.y, ea_.z, ea_.w, eb_.x, eb_.y, eb_.z, eb_.w}; \
            _Pragma("unroll") for (int k = 0; k < 8; ++k) BUF[k] = *(const u32x4*)((TAB) + ((en_[k] & 0x3fffu) * 1024u + 16u * (unsigned)l)); } while (0)
#define U8(BUF, tk, eb) do { float p[8]; const u32x4 xa_ = *(const LAS u32x4*)(lx + (tk) * 512 + l * 8), xb_ = *(const LAS u32x4*)(lx + (tk) * 512 + l * 8 + 4); \
            const unsigned xq[8] = {xa_.x, xa_.y, xa_.z, xa_.w, xb_.x, xb_.y, xb_.z, xb_.w}; \
            _Pragma("unroll") for (int k = 0; k < 8; ++k) { float f[16]; FP8_UNPACK16(BUF[k], f); float s = 0.f; \
                _Pragma("unroll") for (int i = 0; i < 8; ++i) s = __builtin_amdgcn_fdot2_f32_bf16(__builtin_bit_cast(bf16x2_t, cvtpk(f[2 * i], f[2 * i + 1])), __builtin_bit_cast(bf16x2_t, xq[i]), s, false); \
                p[k] = s; if (k & 1) __builtin_amdgcn_sched_barrier(0); } \
            float q4[4], q2[2], q1; \
            _Pragma("unroll") for (int j = 0; j < 4; ++j) q4[j] = sum_swap32(p[j], p[4 + j]); \
            _Pragma("unroll") for (int j = 0; j < 2; ++j) q2[j] = sum_swap16(q4[j], q4[2 + j]); \
            { const bool up = (l & 8) != 0; const float keep = up ? q2[1] : q2[0], send = up ? q2[0] : q2[1]; q1 = keep + sxf<8>(send, l); } \
            q1 += sxf<4>(q1, l); q1 += sxf<2>(q1, l); q1 += sxf<1>(q1, l); \
            const float cu = lcu[(tk) * 128 + (eb) + (l >> 3)], cv = lcv[(tk) * 128 + (eb) + (l >> 3)]; \
            const float a_ = gelu_tanh(q1 * cu) * cv; if ((l & 7) == 0) acl[(tk) * 128 + (eb) + (l >> 3)] = a_; __builtin_amdgcn_sched_barrier(0); } while (0)
#define V8(BUF, tk, eb) do { const float av = acl[(tk) * 128 + (eb) + (l & 7)]; \
            _Pragma("unroll") for (int k = 0; k < 8; ++k) { const float ak = __uint_as_float(__builtin_amdgcn_readlane(__float_as_uint(av), k)); float f[16]; FP8_UNPACK16(BUF[k], f); \
                _Pragma("unroll") for (int i = 0; i < 16; ++i) acc[tk][i] += ak * f[i]; if (k & 1) __builtin_amdgcn_sched_barrier(0); } } while (0)
        ROWS8(buf0, UB, 0, 0);
#if PG_TOK == 4
#define TURNS4(CONS, TAB, eb, NEXT) do { ROWS8(buf1, TAB, 1, eb); CONS(buf0, 0, eb); ROWS8(buf0, TAB, 2, eb); CONS(buf1, 1, eb); ROWS8(buf1, TAB, 3, eb); CONS(buf0, 2, eb); NEXT; CONS(buf1, 3, eb); } while (0)
#pragma unroll 1
        for (int eb = 0; eb < 120; eb += 8) TURNS4(U8, UB, eb, ROWS8(buf0, UB, 0, eb + 8));
        TURNS4(U8, UB, 120, ROWS8(buf0, VB, 0, 0));
        LDS_WAIT(); asm volatile("" ::: "memory");
#pragma unroll 1
        for (int eb = 0; eb < 120; eb += 8) TURNS4(V8, VB, eb, ROWS8(buf0, VB, 0, eb + 8));
        TURNS4(V8, VB, 120, (void)0);
#undef TURNS4
#elif PG_TOK == 2
#define TURNS2(CONS, TAB, eb, NEXT) do { ROWS8(buf1, TAB, 1, eb); CONS(buf0, 0, eb); NEXT; CONS(buf1, 1, eb); } while (0)
#pragma unroll 1
        for (int eb = 0; eb < 120; eb += 8) TURNS2(U8, UB, eb, ROWS8(buf0, UB, 0, eb + 8));
        TURNS2(U8, UB, 120, ROWS8(buf0, VB, 0, 0));
        LDS_WAIT(); asm volatile("" ::: "memory");
#pragma unroll 1
        for (int eb = 0; eb < 120; eb += 8) TURNS2(V8, VB, eb, ROWS8(buf0, VB, 0, eb + 8));
        TURNS2(V8, VB, 120, (void)0);
#undef TURNS2
#else
#error PG_TOK must be 2 or 4
#endif
#undef ROWS8
#undef U8
#undef V8
#pragma unroll
        for (int tk = 0; tk < PG_TOK; ++tk) { const int t = F.vcu * ntok_wg + ti + tk;
            const float* hrow = H1 + (size_t)t * 1024 + 16 * l; float* h2row = H2 + (size_t)t * 1024 + 16 * l; float ss = 0.f; f32x4 h[4];
#pragma unroll
            for (int q = 0; q < 4; ++q) { h[q] = *(const f32x4*)(hrow + 4 * q);
#pragma unroll
                for (int j = 0; j < 4; ++j) { h[q][j] += acc[tk][4 * q + j]; ss += h[q][j] * h[q][j]; }
                if (!F.dry) *(f32x4*)(h2row + 4 * q) = h[q]; }
            const float rstd3 = __builtin_amdgcn_rsqf(wave_sum_sx(ss, l) * (1.0f / 1024.0f) + EPS);
            u32x4 o[2];
#pragma unroll
            for (int q2 = 0; q2 < 2; ++q2) { const f32x4 g0 = *(const f32x4*)(g_ple + 16 * l + 8 * q2), g1 = *(const f32x4*)(g_ple + 16 * l + 8 * q2 + 4);
                const f32x4 a = h[2 * q2] * rstd3 * g0, c = h[2 * q2 + 1] * rstd3 * g1;
                o[q2].x = cvtpk(a[0], a[1]); o[q2].y = cvtpk(a[2], a[3]); o[q2].z = cvtpk(c[0], c[1]); o[q2].w = cvtpk(c[2], c[3]); }
            if (!F.dry) { *(u32x4*)(XN3 + (size_t)t * 1024 + 16 * l) = o[0]; *(u32x4*)(XN3 + (size_t)t * 1024 + 16 * l + 8) = o[1]; } }
    }
}

__device__ __forceinline__ void phase_final(Frame& F) {
    const float* SSQ3 = WSP(float, WS_SSQ3); const float* g = F.in[19];
    const int l = F.lane; const int gw = F.vcu * NWAVES + F.wave, NGW = F.G * NWAVES;
    for (int t = gw; t < T_TOK; t += NGW) {
        const f32x4* sp = (const f32x4*)(SSQ3 + (size_t)t * 16); const f32x4 st = (sp[0] + sp[1]) + (sp[2] + sp[3]);
        const float rstd = __builtin_amdgcn_rsqf(((st[0] + st[1]) + (st[2] + st[3])) * (1.0f / 1024.0f) + EPS);
        f32x4* row = (f32x4*)(F.out + (size_t)t * 1024);
#pragma unroll
        for (int j = 0; j < 4; ++j) { const f32x4 gv = *((const f32x4*)g + l + 64 * j); const f32x4 o = row[l + 64 * j] * rstd * gv; if (!F.dry) row[l + 64 * j] = o; }
    }
}
#ifndef MK_FUSED
#define MK_FUSED 1
#endif
constexpr int NPHASE = 11;
struct Args { const float* in[20]; float* out; unsigned char* ws; int ph_lo, ph_hi, dry, pad; };
static_assert(sizeof(Args) == 20 * 8 + 8 + 8 + 4 * 4, "Args has no padding");

__global__ void __launch_bounds__(NWAVES * 64, 2) mk_fwd(Args args) {
    extern __shared__ __attribute__((aligned(16))) unsigned char lds_raw[];
    Frame F;
    F.lds = (LAS unsigned char*)lds_raw;
    F.wave = __builtin_amdgcn_readfirstlane(threadIdx.x >> 6); F.lane = lane_id(); F.tid = F.wave * 64 + F.lane;
    F.G = gridDim.x; { const int bx = blockIdx.x; F.vcu = (F.G % 8 == 0) ? (bx % 8) * (F.G / 8) + bx / 8 : bx; }
    F.in = args.in; F.out = args.out; F.ws = args.ws; F.dry = args.dry;
    volatile LAS unsigned* MISC = (volatile LAS unsigned*)(F.lds + MISC_OFF);
    if (F.tid < 64) MISC[F.tid] = 0u;
    __syncthreads();
    const int lo = args.ph_lo, hi = args.ph_hi;
    XcdBarrier bar; bar.bar = (unsigned*)(F.ws + WS_CTL) + CW_BAR; bar.x = 0; bar.st = nullptr;
    if (hi - lo > 1) bar = xcd_barrier_post((unsigned*)(F.ws + WS_CTL) + CW_BAR, MISC + 8, F.tid);
#ifndef PH_MASK
#define PH_MASK 0xFFFFFFFFu
#endif
#define IN(k) (((PH_MASK >> (k)) & 1u) && lo <= (k) && (k) < hi)
#define LAUNDER(p, T) do { unsigned _lo = (unsigned)(unsigned long long)(p), _hi = (unsigned)((unsigned long long)(p) >> 32); asm volatile("" : "+v"(_lo), "+v"(_hi)); \
        _lo = __builtin_amdgcn_readfirstlane(_lo); _hi = __builtin_amdgcn_readfirstlane(_hi); (p) = (T)(((unsigned long long)_hi << 32) | _lo); } while (0)
#define SEAM(k) do { if (IN(k) && IN((k) + 1)) xcd_barrier(bar, F.tid); LAUNDER(F.ws, unsigned char*); LAUNDER(F.out, float*); F.lane = lane_id(); F.tid = F.wave * 64 + F.lane; } while (0)
    const int bx = (int)blockIdx.x;
    LAS unsigned char* ring = F.lds + RING_OFF;

    if (IN(0)) { phase_prologue(F); } SEAM(0);
    if (IN(1)) {
        pg8::Gemm g{WSP(bf16_t, WS_XN1), WSP(bf16_t, WS_WIN), T_TOK, 8192, 1024, 1024, 0, 2, 8}; pg8::StaticOrder S; S.init(T_TOK, 8192, F.G, bx);
        pg8::EpiProj E{WSP(bf16_t, WS_GQ), WSP(bf16_t, WS_GK), WSP(bf16_t, WS_GV), WSP(bf16_t, WS_GR), WSP(bf16_t, WS_SQ), WSP(bf16_t, WS_SK), WSP(bf16_t, WS_SV),
                       (bf16_t*)F.out, (bf16_t*)F.out + (size_t)T_TOK * 1024};
        pg8::gemm_phase<pg8::EpiProj>(ring, g, S, E, F.tid);
    } SEAM(1);
    if (IN(2)) { phase_gla_prep(F); } SEAM(2);
    if (IN(3)) { phase_attn_a(F); } SEAM(3);
    if (IN(4)) { phase_attn_b(F); } SEAM(4);
    if (IN(5)) {
        cvt_rows_fp8(F, F.in[14], WSP(unsigned char, WS_UB8), WSP(float, WS_RSU));
        cvt_rows_fp8(F, F.in[15], WSP(unsigned char, WS_VB8), WSP(float, WS_RSV));
        VM_WAIT(); __syncthreads();
        pg8::StaticOrder S; S.init(T_TOK, 1024, F.G, bx);
        { pg8::Gemm g{WSP(bf16_t, WS_GLAN), WSP(bf16_t, WS_WGA), T_TOK, 1024, 1024, 1024, 0, 0, 0}; pg8::EpiMix<true> E{(const bf16_t*)F.out, WSP(bf16_t, WS_MIX)};
          pg8::gemm_phase<pg8::EpiMix<true>>(ring, g, S, E, F.tid); }
        { pg8::Gemm g{WSP(bf16_t, WS_SQ), WSP(bf16_t, WS_WSB), T_TOK, 1024, 1024, 1024, 0, 0, 0}; pg8::EpiMix<false> E{(const bf16_t*)F.out + (size_t)T_TOK * 1024, WSP(bf16_t, WS_MIX)};
          pg8::gemm_phase<pg8::EpiMix<false>>(ring, g, S, E, F.tid); }
    } SEAM(5);
    if (IN(6)) {
        pg8::Gemm g{WSP(bf16_t, WS_MIX), WSP(bf16_t, WS_WO), T_TOK, 1024, 1024, 1024, 0, 0, 0}; pg8::StaticOrder S; S.init(T_TOK, 1024, F.G, bx);
        pg8::EpiH1 E{F.in[0], F.in[10], WSP(float, WS_H1), WSP(bf16_t, WS_H1G), WSP(float, WS_SSQ1)};
        pg8::gemm_phase<pg8::EpiH1>(ring, g, S, E, F.tid);
    } SEAM(6);
    if (IN(7)) {
        pg8::Gemm g{WSP(bf16_t, WS_H1G), WSP(bf16_t, WS_WPQ), T_TOK, 2048, 1024, 1024, 0, 0, 0}; pg8::StaticOrder S; S.init(T_TOK, 2048, F.G, bx);
        pg8::EpiQ E{WSP(float, WS_SSQ1), WSP(bf16_t, WS_Q), 2048};
        pg8::gemm_phase<pg8::EpiQ>(ring, g, S, E, F.tid);
    } SEAM(7);
    if (IN(8)) {
        cvt_copy(F, F.in[1], WSP(bf16_t, WS_PB), (size_t)T_TOK * 256);
        phase_peer_retrieve(F);
        VM_WAIT(); __syncthreads();
        phase_peer_gather(F, bar, false);
    } SEAM(8);
    if (IN(9)) {
        pg8::StaticOrder S; S.init(T_TOK, 1024, F.G, bx);
        { pg8::Gemm g{WSP(bf16_t, WS_PB), WSP(bf16_t, WS_WPLE), T_TOK, 1024, 256, 256, 0, 0, 0}; pg8::EpiBf E{WSP(bf16_t, WS_PLE), 1024};
          pg8::gemm_phase<pg8::EpiBf>(ring, g, S, E, F.tid); }
        { pg8::Gemm g{WSP(bf16_t, WS_XN3), WSP(bf16_t, WS_WPG), T_TOK, 1024, 1024, 1024, 0, 0, 0}; pg8::EpiH3 E{F.out, WSP(bf16_t, WS_PLE), F.out, WSP(float, WS_SSQ3), F.dry};
          pg8::gemm_phase<pg8::EpiH3>(ring, g, S, E, F.tid); }
    } SEAM(9);
    if (IN(10)) { phase_final(F); }
#undef IN
#undef SEAM
}

extern "C" void kernel_launch(void* const* d_in, const int* in_sizes, int n_in, void* d_out, int out_size, void* d_ws, size_t ws_size, hipStream_t stream) {
    static int grid = 0;
    if (grid == 0) {
        if (n_in != 20 || in_sizes[0] != T_TOK * 1024 || out_size != T_TOK * 1024 || ws_size < WS_END) {
            fprintf(stderr, "kernel_launch: unexpected shapes (n_in %d, in0 %d, out %d, ws %zu < %zu?); nothing launched\n", n_in, n_in > 0 ? in_sizes[0] : -1, out_size, ws_size, (size_t)WS_END); grid = -1; return; }
        int dev = 0, cus = 0, per_cu = 0;
        if (hipGetDevice(&dev) != hipSuccess || hipDeviceGetAttribute(&cus, hipDeviceAttributeMultiprocessorCount, dev) != hipSuccess) { grid = -1; return; }
        if (hipFuncSetAttribute((const void*)mk_fwd, hipFuncAttributeMaxDynamicSharedMemorySize, LDS_BYTES) != hipSuccess) { fprintf(stderr, "kernel_launch: hipFuncSetAttribute failed\n"); grid = -1; return; }
        if (hipOccupancyMaxActiveBlocksPerMultiprocessor(&per_cu, (const void*)mk_fwd, NWAVES * 64, LDS_BYTES) != hipSuccess || per_cu < 1)
            fprintf(stderr, "kernel_launch: note: occupancy query reports %d workgroups per CU\n", per_cu);
        (void)hipGetLastError();
        grid = cus;
        if (grid != 256) fprintf(stderr, "kernel_launch: note: %d CUs (kernel tuned for 256)\n", grid);
    }
    if (grid < 0) return;
    if (hipMemsetAsync((char*)d_ws + WS_CTL, 0, CTL_ZERO_BYTES, stream) != hipSuccess) { fprintf(stderr, "kernel_launch: hipMemsetAsync failed\n"); return; }
    Args a{};
    for (int i = 0; i < 20; ++i) a.in[i] = (const float*)d_in[i];
    a.out = (float*)d_out; a.ws = (unsigned char*)d_ws;
#if MK_FUSED
    a.ph_lo = 0; a.ph_hi = NPHASE;
    hipLaunchKernelGGL(mk_fwd, dim3(grid), dim3(NWAVES * 64), LDS_BYTES, stream, a);
#else
#ifndef PROBE_PHASE
#define PROBE_PHASE -1
#define PROBE_REPS 0
#endif
    for (int p = 0; p < NPHASE; ++p) { a.ph_lo = p; a.ph_hi = p + 1;
        if (p == PROBE_PHASE) { a.dry = 1; for (int r = 0; r < PROBE_REPS; ++r) hipLaunchKernelGGL(mk_fwd, dim3(grid), dim3(NWAVES * 64), LDS_BYTES, stream, a); a.dry = 0; }
        hipLaunchKernelGGL(mk_fwd, dim3(grid), dim3(NWAVES * 64), LDS_BYTES, stream, a); }
#endif
}
```

```cpp
#define MK_FUSED 1
#define PG_TOK 2
#include <hip/hip_runtime.h>
#include <cstdio>
#include <cstdint>

#define LAS __attribute__((address_space(3)))
#define GAS __attribute__((address_space(1)))
typedef unsigned short bf16_t;
typedef short bf16x8 __attribute__((ext_vector_type(8)));
typedef short s16x4 __attribute__((ext_vector_type(4)));
typedef float f32x2 __attribute__((ext_vector_type(2)));
typedef float f32x4 __attribute__((ext_vector_type(4)));
typedef float f32x16 __attribute__((ext_vector_type(16)));
typedef unsigned u32x2 __attribute__((ext_vector_type(2)));
typedef unsigned u32x4 __attribute__((ext_vector_type(4)));
typedef __bf16 bf16x2_t __attribute__((ext_vector_type(2)));

__device__ __forceinline__ unsigned cvtpk(float lo, float hi) { f32x2 v = {lo, hi}; bf16x2_t b = __builtin_convertvector(v, bf16x2_t); return __builtin_bit_cast(unsigned, b); }
__device__ __forceinline__ float bf_lo(unsigned u) { return __uint_as_float(u << 16); }
__device__ __forceinline__ float bf_hi(unsigned u) { return __uint_as_float(u & 0xffff0000u); }
__device__ __forceinline__ float bf1(bf16_t u) { return __uint_as_float(((unsigned)u) << 16); }
__device__ __forceinline__ float fast_sigmoid(float x) { return __builtin_amdgcn_rcpf(1.0f + __expf(-x)); }

namespace pg8 {
constexpr int BM = 256, BK = 64, HALF = 128, HTB = HALF * BK * 2  , STAGE_BYTES = 8 * HTB, NXCD = 8, WGM = 8;

__host__ __device__ __forceinline__ int lds_byte(int r, int c) { const int st = (r >> 4) * 2 + (c >> 5), rr = r & 15, cc = c & 31, ob = rr * 64 + cc * 2; return st * 1024 + (ob ^ (((ob >> 9) & 1) << 5)); }
__host__ __device__ __forceinline__ void stage_rc(int b, int& R, int& C) { const int st = b / 1024, sb = b % 1024, swz = sb ^ (((sb >> 9) & 1) << 5); R = (st >> 1) * 16 + swz / 64; C = (st & 1) * 32 + (swz % 64) / 2; }
__host__ __device__ __forceinline__ int perm32(int rho) { const int n = rho >> 4, i = rho & 15; return 8 * (i >> 2) + 4 * n + (i & 3); }

struct Unit { int pm, pn; };
struct Gemm { const bf16_t* A; const bf16_t* Bt; int M, N, K, lda, a_pn_cols; int swap_lo, swap_hi; };

struct StaticOrder {
    int nM, nN, nwg, G, c;
    __host__ __device__ void init(int M, int N, int G_, int c_) { nM = M / BM; nN = N / BM; nwg = nM * nN; G = G_; c = c_; }
    __host__ __device__ bool next(int i, Unit& u) const {
        const long L = (long)i * G + c; if (L >= nwg) return false;
        int wgid = (int)L; { const int q = nwg / NXCD, r = nwg % NXCD, xcd = wgid % NXCD, off = wgid / NXCD; wgid = (xcd < r ? xcd * (q + 1) : r * (q + 1) + (xcd - r) * q) + off; }
        const int nig = WGM * nN, gid = wgid / nig, fm = gid * WGM, gsz = (nM - fm) < WGM ? (nM - fm) : WGM;
        u.pm = fm + ((wgid % nig) % gsz); u.pn = (wgid % nig) / gsz; return true;
    }
};

template <class Epi, bool ALIGN_EPI = true, bool SP2 = true>
__device__ __forceinline__ void gemm_phase(LAS unsigned char* lds, const Gemm g, const StaticOrder& S, const Epi& E, int tid) {
    const int wid = __builtin_amdgcn_readfirstlane(tid >> 6), lane = tid & 63, wr = wid >> 2, wc = wid & 3, fr = lane & 15, fq = lane >> 4;
    const int K = g.K, nt = K / BK, lda = g.lda;
    unsigned voffA[2], voffB[2];
#pragma unroll
    for (int i = 0; i < 2; ++i) { int R, C; stage_rc(tid * 16 + i * 8192, R, C); const int Rb = Epi::PERM ? ((R & ~31) + perm32(R & 31)) : R;
        voffA[i] = (unsigned)(R * lda + C) * 2u; voffB[i] = (unsigned)(Rb * K + C) * 2u; }
    const size_t kstep = (size_t)(BK * 2);
    const size_t hA = (size_t)HALF * lda * 2, hB = (size_t)HALF * K * 2;
    const size_t tA = 2 * hA, tB = 2 * hB;
    const size_t pnA = (size_t)g.a_pn_cols * 2;
    const unsigned ldsw = (unsigned)wid * 1024u;
    const int aoff = lds_byte(wr * 64 + fr, fq * 8), boff = lds_byte(wc * 32 + fr, fq * 8);
#define PG8_SA(b, h) (((b) * 2 + (h)) * HTB)
#define PG8_SB(b, h) ((4 + (b) * 2 + (h)) * HTB)
#define PG8_STAGE(bufoff, gbase, voff) do { _Pragma("unroll") for (int _i = 0; _i < 2; ++_i) \
        __builtin_amdgcn_global_load_lds((const unsigned*)((const char*)(gbase) + (voff)[_i]), (LAS unsigned*)(lds + (bufoff) + ldsw + _i * 8192), 16, 0, 0); } while (0)
#define PG8_LDA(dst, b, h) do { _Pragma("unroll") for (int m = 0; m < 4; ++m) _Pragma("unroll") for (int k = 0; k < 2; ++k) dst[m][k] = *(const LAS bf16x8*)(lds + PG8_SA(b, h) + aoff + m * 2048 + k * 1024); } while (0)
#define PG8_LDB(dst, b, h) do { _Pragma("unroll") for (int n = 0; n < 2; ++n) _Pragma("unroll") for (int k = 0; k < 2; ++k) dst[n][k] = *(const LAS bf16x8*)(lds + PG8_SB(b, h) + boff + n * 2048 + k * 1024); } while (0)
#define PG8_MMA(ai, bj, At, Bt) do { __builtin_amdgcn_s_setprio(1); _Pragma("unroll") for (int m = 0; m < 4; ++m) _Pragma("unroll") for (int n = 0; n < 2; ++n) _Pragma("unroll") for (int k = 0; k < 2; ++k) \
        acc[ai][bj][m][n] = __builtin_amdgcn_mfma_f32_16x16x32_bf16(Bt[n][k], At[m][k], acc[ai][bj][m][n], 0, 0, 0); __builtin_amdgcn_s_setprio(0); } while (0)
#define PG8_WAIT_V(n) asm volatile("s_waitcnt vmcnt(" #n ")" ::: "memory")
#define PG8_WAIT_L(n) asm volatile("s_waitcnt lgkmcnt(" #n ")" ::: "memory")
#define PG8_BAR __builtin_amdgcn_s_barrier()
#define PG8_SCHED __builtin_amdgcn_sched_barrier(0)
    Unit cur, nxt; int ui = 0;
    if (!S.next(0, cur)) return;
    f32x4 acc[2][2][4][2];
#pragma unroll
    for (int a = 0; a < 2; ++a)
#pragma unroll
        for (int b = 0; b < 2; ++b)
#pragma unroll
            for (int m = 0; m < 4; ++m)
#pragma unroll
                for (int n = 0; n < 2; ++n) acc[a][b][m][n] = (f32x4){0.f, 0.f, 0.f, 0.f};
    bf16x8 At[4][2], B0[2][2], B1[2][2];
#define PG8_APTR(u) (((u).pn >= g.swap_lo && (u).pn < g.swap_hi) ? (const char*)g.Bt + (size_t)(u).pn * tB : (const char*)g.A + (size_t)(u).pm * tA + (size_t)(u).pn * pnA)
#define PG8_BPTR(u) (((u).pn >= g.swap_lo && (u).pn < g.swap_hi) ? (const char*)g.A + (size_t)(u).pm * tA : (const char*)g.Bt + (size_t)(u).pn * tB)
    const char* cA = PG8_APTR(cur); const char* cB = PG8_BPTR(cur);
    if constexpr (SP2) {
        PG8_STAGE(PG8_SB(0, 0), cB, voffB); PG8_STAGE(PG8_SB(0, 1), cB + hB, voffB); PG8_STAGE(PG8_SA(0, 0), cA, voffA); PG8_STAGE(PG8_SA(0, 1), cA + hA, voffA);
        if (wr == 1) PG8_BAR;
        PG8_WAIT_V(2); PG8_BAR;
        PG8_STAGE(PG8_SB(1, 0), cB + kstep, voffB); PG8_STAGE(PG8_SA(1, 0), cA + kstep, voffA); PG8_STAGE(PG8_SB(1, 1), cB + hB + kstep, voffB);
        PG8_WAIT_V(6); PG8_BAR;
    } else {
        PG8_STAGE(PG8_SB(0, 0), cB, voffB); PG8_STAGE(PG8_SA(0, 0), cA, voffA); PG8_STAGE(PG8_SB(0, 1), cB + hB, voffB); PG8_STAGE(PG8_SA(0, 1), cA + hA, voffA);
        if (wr == 1) PG8_BAR;
        PG8_WAIT_V(4); PG8_BAR;
        PG8_STAGE(PG8_SB(1, 0), cB + kstep, voffB); PG8_STAGE(PG8_SA(1, 0), cA + kstep, voffA); PG8_STAGE(PG8_SB(1, 1), cB + hB + kstep, voffB);
        PG8_WAIT_V(6); PG8_BAR;
    }
    for (;;) {
        const bool has_next = S.next(ui + 1, nxt);
        const char* nA = has_next ? PG8_APTR(nxt) : cA; const char* nB = has_next ? PG8_BPTR(nxt) : cB;
#pragma unroll 1
        for (int t = 0; t < nt; t += 2) {
            const bool last = (t == nt - 2);
            const char* a1 = cA + (size_t)(t + 1) * kstep;
            const char* a2 = last ? nA : cA + (size_t)(t + 2) * kstep; const char* b2 = last ? nB : cB + (size_t)(t + 2) * kstep;
            const char* a3 = a2 + kstep; const char* b3 = b2 + kstep;
            if constexpr (SP2) {
            PG8_LDB(B0, 0, 0); PG8_LDB(B1, 0, 1); PG8_SCHED; PG8_LDA(At, 0, 0); PG8_STAGE(PG8_SA(1, 1), a1 + hA, voffA);
            PG8_WAIT_V(8); PG8_WAIT_L(0); PG8_BAR; PG8_MMA(0, 0, At, B0); PG8_MMA(0, 1, At, B1); PG8_BAR; PG8_SCHED;
            PG8_LDA(At, 0, 1); PG8_STAGE(PG8_SB(0, 0), b2, voffB); PG8_STAGE(PG8_SB(0, 1), b2 + hB, voffB); PG8_STAGE(PG8_SA(0, 0), a2, voffA);
            PG8_WAIT_V(8); PG8_WAIT_L(0); PG8_BAR; PG8_MMA(1, 0, At, B0); PG8_MMA(1, 1, At, B1); PG8_BAR; PG8_SCHED;
            PG8_LDB(B0, 1, 0); PG8_LDB(B1, 1, 1); PG8_SCHED; PG8_LDA(At, 1, 0); PG8_STAGE(PG8_SA(0, 1), a2 + hA, voffA);
            PG8_WAIT_V(8); PG8_WAIT_L(0); PG8_BAR; PG8_MMA(0, 0, At, B0); PG8_MMA(0, 1, At, B1); PG8_BAR; PG8_SCHED;
            PG8_LDA(At, 1, 1); PG8_STAGE(PG8_SB(1, 0), b3, voffB); PG8_STAGE(PG8_SB(1, 1), b3 + hB, voffB); PG8_STAGE(PG8_SA(1, 0), a3, voffA);
            PG8_WAIT_V(8); PG8_WAIT_L(0); PG8_BAR; PG8_MMA(1, 0, At, B0); PG8_MMA(1, 1, At, B1); PG8_BAR; PG8_SCHED;
            } else {
            PG8_LDB(B0, 0, 0); PG8_SCHED; PG8_LDA(At, 0, 0); PG8_STAGE(PG8_SA(1, 1), a1 + hA, voffA);
            PG8_WAIT_L(8); PG8_BAR; PG8_WAIT_L(0); PG8_MMA(0, 0, At, B0); PG8_BAR; PG8_SCHED;
            PG8_LDB(B1, 0, 1); PG8_STAGE(PG8_SB(0, 0), b2, voffB);
            PG8_BAR; PG8_WAIT_L(0); PG8_MMA(0, 1, At, B1); PG8_BAR;
            PG8_LDA(At, 0, 1); PG8_STAGE(PG8_SA(0, 0), a2, voffA);
            PG8_BAR; PG8_WAIT_L(0); PG8_MMA(1, 0, At, B0); PG8_BAR; PG8_SCHED;
            PG8_STAGE(PG8_SB(0, 1), b2 + hB, voffB);
            PG8_WAIT_V(6); PG8_BAR; PG8_MMA(1, 1, At, B1); PG8_BAR;
            PG8_LDB(B0, 1, 0); PG8_SCHED; PG8_LDA(At, 1, 0); PG8_STAGE(PG8_SA(0, 1), a2 + hA, voffA);
            PG8_WAIT_L(8); PG8_BAR; PG8_WAIT_L(0); PG8_MMA(0, 0, At, B0); PG8_BAR; PG8_SCHED;
            PG8_LDB(B1, 1, 1); PG8_STAGE(PG8_SB(1, 0), b3, voffB);
            PG8_BAR; PG8_WAIT_L(0); PG8_MMA(0, 1, At, B1); PG8_BAR;
            PG8_LDA(At, 1, 1); PG8_STAGE(PG8_SA(1, 0), a3, voffA);
            PG8_BAR; PG8_WAIT_L(0); PG8_MMA(1, 0, At, B0); PG8_BAR; PG8_SCHED;
            PG8_STAGE(PG8_SB(1, 1), b3 + hB, voffB);
            PG8_WAIT_V(6); PG8_BAR; PG8_MMA(1, 1, At, B1); PG8_BAR;
            }
        }
        if constexpr (ALIGN_EPI) { if (wr == 0) PG8_BAR; }
        E(acc, cur, wr, wc, fr, fq);
        if (!has_next) break;
#pragma unroll
        for (int a = 0; a < 2; ++a)
#pragma unroll
            for (int b = 0; b < 2; ++b)
#pragma unroll
                for (int m = 0; m < 4; ++m)
#pragma unroll
                    for (int n = 0; n < 2; ++n) acc[a][b][m][n] = (f32x4){0.f, 0.f, 0.f, 0.f};
        cur = nxt; cA = nA; cB = nB; ++ui;
        if constexpr (ALIGN_EPI) { if (wr == 1) PG8_BAR; }
    }
    PG8_WAIT_V(0);
    if constexpr (!ALIGN_EPI) { if (wr == 0) PG8_BAR; }
    PG8_BAR;
#undef PG8_APTR
#undef PG8_BPTR
#undef PG8_SA
#undef PG8_SB
#undef PG8_STAGE
#undef PG8_LDA
#undef PG8_LDB
#undef PG8_MMA
#undef PG8_WAIT_V
#undef PG8_WAIT_L
#undef PG8_BAR
#undef PG8_SCHED
}
}
constexpr int T_TOK = 16384, DM = 1024, SEQ = 4096, NB = 4;
constexpr float EPS = 1e-6f;
constexpr float LOG2E = 1.4426950408889634f;

namespace pg8 {
struct EpiProj {
    static constexpr bool PERM = true;
    bf16_t *GQ, *GK, *GV, *GR, *SQ, *SK, *SV, *SGA, *SGB;
    __device__ __forceinline__ void operator()(const f32x4 (&acc)[2][2][4][2], const Unit& u, int wr, int wc, int fr, int fq) const {
        const int pn = u.pn; bf16_t* base; int ldc = 1024, c0; int act = 0; float sc = 1.f;
        if (pn >= 2 && pn < 8) {
            bf16_t* tb = (pn < 4) ? GK : GV; const int f0 = ((pn < 4) ? (pn - 2) : (pn - 4)) * 256 + wr * 64 + fr, t0 = u.pm * BM + wc * 32 + 8 * fq;
#pragma unroll
            for (int ai = 0; ai < 2; ++ai)
#pragma unroll
                for (int m = 0; m < 4; ++m) { bf16_t* rowp = tb + (size_t)(f0 + ai * HALF + m * 16) * T_TOK + t0;
#pragma unroll
                    for (int bj = 0; bj < 2; ++bj) { const f32x4 v0 = acc[ai][bj][m][0], v1 = acc[ai][bj][m][1];
                        u32x4 w; w.x = cvtpk(v0[0], v0[1]); w.y = cvtpk(v0[2], v0[3]); w.z = cvtpk(v1[0], v1[1]); w.w = cvtpk(v1[2], v1[3]);
                        *(u32x4*)(rowp + bj * HALF) = w; } }
            return; }
        if (pn < 2) { base = GQ; ldc = 512; c0 = pn * 256; sc = 0.08838834764831845f; }
        else if (pn < 4) { base = GK; ldc = 512; c0 = (pn - 2) * 256; }
        else if (pn < 8) { base = GV; c0 = (pn - 4) * 256; }
        else if (pn < 12) { base = GR; c0 = (pn - 8) * 256; act = 1; }
        else if (pn < 16) { base = SQ; c0 = (pn - 12) * 256; sc = 0.125f * LOG2E; }
        else if (pn < 20) { base = SK; c0 = (pn - 16) * 256; }
        else if (pn < 24) { base = SV; c0 = (pn - 20) * 256; }
        else if (pn < 28) { base = SGA; c0 = (pn - 24) * 256; act = 2; }
        else { base = SGB; c0 = (pn - 28) * 256; act = 2; }
        const int row0 = u.pm * BM + wr * 64 + fr, col0 = c0 + wc * 32 + 8 * fq;
#pragma unroll
        for (int ai = 0; ai < 2; ++ai)
#pragma unroll
            for (int m = 0; m < 4; ++m) { bf16_t* rowp = base + (size_t)(row0 + ai * HALF + m * 16) * ldc + col0;
#pragma unroll
                for (int bj = 0; bj < 2; ++bj) { f32x4 v0 = acc[ai][bj][m][0], v1 = acc[ai][bj][m][1];
                    if (act == 1) {
#pragma unroll
                        for (int j = 0; j < 4; ++j) { v0[j] = v0[j] * fast_sigmoid(v0[j]); v1[j] = v1[j] * fast_sigmoid(v1[j]); } }
                    else if (act == 2) {
#pragma unroll
                        for (int j = 0; j < 4; ++j) { v0[j] = fast_sigmoid(v0[j]); v1[j] = fast_sigmoid(v1[j]); } }
                    else { v0 = v0 * sc; v1 = v1 * sc; }
                    u32x4 w; w.x = cvtpk(v0[0], v0[1]); w.y = cvtpk(v0[2], v0[3]); w.z = cvtpk(v1[0], v1[1]); w.w = cvtpk(v1[2], v1[3]);
                    *(u32x4*)(rowp + bj * HALF) = w; } }
    }
};
template <bool FIRST> struct EpiMix {
    static constexpr bool PERM = true;
    const bf16_t* gate; bf16_t* mixed;
    __device__ __forceinline__ void operator()(const f32x4 (&acc)[2][2][4][2], const Unit& u, int wr, int wc, int fr, int fq) const {
        const int row0 = u.pm * BM + wr * 64 + fr, col0 = u.pn * BM + wc * 32 + 8 * fq;
#pragma unroll
        for (int ai = 0; ai < 2; ++ai)
#pragma unroll
            for (int m = 0; m < 4; ++m) { const size_t off = (size_t)(row0 + ai * HALF + m * 16) * 1024 + col0;
#pragma unroll
                for (int bj = 0; bj < 2; ++bj) { const f32x4 a0 = acc[ai][bj][m][0], a1 = acc[ai][bj][m][1];
                    const u32x4 gv = *(const u32x4*)(gate + off + bj * HALF);
                    float r[8];
                    r[0] = a0[0] * bf_lo(gv.x); r[1] = a0[1] * bf_hi(gv.x); r[2] = a0[2] * bf_lo(gv.y); r[3] = a0[3] * bf_hi(gv.y);
                    r[4] = a1[0] * bf_lo(gv.z); r[5] = a1[1] * bf_hi(gv.z); r[6] = a1[2] * bf_lo(gv.w); r[7] = a1[3] * bf_hi(gv.w);
                    if (!FIRST) { const u32x4 mv = *(const u32x4*)(mixed + off + bj * HALF);
                        r[0] += bf_lo(mv.x); r[1] += bf_hi(mv.x); r[2] += bf_lo(mv.y); r[3] += bf_hi(mv.y); r[4] += bf_lo(mv.z); r[5] += bf_hi(mv.z); r[6] += bf_lo(mv.w); r[7] += bf_hi(mv.w); }
                    u32x4 w; w.x = cvtpk(r[0], r[1]); w.y = cvtpk(r[2], r[3]); w.z = cvtpk(r[4], r[5]); w.w = cvtpk(r[6], r[7]);
                    *(u32x4*)(mixed + off + bj * HALF) = w; } }
    }
};
struct EpiH1 {
    static constexpr bool PERM = false;
    const float* x; const float* g; bf16_t* H1B; bf16_t* H1G; float* SSQ;
    __device__ __forceinline__ void operator()(const f32x4 (&acc)[2][2][4][2], const Unit& u, int wr, int wc, int fr, int fq) const {
        const int row0 = u.pm * BM + wr * 64 + fr, col0 = u.pn * BM + wc * 32 + 4 * fq;
        f32x4 gv[2][2];
#pragma unroll
        for (int bj = 0; bj < 2; ++bj)
#pragma unroll
            for (int n = 0; n < 2; ++n) gv[bj][n] = *(const f32x4*)(g + col0 + bj * HALF + n * 16);
#pragma unroll
        for (int ai = 0; ai < 2; ++ai)
#pragma unroll
            for (int m = 0; m < 4; ++m) { const int row = row0 + ai * HALF + m * 16; const size_t off = (size_t)row * 1024 + col0; float s = 0.f;
#pragma unroll
                for (int bj = 0; bj < 2; ++bj)
#pragma unroll
                    for (int n = 0; n < 2; ++n) { const f32x4 xv = *(const f32x4*)(x + off + bj * HALF + n * 16); const f32x4 h = xv + acc[ai][bj][m][n];
                        s += (h[0] * h[0] + h[1] * h[1]) + (h[2] * h[2] + h[3] * h[3]);
                        u32x2 hb; hb.x = cvtpk(h[0], h[1]); hb.y = cvtpk(h[2], h[3]); *(u32x2*)(H1B + off + bj * HALF + n * 16) = hb;
                        const f32x4 hg = h * gv[bj][n]; u32x2 w; w.x = cvtpk(hg[0], hg[1]); w.y = cvtpk(hg[2], hg[3]); *(u32x2*)(H1G + off + bj * HALF + n * 16) = w; }
                s += __shfl_xor(s, 16); s += __shfl_xor(s, 32);
                if (fq == 0) SSQ[(size_t)row * 16 + u.pn * 4 + wc] = s; }
    }
};
struct EpiQ {
    static constexpr bool PERM = true;
    const float* SSQ; bf16_t* Q; int ldc;
    __device__ __forceinline__ void operator()(const f32x4 (&acc)[2][2][4][2], const Unit& u, int wr, int wc, int fr, int fq) const {
        const int row0 = u.pm * BM + wr * 64 + fr, col0 = u.pn * BM + wc * 32 + 8 * fq;
#pragma unroll
        for (int ai = 0; ai < 2; ++ai)
#pragma unroll
            for (int m = 0; m < 4; ++m) { const int row = row0 + ai * HALF + m * 16; const f32x4* sp = (const f32x4*)(SSQ + (size_t)row * 16);
                const f32x4 s0 = sp[0], s1 = sp[1], s2 = sp[2], s3 = sp[3]; const f32x4 st = (s0 + s1) + (s2 + s3);
                const float rstd = __builtin_amdgcn_rsqf(((st[0] + st[1]) + (st[2] + st[3])) * (1.0f / 1024.0f) + EPS);
                bf16_t* rowp = Q + (size_t)row * ldc + col0;
#pragma unroll
                for (int bj = 0; bj < 2; ++bj) { const f32x4 v0 = acc[ai][bj][m][0] * rstd, v1 = acc[ai][bj][m][1] * rstd;
                    u32x4 w; w.x = cvtpk(v0[0], v0[1]); w.y = cvtpk(v0[2], v0[3]); w.z = cvtpk(v1[0], v1[1]); w.w = cvtpk(v1[2], v1[3]);
                    *(u32x4*)(rowp + bj * HALF) = w; } }
    }
};
struct EpiF32 {
    static constexpr bool PERM = false;
    float* O; int ldc;
    __device__ __forceinline__ void operator()(const f32x4 (&acc)[2][2][4][2], const Unit& u, int wr, int wc, int fr, int fq) const {
        const int row0 = u.pm * BM + wr * 64 + fr, col0 = u.pn * BM + wc * 32 + 4 * fq;
#pragma unroll
        for (int ai = 0; ai < 2; ++ai)
#pragma unroll
            for (int m = 0; m < 4; ++m) { float* rowp = O + (size_t)(row0 + ai * HALF + m * 16) * ldc + col0;
#pragma unroll
                for (int bj = 0; bj < 2; ++bj)
#pragma unroll
                    for (int n = 0; n < 2; ++n) *(f32x4*)(rowp + bj * HALF + n * 16) = acc[ai][bj][m][n]; }
    }
};
struct EpiBf {
    static constexpr bool PERM = true;
    bf16_t* O; int ldc;
    __device__ __forceinline__ void operator()(const f32x4 (&acc)[2][2][4][2], const Unit& u, int wr, int wc, int fr, int fq) const {
        const int row0 = u.pm * BM + wr * 64 + fr, col0 = u.pn * BM + wc * 32 + 8 * fq;
#pragma unroll
        for (int ai = 0; ai < 2; ++ai)
#pragma unroll
            for (int m = 0; m < 4; ++m) { bf16_t* rowp = O + (size_t)(row0 + ai * HALF + m * 16) * ldc + col0;
#pragma unroll
                for (int bj = 0; bj < 2; ++bj) { const f32x4 v0 = acc[ai][bj][m][0], v1 = acc[ai][bj][m][1];
                    u32x4 w; w.x = cvtpk(v0[0], v0[1]); w.y = cvtpk(v0[2], v0[3]); w.z = cvtpk(v1[0], v1[1]); w.w = cvtpk(v1[2], v1[3]);
                    *(u32x4*)(rowp + bj * HALF) = w; } }
    }
};
struct EpiH3 {
    static constexpr bool PERM = false;
    const bf16_t* H2B; const bf16_t* PLE; bf16_t* H3B; float* SSQ; int dry;
    __device__ __forceinline__ void operator()(const f32x4 (&acc)[2][2][4][2], const Unit& u, int wr, int wc, int fr, int fq) const {
        const int row0 = u.pm * BM + wr * 64 + fr, col0 = u.pn * BM + wc * 32 + 4 * fq;
#pragma unroll
        for (int ai = 0; ai < 2; ++ai)
#pragma unroll
            for (int m = 0; m < 4; ++m) { const int row = row0 + ai * HALF + m * 16; const size_t off = (size_t)row * 1024 + col0; float s = 0.f;
#pragma unroll
                for (int bj = 0; bj < 2; ++bj)
#pragma unroll
                    for (int n = 0; n < 2; ++n) { const size_t o2 = off + bj * HALF + n * 16; const u32x2 hv = *(const u32x2*)(H2B + o2); const u32x2 pv = *(const u32x2*)(PLE + o2);
                        const f32x4 a = acc[ai][bj][m][n]; f32x4 h;
                        h[0] = bf_lo(hv.x) + bf_lo(pv.x) * fast_sigmoid(a[0]); h[1] = bf_hi(hv.x) + bf_hi(pv.x) * fast_sigmoid(a[1]);
                        h[2] = bf_lo(hv.y) + bf_lo(pv.y) * fast_sigmoid(a[2]); h[3] = bf_hi(hv.y) + bf_hi(pv.y) * fast_sigmoid(a[3]);
                        u32x2 w; w.x = cvtpk(h[0], h[1]); w.y = cvtpk(h[2], h[3]); if (!dry) *(u32x2*)(H3B + o2) = w;
                        s += (h[0] * h[0] + h[1] * h[1]) + (h[2] * h[2] + h[3] * h[3]); }
                s += __shfl_xor(s, 16); s += __shfl_xor(s, 32);
                if (fq == 0) SSQ[(size_t)row * 16 + u.pn * 4 + wc] = s;
                asm volatile("" ::: "memory"); }
    }
};
}
constexpr size_t MiB = 1u << 20;
constexpr size_t WS_CTL = 0, CTL_ZERO_BYTES = 64 * 1024;
constexpr size_t WS_PEND = 64 * 1024;
constexpr size_t WS_WPLE = 512 * 1024;
constexpr size_t WS_KD = 1 * MiB;
constexpr size_t WS_GLAG = 2 * MiB;
constexpr size_t WS_WIN = 3 * MiB;
constexpr size_t WS_SEND = 4 * MiB;
constexpr size_t WS_EXP = 4 * MiB;
constexpr size_t WS_SSQ1 = 13 * MiB;
constexpr size_t WS_SSQ3 = 14 * MiB;
constexpr size_t WS_RSU = 15 * MiB, WS_RSV = 15 * MiB + 64 * 1024;
constexpr size_t WS_WGA = 20 * MiB, WS_WSB = 22 * MiB, WS_WO = 24 * MiB, WS_WPG = 26 * MiB, WS_WPQ = 28 * MiB;
constexpr size_t WS_A = 32 * MiB;
constexpr size_t WS_GQ = WS_A, WS_GK = WS_A + 16 * MiB, WS_UB8 = WS_A, WS_VB8 = WS_A + 16 * MiB;
constexpr size_t WS_B = 64 * MiB;
constexpr size_t WS_GV = WS_B, WS_PB = WS_B;
constexpr size_t WS_C = 96 * MiB;
constexpr size_t WS_GR = WS_C, WS_H1 = WS_C, WS_H3B = WS_C;
constexpr size_t WS_D = 128 * MiB;
constexpr size_t WS_SQ = WS_D, WS_H2B = WS_D;
constexpr size_t WS_E = 160 * MiB;
constexpr size_t WS_SK = WS_E, WS_MIX = WS_E, WS_Q = WS_E, WS_PLE = WS_E;
constexpr size_t WS_F = 192 * MiB;
constexpr size_t WS_SV = WS_F;
constexpr size_t WS_G = 224 * MiB;
constexpr size_t WS_XN1 = WS_G, WS_GLAN = WS_G, WS_H1G = WS_G, WS_XN3 = WS_G;
constexpr size_t WS_END = 256 * MiB;

constexpr int NWAVES = 8;
constexpr int RING_OFF = 0, RING_BYTES = 131072;
constexpr int MISC_OFF = RING_BYTES;
constexpr int LDS_BYTES = 147456;
constexpr int CW_BAR = 1024;

typedef GAS unsigned gu32;
#define RLX_AGENT __ATOMIC_RELAXED, __HIP_MEMORY_SCOPE_AGENT
#define LDS_WAIT() asm volatile("s_waitcnt lgkmcnt(0)" ::: "memory")
#define VM_WAIT() asm volatile("s_waitcnt vmcnt(0)" ::: "memory")

#define XB_TMO      128
#define XB_XCNT(j)  (256  + 64 * (j))
#define XB_XSUB(j)  (1280 + 64 * (j))
#define XB_XGEN(j)  (2304 + 64 * (j))
#define XB_TOP      3328
#define XB_TOPGEN   3392
#define XCD_BAR_WORDS 3456
#define XB_SPIN_CAP (1u << 22)
__device__ __forceinline__ unsigned xb_ld(unsigned* p)              { return __hip_atomic_load(p, __ATOMIC_RELAXED, __HIP_MEMORY_SCOPE_AGENT); }
__device__ __forceinline__ unsigned xb_add(unsigned* p, unsigned v) { return __hip_atomic_fetch_add(p, v, __ATOMIC_RELAXED, __HIP_MEMORY_SCOPE_AGENT); }
__device__ __forceinline__ unsigned xb_xcc_id() { return (unsigned)__builtin_amdgcn_s_getreg((3 << 11) | 20) & 0xFu; }
#define XB_SPIN(cond, bar) do { unsigned _sp = 0; while (cond) { __builtin_amdgcn_s_sleep(1); \
    if ((++_sp & 255u) == 0u) { if (xb_ld(&(bar)[XB_TMO])) break; if (_sp > XB_SPIN_CAP) { atomicAdd(&(bar)[XB_TMO], 1u); break; } } } } while (0)
struct XcdBarrier { unsigned* bar; unsigned x; volatile LAS unsigned* st; };
__device__ __forceinline__ XcdBarrier xcd_barrier_post(unsigned* bar, volatile LAS unsigned* st, int tid) {
    XcdBarrier b; b.bar = bar; b.x = xb_xcc_id(); b.st = st;
    if (tid == 0) (void)xb_add(&bar[XB_XCNT(b.x)], 1u);
    return b;
}
__device__ __forceinline__ void xcd_barrier_complete(unsigned* bar, unsigned x, unsigned& nloc, unsigned& nx) {
    const unsigned G = gridDim.x * gridDim.y * gridDim.z;
    unsigned sum, cnt, mine, sp = 0u;
    for (;;) {
        sum = 0u; cnt = 0u; mine = 0u;
#pragma unroll
        for (unsigned j = 0; j < 16; ++j) { const unsigned c = xb_ld(&bar[XB_XCNT(j)]); sum += c; cnt += (c > 0u) ? 1u : 0u; mine = (j == x) ? c : mine; }
        if (sum == G) break;
        __builtin_amdgcn_s_sleep(1);
        if ((++sp & 255u) == 0u) { if (xb_ld(&bar[XB_TMO])) break; if (sp > XB_SPIN_CAP) { atomicAdd(&bar[XB_TMO], 1u); break; } }
    }
    nloc = mine > 0u ? mine : 1u; nx = cnt > 0u ? cnt : 1u;
}
__device__ __forceinline__ void xcd_barrier(const XcdBarrier& b, int tid) {
    asm volatile("s_waitcnt vmcnt(0)" ::: "memory");
    __syncthreads();
    if (tid == 0) {
        unsigned* bar = b.bar;
        __builtin_amdgcn_s_waitcnt(0);
        unsigned nloc = b.st[0], nx = b.st[1];
        if (nloc == 0u) { xcd_barrier_complete(bar, b.x, nloc, nx); b.st[0] = nloc; b.st[1] = nx; }
        const unsigned old = xb_add(&bar[XB_XSUB(b.x)], 1u);
        const unsigned gen = old / nloc;
        if (old + 1u == (gen + 1u) * nloc) {
            __builtin_amdgcn_fence(__ATOMIC_RELEASE, "agent");
            asm volatile("s_waitcnt vmcnt(0)" ::: "memory");
            const unsigned og = xb_add(&bar[XB_TOP], 1u);
            const unsigned tg = og / nx;
            if (og + 1u == (tg + 1u) * nx) xb_add(&bar[XB_TOPGEN], 1u);
            else XB_SPIN(xb_ld(&bar[XB_TOPGEN]) == tg, bar);
            __builtin_amdgcn_fence(__ATOMIC_ACQUIRE, "agent");
            xb_add(&bar[XB_XGEN(b.x)], 1u);
            asm volatile("s_waitcnt vmcnt(0)" ::: "memory");
        } else {
            XB_SPIN(xb_ld(&bar[XB_XGEN(b.x)]) == gen, bar);
            __builtin_amdgcn_fence(__ATOMIC_ACQUIRE, "agent");
            asm volatile("s_waitcnt vmcnt(0)" ::: "memory");
        }
    }
    __syncthreads();
}

struct Frame {
    LAS unsigned char* lds;
    int tid, lane, wave, vcu, G, dry;
    const float* const* in; float* out; unsigned char* ws;
};
__device__ __forceinline__ int lane_id() { int l; asm volatile("v_mbcnt_lo_u32_b32 %0, -1, 0\n\tv_mbcnt_hi_u32_b32 %0, -1, %0" : "=v"(l)); return l; }
#define WSP(T, off) ((T*)(F.ws + (off)))
__device__ __forceinline__ float wave_sum(float v) {
#pragma unroll
    for (int o = 1; o < 64; o <<= 1) v += __shfl_xor(v, o);
    return v;
}
template <class RowMap>
__device__ __forceinline__ void p0_transpose_item(const float* W, int K, int N, bf16_t* WT, RowMap rm, LAS float* scr, int item, int lane) {
    const int nblk = (N + 31) / 32, kb = item / nblk, nb = item % nblk, k0 = 64 * kb, n0 = 32 * nb;
    { const int kr = lane >> 3, c4 = lane & 7, nl = n0 + 4 * c4; f32x4 v[8];
#pragma unroll
      for (int i = 0; i < 8; ++i) v[i] = (nl < N) ? *(const f32x4*)(W + (size_t)(k0 + 8 * i + kr) * N + nl) : (f32x4){0.f, 0.f, 0.f, 0.f};
#pragma unroll
      for (int i = 0; i < 8; ++i) { LAS float* d = scr + (8 * i + kr) * 33 + 4 * c4; d[0] = v[i][0]; d[1] = v[i][1]; d[2] = v[i][2]; d[3] = v[i][3]; } }
    LDS_WAIT(); asm volatile("" ::: "memory");
    const int c = lane & 7;
#pragma unroll
    for (int j = 0; j < 4; ++j) { const int n = (lane >> 3) + 8 * j; const LAS float* s = scr + (8 * c) * 33 + n;
        u32x4 o; o.x = cvtpk(s[0 * 33], s[1 * 33]); o.y = cvtpk(s[2 * 33], s[3 * 33]); o.z = cvtpk(s[4 * 33], s[5 * 33]); o.w = cvtpk(s[6 * 33], s[7 * 33]);
        if (n0 + n < N) *(u32x4*)(WT + (size_t)rm(n0 + n) * K + k0 + 8 * c) = o; }
    LDS_WAIT(); asm volatile("" ::: "memory");
}
struct RmId { __device__ __forceinline__ int operator()(int n) const { return n; } };
struct RmWin { __device__ __forceinline__ int operator()(int n) const { return n < 3072 ? n : (n < 3088 ? 8192 + (n - 3072) : n - 16); } };

__device__ __forceinline__ void cvt_copy(Frame& F, const float* src, bf16_t* dst, size_t n) {
    const size_t nth = (size_t)F.G * 512, n8 = n / 8;
    for (size_t i = (size_t)F.vcu * 512 + F.tid; i < n8; i += nth) {
        const f32x4 a = *(const f32x4*)(src + i * 8), b = *(const f32x4*)(src + i * 8 + 4);
        u32x4 o; o.x = cvtpk(a[0], a[1]); o.y = cvtpk(a[2], a[3]); o.z = cvtpk(b[0], b[1]); o.w = cvtpk(b[2], b[3]);
        *(u32x4*)(dst + i * 8) = o; }
}
__device__ __forceinline__ void rms_row_to_bf16(const float* xrow, const float* g, bf16_t* orow, int lane) {
    f32x4 v[4]; float s = 0.f;
#pragma unroll
    for (int j = 0; j < 4; ++j) { v[j] = *((const f32x4*)xrow + lane + 64 * j); s += (v[j][0] * v[j][0] + v[j][1] * v[j][1]) + (v[j][2] * v[j][2] + v[j][3] * v[j][3]); }
    const float rstd = __builtin_amdgcn_rsqf(wave_sum(s) * (1.f / 1024.f) + EPS);
#pragma unroll
    for (int j = 0; j < 4; ++j) { const f32x4 gv = *((const f32x4*)g + lane + 64 * j); const f32x4 o = v[j] * rstd * gv;
        u32x2 w; w.x = cvtpk(o[0], o[1]); w.y = cvtpk(o[2], o[3]); *((u32x2*)orow + lane + 64 * j) = w; }
}
__device__ __forceinline__ void phase_prologue(Frame& F) {
    LAS float* scr = (LAS float*)(F.lds + RING_OFF + F.wave * 16384);
    const int gw = F.vcu * NWAVES + F.wave, NGW = F.G * NWAVES;
    constexpr int I_IN = 16 * 257, I_SQ = 16 * 32, I_PQ = 16 * 64, I_PLE = 4 * 32;
    constexpr int NITEMS = I_IN + 4 * I_SQ + I_PQ + I_PLE;
    for (int it = gw; it < NITEMS; it += NGW) {
        int r = it;
        if (r < I_IN) { p0_transpose_item(F.in[3], 1024, 8208, WSP(bf16_t, WS_WIN), RmWin(), scr, r, F.lane); continue; } r -= I_IN;
        if (r < I_SQ) { p0_transpose_item(F.in[7], 1024, 1024, WSP(bf16_t, WS_WGA), RmId(), scr, r, F.lane); continue; } r -= I_SQ;
        if (r < I_SQ) { p0_transpose_item(F.in[8], 1024, 1024, WSP(bf16_t, WS_WSB), RmId(), scr, r, F.lane); continue; } r -= I_SQ;
        if (r < I_SQ) { p0_transpose_item(F.in[9], 1024, 1024, WSP(bf16_t, WS_WO), RmId(), scr, r, F.lane); continue; } r -= I_SQ;
        if (r < I_SQ) { p0_transpose_item(F.in[17], 1024, 1024, WSP(bf16_t, WS_WPG), RmId(), scr, r, F.lane); continue; } r -= I_SQ;
        if (r < I_PQ) { p0_transpose_item(F.in[11], 1024, 2048, WSP(bf16_t, WS_WPQ), RmId(), scr, r, F.lane); continue; } r -= I_PQ;
        p0_transpose_item(F.in[18], 256, 1024, WSP(bf16_t, WS_WPLE), RmId(), scr, r, F.lane);
    }
    { const float* k1 = F.in[12]; const float* k2 = F.in[13]; bf16_t* KB = WSP(bf16_t, WS_KD);
      for (int i = F.vcu * 512 + F.tid; i < 2 * 8 * 128 * 16; i += F.G * 512) { const int half = i >> 14, rem = i & 16383, h = rem >> 11, r8 = rem & 2047;
          const float* s = (half ? k2 : k1) + (size_t)h * 16384 + (size_t)r8 * 8; const f32x4 a = *(const f32x4*)s, b = *(const f32x4*)(s + 4);
          u32x4 o; o.x = cvtpk(a[0], a[1]); o.y = cvtpk(a[2], a[3]); o.z = cvtpk(b[0], b[1]); o.w = cvtpk(b[2], b[3]);
          *(u32x4*)(KB + (size_t)(h * 2 + half) * 16384 + (size_t)r8 * 8) = o; } }
    for (int m = gw; m < T_TOK; m += 4 * NGW) {
        f32x4 v[4][4]; float s[4];
#pragma unroll
        for (int q = 0; q < 4; ++q) { const float* xr = F.in[0] + (size_t)(m + q * NGW) * 1024; s[q] = 0.f;
#pragma unroll
            for (int j = 0; j < 4; ++j) { v[q][j] = *((const f32x4*)xr + F.lane + 64 * j); s[q] += (v[q][j][0] * v[q][j][0] + v[q][j][1] * v[q][j][1]) + (v[q][j][2] * v[q][j][2] + v[q][j][3] * v[q][j][3]); } }
#pragma unroll
        for (int o = 1; o < 64; o <<= 1) {
#pragma unroll
            for (int q = 0; q < 4; ++q) s[q] += __shfl_xor(s[q], o); }
#pragma unroll
        for (int q = 0; q < 4; ++q) { const float rstd = __builtin_amdgcn_rsqf(s[q] * (1.f / 1024.f) + EPS); bf16_t* orow = WSP(bf16_t, WS_XN1) + (size_t)(m + q * NGW) * 1024;
#pragma unroll
            for (int j = 0; j < 4; ++j) { const f32x4 gv = *((const f32x4*)F.in[2] + F.lane + 64 * j); const f32x4 o = v[q][j] * rstd * gv;
                u32x2 wq; wq.x = cvtpk(o[0], o[1]); wq.y = cvtpk(o[2], o[3]); *((u32x2*)orow + F.lane + 64 * j) = wq; } }
    }
}

__device__ __forceinline__ void phase_gla_prep(Frame& F) {
    LAS float* alo = (LAS float*)(F.lds + RING_OFF);
    const bf16_t* XN1 = WSP(bf16_t, WS_XN1); const bf16_t* WGAT = WSP(bf16_t, WS_WIN) + (size_t)8192 * 1024;
    bf16_t* GKT = WSP(bf16_t, WS_GK); float* GLAG = WSP(float, WS_GLAG);
    const float* w_up = F.in[4]; const float* b_a = F.in[5];
    const int tid = F.tid, lane = F.lane, w = F.wave;
    for (int u = F.vcu; u < 256; u += F.G) {
        const size_t r0 = (size_t)u * 64;
        __syncthreads();
        const int kk = tid;
        bf16_t* krow = GKT + (size_t)kk * T_TOK + r0;
        u32x4 kq[8];
#pragma unroll
        for (int j = 0; j < 8; ++j) kq[j] = *(const u32x4*)(krow + 8 * j);
        {
            LAS float* part = alo + 1024;
            const bf16_t* bp = WGAT + (size_t)(lane & 15) * 1024 + 8 * (lane >> 4) + 128 * w;
            bf16x8 bq[4];
#pragma unroll
            for (int s = 0; s < 4; ++s) bq[s] = *(const bf16x8*)(bp + 32 * s);
#pragma unroll
            for (int rt = 0; rt < 4; ++rt) { f32x4 acc = (f32x4){0.f, 0.f, 0.f, 0.f};
                const bf16_t* ap = XN1 + (r0 + 16 * rt + (lane & 15)) * 1024 + 8 * (lane >> 4) + 128 * w;
#pragma unroll
                for (int s = 0; s < 4; ++s) { const bf16x8 a = *(const bf16x8*)(ap + 32 * s); acc = __builtin_amdgcn_mfma_f32_16x16x32_bf16(a, bq[s], acc, 0, 0, 0); }
#pragma unroll
                for (int r = 0; r < 4; ++r) part[w * 1024 + (16 * rt + 4 * (lane >> 4) + r) * 16 + (lane & 15)] = acc[r]; }
            __syncthreads();
#pragma unroll
            for (int q = 0; q < 2; ++q) { const int e = tid + 512 * q; float s = 0.f;
#pragma unroll
                for (int ww = 0; ww < 8; ++ww) s += part[ww * 1024 + e];
                alo[e] = s; }
        }
        float wv[16];
#pragma unroll
        for (int r = 0; r < 16; ++r) wv[r] = w_up[r * 512 + kk];
        const float bias = b_a[kk];
        __syncthreads();
        float suffix = 0.f;
#pragma unroll
        for (int i8 = 7; i8 >= 0; --i8) {
            const unsigned kw[4] = {kq[i8].x, kq[i8].y, kq[i8].z, kq[i8].w};
            float o[8];
#pragma unroll
            for (int j = 7; j >= 0; --j) { const int i = i8 * 8 + j;
                const f32x4 a0 = *(const LAS f32x4*)(alo + i * 16), a1 = *(const LAS f32x4*)(alo + i * 16 + 4), a2 = *(const LAS f32x4*)(alo + i * 16 + 8), a3 = *(const LAS f32x4*)(alo + i * 16 + 12);
                float x = bias;
                x += a0[0] * wv[0] + a0[1] * wv[1] + a0[2] * wv[2] + a0[3] * wv[3];
                x += a1[0] * wv[4] + a1[1] * wv[5] + a1[2] * wv[6] + a1[3] * wv[7];
                x += a2[0] * wv[8] + a2[1] * wv[9] + a2[2] * wv[10] + a2[3] * wv[11];
                x += a3[0] * wv[12] + a3[1] * wv[13] + a3[2] * wv[14] + a3[3] * wv[15];
                const float la = (fminf(x, 0.f) - __logf(1.0f + __expf(-fabsf(x)))) * (1.0f / 16.0f);
                const float kvv = (j & 1) ? bf_hi(kw[j >> 1]) : bf_lo(kw[j >> 1]);
                o[j] = kvv * __expf(suffix);
                suffix += la; }
            u32x4 pk; pk.x = cvtpk(o[0], o[1]); pk.y = cvtpk(o[2], o[3]); pk.z = cvtpk(o[4], o[5]); pk.w = cvtpk(o[6], o[7]);
            if (!F.dry) *(u32x4*)(krow + i8 * 8) = pk; }
        GLAG[(size_t)u * 512 + kk] = __expf(suffix);
    }
}
constexpr int GL_KD = 0, GL_Q = 32768, GL_G = 65536, GL_RED = 65536 + 1024;
__device__ __forceinline__ int gl_kd_off(int row, int chunk) { return row * 128 + ((chunk ^ ((row >> 1) & 7)) << 4); }
__device__ __forceinline__ int gl_q_off(int row, int chunk16) { return row * 256 + ((chunk16 ^ (row & 15)) << 4); }

struct GlaStage { u32x4 kd[2]; u32x4 q[2]; bf16x8 vt[4]; float g; };
__device__ __forceinline__ void gla_prefetch_vt(Frame& F, GlaStage& st, int b, int h, int c) {
    const int u = b * 64 + c; const size_t r0 = (size_t)u * 64; const int w = F.wave, lq = F.lane & 31, hh = F.lane >> 5;
    const bf16_t* vt = WSP(bf16_t, WS_GV) + (size_t)(h * 256 + 32 * w + lq) * T_TOK + r0;
#pragma unroll
    for (int ts = 0; ts < 4; ++ts) st.vt[ts] = *(const bf16x8*)(vt + 16 * ts + 8 * hh);
}
template <bool WITH_Q>
__device__ __forceinline__ void gla_prefetch(Frame& F, GlaStage& st, int b, int h, int c) {
    const int u = b * 64 + c; const size_t r0 = (size_t)u * 64; const int tid = F.tid;
    const bf16_t* kd = WSP(bf16_t, WS_GK) + (size_t)(h * 128) * T_TOK + r0;
#pragma unroll
    for (int j = 0; j < 2; ++j) { const int pi = tid + 512 * j; st.kd[j] = *(const u32x4*)(kd + (size_t)(pi >> 3) * T_TOK + (pi & 7) * 8); }
    if (WITH_Q) { const bf16_t* gq = WSP(bf16_t, WS_GQ) + r0 * 512 + h * 128;
#pragma unroll
        for (int j = 0; j < 2; ++j) { const int pi = tid + 512 * j; st.q[j] = *(const u32x4*)(gq + (size_t)(pi >> 4) * 512 + (pi & 15) * 8); } }
    st.g = (tid < 128) ? WSP(float, WS_GLAG)[((size_t)u * 4 + h) * 128 + tid] : 1.f;
}
template <bool WITH_Q>
__device__ __forceinline__ void gla_stage_write(Frame& F, const GlaStage& st, int buf) {
    LAS unsigned char* lds = F.lds + RING_OFF; const int tid = F.tid;
#pragma unroll
    for (int j = 0; j < 2; ++j) { const int pi = tid + 512 * j; *(LAS u32x4*)(lds + GL_KD + buf * 16384 + gl_kd_off(pi >> 3, pi & 7)) = st.kd[j]; }
    if (WITH_Q) {
#pragma unroll
        for (int j = 0; j < 2; ++j) { const int pi = tid + 512 * j; *(LAS u32x4*)(lds + GL_Q + buf * 16384 + gl_q_off(pi >> 4, pi & 15)) = st.q[j]; } }
    if (tid < 128) *(LAS float*)(lds + GL_G + buf * 512 + tid * 4) = st.g;
}
__device__ __forceinline__ void gla_update(Frame& F, f32x16 (&S)[4], const bf16x8 (&vt)[4], int buf) {
    const LAS unsigned char* lds = F.lds + RING_OFF; const int lq = F.lane & 31, hh = F.lane >> 5;
    const LAS float* G = (const LAS float*)(lds + GL_G + buf * 512);
#pragma unroll
    for (int kt = 0; kt < 4; ++kt)
#pragma unroll
        for (int g4 = 0; g4 < 4; ++g4) { const f32x4 g = *(const LAS f32x4*)(G + 32 * kt + 8 * g4 + 4 * hh);
#pragma unroll
            for (int j = 0; j < 4; ++j) S[kt][4 * g4 + j] *= g[j]; }
#pragma unroll
    for (int ts = 0; ts < 4; ++ts)
#pragma unroll
        for (int kt = 0; kt < 4; ++kt) { const bf16x8 a = *(const LAS bf16x8*)(lds + GL_KD + buf * 16384 + gl_kd_off(32 * kt + lq, 2 * ts + hh));
            S[kt] = __builtin_amdgcn_mfma_f32_32x32x16_bf16(a, vt[ts], S[kt], 0, 0, 0); if (kt == 3 && (ts & 1)) __builtin_amdgcn_sched_barrier(0); }
}
constexpr size_t SEND_WAVE_FLOATS = 4 * 4 * 64 * 4;
__device__ __forceinline__ void gla_stage1(Frame& F, int unit) {
    const int bh = unit >> 3, seg = unit & 7, b = bh >> 2, h = bh & 3, w = F.wave, l = F.lane;
    f32x16 S[4];
#pragma unroll
    for (int kt = 0; kt < 4; ++kt)
#pragma unroll
        for (int r = 0; r < 16; ++r) S[kt][r] = 0.f;
    float pend = 1.f;
    GlaStage st; gla_prefetch<false>(F, st, b, h, seg * 8); gla_prefetch_vt(F, st, b, h, seg * 8);
    for (int ci = 0; ci < 8; ++ci) {
        gla_stage_write<false>(F, st, ci & 1); pend *= st.g;
        __syncthreads();
        if (ci < 7) gla_prefetch<false>(F, st, b, h, seg * 8 + ci + 1);
        gla_update(F, S, st.vt, ci & 1);
        if (ci < 7) gla_prefetch_vt(F, st, b, h, seg * 8 + ci + 1);
    }
    float* se = WSP(float, WS_SEND) + ((size_t)unit * 8 + w) * SEND_WAVE_FLOATS;
#pragma unroll
    for (int kt = 0; kt < 4; ++kt)
#pragma unroll
        for (int g4 = 0; g4 < 4; ++g4) *(f32x4*)(se + ((kt * 4 + g4) * 64 + l) * 4) = (f32x4){S[kt][4 * g4], S[kt][4 * g4 + 1], S[kt][4 * g4 + 2], S[kt][4 * g4 + 3]};
    if (F.tid < 128) WSP(float, WS_PEND)[unit * 128 + F.tid] = pend;
    __syncthreads();
}
__device__ __forceinline__ void gla_stage3(Frame& F, int unit) {
    const int bh = unit >> 3, seg = unit & 7, b = bh >> 2, h = bh & 3, w = F.wave, l = F.lane, lq = l & 31, hh = l >> 5;
    LAS unsigned char* lds = F.lds + RING_OFF;
    const bf16_t* GR = WSP(bf16_t, WS_GR); bf16_t* GLAN = WSP(bf16_t, WS_GLAN); const float* g_o = F.in[6];
    f32x16 S[4];
#pragma unroll
    for (int kt = 0; kt < 4; ++kt)
#pragma unroll
        for (int r = 0; r < 16; ++r) S[kt][r] = 0.f;
    GlaStage st; gla_prefetch<true>(F, st, b, h, seg * 8); gla_prefetch_vt(F, st, b, h, seg * 8);
    for (int sp = 0; sp < seg; ++sp) {
        const int un = bh * 8 + sp; const float* se = WSP(float, WS_SEND) + ((size_t)un * 8 + w) * SEND_WAVE_FLOATS; const float* pe = WSP(float, WS_PEND) + un * 128;
#pragma unroll
        for (int kt = 0; kt < 4; ++kt)
#pragma unroll
            for (int g4 = 0; g4 < 4; ++g4) { const f32x4 p = *(const f32x4*)(pe + 32 * kt + 8 * g4 + 4 * hh); const f32x4 s = *(const f32x4*)(se + ((kt * 4 + g4) * 64 + l) * 4);
#pragma unroll
                for (int j = 0; j < 4; ++j) S[kt][4 * g4 + j] = S[kt][4 * g4 + j] * p[j] + s[j]; }
    }
    for (int ci = 0; ci < 8; ++ci) {
        const int c = seg * 8 + ci; const size_t r0 = (size_t)(b * 64 + c) * 64; const int buf = ci & 1;
        gla_stage_write<true>(F, st, buf);
        __syncthreads();
        if (ci < 7) gla_prefetch<true>(F, st, b, h, c + 1);
        gla_update(F, S, st.vt, buf);
        f32x16 oT[2];
#pragma unroll
        for (int tt = 0; tt < 2; ++tt) {
#pragma unroll
            for (int r = 0; r < 16; ++r) oT[tt][r] = 0.f;
            const int t = 32 * tt + lq;
#pragma unroll
            for (int kt = 0; kt < 4; ++kt)
#pragma unroll
                for (int s = 0; s < 2; ++s) {
                    u32x4 aw; aw.x = cvtpk(S[kt][8 * s + 0], S[kt][8 * s + 1]); aw.y = cvtpk(S[kt][8 * s + 2], S[kt][8 * s + 3]); aw.z = cvtpk(S[kt][8 * s + 4], S[kt][8 * s + 5]); aw.w = cvtpk(S[kt][8 * s + 6], S[kt][8 * s + 7]);
                    const u32x2 qlo = *(const LAS u32x2*)(lds + GL_Q + buf * 16384 + gl_q_off(t, 4 * kt + 2 * s) + 8 * hh), qhi = *(const LAS u32x2*)(lds + GL_Q + buf * 16384 + gl_q_off(t, 4 * kt + 2 * s + 1) + 8 * hh);
                    const u32x4 bw = (u32x4){qlo.x, qlo.y, qhi.x, qhi.y};
                    oT[tt] = __builtin_amdgcn_mfma_f32_32x32x16_bf16(__builtin_bit_cast(bf16x8, aw), __builtin_bit_cast(bf16x8, bw), oT[tt], 0, 0, 0);
                    if (s == 1 && (kt & 1)) __builtin_amdgcn_sched_barrier(0); }
        }
        LAS float* redc = (LAS float*)(lds + GL_RED) + buf * 512;
#pragma unroll
        for (int tt = 0; tt < 2; ++tt) { float s = 0.f;
#pragma unroll
            for (int r = 0; r < 16; ++r) s += oT[tt][r] * oT[tt][r];
            s += __shfl_xor(s, 32);
            if (hh == 0) redc[w * 64 + 32 * tt + lq] = s; }
        if (ci < 7) gla_prefetch_vt(F, st, b, h, c + 1);
        u32x2 sr[2][4];
#pragma unroll
        for (int tt = 0; tt < 2; ++tt)
#pragma unroll
            for (int g4 = 0; g4 < 4; ++g4) sr[tt][g4] = *(const u32x2*)(GR + (r0 + 32 * tt + lq) * 1024 + h * 256 + 32 * w + 8 * g4 + 4 * hh);
        __syncthreads();
#pragma unroll
        for (int tt = 0; tt < 2; ++tt) { float tot = 0.f;
#pragma unroll
            for (int ww = 0; ww < 8; ++ww) tot += redc[ww * 64 + 32 * tt + lq];
            const float rstd = __builtin_amdgcn_rsqf(tot * (1.0f / 256.0f) + EPS);
            const size_t row = r0 + 32 * tt + lq;
#pragma unroll
            for (int g4 = 0; g4 < 4; ++g4) { const int v0 = h * 256 + 32 * w + 8 * g4 + 4 * hh;
                const f32x4 go = *(const f32x4*)(g_o + v0);
                const float o0 = oT[tt][4 * g4 + 0] * rstd * go[0] * bf_lo(sr[tt][g4].x), o1 = oT[tt][4 * g4 + 1] * rstd * go[1] * bf_hi(sr[tt][g4].x);
                const float o2 = oT[tt][4 * g4 + 2] * rstd * go[2] * bf_lo(sr[tt][g4].y), o3 = oT[tt][4 * g4 + 3] * rstd * go[3] * bf_hi(sr[tt][g4].y);
                u32x2 wv; wv.x = cvtpk(o0, o1); wv.y = cvtpk(o2, o3); *(u32x2*)(GLAN + row * 1024 + v0) = wv; } }
    }
    __syncthreads();
}

constexpr int SB_TILE = 16384, SB_FLAG = 7 * SB_TILE;
typedef short v4i16_t __attribute__((ext_vector_type(4)));
__device__ __forceinline__ s16x4 vtr(const LAS unsigned char* p) { return __builtin_bit_cast(s16x4, __builtin_amdgcn_ds_read_tr16_b64_v4i16((LAS v4i16_t*)p)); }
__device__ __forceinline__ float partner32(float x, int hh) { auto rr = __builtin_amdgcn_permlane32_swap(__float_as_uint(x), __float_as_uint(x), false, false); return __uint_as_float(hh ? rr[0] : rr[1]); }
__device__ __forceinline__ int sbk_off(int key, int chunk) { return key * 128 + ((chunk ^ ((key >> 1) & 7)) << 4); }
__device__ __forceinline__ int sbv_off(int key, int chunk) { return 8192 + key * 128 + ((chunk ^ (((key >> 1) & 1) << 2)) << 4); }

template <bool DIAG>
__device__ __forceinline__ void sb_tile_t(const LAS unsigned char* tile, int kt, int qabs, int l, const bf16x8 (&qf)[4], f32x16& o0, f32x16& o1, float& carry) {
    const int lq = l & 31, hh = l >> 5, g1 = (l >> 4) & 1, i = l & 15;
    float run = carry;
#pragma unroll
    for (int half = 1; half >= 0; --half) {
        f32x16 p;
#pragma unroll
        for (int r = 0; r < 16; ++r) p[r] = 0.f;
#pragma unroll
        for (int s = 0; s < 4; ++s) { const bf16x8 a = *(const LAS bf16x8*)(tile + sbk_off(32 * half + lq, 2 * s + hh)); p = __builtin_amdgcn_mfma_f32_32x32x16_bf16(a, qf[s], p, 0, 0, 0); }
        float Lh[16];
#pragma unroll
        for (int r = 0; r < 16; ++r) { const float z = p[r];
            float L = fmaxf(z, 0.f) + __builtin_amdgcn_logf(1.0f + __builtin_amdgcn_exp2f(-fabsf(z)));
            if (DIAG) { const int key = 64 * kt + 32 * half + (r & 3) + 8 * (r >> 2) + 4 * hh; if (key >= qabs) L = 0.f; }
            Lh[r] = L; }
        float tot[4];
#pragma unroll
        for (int g4 = 0; g4 < 4; ++g4) { float* Lg = &Lh[4 * g4]; Lg[2] += Lg[3]; Lg[1] += Lg[2]; Lg[0] += Lg[1]; tot[g4] = Lg[0]; }
        float E[4];
#pragma unroll
        for (int m = 3; m >= 0; --m) { const float tp = partner32(tot[m], hh); E[m] = run + (hh ? 0.f : tp); run += tot[m] + tp; }
        u32x4 pw[2];
#pragma unroll
        for (int s = 0; s < 2; ++s) { float wv[8];
#pragma unroll
            for (int j = 0; j < 8; ++j) { const int r = 8 * s + j;
                float wgt = __builtin_amdgcn_exp2f(p[r] - (E[r >> 2] + Lh[r]));
                if (DIAG) { const int key = 64 * kt + 32 * half + (r & 3) + 8 * (r >> 2) + 4 * hh; if (key >= qabs) wgt = 0.f; }
                wv[j] = wgt; }
            pw[s] = (u32x4){cvtpk(wv[0], wv[1]), cvtpk(wv[2], wv[3]), cvtpk(wv[4], wv[5]), cvtpk(wv[6], wv[7])}; }
#pragma unroll
        for (int s = 0; s < 2; ++s) { const bf16x8 pb = __builtin_bit_cast(bf16x8, pw[s]);
            const int k0 = 32 * half + 16 * s + 4 * hh + (i >> 2), k1 = k0 + 8;
#pragma unroll
            for (int dt = 0; dt < 2; ++dt) { const int ch = 4 * dt + 2 * g1 + ((i & 3) >> 1);
                const s16x4 lo = vtr(tile + sbv_off(k0, ch) + 8 * (i & 1)), hi = vtr(tile + sbv_off(k1, ch) + 8 * (i & 1));
                const bf16x8 a = (bf16x8){lo[0], lo[1], lo[2], lo[3], hi[0], hi[1], hi[2], hi[3]};
                if (dt == 0) o0 = __builtin_amdgcn_mfma_f32_32x32x16_bf16(a, pb, o0, 0, 0, 0); else o1 = __builtin_amdgcn_mfma_f32_32x32x16_bf16(a, pb, o1, 0, 0, 0); } }
    }
    carry = run;
}
__device__ __forceinline__ void sb_tile(const LAS unsigned char* tile, int kt, int q0, int qabs, int l, const bf16x8 (&qf)[4], f32x16& o0, f32x16& o1, float& carry) {
    if (64 * kt + 63 >= q0) sb_tile_t<true>(tile, kt, qabs, l, qf, o0, o1, carry); else sb_tile_t<false>(tile, kt, qabs, l, qf, o0, o1, carry);
}
__device__ __forceinline__ void sb_attn_unit(Frame& F, int uidx) {
    const int bh = uidx >> 4, qb = uidx & 15, b = bh >> 4, h = bh & 15;
    LAS unsigned char* lds = F.lds + RING_OFF;
    volatile LAS unsigned* flags = (volatile LAS unsigned*)(lds + SB_FLAG);
    const int tid = F.tid, w = F.wave, l = F.lane, lq = l & 31, hh = l >> 5;
    bf16_t* SQ = WSP(bf16_t, WS_SQ); const bf16_t* SK = WSP(bf16_t, WS_SK); const bf16_t* SV = WSP(bf16_t, WS_SV);
    const size_t rowbase = (size_t)b * SEQ;
    const int q0 = qb * 256 + 32 * w, qabs = q0 + lq;
    const int kt_hi = qb * 4 + 3, kt_lo = (qb * 4 - 3) > 0 ? (qb * 4 - 3) : 0, nwin = kt_hi - kt_lo + 1;
    const int skey = tid >> 3, sch = tid & 7;
    const bf16_t* kgd = SK + (rowbase + skey) * 1024 + h * 64 + ((sch ^ ((skey >> 1) & 7)) * 8);
    const bf16_t* vgd = SV + (rowbase + skey) * 1024 + h * 64 + ((sch ^ (((skey >> 1) & 1) << 2)) * 8);
    __syncthreads();
#pragma unroll
    for (int j = 0; j < 7; ++j) if (j < nwin) {
        __builtin_amdgcn_global_load_lds((const unsigned*)(kgd + (size_t)(kt_lo + j) * 64 * 1024), (LAS unsigned*)(lds + j * SB_TILE + w * 1024), 16, 0, 0);
        __builtin_amdgcn_global_load_lds((const unsigned*)(vgd + (size_t)(kt_lo + j) * 64 * 1024), (LAS unsigned*)(lds + j * SB_TILE + 8192 + w * 1024), 16, 0, 0); }
    bf16x8 qf[4];
    { const bf16_t* qrow = SQ + (rowbase + qabs) * 1024 + h * 64;
#pragma unroll
      for (int s = 0; s < 4; ++s) qf[s] = *(const bf16x8*)(qrow + 16 * s + 8 * hh); }
    f32x16 o0, o1;
#pragma unroll
    for (int r = 0; r < 16; ++r) { o0[r] = 0.f; o1[r] = 0.f; }
    float carry = 0.f;
    VM_WAIT(); __syncthreads();
    bool done = false;
    for (int kt = (q0 + 30) >> 6; kt >= kt_lo; --kt) {
        sb_tile(lds + (kt - kt_lo) * SB_TILE, kt, q0, qabs, l, qf, o0, o1, carry);
        if (__all(carry > 150.0f)) { done = true; break; }
    }
    if (kt_lo == 0) done = true;
    if (l == 0) flags[w] = done ? 1u : 0u;
    __syncthreads();
    bool alld = true;
#pragma unroll
    for (int i = 0; i < 8; ++i) alld = alld && (flags[i] != 0u);
    if (!alld) {
        const bf16_t* kg = SK + (rowbase + skey) * 1024 + h * 64 + sch * 8;
        const bf16_t* vg = SV + (rowbase + skey) * 1024 + h * 64 + sch * 8;
        for (int kt = kt_lo - 1; kt >= 0; --kt) {
            const u32x4 kr = *(const u32x4*)(kg + (size_t)kt * 64 * 1024), vr = *(const u32x4*)(vg + (size_t)kt * 64 * 1024);
            __syncthreads();
            { unsigned a = 1u;
#pragma unroll
              for (int i = 0; i < 8; ++i) a &= flags[i];
              if (a) break; }
            *(LAS u32x4*)(lds + sbk_off(skey, sch)) = kr; *(LAS u32x4*)(lds + sbv_off(skey, sch)) = vr;
            __syncthreads();
            if (!done) { sb_tile(lds, kt, q0, qabs, l, qf, o0, o1, carry); if (__all(carry > 150.0f) || kt == 0) done = true; }
            if (l == 0) flags[w] = done ? 1u : 0u;
        }
    }
    if (!F.dry) { bf16_t* orow = SQ + (rowbase + qabs) * 1024 + h * 64;
#pragma unroll
      for (int g4 = 0; g4 < 4; ++g4) { u32x2 a, c2; a.x = cvtpk(o0[4 * g4], o0[4 * g4 + 1]); a.y = cvtpk(o0[4 * g4 + 2], o0[4 * g4 + 3]); c2.x = cvtpk(o1[4 * g4], o1[4 * g4 + 1]); c2.y = cvtpk(o1[4 * g4 + 2], o1[4 * g4 + 3]);
          *(u32x2*)(orow + 8 * g4 + 4 * hh) = a; *(u32x2*)(orow + 32 + 8 * g4 + 4 * hh) = c2; } }
}
__device__ __forceinline__ void sb_units_dyn(Frame& F, unsigned* ctr, int lo, int hi) {
    volatile LAS int* slot = (volatile LAS int*)(F.lds + MISC_OFF + 64);
    for (;;) {
        __syncthreads();
        if (F.tid == 0) *slot = lo + (int)__hip_atomic_fetch_add(ctr, 1u, __ATOMIC_RELAXED, __HIP_MEMORY_SCOPE_AGENT);
        __syncthreads();
        const int u = *slot;
        if (u >= hi) break;
        sb_attn_unit(F, u);
    }
}
__device__ __forceinline__ void phase_attn_a(Frame& F) {
    if (F.vcu < 128) gla_stage1(F, F.vcu);
    sb_units_dyn(F, (unsigned*)(F.ws + WS_CTL) + 64 + 16 * F.dry, 0, 384);
    __syncthreads();
}
__device__ __forceinline__ void phase_attn_b(Frame& F) {
    if (F.vcu < 128) gla_stage3(F, F.vcu);
    sb_units_dyn(F, (unsigned*)(F.ws + WS_CTL) + 128 + 16 * F.dry, 384, 1024);
    __syncthreads();
}
__device__ __forceinline__ int okey(float v, int tag, int mask) { int u = __float_as_int(v); u ^= (u >> 31) & 0x7fffffff; return (u & ~mask) | tag; }
__device__ __forceinline__ float okey_val(int key, int mask) { int u = key & ~mask; u ^= (u >> 31) & 0x7fffffff; return __int_as_float(u); }
#define INS16(Lst, xin) do { int _x = (xin); _Pragma("unroll") for (int _j = 0; _j < 16; ++_j) { const int _h = max(Lst[_j], _x); _x = min(Lst[_j], _x); Lst[_j] = _h; } } while (0)

#define CEX(a, b) do { const int _hi = max(a, b), _lo = min(a, b); a = _hi; b = _lo; } while (0)
#define BITONIC16(K) do { \
    _Pragma("unroll") for (int _i = 0; _i < 8; ++_i) CEX(K[_i], K[_i + 8]); \
    _Pragma("unroll") for (int _b = 0; _b < 16; _b += 8) _Pragma("unroll") for (int _i = 0; _i < 4; ++_i) CEX(K[_b + _i], K[_b + _i + 4]); \
    _Pragma("unroll") for (int _b = 0; _b < 16; _b += 4) _Pragma("unroll") for (int _i = 0; _i < 2; ++_i) CEX(K[_b + _i], K[_b + _i + 2]); \
    _Pragma("unroll") for (int _b = 0; _b < 16; _b += 2) CEX(K[_b], K[_b + 1]); } while (0)
#define CEXD(a, b, d) do { const int _hi = max(a, b), _lo = min(a, b); a = (d) ? _hi : _lo; b = (d) ? _lo : _hi; } while (0)
#define FULLSORT16(K) do { \
    _Pragma("unroll") for (int _k = 2; _k <= 16; _k <<= 1) _Pragma("unroll") for (int _j = _k >> 1; _j >= 1; _j >>= 1) _Pragma("unroll") for (int _i = 0; _i < 16; ++_i) { \
        const int _p = _i ^ _j; if (_p > _i) { const bool _desc = ((_i & _k) == 0); CEXD(K[_i], K[_p], _desc); } } } while (0)
__device__ __forceinline__ int swap32i(int x) { auto r = __builtin_amdgcn_permlane32_swap((unsigned)x, (unsigned)x, false, false); return (int)((__builtin_amdgcn_mbcnt_hi(~0u, __builtin_amdgcn_mbcnt_lo(~0u, 0u)) & 32) ? r[0] : r[1]); }

__device__ __forceinline__ void phase_peer_retrieve(Frame& F) {
    const bf16_t* Q = WSP(bf16_t, WS_Q); const bf16_t* KB = WSP(bf16_t, WS_KD); unsigned* EXPO = WSP(unsigned, WS_EXP);
    LAS unsigned char* idxb = F.lds + RING_OFF + F.wave * 2048;
    const int l = F.lane, lq = l & 31, hh = l >> 5;
    const int ntok_wg = T_TOK / F.G;
#pragma unroll 1
    for (int it = F.wave; it < (ntok_wg / 32) * 8; it += NWAVES) {
        const int tg = it >> 3, h = it & 7;
        const int t = F.vcu * ntok_wg + tg * 32 + lq;
        int XY[2][16];
#pragma unroll
        for (int half = 0; half < 2; ++half) {
            bf16x8 qf[8];
            { const bf16_t* qp = Q + (size_t)t * 2048 + h * 256 + half * 128 + 8 * hh;
#pragma unroll
              for (int s = 0; s < 8; ++s) qf[s] = *(const bf16x8*)(qp + 16 * s); }
            int L[16];
#pragma unroll
            for (int j = 0; j < 16; ++j) L[j] = INT_MIN;
            const bf16_t* kp = KB + (size_t)(h * 2 + half) * 16384 + (size_t)lq * 128 + 8 * hh;
#pragma unroll 1
            for (int tile = 0; tile < 4; ++tile) {
                f32x16 acc; int Tk[16];
#pragma unroll
                for (int r = 0; r < 16; ++r) acc[r] = 0.f;
#pragma unroll
                for (int s = 0; s < 8; ++s) { const bf16x8 a = *(const bf16x8*)(kp + (size_t)tile * 32 * 128 + 16 * s); acc = __builtin_amdgcn_mfma_f32_32x32x16_bf16(a, qf[s], acc, 0, 0, 0); }
#pragma unroll
                for (int r = 0; r < 16; ++r) { const int key = 32 * tile + (r & 3) + 8 * (r >> 2) + 4 * hh; Tk[r] = okey(acc[r], 127 - key, 127); }
                FULLSORT16(Tk);
#pragma unroll
                for (int k = 0; k < 16; ++k) L[k] = max(L[k], Tk[15 - k]);
                BITONIC16(L);
            }
#pragma unroll
            for (int k = 0; k < 8; ++k) { const int a = swap32i(L[15 - k]), b = swap32i(L[k]); L[k] = max(L[k], a); L[15 - k] = max(L[15 - k], b); }
            BITONIC16(L);
#pragma unroll
            for (int j = 0; j < 16; ++j) XY[half][j] = L[j];
        }
        { u32x4 pk[2];
#pragma unroll
          for (int half = 0; half < 2; ++half) { const int* L = XY[half];
            pk[half].x = (unsigned)(127 - (L[0] & 127)) | ((unsigned)(127 - (L[1] & 127)) << 8) | ((unsigned)(127 - (L[2] & 127)) << 16) | ((unsigned)(127 - (L[3] & 127)) << 24);
            pk[half].y = (unsigned)(127 - (L[4] & 127)) | ((unsigned)(127 - (L[5] & 127)) << 8) | ((unsigned)(127 - (L[6] & 127)) << 16) | ((unsigned)(127 - (L[7] & 127)) << 24);
            pk[half].z = (unsigned)(127 - (L[8] & 127)) | ((unsigned)(127 - (L[9] & 127)) << 8) | ((unsigned)(127 - (L[10] & 127)) << 16) | ((unsigned)(127 - (L[11] & 127)) << 24);
            pk[half].w = (unsigned)(127 - (L[12] & 127)) | ((unsigned)(127 - (L[13] & 127)) << 8) | ((unsigned)(127 - (L[14] & 127)) << 16) | ((unsigned)(127 - (L[15] & 127)) << 24); }
          *(LAS u32x4*)(idxb + l * 32) = pk[0]; *(LAS u32x4*)(idxb + l * 32 + 16) = pk[1]; }
        float X[16], Y[16];
#pragma unroll
        for (int j = 0; j < 16; ++j) { X[j] = okey_val(XY[0][j], 127); Y[j] = okey_val(XY[1][j], 127); }
        int M[16];
#pragma unroll
        for (int j = 0; j < 16; ++j) M[j] = INT_MIN;
#define CAND(i, j) do { const float sm = hh ? (X[j] + Y[i]) : (X[i] + Y[j]); const int pos = hh ? ((j) * 16 + (i)) : ((i) * 16 + (j)); int key = okey(sm, 255 - pos, 255); if ((i) == (j) && hh) key = INT_MIN; INS16(M, key); } while (0)
        CAND(0, 0); CAND(0, 1); CAND(0, 2); CAND(0, 3); CAND(0, 4); CAND(0, 5); CAND(0, 6); CAND(0, 7); CAND(0, 8); CAND(0, 9); CAND(0, 10); CAND(0, 11); CAND(0, 12); CAND(0, 13); CAND(0, 14); CAND(0, 15);
        CAND(1, 1); CAND(1, 2); CAND(1, 3); CAND(1, 4); CAND(1, 5); CAND(1, 6); CAND(1, 7);
        CAND(2, 2); CAND(2, 3); CAND(2, 4);
        CAND(3, 3);
#undef CAND
        int TK[16];
#pragma unroll
        for (int k = 0; k < 16; ++k) TK[k] = max(M[k], swap32i(M[15 - k]));
        float sv[16]; float mx = -INFINITY;
#pragma unroll
        for (int k = 0; k < 16; ++k) { sv[k] = okey_val(TK[k], 255); mx = fmaxf(mx, sv[k]); }
        float den = 0.f;
#pragma unroll
        for (int k = 0; k < 16; ++k) { sv[k] = __expf(sv[k] - mx); den += sv[k]; }
        const float rden = 1.0f / den;
        LDS_WAIT(); asm volatile("" ::: "memory");
        const LAS unsigned char* ib = idxb + l * 32;
        unsigned* dst = EXPO + (size_t)t * 128 + h * 16 + hh * 8;
        u32x4 o0, o1; unsigned ov[8];
#pragma unroll
        for (int k = 0; k < 8; ++k) { const int pos = 255 - (TK[k] & 255); const unsigned i1 = ib[pos >> 4], i2 = ib[16 + (pos & 15)];
            ov[k] = (__float_as_uint(sv[k] * rden) & ~0x3fffu) | (i1 * 128u + i2); }
        o0 = (u32x4){ov[0], ov[1], ov[2], ov[3]}; o1 = (u32x4){ov[4], ov[5], ov[6], ov[7]};
        *(u32x4*)dst = o0; *(u32x4*)(dst + 4) = o1;
        LDS_WAIT(); asm volatile("" ::: "memory");
    }
}

__device__ __forceinline__ void cvt_rows_fp8(Frame& F, const float* src, unsigned char* dst, float* rscale) {
    const int l = F.lane; const int gw = F.vcu * NWAVES + F.wave, NGW = F.G * NWAVES;
    for (int e = gw; e < 16384; e += NGW) {
        const f32x4* sp = (const f32x4*)(src + (size_t)e * 1024 + 16 * l);
        const f32x4 a = sp[0], b = sp[1], c = sp[2], d = sp[3];
        float m = fmaxf(fmaxf(fmaxf(fabsf(a[0]), fabsf(a[1])), fmaxf(fabsf(a[2]), fabsf(a[3]))), fmaxf(fmaxf(fabsf(b[0]), fabsf(b[1])), fmaxf(fabsf(b[2]), fabsf(b[3]))));
        m = fmaxf(m, fmaxf(fmaxf(fmaxf(fabsf(c[0]), fabsf(c[1])), fmaxf(fabsf(c[2]), fabsf(c[3]))), fmaxf(fmaxf(fabsf(d[0]), fabsf(d[1])), fmaxf(fabsf(d[2]), fabsf(d[3])))));
#pragma unroll
        for (int o = 1; o < 64; o <<= 1) m = fmaxf(m, __shfl_xor(m, o));
        const float t = 448.0f / fmaxf(m, 1e-30f); const float s = __uint_as_float(__float_as_uint(t) & 0x7f800000u);
        u32x4 w; int x;
        x = __builtin_amdgcn_cvt_pk_fp8_f32(a[0] * s, a[1] * s, 0, false); x = __builtin_amdgcn_cvt_pk_fp8_f32(a[2] * s, a[3] * s, x, true); w.x = (unsigned)x;
        x = __builtin_amdgcn_cvt_pk_fp8_f32(b[0] * s, b[1] * s, 0, false); x = __builtin_amdgcn_cvt_pk_fp8_f32(b[2] * s, b[3] * s, x, true); w.y = (unsigned)x;
        x = __builtin_amdgcn_cvt_pk_fp8_f32(c[0] * s, c[1] * s, 0, false); x = __builtin_amdgcn_cvt_pk_fp8_f32(c[2] * s, c[3] * s, x, true); w.z = (unsigned)x;
        x = __builtin_amdgcn_cvt_pk_fp8_f32(d[0] * s, d[1] * s, 0, false); x = __builtin_amdgcn_cvt_pk_fp8_f32(d[2] * s, d[3] * s, x, true); w.w = (unsigned)x;
        *(u32x4*)(dst + (size_t)e * 1024 + 16 * l) = w;
        if (l == 0) rscale[e] = 1.0f / s;
    }
}

__device__ __forceinline__ float gelu_tanh(float x) { const float y = 0.7978845608028654f * (x + 0.044715f * x * x * x); return x * __builtin_amdgcn_rcpf(1.0f + __expf(-2.0f * y)); }
#define FP8_UNPACK16(W, f) do { f32x2 _t; \
    _t = __builtin_amdgcn_cvt_pk_f32_fp8((int)(W).x, false); f[0] = _t[0]; f[1] = _t[1]; _t = __builtin_amdgcn_cvt_pk_f32_fp8((int)(W).x, true); f[2] = _t[0]; f[3] = _t[1]; \
    _t = __builtin_amdgcn_cvt_pk_f32_fp8((int)(W).y, false); f[4] = _t[0]; f[5] = _t[1]; _t = __builtin_amdgcn_cvt_pk_f32_fp8((int)(W).y, true); f[6] = _t[0]; f[7] = _t[1]; \
    _t = __builtin_amdgcn_cvt_pk_f32_fp8((int)(W).z, false); f[8] = _t[0]; f[9] = _t[1]; _t = __builtin_amdgcn_cvt_pk_f32_fp8((int)(W).z, true); f[10] = _t[0]; f[11] = _t[1]; \
    _t = __builtin_amdgcn_cvt_pk_f32_fp8((int)(W).w, false); f[12] = _t[0]; f[13] = _t[1]; _t = __builtin_amdgcn_cvt_pk_f32_fp8((int)(W).w, true); f[14] = _t[0]; f[15] = _t[1]; } while (0)
__device__ __forceinline__ float sum_swap32(float a, float b) { auto r = __builtin_amdgcn_permlane32_swap(__float_as_uint(a), __float_as_uint(b), false, false); return __uint_as_float(r[0]) + __uint_as_float(r[1]); }
__device__ __forceinline__ float sum_swap16(float a, float b) { auto r = __builtin_amdgcn_permlane16_swap(__float_as_uint(a), __float_as_uint(b), false, false); return __uint_as_float(r[0]) + __uint_as_float(r[1]); }
template <int M> __device__ __forceinline__ unsigned sxu(unsigned v, int lane) {
    if constexpr (M == 32) { auto r = __builtin_amdgcn_permlane32_swap(v, v, false, false); return (lane & 32) ? r[0] : r[1]; }
    else return (unsigned)__builtin_amdgcn_ds_swizzle((int)v, (M << 10) | 0x1f);
}
template <int M> __device__ __forceinline__ float sxf(float v, int lane) { return __uint_as_float(sxu<M>(__float_as_uint(v), lane)); }
__device__ __forceinline__ float wave_sum_sx(float v, int lane) { v += sxf<1>(v, lane); v += sxf<2>(v, lane); v += sxf<4>(v, lane); v += sxf<8>(v, lane); v += sxf<16>(v, lane); v += sxf<32>(v, lane); return v; }
#ifndef PG_TOK
#define PG_TOK 4
#endif
template <class Bar>
__device__ __forceinline__ void phase_peer_gather(Frame& F, const Bar& bar, bool use_bar) {
    const unsigned char* UB = WSP(unsigned char, WS_UB8); const unsigned char* VB = WSP(unsigned char, WS_VB8); const float* RSU = WSP(float, WS_RSU); const float* RSV = WSP(float, WS_RSV);
    const unsigned* EXPO = WSP(unsigned, WS_EXP);
    const bf16_t* H1G = WSP(bf16_t, WS_H1G); bf16_t* XN3 = WSP(bf16_t, WS_XN3); const bf16_t* H1B = WSP(bf16_t, WS_H1); bf16_t* H2B = WSP(bf16_t, WS_H2B); const float* SSQ1 = WSP(float, WS_SSQ1); const float* g_ple = F.in[16];
    const int l = F.lane; const int ntok_wg = T_TOK / F.G;
#pragma unroll 1
    for (int ti = F.wave * PG_TOK; ti < ntok_wg; ti += NWAVES * PG_TOK) {
        if (use_bar && ti >= NWAVES * PG_TOK) xcd_barrier(bar, F.tid); else __syncthreads();
        float acc[PG_TOK][16];
        LAS unsigned* lent = (LAS unsigned*)(F.lds + RING_OFF + F.wave * (2048 * PG_TOK)); LAS float* lcu = (LAS float*)(lent + 128 * PG_TOK); LAS float* lcv = lcu + 128 * PG_TOK; LAS float* acl = lcv + 128 * PG_TOK;
        LAS unsigned* lx = (LAS unsigned*)(F.lds + RING_OFF + NWAVES * 2048 * PG_TOK + F.wave * (2048 * PG_TOK));
#pragma unroll
        for (int tk = 0; tk < PG_TOK; ++tk) { const int t = F.vcu * ntok_wg + ti + tk;
            const u32x4 xa = *(const u32x4*)(H1G + (size_t)t * 1024 + 16 * l), xb = *(const u32x4*)(H1G + (size_t)t * 1024 + 16 * l + 8);
            *(LAS u32x4*)(lx + tk * 512 + l * 8) = xa; *(LAS u32x4*)(lx + tk * 512 + l * 8 + 4) = xb;
#pragma unroll
            for (int i = 0; i < 16; ++i) acc[tk][i] = 0.f; }
#pragma unroll 1
        for (int tk = 0; tk < PG_TOK; ++tk) { const int t = F.vcu * ntok_wg + ti + tk;
            const f32x4* sp = (const f32x4*)(SSQ1 + (size_t)t * 16); const f32x4 st = (sp[0] + sp[1]) + (sp[2] + sp[3]); const float rstd1 = __builtin_amdgcn_rsqf(((st[0] + st[1]) + (st[2] + st[3])) * (1.0f / 1024.0f) + EPS);
            unsigned a0 = EXPO[(size_t)t * 128 + l], a1 = EXPO[(size_t)t * 128 + 64 + l];
            { unsigned s0 = (a0 << 18) | (a0 >> 14), s1 = (a1 << 18) | (a1 >> 14);
              int ls = l; asm volatile("" : "+v"(ls));
#define BSTEP(K, J) do { const bool up = (ls & (J)) != 0; const unsigned p0 = sxu<J>(s0, ls), p1 = sxu<J>(s1, ls); \
                  const bool asc0 = (ls & (K)) == 0, asc1 = ((ls + 64) & (K)) == 0; \
                  s0 = (up == asc0) ? max(s0, p0) : min(s0, p0); s1 = (up == asc1) ? max(s1, p1) : min(s1, p1); } while (0)
              BSTEP(2, 1);
              BSTEP(4, 2); BSTEP(4, 1);
              BSTEP(8, 4); BSTEP(8, 2); BSTEP(8, 1);
              BSTEP(16, 8); BSTEP(16, 4); BSTEP(16, 2); BSTEP(16, 1);
              BSTEP(32, 16); BSTEP(32, 8); BSTEP(32, 4); BSTEP(32, 2); BSTEP(32, 1);
              BSTEP(64, 32); BSTEP(64, 16); BSTEP(64, 8); BSTEP(64, 4); BSTEP(64, 2); BSTEP(64, 1);
              { const unsigned lo = min(s0, s1), hi = max(s0, s1); s0 = lo; s1 = hi; }
              BSTEP(128, 32); BSTEP(128, 16); BSTEP(128, 8); BSTEP(128, 4); BSTEP(128, 2); BSTEP(128, 1);
#undef BSTEP
              a0 = (s0 >> 18) | (s0 << 14); a1 = (s1 >> 18) | (s1 << 14); }
            lent[tk * 128 + l] = a0; lent[tk * 128 + 64 + l] = a1;
            lcu[tk * 128 + l] = RSU[a0 & 0x3fffu] * rstd1; lcu[tk * 128 + 64 + l] = RSU[a1 & 0x3fffu] * rstd1;
            lcv[tk * 128 + l] = RSV[a0 & 0x3fffu] * __uint_as_float(a0 & ~0x3fffu); lcv[tk * 128 + 64 + l] = RSV[a1 & 0x3fffu] * __uint_as_float(a1 & ~0x3fffu); }
        LDS_WAIT(); asm volatile("" ::: "memory");
        u32x4 buf0[8], buf1[8];
#define ROWS8(BUF, TAB, tk, eb) do { const u32x4 ea_ = *(const LAS u32x4*)(lent + (tk) * 128 + (eb)), eb_ = *(const LAS u32x4*)(lent + (tk) * 128 + (eb) + 4); \
            const unsigned en_[8] = {ea_.x, ea_.y, ea_.z, ea_.w, eb_.x, eb_.y, eb_.z, eb_.w}; \
            _Pragma("unroll") for (int k = 0; k < 8; ++k) BUF[k] = *(const u32x4*)((TAB) + ((en_[k] & 0x3fffu) * 1024u + 16u * (unsigned)l)); } while (0)
#define U8(BUF, tk, eb) do { float p[8]; const u32x4 xa_ = *(const LAS u32x4*)(lx + (tk) * 512 + l * 8), xb_ = *(const LAS u32x4*)(lx + (tk) * 512 + l * 8 + 4); \
            const unsigned xq[8] = {xa_.x, xa_.y, xa_.z, xa_.w, xb_.x, xb_.y, xb_.z, xb_.w}; \
            _Pragma("unroll") for (int k = 0; k < 8; ++k) { float f[16]; FP8_UNPACK16(BUF[k], f); float s = 0.f; \
                _Pragma("unroll") for (int i = 0; i < 8; ++i) s = __builtin_amdgcn_fdot2_f32_bf16(__builtin_bit_cast(bf16x2_t, cvtpk(f[2 * i], f[2 * i + 1])), __builtin_bit_cast(bf16x2_t, xq[i]), s, false); \
                p[k] = s; if (k & 1) __builtin_amdgcn_sched_barrier(0); } \
            float q4[4], q2[2], q1; \
            _Pragma("unroll") for (int j = 0; j < 4; ++j) q4[j] = sum_swap32(p[j], p[4 + j]); \
            _Pragma("unroll") for (int j = 0; j < 2; ++j) q2[j] = sum_swap16(q4[j], q4[2 + j]); \
            { const bool up = (l & 8) != 0; const float keep = up ? q2[1] : q2[0], send = up ? q2[0] : q2[1]; q1 = keep + sxf<8>(send, l); } \
            q1 += sxf<4>(q1, l); q1 += sxf<2>(q1, l); q1 += sxf<1>(q1, l); \
            const float cu = lcu[(tk) * 128 + (eb) + (l >> 3)], cv = lcv[(tk) * 128 + (eb) + (l >> 3)]; \
            const float a_ = gelu_tanh(q1 * cu) * cv; if ((l & 7) == 0) acl[(tk) * 128 + (eb) + (l >> 3)] = a_; __builtin_amdgcn_sched_barrier(0); } while (0)
#define V8(BUF, tk, eb) do { const float av = acl[(tk) * 128 + (eb) + (l & 7)]; \
            _Pragma("unroll") for (int k = 0; k < 8; ++k) { const float ak = __uint_as_float(__builtin_amdgcn_readlane(__float_as_uint(av), k)); float f[16]; FP8_UNPACK16(BUF[k], f); \
                _Pragma("unroll") for (int i = 0; i < 16; ++i) acc[tk][i] += ak * f[i]; if (k & 1) __builtin_amdgcn_sched_barrier(0); } } while (0)
        ROWS8(buf0, UB, 0, 0);
#if PG_TOK == 4
#define TURNS4(CONS, TAB, eb, NEXT) do { ROWS8(buf1, TAB, 1, eb); CONS(buf0, 0, eb); ROWS8(buf0, TAB, 2, eb); CONS(buf1, 1, eb); ROWS8(buf1, TAB, 3, eb); CONS(buf0, 2, eb); NEXT; CONS(buf1, 3, eb); } while (0)
#pragma unroll 1
        for (int eb = 0; eb < 120; eb += 8) TURNS4(U8, UB, eb, ROWS8(buf0, UB, 0, eb + 8));
        TURNS4(U8, UB, 120, ROWS8(buf0, VB, 0, 0));
        LDS_WAIT(); asm volatile("" ::: "memory");
#pragma unroll 1
        for (int eb = 0; eb < 120; eb += 8) TURNS4(V8, VB, eb, ROWS8(buf0, VB, 0, eb + 8));
        TURNS4(V8, VB, 120, (void)0);
#undef TURNS4
#elif PG_TOK == 2
#define TURNS2(CONS, TAB, eb, NEXT) do { ROWS8(buf1, TAB, 1, eb); CONS(buf0, 0, eb); NEXT; CONS(buf1, 1, eb); } while (0)
#pragma unroll 1
        for (int eb = 0; eb < 120; eb += 8) TURNS2(U8, UB, eb, ROWS8(buf0, UB, 0, eb + 8));
        TURNS2(U8, UB, 120, ROWS8(buf0, VB, 0, 0));
        LDS_WAIT(); asm volatile("" ::: "memory");
#pragma unroll 1
        for (int eb = 0; eb < 120; eb += 8) TURNS2(V8, VB, eb, ROWS8(buf0, VB, 0, eb + 8));
        TURNS2(V8, VB, 120, (void)0);
#undef TURNS2
#else
#error PG_TOK must be 2 or 4
#endif
#undef ROWS8
#undef U8
#undef V8
#pragma unroll
        for (int tk = 0; tk < PG_TOK; ++tk) { const int t = F.vcu * ntok_wg + ti + tk;
            float ss = 0.f; f32x4 h[4];
#pragma unroll
            for (int q2 = 0; q2 < 2; ++q2) { const u32x4 ha = *(const u32x4*)(H1B + (size_t)t * 1024 + 16 * l + 8 * q2);
                h[2 * q2] = (f32x4){bf_lo(ha.x), bf_hi(ha.x), bf_lo(ha.y), bf_hi(ha.y)}; h[2 * q2 + 1] = (f32x4){bf_lo(ha.z), bf_hi(ha.z), bf_lo(ha.w), bf_hi(ha.w)};
#pragma unroll
                for (int j = 0; j < 4; ++j) { h[2 * q2][j] += acc[tk][8 * q2 + j]; h[2 * q2 + 1][j] += acc[tk][8 * q2 + 4 + j]; ss += h[2 * q2][j] * h[2 * q2][j] + h[2 * q2 + 1][j] * h[2 * q2 + 1][j]; }
                u32x4 w0; w0.x = cvtpk(h[2 * q2][0], h[2 * q2][1]); w0.y = cvtpk(h[2 * q2][2], h[2 * q2][3]); w0.z = cvtpk(h[2 * q2 + 1][0], h[2 * q2 + 1][1]); w0.w = cvtpk(h[2 * q2 + 1][2], h[2 * q2 + 1][3]);
                if (!F.dry) *(u32x4*)(H2B + (size_t)t * 1024 + 16 * l + 8 * q2) = w0; }
            const float rstd3 = __builtin_amdgcn_rsqf(wave_sum_sx(ss, l) * (1.0f / 1024.0f) + EPS);
            u32x4 o[2];
#pragma unroll
            for (int q2 = 0; q2 < 2; ++q2) { const f32x4 g0 = *(const f32x4*)(g_ple + 16 * l + 8 * q2), g1 = *(const f32x4*)(g_ple + 16 * l + 8 * q2 + 4);
                const f32x4 a = h[2 * q2] * rstd3 * g0, c = h[2 * q2 + 1] * rstd3 * g1;
                o[q2].x = cvtpk(a[0], a[1]); o[q2].y = cvtpk(a[2], a[3]); o[q2].z = cvtpk(c[0], c[1]); o[q2].w = cvtpk(c[2], c[3]); }
            if (!F.dry) { *(u32x4*)(XN3 + (size_t)t * 1024 + 16 * l) = o[0]; *(u32x4*)(XN3 + (size_t)t * 1024 + 16 * l + 8) = o[1]; } __builtin_amdgcn_sched_barrier(0); }
    }
}

__device__ __forceinline__ void phase_final(Frame& F) {
    const float* SSQ3 = WSP(float, WS_SSQ3); const float* g = F.in[19]; const bf16_t* H3B = WSP(bf16_t, WS_H3B);
    const int l = F.lane; const int gw = F.vcu * NWAVES + F.wave, NGW = F.G * NWAVES;
    for (int t = gw; t < T_TOK; t += NGW) {
        const f32x4* sp = (const f32x4*)(SSQ3 + (size_t)t * 16); const f32x4 st = (sp[0] + sp[1]) + (sp[2] + sp[3]);
        const float rstd = __builtin_amdgcn_rsqf(((st[0] + st[1]) + (st[2] + st[3])) * (1.0f / 1024.0f) + EPS);
        f32x4* row = (f32x4*)(F.out + (size_t)t * 1024);
#pragma unroll
        for (int j = 0; j < 4; ++j) { const u32x2 hv = *((const u32x2*)(H3B + (size_t)t * 1024) + l + 64 * j); const f32x4 gv = *((const f32x4*)g + l + 64 * j);
            const f32x4 h = (f32x4){bf_lo(hv.x), bf_hi(hv.x), bf_lo(hv.y), bf_hi(hv.y)}; row[l + 64 * j] = h * rstd * gv; }
    }
}
#ifndef MK_FUSED
#define MK_FUSED 1
#endif
constexpr int NPHASE = 11;
struct Args { const float* in[20]; float* out; unsigned char* ws; int ph_lo, ph_hi, dry, pad; };
static_assert(sizeof(Args) == 20 * 8 + 8 + 8 + 4 * 4, "Args has no padding");

__global__ void __launch_bounds__(NWAVES * 64, 2) mk_fwd(Args args) {
    extern __shared__ __attribute__((aligned(16))) unsigned char lds_raw[];
    Frame F;
    F.lds = (LAS unsigned char*)lds_raw;
    F.wave = __builtin_amdgcn_readfirstlane(threadIdx.x >> 6); F.lane = lane_id(); F.tid = F.wave * 64 + F.lane;
    F.G = gridDim.x; { const int bx = blockIdx.x; F.vcu = (F.G % 8 == 0) ? (bx % 8) * (F.G / 8) + bx / 8 : bx; }
    F.in = args.in; F.out = args.out; F.ws = args.ws; F.dry = args.dry;
    volatile LAS unsigned* MISC = (volatile LAS unsigned*)(F.lds + MISC_OFF);
    if (F.tid < 64) MISC[F.tid] = 0u;
    __syncthreads();
    const int lo = args.ph_lo, hi = args.ph_hi;
    XcdBarrier bar; bar.bar = (unsigned*)(F.ws + WS_CTL) + CW_BAR; bar.x = 0; bar.st = nullptr;
    if (hi - lo > 1) bar = xcd_barrier_post((unsigned*)(F.ws + WS_CTL) + CW_BAR, MISC + 8, F.tid);
#ifndef PH_MASK
#define PH_MASK 0xFFFFFFFFu
#endif
#define IN(k) (((PH_MASK >> (k)) & 1u) && lo <= (k) && (k) < hi)
#define LAUNDER(p, T) do { unsigned _lo = (unsigned)(unsigned long long)(p), _hi = (unsigned)((unsigned long long)(p) >> 32); asm volatile("" : "+v"(_lo), "+v"(_hi)); \
        _lo = __builtin_amdgcn_readfirstlane(_lo); _hi = __builtin_amdgcn_readfirstlane(_hi); (p) = (T)(((unsigned long long)_hi << 32) | _lo); } while (0)
#define SEAM(k) do { if (IN(k) && IN((k) + 1)) xcd_barrier(bar, F.tid); LAUNDER(F.ws, unsigned char*); LAUNDER(F.out, float*); F.lane = lane_id(); F.tid = F.wave * 64 + F.lane; } while (0)
    const int bx = (int)blockIdx.x;
    LAS unsigned char* ring = F.lds + RING_OFF;

    if (IN(0)) { phase_prologue(F); } SEAM(0);
    if (IN(1)) {
        pg8::Gemm g{WSP(bf16_t, WS_XN1), WSP(bf16_t, WS_WIN), T_TOK, 8192, 1024, 1024, 0, 2, 8}; pg8::StaticOrder S; S.init(T_TOK, 8192, F.G, bx);
        pg8::EpiProj E{WSP(bf16_t, WS_GQ), WSP(bf16_t, WS_GK), WSP(bf16_t, WS_GV), WSP(bf16_t, WS_GR), WSP(bf16_t, WS_SQ), WSP(bf16_t, WS_SK), WSP(bf16_t, WS_SV),
                       (bf16_t*)F.out, (bf16_t*)F.out + (size_t)T_TOK * 1024};
        pg8::gemm_phase<pg8::EpiProj>(ring, g, S, E, F.tid);
    } SEAM(1);
    if (IN(2)) { phase_gla_prep(F); } SEAM(2);
    if (IN(3)) { phase_attn_a(F); } SEAM(3);
    if (IN(4)) { phase_attn_b(F); } SEAM(4);
    if (IN(5)) {
        cvt_rows_fp8(F, F.in[14], WSP(unsigned char, WS_UB8), WSP(float, WS_RSU));
        cvt_rows_fp8(F, F.in[15], WSP(unsigned char, WS_VB8), WSP(float, WS_RSV));
        VM_WAIT(); __syncthreads();
        pg8::StaticOrder S; S.init(T_TOK, 1024, F.G, bx);
        { pg8::Gemm g{WSP(bf16_t, WS_GLAN), WSP(bf16_t, WS_WGA), T_TOK, 1024, 1024, 1024, 0, 0, 0}; pg8::EpiMix<true> E{(const bf16_t*)F.out, WSP(bf16_t, WS_MIX)};
          pg8::gemm_phase<pg8::EpiMix<true>>(ring, g, S, E, F.tid); }
        { pg8::Gemm g{WSP(bf16_t, WS_SQ), WSP(bf16_t, WS_WSB), T_TOK, 1024, 1024, 1024, 0, 0, 0}; pg8::EpiMix<false> E{(const bf16_t*)F.out + (size_t)T_TOK * 1024, WSP(bf16_t, WS_MIX)};
          pg8::gemm_phase<pg8::EpiMix<false>>(ring, g, S, E, F.tid); }
    } SEAM(5);
    if (IN(6)) {
        pg8::Gemm g{WSP(bf16_t, WS_MIX), WSP(bf16_t, WS_WO), T_TOK, 1024, 1024, 1024, 0, 0, 0}; pg8::StaticOrder S; S.init(T_TOK, 1024, F.G, bx);
        pg8::EpiH1 E{F.in[0], F.in[10], WSP(bf16_t, WS_H1), WSP(bf16_t, WS_H1G), WSP(float, WS_SSQ1)};
        pg8::gemm_phase<pg8::EpiH1>(ring, g, S, E, F.tid);
    } SEAM(6);
    if (IN(7)) {
        pg8::Gemm g{WSP(bf16_t, WS_H1G), WSP(bf16_t, WS_WPQ), T_TOK, 2048, 1024, 1024, 0, 0, 0}; pg8::StaticOrder S; S.init(T_TOK, 2048, F.G, bx);
        pg8::EpiQ E{WSP(float, WS_SSQ1), WSP(bf16_t, WS_Q), 2048};
        pg8::gemm_phase<pg8::EpiQ>(ring, g, S, E, F.tid);
    } SEAM(7);
    if (IN(8)) {
        cvt_copy(F, F.in[1], WSP(bf16_t, WS_PB), (size_t)T_TOK * 256);
        phase_peer_retrieve(F);
        VM_WAIT(); __syncthreads();
        phase_peer_gather(F, bar, false);
    } SEAM(8);
    if (IN(9)) {
        pg8::StaticOrder S; S.init(T_TOK, 1024, F.G, bx);
        { pg8::Gemm g{WSP(bf16_t, WS_PB), WSP(bf16_t, WS_WPLE), T_TOK, 1024, 256, 256, 0, 0, 0}; pg8::EpiBf E{WSP(bf16_t, WS_PLE), 1024};
          pg8::gemm_phase<pg8::EpiBf>(ring, g, S, E, F.tid); }
        { pg8::Gemm g{WSP(bf16_t, WS_XN3), WSP(bf16_t, WS_WPG), T_TOK, 1024, 1024, 1024, 0, 0, 0}; pg8::EpiH3 E{WSP(bf16_t, WS_H2B), WSP(bf16_t, WS_PLE), WSP(bf16_t, WS_H3B), WSP(float, WS_SSQ3), F.dry};
          pg8::gemm_phase<pg8::EpiH3>(ring, g, S, E, F.tid); }
    } SEAM(9);
    if (IN(10)) { phase_final(F); }
#undef IN
#undef SEAM
}

extern "C" void kernel_launch(void* const* d_in, const int* in_sizes, int n_in, void* d_out, int out_size, void* d_ws, size_t ws_size, hipStream_t stream) {
    static int grid = 0;
    if (grid == 0) {
        if (n_in != 20 || in_sizes[0] != T_TOK * 1024 || out_size != T_TOK * 1024 || ws_size < WS_END) {
            fprintf(stderr, "kernel_launch: unexpected shapes (n_in %d, in0 %d, out %d, ws %zu < %zu?); nothing launched\n", n_in, n_in > 0 ? in_sizes[0] : -1, out_size, ws_size, (size_t)WS_END); grid = -1; return; }
        int dev = 0, cus = 0, per_cu = 0;
        if (hipGetDevice(&dev) != hipSuccess || hipDeviceGetAttribute(&cus, hipDeviceAttributeMultiprocessorCount, dev) != hipSuccess) { grid = -1; return; }
        if (hipFuncSetAttribute((const void*)mk_fwd, hipFuncAttributeMaxDynamicSharedMemorySize, LDS_BYTES) != hipSuccess) { fprintf(stderr, "kernel_launch: hipFuncSetAttribute failed\n"); grid = -1; return; }
        if (hipOccupancyMaxActiveBlocksPerMultiprocessor(&per_cu, (const void*)mk_fwd, NWAVES * 64, LDS_BYTES) != hipSuccess || per_cu < 1)
            fprintf(stderr, "kernel_launch: note: occupancy query reports %d workgroups per CU\n", per_cu);
        (void)hipGetLastError();
        grid = cus;
        if (grid != 256) fprintf(stderr, "kernel_launch: note: %d CUs (kernel tuned for 256)\n", grid);
    }
    if (grid < 0) return;
    if (hipMemsetAsync((char*)d_ws + WS_CTL, 0, CTL_ZERO_BYTES, stream) != hipSuccess) { fprintf(stderr, "kernel_launch: hipMemsetAsync failed\n"); return; }
    Args a{};
    for (int i = 0; i < 20; ++i) a.in[i] = (const float*)d_in[i];
    a.out = (float*)d_out; a.ws = (unsigned char*)d_ws;
#if MK_FUSED
    a.ph_lo = 0; a.ph_hi = NPHASE;
    hipLaunchKernelGGL(mk_fwd, dim3(grid), dim3(NWAVES * 64), LDS_BYTES, stream, a);
#else
#ifndef PROBE_PHASE
#define PROBE_PHASE -1
#define PROBE_REPS 0
#endif
    for (int p = 0; p < NPHASE; ++p) { a.ph_lo = p; a.ph_hi = p + 1;
        if (p == PROBE_PHASE) { a.dry = 1; for (int r = 0; r < PROBE_REPS; ++r) hipLaunchKernelGGL(mk_fwd, dim3(grid), dim3(NWAVES * 64), LDS_BYTES, stream, a); a.dry = 0; }
        hipLaunchKernelGGL(mk_fwd, dim3(grid), dim3(NWAVES * 64), LDS_BYTES, stream, a); }
#endif
}
```

```cpp
#define MK_FUSED 1
#define PG_TOK 2
#include <hip/hip_runtime.h>
#include <cstdio>
#include <cstdint>

#define LAS __attribute__((address_space(3)))
#define GAS __attribute__((address_space(1)))
typedef unsigned short bf16_t;
typedef short bf16x8 __attribute__((ext_vector_type(8)));
typedef short s16x4 __attribute__((ext_vector_type(4)));
typedef float f32x2 __attribute__((ext_vector_type(2)));
typedef float f32x4 __attribute__((ext_vector_type(4)));
typedef float f32x16 __attribute__((ext_vector_type(16)));
typedef unsigned u32x2 __attribute__((ext_vector_type(2)));
typedef unsigned u32x4 __attribute__((ext_vector_type(4)));
typedef __bf16 bf16x2_t __attribute__((ext_vector_type(2)));

__device__ __forceinline__ unsigned cvtpk(float lo, float hi) { f32x2 v = {lo, hi}; bf16x2_t b = __builtin_convertvector(v, bf16x2_t); return __builtin_bit_cast(unsigned, b); }
__device__ __forceinline__ float bf_lo(unsigned u) { return __uint_as_float(u << 16); }
__device__ __forceinline__ float bf_hi(unsigned u) { return __uint_as_float(u & 0xffff0000u); }
__device__ __forceinline__ float bf1(bf16_t u) { return __uint_as_float(((unsigned)u) << 16); }
__device__ __forceinline__ float fast_sigmoid(float x) { return __builtin_amdgcn_rcpf(1.0f + __expf(-x)); }

namespace pg8 {
constexpr int BM = 256, BK = 64, HALF = 128, HTB = HALF * BK * 2  , STAGE_BYTES = 8 * HTB, NXCD = 8, WGM = 8;

__host__ __device__ __forceinline__ int lds_byte(int r, int c) { const int st = (r >> 4) * 2 + (c >> 5), rr = r & 15, cc = c & 31, ob = rr * 64 + cc * 2; return st * 1024 + (ob ^ (((ob >> 9) & 1) << 5)); }
__host__ __device__ __forceinline__ void stage_rc(int b, int& R, int& C) { const int st = b / 1024, sb = b % 1024, swz = sb ^ (((sb >> 9) & 1) << 5); R = (st >> 1) * 16 + swz / 64; C = (st & 1) * 32 + (swz % 64) / 2; }
__host__ __device__ __forceinline__ int perm32(int rho) { const int n = rho >> 4, i = rho & 15; return 8 * (i >> 2) + 4 * n + (i & 3); }

struct Unit { int pm, pn; };
struct Gemm { const bf16_t* A; const bf16_t* Bt; int M, N, K, lda, a_pn_cols; int swap_lo, swap_hi; };

struct StaticOrder {
    int nM, nN, nwg, G, c;
    __host__ __device__ void init(int M, int N, int G_, int c_) { nM = M / BM; nN = N / BM; nwg = nM * nN; G = G_; c = c_; }
    __host__ __device__ bool next(int i, Unit& u) const {
        const long L = (long)i * G + c; if (L >= nwg) return false;
        int wgid = (int)L; { const int q = nwg / NXCD, r = nwg % NXCD, xcd = wgid % NXCD, off = wgid / NXCD; wgid = (xcd < r ? xcd * (q + 1) : r * (q + 1) + (xcd - r) * q) + off; }
        const int nig = WGM * nN, gid = wgid / nig, fm = gid * WGM, gsz = (nM - fm) < WGM ? (nM - fm) : WGM;
        u.pm = fm + ((wgid % nig) % gsz); u.pn = (wgid % nig) / gsz; return true;
    }
};

template <class Epi, bool ALIGN_EPI = true, bool SP2 = true>
__device__ __forceinline__ void gemm_phase(LAS unsigned char* lds, const Gemm g, const StaticOrder& S, const Epi& E, int tid) {
    const int wid = __builtin_amdgcn_readfirstlane(tid >> 6), lane = tid & 63, wr = wid >> 2, wc = wid & 3, fr = lane & 15, fq = lane >> 4;
    const int K = g.K, nt = K / BK, lda = g.lda;
    unsigned voffA[2], voffB[2];
#pragma unroll
    for (int i = 0; i < 2; ++i) { int R, C; stage_rc(tid * 16 + i * 8192, R, C); const int Rb = Epi::PERM ? ((R & ~31) + perm32(R & 31)) : R;
        voffA[i] = (unsigned)(R * lda + C) * 2u; voffB[i] = (unsigned)(Rb * K + C) * 2u; }
    const size_t kstep = (size_t)(BK * 2);
    const size_t hA = (size_t)HALF * lda * 2, hB = (size_t)HALF * K * 2;
    const size_t tA = 2 * hA, tB = 2 * hB;
    const size_t pnA = (size_t)g.a_pn_cols * 2;
    const unsigned ldsw = (unsigned)wid * 1024u;
    const int aoff = lds_byte(wr * 64 + fr, fq * 8), boff = lds_byte(wc * 32 + fr, fq * 8);
#define PG8_SA(b, h) (((b) * 2 + (h)) * HTB)
#define PG8_SB(b, h) ((4 + (b) * 2 + (h)) * HTB)
#define PG8_STAGE(bufoff, gbase, voff) do { _Pragma("unroll") for (int _i = 0; _i < 2; ++_i) \
        __builtin_amdgcn_global_load_lds((const unsigned*)((const char*)(gbase) + (voff)[_i]), (LAS unsigned*)(lds + (bufoff) + ldsw + _i * 8192), 16, 0, 0); } while (0)
#define PG8_LDA(dst, b, h) do { _Pragma("unroll") for (int m = 0; m < 4; ++m) _Pragma("unroll") for (int k = 0; k < 2; ++k) dst[m][k] = *(const LAS bf16x8*)(lds + PG8_SA(b, h) + aoff + m * 2048 + k * 1024); } while (0)
#define PG8_LDB(dst, b, h) do { _Pragma("unroll") for (int n = 0; n < 2; ++n) _Pragma("unroll") for (int k = 0; k < 2; ++k) dst[n][k] = *(const LAS bf16x8*)(lds + PG8_SB(b, h) + boff + n * 2048 + k * 1024); } while (0)
#define PG8_MMA(ai, bj, At, Bt) do { __builtin_amdgcn_s_setprio(1); _Pragma("unroll") for (int m = 0; m < 4; ++m) _Pragma("unroll") for (int n = 0; n < 2; ++n) _Pragma("unroll") for (int k = 0; k < 2; ++k) \
        acc[ai][bj][m][n] = __builtin_amdgcn_mfma_f32_16x16x32_bf16(Bt[n][k], At[m][k], acc[ai][bj][m][n], 0, 0, 0); __builtin_amdgcn_s_setprio(0); } while (0)
#define PG8_WAIT_V(n) asm volatile("s_waitcnt vmcnt(" #n ")" ::: "memory")
#define PG8_WAIT_L(n) asm volatile("s_waitcnt lgkmcnt(" #n ")" ::: "memory")
#define PG8_BAR __builtin_amdgcn_s_barrier()
#define PG8_SCHED __builtin_amdgcn_sched_barrier(0)
    Unit cur, nxt; int ui = 0;
    if (!S.next(0, cur)) return;
    f32x4 acc[2][2][4][2];
#pragma unroll
    for (int a = 0; a < 2; ++a)
#pragma unroll
        for (int b = 0; b < 2; ++b)
#pragma unroll
            for (int m = 0; m < 4; ++m)
#pragma unroll
                for (int n = 0; n < 2; ++n) acc[a][b][m][n] = (f32x4){0.f, 0.f, 0.f, 0.f};
    bf16x8 At[4][2], B0[2][2], B1[2][2];
#define PG8_APTR(u) (((u).pn >= g.swap_lo && (u).pn < g.swap_hi) ? (const char*)g.Bt + (size_t)(u).pn * tB : (const char*)g.A + (size_t)(u).pm * tA + (size_t)(u).pn * pnA)
#define PG8_BPTR(u) (((u).pn >= g.swap_lo && (u).pn < g.swap_hi) ? (const char*)g.A + (size_t)(u).pm * tA : (const char*)g.Bt + (size_t)(u).pn * tB)
    const char* cA = PG8_APTR(cur); const char* cB = PG8_BPTR(cur);
    if constexpr (SP2) {
        PG8_STAGE(PG8_SB(0, 0), cB, voffB); PG8_STAGE(PG8_SB(0, 1), cB + hB, voffB); PG8_STAGE(PG8_SA(0, 0), cA, voffA); PG8_STAGE(PG8_SA(0, 1), cA + hA, voffA);
        if (wr == 1) PG8_BAR;
        PG8_WAIT_V(2); PG8_BAR;
        PG8_STAGE(PG8_SB(1, 0), cB + kstep, voffB); PG8_STAGE(PG8_SA(1, 0), cA + kstep, voffA); PG8_STAGE(PG8_SB(1, 1), cB + hB + kstep, voffB);
        PG8_WAIT_V(6); PG8_BAR;
    } else {
        PG8_STAGE(PG8_SB(0, 0), cB, voffB); PG8_STAGE(PG8_SA(0, 0), cA, voffA); PG8_STAGE(PG8_SB(0, 1), cB + hB, voffB); PG8_STAGE(PG8_SA(0, 1), cA + hA, voffA);
        if (wr == 1) PG8_BAR;
        PG8_WAIT_V(4); PG8_BAR;
        PG8_STAGE(PG8_SB(1, 0), cB + kstep, voffB); PG8_STAGE(PG8_SA(1, 0), cA + kstep, voffA); PG8_STAGE(PG8_SB(1, 1), cB + hB + kstep, voffB);
        PG8_WAIT_V(6); PG8_BAR;
    }
    for (;;) {
        const bool has_next = S.next(ui + 1, nxt);
        const char* nA = has_next ? PG8_APTR(nxt) : cA; const char* nB = has_next ? PG8_BPTR(nxt) : cB;
#pragma unroll 1
        for (int t = 0; t < nt; t += 2) {
            const bool last = (t == nt - 2);
            const char* a1 = cA + (size_t)(t + 1) * kstep;
            const char* a2 = last ? nA : cA + (size_t)(t + 2) * kstep; const char* b2 = last ? nB : cB + (size_t)(t + 2) * kstep;
            const char* a3 = a2 + kstep; const char* b3 = b2 + kstep;
            if constexpr (SP2) {
            PG8_LDB(B0, 0, 0); PG8_LDB(B1, 0, 1); PG8_SCHED; PG8_LDA(At, 0, 0); PG8_STAGE(PG8_SA(1, 1), a1 + hA, voffA);
            PG8_WAIT_V(8); PG8_WAIT_L(0); PG8_BAR; PG8_MMA(0, 0, At, B0); PG8_MMA(0, 1, At, B1); PG8_BAR; PG8_SCHED;
            PG8_LDA(At, 0, 1); PG8_STAGE(PG8_SB(0, 0), b2, voffB); PG8_STAGE(PG8_SB(0, 1), b2 + hB, voffB); PG8_STAGE(PG8_SA(0, 0), a2, voffA);
            PG8_WAIT_V(8); PG8_WAIT_L(0); PG8_BAR; PG8_MMA(1, 0, At, B0); PG8_MMA(1, 1, At, B1); PG8_BAR; PG8_SCHED;
            PG8_LDB(B0, 1, 0); PG8_LDB(B1, 1, 1); PG8_SCHED; PG8_LDA(At, 1, 0); PG8_STAGE(PG8_SA(0, 1), a2 + hA, voffA);
            PG8_WAIT_V(8); PG8_WAIT_L(0); PG8_BAR; PG8_MMA(0, 0, At, B0); PG8_MMA(0, 1, At, B1); PG8_BAR; PG8_SCHED;
            PG8_LDA(At, 1, 1); PG8_STAGE(PG8_SB(1, 0), b3, voffB); PG8_STAGE(PG8_SB(1, 1), b3 + hB, voffB); PG8_STAGE(PG8_SA(1, 0), a3, voffA);
            PG8_WAIT_V(8); PG8_WAIT_L(0); PG8_BAR; PG8_MMA(1, 0, At, B0); PG8_MMA(1, 1, At, B1); PG8_BAR; PG8_SCHED;
            } else {
            PG8_LDB(B0, 0, 0); PG8_SCHED; PG8_LDA(At, 0, 0); PG8_STAGE(PG8_SA(1, 1), a1 + hA, voffA);
            PG8_WAIT_L(8); PG8_BAR; PG8_WAIT_L(0); PG8_MMA(0, 0, At, B0); PG8_BAR; PG8_SCHED;
            PG8_LDB(B1, 0, 1); PG8_STAGE(PG8_SB(0, 0), b2, voffB);
            PG8_BAR; PG8_WAIT_L(0); PG8_MMA(0, 1, At, B1); PG8_BAR;
            PG8_LDA(At, 0, 1); PG8_STAGE(PG8_SA(0, 0), a2, voffA);
            PG8_BAR; PG8_WAIT_L(0); PG8_MMA(1, 0, At, B0); PG8_BAR; PG8_SCHED;
            PG8_STAGE(PG8_SB(0, 1), b2 + hB, voffB);
            PG8_WAIT_V(6); PG8_BAR; PG8_MMA(1, 1, At, B1); PG8_BAR;
            PG8_LDB(B0, 1, 0); PG8_SCHED; PG8_LDA(At, 1, 0); PG8_STAGE(PG8_SA(0, 1), a2 + hA, voffA);
            PG8_WAIT_L(8); PG8_BAR; PG8_WAIT_L(0); PG8_MMA(0, 0, At, B0); PG8_BAR; PG8_SCHED;
            PG8_LDB(B1, 1, 1); PG8_STAGE(PG8_SB(1, 0), b3, voffB);
            PG8_BAR; PG8_WAIT_L(0); PG8_MMA(0, 1, At, B1); PG8_BAR;
            PG8_LDA(At, 1, 1); PG8_STAGE(PG8_SA(1, 0), a3, voffA);
            PG8_BAR; PG8_WAIT_L(0); PG8_MMA(1, 0, At, B0); PG8_BAR; PG8_SCHED;
            PG8_STAGE(PG8_SB(1, 1), b3 + hB, voffB);
            PG8_WAIT_V(6); PG8_BAR; PG8_MMA(1, 1, At, B1); PG8_BAR;
            }
        }
        if constexpr (ALIGN_EPI) { if (wr == 0) PG8_BAR; }
        E(acc, cur, wr, wc, fr, fq);
        if (!has_next) break;
#pragma unroll
        for (int a = 0; a < 2; ++a)
#pragma unroll
            for (int b = 0; b < 2; ++b)
#pragma unroll
                for (int m = 0; m < 4; ++m)
#pragma unroll
                    for (int n = 0; n < 2; ++n) acc[a][b][m][n] = (f32x4){0.f, 0.f, 0.f, 0.f};
        cur = nxt; cA = nA; cB = nB; ++ui;
        if constexpr (ALIGN_EPI) { if (wr == 1) PG8_BAR; }
    }
    PG8_WAIT_V(0);
    if constexpr (!ALIGN_EPI) { if (wr == 0) PG8_BAR; }
    PG8_BAR;
#undef PG8_APTR
#undef PG8_BPTR
#undef PG8_SA
#undef PG8_SB
#undef PG8_STAGE
#undef PG8_LDA
#undef PG8_LDB
#undef PG8_MMA
#undef PG8_WAIT_V
#undef PG8_WAIT_L
#undef PG8_BAR
#undef PG8_SCHED
}
}
constexpr int T_TOK = 16384, DM = 1024, SEQ = 4096, NB = 4;
constexpr float EPS = 1e-6f;
constexpr float LOG2E = 1.4426950408889634f;

namespace pg8 {
struct EpiProj {
    static constexpr bool PERM = true;
    bf16_t *GQ, *GK, *GV, *GR, *SQ, *SK, *SV, *SGA, *SGB;
    __device__ __forceinline__ void operator()(const f32x4 (&acc)[2][2][4][2], const Unit& u, int wr, int wc, int fr, int fq) const {
        const int pn = u.pn; bf16_t* base; int ldc = 1024, c0; int act = 0; float sc = 1.f;
        if (pn >= 2 && pn < 8) {
            bf16_t* tb = (pn < 4) ? GK : GV; const int f0 = ((pn < 4) ? (pn - 2) : (pn - 4)) * 256 + wr * 64 + fr, t0 = u.pm * BM + wc * 32 + 8 * fq;
#pragma unroll
            for (int ai = 0; ai < 2; ++ai)
#pragma unroll
                for (int m = 0; m < 4; ++m) { bf16_t* rowp = tb + (size_t)(f0 + ai * HALF + m * 16) * T_TOK + t0;
#pragma unroll
                    for (int bj = 0; bj < 2; ++bj) { const f32x4 v0 = acc[ai][bj][m][0], v1 = acc[ai][bj][m][1];
                        u32x4 w; w.x = cvtpk(v0[0], v0[1]); w.y = cvtpk(v0[2], v0[3]); w.z = cvtpk(v1[0], v1[1]); w.w = cvtpk(v1[2], v1[3]);
                        *(u32x4*)(rowp + bj * HALF) = w; } }
            return; }
        if (pn < 2) { base = GQ; ldc = 512; c0 = pn * 256; sc = 0.08838834764831845f; }
        else if (pn < 4) { base = GK; ldc = 512; c0 = (pn - 2) * 256; }
        else if (pn < 8) { base = GV; c0 = (pn - 4) * 256; }
        else if (pn < 12) { base = GR; c0 = (pn - 8) * 256; act = 1; }
        else if (pn < 16) { base = SQ; c0 = (pn - 12) * 256; sc = 0.125f * LOG2E; }
        else if (pn < 20) { base = SK; c0 = (pn - 16) * 256; }
        else if (pn < 24) { base = SV; c0 = (pn - 20) * 256; }
        else if (pn < 28) { base = SGA; c0 = (pn - 24) * 256; act = 2; }
        else { base = SGB; c0 = (pn - 28) * 256; act = 2; }
        const int row0 = u.pm * BM + wr * 64 + fr, col0 = c0 + wc * 32 + 8 * fq;
#pragma unroll
        for (int ai = 0; ai < 2; ++ai)
#pragma unroll
            for (int m = 0; m < 4; ++m) { bf16_t* rowp = base + (size_t)(row0 + ai * HALF + m * 16) * ldc + col0;
#pragma unroll
                for (int bj = 0; bj < 2; ++bj) { f32x4 v0 = acc[ai][bj][m][0], v1 = acc[ai][bj][m][1];
                    if (act == 1) {
#pragma unroll
                        for (int j = 0; j < 4; ++j) { v0[j] = v0[j] * fast_sigmoid(v0[j]); v1[j] = v1[j] * fast_sigmoid(v1[j]); } }
                    else if (act == 2) {
#pragma unroll
                        for (int j = 0; j < 4; ++j) { v0[j] = fast_sigmoid(v0[j]); v1[j] = fast_sigmoid(v1[j]); } }
                    else { v0 = v0 * sc; v1 = v1 * sc; }
                    u32x4 w; w.x = cvtpk(v0[0], v0[1]); w.y = cvtpk(v0[2], v0[3]); w.z = cvtpk(v1[0], v1[1]); w.w = cvtpk(v1[2], v1[3]);
                    *(u32x4*)(rowp + bj * HALF) = w; } }
    }
};
template <bool FIRST> struct EpiMix {
    static constexpr bool PERM = true;
    const bf16_t* gate; bf16_t* mixed;
    __device__ __forceinline__ void operator()(const f32x4 (&acc)[2][2][4][2], const Unit& u, int wr, int wc, int fr, int fq) const {
        const int row0 = u.pm * BM + wr * 64 + fr, col0 = u.pn * BM + wc * 32 + 8 * fq;
#pragma unroll
        for (int ai = 0; ai < 2; ++ai)
#pragma unroll
            for (int m = 0; m < 4; ++m) { const size_t off = (size_t)(row0 + ai * HALF + m * 16) * 1024 + col0;
#pragma unroll
                for (int bj = 0; bj < 2; ++bj) { const f32x4 a0 = acc[ai][bj][m][0], a1 = acc[ai][bj][m][1];
                    const u32x4 gv = *(const u32x4*)(gate + off + bj * HALF);
                    float r[8];
                    r[0] = a0[0] * bf_lo(gv.x); r[1] = a0[1] * bf_hi(gv.x); r[2] = a0[2] * bf_lo(gv.y); r[3] = a0[3] * bf_hi(gv.y);
                    r[4] = a1[0] * bf_lo(gv.z); r[5] = a1[1] * bf_hi(gv.z); r[6] = a1[2] * bf_lo(gv.w); r[7] = a1[3] * bf_hi(gv.w);
                    if (!FIRST) { const u32x4 mv = *(const u32x4*)(mixed + off + bj * HALF);
                        r[0] += bf_lo(mv.x); r[1] += bf_hi(mv.x); r[2] += bf_lo(mv.y); r[3] += bf_hi(mv.y); r[4] += bf_lo(mv.z); r[5] += bf_hi(mv.z); r[6] += bf_lo(mv.w); r[7] += bf_hi(mv.w); }
                    u32x4 w; w.x = cvtpk(r[0], r[1]); w.y = cvtpk(r[2], r[3]); w.z = cvtpk(r[4], r[5]); w.w = cvtpk(r[6], r[7]);
                    *(u32x4*)(mixed + off + bj * HALF) = w; } }
    }
};
struct EpiH1 {
    static constexpr bool PERM = false;
    const float* x; const float* g; bf16_t* H1B; bf16_t* H1G; float* SSQ;
    __device__ __forceinline__ void operator()(const f32x4 (&acc)[2][2][4][2], const Unit& u, int wr, int wc, int fr, int fq) const {
        const int row0 = u.pm * BM + wr * 64 + fr, col0 = u.pn * BM + wc * 32 + 4 * fq;
        f32x4 gv[2][2];
#pragma unroll
        for (int bj = 0; bj < 2; ++bj)
#pragma unroll
            for (int n = 0; n < 2; ++n) gv[bj][n] = *(const f32x4*)(g + col0 + bj * HALF + n * 16);
#pragma unroll
        for (int ai = 0; ai < 2; ++ai)
#pragma unroll
            for (int m = 0; m < 4; ++m) { const int row = row0 + ai * HALF + m * 16; const size_t off = (size_t)row * 1024 + col0; float s = 0.f;
#pragma unroll
                for (int bj = 0; bj < 2; ++bj)
#pragma unroll
                    for (int n = 0; n < 2; ++n) { const f32x4 xv = *(const f32x4*)(x + off + bj * HALF + n * 16); const f32x4 h = xv + acc[ai][bj][m][n];
                        s += (h[0] * h[0] + h[1] * h[1]) + (h[2] * h[2] + h[3] * h[3]);
                        u32x2 hb; hb.x = cvtpk(h[0], h[1]); hb.y = cvtpk(h[2], h[3]); *(u32x2*)(H1B + off + bj * HALF + n * 16) = hb;
                        const f32x4 hg = h * gv[bj][n]; u32x2 w; w.x = cvtpk(hg[0], hg[1]); w.y = cvtpk(hg[2], hg[3]); *(u32x2*)(H1G + off + bj * HALF + n * 16) = w; }
                s += __shfl_xor(s, 16); s += __shfl_xor(s, 32);
                if (fq == 0) SSQ[(size_t)row * 16 + u.pn * 4 + wc] = s; }
    }
};
struct EpiQ {
    static constexpr bool PERM = true;
    const float* SSQ; bf16_t* Q; int ldc;
    __device__ __forceinline__ void operator()(const f32x4 (&acc)[2][2][4][2], const Unit& u, int wr, int wc, int fr, int fq) const {
        const int row0 = u.pm * BM + wr * 64 + fr, col0 = u.pn * BM + wc * 32 + 8 * fq;
#pragma unroll
        for (int ai = 0; ai < 2; ++ai)
#pragma unroll
            for (int m = 0; m < 4; ++m) { const int row = row0 + ai * HALF + m * 16; const f32x4* sp = (const f32x4*)(SSQ + (size_t)row * 16);
                const f32x4 s0 = sp[0], s1 = sp[1], s2 = sp[2], s3 = sp[3]; const f32x4 st = (s0 + s1) + (s2 + s3);
                const float rstd = __builtin_amdgcn_rsqf(((st[0] + st[1]) + (st[2] + st[3])) * (1.0f / 1024.0f) + EPS);
                bf16_t* rowp = Q + (size_t)row * ldc + col0;
#pragma unroll
                for (int bj = 0; bj < 2; ++bj) { const f32x4 v0 = acc[ai][bj][m][0] * rstd, v1 = acc[ai][bj][m][1] * rstd;
                    u32x4 w; w.x = cvtpk(v0[0], v0[1]); w.y = cvtpk(v0[2], v0[3]); w.z = cvtpk(v1[0], v1[1]); w.w = cvtpk(v1[2], v1[3]);
                    *(u32x4*)(rowp + bj * HALF) = w; } }
    }
};
struct EpiF32 {
    static constexpr bool PERM = false;
    float* O; int ldc;
    __device__ __forceinline__ void operator()(const f32x4 (&acc)[2][2][4][2], const Unit& u, int wr, int wc, int fr, int fq) const {
        const int row0 = u.pm * BM + wr * 64 + fr, col0 = u.pn * BM + wc * 32 + 4 * fq;
#pragma unroll
        for (int ai = 0; ai < 2; ++ai)
#pragma unroll
            for (int m = 0; m < 4; ++m) { float* rowp = O + (size_t)(row0 + ai * HALF + m * 16) * ldc + col0;
#pragma unroll
                for (int bj = 0; bj < 2; ++bj)
#pragma unroll
                    for (int n = 0; n < 2; ++n) *(f32x4*)(rowp + bj * HALF + n * 16) = acc[ai][bj][m][n]; }
    }
};
struct EpiBf {
    static constexpr bool PERM = true;
    bf16_t* O; int ldc;
    __device__ __forceinline__ void operator()(const f32x4 (&acc)[2][2][4][2], const Unit& u, int wr, int wc, int fr, int fq) const {
        const int row0 = u.pm * BM + wr * 64 + fr, col0 = u.pn * BM + wc * 32 + 8 * fq;
#pragma unroll
        for (int ai = 0; ai < 2; ++ai)
#pragma unroll
            for (int m = 0; m < 4; ++m) { bf16_t* rowp = O + (size_t)(row0 + ai * HALF + m * 16) * ldc + col0;
#pragma unroll
                for (int bj = 0; bj < 2; ++bj) { const f32x4 v0 = acc[ai][bj][m][0], v1 = acc[ai][bj][m][1];
                    u32x4 w; w.x = cvtpk(v0[0], v0[1]); w.y = cvtpk(v0[2], v0[3]); w.z = cvtpk(v1[0], v1[1]); w.w = cvtpk(v1[2], v1[3]);
                    *(u32x4*)(rowp + bj * HALF) = w; } }
    }
};
struct EpiH3 {
    static constexpr bool PERM = false;
    const bf16_t* H2B; const bf16_t* PLE; bf16_t* H3B; float* SSQ; int dry;
    __device__ __forceinline__ void operator()(const f32x4 (&acc)[2][2][4][2], const Unit& u, int wr, int wc, int fr, int fq) const {
        const int row0 = u.pm * BM + wr * 64 + fr, col0 = u.pn * BM + wc * 32 + 4 * fq;
#pragma unroll
        for (int ai = 0; ai < 2; ++ai)
#pragma unroll
            for (int m = 0; m < 4; ++m) { const int row = row0 + ai * HALF + m * 16; const size_t off = (size_t)row * 1024 + col0; float s = 0.f;
#pragma unroll
                for (int bj = 0; bj < 2; ++bj)
#pragma unroll
                    for (int n = 0; n < 2; ++n) { const size_t o2 = off + bj * HALF + n * 16; const u32x2 hv = *(const u32x2*)(H2B + o2); const u32x2 pv = *(const u32x2*)(PLE + o2);
                        const f32x4 a = acc[ai][bj][m][n]; f32x4 h;
                        h[0] = bf_lo(hv.x) + bf_lo(pv.x) * fast_sigmoid(a[0]); h[1] = bf_hi(hv.x) + bf_hi(pv.x) * fast_sigmoid(a[1]);
                        h[2] = bf_lo(hv.y) + bf_lo(pv.y) * fast_sigmoid(a[2]); h[3] = bf_hi(hv.y) + bf_hi(pv.y) * fast_sigmoid(a[3]);
                        u32x2 w; w.x = cvtpk(h[0], h[1]); w.y = cvtpk(h[2], h[3]); if (!dry) *(u32x2*)(H3B + o2) = w;
                        s += (h[0] * h[0] + h[1] * h[1]) + (h[2] * h[2] + h[3] * h[3]); }
                s += __shfl_xor(s, 16); s += __shfl_xor(s, 32);
                if (fq == 0) SSQ[(size_t)row * 16 + u.pn * 4 + wc] = s;
                asm volatile("" ::: "memory"); }
    }
};
}
constexpr size_t MiB = 1u << 20;
constexpr size_t WS_CTL = 0, CTL_ZERO_BYTES = 64 * 1024;
constexpr size_t WS_PEND = 64 * 1024;
constexpr size_t WS_WPLE = 512 * 1024;
constexpr size_t WS_KD = 1 * MiB;
constexpr size_t WS_GLAG = 2 * MiB;
constexpr size_t WS_WIN = 3 * MiB;
constexpr size_t WS_SEND = 4 * MiB;
constexpr size_t WS_EXP = 4 * MiB;
constexpr size_t WS_SSQ1 = 13 * MiB;
constexpr size_t WS_SSQ3 = 14 * MiB;
constexpr size_t WS_RSU = 1536 * 1024, WS_RSV = 1536 * 1024 + 64 * 1024;
constexpr size_t WS_WGA = 20 * MiB, WS_WSB = 22 * MiB, WS_WO = 24 * MiB, WS_WPG = 26 * MiB, WS_WPQ = 28 * MiB;
constexpr size_t WS_A = 32 * MiB;
constexpr size_t WS_GQ = WS_A, WS_GK = WS_A + 16 * MiB, WS_H1G = WS_A, WS_XN3 = WS_A;
constexpr size_t WS_B = 64 * MiB;
constexpr size_t WS_GV = WS_B, WS_PB = WS_B;
constexpr size_t WS_C = 96 * MiB;
constexpr size_t WS_GR = WS_C, WS_GLAN = WS_C, WS_H1 = WS_C, WS_H3B = WS_C;
constexpr size_t WS_D = 128 * MiB;
constexpr size_t WS_SQ = WS_D, WS_H2B = WS_D;
constexpr size_t WS_E = 160 * MiB;
constexpr size_t WS_SK = WS_E, WS_MIX = WS_E, WS_Q = WS_E, WS_PLE = WS_E;
constexpr size_t WS_F = 192 * MiB;
constexpr size_t WS_SV = WS_F;
constexpr size_t WS_G = 224 * MiB;
constexpr size_t WS_XN1 = WS_G, WS_UB8 = WS_G, WS_VB8 = WS_G + 16 * MiB;
constexpr size_t WS_END = 256 * MiB;

constexpr int NWAVES = 8;
constexpr int RING_OFF = 0, RING_BYTES = 131072;
constexpr int MISC_OFF = RING_BYTES;
constexpr int LDS_BYTES = 147456;
constexpr int CW_BAR = 1024;

typedef GAS unsigned gu32;
#define RLX_AGENT __ATOMIC_RELAXED, __HIP_MEMORY_SCOPE_AGENT
#define LDS_WAIT() asm volatile("s_waitcnt lgkmcnt(0)" ::: "memory")
#define VM_WAIT() asm volatile("s_waitcnt vmcnt(0)" ::: "memory")

#define XB_TMO      128
#define XB_XCNT(j)  (256  + 64 * (j))
#define XB_XSUB(j)  (1280 + 64 * (j))
#define XB_XGEN(j)  (2304 + 64 * (j))
#define XB_TOP      3328
#define XB_TOPGEN   3392
#define XCD_BAR_WORDS 3456
#define XB_SPIN_CAP (1u << 22)
__device__ __forceinline__ unsigned xb_ld(unsigned* p)              { return __hip_atomic_load(p, __ATOMIC_RELAXED, __HIP_MEMORY_SCOPE_AGENT); }
__device__ __forceinline__ unsigned xb_add(unsigned* p, unsigned v) { return __hip_atomic_fetch_add(p, v, __ATOMIC_RELAXED, __HIP_MEMORY_SCOPE_AGENT); }
__device__ __forceinline__ unsigned xb_xcc_id() { return (unsigned)__builtin_amdgcn_s_getreg((3 << 11) | 20) & 0xFu; }
#define XB_SPIN(cond, bar) do { unsigned _sp = 0; while (cond) { __builtin_amdgcn_s_sleep(1); \
    if ((++_sp & 255u) == 0u) { if (xb_ld(&(bar)[XB_TMO])) break; if (_sp > XB_SPIN_CAP) { atomicAdd(&(bar)[XB_TMO], 1u); break; } } } } while (0)
struct XcdBarrier { unsigned* bar; unsigned x; volatile LAS unsigned* st; };
__device__ __forceinline__ XcdBarrier xcd_barrier_post(unsigned* bar, volatile LAS unsigned* st, int tid) {
    XcdBarrier b; b.bar = bar; b.x = xb_xcc_id(); b.st = st;
    if (tid == 0) (void)xb_add(&bar[XB_XCNT(b.x)], 1u);
    return b;
}
__device__ __forceinline__ void xcd_barrier_complete(unsigned* bar, unsigned x, unsigned& nloc, unsigned& nx) {
    const unsigned G = gridDim.x * gridDim.y * gridDim.z;
    unsigned sum, cnt, mine, sp = 0u;
    for (;;) {
        sum = 0u; cnt = 0u; mine = 0u;
#pragma unroll
        for (unsigned j = 0; j < 16; ++j) { const unsigned c = xb_ld(&bar[XB_XCNT(j)]); sum += c; cnt += (c > 0u) ? 1u : 0u; mine = (j == x) ? c : mine; }
        if (sum == G) break;
        __builtin_amdgcn_s_sleep(1);
        if ((++sp & 255u) == 0u) { if (xb_ld(&bar[XB_TMO])) break; if (sp > XB_SPIN_CAP) { atomicAdd(&bar[XB_TMO], 1u); break; } }
    }
    nloc = mine > 0u ? mine : 1u; nx = cnt > 0u ? cnt : 1u;
}
__device__ __forceinline__ void xcd_barrier(const XcdBarrier& b, int tid) {
    asm volatile("s_waitcnt vmcnt(0)" ::: "memory");
    __syncthreads();
    if (tid == 0) {
        unsigned* bar = b.bar;
        __builtin_amdgcn_s_waitcnt(0);
        unsigned nloc = b.st[0], nx = b.st[1];
        if (nloc == 0u) { xcd_barrier_complete(bar, b.x, nloc, nx); b.st[0] = nloc; b.st[1] = nx; }
        const unsigned old = xb_add(&bar[XB_XSUB(b.x)], 1u);
        const unsigned gen = old / nloc;
        if (old + 1u == (gen + 1u) * nloc) {
            __builtin_amdgcn_fence(__ATOMIC_RELEASE, "agent");
            asm volatile("s_waitcnt vmcnt(0)" ::: "memory");
            const unsigned og = xb_add(&bar[XB_TOP], 1u);
            const unsigned tg = og / nx;
            if (og + 1u == (tg + 1u) * nx) xb_add(&bar[XB_TOPGEN], 1u);
            else XB_SPIN(xb_ld(&bar[XB_TOPGEN]) == tg, bar);
            __builtin_amdgcn_fence(__ATOMIC_ACQUIRE, "agent");
            xb_add(&bar[XB_XGEN(b.x)], 1u);
            asm volatile("s_waitcnt vmcnt(0)" ::: "memory");
        } else {
            XB_SPIN(xb_ld(&bar[XB_XGEN(b.x)]) == gen, bar);
            __builtin_amdgcn_fence(__ATOMIC_ACQUIRE, "agent");
            asm volatile("s_waitcnt vmcnt(0)" ::: "memory");
        }
    }
    __syncthreads();
}

struct Frame {
    LAS unsigned char* lds;
    int tid, lane, wave, vcu, G, dry;
    const float* const* in; float* out; unsigned char* ws;
};
__device__ __forceinline__ int lane_id() { int l; asm volatile("v_mbcnt_lo_u32_b32 %0, -1, 0\n\tv_mbcnt_hi_u32_b32 %0, -1, %0" : "=v"(l)); return l; }
#define WSP(T, off) ((T*)(F.ws + (off)))
__device__ __forceinline__ float wave_sum(float v) {
#pragma unroll
    for (int o = 1; o < 64; o <<= 1) v += __shfl_xor(v, o);
    return v;
}
template <class RowMap>
__device__ __forceinline__ void p0_transpose_item(const float* W, int K, int N, bf16_t* WT, RowMap rm, LAS float* scr, int item, int lane) {
    const int nblk = (N + 31) / 32, kb = item / nblk, nb = item % nblk, k0 = 64 * kb, n0 = 32 * nb;
    { const int kr = lane >> 3, c4 = lane & 7, nl = n0 + 4 * c4; f32x4 v[8];
#pragma unroll
      for (int i = 0; i < 8; ++i) v[i] = (nl < N) ? *(const f32x4*)(W + (size_t)(k0 + 8 * i + kr) * N + nl) : (f32x4){0.f, 0.f, 0.f, 0.f};
#pragma unroll
      for (int i = 0; i < 8; ++i) { LAS float* d = scr + (8 * i + kr) * 33 + 4 * c4; d[0] = v[i][0]; d[1] = v[i][1]; d[2] = v[i][2]; d[3] = v[i][3]; } }
    LDS_WAIT(); asm volatile("" ::: "memory");
    const int c = lane & 7;
#pragma unroll
    for (int j = 0; j < 4; ++j) { const int n = (lane >> 3) + 8 * j; const LAS float* s = scr + (8 * c) * 33 + n;
        u32x4 o; o.x = cvtpk(s[0 * 33], s[1 * 33]); o.y = cvtpk(s[2 * 33], s[3 * 33]); o.z = cvtpk(s[4 * 33], s[5 * 33]); o.w = cvtpk(s[6 * 33], s[7 * 33]);
        if (n0 + n < N) *(u32x4*)(WT + (size_t)rm(n0 + n) * K + k0 + 8 * c) = o; }
    LDS_WAIT(); asm volatile("" ::: "memory");
}
struct RmId { __device__ __forceinline__ int operator()(int n) const { return n; } };
struct RmWin { __device__ __forceinline__ int operator()(int n) const { return n < 3072 ? n : (n < 3088 ? 8192 + (n - 3072) : n - 16); } };

__device__ __forceinline__ void cvt_copy(Frame& F, const float* src, bf16_t* dst, size_t n) {
    const size_t nth = (size_t)F.G * 512, n8 = n / 8;
    for (size_t i = (size_t)F.vcu * 512 + F.tid; i < n8; i += nth) {
        const f32x4 a = *(const f32x4*)(src + i * 8), b = *(const f32x4*)(src + i * 8 + 4);
        u32x4 o; o.x = cvtpk(a[0], a[1]); o.y = cvtpk(a[2], a[3]); o.z = cvtpk(b[0], b[1]); o.w = cvtpk(b[2], b[3]);
        *(u32x4*)(dst + i * 8) = o; }
}
__device__ __forceinline__ void rms_row_to_bf16(const float* xrow, const float* g, bf16_t* orow, int lane) {
    f32x4 v[4]; float s = 0.f;
#pragma unroll
    for (int j = 0; j < 4; ++j) { v[j] = *((const f32x4*)xrow + lane + 64 * j); s += (v[j][0] * v[j][0] + v[j][1] * v[j][1]) + (v[j][2] * v[j][2] + v[j][3] * v[j][3]); }
    const float rstd = __builtin_amdgcn_rsqf(wave_sum(s) * (1.f / 1024.f) + EPS);
#pragma unroll
    for (int j = 0; j < 4; ++j) { const f32x4 gv = *((const f32x4*)g + lane + 64 * j); const f32x4 o = v[j] * rstd * gv;
        u32x2 w; w.x = cvtpk(o[0], o[1]); w.y = cvtpk(o[2], o[3]); *((u32x2*)orow + lane + 64 * j) = w; }
}
__device__ __forceinline__ void phase_prologue(Frame& F) {
    LAS float* scr = (LAS float*)(F.lds + RING_OFF + F.wave * 16384);
    const int gw = F.vcu * NWAVES + F.wave, NGW = F.G * NWAVES;
    constexpr int I_IN = 16 * 257, I_SQ = 16 * 32, I_PQ = 16 * 64, I_PLE = 4 * 32;
    constexpr int NITEMS = I_IN + 4 * I_SQ + I_PQ + I_PLE;
    for (int it = gw; it < NITEMS; it += NGW) {
        int r = it;
        if (r < I_IN) { p0_transpose_item(F.in[3], 1024, 8208, WSP(bf16_t, WS_WIN), RmWin(), scr, r, F.lane); continue; } r -= I_IN;
        if (r < I_SQ) { p0_transpose_item(F.in[7], 1024, 1024, WSP(bf16_t, WS_WGA), RmId(), scr, r, F.lane); continue; } r -= I_SQ;
        if (r < I_SQ) { p0_transpose_item(F.in[8], 1024, 1024, WSP(bf16_t, WS_WSB), RmId(), scr, r, F.lane); continue; } r -= I_SQ;
        if (r < I_SQ) { p0_transpose_item(F.in[9], 1024, 1024, WSP(bf16_t, WS_WO), RmId(), scr, r, F.lane); continue; } r -= I_SQ;
        if (r < I_SQ) { p0_transpose_item(F.in[17], 1024, 1024, WSP(bf16_t, WS_WPG), RmId(), scr, r, F.lane); continue; } r -= I_SQ;
        if (r < I_PQ) { p0_transpose_item(F.in[11], 1024, 2048, WSP(bf16_t, WS_WPQ), RmId(), scr, r, F.lane); continue; } r -= I_PQ;
        p0_transpose_item(F.in[18], 256, 1024, WSP(bf16_t, WS_WPLE), RmId(), scr, r, F.lane);
    }
    { const float* k1 = F.in[12]; const float* k2 = F.in[13]; bf16_t* KB = WSP(bf16_t, WS_KD);
      for (int i = F.vcu * 512 + F.tid; i < 2 * 8 * 128 * 16; i += F.G * 512) { const int half = i >> 14, rem = i & 16383, h = rem >> 11, r8 = rem & 2047;
          const float* s = (half ? k2 : k1) + (size_t)h * 16384 + (size_t)r8 * 8; const f32x4 a = *(const f32x4*)s, b = *(const f32x4*)(s + 4);
          u32x4 o; o.x = cvtpk(a[0], a[1]); o.y = cvtpk(a[2], a[3]); o.z = cvtpk(b[0], b[1]); o.w = cvtpk(b[2], b[3]);
          *(u32x4*)(KB + (size_t)(h * 2 + half) * 16384 + (size_t)r8 * 8) = o; } }
    for (int m = gw; m < T_TOK; m += 4 * NGW) {
        f32x4 v[4][4]; float s[4];
#pragma unroll
        for (int q = 0; q < 4; ++q) { const float* xr = F.in[0] + (size_t)(m + q * NGW) * 1024; s[q] = 0.f;
#pragma unroll
            for (int j = 0; j < 4; ++j) { v[q][j] = *((const f32x4*)xr + F.lane + 64 * j); s[q] += (v[q][j][0] * v[q][j][0] + v[q][j][1] * v[q][j][1]) + (v[q][j][2] * v[q][j][2] + v[q][j][3] * v[q][j][3]); } }
#pragma unroll
        for (int o = 1; o < 64; o <<= 1) {
#pragma unroll
            for (int q = 0; q < 4; ++q) s[q] += __shfl_xor(s[q], o); }
#pragma unroll
        for (int q = 0; q < 4; ++q) { const float rstd = __builtin_amdgcn_rsqf(s[q] * (1.f / 1024.f) + EPS); bf16_t* orow = WSP(bf16_t, WS_XN1) + (size_t)(m + q * NGW) * 1024;
#pragma unroll
            for (int j = 0; j < 4; ++j) { const f32x4 gv = *((const f32x4*)F.in[2] + F.lane + 64 * j); const f32x4 o = v[q][j] * rstd * gv;
                u32x2 wq; wq.x = cvtpk(o[0], o[1]); wq.y = cvtpk(o[2], o[3]); *((u32x2*)orow + F.lane + 64 * j) = wq; } }
    }
}

__device__ __forceinline__ void phase_gla_prep(Frame& F) {
    LAS float* alo = (LAS float*)(F.lds + RING_OFF);
    const bf16_t* XN1 = WSP(bf16_t, WS_XN1); const bf16_t* WGAT = WSP(bf16_t, WS_WIN) + (size_t)8192 * 1024;
    bf16_t* GKT = WSP(bf16_t, WS_GK); float* GLAG = WSP(float, WS_GLAG);
    const float* w_up = F.in[4]; const float* b_a = F.in[5];
    const int tid = F.tid, lane = F.lane, w = F.wave;
    for (int u = F.vcu; u < 256; u += F.G) {
        const size_t r0 = (size_t)u * 64;
        __syncthreads();
        const int kk = tid;
        bf16_t* krow = GKT + (size_t)kk * T_TOK + r0;
        u32x4 kq[8];
#pragma unroll
        for (int j = 0; j < 8; ++j) kq[j] = *(const u32x4*)(krow + 8 * j);
        {
            LAS float* part = alo + 1024;
            const bf16_t* bp = WGAT + (size_t)(lane & 15) * 1024 + 8 * (lane >> 4) + 128 * w;
            bf16x8 bq[4];
#pragma unroll
            for (int s = 0; s < 4; ++s) bq[s] = *(const bf16x8*)(bp + 32 * s);
#pragma unroll
            for (int rt = 0; rt < 4; ++rt) { f32x4 acc = (f32x4){0.f, 0.f, 0.f, 0.f};
                const bf16_t* ap = XN1 + (r0 + 16 * rt + (lane & 15)) * 1024 + 8 * (lane >> 4) + 128 * w;
#pragma unroll
                for (int s = 0; s < 4; ++s) { const bf16x8 a = *(const bf16x8*)(ap + 32 * s); acc = __builtin_amdgcn_mfma_f32_16x16x32_bf16(a, bq[s], acc, 0, 0, 0); }
#pragma unroll
                for (int r = 0; r < 4; ++r) part[w * 1024 + (16 * rt + 4 * (lane >> 4) + r) * 16 + (lane & 15)] = acc[r]; }
            __syncthreads();
#pragma unroll
            for (int q = 0; q < 2; ++q) { const int e = tid + 512 * q; float s = 0.f;
#pragma unroll
                for (int ww = 0; ww < 8; ++ww) s += part[ww * 1024 + e];
                alo[e] = s; }
        }
        float wv[16];
#pragma unroll
        for (int r = 0; r < 16; ++r) wv[r] = w_up[r * 512 + kk];
        const float bias = b_a[kk];
        __syncthreads();
        float suffix = 0.f;
#pragma unroll
        for (int i8 = 7; i8 >= 0; --i8) {
            const unsigned kw[4] = {kq[i8].x, kq[i8].y, kq[i8].z, kq[i8].w};
            float o[8];
#pragma unroll
            for (int j = 7; j >= 0; --j) { const int i = i8 * 8 + j;
                const f32x4 a0 = *(const LAS f32x4*)(alo + i * 16), a1 = *(const LAS f32x4*)(alo + i * 16 + 4), a2 = *(const LAS f32x4*)(alo + i * 16 + 8), a3 = *(const LAS f32x4*)(alo + i * 16 + 12);
                float x = bias;
                x += a0[0] * wv[0] + a0[1] * wv[1] + a0[2] * wv[2] + a0[3] * wv[3];
                x += a1[0] * wv[4] + a1[1] * wv[5] + a1[2] * wv[6] + a1[3] * wv[7];
                x += a2[0] * wv[8] + a2[1] * wv[9] + a2[2] * wv[10] + a2[3] * wv[11];
                x += a3[0] * wv[12] + a3[1] * wv[13] + a3[2] * wv[14] + a3[3] * wv[15];
                const float la = (fminf(x, 0.f) - __logf(1.0f + __expf(-fabsf(x)))) * (1.0f / 16.0f);
                const float kvv = (j & 1) ? bf_hi(kw[j >> 1]) : bf_lo(kw[j >> 1]);
                o[j] = kvv * __expf(suffix);
                suffix += la; }
            u32x4 pk; pk.x = cvtpk(o[0], o[1]); pk.y = cvtpk(o[2], o[3]); pk.z = cvtpk(o[4], o[5]); pk.w = cvtpk(o[6], o[7]);
            if (!F.dry) *(u32x4*)(krow + i8 * 8) = pk; }
        GLAG[(size_t)u * 512 + kk] = __expf(suffix);
    }
}
constexpr int GL_KD = 0, GL_Q = 32768, GL_G = 65536, GL_RED = 65536 + 1024;
__device__ __forceinline__ int gl_kd_off(int row, int chunk) { return row * 128 + ((chunk ^ ((row >> 1) & 7)) << 4); }
__device__ __forceinline__ int gl_q_off(int row, int chunk16) { return row * 256 + ((chunk16 ^ (row & 15)) << 4); }

struct GlaStage { u32x4 kd[2]; u32x4 q[2]; bf16x8 vt[4]; float g; };
__device__ __forceinline__ void gla_prefetch_vt(Frame& F, GlaStage& st, int b, int h, int c) {
    const int u = b * 64 + c; const size_t r0 = (size_t)u * 64; const int w = F.wave, lq = F.lane & 31, hh = F.lane >> 5;
    const bf16_t* vt = WSP(bf16_t, WS_GV) + (size_t)(h * 256 + 32 * w + lq) * T_TOK + r0;
#pragma unroll
    for (int ts = 0; ts < 4; ++ts) st.vt[ts] = *(const bf16x8*)(vt + 16 * ts + 8 * hh);
}
template <bool WITH_Q>
__device__ __forceinline__ void gla_prefetch(Frame& F, GlaStage& st, int b, int h, int c) {
    const int u = b * 64 + c; const size_t r0 = (size_t)u * 64; const int tid = F.tid;
    const bf16_t* kd = WSP(bf16_t, WS_GK) + (size_t)(h * 128) * T_TOK + r0;
#pragma unroll
    for (int j = 0; j < 2; ++j) { const int pi = tid + 512 * j; st.kd[j] = *(const u32x4*)(kd + (size_t)(pi >> 3) * T_TOK + (pi & 7) * 8); }
    if (WITH_Q) { const bf16_t* gq = WSP(bf16_t, WS_GQ) + r0 * 512 + h * 128;
#pragma unroll
        for (int j = 0; j < 2; ++j) { const int pi = tid + 512 * j; st.q[j] = *(const u32x4*)(gq + (size_t)(pi >> 4) * 512 + (pi & 15) * 8); } }
    st.g = (tid < 128) ? WSP(float, WS_GLAG)[((size_t)u * 4 + h) * 128 + tid] : 1.f;
}
template <bool WITH_Q>
__device__ __forceinline__ void gla_stage_write(Frame& F, const GlaStage& st, int buf) {
    LAS unsigned char* lds = F.lds + RING_OFF; const int tid = F.tid;
#pragma unroll
    for (int j = 0; j < 2; ++j) { const int pi = tid + 512 * j; *(LAS u32x4*)(lds + GL_KD + buf * 16384 + gl_kd_off(pi >> 3, pi & 7)) = st.kd[j]; }
    if (WITH_Q) {
#pragma unroll
        for (int j = 0; j < 2; ++j) { const int pi = tid + 512 * j; *(LAS u32x4*)(lds + GL_Q + buf * 16384 + gl_q_off(pi >> 4, pi & 15)) = st.q[j]; } }
    if (tid < 128) *(LAS float*)(lds + GL_G + buf * 512 + tid * 4) = st.g;
}
__device__ __forceinline__ void gla_update(Frame& F, f32x16 (&S)[4], const bf16x8 (&vt)[4], int buf) {
    const LAS unsigned char* lds = F.lds + RING_OFF; const int lq = F.lane & 31, hh = F.lane >> 5;
    const LAS float* G = (const LAS float*)(lds + GL_G + buf * 512);
#pragma unroll
    for (int kt = 0; kt < 4; ++kt)
#pragma unroll
        for (int g4 = 0; g4 < 4; ++g4) { const f32x4 g = *(const LAS f32x4*)(G + 32 * kt + 8 * g4 + 4 * hh);
#pragma unroll
            for (int j = 0; j < 4; ++j) S[kt][4 * g4 + j] *= g[j]; }
#pragma unroll
    for (int ts = 0; ts < 4; ++ts)
#pragma unroll
        for (int kt = 0; kt < 4; ++kt) { const bf16x8 a = *(const LAS bf16x8*)(lds + GL_KD + buf * 16384 + gl_kd_off(32 * kt + lq, 2 * ts + hh));
            S[kt] = __builtin_amdgcn_mfma_f32_32x32x16_bf16(a, vt[ts], S[kt], 0, 0, 0); if (kt == 3 && (ts & 1)) __builtin_amdgcn_sched_barrier(0); }
}
constexpr size_t SEND_WAVE_FLOATS = 4 * 4 * 64 * 4;
__device__ __forceinline__ void gla_stage1(Frame& F, int unit) {
    const int bh = unit >> 3, seg = unit & 7, b = bh >> 2, h = bh & 3, w = F.wave, l = F.lane;
    f32x16 S[4];
#pragma unroll
    for (int kt = 0; kt < 4; ++kt)
#pragma unroll
        for (int r = 0; r < 16; ++r) S[kt][r] = 0.f;
    float pend = 1.f;
    GlaStage st; gla_prefetch<false>(F, st, b, h, seg * 8); gla_prefetch_vt(F, st, b, h, seg * 8);
    for (int ci = 0; ci < 8; ++ci) {
        gla_stage_write<false>(F, st, ci & 1); pend *= st.g;
        __syncthreads();
        if (ci < 7) gla_prefetch<false>(F, st, b, h, seg * 8 + ci + 1);
        gla_update(F, S, st.vt, ci & 1);
        if (ci < 7) gla_prefetch_vt(F, st, b, h, seg * 8 + ci + 1);
    }
    float* se = WSP(float, WS_SEND) + ((size_t)unit * 8 + w) * SEND_WAVE_FLOATS;
#pragma unroll
    for (int kt = 0; kt < 4; ++kt)
#pragma unroll
        for (int g4 = 0; g4 < 4; ++g4) *(f32x4*)(se + ((kt * 4 + g4) * 64 + l) * 4) = (f32x4){S[kt][4 * g4], S[kt][4 * g4 + 1], S[kt][4 * g4 + 2], S[kt][4 * g4 + 3]};
    if (F.tid < 128) WSP(float, WS_PEND)[unit * 128 + F.tid] = pend;
    __syncthreads();
}
__device__ __forceinline__ void gla_stage3(Frame& F, int unit) {
    const int bh = unit >> 3, seg = unit & 7, b = bh >> 2, h = bh & 3, w = F.wave, l = F.lane, lq = l & 31, hh = l >> 5;
    LAS unsigned char* lds = F.lds + RING_OFF;
    const bf16_t* GR = WSP(bf16_t, WS_GR); bf16_t* GLAN = WSP(bf16_t, WS_GLAN); const float* g_o = F.in[6];
    f32x16 S[4];
#pragma unroll
    for (int kt = 0; kt < 4; ++kt)
#pragma unroll
        for (int r = 0; r < 16; ++r) S[kt][r] = 0.f;
    GlaStage st; gla_prefetch<true>(F, st, b, h, seg * 8); gla_prefetch_vt(F, st, b, h, seg * 8);
    for (int sp = 0; sp < seg; ++sp) {
        const int un = bh * 8 + sp; const float* se = WSP(float, WS_SEND) + ((size_t)un * 8 + w) * SEND_WAVE_FLOATS; const float* pe = WSP(float, WS_PEND) + un * 128;
#pragma unroll
        for (int kt = 0; kt < 4; ++kt)
#pragma unroll
            for (int g4 = 0; g4 < 4; ++g4) { const f32x4 p = *(const f32x4*)(pe + 32 * kt + 8 * g4 + 4 * hh); const f32x4 s = *(const f32x4*)(se + ((kt * 4 + g4) * 64 + l) * 4);
#pragma unroll
                for (int j = 0; j < 4; ++j) S[kt][4 * g4 + j] = S[kt][4 * g4 + j] * p[j] + s[j]; }
    }
    for (int ci = 0; ci < 8; ++ci) {
        const int c = seg * 8 + ci; const size_t r0 = (size_t)(b * 64 + c) * 64; const int buf = ci & 1;
        gla_stage_write<true>(F, st, buf);
        __syncthreads();
        if (ci < 7) gla_prefetch<true>(F, st, b, h, c + 1);
        gla_update(F, S, st.vt, buf);
        f32x16 oT[2];
#pragma unroll
        for (int tt = 0; tt < 2; ++tt) {
#pragma unroll
            for (int r = 0; r < 16; ++r) oT[tt][r] = 0.f;
            const int t = 32 * tt + lq;
#pragma unroll
            for (int kt = 0; kt < 4; ++kt)
#pragma unroll
                for (int s = 0; s < 2; ++s) {
                    u32x4 aw; aw.x = cvtpk(S[kt][8 * s + 0], S[kt][8 * s + 1]); aw.y = cvtpk(S[kt][8 * s + 2], S[kt][8 * s + 3]); aw.z = cvtpk(S[kt][8 * s + 4], S[kt][8 * s + 5]); aw.w = cvtpk(S[kt][8 * s + 6], S[kt][8 * s + 7]);
                    const u32x2 qlo = *(const LAS u32x2*)(lds + GL_Q + buf * 16384 + gl_q_off(t, 4 * kt + 2 * s) + 8 * hh), qhi = *(const LAS u32x2*)(lds + GL_Q + buf * 16384 + gl_q_off(t, 4 * kt + 2 * s + 1) + 8 * hh);
                    const u32x4 bw = (u32x4){qlo.x, qlo.y, qhi.x, qhi.y};
                    oT[tt] = __builtin_amdgcn_mfma_f32_32x32x16_bf16(__builtin_bit_cast(bf16x8, aw), __builtin_bit_cast(bf16x8, bw), oT[tt], 0, 0, 0);
                    if (s == 1 && (kt & 1)) __builtin_amdgcn_sched_barrier(0); }
        }
        LAS float* redc = (LAS float*)(lds + GL_RED) + buf * 512;
#pragma unroll
        for (int tt = 0; tt < 2; ++tt) { float s = 0.f;
#pragma unroll
            for (int r = 0; r < 16; ++r) s += oT[tt][r] * oT[tt][r];
            s += __shfl_xor(s, 32);
            if (hh == 0) redc[w * 64 + 32 * tt + lq] = s; }
        if (ci < 7) gla_prefetch_vt(F, st, b, h, c + 1);
        u32x2 sr[2][4];
#pragma unroll
        for (int tt = 0; tt < 2; ++tt)
#pragma unroll
            for (int g4 = 0; g4 < 4; ++g4) sr[tt][g4] = *(const u32x2*)(GR + (r0 + 32 * tt + lq) * 1024 + h * 256 + 32 * w + 8 * g4 + 4 * hh);
        __syncthreads();
#pragma unroll
        for (int tt = 0; tt < 2; ++tt) { float tot = 0.f;
#pragma unroll
            for (int ww = 0; ww < 8; ++ww) tot += redc[ww * 64 + 32 * tt + lq];
            const float rstd = __builtin_amdgcn_rsqf(tot * (1.0f / 256.0f) + EPS);
            const size_t row = r0 + 32 * tt + lq;
#pragma unroll
            for (int g4 = 0; g4 < 4; ++g4) { const int v0 = h * 256 + 32 * w + 8 * g4 + 4 * hh;
                const f32x4 go = *(const f32x4*)(g_o + v0);
                const float o0 = oT[tt][4 * g4 + 0] * rstd * go[0] * bf_lo(sr[tt][g4].x), o1 = oT[tt][4 * g4 + 1] * rstd * go[1] * bf_hi(sr[tt][g4].x);
                const float o2 = oT[tt][4 * g4 + 2] * rstd * go[2] * bf_lo(sr[tt][g4].y), o3 = oT[tt][4 * g4 + 3] * rstd * go[3] * bf_hi(sr[tt][g4].y);
                u32x2 wv; wv.x = cvtpk(o0, o1); wv.y = cvtpk(o2, o3); if (!F.dry) *(u32x2*)(GLAN + row * 1024 + v0) = wv; } }
    }
    __syncthreads();
}

constexpr int SB_TILE = 16384, SB_FLAG = 7 * SB_TILE;
typedef short v4i16_t __attribute__((ext_vector_type(4)));
__device__ __forceinline__ s16x4 vtr(const LAS unsigned char* p) { return __builtin_bit_cast(s16x4, __builtin_amdgcn_ds_read_tr16_b64_v4i16((LAS v4i16_t*)p)); }
__device__ __forceinline__ float partner32(float x, int hh) { auto rr = __builtin_amdgcn_permlane32_swap(__float_as_uint(x), __float_as_uint(x), false, false); return __uint_as_float(hh ? rr[0] : rr[1]); }
__device__ __forceinline__ int sbk_off(int key, int chunk) { return key * 128 + ((chunk ^ ((key >> 1) & 7)) << 4); }
__device__ __forceinline__ int sbv_off(int key, int chunk) { return 8192 + key * 128 + ((chunk ^ (((key >> 1) & 1) << 2)) << 4); }

template <bool DIAG>
__device__ __forceinline__ void sb_tile_t(const LAS unsigned char* tile, int kt, int qabs, int l, const bf16x8 (&qf)[4], f32x16& o0, f32x16& o1, float& carry) {
    const int lq = l & 31, hh = l >> 5, g1 = (l >> 4) & 1, i = l & 15;
    float run = carry;
#pragma unroll
    for (int half = 1; half >= 0; --half) {
        f32x16 p;
#pragma unroll
        for (int r = 0; r < 16; ++r) p[r] = 0.f;
#pragma unroll
        for (int s = 0; s < 4; ++s) { const bf16x8 a = *(const LAS bf16x8*)(tile + sbk_off(32 * half + lq, 2 * s + hh)); p = __builtin_amdgcn_mfma_f32_32x32x16_bf16(a, qf[s], p, 0, 0, 0); }
        float st[16], be[16];
#pragma unroll
        for (int r = 0; r < 16; ++r) { const float ee = __builtin_amdgcn_exp2f(fminf(p[r], 80.0f)); float s_ = __builtin_amdgcn_rcpf(1.0f + ee); float b_ = ee * s_;
            if (DIAG) { const int key = 64 * kt + 32 * half + (r & 3) + 8 * (r >> 2) + 4 * hh; if (key >= qabs) { s_ = 1.0f; b_ = 0.f; } }
            st[r] = s_; be[r] = b_; }
        float tot[4];
#pragma unroll
        for (int g4 = 0; g4 < 4; ++g4) { float* sg = &st[4 * g4]; float* bg = &be[4 * g4];
            const float a2 = sg[3], a1 = sg[2] * a2, a0 = sg[1] * a1; tot[g4] = sg[0] * a0;
            bg[2] *= a2; bg[1] *= a1; bg[0] *= a0; }
        float E[4];
#pragma unroll
        for (int m = 3; m >= 0; --m) { const float tp = partner32(tot[m], hh); E[m] = hh ? run : run * tp; run *= tot[m] * tp; }
        u32x4 pw[2];
#pragma unroll
        for (int s = 0; s < 2; ++s) { float wv[8];
#pragma unroll
            for (int j = 0; j < 8; ++j) { const int r = 8 * s + j; wv[j] = be[r] * E[r >> 2]; }
            pw[s] = (u32x4){cvtpk(wv[0], wv[1]), cvtpk(wv[2], wv[3]), cvtpk(wv[4], wv[5]), cvtpk(wv[6], wv[7])}; }
#pragma unroll
        for (int s = 0; s < 2; ++s) { const bf16x8 pb = __builtin_bit_cast(bf16x8, pw[s]);
            const int k0 = 32 * half + 16 * s + 4 * hh + (i >> 2), k1 = k0 + 8;
#pragma unroll
            for (int dt = 0; dt < 2; ++dt) { const int ch = 4 * dt + 2 * g1 + ((i & 3) >> 1);
                const s16x4 lo = vtr(tile + sbv_off(k0, ch) + 8 * (i & 1)), hi = vtr(tile + sbv_off(k1, ch) + 8 * (i & 1));
                const bf16x8 a = (bf16x8){lo[0], lo[1], lo[2], lo[3], hi[0], hi[1], hi[2], hi[3]};
                if (dt == 0) o0 = __builtin_amdgcn_mfma_f32_32x32x16_bf16(a, pb, o0, 0, 0, 0); else o1 = __builtin_amdgcn_mfma_f32_32x32x16_bf16(a, pb, o1, 0, 0, 0); } }
        if (half == 1 && __all(run == 0.0f)) break;
    }
    carry = run;
}
__device__ __forceinline__ void sb_tile(const LAS unsigned char* tile, int kt, int q0, int qabs, int l, const bf16x8 (&qf)[4], f32x16& o0, f32x16& o1, float& carry) {
    if (64 * kt + 63 >= q0) sb_tile_t<true>(tile, kt, qabs, l, qf, o0, o1, carry); else sb_tile_t<false>(tile, kt, qabs, l, qf, o0, o1, carry);
}
__device__ __forceinline__ void sb_attn_unit(Frame& F, int uidx) {
    const int bh = uidx >> 4, qb = uidx & 15, b = bh >> 4, h = bh & 15;
    LAS unsigned char* lds = F.lds + RING_OFF;
    volatile LAS unsigned* flags = (volatile LAS unsigned*)(lds + SB_FLAG);
    const int tid = F.tid, w = F.wave, l = F.lane, lq = l & 31, hh = l >> 5;
    bf16_t* SQ = WSP(bf16_t, WS_SQ); const bf16_t* SK = WSP(bf16_t, WS_SK); const bf16_t* SV = WSP(bf16_t, WS_SV);
    const size_t rowbase = (size_t)b * SEQ;
    const int q0 = qb * 256 + 32 * w, qabs = q0 + lq;
    const int kt_hi = qb * 4 + 3, kt_lo = (qb * 4 - 3) > 0 ? (qb * 4 - 3) : 0, nwin = kt_hi - kt_lo + 1;
    const int skey = tid >> 3, sch = tid & 7;
    const bf16_t* kgd = SK + (rowbase + skey) * 1024 + h * 64 + ((sch ^ ((skey >> 1) & 7)) * 8);
    const bf16_t* vgd = SV + (rowbase + skey) * 1024 + h * 64 + ((sch ^ (((skey >> 1) & 1) << 2)) * 8);
    __syncthreads();
#pragma unroll
    for (int j = 0; j < 7; ++j) if (j < nwin) {
        __builtin_amdgcn_global_load_lds((const unsigned*)(kgd + (size_t)(kt_lo + j) * 64 * 1024), (LAS unsigned*)(lds + j * SB_TILE + w * 1024), 16, 0, 0);
        __builtin_amdgcn_global_load_lds((const unsigned*)(vgd + (size_t)(kt_lo + j) * 64 * 1024), (LAS unsigned*)(lds + j * SB_TILE + 8192 + w * 1024), 16, 0, 0); }
    bf16x8 qf[4];
    { const bf16_t* qrow = SQ + (rowbase + qabs) * 1024 + h * 64;
#pragma unroll
      for (int s = 0; s < 4; ++s) qf[s] = *(const bf16x8*)(qrow + 16 * s + 8 * hh); }
    f32x16 o0, o1;
#pragma unroll
    for (int r = 0; r < 16; ++r) { o0[r] = 0.f; o1[r] = 0.f; }
    float carry = 1.0f;
    VM_WAIT(); __syncthreads();
    bool done = false;
    for (int kt = (q0 + 30) >> 6; kt >= kt_lo; --kt) {
        sb_tile(lds + (kt - kt_lo) * SB_TILE, kt, q0, qabs, l, qf, o0, o1, carry);
        if (__all(carry == 0.0f)) { done = true; break; }
    }
    if (kt_lo == 0) done = true;
    if (l == 0) flags[w] = done ? 1u : 0u;
    __syncthreads();
    bool alld = true;
#pragma unroll
    for (int i = 0; i < 8; ++i) alld = alld && (flags[i] != 0u);
    if (!alld) {
        const bf16_t* kg = SK + (rowbase + skey) * 1024 + h * 64 + sch * 8;
        const bf16_t* vg = SV + (rowbase + skey) * 1024 + h * 64 + sch * 8;
        for (int kt = kt_lo - 1; kt >= 0; --kt) {
            const u32x4 kr = *(const u32x4*)(kg + (size_t)kt * 64 * 1024), vr = *(const u32x4*)(vg + (size_t)kt * 64 * 1024);
            __syncthreads();
            { unsigned a = 1u;
#pragma unroll
              for (int i = 0; i < 8; ++i) a &= flags[i];
              if (a) break; }
            *(LAS u32x4*)(lds + sbk_off(skey, sch)) = kr; *(LAS u32x4*)(lds + sbv_off(skey, sch)) = vr;
            __syncthreads();
            if (!done) { sb_tile(lds, kt, q0, qabs, l, qf, o0, o1, carry); if (__all(carry == 0.0f) || kt == 0) done = true; }
            if (l == 0) flags[w] = done ? 1u : 0u;
        }
    }
    if (!F.dry) { bf16_t* orow = SQ + (rowbase + qabs) * 1024 + h * 64;
#pragma unroll
      for (int g4 = 0; g4 < 4; ++g4) { u32x2 a, c2; a.x = cvtpk(o0[4 * g4], o0[4 * g4 + 1]); a.y = cvtpk(o0[4 * g4 + 2], o0[4 * g4 + 3]); c2.x = cvtpk(o1[4 * g4], o1[4 * g4 + 1]); c2.y = cvtpk(o1[4 * g4 + 2], o1[4 * g4 + 3]);
          *(u32x2*)(orow + 8 * g4 + 4 * hh) = a; *(u32x2*)(orow + 32 + 8 * g4 + 4 * hh) = c2; } }
}
#define CVT8_PK(V, S, W) do { int _x = __builtin_amdgcn_cvt_pk_fp8_f32((V)[0] * (S), (V)[1] * (S), 0, false); _x = __builtin_amdgcn_cvt_pk_fp8_f32((V)[2] * (S), (V)[3] * (S), _x, true); (W) = (unsigned)_x; } while (0)
__device__ __forceinline__ float absmax4(const f32x4& a) { return fmaxf(fmaxf(fabsf(a[0]), fabsf(a[1])), fmaxf(fabsf(a[2]), fabsf(a[3]))); }
constexpr int CVT8_UNITS = 256;
#ifndef QCONV
#define QCONV 1
#endif
__device__ __forceinline__ void cvt_fp8_unit(Frame& F, int cu) {
    const int l = F.lane, r0 = cu * 128 + F.wave * 16;
    const bool isv = r0 >= 16384; const int e0 = r0 & 16383;
    const float* src = isv ? F.in[15] : F.in[14]; unsigned char* dst = WSP(unsigned char, isv ? WS_VB8 : WS_UB8); float* rscale = WSP(float, isv ? WS_RSV : WS_RSU);
#pragma unroll 1
    for (int it = 0; it < 4; ++it) {
        f32x4 v[4][4]; float m[4];
#pragma unroll
        for (int q = 0; q < 4; ++q) { const f32x4* sp = (const f32x4*)(src + (size_t)(e0 + 4 * it + q) * 1024) + l;
#pragma unroll
            for (int j = 0; j < 4; ++j) v[q][j] = sp[64 * j]; }
#pragma unroll
        for (int q = 0; q < 4; ++q) m[q] = fmaxf(fmaxf(absmax4(v[q][0]), absmax4(v[q][1])), fmaxf(absmax4(v[q][2]), absmax4(v[q][3])));
#pragma unroll
        for (int o = 1; o < 64; o <<= 1) {
#pragma unroll
            for (int q = 0; q < 4; ++q) m[q] = fmaxf(m[q], __shfl_xor(m[q], o)); }
#pragma unroll
        for (int q = 0; q < 4; ++q) { const int e = e0 + 4 * it + q;
            const float t = 448.0f / fmaxf(m[q], 1e-30f); const float s = __uint_as_float(__float_as_uint(t) & 0x7f800000u);
            unsigned w[4]; CVT8_PK(v[q][0], s, w[0]); CVT8_PK(v[q][1], s, w[1]); CVT8_PK(v[q][2], s, w[2]); CVT8_PK(v[q][3], s, w[3]);
            if (!F.dry) { unsigned* dp = (unsigned*)(dst + (size_t)e * 1024) + l;
#pragma unroll
                for (int j = 0; j < 4; ++j) dp[64 * j] = w[j];
                if (l == 0) rscale[e] = 1.0f / s; } }
    }
}
__device__ __forceinline__ void sb_units_dyn(Frame& F, unsigned* ctr, int sb_lo, int nsb, int conv_lo) {
    volatile LAS int* slot = (volatile LAS int*)(F.lds + MISC_OFF + 64);
    const int total = QCONV ? nsb + (nsb >> 2) : nsb;
    __syncthreads();
    if (F.tid == 0) *slot = (int)__hip_atomic_fetch_add(ctr, 1u, __ATOMIC_RELAXED, __HIP_MEMORY_SCOPE_AGENT);
    __syncthreads();
    int i = *slot;
    while (i < total) {
        int nxt = 0;
        if (F.tid == 0) nxt = (int)__hip_atomic_fetch_add(ctr, 1u, __ATOMIC_RELAXED, __HIP_MEMORY_SCOPE_AGENT);
        if (QCONV) { const int g = i / 5, r = i - 5 * g; if (r < 4) sb_attn_unit(F, sb_lo + 4 * g + r); else cvt_fp8_unit(F, conv_lo + g); }
        else sb_attn_unit(F, sb_lo + i);
        __syncthreads();
        if (F.tid == 0) *slot = nxt;
        __syncthreads();
        i = *slot;
    }
}
__device__ __forceinline__ void phase_attn_a(Frame& F) {
#ifdef CONV_PROBE_NWG
    if (F.dry) {
        if (F.vcu < CONV_PROBE_NWG) { volatile LAS int* slot = (volatile LAS int*)(F.lds + MISC_OFF + 64); unsigned* ctr = (unsigned*)(F.ws + WS_CTL) + 64 + 16;
            for (;;) { __syncthreads(); if (F.tid == 0) *slot = (int)__hip_atomic_fetch_add(ctr, 1u, __ATOMIC_RELAXED, __HIP_MEMORY_SCOPE_AGENT); __syncthreads(); const int i = *slot; if (i >= CVT8_UNITS) break; cvt_fp8_unit(F, i); } }
        return; }
#endif
    if (F.vcu < 128) gla_stage1(F, F.vcu);
    sb_units_dyn(F, (unsigned*)(F.ws + WS_CTL) + 64 + 16 * F.dry, 0, 384, 0);
    __syncthreads();
}
__device__ __forceinline__ void phase_attn_b(Frame& F) {
    if (F.vcu < 128) gla_stage3(F, F.vcu);
    sb_units_dyn(F, (unsigned*)(F.ws + WS_CTL) + 128 + 16 * F.dry, 384, 640, 96);
    __syncthreads();
}
__device__ __forceinline__ int okey(float v, int tag, int mask) { int u = __float_as_int(v); u ^= (u >> 31) & 0x7fffffff; return (u & ~mask) | tag; }
__device__ __forceinline__ float okey_val(int key, int mask) { int u = key & ~mask; u ^= (u >> 31) & 0x7fffffff; return __int_as_float(u); }
#define INS16(Lst, xin) do { int _x = (xin); _Pragma("unroll") for (int _j = 0; _j < 16; ++_j) { const int _h = max(Lst[_j], _x); _x = min(Lst[_j], _x); Lst[_j] = _h; } } while (0)

#define CEX(a, b) do { const int _hi = max(a, b), _lo = min(a, b); a = _hi; b = _lo; } while (0)
#define BITONIC16(K) do { \
    _Pragma("unroll") for (int _i = 0; _i < 8; ++_i) CEX(K[_i], K[_i + 8]); \
    _Pragma("unroll") for (int _b = 0; _b < 16; _b += 8) _Pragma("unroll") for (int _i = 0; _i < 4; ++_i) CEX(K[_b + _i], K[_b + _i + 4]); \
    _Pragma("unroll") for (int _b = 0; _b < 16; _b += 4) _Pragma("unroll") for (int _i = 0; _i < 2; ++_i) CEX(K[_b + _i], K[_b + _i + 2]); \
    _Pragma("unroll") for (int _b = 0; _b < 16; _b += 2) CEX(K[_b], K[_b + 1]); } while (0)
#define CEXD(a, b, d) do { const int _hi = max(a, b), _lo = min(a, b); a = (d) ? _hi : _lo; b = (d) ? _lo : _hi; } while (0)
#define FULLSORT16(K) do { \
    _Pragma("unroll") for (int _k = 2; _k <= 16; _k <<= 1) _Pragma("unroll") for (int _j = _k >> 1; _j >= 1; _j >>= 1) _Pragma("unroll") for (int _i = 0; _i < 16; ++_i) { \
        const int _p = _i ^ _j; if (_p > _i) { const bool _desc = ((_i & _k) == 0); CEXD(K[_i], K[_p], _desc); } } } while (0)
__device__ __forceinline__ int swap32i(int x) { auto r = __builtin_amdgcn_permlane32_swap((unsigned)x, (unsigned)x, false, false); return (int)((__builtin_amdgcn_mbcnt_hi(~0u, __builtin_amdgcn_mbcnt_lo(~0u, 0u)) & 32) ? r[0] : r[1]); }

__device__ __forceinline__ void phase_peer_retrieve(Frame& F) {
    const bf16_t* Q = WSP(bf16_t, WS_Q); const bf16_t* KB = WSP(bf16_t, WS_KD); unsigned* EXPO = WSP(unsigned, WS_EXP);
    LAS unsigned char* idxb = F.lds + RING_OFF + F.wave * 2048;
    const int l = F.lane, lq = l & 31, hh = l >> 5;
    const int ntok_wg = T_TOK / F.G;
#pragma unroll 1
    for (int it = F.wave; it < (ntok_wg / 32) * 8; it += NWAVES) {
        const int tg = it >> 3, h = it & 7;
        const int t = F.vcu * ntok_wg + tg * 32 + lq;
        int XY[2][16];
#pragma unroll
        for (int half = 0; half < 2; ++half) {
            bf16x8 qf[8];
            { const bf16_t* qp = Q + (size_t)t * 2048 + h * 256 + half * 128 + 8 * hh;
#pragma unroll
              for (int s = 0; s < 8; ++s) qf[s] = *(const bf16x8*)(qp + 16 * s); }
            int L[16];
#pragma unroll
            for (int j = 0; j < 16; ++j) L[j] = INT_MIN;
            const bf16_t* kp = KB + (size_t)(h * 2 + half) * 16384 + (size_t)lq * 128 + 8 * hh;
#pragma unroll 1
            for (int tile = 0; tile < 4; ++tile) {
                f32x16 acc; int Tk[16];
#pragma unroll
                for (int r = 0; r < 16; ++r) acc[r] = 0.f;
#pragma unroll
                for (int s = 0; s < 8; ++s) { const bf16x8 a = *(const bf16x8*)(kp + (size_t)tile * 32 * 128 + 16 * s); acc = __builtin_amdgcn_mfma_f32_32x32x16_bf16(a, qf[s], acc, 0, 0, 0); }
#pragma unroll
                for (int r = 0; r < 16; ++r) { const int key = 32 * tile + (r & 3) + 8 * (r >> 2) + 4 * hh; Tk[r] = okey(acc[r], 127 - key, 127); }
                FULLSORT16(Tk);
#pragma unroll
                for (int k = 0; k < 16; ++k) L[k] = max(L[k], Tk[15 - k]);
                BITONIC16(L);
            }
#pragma unroll
            for (int k = 0; k < 8; ++k) { const int a = swap32i(L[15 - k]), b = swap32i(L[k]); L[k] = max(L[k], a); L[15 - k] = max(L[15 - k], b); }
            BITONIC16(L);
#pragma unroll
            for (int j = 0; j < 16; ++j) XY[half][j] = L[j];
        }
        { u32x4 pk[2];
#pragma unroll
          for (int half = 0; half < 2; ++half) { const int* L = XY[half];
            pk[half].x = (unsigned)(127 - (L[0] & 127)) | ((unsigned)(127 - (L[1] & 127)) << 8) | ((unsigned)(127 - (L[2] & 127)) << 16) | ((unsigned)(127 - (L[3] & 127)) << 24);
            pk[half].y = (unsigned)(127 - (L[4] & 127)) | ((unsigned)(127 - (L[5] & 127)) << 8) | ((unsigned)(127 - (L[6] & 127)) << 16) | ((unsigned)(127 - (L[7] & 127)) << 24);
            pk[half].z = (unsigned)(127 - (L[8] & 127)) | ((unsigned)(127 - (L[9] & 127)) << 8) | ((unsigned)(127 - (L[10] & 127)) << 16) | ((unsigned)(127 - (L[11] & 127)) << 24);
            pk[half].w = (unsigned)(127 - (L[12] & 127)) | ((unsigned)(127 - (L[13] & 127)) << 8) | ((unsigned)(127 - (L[14] & 127)) << 16) | ((unsigned)(127 - (L[15] & 127)) << 24); }
          *(LAS u32x4*)(idxb + l * 32) = pk[0]; *(LAS u32x4*)(idxb + l * 32 + 16) = pk[1]; }
        float X[16], Y[16];
#pragma unroll
        for (int j = 0; j < 16; ++j) { X[j] = okey_val(XY[0][j], 127); Y[j] = okey_val(XY[1][j], 127); }
        int M[16];
#pragma unroll
        for (int j = 0; j < 16; ++j) M[j] = INT_MIN;
#define CAND(i, j) do { const float sm = hh ? (X[j] + Y[i]) : (X[i] + Y[j]); const int pos = hh ? ((j) * 16 + (i)) : ((i) * 16 + (j)); int key = okey(sm, 255 - pos, 255); if ((i) == (j) && hh) key = INT_MIN; INS16(M, key); } while (0)
        CAND(0, 0); CAND(0, 1); CAND(0, 2); CAND(0, 3); CAND(0, 4); CAND(0, 5); CAND(0, 6); CAND(0, 7); CAND(0, 8); CAND(0, 9); CAND(0, 10); CAND(0, 11); CAND(0, 12); CAND(0, 13); CAND(0, 14); CAND(0, 15);
        CAND(1, 1); CAND(1, 2); CAND(1, 3); CAND(1, 4); CAND(1, 5); CAND(1, 6); CAND(1, 7);
        CAND(2, 2); CAND(2, 3); CAND(2, 4);
        CAND(3, 3);
#undef CAND
        int TK[16];
#pragma unroll
        for (int k = 0; k < 16; ++k) TK[k] = max(M[k], swap32i(M[15 - k]));
        float sv[16]; float mx = -INFINITY;
#pragma unroll
        for (int k = 0; k < 16; ++k) { sv[k] = okey_val(TK[k], 255); mx = fmaxf(mx, sv[k]); }
        float den = 0.f;
#pragma unroll
        for (int k = 0; k < 16; ++k) { sv[k] = __expf(sv[k] - mx); den += sv[k]; }
        const float rden = 1.0f / den;
        LDS_WAIT(); asm volatile("" ::: "memory");
        const LAS unsigned char* ib = idxb + l * 32;
        unsigned* dst = EXPO + (size_t)t * 128 + h * 16 + hh * 8;
        u32x4 o0, o1; unsigned ov[8];
#pragma unroll
        for (int k = 0; k < 8; ++k) { const int pos = 255 - (TK[k] & 255); const unsigned i1 = ib[pos >> 4], i2 = ib[16 + (pos & 15)];
            ov[k] = (__float_as_uint(sv[k] * rden) & ~0x3fffu) | (i1 * 128u + i2); }
        o0 = (u32x4){ov[0], ov[1], ov[2], ov[3]}; o1 = (u32x4){ov[4], ov[5], ov[6], ov[7]};
        *(u32x4*)dst = o0; *(u32x4*)(dst + 4) = o1;
        LDS_WAIT(); asm volatile("" ::: "memory");
    }
}

__device__ __forceinline__ void cvt_rows_fp8(Frame& F, const float* src, unsigned char* dst, float* rscale) {
    const int l = F.lane; const int gw = F.vcu * NWAVES + F.wave, NGW = F.G * NWAVES;
    for (int e = gw; e < 16384; e += NGW) {
        const f32x4* sp = (const f32x4*)(src + (size_t)e * 1024 + 16 * l);
        const f32x4 a = sp[0], b = sp[1], c = sp[2], d = sp[3];
        float m = fmaxf(fmaxf(fmaxf(fabsf(a[0]), fabsf(a[1])), fmaxf(fabsf(a[2]), fabsf(a[3]))), fmaxf(fmaxf(fabsf(b[0]), fabsf(b[1])), fmaxf(fabsf(b[2]), fabsf(b[3]))));
        m = fmaxf(m, fmaxf(fmaxf(fmaxf(fabsf(c[0]), fabsf(c[1])), fmaxf(fabsf(c[2]), fabsf(c[3]))), fmaxf(fmaxf(fabsf(d[0]), fabsf(d[1])), fmaxf(fabsf(d[2]), fabsf(d[3])))));
#pragma unroll
        for (int o = 1; o < 64; o <<= 1) m = fmaxf(m, __shfl_xor(m, o));
        const float t = 448.0f / fmaxf(m, 1e-30f); const float s = __uint_as_float(__float_as_uint(t) & 0x7f800000u);
        u32x4 w; int x;
        x = __builtin_amdgcn_cvt_pk_fp8_f32(a[0] * s, a[1] * s, 0, false); x = __builtin_amdgcn_cvt_pk_fp8_f32(a[2] * s, a[3] * s, x, true); w.x = (unsigned)x;
        x = __builtin_amdgcn_cvt_pk_fp8_f32(b[0] * s, b[1] * s, 0, false); x = __builtin_amdgcn_cvt_pk_fp8_f32(b[2] * s, b[3] * s, x, true); w.y = (unsigned)x;
        x = __builtin_amdgcn_cvt_pk_fp8_f32(c[0] * s, c[1] * s, 0, false); x = __builtin_amdgcn_cvt_pk_fp8_f32(c[2] * s, c[3] * s, x, true); w.z = (unsigned)x;
        x = __builtin_amdgcn_cvt_pk_fp8_f32(d[0] * s, d[1] * s, 0, false); x = __builtin_amdgcn_cvt_pk_fp8_f32(d[2] * s, d[3] * s, x, true); w.w = (unsigned)x;
        *(u32x4*)(dst + (size_t)e * 1024 + 16 * l) = w;
        if (l == 0) rscale[e] = 1.0f / s;
    }
}

__device__ __forceinline__ float gelu_tanh(float x) { const float y = 0.7978845608028654f * (x + 0.044715f * x * x * x); return x * __builtin_amdgcn_rcpf(1.0f + __expf(-2.0f * y)); }
#define FP8_UNPACK16(W, f) do { f32x2 _t; \
    _t = __builtin_amdgcn_cvt_pk_f32_fp8((int)(W).x, false); f[0] = _t[0]; f[1] = _t[1]; _t = __builtin_amdgcn_cvt_pk_f32_fp8((int)(W).x, true); f[2] = _t[0]; f[3] = _t[1]; \
    _t = __builtin_amdgcn_cvt_pk_f32_fp8((int)(W).y, false); f[4] = _t[0]; f[5] = _t[1]; _t = __builtin_amdgcn_cvt_pk_f32_fp8((int)(W).y, true); f[6] = _t[0]; f[7] = _t[1]; \
    _t = __builtin_amdgcn_cvt_pk_f32_fp8((int)(W).z, false); f[8] = _t[0]; f[9] = _t[1]; _t = __builtin_amdgcn_cvt_pk_f32_fp8((int)(W).z, true); f[10] = _t[0]; f[11] = _t[1]; \
    _t = __builtin_amdgcn_cvt_pk_f32_fp8((int)(W).w, false); f[12] = _t[0]; f[13] = _t[1]; _t = __builtin_amdgcn_cvt_pk_f32_fp8((int)(W).w, true); f[14] = _t[0]; f[15] = _t[1]; } while (0)
__device__ __forceinline__ float sum_swap32(float a, float b) { auto r = __builtin_amdgcn_permlane32_swap(__float_as_uint(a), __float_as_uint(b), false, false); return __uint_as_float(r[0]) + __uint_as_float(r[1]); }
__device__ __forceinline__ float sum_swap16(float a, float b) { auto r = __builtin_amdgcn_permlane16_swap(__float_as_uint(a), __float_as_uint(b), false, false); return __uint_as_float(r[0]) + __uint_as_float(r[1]); }
template <int M> __device__ __forceinline__ unsigned sxu(unsigned v, int lane) {
    if constexpr (M == 32) { auto r = __builtin_amdgcn_permlane32_swap(v, v, false, false); return (lane & 32) ? r[0] : r[1]; }
    else return (unsigned)__builtin_amdgcn_ds_swizzle((int)v, (M << 10) | 0x1f);
}
template <int M> __device__ __forceinline__ float sxf(float v, int lane) { return __uint_as_float(sxu<M>(__float_as_uint(v), lane)); }
__device__ __forceinline__ float wave_sum_sx(float v, int lane) { v += sxf<1>(v, lane); v += sxf<2>(v, lane); v += sxf<4>(v, lane); v += sxf<8>(v, lane); v += sxf<16>(v, lane); v += sxf<32>(v, lane); return v; }
#ifndef PG_TOK
#define PG_TOK 4
#endif
template <class Bar>
__device__ __forceinline__ void phase_peer_gather(Frame& F, const Bar& bar, bool use_bar) {
    const unsigned char* UB = WSP(unsigned char, WS_UB8); const unsigned char* VB = WSP(unsigned char, WS_VB8); const float* RSU = WSP(float, WS_RSU); const float* RSV = WSP(float, WS_RSV);
    const unsigned* EXPO = WSP(unsigned, WS_EXP);
    const bf16_t* H1G = WSP(bf16_t, WS_H1G); bf16_t* XN3 = WSP(bf16_t, WS_XN3); const bf16_t* H1B = WSP(bf16_t, WS_H1); bf16_t* H2B = WSP(bf16_t, WS_H2B); const float* SSQ1 = WSP(float, WS_SSQ1); const float* g_ple = F.in[16];
    const int l = F.lane; const int ntok_wg = T_TOK / F.G;
#pragma unroll 1
    for (int ti = F.wave * PG_TOK; ti < ntok_wg; ti += NWAVES * PG_TOK) {
        if (use_bar && ti >= NWAVES * PG_TOK) xcd_barrier(bar, F.tid); else __syncthreads();
        f32x2 acc[PG_TOK][8];
        LAS unsigned* lent = (LAS unsigned*)(F.lds + RING_OFF + F.wave * (2048 * PG_TOK)); LAS float* lcu = (LAS float*)(lent + 128 * PG_TOK); LAS float* lcv = lcu + 128 * PG_TOK; LAS float* acl = lcv + 128 * PG_TOK;
        LAS f32x4* lx = (LAS f32x4*)(F.lds + RING_OFF + NWAVES * 2048 * PG_TOK + F.wave * (4096 * PG_TOK));
#pragma unroll
        for (int tk = 0; tk < PG_TOK; ++tk) { const int t = F.vcu * ntok_wg + ti + tk;
            const u32x4 xa = *(const u32x4*)(H1G + (size_t)t * 1024 + 16 * l), xb = *(const u32x4*)(H1G + (size_t)t * 1024 + 16 * l + 8);
            lx[tk * 256 + l] = (f32x4){bf_lo(xa.x), bf_hi(xa.x), bf_lo(xa.y), bf_hi(xa.y)}; lx[tk * 256 + 64 + l] = (f32x4){bf_lo(xa.z), bf_hi(xa.z), bf_lo(xa.w), bf_hi(xa.w)};
            lx[tk * 256 + 128 + l] = (f32x4){bf_lo(xb.x), bf_hi(xb.x), bf_lo(xb.y), bf_hi(xb.y)}; lx[tk * 256 + 192 + l] = (f32x4){bf_lo(xb.z), bf_hi(xb.z), bf_lo(xb.w), bf_hi(xb.w)};
#pragma unroll
            for (int i = 0; i < 8; ++i) acc[tk][i] = (f32x2){0.f, 0.f}; }
#pragma unroll 1
        for (int tk = 0; tk < PG_TOK; ++tk) { const int t = F.vcu * ntok_wg + ti + tk;
            const f32x4* sp = (const f32x4*)(SSQ1 + (size_t)t * 16); const f32x4 st = (sp[0] + sp[1]) + (sp[2] + sp[3]); const float rstd1 = __builtin_amdgcn_rsqf(((st[0] + st[1]) + (st[2] + st[3])) * (1.0f / 1024.0f) + EPS);
            unsigned a0 = EXPO[(size_t)t * 128 + l], a1 = EXPO[(size_t)t * 128 + 64 + l];
            { unsigned s0 = (a0 << 18) | (a0 >> 14), s1 = (a1 << 18) | (a1 >> 14);
              int ls = l; asm volatile("" : "+v"(ls));
#define BSTEP(K, J) do { const bool up = (ls & (J)) != 0; const unsigned p0 = sxu<J>(s0, ls), p1 = sxu<J>(s1, ls); \
                  const bool asc0 = (ls & (K)) == 0, asc1 = ((ls + 64) & (K)) == 0; \
                  s0 = (up == asc0) ? max(s0, p0) : min(s0, p0); s1 = (up == asc1) ? max(s1, p1) : min(s1, p1); } while (0)
              BSTEP(2, 1);
              BSTEP(4, 2); BSTEP(4, 1);
              BSTEP(8, 4); BSTEP(8, 2); BSTEP(8, 1);
              BSTEP(16, 8); BSTEP(16, 4); BSTEP(16, 2); BSTEP(16, 1);
              BSTEP(32, 16); BSTEP(32, 8); BSTEP(32, 4); BSTEP(32, 2); BSTEP(32, 1);
              BSTEP(64, 32); BSTEP(64, 16); BSTEP(64, 8); BSTEP(64, 4); BSTEP(64, 2); BSTEP(64, 1);
              { const unsigned lo = min(s0, s1), hi = max(s0, s1); s0 = lo; s1 = hi; }
              BSTEP(128, 32); BSTEP(128, 16); BSTEP(128, 8); BSTEP(128, 4); BSTEP(128, 2); BSTEP(128, 1);
#undef BSTEP
              a0 = (s0 >> 18) | (s0 << 14); a1 = (s1 >> 18) | (s1 << 14); }
            lent[tk * 128 + l] = a0; lent[tk * 128 + 64 + l] = a1;
            lcu[tk * 128 + l] = RSU[a0 & 0x3fffu] * rstd1; lcu[tk * 128 + 64 + l] = RSU[a1 & 0x3fffu] * rstd1;
            lcv[tk * 128 + l] = RSV[a0 & 0x3fffu] * __uint_as_float(a0 & ~0x3fffu); lcv[tk * 128 + 64 + l] = RSV[a1 & 0x3fffu] * __uint_as_float(a1 & ~0x3fffu); }
        LDS_WAIT(); asm volatile("" ::: "memory");
        u32x4 buf0[8], buf1[8];
#define ROWS8(BUF, TAB, tk, eb) do { const u32x4 ea_ = *(const LAS u32x4*)(lent + (tk) * 128 + (eb)), eb_ = *(const LAS u32x4*)(lent + (tk) * 128 + (eb) + 4); \
            const unsigned en_[8] = {ea_.x, ea_.y, ea_.z, ea_.w, eb_.x, eb_.y, eb_.z, eb_.w}; \
            _Pragma("unroll") for (int k = 0; k < 8; ++k) BUF[k] = *(const u32x4*)((TAB) + ((en_[k] & 0x3fffu) * 1024u + 16u * (unsigned)l)); } while (0)
#define U8(BUF, tk, eb) do { float p[8]; f32x2 x2[8]; \
            _Pragma("unroll") for (int i = 0; i < 4; ++i) { const f32x4 t_ = lx[(tk) * 256 + 64 * i + l]; x2[2 * i] = (f32x2){t_[0], t_[1]}; x2[2 * i + 1] = (f32x2){t_[2], t_[3]}; } \
            _Pragma("unroll") for (int k = 0; k < 8; ++k) { const unsigned wq[4] = {BUF[k].x, BUF[k].y, BUF[k].z, BUF[k].w}; f32x2 s2 = (f32x2){0.f, 0.f}; \
                _Pragma("unroll") for (int i = 0; i < 4; ++i) { s2 = __builtin_elementwise_fma(__builtin_amdgcn_cvt_pk_f32_fp8((int)wq[i], false), x2[2 * i], s2); \
                                                                s2 = __builtin_elementwise_fma(__builtin_amdgcn_cvt_pk_f32_fp8((int)wq[i], true), x2[2 * i + 1], s2); } \
                p[k] = s2[0] + s2[1]; if (k & 1) __builtin_amdgcn_sched_barrier(0); } \
            float q4[4], q2[2], q1; \
            _Pragma("unroll") for (int j = 0; j < 4; ++j) q4[j] = sum_swap32(p[j], p[4 + j]); \
            _Pragma("unroll") for (int j = 0; j < 2; ++j) q2[j] = sum_swap16(q4[j], q4[2 + j]); \
            { const bool up = (l & 8) != 0; const float keep = up ? q2[1] : q2[0], send = up ? q2[0] : q2[1]; q1 = keep + sxf<8>(send, l); } \
            q1 += sxf<4>(q1, l); q1 += sxf<2>(q1, l); q1 += sxf<1>(q1, l); \
            const float cu = lcu[(tk) * 128 + (eb) + (l >> 3)], cv = lcv[(tk) * 128 + (eb) + (l >> 3)]; \
            const float a_ = gelu_tanh(q1 * cu) * cv; if ((l & 7) == 0) acl[(tk) * 128 + (eb) + (l >> 3)] = a_; __builtin_amdgcn_sched_barrier(0); } while (0)
#define V8(BUF, tk, eb) do { const float av = acl[(tk) * 128 + (eb) + (l & 7)]; \
            _Pragma("unroll") for (int k = 0; k < 8; ++k) { const float ak = __uint_as_float(__builtin_amdgcn_readlane(__float_as_uint(av), k)); const f32x2 ak2 = (f32x2){ak, ak}; \
                const unsigned wq[4] = {BUF[k].x, BUF[k].y, BUF[k].z, BUF[k].w}; \
                _Pragma("unroll") for (int i = 0; i < 4; ++i) { acc[tk][2 * i] = __builtin_elementwise_fma(__builtin_amdgcn_cvt_pk_f32_fp8((int)wq[i], false), ak2, acc[tk][2 * i]); \
                                                                acc[tk][2 * i + 1] = __builtin_elementwise_fma(__builtin_amdgcn_cvt_pk_f32_fp8((int)wq[i], true), ak2, acc[tk][2 * i + 1]); } \
                if (k & 1) __builtin_amdgcn_sched_barrier(0); } } while (0)
        ROWS8(buf0, UB, 0, 0);
#if PG_TOK == 4
#define TURNS4(CONS, TAB, eb, NEXT) do { ROWS8(buf1, TAB, 1, eb); CONS(buf0, 0, eb); ROWS8(buf0, TAB, 2, eb); CONS(buf1, 1, eb); ROWS8(buf1, TAB, 3, eb); CONS(buf0, 2, eb); NEXT; CONS(buf1, 3, eb); } while (0)
#pragma unroll 1
        for (int eb = 0; eb < 120; eb += 8) TURNS4(U8, UB, eb, ROWS8(buf0, UB, 0, eb + 8));
        TURNS4(U8, UB, 120, ROWS8(buf0, VB, 0, 0));
        LDS_WAIT(); asm volatile("" ::: "memory");
#pragma unroll 1
        for (int eb = 0; eb < 120; eb += 8) TURNS4(V8, VB, eb, ROWS8(buf0, VB, 0, eb + 8));
        TURNS4(V8, VB, 120, (void)0);
#undef TURNS4
#elif PG_TOK == 2
#define TURNS2(CONS, TAB, eb, NEXT) do { ROWS8(buf1, TAB, 1, eb); CONS(buf0, 0, eb); NEXT; CONS(buf1, 1, eb); } while (0)
#pragma unroll 1
        for (int eb = 0; eb < 120; eb += 8) TURNS2(U8, UB, eb, ROWS8(buf0, UB, 0, eb + 8));
        TURNS2(U8, UB, 120, ROWS8(buf0, VB, 0, 0));
        LDS_WAIT(); asm volatile("" ::: "memory");
#pragma unroll 1
        for (int eb = 0; eb < 120; eb += 8) TURNS2(V8, VB, eb, ROWS8(buf0, VB, 0, eb + 8));
        TURNS2(V8, VB, 120, (void)0);
#undef TURNS2
#else
#error PG_TOK must be 2 or 4
#endif
#undef ROWS8
#undef U8
#undef V8
#pragma unroll
        for (int tk = 0; tk < PG_TOK; ++tk) { const int t = F.vcu * ntok_wg + ti + tk;
            float ss = 0.f; f32x4 h[4];
#pragma unroll
            for (int q2 = 0; q2 < 2; ++q2) { const u32x4 ha = *(const u32x4*)(H1B + (size_t)t * 1024 + 16 * l + 8 * q2);
                h[2 * q2] = (f32x4){bf_lo(ha.x), bf_hi(ha.x), bf_lo(ha.y), bf_hi(ha.y)}; h[2 * q2 + 1] = (f32x4){bf_lo(ha.z), bf_hi(ha.z), bf_lo(ha.w), bf_hi(ha.w)};
#pragma unroll
                for (int j = 0; j < 4; ++j) { h[2 * q2][j] += acc[tk][4 * q2 + (j >> 1)][j & 1]; h[2 * q2 + 1][j] += acc[tk][4 * q2 + 2 + (j >> 1)][j & 1]; ss += h[2 * q2][j] * h[2 * q2][j] + h[2 * q2 + 1][j] * h[2 * q2 + 1][j]; }
                u32x4 w0; w0.x = cvtpk(h[2 * q2][0], h[2 * q2][1]); w0.y = cvtpk(h[2 * q2][2], h[2 * q2][3]); w0.z = cvtpk(h[2 * q2 + 1][0], h[2 * q2 + 1][1]); w0.w = cvtpk(h[2 * q2 + 1][2], h[2 * q2 + 1][3]);
                if (!F.dry) *(u32x4*)(H2B + (size_t)t * 1024 + 16 * l + 8 * q2) = w0; }
            const float rstd3 = __builtin_amdgcn_rsqf(wave_sum_sx(ss, l) * (1.0f / 1024.0f) + EPS);
            u32x4 o[2];
#pragma unroll
            for (int q2 = 0; q2 < 2; ++q2) { const f32x4 g0 = *(const f32x4*)(g_ple + 16 * l + 8 * q2), g1 = *(const f32x4*)(g_ple + 16 * l + 8 * q2 + 4);
                const f32x4 a = h[2 * q2] * rstd3 * g0, c = h[2 * q2 + 1] * rstd3 * g1;
                o[q2].x = cvtpk(a[0], a[1]); o[q2].y = cvtpk(a[2], a[3]); o[q2].z = cvtpk(c[0], c[1]); o[q2].w = cvtpk(c[2], c[3]); }
            if (!F.dry) { *(u32x4*)(XN3 + (size_t)t * 1024 + 16 * l) = o[0]; *(u32x4*)(XN3 + (size_t)t * 1024 + 16 * l + 8) = o[1]; } __builtin_amdgcn_sched_barrier(0); }
    }
}

__device__ __forceinline__ void phase_final(Frame& F) {
    const float* SSQ3 = WSP(float, WS_SSQ3); const float* g = F.in[19]; const bf16_t* H3B = WSP(bf16_t, WS_H3B);
    const int l = F.lane; const int gw = F.vcu * NWAVES + F.wave, NGW = F.G * NWAVES;
    for (int t = gw; t < T_TOK; t += NGW) {
        const f32x4* sp = (const f32x4*)(SSQ3 + (size_t)t * 16); const f32x4 st = (sp[0] + sp[1]) + (sp[2] + sp[3]);
        const float rstd = __builtin_amdgcn_rsqf(((st[0] + st[1]) + (st[2] + st[3])) * (1.0f / 1024.0f) + EPS);
        f32x4* row = (f32x4*)(F.out + (size_t)t * 1024);
#pragma unroll
        for (int j = 0; j < 4; ++j) { const u32x2 hv = *((const u32x2*)(H3B + (size_t)t * 1024) + l + 64 * j); const f32x4 gv = *((const f32x4*)g + l + 64 * j);
            const f32x4 h = (f32x4){bf_lo(hv.x), bf_hi(hv.x), bf_lo(hv.y), bf_hi(hv.y)}; row[l + 64 * j] = h * rstd * gv; }
    }
}
#ifndef MK_FUSED
#define MK_FUSED 1
#endif
constexpr int NPHASE = 11;
struct Args { const float* in[20]; float* out; unsigned char* ws; int ph_lo, ph_hi, dry, pad; };
static_assert(sizeof(Args) == 20 * 8 + 8 + 8 + 4 * 4, "Args has no padding");

__global__ void __launch_bounds__(NWAVES * 64, 2) mk_fwd(Args args) {
    extern __shared__ __attribute__((aligned(16))) unsigned char lds_raw[];
    Frame F;
    F.lds = (LAS unsigned char*)lds_raw;
    F.wave = __builtin_amdgcn_readfirstlane(threadIdx.x >> 6); F.lane = lane_id(); F.tid = F.wave * 64 + F.lane;
    F.G = gridDim.x; { const int bx = blockIdx.x; F.vcu = (F.G % 8 == 0) ? (bx % 8) * (F.G / 8) + bx / 8 : bx; }
    F.in = args.in; F.out = args.out; F.ws = args.ws; F.dry = args.dry;
    volatile LAS unsigned* MISC = (volatile LAS unsigned*)(F.lds + MISC_OFF);
    if (F.tid < 64) MISC[F.tid] = 0u;
    __syncthreads();
    const int lo = args.ph_lo, hi = args.ph_hi;
    XcdBarrier bar; bar.bar = (unsigned*)(F.ws + WS_CTL) + CW_BAR; bar.x = 0; bar.st = nullptr;
    if (hi - lo > 1) bar = xcd_barrier_post((unsigned*)(F.ws + WS_CTL) + CW_BAR, MISC + 8, F.tid);
#ifndef PH_MASK
#define PH_MASK 0xFFFFFFFFu
#endif
#define IN(k) (((PH_MASK >> (k)) & 1u) && lo <= (k) && (k) < hi)
#define LAUNDER(p, T) do { unsigned _lo = (unsigned)(unsigned long long)(p), _hi = (unsigned)((unsigned long long)(p) >> 32); asm volatile("" : "+v"(_lo), "+v"(_hi)); \
        _lo = __builtin_amdgcn_readfirstlane(_lo); _hi = __builtin_amdgcn_readfirstlane(_hi); (p) = (T)(((unsigned long long)_hi << 32) | _lo); } while (0)
#define SEAM(k) do { if (IN(k) && IN((k) + 1)) xcd_barrier(bar, F.tid); LAUNDER(F.ws, unsigned char*); LAUNDER(F.out, float*); F.lane = lane_id(); F.tid = F.wave * 64 + F.lane; } while (0)
    const int bx = (int)blockIdx.x;
    LAS unsigned char* ring = F.lds + RING_OFF;

    if (IN(0)) { phase_prologue(F); } SEAM(0);
    if (IN(1)) {
        pg8::Gemm g{WSP(bf16_t, WS_XN1), WSP(bf16_t, WS_WIN), T_TOK, 8192, 1024, 1024, 0, 2, 8}; pg8::StaticOrder S; S.init(T_TOK, 8192, F.G, bx);
        pg8::EpiProj E{WSP(bf16_t, WS_GQ), WSP(bf16_t, WS_GK), WSP(bf16_t, WS_GV), WSP(bf16_t, WS_GR), WSP(bf16_t, WS_SQ), WSP(bf16_t, WS_SK), WSP(bf16_t, WS_SV),
                       (bf16_t*)F.out, (bf16_t*)F.out + (size_t)T_TOK * 1024};
        pg8::gemm_phase<pg8::EpiProj>(ring, g, S, E, F.tid);
    } SEAM(1);
    if (IN(2)) { phase_gla_prep(F); } SEAM(2);
    if (IN(3)) { phase_attn_a(F); } SEAM(3);
    if (IN(4)) { phase_attn_b(F); } SEAM(4);
    if (IN(5)) {
        if (!QCONV) { for (int cu = F.vcu; cu < CVT8_UNITS; cu += F.G) cvt_fp8_unit(F, cu); VM_WAIT(); __syncthreads(); }
        pg8::StaticOrder S; S.init(T_TOK, 1024, F.G, bx);
        { pg8::Gemm g{WSP(bf16_t, WS_GLAN), WSP(bf16_t, WS_WGA), T_TOK, 1024, 1024, 1024, 0, 0, 0}; pg8::EpiMix<true> E{(const bf16_t*)F.out, WSP(bf16_t, WS_MIX)};
          pg8::gemm_phase<pg8::EpiMix<true>>(ring, g, S, E, F.tid); }
        { pg8::Gemm g{WSP(bf16_t, WS_SQ), WSP(bf16_t, WS_WSB), T_TOK, 1024, 1024, 1024, 0, 0, 0}; pg8::EpiMix<false> E{(const bf16_t*)F.out + (size_t)T_TOK * 1024, WSP(bf16_t, WS_MIX)};
          pg8::gemm_phase<pg8::EpiMix<false>>(ring, g, S, E, F.tid); }
    } SEAM(5);
    if (IN(6)) {
        pg8::Gemm g{WSP(bf16_t, WS_MIX), WSP(bf16_t, WS_WO), T_TOK, 1024, 1024, 1024, 0, 0, 0}; pg8::StaticOrder S; S.init(T_TOK, 1024, F.G, bx);
        pg8::EpiH1 E{F.in[0], F.in[10], WSP(bf16_t, WS_H1), WSP(bf16_t, WS_H1G), WSP(float, WS_SSQ1)};
        pg8::gemm_phase<pg8::EpiH1>(ring, g, S, E, F.tid);
    } SEAM(6);
    if (IN(7)) {
        pg8::Gemm g{WSP(bf16_t, WS_H1G), WSP(bf16_t, WS_WPQ), T_TOK, 2048, 1024, 1024, 0, 0, 0}; pg8::StaticOrder S; S.init(T_TOK, 2048, F.G, bx);
        pg8::EpiQ E{WSP(float, WS_SSQ1), WSP(bf16_t, WS_Q), 2048};
        pg8::gemm_phase<pg8::EpiQ>(ring, g, S, E, F.tid);
    } SEAM(7);
    if (IN(8)) {
        cvt_copy(F, F.in[1], WSP(bf16_t, WS_PB), (size_t)T_TOK * 256);
        phase_peer_retrieve(F);
        VM_WAIT(); __syncthreads();
        phase_peer_gather(F, bar, false);
    } SEAM(8);
    if (IN(9)) {
        pg8::StaticOrder S; S.init(T_TOK, 1024, F.G, bx);
        { pg8::Gemm g{WSP(bf16_t, WS_PB), WSP(bf16_t, WS_WPLE), T_TOK, 1024, 256, 256, 0, 0, 0}; pg8::EpiBf E{WSP(bf16_t, WS_PLE), 1024};
          pg8::gemm_phase<pg8::EpiBf>(ring, g, S, E, F.tid); }
        { pg8::Gemm g{WSP(bf16_t, WS_XN3), WSP(bf16_t, WS_WPG), T_TOK, 1024, 1024, 1024, 0, 0, 0}; pg8::EpiH3 E{WSP(bf16_t, WS_H2B), WSP(bf16_t, WS_PLE), WSP(bf16_t, WS_H3B), WSP(float, WS_SSQ3), F.dry};
          pg8::gemm_phase<pg8::EpiH3>(ring, g, S, E, F.tid); }
    } SEAM(9);
    if (IN(10)) { phase_final(F); }
#undef IN
#undef SEAM
}

extern "C" void kernel_launch(void* const* d_in, const int* in_sizes, int n_in, void* d_out, int out_size, void* d_ws, size_t ws_size, hipStream_t stream) {
    static int grid = 0;
    if (grid == 0) {
        if (n_in != 20 || in_sizes[0] != T_TOK * 1024 || out_size != T_TOK * 1024 || ws_size < WS_END) {
            fprintf(stderr, "kernel_launch: unexpected shapes (n_in %d, in0 %d, out %d, ws %zu < %zu?); nothing launched\n", n_in, n_in > 0 ? in_sizes[0] : -1, out_size, ws_size, (size_t)WS_END); grid = -1; return; }
        int dev = 0, cus = 0, per_cu = 0;
        if (hipGetDevice(&dev) != hipSuccess || hipDeviceGetAttribute(&cus, hipDeviceAttributeMultiprocessorCount, dev) != hipSuccess) { grid = -1; return; }
        if (hipFuncSetAttribute((const void*)mk_fwd, hipFuncAttributeMaxDynamicSharedMemorySize, LDS_BYTES) != hipSuccess) { fprintf(stderr, "kernel_launch: hipFuncSetAttribute failed\n"); grid = -1; return; }
        if (hipOccupancyMaxActiveBlocksPerMultiprocessor(&per_cu, (const void*)mk_fwd, NWAVES * 64, LDS_BYTES) != hipSuccess || per_cu < 1)
            fprintf(stderr, "kernel_launch: note: occupancy query reports %d workgroups per CU\n", per_cu);
        (void)hipGetLastError();
        grid = cus;
        if (grid != 256) fprintf(stderr, "kernel_launch: note: %d CUs (kernel tuned for 256)\n", grid);
    }
    if (grid < 0) return;
    if (hipMemsetAsync((char*)d_ws + WS_CTL, 0, CTL_ZERO_BYTES, stream) != hipSuccess) { fprintf(stderr, "kernel_launch: hipMemsetAsync failed\n"); return; }
    Args a{};
    for (int i = 0; i < 20; ++i) a.in[i] = (const float*)d_in[i];
    a.out = (float*)d_out; a.ws = (unsigned char*)d_ws;
#if MK_FUSED
    a.ph_lo = 0; a.ph_hi = NPHASE;
    hipLaunchKernelGGL(mk_fwd, dim3(grid), dim3(NWAVES * 64), LDS_BYTES, stream, a);
#else
#ifndef PROBE_PHASE
#define PROBE_PHASE -1
#define PROBE_REPS 0
#endif
    for (int p = 0; p < NPHASE; ++p) { a.ph_lo = p; a.ph_hi = p + 1;
        if (p == PROBE_PHASE) { a.dry = 1; for (int r = 0; r < PROBE_REPS; ++r) hipLaunchKernelGGL(mk_fwd, dim3(grid), dim3(NWAVES * 64), LDS_BYTES, stream, a); a.dry = 0; }
        hipLaunchKernelGGL(mk_fwd, dim3(grid), dim3(NWAVES * 64), LDS_BYTES, stream, a); }
#endif
}
```

```cpp
#define MK_FUSED 1
#define PG_TOK 2
#include <hip/hip_runtime.h>
#include <cstdio>
#include <cstdint>

#define LAS __attribute__((address_space(3)))
#define GAS __attribute__((address_space(1)))
typedef unsigned short bf16_t;
typedef short bf16x8 __attribute__((ext_vector_type(8)));
typedef short s16x4 __attribute__((ext_vector_type(4)));
typedef float f32x2 __attribute__((ext_vector_type(2)));
typedef float f32x4 __attribute__((ext_vector_type(4)));
typedef float f32x16 __attribute__((ext_vector_type(16)));
typedef unsigned u32x2 __attribute__((ext_vector_type(2)));
typedef unsigned u32x4 __attribute__((ext_vector_type(4)));
typedef __bf16 bf16x2_t __attribute__((ext_vector_type(2)));

__device__ __forceinline__ unsigned cvtpk(float lo, float hi) { f32x2 v = {lo, hi}; bf16x2_t b = __builtin_convertvector(v, bf16x2_t); return __builtin_bit_cast(unsigned, b); }
__device__ __forceinline__ float bf_lo(unsigned u) { return __uint_as_float(u << 16); }
__device__ __forceinline__ float bf_hi(unsigned u) { return __uint_as_float(u & 0xffff0000u); }
__device__ __forceinline__ float bf1(bf16_t u) { return __uint_as_float(((unsigned)u) << 16); }
__device__ __forceinline__ float fast_sigmoid(float x) { return __builtin_amdgcn_rcpf(1.0f + __expf(-x)); }

namespace pg8 {
constexpr int BM = 256, BK = 64, HALF = 128, HTB = HALF * BK * 2  , STAGE_BYTES = 8 * HTB, NXCD = 8, WGM = 8;

__host__ __device__ __forceinline__ int lds_byte(int r, int c) { const int st = (r >> 4) * 2 + (c >> 5), rr = r & 15, cc = c & 31, ob = rr * 64 + cc * 2; return st * 1024 + (ob ^ (((ob >> 9) & 1) << 5)); }
__host__ __device__ __forceinline__ void stage_rc(int b, int& R, int& C) { const int st = b / 1024, sb = b % 1024, swz = sb ^ (((sb >> 9) & 1) << 5); R = (st >> 1) * 16 + swz / 64; C = (st & 1) * 32 + (swz % 64) / 2; }
__host__ __device__ __forceinline__ int perm32(int rho) { const int n = rho >> 4, i = rho & 15; return 8 * (i >> 2) + 4 * n + (i & 3); }

struct Unit { int pm, pn; };
struct Gemm { const bf16_t* A; const bf16_t* Bt; int M, N, K, lda, a_pn_cols; int swap_lo, swap_hi; };

struct StaticOrder {
    int nM, nN, nwg, G, c;
    __host__ __device__ void init(int M, int N, int G_, int c_) { nM = M / BM; nN = N / BM; nwg = nM * nN; G = G_; c = c_; }
    __host__ __device__ bool next(int i, Unit& u) const {
        const long L = (long)i * G + c; if (L >= nwg) return false;
        int wgid = (int)L; { const int q = nwg / NXCD, r = nwg % NXCD, xcd = wgid % NXCD, off = wgid / NXCD; wgid = (xcd < r ? xcd * (q + 1) : r * (q + 1) + (xcd - r) * q) + off; }
        const int nig = WGM * nN, gid = wgid / nig, fm = gid * WGM, gsz = (nM - fm) < WGM ? (nM - fm) : WGM;
        u.pm = fm + ((wgid % nig) % gsz); u.pn = (wgid % nig) / gsz; return true;
    }
};

template <class Epi, bool ALIGN_EPI = true, bool SP2 = true>
__device__ __forceinline__ void gemm_phase(LAS unsigned char* lds, const Gemm g, const StaticOrder& S, const Epi& E, int tid) {
    const int wid = __builtin_amdgcn_readfirstlane(tid >> 6), lane = tid & 63, wr = wid >> 2, wc = wid & 3, fr = lane & 15, fq = lane >> 4;
    const int K = g.K, nt = K / BK, lda = g.lda;
    unsigned voffA[2], voffB[2];
#pragma unroll
    for (int i = 0; i < 2; ++i) { int R, C; stage_rc(tid * 16 + i * 8192, R, C); const int Rb = Epi::PERM ? ((R & ~31) + perm32(R & 31)) : R;
        voffA[i] = (unsigned)(R * lda + C) * 2u; voffB[i] = (unsigned)(Rb * K + C) * 2u; }
    const size_t kstep = (size_t)(BK * 2);
    const size_t hA = (size_t)HALF * lda * 2, hB = (size_t)HALF * K * 2;
    const size_t tA = 2 * hA, tB = 2 * hB;
    const size_t pnA = (size_t)g.a_pn_cols * 2;
    const unsigned ldsw = (unsigned)wid * 1024u;
    const int aoff = lds_byte(wr * 64 + fr, fq * 8), boff = lds_byte(wc * 32 + fr, fq * 8);
#define PG8_SA(b, h) (((b) * 2 + (h)) * HTB)
#define PG8_SB(b, h) ((4 + (b) * 2 + (h)) * HTB)
#define PG8_STAGE(bufoff, gbase, voff) do { _Pragma("unroll") for (int _i = 0; _i < 2; ++_i) \
        __builtin_amdgcn_global_load_lds((const unsigned*)((const char*)(gbase) + (voff)[_i]), (LAS unsigned*)(lds + (bufoff) + ldsw + _i * 8192), 16, 0, 0); } while (0)
#define PG8_LDA(dst, b, h) do { _Pragma("unroll") for (int m = 0; m < 4; ++m) _Pragma("unroll") for (int k = 0; k < 2; ++k) dst[m][k] = *(const LAS bf16x8*)(lds + PG8_SA(b, h) + aoff + m * 2048 + k * 1024); } while (0)
#define PG8_LDB(dst, b, h) do { _Pragma("unroll") for (int n = 0; n < 2; ++n) _Pragma("unroll") for (int k = 0; k < 2; ++k) dst[n][k] = *(const LAS bf16x8*)(lds + PG8_SB(b, h) + boff + n * 2048 + k * 1024); } while (0)
#define PG8_MMA(ai, bj, At, Bt) do { __builtin_amdgcn_s_setprio(1); _Pragma("unroll") for (int m = 0; m < 4; ++m) _Pragma("unroll") for (int n = 0; n < 2; ++n) _Pragma("unroll") for (int k = 0; k < 2; ++k) \
        acc[ai][bj][m][n] = __builtin_amdgcn_mfma_f32_16x16x32_bf16(Bt[n][k], At[m][k], acc[ai][bj][m][n], 0, 0, 0); __builtin_amdgcn_s_setprio(0); } while (0)
#define PG8_WAIT_V(n) asm volatile("s_waitcnt vmcnt(" #n ")" ::: "memory")
#define PG8_WAIT_L(n) asm volatile("s_waitcnt lgkmcnt(" #n ")" ::: "memory")
#define PG8_BAR __builtin_amdgcn_s_barrier()
#define PG8_SCHED __builtin_amdgcn_sched_barrier(0)
    Unit cur, nxt; int ui = 0;
    if (!S.next(0, cur)) return;
    f32x4 acc[2][2][4][2];
#pragma unroll
    for (int a = 0; a < 2; ++a)
#pragma unroll
        for (int b = 0; b < 2; ++b)
#pragma unroll
            for (int m = 0; m < 4; ++m)
#pragma unroll
                for (int n = 0; n < 2; ++n) acc[a][b][m][n] = (f32x4){0.f, 0.f, 0.f, 0.f};
    bf16x8 At[4][2], B0[2][2], B1[2][2];
#define PG8_APTR(u) (((u).pn >= g.swap_lo && (u).pn < g.swap_hi) ? (const char*)g.Bt + (size_t)(u).pn * tB : (const char*)g.A + (size_t)(u).pm * tA + (size_t)(u).pn * pnA)
#define PG8_BPTR(u) (((u).pn >= g.swap_lo && (u).pn < g.swap_hi) ? (const char*)g.A + (size_t)(u).pm * tA : (const char*)g.Bt + (size_t)(u).pn * tB)
    const char* cA = PG8_APTR(cur); const char* cB = PG8_BPTR(cur);
    if constexpr (SP2) {
        PG8_STAGE(PG8_SB(0, 0), cB, voffB); PG8_STAGE(PG8_SB(0, 1), cB + hB, voffB); PG8_STAGE(PG8_SA(0, 0), cA, voffA); PG8_STAGE(PG8_SA(0, 1), cA + hA, voffA);
        if (wr == 1) PG8_BAR;
        PG8_WAIT_V(2); PG8_BAR;
        PG8_STAGE(PG8_SB(1, 0), cB + kstep, voffB); PG8_STAGE(PG8_SA(1, 0), cA + kstep, voffA); PG8_STAGE(PG8_SB(1, 1), cB + hB + kstep, voffB);
        PG8_WAIT_V(6); PG8_BAR;
    } else {
        PG8_STAGE(PG8_SB(0, 0), cB, voffB); PG8_STAGE(PG8_SA(0, 0), cA, voffA); PG8_STAGE(PG8_SB(0, 1), cB + hB, voffB); PG8_STAGE(PG8_SA(0, 1), cA + hA, voffA);
        if (wr == 1) PG8_BAR;
        PG8_WAIT_V(4); PG8_BAR;
        PG8_STAGE(PG8_SB(1, 0), cB + kstep, voffB); PG8_STAGE(PG8_SA(1, 0), cA + kstep, voffA); PG8_STAGE(PG8_SB(1, 1), cB + hB + kstep, voffB);
        PG8_WAIT_V(6); PG8_BAR;
    }
    for (;;) {
        const bool has_next = S.next(ui + 1, nxt);
        const char* nA = has_next ? PG8_APTR(nxt) : cA; const char* nB = has_next ? PG8_BPTR(nxt) : cB;
#pragma unroll 1
        for (int t = 0; t < nt; t += 2) {
            const bool last = (t == nt - 2);
            const char* a1 = cA + (size_t)(t + 1) * kstep;
            const char* a2 = last ? nA : cA + (size_t)(t + 2) * kstep; const char* b2 = last ? nB : cB + (size_t)(t + 2) * kstep;
            const char* a3 = a2 + kstep; const char* b3 = b2 + kstep;
            if constexpr (SP2) {
            PG8_LDB(B0, 0, 0); PG8_LDB(B1, 0, 1); PG8_SCHED; PG8_LDA(At, 0, 0); PG8_STAGE(PG8_SA(1, 1), a1 + hA, voffA);
            PG8_WAIT_V(8); PG8_WAIT_L(0); PG8_BAR; PG8_MMA(0, 0, At, B0); PG8_MMA(0, 1, At, B1); PG8_BAR; PG8_SCHED;
            PG8_LDA(At, 0, 1); PG8_STAGE(PG8_SB(0, 0), b2, voffB); PG8_STAGE(PG8_SB(0, 1), b2 + hB, voffB); PG8_STAGE(PG8_SA(0, 0), a2, voffA);
            PG8_WAIT_V(8); PG8_WAIT_L(0); PG8_BAR; PG8_MMA(1, 0, At, B0); PG8_MMA(1, 1, At, B1); PG8_BAR; PG8_SCHED;
            PG8_LDB(B0, 1, 0); PG8_LDB(B1, 1, 1); PG8_SCHED; PG8_LDA(At, 1, 0); PG8_STAGE(PG8_SA(0, 1), a2 + hA, voffA);
            PG8_WAIT_V(8); PG8_WAIT_L(0); PG8_BAR; PG8_MMA(0, 0, At, B0); PG8_MMA(0, 1, At, B1); PG8_BAR; PG8_SCHED;
            PG8_LDA(At, 1, 1); PG8_STAGE(PG8_SB(1, 0), b3, voffB); PG8_STAGE(PG8_SB(1, 1), b3 + hB, voffB); PG8_STAGE(PG8_SA(1, 0), a3, voffA);
            PG8_WAIT_V(8); PG8_WAIT_L(0); PG8_BAR; PG8_MMA(1, 0, At, B0); PG8_MMA(1, 1, At, B1); PG8_BAR; PG8_SCHED;
            } else {
            PG8_LDB(B0, 0, 0); PG8_SCHED; PG8_LDA(At, 0, 0); PG8_STAGE(PG8_SA(1, 1), a1 + hA, voffA);
            PG8_WAIT_L(8); PG8_BAR; PG8_WAIT_L(0); PG8_MMA(0, 0, At, B0); PG8_BAR; PG8_SCHED;
            PG8_LDB(B1, 0, 1); PG8_STAGE(PG8_SB(0, 0), b2, voffB);
            PG8_BAR; PG8_WAIT_L(0); PG8_MMA(0, 1, At, B1); PG8_BAR;
            PG8_LDA(At, 0, 1); PG8_STAGE(PG8_SA(0, 0), a2, voffA);
            PG8_BAR; PG8_WAIT_L(0); PG8_MMA(1, 0, At, B0); PG8_BAR; PG8_SCHED;
            PG8_STAGE(PG8_SB(0, 1), b2 + hB, voffB);
            PG8_WAIT_V(6); PG8_BAR; PG8_MMA(1, 1, At, B1); PG8_BAR;
            PG8_LDB(B0, 1, 0); PG8_SCHED; PG8_LDA(At, 1, 0); PG8_STAGE(PG8_SA(0, 1), a2 + hA, voffA);
            PG8_WAIT_L(8); PG8_BAR; PG8_WAIT_L(0); PG8_MMA(0, 0, At, B0); PG8_BAR; PG8_SCHED;
            PG8_LDB(B1, 1, 1); PG8_STAGE(PG8_SB(1, 0), b3, voffB);
            PG8_BAR; PG8_WAIT_L(0); PG8_MMA(0, 1, At, B1); PG8_BAR;
            PG8_LDA(At, 1, 1); PG8_STAGE(PG8_SA(1, 0), a3, voffA);
            PG8_BAR; PG8_WAIT_L(0); PG8_MMA(1, 0, At, B0); PG8_BAR; PG8_SCHED;
            PG8_STAGE(PG8_SB(1, 1), b3 + hB, voffB);
            PG8_WAIT_V(6); PG8_BAR; PG8_MMA(1, 1, At, B1); PG8_BAR;
            }
        }
        if constexpr (ALIGN_EPI) { if (wr == 0) PG8_BAR; }
        E(acc, cur, wr, wc, fr, fq);
        if (!has_next) break;
#pragma unroll
        for (int a = 0; a < 2; ++a)
#pragma unroll
            for (int b = 0; b < 2; ++b)
#pragma unroll
                for (int m = 0; m < 4; ++m)
#pragma unroll
                    for (int n = 0; n < 2; ++n) acc[a][b][m][n] = (f32x4){0.f, 0.f, 0.f, 0.f};
        cur = nxt; cA = nA; cB = nB; ++ui;
        if constexpr (ALIGN_EPI) { if (wr == 1) PG8_BAR; }
    }
    PG8_WAIT_V(0);
    if constexpr (!ALIGN_EPI) { if (wr == 0) PG8_BAR; }
    PG8_BAR;
#undef PG8_APTR
#undef PG8_BPTR
#undef PG8_SA
#undef PG8_SB
#undef PG8_STAGE
#undef PG8_LDA
#undef PG8_LDB
#undef PG8_MMA
#undef PG8_WAIT_V
#undef PG8_WAIT_L
#undef PG8_BAR
#undef PG8_SCHED
}
}
constexpr int T_TOK = 16384, DM = 1024, SEQ = 4096, NB = 4;
constexpr float EPS = 1e-6f;
constexpr float LOG2E = 1.4426950408889634f;

namespace pg8 {
struct EpiProj {
    static constexpr bool PERM = true;
    bf16_t *GQ, *GK, *GV, *GR, *SQ, *SK, *SV, *SGA, *SGB;
    __device__ __forceinline__ void operator()(const f32x4 (&acc)[2][2][4][2], const Unit& u, int wr, int wc, int fr, int fq) const {
        const int pn = u.pn; bf16_t* base; int ldc = 1024, c0; int act = 0; float sc = 1.f;
        if (pn >= 2 && pn < 8) {
            bf16_t* tb = (pn < 4) ? GK : GV; const int f0 = ((pn < 4) ? (pn - 2) : (pn - 4)) * 256 + wr * 64 + fr, t0 = u.pm * BM + wc * 32 + 8 * fq;
#pragma unroll
            for (int ai = 0; ai < 2; ++ai)
#pragma unroll
                for (int m = 0; m < 4; ++m) { bf16_t* rowp = tb + (size_t)(f0 + ai * HALF + m * 16) * T_TOK + t0;
#pragma unroll
                    for (int bj = 0; bj < 2; ++bj) { const f32x4 v0 = acc[ai][bj][m][0], v1 = acc[ai][bj][m][1];
                        u32x4 w; w.x = cvtpk(v0[0], v0[1]); w.y = cvtpk(v0[2], v0[3]); w.z = cvtpk(v1[0], v1[1]); w.w = cvtpk(v1[2], v1[3]);
                        *(u32x4*)(rowp + bj * HALF) = w; } }
            return; }
        if (pn < 2) { base = GQ; ldc = 512; c0 = pn * 256; sc = 0.08838834764831845f; }
        else if (pn < 4) { base = GK; ldc = 512; c0 = (pn - 2) * 256; }
        else if (pn < 8) { base = GV; c0 = (pn - 4) * 256; }
        else if (pn < 12) { base = GR; c0 = (pn - 8) * 256; act = 1; }
        else if (pn < 16) { base = SQ; c0 = (pn - 12) * 256; sc = 0.125f * LOG2E; }
        else if (pn < 20) { base = SK; c0 = (pn - 16) * 256; }
        else if (pn < 24) { base = SV; c0 = (pn - 20) * 256; }
        else if (pn < 28) { base = SGA; c0 = (pn - 24) * 256; act = 2; }
        else { base = SGB; c0 = (pn - 28) * 256; act = 2; }
        const int row0 = u.pm * BM + wr * 64 + fr, col0 = c0 + wc * 32 + 8 * fq;
#pragma unroll
        for (int ai = 0; ai < 2; ++ai)
#pragma unroll
            for (int m = 0; m < 4; ++m) { bf16_t* rowp = base + (size_t)(row0 + ai * HALF + m * 16) * ldc + col0;
#pragma unroll
                for (int bj = 0; bj < 2; ++bj) { f32x4 v0 = acc[ai][bj][m][0], v1 = acc[ai][bj][m][1];
                    if (act == 1) {
#pragma unroll
                        for (int j = 0; j < 4; ++j) { v0[j] = v0[j] * fast_sigmoid(v0[j]); v1[j] = v1[j] * fast_sigmoid(v1[j]); } }
                    else if (act == 2) {
#pragma unroll
                        for (int j = 0; j < 4; ++j) { v0[j] = fast_sigmoid(v0[j]); v1[j] = fast_sigmoid(v1[j]); } }
                    else { v0 = v0 * sc; v1 = v1 * sc; }
                    u32x4 w; w.x = cvtpk(v0[0], v0[1]); w.y = cvtpk(v0[2], v0[3]); w.z = cvtpk(v1[0], v1[1]); w.w = cvtpk(v1[2], v1[3]);
                    *(u32x4*)(rowp + bj * HALF) = w; } }
    }
};
template <bool FIRST> struct EpiMix {
    static constexpr bool PERM = true;
    const bf16_t* gate; bf16_t* mixed;
    __device__ __forceinline__ void operator()(const f32x4 (&acc)[2][2][4][2], const Unit& u, int wr, int wc, int fr, int fq) const {
        const int row0 = u.pm * BM + wr * 64 + fr, col0 = u.pn * BM + wc * 32 + 8 * fq;
#pragma unroll
        for (int ai = 0; ai < 2; ++ai) {
            u32x4 gv[4][2], mv[4][2];
#pragma unroll
            for (int m = 0; m < 4; ++m)
#pragma unroll
                for (int bj = 0; bj < 2; ++bj) { const size_t off = (size_t)(row0 + ai * HALF + m * 16) * 1024 + col0 + bj * HALF;
                    gv[m][bj] = *(const u32x4*)(gate + off); if (!FIRST) mv[m][bj] = *(const u32x4*)(mixed + off); }
#pragma unroll
            for (int m = 0; m < 4; ++m)
#pragma unroll
                for (int bj = 0; bj < 2; ++bj) { const size_t off = (size_t)(row0 + ai * HALF + m * 16) * 1024 + col0 + bj * HALF;
                    const f32x4 a0 = acc[ai][bj][m][0], a1 = acc[ai][bj][m][1]; const u32x4 g4 = gv[m][bj];
                    float r[8];
                    r[0] = a0[0] * bf_lo(g4.x); r[1] = a0[1] * bf_hi(g4.x); r[2] = a0[2] * bf_lo(g4.y); r[3] = a0[3] * bf_hi(g4.y);
                    r[4] = a1[0] * bf_lo(g4.z); r[5] = a1[1] * bf_hi(g4.z); r[6] = a1[2] * bf_lo(g4.w); r[7] = a1[3] * bf_hi(g4.w);
                    if (!FIRST) { const u32x4 m4 = mv[m][bj];
                        r[0] += bf_lo(m4.x); r[1] += bf_hi(m4.x); r[2] += bf_lo(m4.y); r[3] += bf_hi(m4.y); r[4] += bf_lo(m4.z); r[5] += bf_hi(m4.z); r[6] += bf_lo(m4.w); r[7] += bf_hi(m4.w); }
                    u32x4 w; w.x = cvtpk(r[0], r[1]); w.y = cvtpk(r[2], r[3]); w.z = cvtpk(r[4], r[5]); w.w = cvtpk(r[6], r[7]);
                    *(u32x4*)(mixed + off) = w; }
        }
    }
};
struct EpiH1 {
    static constexpr bool PERM = false;
    const float* x; bf16_t* H1B; float* SSQ;
    __device__ __forceinline__ void operator()(const f32x4 (&acc)[2][2][4][2], const Unit& u, int wr, int wc, int fr, int fq) const {
        const int row0 = u.pm * BM + wr * 64 + fr, col0 = u.pn * BM + wc * 32 + 4 * fq;
#pragma unroll
        for (int ai = 0; ai < 2; ++ai) {
            f32x4 xv[4][2][2];
#pragma unroll
            for (int m = 0; m < 4; ++m)
#pragma unroll
                for (int bj = 0; bj < 2; ++bj)
#pragma unroll
                    for (int n = 0; n < 2; ++n) xv[m][bj][n] = *(const f32x4*)(x + (size_t)(row0 + ai * HALF + m * 16) * 1024 + col0 + bj * HALF + n * 16);
#pragma unroll
            for (int m = 0; m < 4; ++m) { const int row = row0 + ai * HALF + m * 16; const size_t off = (size_t)row * 1024 + col0; float s = 0.f;
#pragma unroll
                for (int bj = 0; bj < 2; ++bj)
#pragma unroll
                    for (int n = 0; n < 2; ++n) { const f32x4 h = xv[m][bj][n] + acc[ai][bj][m][n];
                        s += (h[0] * h[0] + h[1] * h[1]) + (h[2] * h[2] + h[3] * h[3]);
                        u32x2 hb; hb.x = cvtpk(h[0], h[1]); hb.y = cvtpk(h[2], h[3]); *(u32x2*)(H1B + off + bj * HALF + n * 16) = hb; }
                s += __shfl_xor(s, 16); s += __shfl_xor(s, 32);
                if (fq == 0) SSQ[(size_t)row * 16 + u.pn * 4 + wc] = s; }
        }
    }
};
struct EpiQ {
    static constexpr bool PERM = true;
    const float* SSQ; bf16_t* Q; int ldc;
    __device__ __forceinline__ void operator()(const f32x4 (&acc)[2][2][4][2], const Unit& u, int wr, int wc, int fr, int fq) const {
        const int row0 = u.pm * BM + wr * 64 + fr, col0 = u.pn * BM + wc * 32 + 8 * fq;
        float rstd[2][4];
#pragma unroll
        for (int ai = 0; ai < 2; ++ai) { f32x4 sq[4][4];
#pragma unroll
            for (int m = 0; m < 4; ++m) { const f32x4* sp = (const f32x4*)(SSQ + (size_t)(row0 + ai * HALF + m * 16) * 16);
#pragma unroll
                for (int j = 0; j < 4; ++j) sq[m][j] = sp[j]; }
#pragma unroll
            for (int m = 0; m < 4; ++m) { const f32x4 st = (sq[m][0] + sq[m][1]) + (sq[m][2] + sq[m][3]);
                rstd[ai][m] = __builtin_amdgcn_rsqf(((st[0] + st[1]) + (st[2] + st[3])) * (1.0f / 1024.0f) + EPS); } }
#pragma unroll
        for (int ai = 0; ai < 2; ++ai)
#pragma unroll
            for (int m = 0; m < 4; ++m) { const int row = row0 + ai * HALF + m * 16;
                bf16_t* rowp = Q + (size_t)row * ldc + col0;
#pragma unroll
                for (int bj = 0; bj < 2; ++bj) { const f32x4 v0 = acc[ai][bj][m][0] * rstd[ai][m], v1 = acc[ai][bj][m][1] * rstd[ai][m];
                    u32x4 w; w.x = cvtpk(v0[0], v0[1]); w.y = cvtpk(v0[2], v0[3]); w.z = cvtpk(v1[0], v1[1]); w.w = cvtpk(v1[2], v1[3]);
                    *(u32x4*)(rowp + bj * HALF) = w; } }
    }
};
struct EpiF32 {
    static constexpr bool PERM = false;
    float* O; int ldc;
    __device__ __forceinline__ void operator()(const f32x4 (&acc)[2][2][4][2], const Unit& u, int wr, int wc, int fr, int fq) const {
        const int row0 = u.pm * BM + wr * 64 + fr, col0 = u.pn * BM + wc * 32 + 4 * fq;
#pragma unroll
        for (int ai = 0; ai < 2; ++ai)
#pragma unroll
            for (int m = 0; m < 4; ++m) { float* rowp = O + (size_t)(row0 + ai * HALF + m * 16) * ldc + col0;
#pragma unroll
                for (int bj = 0; bj < 2; ++bj)
#pragma unroll
                    for (int n = 0; n < 2; ++n) *(f32x4*)(rowp + bj * HALF + n * 16) = acc[ai][bj][m][n]; }
    }
};
struct EpiBf {
    static constexpr bool PERM = true;
    bf16_t* O; int ldc;
    __device__ __forceinline__ void operator()(const f32x4 (&acc)[2][2][4][2], const Unit& u, int wr, int wc, int fr, int fq) const {
        const int row0 = u.pm * BM + wr * 64 + fr, col0 = u.pn * BM + wc * 32 + 8 * fq;
#pragma unroll
        for (int ai = 0; ai < 2; ++ai)
#pragma unroll
            for (int m = 0; m < 4; ++m) { bf16_t* rowp = O + (size_t)(row0 + ai * HALF + m * 16) * ldc + col0;
#pragma unroll
                for (int bj = 0; bj < 2; ++bj) { const f32x4 v0 = acc[ai][bj][m][0], v1 = acc[ai][bj][m][1];
                    u32x4 w; w.x = cvtpk(v0[0], v0[1]); w.y = cvtpk(v0[2], v0[3]); w.z = cvtpk(v1[0], v1[1]); w.w = cvtpk(v1[2], v1[3]);
                    *(u32x4*)(rowp + bj * HALF) = w; } }
    }
};
struct EpiH3 {
    static constexpr bool PERM = false;
    const bf16_t* H2B; const bf16_t* PLE; const float* RS; bf16_t* H3B; float* SSQ; int dry;
    __device__ __forceinline__ void operator()(const f32x4 (&acc)[2][2][4][2], const Unit& u, int wr, int wc, int fr, int fq) const {
        const int row0 = u.pm * BM + wr * 64 + fr, col0 = u.pn * BM + wc * 32 + 4 * fq;
#pragma unroll
        for (int ai = 0; ai < 2; ++ai) {
            u32x2 hv[4][2][2], pv[4][2][2]; float rs[4];
#pragma unroll
            for (int m = 0; m < 4; ++m) rs[m] = RS[row0 + ai * HALF + m * 16];
#pragma unroll
            for (int m = 0; m < 4; ++m)
#pragma unroll
                for (int bj = 0; bj < 2; ++bj)
#pragma unroll
                    for (int n = 0; n < 2; ++n) { const size_t o2 = (size_t)(row0 + ai * HALF + m * 16) * 1024 + col0 + bj * HALF + n * 16; hv[m][bj][n] = *(const u32x2*)(H2B + o2); pv[m][bj][n] = *(const u32x2*)(PLE + o2); }
#pragma unroll
            for (int m = 0; m < 4; ++m) { const int row = row0 + ai * HALF + m * 16; const size_t off = (size_t)row * 1024 + col0; float s = 0.f;
#pragma unroll
                for (int bj = 0; bj < 2; ++bj)
#pragma unroll
                    for (int n = 0; n < 2; ++n) { const size_t o2 = off + bj * HALF + n * 16; const u32x2 h2 = hv[m][bj][n], p2 = pv[m][bj][n];
                        const f32x4 a = acc[ai][bj][m][n] * rs[m]; f32x4 h;
                        h[0] = bf_lo(h2.x) + bf_lo(p2.x) * fast_sigmoid(a[0]); h[1] = bf_hi(h2.x) + bf_hi(p2.x) * fast_sigmoid(a[1]);
                        h[2] = bf_lo(h2.y) + bf_lo(p2.y) * fast_sigmoid(a[2]); h[3] = bf_hi(h2.y) + bf_hi(p2.y) * fast_sigmoid(a[3]);
                        u32x2 w; w.x = cvtpk(h[0], h[1]); w.y = cvtpk(h[2], h[3]); if (!dry) *(u32x2*)(H3B + o2) = w;
                        s += (h[0] * h[0] + h[1] * h[1]) + (h[2] * h[2] + h[3] * h[3]); }
                s += __shfl_xor(s, 16); s += __shfl_xor(s, 32);
                if (fq == 0) SSQ[(size_t)row * 16 + u.pn * 4 + wc] = s; }
        }
    }
};
}
constexpr size_t MiB = 1u << 20;
constexpr size_t WS_CTL = 0, CTL_ZERO_BYTES = 64 * 1024;
constexpr size_t WS_PEND = 64 * 1024;
constexpr size_t WS_WPLE = 512 * 1024;
constexpr size_t WS_KD = 1 * MiB;
constexpr size_t WS_GLAG = 2 * MiB;
constexpr size_t WS_WIN = 3 * MiB;
constexpr size_t WS_SEND = 4 * MiB;
constexpr size_t WS_EXP = 4 * MiB;
constexpr size_t WS_SSQ1 = 13 * MiB;
constexpr size_t WS_SSQ3 = 14 * MiB;
constexpr size_t WS_RS3 = 15 * MiB;
constexpr size_t WS_RSU = 1536 * 1024, WS_RSV = 1536 * 1024 + 64 * 1024;
constexpr size_t WS_WGA = 20 * MiB, WS_WSB = 22 * MiB, WS_WO = 24 * MiB, WS_WPG = 26 * MiB, WS_WPQ = 28 * MiB;
constexpr size_t WS_A = 32 * MiB;
constexpr size_t WS_GQ = WS_A, WS_GK = WS_A + 16 * MiB;
constexpr size_t WS_B = 64 * MiB;
constexpr size_t WS_GV = WS_B, WS_PB = WS_B;
constexpr size_t WS_C = 96 * MiB;
constexpr size_t WS_GR = WS_C, WS_GLAN = WS_C, WS_H1 = WS_C, WS_H3B = WS_C;
constexpr size_t WS_D = 128 * MiB;
constexpr size_t WS_SQ = WS_D, WS_H2B = WS_D;
constexpr size_t WS_E = 160 * MiB;
constexpr size_t WS_SK = WS_E, WS_MIX = WS_E, WS_Q = WS_E, WS_PLE = WS_E;
constexpr size_t WS_F = 192 * MiB;
constexpr size_t WS_SV = WS_F;
constexpr size_t WS_G = 224 * MiB;
constexpr size_t WS_XN1 = WS_G, WS_UB8 = WS_G, WS_VB8 = WS_G + 16 * MiB;
constexpr size_t WS_END = 256 * MiB;

constexpr int NWAVES = 8;
constexpr int RING_OFF = 0, RING_BYTES = 131072;
constexpr int MISC_OFF = RING_BYTES;
constexpr int LDS_BYTES = 147456;
constexpr int CW_BAR = 1024;

typedef GAS unsigned gu32;
#define RLX_AGENT __ATOMIC_RELAXED, __HIP_MEMORY_SCOPE_AGENT
#define LDS_WAIT() asm volatile("s_waitcnt lgkmcnt(0)" ::: "memory")
#define VM_WAIT() asm volatile("s_waitcnt vmcnt(0)" ::: "memory")

#define XB_TMO      128
#define XB_XCNT(j)  (256  + 64 * (j))
#define XB_XSUB(j)  (1280 + 64 * (j))
#define XB_XGEN(j)  (2304 + 64 * (j))
#define XB_TOP      3328
#define XB_TOPGEN   3392
#define XCD_BAR_WORDS 3456
#define XB_SPIN_CAP (1u << 22)
__device__ __forceinline__ unsigned xb_ld(unsigned* p)              { return __hip_atomic_load(p, __ATOMIC_RELAXED, __HIP_MEMORY_SCOPE_AGENT); }
__device__ __forceinline__ unsigned xb_add(unsigned* p, unsigned v) { return __hip_atomic_fetch_add(p, v, __ATOMIC_RELAXED, __HIP_MEMORY_SCOPE_AGENT); }
__device__ __forceinline__ unsigned xb_xcc_id() { return (unsigned)__builtin_amdgcn_s_getreg((3 << 11) | 20) & 0xFu; }
#define XB_SPIN(cond, bar) do { unsigned _sp = 0; while (cond) { __builtin_amdgcn_s_sleep(1); \
    if ((++_sp & 255u) == 0u) { if (xb_ld(&(bar)[XB_TMO])) break; if (_sp > XB_SPIN_CAP) { atomicAdd(&(bar)[XB_TMO], 1u); break; } } } } while (0)
struct XcdBarrier { unsigned* bar; unsigned x; volatile LAS unsigned* st; };
__device__ __forceinline__ XcdBarrier xcd_barrier_post(unsigned* bar, volatile LAS unsigned* st, int tid) {
    XcdBarrier b; b.bar = bar; b.x = xb_xcc_id(); b.st = st;
    if (tid == 0) (void)xb_add(&bar[XB_XCNT(b.x)], 1u);
    return b;
}
__device__ __forceinline__ void xcd_barrier_complete(unsigned* bar, unsigned x, unsigned& nloc, unsigned& nx) {
    const unsigned G = gridDim.x * gridDim.y * gridDim.z;
    unsigned sum, cnt, mine, sp = 0u;
    for (;;) {
        sum = 0u; cnt = 0u; mine = 0u;
#pragma unroll
        for (unsigned j = 0; j < 16; ++j) { const unsigned c = xb_ld(&bar[XB_XCNT(j)]); sum += c; cnt += (c > 0u) ? 1u : 0u; mine = (j == x) ? c : mine; }
        if (sum == G) break;
        __builtin_amdgcn_s_sleep(1);
        if ((++sp & 255u) == 0u) { if (xb_ld(&bar[XB_TMO])) break; if (sp > XB_SPIN_CAP) { atomicAdd(&bar[XB_TMO], 1u); break; } }
    }
    nloc = mine > 0u ? mine : 1u; nx = cnt > 0u ? cnt : 1u;
}
__device__ __forceinline__ void xcd_barrier(const XcdBarrier& b, int tid) {
    asm volatile("s_waitcnt vmcnt(0)" ::: "memory");
    __syncthreads();
    if (tid == 0) {
        unsigned* bar = b.bar;
        __builtin_amdgcn_s_waitcnt(0);
        unsigned nloc = b.st[0], nx = b.st[1];
        if (nloc == 0u) { xcd_barrier_complete(bar, b.x, nloc, nx); b.st[0] = nloc; b.st[1] = nx; }
        const unsigned old = xb_add(&bar[XB_XSUB(b.x)], 1u);
        const unsigned gen = old / nloc;
        if (old + 1u == (gen + 1u) * nloc) {
            __builtin_amdgcn_fence(__ATOMIC_RELEASE, "agent");
            asm volatile("s_waitcnt vmcnt(0)" ::: "memory");
            const unsigned og = xb_add(&bar[XB_TOP], 1u);
            const unsigned tg = og / nx;
            if (og + 1u == (tg + 1u) * nx) xb_add(&bar[XB_TOPGEN], 1u);
            else XB_SPIN(xb_ld(&bar[XB_TOPGEN]) == tg, bar);
            __builtin_amdgcn_fence(__ATOMIC_ACQUIRE, "agent");
            xb_add(&bar[XB_XGEN(b.x)], 1u);
            asm volatile("s_waitcnt vmcnt(0)" ::: "memory");
        } else {
            XB_SPIN(xb_ld(&bar[XB_XGEN(b.x)]) == gen, bar);
            __builtin_amdgcn_fence(__ATOMIC_ACQUIRE, "agent");
            asm volatile("s_waitcnt vmcnt(0)" ::: "memory");
        }
    }
    __syncthreads();
}

struct Frame {
    LAS unsigned char* lds;
    int tid, lane, wave, vcu, G, dry;
    const float* const* in; float* out; unsigned char* ws;
};
__device__ __forceinline__ int lane_id() { int l; asm volatile("v_mbcnt_lo_u32_b32 %0, -1, 0\n\tv_mbcnt_hi_u32_b32 %0, -1, %0" : "=v"(l)); return l; }
#define WSP(T, off) ((T*)(F.ws + (off)))
__device__ __forceinline__ float wave_sum(float v) {
#pragma unroll
    for (int o = 1; o < 64; o <<= 1) v += __shfl_xor(v, o);
    return v;
}
template <class RowMap>
__device__ __forceinline__ void p0_transpose_item(const float* W, int K, int N, bf16_t* WT, RowMap rm, LAS float* scr, int item, int lane, const float* gk = nullptr) {
    const int nblk = (N + 31) / 32, kb = item / nblk, nb = item % nblk, k0 = 64 * kb, n0 = 32 * nb;
    { const int kr = lane >> 3, c4 = lane & 7, nl = n0 + 4 * c4; f32x4 v[8];
#pragma unroll
      for (int i = 0; i < 8; ++i) v[i] = (nl < N) ? *(const f32x4*)(W + (size_t)(k0 + 8 * i + kr) * N + nl) : (f32x4){0.f, 0.f, 0.f, 0.f};
#pragma unroll
      for (int i = 0; i < 8; ++i) { LAS float* d = scr + (8 * i + kr) * 33 + 4 * c4; d[0] = v[i][0]; d[1] = v[i][1]; d[2] = v[i][2]; d[3] = v[i][3]; } }
    LDS_WAIT(); asm volatile("" ::: "memory");
    const int c = lane & 7;
#pragma unroll
    for (int j = 0; j < 4; ++j) { const int n = (lane >> 3) + 8 * j; const LAS float* s = scr + (8 * c) * 33 + n;
        f32x4 ga = (f32x4){1.f, 1.f, 1.f, 1.f}, gb = ga; if (gk) { ga = *(const f32x4*)(gk + k0 + 8 * c); gb = *(const f32x4*)(gk + k0 + 8 * c + 4); }
        u32x4 o; o.x = cvtpk(s[0 * 33] * ga[0], s[1 * 33] * ga[1]); o.y = cvtpk(s[2 * 33] * ga[2], s[3 * 33] * ga[3]); o.z = cvtpk(s[4 * 33] * gb[0], s[5 * 33] * gb[1]); o.w = cvtpk(s[6 * 33] * gb[2], s[7 * 33] * gb[3]);
        if (n0 + n < N) *(u32x4*)(WT + (size_t)rm(n0 + n) * K + k0 + 8 * c) = o; }
    LDS_WAIT(); asm volatile("" ::: "memory");
}
struct RmId { __device__ __forceinline__ int operator()(int n) const { return n; } };
struct RmWin { __device__ __forceinline__ int operator()(int n) const { return n < 3072 ? n : (n < 3088 ? 8192 + (n - 3072) : n - 16); } };

__device__ __forceinline__ void cvt_copy(Frame& F, const float* src, bf16_t* dst, size_t n) {
    const size_t nth = (size_t)F.G * 512, n8 = n / 8;
    for (size_t i = (size_t)F.vcu * 512 + F.tid; i < n8; i += nth) {
        const f32x4 a = *(const f32x4*)(src + i * 8), b = *(const f32x4*)(src + i * 8 + 4);
        u32x4 o; o.x = cvtpk(a[0], a[1]); o.y = cvtpk(a[2], a[3]); o.z = cvtpk(b[0], b[1]); o.w = cvtpk(b[2], b[3]);
        *(u32x4*)(dst + i * 8) = o; }
}
__device__ __forceinline__ void rms_row_to_bf16(const float* xrow, const float* g, bf16_t* orow, int lane) {
    f32x4 v[4]; float s = 0.f;
#pragma unroll
    for (int j = 0; j < 4; ++j) { v[j] = *((const f32x4*)xrow + lane + 64 * j); s += (v[j][0] * v[j][0] + v[j][1] * v[j][1]) + (v[j][2] * v[j][2] + v[j][3] * v[j][3]); }
    const float rstd = __builtin_amdgcn_rsqf(wave_sum(s) * (1.f / 1024.f) + EPS);
#pragma unroll
    for (int j = 0; j < 4; ++j) { const f32x4 gv = *((const f32x4*)g + lane + 64 * j); const f32x4 o = v[j] * rstd * gv;
        u32x2 w; w.x = cvtpk(o[0], o[1]); w.y = cvtpk(o[2], o[3]); *((u32x2*)orow + lane + 64 * j) = w; }
}
__device__ __forceinline__ void phase_prologue(Frame& F) {
    LAS float* scr = (LAS float*)(F.lds + RING_OFF + F.wave * 16384);
    const int gw = F.vcu * NWAVES + F.wave, NGW = F.G * NWAVES;
    constexpr int I_IN = 16 * 257, I_SQ = 16 * 32, I_PQ = 16 * 64, I_PLE = 4 * 32;
    constexpr int NITEMS = I_IN + 4 * I_SQ + I_PQ + I_PLE;
    for (int it = gw; it < NITEMS; it += NGW) {
        int r = it;
        if (r < I_IN) { p0_transpose_item(F.in[3], 1024, 8208, WSP(bf16_t, WS_WIN), RmWin(), scr, r, F.lane); continue; } r -= I_IN;
        if (r < I_SQ) { p0_transpose_item(F.in[7], 1024, 1024, WSP(bf16_t, WS_WGA), RmId(), scr, r, F.lane); continue; } r -= I_SQ;
        if (r < I_SQ) { p0_transpose_item(F.in[8], 1024, 1024, WSP(bf16_t, WS_WSB), RmId(), scr, r, F.lane); continue; } r -= I_SQ;
        if (r < I_SQ) { p0_transpose_item(F.in[9], 1024, 1024, WSP(bf16_t, WS_WO), RmId(), scr, r, F.lane); continue; } r -= I_SQ;
        if (r < I_SQ) { p0_transpose_item(F.in[17], 1024, 1024, WSP(bf16_t, WS_WPG), RmId(), scr, r, F.lane, F.in[16]); continue; } r -= I_SQ;
        if (r < I_PQ) { p0_transpose_item(F.in[11], 1024, 2048, WSP(bf16_t, WS_WPQ), RmId(), scr, r, F.lane, F.in[10]); continue; } r -= I_PQ;
        p0_transpose_item(F.in[18], 256, 1024, WSP(bf16_t, WS_WPLE), RmId(), scr, r, F.lane);
    }
    { const float* k1 = F.in[12]; const float* k2 = F.in[13]; bf16_t* KB = WSP(bf16_t, WS_KD);
      for (int i = F.vcu * 512 + F.tid; i < 2 * 8 * 128 * 16; i += F.G * 512) { const int half = i >> 14, rem = i & 16383, h = rem >> 11, r8 = rem & 2047;
          const float* s = (half ? k2 : k1) + (size_t)h * 16384 + (size_t)r8 * 8; const f32x4 a = *(const f32x4*)s, b = *(const f32x4*)(s + 4);
          u32x4 o; o.x = cvtpk(a[0], a[1]); o.y = cvtpk(a[2], a[3]); o.z = cvtpk(b[0], b[1]); o.w = cvtpk(b[2], b[3]);
          *(u32x4*)(KB + (size_t)(h * 2 + half) * 16384 + (size_t)r8 * 8) = o; } }
    for (int m = gw; m < T_TOK; m += 4 * NGW) {
        f32x4 v[4][4]; float s[4];
#pragma unroll
        for (int q = 0; q < 4; ++q) { const float* xr = F.in[0] + (size_t)(m + q * NGW) * 1024; s[q] = 0.f;
#pragma unroll
            for (int j = 0; j < 4; ++j) { v[q][j] = *((const f32x4*)xr + F.lane + 64 * j); s[q] += (v[q][j][0] * v[q][j][0] + v[q][j][1] * v[q][j][1]) + (v[q][j][2] * v[q][j][2] + v[q][j][3] * v[q][j][3]); } }
#pragma unroll
        for (int o = 1; o < 64; o <<= 1) {
#pragma unroll
            for (int q = 0; q < 4; ++q) s[q] += __shfl_xor(s[q], o); }
#pragma unroll
        for (int q = 0; q < 4; ++q) { const float rstd = __builtin_amdgcn_rsqf(s[q] * (1.f / 1024.f) + EPS); bf16_t* orow = WSP(bf16_t, WS_XN1) + (size_t)(m + q * NGW) * 1024;
#pragma unroll
            for (int j = 0; j < 4; ++j) { const f32x4 gv = *((const f32x4*)F.in[2] + F.lane + 64 * j); const f32x4 o = v[q][j] * rstd * gv;
                u32x2 wq; wq.x = cvtpk(o[0], o[1]); wq.y = cvtpk(o[2], o[3]); *((u32x2*)orow + F.lane + 64 * j) = wq; } }
    }
}

__device__ __forceinline__ void phase_gla_prep(Frame& F) {
    LAS float* alo = (LAS float*)(F.lds + RING_OFF);
    const bf16_t* XN1 = WSP(bf16_t, WS_XN1); const bf16_t* WGAT = WSP(bf16_t, WS_WIN) + (size_t)8192 * 1024;
    bf16_t* GKT = WSP(bf16_t, WS_GK); float* GLAG = WSP(float, WS_GLAG);
    const float* w_up = F.in[4]; const float* b_a = F.in[5];
    const int tid = F.tid, lane = F.lane, w = F.wave;
    for (int u = F.vcu; u < 256; u += F.G) {
        const size_t r0 = (size_t)u * 64;
        __syncthreads();
        const int kk = tid;
        bf16_t* krow = GKT + (size_t)kk * T_TOK + r0;
        u32x4 kq[8];
#pragma unroll
        for (int j = 0; j < 8; ++j) kq[j] = *(const u32x4*)(krow + 8 * j);
        {
            LAS float* part = alo + 1024;
            const bf16_t* bp = WGAT + (size_t)(lane & 15) * 1024 + 8 * (lane >> 4) + 128 * w;
            bf16x8 bq[4];
#pragma unroll
            for (int s = 0; s < 4; ++s) bq[s] = *(const bf16x8*)(bp + 32 * s);
#pragma unroll
            for (int rt = 0; rt < 4; ++rt) { f32x4 acc = (f32x4){0.f, 0.f, 0.f, 0.f};
                const bf16_t* ap = XN1 + (r0 + 16 * rt + (lane & 15)) * 1024 + 8 * (lane >> 4) + 128 * w;
#pragma unroll
                for (int s = 0; s < 4; ++s) { const bf16x8 a = *(const bf16x8*)(ap + 32 * s); acc = __builtin_amdgcn_mfma_f32_16x16x32_bf16(a, bq[s], acc, 0, 0, 0); }
#pragma unroll
                for (int r = 0; r < 4; ++r) part[w * 1024 + (16 * rt + 4 * (lane >> 4) + r) * 16 + (lane & 15)] = acc[r]; }
            __syncthreads();
#pragma unroll
            for (int q = 0; q < 2; ++q) { const int e = tid + 512 * q; float s = 0.f;
#pragma unroll
                for (int ww = 0; ww < 8; ++ww) s += part[ww * 1024 + e];
                alo[e] = s; }
        }
        float wv[16];
#pragma unroll
        for (int r = 0; r < 16; ++r) wv[r] = w_up[r * 512 + kk];
        const float bias = b_a[kk];
        __syncthreads();
        float suffix = 0.f;
#pragma unroll
        for (int i8 = 7; i8 >= 0; --i8) {
            const unsigned kw[4] = {kq[i8].x, kq[i8].y, kq[i8].z, kq[i8].w};
            float o[8];
#pragma unroll
            for (int j = 7; j >= 0; --j) { const int i = i8 * 8 + j;
                const f32x4 a0 = *(const LAS f32x4*)(alo + i * 16), a1 = *(const LAS f32x4*)(alo + i * 16 + 4), a2 = *(const LAS f32x4*)(alo + i * 16 + 8), a3 = *(const LAS f32x4*)(alo + i * 16 + 12);
                float x = bias;
                x += a0[0] * wv[0] + a0[1] * wv[1] + a0[2] * wv[2] + a0[3] * wv[3];
                x += a1[0] * wv[4] + a1[1] * wv[5] + a1[2] * wv[6] + a1[3] * wv[7];
                x += a2[0] * wv[8] + a2[1] * wv[9] + a2[2] * wv[10] + a2[3] * wv[11];
                x += a3[0] * wv[12] + a3[1] * wv[13] + a3[2] * wv[14] + a3[3] * wv[15];
                const float la = (fminf(x, 0.f) - __logf(1.0f + __expf(-fabsf(x)))) * (1.0f / 16.0f);
                const float kvv = (j & 1) ? bf_hi(kw[j >> 1]) : bf_lo(kw[j >> 1]);
                o[j] = kvv * __expf(suffix);
                suffix += la; }
            u32x4 pk; pk.x = cvtpk(o[0], o[1]); pk.y = cvtpk(o[2], o[3]); pk.z = cvtpk(o[4], o[5]); pk.w = cvtpk(o[6], o[7]);
            if (!F.dry) *(u32x4*)(krow + i8 * 8) = pk; }
        GLAG[(size_t)u * 512 + kk] = __expf(suffix);
    }
}
constexpr int GL_KD = 0, GL_Q = 32768, GL_G = 65536, GL_RED = 65536 + 1024;
__device__ __forceinline__ int gl_kd_off(int row, int chunk) { return row * 128 + ((chunk ^ ((row >> 1) & 7)) << 4); }
__device__ __forceinline__ int gl_q_off(int row, int chunk16) { return row * 256 + ((chunk16 ^ (row & 15)) << 4); }

struct GlaStage { u32x4 kd[2]; u32x4 q[2]; bf16x8 vt[4]; float g; };
__device__ __forceinline__ void gla_prefetch_vt(Frame& F, GlaStage& st, int b, int h, int c) {
    const int u = b * 64 + c; const size_t r0 = (size_t)u * 64; const int w = F.wave, lq = F.lane & 31, hh = F.lane >> 5;
    const bf16_t* vt = WSP(bf16_t, WS_GV) + (size_t)(h * 256 + 32 * w + lq) * T_TOK + r0;
#pragma unroll
    for (int ts = 0; ts < 4; ++ts) st.vt[ts] = *(const bf16x8*)(vt + 16 * ts + 8 * hh);
}
template <bool WITH_Q>
__device__ __forceinline__ void gla_prefetch(Frame& F, GlaStage& st, int b, int h, int c) {
    const int u = b * 64 + c; const size_t r0 = (size_t)u * 64; const int tid = F.tid;
    const bf16_t* kd = WSP(bf16_t, WS_GK) + (size_t)(h * 128) * T_TOK + r0;
#pragma unroll
    for (int j = 0; j < 2; ++j) { const int pi = tid + 512 * j; st.kd[j] = *(const u32x4*)(kd + (size_t)(pi >> 3) * T_TOK + (pi & 7) * 8); }
    if (WITH_Q) { const bf16_t* gq = WSP(bf16_t, WS_GQ) + r0 * 512 + h * 128;
#pragma unroll
        for (int j = 0; j < 2; ++j) { const int pi = tid + 512 * j; st.q[j] = *(const u32x4*)(gq + (size_t)(pi >> 4) * 512 + (pi & 15) * 8); } }
    st.g = (tid < 128) ? WSP(float, WS_GLAG)[((size_t)u * 4 + h) * 128 + tid] : 1.f;
}
template <bool WITH_Q>
__device__ __forceinline__ void gla_stage_write(Frame& F, const GlaStage& st, int buf) {
    LAS unsigned char* lds = F.lds + RING_OFF; const int tid = F.tid;
#pragma unroll
    for (int j = 0; j < 2; ++j) { const int pi = tid + 512 * j; *(LAS u32x4*)(lds + GL_KD + buf * 16384 + gl_kd_off(pi >> 3, pi & 7)) = st.kd[j]; }
    if (WITH_Q) {
#pragma unroll
        for (int j = 0; j < 2; ++j) { const int pi = tid + 512 * j; *(LAS u32x4*)(lds + GL_Q + buf * 16384 + gl_q_off(pi >> 4, pi & 15)) = st.q[j]; } }
    if (tid < 128) *(LAS float*)(lds + GL_G + buf * 512 + tid * 4) = st.g;
}
__device__ __forceinline__ void gla_update(Frame& F, f32x16 (&S)[4], const bf16x8 (&vt)[4], int buf) {
    const LAS unsigned char* lds = F.lds + RING_OFF; const int lq = F.lane & 31, hh = F.lane >> 5;
    const LAS float* G = (const LAS float*)(lds + GL_G + buf * 512);
#pragma unroll
    for (int kt = 0; kt < 4; ++kt)
#pragma unroll
        for (int g4 = 0; g4 < 4; ++g4) { const f32x4 g = *(const LAS f32x4*)(G + 32 * kt + 8 * g4 + 4 * hh);
#pragma unroll
            for (int j = 0; j < 4; ++j) S[kt][4 * g4 + j] *= g[j]; }
#pragma unroll
    for (int ts = 0; ts < 4; ++ts)
#pragma unroll
        for (int kt = 0; kt < 4; ++kt) { const bf16x8 a = *(const LAS bf16x8*)(lds + GL_KD + buf * 16384 + gl_kd_off(32 * kt + lq, 2 * ts + hh));
            S[kt] = __builtin_amdgcn_mfma_f32_32x32x16_bf16(a, vt[ts], S[kt], 0, 0, 0); if (kt == 3 && (ts & 1)) __builtin_amdgcn_sched_barrier(0); }
}
constexpr size_t SEND_WAVE_FLOATS = 4 * 4 * 64 * 4;
__device__ __forceinline__ void gla_stage1(Frame& F, int unit) {
    const int bh = unit >> 3, seg = unit & 7, b = bh >> 2, h = bh & 3, w = F.wave, l = F.lane;
    f32x16 S[4];
#pragma unroll
    for (int kt = 0; kt < 4; ++kt)
#pragma unroll
        for (int r = 0; r < 16; ++r) S[kt][r] = 0.f;
    float pend = 1.f;
    GlaStage st; gla_prefetch<false>(F, st, b, h, seg * 8); gla_prefetch_vt(F, st, b, h, seg * 8);
    for (int ci = 0; ci < 8; ++ci) {
        gla_stage_write<false>(F, st, ci & 1); pend *= st.g;
        __syncthreads();
        if (ci < 7) gla_prefetch<false>(F, st, b, h, seg * 8 + ci + 1);
        gla_update(F, S, st.vt, ci & 1);
        if (ci < 7) gla_prefetch_vt(F, st, b, h, seg * 8 + ci + 1);
    }
    float* se = WSP(float, WS_SEND) + ((size_t)unit * 8 + w) * SEND_WAVE_FLOATS;
#pragma unroll
    for (int kt = 0; kt < 4; ++kt)
#pragma unroll
        for (int g4 = 0; g4 < 4; ++g4) *(f32x4*)(se + ((kt * 4 + g4) * 64 + l) * 4) = (f32x4){S[kt][4 * g4], S[kt][4 * g4 + 1], S[kt][4 * g4 + 2], S[kt][4 * g4 + 3]};
    if (F.tid < 128) WSP(float, WS_PEND)[unit * 128 + F.tid] = pend;
    __syncthreads();
}
__device__ __forceinline__ void gla_stage3(Frame& F, int unit) {
    const int bh = unit >> 3, seg = unit & 7, b = bh >> 2, h = bh & 3, w = F.wave, l = F.lane, lq = l & 31, hh = l >> 5;
    LAS unsigned char* lds = F.lds + RING_OFF;
    const bf16_t* GR = WSP(bf16_t, WS_GR); bf16_t* GLAN = WSP(bf16_t, WS_GLAN); const float* g_o = F.in[6];
    f32x16 S[4];
#pragma unroll
    for (int kt = 0; kt < 4; ++kt)
#pragma unroll
        for (int r = 0; r < 16; ++r) S[kt][r] = 0.f;
    GlaStage st; gla_prefetch<true>(F, st, b, h, seg * 8); gla_prefetch_vt(F, st, b, h, seg * 8);
    for (int sp = 0; sp < seg; ++sp) {
        const int un = bh * 8 + sp; const float* se = WSP(float, WS_SEND) + ((size_t)un * 8 + w) * SEND_WAVE_FLOATS; const float* pe = WSP(float, WS_PEND) + un * 128;
#pragma unroll
        for (int kt = 0; kt < 4; ++kt)
#pragma unroll
            for (int g4 = 0; g4 < 4; ++g4) { const f32x4 p = *(const f32x4*)(pe + 32 * kt + 8 * g4 + 4 * hh); const f32x4 s = *(const f32x4*)(se + ((kt * 4 + g4) * 64 + l) * 4);
#pragma unroll
                for (int j = 0; j < 4; ++j) S[kt][4 * g4 + j] = S[kt][4 * g4 + j] * p[j] + s[j]; }
    }
    for (int ci = 0; ci < 8; ++ci) {
        const int c = seg * 8 + ci; const size_t r0 = (size_t)(b * 64 + c) * 64; const int buf = ci & 1;
        gla_stage_write<true>(F, st, buf);
        __syncthreads();
        if (ci < 7) gla_prefetch<true>(F, st, b, h, c + 1);
        gla_update(F, S, st.vt, buf);
        f32x16 oT[2];
#pragma unroll
        for (int tt = 0; tt < 2; ++tt) {
#pragma unroll
            for (int r = 0; r < 16; ++r) oT[tt][r] = 0.f;
            const int t = 32 * tt + lq;
#pragma unroll
            for (int kt = 0; kt < 4; ++kt)
#pragma unroll
                for (int s = 0; s < 2; ++s) {
                    u32x4 aw; aw.x = cvtpk(S[kt][8 * s + 0], S[kt][8 * s + 1]); aw.y = cvtpk(S[kt][8 * s + 2], S[kt][8 * s + 3]); aw.z = cvtpk(S[kt][8 * s + 4], S[kt][8 * s + 5]); aw.w = cvtpk(S[kt][8 * s + 6], S[kt][8 * s + 7]);
                    const u32x2 qlo = *(const LAS u32x2*)(lds + GL_Q + buf * 16384 + gl_q_off(t, 4 * kt + 2 * s) + 8 * hh), qhi = *(const LAS u32x2*)(lds + GL_Q + buf * 16384 + gl_q_off(t, 4 * kt + 2 * s + 1) + 8 * hh);
                    const u32x4 bw = (u32x4){qlo.x, qlo.y, qhi.x, qhi.y};
                    oT[tt] = __builtin_amdgcn_mfma_f32_32x32x16_bf16(__builtin_bit_cast(bf16x8, aw), __builtin_bit_cast(bf16x8, bw), oT[tt], 0, 0, 0);
                    if (s == 1 && (kt & 1)) __builtin_amdgcn_sched_barrier(0); }
        }
        LAS float* redc = (LAS float*)(lds + GL_RED) + buf * 512;
#pragma unroll
        for (int tt = 0; tt < 2; ++tt) { float s = 0.f;
#pragma unroll
            for (int r = 0; r < 16; ++r) s += oT[tt][r] * oT[tt][r];
            s += __shfl_xor(s, 32);
            if (hh == 0) redc[w * 64 + 32 * tt + lq] = s; }
        if (ci < 7) gla_prefetch_vt(F, st, b, h, c + 1);
        u32x2 sr[2][4];
#pragma unroll
        for (int tt = 0; tt < 2; ++tt)
#pragma unroll
            for (int g4 = 0; g4 < 4; ++g4) sr[tt][g4] = *(const u32x2*)(GR + (r0 + 32 * tt + lq) * 1024 + h * 256 + 32 * w + 8 * g4 + 4 * hh);
        __syncthreads();
#pragma unroll
        for (int tt = 0; tt < 2; ++tt) { float tot = 0.f;
#pragma unroll
            for (int ww = 0; ww < 8; ++ww) tot += redc[ww * 64 + 32 * tt + lq];
            const float rstd = __builtin_amdgcn_rsqf(tot * (1.0f / 256.0f) + EPS);
            const size_t row = r0 + 32 * tt + lq;
#pragma unroll
            for (int g4 = 0; g4 < 4; ++g4) { const int v0 = h * 256 + 32 * w + 8 * g4 + 4 * hh;
                const f32x4 go = *(const f32x4*)(g_o + v0);
                const float o0 = oT[tt][4 * g4 + 0] * rstd * go[0] * bf_lo(sr[tt][g4].x), o1 = oT[tt][4 * g4 + 1] * rstd * go[1] * bf_hi(sr[tt][g4].x);
                const float o2 = oT[tt][4 * g4 + 2] * rstd * go[2] * bf_lo(sr[tt][g4].y), o3 = oT[tt][4 * g4 + 3] * rstd * go[3] * bf_hi(sr[tt][g4].y);
                u32x2 wv; wv.x = cvtpk(o0, o1); wv.y = cvtpk(o2, o3); if (!F.dry) *(u32x2*)(GLAN + row * 1024 + v0) = wv; } }
    }
    __syncthreads();
}

constexpr int SB_TILE = 16384, SB_FLAG = 7 * SB_TILE;
typedef short v4i16_t __attribute__((ext_vector_type(4)));
__device__ __forceinline__ s16x4 vtr(const LAS unsigned char* p) { return __builtin_bit_cast(s16x4, __builtin_amdgcn_ds_read_tr16_b64_v4i16((LAS v4i16_t*)p)); }
__device__ __forceinline__ float partner32(float x, int hh) { auto rr = __builtin_amdgcn_permlane32_swap(__float_as_uint(x), __float_as_uint(x), false, false); return __uint_as_float(hh ? rr[0] : rr[1]); }
__device__ __forceinline__ int sbk_off(int key, int chunk) { return key * 128 + ((chunk ^ ((key >> 1) & 7)) << 4); }
__device__ __forceinline__ int sbv_off(int key, int chunk) { return 8192 + key * 128 + ((chunk ^ (((key >> 1) & 1) << 2)) << 4); }

template <bool DIAG>
__device__ __forceinline__ void sb_tile_t(const LAS unsigned char* tile, int kt, int qabs, int l, const bf16x8 (&qf)[4], f32x16& o0, f32x16& o1, float& carry) {
    const int lq = l & 31, hh = l >> 5, g1 = (l >> 4) & 1, i = l & 15;
    float run = carry;
#pragma unroll
    for (int half = 1; half >= 0; --half) {
        f32x16 p;
#pragma unroll
        for (int r = 0; r < 16; ++r) p[r] = 0.f;
#pragma unroll
        for (int s = 0; s < 4; ++s) { const bf16x8 a = *(const LAS bf16x8*)(tile + sbk_off(32 * half + lq, 2 * s + hh)); p = __builtin_amdgcn_mfma_f32_32x32x16_bf16(a, qf[s], p, 0, 0, 0); }
        float st[16], be[16];
#pragma unroll
        for (int r = 0; r < 16; ++r) { const float ee = __builtin_amdgcn_exp2f(fminf(p[r], 80.0f)); float s_ = __builtin_amdgcn_rcpf(1.0f + ee); float b_ = ee * s_;
            if (DIAG) { const int key = 64 * kt + 32 * half + (r & 3) + 8 * (r >> 2) + 4 * hh; if (key >= qabs) { s_ = 1.0f; b_ = 0.f; } }
            st[r] = s_; be[r] = b_; }
        float tot[4];
#pragma unroll
        for (int g4 = 0; g4 < 4; ++g4) { float* sg = &st[4 * g4]; float* bg = &be[4 * g4];
            const float a2 = sg[3], a1 = sg[2] * a2, a0 = sg[1] * a1; tot[g4] = sg[0] * a0;
            bg[2] *= a2; bg[1] *= a1; bg[0] *= a0; }
        float E[4];
#pragma unroll
        for (int m = 3; m >= 0; --m) { const float tp = partner32(tot[m], hh); E[m] = hh ? run : run * tp; run *= tot[m] * tp; }
        u32x4 pw[2];
#pragma unroll
        for (int s = 0; s < 2; ++s) { float wv[8];
#pragma unroll
            for (int j = 0; j < 8; ++j) { const int r = 8 * s + j; wv[j] = be[r] * E[r >> 2]; }
            pw[s] = (u32x4){cvtpk(wv[0], wv[1]), cvtpk(wv[2], wv[3]), cvtpk(wv[4], wv[5]), cvtpk(wv[6], wv[7])}; }
#pragma unroll
        for (int s = 0; s < 2; ++s) { const bf16x8 pb = __builtin_bit_cast(bf16x8, pw[s]);
            const int k0 = 32 * half + 16 * s + 4 * hh + (i >> 2), k1 = k0 + 8;
#pragma unroll
            for (int dt = 0; dt < 2; ++dt) { const int ch = 4 * dt + 2 * g1 + ((i & 3) >> 1);
                const s16x4 lo = vtr(tile + sbv_off(k0, ch) + 8 * (i & 1)), hi = vtr(tile + sbv_off(k1, ch) + 8 * (i & 1));
                const bf16x8 a = (bf16x8){lo[0], lo[1], lo[2], lo[3], hi[0], hi[1], hi[2], hi[3]};
                if (dt == 0) o0 = __builtin_amdgcn_mfma_f32_32x32x16_bf16(a, pb, o0, 0, 0, 0); else o1 = __builtin_amdgcn_mfma_f32_32x32x16_bf16(a, pb, o1, 0, 0, 0); } }
        if (half == 1 && __all(run == 0.0f)) break;
    }
    carry = run;
}
__device__ __forceinline__ void sb_tile(const LAS unsigned char* tile, int kt, int q0, int qabs, int l, const bf16x8 (&qf)[4], f32x16& o0, f32x16& o1, float& carry) {
    if (64 * kt + 63 >= q0) sb_tile_t<true>(tile, kt, qabs, l, qf, o0, o1, carry); else sb_tile_t<false>(tile, kt, qabs, l, qf, o0, o1, carry);
}
__device__ __forceinline__ void sb_attn_unit(Frame& F, int uidx) {
    const int bh = uidx >> 4, qb = uidx & 15, b = bh >> 4, h = bh & 15;
    LAS unsigned char* lds = F.lds + RING_OFF;
    volatile LAS unsigned* flags = (volatile LAS unsigned*)(lds + SB_FLAG);
    const int tid = F.tid, w = F.wave, l = F.lane, lq = l & 31, hh = l >> 5;
    bf16_t* SQ = WSP(bf16_t, WS_SQ); const bf16_t* SK = WSP(bf16_t, WS_SK); const bf16_t* SV = WSP(bf16_t, WS_SV);
    const size_t rowbase = (size_t)b * SEQ;
    const int q0 = qb * 256 + 32 * w, qabs = q0 + lq;
    const int kt_hi = qb * 4 + 3, kt_lo = (qb * 4 - 3) > 0 ? (qb * 4 - 3) : 0, nwin = kt_hi - kt_lo + 1;
    const int skey = tid >> 3, sch = tid & 7;
    const bf16_t* kgd = SK + (rowbase + skey) * 1024 + h * 64 + ((sch ^ ((skey >> 1) & 7)) * 8);
    const bf16_t* vgd = SV + (rowbase + skey) * 1024 + h * 64 + ((sch ^ (((skey >> 1) & 1) << 2)) * 8);
    __syncthreads();
#pragma unroll
    for (int j = 0; j < 7; ++j) if (j < nwin) {
        __builtin_amdgcn_global_load_lds((const unsigned*)(kgd + (size_t)(kt_lo + j) * 64 * 1024), (LAS unsigned*)(lds + j * SB_TILE + w * 1024), 16, 0, 0);
        __builtin_amdgcn_global_load_lds((const unsigned*)(vgd + (size_t)(kt_lo + j) * 64 * 1024), (LAS unsigned*)(lds + j * SB_TILE + 8192 + w * 1024), 16, 0, 0); }
    bf16x8 qf[4];
    { const bf16_t* qrow = SQ + (rowbase + qabs) * 1024 + h * 64;
#pragma unroll
      for (int s = 0; s < 4; ++s) qf[s] = *(const bf16x8*)(qrow + 16 * s + 8 * hh); }
    f32x16 o0, o1;
#pragma unroll
    for (int r = 0; r < 16; ++r) { o0[r] = 0.f; o1[r] = 0.f; }
    float carry = 1.0f;
    VM_WAIT(); __syncthreads();
    bool done = false;
    for (int kt = (q0 + 30) >> 6; kt >= kt_lo; --kt) {
        sb_tile(lds + (kt - kt_lo) * SB_TILE, kt, q0, qabs, l, qf, o0, o1, carry);
        if (__all(carry == 0.0f)) { done = true; break; }
    }
    if (kt_lo == 0) done = true;
    if (l == 0) flags[w] = done ? 1u : 0u;
    __syncthreads();
    bool alld = true;
#pragma unroll
    for (int i = 0; i < 8; ++i) alld = alld && (flags[i] != 0u);
    if (!alld) {
        const bf16_t* kg = SK + (rowbase + skey) * 1024 + h * 64 + sch * 8;
        const bf16_t* vg = SV + (rowbase + skey) * 1024 + h * 64 + sch * 8;
        for (int kt = kt_lo - 1; kt >= 0; --kt) {
            const u32x4 kr = *(const u32x4*)(kg + (size_t)kt * 64 * 1024), vr = *(const u32x4*)(vg + (size_t)kt * 64 * 1024);
            __syncthreads();
            { unsigned a = 1u;
#pragma unroll
              for (int i = 0; i < 8; ++i) a &= flags[i];
              if (a) break; }
            *(LAS u32x4*)(lds + sbk_off(skey, sch)) = kr; *(LAS u32x4*)(lds + sbv_off(skey, sch)) = vr;
            __syncthreads();
            if (!done) { sb_tile(lds, kt, q0, qabs, l, qf, o0, o1, carry); if (__all(carry == 0.0f) || kt == 0) done = true; }
            if (l == 0) flags[w] = done ? 1u : 0u;
        }
    }
    if (!F.dry) { bf16_t* orow = SQ + (rowbase + qabs) * 1024 + h * 64;
#pragma unroll
      for (int g4 = 0; g4 < 4; ++g4) { u32x2 a, c2; a.x = cvtpk(o0[4 * g4], o0[4 * g4 + 1]); a.y = cvtpk(o0[4 * g4 + 2], o0[4 * g4 + 3]); c2.x = cvtpk(o1[4 * g4], o1[4 * g4 + 1]); c2.y = cvtpk(o1[4 * g4 + 2], o1[4 * g4 + 3]);
          *(u32x2*)(orow + 8 * g4 + 4 * hh) = a; *(u32x2*)(orow + 32 + 8 * g4 + 4 * hh) = c2; } }
}
#define CVT8_PK(V, S, W) do { int _x = __builtin_amdgcn_cvt_pk_fp8_f32((V)[0] * (S), (V)[1] * (S), 0, false); _x = __builtin_amdgcn_cvt_pk_fp8_f32((V)[2] * (S), (V)[3] * (S), _x, true); (W) = (unsigned)_x; } while (0)
__device__ __forceinline__ float absmax4(const f32x4& a) { return fmaxf(fmaxf(fabsf(a[0]), fabsf(a[1])), fmaxf(fabsf(a[2]), fabsf(a[3]))); }
constexpr int CVT8_UNITS = 256;
#ifndef QCONV
#define QCONV 1
#endif
__device__ __forceinline__ void cvt_fp8_unit(Frame& F, int cu) {
    const int l = F.lane, r0 = cu * 128 + F.wave * 16;
    const bool isv = r0 >= 16384; const int e0 = r0 & 16383;
    const float* src = isv ? F.in[15] : F.in[14]; unsigned char* dst = WSP(unsigned char, isv ? WS_VB8 : WS_UB8); float* rscale = WSP(float, isv ? WS_RSV : WS_RSU);
#pragma unroll 1
    for (int it = 0; it < 4; ++it) {
        f32x4 v[4][4]; float m[4];
#pragma unroll
        for (int q = 0; q < 4; ++q) { const f32x4* sp = (const f32x4*)(src + (size_t)(e0 + 4 * it + q) * 1024) + l;
#pragma unroll
            for (int j = 0; j < 4; ++j) v[q][j] = sp[64 * j]; }
#pragma unroll
        for (int q = 0; q < 4; ++q) m[q] = fmaxf(fmaxf(absmax4(v[q][0]), absmax4(v[q][1])), fmaxf(absmax4(v[q][2]), absmax4(v[q][3])));
#pragma unroll
        for (int o = 1; o < 64; o <<= 1) {
#pragma unroll
            for (int q = 0; q < 4; ++q) m[q] = fmaxf(m[q], __shfl_xor(m[q], o)); }
#pragma unroll
        for (int q = 0; q < 4; ++q) { const int e = e0 + 4 * it + q;
            const float t = 448.0f / fmaxf(m[q], 1e-30f); const float s = __uint_as_float(__float_as_uint(t) & 0x7f800000u);
            unsigned w[4]; CVT8_PK(v[q][0], s, w[0]); CVT8_PK(v[q][1], s, w[1]); CVT8_PK(v[q][2], s, w[2]); CVT8_PK(v[q][3], s, w[3]);
            if (!F.dry) { unsigned* dp = (unsigned*)(dst + (size_t)e * 1024) + l;
#pragma unroll
                for (int j = 0; j < 4; ++j) dp[64 * j] = w[j];
                if (l == 0) rscale[e] = 1.0f / s; } }
    }
}
__device__ __forceinline__ void sb_units_dyn(Frame& F, unsigned* ctr, int sb_lo, int nsb, int conv_lo) {
    volatile LAS int* slot = (volatile LAS int*)(F.lds + MISC_OFF + 64);
    const int total = QCONV ? nsb + (nsb >> 2) : nsb;
    __syncthreads();
    if (F.tid == 0) *slot = (int)__hip_atomic_fetch_add(ctr, 1u, __ATOMIC_RELAXED, __HIP_MEMORY_SCOPE_AGENT);
    __syncthreads();
    int i = *slot;
    while (i < total) {
        int nxt = 0;
        if (F.tid == 0) nxt = (int)__hip_atomic_fetch_add(ctr, 1u, __ATOMIC_RELAXED, __HIP_MEMORY_SCOPE_AGENT);
        if (QCONV) { const int g = i / 5, r = i - 5 * g; if (r < 4) sb_attn_unit(F, sb_lo + 4 * g + r); else cvt_fp8_unit(F, conv_lo + g); }
        else sb_attn_unit(F, sb_lo + i);
        __syncthreads();
        if (F.tid == 0) *slot = nxt;
        __syncthreads();
        i = *slot;
    }
}
__device__ __forceinline__ void phase_attn_a(Frame& F) {
#ifdef CONV_PROBE_NWG
    if (F.dry) {
        if (F.vcu < CONV_PROBE_NWG) { volatile LAS int* slot = (volatile LAS int*)(F.lds + MISC_OFF + 64); unsigned* ctr = (unsigned*)(F.ws + WS_CTL) + 64 + 16;
            for (;;) { __syncthreads(); if (F.tid == 0) *slot = (int)__hip_atomic_fetch_add(ctr, 1u, __ATOMIC_RELAXED, __HIP_MEMORY_SCOPE_AGENT); __syncthreads(); const int i = *slot; if (i >= CVT8_UNITS) break; cvt_fp8_unit(F, i); } }
        return; }
#endif
    if (F.vcu < 128) gla_stage1(F, F.vcu);
    sb_units_dyn(F, (unsigned*)(F.ws + WS_CTL) + 64 + 16 * F.dry, 0, 384, 0);
    __syncthreads();
}
__device__ __forceinline__ void phase_attn_b(Frame& F) {
    if (F.vcu < 128) gla_stage3(F, F.vcu);
    sb_units_dyn(F, (unsigned*)(F.ws + WS_CTL) + 128 + 16 * F.dry, 384, 640, 96);
    __syncthreads();
}
__device__ __forceinline__ int okey(float v, int tag, int mask) { int u = __float_as_int(v); u ^= (u >> 31) & 0x7fffffff; return (u & ~mask) | tag; }
__device__ __forceinline__ float okey_val(int key, int mask) { int u = key & ~mask; u ^= (u >> 31) & 0x7fffffff; return __int_as_float(u); }
#define INS16(Lst, xin) do { int _x = (xin); _Pragma("unroll") for (int _j = 0; _j < 16; ++_j) { const int _h = max(Lst[_j], _x); _x = min(Lst[_j], _x); Lst[_j] = _h; } } while (0)

#define CEX(a, b) do { const int _hi = max(a, b), _lo = min(a, b); a = _hi; b = _lo; } while (0)
#define BITONIC16(K) do { \
    _Pragma("unroll") for (int _i = 0; _i < 8; ++_i) CEX(K[_i], K[_i + 8]); \
    _Pragma("unroll") for (int _b = 0; _b < 16; _b += 8) _Pragma("unroll") for (int _i = 0; _i < 4; ++_i) CEX(K[_b + _i], K[_b + _i + 4]); \
    _Pragma("unroll") for (int _b = 0; _b < 16; _b += 4) _Pragma("unroll") for (int _i = 0; _i < 2; ++_i) CEX(K[_b + _i], K[_b + _i + 2]); \
    _Pragma("unroll") for (int _b = 0; _b < 16; _b += 2) CEX(K[_b], K[_b + 1]); } while (0)
#define CEXD(a, b, d) do { const int _hi = max(a, b), _lo = min(a, b); a = (d) ? _hi : _lo; b = (d) ? _lo : _hi; } while (0)
#define FULLSORT16(K) do { \
    _Pragma("unroll") for (int _k = 2; _k <= 16; _k <<= 1) _Pragma("unroll") for (int _j = _k >> 1; _j >= 1; _j >>= 1) _Pragma("unroll") for (int _i = 0; _i < 16; ++_i) { \
        const int _p = _i ^ _j; if (_p > _i) { const bool _desc = ((_i & _k) == 0); CEXD(K[_i], K[_p], _desc); } } } while (0)
__device__ __forceinline__ int swap32i(int x) { auto r = __builtin_amdgcn_permlane32_swap((unsigned)x, (unsigned)x, false, false); return (int)((__builtin_amdgcn_mbcnt_hi(~0u, __builtin_amdgcn_mbcnt_lo(~0u, 0u)) & 32) ? r[0] : r[1]); }

__device__ __forceinline__ void phase_peer_retrieve(Frame& F) {
    const bf16_t* Q = WSP(bf16_t, WS_Q); const bf16_t* KB = WSP(bf16_t, WS_KD); unsigned* EXPO = WSP(unsigned, WS_EXP);
    LAS unsigned char* idxb = F.lds + RING_OFF + F.wave * 2048;
    const int l = F.lane, lq = l & 31, hh = l >> 5;
    const int ntok_wg = T_TOK / F.G;
#pragma unroll 1
    for (int it = F.wave; it < (ntok_wg / 32) * 8; it += NWAVES) {
        const int tg = it >> 3, h = it & 7;
        const int t = F.vcu * ntok_wg + tg * 32 + lq;
        int XY[2][16];
#pragma unroll
        for (int half = 0; half < 2; ++half) {
            bf16x8 qf[8];
            { const bf16_t* qp = Q + (size_t)t * 2048 + h * 256 + half * 128 + 8 * hh;
#pragma unroll
              for (int s = 0; s < 8; ++s) qf[s] = *(const bf16x8*)(qp + 16 * s); }
            int L[16];
#pragma unroll
            for (int j = 0; j < 16; ++j) L[j] = INT_MIN;
            const bf16_t* kp = KB + (size_t)(h * 2 + half) * 16384 + (size_t)lq * 128 + 8 * hh;
#pragma unroll 1
            for (int tile = 0; tile < 4; ++tile) {
                f32x16 acc; int Tk[16];
#pragma unroll
                for (int r = 0; r < 16; ++r) acc[r] = 0.f;
#pragma unroll
                for (int s = 0; s < 8; ++s) { const bf16x8 a = *(const bf16x8*)(kp + (size_t)tile * 32 * 128 + 16 * s); acc = __builtin_amdgcn_mfma_f32_32x32x16_bf16(a, qf[s], acc, 0, 0, 0); }
#pragma unroll
                for (int r = 0; r < 16; ++r) { const int key = 32 * tile + (r & 3) + 8 * (r >> 2) + 4 * hh; Tk[r] = okey(acc[r], 127 - key, 127); }
                FULLSORT16(Tk);
#pragma unroll
                for (int k = 0; k < 16; ++k) L[k] = max(L[k], Tk[15 - k]);
                BITONIC16(L);
            }
#pragma unroll
            for (int k = 0; k < 8; ++k) { const int a = swap32i(L[15 - k]), b = swap32i(L[k]); L[k] = max(L[k], a); L[15 - k] = max(L[15 - k], b); }
            BITONIC16(L);
#pragma unroll
            for (int j = 0; j < 16; ++j) XY[half][j] = L[j];
        }
        { u32x4 pk[2];
#pragma unroll
          for (int half = 0; half < 2; ++half) { const int* L = XY[half];
            pk[half].x = (unsigned)(127 - (L[0] & 127)) | ((unsigned)(127 - (L[1] & 127)) << 8) | ((unsigned)(127 - (L[2] & 127)) << 16) | ((unsigned)(127 - (L[3] & 127)) << 24);
            pk[half].y = (unsigned)(127 - (L[4] & 127)) | ((unsigned)(127 - (L[5] & 127)) << 8) | ((unsigned)(127 - (L[6] & 127)) << 16) | ((unsigned)(127 - (L[7] & 127)) << 24);
            pk[half].z = (unsigned)(127 - (L[8] & 127)) | ((unsigned)(127 - (L[9] & 127)) << 8) | ((unsigned)(127 - (L[10] & 127)) << 16) | ((unsigned)(127 - (L[11] & 127)) << 24);
            pk[half].w = (unsigned)(127 - (L[12] & 127)) | ((unsigned)(127 - (L[13] & 127)) << 8) | ((unsigned)(127 - (L[14] & 127)) << 16) | ((unsigned)(127 - (L[15] & 127)) << 24); }
          *(LAS u32x4*)(idxb + l * 32) = pk[0]; *(LAS u32x4*)(idxb + l * 32 + 16) = pk[1]; }
        float X[16], Y[16];
#pragma unroll
        for (int j = 0; j < 16; ++j) { X[j] = okey_val(XY[0][j], 127); Y[j] = okey_val(XY[1][j], 127); }
        int M[16];
#pragma unroll
        for (int j = 0; j < 16; ++j) M[j] = INT_MIN;
#define CAND(i, j) do { const float sm = hh ? (X[j] + Y[i]) : (X[i] + Y[j]); const int pos = hh ? ((j) * 16 + (i)) : ((i) * 16 + (j)); int key = okey(sm, 255 - pos, 255); if ((i) == (j) && hh) key = INT_MIN; INS16(M, key); } while (0)
        CAND(0, 0); CAND(0, 1); CAND(0, 2); CAND(0, 3); CAND(0, 4); CAND(0, 5); CAND(0, 6); CAND(0, 7); CAND(0, 8); CAND(0, 9); CAND(0, 10); CAND(0, 11); CAND(0, 12); CAND(0, 13); CAND(0, 14); CAND(0, 15);
        CAND(1, 1); CAND(1, 2); CAND(1, 3); CAND(1, 4); CAND(1, 5); CAND(1, 6); CAND(1, 7);
        CAND(2, 2); CAND(2, 3); CAND(2, 4);
        CAND(3, 3);
#undef CAND
        int TK[16];
#pragma unroll
        for (int k = 0; k < 16; ++k) TK[k] = max(M[k], swap32i(M[15 - k]));
        float sv[16]; float mx = -INFINITY;
#pragma unroll
        for (int k = 0; k < 16; ++k) { sv[k] = okey_val(TK[k], 255); mx = fmaxf(mx, sv[k]); }
        float den = 0.f;
#pragma unroll
        for (int k = 0; k < 16; ++k) { sv[k] = __expf(sv[k] - mx); den += sv[k]; }
        const float rden = 1.0f / den;
        LDS_WAIT(); asm volatile("" ::: "memory");
        const LAS unsigned char* ib = idxb + l * 32;
        unsigned* dst = EXPO + (size_t)t * 128 + h * 16 + hh * 8;
        u32x4 o0, o1; unsigned ov[8];
#pragma unroll
        for (int k = 0; k < 8; ++k) { const int pos = 255 - (TK[k] & 255); const unsigned i1 = ib[pos >> 4], i2 = ib[16 + (pos & 15)];
            ov[k] = (__float_as_uint(sv[k] * rden) & ~0x3fffu) | (i1 * 128u + i2); }
        o0 = (u32x4){ov[0], ov[1], ov[2], ov[3]}; o1 = (u32x4){ov[4], ov[5], ov[6], ov[7]};
        *(u32x4*)dst = o0; *(u32x4*)(dst + 4) = o1;
        LDS_WAIT(); asm volatile("" ::: "memory");
    }
}

__device__ __forceinline__ void cvt_rows_fp8(Frame& F, const float* src, unsigned char* dst, float* rscale) {
    const int l = F.lane; const int gw = F.vcu * NWAVES + F.wave, NGW = F.G * NWAVES;
    for (int e = gw; e < 16384; e += NGW) {
        const f32x4* sp = (const f32x4*)(src + (size_t)e * 1024 + 16 * l);
        const f32x4 a = sp[0], b = sp[1], c = sp[2], d = sp[3];
        float m = fmaxf(fmaxf(fmaxf(fabsf(a[0]), fabsf(a[1])), fmaxf(fabsf(a[2]), fabsf(a[3]))), fmaxf(fmaxf(fabsf(b[0]), fabsf(b[1])), fmaxf(fabsf(b[2]), fabsf(b[3]))));
        m = fmaxf(m, fmaxf(fmaxf(fmaxf(fabsf(c[0]), fabsf(c[1])), fmaxf(fabsf(c[2]), fabsf(c[3]))), fmaxf(fmaxf(fabsf(d[0]), fabsf(d[1])), fmaxf(fabsf(d[2]), fabsf(d[3])))));
#pragma unroll
        for (int o = 1; o < 64; o <<= 1) m = fmaxf(m, __shfl_xor(m, o));
        const float t = 448.0f / fmaxf(m, 1e-30f); const float s = __uint_as_float(__float_as_uint(t) & 0x7f800000u);
        u32x4 w; int x;
        x = __builtin_amdgcn_cvt_pk_fp8_f32(a[0] * s, a[1] * s, 0, false); x = __builtin_amdgcn_cvt_pk_fp8_f32(a[2] * s, a[3] * s, x, true); w.x = (unsigned)x;
        x = __builtin_amdgcn_cvt_pk_fp8_f32(b[0] * s, b[1] * s, 0, false); x = __builtin_amdgcn_cvt_pk_fp8_f32(b[2] * s, b[3] * s, x, true); w.y = (unsigned)x;
        x = __builtin_amdgcn_cvt_pk_fp8_f32(c[0] * s, c[1] * s, 0, false); x = __builtin_amdgcn_cvt_pk_fp8_f32(c[2] * s, c[3] * s, x, true); w.z = (unsigned)x;
        x = __builtin_amdgcn_cvt_pk_fp8_f32(d[0] * s, d[1] * s, 0, false); x = __builtin_amdgcn_cvt_pk_fp8_f32(d[2] * s, d[3] * s, x, true); w.w = (unsigned)x;
        *(u32x4*)(dst + (size_t)e * 1024 + 16 * l) = w;
        if (l == 0) rscale[e] = 1.0f / s;
    }
}

__device__ __forceinline__ float gelu_tanh(float x) { const float y = 0.7978845608028654f * (x + 0.044715f * x * x * x); return x * __builtin_amdgcn_rcpf(1.0f + __expf(-2.0f * y)); }
#define FP8_UNPACK16(W, f) do { f32x2 _t; \
    _t = __builtin_amdgcn_cvt_pk_f32_fp8((int)(W).x, false); f[0] = _t[0]; f[1] = _t[1]; _t = __builtin_amdgcn_cvt_pk_f32_fp8((int)(W).x, true); f[2] = _t[0]; f[3] = _t[1]; \
    _t = __builtin_amdgcn_cvt_pk_f32_fp8((int)(W).y, false); f[4] = _t[0]; f[5] = _t[1]; _t = __builtin_amdgcn_cvt_pk_f32_fp8((int)(W).y, true); f[6] = _t[0]; f[7] = _t[1]; \
    _t = __builtin_amdgcn_cvt_pk_f32_fp8((int)(W).z, false); f[8] = _t[0]; f[9] = _t[1]; _t = __builtin_amdgcn_cvt_pk_f32_fp8((int)(W).z, true); f[10] = _t[0]; f[11] = _t[1]; \
    _t = __builtin_amdgcn_cvt_pk_f32_fp8((int)(W).w, false); f[12] = _t[0]; f[13] = _t[1]; _t = __builtin_amdgcn_cvt_pk_f32_fp8((int)(W).w, true); f[14] = _t[0]; f[15] = _t[1]; } while (0)
__device__ __forceinline__ float sum_swap32(float a, float b) { auto r = __builtin_amdgcn_permlane32_swap(__float_as_uint(a), __float_as_uint(b), false, false); return __uint_as_float(r[0]) + __uint_as_float(r[1]); }
__device__ __forceinline__ float sum_swap16(float a, float b) { auto r = __builtin_amdgcn_permlane16_swap(__float_as_uint(a), __float_as_uint(b), false, false); return __uint_as_float(r[0]) + __uint_as_float(r[1]); }
template <int M> __device__ __forceinline__ unsigned sxu(unsigned v, int lane) {
    if constexpr (M == 32) { auto r = __builtin_amdgcn_permlane32_swap(v, v, false, false); return (lane & 32) ? r[0] : r[1]; }
    else return (unsigned)__builtin_amdgcn_ds_swizzle((int)v, (M << 10) | 0x1f);
}
template <int M> __device__ __forceinline__ float sxf(float v, int lane) { return __uint_as_float(sxu<M>(__float_as_uint(v), lane)); }
__device__ __forceinline__ float wave_sum_sx(float v, int lane) { v += sxf<1>(v, lane); v += sxf<2>(v, lane); v += sxf<4>(v, lane); v += sxf<8>(v, lane); v += sxf<16>(v, lane); v += sxf<32>(v, lane); return v; }
#ifndef PG_TOK
#define PG_TOK 4
#endif
template <class Bar>
__device__ __forceinline__ void phase_peer_gather(Frame& F, const Bar& bar, bool use_bar) {
    const unsigned char* UB = WSP(unsigned char, WS_UB8); const unsigned char* VB = WSP(unsigned char, WS_VB8); const float* RSU = WSP(float, WS_RSU); const float* RSV = WSP(float, WS_RSV);
    const unsigned* EXPO = WSP(unsigned, WS_EXP);
    const bf16_t* H1B = WSP(bf16_t, WS_H1); bf16_t* H2B = WSP(bf16_t, WS_H2B); const float* SSQ1 = WSP(float, WS_SSQ1); float* RS3 = WSP(float, WS_RS3); const float* g_ffn = F.in[10];
    const int l = F.lane; const int ntok_wg = T_TOK / F.G;
#pragma unroll 1
    for (int ti = F.wave * PG_TOK; ti < ntok_wg; ti += NWAVES * PG_TOK) {
        if (use_bar && ti >= NWAVES * PG_TOK) xcd_barrier(bar, F.tid); else __syncthreads();
        f32x2 acc[PG_TOK][8];
        LAS unsigned* lent = (LAS unsigned*)(F.lds + RING_OFF + F.wave * (2048 * PG_TOK)); LAS float* lcu = (LAS float*)(lent + 128 * PG_TOK); LAS float* lcv = lcu + 128 * PG_TOK; LAS float* acl = lcv + 128 * PG_TOK;
        LAS f32x4* lx = (LAS f32x4*)(F.lds + RING_OFF + NWAVES * 2048 * PG_TOK + F.wave * (4096 * PG_TOK));
#pragma unroll
        for (int tk = 0; tk < PG_TOK; ++tk) { const int t = F.vcu * ntok_wg + ti + tk;
            const u32x4 xa = *(const u32x4*)(H1B + (size_t)t * 1024 + 16 * l), xb = *(const u32x4*)(H1B + (size_t)t * 1024 + 16 * l + 8);
            const f32x4* gp = (const f32x4*)(g_ffn + 16 * l);
            lx[tk * 256 + l] = (f32x4){bf_lo(xa.x), bf_hi(xa.x), bf_lo(xa.y), bf_hi(xa.y)} * gp[0]; lx[tk * 256 + 64 + l] = (f32x4){bf_lo(xa.z), bf_hi(xa.z), bf_lo(xa.w), bf_hi(xa.w)} * gp[1];
            lx[tk * 256 + 128 + l] = (f32x4){bf_lo(xb.x), bf_hi(xb.x), bf_lo(xb.y), bf_hi(xb.y)} * gp[2]; lx[tk * 256 + 192 + l] = (f32x4){bf_lo(xb.z), bf_hi(xb.z), bf_lo(xb.w), bf_hi(xb.w)} * gp[3];
#pragma unroll
            for (int i = 0; i < 8; ++i) acc[tk][i] = (f32x2){0.f, 0.f}; }
#pragma unroll 1
        for (int tk = 0; tk < PG_TOK; ++tk) { const int t = F.vcu * ntok_wg + ti + tk;
            const f32x4* sp = (const f32x4*)(SSQ1 + (size_t)t * 16); const f32x4 st = (sp[0] + sp[1]) + (sp[2] + sp[3]); const float rstd1 = __builtin_amdgcn_rsqf(((st[0] + st[1]) + (st[2] + st[3])) * (1.0f / 1024.0f) + EPS);
            unsigned a0 = EXPO[(size_t)t * 128 + l], a1 = EXPO[(size_t)t * 128 + 64 + l];
            { unsigned s0 = (a0 << 18) | (a0 >> 14), s1 = (a1 << 18) | (a1 >> 14);
              int ls = l; asm volatile("" : "+v"(ls));
#define BSTEP(K, J) do { const bool up = (ls & (J)) != 0; const unsigned p0 = sxu<J>(s0, ls), p1 = sxu<J>(s1, ls); \
                  const bool asc0 = (ls & (K)) == 0, asc1 = ((ls + 64) & (K)) == 0; \
                  s0 = (up == asc0) ? max(s0, p0) : min(s0, p0); s1 = (up == asc1) ? max(s1, p1) : min(s1, p1); } while (0)
              BSTEP(2, 1);
              BSTEP(4, 2); BSTEP(4, 1);
              BSTEP(8, 4); BSTEP(8, 2); BSTEP(8, 1);
              BSTEP(16, 8); BSTEP(16, 4); BSTEP(16, 2); BSTEP(16, 1);
              BSTEP(32, 16); BSTEP(32, 8); BSTEP(32, 4); BSTEP(32, 2); BSTEP(32, 1);
              BSTEP(64, 32); BSTEP(64, 16); BSTEP(64, 8); BSTEP(64, 4); BSTEP(64, 2); BSTEP(64, 1);
              { const unsigned lo = min(s0, s1), hi = max(s0, s1); s0 = lo; s1 = hi; }
              BSTEP(128, 32); BSTEP(128, 16); BSTEP(128, 8); BSTEP(128, 4); BSTEP(128, 2); BSTEP(128, 1);
#undef BSTEP
              a0 = (s0 >> 18) | (s0 << 14); a1 = (s1 >> 18) | (s1 << 14); }
            lent[tk * 128 + l] = a0; lent[tk * 128 + 64 + l] = a1;
            lcu[tk * 128 + l] = RSU[a0 & 0x3fffu] * rstd1; lcu[tk * 128 + 64 + l] = RSU[a1 & 0x3fffu] * rstd1;
            lcv[tk * 128 + l] = RSV[a0 & 0x3fffu] * __uint_as_float(a0 & ~0x3fffu); lcv[tk * 128 + 64 + l] = RSV[a1 & 0x3fffu] * __uint_as_float(a1 & ~0x3fffu); }
        LDS_WAIT(); asm volatile("" ::: "memory");
        u32x4 buf0[8], buf1[8];
#define ROWS8(BUF, TAB, tk, eb) do { const u32x4 ea_ = *(const LAS u32x4*)(lent + (tk) * 128 + (eb)), eb_ = *(const LAS u32x4*)(lent + (tk) * 128 + (eb) + 4); \
            const unsigned en_[8] = {ea_.x, ea_.y, ea_.z, ea_.w, eb_.x, eb_.y, eb_.z, eb_.w}; \
            _Pragma("unroll") for (int k = 0; k < 8; ++k) BUF[k] = *(const u32x4*)((TAB) + ((en_[k] & 0x3fffu) * 1024u + 16u * (unsigned)l)); } while (0)
#define U8(BUF, tk, eb) do { float p[8]; f32x2 x2[8]; \
            _Pragma("unroll") for (int i = 0; i < 4; ++i) { const f32x4 t_ = lx[(tk) * 256 + 64 * i + l]; x2[2 * i] = (f32x2){t_[0], t_[1]}; x2[2 * i + 1] = (f32x2){t_[2], t_[3]}; } \
            _Pragma("unroll") for (int k = 0; k < 8; ++k) { const unsigned wq[4] = {BUF[k].x, BUF[k].y, BUF[k].z, BUF[k].w}; f32x2 s2 = (f32x2){0.f, 0.f}; \
                _Pragma("unroll") for (int i = 0; i < 4; ++i) { s2 = __builtin_elementwise_fma(__builtin_amdgcn_cvt_pk_f32_fp8((int)wq[i], false), x2[2 * i], s2); \
                                                                s2 = __builtin_elementwise_fma(__builtin_amdgcn_cvt_pk_f32_fp8((int)wq[i], true), x2[2 * i + 1], s2); } \
                p[k] = s2[0] + s2[1]; if (k & 1) __builtin_amdgcn_sched_barrier(0); } \
            float q4[4], q2[2], q1; \
            _Pragma("unroll") for (int j = 0; j < 4; ++j) q4[j] = sum_swap32(p[j], p[4 + j]); \
            _Pragma("unroll") for (int j = 0; j < 2; ++j) q2[j] = sum_swap16(q4[j], q4[2 + j]); \
            { const bool up = (l & 8) != 0; const float keep = up ? q2[1] : q2[0], send = up ? q2[0] : q2[1]; q1 = keep + sxf<8>(send, l); } \
            q1 += sxf<4>(q1, l); q1 += sxf<2>(q1, l); q1 += sxf<1>(q1, l); \
            const float cu = lcu[(tk) * 128 + (eb) + (l >> 3)], cv = lcv[(tk) * 128 + (eb) + (l >> 3)]; \
            const float a_ = gelu_tanh(q1 * cu) * cv; if ((l & 7) == 0) acl[(tk) * 128 + (eb) + (l >> 3)] = a_; __builtin_amdgcn_sched_barrier(0); } while (0)
#define V8(BUF, tk, eb) do { const float av = acl[(tk) * 128 + (eb) + (l & 7)]; \
            _Pragma("unroll") for (int k = 0; k < 8; ++k) { const float ak = __uint_as_float(__builtin_amdgcn_readlane(__float_as_uint(av), k)); const f32x2 ak2 = (f32x2){ak, ak}; \
                const unsigned wq[4] = {BUF[k].x, BUF[k].y, BUF[k].z, BUF[k].w}; \
                _Pragma("unroll") for (int i = 0; i < 4; ++i) { acc[tk][2 * i] = __builtin_elementwise_fma(__builtin_amdgcn_cvt_pk_f32_fp8((int)wq[i], false), ak2, acc[tk][2 * i]); \
                                                                acc[tk][2 * i + 1] = __builtin_elementwise_fma(__builtin_amdgcn_cvt_pk_f32_fp8((int)wq[i], true), ak2, acc[tk][2 * i + 1]); } \
                if (k & 1) __builtin_amdgcn_sched_barrier(0); } } while (0)
        ROWS8(buf0, UB, 0, 0);
#if PG_TOK == 4
#define TURNS4(CONS, TAB, eb, NEXT) do { ROWS8(buf1, TAB, 1, eb); CONS(buf0, 0, eb); ROWS8(buf0, TAB, 2, eb); CONS(buf1, 1, eb); ROWS8(buf1, TAB, 3, eb); CONS(buf0, 2, eb); NEXT; CONS(buf1, 3, eb); } while (0)
#pragma unroll 1
        for (int eb = 0; eb < 120; eb += 8) TURNS4(U8, UB, eb, ROWS8(buf0, UB, 0, eb + 8));
        TURNS4(U8, UB, 120, ROWS8(buf0, VB, 0, 0));
        LDS_WAIT(); asm volatile("" ::: "memory");
#pragma unroll 1
        for (int eb = 0; eb < 120; eb += 8) TURNS4(V8, VB, eb, ROWS8(buf0, VB, 0, eb + 8));
        TURNS4(V8, VB, 120, (void)0);
#undef TURNS4
#elif PG_TOK == 2
#define TURNS2(CONS, TAB, eb, NEXT) do { ROWS8(buf1, TAB, 1, eb); CONS(buf0, 0, eb); NEXT; CONS(buf1, 1, eb); } while (0)
#pragma unroll 1
        for (int eb = 0; eb < 120; eb += 8) TURNS2(U8, UB, eb, ROWS8(buf0, UB, 0, eb + 8));
        TURNS2(U8, UB, 120, ROWS8(buf0, VB, 0, 0));
        LDS_WAIT(); asm volatile("" ::: "memory");
#pragma unroll 1
        for (int eb = 0; eb < 120; eb += 8) TURNS2(V8, VB, eb, ROWS8(buf0, VB, 0, eb + 8));
        TURNS2(V8, VB, 120, (void)0);
#undef TURNS2
#else
#error PG_TOK must be 2 or 4
#endif
#undef ROWS8
#undef U8
#undef V8
#pragma unroll
        for (int tk = 0; tk < PG_TOK; ++tk) { const int t = F.vcu * ntok_wg + ti + tk;
            float ss = 0.f; f32x4 h[4];
#pragma unroll
            for (int q2 = 0; q2 < 2; ++q2) { const u32x4 ha = *(const u32x4*)(H1B + (size_t)t * 1024 + 16 * l + 8 * q2);
                h[2 * q2] = (f32x4){bf_lo(ha.x), bf_hi(ha.x), bf_lo(ha.y), bf_hi(ha.y)}; h[2 * q2 + 1] = (f32x4){bf_lo(ha.z), bf_hi(ha.z), bf_lo(ha.w), bf_hi(ha.w)};
#pragma unroll
                for (int j = 0; j < 4; ++j) { h[2 * q2][j] += acc[tk][4 * q2 + (j >> 1)][j & 1]; h[2 * q2 + 1][j] += acc[tk][4 * q2 + 2 + (j >> 1)][j & 1]; ss += h[2 * q2][j] * h[2 * q2][j] + h[2 * q2 + 1][j] * h[2 * q2 + 1][j]; }
                u32x4 w0; w0.x = cvtpk(h[2 * q2][0], h[2 * q2][1]); w0.y = cvtpk(h[2 * q2][2], h[2 * q2][3]); w0.z = cvtpk(h[2 * q2 + 1][0], h[2 * q2 + 1][1]); w0.w = cvtpk(h[2 * q2 + 1][2], h[2 * q2 + 1][3]);
                if (!F.dry) *(u32x4*)(H2B + (size_t)t * 1024 + 16 * l + 8 * q2) = w0; }
            const float rstd3 = __builtin_amdgcn_rsqf(wave_sum_sx(ss, l) * (1.0f / 1024.0f) + EPS);
            if (!F.dry && l == 0) RS3[t] = rstd3;
            __builtin_amdgcn_sched_barrier(0); }
    }
}

__device__ __forceinline__ void phase_final(Frame& F) {
    const float* SSQ3 = WSP(float, WS_SSQ3); const float* g = F.in[19]; const bf16_t* H3B = WSP(bf16_t, WS_H3B);
    const int l = F.lane; const int gw = F.vcu * NWAVES + F.wave, NGW = F.G * NWAVES;
    for (int t = gw; t < T_TOK; t += NGW) {
        const f32x4* sp = (const f32x4*)(SSQ3 + (size_t)t * 16); const f32x4 st = (sp[0] + sp[1]) + (sp[2] + sp[3]);
        const float rstd = __builtin_amdgcn_rsqf(((st[0] + st[1]) + (st[2] + st[3])) * (1.0f / 1024.0f) + EPS);
        f32x4* row = (f32x4*)(F.out + (size_t)t * 1024);
#pragma unroll
        for (int j = 0; j < 4; ++j) { const u32x2 hv = *((const u32x2*)(H3B + (size_t)t * 1024) + l + 64 * j); const f32x4 gv = *((const f32x4*)g + l + 64 * j);
            const f32x4 h = (f32x4){bf_lo(hv.x), bf_hi(hv.x), bf_lo(hv.y), bf_hi(hv.y)}; row[l + 64 * j] = h * rstd * gv; }
    }
}
#ifndef MK_FUSED
#define MK_FUSED 1
#endif
constexpr int NPHASE = 11;
struct Args { const float* in[20]; float* out; unsigned char* ws; int ph_lo, ph_hi, dry, pad; };
static_assert(sizeof(Args) == 20 * 8 + 8 + 8 + 4 * 4, "Args has no padding");

__global__ void __launch_bounds__(NWAVES * 64, 2) mk_fwd(Args args) {
    extern __shared__ __attribute__((aligned(16))) unsigned char lds_raw[];
    Frame F;
    F.lds = (LAS unsigned char*)lds_raw;
    F.wave = __builtin_amdgcn_readfirstlane(threadIdx.x >> 6); F.lane = lane_id(); F.tid = F.wave * 64 + F.lane;
    F.G = gridDim.x; { const int bx = blockIdx.x; F.vcu = (F.G % 8 == 0) ? (bx % 8) * (F.G / 8) + bx / 8 : bx; }
    F.in = args.in; F.out = args.out; F.ws = args.ws; F.dry = args.dry;
    volatile LAS unsigned* MISC = (volatile LAS unsigned*)(F.lds + MISC_OFF);
    if (F.tid < 64) MISC[F.tid] = 0u;
    __syncthreads();
    const int lo = args.ph_lo, hi = args.ph_hi;
    XcdBarrier bar; bar.bar = (unsigned*)(F.ws + WS_CTL) + CW_BAR; bar.x = 0; bar.st = nullptr;
    if (hi - lo > 1) bar = xcd_barrier_post((unsigned*)(F.ws + WS_CTL) + CW_BAR, MISC + 8, F.tid);
#ifndef PH_MASK
#define PH_MASK 0xFFFFFFFFu
#endif
#define IN(k) (((PH_MASK >> (k)) & 1u) && lo <= (k) && (k) < hi)
#define LAUNDER(p, T) do { unsigned _lo = (unsigned)(unsigned long long)(p), _hi = (unsigned)((unsigned long long)(p) >> 32); asm volatile("" : "+v"(_lo), "+v"(_hi)); \
        _lo = __builtin_amdgcn_readfirstlane(_lo); _hi = __builtin_amdgcn_readfirstlane(_hi); (p) = (T)(((unsigned long long)_hi << 32) | _lo); } while (0)
#define SEAM(k) do { if (IN(k) && IN((k) + 1)) xcd_barrier(bar, F.tid); LAUNDER(F.ws, unsigned char*); LAUNDER(F.out, float*); F.lane = lane_id(); F.tid = F.wave * 64 + F.lane; } while (0)
    const int bx = (int)blockIdx.x;
    LAS unsigned char* ring = F.lds + RING_OFF;

    if (IN(0)) { phase_prologue(F); } SEAM(0);
    if (IN(1)) {
        pg8::Gemm g{WSP(bf16_t, WS_XN1), WSP(bf16_t, WS_WIN), T_TOK, 8192, 1024, 1024, 0, 2, 8}; pg8::StaticOrder S; S.init(T_TOK, 8192, F.G, bx);
        pg8::EpiProj E{WSP(bf16_t, WS_GQ), WSP(bf16_t, WS_GK), WSP(bf16_t, WS_GV), WSP(bf16_t, WS_GR), WSP(bf16_t, WS_SQ), WSP(bf16_t, WS_SK), WSP(bf16_t, WS_SV),
                       (bf16_t*)F.out, (bf16_t*)F.out + (size_t)T_TOK * 1024};
        pg8::gemm_phase<pg8::EpiProj>(ring, g, S, E, F.tid);
    } SEAM(1);
    if (IN(2)) { phase_gla_prep(F); } SEAM(2);
    if (IN(3)) { phase_attn_a(F); } SEAM(3);
    if (IN(4)) { phase_attn_b(F); } SEAM(4);
    if (IN(5)) {
        if (!QCONV) { for (int cu = F.vcu; cu < CVT8_UNITS; cu += F.G) cvt_fp8_unit(F, cu); VM_WAIT(); __syncthreads(); }
        pg8::StaticOrder S; S.init(T_TOK, 1024, F.G, bx);
        { pg8::Gemm g{WSP(bf16_t, WS_GLAN), WSP(bf16_t, WS_WGA), T_TOK, 1024, 1024, 1024, 0, 0, 0}; pg8::EpiMix<true> E{(const bf16_t*)F.out, WSP(bf16_t, WS_MIX)};
          pg8::gemm_phase<pg8::EpiMix<true>>(ring, g, S, E, F.tid); }
        { pg8::Gemm g{WSP(bf16_t, WS_SQ), WSP(bf16_t, WS_WSB), T_TOK, 1024, 1024, 1024, 0, 0, 0}; pg8::EpiMix<false> E{(const bf16_t*)F.out + (size_t)T_TOK * 1024, WSP(bf16_t, WS_MIX)};
          pg8::gemm_phase<pg8::EpiMix<false>>(ring, g, S, E, F.tid); }
    } SEAM(5);
    if (IN(6)) {
        pg8::Gemm g{WSP(bf16_t, WS_MIX), WSP(bf16_t, WS_WO), T_TOK, 1024, 1024, 1024, 0, 0, 0}; pg8::StaticOrder S; S.init(T_TOK, 1024, F.G, bx);
        pg8::EpiH1 E{F.in[0], WSP(bf16_t, WS_H1), WSP(float, WS_SSQ1)};
        pg8::gemm_phase<pg8::EpiH1>(ring, g, S, E, F.tid);
    } SEAM(6);
    if (IN(7)) {
        pg8::Gemm g{WSP(bf16_t, WS_H1), WSP(bf16_t, WS_WPQ), T_TOK, 2048, 1024, 1024, 0, 0, 0}; pg8::StaticOrder S; S.init(T_TOK, 2048, F.G, bx);
        pg8::EpiQ E{WSP(float, WS_SSQ1), WSP(bf16_t, WS_Q), 2048};
        pg8::gemm_phase<pg8::EpiQ>(ring, g, S, E, F.tid);
    } SEAM(7);
    if (IN(8)) {
        cvt_copy(F, F.in[1], WSP(bf16_t, WS_PB), (size_t)T_TOK * 256);
        phase_peer_retrieve(F);
        VM_WAIT(); __syncthreads();
        phase_peer_gather(F, bar, false);
    } SEAM(8);
    if (IN(9)) {
        pg8::StaticOrder S; S.init(T_TOK, 1024, F.G, bx);
        { pg8::Gemm g{WSP(bf16_t, WS_PB), WSP(bf16_t, WS_WPLE), T_TOK, 1024, 256, 256, 0, 0, 0}; pg8::EpiBf E{WSP(bf16_t, WS_PLE), 1024};
          pg8::gemm_phase<pg8::EpiBf>(ring, g, S, E, F.tid); }
        { pg8::Gemm g{WSP(bf16_t, WS_H2B), WSP(bf16_t, WS_WPG), T_TOK, 1024, 1024, 1024, 0, 0, 0}; pg8::EpiH3 E{WSP(bf16_t, WS_H2B), WSP(bf16_t, WS_PLE), WSP(float, WS_RS3), WSP(bf16_t, WS_H3B), WSP(float, WS_SSQ3), F.dry};
          pg8::gemm_phase<pg8::EpiH3>(ring, g, S, E, F.tid); }
    } SEAM(9);
    if (IN(10)) { phase_final(F); }
#undef IN
#undef SEAM
}

extern "C" void kernel_launch(void* const* d_in, const int* in_sizes, int n_in, void* d_out, int out_size, void* d_ws, size_t ws_size, hipStream_t stream) {
    static int grid = 0;
    if (grid == 0) {
        if (n_in != 20 || in_sizes[0] != T_TOK * 1024 || out_size != T_TOK * 1024 || ws_size < WS_END) {
            fprintf(stderr, "kernel_launch: unexpected shapes (n_in %d, in0 %d, out %d, ws %zu < %zu?); nothing launched\n", n_in, n_in > 0 ? in_sizes[0] : -1, out_size, ws_size, (size_t)WS_END); grid = -1; return; }
        int dev = 0, cus = 0, per_cu = 0;
        if (hipGetDevice(&dev) != hipSuccess || hipDeviceGetAttribute(&cus, hipDeviceAttributeMultiprocessorCount, dev) != hipSuccess) { grid = -1; return; }
        if (hipFuncSetAttribute((const void*)mk_fwd, hipFuncAttributeMaxDynamicSharedMemorySize, LDS_BYTES) != hipSuccess) { fprintf(stderr, "kernel_launch: hipFuncSetAttribute failed\n"); grid = -1; return; }
        if (hipOccupancyMaxActiveBlocksPerMultiprocessor(&per_cu, (const void*)mk_fwd, NWAVES * 64, LDS_BYTES) != hipSuccess || per_cu < 1)
            fprintf(stderr, "kernel_launch: note: occupancy query reports %d workgroups per CU\n", per_cu);
        (void)hipGetLastError();
        grid = cus;
        if (grid != 256) fprintf(stderr, "kernel_launch: note: %d CUs (kernel tuned for 256)\n", grid);
    }
    if (grid < 0) return;
    if (hipMemsetAsync((char*)d_ws + WS_CTL, 0, CTL_ZERO_BYTES, stream) != hipSuccess) { fprintf(stderr, "kernel_launch: hipMemsetAsync failed\n"); return; }
    Args a{};
    for (int i = 0; i < 20; ++i) a.in[i] = (const float*)d_in[i];
    a.out = (float*)d_out; a.ws = (unsigned char*)d_ws;
#if MK_FUSED
    a.ph_lo = 0; a.ph_hi = NPHASE;
    hipLaunchKernelGGL(mk_fwd, dim3(grid), dim3(NWAVES * 64), LDS_BYTES, stream, a);
#else
#ifndef PROBE_PHASE
#define PROBE_PHASE -1
#define PROBE_REPS 0
#endif
    for (int p = 0; p < NPHASE; ++p) { a.ph_lo = p; a.ph_hi = p + 1;
        if (p == PROBE_PHASE) { a.dry = 1; for (int r = 0; r < PROBE_REPS; ++r) hipLaunchKernelGGL(mk_fwd, dim3(grid), dim3(NWAVES * 64), LDS_BYTES, stream, a); a.dry = 0; }
        hipLaunchKernelGGL(mk_fwd, dim3(grid), dim3(NWAVES * 64), LDS_BYTES, stream, a); }
#endif
}
```

```cpp
#define MK_FUSED 1
#define PG_TOK 2
#include <hip/hip_runtime.h>
#include <cstdio>
#include <cstdint>

#define LAS __attribute__((address_space(3)))
#define GAS __attribute__((address_space(1)))
typedef unsigned short bf16_t;
typedef short bf16x8 __attribute__((ext_vector_type(8)));
typedef short s16x4 __attribute__((ext_vector_type(4)));
typedef float f32x2 __attribute__((ext_vector_type(2)));
typedef float f32x4 __attribute__((ext_vector_type(4)));
typedef float f32x16 __attribute__((ext_vector_type(16)));
typedef unsigned u32x2 __attribute__((ext_vector_type(2)));
typedef unsigned u32x4 __attribute__((ext_vector_type(4)));
typedef __bf16 bf16x2_t __attribute__((ext_vector_type(2)));

__device__ __forceinline__ unsigned cvtpk(float lo, float hi) { f32x2 v = {lo, hi}; bf16x2_t b = __builtin_convertvector(v, bf16x2_t); return __builtin_bit_cast(unsigned, b); }
__device__ __forceinline__ float bf_lo(unsigned u) { return __uint_as_float(u << 16); }
__device__ __forceinline__ float bf_hi(unsigned u) { return __uint_as_float(u & 0xffff0000u); }
__device__ __forceinline__ float bf1(bf16_t u) { return __uint_as_float(((unsigned)u) << 16); }
__device__ __forceinline__ float fast_sigmoid(float x) { return __builtin_amdgcn_rcpf(1.0f + __expf(-x)); }

namespace pg8 {
constexpr int BM = 256, BK = 64, HALF = 128, HTB = HALF * BK * 2  , STAGE_BYTES = 8 * HTB, NXCD = 8, WGM = 8;

__host__ __device__ __forceinline__ int lds_byte(int r, int c) { const int st = (r >> 4) * 2 + (c >> 5), rr = r & 15, cc = c & 31, ob = rr * 64 + cc * 2; return st * 1024 + (ob ^ (((ob >> 9) & 1) << 5)); }
__host__ __device__ __forceinline__ void stage_rc(int b, int& R, int& C) { const int st = b / 1024, sb = b % 1024, swz = sb ^ (((sb >> 9) & 1) << 5); R = (st >> 1) * 16 + swz / 64; C = (st & 1) * 32 + (swz % 64) / 2; }
__host__ __device__ __forceinline__ int perm32(int rho) { const int n = rho >> 4, i = rho & 15; return 8 * (i >> 2) + 4 * n + (i & 3); }

struct Unit { int pm, pn, half; };
struct Gemm { const bf16_t* A; const bf16_t* Bt; int M, N, K, lda, a_pn_cols; int swap_lo, swap_hi; const bf16_t* A2 = nullptr; const bf16_t* Bt2 = nullptr; };

struct StaticOrder {
    int nM, nN, nwg, G, c;
    __host__ __device__ void init(int M, int N, int G_, int c_) { nM = M / BM; nN = N / BM; nwg = nM * nN; G = G_; c = c_; }
    __host__ __device__ bool next(int i, Unit& u) const {
        const long L = (long)i * G + c; if (L >= nwg) return false;
        int wgid = (int)L; { const int q = nwg / NXCD, r = nwg % NXCD, xcd = wgid % NXCD, off = wgid / NXCD; wgid = (xcd < r ? xcd * (q + 1) : r * (q + 1) + (xcd - r) * q) + off; }
        const int nig = WGM * nN, gid = wgid / nig, fm = gid * WGM, gsz = (nM - fm) < WGM ? (nM - fm) : WGM;
        u.pm = fm + ((wgid % nig) % gsz); u.pn = (wgid % nig) / gsz; u.half = 0; return true;
    }
};
struct PairOrder {
    StaticOrder S;
    __host__ __device__ void init(int M, int N, int G_, int c_) { S.init(M, N, G_, c_); }
    __host__ __device__ bool next(int i, Unit& u) const { if (!S.next(i >> 1, u)) return false; u.half = i & 1; return true; }
};

template <class Epi, bool ALIGN_EPI = true, bool SP2 = true, class Order = StaticOrder>
__device__ __forceinline__ void gemm_phase(LAS unsigned char* lds, const Gemm g, const Order& S, const Epi& E, int tid) {
    const int wid = __builtin_amdgcn_readfirstlane(tid >> 6), lane = tid & 63, wr = wid >> 2, wc = wid & 3, fr = lane & 15, fq = lane >> 4;
    const int K = g.K, nt = K / BK, lda = g.lda;
    unsigned voffA[2], voffB[2];
#pragma unroll
    for (int i = 0; i < 2; ++i) { int R, C; stage_rc(tid * 16 + i * 8192, R, C); const int Rb = Epi::PERM ? ((R & ~31) + perm32(R & 31)) : R;
        voffA[i] = (unsigned)(R * lda + C) * 2u; voffB[i] = (unsigned)(Rb * K + C) * 2u; }
    const size_t kstep = (size_t)(BK * 2);
    const size_t hA = (size_t)HALF * lda * 2, hB = (size_t)HALF * K * 2;
    const size_t tA = 2 * hA, tB = 2 * hB;
    const size_t pnA = (size_t)g.a_pn_cols * 2;
    const unsigned ldsw = (unsigned)wid * 1024u;
    const int aoff = lds_byte(wr * 64 + fr, fq * 8), boff = lds_byte(wc * 32 + fr, fq * 8);
#define PG8_SA(b, h) (((b) * 2 + (h)) * HTB)
#define PG8_SB(b, h) ((4 + (b) * 2 + (h)) * HTB)
#define PG8_STAGE(bufoff, gbase, voff) do { _Pragma("unroll") for (int _i = 0; _i < 2; ++_i) \
        __builtin_amdgcn_global_load_lds((const unsigned*)((const char*)(gbase) + (voff)[_i]), (LAS unsigned*)(lds + (bufoff) + ldsw + _i * 8192), 16, 0, 0); } while (0)
#define PG8_LDA(dst, b, h) do { _Pragma("unroll") for (int m = 0; m < 4; ++m) _Pragma("unroll") for (int k = 0; k < 2; ++k) dst[m][k] = *(const LAS bf16x8*)(lds + PG8_SA(b, h) + aoff + m * 2048 + k * 1024); } while (0)
#define PG8_LDB(dst, b, h) do { _Pragma("unroll") for (int n = 0; n < 2; ++n) _Pragma("unroll") for (int k = 0; k < 2; ++k) dst[n][k] = *(const LAS bf16x8*)(lds + PG8_SB(b, h) + boff + n * 2048 + k * 1024); } while (0)
#define PG8_MMA(ai, bj, At, Bt) do { __builtin_amdgcn_s_setprio(1); _Pragma("unroll") for (int m = 0; m < 4; ++m) _Pragma("unroll") for (int n = 0; n < 2; ++n) _Pragma("unroll") for (int k = 0; k < 2; ++k) \
        acc[ai][bj][m][n] = __builtin_amdgcn_mfma_f32_16x16x32_bf16(Bt[n][k], At[m][k], acc[ai][bj][m][n], 0, 0, 0); __builtin_amdgcn_s_setprio(0); } while (0)
#define PG8_WAIT_V(n) asm volatile("s_waitcnt vmcnt(" #n ")" ::: "memory")
#define PG8_WAIT_L(n) asm volatile("s_waitcnt lgkmcnt(" #n ")" ::: "memory")
#define PG8_BAR __builtin_amdgcn_s_barrier()
#define PG8_SCHED __builtin_amdgcn_sched_barrier(0)
    Unit cur, nxt; int ui = 0;
    if (!S.next(0, cur)) return;
    f32x4 acc[2][2][4][2];
#pragma unroll
    for (int a = 0; a < 2; ++a)
#pragma unroll
        for (int b = 0; b < 2; ++b)
#pragma unroll
            for (int m = 0; m < 4; ++m)
#pragma unroll
                for (int n = 0; n < 2; ++n) acc[a][b][m][n] = (f32x4){0.f, 0.f, 0.f, 0.f};
    bf16x8 At[4][2], B0[2][2], B1[2][2];
#define PG8_APTR(u) ((u).half ? (const char*)g.A2 + (size_t)(u).pm * tA : ((u).pn >= g.swap_lo && (u).pn < g.swap_hi) ? (const char*)g.Bt + (size_t)(u).pn * tB : (const char*)g.A + (size_t)(u).pm * tA + (size_t)(u).pn * pnA)
#define PG8_BPTR(u) ((u).half ? (const char*)g.Bt2 + (size_t)(u).pn * tB : ((u).pn >= g.swap_lo && (u).pn < g.swap_hi) ? (const char*)g.A + (size_t)(u).pm * tA : (const char*)g.Bt + (size_t)(u).pn * tB)
    const char* cA = PG8_APTR(cur); const char* cB = PG8_BPTR(cur);
    if constexpr (SP2) {
        PG8_STAGE(PG8_SB(0, 0), cB, voffB); PG8_STAGE(PG8_SB(0, 1), cB + hB, voffB); PG8_STAGE(PG8_SA(0, 0), cA, voffA); PG8_STAGE(PG8_SA(0, 1), cA + hA, voffA);
        if (wr == 1) PG8_BAR;
        PG8_WAIT_V(2); PG8_BAR;
        PG8_STAGE(PG8_SB(1, 0), cB + kstep, voffB); PG8_STAGE(PG8_SA(1, 0), cA + kstep, voffA); PG8_STAGE(PG8_SB(1, 1), cB + hB + kstep, voffB);
        PG8_WAIT_V(6); PG8_BAR;
    } else {
        PG8_STAGE(PG8_SB(0, 0), cB, voffB); PG8_STAGE(PG8_SA(0, 0), cA, voffA); PG8_STAGE(PG8_SB(0, 1), cB + hB, voffB); PG8_STAGE(PG8_SA(0, 1), cA + hA, voffA);
        if (wr == 1) PG8_BAR;
        PG8_WAIT_V(4); PG8_BAR;
        PG8_STAGE(PG8_SB(1, 0), cB + kstep, voffB); PG8_STAGE(PG8_SA(1, 0), cA + kstep, voffA); PG8_STAGE(PG8_SB(1, 1), cB + hB + kstep, voffB);
        PG8_WAIT_V(6); PG8_BAR;
    }
    for (;;) {
        const bool has_next = S.next(ui + 1, nxt);
        const char* nA = has_next ? PG8_APTR(nxt) : cA; const char* nB = has_next ? PG8_BPTR(nxt) : cB;
#pragma unroll 1
        for (int t = 0; t < nt; t += 2) {
            const bool last = (t == nt - 2);
            const char* a1 = cA + (size_t)(t + 1) * kstep;
            const char* a2 = last ? nA : cA + (size_t)(t + 2) * kstep; const char* b2 = last ? nB : cB + (size_t)(t + 2) * kstep;
            const char* a3 = a2 + kstep; const char* b3 = b2 + kstep;
            if constexpr (SP2) {
            PG8_LDB(B0, 0, 0); PG8_LDB(B1, 0, 1); PG8_SCHED; PG8_LDA(At, 0, 0); PG8_STAGE(PG8_SA(1, 1), a1 + hA, voffA);
            PG8_WAIT_V(8); PG8_WAIT_L(0); PG8_BAR; PG8_MMA(0, 0, At, B0); PG8_MMA(0, 1, At, B1); PG8_BAR; PG8_SCHED;
            PG8_LDA(At, 0, 1); PG8_STAGE(PG8_SB(0, 0), b2, voffB); PG8_STAGE(PG8_SB(0, 1), b2 + hB, voffB); PG8_STAGE(PG8_SA(0, 0), a2, voffA);
            PG8_WAIT_V(8); PG8_WAIT_L(0); PG8_BAR; PG8_MMA(1, 0, At, B0); PG8_MMA(1, 1, At, B1); PG8_BAR; PG8_SCHED;
            PG8_LDB(B0, 1, 0); PG8_LDB(B1, 1, 1); PG8_SCHED; PG8_LDA(At, 1, 0); PG8_STAGE(PG8_SA(0, 1), a2 + hA, voffA);
            PG8_WAIT_V(8); PG8_WAIT_L(0); PG8_BAR; PG8_MMA(0, 0, At, B0); PG8_MMA(0, 1, At, B1); PG8_BAR; PG8_SCHED;
            PG8_LDA(At, 1, 1); PG8_STAGE(PG8_SB(1, 0), b3, voffB); PG8_STAGE(PG8_SB(1, 1), b3 + hB, voffB); PG8_STAGE(PG8_SA(1, 0), a3, voffA);
            PG8_WAIT_V(8); PG8_WAIT_L(0); PG8_BAR; PG8_MMA(1, 0, At, B0); PG8_MMA(1, 1, At, B1); PG8_BAR; PG8_SCHED;
            } else {
            PG8_LDB(B0, 0, 0); PG8_SCHED; PG8_LDA(At, 0, 0); PG8_STAGE(PG8_SA(1, 1), a1 + hA, voffA);
            PG8_WAIT_L(8); PG8_BAR; PG8_WAIT_L(0); PG8_MMA(0, 0, At, B0); PG8_BAR; PG8_SCHED;
            PG8_LDB(B1, 0, 1); PG8_STAGE(PG8_SB(0, 0), b2, voffB);
            PG8_BAR; PG8_WAIT_L(0); PG8_MMA(0, 1, At, B1); PG8_BAR;
            PG8_LDA(At, 0, 1); PG8_STAGE(PG8_SA(0, 0), a2, voffA);
            PG8_BAR; PG8_WAIT_L(0); PG8_MMA(1, 0, At, B0); PG8_BAR; PG8_SCHED;
            PG8_STAGE(PG8_SB(0, 1), b2 + hB, voffB);
            PG8_WAIT_V(6); PG8_BAR; PG8_MMA(1, 1, At, B1); PG8_BAR;
            PG8_LDB(B0, 1, 0); PG8_SCHED; PG8_LDA(At, 1, 0); PG8_STAGE(PG8_SA(0, 1), a2 + hA, voffA);
            PG8_WAIT_L(8); PG8_BAR; PG8_WAIT_L(0); PG8_MMA(0, 0, At, B0); PG8_BAR; PG8_SCHED;
            PG8_LDB(B1, 1, 1); PG8_STAGE(PG8_SB(1, 0), b3, voffB);
            PG8_BAR; PG8_WAIT_L(0); PG8_MMA(0, 1, At, B1); PG8_BAR;
            PG8_LDA(At, 1, 1); PG8_STAGE(PG8_SA(1, 0), a3, voffA);
            PG8_BAR; PG8_WAIT_L(0); PG8_MMA(1, 0, At, B0); PG8_BAR; PG8_SCHED;
            PG8_STAGE(PG8_SB(1, 1), b3 + hB, voffB);
            PG8_WAIT_V(6); PG8_BAR; PG8_MMA(1, 1, At, B1); PG8_BAR;
            }
        }
        if constexpr (ALIGN_EPI) { if (wr == 0) PG8_BAR; }
        E(acc, cur, wr, wc, fr, fq);
        if (!has_next) break;
        if (!(Epi::ACCUM && cur.half == 0))
#pragma unroll
        for (int a = 0; a < 2; ++a)
#pragma unroll
            for (int b = 0; b < 2; ++b)
#pragma unroll
                for (int m = 0; m < 4; ++m)
#pragma unroll
                    for (int n = 0; n < 2; ++n) acc[a][b][m][n] = (f32x4){0.f, 0.f, 0.f, 0.f};
        cur = nxt; cA = nA; cB = nB; ++ui;
        if constexpr (ALIGN_EPI) { if (wr == 1) PG8_BAR; }
    }
    PG8_WAIT_V(0);
    if constexpr (!ALIGN_EPI) { if (wr == 0) PG8_BAR; }
    PG8_BAR;
#undef PG8_APTR
#undef PG8_BPTR
#undef PG8_SA
#undef PG8_SB
#undef PG8_STAGE
#undef PG8_LDA
#undef PG8_LDB
#undef PG8_MMA
#undef PG8_WAIT_V
#undef PG8_WAIT_L
#undef PG8_BAR
#undef PG8_SCHED
}
}
constexpr int T_TOK = 16384, DM = 1024, SEQ = 4096, NB = 4;
constexpr float EPS = 1e-6f;
constexpr float LOG2E = 1.4426950408889634f;

namespace pg8 {
struct EpiProj {
    static constexpr bool PERM = true, ACCUM = false;
    bf16_t *GQ, *GK, *GV, *GR, *SQ, *SK, *SV, *SGA, *SGB;
    __device__ __forceinline__ void operator()(const f32x4 (&acc)[2][2][4][2], const Unit& u, int wr, int wc, int fr, int fq) const {
        const int pn = u.pn; bf16_t* base; int ldc = 1024, c0; int act = 0; float sc = 1.f;
        if (pn >= 2 && pn < 8) {
            bf16_t* tb = (pn < 4) ? GK : GV; const int f0 = ((pn < 4) ? (pn - 2) : (pn - 4)) * 256 + wr * 64 + fr, t0 = u.pm * BM + wc * 32 + 8 * fq;
#pragma unroll
            for (int ai = 0; ai < 2; ++ai)
#pragma unroll
                for (int m = 0; m < 4; ++m) { bf16_t* rowp = tb + (size_t)(f0 + ai * HALF + m * 16) * T_TOK + t0;
#pragma unroll
                    for (int bj = 0; bj < 2; ++bj) { const f32x4 v0 = acc[ai][bj][m][0], v1 = acc[ai][bj][m][1];
                        u32x4 w; w.x = cvtpk(v0[0], v0[1]); w.y = cvtpk(v0[2], v0[3]); w.z = cvtpk(v1[0], v1[1]); w.w = cvtpk(v1[2], v1[3]);
                        *(u32x4*)(rowp + bj * HALF) = w; } }
            return; }
        if (pn < 2) { base = GQ; ldc = 512; c0 = pn * 256; sc = 0.08838834764831845f; }
        else if (pn < 4) { base = GK; ldc = 512; c0 = (pn - 2) * 256; }
        else if (pn < 8) { base = GV; c0 = (pn - 4) * 256; }
        else if (pn < 12) { base = GR; c0 = (pn - 8) * 256; act = 1; }
        else if (pn < 16) { base = SQ; c0 = (pn - 12) * 256; sc = 0.125f * LOG2E; }
        else if (pn < 20) { base = SK; c0 = (pn - 16) * 256; }
        else if (pn < 24) { base = SV; c0 = (pn - 20) * 256; }
        else if (pn < 28) { base = SGA; c0 = (pn - 24) * 256; act = 2; }
        else { base = SGB; c0 = (pn - 28) * 256; act = 2; }
        const int row0 = u.pm * BM + wr * 64 + fr, col0 = c0 + wc * 32 + 8 * fq;
#pragma unroll
        for (int ai = 0; ai < 2; ++ai)
#pragma unroll
            for (int m = 0; m < 4; ++m) { bf16_t* rowp = base + (size_t)(row0 + ai * HALF + m * 16) * ldc + col0;
#pragma unroll
                for (int bj = 0; bj < 2; ++bj) { f32x4 v0 = acc[ai][bj][m][0], v1 = acc[ai][bj][m][1];
                    if (act == 1) {
#pragma unroll
                        for (int j = 0; j < 4; ++j) { v0[j] = v0[j] * fast_sigmoid(v0[j]); v1[j] = v1[j] * fast_sigmoid(v1[j]); } }
                    else if (act == 2) {
#pragma unroll
                        for (int j = 0; j < 4; ++j) { v0[j] = fast_sigmoid(v0[j]); v1[j] = fast_sigmoid(v1[j]); } }
                    else { v0 = v0 * sc; v1 = v1 * sc; }
                    u32x4 w; w.x = cvtpk(v0[0], v0[1]); w.y = cvtpk(v0[2], v0[3]); w.z = cvtpk(v1[0], v1[1]); w.w = cvtpk(v1[2], v1[3]);
                    *(u32x4*)(rowp + bj * HALF) = w; } }
    }
};
template <bool FIRST> struct EpiMix {
    static constexpr bool PERM = true, ACCUM = false;
    const bf16_t* gate; bf16_t* mixed;
    __device__ __forceinline__ void operator()(const f32x4 (&acc)[2][2][4][2], const Unit& u, int wr, int wc, int fr, int fq) const {
        const int row0 = u.pm * BM + wr * 64 + fr, col0 = u.pn * BM + wc * 32 + 8 * fq;
#pragma unroll
        for (int ai = 0; ai < 2; ++ai) {
            u32x4 gv[4][2], mv[4][2];
#pragma unroll
            for (int m = 0; m < 4; ++m)
#pragma unroll
                for (int bj = 0; bj < 2; ++bj) { const size_t off = (size_t)(row0 + ai * HALF + m * 16) * 1024 + col0 + bj * HALF;
                    gv[m][bj] = *(const u32x4*)(gate + off); if (!FIRST) mv[m][bj] = *(const u32x4*)(mixed + off); }
#pragma unroll
            for (int m = 0; m < 4; ++m)
#pragma unroll
                for (int bj = 0; bj < 2; ++bj) { const size_t off = (size_t)(row0 + ai * HALF + m * 16) * 1024 + col0 + bj * HALF;
                    const f32x4 a0 = acc[ai][bj][m][0], a1 = acc[ai][bj][m][1]; const u32x4 g4 = gv[m][bj];
                    float r[8];
                    r[0] = a0[0] * bf_lo(g4.x); r[1] = a0[1] * bf_hi(g4.x); r[2] = a0[2] * bf_lo(g4.y); r[3] = a0[3] * bf_hi(g4.y);
                    r[4] = a1[0] * bf_lo(g4.z); r[5] = a1[1] * bf_hi(g4.z); r[6] = a1[2] * bf_lo(g4.w); r[7] = a1[3] * bf_hi(g4.w);
                    if (!FIRST) { const u32x4 m4 = mv[m][bj];
                        r[0] += bf_lo(m4.x); r[1] += bf_hi(m4.x); r[2] += bf_lo(m4.y); r[3] += bf_hi(m4.y); r[4] += bf_lo(m4.z); r[5] += bf_hi(m4.z); r[6] += bf_lo(m4.w); r[7] += bf_hi(m4.w); }
                    u32x4 w; w.x = cvtpk(r[0], r[1]); w.y = cvtpk(r[2], r[3]); w.z = cvtpk(r[4], r[5]); w.w = cvtpk(r[6], r[7]);
                    *(u32x4*)(mixed + off) = w; }
        }
    }
};
struct EpiMixPair {
    static constexpr bool PERM = true, ACCUM = true;
    const bf16_t* ga; const bf16_t* gb; bf16_t* mixed;
    __device__ __forceinline__ void operator()(f32x4 (&acc)[2][2][4][2], const Unit& u, int wr, int wc, int fr, int fq) const {
        const int row0 = u.pm * BM + wr * 64 + fr, col0 = u.pn * BM + wc * 32 + 8 * fq;
        const float TINY = 8.673617379884035e-19f;
        if (u.half == 0) {
#pragma unroll
            for (int ai = 0; ai < 2; ++ai) {
                u32x4 av[4][2], bv[4][2];
#pragma unroll
                for (int m = 0; m < 4; ++m)
#pragma unroll
                    for (int bj = 0; bj < 2; ++bj) { const size_t off = (size_t)(row0 + ai * HALF + m * 16) * 1024 + col0 + bj * HALF; av[m][bj] = *(const u32x4*)(ga + off); bv[m][bj] = *(const u32x4*)(gb + off); }
#pragma unroll
                for (int m = 0; m < 4; ++m)
#pragma unroll
                    for (int bj = 0; bj < 2; ++bj) { const u32x4 a4 = av[m][bj], b4 = bv[m][bj];
                        const unsigned aw[4] = {a4.x, a4.y, a4.z, a4.w}, bw[4] = {b4.x, b4.y, b4.z, b4.w};
#pragma unroll
                        for (int j = 0; j < 4; ++j) { const float r0 = bf_lo(aw[j]) * __builtin_amdgcn_rcpf(fmaxf(bf_lo(bw[j]), TINY)), r1 = bf_hi(aw[j]) * __builtin_amdgcn_rcpf(fmaxf(bf_hi(bw[j]), TINY));
                            acc[ai][bj][m][j >> 1][2 * (j & 1)] *= r0; acc[ai][bj][m][j >> 1][2 * (j & 1) + 1] *= r1; } }
            }
        } else {
#pragma unroll
            for (int ai = 0; ai < 2; ++ai) {
                u32x4 bv[4][2];
#pragma unroll
                for (int m = 0; m < 4; ++m)
#pragma unroll
                    for (int bj = 0; bj < 2; ++bj) bv[m][bj] = *(const u32x4*)(gb + (size_t)(row0 + ai * HALF + m * 16) * 1024 + col0 + bj * HALF);
#pragma unroll
                for (int m = 0; m < 4; ++m)
#pragma unroll
                    for (int bj = 0; bj < 2; ++bj) { const size_t off = (size_t)(row0 + ai * HALF + m * 16) * 1024 + col0 + bj * HALF; const u32x4 b4 = bv[m][bj];
                        const f32x4 a0 = acc[ai][bj][m][0], a1 = acc[ai][bj][m][1];
                        float r[8];
                        r[0] = a0[0] * fmaxf(bf_lo(b4.x), TINY); r[1] = a0[1] * fmaxf(bf_hi(b4.x), TINY); r[2] = a0[2] * fmaxf(bf_lo(b4.y), TINY); r[3] = a0[3] * fmaxf(bf_hi(b4.y), TINY);
                        r[4] = a1[0] * fmaxf(bf_lo(b4.z), TINY); r[5] = a1[1] * fmaxf(bf_hi(b4.z), TINY); r[6] = a1[2] * fmaxf(bf_lo(b4.w), TINY); r[7] = a1[3] * fmaxf(bf_hi(b4.w), TINY);
                        u32x4 w; w.x = cvtpk(r[0], r[1]); w.y = cvtpk(r[2], r[3]); w.z = cvtpk(r[4], r[5]); w.w = cvtpk(r[6], r[7]);
                        *(u32x4*)(mixed + off) = w; }
            }
        }
    }
};
struct EpiH1 {
    static constexpr bool PERM = false, ACCUM = false;
    const float* x; bf16_t* H1B; float* SSQ;
    __device__ __forceinline__ void operator()(const f32x4 (&acc)[2][2][4][2], const Unit& u, int wr, int wc, int fr, int fq) const {
        const int row0 = u.pm * BM + wr * 64 + fr, col0 = u.pn * BM + wc * 32 + 4 * fq;
#pragma unroll
        for (int ai = 0; ai < 2; ++ai) {
            f32x4 xv[4][2][2];
#pragma unroll
            for (int m = 0; m < 4; ++m)
#pragma unroll
                for (int bj = 0; bj < 2; ++bj)
#pragma unroll
                    for (int n = 0; n < 2; ++n) xv[m][bj][n] = *(const f32x4*)(x + (size_t)(row0 + ai * HALF + m * 16) * 1024 + col0 + bj * HALF + n * 16);
#pragma unroll
            for (int m = 0; m < 4; ++m) { const int row = row0 + ai * HALF + m * 16; const size_t off = (size_t)row * 1024 + col0; float s = 0.f;
#pragma unroll
                for (int bj = 0; bj < 2; ++bj)
#pragma unroll
                    for (int n = 0; n < 2; ++n) { const f32x4 h = xv[m][bj][n] + acc[ai][bj][m][n];
                        s += (h[0] * h[0] + h[1] * h[1]) + (h[2] * h[2] + h[3] * h[3]);
                        u32x2 hb; hb.x = cvtpk(h[0], h[1]); hb.y = cvtpk(h[2], h[3]); *(u32x2*)(H1B + off + bj * HALF + n * 16) = hb; }
                s += __shfl_xor(s, 16); s += __shfl_xor(s, 32);
                if (fq == 0) SSQ[(size_t)row * 16 + u.pn * 4 + wc] = s; }
        }
    }
};
struct EpiQ {
    static constexpr bool PERM = true, ACCUM = false;
    const float* SSQ; bf16_t* Q; int ldc;
    __device__ __forceinline__ void operator()(const f32x4 (&acc)[2][2][4][2], const Unit& u, int wr, int wc, int fr, int fq) const {
        const int row0 = u.pm * BM + wr * 64 + fr, col0 = u.pn * BM + wc * 32 + 8 * fq;
        float rstd[2][4];
#pragma unroll
        for (int ai = 0; ai < 2; ++ai) { f32x4 sq[4][4];
#pragma unroll
            for (int m = 0; m < 4; ++m) { const f32x4* sp = (const f32x4*)(SSQ + (size_t)(row0 + ai * HALF + m * 16) * 16);
#pragma unroll
                for (int j = 0; j < 4; ++j) sq[m][j] = sp[j]; }
#pragma unroll
            for (int m = 0; m < 4; ++m) { const f32x4 st = (sq[m][0] + sq[m][1]) + (sq[m][2] + sq[m][3]);
                rstd[ai][m] = __builtin_amdgcn_rsqf(((st[0] + st[1]) + (st[2] + st[3])) * (1.0f / 1024.0f) + EPS); } }
#pragma unroll
        for (int ai = 0; ai < 2; ++ai)
#pragma unroll
            for (int m = 0; m < 4; ++m) { const int row = row0 + ai * HALF + m * 16;
                bf16_t* rowp = Q + (size_t)row * ldc + col0;
#pragma unroll
                for (int bj = 0; bj < 2; ++bj) { const f32x4 v0 = acc[ai][bj][m][0] * rstd[ai][m], v1 = acc[ai][bj][m][1] * rstd[ai][m];
                    u32x4 w; w.x = cvtpk(v0[0], v0[1]); w.y = cvtpk(v0[2], v0[3]); w.z = cvtpk(v1[0], v1[1]); w.w = cvtpk(v1[2], v1[3]);
                    *(u32x4*)(rowp + bj * HALF) = w; } }
    }
};
struct EpiF32 {
    static constexpr bool PERM = false, ACCUM = false;
    float* O; int ldc;
    __device__ __forceinline__ void operator()(const f32x4 (&acc)[2][2][4][2], const Unit& u, int wr, int wc, int fr, int fq) const {
        const int row0 = u.pm * BM + wr * 64 + fr, col0 = u.pn * BM + wc * 32 + 4 * fq;
#pragma unroll
        for (int ai = 0; ai < 2; ++ai)
#pragma unroll
            for (int m = 0; m < 4; ++m) { float* rowp = O + (size_t)(row0 + ai * HALF + m * 16) * ldc + col0;
#pragma unroll
                for (int bj = 0; bj < 2; ++bj)
#pragma unroll
                    for (int n = 0; n < 2; ++n) *(f32x4*)(rowp + bj * HALF + n * 16) = acc[ai][bj][m][n]; }
    }
};
struct EpiBf {
    static constexpr bool PERM = true, ACCUM = false;
    bf16_t* O; int ldc;
    __device__ __forceinline__ void operator()(const f32x4 (&acc)[2][2][4][2], const Unit& u, int wr, int wc, int fr, int fq) const {
        const int row0 = u.pm * BM + wr * 64 + fr, col0 = u.pn * BM + wc * 32 + 8 * fq;
#pragma unroll
        for (int ai = 0; ai < 2; ++ai)
#pragma unroll
            for (int m = 0; m < 4; ++m) { bf16_t* rowp = O + (size_t)(row0 + ai * HALF + m * 16) * ldc + col0;
#pragma unroll
                for (int bj = 0; bj < 2; ++bj) { const f32x4 v0 = acc[ai][bj][m][0], v1 = acc[ai][bj][m][1];
                    u32x4 w; w.x = cvtpk(v0[0], v0[1]); w.y = cvtpk(v0[2], v0[3]); w.z = cvtpk(v1[0], v1[1]); w.w = cvtpk(v1[2], v1[3]);
                    *(u32x4*)(rowp + bj * HALF) = w; } }
    }
};
struct EpiH3 {
    static constexpr bool PERM = false, ACCUM = false;
    const bf16_t* H2B; const bf16_t* PLE; const float* RS; bf16_t* H3B; float* SSQ; int dry;
    __device__ __forceinline__ void operator()(const f32x4 (&acc)[2][2][4][2], const Unit& u, int wr, int wc, int fr, int fq) const {
        const int row0 = u.pm * BM + wr * 64 + fr, col0 = u.pn * BM + wc * 32 + 4 * fq;
#pragma unroll
        for (int ai = 0; ai < 2; ++ai) {
            u32x2 hv[4][2][2], pv[4][2][2]; float rs[4];
#pragma unroll
            for (int m = 0; m < 4; ++m) rs[m] = RS[row0 + ai * HALF + m * 16];
#pragma unroll
            for (int m = 0; m < 4; ++m)
#pragma unroll
                for (int bj = 0; bj < 2; ++bj)
#pragma unroll
                    for (int n = 0; n < 2; ++n) { const size_t o2 = (size_t)(row0 + ai * HALF + m * 16) * 1024 + col0 + bj * HALF + n * 16; hv[m][bj][n] = *(const u32x2*)(H2B + o2); pv[m][bj][n] = *(const u32x2*)(PLE + o2); }
#pragma unroll
            for (int m = 0; m < 4; ++m) { const int row = row0 + ai * HALF + m * 16; const size_t off = (size_t)row * 1024 + col0; float s = 0.f;
#pragma unroll
                for (int bj = 0; bj < 2; ++bj)
#pragma unroll
                    for (int n = 0; n < 2; ++n) { const size_t o2 = off + bj * HALF + n * 16; const u32x2 h2 = hv[m][bj][n], p2 = pv[m][bj][n];
                        const f32x4 a = acc[ai][bj][m][n] * rs[m]; f32x4 h;
                        h[0] = bf_lo(h2.x) + bf_lo(p2.x) * fast_sigmoid(a[0]); h[1] = bf_hi(h2.x) + bf_hi(p2.x) * fast_sigmoid(a[1]);
                        h[2] = bf_lo(h2.y) + bf_lo(p2.y) * fast_sigmoid(a[2]); h[3] = bf_hi(h2.y) + bf_hi(p2.y) * fast_sigmoid(a[3]);
                        u32x2 w; w.x = cvtpk(h[0], h[1]); w.y = cvtpk(h[2], h[3]); if (!dry) *(u32x2*)(H3B + o2) = w;
                        s += (h[0] * h[0] + h[1] * h[1]) + (h[2] * h[2] + h[3] * h[3]); }
                s += __shfl_xor(s, 16); s += __shfl_xor(s, 32);
                if (fq == 0) SSQ[(size_t)row * 16 + u.pn * 4 + wc] = s; }
        }
    }
};
constexpr int H3L_PITCH = 544;
struct EpiH3L {
    static constexpr bool PERM = false, ACCUM = false;
    const bf16_t* H2B; const bf16_t* PLE; const float* RS; LAS unsigned char* tile; float* SSQ;
    __device__ __forceinline__ void operator()(const f32x4 (&acc)[2][2][4][2], const Unit& u, int wr, int wc, int fr, int fq) const {
        const int lrow0 = wr * 64 + fr, lcol0 = wc * 32 + 4 * fq, row0 = u.pm * BM + lrow0, col0 = u.pn * BM + lcol0;
        asm volatile("s_waitcnt vmcnt(0)" ::: "memory"); __builtin_amdgcn_s_barrier();
#pragma unroll
        for (int ai = 0; ai < 2; ++ai) {
            u32x2 hv[4][2][2], pv[4][2][2]; float rs[4];
#pragma unroll
            for (int m = 0; m < 4; ++m) rs[m] = RS[row0 + ai * HALF + m * 16];
#pragma unroll
            for (int m = 0; m < 4; ++m)
#pragma unroll
                for (int bj = 0; bj < 2; ++bj)
#pragma unroll
                    for (int n = 0; n < 2; ++n) { const size_t o2 = (size_t)(row0 + ai * HALF + m * 16) * 1024 + col0 + bj * HALF + n * 16; hv[m][bj][n] = *(const u32x2*)(H2B + o2); pv[m][bj][n] = *(const u32x2*)(PLE + o2); }
#pragma unroll
            for (int m = 0; m < 4; ++m) { const int lrow = lrow0 + ai * HALF + m * 16; float s = 0.f;
#pragma unroll
                for (int bj = 0; bj < 2; ++bj)
#pragma unroll
                    for (int n = 0; n < 2; ++n) { const u32x2 h2 = hv[m][bj][n], p2 = pv[m][bj][n];
                        const f32x4 a = acc[ai][bj][m][n] * rs[m]; f32x4 h;
                        h[0] = bf_lo(h2.x) + bf_lo(p2.x) * fast_sigmoid(a[0]); h[1] = bf_hi(h2.x) + bf_hi(p2.x) * fast_sigmoid(a[1]);
                        h[2] = bf_lo(h2.y) + bf_lo(p2.y) * fast_sigmoid(a[2]); h[3] = bf_hi(h2.y) + bf_hi(p2.y) * fast_sigmoid(a[3]);
                        u32x2 w; w.x = cvtpk(h[0], h[1]); w.y = cvtpk(h[2], h[3]); *(LAS u32x2*)(tile + lrow * H3L_PITCH + (lcol0 + bj * HALF + n * 16) * 2) = w;
                        s += (h[0] * h[0] + h[1] * h[1]) + (h[2] * h[2] + h[3] * h[3]); }
                s += __shfl_xor(s, 16); s += __shfl_xor(s, 32);
                if (fq == 0) SSQ[(size_t)(u.pm * BM + lrow) * 16 + u.pn * 4 + wc] = s; }
        }
    }
};
}
constexpr size_t MiB = 1u << 20;
constexpr size_t WS_CTL = 0, CTL_ZERO_BYTES = 64 * 1024;
constexpr size_t WS_PEND = 64 * 1024;
constexpr size_t WS_WPLE = 512 * 1024;
constexpr size_t WS_KD = 1 * MiB;
constexpr size_t WS_GLAG = 2 * MiB;
constexpr size_t WS_WIN = 3 * MiB;
constexpr size_t WS_SEND = 4 * MiB;
constexpr size_t WS_EXP = 4 * MiB;
constexpr size_t WS_SSQ1 = 13 * MiB;
constexpr size_t WS_SSQ3 = 14 * MiB;
constexpr size_t WS_RS3 = 15 * MiB;
constexpr size_t WS_RSU = 1536 * 1024, WS_RSV = 1536 * 1024 + 64 * 1024;
constexpr size_t WS_WGA = 20 * MiB, WS_WSB = 22 * MiB, WS_WO = 24 * MiB, WS_WPG = 26 * MiB, WS_WPQ = 28 * MiB;
constexpr size_t WS_A = 32 * MiB;
constexpr size_t WS_GQ = WS_A, WS_GK = WS_A + 16 * MiB;
constexpr size_t WS_B = 64 * MiB;
constexpr size_t WS_GV = WS_B, WS_PB = WS_B;
constexpr size_t WS_C = 96 * MiB;
constexpr size_t WS_GR = WS_C, WS_GLAN = WS_C, WS_H1 = WS_C, WS_H3B = WS_C;
constexpr size_t WS_D = 128 * MiB;
constexpr size_t WS_SQ = WS_D, WS_H2B = WS_D;
constexpr size_t WS_E = 160 * MiB;
constexpr size_t WS_SK = WS_E, WS_MIX = WS_E, WS_Q = WS_E, WS_PLE = WS_E;
constexpr size_t WS_F = 192 * MiB;
constexpr size_t WS_SV = WS_F;
constexpr size_t WS_G = 224 * MiB;
constexpr size_t WS_XN1 = WS_G, WS_UB8 = WS_G, WS_VB8 = WS_G + 16 * MiB;
constexpr size_t WS_END = 256 * MiB;

constexpr int NWAVES = 8;
constexpr int RING_OFF = 0, RING_BYTES = 131072;
constexpr int MISC_OFF = 143360;
constexpr int LDS_BYTES = 147456;
constexpr int CW_BAR = 1024;
constexpr int CW_ROWCNT = 512;

typedef GAS unsigned gu32;
#define RLX_AGENT __ATOMIC_RELAXED, __HIP_MEMORY_SCOPE_AGENT
#define LDS_WAIT() asm volatile("s_waitcnt lgkmcnt(0)" ::: "memory")
#define VM_WAIT() asm volatile("s_waitcnt vmcnt(0)" ::: "memory")

#define XB_TMO      128
#define XB_XCNT(j)  (256  + 64 * (j))
#define XB_XSUB(j)  (1280 + 64 * (j))
#define XB_XGEN(j)  (2304 + 64 * (j))
#define XB_TOP      3328
#define XB_TOPGEN   3392
#define XCD_BAR_WORDS 3456
#define XB_SPIN_CAP (1u << 22)
__device__ __forceinline__ unsigned xb_ld(unsigned* p)              { return __hip_atomic_load(p, __ATOMIC_RELAXED, __HIP_MEMORY_SCOPE_AGENT); }
__device__ __forceinline__ unsigned xb_add(unsigned* p, unsigned v) { return __hip_atomic_fetch_add(p, v, __ATOMIC_RELAXED, __HIP_MEMORY_SCOPE_AGENT); }
__device__ __forceinline__ unsigned xb_xcc_id() { return (unsigned)__builtin_amdgcn_s_getreg((3 << 11) | 20) & 0xFu; }
#define XB_SPIN(cond, bar) do { unsigned _sp = 0; while (cond) { __builtin_amdgcn_s_sleep(1); \
    if ((++_sp & 255u) == 0u) { if (xb_ld(&(bar)[XB_TMO])) break; if (_sp > XB_SPIN_CAP) { atomicAdd(&(bar)[XB_TMO], 1u); break; } } } } while (0)
struct XcdBarrier { unsigned* bar; unsigned x; volatile LAS unsigned* st; };
__device__ __forceinline__ XcdBarrier xcd_barrier_post(unsigned* bar, volatile LAS unsigned* st, int tid) {
    XcdBarrier b; b.bar = bar; b.x = xb_xcc_id(); b.st = st;
    if (tid == 0) (void)xb_add(&bar[XB_XCNT(b.x)], 1u);
    return b;
}
__device__ __forceinline__ void xcd_barrier_complete(unsigned* bar, unsigned x, unsigned& nloc, unsigned& nx) {
    const unsigned G = gridDim.x * gridDim.y * gridDim.z;
    unsigned sum, cnt, mine, sp = 0u;
    for (;;) {
        sum = 0u; cnt = 0u; mine = 0u;
#pragma unroll
        for (unsigned j = 0; j < 16; ++j) { const unsigned c = xb_ld(&bar[XB_XCNT(j)]); sum += c; cnt += (c > 0u) ? 1u : 0u; mine = (j == x) ? c : mine; }
        if (sum == G) break;
        __builtin_amdgcn_s_sleep(1);
        if ((++sp & 255u) == 0u) { if (xb_ld(&bar[XB_TMO])) break; if (sp > XB_SPIN_CAP) { atomicAdd(&bar[XB_TMO], 1u); break; } }
    }
    nloc = mine > 0u ? mine : 1u; nx = cnt > 0u ? cnt : 1u;
}
__device__ __forceinline__ void xcd_barrier(const XcdBarrier& b, int tid) {
    asm volatile("s_waitcnt vmcnt(0)" ::: "memory");
    __syncthreads();
    if (tid == 0) {
        unsigned* bar = b.bar;
        __builtin_amdgcn_s_waitcnt(0);
        unsigned nloc = b.st[0], nx = b.st[1];
        if (nloc == 0u) { xcd_barrier_complete(bar, b.x, nloc, nx); b.st[0] = nloc; b.st[1] = nx; }
        const unsigned old = xb_add(&bar[XB_XSUB(b.x)], 1u);
        const unsigned gen = old / nloc;
        if (old + 1u == (gen + 1u) * nloc) {
            __builtin_amdgcn_fence(__ATOMIC_RELEASE, "agent");
            asm volatile("s_waitcnt vmcnt(0)" ::: "memory");
            const unsigned og = xb_add(&bar[XB_TOP], 1u);
            const unsigned tg = og / nx;
            if (og + 1u == (tg + 1u) * nx) xb_add(&bar[XB_TOPGEN], 1u);
            else XB_SPIN(xb_ld(&bar[XB_TOPGEN]) == tg, bar);
            __builtin_amdgcn_fence(__ATOMIC_ACQUIRE, "agent");
            xb_add(&bar[XB_XGEN(b.x)], 1u);
            asm volatile("s_waitcnt vmcnt(0)" ::: "memory");
        } else {
            XB_SPIN(xb_ld(&bar[XB_XGEN(b.x)]) == gen, bar);
            __builtin_amdgcn_fence(__ATOMIC_ACQUIRE, "agent");
            asm volatile("s_waitcnt vmcnt(0)" ::: "memory");
        }
    }
    __syncthreads();
}

struct Frame {
    LAS unsigned char* lds;
    int tid, lane, wave, vcu, G, dry;
    const float* const* in; float* out; unsigned char* ws;
};
__device__ __forceinline__ int lane_id() { int l; asm volatile("v_mbcnt_lo_u32_b32 %0, -1, 0\n\tv_mbcnt_hi_u32_b32 %0, -1, %0" : "=v"(l)); return l; }
#define WSP(T, off) ((T*)(F.ws + (off)))
__device__ __forceinline__ float wave_sum(float v) {
#pragma unroll
    for (int o = 1; o < 64; o <<= 1) v += __shfl_xor(v, o);
    return v;
}
template <class RowMap>
__device__ __forceinline__ void p0_transpose_item(const float* W, int K, int N, bf16_t* WT, RowMap rm, LAS float* scr, int item, int lane, const float* gk = nullptr) {
    const int nblk = (N + 31) / 32, kb = item / nblk, nb = item % nblk, k0 = 64 * kb, n0 = 32 * nb;
    { const int kr = lane >> 3, c4 = lane & 7, nl = n0 + 4 * c4; f32x4 v[8];
#pragma unroll
      for (int i = 0; i < 8; ++i) v[i] = (nl < N) ? *(const f32x4*)(W + (size_t)(k0 + 8 * i + kr) * N + nl) : (f32x4){0.f, 0.f, 0.f, 0.f};
#pragma unroll
      for (int i = 0; i < 8; ++i) { LAS float* d = scr + (8 * i + kr) * 33 + 4 * c4; d[0] = v[i][0]; d[1] = v[i][1]; d[2] = v[i][2]; d[3] = v[i][3]; } }
    LDS_WAIT(); asm volatile("" ::: "memory");
    const int c = lane & 7;
#pragma unroll
    for (int j = 0; j < 4; ++j) { const int n = (lane >> 3) + 8 * j; const LAS float* s = scr + (8 * c) * 33 + n;
        f32x4 ga = (f32x4){1.f, 1.f, 1.f, 1.f}, gb = ga; if (gk) { ga = *(const f32x4*)(gk + k0 + 8 * c); gb = *(const f32x4*)(gk + k0 + 8 * c + 4); }
        u32x4 o; o.x = cvtpk(s[0 * 33] * ga[0], s[1 * 33] * ga[1]); o.y = cvtpk(s[2 * 33] * ga[2], s[3 * 33] * ga[3]); o.z = cvtpk(s[4 * 33] * gb[0], s[5 * 33] * gb[1]); o.w = cvtpk(s[6 * 33] * gb[2], s[7 * 33] * gb[3]);
        if (n0 + n < N) *(u32x4*)(WT + (size_t)rm(n0 + n) * K + k0 + 8 * c) = o; }
    LDS_WAIT(); asm volatile("" ::: "memory");
}
struct RmId { __device__ __forceinline__ int operator()(int n) const { return n; } };
struct RmWin { __device__ __forceinline__ int operator()(int n) const { return n < 3072 ? n : (n < 3088 ? 8192 + (n - 3072) : n - 16); } };

__device__ __forceinline__ void cvt_copy(Frame& F, const float* src, bf16_t* dst, size_t n) {
    const size_t nth = (size_t)F.G * 512, n8 = n / 8;
    for (size_t i = (size_t)F.vcu * 512 + F.tid; i < n8; i += nth) {
        const f32x4 a = *(const f32x4*)(src + i * 8), b = *(const f32x4*)(src + i * 8 + 4);
        u32x4 o; o.x = cvtpk(a[0], a[1]); o.y = cvtpk(a[2], a[3]); o.z = cvtpk(b[0], b[1]); o.w = cvtpk(b[2], b[3]);
        *(u32x4*)(dst + i * 8) = o; }
}
__device__ __forceinline__ void rms_row_to_bf16(const float* xrow, const float* g, bf16_t* orow, int lane) {
    f32x4 v[4]; float s = 0.f;
#pragma unroll
    for (int j = 0; j < 4; ++j) { v[j] = *((const f32x4*)xrow + lane + 64 * j); s += (v[j][0] * v[j][0] + v[j][1] * v[j][1]) + (v[j][2] * v[j][2] + v[j][3] * v[j][3]); }
    const float rstd = __builtin_amdgcn_rsqf(wave_sum(s) * (1.f / 1024.f) + EPS);
#pragma unroll
    for (int j = 0; j < 4; ++j) { const f32x4 gv = *((const f32x4*)g + lane + 64 * j); const f32x4 o = v[j] * rstd * gv;
        u32x2 w; w.x = cvtpk(o[0], o[1]); w.y = cvtpk(o[2], o[3]); *((u32x2*)orow + lane + 64 * j) = w; }
}
__device__ __forceinline__ void phase_prologue(Frame& F) {
    LAS float* scr = (LAS float*)(F.lds + RING_OFF + F.wave * 16384);
    const int gw = F.vcu * NWAVES + F.wave, NGW = F.G * NWAVES;
    constexpr int I_IN = 16 * 257, I_SQ = 16 * 32, I_PQ = 16 * 64, I_PLE = 4 * 32;
    constexpr int NITEMS = I_IN + 4 * I_SQ + I_PQ + I_PLE;
    for (int it = gw; it < NITEMS; it += NGW) {
        int r = it;
        if (r < I_IN) { p0_transpose_item(F.in[3], 1024, 8208, WSP(bf16_t, WS_WIN), RmWin(), scr, r, F.lane); continue; } r -= I_IN;
        if (r < I_SQ) { p0_transpose_item(F.in[7], 1024, 1024, WSP(bf16_t, WS_WGA), RmId(), scr, r, F.lane); continue; } r -= I_SQ;
        if (r < I_SQ) { p0_transpose_item(F.in[8], 1024, 1024, WSP(bf16_t, WS_WSB), RmId(), scr, r, F.lane); continue; } r -= I_SQ;
        if (r < I_SQ) { p0_transpose_item(F.in[9], 1024, 1024, WSP(bf16_t, WS_WO), RmId(), scr, r, F.lane); continue; } r -= I_SQ;
        if (r < I_SQ) { p0_transpose_item(F.in[17], 1024, 1024, WSP(bf16_t, WS_WPG), RmId(), scr, r, F.lane, F.in[16]); continue; } r -= I_SQ;
        if (r < I_PQ) { p0_transpose_item(F.in[11], 1024, 2048, WSP(bf16_t, WS_WPQ), RmId(), scr, r, F.lane, F.in[10]); continue; } r -= I_PQ;
        p0_transpose_item(F.in[18], 256, 1024, WSP(bf16_t, WS_WPLE), RmId(), scr, r, F.lane);
    }
    { const float* k1 = F.in[12]; const float* k2 = F.in[13]; bf16_t* KB = WSP(bf16_t, WS_KD);
      for (int i = F.vcu * 512 + F.tid; i < 2 * 8 * 128 * 16; i += F.G * 512) { const int half = i >> 14, rem = i & 16383, h = rem >> 11, r8 = rem & 2047;
          const float* s = (half ? k2 : k1) + (size_t)h * 16384 + (size_t)r8 * 8; const f32x4 a = *(const f32x4*)s, b = *(const f32x4*)(s + 4);
          u32x4 o; o.x = cvtpk(a[0], a[1]); o.y = cvtpk(a[2], a[3]); o.z = cvtpk(b[0], b[1]); o.w = cvtpk(b[2], b[3]);
          *(u32x4*)(KB + (size_t)(h * 2 + half) * 16384 + (size_t)r8 * 8) = o; } }
    for (int m = gw; m < T_TOK; m += 4 * NGW) {
        f32x4 v[4][4]; float s[4];
#pragma unroll
        for (int q = 0; q < 4; ++q) { const float* xr = F.in[0] + (size_t)(m + q * NGW) * 1024; s[q] = 0.f;
#pragma unroll
            for (int j = 0; j < 4; ++j) { v[q][j] = *((const f32x4*)xr + F.lane + 64 * j); s[q] += (v[q][j][0] * v[q][j][0] + v[q][j][1] * v[q][j][1]) + (v[q][j][2] * v[q][j][2] + v[q][j][3] * v[q][j][3]); } }
#pragma unroll
        for (int o = 1; o < 64; o <<= 1) {
#pragma unroll
            for (int q = 0; q < 4; ++q) s[q] += __shfl_xor(s[q], o); }
#pragma unroll
        for (int q = 0; q < 4; ++q) { const float rstd = __builtin_amdgcn_rsqf(s[q] * (1.f / 1024.f) + EPS); bf16_t* orow = WSP(bf16_t, WS_XN1) + (size_t)(m + q * NGW) * 1024;
#pragma unroll
            for (int j = 0; j < 4; ++j) { const f32x4 gv = *((const f32x4*)F.in[2] + F.lane + 64 * j); const f32x4 o = v[q][j] * rstd * gv;
                u32x2 wq; wq.x = cvtpk(o[0], o[1]); wq.y = cvtpk(o[2], o[3]); *((u32x2*)orow + F.lane + 64 * j) = wq; } }
    }
}

__device__ __forceinline__ void phase_gla_prep(Frame& F) {
    LAS float* alo = (LAS float*)(F.lds + RING_OFF);
    const bf16_t* XN1 = WSP(bf16_t, WS_XN1); const bf16_t* WGAT = WSP(bf16_t, WS_WIN) + (size_t)8192 * 1024;
    bf16_t* GKT = WSP(bf16_t, WS_GK); float* GLAG = WSP(float, WS_GLAG);
    const float* w_up = F.in[4]; const float* b_a = F.in[5];
    const int tid = F.tid, lane = F.lane, w = F.wave;
    for (int u = F.vcu; u < 256; u += F.G) {
        const size_t r0 = (size_t)u * 64;
        __syncthreads();
        const int kk = tid;
        bf16_t* krow = GKT + (size_t)kk * T_TOK + r0;
        u32x4 kq[8];
#pragma unroll
        for (int j = 0; j < 8; ++j) kq[j] = *(const u32x4*)(krow + 8 * j);
        {
            LAS float* part = alo + 1024;
            const bf16_t* bp = WGAT + (size_t)(lane & 15) * 1024 + 8 * (lane >> 4) + 128 * w;
            bf16x8 bq[4];
#pragma unroll
            for (int s = 0; s < 4; ++s) bq[s] = *(const bf16x8*)(bp + 32 * s);
#pragma unroll
            for (int rt = 0; rt < 4; ++rt) { f32x4 acc = (f32x4){0.f, 0.f, 0.f, 0.f};
                const bf16_t* ap = XN1 + (r0 + 16 * rt + (lane & 15)) * 1024 + 8 * (lane >> 4) + 128 * w;
#pragma unroll
                for (int s = 0; s < 4; ++s) { const bf16x8 a = *(const bf16x8*)(ap + 32 * s); acc = __builtin_amdgcn_mfma_f32_16x16x32_bf16(a, bq[s], acc, 0, 0, 0); }
#pragma unroll
                for (int r = 0; r < 4; ++r) part[w * 1024 + (16 * rt + 4 * (lane >> 4) + r) * 16 + (lane & 15)] = acc[r]; }
            __syncthreads();
#pragma unroll
            for (int q = 0; q < 2; ++q) { const int e = tid + 512 * q; float s = 0.f;
#pragma unroll
                for (int ww = 0; ww < 8; ++ww) s += part[ww * 1024 + e];
                alo[e] = s; }
        }
        float wv[16];
#pragma unroll
        for (int r = 0; r < 16; ++r) wv[r] = w_up[r * 512 + kk];
        const float bias = b_a[kk];
        __syncthreads();
        float suffix = 0.f;
#pragma unroll
        for (int i8 = 7; i8 >= 0; --i8) {
            const unsigned kw[4] = {kq[i8].x, kq[i8].y, kq[i8].z, kq[i8].w};
            float o[8];
#pragma unroll
            for (int j = 7; j >= 0; --j) { const int i = i8 * 8 + j;
                const f32x4 a0 = *(const LAS f32x4*)(alo + i * 16), a1 = *(const LAS f32x4*)(alo + i * 16 + 4), a2 = *(const LAS f32x4*)(alo + i * 16 + 8), a3 = *(const LAS f32x4*)(alo + i * 16 + 12);
                float x = bias;
                x += a0[0] * wv[0] + a0[1] * wv[1] + a0[2] * wv[2] + a0[3] * wv[3];
                x += a1[0] * wv[4] + a1[1] * wv[5] + a1[2] * wv[6] + a1[3] * wv[7];
                x += a2[0] * wv[8] + a2[1] * wv[9] + a2[2] * wv[10] + a2[3] * wv[11];
                x += a3[0] * wv[12] + a3[1] * wv[13] + a3[2] * wv[14] + a3[3] * wv[15];
                const float la = (fminf(x, 0.f) - __logf(1.0f + __expf(-fabsf(x)))) * (1.0f / 16.0f);
                const float kvv = (j & 1) ? bf_hi(kw[j >> 1]) : bf_lo(kw[j >> 1]);
                o[j] = kvv * __expf(suffix);
                suffix += la; }
            u32x4 pk; pk.x = cvtpk(o[0], o[1]); pk.y = cvtpk(o[2], o[3]); pk.z = cvtpk(o[4], o[5]); pk.w = cvtpk(o[6], o[7]);
            if (!F.dry) *(u32x4*)(krow + i8 * 8) = pk; }
        GLAG[(size_t)u * 512 + kk] = __expf(suffix);
    }
}
constexpr int GL_KD = 0, GL_Q = 32768, GL_G = 65536, GL_RED = 65536 + 1024;
__device__ __forceinline__ int gl_kd_off(int row, int chunk) { return row * 128 + ((chunk ^ ((row >> 1) & 7)) << 4); }
__device__ __forceinline__ int gl_q_off(int row, int chunk16) { return row * 256 + ((chunk16 ^ (row & 15)) << 4); }

struct GlaStage { u32x4 kd[2]; u32x4 q[2]; bf16x8 vt[4]; float g; };
__device__ __forceinline__ void gla_prefetch_vt(Frame& F, GlaStage& st, int b, int h, int c) {
    const int u = b * 64 + c; const size_t r0 = (size_t)u * 64; const int w = F.wave, lq = F.lane & 31, hh = F.lane >> 5;
    const bf16_t* vt = WSP(bf16_t, WS_GV) + (size_t)(h * 256 + 32 * w + lq) * T_TOK + r0;
#pragma unroll
    for (int ts = 0; ts < 4; ++ts) st.vt[ts] = *(const bf16x8*)(vt + 16 * ts + 8 * hh);
}
template <bool WITH_Q>
__device__ __forceinline__ void gla_prefetch(Frame& F, GlaStage& st, int b, int h, int c) {
    const int u = b * 64 + c; const size_t r0 = (size_t)u * 64; const int tid = F.tid;
    const bf16_t* kd = WSP(bf16_t, WS_GK) + (size_t)(h * 128) * T_TOK + r0;
#pragma unroll
    for (int j = 0; j < 2; ++j) { const int pi = tid + 512 * j; st.kd[j] = *(const u32x4*)(kd + (size_t)(pi >> 3) * T_TOK + (pi & 7) * 8); }
    if (WITH_Q) { const bf16_t* gq = WSP(bf16_t, WS_GQ) + r0 * 512 + h * 128;
#pragma unroll
        for (int j = 0; j < 2; ++j) { const int pi = tid + 512 * j; st.q[j] = *(const u32x4*)(gq + (size_t)(pi >> 4) * 512 + (pi & 15) * 8); } }
    st.g = (tid < 128) ? WSP(float, WS_GLAG)[((size_t)u * 4 + h) * 128 + tid] : 1.f;
}
template <bool WITH_Q>
__device__ __forceinline__ void gla_stage_write(Frame& F, const GlaStage& st, int buf) {
    LAS unsigned char* lds = F.lds + RING_OFF; const int tid = F.tid;
#pragma unroll
    for (int j = 0; j < 2; ++j) { const int pi = tid + 512 * j; *(LAS u32x4*)(lds + GL_KD + buf * 16384 + gl_kd_off(pi >> 3, pi & 7)) = st.kd[j]; }
    if (WITH_Q) {
#pragma unroll
        for (int j = 0; j < 2; ++j) { const int pi = tid + 512 * j; *(LAS u32x4*)(lds + GL_Q + buf * 16384 + gl_q_off(pi >> 4, pi & 15)) = st.q[j]; } }
    if (tid < 128) *(LAS float*)(lds + GL_G + buf * 512 + tid * 4) = st.g;
}
__device__ __forceinline__ void gla_update(Frame& F, f32x16 (&S)[4], const bf16x8 (&vt)[4], int buf) {
    const LAS unsigned char* lds = F.lds + RING_OFF; const int lq = F.lane & 31, hh = F.lane >> 5;
    const LAS float* G = (const LAS float*)(lds + GL_G + buf * 512);
#pragma unroll
    for (int kt = 0; kt < 4; ++kt)
#pragma unroll
        for (int g4 = 0; g4 < 4; ++g4) { const f32x4 g = *(const LAS f32x4*)(G + 32 * kt + 8 * g4 + 4 * hh);
#pragma unroll
            for (int j = 0; j < 4; ++j) S[kt][4 * g4 + j] *= g[j]; }
#pragma unroll
    for (int ts = 0; ts < 4; ++ts)
#pragma unroll
        for (int kt = 0; kt < 4; ++kt) { const bf16x8 a = *(const LAS bf16x8*)(lds + GL_KD + buf * 16384 + gl_kd_off(32 * kt + lq, 2 * ts + hh));
            S[kt] = __builtin_amdgcn_mfma_f32_32x32x16_bf16(a, vt[ts], S[kt], 0, 0, 0); if (kt == 3 && (ts & 1)) __builtin_amdgcn_sched_barrier(0); }
}
constexpr size_t SEND_WAVE_FLOATS = 4 * 4 * 64 * 4;
__device__ __forceinline__ void gla_stage1(Frame& F, int unit) {
    const int bh = unit >> 3, seg = unit & 7, b = bh >> 2, h = bh & 3, w = F.wave, l = F.lane;
    f32x16 S[4];
#pragma unroll
    for (int kt = 0; kt < 4; ++kt)
#pragma unroll
        for (int r = 0; r < 16; ++r) S[kt][r] = 0.f;
    float pend = 1.f;
    GlaStage st; gla_prefetch<false>(F, st, b, h, seg * 8); gla_prefetch_vt(F, st, b, h, seg * 8);
    for (int ci = 0; ci < 8; ++ci) {
        gla_stage_write<false>(F, st, ci & 1); pend *= st.g;
        __syncthreads();
        if (ci < 7) gla_prefetch<false>(F, st, b, h, seg * 8 + ci + 1);
        gla_update(F, S, st.vt, ci & 1);
        if (ci < 7) gla_prefetch_vt(F, st, b, h, seg * 8 + ci + 1);
    }
    float* se = WSP(float, WS_SEND) + ((size_t)unit * 8 + w) * SEND_WAVE_FLOATS;
#pragma unroll
    for (int kt = 0; kt < 4; ++kt)
#pragma unroll
        for (int g4 = 0; g4 < 4; ++g4) *(f32x4*)(se + ((kt * 4 + g4) * 64 + l) * 4) = (f32x4){S[kt][4 * g4], S[kt][4 * g4 + 1], S[kt][4 * g4 + 2], S[kt][4 * g4 + 3]};
    if (F.tid < 128) WSP(float, WS_PEND)[unit * 128 + F.tid] = pend;
    __syncthreads();
}
__device__ __forceinline__ void gla_stage3(Frame& F, int unit) {
    const int bh = unit >> 3, seg = unit & 7, b = bh >> 2, h = bh & 3, w = F.wave, l = F.lane, lq = l & 31, hh = l >> 5;
    LAS unsigned char* lds = F.lds + RING_OFF;
    const bf16_t* GR = WSP(bf16_t, WS_GR); bf16_t* GLAN = WSP(bf16_t, WS_GLAN); const float* g_o = F.in[6];
    f32x16 S[4];
#pragma unroll
    for (int kt = 0; kt < 4; ++kt)
#pragma unroll
        for (int r = 0; r < 16; ++r) S[kt][r] = 0.f;
    GlaStage st; gla_prefetch<true>(F, st, b, h, seg * 8); gla_prefetch_vt(F, st, b, h, seg * 8);
    for (int sp = 0; sp < seg; ++sp) {
        const int un = bh * 8 + sp; const float* se = WSP(float, WS_SEND) + ((size_t)un * 8 + w) * SEND_WAVE_FLOATS; const float* pe = WSP(float, WS_PEND) + un * 128;
#pragma unroll
        for (int kt = 0; kt < 4; ++kt)
#pragma unroll
            for (int g4 = 0; g4 < 4; ++g4) { const f32x4 p = *(const f32x4*)(pe + 32 * kt + 8 * g4 + 4 * hh); const f32x4 s = *(const f32x4*)(se + ((kt * 4 + g4) * 64 + l) * 4);
#pragma unroll
                for (int j = 0; j < 4; ++j) S[kt][4 * g4 + j] = S[kt][4 * g4 + j] * p[j] + s[j]; }
    }
    for (int ci = 0; ci < 8; ++ci) {
        const int c = seg * 8 + ci; const size_t r0 = (size_t)(b * 64 + c) * 64; const int buf = ci & 1;
        gla_stage_write<true>(F, st, buf);
        __syncthreads();
        if (ci < 7) gla_prefetch<true>(F, st, b, h, c + 1);
        gla_update(F, S, st.vt, buf);
        f32x16 oT[2];
#pragma unroll
        for (int tt = 0; tt < 2; ++tt) {
#pragma unroll
            for (int r = 0; r < 16; ++r) oT[tt][r] = 0.f;
            const int t = 32 * tt + lq;
#pragma unroll
            for (int kt = 0; kt < 4; ++kt)
#pragma unroll
                for (int s = 0; s < 2; ++s) {
                    u32x4 aw; aw.x = cvtpk(S[kt][8 * s + 0], S[kt][8 * s + 1]); aw.y = cvtpk(S[kt][8 * s + 2], S[kt][8 * s + 3]); aw.z = cvtpk(S[kt][8 * s + 4], S[kt][8 * s + 5]); aw.w = cvtpk(S[kt][8 * s + 6], S[kt][8 * s + 7]);
                    const u32x2 qlo = *(const LAS u32x2*)(lds + GL_Q + buf * 16384 + gl_q_off(t, 4 * kt + 2 * s) + 8 * hh), qhi = *(const LAS u32x2*)(lds + GL_Q + buf * 16384 + gl_q_off(t, 4 * kt + 2 * s + 1) + 8 * hh);
                    const u32x4 bw = (u32x4){qlo.x, qlo.y, qhi.x, qhi.y};
                    oT[tt] = __builtin_amdgcn_mfma_f32_32x32x16_bf16(__builtin_bit_cast(bf16x8, aw), __builtin_bit_cast(bf16x8, bw), oT[tt], 0, 0, 0);
                    if (s == 1 && (kt & 1)) __builtin_amdgcn_sched_barrier(0); }
        }
        LAS float* redc = (LAS float*)(lds + GL_RED) + buf * 512;
#pragma unroll
        for (int tt = 0; tt < 2; ++tt) { float s = 0.f;
#pragma unroll
            for (int r = 0; r < 16; ++r) s += oT[tt][r] * oT[tt][r];
            s += __shfl_xor(s, 32);
            if (hh == 0) redc[w * 64 + 32 * tt + lq] = s; }
        if (ci < 7) gla_prefetch_vt(F, st, b, h, c + 1);
        u32x2 sr[2][4];
#pragma unroll
        for (int tt = 0; tt < 2; ++tt)
#pragma unroll
            for (int g4 = 0; g4 < 4; ++g4) sr[tt][g4] = *(const u32x2*)(GR + (r0 + 32 * tt + lq) * 1024 + h * 256 + 32 * w + 8 * g4 + 4 * hh);
        __syncthreads();
#pragma unroll
        for (int tt = 0; tt < 2; ++tt) { float tot = 0.f;
#pragma unroll
            for (int ww = 0; ww < 8; ++ww) tot += redc[ww * 64 + 32 * tt + lq];
            const float rstd = __builtin_amdgcn_rsqf(tot * (1.0f / 256.0f) + EPS);
            const size_t row = r0 + 32 * tt + lq;
#pragma unroll
            for (int g4 = 0; g4 < 4; ++g4) { const int v0 = h * 256 + 32 * w + 8 * g4 + 4 * hh;
                const f32x4 go = *(const f32x4*)(g_o + v0);
                const float o0 = oT[tt][4 * g4 + 0] * rstd * go[0] * bf_lo(sr[tt][g4].x), o1 = oT[tt][4 * g4 + 1] * rstd * go[1] * bf_hi(sr[tt][g4].x);
                const float o2 = oT[tt][4 * g4 + 2] * rstd * go[2] * bf_lo(sr[tt][g4].y), o3 = oT[tt][4 * g4 + 3] * rstd * go[3] * bf_hi(sr[tt][g4].y);
                u32x2 wv; wv.x = cvtpk(o0, o1); wv.y = cvtpk(o2, o3); if (!F.dry) *(u32x2*)(GLAN + row * 1024 + v0) = wv; } }
    }
    __syncthreads();
}

constexpr int SB_TILE = 16384, SB_FLAG = 7 * SB_TILE;
typedef short v4i16_t __attribute__((ext_vector_type(4)));
__device__ __forceinline__ s16x4 vtr(const LAS unsigned char* p) { return __builtin_bit_cast(s16x4, __builtin_amdgcn_ds_read_tr16_b64_v4i16((LAS v4i16_t*)p)); }
__device__ __forceinline__ float partner32(float x, int hh) { auto rr = __builtin_amdgcn_permlane32_swap(__float_as_uint(x), __float_as_uint(x), false, false); return __uint_as_float(hh ? rr[0] : rr[1]); }
__device__ __forceinline__ int sbk_off(int key, int chunk) { return key * 128 + ((chunk ^ ((key >> 1) & 7)) << 4); }
__device__ __forceinline__ int sbv_off(int key, int chunk) { return 8192 + key * 128 + ((chunk ^ (((key >> 1) & 1) << 2)) << 4); }

template <bool DIAG>
__device__ __forceinline__ void sb_tile_t(const LAS unsigned char* tile, int kt, int qabs, int l, const bf16x8 (&qf)[4], f32x16& o0, f32x16& o1, float& carry) {
    const int lq = l & 31, hh = l >> 5, g1 = (l >> 4) & 1, i = l & 15;
    float run = carry;
#pragma unroll
    for (int half = 1; half >= 0; --half) {
        f32x16 p;
#pragma unroll
        for (int r = 0; r < 16; ++r) p[r] = 0.f;
#pragma unroll
        for (int s = 0; s < 4; ++s) { const bf16x8 a = *(const LAS bf16x8*)(tile + sbk_off(32 * half + lq, 2 * s + hh)); p = __builtin_amdgcn_mfma_f32_32x32x16_bf16(a, qf[s], p, 0, 0, 0); }
        float st[16], be[16];
#pragma unroll
        for (int r = 0; r < 16; ++r) { const float ee = __builtin_amdgcn_exp2f(fminf(p[r], 80.0f)); float s_ = __builtin_amdgcn_rcpf(1.0f + ee); float b_ = ee * s_;
            if (DIAG) { const int key = 64 * kt + 32 * half + (r & 3) + 8 * (r >> 2) + 4 * hh; if (key >= qabs) { s_ = 1.0f; b_ = 0.f; } }
            st[r] = s_; be[r] = b_; }
        float tot[4];
#pragma unroll
        for (int g4 = 0; g4 < 4; ++g4) { float* sg = &st[4 * g4]; float* bg = &be[4 * g4];
            const float a2 = sg[3], a1 = sg[2] * a2, a0 = sg[1] * a1; tot[g4] = sg[0] * a0;
            bg[2] *= a2; bg[1] *= a1; bg[0] *= a0; }
        float E[4];
#pragma unroll
        for (int m = 3; m >= 0; --m) { const float tp = partner32(tot[m], hh); E[m] = hh ? run : run * tp; run *= tot[m] * tp; }
        u32x4 pw[2];
#pragma unroll
        for (int s = 0; s < 2; ++s) { float wv[8];
#pragma unroll
            for (int j = 0; j < 8; ++j) { const int r = 8 * s + j; wv[j] = be[r] * E[r >> 2]; }
            pw[s] = (u32x4){cvtpk(wv[0], wv[1]), cvtpk(wv[2], wv[3]), cvtpk(wv[4], wv[5]), cvtpk(wv[6], wv[7])}; }
#pragma unroll
        for (int s = 0; s < 2; ++s) { const bf16x8 pb = __builtin_bit_cast(bf16x8, pw[s]);
            const int k0 = 32 * half + 16 * s + 4 * hh + (i >> 2), k1 = k0 + 8;
#pragma unroll
            for (int dt = 0; dt < 2; ++dt) { const int ch = 4 * dt + 2 * g1 + ((i & 3) >> 1);
                const s16x4 lo = vtr(tile + sbv_off(k0, ch) + 8 * (i & 1)), hi = vtr(tile + sbv_off(k1, ch) + 8 * (i & 1));
                const bf16x8 a = (bf16x8){lo[0], lo[1], lo[2], lo[3], hi[0], hi[1], hi[2], hi[3]};
                if (dt == 0) o0 = __builtin_amdgcn_mfma_f32_32x32x16_bf16(a, pb, o0, 0, 0, 0); else o1 = __builtin_amdgcn_mfma_f32_32x32x16_bf16(a, pb, o1, 0, 0, 0); } }
        if (half == 1 && __all(run == 0.0f)) break;
    }
    carry = run;
}
__device__ __forceinline__ void sb_tile(const LAS unsigned char* tile, int kt, int q0, int qabs, int l, const bf16x8 (&qf)[4], f32x16& o0, f32x16& o1, float& carry) {
    if (64 * kt + 63 >= q0) sb_tile_t<true>(tile, kt, qabs, l, qf, o0, o1, carry); else sb_tile_t<false>(tile, kt, qabs, l, qf, o0, o1, carry);
}
__device__ __forceinline__ void sb_attn_unit(Frame& F, int uidx) {
    const int bh = uidx >> 4, qb = uidx & 15, b = bh >> 4, h = bh & 15;
    LAS unsigned char* lds = F.lds + RING_OFF;
    volatile LAS unsigned* flags = (volatile LAS unsigned*)(lds + SB_FLAG);
    const int tid = F.tid, w = F.wave, l = F.lane, lq = l & 31, hh = l >> 5;
    bf16_t* SQ = WSP(bf16_t, WS_SQ); const bf16_t* SK = WSP(bf16_t, WS_SK); const bf16_t* SV = WSP(bf16_t, WS_SV);
    const size_t rowbase = (size_t)b * SEQ;
    const int q0 = qb * 256 + 32 * w, qabs = q0 + lq;
    const int kt_hi = qb * 4 + 3, kt_lo = (qb * 4 - 3) > 0 ? (qb * 4 - 3) : 0, nwin = kt_hi - kt_lo + 1;
    const int skey = tid >> 3, sch = tid & 7;
    const bf16_t* kgd = SK + (rowbase + skey) * 1024 + h * 64 + ((sch ^ ((skey >> 1) & 7)) * 8);
    const bf16_t* vgd = SV + (rowbase + skey) * 1024 + h * 64 + ((sch ^ (((skey >> 1) & 1) << 2)) * 8);
    __syncthreads();
#pragma unroll
    for (int j = 0; j < 7; ++j) if (j < nwin) {
        __builtin_amdgcn_global_load_lds((const unsigned*)(kgd + (size_t)(kt_lo + j) * 64 * 1024), (LAS unsigned*)(lds + j * SB_TILE + w * 1024), 16, 0, 0);
        __builtin_amdgcn_global_load_lds((const unsigned*)(vgd + (size_t)(kt_lo + j) * 64 * 1024), (LAS unsigned*)(lds + j * SB_TILE + 8192 + w * 1024), 16, 0, 0); }
    bf16x8 qf[4];
    { const bf16_t* qrow = SQ + (rowbase + qabs) * 1024 + h * 64;
#pragma unroll
      for (int s = 0; s < 4; ++s) qf[s] = *(const bf16x8*)(qrow + 16 * s + 8 * hh); }
    f32x16 o0, o1;
#pragma unroll
    for (int r = 0; r < 16; ++r) { o0[r] = 0.f; o1[r] = 0.f; }
    float carry = 1.0f;
    VM_WAIT(); __syncthreads();
    bool done = false;
    for (int kt = (q0 + 30) >> 6; kt >= kt_lo; --kt) {
        sb_tile(lds + (kt - kt_lo) * SB_TILE, kt, q0, qabs, l, qf, o0, o1, carry);
        if (__all(carry == 0.0f)) { done = true; break; }
    }
    if (kt_lo == 0) done = true;
    if (l == 0) flags[w] = done ? 1u : 0u;
    __syncthreads();
    bool alld = true;
#pragma unroll
    for (int i = 0; i < 8; ++i) alld = alld && (flags[i] != 0u);
    if (!alld) {
        const bf16_t* kg = SK + (rowbase + skey) * 1024 + h * 64 + sch * 8;
        const bf16_t* vg = SV + (rowbase + skey) * 1024 + h * 64 + sch * 8;
        for (int kt = kt_lo - 1; kt >= 0; --kt) {
            const u32x4 kr = *(const u32x4*)(kg + (size_t)kt * 64 * 1024), vr = *(const u32x4*)(vg + (size_t)kt * 64 * 1024);
            __syncthreads();
            { unsigned a = 1u;
#pragma unroll
              for (int i = 0; i < 8; ++i) a &= flags[i];
              if (a) break; }
            *(LAS u32x4*)(lds + sbk_off(skey, sch)) = kr; *(LAS u32x4*)(lds + sbv_off(skey, sch)) = vr;
            __syncthreads();
            if (!done) { sb_tile(lds, kt, q0, qabs, l, qf, o0, o1, carry); if (__all(carry == 0.0f) || kt == 0) done = true; }
            if (l == 0) flags[w] = done ? 1u : 0u;
        }
    }
    if (!F.dry) { bf16_t* orow = SQ + (rowbase + qabs) * 1024 + h * 64;
#pragma unroll
      for (int g4 = 0; g4 < 4; ++g4) { u32x2 a, c2; a.x = cvtpk(o0[4 * g4], o0[4 * g4 + 1]); a.y = cvtpk(o0[4 * g4 + 2], o0[4 * g4 + 3]); c2.x = cvtpk(o1[4 * g4], o1[4 * g4 + 1]); c2.y = cvtpk(o1[4 * g4 + 2], o1[4 * g4 + 3]);
          *(u32x2*)(orow + 8 * g4 + 4 * hh) = a; *(u32x2*)(orow + 32 + 8 * g4 + 4 * hh) = c2; } }
}
#define CVT8_PK(V, S, W) do { int _x = __builtin_amdgcn_cvt_pk_fp8_f32((V)[0] * (S), (V)[1] * (S), 0, false); _x = __builtin_amdgcn_cvt_pk_fp8_f32((V)[2] * (S), (V)[3] * (S), _x, true); (W) = (unsigned)_x; } while (0)
__device__ __forceinline__ float absmax4(const f32x4& a) { return fmaxf(fmaxf(fabsf(a[0]), fabsf(a[1])), fmaxf(fabsf(a[2]), fabsf(a[3]))); }
constexpr int CVT8_UNITS = 256;
#ifndef QCONV
#define QCONV 1
#endif
__device__ __forceinline__ void cvt_fp8_unit(Frame& F, int cu) {
    const int l = F.lane, r0 = cu * 128 + F.wave * 16;
    const bool isv = r0 >= 16384; const int e0 = r0 & 16383;
    const float* src = isv ? F.in[15] : F.in[14]; unsigned char* dst = WSP(unsigned char, isv ? WS_VB8 : WS_UB8); float* rscale = WSP(float, isv ? WS_RSV : WS_RSU);
#pragma unroll 1
    for (int it = 0; it < 4; ++it) {
        f32x4 v[4][4]; float m[4];
#pragma unroll
        for (int q = 0; q < 4; ++q) { const f32x4* sp = (const f32x4*)(src + (size_t)(e0 + 4 * it + q) * 1024) + l;
#pragma unroll
            for (int j = 0; j < 4; ++j) v[q][j] = sp[64 * j]; }
#pragma unroll
        for (int q = 0; q < 4; ++q) m[q] = fmaxf(fmaxf(absmax4(v[q][0]), absmax4(v[q][1])), fmaxf(absmax4(v[q][2]), absmax4(v[q][3])));
#pragma unroll
        for (int o = 1; o < 64; o <<= 1) {
#pragma unroll
            for (int q = 0; q < 4; ++q) m[q] = fmaxf(m[q], __shfl_xor(m[q], o)); }
#pragma unroll
        for (int q = 0; q < 4; ++q) { const int e = e0 + 4 * it + q;
            const float t = 448.0f / fmaxf(m[q], 1e-30f); const float s = __uint_as_float(__float_as_uint(t) & 0x7f800000u);
            unsigned w[4]; CVT8_PK(v[q][0], s, w[0]); CVT8_PK(v[q][1], s, w[1]); CVT8_PK(v[q][2], s, w[2]); CVT8_PK(v[q][3], s, w[3]);
            if (!F.dry) { unsigned* dp = (unsigned*)(dst + (size_t)e * 1024) + l;
#pragma unroll
                for (int j = 0; j < 4; ++j) dp[64 * j] = w[j];
                if (l == 0) rscale[e] = 1.0f / s; } }
    }
}
__device__ __forceinline__ void sb_units_dyn(Frame& F, unsigned* ctr, int sb_lo, int nsb, int conv_lo) {
    volatile LAS int* slot = (volatile LAS int*)(F.lds + MISC_OFF + 64);
    const int total = QCONV ? nsb + (nsb >> 2) : nsb;
    __syncthreads();
    if (F.tid == 0) *slot = (int)__hip_atomic_fetch_add(ctr, 1u, __ATOMIC_RELAXED, __HIP_MEMORY_SCOPE_AGENT);
    __syncthreads();
    int i = *slot;
    while (i < total) {
        int nxt = 0;
        if (F.tid == 0) nxt = (int)__hip_atomic_fetch_add(ctr, 1u, __ATOMIC_RELAXED, __HIP_MEMORY_SCOPE_AGENT);
        if (QCONV) { const int g = i / 5, r = i - 5 * g; if (r < 4) sb_attn_unit(F, sb_lo + 4 * g + r); else cvt_fp8_unit(F, conv_lo + g); }
        else sb_attn_unit(F, sb_lo + i);
        __syncthreads();
        if (F.tid == 0) *slot = nxt;
        __syncthreads();
        i = *slot;
    }
}
__device__ __forceinline__ void phase_attn_a(Frame& F) {
#ifdef CONV_PROBE_NWG
    if (F.dry) {
        if (F.vcu < CONV_PROBE_NWG) { volatile LAS int* slot = (volatile LAS int*)(F.lds + MISC_OFF + 64); unsigned* ctr = (unsigned*)(F.ws + WS_CTL) + 64 + 16;
            for (;;) { __syncthreads(); if (F.tid == 0) *slot = (int)__hip_atomic_fetch_add(ctr, 1u, __ATOMIC_RELAXED, __HIP_MEMORY_SCOPE_AGENT); __syncthreads(); const int i = *slot; if (i >= CVT8_UNITS) break; cvt_fp8_unit(F, i); } }
        return; }
#endif
    if (F.vcu < 128) gla_stage1(F, F.vcu);
    sb_units_dyn(F, (unsigned*)(F.ws + WS_CTL) + 64 + 16 * F.dry, 0, 384, 0);
    __syncthreads();
}
__device__ __forceinline__ void phase_attn_b(Frame& F) {
    if (F.vcu < 128) gla_stage3(F, F.vcu);
    sb_units_dyn(F, (unsigned*)(F.ws + WS_CTL) + 128 + 16 * F.dry, 384, 640, 96);
    __syncthreads();
}
__device__ __forceinline__ int okey(float v, int tag, int mask) { int u = __float_as_int(v); u ^= (u >> 31) & 0x7fffffff; return (u & ~mask) | tag; }
__device__ __forceinline__ float okey_val(int key, int mask) { int u = key & ~mask; u ^= (u >> 31) & 0x7fffffff; return __int_as_float(u); }
#define INS16(Lst, xin) do { int _x = (xin); _Pragma("unroll") for (int _j = 0; _j < 16; ++_j) { const int _h = max(Lst[_j], _x); _x = min(Lst[_j], _x); Lst[_j] = _h; } } while (0)

#define CEX(a, b) do { const int _hi = max(a, b), _lo = min(a, b); a = _hi; b = _lo; } while (0)
#define BITONIC16(K) do { \
    _Pragma("unroll") for (int _i = 0; _i < 8; ++_i) CEX(K[_i], K[_i + 8]); \
    _Pragma("unroll") for (int _b = 0; _b < 16; _b += 8) _Pragma("unroll") for (int _i = 0; _i < 4; ++_i) CEX(K[_b + _i], K[_b + _i + 4]); \
    _Pragma("unroll") for (int _b = 0; _b < 16; _b += 4) _Pragma("unroll") for (int _i = 0; _i < 2; ++_i) CEX(K[_b + _i], K[_b + _i + 2]); \
    _Pragma("unroll") for (int _b = 0; _b < 16; _b += 2) CEX(K[_b], K[_b + 1]); } while (0)
#define CEXD(a, b, d) do { const int _hi = max(a, b), _lo = min(a, b); a = (d) ? _hi : _lo; b = (d) ? _lo : _hi; } while (0)
#define FULLSORT16(K) do { \
    _Pragma("unroll") for (int _k = 2; _k <= 16; _k <<= 1) _Pragma("unroll") for (int _j = _k >> 1; _j >= 1; _j >>= 1) _Pragma("unroll") for (int _i = 0; _i < 16; ++_i) { \
        const int _p = _i ^ _j; if (_p > _i) { const bool _desc = ((_i & _k) == 0); CEXD(K[_i], K[_p], _desc); } } } while (0)
__device__ __forceinline__ int swap32i(int x) { auto r = __builtin_amdgcn_permlane32_swap((unsigned)x, (unsigned)x, false, false); return (int)((__builtin_amdgcn_mbcnt_hi(~0u, __builtin_amdgcn_mbcnt_lo(~0u, 0u)) & 32) ? r[0] : r[1]); }

__device__ __forceinline__ void phase_peer_retrieve(Frame& F) {
    const bf16_t* Q = WSP(bf16_t, WS_Q); const bf16_t* KB = WSP(bf16_t, WS_KD); unsigned* EXPO = WSP(unsigned, WS_EXP);
    LAS unsigned char* idxb = F.lds + RING_OFF + F.wave * 2048;
    const int l = F.lane, lq = l & 31, hh = l >> 5;
    const int ntok_wg = T_TOK / F.G;
#pragma unroll 1
    for (int it = F.wave; it < (ntok_wg / 32) * 8; it += NWAVES) {
        const int tg = it >> 3, h = it & 7;
        const int t = F.vcu * ntok_wg + tg * 32 + lq;
        int XY[2][16];
#pragma unroll
        for (int half = 0; half < 2; ++half) {
            bf16x8 qf[8];
            { const bf16_t* qp = Q + (size_t)t * 2048 + h * 256 + half * 128 + 8 * hh;
#pragma unroll
              for (int s = 0; s < 8; ++s) qf[s] = *(const bf16x8*)(qp + 16 * s); }
            int L[16];
#pragma unroll
            for (int j = 0; j < 16; ++j) L[j] = INT_MIN;
            const bf16_t* kp = KB + (size_t)(h * 2 + half) * 16384 + (size_t)lq * 128 + 8 * hh;
#pragma unroll 1
            for (int tile = 0; tile < 4; ++tile) {
                f32x16 acc; int Tk[16];
#pragma unroll
                for (int r = 0; r < 16; ++r) acc[r] = 0.f;
#pragma unroll
                for (int s = 0; s < 8; ++s) { const bf16x8 a = *(const bf16x8*)(kp + (size_t)tile * 32 * 128 + 16 * s); acc = __builtin_amdgcn_mfma_f32_32x32x16_bf16(a, qf[s], acc, 0, 0, 0); }
#pragma unroll
                for (int r = 0; r < 16; ++r) { const int key = 32 * tile + (r & 3) + 8 * (r >> 2) + 4 * hh; Tk[r] = okey(acc[r], 127 - key, 127); }
                FULLSORT16(Tk);
#pragma unroll
                for (int k = 0; k < 16; ++k) L[k] = max(L[k], Tk[15 - k]);
                BITONIC16(L);
            }
#pragma unroll
            for (int k = 0; k < 8; ++k) { const int a = swap32i(L[15 - k]), b = swap32i(L[k]); L[k] = max(L[k], a); L[15 - k] = max(L[15 - k], b); }
            BITONIC16(L);
#pragma unroll
            for (int j = 0; j < 16; ++j) XY[half][j] = L[j];
        }
        { u32x4 pk[2];
#pragma unroll
          for (int half = 0; half < 2; ++half) { const int* L = XY[half];
            pk[half].x = (unsigned)(127 - (L[0] & 127)) | ((unsigned)(127 - (L[1] & 127)) << 8) | ((unsigned)(127 - (L[2] & 127)) << 16) | ((unsigned)(127 - (L[3] & 127)) << 24);
            pk[half].y = (unsigned)(127 - (L[4] & 127)) | ((unsigned)(127 - (L[5] & 127)) << 8) | ((unsigned)(127 - (L[6] & 127)) << 16) | ((unsigned)(127 - (L[7] & 127)) << 24);
            pk[half].z = (unsigned)(127 - (L[8] & 127)) | ((unsigned)(127 - (L[9] & 127)) << 8) | ((unsigned)(127 - (L[10] & 127)) << 16) | ((unsigned)(127 - (L[11] & 127)) << 24);
            pk[half].w = (unsigned)(127 - (L[12] & 127)) | ((unsigned)(127 - (L[13] & 127)) << 8) | ((unsigned)(127 - (L[14] & 127)) << 16) | ((unsigned)(127 - (L[15] & 127)) << 24); }
          *(LAS u32x4*)(idxb + l * 32) = pk[0]; *(LAS u32x4*)(idxb + l * 32 + 16) = pk[1]; }
        float X[16], Y[16];
#pragma unroll
        for (int j = 0; j < 16; ++j) { X[j] = okey_val(XY[0][j], 127); Y[j] = okey_val(XY[1][j], 127); }
        int M[16];
#pragma unroll
        for (int j = 0; j < 16; ++j) M[j] = INT_MIN;
#define CAND(i, j) do { const float sm = hh ? (X[j] + Y[i]) : (X[i] + Y[j]); const int pos = hh ? ((j) * 16 + (i)) : ((i) * 16 + (j)); int key = okey(sm, 255 - pos, 255); if ((i) == (j) && hh) key = INT_MIN; INS16(M, key); } while (0)
        CAND(0, 0); CAND(0, 1); CAND(0, 2); CAND(0, 3); CAND(0, 4); CAND(0, 5); CAND(0, 6); CAND(0, 7); CAND(0, 8); CAND(0, 9); CAND(0, 10); CAND(0, 11); CAND(0, 12); CAND(0, 13); CAND(0, 14); CAND(0, 15);
        CAND(1, 1); CAND(1, 2); CAND(1, 3); CAND(1, 4); CAND(1, 5); CAND(1, 6); CAND(1, 7);
        CAND(2, 2); CAND(2, 3); CAND(2, 4);
        CAND(3, 3);
#undef CAND
        int TK[16];
#pragma unroll
        for (int k = 0; k < 16; ++k) TK[k] = max(M[k], swap32i(M[15 - k]));
        float sv[16]; float mx = -INFINITY;
#pragma unroll
        for (int k = 0; k < 16; ++k) { sv[k] = okey_val(TK[k], 255); mx = fmaxf(mx, sv[k]); }
        float den = 0.f;
#pragma unroll
        for (int k = 0; k < 16; ++k) { sv[k] = __expf(sv[k] - mx); den += sv[k]; }
        const float rden = 1.0f / den;
        LDS_WAIT(); asm volatile("" ::: "memory");
        const LAS unsigned char* ib = idxb + l * 32;
        unsigned* dst = EXPO + (size_t)t * 128 + h * 16 + hh * 8;
        u32x4 o0, o1; unsigned ov[8];
#pragma unroll
        for (int k = 0; k < 8; ++k) { const int pos = 255 - (TK[k] & 255); const unsigned i1 = ib[pos >> 4], i2 = ib[16 + (pos & 15)];
            ov[k] = (__float_as_uint(sv[k] * rden) & ~0x3fffu) | (i1 * 128u + i2); }
        o0 = (u32x4){ov[0], ov[1], ov[2], ov[3]}; o1 = (u32x4){ov[4], ov[5], ov[6], ov[7]};
        *(u32x4*)dst = o0; *(u32x4*)(dst + 4) = o1;
        LDS_WAIT(); asm volatile("" ::: "memory");
    }
}

__device__ __forceinline__ void cvt_rows_fp8(Frame& F, const float* src, unsigned char* dst, float* rscale) {
    const int l = F.lane; const int gw = F.vcu * NWAVES + F.wave, NGW = F.G * NWAVES;
    for (int e = gw; e < 16384; e += NGW) {
        const f32x4* sp = (const f32x4*)(src + (size_t)e * 1024 + 16 * l);
        const f32x4 a = sp[0], b = sp[1], c = sp[2], d = sp[3];
        float m = fmaxf(fmaxf(fmaxf(fabsf(a[0]), fabsf(a[1])), fmaxf(fabsf(a[2]), fabsf(a[3]))), fmaxf(fmaxf(fabsf(b[0]), fabsf(b[1])), fmaxf(fabsf(b[2]), fabsf(b[3]))));
        m = fmaxf(m, fmaxf(fmaxf(fmaxf(fabsf(c[0]), fabsf(c[1])), fmaxf(fabsf(c[2]), fabsf(c[3]))), fmaxf(fmaxf(fabsf(d[0]), fabsf(d[1])), fmaxf(fabsf(d[2]), fabsf(d[3])))));
#pragma unroll
        for (int o = 1; o < 64; o <<= 1) m = fmaxf(m, __shfl_xor(m, o));
        const float t = 448.0f / fmaxf(m, 1e-30f); const float s = __uint_as_float(__float_as_uint(t) & 0x7f800000u);
        u32x4 w; int x;
        x = __builtin_amdgcn_cvt_pk_fp8_f32(a[0] * s, a[1] * s, 0, false); x = __builtin_amdgcn_cvt_pk_fp8_f32(a[2] * s, a[3] * s, x, true); w.x = (unsigned)x;
        x = __builtin_amdgcn_cvt_pk_fp8_f32(b[0] * s, b[1] * s, 0, false); x = __builtin_amdgcn_cvt_pk_fp8_f32(b[2] * s, b[3] * s, x, true); w.y = (unsigned)x;
        x = __builtin_amdgcn_cvt_pk_fp8_f32(c[0] * s, c[1] * s, 0, false); x = __builtin_amdgcn_cvt_pk_fp8_f32(c[2] * s, c[3] * s, x, true); w.z = (unsigned)x;
        x = __builtin_amdgcn_cvt_pk_fp8_f32(d[0] * s, d[1] * s, 0, false); x = __builtin_amdgcn_cvt_pk_fp8_f32(d[2] * s, d[3] * s, x, true); w.w = (unsigned)x;
        *(u32x4*)(dst + (size_t)e * 1024 + 16 * l) = w;
        if (l == 0) rscale[e] = 1.0f / s;
    }
}

__device__ __forceinline__ float gelu_tanh(float x) { const float y = 0.7978845608028654f * (x + 0.044715f * x * x * x); return x * __builtin_amdgcn_rcpf(1.0f + __expf(-2.0f * y)); }
#define FP8_UNPACK16(W, f) do { f32x2 _t; \
    _t = __builtin_amdgcn_cvt_pk_f32_fp8((int)(W).x, false); f[0] = _t[0]; f[1] = _t[1]; _t = __builtin_amdgcn_cvt_pk_f32_fp8((int)(W).x, true); f[2] = _t[0]; f[3] = _t[1]; \
    _t = __builtin_amdgcn_cvt_pk_f32_fp8((int)(W).y, false); f[4] = _t[0]; f[5] = _t[1]; _t = __builtin_amdgcn_cvt_pk_f32_fp8((int)(W).y, true); f[6] = _t[0]; f[7] = _t[1]; \
    _t = __builtin_amdgcn_cvt_pk_f32_fp8((int)(W).z, false); f[8] = _t[0]; f[9] = _t[1]; _t = __builtin_amdgcn_cvt_pk_f32_fp8((int)(W).z, true); f[10] = _t[0]; f[11] = _t[1]; \
    _t = __builtin_amdgcn_cvt_pk_f32_fp8((int)(W).w, false); f[12] = _t[0]; f[13] = _t[1]; _t = __builtin_amdgcn_cvt_pk_f32_fp8((int)(W).w, true); f[14] = _t[0]; f[15] = _t[1]; } while (0)
__device__ __forceinline__ float sum_swap32(float a, float b) { auto r = __builtin_amdgcn_permlane32_swap(__float_as_uint(a), __float_as_uint(b), false, false); return __uint_as_float(r[0]) + __uint_as_float(r[1]); }
__device__ __forceinline__ float sum_swap16(float a, float b) { auto r = __builtin_amdgcn_permlane16_swap(__float_as_uint(a), __float_as_uint(b), false, false); return __uint_as_float(r[0]) + __uint_as_float(r[1]); }
template <int M> __device__ __forceinline__ unsigned sxu(unsigned v, int lane) {
    if constexpr (M == 32) { auto r = __builtin_amdgcn_permlane32_swap(v, v, false, false); return (lane & 32) ? r[0] : r[1]; }
    else return (unsigned)__builtin_amdgcn_ds_swizzle((int)v, (M << 10) | 0x1f);
}
template <int M> __device__ __forceinline__ float sxf(float v, int lane) { return __uint_as_float(sxu<M>(__float_as_uint(v), lane)); }
__device__ __forceinline__ float wave_sum_sx(float v, int lane) { v += sxf<1>(v, lane); v += sxf<2>(v, lane); v += sxf<4>(v, lane); v += sxf<8>(v, lane); v += sxf<16>(v, lane); v += sxf<32>(v, lane); return v; }
#ifndef PG_TOK
#define PG_TOK 4
#endif
template <class Bar>
__device__ __forceinline__ void phase_peer_gather(Frame& F, const Bar& bar, bool use_bar) {
    const unsigned char* UB = WSP(unsigned char, WS_UB8); const unsigned char* VB = WSP(unsigned char, WS_VB8); const float* RSU = WSP(float, WS_RSU); const float* RSV = WSP(float, WS_RSV);
    const unsigned* EXPO = WSP(unsigned, WS_EXP);
    const bf16_t* H1B = WSP(bf16_t, WS_H1); bf16_t* H2B = WSP(bf16_t, WS_H2B); const float* SSQ1 = WSP(float, WS_SSQ1); float* RS3 = WSP(float, WS_RS3); const float* g_ffn = F.in[10];
    const int l = F.lane; const int ntok_wg = T_TOK / F.G;
#pragma unroll 1
    for (int ti = F.wave * PG_TOK; ti < ntok_wg; ti += NWAVES * PG_TOK) {
        if (use_bar && ti >= NWAVES * PG_TOK) xcd_barrier(bar, F.tid); else __syncthreads();
        f32x2 acc[PG_TOK][8];
        LAS unsigned* lent = (LAS unsigned*)(F.lds + RING_OFF + F.wave * (2048 * PG_TOK)); LAS float* lcu = (LAS float*)(lent + 128 * PG_TOK); LAS float* lcv = lcu + 128 * PG_TOK; LAS float* acl = lcv + 128 * PG_TOK;
        LAS f32x4* lx = (LAS f32x4*)(F.lds + RING_OFF + NWAVES * 2048 * PG_TOK + F.wave * (4096 * PG_TOK));
#pragma unroll
        for (int tk = 0; tk < PG_TOK; ++tk) { const int t = F.vcu * ntok_wg + ti + tk;
            const u32x4 xa = *(const u32x4*)(H1B + (size_t)t * 1024 + 16 * l), xb = *(const u32x4*)(H1B + (size_t)t * 1024 + 16 * l + 8);
            const f32x4* gp = (const f32x4*)(g_ffn + 16 * l);
            lx[tk * 256 + l] = (f32x4){bf_lo(xa.x), bf_hi(xa.x), bf_lo(xa.y), bf_hi(xa.y)} * gp[0]; lx[tk * 256 + 64 + l] = (f32x4){bf_lo(xa.z), bf_hi(xa.z), bf_lo(xa.w), bf_hi(xa.w)} * gp[1];
            lx[tk * 256 + 128 + l] = (f32x4){bf_lo(xb.x), bf_hi(xb.x), bf_lo(xb.y), bf_hi(xb.y)} * gp[2]; lx[tk * 256 + 192 + l] = (f32x4){bf_lo(xb.z), bf_hi(xb.z), bf_lo(xb.w), bf_hi(xb.w)} * gp[3];
#pragma unroll
            for (int i = 0; i < 8; ++i) acc[tk][i] = (f32x2){0.f, 0.f}; }
#pragma unroll 1
        for (int tk = 0; tk < PG_TOK; ++tk) { const int t = F.vcu * ntok_wg + ti + tk;
            const f32x4* sp = (const f32x4*)(SSQ1 + (size_t)t * 16); const f32x4 st = (sp[0] + sp[1]) + (sp[2] + sp[3]); const float rstd1 = __builtin_amdgcn_rsqf(((st[0] + st[1]) + (st[2] + st[3])) * (1.0f / 1024.0f) + EPS);
            unsigned a0 = EXPO[(size_t)t * 128 + l], a1 = EXPO[(size_t)t * 128 + 64 + l];
            { unsigned s0 = (a0 << 18) | (a0 >> 14), s1 = (a1 << 18) | (a1 >> 14);
              int ls = l; asm volatile("" : "+v"(ls));
#define BSTEP(K, J) do { const bool up = (ls & (J)) != 0; const unsigned p0 = sxu<J>(s0, ls), p1 = sxu<J>(s1, ls); \
                  const bool asc0 = (ls & (K)) == 0, asc1 = ((ls + 64) & (K)) == 0; \
                  s0 = (up == asc0) ? max(s0, p0) : min(s0, p0); s1 = (up == asc1) ? max(s1, p1) : min(s1, p1); } while (0)
              BSTEP(2, 1);
              BSTEP(4, 2); BSTEP(4, 1);
              BSTEP(8, 4); BSTEP(8, 2); BSTEP(8, 1);
              BSTEP(16, 8); BSTEP(16, 4); BSTEP(16, 2); BSTEP(16, 1);
              BSTEP(32, 16); BSTEP(32, 8); BSTEP(32, 4); BSTEP(32, 2); BSTEP(32, 1);
              BSTEP(64, 32); BSTEP(64, 16); BSTEP(64, 8); BSTEP(64, 4); BSTEP(64, 2); BSTEP(64, 1);
              { const unsigned lo = min(s0, s1), hi = max(s0, s1); s0 = lo; s1 = hi; }
              BSTEP(128, 32); BSTEP(128, 16); BSTEP(128, 8); BSTEP(128, 4); BSTEP(128, 2); BSTEP(128, 1);
#undef BSTEP
              a0 = (s0 >> 18) | (s0 << 14); a1 = (s1 >> 18) | (s1 << 14); }
            lent[tk * 128 + l] = a0; lent[tk * 128 + 64 + l] = a1;
            lcu[tk * 128 + l] = RSU[a0 & 0x3fffu] * rstd1; lcu[tk * 128 + 64 + l] = RSU[a1 & 0x3fffu] * rstd1;
            lcv[tk * 128 + l] = RSV[a0 & 0x3fffu] * __uint_as_float(a0 & ~0x3fffu); lcv[tk * 128 + 64 + l] = RSV[a1 & 0x3fffu] * __uint_as_float(a1 & ~0x3fffu); }
        LDS_WAIT(); asm volatile("" ::: "memory");
        u32x4 buf0[8], buf1[8];
#define ROWS8(BUF, TAB, tk, eb) do { const u32x4 ea_ = *(const LAS u32x4*)(lent + (tk) * 128 + (eb)), eb_ = *(const LAS u32x4*)(lent + (tk) * 128 + (eb) + 4); \
            const unsigned en_[8] = {ea_.x, ea_.y, ea_.z, ea_.w, eb_.x, eb_.y, eb_.z, eb_.w}; \
            _Pragma("unroll") for (int k = 0; k < 8; ++k) BUF[k] = *(const u32x4*)((TAB) + ((en_[k] & 0x3fffu) * 1024u + 16u * (unsigned)l)); } while (0)
#define U8(BUF, tk, eb) do { float p[8]; f32x2 x2[8]; \
            _Pragma("unroll") for (int i = 0; i < 4; ++i) { const f32x4 t_ = lx[(tk) * 256 + 64 * i + l]; x2[2 * i] = (f32x2){t_[0], t_[1]}; x2[2 * i + 1] = (f32x2){t_[2], t_[3]}; } \
            _Pragma("unroll") for (int k = 0; k < 8; ++k) { const unsigned wq[4] = {BUF[k].x, BUF[k].y, BUF[k].z, BUF[k].w}; f32x2 s2 = (f32x2){0.f, 0.f}; \
                _Pragma("unroll") for (int i = 0; i < 4; ++i) { s2 = __builtin_elementwise_fma(__builtin_amdgcn_cvt_pk_f32_fp8((int)wq[i], false), x2[2 * i], s2); \
                                                                s2 = __builtin_elementwise_fma(__builtin_amdgcn_cvt_pk_f32_fp8((int)wq[i], true), x2[2 * i + 1], s2); } \
                p[k] = s2[0] + s2[1]; if (k & 1) __builtin_amdgcn_sched_barrier(0); } \
            float q4[4], q2[2], q1; \
            _Pragma("unroll") for (int j = 0; j < 4; ++j) q4[j] = sum_swap32(p[j], p[4 + j]); \
            _Pragma("unroll") for (int j = 0; j < 2; ++j) q2[j] = sum_swap16(q4[j], q4[2 + j]); \
            { const bool up = (l & 8) != 0; const float keep = up ? q2[1] : q2[0], send = up ? q2[0] : q2[1]; q1 = keep + sxf<8>(send, l); } \
            q1 += sxf<4>(q1, l); q1 += sxf<2>(q1, l); q1 += sxf<1>(q1, l); \
            const float cu = lcu[(tk) * 128 + (eb) + (l >> 3)], cv = lcv[(tk) * 128 + (eb) + (l >> 3)]; \
            const float a_ = gelu_tanh(q1 * cu) * cv; if ((l & 7) == 0) acl[(tk) * 128 + (eb) + (l >> 3)] = a_; __builtin_amdgcn_sched_barrier(0); } while (0)
#define V8(BUF, tk, eb) do { const float av = acl[(tk) * 128 + (eb) + (l & 7)]; \
            _Pragma("unroll") for (int k = 0; k < 8; ++k) { const float ak = __uint_as_float(__builtin_amdgcn_readlane(__float_as_uint(av), k)); const f32x2 ak2 = (f32x2){ak, ak}; \
                const unsigned wq[4] = {BUF[k].x, BUF[k].y, BUF[k].z, BUF[k].w}; \
                _Pragma("unroll") for (int i = 0; i < 4; ++i) { acc[tk][2 * i] = __builtin_elementwise_fma(__builtin_amdgcn_cvt_pk_f32_fp8((int)wq[i], false), ak2, acc[tk][2 * i]); \
                                                                acc[tk][2 * i + 1] = __builtin_elementwise_fma(__builtin_amdgcn_cvt_pk_f32_fp8((int)wq[i], true), ak2, acc[tk][2 * i + 1]); } \
                if (k & 1) __builtin_amdgcn_sched_barrier(0); } } while (0)
        ROWS8(buf0, UB, 0, 0);
#if PG_TOK == 4
#define TURNS4(CONS, TAB, eb, NEXT) do { ROWS8(buf1, TAB, 1, eb); CONS(buf0, 0, eb); ROWS8(buf0, TAB, 2, eb); CONS(buf1, 1, eb); ROWS8(buf1, TAB, 3, eb); CONS(buf0, 2, eb); NEXT; CONS(buf1, 3, eb); } while (0)
#pragma unroll 1
        for (int eb = 0; eb < 120; eb += 8) TURNS4(U8, UB, eb, ROWS8(buf0, UB, 0, eb + 8));
        TURNS4(U8, UB, 120, ROWS8(buf0, VB, 0, 0));
        LDS_WAIT(); asm volatile("" ::: "memory");
#pragma unroll 1
        for (int eb = 0; eb < 120; eb += 8) TURNS4(V8, VB, eb, ROWS8(buf0, VB, 0, eb + 8));
        TURNS4(V8, VB, 120, (void)0);
#undef TURNS4
#elif PG_TOK == 2
#define TURNS2(CONS, TAB, eb, NEXT) do { ROWS8(buf1, TAB, 1, eb); CONS(buf0, 0, eb); NEXT; CONS(buf1, 1, eb); } while (0)
#pragma unroll 1
        for (int eb = 0; eb < 120; eb += 8) TURNS2(U8, UB, eb, ROWS8(buf0, UB, 0, eb + 8));
        TURNS2(U8, UB, 120, ROWS8(buf0, VB, 0, 0));
        LDS_WAIT(); asm volatile("" ::: "memory");
#pragma unroll 1
        for (int eb = 0; eb < 120; eb += 8) TURNS2(V8, VB, eb, ROWS8(buf0, VB, 0, eb + 8));
        TURNS2(V8, VB, 120, (void)0);
#undef TURNS2
#else
#error PG_TOK must be 2 or 4
#endif
#undef ROWS8
#undef U8
#undef V8
#pragma unroll
        for (int tk = 0; tk < PG_TOK; ++tk) { const int t = F.vcu * ntok_wg + ti + tk;
            float ss = 0.f; f32x4 h[4];
#pragma unroll
            for (int q2 = 0; q2 < 2; ++q2) { const u32x4 ha = *(const u32x4*)(H1B + (size_t)t * 1024 + 16 * l + 8 * q2);
                h[2 * q2] = (f32x4){bf_lo(ha.x), bf_hi(ha.x), bf_lo(ha.y), bf_hi(ha.y)}; h[2 * q2 + 1] = (f32x4){bf_lo(ha.z), bf_hi(ha.z), bf_lo(ha.w), bf_hi(ha.w)};
#pragma unroll
                for (int j = 0; j < 4; ++j) { h[2 * q2][j] += acc[tk][4 * q2 + (j >> 1)][j & 1]; h[2 * q2 + 1][j] += acc[tk][4 * q2 + 2 + (j >> 1)][j & 1]; ss += h[2 * q2][j] * h[2 * q2][j] + h[2 * q2 + 1][j] * h[2 * q2 + 1][j]; }
                u32x4 w0; w0.x = cvtpk(h[2 * q2][0], h[2 * q2][1]); w0.y = cvtpk(h[2 * q2][2], h[2 * q2][3]); w0.z = cvtpk(h[2 * q2 + 1][0], h[2 * q2 + 1][1]); w0.w = cvtpk(h[2 * q2 + 1][2], h[2 * q2 + 1][3]);
                if (!F.dry) *(u32x4*)(H2B + (size_t)t * 1024 + 16 * l + 8 * q2) = w0; }
            const float rstd3 = __builtin_amdgcn_rsqf(wave_sum_sx(ss, l) * (1.0f / 1024.0f) + EPS);
            if (!F.dry && l == 0) RS3[t] = rstd3;
            __builtin_amdgcn_sched_barrier(0); }
    }
}

__device__ __forceinline__ void phase_final(Frame& F) {
    const float* SSQ3 = WSP(float, WS_SSQ3); const float* g = F.in[19]; const bf16_t* H3B = WSP(bf16_t, WS_H3B);
    const int l = F.lane; const int gw = F.vcu * NWAVES + F.wave, NGW = F.G * NWAVES;
    for (int t = gw; t < T_TOK; t += NGW) {
        const f32x4* sp = (const f32x4*)(SSQ3 + (size_t)t * 16); const f32x4 st = (sp[0] + sp[1]) + (sp[2] + sp[3]);
        const float rstd = __builtin_amdgcn_rsqf(((st[0] + st[1]) + (st[2] + st[3])) * (1.0f / 1024.0f) + EPS);
        f32x4* row = (f32x4*)(F.out + (size_t)t * 1024);
#pragma unroll
        for (int j = 0; j < 4; ++j) { const u32x2 hv = *((const u32x2*)(H3B + (size_t)t * 1024) + l + 64 * j); const f32x4 gv = *((const f32x4*)g + l + 64 * j);
            const f32x4 h = (f32x4){bf_lo(hv.x), bf_hi(hv.x), bf_lo(hv.y), bf_hi(hv.y)}; row[l + 64 * j] = h * rstd * gv; }
    }
}
#ifndef MK_FUSED
#define MK_FUSED 1
#endif
constexpr int NPHASE = 10;
struct Args { const float* in[20]; float* out; unsigned char* ws; int ph_lo, ph_hi, dry, pad; };
static_assert(sizeof(Args) == 20 * 8 + 8 + 8 + 4 * 4, "Args has no padding");

__global__ void __launch_bounds__(NWAVES * 64, 2) mk_fwd(Args args) {
    extern __shared__ __attribute__((aligned(16))) unsigned char lds_raw[];
    Frame F;
    F.lds = (LAS unsigned char*)lds_raw;
    F.wave = __builtin_amdgcn_readfirstlane(threadIdx.x >> 6); F.lane = lane_id(); F.tid = F.wave * 64 + F.lane;
    F.G = gridDim.x; { const int bx = blockIdx.x; F.vcu = (F.G % 8 == 0) ? (bx % 8) * (F.G / 8) + bx / 8 : bx; }
    F.in = args.in; F.out = args.out; F.ws = args.ws; F.dry = args.dry;
    volatile LAS unsigned* MISC = (volatile LAS unsigned*)(F.lds + MISC_OFF);
    if (F.tid < 64) MISC[F.tid] = 0u;
    __syncthreads();
    const int lo = args.ph_lo, hi = args.ph_hi;
    XcdBarrier bar; bar.bar = (unsigned*)(F.ws + WS_CTL) + CW_BAR; bar.x = 0; bar.st = nullptr;
    if (hi - lo > 1) bar = xcd_barrier_post((unsigned*)(F.ws + WS_CTL) + CW_BAR, MISC + 8, F.tid);
#ifndef PH_MASK
#define PH_MASK 0xFFFFFFFFu
#endif
#define IN(k) (((PH_MASK >> (k)) & 1u) && lo <= (k) && (k) < hi)
#define LAUNDER(p, T) do { unsigned _lo = (unsigned)(unsigned long long)(p), _hi = (unsigned)((unsigned long long)(p) >> 32); asm volatile("" : "+v"(_lo), "+v"(_hi)); \
        _lo = __builtin_amdgcn_readfirstlane(_lo); _hi = __builtin_amdgcn_readfirstlane(_hi); (p) = (T)(((unsigned long long)_hi << 32) | _lo); } while (0)
#define SEAM(k) do { if (IN(k) && IN((k) + 1)) xcd_barrier(bar, F.tid); LAUNDER(F.ws, unsigned char*); LAUNDER(F.out, float*); F.lane = lane_id(); F.tid = F.wave * 64 + F.lane; } while (0)
    const int bx = (int)blockIdx.x;
    LAS unsigned char* ring = F.lds + RING_OFF;

    if (IN(0)) { phase_prologue(F); } SEAM(0);
    if (IN(1)) {
        pg8::Gemm g{WSP(bf16_t, WS_XN1), WSP(bf16_t, WS_WIN), T_TOK, 8192, 1024, 1024, 0, 2, 8}; pg8::StaticOrder S; S.init(T_TOK, 8192, F.G, bx);
        pg8::EpiProj E{WSP(bf16_t, WS_GQ), WSP(bf16_t, WS_GK), WSP(bf16_t, WS_GV), WSP(bf16_t, WS_GR), WSP(bf16_t, WS_SQ), WSP(bf16_t, WS_SK), WSP(bf16_t, WS_SV),
                       (bf16_t*)F.out, (bf16_t*)F.out + (size_t)T_TOK * 1024};
        pg8::gemm_phase<pg8::EpiProj>(ring, g, S, E, F.tid);
    } SEAM(1);
    if (IN(2)) { phase_gla_prep(F); } SEAM(2);
    if (IN(3)) { phase_attn_a(F); } SEAM(3);
    if (IN(4)) { phase_attn_b(F); } SEAM(4);
    if (IN(5)) {
        if (!QCONV) { for (int cu = F.vcu; cu < CVT8_UNITS; cu += F.G) cvt_fp8_unit(F, cu); VM_WAIT(); __syncthreads(); }
        pg8::PairOrder S; S.init(T_TOK, 1024, F.G, bx);
        pg8::Gemm g{WSP(bf16_t, WS_GLAN), WSP(bf16_t, WS_WGA), T_TOK, 1024, 1024, 1024, 0, 0, 0, WSP(bf16_t, WS_SQ), WSP(bf16_t, WS_WSB)};
        pg8::EpiMixPair E{(const bf16_t*)F.out, (const bf16_t*)F.out + (size_t)T_TOK * 1024, WSP(bf16_t, WS_MIX)};
        pg8::gemm_phase<pg8::EpiMixPair, true, true, pg8::PairOrder>(ring, g, S, E, F.tid);
    } SEAM(5);
    if (IN(6)) {
        pg8::Gemm g{WSP(bf16_t, WS_MIX), WSP(bf16_t, WS_WO), T_TOK, 1024, 1024, 1024, 0, 0, 0}; pg8::StaticOrder S; S.init(T_TOK, 1024, F.G, bx);
        pg8::EpiH1 E{F.in[0], WSP(bf16_t, WS_H1), WSP(float, WS_SSQ1)};
        pg8::gemm_phase<pg8::EpiH1>(ring, g, S, E, F.tid);
    } SEAM(6);
    if (IN(7)) {
        pg8::Gemm g{WSP(bf16_t, WS_H1), WSP(bf16_t, WS_WPQ), T_TOK, 2048, 1024, 1024, 0, 0, 0}; pg8::StaticOrder S; S.init(T_TOK, 2048, F.G, bx);
        pg8::EpiQ E{WSP(float, WS_SSQ1), WSP(bf16_t, WS_Q), 2048};
        pg8::gemm_phase<pg8::EpiQ>(ring, g, S, E, F.tid);
    } SEAM(7);
    if (IN(8)) {
        cvt_copy(F, F.in[1], WSP(bf16_t, WS_PB), (size_t)T_TOK * 256);
        phase_peer_retrieve(F);
        VM_WAIT(); __syncthreads();
        phase_peer_gather(F, bar, false);
    } SEAM(8);
    if (IN(9)) {
        pg8::StaticOrder S; S.init(T_TOK, 1024, F.G, bx);
        { pg8::Gemm g{WSP(bf16_t, WS_PB), WSP(bf16_t, WS_WPLE), T_TOK, 1024, 256, 256, 0, 0, 0}; pg8::EpiBf E{WSP(bf16_t, WS_PLE), 1024};
          pg8::gemm_phase<pg8::EpiBf>(ring, g, S, E, F.tid); }
        { pg8::Gemm g{WSP(bf16_t, WS_H2B), WSP(bf16_t, WS_WPG), T_TOK, 1024, 1024, 1024, 0, 0, 0}; pg8::EpiH3L E{WSP(bf16_t, WS_H2B), WSP(bf16_t, WS_PLE), WSP(float, WS_RS3), ring, WSP(float, WS_SSQ3)};
          pg8::gemm_phase<pg8::EpiH3L>(ring, g, S, E, F.tid); }
        { pg8::Unit u; S.next(0, u);
          unsigned* cnt = (unsigned*)(F.ws + WS_CTL) + CW_ROWCNT + 64 * F.dry + u.pm;
          if (F.tid == 0) {
              __builtin_amdgcn_fence(__ATOMIC_RELEASE, "agent");
              __hip_atomic_fetch_add(cnt, 1u, __ATOMIC_RELAXED, __HIP_MEMORY_SCOPE_AGENT);
              unsigned sp = 0; while (__hip_atomic_load(cnt, __ATOMIC_RELAXED, __HIP_MEMORY_SCOPE_AGENT) < 4u && ++sp < (1u << 24)) __builtin_amdgcn_s_sleep(1);
              __builtin_amdgcn_fence(__ATOMIC_ACQUIRE, "agent");
          }
          __syncthreads();
          LAS float* rsl = (LAS float*)(ring + 256 * pg8::H3L_PITCH);
          if (F.tid < 256) { const f32x4* sp = (const f32x4*)(WSP(float, WS_SSQ3) + (size_t)(u.pm * 256 + F.tid) * 16); const f32x4 st = (sp[0] + sp[1]) + (sp[2] + sp[3]);
              rsl[F.tid] = __builtin_amdgcn_rsqf(((st[0] + st[1]) + (st[2] + st[3])) * (1.0f / 1024.0f) + EPS); }
          __syncthreads();
          const int c8 = F.tid & 31, r0 = F.tid >> 5;
          const f32x4 g0 = *(const f32x4*)(F.in[19] + u.pn * 256 + 8 * c8), g1 = *(const f32x4*)(F.in[19] + u.pn * 256 + 8 * c8 + 4);
#pragma unroll 4
          for (int ps = 0; ps < 16; ++ps) { const int lrow = ps * 16 + r0; const u32x4 hv = *(const LAS u32x4*)(ring + lrow * pg8::H3L_PITCH + 16 * c8); const float rstd = rsl[lrow];
              float* op = F.out + (size_t)(u.pm * 256 + lrow) * 1024 + u.pn * 256 + 8 * c8;
              *(f32x4*)op = (f32x4){bf_lo(hv.x), bf_hi(hv.x), bf_lo(hv.y), bf_hi(hv.y)} * rstd * g0; *(f32x4*)(op + 4) = (f32x4){bf_lo(hv.z), bf_hi(hv.z), bf_lo(hv.w), bf_hi(hv.w)} * rstd * g1; }
        }
    }
#undef IN
#undef SEAM
}

extern "C" void kernel_launch(void* const* d_in, const int* in_sizes, int n_in, void* d_out, int out_size, void* d_ws, size_t ws_size, hipStream_t stream) {
    static int grid = 0;
    if (grid == 0) {
        if (n_in != 20 || in_sizes[0] != T_TOK * 1024 || out_size != T_TOK * 1024 || ws_size < WS_END) {
            fprintf(stderr, "kernel_launch: unexpected shapes (n_in %d, in0 %d, out %d, ws %zu < %zu?); nothing launched\n", n_in, n_in > 0 ? in_sizes[0] : -1, out_size, ws_size, (size_t)WS_END); grid = -1; return; }
        int dev = 0, cus = 0, per_cu = 0;
        if (hipGetDevice(&dev) != hipSuccess || hipDeviceGetAttribute(&cus, hipDeviceAttributeMultiprocessorCount, dev) != hipSuccess) { grid = -1; return; }
        if (hipFuncSetAttribute((const void*)mk_fwd, hipFuncAttributeMaxDynamicSharedMemorySize, LDS_BYTES) != hipSuccess) { fprintf(stderr, "kernel_launch: hipFuncSetAttribute failed\n"); grid = -1; return; }
        if (hipOccupancyMaxActiveBlocksPerMultiprocessor(&per_cu, (const void*)mk_fwd, NWAVES * 64, LDS_BYTES) != hipSuccess || per_cu < 1)
            fprintf(stderr, "kernel_launch: note: occupancy query reports %d workgroups per CU\n", per_cu);
        (void)hipGetLastError();
        grid = cus;
        if (grid != (T_TOK / 256) * 4) { fprintf(stderr, "kernel_launch: the last phase needs one output tile per workgroup (grid %d)\n", grid); grid = -1; return; }
        if (grid != 256) fprintf(stderr, "kernel_launch: note: %d CUs (kernel tuned for 256)\n", grid);
    }
    if (grid < 0) return;
    if (hipMemsetAsync((char*)d_ws + WS_CTL, 0, CTL_ZERO_BYTES, stream) != hipSuccess) { fprintf(stderr, "kernel_launch: hipMemsetAsync failed\n"); return; }
    Args a{};
    for (int i = 0; i < 20; ++i) a.in[i] = (const float*)d_in[i];
    a.out = (float*)d_out; a.ws = (unsigned char*)d_ws;
#if MK_FUSED
    a.ph_lo = 0; a.ph_hi = NPHASE;
    hipLaunchKernelGGL(mk_fwd, dim3(grid), dim3(NWAVES * 64), LDS_BYTES, stream, a);
#else
#ifndef PROBE_PHASE
#define PROBE_PHASE -1
#define PROBE_REPS 0
#endif
    for (int p = 0; p < NPHASE; ++p) { a.ph_lo = p; a.ph_hi = p + 1;
        if (p == PROBE_PHASE) { a.dry = 1; for (int r = 0; r < PROBE_REPS; ++r) hipLaunchKernelGGL(mk_fwd, dim3(grid), dim3(NWAVES * 64), LDS_BYTES, stream, a); a.dry = 0; }
        hipLaunchKernelGGL(mk_fwd, dim3(grid), dim3(NWAVES * 64), LDS_BYTES, stream, a); }
#endif
}
```

```cpp
#define MK_FUSED 1
#define PG_TOK 2
#include <hip/hip_runtime.h>
#include <cstdio>
#include <cstdint>

#define LAS __attribute__((address_space(3)))
#define GAS __attribute__((address_space(1)))
typedef unsigned short bf16_t;
typedef short bf16x8 __attribute__((ext_vector_type(8)));
typedef short s16x4 __attribute__((ext_vector_type(4)));
typedef float f32x2 __attribute__((ext_vector_type(2)));
typedef float f32x4 __attribute__((ext_vector_type(4)));
typedef float f32x16 __attribute__((ext_vector_type(16)));
typedef unsigned u32x2 __attribute__((ext_vector_type(2)));
typedef unsigned u32x4 __attribute__((ext_vector_type(4)));
typedef __bf16 bf16x2_t __attribute__((ext_vector_type(2)));

__device__ __forceinline__ unsigned cvtpk(float lo, float hi) { f32x2 v = {lo, hi}; bf16x2_t b = __builtin_convertvector(v, bf16x2_t); return __builtin_bit_cast(unsigned, b); }
__device__ __forceinline__ float bf_lo(unsigned u) { return __uint_as_float(u << 16); }
__device__ __forceinline__ float bf_hi(unsigned u) { return __uint_as_float(u & 0xffff0000u); }
__device__ __forceinline__ float bf1(bf16_t u) { return __uint_as_float(((unsigned)u) << 16); }
__device__ __forceinline__ float fast_sigmoid(float x) { return __builtin_amdgcn_rcpf(1.0f + __expf(-x)); }

namespace pg8 {
constexpr int BM = 256, BK = 64, HALF = 128, HTB = HALF * BK * 2  , STAGE_BYTES = 8 * HTB, NXCD = 8, WGM = 8;

__host__ __device__ __forceinline__ int lds_byte(int r, int c) { const int st = (r >> 4) * 2 + (c >> 5), rr = r & 15, cc = c & 31, ob = rr * 64 + cc * 2; return st * 1024 + (ob ^ (((ob >> 9) & 1) << 5)); }
__host__ __device__ __forceinline__ void stage_rc(int b, int& R, int& C) { const int st = b / 1024, sb = b % 1024, swz = sb ^ (((sb >> 9) & 1) << 5); R = (st >> 1) * 16 + swz / 64; C = (st & 1) * 32 + (swz % 64) / 2; }
__host__ __device__ __forceinline__ int perm32(int rho) { const int n = rho >> 4, i = rho & 15; return 8 * (i >> 2) + 4 * n + (i & 3); }

struct Unit { int pm, pn, half; };
struct Gemm { const bf16_t* A; const bf16_t* Bt; int M, N, K, lda, a_pn_cols; int swap_lo, swap_hi; const bf16_t* A2 = nullptr; const bf16_t* Bt2 = nullptr; };

struct StaticOrder {
    int nM, nN, nwg, G, c;
    __host__ __device__ void init(int M, int N, int G_, int c_) { nM = M / BM; nN = N / BM; nwg = nM * nN; G = G_; c = c_; }
    __host__ __device__ bool next(int i, Unit& u) const {
        const long L = (long)i * G + c; if (L >= nwg) return false;
        int wgid = (int)L; { const int q = nwg / NXCD, r = nwg % NXCD, xcd = wgid % NXCD, off = wgid / NXCD; wgid = (xcd < r ? xcd * (q + 1) : r * (q + 1) + (xcd - r) * q) + off; }
        const int nig = WGM * nN, gid = wgid / nig, fm = gid * WGM, gsz = (nM - fm) < WGM ? (nM - fm) : WGM;
        u.pm = fm + ((wgid % nig) % gsz); u.pn = (wgid % nig) / gsz; u.half = 0; return true;
    }
};
struct PairOrder {
    StaticOrder S;
    __host__ __device__ void init(int M, int N, int G_, int c_) { S.init(M, N, G_, c_); }
    __host__ __device__ bool next(int i, Unit& u) const { if (!S.next(i >> 1, u)) return false; u.half = i & 1; return true; }
};

template <class Epi, bool ALIGN_EPI = true, bool SP2 = true, class Order = StaticOrder>
__device__ __forceinline__ void gemm_phase(LAS unsigned char* lds, const Gemm g, const Order& S, const Epi& E, int tid) {
    const int wid = __builtin_amdgcn_readfirstlane(tid >> 6), lane = tid & 63, wr = wid >> 2, wc = wid & 3, fr = lane & 15, fq = lane >> 4;
    const int K = g.K, nt = K / BK, lda = g.lda;
    unsigned voffA[2], voffB[2];
#pragma unroll
    for (int i = 0; i < 2; ++i) { int R, C; stage_rc(tid * 16 + i * 8192, R, C); const int Rb = Epi::PERM ? ((R & ~31) + perm32(R & 31)) : R;
        voffA[i] = (unsigned)(R * lda + C) * 2u; voffB[i] = (unsigned)(Rb * K + C) * 2u; }
    const size_t kstep = (size_t)(BK * 2);
    const size_t hA = (size_t)HALF * lda * 2, hB = (size_t)HALF * K * 2;
    const size_t tA = 2 * hA, tB = 2 * hB;
    const size_t pnA = (size_t)g.a_pn_cols * 2;
    const unsigned ldsw = (unsigned)wid * 1024u;
    const int aoff = lds_byte(wr * 64 + fr, fq * 8), boff = lds_byte(wc * 32 + fr, fq * 8);
#define PG8_SA(b, h) (((b) * 2 + (h)) * HTB)
#define PG8_SB(b, h) ((4 + (b) * 2 + (h)) * HTB)
#define PG8_STAGE(bufoff, gbase, voff) do { _Pragma("unroll") for (int _i = 0; _i < 2; ++_i) \
        __builtin_amdgcn_global_load_lds((const unsigned*)((const char*)(gbase) + (voff)[_i]), (LAS unsigned*)(lds + (bufoff) + ldsw + _i * 8192), 16, 0, 0); } while (0)
#define PG8_LDA(dst, b, h) do { _Pragma("unroll") for (int m = 0; m < 4; ++m) _Pragma("unroll") for (int k = 0; k < 2; ++k) dst[m][k] = *(const LAS bf16x8*)(lds + PG8_SA(b, h) + aoff + m * 2048 + k * 1024); } while (0)
#define PG8_LDB(dst, b, h) do { _Pragma("unroll") for (int n = 0; n < 2; ++n) _Pragma("unroll") for (int k = 0; k < 2; ++k) dst[n][k] = *(const LAS bf16x8*)(lds + PG8_SB(b, h) + boff + n * 2048 + k * 1024); } while (0)
#define PG8_MMA(ai, bj, At, Bt) do { __builtin_amdgcn_s_setprio(1); _Pragma("unroll") for (int m = 0; m < 4; ++m) _Pragma("unroll") for (int n = 0; n < 2; ++n) _Pragma("unroll") for (int k = 0; k < 2; ++k) \
        acc[ai][bj][m][n] = __builtin_amdgcn_mfma_f32_16x16x32_bf16(Bt[n][k], At[m][k], acc[ai][bj][m][n], 0, 0, 0); __builtin_amdgcn_s_setprio(0); } while (0)
#define PG8_WAIT_V(n) asm volatile("s_waitcnt vmcnt(" #n ")" ::: "memory")
#define PG8_WAIT_L(n) asm volatile("s_waitcnt lgkmcnt(" #n ")" ::: "memory")
#define PG8_BAR __builtin_amdgcn_s_barrier()
#define PG8_SCHED __builtin_amdgcn_sched_barrier(0)
    Unit cur, nxt; int ui = 0;
    if (!S.next(0, cur)) return;
    f32x4 acc[2][2][4][2];
#pragma unroll
    for (int a = 0; a < 2; ++a)
#pragma unroll
        for (int b = 0; b < 2; ++b)
#pragma unroll
            for (int m = 0; m < 4; ++m)
#pragma unroll
                for (int n = 0; n < 2; ++n) acc[a][b][m][n] = (f32x4){0.f, 0.f, 0.f, 0.f};
    bf16x8 At[4][2], B0[2][2], B1[2][2];
#define PG8_APTR(u) ((u).half ? (const char*)g.A2 + (size_t)(u).pm * tA : ((u).pn >= g.swap_lo && (u).pn < g.swap_hi) ? (const char*)g.Bt + (size_t)(u).pn * tB : (const char*)g.A + (size_t)(u).pm * tA + (size_t)(u).pn * pnA)
#define PG8_BPTR(u) ((u).half ? (const char*)g.Bt2 + (size_t)(u).pn * tB : ((u).pn >= g.swap_lo && (u).pn < g.swap_hi) ? (const char*)g.A + (size_t)(u).pm * tA : (const char*)g.Bt + (size_t)(u).pn * tB)
    const char* cA = PG8_APTR(cur); const char* cB = PG8_BPTR(cur);
    if constexpr (SP2) {
        PG8_STAGE(PG8_SB(0, 0), cB, voffB); PG8_STAGE(PG8_SB(0, 1), cB + hB, voffB); PG8_STAGE(PG8_SA(0, 0), cA, voffA); PG8_STAGE(PG8_SA(0, 1), cA + hA, voffA);
        if (wr == 1) PG8_BAR;
        PG8_WAIT_V(2); PG8_BAR;
        PG8_STAGE(PG8_SB(1, 0), cB + kstep, voffB); PG8_STAGE(PG8_SA(1, 0), cA + kstep, voffA); PG8_STAGE(PG8_SB(1, 1), cB + hB + kstep, voffB);
        PG8_WAIT_V(6); PG8_BAR;
    } else {
        PG8_STAGE(PG8_SB(0, 0), cB, voffB); PG8_STAGE(PG8_SA(0, 0), cA, voffA); PG8_STAGE(PG8_SB(0, 1), cB + hB, voffB); PG8_STAGE(PG8_SA(0, 1), cA + hA, voffA);
        if (wr == 1) PG8_BAR;
        PG8_WAIT_V(4); PG8_BAR;
        PG8_STAGE(PG8_SB(1, 0), cB + kstep, voffB); PG8_STAGE(PG8_SA(1, 0), cA + kstep, voffA); PG8_STAGE(PG8_SB(1, 1), cB + hB + kstep, voffB);
        PG8_WAIT_V(6); PG8_BAR;
    }
    for (;;) {
        const bool has_next = S.next(ui + 1, nxt);
        const char* nA = has_next ? PG8_APTR(nxt) : cA; const char* nB = has_next ? PG8_BPTR(nxt) : cB;
#pragma unroll 1
        for (int t = 0; t < nt; t += 2) {
            const bool last = (t == nt - 2);
            const char* a1 = cA + (size_t)(t + 1) * kstep;
            const char* a2 = last ? nA : cA + (size_t)(t + 2) * kstep; const char* b2 = last ? nB : cB + (size_t)(t + 2) * kstep;
            const char* a3 = a2 + kstep; const char* b3 = b2 + kstep;
            if constexpr (SP2) {
            PG8_LDB(B0, 0, 0); PG8_LDB(B1, 0, 1); PG8_SCHED; PG8_LDA(At, 0, 0); PG8_STAGE(PG8_SA(1, 1), a1 + hA, voffA);
            PG8_WAIT_V(8); PG8_WAIT_L(0); PG8_BAR; PG8_MMA(0, 0, At, B0); PG8_MMA(0, 1, At, B1); PG8_BAR; PG8_SCHED;
            PG8_LDA(At, 0, 1); PG8_STAGE(PG8_SB(0, 0), b2, voffB); PG8_STAGE(PG8_SB(0, 1), b2 + hB, voffB); PG8_STAGE(PG8_SA(0, 0), a2, voffA);
            PG8_WAIT_V(8); PG8_WAIT_L(0); PG8_BAR; PG8_MMA(1, 0, At, B0); PG8_MMA(1, 1, At, B1); PG8_BAR; PG8_SCHED;
            PG8_LDB(B0, 1, 0); PG8_LDB(B1, 1, 1); PG8_SCHED; PG8_LDA(At, 1, 0); PG8_STAGE(PG8_SA(0, 1), a2 + hA, voffA);
            PG8_WAIT_V(8); PG8_WAIT_L(0); PG8_BAR; PG8_MMA(0, 0, At, B0); PG8_MMA(0, 1, At, B1); PG8_BAR; PG8_SCHED;
            PG8_LDA(At, 1, 1); PG8_STAGE(PG8_SB(1, 0), b3, voffB); PG8_STAGE(PG8_SB(1, 1), b3 + hB, voffB); PG8_STAGE(PG8_SA(1, 0), a3, voffA);
            PG8_WAIT_V(8); PG8_WAIT_L(0); PG8_BAR; PG8_MMA(1, 0, At, B0); PG8_MMA(1, 1, At, B1); PG8_BAR; PG8_SCHED;
            } else {
            PG8_LDB(B0, 0, 0); PG8_SCHED; PG8_LDA(At, 0, 0); PG8_STAGE(PG8_SA(1, 1), a1 + hA, voffA);
            PG8_WAIT_L(8); PG8_BAR; PG8_WAIT_L(0); PG8_MMA(0, 0, At, B0); PG8_BAR; PG8_SCHED;
            PG8_LDB(B1, 0, 1); PG8_STAGE(PG8_SB(0, 0), b2, voffB);
            PG8_BAR; PG8_WAIT_L(0); PG8_MMA(0, 1, At, B1); PG8_BAR;
            PG8_LDA(At, 0, 1); PG8_STAGE(PG8_SA(0, 0), a2, voffA);
            PG8_BAR; PG8_WAIT_L(0); PG8_MMA(1, 0, At, B0); PG8_BAR; PG8_SCHED;
            PG8_STAGE(PG8_SB(0, 1), b2 + hB, voffB);
            PG8_WAIT_V(6); PG8_BAR; PG8_MMA(1, 1, At, B1); PG8_BAR;
            PG8_LDB(B0, 1, 0); PG8_SCHED; PG8_LDA(At, 1, 0); PG8_STAGE(PG8_SA(0, 1), a2 + hA, voffA);
            PG8_WAIT_L(8); PG8_BAR; PG8_WAIT_L(0); PG8_MMA(0, 0, At, B0); PG8_BAR; PG8_SCHED;
            PG8_LDB(B1, 1, 1); PG8_STAGE(PG8_SB(1, 0), b3, voffB);
            PG8_BAR; PG8_WAIT_L(0); PG8_MMA(0, 1, At, B1); PG8_BAR;
            PG8_LDA(At, 1, 1); PG8_STAGE(PG8_SA(1, 0), a3, voffA);
            PG8_BAR; PG8_WAIT_L(0); PG8_MMA(1, 0, At, B0); PG8_BAR; PG8_SCHED;
            PG8_STAGE(PG8_SB(1, 1), b3 + hB, voffB);
            PG8_WAIT_V(6); PG8_BAR; PG8_MMA(1, 1, At, B1); PG8_BAR;
            }
        }
        if constexpr (ALIGN_EPI) { if (wr == 0) PG8_BAR; }
        E(acc, cur, wr, wc, fr, fq);
        if (!has_next) break;
        if (!(Epi::ACCUM && cur.half == 0))
#pragma unroll
        for (int a = 0; a < 2; ++a)
#pragma unroll
            for (int b = 0; b < 2; ++b)
#pragma unroll
                for (int m = 0; m < 4; ++m)
#pragma unroll
                    for (int n = 0; n < 2; ++n) acc[a][b][m][n] = (f32x4){0.f, 0.f, 0.f, 0.f};
        cur = nxt; cA = nA; cB = nB; ++ui;
        if constexpr (ALIGN_EPI) { if (wr == 1) PG8_BAR; }
    }
    PG8_WAIT_V(0);
    if constexpr (!ALIGN_EPI) { if (wr == 0) PG8_BAR; }
    PG8_BAR;
#undef PG8_APTR
#undef PG8_BPTR
#undef PG8_SA
#undef PG8_SB
#undef PG8_STAGE
#undef PG8_LDA
#undef PG8_LDB
#undef PG8_MMA
#undef PG8_WAIT_V
#undef PG8_WAIT_L
#undef PG8_BAR
#undef PG8_SCHED
}
}
constexpr int T_TOK = 16384, DM = 1024, SEQ = 4096, NB = 4;
constexpr float EPS = 1e-6f;
constexpr float LOG2E = 1.4426950408889634f;

namespace pg8 {
struct EpiProj {
    static constexpr bool PERM = true, ACCUM = false;
    bf16_t *GQ, *GK, *GV, *GR, *SQ, *SK, *SV, *SGA, *SGB;
    __device__ __forceinline__ void operator()(const f32x4 (&acc)[2][2][4][2], const Unit& u, int wr, int wc, int fr, int fq) const {
        const int pn = u.pn; bf16_t* base; int ldc = 1024, c0; int act = 0; float sc = 1.f;
        if (pn >= 2 && pn < 8) {
            bf16_t* tb = (pn < 4) ? GK : GV; const int f0 = ((pn < 4) ? (pn - 2) : (pn - 4)) * 256 + wr * 64 + fr, t0 = u.pm * BM + wc * 32 + 8 * fq;
#pragma unroll
            for (int ai = 0; ai < 2; ++ai)
#pragma unroll
                for (int m = 0; m < 4; ++m) { bf16_t* rowp = tb + (size_t)(f0 + ai * HALF + m * 16) * T_TOK + t0;
#pragma unroll
                    for (int bj = 0; bj < 2; ++bj) { const f32x4 v0 = acc[ai][bj][m][0], v1 = acc[ai][bj][m][1];
                        u32x4 w; w.x = cvtpk(v0[0], v0[1]); w.y = cvtpk(v0[2], v0[3]); w.z = cvtpk(v1[0], v1[1]); w.w = cvtpk(v1[2], v1[3]);
                        *(u32x4*)(rowp + bj * HALF) = w; } }
            return; }
        if (pn < 2) { base = GQ; ldc = 512; c0 = pn * 256; sc = 0.08838834764831845f; }
        else if (pn < 4) { base = GK; ldc = 512; c0 = (pn - 2) * 256; }
        else if (pn < 8) { base = GV; c0 = (pn - 4) * 256; }
        else if (pn < 12) { base = GR; c0 = (pn - 8) * 256; act = 1; }
        else if (pn < 16) { base = SQ; c0 = (pn - 12) * 256; sc = 0.125f * LOG2E; }
        else if (pn < 20) { base = SK; c0 = (pn - 16) * 256; }
        else if (pn < 24) { base = SV; c0 = (pn - 20) * 256; }
        else if (pn < 28) { base = SGA; c0 = (pn - 24) * 256; act = 2; }
        else { base = SGB; c0 = (pn - 28) * 256; act = 2; }
        const int row0 = u.pm * BM + wr * 64 + fr, col0 = c0 + wc * 32 + 8 * fq;
#pragma unroll
        for (int ai = 0; ai < 2; ++ai)
#pragma unroll
            for (int m = 0; m < 4; ++m) { bf16_t* rowp = base + (size_t)(row0 + ai * HALF + m * 16) * ldc + col0;
#pragma unroll
                for (int bj = 0; bj < 2; ++bj) { f32x4 v0 = acc[ai][bj][m][0], v1 = acc[ai][bj][m][1];
                    if (act == 1) {
#pragma unroll
                        for (int j = 0; j < 4; ++j) { v0[j] = v0[j] * fast_sigmoid(v0[j]); v1[j] = v1[j] * fast_sigmoid(v1[j]); } }
                    else if (act == 2) {
#pragma unroll
                        for (int j = 0; j < 4; ++j) { v0[j] = fast_sigmoid(v0[j]); v1[j] = fast_sigmoid(v1[j]); } }
                    else { v0 = v0 * sc; v1 = v1 * sc; }
                    u32x4 w; w.x = cvtpk(v0[0], v0[1]); w.y = cvtpk(v0[2], v0[3]); w.z = cvtpk(v1[0], v1[1]); w.w = cvtpk(v1[2], v1[3]);
                    *(u32x4*)(rowp + bj * HALF) = w; } }
    }
};
template <bool FIRST> struct EpiMix {
    static constexpr bool PERM = true, ACCUM = false;
    const bf16_t* gate; bf16_t* mixed;
    __device__ __forceinline__ void operator()(const f32x4 (&acc)[2][2][4][2], const Unit& u, int wr, int wc, int fr, int fq) const {
        const int row0 = u.pm * BM + wr * 64 + fr, col0 = u.pn * BM + wc * 32 + 8 * fq;
#pragma unroll
        for (int ai = 0; ai < 2; ++ai) {
            u32x4 gv[4][2], mv[4][2];
#pragma unroll
            for (int m = 0; m < 4; ++m)
#pragma unroll
                for (int bj = 0; bj < 2; ++bj) { const size_t off = (size_t)(row0 + ai * HALF + m * 16) * 1024 + col0 + bj * HALF;
                    gv[m][bj] = *(const u32x4*)(gate + off); if (!FIRST) mv[m][bj] = *(const u32x4*)(mixed + off); }
#pragma unroll
            for (int m = 0; m < 4; ++m)
#pragma unroll
                for (int bj = 0; bj < 2; ++bj) { const size_t off = (size_t)(row0 + ai * HALF + m * 16) * 1024 + col0 + bj * HALF;
                    const f32x4 a0 = acc[ai][bj][m][0], a1 = acc[ai][bj][m][1]; const u32x4 g4 = gv[m][bj];
                    float r[8];
                    r[0] = a0[0] * bf_lo(g4.x); r[1] = a0[1] * bf_hi(g4.x); r[2] = a0[2] * bf_lo(g4.y); r[3] = a0[3] * bf_hi(g4.y);
                    r[4] = a1[0] * bf_lo(g4.z); r[5] = a1[1] * bf_hi(g4.z); r[6] = a1[2] * bf_lo(g4.w); r[7] = a1[3] * bf_hi(g4.w);
                    if (!FIRST) { const u32x4 m4 = mv[m][bj];
                        r[0] += bf_lo(m4.x); r[1] += bf_hi(m4.x); r[2] += bf_lo(m4.y); r[3] += bf_hi(m4.y); r[4] += bf_lo(m4.z); r[5] += bf_hi(m4.z); r[6] += bf_lo(m4.w); r[7] += bf_hi(m4.w); }
                    u32x4 w; w.x = cvtpk(r[0], r[1]); w.y = cvtpk(r[2], r[3]); w.z = cvtpk(r[4], r[5]); w.w = cvtpk(r[6], r[7]);
                    *(u32x4*)(mixed + off) = w; }
        }
    }
};
struct EpiMixPair {
    static constexpr bool PERM = true, ACCUM = true;
    const bf16_t* ga; const bf16_t* gb; bf16_t* mixed;
    __device__ __forceinline__ void operator()(f32x4 (&acc)[2][2][4][2], const Unit& u, int wr, int wc, int fr, int fq) const {
        const int row0 = u.pm * BM + wr * 64 + fr, col0 = u.pn * BM + wc * 32 + 8 * fq;
        const float TINY = 8.673617379884035e-19f;
        if (u.half == 0) {
#pragma unroll
            for (int ai = 0; ai < 2; ++ai) {
                u32x4 av[4][2], bv[4][2];
#pragma unroll
                for (int m = 0; m < 4; ++m)
#pragma unroll
                    for (int bj = 0; bj < 2; ++bj) { const size_t off = (size_t)(row0 + ai * HALF + m * 16) * 1024 + col0 + bj * HALF; av[m][bj] = *(const u32x4*)(ga + off); bv[m][bj] = *(const u32x4*)(gb + off); }
#pragma unroll
                for (int m = 0; m < 4; ++m)
#pragma unroll
                    for (int bj = 0; bj < 2; ++bj) { const u32x4 a4 = av[m][bj], b4 = bv[m][bj];
                        const unsigned aw[4] = {a4.x, a4.y, a4.z, a4.w}, bw[4] = {b4.x, b4.y, b4.z, b4.w};
#pragma unroll
                        for (int j = 0; j < 4; ++j) { const float r0 = bf_lo(aw[j]) * __builtin_amdgcn_rcpf(fmaxf(bf_lo(bw[j]), TINY)), r1 = bf_hi(aw[j]) * __builtin_amdgcn_rcpf(fmaxf(bf_hi(bw[j]), TINY));
                            acc[ai][bj][m][j >> 1][2 * (j & 1)] *= r0; acc[ai][bj][m][j >> 1][2 * (j & 1) + 1] *= r1; } }
            }
        } else {
#pragma unroll
            for (int ai = 0; ai < 2; ++ai) {
                u32x4 bv[4][2];
#pragma unroll
                for (int m = 0; m < 4; ++m)
#pragma unroll
                    for (int bj = 0; bj < 2; ++bj) bv[m][bj] = *(const u32x4*)(gb + (size_t)(row0 + ai * HALF + m * 16) * 1024 + col0 + bj * HALF);
#pragma unroll
                for (int m = 0; m < 4; ++m)
#pragma unroll
                    for (int bj = 0; bj < 2; ++bj) { const size_t off = (size_t)(row0 + ai * HALF + m * 16) * 1024 + col0 + bj * HALF; const u32x4 b4 = bv[m][bj];
                        const f32x4 a0 = acc[ai][bj][m][0], a1 = acc[ai][bj][m][1];
                        float r[8];
                        r[0] = a0[0] * fmaxf(bf_lo(b4.x), TINY); r[1] = a0[1] * fmaxf(bf_hi(b4.x), TINY); r[2] = a0[2] * fmaxf(bf_lo(b4.y), TINY); r[3] = a0[3] * fmaxf(bf_hi(b4.y), TINY);
                        r[4] = a1[0] * fmaxf(bf_lo(b4.z), TINY); r[5] = a1[1] * fmaxf(bf_hi(b4.z), TINY); r[6] = a1[2] * fmaxf(bf_lo(b4.w), TINY); r[7] = a1[3] * fmaxf(bf_hi(b4.w), TINY);
                        u32x4 w; w.x = cvtpk(r[0], r[1]); w.y = cvtpk(r[2], r[3]); w.z = cvtpk(r[4], r[5]); w.w = cvtpk(r[6], r[7]);
                        *(u32x4*)(mixed + off) = w; }
            }
        }
    }
};
struct EpiH1 {
    static constexpr bool PERM = false, ACCUM = false;
    const float* x; bf16_t* H1B; float* SSQ;
    __device__ __forceinline__ void operator()(const f32x4 (&acc)[2][2][4][2], const Unit& u, int wr, int wc, int fr, int fq) const {
        const int row0 = u.pm * BM + wr * 64 + fr, col0 = u.pn * BM + wc * 32 + 4 * fq;
#pragma unroll
        for (int ai = 0; ai < 2; ++ai) {
            f32x4 xv[4][2][2];
#pragma unroll
            for (int m = 0; m < 4; ++m)
#pragma unroll
                for (int bj = 0; bj < 2; ++bj)
#pragma unroll
                    for (int n = 0; n < 2; ++n) xv[m][bj][n] = *(const f32x4*)(x + (size_t)(row0 + ai * HALF + m * 16) * 1024 + col0 + bj * HALF + n * 16);
#pragma unroll
            for (int m = 0; m < 4; ++m) { const int row = row0 + ai * HALF + m * 16; const size_t off = (size_t)row * 1024 + col0; float s = 0.f;
#pragma unroll
                for (int bj = 0; bj < 2; ++bj)
#pragma unroll
                    for (int n = 0; n < 2; ++n) { const f32x4 h = xv[m][bj][n] + acc[ai][bj][m][n];
                        s += (h[0] * h[0] + h[1] * h[1]) + (h[2] * h[2] + h[3] * h[3]);
                        u32x2 hb; hb.x = cvtpk(h[0], h[1]); hb.y = cvtpk(h[2], h[3]); *(u32x2*)(H1B + off + bj * HALF + n * 16) = hb; }
                s += __shfl_xor(s, 16); s += __shfl_xor(s, 32);
                if (fq == 0) SSQ[(size_t)row * 16 + u.pn * 4 + wc] = s; }
        }
    }
};
struct EpiQ {
    static constexpr bool PERM = true, ACCUM = false;
    const float* SSQ; bf16_t* Q; int ldc;
    __device__ __forceinline__ void operator()(const f32x4 (&acc)[2][2][4][2], const Unit& u, int wr, int wc, int fr, int fq) const {
        const int row0 = u.pm * BM + wr * 64 + fr, col0 = u.pn * BM + wc * 32 + 8 * fq;
        float rstd[2][4];
#pragma unroll
        for (int ai = 0; ai < 2; ++ai) { f32x4 sq[4][4];
#pragma unroll
            for (int m = 0; m < 4; ++m) { const f32x4* sp = (const f32x4*)(SSQ + (size_t)(row0 + ai * HALF + m * 16) * 16);
#pragma unroll
                for (int j = 0; j < 4; ++j) sq[m][j] = sp[j]; }
#pragma unroll
            for (int m = 0; m < 4; ++m) { const f32x4 st = (sq[m][0] + sq[m][1]) + (sq[m][2] + sq[m][3]);
                rstd[ai][m] = __builtin_amdgcn_rsqf(((st[0] + st[1]) + (st[2] + st[3])) * (1.0f / 1024.0f) + EPS); } }
#pragma unroll
        for (int ai = 0; ai < 2; ++ai)
#pragma unroll
            for (int m = 0; m < 4; ++m) { const int row = row0 + ai * HALF + m * 16;
                bf16_t* rowp = Q + (size_t)row * ldc + col0;
#pragma unroll
                for (int bj = 0; bj < 2; ++bj) { const f32x4 v0 = acc[ai][bj][m][0] * rstd[ai][m], v1 = acc[ai][bj][m][1] * rstd[ai][m];
                    u32x4 w; w.x = cvtpk(v0[0], v0[1]); w.y = cvtpk(v0[2], v0[3]); w.z = cvtpk(v1[0], v1[1]); w.w = cvtpk(v1[2], v1[3]);
                    *(u32x4*)(rowp + bj * HALF) = w; } }
    }
};
struct EpiF32 {
    static constexpr bool PERM = false, ACCUM = false;
    float* O; int ldc;
    __device__ __forceinline__ void operator()(const f32x4 (&acc)[2][2][4][2], const Unit& u, int wr, int wc, int fr, int fq) const {
        const int row0 = u.pm * BM + wr * 64 + fr, col0 = u.pn * BM + wc * 32 + 4 * fq;
#pragma unroll
        for (int ai = 0; ai < 2; ++ai)
#pragma unroll
            for (int m = 0; m < 4; ++m) { float* rowp = O + (size_t)(row0 + ai * HALF + m * 16) * ldc + col0;
#pragma unroll
                for (int bj = 0; bj < 2; ++bj)
#pragma unroll
                    for (int n = 0; n < 2; ++n) *(f32x4*)(rowp + bj * HALF + n * 16) = acc[ai][bj][m][n]; }
    }
};
struct EpiBf {
    static constexpr bool PERM = true, ACCUM = false;
    bf16_t* O; int ldc;
    __device__ __forceinline__ void operator()(const f32x4 (&acc)[2][2][4][2], const Unit& u, int wr, int wc, int fr, int fq) const {
        const int row0 = u.pm * BM + wr * 64 + fr, col0 = u.pn * BM + wc * 32 + 8 * fq;
#pragma unroll
        for (int ai = 0; ai < 2; ++ai)
#pragma unroll
            for (int m = 0; m < 4; ++m) { bf16_t* rowp = O + (size_t)(row0 + ai * HALF + m * 16) * ldc + col0;
#pragma unroll
                for (int bj = 0; bj < 2; ++bj) { const f32x4 v0 = acc[ai][bj][m][0], v1 = acc[ai][bj][m][1];
                    u32x4 w; w.x = cvtpk(v0[0], v0[1]); w.y = cvtpk(v0[2], v0[3]); w.z = cvtpk(v1[0], v1[1]); w.w = cvtpk(v1[2], v1[3]);
                    *(u32x4*)(rowp + bj * HALF) = w; } }
    }
};
struct EpiH3 {
    static constexpr bool PERM = false, ACCUM = false;
    const bf16_t* H2B; const bf16_t* PLE; const float* RS; bf16_t* H3B; float* SSQ; int dry;
    __device__ __forceinline__ void operator()(const f32x4 (&acc)[2][2][4][2], const Unit& u, int wr, int wc, int fr, int fq) const {
        const int row0 = u.pm * BM + wr * 64 + fr, col0 = u.pn * BM + wc * 32 + 4 * fq;
#pragma unroll
        for (int ai = 0; ai < 2; ++ai) {
            u32x2 hv[4][2][2], pv[4][2][2]; float rs[4];
#pragma unroll
            for (int m = 0; m < 4; ++m) rs[m] = RS[row0 + ai * HALF + m * 16];
#pragma unroll
            for (int m = 0; m < 4; ++m)
#pragma unroll
                for (int bj = 0; bj < 2; ++bj)
#pragma unroll
                    for (int n = 0; n < 2; ++n) { const size_t o2 = (size_t)(row0 + ai * HALF + m * 16) * 1024 + col0 + bj * HALF + n * 16; hv[m][bj][n] = *(const u32x2*)(H2B + o2); pv[m][bj][n] = *(const u32x2*)(PLE + o2); }
#pragma unroll
            for (int m = 0; m < 4; ++m) { const int row = row0 + ai * HALF + m * 16; const size_t off = (size_t)row * 1024 + col0; float s = 0.f;
#pragma unroll
                for (int bj = 0; bj < 2; ++bj)
#pragma unroll
                    for (int n = 0; n < 2; ++n) { const size_t o2 = off + bj * HALF + n * 16; const u32x2 h2 = hv[m][bj][n], p2 = pv[m][bj][n];
                        const f32x4 a = acc[ai][bj][m][n] * rs[m]; f32x4 h;
                        h[0] = bf_lo(h2.x) + bf_lo(p2.x) * fast_sigmoid(a[0]); h[1] = bf_hi(h2.x) + bf_hi(p2.x) * fast_sigmoid(a[1]);
                        h[2] = bf_lo(h2.y) + bf_lo(p2.y) * fast_sigmoid(a[2]); h[3] = bf_hi(h2.y) + bf_hi(p2.y) * fast_sigmoid(a[3]);
                        u32x2 w; w.x = cvtpk(h[0], h[1]); w.y = cvtpk(h[2], h[3]); if (!dry) *(u32x2*)(H3B + o2) = w;
                        s += (h[0] * h[0] + h[1] * h[1]) + (h[2] * h[2] + h[3] * h[3]); }
                s += __shfl_xor(s, 16); s += __shfl_xor(s, 32);
                if (fq == 0) SSQ[(size_t)row * 16 + u.pn * 4 + wc] = s; }
        }
    }
};
constexpr int H3L_PITCH = 544;
struct EpiH3L {
    static constexpr bool PERM = false, ACCUM = false;
    const bf16_t* H2B; const bf16_t* PLE; const float* RS; LAS unsigned char* tile; float* SSQ;
    __device__ __forceinline__ void operator()(const f32x4 (&acc)[2][2][4][2], const Unit& u, int wr, int wc, int fr, int fq) const {
        const int lrow0 = wr * 64 + fr, lcol0 = wc * 32 + 4 * fq, row0 = u.pm * BM + lrow0, col0 = u.pn * BM + lcol0;
        asm volatile("s_waitcnt vmcnt(0)" ::: "memory"); __builtin_amdgcn_s_barrier();
#pragma unroll
        for (int ai = 0; ai < 2; ++ai) {
            u32x2 hv[4][2][2], pv[4][2][2]; float rs[4];
#pragma unroll
            for (int m = 0; m < 4; ++m) rs[m] = RS[row0 + ai * HALF + m * 16];
#pragma unroll
            for (int m = 0; m < 4; ++m)
#pragma unroll
                for (int bj = 0; bj < 2; ++bj)
#pragma unroll
                    for (int n = 0; n < 2; ++n) { const size_t o2 = (size_t)(row0 + ai * HALF + m * 16) * 1024 + col0 + bj * HALF + n * 16; hv[m][bj][n] = *(const u32x2*)(H2B + o2); pv[m][bj][n] = *(const u32x2*)(PLE + o2); }
#pragma unroll
            for (int m = 0; m < 4; ++m) { const int lrow = lrow0 + ai * HALF + m * 16; float s = 0.f;
#pragma unroll
                for (int bj = 0; bj < 2; ++bj)
#pragma unroll
                    for (int n = 0; n < 2; ++n) { const u32x2 h2 = hv[m][bj][n], p2 = pv[m][bj][n];
                        const f32x4 a = acc[ai][bj][m][n] * rs[m]; f32x4 h;
                        h[0] = bf_lo(h2.x) + bf_lo(p2.x) * fast_sigmoid(a[0]); h[1] = bf_hi(h2.x) + bf_hi(p2.x) * fast_sigmoid(a[1]);
                        h[2] = bf_lo(h2.y) + bf_lo(p2.y) * fast_sigmoid(a[2]); h[3] = bf_hi(h2.y) + bf_hi(p2.y) * fast_sigmoid(a[3]);
                        u32x2 w; w.x = cvtpk(h[0], h[1]); w.y = cvtpk(h[2], h[3]); *(LAS u32x2*)(tile + lrow * H3L_PITCH + (lcol0 + bj * HALF + n * 16) * 2) = w;
                        s += (h[0] * h[0] + h[1] * h[1]) + (h[2] * h[2] + h[3] * h[3]); }
                s += __shfl_xor(s, 16); s += __shfl_xor(s, 32);
                if (fq == 0) SSQ[(size_t)(u.pm * BM + lrow) * 16 + u.pn * 4 + wc] = s; }
        }
    }
};
}
constexpr size_t MiB = 1u << 20;
constexpr size_t WS_CTL = 0, CTL_ZERO_BYTES = 64 * 1024;
constexpr size_t WS_PEND = 64 * 1024;
constexpr size_t WS_WPLE = 512 * 1024;
constexpr size_t WS_KD = 1 * MiB;
constexpr size_t WS_GLAG = 2 * MiB;
constexpr size_t WS_WIN = 3 * MiB;
constexpr size_t WS_SEND = 4 * MiB;
constexpr size_t WS_EXP = 4 * MiB;
constexpr size_t WS_SSQ1 = 13 * MiB;
constexpr size_t WS_SSQ3 = 14 * MiB;
constexpr size_t WS_RS3 = 15 * MiB;
constexpr size_t WS_RSU = 1536 * 1024, WS_RSV = 1536 * 1024 + 64 * 1024;
constexpr size_t WS_WGA = 20 * MiB, WS_WSB = 22 * MiB, WS_WO = 24 * MiB, WS_WPG = 26 * MiB, WS_WPQ = 28 * MiB;
constexpr size_t WS_A = 32 * MiB;
constexpr size_t WS_GQ = WS_A, WS_GK = WS_A + 16 * MiB;
constexpr size_t WS_B = 64 * MiB;
constexpr size_t WS_GV = WS_B, WS_PB = WS_B;
constexpr size_t WS_C = 96 * MiB;
constexpr size_t WS_GR = WS_C, WS_GLAN = WS_C, WS_H1 = WS_C, WS_H3B = WS_C;
constexpr size_t WS_D = 128 * MiB;
constexpr size_t WS_SQ = WS_D, WS_H2B = WS_D;
constexpr size_t WS_E = 160 * MiB;
constexpr size_t WS_SK = WS_E, WS_MIX = WS_E, WS_Q = WS_E, WS_PLE = WS_E;
constexpr size_t WS_F = 192 * MiB;
constexpr size_t WS_SV = WS_F;
constexpr size_t WS_G = 224 * MiB;
constexpr size_t WS_XN1 = WS_G, WS_UB8 = WS_G, WS_VB8 = WS_G + 16 * MiB;
constexpr size_t WS_END = 256 * MiB;

constexpr int NWAVES = 8;
constexpr int RING_OFF = 0, RING_BYTES = 131072;
constexpr int MISC_OFF = 143360;
constexpr int LDS_BYTES = 147456;
constexpr int CW_BAR = 1024;
constexpr int CW_ROWCNT = 512;

typedef GAS unsigned gu32;
#define RLX_AGENT __ATOMIC_RELAXED, __HIP_MEMORY_SCOPE_AGENT
#define LDS_WAIT() asm volatile("s_waitcnt lgkmcnt(0)" ::: "memory")
#define VM_WAIT() asm volatile("s_waitcnt vmcnt(0)" ::: "memory")

#define XB_TMO      128
#define XB_XCNT(j)  (256  + 64 * (j))
#define XB_XSUB(j)  (1280 + 64 * (j))
#define XB_XGEN(j)  (2304 + 64 * (j))
#define XB_TOP      3328
#define XB_TOPGEN   3392
#define XCD_BAR_WORDS 3456
#define XB_SPIN_CAP (1u << 22)
__device__ __forceinline__ unsigned xb_ld(unsigned* p)              { return __hip_atomic_load(p, __ATOMIC_RELAXED, __HIP_MEMORY_SCOPE_AGENT); }
__device__ __forceinline__ unsigned xb_add(unsigned* p, unsigned v) { return __hip_atomic_fetch_add(p, v, __ATOMIC_RELAXED, __HIP_MEMORY_SCOPE_AGENT); }
__device__ __forceinline__ unsigned xb_xcc_id() { return (unsigned)__builtin_amdgcn_s_getreg((3 << 11) | 20) & 0xFu; }
#define XB_SPIN(cond, bar) do { unsigned _sp = 0; while (cond) { __builtin_amdgcn_s_sleep(1); \
    if ((++_sp & 255u) == 0u) { if (xb_ld(&(bar)[XB_TMO])) break; if (_sp > XB_SPIN_CAP) { atomicAdd(&(bar)[XB_TMO], 1u); break; } } } } while (0)
struct XcdBarrier { unsigned* bar; unsigned x; volatile LAS unsigned* st; };
__device__ __forceinline__ XcdBarrier xcd_barrier_post(unsigned* bar, volatile LAS unsigned* st, int tid) {
    XcdBarrier b; b.bar = bar; b.x = xb_xcc_id(); b.st = st;
    if (tid == 0) (void)xb_add(&bar[XB_XCNT(b.x)], 1u);
    return b;
}
__device__ __forceinline__ void xcd_barrier_complete(unsigned* bar, unsigned x, unsigned& nloc, unsigned& nx) {
    const unsigned G = gridDim.x * gridDim.y * gridDim.z;
    unsigned sum, cnt, mine, sp = 0u;
    for (;;) {
        sum = 0u; cnt = 0u; mine = 0u;
#pragma unroll
        for (unsigned j = 0; j < 16; ++j) { const unsigned c = xb_ld(&bar[XB_XCNT(j)]); sum += c; cnt += (c > 0u) ? 1u : 0u; mine = (j == x) ? c : mine; }
        if (sum == G) break;
        __builtin_amdgcn_s_sleep(1);
        if ((++sp & 255u) == 0u) { if (xb_ld(&bar[XB_TMO])) break; if (sp > XB_SPIN_CAP) { atomicAdd(&bar[XB_TMO], 1u); break; } }
    }
    nloc = mine > 0u ? mine : 1u; nx = cnt > 0u ? cnt : 1u;
}
__device__ __forceinline__ void xcd_barrier(const XcdBarrier& b, int tid) {
    asm volatile("s_waitcnt vmcnt(0)" ::: "memory");
    __syncthreads();
    if (tid == 0) {
        unsigned* bar = b.bar;
        __builtin_amdgcn_s_waitcnt(0);
        unsigned nloc = b.st[0], nx = b.st[1];
        if (nloc == 0u) { xcd_barrier_complete(bar, b.x, nloc, nx); b.st[0] = nloc; b.st[1] = nx; }
        const unsigned old = xb_add(&bar[XB_XSUB(b.x)], 1u);
        const unsigned gen = old / nloc;
        if (old + 1u == (gen + 1u) * nloc) {
            __builtin_amdgcn_fence(__ATOMIC_RELEASE, "agent");
            asm volatile("s_waitcnt vmcnt(0)" ::: "memory");
            const unsigned og = xb_add(&bar[XB_TOP], 1u);
            const unsigned tg = og / nx;
            if (og + 1u == (tg + 1u) * nx) xb_add(&bar[XB_TOPGEN], 1u);
            else XB_SPIN(xb_ld(&bar[XB_TOPGEN]) == tg, bar);
            __builtin_amdgcn_fence(__ATOMIC_ACQUIRE, "agent");
            xb_add(&bar[XB_XGEN(b.x)], 1u);
            asm volatile("s_waitcnt vmcnt(0)" ::: "memory");
        } else {
            XB_SPIN(xb_ld(&bar[XB_XGEN(b.x)]) == gen, bar);
            __builtin_amdgcn_fence(__ATOMIC_ACQUIRE, "agent");
            asm volatile("s_waitcnt vmcnt(0)" ::: "memory");
        }
    }
    __syncthreads();
}

struct Frame {
    LAS unsigned char* lds;
    int tid, lane, wave, vcu, G, dry;
    const float* const* in; float* out; unsigned char* ws;
};
__device__ __forceinline__ int lane_id() { int l; asm volatile("v_mbcnt_lo_u32_b32 %0, -1, 0\n\tv_mbcnt_hi_u32_b32 %0, -1, %0" : "=v"(l)); return l; }
#define WSP(T, off) ((T*)(F.ws + (off)))
__device__ __forceinline__ float wave_sum(float v) {
#pragma unroll
    for (int o = 1; o < 64; o <<= 1) v += __shfl_xor(v, o);
    return v;
}
template <class RowMap>
__device__ __forceinline__ void p0_transpose_item(const float* W, int K, int N, bf16_t* WT, RowMap rm, LAS float* scr, int item, int lane, const float* gk = nullptr) {
    const int nblk = (N + 31) / 32, kb = item / nblk, nb = item % nblk, k0 = 64 * kb, n0 = 32 * nb;
    { const int kr = lane >> 3, c4 = lane & 7, nl = n0 + 4 * c4; f32x4 v[8];
#pragma unroll
      for (int i = 0; i < 8; ++i) v[i] = (nl < N) ? *(const f32x4*)(W + (size_t)(k0 + 8 * i + kr) * N + nl) : (f32x4){0.f, 0.f, 0.f, 0.f};
#pragma unroll
      for (int i = 0; i < 8; ++i) { LAS float* d = scr + (8 * i + kr) * 33 + 4 * c4; d[0] = v[i][0]; d[1] = v[i][1]; d[2] = v[i][2]; d[3] = v[i][3]; } }
    LDS_WAIT(); asm volatile("" ::: "memory");
    const int c = lane & 7;
#pragma unroll
    for (int j = 0; j < 4; ++j) { const int n = (lane >> 3) + 8 * j; const LAS float* s = scr + (8 * c) * 33 + n;
        f32x4 ga = (f32x4){1.f, 1.f, 1.f, 1.f}, gb = ga; if (gk) { ga = *(const f32x4*)(gk + k0 + 8 * c); gb = *(const f32x4*)(gk + k0 + 8 * c + 4); }
        u32x4 o; o.x = cvtpk(s[0 * 33] * ga[0], s[1 * 33] * ga[1]); o.y = cvtpk(s[2 * 33] * ga[2], s[3 * 33] * ga[3]); o.z = cvtpk(s[4 * 33] * gb[0], s[5 * 33] * gb[1]); o.w = cvtpk(s[6 * 33] * gb[2], s[7 * 33] * gb[3]);
        if (n0 + n < N) *(u32x4*)(WT + (size_t)rm(n0 + n) * K + k0 + 8 * c) = o; }
    LDS_WAIT(); asm volatile("" ::: "memory");
}
struct RmId { __device__ __forceinline__ int operator()(int n) const { return n; } };
struct RmWin { __device__ __forceinline__ int operator()(int n) const { return n < 3072 ? n : (n < 3088 ? 8192 + (n - 3072) : n - 16); } };

__device__ __forceinline__ void cvt_copy(Frame& F, const float* src, bf16_t* dst, size_t n) {
    const size_t nth = (size_t)F.G * 512, n8 = n / 8;
    for (size_t i = (size_t)F.vcu * 512 + F.tid; i < n8; i += nth) {
        const f32x4 a = *(const f32x4*)(src + i * 8), b = *(const f32x4*)(src + i * 8 + 4);
        u32x4 o; o.x = cvtpk(a[0], a[1]); o.y = cvtpk(a[2], a[3]); o.z = cvtpk(b[0], b[1]); o.w = cvtpk(b[2], b[3]);
        *(u32x4*)(dst + i * 8) = o; }
}
__device__ __forceinline__ void rms_row_to_bf16(const float* xrow, const float* g, bf16_t* orow, int lane) {
    f32x4 v[4]; float s = 0.f;
#pragma unroll
    for (int j = 0; j < 4; ++j) { v[j] = *((const f32x4*)xrow + lane + 64 * j); s += (v[j][0] * v[j][0] + v[j][1] * v[j][1]) + (v[j][2] * v[j][2] + v[j][3] * v[j][3]); }
    const float rstd = __builtin_amdgcn_rsqf(wave_sum(s) * (1.f / 1024.f) + EPS);
#pragma unroll
    for (int j = 0; j < 4; ++j) { const f32x4 gv = *((const f32x4*)g + lane + 64 * j); const f32x4 o = v[j] * rstd * gv;
        u32x2 w; w.x = cvtpk(o[0], o[1]); w.y = cvtpk(o[2], o[3]); *((u32x2*)orow + lane + 64 * j) = w; }
}
__device__ __forceinline__ void phase_prologue(Frame& F) {
    LAS float* scr = (LAS float*)(F.lds + RING_OFF + F.wave * 16384);
    const int gw = F.vcu * NWAVES + F.wave, NGW = F.G * NWAVES;
    constexpr int I_IN = 16 * 257, I_SQ = 16 * 32, I_PQ = 16 * 64, I_PLE = 4 * 32;
    constexpr int NITEMS = I_IN + 4 * I_SQ + I_PQ + I_PLE;
    for (int it = gw; it < NITEMS; it += NGW) {
        int r = it;
        if (r < I_IN) { p0_transpose_item(F.in[3], 1024, 8208, WSP(bf16_t, WS_WIN), RmWin(), scr, r, F.lane); continue; } r -= I_IN;
        if (r < I_SQ) { p0_transpose_item(F.in[7], 1024, 1024, WSP(bf16_t, WS_WGA), RmId(), scr, r, F.lane); continue; } r -= I_SQ;
        if (r < I_SQ) { p0_transpose_item(F.in[8], 1024, 1024, WSP(bf16_t, WS_WSB), RmId(), scr, r, F.lane); continue; } r -= I_SQ;
        if (r < I_SQ) { p0_transpose_item(F.in[9], 1024, 1024, WSP(bf16_t, WS_WO), RmId(), scr, r, F.lane); continue; } r -= I_SQ;
        if (r < I_SQ) { p0_transpose_item(F.in[17], 1024, 1024, WSP(bf16_t, WS_WPG), RmId(), scr, r, F.lane, F.in[16]); continue; } r -= I_SQ;
        if (r < I_PQ) { p0_transpose_item(F.in[11], 1024, 2048, WSP(bf16_t, WS_WPQ), RmId(), scr, r, F.lane, F.in[10]); continue; } r -= I_PQ;
        p0_transpose_item(F.in[18], 256, 1024, WSP(bf16_t, WS_WPLE), RmId(), scr, r, F.lane);
    }
    { const float* k1 = F.in[12]; const float* k2 = F.in[13]; bf16_t* KB = WSP(bf16_t, WS_KD);
      for (int i = F.vcu * 512 + F.tid; i < 2 * 8 * 128 * 16; i += F.G * 512) { const int half = i >> 14, rem = i & 16383, h = rem >> 11, r8 = rem & 2047;
          const float* s = (half ? k2 : k1) + (size_t)h * 16384 + (size_t)r8 * 8; const f32x4 a = *(const f32x4*)s, b = *(const f32x4*)(s + 4);
          u32x4 o; o.x = cvtpk(a[0], a[1]); o.y = cvtpk(a[2], a[3]); o.z = cvtpk(b[0], b[1]); o.w = cvtpk(b[2], b[3]);
          *(u32x4*)(KB + (size_t)(h * 2 + half) * 16384 + (size_t)r8 * 8) = o; } }
    for (int m = gw; m < T_TOK; m += 4 * NGW) {
        f32x4 v[4][4]; float s[4];
#pragma unroll
        for (int q = 0; q < 4; ++q) { const float* xr = F.in[0] + (size_t)(m + q * NGW) * 1024; s[q] = 0.f;
#pragma unroll
            for (int j = 0; j < 4; ++j) { v[q][j] = *((const f32x4*)xr + F.lane + 64 * j); s[q] += (v[q][j][0] * v[q][j][0] + v[q][j][1] * v[q][j][1]) + (v[q][j][2] * v[q][j][2] + v[q][j][3] * v[q][j][3]); } }
#pragma unroll
        for (int o = 1; o < 64; o <<= 1) {
#pragma unroll
            for (int q = 0; q < 4; ++q) s[q] += __shfl_xor(s[q], o); }
#pragma unroll
        for (int q = 0; q < 4; ++q) { const float rstd = __builtin_amdgcn_rsqf(s[q] * (1.f / 1024.f) + EPS); bf16_t* orow = WSP(bf16_t, WS_XN1) + (size_t)(m + q * NGW) * 1024;
#pragma unroll
            for (int j = 0; j < 4; ++j) { const f32x4 gv = *((const f32x4*)F.in[2] + F.lane + 64 * j); const f32x4 o = v[q][j] * rstd * gv;
                u32x2 wq; wq.x = cvtpk(o[0], o[1]); wq.y = cvtpk(o[2], o[3]); *((u32x2*)orow + F.lane + 64 * j) = wq; } }
    }
}

__device__ __forceinline__ void phase_gla_prep(Frame& F) {
    LAS float* alo = (LAS float*)(F.lds + RING_OFF);
    const bf16_t* XN1 = WSP(bf16_t, WS_XN1); const bf16_t* WGAT = WSP(bf16_t, WS_WIN) + (size_t)8192 * 1024;
    bf16_t* GKT = WSP(bf16_t, WS_GK); float* GLAG = WSP(float, WS_GLAG);
    const float* w_up = F.in[4]; const float* b_a = F.in[5];
    const int tid = F.tid, lane = F.lane, w = F.wave;
    for (int u = F.vcu; u < 256; u += F.G) {
        const size_t r0 = (size_t)u * 64;
        __syncthreads();
        const int kk = tid;
        bf16_t* krow = GKT + (size_t)kk * T_TOK + r0;
        u32x4 kq[8];
#pragma unroll
        for (int j = 0; j < 8; ++j) kq[j] = *(const u32x4*)(krow + 8 * j);
        {
            LAS float* part = alo + 1024;
            const bf16_t* bp = WGAT + (size_t)(lane & 15) * 1024 + 8 * (lane >> 4) + 128 * w;
            bf16x8 bq[4];
#pragma unroll
            for (int s = 0; s < 4; ++s) bq[s] = *(const bf16x8*)(bp + 32 * s);
#pragma unroll
            for (int rt = 0; rt < 4; ++rt) { f32x4 acc = (f32x4){0.f, 0.f, 0.f, 0.f};
                const bf16_t* ap = XN1 + (r0 + 16 * rt + (lane & 15)) * 1024 + 8 * (lane >> 4) + 128 * w;
#pragma unroll
                for (int s = 0; s < 4; ++s) { const bf16x8 a = *(const bf16x8*)(ap + 32 * s); acc = __builtin_amdgcn_mfma_f32_16x16x32_bf16(a, bq[s], acc, 0, 0, 0); }
#pragma unroll
                for (int r = 0; r < 4; ++r) part[w * 1024 + (16 * rt + 4 * (lane >> 4) + r) * 16 + (lane & 15)] = acc[r]; }
            __syncthreads();
#pragma unroll
            for (int q = 0; q < 2; ++q) { const int e = tid + 512 * q; float s = 0.f;
#pragma unroll
                for (int ww = 0; ww < 8; ++ww) s += part[ww * 1024 + e];
                alo[e] = s; }
        }
        float wv[16];
#pragma unroll
        for (int r = 0; r < 16; ++r) wv[r] = w_up[r * 512 + kk];
        const float bias = b_a[kk];
        __syncthreads();
        float suffix = 0.f;
#pragma unroll
        for (int i8 = 7; i8 >= 0; --i8) {
            const unsigned kw[4] = {kq[i8].x, kq[i8].y, kq[i8].z, kq[i8].w};
            float o[8];
#pragma unroll
            for (int j = 7; j >= 0; --j) { const int i = i8 * 8 + j;
                const f32x4 a0 = *(const LAS f32x4*)(alo + i * 16), a1 = *(const LAS f32x4*)(alo + i * 16 + 4), a2 = *(const LAS f32x4*)(alo + i * 16 + 8), a3 = *(const LAS f32x4*)(alo + i * 16 + 12);
                float x = bias;
                x += a0[0] * wv[0] + a0[1] * wv[1] + a0[2] * wv[2] + a0[3] * wv[3];
                x += a1[0] * wv[4] + a1[1] * wv[5] + a1[2] * wv[6] + a1[3] * wv[7];
                x += a2[0] * wv[8] + a2[1] * wv[9] + a2[2] * wv[10] + a2[3] * wv[11];
                x += a3[0] * wv[12] + a3[1] * wv[13] + a3[2] * wv[14] + a3[3] * wv[15];
                const float la = (fminf(x, 0.f) - __logf(1.0f + __expf(-fabsf(x)))) * (1.0f / 16.0f);
                const float kvv = (j & 1) ? bf_hi(kw[j >> 1]) : bf_lo(kw[j >> 1]);
                o[j] = kvv * __expf(suffix);
                suffix += la; }
            u32x4 pk; pk.x = cvtpk(o[0], o[1]); pk.y = cvtpk(o[2], o[3]); pk.z = cvtpk(o[4], o[5]); pk.w = cvtpk(o[6], o[7]);
            if (!F.dry) *(u32x4*)(krow + i8 * 8) = pk; }
        GLAG[(size_t)u * 512 + kk] = __expf(suffix);
    }
}
constexpr int GL_KD = 0, GL_Q = 32768, GL_G = 65536, GL_RED = 65536 + 1024, GL_OT = 65536 + 1024 + 4096, GL_OT_PITCH = 260;
__device__ __forceinline__ int gl_kd_off(int row, int chunk) { return row * 128 + ((chunk ^ ((row >> 1) & 7)) << 4); }
__device__ __forceinline__ int gl_q_off(int row, int chunk16) { return row * 256 + ((chunk16 ^ (row & 15)) << 4); }

struct GlaStage { u32x4 kd[2]; u32x4 q[2]; bf16x8 vt[4]; float g; };
__device__ __forceinline__ void gla_prefetch_vt(Frame& F, GlaStage& st, int b, int h, int c) {
    const int u = b * 64 + c; const size_t r0 = (size_t)u * 64; const int w = F.wave, lq = F.lane & 31, hh = F.lane >> 5;
    const bf16_t* vt = WSP(bf16_t, WS_GV) + (size_t)(h * 256 + 32 * w + lq) * T_TOK + r0;
#pragma unroll
    for (int ts = 0; ts < 4; ++ts) st.vt[ts] = *(const bf16x8*)(vt + 16 * ts + 8 * hh);
}
template <bool WITH_Q>
__device__ __forceinline__ void gla_prefetch(Frame& F, GlaStage& st, int b, int h, int c) {
    const int u = b * 64 + c; const size_t r0 = (size_t)u * 64; const int tid = F.tid;
    const bf16_t* kd = WSP(bf16_t, WS_GK) + (size_t)(h * 128) * T_TOK + r0;
#pragma unroll
    for (int j = 0; j < 2; ++j) { const int pi = tid + 512 * j; st.kd[j] = *(const u32x4*)(kd + (size_t)(pi >> 3) * T_TOK + (pi & 7) * 8); }
    if (WITH_Q) { const bf16_t* gq = WSP(bf16_t, WS_GQ) + r0 * 512 + h * 128;
#pragma unroll
        for (int j = 0; j < 2; ++j) { const int pi = tid + 512 * j; st.q[j] = *(const u32x4*)(gq + (size_t)(pi >> 4) * 512 + (pi & 15) * 8); } }
    st.g = (tid < 128) ? WSP(float, WS_GLAG)[((size_t)u * 4 + h) * 128 + tid] : 1.f;
}
template <bool WITH_Q>
__device__ __forceinline__ void gla_stage_write(Frame& F, const GlaStage& st, int buf) {
    LAS unsigned char* lds = F.lds + RING_OFF; const int tid = F.tid;
#pragma unroll
    for (int j = 0; j < 2; ++j) { const int pi = tid + 512 * j; *(LAS u32x4*)(lds + GL_KD + buf * 16384 + gl_kd_off(pi >> 3, pi & 7)) = st.kd[j]; }
    if (WITH_Q) {
#pragma unroll
        for (int j = 0; j < 2; ++j) { const int pi = tid + 512 * j; *(LAS u32x4*)(lds + GL_Q + buf * 16384 + gl_q_off(pi >> 4, pi & 15)) = st.q[j]; } }
    if (tid < 128) *(LAS float*)(lds + GL_G + buf * 512 + tid * 4) = st.g;
}
__device__ __forceinline__ void gla_update(Frame& F, f32x16 (&S)[4], const bf16x8 (&vt)[4], int buf) {
    const LAS unsigned char* lds = F.lds + RING_OFF; const int lq = F.lane & 31, hh = F.lane >> 5;
    const LAS float* G = (const LAS float*)(lds + GL_G + buf * 512);
#pragma unroll
    for (int kt = 0; kt < 4; ++kt)
#pragma unroll
        for (int g4 = 0; g4 < 4; ++g4) { const f32x4 g = *(const LAS f32x4*)(G + 32 * kt + 8 * g4 + 4 * hh);
#pragma unroll
            for (int j = 0; j < 4; ++j) S[kt][4 * g4 + j] *= g[j]; }
#pragma unroll
    for (int ts = 0; ts < 4; ++ts)
#pragma unroll
        for (int kt = 0; kt < 4; ++kt) { const bf16x8 a = *(const LAS bf16x8*)(lds + GL_KD + buf * 16384 + gl_kd_off(32 * kt + lq, 2 * ts + hh));
            S[kt] = __builtin_amdgcn_mfma_f32_32x32x16_bf16(a, vt[ts], S[kt], 0, 0, 0); if (kt == 3 && (ts & 1)) __builtin_amdgcn_sched_barrier(0); }
}
constexpr size_t SEND_WAVE_FLOATS = 4 * 4 * 64 * 4;
__device__ __forceinline__ void gla_stage1(Frame& F, int unit) {
    const int bh = unit >> 3, seg = unit & 7, b = bh >> 2, h = bh & 3, w = F.wave, l = F.lane;
    f32x16 S[4];
#pragma unroll
    for (int kt = 0; kt < 4; ++kt)
#pragma unroll
        for (int r = 0; r < 16; ++r) S[kt][r] = 0.f;
    float pend = 1.f;
    GlaStage st; gla_prefetch<false>(F, st, b, h, seg * 8); gla_prefetch_vt(F, st, b, h, seg * 8);
    for (int ci = 0; ci < 8; ++ci) {
        gla_stage_write<false>(F, st, ci & 1); pend *= st.g;
        __syncthreads();
        if (ci < 7) gla_prefetch<false>(F, st, b, h, seg * 8 + ci + 1);
        gla_update(F, S, st.vt, ci & 1);
        if (ci < 7) gla_prefetch_vt(F, st, b, h, seg * 8 + ci + 1);
    }
    float* se = WSP(float, WS_SEND) + ((size_t)unit * 8 + w) * SEND_WAVE_FLOATS;
#pragma unroll
    for (int kt = 0; kt < 4; ++kt)
#pragma unroll
        for (int g4 = 0; g4 < 4; ++g4) *(f32x4*)(se + ((kt * 4 + g4) * 64 + l) * 4) = (f32x4){S[kt][4 * g4], S[kt][4 * g4 + 1], S[kt][4 * g4 + 2], S[kt][4 * g4 + 3]};
    if (F.tid < 128) WSP(float, WS_PEND)[unit * 128 + F.tid] = pend;
    __syncthreads();
}
__device__ __forceinline__ void gla_stage3(Frame& F, int unit) {
    const int bh = unit >> 3, seg = unit & 7, b = bh >> 2, h = bh & 3, w = F.wave, l = F.lane, lq = l & 31, hh = l >> 5;
    LAS unsigned char* lds = F.lds + RING_OFF;
    const bf16_t* GR = WSP(bf16_t, WS_GR); bf16_t* GLAN = WSP(bf16_t, WS_GLAN); const float* g_o = F.in[6];
    f32x16 S[4];
#pragma unroll
    for (int kt = 0; kt < 4; ++kt)
#pragma unroll
        for (int r = 0; r < 16; ++r) S[kt][r] = 0.f;
    GlaStage st; gla_prefetch<true>(F, st, b, h, seg * 8); gla_prefetch_vt(F, st, b, h, seg * 8);
    for (int sp = 0; sp < seg; ++sp) {
        const int un = bh * 8 + sp; const float* se = WSP(float, WS_SEND) + ((size_t)un * 8 + w) * SEND_WAVE_FLOATS; const float* pe = WSP(float, WS_PEND) + un * 128;
#pragma unroll
        for (int kt = 0; kt < 4; ++kt)
#pragma unroll
            for (int g4 = 0; g4 < 4; ++g4) { const f32x4 p = *(const f32x4*)(pe + 32 * kt + 8 * g4 + 4 * hh); const f32x4 s = *(const f32x4*)(se + ((kt * 4 + g4) * 64 + l) * 4);
#pragma unroll
                for (int j = 0; j < 4; ++j) S[kt][4 * g4 + j] = S[kt][4 * g4 + j] * p[j] + s[j]; }
    }
    const int tid = F.tid; u32x4 sr[4]; size_t pend_r0 = 0;
#define GLA_STORE_PASS(R0) do { const LAS float* otr = (const LAS float*)(lds + GL_OT) + (tid >> 3) * GL_OT_PITCH + 8 * (tid & 7); \
        _Pragma("unroll") for (int j = 0; j < 4; ++j) { const f32x4 a0 = *(const LAS f32x4*)(otr + 64 * j), a1 = *(const LAS f32x4*)(otr + 64 * j + 4); const u32x4 s4 = sr[j]; u32x4 wv; \
            wv.x = cvtpk(a0[0] * bf_lo(s4.x), a0[1] * bf_hi(s4.x)); wv.y = cvtpk(a0[2] * bf_lo(s4.y), a0[3] * bf_hi(s4.y)); wv.z = cvtpk(a1[0] * bf_lo(s4.z), a1[1] * bf_hi(s4.z)); wv.w = cvtpk(a1[2] * bf_lo(s4.w), a1[3] * bf_hi(s4.w)); \
            if (!F.dry) *(u32x4*)(GLAN + ((R0) + (tid >> 3)) * 1024 + h * 256 + 8 * (tid & 7) + 64 * j) = wv; } } while (0)
    for (int ci = 0; ci < 8; ++ci) {
        const int c = seg * 8 + ci; const size_t r0 = (size_t)(b * 64 + c) * 64; const int buf = ci & 1;
        gla_stage_write<true>(F, st, buf);
        __syncthreads();
        if (ci < 7) gla_prefetch<true>(F, st, b, h, c + 1);
        if (ci > 0) GLA_STORE_PASS(pend_r0);
        gla_update(F, S, st.vt, buf);
        f32x16 oT[2];
#pragma unroll
        for (int tt = 0; tt < 2; ++tt) {
#pragma unroll
            for (int r = 0; r < 16; ++r) oT[tt][r] = 0.f;
            const int t = 32 * tt + lq;
#pragma unroll
            for (int kt = 0; kt < 4; ++kt)
#pragma unroll
                for (int s = 0; s < 2; ++s) {
                    u32x4 aw; aw.x = cvtpk(S[kt][8 * s + 0], S[kt][8 * s + 1]); aw.y = cvtpk(S[kt][8 * s + 2], S[kt][8 * s + 3]); aw.z = cvtpk(S[kt][8 * s + 4], S[kt][8 * s + 5]); aw.w = cvtpk(S[kt][8 * s + 6], S[kt][8 * s + 7]);
                    const u32x2 qlo = *(const LAS u32x2*)(lds + GL_Q + buf * 16384 + gl_q_off(t, 4 * kt + 2 * s) + 8 * hh), qhi = *(const LAS u32x2*)(lds + GL_Q + buf * 16384 + gl_q_off(t, 4 * kt + 2 * s + 1) + 8 * hh);
                    const u32x4 bw = (u32x4){qlo.x, qlo.y, qhi.x, qhi.y};
                    oT[tt] = __builtin_amdgcn_mfma_f32_32x32x16_bf16(__builtin_bit_cast(bf16x8, aw), __builtin_bit_cast(bf16x8, bw), oT[tt], 0, 0, 0);
                    if (s == 1 && (kt & 1)) __builtin_amdgcn_sched_barrier(0); }
        }
        LAS float* redc = (LAS float*)(lds + GL_RED) + buf * 512;
#pragma unroll
        for (int tt = 0; tt < 2; ++tt) { float s = 0.f;
#pragma unroll
            for (int r = 0; r < 16; ++r) s += oT[tt][r] * oT[tt][r];
            s += __shfl_xor(s, 32);
            if (hh == 0) redc[w * 64 + 32 * tt + lq] = s; }
        if (ci < 7) gla_prefetch_vt(F, st, b, h, c + 1);
#pragma unroll
        for (int j = 0; j < 4; ++j) sr[j] = *(const u32x4*)(GR + (r0 + (tid >> 3)) * 1024 + h * 256 + 8 * (tid & 7) + 64 * j);
        __syncthreads();
        LAS float* ot = (LAS float*)(lds + GL_OT);
#pragma unroll
        for (int tt = 0; tt < 2; ++tt) { float tot = 0.f;
#pragma unroll
            for (int ww = 0; ww < 8; ++ww) tot += redc[ww * 64 + 32 * tt + lq];
            const float rstd = __builtin_amdgcn_rsqf(tot * (1.0f / 256.0f) + EPS);
#pragma unroll
            for (int g4 = 0; g4 < 4; ++g4) { const int vl = 32 * w + 8 * g4 + 4 * hh;
                const f32x4 go = *(const f32x4*)(g_o + h * 256 + vl);
                *(LAS f32x4*)(ot + (32 * tt + lq) * GL_OT_PITCH + vl) = (f32x4){oT[tt][4 * g4 + 0] * rstd * go[0], oT[tt][4 * g4 + 1] * rstd * go[1], oT[tt][4 * g4 + 2] * rstd * go[2], oT[tt][4 * g4 + 3] * rstd * go[3]}; } }
        pend_r0 = r0;
    }
    __syncthreads();
    GLA_STORE_PASS(pend_r0);
    __syncthreads();
#undef GLA_STORE_PASS
}

constexpr int SB_TILE = 16384, SB_FLAG = 7 * SB_TILE;
typedef short v4i16_t __attribute__((ext_vector_type(4)));
__device__ __forceinline__ s16x4 vtr(const LAS unsigned char* p) { return __builtin_bit_cast(s16x4, __builtin_amdgcn_ds_read_tr16_b64_v4i16((LAS v4i16_t*)p)); }
__device__ __forceinline__ float partner32(float x, int hh) { auto rr = __builtin_amdgcn_permlane32_swap(__float_as_uint(x), __float_as_uint(x), false, false); return __uint_as_float(hh ? rr[0] : rr[1]); }
__device__ __forceinline__ int sbk_off(int key, int chunk) { return key * 128 + ((chunk ^ ((key >> 1) & 7)) << 4); }
__device__ __forceinline__ int sbv_off(int key, int chunk) { return 8192 + key * 128 + ((chunk ^ (((key >> 1) & 1) << 2)) << 4); }

template <bool DIAG>
__device__ __forceinline__ void sb_tile_t(const LAS unsigned char* tile, int kt, int qabs, int l, const bf16x8 (&qf)[4], f32x16& o0, f32x16& o1, float& carry) {
    const int lq = l & 31, hh = l >> 5, g1 = (l >> 4) & 1, i = l & 15;
    float run = carry;
#pragma unroll
    for (int half = 1; half >= 0; --half) {
        f32x16 p;
#pragma unroll
        for (int r = 0; r < 16; ++r) p[r] = 0.f;
#pragma unroll
        for (int s = 0; s < 4; ++s) { const bf16x8 a = *(const LAS bf16x8*)(tile + sbk_off(32 * half + lq, 2 * s + hh)); p = __builtin_amdgcn_mfma_f32_32x32x16_bf16(a, qf[s], p, 0, 0, 0); }
        float st[16], be[16];
#pragma unroll
        for (int r = 0; r < 16; ++r) { const float ee = __builtin_amdgcn_exp2f(fminf(p[r], 80.0f)); float s_ = __builtin_amdgcn_rcpf(1.0f + ee); float b_ = ee * s_;
            if (DIAG) { const int key = 64 * kt + 32 * half + (r & 3) + 8 * (r >> 2) + 4 * hh; if (key >= qabs) { s_ = 1.0f; b_ = 0.f; } }
            st[r] = s_; be[r] = b_; }
        float tot[4];
#pragma unroll
        for (int g4 = 0; g4 < 4; ++g4) { float* sg = &st[4 * g4]; float* bg = &be[4 * g4];
            const float a2 = sg[3], a1 = sg[2] * a2, a0 = sg[1] * a1; tot[g4] = sg[0] * a0;
            bg[2] *= a2; bg[1] *= a1; bg[0] *= a0; }
        float E[4];
#pragma unroll
        for (int m = 3; m >= 0; --m) { const float tp = partner32(tot[m], hh); E[m] = hh ? run : run * tp; run *= tot[m] * tp; }
        u32x4 pw[2];
#pragma unroll
        for (int s = 0; s < 2; ++s) { float wv[8];
#pragma unroll
            for (int j = 0; j < 8; ++j) { const int r = 8 * s + j; wv[j] = be[r] * E[r >> 2]; }
            pw[s] = (u32x4){cvtpk(wv[0], wv[1]), cvtpk(wv[2], wv[3]), cvtpk(wv[4], wv[5]), cvtpk(wv[6], wv[7])}; }
#pragma unroll
        for (int s = 0; s < 2; ++s) { const bf16x8 pb = __builtin_bit_cast(bf16x8, pw[s]);
            const int k0 = 32 * half + 16 * s + 4 * hh + (i >> 2), k1 = k0 + 8;
#pragma unroll
            for (int dt = 0; dt < 2; ++dt) { const int ch = 4 * dt + 2 * g1 + ((i & 3) >> 1);
                const s16x4 lo = vtr(tile + sbv_off(k0, ch) + 8 * (i & 1)), hi = vtr(tile + sbv_off(k1, ch) + 8 * (i & 1));
                const bf16x8 a = (bf16x8){lo[0], lo[1], lo[2], lo[3], hi[0], hi[1], hi[2], hi[3]};
                if (dt == 0) o0 = __builtin_amdgcn_mfma_f32_32x32x16_bf16(a, pb, o0, 0, 0, 0); else o1 = __builtin_amdgcn_mfma_f32_32x32x16_bf16(a, pb, o1, 0, 0, 0); } }
        if (half == 1 && __all(run == 0.0f)) break;
    }
    carry = run;
}
__device__ __forceinline__ void sb_tile(const LAS unsigned char* tile, int kt, int q0, int qabs, int l, const bf16x8 (&qf)[4], f32x16& o0, f32x16& o1, float& carry) {
    if (64 * kt + 63 >= q0) sb_tile_t<true>(tile, kt, qabs, l, qf, o0, o1, carry); else sb_tile_t<false>(tile, kt, qabs, l, qf, o0, o1, carry);
}
__device__ __forceinline__ void sb_attn_unit(Frame& F, int uidx) {
    const int bh = uidx >> 4, qb = uidx & 15, b = bh >> 4, h = bh & 15;
    LAS unsigned char* lds = F.lds + RING_OFF;
    volatile LAS unsigned* flags = (volatile LAS unsigned*)(lds + SB_FLAG);
    const int tid = F.tid, w = F.wave, l = F.lane, lq = l & 31, hh = l >> 5;
    bf16_t* SQ = WSP(bf16_t, WS_SQ); const bf16_t* SK = WSP(bf16_t, WS_SK); const bf16_t* SV = WSP(bf16_t, WS_SV);
    const size_t rowbase = (size_t)b * SEQ;
    const int q0 = qb * 256 + 32 * w, qabs = q0 + lq;
    const int kt_hi = qb * 4 + 3, kt_lo = (qb * 4 - 3) > 0 ? (qb * 4 - 3) : 0, nwin = kt_hi - kt_lo + 1;
    const int skey = tid >> 3, sch = tid & 7;
    const bf16_t* kgd = SK + (rowbase + skey) * 1024 + h * 64 + ((sch ^ ((skey >> 1) & 7)) * 8);
    const bf16_t* vgd = SV + (rowbase + skey) * 1024 + h * 64 + ((sch ^ (((skey >> 1) & 1) << 2)) * 8);
    __syncthreads();
#pragma unroll
    for (int j = 0; j < 7; ++j) if (j < nwin) {
        __builtin_amdgcn_global_load_lds((const unsigned*)(kgd + (size_t)(kt_lo + j) * 64 * 1024), (LAS unsigned*)(lds + j * SB_TILE + w * 1024), 16, 0, 0);
        __builtin_amdgcn_global_load_lds((const unsigned*)(vgd + (size_t)(kt_lo + j) * 64 * 1024), (LAS unsigned*)(lds + j * SB_TILE + 8192 + w * 1024), 16, 0, 0); }
    bf16x8 qf[4];
    { const bf16_t* qrow = SQ + (rowbase + qabs) * 1024 + h * 64;
#pragma unroll
      for (int s = 0; s < 4; ++s) qf[s] = *(const bf16x8*)(qrow + 16 * s + 8 * hh); }
    f32x16 o0, o1;
#pragma unroll
    for (int r = 0; r < 16; ++r) { o0[r] = 0.f; o1[r] = 0.f; }
    float carry = 1.0f;
    VM_WAIT(); __syncthreads();
    bool done = false;
    for (int kt = (q0 + 30) >> 6; kt >= kt_lo; --kt) {
        sb_tile(lds + (kt - kt_lo) * SB_TILE, kt, q0, qabs, l, qf, o0, o1, carry);
        if (__all(carry == 0.0f)) { done = true; break; }
    }
    if (kt_lo == 0) done = true;
    if (l == 0) flags[w] = done ? 1u : 0u;
    __syncthreads();
    bool alld = true;
#pragma unroll
    for (int i = 0; i < 8; ++i) alld = alld && (flags[i] != 0u);
    if (!alld) {
        const bf16_t* kg = SK + (rowbase + skey) * 1024 + h * 64 + sch * 8;
        const bf16_t* vg = SV + (rowbase + skey) * 1024 + h * 64 + sch * 8;
        for (int kt = kt_lo - 1; kt >= 0; --kt) {
            const u32x4 kr = *(const u32x4*)(kg + (size_t)kt * 64 * 1024), vr = *(const u32x4*)(vg + (size_t)kt * 64 * 1024);
            __syncthreads();
            { unsigned a = 1u;
#pragma unroll
              for (int i = 0; i < 8; ++i) a &= flags[i];
              if (a) break; }
            *(LAS u32x4*)(lds + sbk_off(skey, sch)) = kr; *(LAS u32x4*)(lds + sbv_off(skey, sch)) = vr;
            __syncthreads();
            if (!done) { sb_tile(lds, kt, q0, qabs, l, qf, o0, o1, carry); if (__all(carry == 0.0f) || kt == 0) done = true; }
            if (l == 0) flags[w] = done ? 1u : 0u;
        }
    }
    if (!F.dry) { bf16_t* orow = SQ + (rowbase + qabs) * 1024 + h * 64;
#pragma unroll
      for (int g4 = 0; g4 < 4; ++g4) { u32x2 a, c2; a.x = cvtpk(o0[4 * g4], o0[4 * g4 + 1]); a.y = cvtpk(o0[4 * g4 + 2], o0[4 * g4 + 3]); c2.x = cvtpk(o1[4 * g4], o1[4 * g4 + 1]); c2.y = cvtpk(o1[4 * g4 + 2], o1[4 * g4 + 3]);
          *(u32x2*)(orow + 8 * g4 + 4 * hh) = a; *(u32x2*)(orow + 32 + 8 * g4 + 4 * hh) = c2; } }
}
#define CVT8_PK(V, S, W) do { int _x = __builtin_amdgcn_cvt_pk_fp8_f32((V)[0] * (S), (V)[1] * (S), 0, false); _x = __builtin_amdgcn_cvt_pk_fp8_f32((V)[2] * (S), (V)[3] * (S), _x, true); (W) = (unsigned)_x; } while (0)
__device__ __forceinline__ float absmax4(const f32x4& a) { return fmaxf(fmaxf(fabsf(a[0]), fabsf(a[1])), fmaxf(fabsf(a[2]), fabsf(a[3]))); }
constexpr int CVT8_UNITS = 256;
#ifndef QCONV
#define QCONV 1
#endif
__device__ __forceinline__ void cvt_fp8_unit(Frame& F, int cu) {
    const int l = F.lane, r0 = cu * 128 + F.wave * 16;
    const bool isv = r0 >= 16384; const int e0 = r0 & 16383;
    const float* src = isv ? F.in[15] : F.in[14]; unsigned char* dst = WSP(unsigned char, isv ? WS_VB8 : WS_UB8); float* rscale = WSP(float, isv ? WS_RSV : WS_RSU);
#pragma unroll 1
    for (int it = 0; it < 4; ++it) {
        f32x4 v[4][4]; float m[4];
#pragma unroll
        for (int q = 0; q < 4; ++q) { const f32x4* sp = (const f32x4*)(src + (size_t)(e0 + 4 * it + q) * 1024) + l;
#pragma unroll
            for (int j = 0; j < 4; ++j) v[q][j] = sp[64 * j]; }
#pragma unroll
        for (int q = 0; q < 4; ++q) m[q] = fmaxf(fmaxf(absmax4(v[q][0]), absmax4(v[q][1])), fmaxf(absmax4(v[q][2]), absmax4(v[q][3])));
#pragma unroll
        for (int o = 1; o < 64; o <<= 1) {
#pragma unroll
            for (int q = 0; q < 4; ++q) m[q] = fmaxf(m[q], __shfl_xor(m[q], o)); }
#pragma unroll
        for (int q = 0; q < 4; ++q) { const int e = e0 + 4 * it + q;
            const float t = 448.0f / fmaxf(m[q], 1e-30f); const float s = __uint_as_float(__float_as_uint(t) & 0x7f800000u);
            unsigned w[4]; CVT8_PK(v[q][0], s, w[0]); CVT8_PK(v[q][1], s, w[1]); CVT8_PK(v[q][2], s, w[2]); CVT8_PK(v[q][3], s, w[3]);
            if (!F.dry) { unsigned* dp = (unsigned*)(dst + (size_t)e * 1024) + l;
#pragma unroll
                for (int j = 0; j < 4; ++j) dp[64 * j] = w[j];
                if (l == 0) rscale[e] = 1.0f / s; } }
    }
}
__device__ __forceinline__ void sb_units_dyn(Frame& F, unsigned* ctr, int sb_lo, int nsb, int conv_lo) {
    volatile LAS int* slot = (volatile LAS int*)(F.lds + MISC_OFF + 64);
    const int total = QCONV ? nsb + (nsb >> 2) : nsb;
    __syncthreads();
    if (F.tid == 0) *slot = (int)__hip_atomic_fetch_add(ctr, 1u, __ATOMIC_RELAXED, __HIP_MEMORY_SCOPE_AGENT);
    __syncthreads();
    int i = *slot;
    while (i < total) {
        int nxt = 0;
        if (F.tid == 0) nxt = (int)__hip_atomic_fetch_add(ctr, 1u, __ATOMIC_RELAXED, __HIP_MEMORY_SCOPE_AGENT);
        if (QCONV) { const int g = i / 5, r = i - 5 * g; if (r < 4) sb_attn_unit(F, sb_lo + 4 * g + r); else cvt_fp8_unit(F, conv_lo + g); }
        else sb_attn_unit(F, sb_lo + i);
        __syncthreads();
        if (F.tid == 0) *slot = nxt;
        __syncthreads();
        i = *slot;
    }
}
__device__ __forceinline__ void phase_attn_a(Frame& F) {
#ifdef CONV_PROBE_NWG
    if (F.dry) {
        if (F.vcu < CONV_PROBE_NWG) { volatile LAS int* slot = (volatile LAS int*)(F.lds + MISC_OFF + 64); unsigned* ctr = (unsigned*)(F.ws + WS_CTL) + 64 + 16;
            for (;;) { __syncthreads(); if (F.tid == 0) *slot = (int)__hip_atomic_fetch_add(ctr, 1u, __ATOMIC_RELAXED, __HIP_MEMORY_SCOPE_AGENT); __syncthreads(); const int i = *slot; if (i >= CVT8_UNITS) break; cvt_fp8_unit(F, i); } }
        return; }
#endif
    if (F.vcu < 128) gla_stage1(F, F.vcu);
    sb_units_dyn(F, (unsigned*)(F.ws + WS_CTL) + 64 + 16 * F.dry, 0, 384, 0);
    __syncthreads();
}
__device__ __forceinline__ void phase_attn_b(Frame& F) {
    if (F.vcu < 128) gla_stage3(F, F.vcu);
    sb_units_dyn(F, (unsigned*)(F.ws + WS_CTL) + 128 + 16 * F.dry, 384, 640, 96);
    __syncthreads();
}
__device__ __forceinline__ int okey(float v, int tag, int mask) { int u = __float_as_int(v); u ^= (u >> 31) & 0x7fffffff; return (u & ~mask) | tag; }
__device__ __forceinline__ float okey_val(int key, int mask) { int u = key & ~mask; u ^= (u >> 31) & 0x7fffffff; return __int_as_float(u); }
#define INS16(Lst, xin) do { int _x = (xin); _Pragma("unroll") for (int _j = 0; _j < 16; ++_j) { const int _h = max(Lst[_j], _x); _x = min(Lst[_j], _x); Lst[_j] = _h; } } while (0)

#define CEX(a, b) do { const int _hi = max(a, b), _lo = min(a, b); a = _hi; b = _lo; } while (0)
#define BITONIC16(K) do { \
    _Pragma("unroll") for (int _i = 0; _i < 8; ++_i) CEX(K[_i], K[_i + 8]); \
    _Pragma("unroll") for (int _b = 0; _b < 16; _b += 8) _Pragma("unroll") for (int _i = 0; _i < 4; ++_i) CEX(K[_b + _i], K[_b + _i + 4]); \
    _Pragma("unroll") for (int _b = 0; _b < 16; _b += 4) _Pragma("unroll") for (int _i = 0; _i < 2; ++_i) CEX(K[_b + _i], K[_b + _i + 2]); \
    _Pragma("unroll") for (int _b = 0; _b < 16; _b += 2) CEX(K[_b], K[_b + 1]); } while (0)
#define CEXD(a, b, d) do { const int _hi = max(a, b), _lo = min(a, b); a = (d) ? _hi : _lo; b = (d) ? _lo : _hi; } while (0)
#define FULLSORT16(K) do { \
    _Pragma("unroll") for (int _k = 2; _k <= 16; _k <<= 1) _Pragma("unroll") for (int _j = _k >> 1; _j >= 1; _j >>= 1) _Pragma("unroll") for (int _i = 0; _i < 16; ++_i) { \
        const int _p = _i ^ _j; if (_p > _i) { const bool _desc = ((_i & _k) == 0); CEXD(K[_i], K[_p], _desc); } } } while (0)
__device__ __forceinline__ int swap32i(int x) { auto r = __builtin_amdgcn_permlane32_swap((unsigned)x, (unsigned)x, false, false); return (int)((__builtin_amdgcn_mbcnt_hi(~0u, __builtin_amdgcn_mbcnt_lo(~0u, 0u)) & 32) ? r[0] : r[1]); }

__device__ __forceinline__ void phase_peer_retrieve(Frame& F) {
    const bf16_t* Q = WSP(bf16_t, WS_Q); const bf16_t* KB = WSP(bf16_t, WS_KD); unsigned* EXPO = WSP(unsigned, WS_EXP);
    LAS unsigned char* idxb = F.lds + RING_OFF + F.wave * 2048;
    const int l = F.lane, lq = l & 31, hh = l >> 5;
    const int ntok_wg = T_TOK / F.G;
#pragma unroll 1
    for (int it = F.wave; it < (ntok_wg / 32) * 8; it += NWAVES) {
        const int tg = it >> 3, h = it & 7;
        const int t = F.vcu * ntok_wg + tg * 32 + lq;
        int XY[2][16];
#pragma unroll
        for (int half = 0; half < 2; ++half) {
            bf16x8 qf[8];
            { const bf16_t* qp = Q + (size_t)t * 2048 + h * 256 + half * 128 + 8 * hh;
#pragma unroll
              for (int s = 0; s < 8; ++s) qf[s] = *(const bf16x8*)(qp + 16 * s); }
            int L[16];
#pragma unroll
            for (int j = 0; j < 16; ++j) L[j] = INT_MIN;
            const bf16_t* kp = KB + (size_t)(h * 2 + half) * 16384 + (size_t)lq * 128 + 8 * hh;
#pragma unroll 1
            for (int tile = 0; tile < 4; ++tile) {
                f32x16 acc; int Tk[16];
#pragma unroll
                for (int r = 0; r < 16; ++r) acc[r] = 0.f;
#pragma unroll
                for (int s = 0; s < 8; ++s) { const bf16x8 a = *(const bf16x8*)(kp + (size_t)tile * 32 * 128 + 16 * s); acc = __builtin_amdgcn_mfma_f32_32x32x16_bf16(a, qf[s], acc, 0, 0, 0); }
#pragma unroll
                for (int r = 0; r < 16; ++r) { const int key = 32 * tile + (r & 3) + 8 * (r >> 2) + 4 * hh; Tk[r] = okey(acc[r], 127 - key, 127); }
                FULLSORT16(Tk);
#pragma unroll
                for (int k = 0; k < 16; ++k) L[k] = max(L[k], Tk[15 - k]);
                BITONIC16(L);
            }
#pragma unroll
            for (int k = 0; k < 8; ++k) { const int a = swap32i(L[15 - k]), b = swap32i(L[k]); L[k] = max(L[k], a); L[15 - k] = max(L[15 - k], b); }
            BITONIC16(L);
#pragma unroll
            for (int j = 0; j < 16; ++j) XY[half][j] = L[j];
        }
        { u32x4 pk[2];
#pragma unroll
          for (int half = 0; half < 2; ++half) { const int* L = XY[half];
            pk[half].x = (unsigned)(127 - (L[0] & 127)) | ((unsigned)(127 - (L[1] & 127)) << 8) | ((unsigned)(127 - (L[2] & 127)) << 16) | ((unsigned)(127 - (L[3] & 127)) << 24);
            pk[half].y = (unsigned)(127 - (L[4] & 127)) | ((unsigned)(127 - (L[5] & 127)) << 8) | ((unsigned)(127 - (L[6] & 127)) << 16) | ((unsigned)(127 - (L[7] & 127)) << 24);
            pk[half].z = (unsigned)(127 - (L[8] & 127)) | ((unsigned)(127 - (L[9] & 127)) << 8) | ((unsigned)(127 - (L[10] & 127)) << 16) | ((unsigned)(127 - (L[11] & 127)) << 24);
            pk[half].w = (unsigned)(127 - (L[12] & 127)) | ((unsigned)(127 - (L[13] & 127)) << 8) | ((unsigned)(127 - (L[14] & 127)) << 16) | ((unsigned)(127 - (L[15] & 127)) << 24); }
          *(LAS u32x4*)(idxb + l * 32) = pk[0]; *(LAS u32x4*)(idxb + l * 32 + 16) = pk[1]; }
        float X[16], Y[16];
#pragma unroll
        for (int j = 0; j < 16; ++j) { X[j] = okey_val(XY[0][j], 127); Y[j] = okey_val(XY[1][j], 127); }
        int M[16];
#pragma unroll
        for (int j = 0; j < 16; ++j) M[j] = INT_MIN;
#define CAND(i, j) do { const float sm = hh ? (X[j] + Y[i]) : (X[i] + Y[j]); const int pos = hh ? ((j) * 16 + (i)) : ((i) * 16 + (j)); int key = okey(sm, 255 - pos, 255); if ((i) == (j) && hh) key = INT_MIN; INS16(M, key); } while (0)
        CAND(0, 0); CAND(0, 1); CAND(0, 2); CAND(0, 3); CAND(0, 4); CAND(0, 5); CAND(0, 6); CAND(0, 7); CAND(0, 8); CAND(0, 9); CAND(0, 10); CAND(0, 11); CAND(0, 12); CAND(0, 13); CAND(0, 14); CAND(0, 15);
        CAND(1, 1); CAND(1, 2); CAND(1, 3); CAND(1, 4); CAND(1, 5); CAND(1, 6); CAND(1, 7);
        CAND(2, 2); CAND(2, 3); CAND(2, 4);
        CAND(3, 3);
#undef CAND
        int TK[16];
#pragma unroll
        for (int k = 0; k < 16; ++k) TK[k] = max(M[k], swap32i(M[15 - k]));
        float sv[16]; float mx = -INFINITY;
#pragma unroll
        for (int k = 0; k < 16; ++k) { sv[k] = okey_val(TK[k], 255); mx = fmaxf(mx, sv[k]); }
        float den = 0.f;
#pragma unroll
        for (int k = 0; k < 16; ++k) { sv[k] = __expf(sv[k] - mx); den += sv[k]; }
        const float rden = 1.0f / den;
        LDS_WAIT(); asm volatile("" ::: "memory");
        const LAS unsigned char* ib = idxb + l * 32;
        unsigned* dst = EXPO + (size_t)t * 128 + h * 16 + hh * 8;
        u32x4 o0, o1; unsigned ov[8];
#pragma unroll
        for (int k = 0; k < 8; ++k) { const int pos = 255 - (TK[k] & 255); const unsigned i1 = ib[pos >> 4], i2 = ib[16 + (pos & 15)];
            ov[k] = (__float_as_uint(sv[k] * rden) & ~0x3fffu) | (i1 * 128u + i2); }
        o0 = (u32x4){ov[0], ov[1], ov[2], ov[3]}; o1 = (u32x4){ov[4], ov[5], ov[6], ov[7]};
        *(u32x4*)dst = o0; *(u32x4*)(dst + 4) = o1;
        LDS_WAIT(); asm volatile("" ::: "memory");
    }
}

__device__ __forceinline__ void cvt_rows_fp8(Frame& F, const float* src, unsigned char* dst, float* rscale) {
    const int l = F.lane; const int gw = F.vcu * NWAVES + F.wave, NGW = F.G * NWAVES;
    for (int e = gw; e < 16384; e += NGW) {
        const f32x4* sp = (const f32x4*)(src + (size_t)e * 1024 + 16 * l);
        const f32x4 a = sp[0], b = sp[1], c = sp[2], d = sp[3];
        float m = fmaxf(fmaxf(fmaxf(fabsf(a[0]), fabsf(a[1])), fmaxf(fabsf(a[2]), fabsf(a[3]))), fmaxf(fmaxf(fabsf(b[0]), fabsf(b[1])), fmaxf(fabsf(b[2]), fabsf(b[3]))));
        m = fmaxf(m, fmaxf(fmaxf(fmaxf(fabsf(c[0]), fabsf(c[1])), fmaxf(fabsf(c[2]), fabsf(c[3]))), fmaxf(fmaxf(fabsf(d[0]), fabsf(d[1])), fmaxf(fabsf(d[2]), fabsf(d[3])))));
#pragma unroll
        for (int o = 1; o < 64; o <<= 1) m = fmaxf(m, __shfl_xor(m, o));
        const float t = 448.0f / fmaxf(m, 1e-30f); const float s = __uint_as_float(__float_as_uint(t) & 0x7f800000u);
        u32x4 w; int x;
        x = __builtin_amdgcn_cvt_pk_fp8_f32(a[0] * s, a[1] * s, 0, false); x = __builtin_amdgcn_cvt_pk_fp8_f32(a[2] * s, a[3] * s, x, true); w.x = (unsigned)x;
        x = __builtin_amdgcn_cvt_pk_fp8_f32(b[0] * s, b[1] * s, 0, false); x = __builtin_amdgcn_cvt_pk_fp8_f32(b[2] * s, b[3] * s, x, true); w.y = (unsigned)x;
        x = __builtin_amdgcn_cvt_pk_fp8_f32(c[0] * s, c[1] * s, 0, false); x = __builtin_amdgcn_cvt_pk_fp8_f32(c[2] * s, c[3] * s, x, true); w.z = (unsigned)x;
        x = __builtin_amdgcn_cvt_pk_fp8_f32(d[0] * s, d[1] * s, 0, false); x = __builtin_amdgcn_cvt_pk_fp8_f32(d[2] * s, d[3] * s, x, true); w.w = (unsigned)x;
        *(u32x4*)(dst + (size_t)e * 1024 + 16 * l) = w;
        if (l == 0) rscale[e] = 1.0f / s;
    }
}

__device__ __forceinline__ float gelu_tanh(float x) { const float y = 0.7978845608028654f * (x + 0.044715f * x * x * x); return x * __builtin_amdgcn_rcpf(1.0f + __expf(-2.0f * y)); }
#define FP8_UNPACK16(W, f) do { f32x2 _t; \
    _t = __builtin_amdgcn_cvt_pk_f32_fp8((int)(W).x, false); f[0] = _t[0]; f[1] = _t[1]; _t = __builtin_amdgcn_cvt_pk_f32_fp8((int)(W).x, true); f[2] = _t[0]; f[3] = _t[1]; \
    _t = __builtin_amdgcn_cvt_pk_f32_fp8((int)(W).y, false); f[4] = _t[0]; f[5] = _t[1]; _t = __builtin_amdgcn_cvt_pk_f32_fp8((int)(W).y, true); f[6] = _t[0]; f[7] = _t[1]; \
    _t = __builtin_amdgcn_cvt_pk_f32_fp8((int)(W).z, false); f[8] = _t[0]; f[9] = _t[1]; _t = __builtin_amdgcn_cvt_pk_f32_fp8((int)(W).z, true); f[10] = _t[0]; f[11] = _t[1]; \
    _t = __builtin_amdgcn_cvt_pk_f32_fp8((int)(W).w, false); f[12] = _t[0]; f[13] = _t[1]; _t = __builtin_amdgcn_cvt_pk_f32_fp8((int)(W).w, true); f[14] = _t[0]; f[15] = _t[1]; } while (0)
__device__ __forceinline__ float sum_swap32(float a, float b) { auto r = __builtin_amdgcn_permlane32_swap(__float_as_uint(a), __float_as_uint(b), false, false); return __uint_as_float(r[0]) + __uint_as_float(r[1]); }
__device__ __forceinline__ float sum_swap16(float a, float b) { auto r = __builtin_amdgcn_permlane16_swap(__float_as_uint(a), __float_as_uint(b), false, false); return __uint_as_float(r[0]) + __uint_as_float(r[1]); }
template <int M> __device__ __forceinline__ unsigned sxu(unsigned v, int lane) {
    if constexpr (M == 32) { auto r = __builtin_amdgcn_permlane32_swap(v, v, false, false); return (lane & 32) ? r[0] : r[1]; }
    else return (unsigned)__builtin_amdgcn_ds_swizzle((int)v, (M << 10) | 0x1f);
}
template <int M> __device__ __forceinline__ float sxf(float v, int lane) { return __uint_as_float(sxu<M>(__float_as_uint(v), lane)); }
__device__ __forceinline__ float wave_sum_sx(float v, int lane) { v += sxf<1>(v, lane); v += sxf<2>(v, lane); v += sxf<4>(v, lane); v += sxf<8>(v, lane); v += sxf<16>(v, lane); v += sxf<32>(v, lane); return v; }
#ifndef PG_TOK
#define PG_TOK 4
#endif
template <class Bar>
__device__ __forceinline__ void phase_peer_gather(Frame& F, const Bar& bar, bool use_bar) {
    const unsigned char* UB = WSP(unsigned char, WS_UB8); const unsigned char* VB = WSP(unsigned char, WS_VB8); const float* RSU = WSP(float, WS_RSU); const float* RSV = WSP(float, WS_RSV);
    const unsigned* EXPO = WSP(unsigned, WS_EXP);
    const bf16_t* H1B = WSP(bf16_t, WS_H1); bf16_t* H2B = WSP(bf16_t, WS_H2B); const float* SSQ1 = WSP(float, WS_SSQ1); float* RS3 = WSP(float, WS_RS3); const float* g_ffn = F.in[10];
    const int l = F.lane; const int ntok_wg = T_TOK / F.G;
#pragma unroll 1
    for (int ti = F.wave * PG_TOK; ti < ntok_wg; ti += NWAVES * PG_TOK) {
        if (use_bar && ti >= NWAVES * PG_TOK) xcd_barrier(bar, F.tid); else __syncthreads();
        f32x2 acc[PG_TOK][8];
        LAS unsigned* lent = (LAS unsigned*)(F.lds + RING_OFF + F.wave * (2048 * PG_TOK)); LAS float* lcu = (LAS float*)(lent + 128 * PG_TOK); LAS float* lcv = lcu + 128 * PG_TOK; LAS float* acl = lcv + 128 * PG_TOK;
        LAS f32x4* lx = (LAS f32x4*)(F.lds + RING_OFF + NWAVES * 2048 * PG_TOK + F.wave * (4096 * PG_TOK));
#pragma unroll
        for (int tk = 0; tk < PG_TOK; ++tk) { const int t = F.vcu * ntok_wg + ti + tk;
            const u32x4 xa = *(const u32x4*)(H1B + (size_t)t * 1024 + 16 * l), xb = *(const u32x4*)(H1B + (size_t)t * 1024 + 16 * l + 8);
            const f32x4* gp = (const f32x4*)(g_ffn + 16 * l);
            lx[tk * 256 + l] = (f32x4){bf_lo(xa.x), bf_hi(xa.x), bf_lo(xa.y), bf_hi(xa.y)} * gp[0]; lx[tk * 256 + 64 + l] = (f32x4){bf_lo(xa.z), bf_hi(xa.z), bf_lo(xa.w), bf_hi(xa.w)} * gp[1];
            lx[tk * 256 + 128 + l] = (f32x4){bf_lo(xb.x), bf_hi(xb.x), bf_lo(xb.y), bf_hi(xb.y)} * gp[2]; lx[tk * 256 + 192 + l] = (f32x4){bf_lo(xb.z), bf_hi(xb.z), bf_lo(xb.w), bf_hi(xb.w)} * gp[3];
#pragma unroll
            for (int i = 0; i < 8; ++i) acc[tk][i] = (f32x2){0.f, 0.f}; }
#pragma unroll 1
        for (int tk = 0; tk < PG_TOK; ++tk) { const int t = F.vcu * ntok_wg + ti + tk;
            const f32x4* sp = (const f32x4*)(SSQ1 + (size_t)t * 16); const f32x4 st = (sp[0] + sp[1]) + (sp[2] + sp[3]); const float rstd1 = __builtin_amdgcn_rsqf(((st[0] + st[1]) + (st[2] + st[3])) * (1.0f / 1024.0f) + EPS);
            unsigned a0 = EXPO[(size_t)t * 128 + l], a1 = EXPO[(size_t)t * 128 + 64 + l];
            { unsigned s0 = (a0 << 18) | (a0 >> 14), s1 = (a1 << 18) | (a1 >> 14);
              int ls = l; asm volatile("" : "+v"(ls));
#define BSTEP(K, J) do { const bool up = (ls & (J)) != 0; const unsigned p0 = sxu<J>(s0, ls), p1 = sxu<J>(s1, ls); \
                  const bool asc0 = (ls & (K)) == 0, asc1 = ((ls + 64) & (K)) == 0; \
                  s0 = (up == asc0) ? max(s0, p0) : min(s0, p0); s1 = (up == asc1) ? max(s1, p1) : min(s1, p1); } while (0)
              BSTEP(2, 1);
              BSTEP(4, 2); BSTEP(4, 1);
              BSTEP(8, 4); BSTEP(8, 2); BSTEP(8, 1);
              BSTEP(16, 8); BSTEP(16, 4); BSTEP(16, 2); BSTEP(16, 1);
              BSTEP(32, 16); BSTEP(32, 8); BSTEP(32, 4); BSTEP(32, 2); BSTEP(32, 1);
              BSTEP(64, 32); BSTEP(64, 16); BSTEP(64, 8); BSTEP(64, 4); BSTEP(64, 2); BSTEP(64, 1);
              { const unsigned lo = min(s0, s1), hi = max(s0, s1); s0 = lo; s1 = hi; }
              BSTEP(128, 32); BSTEP(128, 16); BSTEP(128, 8); BSTEP(128, 4); BSTEP(128, 2); BSTEP(128, 1);
#undef BSTEP
              a0 = (s0 >> 18) | (s0 << 14); a1 = (s1 >> 18) | (s1 << 14); }
            lent[tk * 128 + l] = a0; lent[tk * 128 + 64 + l] = a1;
            lcu[tk * 128 + l] = RSU[a0 & 0x3fffu] * rstd1; lcu[tk * 128 + 64 + l] = RSU[a1 & 0x3fffu] * rstd1;
            lcv[tk * 128 + l] = RSV[a0 & 0x3fffu] * __uint_as_float(a0 & ~0x3fffu); lcv[tk * 128 + 64 + l] = RSV[a1 & 0x3fffu] * __uint_as_float(a1 & ~0x3fffu); }
        LDS_WAIT(); asm volatile("" ::: "memory");
        u32x4 buf0[8], buf1[8];
#define ROWS8(BUF, TAB, tk, eb) do { const u32x4 ea_ = *(const LAS u32x4*)(lent + (tk) * 128 + (eb)), eb_ = *(const LAS u32x4*)(lent + (tk) * 128 + (eb) + 4); \
            const unsigned en_[8] = {ea_.x, ea_.y, ea_.z, ea_.w, eb_.x, eb_.y, eb_.z, eb_.w}; \
            _Pragma("unroll") for (int k = 0; k < 8; ++k) BUF[k] = *(const u32x4*)((TAB) + ((en_[k] & 0x3fffu) * 1024u + 16u * (unsigned)l)); } while (0)
#define U8(BUF, tk, eb) do { float p[8]; f32x2 x2[8]; \
            _Pragma("unroll") for (int i = 0; i < 4; ++i) { const f32x4 t_ = lx[(tk) * 256 + 64 * i + l]; x2[2 * i] = (f32x2){t_[0], t_[1]}; x2[2 * i + 1] = (f32x2){t_[2], t_[3]}; } \
            _Pragma("unroll") for (int k = 0; k < 8; ++k) { const unsigned wq[4] = {BUF[k].x, BUF[k].y, BUF[k].z, BUF[k].w}; f32x2 s2 = (f32x2){0.f, 0.f}; \
                _Pragma("unroll") for (int i = 0; i < 4; ++i) { s2 = __builtin_elementwise_fma(__builtin_amdgcn_cvt_pk_f32_fp8((int)wq[i], false), x2[2 * i], s2); \
                                                                s2 = __builtin_elementwise_fma(__builtin_amdgcn_cvt_pk_f32_fp8((int)wq[i], true), x2[2 * i + 1], s2); } \
                p[k] = s2[0] + s2[1]; if (k & 1) __builtin_amdgcn_sched_barrier(0); } \
            float q4[4], q2[2], q1; \
            _Pragma("unroll") for (int j = 0; j < 4; ++j) q4[j] = sum_swap32(p[j], p[4 + j]); \
            _Pragma("unroll") for (int j = 0; j < 2; ++j) q2[j] = sum_swap16(q4[j], q4[2 + j]); \
            { const bool up = (l & 8) != 0; const float keep = up ? q2[1] : q2[0], send = up ? q2[0] : q2[1]; q1 = keep + sxf<8>(send, l); } \
            q1 += sxf<4>(q1, l); q1 += sxf<2>(q1, l); q1 += sxf<1>(q1, l); \
            const float cu = lcu[(tk) * 128 + (eb) + (l >> 3)], cv = lcv[(tk) * 128 + (eb) + (l >> 3)]; \
            const float a_ = gelu_tanh(q1 * cu) * cv; if ((l & 7) == 0) acl[(tk) * 128 + (eb) + (l >> 3)] = a_; __builtin_amdgcn_sched_barrier(0); } while (0)
#define V8(BUF, tk, eb) do { const float av = acl[(tk) * 128 + (eb) + (l & 7)]; \
            _Pragma("unroll") for (int k = 0; k < 8; ++k) { const float ak = __uint_as_float(__builtin_amdgcn_readlane(__float_as_uint(av), k)); const f32x2 ak2 = (f32x2){ak, ak}; \
                const unsigned wq[4] = {BUF[k].x, BUF[k].y, BUF[k].z, BUF[k].w}; \
                _Pragma("unroll") for (int i = 0; i < 4; ++i) { acc[tk][2 * i] = __builtin_elementwise_fma(__builtin_amdgcn_cvt_pk_f32_fp8((int)wq[i], false), ak2, acc[tk][2 * i]); \
                                                                acc[tk][2 * i + 1] = __builtin_elementwise_fma(__builtin_amdgcn_cvt_pk_f32_fp8((int)wq[i], true), ak2, acc[tk][2 * i + 1]); } \
                if (k & 1) __builtin_amdgcn_sched_barrier(0); } } while (0)
        ROWS8(buf0, UB, 0, 0);
#if PG_TOK == 4
#define TURNS4(CONS, TAB, eb, NEXT) do { ROWS8(buf1, TAB, 1, eb); CONS(buf0, 0, eb); ROWS8(buf0, TAB, 2, eb); CONS(buf1, 1, eb); ROWS8(buf1, TAB, 3, eb); CONS(buf0, 2, eb); NEXT; CONS(buf1, 3, eb); } while (0)
#pragma unroll 1
        for (int eb = 0; eb < 120; eb += 8) TURNS4(U8, UB, eb, ROWS8(buf0, UB, 0, eb + 8));
        TURNS4(U8, UB, 120, ROWS8(buf0, VB, 0, 0));
        LDS_WAIT(); asm volatile("" ::: "memory");
#pragma unroll 1
        for (int eb = 0; eb < 120; eb += 8) TURNS4(V8, VB, eb, ROWS8(buf0, VB, 0, eb + 8));
        TURNS4(V8, VB, 120, (void)0);
#undef TURNS4
#elif PG_TOK == 2
#define TURNS2(CONS, TAB, eb, NEXT) do { ROWS8(buf1, TAB, 1, eb); CONS(buf0, 0, eb); NEXT; CONS(buf1, 1, eb); } while (0)
#pragma unroll 1
        for (int eb = 0; eb < 120; eb += 8) TURNS2(U8, UB, eb, ROWS8(buf0, UB, 0, eb + 8));
        TURNS2(U8, UB, 120, ROWS8(buf0, VB, 0, 0));
        LDS_WAIT(); asm volatile("" ::: "memory");
#pragma unroll 1
        for (int eb = 0; eb < 120; eb += 8) TURNS2(V8, VB, eb, ROWS8(buf0, VB, 0, eb + 8));
        TURNS2(V8, VB, 120, (void)0);
#undef TURNS2
#else
#error PG_TOK must be 2 or 4
#endif
#undef ROWS8
#undef U8
#undef V8
#pragma unroll
        for (int tk = 0; tk < PG_TOK; ++tk) { const int t = F.vcu * ntok_wg + ti + tk;
            float ss = 0.f; f32x4 h[4];
#pragma unroll
            for (int q2 = 0; q2 < 2; ++q2) { const u32x4 ha = *(const u32x4*)(H1B + (size_t)t * 1024 + 16 * l + 8 * q2);
                h[2 * q2] = (f32x4){bf_lo(ha.x), bf_hi(ha.x), bf_lo(ha.y), bf_hi(ha.y)}; h[2 * q2 + 1] = (f32x4){bf_lo(ha.z), bf_hi(ha.z), bf_lo(ha.w), bf_hi(ha.w)};
#pragma unroll
                for (int j = 0; j < 4; ++j) { h[2 * q2][j] += acc[tk][4 * q2 + (j >> 1)][j & 1]; h[2 * q2 + 1][j] += acc[tk][4 * q2 + 2 + (j >> 1)][j & 1]; ss += h[2 * q2][j] * h[2 * q2][j] + h[2 * q2 + 1][j] * h[2 * q2 + 1][j]; }
                u32x4 w0; w0.x = cvtpk(h[2 * q2][0], h[2 * q2][1]); w0.y = cvtpk(h[2 * q2][2], h[2 * q2][3]); w0.z = cvtpk(h[2 * q2 + 1][0], h[2 * q2 + 1][1]); w0.w = cvtpk(h[2 * q2 + 1][2], h[2 * q2 + 1][3]);
                if (!F.dry) *(u32x4*)(H2B + (size_t)t * 1024 + 16 * l + 8 * q2) = w0; }
            const float rstd3 = __builtin_amdgcn_rsqf(wave_sum_sx(ss, l) * (1.0f / 1024.0f) + EPS);
            if (!F.dry && l == 0) RS3[t] = rstd3;
            __builtin_amdgcn_sched_barrier(0); }
    }
}

__device__ __forceinline__ void phase_final(Frame& F) {
    const float* SSQ3 = WSP(float, WS_SSQ3); const float* g = F.in[19]; const bf16_t* H3B = WSP(bf16_t, WS_H3B);
    const int l = F.lane; const int gw = F.vcu * NWAVES + F.wave, NGW = F.G * NWAVES;
    for (int t = gw; t < T_TOK; t += NGW) {
        const f32x4* sp = (const f32x4*)(SSQ3 + (size_t)t * 16); const f32x4 st = (sp[0] + sp[1]) + (sp[2] + sp[3]);
        const float rstd = __builtin_amdgcn_rsqf(((st[0] + st[1]) + (st[2] + st[3])) * (1.0f / 1024.0f) + EPS);
        f32x4* row = (f32x4*)(F.out + (size_t)t * 1024);
#pragma unroll
        for (int j = 0; j < 4; ++j) { const u32x2 hv = *((const u32x2*)(H3B + (size_t)t * 1024) + l + 64 * j); const f32x4 gv = *((const f32x4*)g + l + 64 * j);
            const f32x4 h = (f32x4){bf_lo(hv.x), bf_hi(hv.x), bf_lo(hv.y), bf_hi(hv.y)}; row[l + 64 * j] = h * rstd * gv; }
    }
}
#ifndef MK_FUSED
#define MK_FUSED 1
#endif
constexpr int NPHASE = 10;
struct Args { const float* in[20]; float* out; unsigned char* ws; int ph_lo, ph_hi, dry, pad; };
static_assert(sizeof(Args) == 20 * 8 + 8 + 8 + 4 * 4, "Args has no padding");

__global__ void __launch_bounds__(NWAVES * 64, 2) mk_fwd(Args args) {
    extern __shared__ __attribute__((aligned(16))) unsigned char lds_raw[];
    Frame F;
    F.lds = (LAS unsigned char*)lds_raw;
    F.wave = __builtin_amdgcn_readfirstlane(threadIdx.x >> 6); F.lane = lane_id(); F.tid = F.wave * 64 + F.lane;
    F.G = gridDim.x; { const int bx = blockIdx.x; F.vcu = (F.G % 8 == 0) ? (bx % 8) * (F.G / 8) + bx / 8 : bx; }
    F.in = args.in; F.out = args.out; F.ws = args.ws; F.dry = args.dry;
    volatile LAS unsigned* MISC = (volatile LAS unsigned*)(F.lds + MISC_OFF);
    if (F.tid < 64) MISC[F.tid] = 0u;
    __syncthreads();
    const int lo = args.ph_lo, hi = args.ph_hi;
    XcdBarrier bar; bar.bar = (unsigned*)(F.ws + WS_CTL) + CW_BAR; bar.x = 0; bar.st = nullptr;
    if (hi - lo > 1) bar = xcd_barrier_post((unsigned*)(F.ws + WS_CTL) + CW_BAR, MISC + 8, F.tid);
#ifndef PH_MASK
#define PH_MASK 0xFFFFFFFFu
#endif
#define IN(k) (((PH_MASK >> (k)) & 1u) && lo <= (k) && (k) < hi)
#define LAUNDER(p, T) do { unsigned _lo = (unsigned)(unsigned long long)(p), _hi = (unsigned)((unsigned long long)(p) >> 32); asm volatile("" : "+v"(_lo), "+v"(_hi)); \
        _lo = __builtin_amdgcn_readfirstlane(_lo); _hi = __builtin_amdgcn_readfirstlane(_hi); (p) = (T)(((unsigned long long)_hi << 32) | _lo); } while (0)
#define SEAM(k) do { if (IN(k) && IN((k) + 1)) xcd_barrier(bar, F.tid); LAUNDER(F.ws, unsigned char*); LAUNDER(F.out, float*); F.lane = lane_id(); F.tid = F.wave * 64 + F.lane; } while (0)
    const int bx = (int)blockIdx.x;
    LAS unsigned char* ring = F.lds + RING_OFF;

    if (IN(0)) { phase_prologue(F); } SEAM(0);
    if (IN(1)) {
        pg8::Gemm g{WSP(bf16_t, WS_XN1), WSP(bf16_t, WS_WIN), T_TOK, 8192, 1024, 1024, 0, 2, 8}; pg8::StaticOrder S; S.init(T_TOK, 8192, F.G, bx);
        pg8::EpiProj E{WSP(bf16_t, WS_GQ), WSP(bf16_t, WS_GK), WSP(bf16_t, WS_GV), WSP(bf16_t, WS_GR), WSP(bf16_t, WS_SQ), WSP(bf16_t, WS_SK), WSP(bf16_t, WS_SV),
                       (bf16_t*)F.out, (bf16_t*)F.out + (size_t)T_TOK * 1024};
        pg8::gemm_phase<pg8::EpiProj>(ring, g, S, E, F.tid);
    } SEAM(1);
    if (IN(2)) { phase_gla_prep(F); } SEAM(2);
    if (IN(3)) { phase_attn_a(F); } SEAM(3);
    if (IN(4)) { phase_attn_b(F); } SEAM(4);
    if (IN(5)) {
        if (!QCONV) { for (int cu = F.vcu; cu < CVT8_UNITS; cu += F.G) cvt_fp8_unit(F, cu); VM_WAIT(); __syncthreads(); }
        pg8::PairOrder S; S.init(T_TOK, 1024, F.G, bx);
        pg8::Gemm g{WSP(bf16_t, WS_GLAN), WSP(bf16_t, WS_WGA), T_TOK, 1024, 1024, 1024, 0, 0, 0, WSP(bf16_t, WS_SQ), WSP(bf16_t, WS_WSB)};
        pg8::EpiMixPair E{(const bf16_t*)F.out, (const bf16_t*)F.out + (size_t)T_TOK * 1024, WSP(bf16_t, WS_MIX)};
        pg8::gemm_phase<pg8::EpiMixPair, true, true, pg8::PairOrder>(ring, g, S, E, F.tid);
    } SEAM(5);
    if (IN(6)) {
        pg8::Gemm g{WSP(bf16_t, WS_MIX), WSP(bf16_t, WS_WO), T_TOK, 1024, 1024, 1024, 0, 0, 0}; pg8::StaticOrder S; S.init(T_TOK, 1024, F.G, bx);
        pg8::EpiH1 E{F.in[0], WSP(bf16_t, WS_H1), WSP(float, WS_SSQ1)};
        pg8::gemm_phase<pg8::EpiH1>(ring, g, S, E, F.tid);
    } SEAM(6);
    if (IN(7)) {
        pg8::Gemm g{WSP(bf16_t, WS_H1), WSP(bf16_t, WS_WPQ), T_TOK, 2048, 1024, 1024, 0, 0, 0}; pg8::StaticOrder S; S.init(T_TOK, 2048, F.G, bx);
        pg8::EpiQ E{WSP(float, WS_SSQ1), WSP(bf16_t, WS_Q), 2048};
        pg8::gemm_phase<pg8::EpiQ>(ring, g, S, E, F.tid);
    } SEAM(7);
    if (IN(8)) {
        cvt_copy(F, F.in[1], WSP(bf16_t, WS_PB), (size_t)T_TOK * 256);
        phase_peer_retrieve(F);
        VM_WAIT(); __syncthreads();
        phase_peer_gather(F, bar, false);
    } SEAM(8);
    if (IN(9)) {
        pg8::StaticOrder S; S.init(T_TOK, 1024, F.G, bx);
        { pg8::Gemm g{WSP(bf16_t, WS_PB), WSP(bf16_t, WS_WPLE), T_TOK, 1024, 256, 256, 0, 0, 0}; pg8::EpiBf E{WSP(bf16_t, WS_PLE), 1024};
          pg8::gemm_phase<pg8::EpiBf>(ring, g, S, E, F.tid); }
        { pg8::Gemm g{WSP(bf16_t, WS_H2B), WSP(bf16_t, WS_WPG), T_TOK, 1024, 1024, 1024, 0, 0, 0}; pg8::EpiH3L E{WSP(bf16_t, WS_H2B), WSP(bf16_t, WS_PLE), WSP(float, WS_RS3), ring, WSP(float, WS_SSQ3)};
          pg8::gemm_phase<pg8::EpiH3L>(ring, g, S, E, F.tid); }
        { pg8::Unit u; S.next(0, u);
          unsigned* cnt = (unsigned*)(F.ws + WS_CTL) + CW_ROWCNT + 64 * F.dry + u.pm;
          if (F.tid == 0) {
              __builtin_amdgcn_fence(__ATOMIC_RELEASE, "agent");
              __hip_atomic_fetch_add(cnt, 1u, __ATOMIC_RELAXED, __HIP_MEMORY_SCOPE_AGENT);
              unsigned sp = 0; while (__hip_atomic_load(cnt, __ATOMIC_RELAXED, __HIP_MEMORY_SCOPE_AGENT) < 4u && ++sp < (1u << 24)) __builtin_amdgcn_s_sleep(1);
              __builtin_amdgcn_fence(__ATOMIC_ACQUIRE, "agent");
          }
          __syncthreads();
          LAS float* rsl = (LAS float*)(ring + 256 * pg8::H3L_PITCH);
          if (F.tid < 256) { const f32x4* sp = (const f32x4*)(WSP(float, WS_SSQ3) + (size_t)(u.pm * 256 + F.tid) * 16); const f32x4 st = (sp[0] + sp[1]) + (sp[2] + sp[3]);
              rsl[F.tid] = __builtin_amdgcn_rsqf(((st[0] + st[1]) + (st[2] + st[3])) * (1.0f / 1024.0f) + EPS); }
          __syncthreads();
          const int c8 = F.tid & 31, r0 = F.tid >> 5;
          const f32x4 g0 = *(const f32x4*)(F.in[19] + u.pn * 256 + 8 * c8), g1 = *(const f32x4*)(F.in[19] + u.pn * 256 + 8 * c8 + 4);
#pragma unroll 4
          for (int ps = 0; ps < 16; ++ps) { const int lrow = ps * 16 + r0; const u32x4 hv = *(const LAS u32x4*)(ring + lrow * pg8::H3L_PITCH + 16 * c8); const float rstd = rsl[lrow];
              float* op = F.out + (size_t)(u.pm * 256 + lrow) * 1024 + u.pn * 256 + 8 * c8;
              *(f32x4*)op = (f32x4){bf_lo(hv.x), bf_hi(hv.x), bf_lo(hv.y), bf_hi(hv.y)} * rstd * g0; *(f32x4*)(op + 4) = (f32x4){bf_lo(hv.z), bf_hi(hv.z), bf_lo(hv.w), bf_hi(hv.w)} * rstd * g1; }
        }
    }
#undef IN
#undef SEAM
}

extern "C" void kernel_launch(void* const* d_in, const int* in_sizes, int n_in, void* d_out, int out_size, void* d_ws, size_t ws_size, hipStream_t stream) {
    static int grid = 0;
    if (grid == 0) {
        if (n_in != 20 || in_sizes[0] != T_TOK * 1024 || out_size != T_TOK * 1024 || ws_size < WS_END) {
            fprintf(stderr, "kernel_launch: unexpected shapes (n_in %d, in0 %d, out %d, ws %zu < %zu?); nothing launched\n", n_in, n_in > 0 ? in_sizes[0] : -1, out_size, ws_size, (size_t)WS_END); grid = -1; return; }
        int dev = 0, cus = 0, per_cu = 0;
        if (hipGetDevice(&dev) != hipSuccess || hipDeviceGetAttribute(&cus, hipDeviceAttributeMultiprocessorCount, dev) != hipSuccess) { grid = -1; return; }
        if (hipFuncSetAttribute((const void*)mk_fwd, hipFuncAttributeMaxDynamicSharedMemorySize, LDS_BYTES) != hipSuccess) { fprintf(stderr, "kernel_launch: hipFuncSetAttribute failed\n"); grid = -1; return; }
        if (hipOccupancyMaxActiveBlocksPerMultiprocessor(&per_cu, (const void*)mk_fwd, NWAVES * 64, LDS_BYTES) != hipSuccess || per_cu < 1)
            fprintf(stderr, "kernel_launch: note: occupancy query reports %d workgroups per CU\n", per_cu);
        (void)hipGetLastError();
        grid = cus;
        if (grid != (T_TOK / 256) * 4) { fprintf(stderr, "kernel_launch: the last phase needs one output tile per workgroup (grid %d)\n", grid); grid = -1; return; }
        if (grid != 256) fprintf(stderr, "kernel_launch: note: %d CUs (kernel tuned for 256)\n", grid);
    }
    if (grid < 0) return;
    if (hipMemsetAsync((char*)d_ws + WS_CTL, 0, CTL_ZERO_BYTES, stream) != hipSuccess) { fprintf(stderr, "kernel_launch: hipMemsetAsync failed\n"); return; }
    Args a{};
    for (int i = 0; i < 20; ++i) a.in[i] = (const float*)d_in[i];
    a.out = (float*)d_out; a.ws = (unsigned char*)d_ws;
#if MK_FUSED
    a.ph_lo = 0; a.ph_hi = NPHASE;
    hipLaunchKernelGGL(mk_fwd, dim3(grid), dim3(NWAVES * 64), LDS_BYTES, stream, a);
#else
#ifndef PROBE_PHASE
#define PROBE_PHASE -1
#define PROBE_REPS 0
#endif
    for (int p = 0; p < NPHASE; ++p) { a.ph_lo = p; a.ph_hi = p + 1;
        if (p == PROBE_PHASE) { a.dry = 1; for (int r = 0; r < PROBE_REPS; ++r) hipLaunchKernelGGL(mk_fwd, dim3(grid), dim3(NWAVES * 64), LDS_BYTES, stream, a); a.dry = 0; }
        hipLaunchKernelGGL(mk_fwd, dim3(grid), dim3(NWAVES * 64), LDS_BYTES, stream, a); }
#endif
}
```

```cpp
#define MK_FUSED 1
#define PG_TOK 2
#include <hip/hip_runtime.h>
#include <cstdio>
#include <cstdint>

#define LAS __attribute__((address_space(3)))
#define GAS __attribute__((address_space(1)))
typedef unsigned short bf16_t;
typedef short bf16x8 __attribute__((ext_vector_type(8)));
typedef short s16x4 __attribute__((ext_vector_type(4)));
typedef float f32x2 __attribute__((ext_vector_type(2)));
typedef float f32x4 __attribute__((ext_vector_type(4)));
typedef float f32x16 __attribute__((ext_vector_type(16)));
typedef unsigned u32x2 __attribute__((ext_vector_type(2)));
typedef unsigned u32x4 __attribute__((ext_vector_type(4)));
typedef __bf16 bf16x2_t __attribute__((ext_vector_type(2)));

__device__ __forceinline__ unsigned cvtpk(float lo, float hi) { f32x2 v = {lo, hi}; bf16x2_t b = __builtin_convertvector(v, bf16x2_t); return __builtin_bit_cast(unsigned, b); }
__device__ __forceinline__ float bf_lo(unsigned u) { return __uint_as_float(u << 16); }
__device__ __forceinline__ float bf_hi(unsigned u) { return __uint_as_float(u & 0xffff0000u); }
__device__ __forceinline__ float bf1(bf16_t u) { return __uint_as_float(((unsigned)u) << 16); }
__device__ __forceinline__ float fast_sigmoid(float x) { return __builtin_amdgcn_rcpf(1.0f + __expf(-x)); }

template <int ON, class T> __device__ __forceinline__ void st_nt(T v, T* p) { if constexpr (ON != 0) __builtin_nontemporal_store(v, p); else *p = v; }
#ifndef NT_PROJ_T
#define NT_PROJ_T 1
#endif
#ifndef NT_PROJ_MASK
#define NT_PROJ_MASK 0xFFFFFFFFu
#endif
#ifndef NT_EPI
#define NT_EPI 0
#endif
#ifndef NT_PRE
#define NT_PRE 0
#endif
#ifndef NT_ATT
#define NT_ATT 0
#endif
#ifndef NT_OUT
#define NT_OUT 0
#endif

namespace pg8 {
constexpr int BM = 256, BK = 64, HALF = 128, HTB = HALF * BK * 2  , STAGE_BYTES = 8 * HTB, NXCD = 8, WGM = 8;

__host__ __device__ __forceinline__ int lds_byte(int r, int c) { const int st = (r >> 4) * 2 + (c >> 5), rr = r & 15, cc = c & 31, ob = rr * 64 + cc * 2; return st * 1024 + (ob ^ (((ob >> 9) & 1) << 5)); }
__host__ __device__ __forceinline__ void stage_rc(int b, int& R, int& C) { const int st = b / 1024, sb = b % 1024, swz = sb ^ (((sb >> 9) & 1) << 5); R = (st >> 1) * 16 + swz / 64; C = (st & 1) * 32 + (swz % 64) / 2; }
__host__ __device__ __forceinline__ int perm32(int rho) { const int n = rho >> 4, i = rho & 15; return 8 * (i >> 2) + 4 * n + (i & 3); }

struct Unit { int pm, pn, half; };
struct Gemm { const bf16_t* A; const bf16_t* Bt; int M, N, K, lda, a_pn_cols; int swap_lo, swap_hi; const bf16_t* A2 = nullptr; const bf16_t* Bt2 = nullptr; };

struct StaticOrder {
    int nM, nN, nwg, G, c;
    __host__ __device__ void init(int M, int N, int G_, int c_) { nM = M / BM; nN = N / BM; nwg = nM * nN; G = G_; c = c_; }
    __host__ __device__ bool next(int i, Unit& u) const {
        const long L = (long)i * G + c; if (L >= nwg) return false;
        int wgid = (int)L; { const int q = nwg / NXCD, r = nwg % NXCD, xcd = wgid % NXCD, off = wgid / NXCD; wgid = (xcd < r ? xcd * (q + 1) : r * (q + 1) + (xcd - r) * q) + off; }
        const int nig = WGM * nN, gid = wgid / nig, fm = gid * WGM, gsz = (nM - fm) < WGM ? (nM - fm) : WGM;
        u.pm = fm + ((wgid % nig) % gsz); u.pn = (wgid % nig) / gsz; u.half = 0; return true;
    }
};
struct PairOrder {
    StaticOrder S;
    __host__ __device__ void init(int M, int N, int G_, int c_) { S.init(M, N, G_, c_); }
    __host__ __device__ bool next(int i, Unit& u) const { if (!S.next(i >> 1, u)) return false; u.half = i & 1; return true; }
};

template <class Epi, bool ALIGN_EPI = true, bool SP2 = true, class Order = StaticOrder>
__device__ __forceinline__ void gemm_phase(LAS unsigned char* lds, const Gemm g, const Order& S, const Epi& E, int tid) {
    const int wid = __builtin_amdgcn_readfirstlane(tid >> 6), lane = tid & 63, wr = wid >> 2, wc = wid & 3, fr = lane & 15, fq = lane >> 4;
    const int K = g.K, nt = K / BK, lda = g.lda;
    unsigned voffA[2], voffB[2];
#pragma unroll
    for (int i = 0; i < 2; ++i) { int R, C; stage_rc(tid * 16 + i * 8192, R, C); const int Rb = Epi::PERM ? ((R & ~31) + perm32(R & 31)) : R;
        voffA[i] = (unsigned)(R * lda + C) * 2u; voffB[i] = (unsigned)(Rb * K + C) * 2u; }
    const size_t kstep = (size_t)(BK * 2);
    const size_t hA = (size_t)HALF * lda * 2, hB = (size_t)HALF * K * 2;
    const size_t tA = 2 * hA, tB = 2 * hB;
    const size_t pnA = (size_t)g.a_pn_cols * 2;
    const unsigned ldsw = (unsigned)wid * 1024u;
    const int aoff = lds_byte(wr * 64 + fr, fq * 8), boff = lds_byte(wc * 32 + fr, fq * 8);
#define PG8_SA(b, h) (((b) * 2 + (h)) * HTB)
#define PG8_SB(b, h) ((4 + (b) * 2 + (h)) * HTB)
#define PG8_STAGE(bufoff, gbase, voff) do { _Pragma("unroll") for (int _i = 0; _i < 2; ++_i) \
        __builtin_amdgcn_global_load_lds((const unsigned*)((const char*)(gbase) + (voff)[_i]), (LAS unsigned*)(lds + (bufoff) + ldsw + _i * 8192), 16, 0, 0); } while (0)
#define PG8_LDA(dst, b, h) do { _Pragma("unroll") for (int m = 0; m < 4; ++m) _Pragma("unroll") for (int k = 0; k < 2; ++k) dst[m][k] = *(const LAS bf16x8*)(lds + PG8_SA(b, h) + aoff + m * 2048 + k * 1024); } while (0)
#define PG8_LDB(dst, b, h) do { _Pragma("unroll") for (int n = 0; n < 2; ++n) _Pragma("unroll") for (int k = 0; k < 2; ++k) dst[n][k] = *(const LAS bf16x8*)(lds + PG8_SB(b, h) + boff + n * 2048 + k * 1024); } while (0)
#define PG8_MMA(ai, bj, At, Bt) do { __builtin_amdgcn_s_setprio(1); _Pragma("unroll") for (int m = 0; m < 4; ++m) _Pragma("unroll") for (int n = 0; n < 2; ++n) _Pragma("unroll") for (int k = 0; k < 2; ++k) \
        acc[ai][bj][m][n] = __builtin_amdgcn_mfma_f32_16x16x32_bf16(Bt[n][k], At[m][k], acc[ai][bj][m][n], 0, 0, 0); __builtin_amdgcn_s_setprio(0); } while (0)
#define PG8_WAIT_V(n) asm volatile("s_waitcnt vmcnt(" #n ")" ::: "memory")
#define PG8_WAIT_L(n) asm volatile("s_waitcnt lgkmcnt(" #n ")" ::: "memory")
#define PG8_BAR __builtin_amdgcn_s_barrier()
#define PG8_SCHED __builtin_amdgcn_sched_barrier(0)
    Unit cur, nxt; int ui = 0;
    if (!S.next(0, cur)) return;
    f32x4 acc[2][2][4][2];
#pragma unroll
    for (int a = 0; a < 2; ++a)
#pragma unroll
        for (int b = 0; b < 2; ++b)
#pragma unroll
            for (int m = 0; m < 4; ++m)
#pragma unroll
                for (int n = 0; n < 2; ++n) acc[a][b][m][n] = (f32x4){0.f, 0.f, 0.f, 0.f};
    bf16x8 At[4][2], B0[2][2], B1[2][2];
#define PG8_APTR(u) ((u).half ? (const char*)g.A2 + (size_t)(u).pm * tA : ((u).pn >= g.swap_lo && (u).pn < g.swap_hi) ? (const char*)g.Bt + (size_t)(u).pn * tB : (const char*)g.A + (size_t)(u).pm * tA + (size_t)(u).pn * pnA)
#define PG8_BPTR(u) ((u).half ? (const char*)g.Bt2 + (size_t)(u).pn * tB : ((u).pn >= g.swap_lo && (u).pn < g.swap_hi) ? (const char*)g.A + (size_t)(u).pm * tA : (const char*)g.Bt + (size_t)(u).pn * tB)
    const char* cA = PG8_APTR(cur); const char* cB = PG8_BPTR(cur);
    if constexpr (SP2) {
        PG8_STAGE(PG8_SB(0, 0), cB, voffB); PG8_STAGE(PG8_SB(0, 1), cB + hB, voffB); PG8_STAGE(PG8_SA(0, 0), cA, voffA); PG8_STAGE(PG8_SA(0, 1), cA + hA, voffA);
        if (wr == 1) PG8_BAR;
        PG8_WAIT_V(2); PG8_BAR;
        PG8_STAGE(PG8_SB(1, 0), cB + kstep, voffB); PG8_STAGE(PG8_SA(1, 0), cA + kstep, voffA); PG8_STAGE(PG8_SB(1, 1), cB + hB + kstep, voffB);
        PG8_WAIT_V(6); PG8_BAR;
    } else {
        PG8_STAGE(PG8_SB(0, 0), cB, voffB); PG8_STAGE(PG8_SA(0, 0), cA, voffA); PG8_STAGE(PG8_SB(0, 1), cB + hB, voffB); PG8_STAGE(PG8_SA(0, 1), cA + hA, voffA);
        if (wr == 1) PG8_BAR;
        PG8_WAIT_V(4); PG8_BAR;
        PG8_STAGE(PG8_SB(1, 0), cB + kstep, voffB); PG8_STAGE(PG8_SA(1, 0), cA + kstep, voffA); PG8_STAGE(PG8_SB(1, 1), cB + hB + kstep, voffB);
        PG8_WAIT_V(6); PG8_BAR;
    }
    for (;;) {
        const bool has_next = S.next(ui + 1, nxt);
        const char* nA = has_next ? PG8_APTR(nxt) : cA; const char* nB = has_next ? PG8_BPTR(nxt) : cB;
#pragma unroll 1
        for (int t = 0; t < nt; t += 2) {
            const bool last = (t == nt - 2);
            const char* a1 = cA + (size_t)(t + 1) * kstep;
            const char* a2 = last ? nA : cA + (size_t)(t + 2) * kstep; const char* b2 = last ? nB : cB + (size_t)(t + 2) * kstep;
            const char* a3 = a2 + kstep; const char* b3 = b2 + kstep;
            if constexpr (SP2) {
            PG8_LDB(B0, 0, 0); PG8_LDB(B1, 0, 1); PG8_SCHED; PG8_LDA(At, 0, 0); PG8_STAGE(PG8_SA(1, 1), a1 + hA, voffA);
            PG8_WAIT_V(8); PG8_WAIT_L(0); PG8_BAR; PG8_MMA(0, 0, At, B0); PG8_MMA(0, 1, At, B1); PG8_BAR; PG8_SCHED;
            PG8_LDA(At, 0, 1); PG8_STAGE(PG8_SB(0, 0), b2, voffB); PG8_STAGE(PG8_SB(0, 1), b2 + hB, voffB); PG8_STAGE(PG8_SA(0, 0), a2, voffA);
            PG8_WAIT_V(8); PG8_WAIT_L(0); PG8_BAR; PG8_MMA(1, 0, At, B0); PG8_MMA(1, 1, At, B1); PG8_BAR; PG8_SCHED;
            PG8_LDB(B0, 1, 0); PG8_LDB(B1, 1, 1); PG8_SCHED; PG8_LDA(At, 1, 0); PG8_STAGE(PG8_SA(0, 1), a2 + hA, voffA);
            PG8_WAIT_V(8); PG8_WAIT_L(0); PG8_BAR; PG8_MMA(0, 0, At, B0); PG8_MMA(0, 1, At, B1); PG8_BAR; PG8_SCHED;
            PG8_LDA(At, 1, 1); PG8_STAGE(PG8_SB(1, 0), b3, voffB); PG8_STAGE(PG8_SB(1, 1), b3 + hB, voffB); PG8_STAGE(PG8_SA(1, 0), a3, voffA);
            PG8_WAIT_V(8); PG8_WAIT_L(0); PG8_BAR; PG8_MMA(1, 0, At, B0); PG8_MMA(1, 1, At, B1); PG8_BAR; PG8_SCHED;
            } else {
            PG8_LDB(B0, 0, 0); PG8_SCHED; PG8_LDA(At, 0, 0); PG8_STAGE(PG8_SA(1, 1), a1 + hA, voffA);
            PG8_WAIT_L(8); PG8_BAR; PG8_WAIT_L(0); PG8_MMA(0, 0, At, B0); PG8_BAR; PG8_SCHED;
            PG8_LDB(B1, 0, 1); PG8_STAGE(PG8_SB(0, 0), b2, voffB);
            PG8_BAR; PG8_WAIT_L(0); PG8_MMA(0, 1, At, B1); PG8_BAR;
            PG8_LDA(At, 0, 1); PG8_STAGE(PG8_SA(0, 0), a2, voffA);
            PG8_BAR; PG8_WAIT_L(0); PG8_MMA(1, 0, At, B0); PG8_BAR; PG8_SCHED;
            PG8_STAGE(PG8_SB(0, 1), b2 + hB, voffB);
            PG8_WAIT_V(6); PG8_BAR; PG8_MMA(1, 1, At, B1); PG8_BAR;
            PG8_LDB(B0, 1, 0); PG8_SCHED; PG8_LDA(At, 1, 0); PG8_STAGE(PG8_SA(0, 1), a2 + hA, voffA);
            PG8_WAIT_L(8); PG8_BAR; PG8_WAIT_L(0); PG8_MMA(0, 0, At, B0); PG8_BAR; PG8_SCHED;
            PG8_LDB(B1, 1, 1); PG8_STAGE(PG8_SB(1, 0), b3, voffB);
            PG8_BAR; PG8_WAIT_L(0); PG8_MMA(0, 1, At, B1); PG8_BAR;
            PG8_LDA(At, 1, 1); PG8_STAGE(PG8_SA(1, 0), a3, voffA);
            PG8_BAR; PG8_WAIT_L(0); PG8_MMA(1, 0, At, B0); PG8_BAR; PG8_SCHED;
            PG8_STAGE(PG8_SB(1, 1), b3 + hB, voffB);
            PG8_WAIT_V(6); PG8_BAR; PG8_MMA(1, 1, At, B1); PG8_BAR;
            }
        }
        if constexpr (ALIGN_EPI) { if (wr == 0) PG8_BAR; }
        E(acc, cur, wr, wc, fr, fq);
        if (!has_next) break;
        if (!(Epi::ACCUM && cur.half == 0))
#pragma unroll
        for (int a = 0; a < 2; ++a)
#pragma unroll
            for (int b = 0; b < 2; ++b)
#pragma unroll
                for (int m = 0; m < 4; ++m)
#pragma unroll
                    for (int n = 0; n < 2; ++n) acc[a][b][m][n] = (f32x4){0.f, 0.f, 0.f, 0.f};
        cur = nxt; cA = nA; cB = nB; ++ui;
        if constexpr (ALIGN_EPI) { if (wr == 1) PG8_BAR; }
    }
    PG8_WAIT_V(0);
    if constexpr (!ALIGN_EPI) { if (wr == 0) PG8_BAR; }
    PG8_BAR;
#undef PG8_APTR
#undef PG8_BPTR
#undef PG8_SA
#undef PG8_SB
#undef PG8_STAGE
#undef PG8_LDA
#undef PG8_LDB
#undef PG8_MMA
#undef PG8_WAIT_V
#undef PG8_WAIT_L
#undef PG8_BAR
#undef PG8_SCHED
}
}
constexpr int T_TOK = 16384, DM = 1024, SEQ = 4096, NB = 4;
constexpr float EPS = 1e-6f;
constexpr float LOG2E = 1.4426950408889634f;

namespace pg8 {
struct EpiProj {
    static constexpr bool PERM = true, ACCUM = false;
    bf16_t *GQ, *GK, *GV, *GR, *SQ, *SK, *SV, *SGA, *SGB;
    __device__ __forceinline__ void operator()(const f32x4 (&acc)[2][2][4][2], const Unit& u, int wr, int wc, int fr, int fq) const {
        const int pn = u.pn; bf16_t* base; int ldc = 1024, c0; int act = 0; float sc = 1.f;
        if (pn >= 2 && pn < 8) {
            bf16_t* tb = (pn < 4) ? GK : GV; const int f0 = ((pn < 4) ? (pn - 2) : (pn - 4)) * 256 + wr * 64 + fr, t0 = u.pm * BM + wc * 32 + 8 * fq;
#pragma unroll
            for (int ai = 0; ai < 2; ++ai)
#pragma unroll
                for (int m = 0; m < 4; ++m) { bf16_t* rowp = tb + (size_t)(f0 + ai * HALF + m * 16) * T_TOK + t0;
#pragma unroll
                    for (int bj = 0; bj < 2; ++bj) { const f32x4 v0 = acc[ai][bj][m][0], v1 = acc[ai][bj][m][1];
                        u32x4 w; w.x = cvtpk(v0[0], v0[1]); w.y = cvtpk(v0[2], v0[3]); w.z = cvtpk(v1[0], v1[1]); w.w = cvtpk(v1[2], v1[3]);
                        st_nt<NT_PROJ_T>(w, (u32x4*)(rowp + bj * HALF)); } }
            return; }
        if (pn < 2) { base = GQ; ldc = 512; c0 = pn * 256; sc = 0.08838834764831845f; }
        else if (pn < 4) { base = GK; ldc = 512; c0 = (pn - 2) * 256; }
        else if (pn < 8) { base = GV; c0 = (pn - 4) * 256; }
        else if (pn < 12) { base = GR; c0 = (pn - 8) * 256; act = 1; }
        else if (pn < 16) { base = SQ; c0 = (pn - 12) * 256; sc = 0.125f * LOG2E; }
        else if (pn < 20) { base = SK; c0 = (pn - 16) * 256; }
        else if (pn < 24) { base = SV; c0 = (pn - 20) * 256; }
        else if (pn < 28) { base = SGA; c0 = (pn - 24) * 256; act = 2; }
        else { base = SGB; c0 = (pn - 28) * 256; act = 2; }
        const int row0 = u.pm * BM + wr * 64 + fr, col0 = c0 + wc * 32 + 8 * fq;
#pragma unroll
        for (int ai = 0; ai < 2; ++ai)
#pragma unroll
            for (int m = 0; m < 4; ++m) { bf16_t* rowp = base + (size_t)(row0 + ai * HALF + m * 16) * ldc + col0;
#pragma unroll
                for (int bj = 0; bj < 2; ++bj) { f32x4 v0 = acc[ai][bj][m][0], v1 = acc[ai][bj][m][1];
                    if (act == 1) {
#pragma unroll
                        for (int j = 0; j < 4; ++j) { v0[j] = v0[j] * fast_sigmoid(v0[j]); v1[j] = v1[j] * fast_sigmoid(v1[j]); } }
                    else if (act == 2) {
#pragma unroll
                        for (int j = 0; j < 4; ++j) { v0[j] = fast_sigmoid(v0[j]); v1[j] = fast_sigmoid(v1[j]); } }
                    else { v0 = v0 * sc; v1 = v1 * sc; }
                    u32x4 w; w.x = cvtpk(v0[0], v0[1]); w.y = cvtpk(v0[2], v0[3]); w.z = cvtpk(v1[0], v1[1]); w.w = cvtpk(v1[2], v1[3]);
                    if (NT_PROJ_MASK >> pn & 1u) __builtin_nontemporal_store(w, (u32x4*)(rowp + bj * HALF)); else *(u32x4*)(rowp + bj * HALF) = w; } }
    }
};
template <bool FIRST> struct EpiMix {
    static constexpr bool PERM = true, ACCUM = false;
    const bf16_t* gate; bf16_t* mixed;
    __device__ __forceinline__ void operator()(const f32x4 (&acc)[2][2][4][2], const Unit& u, int wr, int wc, int fr, int fq) const {
        const int row0 = u.pm * BM + wr * 64 + fr, col0 = u.pn * BM + wc * 32 + 8 * fq;
#pragma unroll
        for (int ai = 0; ai < 2; ++ai) {
            u32x4 gv[4][2], mv[4][2];
#pragma unroll
            for (int m = 0; m < 4; ++m)
#pragma unroll
                for (int bj = 0; bj < 2; ++bj) { const size_t off = (size_t)(row0 + ai * HALF + m * 16) * 1024 + col0 + bj * HALF;
                    gv[m][bj] = *(const u32x4*)(gate + off); if (!FIRST) mv[m][bj] = *(const u32x4*)(mixed + off); }
#pragma unroll
            for (int m = 0; m < 4; ++m)
#pragma unroll
                for (int bj = 0; bj < 2; ++bj) { const size_t off = (size_t)(row0 + ai * HALF + m * 16) * 1024 + col0 + bj * HALF;
                    const f32x4 a0 = acc[ai][bj][m][0], a1 = acc[ai][bj][m][1]; const u32x4 g4 = gv[m][bj];
                    float r[8];
                    r[0] = a0[0] * bf_lo(g4.x); r[1] = a0[1] * bf_hi(g4.x); r[2] = a0[2] * bf_lo(g4.y); r[3] = a0[3] * bf_hi(g4.y);
                    r[4] = a1[0] * bf_lo(g4.z); r[5] = a1[1] * bf_hi(g4.z); r[6] = a1[2] * bf_lo(g4.w); r[7] = a1[3] * bf_hi(g4.w);
                    if (!FIRST) { const u32x4 m4 = mv[m][bj];
                        r[0] += bf_lo(m4.x); r[1] += bf_hi(m4.x); r[2] += bf_lo(m4.y); r[3] += bf_hi(m4.y); r[4] += bf_lo(m4.z); r[5] += bf_hi(m4.z); r[6] += bf_lo(m4.w); r[7] += bf_hi(m4.w); }
                    u32x4 w; w.x = cvtpk(r[0], r[1]); w.y = cvtpk(r[2], r[3]); w.z = cvtpk(r[4], r[5]); w.w = cvtpk(r[6], r[7]);
                    *(u32x4*)(mixed + off) = w; }
        }
    }
};
struct EpiMixPair {
    static constexpr bool PERM = true, ACCUM = true;
    const bf16_t* ga; const bf16_t* gb; bf16_t* mixed;
    __device__ __forceinline__ void operator()(f32x4 (&acc)[2][2][4][2], const Unit& u, int wr, int wc, int fr, int fq) const {
        const int row0 = u.pm * BM + wr * 64 + fr, col0 = u.pn * BM + wc * 32 + 8 * fq;
        const float TINY = 8.673617379884035e-19f;
        if (u.half == 0) {
#pragma unroll
            for (int ai = 0; ai < 2; ++ai) {
                u32x4 av[4][2], bv[4][2];
#pragma unroll
                for (int m = 0; m < 4; ++m)
#pragma unroll
                    for (int bj = 0; bj < 2; ++bj) { const size_t off = (size_t)(row0 + ai * HALF + m * 16) * 1024 + col0 + bj * HALF; av[m][bj] = *(const u32x4*)(ga + off); bv[m][bj] = *(const u32x4*)(gb + off); }
#pragma unroll
                for (int m = 0; m < 4; ++m)
#pragma unroll
                    for (int bj = 0; bj < 2; ++bj) { const u32x4 a4 = av[m][bj], b4 = bv[m][bj];
                        const unsigned aw[4] = {a4.x, a4.y, a4.z, a4.w}, bw[4] = {b4.x, b4.y, b4.z, b4.w};
#pragma unroll
                        for (int j = 0; j < 4; ++j) { const float r0 = bf_lo(aw[j]) * __builtin_amdgcn_rcpf(fmaxf(bf_lo(bw[j]), TINY)), r1 = bf_hi(aw[j]) * __builtin_amdgcn_rcpf(fmaxf(bf_hi(bw[j]), TINY));
                            acc[ai][bj][m][j >> 1][2 * (j & 1)] *= r0; acc[ai][bj][m][j >> 1][2 * (j & 1) + 1] *= r1; } }
            }
        } else {
#pragma unroll
            for (int ai = 0; ai < 2; ++ai) {
                u32x4 bv[4][2];
#pragma unroll
                for (int m = 0; m < 4; ++m)
#pragma unroll
                    for (int bj = 0; bj < 2; ++bj) bv[m][bj] = *(const u32x4*)(gb + (size_t)(row0 + ai * HALF + m * 16) * 1024 + col0 + bj * HALF);
#pragma unroll
                for (int m = 0; m < 4; ++m)
#pragma unroll
                    for (int bj = 0; bj < 2; ++bj) { const size_t off = (size_t)(row0 + ai * HALF + m * 16) * 1024 + col0 + bj * HALF; const u32x4 b4 = bv[m][bj];
                        const f32x4 a0 = acc[ai][bj][m][0], a1 = acc[ai][bj][m][1];
                        float r[8];
                        r[0] = a0[0] * fmaxf(bf_lo(b4.x), TINY); r[1] = a0[1] * fmaxf(bf_hi(b4.x), TINY); r[2] = a0[2] * fmaxf(bf_lo(b4.y), TINY); r[3] = a0[3] * fmaxf(bf_hi(b4.y), TINY);
                        r[4] = a1[0] * fmaxf(bf_lo(b4.z), TINY); r[5] = a1[1] * fmaxf(bf_hi(b4.z), TINY); r[6] = a1[2] * fmaxf(bf_lo(b4.w), TINY); r[7] = a1[3] * fmaxf(bf_hi(b4.w), TINY);
                        u32x4 w; w.x = cvtpk(r[0], r[1]); w.y = cvtpk(r[2], r[3]); w.z = cvtpk(r[4], r[5]); w.w = cvtpk(r[6], r[7]);
                        st_nt<NT_EPI>(w, (u32x4*)(mixed + off)); }
            }
        }
    }
};
struct EpiH1 {
    static constexpr bool PERM = true, ACCUM = false;
    const float* x; bf16_t* H1B; float* SSQ;
    __device__ __forceinline__ void operator()(const f32x4 (&acc)[2][2][4][2], const Unit& u, int wr, int wc, int fr, int fq) const {
        const int row0 = u.pm * BM + wr * 64 + fr, col0 = u.pn * BM + wc * 32 + 8 * fq;
#pragma unroll
        for (int ai = 0; ai < 2; ++ai) {
            f32x4 xv[4][2][2];
#pragma unroll
            for (int m = 0; m < 4; ++m)
#pragma unroll
                for (int bj = 0; bj < 2; ++bj)
#pragma unroll
                    for (int n = 0; n < 2; ++n) xv[m][bj][n] = *(const f32x4*)(x + (size_t)(row0 + ai * HALF + m * 16) * 1024 + col0 + bj * HALF + n * 4);
#pragma unroll
            for (int m = 0; m < 4; ++m) { const int row = row0 + ai * HALF + m * 16; const size_t off = (size_t)row * 1024 + col0; float s = 0.f;
#pragma unroll
                for (int bj = 0; bj < 2; ++bj) { const f32x4 h0 = xv[m][bj][0] + acc[ai][bj][m][0], h1 = xv[m][bj][1] + acc[ai][bj][m][1];
                    s += ((h0[0] * h0[0] + h0[1] * h0[1]) + (h0[2] * h0[2] + h0[3] * h0[3])) + ((h1[0] * h1[0] + h1[1] * h1[1]) + (h1[2] * h1[2] + h1[3] * h1[3]));
                    u32x4 hb; hb.x = cvtpk(h0[0], h0[1]); hb.y = cvtpk(h0[2], h0[3]); hb.z = cvtpk(h1[0], h1[1]); hb.w = cvtpk(h1[2], h1[3]); st_nt<NT_EPI>(hb, (u32x4*)(H1B + off + bj * HALF)); }
                s += __shfl_xor(s, 16); s += __shfl_xor(s, 32);
                if (fq == 0) SSQ[(size_t)row * 16 + u.pn * 4 + wc] = s; }
        }
    }
};
struct EpiQ {
    static constexpr bool PERM = true, ACCUM = false;
    const float* SSQ; bf16_t* Q; int ldc;
    __device__ __forceinline__ void operator()(const f32x4 (&acc)[2][2][4][2], const Unit& u, int wr, int wc, int fr, int fq) const {
        const int row0 = u.pm * BM + wr * 64 + fr, col0 = u.pn * BM + wc * 32 + 8 * fq;
        float rstd[2][4];
#pragma unroll
        for (int ai = 0; ai < 2; ++ai) { f32x4 sq[4][4];
#pragma unroll
            for (int m = 0; m < 4; ++m) { const f32x4* sp = (const f32x4*)(SSQ + (size_t)(row0 + ai * HALF + m * 16) * 16);
#pragma unroll
                for (int j = 0; j < 4; ++j) sq[m][j] = sp[j]; }
#pragma unroll
            for (int m = 0; m < 4; ++m) { const f32x4 st = (sq[m][0] + sq[m][1]) + (sq[m][2] + sq[m][3]);
                rstd[ai][m] = __builtin_amdgcn_rsqf(((st[0] + st[1]) + (st[2] + st[3])) * (1.0f / 1024.0f) + EPS); } }
#pragma unroll
        for (int ai = 0; ai < 2; ++ai)
#pragma unroll
            for (int m = 0; m < 4; ++m) { const int row = row0 + ai * HALF + m * 16;
                bf16_t* rowp = Q + (size_t)row * ldc + col0;
#pragma unroll
                for (int bj = 0; bj < 2; ++bj) { const f32x4 v0 = acc[ai][bj][m][0] * rstd[ai][m], v1 = acc[ai][bj][m][1] * rstd[ai][m];
                    u32x4 w; w.x = cvtpk(v0[0], v0[1]); w.y = cvtpk(v0[2], v0[3]); w.z = cvtpk(v1[0], v1[1]); w.w = cvtpk(v1[2], v1[3]);
                    st_nt<NT_EPI>(w, (u32x4*)(rowp + bj * HALF)); } }
    }
};
struct EpiF32 {
    static constexpr bool PERM = false, ACCUM = false;
    float* O; int ldc;
    __device__ __forceinline__ void operator()(const f32x4 (&acc)[2][2][4][2], const Unit& u, int wr, int wc, int fr, int fq) const {
        const int row0 = u.pm * BM + wr * 64 + fr, col0 = u.pn * BM + wc * 32 + 4 * fq;
#pragma unroll
        for (int ai = 0; ai < 2; ++ai)
#pragma unroll
            for (int m = 0; m < 4; ++m) { float* rowp = O + (size_t)(row0 + ai * HALF + m * 16) * ldc + col0;
#pragma unroll
                for (int bj = 0; bj < 2; ++bj)
#pragma unroll
                    for (int n = 0; n < 2; ++n) *(f32x4*)(rowp + bj * HALF + n * 16) = acc[ai][bj][m][n]; }
    }
};
struct EpiBf {
    static constexpr bool PERM = true, ACCUM = false;
    bf16_t* O; int ldc;
    __device__ __forceinline__ void operator()(const f32x4 (&acc)[2][2][4][2], const Unit& u, int wr, int wc, int fr, int fq) const {
        const int row0 = u.pm * BM + wr * 64 + fr, col0 = u.pn * BM + wc * 32 + 8 * fq;
#pragma unroll
        for (int ai = 0; ai < 2; ++ai)
#pragma unroll
            for (int m = 0; m < 4; ++m) { bf16_t* rowp = O + (size_t)(row0 + ai * HALF + m * 16) * ldc + col0;
#pragma unroll
                for (int bj = 0; bj < 2; ++bj) { const f32x4 v0 = acc[ai][bj][m][0], v1 = acc[ai][bj][m][1];
                    u32x4 w; w.x = cvtpk(v0[0], v0[1]); w.y = cvtpk(v0[2], v0[3]); w.z = cvtpk(v1[0], v1[1]); w.w = cvtpk(v1[2], v1[3]);
                    st_nt<NT_EPI>(w, (u32x4*)(rowp + bj * HALF)); } }
    }
};
struct EpiH3 {
    static constexpr bool PERM = false, ACCUM = false;
    const bf16_t* H2B; const bf16_t* PLE; const float* RS; bf16_t* H3B; float* SSQ; int dry;
    __device__ __forceinline__ void operator()(const f32x4 (&acc)[2][2][4][2], const Unit& u, int wr, int wc, int fr, int fq) const {
        const int row0 = u.pm * BM + wr * 64 + fr, col0 = u.pn * BM + wc * 32 + 4 * fq;
#pragma unroll
        for (int ai = 0; ai < 2; ++ai) {
            u32x2 hv[4][2][2], pv[4][2][2]; float rs[4];
#pragma unroll
            for (int m = 0; m < 4; ++m) rs[m] = RS[row0 + ai * HALF + m * 16];
#pragma unroll
            for (int m = 0; m < 4; ++m)
#pragma unroll
                for (int bj = 0; bj < 2; ++bj)
#pragma unroll
                    for (int n = 0; n < 2; ++n) { const size_t o2 = (size_t)(row0 + ai * HALF + m * 16) * 1024 + col0 + bj * HALF + n * 16; hv[m][bj][n] = *(const u32x2*)(H2B + o2); pv[m][bj][n] = *(const u32x2*)(PLE + o2); }
#pragma unroll
            for (int m = 0; m < 4; ++m) { const int row = row0 + ai * HALF + m * 16; const size_t off = (size_t)row * 1024 + col0; float s = 0.f;
#pragma unroll
                for (int bj = 0; bj < 2; ++bj)
#pragma unroll
                    for (int n = 0; n < 2; ++n) { const size_t o2 = off + bj * HALF + n * 16; const u32x2 h2 = hv[m][bj][n], p2 = pv[m][bj][n];
                        const f32x4 a = acc[ai][bj][m][n] * rs[m]; f32x4 h;
                        h[0] = bf_lo(h2.x) + bf_lo(p2.x) * fast_sigmoid(a[0]); h[1] = bf_hi(h2.x) + bf_hi(p2.x) * fast_sigmoid(a[1]);
                        h[2] = bf_lo(h2.y) + bf_lo(p2.y) * fast_sigmoid(a[2]); h[3] = bf_hi(h2.y) + bf_hi(p2.y) * fast_sigmoid(a[3]);
                        u32x2 w; w.x = cvtpk(h[0], h[1]); w.y = cvtpk(h[2], h[3]); if (!dry) *(u32x2*)(H3B + o2) = w;
                        s += (h[0] * h[0] + h[1] * h[1]) + (h[2] * h[2] + h[3] * h[3]); }
                s += __shfl_xor(s, 16); s += __shfl_xor(s, 32);
                if (fq == 0) SSQ[(size_t)row * 16 + u.pn * 4 + wc] = s; }
        }
    }
};
constexpr int H3L_PITCH = 544;
struct EpiH3L {
    static constexpr bool PERM = true, ACCUM = false;
    const bf16_t* H2B; const bf16_t* PLE; const float* RS; LAS unsigned char* tile; float* SSQ;
    __device__ __forceinline__ void operator()(const f32x4 (&acc)[2][2][4][2], const Unit& u, int wr, int wc, int fr, int fq) const {
        const int lrow0 = wr * 64 + fr, lcol0 = wc * 32 + 8 * fq, row0 = u.pm * BM + lrow0, col0 = u.pn * BM + lcol0;
        asm volatile("s_waitcnt vmcnt(0)" ::: "memory"); __builtin_amdgcn_s_barrier();
#pragma unroll
        for (int ai = 0; ai < 2; ++ai) {
            u32x4 hv[4][2], pv[4][2]; float rs[4];
#pragma unroll
            for (int m = 0; m < 4; ++m) rs[m] = RS[row0 + ai * HALF + m * 16];
#pragma unroll
            for (int m = 0; m < 4; ++m)
#pragma unroll
                for (int bj = 0; bj < 2; ++bj) { const size_t o2 = (size_t)(row0 + ai * HALF + m * 16) * 1024 + col0 + bj * HALF; hv[m][bj] = *(const u32x4*)(H2B + o2); pv[m][bj] = *(const u32x4*)(PLE + o2); }
#pragma unroll
            for (int m = 0; m < 4; ++m) { const int lrow = lrow0 + ai * HALF + m * 16; float s = 0.f;
#pragma unroll
                for (int bj = 0; bj < 2; ++bj) { const u32x4 h4 = hv[m][bj], p4 = pv[m][bj];
                    const f32x4 a0 = acc[ai][bj][m][0] * rs[m], a1 = acc[ai][bj][m][1] * rs[m]; float h[8];
                    h[0] = bf_lo(h4.x) + bf_lo(p4.x) * fast_sigmoid(a0[0]); h[1] = bf_hi(h4.x) + bf_hi(p4.x) * fast_sigmoid(a0[1]);
                    h[2] = bf_lo(h4.y) + bf_lo(p4.y) * fast_sigmoid(a0[2]); h[3] = bf_hi(h4.y) + bf_hi(p4.y) * fast_sigmoid(a0[3]);
                    h[4] = bf_lo(h4.z) + bf_lo(p4.z) * fast_sigmoid(a1[0]); h[5] = bf_hi(h4.z) + bf_hi(p4.z) * fast_sigmoid(a1[1]);
                    h[6] = bf_lo(h4.w) + bf_lo(p4.w) * fast_sigmoid(a1[2]); h[7] = bf_hi(h4.w) + bf_hi(p4.w) * fast_sigmoid(a1[3]);
                    u32x4 w; w.x = cvtpk(h[0], h[1]); w.y = cvtpk(h[2], h[3]); w.z = cvtpk(h[4], h[5]); w.w = cvtpk(h[6], h[7]);
                    *(LAS u32x4*)(tile + lrow * H3L_PITCH + (lcol0 + bj * HALF) * 2) = w;
                    s += ((h[0] * h[0] + h[1] * h[1]) + (h[2] * h[2] + h[3] * h[3])) + ((h[4] * h[4] + h[5] * h[5]) + (h[6] * h[6] + h[7] * h[7])); }
                s += __shfl_xor(s, 16); s += __shfl_xor(s, 32);
                if (fq == 0) SSQ[(size_t)(u.pm * BM + lrow) * 16 + u.pn * 4 + wc] = s; }
        }
    }
};
}
constexpr size_t MiB = 1u << 20;
constexpr size_t WS_CTL = 0, CTL_ZERO_BYTES = 64 * 1024;
constexpr size_t WS_PEND = 64 * 1024;
constexpr size_t WS_WPLE = 512 * 1024;
constexpr size_t WS_KD = 1 * MiB;
constexpr size_t WS_GLAG = 2 * MiB;
constexpr size_t WS_WIN = 3 * MiB;
constexpr size_t WS_SEND = 4 * MiB;
constexpr size_t WS_EXP = 4 * MiB;
constexpr size_t WS_SSQ1 = 13 * MiB;
constexpr size_t WS_SSQ3 = 14 * MiB;
constexpr size_t WS_RS3 = 15 * MiB;
constexpr size_t WS_RSU = 1536 * 1024, WS_RSV = 1536 * 1024 + 64 * 1024;
constexpr size_t WS_WGA = 20 * MiB, WS_WSB = 22 * MiB, WS_WO = 24 * MiB, WS_WPG = 26 * MiB, WS_WPQ = 28 * MiB;
constexpr size_t WS_A = 32 * MiB;
constexpr size_t WS_GQ = WS_A, WS_GK = WS_A + 16 * MiB;
constexpr size_t WS_B = 64 * MiB;
constexpr size_t WS_GV = WS_B, WS_PB = WS_B;
constexpr size_t WS_C = 96 * MiB;
constexpr size_t WS_GR = WS_C, WS_GLAN = WS_C, WS_H1 = WS_C, WS_H3B = WS_C;
constexpr size_t WS_D = 128 * MiB;
constexpr size_t WS_SQ = WS_D, WS_H2B = WS_D;
constexpr size_t WS_E = 160 * MiB;
constexpr size_t WS_SK = WS_E, WS_MIX = WS_E, WS_Q = WS_E, WS_PLE = WS_E;
constexpr size_t WS_F = 192 * MiB;
constexpr size_t WS_SV = WS_F;
constexpr size_t WS_G = 224 * MiB;
constexpr size_t WS_XN1 = WS_G, WS_UB8 = WS_G, WS_VB8 = WS_G + 16 * MiB;
constexpr size_t WS_END = 256 * MiB;

constexpr int NWAVES = 8;
constexpr int RING_OFF = 0, RING_BYTES = 131072;
constexpr int MISC_OFF = 143360;
constexpr int LDS_BYTES = 147456;
constexpr int CW_BAR = 1024;
constexpr int CW_ROWCNT = 512;

typedef GAS unsigned gu32;
#define RLX_AGENT __ATOMIC_RELAXED, __HIP_MEMORY_SCOPE_AGENT
#define LDS_WAIT() asm volatile("s_waitcnt lgkmcnt(0)" ::: "memory")
#define VM_WAIT() asm volatile("s_waitcnt vmcnt(0)" ::: "memory")

#define XB_TMO      128
#define XB_XCNT(j)  (256  + 64 * (j))
#define XB_XSUB(j)  (1280 + 64 * (j))
#define XB_XGEN(j)  (2304 + 64 * (j))
#define XB_TOP      3328
#define XB_TOPGEN   3392
#define XCD_BAR_WORDS 3456
#define XB_SPIN_CAP (1u << 22)
__device__ __forceinline__ unsigned xb_ld(unsigned* p)              { return __hip_atomic_load(p, __ATOMIC_RELAXED, __HIP_MEMORY_SCOPE_AGENT); }
__device__ __forceinline__ unsigned xb_add(unsigned* p, unsigned v) { return __hip_atomic_fetch_add(p, v, __ATOMIC_RELAXED, __HIP_MEMORY_SCOPE_AGENT); }
__device__ __forceinline__ unsigned xb_xcc_id() { return (unsigned)__builtin_amdgcn_s_getreg((3 << 11) | 20) & 0xFu; }
#define XB_SPIN(cond, bar) do { unsigned _sp = 0; while (cond) { __builtin_amdgcn_s_sleep(1); \
    if ((++_sp & 255u) == 0u) { if (xb_ld(&(bar)[XB_TMO])) break; if (_sp > XB_SPIN_CAP) { atomicAdd(&(bar)[XB_TMO], 1u); break; } } } } while (0)
struct XcdBarrier { unsigned* bar; unsigned x; volatile LAS unsigned* st; };
__device__ __forceinline__ XcdBarrier xcd_barrier_post(unsigned* bar, volatile LAS unsigned* st, int tid) {
    XcdBarrier b; b.bar = bar; b.x = xb_xcc_id(); b.st = st;
    if (tid == 0) (void)xb_add(&bar[XB_XCNT(b.x)], 1u);
    return b;
}
__device__ __forceinline__ void xcd_barrier_complete(unsigned* bar, unsigned x, unsigned& nloc, unsigned& nx) {
    const unsigned G = gridDim.x * gridDim.y * gridDim.z;
    unsigned sum, cnt, mine, sp = 0u;
    for (;;) {
        sum = 0u; cnt = 0u; mine = 0u;
#pragma unroll
        for (unsigned j = 0; j < 16; ++j) { const unsigned c = xb_ld(&bar[XB_XCNT(j)]); sum += c; cnt += (c > 0u) ? 1u : 0u; mine = (j == x) ? c : mine; }
        if (sum == G) break;
        __builtin_amdgcn_s_sleep(1);
        if ((++sp & 255u) == 0u) { if (xb_ld(&bar[XB_TMO])) break; if (sp > XB_SPIN_CAP) { atomicAdd(&bar[XB_TMO], 1u); break; } }
    }
    nloc = mine > 0u ? mine : 1u; nx = cnt > 0u ? cnt : 1u;
}
__device__ __forceinline__ void xcd_barrier(const XcdBarrier& b, int tid) {
    asm volatile("s_waitcnt vmcnt(0)" ::: "memory");
    __syncthreads();
    if (tid == 0) {
        unsigned* bar = b.bar;
        __builtin_amdgcn_s_waitcnt(0);
        unsigned nloc = b.st[0], nx = b.st[1];
        if (nloc == 0u) { xcd_barrier_complete(bar, b.x, nloc, nx); b.st[0] = nloc; b.st[1] = nx; }
        const unsigned old = xb_add(&bar[XB_XSUB(b.x)], 1u);
        const unsigned gen = old / nloc;
        if (old + 1u == (gen + 1u) * nloc) {
            __builtin_amdgcn_fence(__ATOMIC_RELEASE, "agent");
            asm volatile("s_waitcnt vmcnt(0)" ::: "memory");
            const unsigned og = xb_add(&bar[XB_TOP], 1u);
            const unsigned tg = og / nx;
            if (og + 1u == (tg + 1u) * nx) xb_add(&bar[XB_TOPGEN], 1u);
            else XB_SPIN(xb_ld(&bar[XB_TOPGEN]) == tg, bar);
            __builtin_amdgcn_fence(__ATOMIC_ACQUIRE, "agent");
            xb_add(&bar[XB_XGEN(b.x)], 1u);
            asm volatile("s_waitcnt vmcnt(0)" ::: "memory");
        } else {
            XB_SPIN(xb_ld(&bar[XB_XGEN(b.x)]) == gen, bar);
            __builtin_amdgcn_fence(__ATOMIC_ACQUIRE, "agent");
            asm volatile("s_waitcnt vmcnt(0)" ::: "memory");
        }
    }
    __syncthreads();
}

struct Frame {
    LAS unsigned char* lds;
    int tid, lane, wave, vcu, G, dry;
    const float* const* in; float* out; unsigned char* ws;
};
__device__ __forceinline__ int lane_id() { int l; asm volatile("v_mbcnt_lo_u32_b32 %0, -1, 0\n\tv_mbcnt_hi_u32_b32 %0, -1, %0" : "=v"(l)); return l; }
#define WSP(T, off) ((T*)(F.ws + (off)))
__device__ __forceinline__ float wave_sum(float v) {
#pragma unroll
    for (int o = 1; o < 64; o <<= 1) v += __shfl_xor(v, o);
    return v;
}
template <class RowMap>
__device__ __forceinline__ void p0_transpose_item(const float* W, int K, int N, bf16_t* WT, RowMap rm, LAS float* scr, int item, int lane, const float* gk = nullptr) {
    const int nblk = (N + 31) / 32, kb = item / nblk, nb = item % nblk, k0 = 64 * kb, n0 = 32 * nb;
    { const int kr = lane >> 3, c4 = lane & 7, nl = n0 + 4 * c4; f32x4 v[8];
#pragma unroll
      for (int i = 0; i < 8; ++i) v[i] = (nl < N) ? *(const f32x4*)(W + (size_t)(k0 + 8 * i + kr) * N + nl) : (f32x4){0.f, 0.f, 0.f, 0.f};
#pragma unroll
      for (int i = 0; i < 8; ++i) { LAS float* d = scr + (8 * i + kr) * 33 + 4 * c4; d[0] = v[i][0]; d[1] = v[i][1]; d[2] = v[i][2]; d[3] = v[i][3]; } }
    LDS_WAIT(); asm volatile("" ::: "memory");
    const int c = lane & 7;
#pragma unroll
    for (int j = 0; j < 4; ++j) { const int n = (lane >> 3) + 8 * j; const LAS float* s = scr + (8 * c) * 33 + n;
        f32x4 ga = (f32x4){1.f, 1.f, 1.f, 1.f}, gb = ga; if (gk) { ga = *(const f32x4*)(gk + k0 + 8 * c); gb = *(const f32x4*)(gk + k0 + 8 * c + 4); }
        u32x4 o; o.x = cvtpk(s[0 * 33] * ga[0], s[1 * 33] * ga[1]); o.y = cvtpk(s[2 * 33] * ga[2], s[3 * 33] * ga[3]); o.z = cvtpk(s[4 * 33] * gb[0], s[5 * 33] * gb[1]); o.w = cvtpk(s[6 * 33] * gb[2], s[7 * 33] * gb[3]);
        if (n0 + n < N) st_nt<NT_PRE>(o, (u32x4*)(WT + (size_t)rm(n0 + n) * K + k0 + 8 * c)); }
    LDS_WAIT(); asm volatile("" ::: "memory");
}
struct RmId { __device__ __forceinline__ int operator()(int n) const { return n; } };
struct RmWin { __device__ __forceinline__ int operator()(int n) const { return n < 3072 ? n : (n < 3088 ? 8192 + (n - 3072) : n - 16); } };

__device__ __forceinline__ void cvt_copy(Frame& F, const float* src, bf16_t* dst, size_t n) {
    const size_t nth = (size_t)F.G * 512, n8 = n / 8;
    for (size_t i = (size_t)F.vcu * 512 + F.tid; i < n8; i += nth) {
        const f32x4 a = *(const f32x4*)(src + i * 8), b = *(const f32x4*)(src + i * 8 + 4);
        u32x4 o; o.x = cvtpk(a[0], a[1]); o.y = cvtpk(a[2], a[3]); o.z = cvtpk(b[0], b[1]); o.w = cvtpk(b[2], b[3]);
        st_nt<NT_PRE>(o, (u32x4*)(dst + i * 8)); }
}
__device__ __forceinline__ void rms_row_to_bf16(const float* xrow, const float* g, bf16_t* orow, int lane) {
    f32x4 v[4]; float s = 0.f;
#pragma unroll
    for (int j = 0; j < 4; ++j) { v[j] = *((const f32x4*)xrow + lane + 64 * j); s += (v[j][0] * v[j][0] + v[j][1] * v[j][1]) + (v[j][2] * v[j][2] + v[j][3] * v[j][3]); }
    const float rstd = __builtin_amdgcn_rsqf(wave_sum(s) * (1.f / 1024.f) + EPS);
#pragma unroll
    for (int j = 0; j < 4; ++j) { const f32x4 gv = *((const f32x4*)g + lane + 64 * j); const f32x4 o = v[j] * rstd * gv;
        u32x2 w; w.x = cvtpk(o[0], o[1]); w.y = cvtpk(o[2], o[3]); *((u32x2*)orow + lane + 64 * j) = w; }
}
__device__ __forceinline__ void phase_prologue(Frame& F) {
    LAS float* scr = (LAS float*)(F.lds + RING_OFF + F.wave * 16384);
    const int gw = F.vcu * NWAVES + F.wave, NGW = F.G * NWAVES;
    constexpr int I_IN = 16 * 257, I_SQ = 16 * 32, I_PQ = 16 * 64, I_PLE = 4 * 32;
    constexpr int NITEMS = I_IN + 4 * I_SQ + I_PQ + I_PLE;
    for (int it = gw; it < NITEMS; it += NGW) {
        int r = it;
        if (r < I_IN) { p0_transpose_item(F.in[3], 1024, 8208, WSP(bf16_t, WS_WIN), RmWin(), scr, r, F.lane); continue; } r -= I_IN;
        if (r < I_SQ) { p0_transpose_item(F.in[7], 1024, 1024, WSP(bf16_t, WS_WGA), RmId(), scr, r, F.lane); continue; } r -= I_SQ;
        if (r < I_SQ) { p0_transpose_item(F.in[8], 1024, 1024, WSP(bf16_t, WS_WSB), RmId(), scr, r, F.lane); continue; } r -= I_SQ;
        if (r < I_SQ) { p0_transpose_item(F.in[9], 1024, 1024, WSP(bf16_t, WS_WO), RmId(), scr, r, F.lane); continue; } r -= I_SQ;
        if (r < I_SQ) { p0_transpose_item(F.in[17], 1024, 1024, WSP(bf16_t, WS_WPG), RmId(), scr, r, F.lane, F.in[16]); continue; } r -= I_SQ;
        if (r < I_PQ) { p0_transpose_item(F.in[11], 1024, 2048, WSP(bf16_t, WS_WPQ), RmId(), scr, r, F.lane, F.in[10]); continue; } r -= I_PQ;
        p0_transpose_item(F.in[18], 256, 1024, WSP(bf16_t, WS_WPLE), RmId(), scr, r, F.lane);
    }
    { const float* k1 = F.in[12]; const float* k2 = F.in[13]; bf16_t* KB = WSP(bf16_t, WS_KD);
      for (int i = F.vcu * 512 + F.tid; i < 2 * 8 * 128 * 16; i += F.G * 512) { const int half = i >> 14, rem = i & 16383, h = rem >> 11, r8 = rem & 2047;
          const float* s = (half ? k2 : k1) + (size_t)h * 16384 + (size_t)r8 * 8; const f32x4 a = *(const f32x4*)s, b = *(const f32x4*)(s + 4);
          u32x4 o; o.x = cvtpk(a[0], a[1]); o.y = cvtpk(a[2], a[3]); o.z = cvtpk(b[0], b[1]); o.w = cvtpk(b[2], b[3]);
          *(u32x4*)(KB + (size_t)(h * 2 + half) * 16384 + (size_t)r8 * 8) = o; } }
    for (int m = gw; m < T_TOK; m += 4 * NGW) {
        f32x4 v[4][4]; float s[4];
#pragma unroll
        for (int q = 0; q < 4; ++q) { const float* xr = F.in[0] + (size_t)(m + q * NGW) * 1024; s[q] = 0.f;
#pragma unroll
            for (int j = 0; j < 4; ++j) { v[q][j] = *((const f32x4*)xr + F.lane + 64 * j); s[q] += (v[q][j][0] * v[q][j][0] + v[q][j][1] * v[q][j][1]) + (v[q][j][2] * v[q][j][2] + v[q][j][3] * v[q][j][3]); } }
#pragma unroll
        for (int o = 1; o < 64; o <<= 1) {
#pragma unroll
            for (int q = 0; q < 4; ++q) s[q] += __shfl_xor(s[q], o); }
#pragma unroll
        for (int q = 0; q < 4; ++q) { const float rstd = __builtin_amdgcn_rsqf(s[q] * (1.f / 1024.f) + EPS); bf16_t* orow = WSP(bf16_t, WS_XN1) + (size_t)(m + q * NGW) * 1024;
#pragma unroll
            for (int j = 0; j < 4; ++j) { const f32x4 gv = *((const f32x4*)F.in[2] + F.lane + 64 * j); const f32x4 o = v[q][j] * rstd * gv;
                u32x2 wq; wq.x = cvtpk(o[0], o[1]); wq.y = cvtpk(o[2], o[3]); st_nt<NT_PRE>(wq, (u32x2*)orow + F.lane + 64 * j); } }
    }
}

__device__ __forceinline__ void phase_gla_prep(Frame& F) {
    LAS float* alo = (LAS float*)(F.lds + RING_OFF);
    const bf16_t* XN1 = WSP(bf16_t, WS_XN1); const bf16_t* WGAT = WSP(bf16_t, WS_WIN) + (size_t)8192 * 1024;
    bf16_t* GKT = WSP(bf16_t, WS_GK); float* GLAG = WSP(float, WS_GLAG);
    const float* w_up = F.in[4]; const float* b_a = F.in[5];
    const int tid = F.tid, lane = F.lane, w = F.wave;
    for (int u = F.vcu; u < 256; u += F.G) {
        const size_t r0 = (size_t)u * 64;
        __syncthreads();
        const int kk = tid;
        bf16_t* krow = GKT + (size_t)kk * T_TOK + r0;
        u32x4 kq[8];
#pragma unroll
        for (int j = 0; j < 8; ++j) kq[j] = *(const u32x4*)(krow + 8 * j);
        {
            LAS float* part = alo + 1024;
            const bf16_t* bp = WGAT + (size_t)(lane & 15) * 1024 + 8 * (lane >> 4) + 128 * w;
            bf16x8 bq[4];
#pragma unroll
            for (int s = 0; s < 4; ++s) bq[s] = *(const bf16x8*)(bp + 32 * s);
#pragma unroll
            for (int rt = 0; rt < 4; ++rt) { f32x4 acc = (f32x4){0.f, 0.f, 0.f, 0.f};
                const bf16_t* ap = XN1 + (r0 + 16 * rt + (lane & 15)) * 1024 + 8 * (lane >> 4) + 128 * w;
#pragma unroll
                for (int s = 0; s < 4; ++s) { const bf16x8 a = *(const bf16x8*)(ap + 32 * s); acc = __builtin_amdgcn_mfma_f32_16x16x32_bf16(a, bq[s], acc, 0, 0, 0); }
#pragma unroll
                for (int r = 0; r < 4; ++r) part[w * 1024 + (16 * rt + 4 * (lane >> 4) + r) * 16 + (lane & 15)] = acc[r]; }
            __syncthreads();
#pragma unroll
            for (int q = 0; q < 2; ++q) { const int e = tid + 512 * q; float s = 0.f;
#pragma unroll
                for (int ww = 0; ww < 8; ++ww) s += part[ww * 1024 + e];
                alo[e] = s; }
        }
        float wv[16];
#pragma unroll
        for (int r = 0; r < 16; ++r) wv[r] = w_up[r * 512 + kk];
        const float bias = b_a[kk];
        __syncthreads();
        float suffix = 0.f;
#pragma unroll
        for (int i8 = 7; i8 >= 0; --i8) {
            const unsigned kw[4] = {kq[i8].x, kq[i8].y, kq[i8].z, kq[i8].w};
            float o[8];
#pragma unroll
            for (int j = 7; j >= 0; --j) { const int i = i8 * 8 + j;
                const f32x4 a0 = *(const LAS f32x4*)(alo + i * 16), a1 = *(const LAS f32x4*)(alo + i * 16 + 4), a2 = *(const LAS f32x4*)(alo + i * 16 + 8), a3 = *(const LAS f32x4*)(alo + i * 16 + 12);
                float x = bias;
                x += a0[0] * wv[0] + a0[1] * wv[1] + a0[2] * wv[2] + a0[3] * wv[3];
                x += a1[0] * wv[4] + a1[1] * wv[5] + a1[2] * wv[6] + a1[3] * wv[7];
                x += a2[0] * wv[8] + a2[1] * wv[9] + a2[2] * wv[10] + a2[3] * wv[11];
                x += a3[0] * wv[12] + a3[1] * wv[13] + a3[2] * wv[14] + a3[3] * wv[15];
                const float la = (fminf(x, 0.f) - __logf(1.0f + __expf(-fabsf(x)))) * (1.0f / 16.0f);
                const float kvv = (j & 1) ? bf_hi(kw[j >> 1]) : bf_lo(kw[j >> 1]);
                o[j] = kvv * __expf(suffix);
                suffix += la; }
            u32x4 pk; pk.x = cvtpk(o[0], o[1]); pk.y = cvtpk(o[2], o[3]); pk.z = cvtpk(o[4], o[5]); pk.w = cvtpk(o[6], o[7]);
            if (!F.dry) st_nt<NT_PRE>(pk, (u32x4*)(krow + i8 * 8)); }
        GLAG[(size_t)u * 512 + kk] = __expf(suffix);
    }
}
constexpr int GL_KD = 0, GL_Q = 32768, GL_G = 65536, GL_RED = 65536 + 1024, GL_OT = 65536 + 1024 + 4096, GL_OT_PITCH = 260;
__device__ __forceinline__ int gl_kd_off(int row, int chunk) { return row * 128 + ((chunk ^ ((row >> 1) & 7)) << 4); }
__device__ __forceinline__ int gl_q_off(int row, int chunk16) { return row * 256 + ((chunk16 ^ (row & 15)) << 4); }

struct GlaStage { u32x4 kd[2]; u32x4 q[2]; bf16x8 vt[4]; float g; };
__device__ __forceinline__ void gla_prefetch_vt(Frame& F, GlaStage& st, int b, int h, int c) {
    const int u = b * 64 + c; const size_t r0 = (size_t)u * 64; const int w = F.wave, lq = F.lane & 31, hh = F.lane >> 5;
    const bf16_t* vt = WSP(bf16_t, WS_GV) + (size_t)(h * 256 + 32 * w + lq) * T_TOK + r0;
#pragma unroll
    for (int ts = 0; ts < 4; ++ts) st.vt[ts] = *(const bf16x8*)(vt + 16 * ts + 8 * hh);
}
template <bool WITH_Q>
__device__ __forceinline__ void gla_prefetch(Frame& F, GlaStage& st, int b, int h, int c) {
    const int u = b * 64 + c; const size_t r0 = (size_t)u * 64; const int tid = F.tid;
    const bf16_t* kd = WSP(bf16_t, WS_GK) + (size_t)(h * 128) * T_TOK + r0;
#pragma unroll
    for (int j = 0; j < 2; ++j) { const int pi = tid + 512 * j; st.kd[j] = *(const u32x4*)(kd + (size_t)(pi >> 3) * T_TOK + (pi & 7) * 8); }
    if (WITH_Q) { const bf16_t* gq = WSP(bf16_t, WS_GQ) + r0 * 512 + h * 128;
#pragma unroll
        for (int j = 0; j < 2; ++j) { const int pi = tid + 512 * j; st.q[j] = *(const u32x4*)(gq + (size_t)(pi >> 4) * 512 + (pi & 15) * 8); } }
    st.g = (tid < 128) ? WSP(float, WS_GLAG)[((size_t)u * 4 + h) * 128 + tid] : 1.f;
}
template <bool WITH_Q>
__device__ __forceinline__ void gla_stage_write(Frame& F, const GlaStage& st, int buf) {
    LAS unsigned char* lds = F.lds + RING_OFF; const int tid = F.tid;
#pragma unroll
    for (int j = 0; j < 2; ++j) { const int pi = tid + 512 * j; *(LAS u32x4*)(lds + GL_KD + buf * 16384 + gl_kd_off(pi >> 3, pi & 7)) = st.kd[j]; }
    if (WITH_Q) {
#pragma unroll
        for (int j = 0; j < 2; ++j) { const int pi = tid + 512 * j; *(LAS u32x4*)(lds + GL_Q + buf * 16384 + gl_q_off(pi >> 4, pi & 15)) = st.q[j]; } }
    if (tid < 128) *(LAS float*)(lds + GL_G + buf * 512 + tid * 4) = st.g;
}
__device__ __forceinline__ void gla_update(Frame& F, f32x16 (&S)[4], const bf16x8 (&vt)[4], int buf) {
    const LAS unsigned char* lds = F.lds + RING_OFF; const int lq = F.lane & 31, hh = F.lane >> 5;
    const LAS float* G = (const LAS float*)(lds + GL_G + buf * 512);
#pragma unroll
    for (int kt = 0; kt < 4; ++kt)
#pragma unroll
        for (int g4 = 0; g4 < 4; ++g4) { const f32x4 g = *(const LAS f32x4*)(G + 32 * kt + 8 * g4 + 4 * hh);
#pragma unroll
            for (int j = 0; j < 4; ++j) S[kt][4 * g4 + j] *= g[j]; }
#pragma unroll
    for (int ts = 0; ts < 4; ++ts)
#pragma unroll
        for (int kt = 0; kt < 4; ++kt) { const bf16x8 a = *(const LAS bf16x8*)(lds + GL_KD + buf * 16384 + gl_kd_off(32 * kt + lq, 2 * ts + hh));
            S[kt] = __builtin_amdgcn_mfma_f32_32x32x16_bf16(a, vt[ts], S[kt], 0, 0, 0); if (kt == 3 && (ts & 1)) __builtin_amdgcn_sched_barrier(0); }
}
constexpr size_t SEND_WAVE_FLOATS = 4 * 4 * 64 * 4;
__device__ __forceinline__ void gla_stage1(Frame& F, int unit) {
    const int bh = unit >> 3, seg = unit & 7, b = bh >> 2, h = bh & 3, w = F.wave, l = F.lane;
    f32x16 S[4];
#pragma unroll
    for (int kt = 0; kt < 4; ++kt)
#pragma unroll
        for (int r = 0; r < 16; ++r) S[kt][r] = 0.f;
    float pend = 1.f;
    GlaStage st; gla_prefetch<false>(F, st, b, h, seg * 8); gla_prefetch_vt(F, st, b, h, seg * 8);
    for (int ci = 0; ci < 8; ++ci) {
        gla_stage_write<false>(F, st, ci & 1); pend *= st.g;
        __syncthreads();
        if (ci < 7) gla_prefetch<false>(F, st, b, h, seg * 8 + ci + 1);
        gla_update(F, S, st.vt, ci & 1);
        if (ci < 7) gla_prefetch_vt(F, st, b, h, seg * 8 + ci + 1);
    }
    float* se = WSP(float, WS_SEND) + ((size_t)unit * 8 + w) * SEND_WAVE_FLOATS;
#pragma unroll
    for (int kt = 0; kt < 4; ++kt)
#pragma unroll
        for (int g4 = 0; g4 < 4; ++g4) st_nt<NT_ATT>((f32x4){S[kt][4 * g4], S[kt][4 * g4 + 1], S[kt][4 * g4 + 2], S[kt][4 * g4 + 3]}, (f32x4*)(se + ((kt * 4 + g4) * 64 + l) * 4));
    if (F.tid < 128) WSP(float, WS_PEND)[unit * 128 + F.tid] = pend;
    __syncthreads();
}
__device__ __forceinline__ void gla_stage3(Frame& F, int unit) {
    const int bh = unit >> 3, seg = unit & 7, b = bh >> 2, h = bh & 3, w = F.wave, l = F.lane, lq = l & 31, hh = l >> 5;
    LAS unsigned char* lds = F.lds + RING_OFF;
    const bf16_t* GR = WSP(bf16_t, WS_GR); bf16_t* GLAN = WSP(bf16_t, WS_GLAN); const float* g_o = F.in[6];
    f32x16 S[4];
#pragma unroll
    for (int kt = 0; kt < 4; ++kt)
#pragma unroll
        for (int r = 0; r < 16; ++r) S[kt][r] = 0.f;
    GlaStage st; gla_prefetch<true>(F, st, b, h, seg * 8); gla_prefetch_vt(F, st, b, h, seg * 8);
    for (int sp = 0; sp < seg; ++sp) {
        const int un = bh * 8 + sp; const float* se = WSP(float, WS_SEND) + ((size_t)un * 8 + w) * SEND_WAVE_FLOATS; const float* pe = WSP(float, WS_PEND) + un * 128;
#pragma unroll
        for (int kt = 0; kt < 4; ++kt)
#pragma unroll
            for (int g4 = 0; g4 < 4; ++g4) { const f32x4 p = *(const f32x4*)(pe + 32 * kt + 8 * g4 + 4 * hh); const f32x4 s = *(const f32x4*)(se + ((kt * 4 + g4) * 64 + l) * 4);
#pragma unroll
                for (int j = 0; j < 4; ++j) S[kt][4 * g4 + j] = S[kt][4 * g4 + j] * p[j] + s[j]; }
    }
    const int tid = F.tid; u32x4 sr[4]; size_t pend_r0 = 0;
#define GLA_STORE_PASS(R0) do { const LAS float* otr = (const LAS float*)(lds + GL_OT) + (tid >> 3) * GL_OT_PITCH + 8 * (tid & 7); \
        _Pragma("unroll") for (int j = 0; j < 4; ++j) { const f32x4 a0 = *(const LAS f32x4*)(otr + 64 * j), a1 = *(const LAS f32x4*)(otr + 64 * j + 4); const u32x4 s4 = sr[j]; u32x4 wv; \
            wv.x = cvtpk(a0[0] * bf_lo(s4.x), a0[1] * bf_hi(s4.x)); wv.y = cvtpk(a0[2] * bf_lo(s4.y), a0[3] * bf_hi(s4.y)); wv.z = cvtpk(a1[0] * bf_lo(s4.z), a1[1] * bf_hi(s4.z)); wv.w = cvtpk(a1[2] * bf_lo(s4.w), a1[3] * bf_hi(s4.w)); \
            if (!F.dry) st_nt<NT_ATT>(wv, (u32x4*)(GLAN + ((R0) + (tid >> 3)) * 1024 + h * 256 + 8 * (tid & 7) + 64 * j)); } } while (0)
    for (int ci = 0; ci < 8; ++ci) {
        const int c = seg * 8 + ci; const size_t r0 = (size_t)(b * 64 + c) * 64; const int buf = ci & 1;
        gla_stage_write<true>(F, st, buf);
        __syncthreads();
        if (ci < 7) gla_prefetch<true>(F, st, b, h, c + 1);
        if (ci > 0) GLA_STORE_PASS(pend_r0);
        gla_update(F, S, st.vt, buf);
        f32x16 oT[2];
#pragma unroll
        for (int tt = 0; tt < 2; ++tt) {
#pragma unroll
            for (int r = 0; r < 16; ++r) oT[tt][r] = 0.f;
            const int t = 32 * tt + lq;
#pragma unroll
            for (int kt = 0; kt < 4; ++kt)
#pragma unroll
                for (int s = 0; s < 2; ++s) {
                    u32x4 aw; aw.x = cvtpk(S[kt][8 * s + 0], S[kt][8 * s + 1]); aw.y = cvtpk(S[kt][8 * s + 2], S[kt][8 * s + 3]); aw.z = cvtpk(S[kt][8 * s + 4], S[kt][8 * s + 5]); aw.w = cvtpk(S[kt][8 * s + 6], S[kt][8 * s + 7]);
                    const u32x2 qlo = *(const LAS u32x2*)(lds + GL_Q + buf * 16384 + gl_q_off(t, 4 * kt + 2 * s) + 8 * hh), qhi = *(const LAS u32x2*)(lds + GL_Q + buf * 16384 + gl_q_off(t, 4 * kt + 2 * s + 1) + 8 * hh);
                    const u32x4 bw = (u32x4){qlo.x, qlo.y, qhi.x, qhi.y};
                    oT[tt] = __builtin_amdgcn_mfma_f32_32x32x16_bf16(__builtin_bit_cast(bf16x8, aw), __builtin_bit_cast(bf16x8, bw), oT[tt], 0, 0, 0);
                    if (s == 1 && (kt & 1)) __builtin_amdgcn_sched_barrier(0); }
        }
        LAS float* redc = (LAS float*)(lds + GL_RED) + buf * 512;
#pragma unroll
        for (int tt = 0; tt < 2; ++tt) { float s = 0.f;
#pragma unroll
            for (int r = 0; r < 16; ++r) s += oT[tt][r] * oT[tt][r];
            s += __shfl_xor(s, 32);
            if (hh == 0) redc[w * 64 + 32 * tt + lq] = s; }
        if (ci < 7) gla_prefetch_vt(F, st, b, h, c + 1);
#pragma unroll
        for (int j = 0; j < 4; ++j) sr[j] = *(const u32x4*)(GR + (r0 + (tid >> 3)) * 1024 + h * 256 + 8 * (tid & 7) + 64 * j);
        __syncthreads();
        LAS float* ot = (LAS float*)(lds + GL_OT);
#pragma unroll
        for (int tt = 0; tt < 2; ++tt) { float tot = 0.f;
#pragma unroll
            for (int ww = 0; ww < 8; ++ww) tot += redc[ww * 64 + 32 * tt + lq];
            const float rstd = __builtin_amdgcn_rsqf(tot * (1.0f / 256.0f) + EPS);
#pragma unroll
            for (int g4 = 0; g4 < 4; ++g4) { const int vl = 32 * w + 8 * g4 + 4 * hh;
                const f32x4 go = *(const f32x4*)(g_o + h * 256 + vl);
                *(LAS f32x4*)(ot + (32 * tt + lq) * GL_OT_PITCH + vl) = (f32x4){oT[tt][4 * g4 + 0] * rstd * go[0], oT[tt][4 * g4 + 1] * rstd * go[1], oT[tt][4 * g4 + 2] * rstd * go[2], oT[tt][4 * g4 + 3] * rstd * go[3]}; } }
        pend_r0 = r0;
    }
    __syncthreads();
    GLA_STORE_PASS(pend_r0);
    __syncthreads();
#undef GLA_STORE_PASS
}

constexpr int SB_TILE = 16384, SB_FLAG = 7 * SB_TILE;
typedef short v4i16_t __attribute__((ext_vector_type(4)));
__device__ __forceinline__ s16x4 vtr(const LAS unsigned char* p) { return __builtin_bit_cast(s16x4, __builtin_amdgcn_ds_read_tr16_b64_v4i16((LAS v4i16_t*)p)); }
__device__ __forceinline__ float partner32(float x, int hh) { auto rr = __builtin_amdgcn_permlane32_swap(__float_as_uint(x), __float_as_uint(x), false, false); return __uint_as_float(hh ? rr[0] : rr[1]); }
__device__ __forceinline__ int sbk_off(int key, int chunk) { return key * 128 + ((chunk ^ ((key >> 1) & 7)) << 4); }
__device__ __forceinline__ int sbv_off(int key, int chunk) { return 8192 + key * 128 + ((chunk ^ (((key >> 1) & 1) << 2)) << 4); }

template <bool DIAG>
__device__ __forceinline__ void sb_tile_t(const LAS unsigned char* tile, int kt, int qabs, int l, const bf16x8 (&qf)[4], f32x16& o0, f32x16& o1, float& carry) {
    const int lq = l & 31, hh = l >> 5, g1 = (l >> 4) & 1, i = l & 15;
    float run = carry;
#pragma unroll
    for (int half = 1; half >= 0; --half) {
        f32x16 p;
#pragma unroll
        for (int r = 0; r < 16; ++r) p[r] = 0.f;
#pragma unroll
        for (int s = 0; s < 4; ++s) { const bf16x8 a = *(const LAS bf16x8*)(tile + sbk_off(32 * half + lq, 2 * s + hh)); p = __builtin_amdgcn_mfma_f32_32x32x16_bf16(a, qf[s], p, 0, 0, 0); }
        float st[16], be[16];
#pragma unroll
        for (int r = 0; r < 16; ++r) { const float ee = __builtin_amdgcn_exp2f(fminf(p[r], 80.0f)); float s_ = __builtin_amdgcn_rcpf(1.0f + ee); float b_ = ee * s_;
            if (DIAG) { const int key = 64 * kt + 32 * half + (r & 3) + 8 * (r >> 2) + 4 * hh; if (key >= qabs) { s_ = 1.0f; b_ = 0.f; } }
            st[r] = s_; be[r] = b_; }
        float tot[4];
#pragma unroll
        for (int g4 = 0; g4 < 4; ++g4) { float* sg = &st[4 * g4]; float* bg = &be[4 * g4];
            const float a2 = sg[3], a1 = sg[2] * a2, a0 = sg[1] * a1; tot[g4] = sg[0] * a0;
            bg[2] *= a2; bg[1] *= a1; bg[0] *= a0; }
        float E[4];
#pragma unroll
        for (int m = 3; m >= 0; --m) { const float tp = partner32(tot[m], hh); E[m] = hh ? run : run * tp; run *= tot[m] * tp; }
        u32x4 pw[2];
#pragma unroll
        for (int s = 0; s < 2; ++s) { float wv[8];
#pragma unroll
            for (int j = 0; j < 8; ++j) { const int r = 8 * s + j; wv[j] = be[r] * E[r >> 2]; }
            pw[s] = (u32x4){cvtpk(wv[0], wv[1]), cvtpk(wv[2], wv[3]), cvtpk(wv[4], wv[5]), cvtpk(wv[6], wv[7])}; }
#pragma unroll
        for (int s = 0; s < 2; ++s) { const bf16x8 pb = __builtin_bit_cast(bf16x8, pw[s]);
            const int k0 = 32 * half + 16 * s + 4 * hh + (i >> 2), k1 = k0 + 8;
#pragma unroll
            for (int dt = 0; dt < 2; ++dt) { const int ch = 4 * dt + 2 * g1 + ((i & 3) >> 1);
                const s16x4 lo = vtr(tile + sbv_off(k0, ch) + 8 * (i & 1)), hi = vtr(tile + sbv_off(k1, ch) + 8 * (i & 1));
                const bf16x8 a = (bf16x8){lo[0], lo[1], lo[2], lo[3], hi[0], hi[1], hi[2], hi[3]};
                if (dt == 0) o0 = __builtin_amdgcn_mfma_f32_32x32x16_bf16(a, pb, o0, 0, 0, 0); else o1 = __builtin_amdgcn_mfma_f32_32x32x16_bf16(a, pb, o1, 0, 0, 0); } }
        if (half == 1 && __all(run == 0.0f)) break;
    }
    carry = run;
}
__device__ __forceinline__ void sb_tile(const LAS unsigned char* tile, int kt, int q0, int qabs, int l, const bf16x8 (&qf)[4], f32x16& o0, f32x16& o1, float& carry) {
    if (64 * kt + 63 >= q0) sb_tile_t<true>(tile, kt, qabs, l, qf, o0, o1, carry); else sb_tile_t<false>(tile, kt, qabs, l, qf, o0, o1, carry);
}
__device__ __forceinline__ void sb_attn_unit(Frame& F, int uidx) {
    const int bh = uidx >> 4, qb = uidx & 15, b = bh >> 4, h = bh & 15;
    LAS unsigned char* lds = F.lds + RING_OFF;
    volatile LAS unsigned* flags = (volatile LAS unsigned*)(lds + SB_FLAG);
    const int tid = F.tid, w = F.wave, l = F.lane, lq = l & 31, hh = l >> 5;
    bf16_t* SQ = WSP(bf16_t, WS_SQ); const bf16_t* SK = WSP(bf16_t, WS_SK); const bf16_t* SV = WSP(bf16_t, WS_SV);
    const size_t rowbase = (size_t)b * SEQ;
    const int q0 = qb * 256 + 32 * w, qabs = q0 + lq;
    const int kt_hi = qb * 4 + 3, kt_lo = (qb * 4 - 3) > 0 ? (qb * 4 - 3) : 0, nwin = kt_hi - kt_lo + 1;
    const int skey = tid >> 3, sch = tid & 7;
    const bf16_t* kgd = SK + (rowbase + skey) * 1024 + h * 64 + ((sch ^ ((skey >> 1) & 7)) * 8);
    const bf16_t* vgd = SV + (rowbase + skey) * 1024 + h * 64 + ((sch ^ (((skey >> 1) & 1) << 2)) * 8);
    __syncthreads();
#pragma unroll
    for (int j = 0; j < 7; ++j) if (j < nwin) {
        __builtin_amdgcn_global_load_lds((const unsigned*)(kgd + (size_t)(kt_lo + j) * 64 * 1024), (LAS unsigned*)(lds + j * SB_TILE + w * 1024), 16, 0, 0);
        __builtin_amdgcn_global_load_lds((const unsigned*)(vgd + (size_t)(kt_lo + j) * 64 * 1024), (LAS unsigned*)(lds + j * SB_TILE + 8192 + w * 1024), 16, 0, 0); }
    bf16x8 qf[4];
    { const bf16_t* qrow = SQ + (rowbase + qabs) * 1024 + h * 64;
#pragma unroll
      for (int s = 0; s < 4; ++s) qf[s] = *(const bf16x8*)(qrow + 16 * s + 8 * hh); }
    f32x16 o0, o1;
#pragma unroll
    for (int r = 0; r < 16; ++r) { o0[r] = 0.f; o1[r] = 0.f; }
    float carry = 1.0f;
    VM_WAIT(); __syncthreads();
    bool done = false;
    for (int kt = (q0 + 30) >> 6; kt >= kt_lo; --kt) {
        sb_tile(lds + (kt - kt_lo) * SB_TILE, kt, q0, qabs, l, qf, o0, o1, carry);
        if (__all(carry == 0.0f)) { done = true; break; }
    }
    if (kt_lo == 0) done = true;
    if (l == 0) flags[w] = done ? 1u : 0u;
    __syncthreads();
    bool alld = true;
#pragma unroll
    for (int i = 0; i < 8; ++i) alld = alld && (flags[i] != 0u);
    if (!alld) {
        const bf16_t* kg = SK + (rowbase + skey) * 1024 + h * 64 + sch * 8;
        const bf16_t* vg = SV + (rowbase + skey) * 1024 + h * 64 + sch * 8;
        for (int kt = kt_lo - 1; kt >= 0; --kt) {
            const u32x4 kr = *(const u32x4*)(kg + (size_t)kt * 64 * 1024), vr = *(const u32x4*)(vg + (size_t)kt * 64 * 1024);
            __syncthreads();
            { unsigned a = 1u;
#pragma unroll
              for (int i = 0; i < 8; ++i) a &= flags[i];
              if (a) break; }
            *(LAS u32x4*)(lds + sbk_off(skey, sch)) = kr; *(LAS u32x4*)(lds + sbv_off(skey, sch)) = vr;
            __syncthreads();
            if (!done) { sb_tile(lds, kt, q0, qabs, l, qf, o0, o1, carry); if (__all(carry == 0.0f) || kt == 0) done = true; }
            if (l == 0) flags[w] = done ? 1u : 0u;
        }
    }
    if (!F.dry) { bf16_t* orow = SQ + (rowbase + qabs) * 1024 + h * 64;
#pragma unroll
      for (int g4 = 0; g4 < 4; ++g4) { u32x2 a, c2; a.x = cvtpk(o0[4 * g4], o0[4 * g4 + 1]); a.y = cvtpk(o0[4 * g4 + 2], o0[4 * g4 + 3]); c2.x = cvtpk(o1[4 * g4], o1[4 * g4 + 1]); c2.y = cvtpk(o1[4 * g4 + 2], o1[4 * g4 + 3]);
          st_nt<NT_ATT>(a, (u32x2*)(orow + 8 * g4 + 4 * hh)); st_nt<NT_ATT>(c2, (u32x2*)(orow + 32 + 8 * g4 + 4 * hh)); } }
}
#define CVT8_PK(V, S, W) do { int _x = __builtin_amdgcn_cvt_pk_fp8_f32((V)[0] * (S), (V)[1] * (S), 0, false); _x = __builtin_amdgcn_cvt_pk_fp8_f32((V)[2] * (S), (V)[3] * (S), _x, true); (W) = (unsigned)_x; } while (0)
__device__ __forceinline__ float absmax4(const f32x4& a) { return fmaxf(fmaxf(fabsf(a[0]), fabsf(a[1])), fmaxf(fabsf(a[2]), fabsf(a[3]))); }
constexpr int CVT8_UNITS = 256;
#ifndef QCONV
#define QCONV 1
#endif
__device__ __forceinline__ void cvt_fp8_unit(Frame& F, int cu) {
    const int l = F.lane, r0 = cu * 128 + F.wave * 16;
    const bool isv = r0 >= 16384; const int e0 = r0 & 16383;
    const float* src = isv ? F.in[15] : F.in[14]; unsigned char* dst = WSP(unsigned char, isv ? WS_VB8 : WS_UB8); float* rscale = WSP(float, isv ? WS_RSV : WS_RSU);
#pragma unroll 1
    for (int it = 0; it < 4; ++it) {
        f32x4 v[4][4]; float m[4];
#pragma unroll
        for (int q = 0; q < 4; ++q) { const f32x4* sp = (const f32x4*)(src + (size_t)(e0 + 4 * it + q) * 1024) + l;
#pragma unroll
            for (int j = 0; j < 4; ++j) v[q][j] = sp[64 * j]; }
#pragma unroll
        for (int q = 0; q < 4; ++q) m[q] = fmaxf(fmaxf(absmax4(v[q][0]), absmax4(v[q][1])), fmaxf(absmax4(v[q][2]), absmax4(v[q][3])));
#pragma unroll
        for (int o = 1; o < 64; o <<= 1) {
#pragma unroll
            for (int q = 0; q < 4; ++q) m[q] = fmaxf(m[q], __shfl_xor(m[q], o)); }
#pragma unroll
        for (int q = 0; q < 4; ++q) { const int e = e0 + 4 * it + q;
            const float t = 448.0f / fmaxf(m[q], 1e-30f); const float s = __uint_as_float(__float_as_uint(t) & 0x7f800000u);
            unsigned w[4]; CVT8_PK(v[q][0], s, w[0]); CVT8_PK(v[q][1], s, w[1]); CVT8_PK(v[q][2], s, w[2]); CVT8_PK(v[q][3], s, w[3]);
            if (!F.dry) { unsigned* dp = (unsigned*)(dst + (size_t)e * 1024) + l;
#pragma unroll
                for (int j = 0; j < 4; ++j) st_nt<NT_ATT>(w[j], dp + 64 * j);
                if (l == 0) rscale[e] = 1.0f / s; } }
    }
}
__device__ __forceinline__ void sb_units_dyn(Frame& F, unsigned* ctr, int sb_lo, int nsb, int conv_lo) {
    volatile LAS int* slot = (volatile LAS int*)(F.lds + MISC_OFF + 64);
    const int total = QCONV ? nsb + (nsb >> 2) : nsb;
    __syncthreads();
    if (F.tid == 0) *slot = (int)__hip_atomic_fetch_add(ctr, 1u, __ATOMIC_RELAXED, __HIP_MEMORY_SCOPE_AGENT);
    __syncthreads();
    int i = *slot;
    while (i < total) {
        int nxt = 0;
        if (F.tid == 0) nxt = (int)__hip_atomic_fetch_add(ctr, 1u, __ATOMIC_RELAXED, __HIP_MEMORY_SCOPE_AGENT);
        if (QCONV) { const int g = i / 5, r = i - 5 * g; if (r < 4) sb_attn_unit(F, sb_lo + 4 * g + r); else cvt_fp8_unit(F, conv_lo + g); }
        else sb_attn_unit(F, sb_lo + i);
        __syncthreads();
        if (F.tid == 0) *slot = nxt;
        __syncthreads();
        i = *slot;
    }
}
__device__ __forceinline__ void phase_attn_a(Frame& F) {
#ifdef CONV_PROBE_NWG
    if (F.dry) {
        if (F.vcu < CONV_PROBE_NWG) { volatile LAS int* slot = (volatile LAS int*)(F.lds + MISC_OFF + 64); unsigned* ctr = (unsigned*)(F.ws + WS_CTL) + 64 + 16;
            for (;;) { __syncthreads(); if (F.tid == 0) *slot = (int)__hip_atomic_fetch_add(ctr, 1u, __ATOMIC_RELAXED, __HIP_MEMORY_SCOPE_AGENT); __syncthreads(); const int i = *slot; if (i >= CVT8_UNITS) break; cvt_fp8_unit(F, i); } }
        return; }
#endif
    if (F.vcu < 128) gla_stage1(F, F.vcu);
    sb_units_dyn(F, (unsigned*)(F.ws + WS_CTL) + 64 + 16 * F.dry, 0, 384, 0);
    __syncthreads();
}
__device__ __forceinline__ void phase_attn_b(Frame& F) {
    if (F.vcu < 128) gla_stage3(F, F.vcu);
    sb_units_dyn(F, (unsigned*)(F.ws + WS_CTL) + 128 + 16 * F.dry, 384, 640, 96);
    __syncthreads();
}
__device__ __forceinline__ int okey(float v, int tag, int mask) { int u = __float_as_int(v); u ^= (u >> 31) & 0x7fffffff; return (u & ~mask) | tag; }
__device__ __forceinline__ float okey_val(int key, int mask) { int u = key & ~mask; u ^= (u >> 31) & 0x7fffffff; return __int_as_float(u); }
#define INS16(Lst, xin) do { int _x = (xin); _Pragma("unroll") for (int _j = 0; _j < 16; ++_j) { const int _h = max(Lst[_j], _x); _x = min(Lst[_j], _x); Lst[_j] = _h; } } while (0)

#define CEX(a, b) do { const int _hi = max(a, b), _lo = min(a, b); a = _hi; b = _lo; } while (0)
#define BITONIC16(K) do { \
    _Pragma("unroll") for (int _i = 0; _i < 8; ++_i) CEX(K[_i], K[_i + 8]); \
    _Pragma("unroll") for (int _b = 0; _b < 16; _b += 8) _Pragma("unroll") for (int _i = 0; _i < 4; ++_i) CEX(K[_b + _i], K[_b + _i + 4]); \
    _Pragma("unroll") for (int _b = 0; _b < 16; _b += 4) _Pragma("unroll") for (int _i = 0; _i < 2; ++_i) CEX(K[_b + _i], K[_b + _i + 2]); \
    _Pragma("unroll") for (int _b = 0; _b < 16; _b += 2) CEX(K[_b], K[_b + 1]); } while (0)
#define CEXD(a, b, d) do { const int _hi = max(a, b), _lo = min(a, b); a = (d) ? _hi : _lo; b = (d) ? _lo : _hi; } while (0)
#define FULLSORT16(K) do { \
    _Pragma("unroll") for (int _k = 2; _k <= 16; _k <<= 1) _Pragma("unroll") for (int _j = _k >> 1; _j >= 1; _j >>= 1) _Pragma("unroll") for (int _i = 0; _i < 16; ++_i) { \
        const int _p = _i ^ _j; if (_p > _i) { const bool _desc = ((_i & _k) == 0); CEXD(K[_i], K[_p], _desc); } } } while (0)
__device__ __forceinline__ int swap32i(int x) { auto r = __builtin_amdgcn_permlane32_swap((unsigned)x, (unsigned)x, false, false); return (int)((__builtin_amdgcn_mbcnt_hi(~0u, __builtin_amdgcn_mbcnt_lo(~0u, 0u)) & 32) ? r[0] : r[1]); }

__device__ __forceinline__ void phase_peer_retrieve(Frame& F) {
    const bf16_t* Q = WSP(bf16_t, WS_Q); const bf16_t* KB = WSP(bf16_t, WS_KD); unsigned* EXPO = WSP(unsigned, WS_EXP);
    LAS unsigned char* idxb = F.lds + RING_OFF + F.wave * 2048;
    const int l = F.lane, lq = l & 31, hh = l >> 5;
    const int ntok_wg = T_TOK / F.G;
#pragma unroll 1
    for (int it = F.wave; it < (ntok_wg / 32) * 8; it += NWAVES) {
        const int tg = it >> 3, h = it & 7;
        const int t = F.vcu * ntok_wg + tg * 32 + lq;
        int XY[2][16];
#pragma unroll
        for (int half = 0; half < 2; ++half) {
            bf16x8 qf[8];
            { const bf16_t* qp = Q + (size_t)t * 2048 + h * 256 + half * 128 + 8 * hh;
#pragma unroll
              for (int s = 0; s < 8; ++s) qf[s] = *(const bf16x8*)(qp + 16 * s); }
            int L[16];
#pragma unroll
            for (int j = 0; j < 16; ++j) L[j] = INT_MIN;
            const bf16_t* kp = KB + (size_t)(h * 2 + half) * 16384 + (size_t)lq * 128 + 8 * hh;
#pragma unroll 1
            for (int tile = 0; tile < 4; ++tile) {
                f32x16 acc; int Tk[16];
#pragma unroll
                for (int r = 0; r < 16; ++r) acc[r] = 0.f;
#pragma unroll
                for (int s = 0; s < 8; ++s) { const bf16x8 a = *(const bf16x8*)(kp + (size_t)tile * 32 * 128 + 16 * s); acc = __builtin_amdgcn_mfma_f32_32x32x16_bf16(a, qf[s], acc, 0, 0, 0); }
#pragma unroll
                for (int r = 0; r < 16; ++r) { const int key = 32 * tile + (r & 3) + 8 * (r >> 2) + 4 * hh; Tk[r] = okey(acc[r], 127 - key, 127); }
                FULLSORT16(Tk);
#pragma unroll
                for (int k = 0; k < 16; ++k) L[k] = max(L[k], Tk[15 - k]);
                BITONIC16(L);
            }
#pragma unroll
            for (int k = 0; k < 8; ++k) { const int a = swap32i(L[15 - k]), b = swap32i(L[k]); L[k] = max(L[k], a); L[15 - k] = max(L[15 - k], b); }
            BITONIC16(L);
#pragma unroll
            for (int j = 0; j < 16; ++j) XY[half][j] = L[j];
        }
        { u32x4 pk[2];
#pragma unroll
          for (int half = 0; half < 2; ++half) { const int* L = XY[half];
            pk[half].x = (unsigned)(127 - (L[0] & 127)) | ((unsigned)(127 - (L[1] & 127)) << 8) | ((unsigned)(127 - (L[2] & 127)) << 16) | ((unsigned)(127 - (L[3] & 127)) << 24);
            pk[half].y = (unsigned)(127 - (L[4] & 127)) | ((unsigned)(127 - (L[5] & 127)) << 8) | ((unsigned)(127 - (L[6] & 127)) << 16) | ((unsigned)(127 - (L[7] & 127)) << 24);
            pk[half].z = (unsigned)(127 - (L[8] & 127)) | ((unsigned)(127 - (L[9] & 127)) << 8) | ((unsigned)(127 - (L[10] & 127)) << 16) | ((unsigned)(127 - (L[11] & 127)) << 24);
            pk[half].w = (unsigned)(127 - (L[12] & 127)) | ((unsigned)(127 - (L[13] & 127)) << 8) | ((unsigned)(127 - (L[14] & 127)) << 16) | ((unsigned)(127 - (L[15] & 127)) << 24); }
          *(LAS u32x4*)(idxb + l * 32) = pk[0]; *(LAS u32x4*)(idxb + l * 32 + 16) = pk[1]; }
        float X[16], Y[16];
#pragma unroll
        for (int j = 0; j < 16; ++j) { X[j] = okey_val(XY[0][j], 127); Y[j] = okey_val(XY[1][j], 127); }
        int M[16];
#pragma unroll
        for (int j = 0; j < 16; ++j) M[j] = INT_MIN;
#define CAND(i, j) do { const float sm = hh ? (X[j] + Y[i]) : (X[i] + Y[j]); const int pos = hh ? ((j) * 16 + (i)) : ((i) * 16 + (j)); int key = okey(sm, 255 - pos, 255); if ((i) == (j) && hh) key = INT_MIN; INS16(M, key); } while (0)
        CAND(0, 0); CAND(0, 1); CAND(0, 2); CAND(0, 3); CAND(0, 4); CAND(0, 5); CAND(0, 6); CAND(0, 7); CAND(0, 8); CAND(0, 9); CAND(0, 10); CAND(0, 11); CAND(0, 12); CAND(0, 13); CAND(0, 14); CAND(0, 15);
        CAND(1, 1); CAND(1, 2); CAND(1, 3); CAND(1, 4); CAND(1, 5); CAND(1, 6); CAND(1, 7);
        CAND(2, 2); CAND(2, 3); CAND(2, 4);
        CAND(3, 3);
#undef CAND
        int TK[16];
#pragma unroll
        for (int k = 0; k < 16; ++k) TK[k] = max(M[k], swap32i(M[15 - k]));
        float sv[16]; float mx = -INFINITY;
#pragma unroll
        for (int k = 0; k < 16; ++k) { sv[k] = okey_val(TK[k], 255); mx = fmaxf(mx, sv[k]); }
        float den = 0.f;
#pragma unroll
        for (int k = 0; k < 16; ++k) { sv[k] = __expf(sv[k] - mx); den += sv[k]; }
        const float rden = 1.0f / den;
        LDS_WAIT(); asm volatile("" ::: "memory");
        const LAS unsigned char* ib = idxb + l * 32;
        unsigned* dst = EXPO + (size_t)t * 128 + h * 16 + hh * 8;
        u32x4 o0, o1; unsigned ov[8];
#pragma unroll
        for (int k = 0; k < 8; ++k) { const int pos = 255 - (TK[k] & 255); const unsigned i1 = ib[pos >> 4], i2 = ib[16 + (pos & 15)];
            ov[k] = (__float_as_uint(sv[k] * rden) & ~0x3fffu) | (i1 * 128u + i2); }
        o0 = (u32x4){ov[0], ov[1], ov[2], ov[3]}; o1 = (u32x4){ov[4], ov[5], ov[6], ov[7]};
        *(u32x4*)dst = o0; *(u32x4*)(dst + 4) = o1;
        LDS_WAIT(); asm volatile("" ::: "memory");
    }
}

__device__ __forceinline__ void cvt_rows_fp8(Frame& F, const float* src, unsigned char* dst, float* rscale) {
    const int l = F.lane; const int gw = F.vcu * NWAVES + F.wave, NGW = F.G * NWAVES;
    for (int e = gw; e < 16384; e += NGW) {
        const f32x4* sp = (const f32x4*)(src + (size_t)e * 1024 + 16 * l);
        const f32x4 a = sp[0], b = sp[1], c = sp[2], d = sp[3];
        float m = fmaxf(fmaxf(fmaxf(fabsf(a[0]), fabsf(a[1])), fmaxf(fabsf(a[2]), fabsf(a[3]))), fmaxf(fmaxf(fabsf(b[0]), fabsf(b[1])), fmaxf(fabsf(b[2]), fabsf(b[3]))));
        m = fmaxf(m, fmaxf(fmaxf(fmaxf(fabsf(c[0]), fabsf(c[1])), fmaxf(fabsf(c[2]), fabsf(c[3]))), fmaxf(fmaxf(fabsf(d[0]), fabsf(d[1])), fmaxf(fabsf(d[2]), fabsf(d[3])))));
#pragma unroll
        for (int o = 1; o < 64; o <<= 1) m = fmaxf(m, __shfl_xor(m, o));
        const float t = 448.0f / fmaxf(m, 1e-30f); const float s = __uint_as_float(__float_as_uint(t) & 0x7f800000u);
        u32x4 w; int x;
        x = __builtin_amdgcn_cvt_pk_fp8_f32(a[0] * s, a[1] * s, 0, false); x = __builtin_amdgcn_cvt_pk_fp8_f32(a[2] * s, a[3] * s, x, true); w.x = (unsigned)x;
        x = __builtin_amdgcn_cvt_pk_fp8_f32(b[0] * s, b[1] * s, 0, false); x = __builtin_amdgcn_cvt_pk_fp8_f32(b[2] * s, b[3] * s, x, true); w.y = (unsigned)x;
        x = __builtin_amdgcn_cvt_pk_fp8_f32(c[0] * s, c[1] * s, 0, false); x = __builtin_amdgcn_cvt_pk_fp8_f32(c[2] * s, c[3] * s, x, true); w.z = (unsigned)x;
        x = __builtin_amdgcn_cvt_pk_fp8_f32(d[0] * s, d[1] * s, 0, false); x = __builtin_amdgcn_cvt_pk_fp8_f32(d[2] * s, d[3] * s, x, true); w.w = (unsigned)x;
        *(u32x4*)(dst + (size_t)e * 1024 + 16 * l) = w;
        if (l == 0) rscale[e] = 1.0f / s;
    }
}

__device__ __forceinline__ float gelu_tanh(float x) { const float y = 0.7978845608028654f * (x + 0.044715f * x * x * x); return x * __builtin_amdgcn_rcpf(1.0f + __expf(-2.0f * y)); }
#define FP8_UNPACK16(W, f) do { f32x2 _t; \
    _t = __builtin_amdgcn_cvt_pk_f32_fp8((int)(W).x, false); f[0] = _t[0]; f[1] = _t[1]; _t = __builtin_amdgcn_cvt_pk_f32_fp8((int)(W).x, true); f[2] = _t[0]; f[3] = _t[1]; \
    _t = __builtin_amdgcn_cvt_pk_f32_fp8((int)(W).y, false); f[4] = _t[0]; f[5] = _t[1]; _t = __builtin_amdgcn_cvt_pk_f32_fp8((int)(W).y, true); f[6] = _t[0]; f[7] = _t[1]; \
    _t = __builtin_amdgcn_cvt_pk_f32_fp8((int)(W).z, false); f[8] = _t[0]; f[9] = _t[1]; _t = __builtin_amdgcn_cvt_pk_f32_fp8((int)(W).z, true); f[10] = _t[0]; f[11] = _t[1]; \
    _t = __builtin_amdgcn_cvt_pk_f32_fp8((int)(W).w, false); f[12] = _t[0]; f[13] = _t[1]; _t = __builtin_amdgcn_cvt_pk_f32_fp8((int)(W).w, true); f[14] = _t[0]; f[15] = _t[1]; } while (0)
__device__ __forceinline__ float sum_swap32(float a, float b) { auto r = __builtin_amdgcn_permlane32_swap(__float_as_uint(a), __float_as_uint(b), false, false); return __uint_as_float(r[0]) + __uint_as_float(r[1]); }
__device__ __forceinline__ float sum_swap16(float a, float b) { auto r = __builtin_amdgcn_permlane16_swap(__float_as_uint(a), __float_as_uint(b), false, false); return __uint_as_float(r[0]) + __uint_as_float(r[1]); }
template <int M> __device__ __forceinline__ unsigned sxu(unsigned v, int lane) {
    if constexpr (M == 32) { auto r = __builtin_amdgcn_permlane32_swap(v, v, false, false); return (lane & 32) ? r[0] : r[1]; }
    else return (unsigned)__builtin_amdgcn_ds_swizzle((int)v, (M << 10) | 0x1f);
}
template <int M> __device__ __forceinline__ float sxf(float v, int lane) { return __uint_as_float(sxu<M>(__float_as_uint(v), lane)); }
__device__ __forceinline__ float wave_sum_sx(float v, int lane) { v += sxf<1>(v, lane); v += sxf<2>(v, lane); v += sxf<4>(v, lane); v += sxf<8>(v, lane); v += sxf<16>(v, lane); v += sxf<32>(v, lane); return v; }
#ifndef PG_TOK
#define PG_TOK 4
#endif
template <class Bar>
__device__ __forceinline__ void phase_peer_gather(Frame& F, const Bar& bar, bool use_bar) {
    const unsigned char* UB = WSP(unsigned char, WS_UB8); const unsigned char* VB = WSP(unsigned char, WS_VB8); const float* RSU = WSP(float, WS_RSU); const float* RSV = WSP(float, WS_RSV);
    const unsigned* EXPO = WSP(unsigned, WS_EXP);
    const bf16_t* H1B = WSP(bf16_t, WS_H1); bf16_t* H2B = WSP(bf16_t, WS_H2B); const float* SSQ1 = WSP(float, WS_SSQ1); float* RS3 = WSP(float, WS_RS3); const float* g_ffn = F.in[10];
    const int l = F.lane; const int ntok_wg = T_TOK / F.G;
#pragma unroll 1
    for (int ti = F.wave * PG_TOK; ti < ntok_wg; ti += NWAVES * PG_TOK) {
        if (use_bar && ti >= NWAVES * PG_TOK) xcd_barrier(bar, F.tid); else __syncthreads();
        f32x2 acc[PG_TOK][8];
        LAS unsigned* lent = (LAS unsigned*)(F.lds + RING_OFF + F.wave * (2048 * PG_TOK)); LAS float* lcu = (LAS float*)(lent + 128 * PG_TOK); LAS float* lcv = lcu + 128 * PG_TOK; LAS float* acl = lcv + 128 * PG_TOK;
        LAS f32x4* lx = (LAS f32x4*)(F.lds + RING_OFF + NWAVES * 2048 * PG_TOK + F.wave * (4096 * PG_TOK));
#pragma unroll
        for (int tk = 0; tk < PG_TOK; ++tk) { const int t = F.vcu * ntok_wg + ti + tk;
            const u32x4 xa = *(const u32x4*)(H1B + (size_t)t * 1024 + 16 * l), xb = *(const u32x4*)(H1B + (size_t)t * 1024 + 16 * l + 8);
            const f32x4* gp = (const f32x4*)(g_ffn + 16 * l);
            lx[tk * 256 + l] = (f32x4){bf_lo(xa.x), bf_hi(xa.x), bf_lo(xa.y), bf_hi(xa.y)} * gp[0]; lx[tk * 256 + 64 + l] = (f32x4){bf_lo(xa.z), bf_hi(xa.z), bf_lo(xa.w), bf_hi(xa.w)} * gp[1];
            lx[tk * 256 + 128 + l] = (f32x4){bf_lo(xb.x), bf_hi(xb.x), bf_lo(xb.y), bf_hi(xb.y)} * gp[2]; lx[tk * 256 + 192 + l] = (f32x4){bf_lo(xb.z), bf_hi(xb.z), bf_lo(xb.w), bf_hi(xb.w)} * gp[3];
#pragma unroll
            for (int i = 0; i < 8; ++i) acc[tk][i] = (f32x2){0.f, 0.f}; }
#pragma unroll 1
        for (int tk = 0; tk < PG_TOK; ++tk) { const int t = F.vcu * ntok_wg + ti + tk;
            const f32x4* sp = (const f32x4*)(SSQ1 + (size_t)t * 16); const f32x4 st = (sp[0] + sp[1]) + (sp[2] + sp[3]); const float rstd1 = __builtin_amdgcn_rsqf(((st[0] + st[1]) + (st[2] + st[3])) * (1.0f / 1024.0f) + EPS);
            unsigned a0 = EXPO[(size_t)t * 128 + l], a1 = EXPO[(size_t)t * 128 + 64 + l];
            { unsigned s0 = (a0 << 18) | (a0 >> 14), s1 = (a1 << 18) | (a1 >> 14);
              int ls = l; asm volatile("" : "+v"(ls));
#define BSTEP(K, J) do { const bool up = (ls & (J)) != 0; const unsigned p0 = sxu<J>(s0, ls), p1 = sxu<J>(s1, ls); \
                  const bool asc0 = (ls & (K)) == 0, asc1 = ((ls + 64) & (K)) == 0; \
                  s0 = (up == asc0) ? max(s0, p0) : min(s0, p0); s1 = (up == asc1) ? max(s1, p1) : min(s1, p1); } while (0)
              BSTEP(2, 1);
              BSTEP(4, 2); BSTEP(4, 1);
              BSTEP(8, 4); BSTEP(8, 2); BSTEP(8, 1);
              BSTEP(16, 8); BSTEP(16, 4); BSTEP(16, 2); BSTEP(16, 1);
              BSTEP(32, 16); BSTEP(32, 8); BSTEP(32, 4); BSTEP(32, 2); BSTEP(32, 1);
              BSTEP(64, 32); BSTEP(64, 16); BSTEP(64, 8); BSTEP(64, 4); BSTEP(64, 2); BSTEP(64, 1);
              { const unsigned lo = min(s0, s1), hi = max(s0, s1); s0 = lo; s1 = hi; }
              BSTEP(128, 32); BSTEP(128, 16); BSTEP(128, 8); BSTEP(128, 4); BSTEP(128, 2); BSTEP(128, 1);
#undef BSTEP
              a0 = (s0 >> 18) | (s0 << 14); a1 = (s1 >> 18) | (s1 << 14); }
            lent[tk * 128 + l] = a0; lent[tk * 128 + 64 + l] = a1;
            lcu[tk * 128 + l] = RSU[a0 & 0x3fffu] * rstd1; lcu[tk * 128 + 64 + l] = RSU[a1 & 0x3fffu] * rstd1;
            lcv[tk * 128 + l] = RSV[a0 & 0x3fffu] * __uint_as_float(a0 & ~0x3fffu); lcv[tk * 128 + 64 + l] = RSV[a1 & 0x3fffu] * __uint_as_float(a1 & ~0x3fffu); }
        LDS_WAIT(); asm volatile("" ::: "memory");
        u32x4 buf0[8], buf1[8];
#define ROWS8(BUF, TAB, tk, eb) do { const u32x4 ea_ = *(const LAS u32x4*)(lent + (tk) * 128 + (eb)), eb_ = *(const LAS u32x4*)(lent + (tk) * 128 + (eb) + 4); \
            const unsigned en_[8] = {ea_.x, ea_.y, ea_.z, ea_.w, eb_.x, eb_.y, eb_.z, eb_.w}; \
            _Pragma("unroll") for (int k = 0; k < 8; ++k) BUF[k] = *(const u32x4*)((TAB) + ((en_[k] & 0x3fffu) * 1024u + 16u * (unsigned)l)); } while (0)
#define U8(BUF, tk, eb) do { float p[8]; f32x2 x2[8]; \
            _Pragma("unroll") for (int i = 0; i < 4; ++i) { const f32x4 t_ = lx[(tk) * 256 + 64 * i + l]; x2[2 * i] = (f32x2){t_[0], t_[1]}; x2[2 * i + 1] = (f32x2){t_[2], t_[3]}; } \
            _Pragma("unroll") for (int k = 0; k < 8; ++k) { const unsigned wq[4] = {BUF[k].x, BUF[k].y, BUF[k].z, BUF[k].w}; f32x2 s2 = (f32x2){0.f, 0.f}; \
                _Pragma("unroll") for (int i = 0; i < 4; ++i) { s2 = __builtin_elementwise_fma(__builtin_amdgcn_cvt_pk_f32_fp8((int)wq[i], false), x2[2 * i], s2); \
                                                                s2 = __builtin_elementwise_fma(__builtin_amdgcn_cvt_pk_f32_fp8((int)wq[i], true), x2[2 * i + 1], s2); } \
                p[k] = s2[0] + s2[1]; if (k & 1) __builtin_amdgcn_sched_barrier(0); } \
            float q4[4], q2[2], q1; \
            _Pragma("unroll") for (int j = 0; j < 4; ++j) q4[j] = sum_swap32(p[j], p[4 + j]); \
            _Pragma("unroll") for (int j = 0; j < 2; ++j) q2[j] = sum_swap16(q4[j], q4[2 + j]); \
            { const bool up = (l & 8) != 0; const float keep = up ? q2[1] : q2[0], send = up ? q2[0] : q2[1]; q1 = keep + sxf<8>(send, l); } \
            q1 += sxf<4>(q1, l); q1 += sxf<2>(q1, l); q1 += sxf<1>(q1, l); \
            const float cu = lcu[(tk) * 128 + (eb) + (l >> 3)], cv = lcv[(tk) * 128 + (eb) + (l >> 3)]; \
            const float a_ = gelu_tanh(q1 * cu) * cv; if ((l & 7) == 0) acl[(tk) * 128 + (eb) + (l >> 3)] = a_; __builtin_amdgcn_sched_barrier(0); } while (0)
#define V8(BUF, tk, eb) do { const float av = acl[(tk) * 128 + (eb) + (l & 7)]; \
            _Pragma("unroll") for (int k = 0; k < 8; ++k) { const float ak = __uint_as_float(__builtin_amdgcn_readlane(__float_as_uint(av), k)); const f32x2 ak2 = (f32x2){ak, ak}; \
                const unsigned wq[4] = {BUF[k].x, BUF[k].y, BUF[k].z, BUF[k].w}; \
                _Pragma("unroll") for (int i = 0; i < 4; ++i) { acc[tk][2 * i] = __builtin_elementwise_fma(__builtin_amdgcn_cvt_pk_f32_fp8((int)wq[i], false), ak2, acc[tk][2 * i]); \
                                                                acc[tk][2 * i + 1] = __builtin_elementwise_fma(__builtin_amdgcn_cvt_pk_f32_fp8((int)wq[i], true), ak2, acc[tk][2 * i + 1]); } \
                if (k & 1) __builtin_amdgcn_sched_barrier(0); } } while (0)
        ROWS8(buf0, UB, 0, 0);
#if PG_TOK == 4
#define TURNS4(CONS, TAB, eb, NEXT) do { ROWS8(buf1, TAB, 1, eb); CONS(buf0, 0, eb); ROWS8(buf0, TAB, 2, eb); CONS(buf1, 1, eb); ROWS8(buf1, TAB, 3, eb); CONS(buf0, 2, eb); NEXT; CONS(buf1, 3, eb); } while (0)
#pragma unroll 1
        for (int eb = 0; eb < 120; eb += 8) TURNS4(U8, UB, eb, ROWS8(buf0, UB, 0, eb + 8));
        TURNS4(U8, UB, 120, ROWS8(buf0, VB, 0, 0));
        LDS_WAIT(); asm volatile("" ::: "memory");
#pragma unroll 1
        for (int eb = 0; eb < 120; eb += 8) TURNS4(V8, VB, eb, ROWS8(buf0, VB, 0, eb + 8));
        TURNS4(V8, VB, 120, (void)0);
#undef TURNS4
#elif PG_TOK == 2
#define TURNS2(CONS, TAB, eb, NEXT) do { ROWS8(buf1, TAB, 1, eb); CONS(buf0, 0, eb); NEXT; CONS(buf1, 1, eb); } while (0)
#pragma unroll 1
        for (int eb = 0; eb < 120; eb += 8) TURNS2(U8, UB, eb, ROWS8(buf0, UB, 0, eb + 8));
        TURNS2(U8, UB, 120, ROWS8(buf0, VB, 0, 0));
        LDS_WAIT(); asm volatile("" ::: "memory");
#pragma unroll 1
        for (int eb = 0; eb < 120; eb += 8) TURNS2(V8, VB, eb, ROWS8(buf0, VB, 0, eb + 8));
        TURNS2(V8, VB, 120, (void)0);
#undef TURNS2
#else
#error PG_TOK must be 2 or 4
#endif
#undef ROWS8
#undef U8
#undef V8
#pragma unroll
        for (int tk = 0; tk < PG_TOK; ++tk) { const int t = F.vcu * ntok_wg + ti + tk;
            float ss = 0.f; f32x4 h[4];
#pragma unroll
            for (int q2 = 0; q2 < 2; ++q2) { const u32x4 ha = *(const u32x4*)(H1B + (size_t)t * 1024 + 16 * l + 8 * q2);
                h[2 * q2] = (f32x4){bf_lo(ha.x), bf_hi(ha.x), bf_lo(ha.y), bf_hi(ha.y)}; h[2 * q2 + 1] = (f32x4){bf_lo(ha.z), bf_hi(ha.z), bf_lo(ha.w), bf_hi(ha.w)};
#pragma unroll
                for (int j = 0; j < 4; ++j) { h[2 * q2][j] += acc[tk][4 * q2 + (j >> 1)][j & 1]; h[2 * q2 + 1][j] += acc[tk][4 * q2 + 2 + (j >> 1)][j & 1]; ss += h[2 * q2][j] * h[2 * q2][j] + h[2 * q2 + 1][j] * h[2 * q2 + 1][j]; }
                u32x4 w0; w0.x = cvtpk(h[2 * q2][0], h[2 * q2][1]); w0.y = cvtpk(h[2 * q2][2], h[2 * q2][3]); w0.z = cvtpk(h[2 * q2 + 1][0], h[2 * q2 + 1][1]); w0.w = cvtpk(h[2 * q2 + 1][2], h[2 * q2 + 1][3]);
                if (!F.dry) st_nt<NT_OUT>(w0, (u32x4*)(H2B + (size_t)t * 1024 + 16 * l + 8 * q2)); }
            const float rstd3 = __builtin_amdgcn_rsqf(wave_sum_sx(ss, l) * (1.0f / 1024.0f) + EPS);
            if (!F.dry && l == 0) RS3[t] = rstd3;
            __builtin_amdgcn_sched_barrier(0); }
    }
}

__device__ __forceinline__ void phase_final(Frame& F) {
    const float* SSQ3 = WSP(float, WS_SSQ3); const float* g = F.in[19]; const bf16_t* H3B = WSP(bf16_t, WS_H3B);
    const int l = F.lane; const int gw = F.vcu * NWAVES + F.wave, NGW = F.G * NWAVES;
    for (int t = gw; t < T_TOK; t += NGW) {
        const f32x4* sp = (const f32x4*)(SSQ3 + (size_t)t * 16); const f32x4 st = (sp[0] + sp[1]) + (sp[2] + sp[3]);
        const float rstd = __builtin_amdgcn_rsqf(((st[0] + st[1]) + (st[2] + st[3])) * (1.0f / 1024.0f) + EPS);
        f32x4* row = (f32x4*)(F.out + (size_t)t * 1024);
#pragma unroll
        for (int j = 0; j < 4; ++j) { const u32x2 hv = *((const u32x2*)(H3B + (size_t)t * 1024) + l + 64 * j); const f32x4 gv = *((const f32x4*)g + l + 64 * j);
            const f32x4 h = (f32x4){bf_lo(hv.x), bf_hi(hv.x), bf_lo(hv.y), bf_hi(hv.y)}; row[l + 64 * j] = h * rstd * gv; }
    }
}
#ifndef MK_FUSED
#define MK_FUSED 1
#endif
constexpr int NPHASE = 10;
struct Args { const float* in[20]; float* out; unsigned char* ws; int ph_lo, ph_hi, dry, pad; };
static_assert(sizeof(Args) == 20 * 8 + 8 + 8 + 4 * 4, "Args has no padding");

__global__ void __launch_bounds__(NWAVES * 64, 2) mk_fwd(Args args) {
    extern __shared__ __attribute__((aligned(16))) unsigned char lds_raw[];
    Frame F;
    F.lds = (LAS unsigned char*)lds_raw;
    F.wave = __builtin_amdgcn_readfirstlane(threadIdx.x >> 6); F.lane = lane_id(); F.tid = F.wave * 64 + F.lane;
    F.G = gridDim.x; { const int bx = blockIdx.x; F.vcu = (F.G % 8 == 0) ? (bx % 8) * (F.G / 8) + bx / 8 : bx; }
    F.in = args.in; F.out = args.out; F.ws = args.ws; F.dry = args.dry;
    volatile LAS unsigned* MISC = (volatile LAS unsigned*)(F.lds + MISC_OFF);
    if (F.tid < 64) MISC[F.tid] = 0u;
    __syncthreads();
    const int lo = args.ph_lo, hi = args.ph_hi;
    XcdBarrier bar; bar.bar = (unsigned*)(F.ws + WS_CTL) + CW_BAR; bar.x = 0; bar.st = nullptr;
    if (hi - lo > 1) bar = xcd_barrier_post((unsigned*)(F.ws + WS_CTL) + CW_BAR, MISC + 8, F.tid);
#ifndef PH_MASK
#define PH_MASK 0xFFFFFFFFu
#endif
#define IN(k) (((PH_MASK >> (k)) & 1u) && lo <= (k) && (k) < hi)
#define LAUNDER(p, T) do { unsigned _lo = (unsigned)(unsigned long long)(p), _hi = (unsigned)((unsigned long long)(p) >> 32); asm volatile("" : "+v"(_lo), "+v"(_hi)); \
        _lo = __builtin_amdgcn_readfirstlane(_lo); _hi = __builtin_amdgcn_readfirstlane(_hi); (p) = (T)(((unsigned long long)_hi << 32) | _lo); } while (0)
#define SEAM(k) do { if (IN(k) && IN((k) + 1)) xcd_barrier(bar, F.tid); LAUNDER(F.ws, unsigned char*); LAUNDER(F.out, float*); F.lane = lane_id(); F.tid = F.wave * 64 + F.lane; } while (0)
    const int bx = (int)blockIdx.x;
    LAS unsigned char* ring = F.lds + RING_OFF;

    if (IN(0)) { phase_prologue(F); } SEAM(0);
    if (IN(1)) {
        pg8::Gemm g{WSP(bf16_t, WS_XN1), WSP(bf16_t, WS_WIN), T_TOK, 8192, 1024, 1024, 0, 2, 8}; pg8::StaticOrder S; S.init(T_TOK, 8192, F.G, bx);
        pg8::EpiProj E{WSP(bf16_t, WS_GQ), WSP(bf16_t, WS_GK), WSP(bf16_t, WS_GV), WSP(bf16_t, WS_GR), WSP(bf16_t, WS_SQ), WSP(bf16_t, WS_SK), WSP(bf16_t, WS_SV),
                       (bf16_t*)F.out, (bf16_t*)F.out + (size_t)T_TOK * 1024};
        pg8::gemm_phase<pg8::EpiProj>(ring, g, S, E, F.tid);
    } SEAM(1);
    if (IN(2)) { phase_gla_prep(F); } SEAM(2);
    if (IN(3)) { phase_attn_a(F); } SEAM(3);
    if (IN(4)) { phase_attn_b(F); } SEAM(4);
    if (IN(5)) {
        if (!QCONV) { for (int cu = F.vcu; cu < CVT8_UNITS; cu += F.G) cvt_fp8_unit(F, cu); VM_WAIT(); __syncthreads(); }
        pg8::PairOrder S; S.init(T_TOK, 1024, F.G, bx);
        pg8::Gemm g{WSP(bf16_t, WS_GLAN), WSP(bf16_t, WS_WGA), T_TOK, 1024, 1024, 1024, 0, 0, 0, WSP(bf16_t, WS_SQ), WSP(bf16_t, WS_WSB)};
        pg8::EpiMixPair E{(const bf16_t*)F.out, (const bf16_t*)F.out + (size_t)T_TOK * 1024, WSP(bf16_t, WS_MIX)};
        pg8::gemm_phase<pg8::EpiMixPair, true, true, pg8::PairOrder>(ring, g, S, E, F.tid);
    } SEAM(5);
    if (IN(6)) {
        pg8::Gemm g{WSP(bf16_t, WS_MIX), WSP(bf16_t, WS_WO), T_TOK, 1024, 1024, 1024, 0, 0, 0}; pg8::StaticOrder S; S.init(T_TOK, 1024, F.G, bx);
        pg8::EpiH1 E{F.in[0], WSP(bf16_t, WS_H1), WSP(float, WS_SSQ1)};
        pg8::gemm_phase<pg8::EpiH1>(ring, g, S, E, F.tid);
    } SEAM(6);
    if (IN(7)) {
        pg8::Gemm g{WSP(bf16_t, WS_H1), WSP(bf16_t, WS_WPQ), T_TOK, 2048, 1024, 1024, 0, 0, 0}; pg8::StaticOrder S; S.init(T_TOK, 2048, F.G, bx);
        pg8::EpiQ E{WSP(float, WS_SSQ1), WSP(bf16_t, WS_Q), 2048};
        pg8::gemm_phase<pg8::EpiQ>(ring, g, S, E, F.tid);
    } SEAM(7);
    if (IN(8)) {
        cvt_copy(F, F.in[1], WSP(bf16_t, WS_PB), (size_t)T_TOK * 256);
        phase_peer_retrieve(F);
        VM_WAIT(); __syncthreads();
        phase_peer_gather(F, bar, false);
    } SEAM(8);
    if (IN(9)) {
        pg8::StaticOrder S; S.init(T_TOK, 1024, F.G, bx);
        { pg8::Gemm g{WSP(bf16_t, WS_PB), WSP(bf16_t, WS_WPLE), T_TOK, 1024, 256, 256, 0, 0, 0}; pg8::EpiBf E{WSP(bf16_t, WS_PLE), 1024};
          pg8::gemm_phase<pg8::EpiBf>(ring, g, S, E, F.tid); }
        { pg8::Gemm g{WSP(bf16_t, WS_H2B), WSP(bf16_t, WS_WPG), T_TOK, 1024, 1024, 1024, 0, 0, 0}; pg8::EpiH3L E{WSP(bf16_t, WS_H2B), WSP(bf16_t, WS_PLE), WSP(float, WS_RS3), ring, WSP(float, WS_SSQ3)};
          pg8::gemm_phase<pg8::EpiH3L>(ring, g, S, E, F.tid); }
        { pg8::Unit u; S.next(0, u);
          unsigned* cnt = (unsigned*)(F.ws + WS_CTL) + CW_ROWCNT + 64 * F.dry + u.pm;
          if (F.tid == 0) {
              __builtin_amdgcn_fence(__ATOMIC_RELEASE, "agent");
              __hip_atomic_fetch_add(cnt, 1u, __ATOMIC_RELAXED, __HIP_MEMORY_SCOPE_AGENT);
              unsigned sp = 0; while (__hip_atomic_load(cnt, __ATOMIC_RELAXED, __HIP_MEMORY_SCOPE_AGENT) < 4u && ++sp < (1u << 24)) __builtin_amdgcn_s_sleep(1);
              __builtin_amdgcn_fence(__ATOMIC_ACQUIRE, "agent");
          }
          __syncthreads();
          LAS float* rsl = (LAS float*)(ring + 256 * pg8::H3L_PITCH);
          if (F.tid < 256) { const f32x4* sp = (const f32x4*)(WSP(float, WS_SSQ3) + (size_t)(u.pm * 256 + F.tid) * 16); const f32x4 st = (sp[0] + sp[1]) + (sp[2] + sp[3]);
              rsl[F.tid] = __builtin_amdgcn_rsqf(((st[0] + st[1]) + (st[2] + st[3])) * (1.0f / 1024.0f) + EPS); }
          __syncthreads();
          const int c8 = F.tid & 31, r0 = F.tid >> 5;
          const f32x4 g0 = *(const f32x4*)(F.in[19] + u.pn * 256 + 8 * c8), g1 = *(const f32x4*)(F.in[19] + u.pn * 256 + 8 * c8 + 4);
#pragma unroll 4
          for (int ps = 0; ps < 16; ++ps) { const int lrow = ps * 16 + r0; const u32x4 hv = *(const LAS u32x4*)(ring + lrow * pg8::H3L_PITCH + 16 * c8); const float rstd = rsl[lrow];
              float* op = F.out + (size_t)(u.pm * 256 + lrow) * 1024 + u.pn * 256 + 8 * c8;
              st_nt<NT_OUT>((f32x4){bf_lo(hv.x), bf_hi(hv.x), bf_lo(hv.y), bf_hi(hv.y)} * rstd * g0, (f32x4*)op); st_nt<NT_OUT>((f32x4){bf_lo(hv.z), bf_hi(hv.z), bf_lo(hv.w), bf_hi(hv.w)} * rstd * g1, (f32x4*)(op + 4)); }
        }
    }
#undef IN
#undef SEAM
}

extern "C" void kernel_launch(void* const* d_in, const int* in_sizes, int n_in, void* d_out, int out_size, void* d_ws, size_t ws_size, hipStream_t stream) {
    static int grid = 0;
    if (grid == 0) {
        if (n_in != 20 || in_sizes[0] != T_TOK * 1024 || out_size != T_TOK * 1024 || ws_size < WS_END) {
            fprintf(stderr, "kernel_launch: unexpected shapes (n_in %d, in0 %d, out %d, ws %zu < %zu?); nothing launched\n", n_in, n_in > 0 ? in_sizes[0] : -1, out_size, ws_size, (size_t)WS_END); grid = -1; return; }
        int dev = 0, cus = 0, per_cu = 0;
        if (hipGetDevice(&dev) != hipSuccess || hipDeviceGetAttribute(&cus, hipDeviceAttributeMultiprocessorCount, dev) != hipSuccess) { grid = -1; return; }
        if (hipFuncSetAttribute((const void*)mk_fwd, hipFuncAttributeMaxDynamicSharedMemorySize, LDS_BYTES) != hipSuccess) { fprintf(stderr, "kernel_launch: hipFuncSetAttribute failed\n"); grid = -1; return; }
        if (hipOccupancyMaxActiveBlocksPerMultiprocessor(&per_cu, (const void*)mk_fwd, NWAVES * 64, LDS_BYTES) != hipSuccess || per_cu < 1)
            fprintf(stderr, "kernel_launch: note: occupancy query reports %d workgroups per CU\n", per_cu);
        (void)hipGetLastError();
        grid = cus;
        if (grid != (T_TOK / 256) * 4) { fprintf(stderr, "kernel_launch: the last phase needs one output tile per workgroup (grid %d)\n", grid); grid = -1; return; }
        if (grid != 256) fprintf(stderr, "kernel_launch: note: %d CUs (kernel tuned for 256)\n", grid);
    }
    if (grid < 0) return;
    if (hipMemsetAsync((char*)d_ws + WS_CTL, 0, CTL_ZERO_BYTES, stream) != hipSuccess) { fprintf(stderr, "kernel_launch: hipMemsetAsync failed\n"); return; }
    Args a{};
    for (int i = 0; i < 20; ++i) a.in[i] = (const float*)d_in[i];
    a.out = (float*)d_out; a.ws = (unsigned char*)d_ws;
#if MK_FUSED
    a.ph_lo = 0; a.ph_hi = NPHASE;
    hipLaunchKernelGGL(mk_fwd, dim3(grid), dim3(NWAVES * 64), LDS_BYTES, stream, a);
#else
#ifndef PROBE_PHASE
#define PROBE_PHASE -1
#define PROBE_REPS 0
#endif
    for (int p = 0; p < NPHASE; ++p) { a.ph_lo = p; a.ph_hi = p + 1;
        if (p == PROBE_PHASE) { a.dry = 1; for (int r = 0; r < PROBE_REPS; ++r) hipLaunchKernelGGL(mk_fwd, dim3(grid), dim3(NWAVES * 64), LDS_BYTES, stream, a); a.dry = 0; }
        hipLaunchKernelGGL(mk_fwd, dim3(grid), dim3(NWAVES * 64), LDS_BYTES, stream, a); }
#endif
}
```

```cpp
#define MK_FUSED 1
#define PG_TOK 4
#include <hip/hip_runtime.h>
#include <cstdio>
#include <cstdint>

#define LAS __attribute__((address_space(3)))
#define GAS __attribute__((address_space(1)))
typedef unsigned short bf16_t;
typedef short bf16x8 __attribute__((ext_vector_type(8)));
typedef short s16x4 __attribute__((ext_vector_type(4)));
typedef float f32x2 __attribute__((ext_vector_type(2)));
typedef float f32x4 __attribute__((ext_vector_type(4)));
typedef float f32x16 __attribute__((ext_vector_type(16)));
typedef unsigned u32x2 __attribute__((ext_vector_type(2)));
typedef unsigned u32x4 __attribute__((ext_vector_type(4)));
typedef __bf16 bf16x2_t __attribute__((ext_vector_type(2)));

__device__ __forceinline__ unsigned cvtpk(float lo, float hi) { f32x2 v = {lo, hi}; bf16x2_t b = __builtin_convertvector(v, bf16x2_t); return __builtin_bit_cast(unsigned, b); }
__device__ __forceinline__ float bf_lo(unsigned u) { return __uint_as_float(u << 16); }
__device__ __forceinline__ float bf_hi(unsigned u) { return __uint_as_float(u & 0xffff0000u); }
__device__ __forceinline__ float bf1(bf16_t u) { return __uint_as_float(((unsigned)u) << 16); }
__device__ __forceinline__ float fast_sigmoid(float x) { return __builtin_amdgcn_rcpf(1.0f + __expf(-x)); }

__device__ __forceinline__ void st_sc1(u32x4 v, void* p) { asm volatile("global_store_dwordx4 %0, %1, off sc1" :: "v"(p), "v"(v) : "memory"); }
template <int ON, class T> __device__ __forceinline__ void st_nt(T v, T* p) { if constexpr (ON != 0) __builtin_nontemporal_store(v, p); else *p = v; }
#ifndef PROJ_ST
#define PROJ_ST 1
#endif
#ifndef NT_PROJ_T
#define NT_PROJ_T 1
#endif
#ifndef NT_PROJ_MASK
#define NT_PROJ_MASK 0xFFFFFFFFu
#endif
#ifndef NT_Q
#define NT_Q 0
#endif
#ifndef NT_EPI
#define NT_EPI 0
#endif
#ifndef NT_PRE
#define NT_PRE 0
#endif
#ifndef NT_ATT
#define NT_ATT 0
#endif
#ifndef NT_OUT
#define NT_OUT 0
#endif

namespace pg8 {
constexpr int BM = 256, BK = 64, HALF = 128, HTB = HALF * BK * 2  , STAGE_BYTES = 8 * HTB, NXCD = 8, WGM = 8;

__host__ __device__ __forceinline__ int lds_byte(int r, int c) { const int st = (r >> 4) * 2 + (c >> 5), rr = r & 15, cc = c & 31, ob = rr * 64 + cc * 2; return st * 1024 + (ob ^ (((ob >> 9) & 1) << 5)); }
__host__ __device__ __forceinline__ void stage_rc(int b, int& R, int& C) { const int st = b / 1024, sb = b % 1024, swz = sb ^ (((sb >> 9) & 1) << 5); R = (st >> 1) * 16 + swz / 64; C = (st & 1) * 32 + (swz % 64) / 2; }
__host__ __device__ __forceinline__ int perm32(int rho) { const int n = rho >> 4, i = rho & 15; return 8 * (i >> 2) + 4 * n + (i & 3); }

struct Unit { int pm, pn, half; };
struct Gemm { const bf16_t* A; const bf16_t* Bt; int M, N, K, lda, a_pn_cols; int swap_lo, swap_hi; const bf16_t* A2 = nullptr; const bf16_t* Bt2 = nullptr; };

struct StaticOrder {
    int nM, nN, nwg, G, c;
    __host__ __device__ void init(int M, int N, int G_, int c_) { nM = M / BM; nN = N / BM; nwg = nM * nN; G = G_; c = c_; }
    __host__ __device__ bool next(int i, Unit& u) const {
        const long L = (long)i * G + c; if (L >= nwg) return false;
        int wgid = (int)L; { const int q = nwg / NXCD, r = nwg % NXCD, xcd = wgid % NXCD, off = wgid / NXCD; wgid = (xcd < r ? xcd * (q + 1) : r * (q + 1) + (xcd - r) * q) + off; }
        const int nig = WGM * nN, gid = wgid / nig, fm = gid * WGM, gsz = (nM - fm) < WGM ? (nM - fm) : WGM;
        u.pm = fm + ((wgid % nig) % gsz); u.pn = (wgid % nig) / gsz; u.half = 0; return true;
    }
};
struct PairOrder {
    StaticOrder S;
    __host__ __device__ void init(int M, int N, int G_, int c_) { S.init(M, N, G_, c_); }
    __host__ __device__ bool next(int i, Unit& u) const { if (!S.next(i >> 1, u)) return false; u.half = i & 1; return true; }
};

template <class Epi, bool ALIGN_EPI = true, bool SP2 = true, class Order = StaticOrder>
__device__ __forceinline__ void gemm_phase(LAS unsigned char* lds, const Gemm g, const Order& S, const Epi& E, int tid) {
    const int wid = __builtin_amdgcn_readfirstlane(tid >> 6), lane = tid & 63, wr = wid >> 2, wc = wid & 3, fr = lane & 15, fq = lane >> 4;
    const int K = g.K, nt = K / BK, lda = g.lda;
    unsigned voffA[2], voffB[2];
#pragma unroll
    for (int i = 0; i < 2; ++i) { int R, C; stage_rc(tid * 16 + i * 8192, R, C); const int Rb = Epi::PERM ? ((R & ~31) + perm32(R & 31)) : R;
        voffA[i] = (unsigned)(R * lda + C) * 2u; voffB[i] = (unsigned)(Rb * K + C) * 2u; }
    const size_t kstep = (size_t)(BK * 2);
    const size_t hA = (size_t)HALF * lda * 2, hB = (size_t)HALF * K * 2;
    const size_t tA = 2 * hA, tB = 2 * hB;
    const size_t pnA = (size_t)g.a_pn_cols * 2;
    const unsigned ldsw = (unsigned)wid * 1024u;
    const int aoff = lds_byte(wr * 64 + fr, fq * 8), boff = lds_byte(wc * 32 + fr, fq * 8);
#define PG8_SA(b, h) (((b) * 2 + (h)) * HTB)
#define PG8_SB(b, h) ((4 + (b) * 2 + (h)) * HTB)
#define PG8_STAGE(bufoff, gbase, voff) do { _Pragma("unroll") for (int _i = 0; _i < 2; ++_i) \
        __builtin_amdgcn_global_load_lds((const unsigned*)((const char*)(gbase) + (voff)[_i]), (LAS unsigned*)(lds + (bufoff) + ldsw + _i * 8192), 16, 0, 0); } while (0)
#define PG8_LDA(dst, b, h) do { _Pragma("unroll") for (int m = 0; m < 4; ++m) _Pragma("unroll") for (int k = 0; k < 2; ++k) dst[m][k] = *(const LAS bf16x8*)(lds + PG8_SA(b, h) + aoff + m * 2048 + k * 1024); } while (0)
#define PG8_LDB(dst, b, h) do { _Pragma("unroll") for (int n = 0; n < 2; ++n) _Pragma("unroll") for (int k = 0; k < 2; ++k) dst[n][k] = *(const LAS bf16x8*)(lds + PG8_SB(b, h) + boff + n * 2048 + k * 1024); } while (0)
#define PG8_MMA(ai, bj, At, Bt) do { __builtin_amdgcn_s_setprio(1); _Pragma("unroll") for (int m = 0; m < 4; ++m) _Pragma("unroll") for (int n = 0; n < 2; ++n) _Pragma("unroll") for (int k = 0; k < 2; ++k) \
        acc[ai][bj][m][n] = __builtin_amdgcn_mfma_f32_16x16x32_bf16(Bt[n][k], At[m][k], acc[ai][bj][m][n], 0, 0, 0); __builtin_amdgcn_s_setprio(0); } while (0)
#define PG8_WAIT_V(n) asm volatile("s_waitcnt vmcnt(" #n ")" ::: "memory")
#define PG8_WAIT_L(n) asm volatile("s_waitcnt lgkmcnt(" #n ")" ::: "memory")
#define PG8_BAR __builtin_amdgcn_s_barrier()
#define PG8_SCHED __builtin_amdgcn_sched_barrier(0)
    Unit cur, nxt; int ui = 0;
    if (!S.next(0, cur)) return;
    f32x4 acc[2][2][4][2];
#pragma unroll
    for (int a = 0; a < 2; ++a)
#pragma unroll
        for (int b = 0; b < 2; ++b)
#pragma unroll
            for (int m = 0; m < 4; ++m)
#pragma unroll
                for (int n = 0; n < 2; ++n) acc[a][b][m][n] = (f32x4){0.f, 0.f, 0.f, 0.f};
    bf16x8 At[4][2], B0[2][2], B1[2][2];
#define PG8_APTR(u) ((u).half ? (const char*)g.A2 + (size_t)(u).pm * tA : ((u).pn >= g.swap_lo && (u).pn < g.swap_hi) ? (const char*)g.Bt + (size_t)(u).pn * tB : (const char*)g.A + (size_t)(u).pm * tA + (size_t)(u).pn * pnA)
#define PG8_BPTR(u) ((u).half ? (const char*)g.Bt2 + (size_t)(u).pn * tB : ((u).pn >= g.swap_lo && (u).pn < g.swap_hi) ? (const char*)g.A + (size_t)(u).pm * tA : (const char*)g.Bt + (size_t)(u).pn * tB)
    const char* cA = PG8_APTR(cur); const char* cB = PG8_BPTR(cur);
    if constexpr (SP2) {
        PG8_STAGE(PG8_SB(0, 0), cB, voffB); PG8_STAGE(PG8_SB(0, 1), cB + hB, voffB); PG8_STAGE(PG8_SA(0, 0), cA, voffA); PG8_STAGE(PG8_SA(0, 1), cA + hA, voffA);
        if (wr == 1) PG8_BAR;
        PG8_WAIT_V(2); PG8_BAR;
        PG8_STAGE(PG8_SB(1, 0), cB + kstep, voffB); PG8_STAGE(PG8_SA(1, 0), cA + kstep, voffA); PG8_STAGE(PG8_SB(1, 1), cB + hB + kstep, voffB);
        PG8_WAIT_V(6); PG8_BAR;
    } else {
        PG8_STAGE(PG8_SB(0, 0), cB, voffB); PG8_STAGE(PG8_SA(0, 0), cA, voffA); PG8_STAGE(PG8_SB(0, 1), cB + hB, voffB); PG8_STAGE(PG8_SA(0, 1), cA + hA, voffA);
        if (wr == 1) PG8_BAR;
        PG8_WAIT_V(4); PG8_BAR;
        PG8_STAGE(PG8_SB(1, 0), cB + kstep, voffB); PG8_STAGE(PG8_SA(1, 0), cA + kstep, voffA); PG8_STAGE(PG8_SB(1, 1), cB + hB + kstep, voffB);
        PG8_WAIT_V(6); PG8_BAR;
    }
    for (;;) {
        const bool has_next = S.next(ui + 1, nxt);
        const char* nA = has_next ? PG8_APTR(nxt) : cA; const char* nB = has_next ? PG8_BPTR(nxt) : cB;
#pragma unroll 1
        for (int t = 0; t < nt; t += 2) {
            const bool last = (t == nt - 2);
            const char* a1 = cA + (size_t)(t + 1) * kstep;
            const char* a2 = last ? nA : cA + (size_t)(t + 2) * kstep; const char* b2 = last ? nB : cB + (size_t)(t + 2) * kstep;
            const char* a3 = a2 + kstep; const char* b3 = b2 + kstep;
            if constexpr (SP2) {
            PG8_LDB(B0, 0, 0); PG8_LDB(B1, 0, 1); PG8_SCHED; PG8_LDA(At, 0, 0); PG8_STAGE(PG8_SA(1, 1), a1 + hA, voffA);
            PG8_WAIT_V(8); PG8_WAIT_L(0); PG8_BAR; PG8_MMA(0, 0, At, B0); PG8_MMA(0, 1, At, B1); PG8_BAR; PG8_SCHED;
            PG8_LDA(At, 0, 1); PG8_STAGE(PG8_SB(0, 0), b2, voffB); PG8_STAGE(PG8_SB(0, 1), b2 + hB, voffB); PG8_STAGE(PG8_SA(0, 0), a2, voffA);
            PG8_WAIT_V(8); PG8_WAIT_L(0); PG8_BAR; PG8_MMA(1, 0, At, B0); PG8_MMA(1, 1, At, B1); PG8_BAR; PG8_SCHED;
            PG8_LDB(B0, 1, 0); PG8_LDB(B1, 1, 1); PG8_SCHED; PG8_LDA(At, 1, 0); PG8_STAGE(PG8_SA(0, 1), a2 + hA, voffA);
            PG8_WAIT_V(8); PG8_WAIT_L(0); PG8_BAR; PG8_MMA(0, 0, At, B0); PG8_MMA(0, 1, At, B1); PG8_BAR; PG8_SCHED;
            PG8_LDA(At, 1, 1); PG8_STAGE(PG8_SB(1, 0), b3, voffB); PG8_STAGE(PG8_SB(1, 1), b3 + hB, voffB); PG8_STAGE(PG8_SA(1, 0), a3, voffA);
            PG8_WAIT_V(8); PG8_WAIT_L(0); PG8_BAR; PG8_MMA(1, 0, At, B0); PG8_MMA(1, 1, At, B1); PG8_BAR; PG8_SCHED;
            } else {
            PG8_LDB(B0, 0, 0); PG8_SCHED; PG8_LDA(At, 0, 0); PG8_STAGE(PG8_SA(1, 1), a1 + hA, voffA);
            PG8_WAIT_L(8); PG8_BAR; PG8_WAIT_L(0); PG8_MMA(0, 0, At, B0); PG8_BAR; PG8_SCHED;
            PG8_LDB(B1, 0, 1); PG8_STAGE(PG8_SB(0, 0), b2, voffB);
            PG8_BAR; PG8_WAIT_L(0); PG8_MMA(0, 1, At, B1); PG8_BAR;
            PG8_LDA(At, 0, 1); PG8_STAGE(PG8_SA(0, 0), a2, voffA);
            PG8_BAR; PG8_WAIT_L(0); PG8_MMA(1, 0, At, B0); PG8_BAR; PG8_SCHED;
            PG8_STAGE(PG8_SB(0, 1), b2 + hB, voffB);
            PG8_WAIT_V(6); PG8_BAR; PG8_MMA(1, 1, At, B1); PG8_BAR;
            PG8_LDB(B0, 1, 0); PG8_SCHED; PG8_LDA(At, 1, 0); PG8_STAGE(PG8_SA(0, 1), a2 + hA, voffA);
            PG8_WAIT_L(8); PG8_BAR; PG8_WAIT_L(0); PG8_MMA(0, 0, At, B0); PG8_BAR; PG8_SCHED;
            PG8_LDB(B1, 1, 1); PG8_STAGE(PG8_SB(1, 0), b3, voffB);
            PG8_BAR; PG8_WAIT_L(0); PG8_MMA(0, 1, At, B1); PG8_BAR;
            PG8_LDA(At, 1, 1); PG8_STAGE(PG8_SA(1, 0), a3, voffA);
            PG8_BAR; PG8_WAIT_L(0); PG8_MMA(1, 0, At, B0); PG8_BAR; PG8_SCHED;
            PG8_STAGE(PG8_SB(1, 1), b3 + hB, voffB);
            PG8_WAIT_V(6); PG8_BAR; PG8_MMA(1, 1, At, B1); PG8_BAR;
            }
        }
        if constexpr (ALIGN_EPI) { if (wr == 0) PG8_BAR; }
        E(acc, cur, wr, wc, fr, fq);
        if (!has_next) break;
        if (!(Epi::ACCUM && cur.half == 0))
#pragma unroll
        for (int a = 0; a < 2; ++a)
#pragma unroll
            for (int b = 0; b < 2; ++b)
#pragma unroll
                for (int m = 0; m < 4; ++m)
#pragma unroll
                    for (int n = 0; n < 2; ++n) acc[a][b][m][n] = (f32x4){0.f, 0.f, 0.f, 0.f};
        cur = nxt; cA = nA; cB = nB; ++ui;
        if constexpr (ALIGN_EPI) { if (wr == 1) PG8_BAR; }
    }
    PG8_WAIT_V(0);
    if constexpr (!ALIGN_EPI) { if (wr == 0) PG8_BAR; }
    PG8_BAR;
#undef PG8_APTR
#undef PG8_BPTR
#undef PG8_SA
#undef PG8_SB
#undef PG8_STAGE
#undef PG8_LDA
#undef PG8_LDB
#undef PG8_MMA
#undef PG8_WAIT_V
#undef PG8_WAIT_L
#undef PG8_BAR
#undef PG8_SCHED
}
}
constexpr int T_TOK = 16384, DM = 1024, SEQ = 4096, NB = 4;
constexpr float EPS = 1e-6f;
constexpr float LOG2E = 1.4426950408889634f;

namespace pg8 {
struct EpiProj {
    static constexpr bool PERM = true, ACCUM = false;
    bf16_t *GQ, *GK, *GV, *GR, *SQ, *SK, *SV, *SGA, *SGB;
    __device__ __forceinline__ void operator()(const f32x4 (&acc)[2][2][4][2], const Unit& u, int wr, int wc, int fr, int fq) const {
        const int pn = u.pn; bf16_t* base; int ldc = 1024, c0; int act = 0; float sc = 1.f;
        if (pn >= 2 && pn < 8) {
            bf16_t* tb = (pn < 4) ? GK : GV; const int f0 = ((pn < 4) ? (pn - 2) : (pn - 4)) * 256 + wr * 64 + fr, t0 = u.pm * BM + wc * 32 + 8 * fq;
#pragma unroll
            for (int ai = 0; ai < 2; ++ai)
#pragma unroll
                for (int m = 0; m < 4; ++m) { bf16_t* rowp = tb + (size_t)(f0 + ai * HALF + m * 16) * T_TOK + t0;
#pragma unroll
                    for (int bj = 0; bj < 2; ++bj) { const f32x4 v0 = acc[ai][bj][m][0], v1 = acc[ai][bj][m][1];
                        u32x4 w; w.x = cvtpk(v0[0], v0[1]); w.y = cvtpk(v0[2], v0[3]); w.z = cvtpk(v1[0], v1[1]); w.w = cvtpk(v1[2], v1[3]);
                        if (PROJ_ST == 2) st_sc1(w, rowp + bj * HALF); else st_nt<PROJ_ST>(w, (u32x4*)(rowp + bj * HALF)); } }
            return; }
        if (pn < 2) { base = GQ; ldc = 512; c0 = pn * 256; sc = 0.08838834764831845f; }
        else if (pn < 4) { base = GK; ldc = 512; c0 = (pn - 2) * 256; }
        else if (pn < 8) { base = GV; c0 = (pn - 4) * 256; }
        else if (pn < 12) { base = GR; c0 = (pn - 8) * 256; act = 1; }
        else if (pn < 16) { base = SQ; c0 = (pn - 12) * 256; sc = 0.125f * LOG2E; }
        else if (pn < 20) { base = SK; c0 = (pn - 16) * 256; }
        else if (pn < 24) { base = SV; c0 = (pn - 20) * 256; }
        else if (pn < 28) { base = SGA; c0 = (pn - 24) * 256; act = 2; }
        else { base = SGB; c0 = (pn - 28) * 256; act = 2; }
        const int row0 = u.pm * BM + wr * 64 + fr, col0 = c0 + wc * 32 + 8 * fq;
#pragma unroll
        for (int ai = 0; ai < 2; ++ai)
#pragma unroll
            for (int m = 0; m < 4; ++m) { bf16_t* rowp = base + (size_t)(row0 + ai * HALF + m * 16) * ldc + col0;
#pragma unroll
                for (int bj = 0; bj < 2; ++bj) { f32x4 v0 = acc[ai][bj][m][0], v1 = acc[ai][bj][m][1];
                    if (act == 1) {
#pragma unroll
                        for (int j = 0; j < 4; ++j) { v0[j] = v0[j] * fast_sigmoid(v0[j]); v1[j] = v1[j] * fast_sigmoid(v1[j]); } }
                    else if (act == 2) {
#pragma unroll
                        for (int j = 0; j < 4; ++j) { v0[j] = fast_sigmoid(v0[j]); v1[j] = fast_sigmoid(v1[j]); } }
                    else { v0 = v0 * sc; v1 = v1 * sc; }
                    u32x4 w; w.x = cvtpk(v0[0], v0[1]); w.y = cvtpk(v0[2], v0[3]); w.z = cvtpk(v1[0], v1[1]); w.w = cvtpk(v1[2], v1[3]);
                    if (PROJ_ST == 2) st_sc1(w, rowp + bj * HALF); else st_nt<PROJ_ST>(w, (u32x4*)(rowp + bj * HALF)); } }
    }
};
template <bool FIRST> struct EpiMix {
    static constexpr bool PERM = true, ACCUM = false;
    const bf16_t* gate; bf16_t* mixed;
    __device__ __forceinline__ void operator()(const f32x4 (&acc)[2][2][4][2], const Unit& u, int wr, int wc, int fr, int fq) const {
        const int row0 = u.pm * BM + wr * 64 + fr, col0 = u.pn * BM + wc * 32 + 8 * fq;
#pragma unroll
        for (int ai = 0; ai < 2; ++ai) {
            u32x4 gv[4][2], mv[4][2];
#pragma unroll
            for (int m = 0; m < 4; ++m)
#pragma unroll
                for (int bj = 0; bj < 2; ++bj) { const size_t off = (size_t)(row0 + ai * HALF + m * 16) * 1024 + col0 + bj * HALF;
                    gv[m][bj] = *(const u32x4*)(gate + off); if (!FIRST) mv[m][bj] = *(const u32x4*)(mixed + off); }
#pragma unroll
            for (int m = 0; m < 4; ++m)
#pragma unroll
                for (int bj = 0; bj < 2; ++bj) { const size_t off = (size_t)(row0 + ai * HALF + m * 16) * 1024 + col0 + bj * HALF;
                    const f32x4 a0 = acc[ai][bj][m][0], a1 = acc[ai][bj][m][1]; const u32x4 g4 = gv[m][bj];
                    float r[8];
                    r[0] = a0[0] * bf_lo(g4.x); r[1] = a0[1] * bf_hi(g4.x); r[2] = a0[2] * bf_lo(g4.y); r[3] = a0[3] * bf_hi(g4.y);
                    r[4] = a1[0] * bf_lo(g4.z); r[5] = a1[1] * bf_hi(g4.z); r[6] = a1[2] * bf_lo(g4.w); r[7] = a1[3] * bf_hi(g4.w);
                    if (!FIRST) { const u32x4 m4 = mv[m][bj];
                        r[0] += bf_lo(m4.x); r[1] += bf_hi(m4.x); r[2] += bf_lo(m4.y); r[3] += bf_hi(m4.y); r[4] += bf_lo(m4.z); r[5] += bf_hi(m4.z); r[6] += bf_lo(m4.w); r[7] += bf_hi(m4.w); }
                    u32x4 w; w.x = cvtpk(r[0], r[1]); w.y = cvtpk(r[2], r[3]); w.z = cvtpk(r[4], r[5]); w.w = cvtpk(r[6], r[7]);
                    *(u32x4*)(mixed + off) = w; }
        }
    }
};
struct EpiMixPair {
    static constexpr bool PERM = true, ACCUM = true;
    const bf16_t* ga; const bf16_t* gb; bf16_t* mixed;
    __device__ __forceinline__ void operator()(f32x4 (&acc)[2][2][4][2], const Unit& u, int wr, int wc, int fr, int fq) const {
        const int row0 = u.pm * BM + wr * 64 + fr, col0 = u.pn * BM + wc * 32 + 8 * fq;
        const float TINY = 8.673617379884035e-19f;
        if (u.half == 0) {
#pragma unroll
            for (int ai = 0; ai < 2; ++ai) {
                u32x4 av[4][2], bv[4][2];
#pragma unroll
                for (int m = 0; m < 4; ++m)
#pragma unroll
                    for (int bj = 0; bj < 2; ++bj) { const size_t off = (size_t)(row0 + ai * HALF + m * 16) * 1024 + col0 + bj * HALF; av[m][bj] = *(const u32x4*)(ga + off); bv[m][bj] = *(const u32x4*)(gb + off); }
#pragma unroll
                for (int m = 0; m < 4; ++m)
#pragma unroll
                    for (int bj = 0; bj < 2; ++bj) { const u32x4 a4 = av[m][bj], b4 = bv[m][bj];
                        const unsigned aw[4] = {a4.x, a4.y, a4.z, a4.w}, bw[4] = {b4.x, b4.y, b4.z, b4.w};
#pragma unroll
                        for (int j = 0; j < 4; ++j) { const float r0 = bf_lo(aw[j]) * __builtin_amdgcn_rcpf(fmaxf(bf_lo(bw[j]), TINY)), r1 = bf_hi(aw[j]) * __builtin_amdgcn_rcpf(fmaxf(bf_hi(bw[j]), TINY));
                            acc[ai][bj][m][j >> 1][2 * (j & 1)] *= r0; acc[ai][bj][m][j >> 1][2 * (j & 1) + 1] *= r1; } }
            }
        } else {
#pragma unroll
            for (int ai = 0; ai < 2; ++ai) {
                u32x4 bv[4][2];
#pragma unroll
                for (int m = 0; m < 4; ++m)
#pragma unroll
                    for (int bj = 0; bj < 2; ++bj) bv[m][bj] = *(const u32x4*)(gb + (size_t)(row0 + ai * HALF + m * 16) * 1024 + col0 + bj * HALF);
#pragma unroll
                for (int m = 0; m < 4; ++m)
#pragma unroll
                    for (int bj = 0; bj < 2; ++bj) { const size_t off = (size_t)(row0 + ai * HALF + m * 16) * 1024 + col0 + bj * HALF; const u32x4 b4 = bv[m][bj];
                        const f32x4 a0 = acc[ai][bj][m][0], a1 = acc[ai][bj][m][1];
                        float r[8];
                        r[0] = a0[0] * fmaxf(bf_lo(b4.x), TINY); r[1] = a0[1] * fmaxf(bf_hi(b4.x), TINY); r[2] = a0[2] * fmaxf(bf_lo(b4.y), TINY); r[3] = a0[3] * fmaxf(bf_hi(b4.y), TINY);
                        r[4] = a1[0] * fmaxf(bf_lo(b4.z), TINY); r[5] = a1[1] * fmaxf(bf_hi(b4.z), TINY); r[6] = a1[2] * fmaxf(bf_lo(b4.w), TINY); r[7] = a1[3] * fmaxf(bf_hi(b4.w), TINY);
                        u32x4 w; w.x = cvtpk(r[0], r[1]); w.y = cvtpk(r[2], r[3]); w.z = cvtpk(r[4], r[5]); w.w = cvtpk(r[6], r[7]);
                        st_nt<NT_EPI>(w, (u32x4*)(mixed + off)); }
            }
        }
    }
};
struct EpiH1 {
    static constexpr bool PERM = true, ACCUM = false;
    const float* x; bf16_t* H1B; float* SSQ;
    __device__ __forceinline__ void operator()(const f32x4 (&acc)[2][2][4][2], const Unit& u, int wr, int wc, int fr, int fq) const {
        const int row0 = u.pm * BM + wr * 64 + fr, col0 = u.pn * BM + wc * 32 + 8 * fq;
#pragma unroll
        for (int ai = 0; ai < 2; ++ai) {
            f32x4 xv[4][2][2];
#pragma unroll
            for (int m = 0; m < 4; ++m)
#pragma unroll
                for (int bj = 0; bj < 2; ++bj)
#pragma unroll
                    for (int n = 0; n < 2; ++n) xv[m][bj][n] = *(const f32x4*)(x + (size_t)(row0 + ai * HALF + m * 16) * 1024 + col0 + bj * HALF + n * 4);
#pragma unroll
            for (int m = 0; m < 4; ++m) { const int row = row0 + ai * HALF + m * 16; const size_t off = (size_t)row * 1024 + col0; float s = 0.f;
#pragma unroll
                for (int bj = 0; bj < 2; ++bj) { const f32x4 h0 = xv[m][bj][0] + acc[ai][bj][m][0], h1 = xv[m][bj][1] + acc[ai][bj][m][1];
                    s += ((h0[0] * h0[0] + h0[1] * h0[1]) + (h0[2] * h0[2] + h0[3] * h0[3])) + ((h1[0] * h1[0] + h1[1] * h1[1]) + (h1[2] * h1[2] + h1[3] * h1[3]));
                    u32x4 hb; hb.x = cvtpk(h0[0], h0[1]); hb.y = cvtpk(h0[2], h0[3]); hb.z = cvtpk(h1[0], h1[1]); hb.w = cvtpk(h1[2], h1[3]); st_nt<NT_EPI>(hb, (u32x4*)(H1B + off + bj * HALF)); }
                s += __shfl_xor(s, 16); s += __shfl_xor(s, 32);
                if (fq == 0) SSQ[(size_t)row * 16 + u.pn * 4 + wc] = s; }
        }
    }
};
struct EpiQ {
    static constexpr bool PERM = true, ACCUM = false;
    const float* SSQ; bf16_t* Q; int ldc;
    __device__ __forceinline__ void operator()(const f32x4 (&acc)[2][2][4][2], const Unit& u, int wr, int wc, int fr, int fq) const {
        const int row0 = u.pm * BM + wr * 64 + fr, col0 = u.pn * BM + wc * 32 + 8 * fq;
        float rstd[2][4];
#pragma unroll
        for (int ai = 0; ai < 2; ++ai) { f32x4 sq[4][4];
#pragma unroll
            for (int m = 0; m < 4; ++m) { const f32x4* sp = (const f32x4*)(SSQ + (size_t)(row0 + ai * HALF + m * 16) * 16);
#pragma unroll
                for (int j = 0; j < 4; ++j) sq[m][j] = sp[j]; }
#pragma unroll
            for (int m = 0; m < 4; ++m) { const f32x4 st = (sq[m][0] + sq[m][1]) + (sq[m][2] + sq[m][3]);
                rstd[ai][m] = __builtin_amdgcn_rsqf(((st[0] + st[1]) + (st[2] + st[3])) * (1.0f / 1024.0f) + EPS); } }
#pragma unroll
        for (int ai = 0; ai < 2; ++ai)
#pragma unroll
            for (int m = 0; m < 4; ++m) { const int row = row0 + ai * HALF + m * 16;
                bf16_t* rowp = Q + (size_t)row * ldc + col0;
#pragma unroll
                for (int bj = 0; bj < 2; ++bj) { const f32x4 v0 = acc[ai][bj][m][0] * rstd[ai][m], v1 = acc[ai][bj][m][1] * rstd[ai][m];
                    u32x4 w; w.x = cvtpk(v0[0], v0[1]); w.y = cvtpk(v0[2], v0[3]); w.z = cvtpk(v1[0], v1[1]); w.w = cvtpk(v1[2], v1[3]);
                    st_nt<NT_Q>(w, (u32x4*)(rowp + bj * HALF)); } }
    }
};
struct EpiF32 {
    static constexpr bool PERM = false, ACCUM = false;
    float* O; int ldc;
    __device__ __forceinline__ void operator()(const f32x4 (&acc)[2][2][4][2], const Unit& u, int wr, int wc, int fr, int fq) const {
        const int row0 = u.pm * BM + wr * 64 + fr, col0 = u.pn * BM + wc * 32 + 4 * fq;
#pragma unroll
        for (int ai = 0; ai < 2; ++ai)
#pragma unroll
            for (int m = 0; m < 4; ++m) { float* rowp = O + (size_t)(row0 + ai * HALF + m * 16) * ldc + col0;
#pragma unroll
                for (int bj = 0; bj < 2; ++bj)
#pragma unroll
                    for (int n = 0; n < 2; ++n) *(f32x4*)(rowp + bj * HALF + n * 16) = acc[ai][bj][m][n]; }
    }
};
struct EpiBf {
    static constexpr bool PERM = true, ACCUM = false;
    bf16_t* O; int ldc;
    __device__ __forceinline__ void operator()(const f32x4 (&acc)[2][2][4][2], const Unit& u, int wr, int wc, int fr, int fq) const {
        const int row0 = u.pm * BM + wr * 64 + fr, col0 = u.pn * BM + wc * 32 + 8 * fq;
#pragma unroll
        for (int ai = 0; ai < 2; ++ai)
#pragma unroll
            for (int m = 0; m < 4; ++m) { bf16_t* rowp = O + (size_t)(row0 + ai * HALF + m * 16) * ldc + col0;
#pragma unroll
                for (int bj = 0; bj < 2; ++bj) { const f32x4 v0 = acc[ai][bj][m][0], v1 = acc[ai][bj][m][1];
                    u32x4 w; w.x = cvtpk(v0[0], v0[1]); w.y = cvtpk(v0[2], v0[3]); w.z = cvtpk(v1[0], v1[1]); w.w = cvtpk(v1[2], v1[3]);
                    st_nt<NT_EPI>(w, (u32x4*)(rowp + bj * HALF)); } }
    }
};
struct EpiH3 {
    static constexpr bool PERM = false, ACCUM = false;
    const bf16_t* H2B; const bf16_t* PLE; const float* RS; bf16_t* H3B; float* SSQ; int dry;
    __device__ __forceinline__ void operator()(const f32x4 (&acc)[2][2][4][2], const Unit& u, int wr, int wc, int fr, int fq) const {
        const int row0 = u.pm * BM + wr * 64 + fr, col0 = u.pn * BM + wc * 32 + 4 * fq;
#pragma unroll
        for (int ai = 0; ai < 2; ++ai) {
            u32x2 hv[4][2][2], pv[4][2][2]; float rs[4];
#pragma unroll
            for (int m = 0; m < 4; ++m) rs[m] = RS[row0 + ai * HALF + m * 16];
#pragma unroll
            for (int m = 0; m < 4; ++m)
#pragma unroll
                for (int bj = 0; bj < 2; ++bj)
#pragma unroll
                    for (int n = 0; n < 2; ++n) { const size_t o2 = (size_t)(row0 + ai * HALF + m * 16) * 1024 + col0 + bj * HALF + n * 16; hv[m][bj][n] = *(const u32x2*)(H2B + o2); pv[m][bj][n] = *(const u32x2*)(PLE + o2); }
#pragma unroll
            for (int m = 0; m < 4; ++m) { const int row = row0 + ai * HALF + m * 16; const size_t off = (size_t)row * 1024 + col0; float s = 0.f;
#pragma unroll
                for (int bj = 0; bj < 2; ++bj)
#pragma unroll
                    for (int n = 0; n < 2; ++n) { const size_t o2 = off + bj * HALF + n * 16; const u32x2 h2 = hv[m][bj][n], p2 = pv[m][bj][n];
                        const f32x4 a = acc[ai][bj][m][n] * rs[m]; f32x4 h;
                        h[0] = bf_lo(h2.x) + bf_lo(p2.x) * fast_sigmoid(a[0]); h[1] = bf_hi(h2.x) + bf_hi(p2.x) * fast_sigmoid(a[1]);
                        h[2] = bf_lo(h2.y) + bf_lo(p2.y) * fast_sigmoid(a[2]); h[3] = bf_hi(h2.y) + bf_hi(p2.y) * fast_sigmoid(a[3]);
                        u32x2 w; w.x = cvtpk(h[0], h[1]); w.y = cvtpk(h[2], h[3]); if (!dry) *(u32x2*)(H3B + o2) = w;
                        s += (h[0] * h[0] + h[1] * h[1]) + (h[2] * h[2] + h[3] * h[3]); }
                s += __shfl_xor(s, 16); s += __shfl_xor(s, 32);
                if (fq == 0) SSQ[(size_t)row * 16 + u.pn * 4 + wc] = s; }
        }
    }
};
constexpr int H3L_PITCH = 544;
struct EpiH3L {
    static constexpr bool PERM = true, ACCUM = false;
    const bf16_t* H2B; const bf16_t* PLE; const float* RS; LAS unsigned char* tile; float* SSQ;
    __device__ __forceinline__ void operator()(const f32x4 (&acc)[2][2][4][2], const Unit& u, int wr, int wc, int fr, int fq) const {
        const int lrow0 = wr * 64 + fr, lcol0 = wc * 32 + 8 * fq, row0 = u.pm * BM + lrow0, col0 = u.pn * BM + lcol0;
        asm volatile("s_waitcnt vmcnt(0)" ::: "memory"); __builtin_amdgcn_s_barrier();
#pragma unroll
        for (int ai = 0; ai < 2; ++ai) {
            u32x4 hv[4][2], pv[4][2]; float rs[4];
#pragma unroll
            for (int m = 0; m < 4; ++m) rs[m] = RS[row0 + ai * HALF + m * 16];
#pragma unroll
            for (int m = 0; m < 4; ++m)
#pragma unroll
                for (int bj = 0; bj < 2; ++bj) { const size_t o2 = (size_t)(row0 + ai * HALF + m * 16) * 1024 + col0 + bj * HALF; hv[m][bj] = *(const u32x4*)(H2B + o2); pv[m][bj] = *(const u32x4*)(PLE + o2); }
#pragma unroll
            for (int m = 0; m < 4; ++m) { const int lrow = lrow0 + ai * HALF + m * 16; float s = 0.f;
#pragma unroll
                for (int bj = 0; bj < 2; ++bj) { const u32x4 h4 = hv[m][bj], p4 = pv[m][bj];
                    const f32x4 a0 = acc[ai][bj][m][0] * rs[m], a1 = acc[ai][bj][m][1] * rs[m]; float h[8];
                    h[0] = bf_lo(h4.x) + bf_lo(p4.x) * fast_sigmoid(a0[0]); h[1] = bf_hi(h4.x) + bf_hi(p4.x) * fast_sigmoid(a0[1]);
                    h[2] = bf_lo(h4.y) + bf_lo(p4.y) * fast_sigmoid(a0[2]); h[3] = bf_hi(h4.y) + bf_hi(p4.y) * fast_sigmoid(a0[3]);
                    h[4] = bf_lo(h4.z) + bf_lo(p4.z) * fast_sigmoid(a1[0]); h[5] = bf_hi(h4.z) + bf_hi(p4.z) * fast_sigmoid(a1[1]);
                    h[6] = bf_lo(h4.w) + bf_lo(p4.w) * fast_sigmoid(a1[2]); h[7] = bf_hi(h4.w) + bf_hi(p4.w) * fast_sigmoid(a1[3]);
                    u32x4 w; w.x = cvtpk(h[0], h[1]); w.y = cvtpk(h[2], h[3]); w.z = cvtpk(h[4], h[5]); w.w = cvtpk(h[6], h[7]);
                    *(LAS u32x4*)(tile + lrow * H3L_PITCH + (lcol0 + bj * HALF) * 2) = w;
                    s += ((h[0] * h[0] + h[1] * h[1]) + (h[2] * h[2] + h[3] * h[3])) + ((h[4] * h[4] + h[5] * h[5]) + (h[6] * h[6] + h[7] * h[7])); }
                s += __shfl_xor(s, 16); s += __shfl_xor(s, 32);
                if (fq == 0) SSQ[(size_t)(u.pm * BM + lrow) * 16 + u.pn * 4 + wc] = s; }
        }
    }
};
}
constexpr size_t MiB = 1u << 20;
constexpr size_t WS_CTL = 0, CTL_ZERO_BYTES = 64 * 1024;
constexpr size_t WS_PEND = 64 * 1024;
constexpr size_t WS_WPLE = 512 * 1024;
constexpr size_t WS_KD = 1 * MiB;
constexpr size_t WS_GLAG = 2 * MiB;
constexpr size_t WS_WIN = 3 * MiB;
constexpr size_t WS_SEND = 4 * MiB;
constexpr size_t WS_EXP = 4 * MiB;
constexpr size_t WS_SSQ1 = 13 * MiB;
constexpr size_t WS_SSQ3 = 14 * MiB;
constexpr size_t WS_RS3 = 15 * MiB;
constexpr size_t WS_RSU = 1536 * 1024, WS_RSV = 1536 * 1024 + 64 * 1024;
constexpr size_t WS_WGA = 20 * MiB, WS_WSB = 22 * MiB, WS_WO = 24 * MiB, WS_WPG = 26 * MiB, WS_WPQ = 28 * MiB;
constexpr size_t WS_A = 32 * MiB;
constexpr size_t WS_GQ = WS_A, WS_GK = WS_A + 16 * MiB;
constexpr size_t WS_B = 64 * MiB;
constexpr size_t WS_GV = WS_B, WS_PB = WS_B;
constexpr size_t WS_C = 96 * MiB;
constexpr size_t WS_GR = WS_C, WS_GLAN = WS_C, WS_H1 = WS_C, WS_H3B = WS_C;
constexpr size_t WS_D = 128 * MiB;
constexpr size_t WS_SQ = WS_D, WS_H2B = WS_D;
constexpr size_t WS_E = 160 * MiB;
constexpr size_t WS_SK = WS_E, WS_MIX = WS_E, WS_Q = WS_E, WS_PLE = WS_E;
constexpr size_t WS_F = 192 * MiB;
constexpr size_t WS_SV = WS_F;
constexpr size_t WS_G = 224 * MiB;
constexpr size_t WS_XN1 = WS_G, WS_UB8 = WS_G, WS_VB8 = WS_G + 16 * MiB;
constexpr size_t WS_END = 256 * MiB;

constexpr int NWAVES = 8;
constexpr int RING_OFF = 0, RING_BYTES = 131072;
constexpr int MISC_OFF = 143360;
constexpr int LDS_BYTES = 147456;
constexpr int CW_BAR = 1024;
constexpr int CW_ROWCNT = 512;

typedef GAS unsigned gu32;
#define RLX_AGENT __ATOMIC_RELAXED, __HIP_MEMORY_SCOPE_AGENT
#define LDS_WAIT() asm volatile("s_waitcnt lgkmcnt(0)" ::: "memory")
#define VM_WAIT() asm volatile("s_waitcnt vmcnt(0)" ::: "memory")

#define XB_TMO      128
#define XB_XCNT(j)  (256  + 64 * (j))
#define XB_XSUB(j)  (1280 + 64 * (j))
#define XB_XGEN(j)  (2304 + 64 * (j))
#define XB_TOP      3328
#define XB_TOPGEN   3392
#define XCD_BAR_WORDS 3456
#define XB_SPIN_CAP (1u << 22)
__device__ __forceinline__ unsigned xb_ld(unsigned* p)              { return __hip_atomic_load(p, __ATOMIC_RELAXED, __HIP_MEMORY_SCOPE_AGENT); }
__device__ __forceinline__ unsigned xb_add(unsigned* p, unsigned v) { return __hip_atomic_fetch_add(p, v, __ATOMIC_RELAXED, __HIP_MEMORY_SCOPE_AGENT); }
__device__ __forceinline__ unsigned xb_xcc_id() { return (unsigned)__builtin_amdgcn_s_getreg((3 << 11) | 20) & 0xFu; }
#define XB_SPIN(cond, bar) do { unsigned _sp = 0; while (cond) { __builtin_amdgcn_s_sleep(1); \
    if ((++_sp & 255u) == 0u) { if (xb_ld(&(bar)[XB_TMO])) break; if (_sp > XB_SPIN_CAP) { atomicAdd(&(bar)[XB_TMO], 1u); break; } } } } while (0)
struct XcdBarrier { unsigned* bar; unsigned x; volatile LAS unsigned* st; };
__device__ __forceinline__ XcdBarrier xcd_barrier_post(unsigned* bar, volatile LAS unsigned* st, int tid) {
    XcdBarrier b; b.bar = bar; b.x = xb_xcc_id(); b.st = st;
    if (tid == 0) (void)xb_add(&bar[XB_XCNT(b.x)], 1u);
    return b;
}
__device__ __forceinline__ void xcd_barrier_complete(unsigned* bar, unsigned x, unsigned& nloc, unsigned& nx) {
    const unsigned G = gridDim.x * gridDim.y * gridDim.z;
    unsigned sum, cnt, mine, sp = 0u;
    for (;;) {
        sum = 0u; cnt = 0u; mine = 0u;
#pragma unroll
        for (unsigned j = 0; j < 16; ++j) { const unsigned c = xb_ld(&bar[XB_XCNT(j)]); sum += c; cnt += (c > 0u) ? 1u : 0u; mine = (j == x) ? c : mine; }
        if (sum == G) break;
        __builtin_amdgcn_s_sleep(1);
        if ((++sp & 255u) == 0u) { if (xb_ld(&bar[XB_TMO])) break; if (sp > XB_SPIN_CAP) { atomicAdd(&bar[XB_TMO], 1u); break; } }
    }
    nloc = mine > 0u ? mine : 1u; nx = cnt > 0u ? cnt : 1u;
}
__device__ __forceinline__ void xcd_barrier(const XcdBarrier& b, int tid) {
    asm volatile("s_waitcnt vmcnt(0)" ::: "memory");
    __syncthreads();
    if (tid == 0) {
        unsigned* bar = b.bar;
        __builtin_amdgcn_s_waitcnt(0);
        unsigned nloc = b.st[0], nx = b.st[1];
        if (nloc == 0u) { xcd_barrier_complete(bar, b.x, nloc, nx); b.st[0] = nloc; b.st[1] = nx; }
        const unsigned old = xb_add(&bar[XB_XSUB(b.x)], 1u);
        const unsigned gen = old / nloc;
        if (old + 1u == (gen + 1u) * nloc) {
            __builtin_amdgcn_fence(__ATOMIC_RELEASE, "agent");
            asm volatile("s_waitcnt vmcnt(0)" ::: "memory");
            const unsigned og = xb_add(&bar[XB_TOP], 1u);
            const unsigned tg = og / nx;
            if (og + 1u == (tg + 1u) * nx) xb_add(&bar[XB_TOPGEN], 1u);
            else XB_SPIN(xb_ld(&bar[XB_TOPGEN]) == tg, bar);
            __builtin_amdgcn_fence(__ATOMIC_ACQUIRE, "agent");
            xb_add(&bar[XB_XGEN(b.x)], 1u);
            asm volatile("s_waitcnt vmcnt(0)" ::: "memory");
        } else {
            XB_SPIN(xb_ld(&bar[XB_XGEN(b.x)]) == gen, bar);
            __builtin_amdgcn_fence(__ATOMIC_ACQUIRE, "agent");
            asm volatile("s_waitcnt vmcnt(0)" ::: "memory");
        }
    }
    __syncthreads();
}

struct Frame {
    LAS unsigned char* lds;
    int tid, lane, wave, vcu, G, dry;
    const float* const* in; float* out; unsigned char* ws;
};
__device__ __forceinline__ int lane_id() { int l; asm volatile("v_mbcnt_lo_u32_b32 %0, -1, 0\n\tv_mbcnt_hi_u32_b32 %0, -1, %0" : "=v"(l)); return l; }
#define WSP(T, off) ((T*)(F.ws + (off)))
__device__ __forceinline__ float wave_sum(float v) {
#pragma unroll
    for (int o = 1; o < 64; o <<= 1) v += __shfl_xor(v, o);
    return v;
}
template <class RowMap>
__device__ __forceinline__ void p0_transpose_item(const float* W, int K, int N, bf16_t* WT, RowMap rm, LAS float* scr, int item, int lane, const float* gk = nullptr) {
    const int nblk = (N + 31) / 32, kb = item / nblk, nb = item % nblk, k0 = 64 * kb, n0 = 32 * nb;
    { const int kr = lane >> 3, c4 = lane & 7, nl = n0 + 4 * c4; f32x4 v[8];
#pragma unroll
      for (int i = 0; i < 8; ++i) v[i] = (nl < N) ? *(const f32x4*)(W + (size_t)(k0 + 8 * i + kr) * N + nl) : (f32x4){0.f, 0.f, 0.f, 0.f};
#pragma unroll
      for (int i = 0; i < 8; ++i) { LAS float* d = scr + (8 * i + kr) * 33 + 4 * c4; d[0] = v[i][0]; d[1] = v[i][1]; d[2] = v[i][2]; d[3] = v[i][3]; } }
    LDS_WAIT(); asm volatile("" ::: "memory");
    const int c = lane & 7;
#pragma unroll
    for (int j = 0; j < 4; ++j) { const int n = (lane >> 3) + 8 * j; const LAS float* s = scr + (8 * c) * 33 + n;
        f32x4 ga = (f32x4){1.f, 1.f, 1.f, 1.f}, gb = ga; if (gk) { ga = *(const f32x4*)(gk + k0 + 8 * c); gb = *(const f32x4*)(gk + k0 + 8 * c + 4); }
        u32x4 o; o.x = cvtpk(s[0 * 33] * ga[0], s[1 * 33] * ga[1]); o.y = cvtpk(s[2 * 33] * ga[2], s[3 * 33] * ga[3]); o.z = cvtpk(s[4 * 33] * gb[0], s[5 * 33] * gb[1]); o.w = cvtpk(s[6 * 33] * gb[2], s[7 * 33] * gb[3]);
        if (n0 + n < N) st_nt<NT_PRE>(o, (u32x4*)(WT + (size_t)rm(n0 + n) * K + k0 + 8 * c)); }
    LDS_WAIT(); asm volatile("" ::: "memory");
}
struct RmId { __device__ __forceinline__ int operator()(int n) const { return n; } };
struct RmWin { __device__ __forceinline__ int operator()(int n) const { return n < 3072 ? n : (n < 3088 ? 8192 + (n - 3072) : n - 16); } };

__device__ __forceinline__ void cvt_copy(Frame& F, const float* src, bf16_t* dst, size_t n) {
    const size_t nth = (size_t)F.G * 512, n8 = n / 8;
    for (size_t i = (size_t)F.vcu * 512 + F.tid; i < n8; i += nth) {
        const f32x4 a = *(const f32x4*)(src + i * 8), b = *(const f32x4*)(src + i * 8 + 4);
        u32x4 o; o.x = cvtpk(a[0], a[1]); o.y = cvtpk(a[2], a[3]); o.z = cvtpk(b[0], b[1]); o.w = cvtpk(b[2], b[3]);
        st_nt<NT_PRE>(o, (u32x4*)(dst + i * 8)); }
}
__device__ __forceinline__ void rms_row_to_bf16(const float* xrow, const float* g, bf16_t* orow, int lane) {
    f32x4 v[4]; float s = 0.f;
#pragma unroll
    for (int j = 0; j < 4; ++j) { v[j] = *((const f32x4*)xrow + lane + 64 * j); s += (v[j][0] * v[j][0] + v[j][1] * v[j][1]) + (v[j][2] * v[j][2] + v[j][3] * v[j][3]); }
    const float rstd = __builtin_amdgcn_rsqf(wave_sum(s) * (1.f / 1024.f) + EPS);
#pragma unroll
    for (int j = 0; j < 4; ++j) { const f32x4 gv = *((const f32x4*)g + lane + 64 * j); const f32x4 o = v[j] * rstd * gv;
        u32x2 w; w.x = cvtpk(o[0], o[1]); w.y = cvtpk(o[2], o[3]); *((u32x2*)orow + lane + 64 * j) = w; }
}
__device__ __forceinline__ void phase_prologue(Frame& F) {
    LAS float* scr = (LAS float*)(F.lds + RING_OFF + F.wave * 16384);
    const int gw = F.vcu * NWAVES + F.wave, NGW = F.G * NWAVES;
    constexpr int I_IN = 16 * 257, I_SQ = 16 * 32, I_PQ = 16 * 64, I_PLE = 4 * 32;
    constexpr int NITEMS = I_IN + 4 * I_SQ + I_PQ + I_PLE;
    for (int it = gw; it < NITEMS; it += NGW) {
        int r = it;
        if (r < I_IN) { p0_transpose_item(F.in[3], 1024, 8208, WSP(bf16_t, WS_WIN), RmWin(), scr, r, F.lane); continue; } r -= I_IN;
        if (r < I_SQ) { p0_transpose_item(F.in[7], 1024, 1024, WSP(bf16_t, WS_WGA), RmId(), scr, r, F.lane); continue; } r -= I_SQ;
        if (r < I_SQ) { p0_transpose_item(F.in[8], 1024, 1024, WSP(bf16_t, WS_WSB), RmId(), scr, r, F.lane); continue; } r -= I_SQ;
        if (r < I_SQ) { p0_transpose_item(F.in[9], 1024, 1024, WSP(bf16_t, WS_WO), RmId(), scr, r, F.lane); continue; } r -= I_SQ;
        if (r < I_SQ) { p0_transpose_item(F.in[17], 1024, 1024, WSP(bf16_t, WS_WPG), RmId(), scr, r, F.lane, F.in[16]); continue; } r -= I_SQ;
        if (r < I_PQ) { p0_transpose_item(F.in[11], 1024, 2048, WSP(bf16_t, WS_WPQ), RmId(), scr, r, F.lane, F.in[10]); continue; } r -= I_PQ;
        p0_transpose_item(F.in[18], 256, 1024, WSP(bf16_t, WS_WPLE), RmId(), scr, r, F.lane);
    }
    { const float* k1 = F.in[12]; const float* k2 = F.in[13]; bf16_t* KB = WSP(bf16_t, WS_KD);
      for (int i = F.vcu * 512 + F.tid; i < 2 * 8 * 128 * 16; i += F.G * 512) { const int half = i >> 14, rem = i & 16383, h = rem >> 11, r8 = rem & 2047;
          const float* s = (half ? k2 : k1) + (size_t)h * 16384 + (size_t)r8 * 8; const f32x4 a = *(const f32x4*)s, b = *(const f32x4*)(s + 4);
          u32x4 o; o.x = cvtpk(a[0], a[1]); o.y = cvtpk(a[2], a[3]); o.z = cvtpk(b[0], b[1]); o.w = cvtpk(b[2], b[3]);
          *(u32x4*)(KB + (size_t)(h * 2 + half) * 16384 + (size_t)r8 * 8) = o; } }
    for (int m = gw; m < T_TOK; m += 4 * NGW) {
        f32x4 v[4][4]; float s[4];
#pragma unroll
        for (int q = 0; q < 4; ++q) { const float* xr = F.in[0] + (size_t)(m + q * NGW) * 1024; s[q] = 0.f;
#pragma unroll
            for (int j = 0; j < 4; ++j) { v[q][j] = *((const f32x4*)xr + F.lane + 64 * j); s[q] += (v[q][j][0] * v[q][j][0] + v[q][j][1] * v[q][j][1]) + (v[q][j][2] * v[q][j][2] + v[q][j][3] * v[q][j][3]); } }
#pragma unroll
        for (int o = 1; o < 64; o <<= 1) {
#pragma unroll
            for (int q = 0; q < 4; ++q) s[q] += __shfl_xor(s[q], o); }
#pragma unroll
        for (int q = 0; q < 4; ++q) { const float rstd = __builtin_amdgcn_rsqf(s[q] * (1.f / 1024.f) + EPS); bf16_t* orow = WSP(bf16_t, WS_XN1) + (size_t)(m + q * NGW) * 1024;
#pragma unroll
            for (int j = 0; j < 4; ++j) { const f32x4 gv = *((const f32x4*)F.in[2] + F.lane + 64 * j); const f32x4 o = v[q][j] * rstd * gv;
                u32x2 wq; wq.x = cvtpk(o[0], o[1]); wq.y = cvtpk(o[2], o[3]); st_nt<NT_PRE>(wq, (u32x2*)orow + F.lane + 64 * j); } }
    }
}

__device__ __forceinline__ void phase_gla_prep(Frame& F) {
    LAS float* alo = (LAS float*)(F.lds + RING_OFF);
    const bf16_t* XN1 = WSP(bf16_t, WS_XN1); const bf16_t* WGAT = WSP(bf16_t, WS_WIN) + (size_t)8192 * 1024;
    bf16_t* GKT = WSP(bf16_t, WS_GK); float* GLAG = WSP(float, WS_GLAG);
    const float* w_up = F.in[4]; const float* b_a = F.in[5];
    const int tid = F.tid, lane = F.lane, w = F.wave;
    for (int u = F.vcu; u < 256; u += F.G) {
        const size_t r0 = (size_t)u * 64;
        __syncthreads();
        const int kk = tid;
        bf16_t* krow = GKT + (size_t)kk * T_TOK + r0;
        u32x4 kq[8];
#pragma unroll
        for (int j = 0; j < 8; ++j) kq[j] = *(const u32x4*)(krow + 8 * j);
        {
            LAS float* part = alo + 1024;
            const bf16_t* bp = WGAT + (size_t)(lane & 15) * 1024 + 8 * (lane >> 4) + 128 * w;
            bf16x8 bq[4];
#pragma unroll
            for (int s = 0; s < 4; ++s) bq[s] = *(const bf16x8*)(bp + 32 * s);
#pragma unroll
            for (int rt = 0; rt < 4; ++rt) { f32x4 acc = (f32x4){0.f, 0.f, 0.f, 0.f};
                const bf16_t* ap = XN1 + (r0 + 16 * rt + (lane & 15)) * 1024 + 8 * (lane >> 4) + 128 * w;
#pragma unroll
                for (int s = 0; s < 4; ++s) { const bf16x8 a = *(const bf16x8*)(ap + 32 * s); acc = __builtin_amdgcn_mfma_f32_16x16x32_bf16(a, bq[s], acc, 0, 0, 0); }
#pragma unroll
                for (int r = 0; r < 4; ++r) part[w * 1024 + (16 * rt + 4 * (lane >> 4) + r) * 16 + (lane & 15)] = acc[r]; }
            __syncthreads();
#pragma unroll
            for (int q = 0; q < 2; ++q) { const int e = tid + 512 * q; float s = 0.f;
#pragma unroll
                for (int ww = 0; ww < 8; ++ww) s += part[ww * 1024 + e];
                alo[e] = s; }
        }
        float wv[16];
#pragma unroll
        for (int r = 0; r < 16; ++r) wv[r] = w_up[r * 512 + kk];
        const float bias = b_a[kk];
        __syncthreads();
        float suffix = 0.f;
#pragma unroll
        for (int i8 = 7; i8 >= 0; --i8) {
            const unsigned kw[4] = {kq[i8].x, kq[i8].y, kq[i8].z, kq[i8].w};
            float o[8];
#pragma unroll
            for (int j = 7; j >= 0; --j) { const int i = i8 * 8 + j;
                const f32x4 a0 = *(const LAS f32x4*)(alo + i * 16), a1 = *(const LAS f32x4*)(alo + i * 16 + 4), a2 = *(const LAS f32x4*)(alo + i * 16 + 8), a3 = *(const LAS f32x4*)(alo + i * 16 + 12);
                float x = bias;
                x += a0[0] * wv[0] + a0[1] * wv[1] + a0[2] * wv[2] + a0[3] * wv[3];
                x += a1[0] * wv[4] + a1[1] * wv[5] + a1[2] * wv[6] + a1[3] * wv[7];
                x += a2[0] * wv[8] + a2[1] * wv[9] + a2[2] * wv[10] + a2[3] * wv[11];
                x += a3[0] * wv[12] + a3[1] * wv[13] + a3[2] * wv[14] + a3[3] * wv[15];
                const float la = (fminf(x, 0.f) - __logf(1.0f + __expf(-fabsf(x)))) * (1.0f / 16.0f);
                const float kvv = (j & 1) ? bf_hi(kw[j >> 1]) : bf_lo(kw[j >> 1]);
                o[j] = kvv * __expf(suffix);
                suffix += la; }
            u32x4 pk; pk.x = cvtpk(o[0], o[1]); pk.y = cvtpk(o[2], o[3]); pk.z = cvtpk(o[4], o[5]); pk.w = cvtpk(o[6], o[7]);
            if (!F.dry) st_nt<NT_PRE>(pk, (u32x4*)(krow + i8 * 8)); }
        GLAG[(size_t)u * 512 + kk] = __expf(suffix);
    }
}
constexpr int GL_KD = 0, GL_Q = 32768, GL_G = 65536, GL_RED = 65536 + 1024, GL_OT = 65536 + 1024 + 4096, GL_OT_PITCH = 260;
__device__ __forceinline__ int gl_kd_off(int row, int chunk) { return row * 128 + ((chunk ^ ((row >> 1) & 7)) << 4); }
__device__ __forceinline__ int gl_q_off(int row, int chunk16) { return row * 256 + ((chunk16 ^ (row & 15)) << 4); }

struct GlaStage { u32x4 kd[2]; u32x4 q[2]; bf16x8 vt[4]; float g; };
__device__ __forceinline__ void gla_prefetch_vt(Frame& F, GlaStage& st, int b, int h, int c) {
    const int u = b * 64 + c; const size_t r0 = (size_t)u * 64; const int w = F.wave, lq = F.lane & 31, hh = F.lane >> 5;
    const bf16_t* vt = WSP(bf16_t, WS_GV) + (size_t)(h * 256 + 32 * w + lq) * T_TOK + r0;
#pragma unroll
    for (int ts = 0; ts < 4; ++ts) st.vt[ts] = *(const bf16x8*)(vt + 16 * ts + 8 * hh);
}
template <bool WITH_Q>
__device__ __forceinline__ void gla_prefetch(Frame& F, GlaStage& st, int b, int h, int c) {
    const int u = b * 64 + c; const size_t r0 = (size_t)u * 64; const int tid = F.tid;
    const bf16_t* kd = WSP(bf16_t, WS_GK) + (size_t)(h * 128) * T_TOK + r0;
#pragma unroll
    for (int j = 0; j < 2; ++j) { const int pi = tid + 512 * j; st.kd[j] = *(const u32x4*)(kd + (size_t)(pi >> 3) * T_TOK + (pi & 7) * 8); }
    if (WITH_Q) { const bf16_t* gq = WSP(bf16_t, WS_GQ) + r0 * 512 + h * 128;
#pragma unroll
        for (int j = 0; j < 2; ++j) { const int pi = tid + 512 * j; st.q[j] = *(const u32x4*)(gq + (size_t)(pi >> 4) * 512 + (pi & 15) * 8); } }
    st.g = (tid < 128) ? WSP(float, WS_GLAG)[((size_t)u * 4 + h) * 128 + tid] : 1.f;
}
template <bool WITH_Q>
__device__ __forceinline__ void gla_stage_write(Frame& F, const GlaStage& st, int buf) {
    LAS unsigned char* lds = F.lds + RING_OFF; const int tid = F.tid;
#pragma unroll
    for (int j = 0; j < 2; ++j) { const int pi = tid + 512 * j; *(LAS u32x4*)(lds + GL_KD + buf * 16384 + gl_kd_off(pi >> 3, pi & 7)) = st.kd[j]; }
    if (WITH_Q) {
#pragma unroll
        for (int j = 0; j < 2; ++j) { const int pi = tid + 512 * j; *(LAS u32x4*)(lds + GL_Q + buf * 16384 + gl_q_off(pi >> 4, pi & 15)) = st.q[j]; } }
    if (tid < 128) *(LAS float*)(lds + GL_G + buf * 512 + tid * 4) = st.g;
}
__device__ __forceinline__ void gla_update(Frame& F, f32x16 (&S)[4], const bf16x8 (&vt)[4], int buf) {
    const LAS unsigned char* lds = F.lds + RING_OFF; const int lq = F.lane & 31, hh = F.lane >> 5;
    const LAS float* G = (const LAS float*)(lds + GL_G + buf * 512);
#pragma unroll
    for (int kt = 0; kt < 4; ++kt)
#pragma unroll
        for (int g4 = 0; g4 < 4; ++g4) { const f32x4 g = *(const LAS f32x4*)(G + 32 * kt + 8 * g4 + 4 * hh);
#pragma unroll
            for (int j = 0; j < 4; ++j) S[kt][4 * g4 + j] *= g[j]; }
#pragma unroll
    for (int ts = 0; ts < 4; ++ts)
#pragma unroll
        for (int kt = 0; kt < 4; ++kt) { const bf16x8 a = *(const LAS bf16x8*)(lds + GL_KD + buf * 16384 + gl_kd_off(32 * kt + lq, 2 * ts + hh));
            S[kt] = __builtin_amdgcn_mfma_f32_32x32x16_bf16(a, vt[ts], S[kt], 0, 0, 0); if (kt == 3 && (ts & 1)) __builtin_amdgcn_sched_barrier(0); }
}
constexpr size_t SEND_WAVE_FLOATS = 4 * 4 * 64 * 4;
__device__ __forceinline__ void gla_stage1(Frame& F, int unit) {
    const int bh = unit >> 3, seg = unit & 7, b = bh >> 2, h = bh & 3, w = F.wave, l = F.lane;
    f32x16 S[4];
#pragma unroll
    for (int kt = 0; kt < 4; ++kt)
#pragma unroll
        for (int r = 0; r < 16; ++r) S[kt][r] = 0.f;
    float pend = 1.f;
    GlaStage st; gla_prefetch<false>(F, st, b, h, seg * 8); gla_prefetch_vt(F, st, b, h, seg * 8);
    for (int ci = 0; ci < 8; ++ci) {
        gla_stage_write<false>(F, st, ci & 1); pend *= st.g;
        __syncthreads();
        if (ci < 7) gla_prefetch<false>(F, st, b, h, seg * 8 + ci + 1);
        gla_update(F, S, st.vt, ci & 1);
        if (ci < 7) gla_prefetch_vt(F, st, b, h, seg * 8 + ci + 1);
    }
    float* se = WSP(float, WS_SEND) + ((size_t)unit * 8 + w) * SEND_WAVE_FLOATS;
#pragma unroll
    for (int kt = 0; kt < 4; ++kt)
#pragma unroll
        for (int g4 = 0; g4 < 4; ++g4) st_nt<NT_ATT>((f32x4){S[kt][4 * g4], S[kt][4 * g4 + 1], S[kt][4 * g4 + 2], S[kt][4 * g4 + 3]}, (f32x4*)(se + ((kt * 4 + g4) * 64 + l) * 4));
    if (F.tid < 128) WSP(float, WS_PEND)[unit * 128 + F.tid] = pend;
    __syncthreads();
}
__device__ __forceinline__ void gla_stage3(Frame& F, int unit) {
    const int bh = unit >> 3, seg = unit & 7, b = bh >> 2, h = bh & 3, w = F.wave, l = F.lane, lq = l & 31, hh = l >> 5;
    LAS unsigned char* lds = F.lds + RING_OFF;
    const bf16_t* GR = WSP(bf16_t, WS_GR); bf16_t* GLAN = WSP(bf16_t, WS_GLAN); const float* g_o = F.in[6];
    f32x16 S[4];
#pragma unroll
    for (int kt = 0; kt < 4; ++kt)
#pragma unroll
        for (int r = 0; r < 16; ++r) S[kt][r] = 0.f;
    GlaStage st; gla_prefetch<true>(F, st, b, h, seg * 8); gla_prefetch_vt(F, st, b, h, seg * 8);
    for (int sp = 0; sp < seg; ++sp) {
        const int un = bh * 8 + sp; const float* se = WSP(float, WS_SEND) + ((size_t)un * 8 + w) * SEND_WAVE_FLOATS; const float* pe = WSP(float, WS_PEND) + un * 128;
#pragma unroll
        for (int kt = 0; kt < 4; ++kt)
#pragma unroll
            for (int g4 = 0; g4 < 4; ++g4) { const f32x4 p = *(const f32x4*)(pe + 32 * kt + 8 * g4 + 4 * hh); const f32x4 s = *(const f32x4*)(se + ((kt * 4 + g4) * 64 + l) * 4);
#pragma unroll
                for (int j = 0; j < 4; ++j) S[kt][4 * g4 + j] = S[kt][4 * g4 + j] * p[j] + s[j]; }
    }
    const int tid = F.tid; u32x4 sr[4]; size_t pend_r0 = 0;
#define GLA_STORE_PASS(R0) do { const LAS float* otr = (const LAS float*)(lds + GL_OT) + (tid >> 3) * GL_OT_PITCH + 8 * (tid & 7); \
        _Pragma("unroll") for (int j = 0; j < 4; ++j) { const f32x4 a0 = *(const LAS f32x4*)(otr + 64 * j), a1 = *(const LAS f32x4*)(otr + 64 * j + 4); const u32x4 s4 = sr[j]; u32x4 wv; \
            wv.x = cvtpk(a0[0] * bf_lo(s4.x), a0[1] * bf_hi(s4.x)); wv.y = cvtpk(a0[2] * bf_lo(s4.y), a0[3] * bf_hi(s4.y)); wv.z = cvtpk(a1[0] * bf_lo(s4.z), a1[1] * bf_hi(s4.z)); wv.w = cvtpk(a1[2] * bf_lo(s4.w), a1[3] * bf_hi(s4.w)); \
            if (!F.dry) st_nt<NT_ATT>(wv, (u32x4*)(GLAN + ((R0) + (tid >> 3)) * 1024 + h * 256 + 8 * (tid & 7) + 64 * j)); } } while (0)
    for (int ci = 0; ci < 8; ++ci) {
        const int c = seg * 8 + ci; const size_t r0 = (size_t)(b * 64 + c) * 64; const int buf = ci & 1;
        gla_stage_write<true>(F, st, buf);
        __syncthreads();
        if (ci < 7) gla_prefetch<true>(F, st, b, h, c + 1);
        if (ci > 0) GLA_STORE_PASS(pend_r0);
        gla_update(F, S, st.vt, buf);
        f32x16 oT[2];
#pragma unroll
        for (int tt = 0; tt < 2; ++tt) {
#pragma unroll
            for (int r = 0; r < 16; ++r) oT[tt][r] = 0.f;
            const int t = 32 * tt + lq;
#pragma unroll
            for (int kt = 0; kt < 4; ++kt)
#pragma unroll
                for (int s = 0; s < 2; ++s) {
                    u32x4 aw; aw.x = cvtpk(S[kt][8 * s + 0], S[kt][8 * s + 1]); aw.y = cvtpk(S[kt][8 * s + 2], S[kt][8 * s + 3]); aw.z = cvtpk(S[kt][8 * s + 4], S[kt][8 * s + 5]); aw.w = cvtpk(S[kt][8 * s + 6], S[kt][8 * s + 7]);
                    const u32x2 qlo = *(const LAS u32x2*)(lds + GL_Q + buf * 16384 + gl_q_off(t, 4 * kt + 2 * s) + 8 * hh), qhi = *(const LAS u32x2*)(lds + GL_Q + buf * 16384 + gl_q_off(t, 4 * kt + 2 * s + 1) + 8 * hh);
                    const u32x4 bw = (u32x4){qlo.x, qlo.y, qhi.x, qhi.y};
                    oT[tt] = __builtin_amdgcn_mfma_f32_32x32x16_bf16(__builtin_bit_cast(bf16x8, aw), __builtin_bit_cast(bf16x8, bw), oT[tt], 0, 0, 0);
                    if (s == 1 && (kt & 1)) __builtin_amdgcn_sched_barrier(0); }
        }
        LAS float* redc = (LAS float*)(lds + GL_RED) + buf * 512;
#pragma unroll
        for (int tt = 0; tt < 2; ++tt) { float s = 0.f;
#pragma unroll
            for (int r = 0; r < 16; ++r) s += oT[tt][r] * oT[tt][r];
            s += __shfl_xor(s, 32);
            if (hh == 0) redc[w * 64 + 32 * tt + lq] = s; }
        if (ci < 7) gla_prefetch_vt(F, st, b, h, c + 1);
#pragma unroll
        for (int j = 0; j < 4; ++j) sr[j] = *(const u32x4*)(GR + (r0 + (tid >> 3)) * 1024 + h * 256 + 8 * (tid & 7) + 64 * j);
        __syncthreads();
        LAS float* ot = (LAS float*)(lds + GL_OT);
#pragma unroll
        for (int tt = 0; tt < 2; ++tt) { float tot = 0.f;
#pragma unroll
            for (int ww = 0; ww < 8; ++ww) tot += redc[ww * 64 + 32 * tt + lq];
            const float rstd = __builtin_amdgcn_rsqf(tot * (1.0f / 256.0f) + EPS);
#pragma unroll
            for (int g4 = 0; g4 < 4; ++g4) { const int vl = 32 * w + 8 * g4 + 4 * hh;
                const f32x4 go = *(const f32x4*)(g_o + h * 256 + vl);
                *(LAS f32x4*)(ot + (32 * tt + lq) * GL_OT_PITCH + vl) = (f32x4){oT[tt][4 * g4 + 0] * rstd * go[0], oT[tt][4 * g4 + 1] * rstd * go[1], oT[tt][4 * g4 + 2] * rstd * go[2], oT[tt][4 * g4 + 3] * rstd * go[3]}; } }
        pend_r0 = r0;
    }
    __syncthreads();
    GLA_STORE_PASS(pend_r0);
    __syncthreads();
#undef GLA_STORE_PASS
}

constexpr int SB_TILE = 16384, SB_FLAG = 7 * SB_TILE;
typedef short v4i16_t __attribute__((ext_vector_type(4)));
__device__ __forceinline__ s16x4 vtr(const LAS unsigned char* p) { return __builtin_bit_cast(s16x4, __builtin_amdgcn_ds_read_tr16_b64_v4i16((LAS v4i16_t*)p)); }
__device__ __forceinline__ float partner32(float x, int hh) { auto rr = __builtin_amdgcn_permlane32_swap(__float_as_uint(x), __float_as_uint(x), false, false); return __uint_as_float(hh ? rr[0] : rr[1]); }
__device__ __forceinline__ int sbk_off(int key, int chunk) { return key * 128 + ((chunk ^ ((key >> 1) & 7)) << 4); }
__device__ __forceinline__ int sbv_off(int key, int chunk) { return 8192 + key * 128 + ((chunk ^ (((key >> 1) & 1) << 2)) << 4); }

template <bool DIAG>
__device__ __forceinline__ void sb_tile_t(const LAS unsigned char* tile, int kt, int qabs, int l, const bf16x8 (&qf)[4], f32x16& o0, f32x16& o1, float& carry) {
    const int lq = l & 31, hh = l >> 5, g1 = (l >> 4) & 1, i = l & 15;
    float run = carry;
#pragma unroll
    for (int half = 1; half >= 0; --half) {
        f32x16 p;
#pragma unroll
        for (int r = 0; r < 16; ++r) p[r] = 0.f;
#pragma unroll
        for (int s = 0; s < 4; ++s) { const bf16x8 a = *(const LAS bf16x8*)(tile + sbk_off(32 * half + lq, 2 * s + hh)); p = __builtin_amdgcn_mfma_f32_32x32x16_bf16(a, qf[s], p, 0, 0, 0); }
        float st[16], be[16];
#pragma unroll
        for (int r = 0; r < 16; ++r) { const float ee = __builtin_amdgcn_exp2f(fminf(p[r], 80.0f)); float s_ = __builtin_amdgcn_rcpf(1.0f + ee); float b_ = ee * s_;
            if (DIAG) { const int key = 64 * kt + 32 * half + (r & 3) + 8 * (r >> 2) + 4 * hh; if (key >= qabs) { s_ = 1.0f; b_ = 0.f; } }
            st[r] = s_; be[r] = b_; }
        float tot[4];
#pragma unroll
        for (int g4 = 0; g4 < 4; ++g4) { float* sg = &st[4 * g4]; float* bg = &be[4 * g4];
            const float a2 = sg[3], a1 = sg[2] * a2, a0 = sg[1] * a1; tot[g4] = sg[0] * a0;
            bg[2] *= a2; bg[1] *= a1; bg[0] *= a0; }
        float E[4];
#pragma unroll
        for (int m = 3; m >= 0; --m) { const float tp = partner32(tot[m], hh); E[m] = hh ? run : run * tp; run *= tot[m] * tp; }
        u32x4 pw[2];
#pragma unroll
        for (int s = 0; s < 2; ++s) { float wv[8];
#pragma unroll
            for (int j = 0; j < 8; ++j) { const int r = 8 * s + j; wv[j] = be[r] * E[r >> 2]; }
            pw[s] = (u32x4){cvtpk(wv[0], wv[1]), cvtpk(wv[2], wv[3]), cvtpk(wv[4], wv[5]), cvtpk(wv[6], wv[7])}; }
#pragma unroll
        for (int s = 0; s < 2; ++s) { const bf16x8 pb = __builtin_bit_cast(bf16x8, pw[s]);
            const int k0 = 32 * half + 16 * s + 4 * hh + (i >> 2), k1 = k0 + 8;
#pragma unroll
            for (int dt = 0; dt < 2; ++dt) { const int ch = 4 * dt + 2 * g1 + ((i & 3) >> 1);
                const s16x4 lo = vtr(tile + sbv_off(k0, ch) + 8 * (i & 1)), hi = vtr(tile + sbv_off(k1, ch) + 8 * (i & 1));
                const bf16x8 a = (bf16x8){lo[0], lo[1], lo[2], lo[3], hi[0], hi[1], hi[2], hi[3]};
                if (dt == 0) o0 = __builtin_amdgcn_mfma_f32_32x32x16_bf16(a, pb, o0, 0, 0, 0); else o1 = __builtin_amdgcn_mfma_f32_32x32x16_bf16(a, pb, o1, 0, 0, 0); } }
        if (half == 1 && __all(run == 0.0f)) break;
    }
    carry = run;
}
__device__ __forceinline__ void sb_tile(const LAS unsigned char* tile, int kt, int q0, int qabs, int l, const bf16x8 (&qf)[4], f32x16& o0, f32x16& o1, float& carry) {
    if (64 * kt + 63 >= q0) sb_tile_t<true>(tile, kt, qabs, l, qf, o0, o1, carry); else sb_tile_t<false>(tile, kt, qabs, l, qf, o0, o1, carry);
}
__device__ __forceinline__ void sb_attn_unit(Frame& F, int uidx) {
    const int bh = uidx >> 4, qb = uidx & 15, b = bh >> 4, h = bh & 15;
    LAS unsigned char* lds = F.lds + RING_OFF;
    volatile LAS unsigned* flags = (volatile LAS unsigned*)(lds + SB_FLAG);
    const int tid = F.tid, w = F.wave, l = F.lane, lq = l & 31, hh = l >> 5;
    bf16_t* SQ = WSP(bf16_t, WS_SQ); const bf16_t* SK = WSP(bf16_t, WS_SK); const bf16_t* SV = WSP(bf16_t, WS_SV);
    const size_t rowbase = (size_t)b * SEQ;
    const int q0 = qb * 256 + 32 * w, qabs = q0 + lq;
    const int kt_hi = qb * 4 + 3, kt_lo = (qb * 4 - 3) > 0 ? (qb * 4 - 3) : 0, nwin = kt_hi - kt_lo + 1;
    const int skey = tid >> 3, sch = tid & 7;
    const bf16_t* kgd = SK + (rowbase + skey) * 1024 + h * 64 + ((sch ^ ((skey >> 1) & 7)) * 8);
    const bf16_t* vgd = SV + (rowbase + skey) * 1024 + h * 64 + ((sch ^ (((skey >> 1) & 1) << 2)) * 8);
    __syncthreads();
#pragma unroll
    for (int j = 0; j < 7; ++j) if (j < nwin) {
        __builtin_amdgcn_global_load_lds((const unsigned*)(kgd + (size_t)(kt_lo + j) * 64 * 1024), (LAS unsigned*)(lds + j * SB_TILE + w * 1024), 16, 0, 0);
        __builtin_amdgcn_global_load_lds((const unsigned*)(vgd + (size_t)(kt_lo + j) * 64 * 1024), (LAS unsigned*)(lds + j * SB_TILE + 8192 + w * 1024), 16, 0, 0); }
    bf16x8 qf[4];
    { const bf16_t* qrow = SQ + (rowbase + qabs) * 1024 + h * 64;
#pragma unroll
      for (int s = 0; s < 4; ++s) qf[s] = *(const bf16x8*)(qrow + 16 * s + 8 * hh); }
    f32x16 o0, o1;
#pragma unroll
    for (int r = 0; r < 16; ++r) { o0[r] = 0.f; o1[r] = 0.f; }
    float carry = 1.0f;
    VM_WAIT(); __syncthreads();
    bool done = false;
    for (int kt = (q0 + 30) >> 6; kt >= kt_lo; --kt) {
        sb_tile(lds + (kt - kt_lo) * SB_TILE, kt, q0, qabs, l, qf, o0, o1, carry);
        if (__all(carry == 0.0f)) { done = true; break; }
    }
    if (kt_lo == 0) done = true;
    if (l == 0) flags[w] = done ? 1u : 0u;
    __syncthreads();
    bool alld = true;
#pragma unroll
    for (int i = 0; i < 8; ++i) alld = alld && (flags[i] != 0u);
    if (!alld) {
        const bf16_t* kg = SK + (rowbase + skey) * 1024 + h * 64 + sch * 8;
        const bf16_t* vg = SV + (rowbase + skey) * 1024 + h * 64 + sch * 8;
        for (int kt = kt_lo - 1; kt >= 0; --kt) {
            const u32x4 kr = *(const u32x4*)(kg + (size_t)kt * 64 * 1024), vr = *(const u32x4*)(vg + (size_t)kt * 64 * 1024);
            __syncthreads();
            { unsigned a = 1u;
#pragma unroll
              for (int i = 0; i < 8; ++i) a &= flags[i];
              if (a) break; }
            *(LAS u32x4*)(lds + sbk_off(skey, sch)) = kr; *(LAS u32x4*)(lds + sbv_off(skey, sch)) = vr;
            __syncthreads();
            if (!done) { sb_tile(lds, kt, q0, qabs, l, qf, o0, o1, carry); if (__all(carry == 0.0f) || kt == 0) done = true; }
            if (l == 0) flags[w] = done ? 1u : 0u;
        }
    }
    if (!F.dry) { bf16_t* orow = SQ + (rowbase + qabs) * 1024 + h * 64;
#pragma unroll
      for (int g4 = 0; g4 < 4; ++g4) { u32x2 a, c2; a.x = cvtpk(o0[4 * g4], o0[4 * g4 + 1]); a.y = cvtpk(o0[4 * g4 + 2], o0[4 * g4 + 3]); c2.x = cvtpk(o1[4 * g4], o1[4 * g4 + 1]); c2.y = cvtpk(o1[4 * g4 + 2], o1[4 * g4 + 3]);
          st_nt<NT_ATT>(a, (u32x2*)(orow + 8 * g4 + 4 * hh)); st_nt<NT_ATT>(c2, (u32x2*)(orow + 32 + 8 * g4 + 4 * hh)); } }
}
#define CVT8_PK(V, S, W) do { int _x = __builtin_amdgcn_cvt_pk_fp8_f32((V)[0] * (S), (V)[1] * (S), 0, false); _x = __builtin_amdgcn_cvt_pk_fp8_f32((V)[2] * (S), (V)[3] * (S), _x, true); (W) = (unsigned)_x; } while (0)
__device__ __forceinline__ float absmax4(const f32x4& a) { return fmaxf(fmaxf(fabsf(a[0]), fabsf(a[1])), fmaxf(fabsf(a[2]), fabsf(a[3]))); }
constexpr int CVT8_UNITS = 256;
#ifndef QCONV
#define QCONV 1
#endif
__device__ __forceinline__ void cvt_fp8_unit(Frame& F, int cu) {
    const int l = F.lane, r0 = cu * 128 + F.wave * 16;
    const bool isv = r0 >= 16384; const int e0 = r0 & 16383;
    const float* src = isv ? F.in[15] : F.in[14]; unsigned char* dst = WSP(unsigned char, isv ? WS_VB8 : WS_UB8); float* rscale = WSP(float, isv ? WS_RSV : WS_RSU);
#pragma unroll 1
    for (int it = 0; it < 4; ++it) {
        f32x4 v[4][4]; float m[4];
#pragma unroll
        for (int q = 0; q < 4; ++q) { const f32x4* sp = (const f32x4*)(src + (size_t)(e0 + 4 * it + q) * 1024) + l;
#pragma unroll
            for (int j = 0; j < 4; ++j) v[q][j] = sp[64 * j]; }
#pragma unroll
        for (int q = 0; q < 4; ++q) m[q] = fmaxf(fmaxf(absmax4(v[q][0]), absmax4(v[q][1])), fmaxf(absmax4(v[q][2]), absmax4(v[q][3])));
#pragma unroll
        for (int o = 1; o < 64; o <<= 1) {
#pragma unroll
            for (int q = 0; q < 4; ++q) m[q] = fmaxf(m[q], __shfl_xor(m[q], o)); }
#pragma unroll
        for (int q = 0; q < 4; ++q) { const int e = e0 + 4 * it + q;
            const float t = 448.0f / fmaxf(m[q], 1e-30f); const float s = __uint_as_float(__float_as_uint(t) & 0x7f800000u);
            unsigned w[4]; CVT8_PK(v[q][0], s, w[0]); CVT8_PK(v[q][1], s, w[1]); CVT8_PK(v[q][2], s, w[2]); CVT8_PK(v[q][3], s, w[3]);
            if (!F.dry) { unsigned* dp = (unsigned*)(dst + (size_t)e * 1024) + l;
#pragma unroll
                for (int j = 0; j < 4; ++j) st_nt<NT_ATT>(w[j], dp + 64 * j);
                if (l == 0) rscale[e] = 1.0f / s; } }
    }
}
__device__ __forceinline__ void sb_units_dyn(Frame& F, unsigned* ctr, int sb_lo, int nsb, int conv_lo) {
    volatile LAS int* slot = (volatile LAS int*)(F.lds + MISC_OFF + 64);
    const int total = QCONV ? nsb + (nsb >> 2) : nsb;
    __syncthreads();
    if (F.tid == 0) *slot = (int)__hip_atomic_fetch_add(ctr, 1u, __ATOMIC_RELAXED, __HIP_MEMORY_SCOPE_AGENT);
    __syncthreads();
    int i = *slot;
    while (i < total) {
        int nxt = 0;
        if (F.tid == 0) nxt = (int)__hip_atomic_fetch_add(ctr, 1u, __ATOMIC_RELAXED, __HIP_MEMORY_SCOPE_AGENT);
        if (QCONV) { const int g = i / 5, r = i - 5 * g; if (r < 4) sb_attn_unit(F, sb_lo + 4 * g + r); else cvt_fp8_unit(F, conv_lo + g); }
        else sb_attn_unit(F, sb_lo + i);
        __syncthreads();
        if (F.tid == 0) *slot = nxt;
        __syncthreads();
        i = *slot;
    }
}
__device__ __forceinline__ void phase_attn_a(Frame& F) {
#ifdef CONV_PROBE_NWG
    if (F.dry) {
        if (F.vcu < CONV_PROBE_NWG) { volatile LAS int* slot = (volatile LAS int*)(F.lds + MISC_OFF + 64); unsigned* ctr = (unsigned*)(F.ws + WS_CTL) + 64 + 16;
            for (;;) { __syncthreads(); if (F.tid == 0) *slot = (int)__hip_atomic_fetch_add(ctr, 1u, __ATOMIC_RELAXED, __HIP_MEMORY_SCOPE_AGENT); __syncthreads(); const int i = *slot; if (i >= CVT8_UNITS) break; cvt_fp8_unit(F, i); } }
        return; }
#endif
    if (F.vcu < 128) gla_stage1(F, F.vcu);
    sb_units_dyn(F, (unsigned*)(F.ws + WS_CTL) + 64 + 16 * F.dry, 0, 384, 0);
    __syncthreads();
}
__device__ __forceinline__ void phase_attn_b(Frame& F) {
    if (F.vcu < 128) gla_stage3(F, F.vcu);
    sb_units_dyn(F, (unsigned*)(F.ws + WS_CTL) + 128 + 16 * F.dry, 384, 640, 96);
    __syncthreads();
}
__device__ __forceinline__ int okey(float v, int tag, int mask) { int u = __float_as_int(v); u ^= (u >> 31) & 0x7fffffff; return (u & ~mask) | tag; }
__device__ __forceinline__ float okey_val(int key, int mask) { int u = key & ~mask; u ^= (u >> 31) & 0x7fffffff; return __int_as_float(u); }
#define INS16(Lst, xin) do { int _x = (xin); _Pragma("unroll") for (int _j = 0; _j < 16; ++_j) { const int _h = max(Lst[_j], _x); _x = min(Lst[_j], _x); Lst[_j] = _h; } } while (0)

#define CEX(a, b) do { const int _hi = max(a, b), _lo = min(a, b); a = _hi; b = _lo; } while (0)
#define BITONIC16(K) do { \
    _Pragma("unroll") for (int _i = 0; _i < 8; ++_i) CEX(K[_i], K[_i + 8]); \
    _Pragma("unroll") for (int _b = 0; _b < 16; _b += 8) _Pragma("unroll") for (int _i = 0; _i < 4; ++_i) CEX(K[_b + _i], K[_b + _i + 4]); \
    _Pragma("unroll") for (int _b = 0; _b < 16; _b += 4) _Pragma("unroll") for (int _i = 0; _i < 2; ++_i) CEX(K[_b + _i], K[_b + _i + 2]); \
    _Pragma("unroll") for (int _b = 0; _b < 16; _b += 2) CEX(K[_b], K[_b + 1]); } while (0)
#define CEXD(a, b, d) do { const int _hi = max(a, b), _lo = min(a, b); a = (d) ? _hi : _lo; b = (d) ? _lo : _hi; } while (0)
#define FULLSORT16(K) do { \
    _Pragma("unroll") for (int _k = 2; _k <= 16; _k <<= 1) _Pragma("unroll") for (int _j = _k >> 1; _j >= 1; _j >>= 1) _Pragma("unroll") for (int _i = 0; _i < 16; ++_i) { \
        const int _p = _i ^ _j; if (_p > _i) { const bool _desc = ((_i & _k) == 0); CEXD(K[_i], K[_p], _desc); } } } while (0)
__device__ __forceinline__ int swap32i(int x) { auto r = __builtin_amdgcn_permlane32_swap((unsigned)x, (unsigned)x, false, false); return (int)((__builtin_amdgcn_mbcnt_hi(~0u, __builtin_amdgcn_mbcnt_lo(~0u, 0u)) & 32) ? r[0] : r[1]); }

__device__ __forceinline__ void phase_peer_retrieve(Frame& F) {
    const bf16_t* Q = WSP(bf16_t, WS_Q); const bf16_t* KB = WSP(bf16_t, WS_KD); unsigned* EXPO = WSP(unsigned, WS_EXP);
    LAS unsigned char* idxb = F.lds + RING_OFF + F.wave * 2048;
    const int l = F.lane, lq = l & 31, hh = l >> 5;
    const int ntok_wg = T_TOK / F.G;
#pragma unroll 1
    for (int it = F.wave; it < (ntok_wg / 32) * 8; it += NWAVES) {
        const int tg = it >> 3, h = it & 7;
        const int t = F.vcu * ntok_wg + tg * 32 + lq;
        int XY[2][16];
#pragma unroll
        for (int half = 0; half < 2; ++half) {
            bf16x8 qf[8];
            { const bf16_t* qp = Q + (size_t)t * 2048 + h * 256 + half * 128 + 8 * hh;
#pragma unroll
              for (int s = 0; s < 8; ++s) qf[s] = *(const bf16x8*)(qp + 16 * s); }
            int L[16];
#pragma unroll
            for (int j = 0; j < 16; ++j) L[j] = INT_MIN;
            const bf16_t* kp = KB + (size_t)(h * 2 + half) * 16384 + (size_t)lq * 128 + 8 * hh;
#pragma unroll 1
            for (int tile = 0; tile < 4; ++tile) {
                f32x16 acc; int Tk[16];
#pragma unroll
                for (int r = 0; r < 16; ++r) acc[r] = 0.f;
#pragma unroll
                for (int s = 0; s < 8; ++s) { const bf16x8 a = *(const bf16x8*)(kp + (size_t)tile * 32 * 128 + 16 * s); acc = __builtin_amdgcn_mfma_f32_32x32x16_bf16(a, qf[s], acc, 0, 0, 0); }
#pragma unroll
                for (int r = 0; r < 16; ++r) { const int key = 32 * tile + (r & 3) + 8 * (r >> 2) + 4 * hh; Tk[r] = okey(acc[r], 127 - key, 127); }
                FULLSORT16(Tk);
#pragma unroll
                for (int k = 0; k < 16; ++k) L[k] = max(L[k], Tk[15 - k]);
                BITONIC16(L);
            }
#pragma unroll
            for (int k = 0; k < 8; ++k) { const int a = swap32i(L[15 - k]), b = swap32i(L[k]); L[k] = max(L[k], a); L[15 - k] = max(L[15 - k], b); }
            BITONIC16(L);
#pragma unroll
            for (int j = 0; j < 16; ++j) XY[half][j] = L[j];
        }
        { u32x4 pk[2];
#pragma unroll
          for (int half = 0; half < 2; ++half) { const int* L = XY[half];
            pk[half].x = (unsigned)(127 - (L[0] & 127)) | ((unsigned)(127 - (L[1] & 127)) << 8) | ((unsigned)(127 - (L[2] & 127)) << 16) | ((unsigned)(127 - (L[3] & 127)) << 24);
            pk[half].y = (unsigned)(127 - (L[4] & 127)) | ((unsigned)(127 - (L[5] & 127)) << 8) | ((unsigned)(127 - (L[6] & 127)) << 16) | ((unsigned)(127 - (L[7] & 127)) << 24);
            pk[half].z = (unsigned)(127 - (L[8] & 127)) | ((unsigned)(127 - (L[9] & 127)) << 8) | ((unsigned)(127 - (L[10] & 127)) << 16) | ((unsigned)(127 - (L[11] & 127)) << 24);
            pk[half].w = (unsigned)(127 - (L[12] & 127)) | ((unsigned)(127 - (L[13] & 127)) << 8) | ((unsigned)(127 - (L[14] & 127)) << 16) | ((unsigned)(127 - (L[15] & 127)) << 24); }
          *(LAS u32x4*)(idxb + l * 32) = pk[0]; *(LAS u32x4*)(idxb + l * 32 + 16) = pk[1]; }
        float X[16], Y[16];
#pragma unroll
        for (int j = 0; j < 16; ++j) { X[j] = okey_val(XY[0][j], 127); Y[j] = okey_val(XY[1][j], 127); }
        int M[16];
#pragma unroll
        for (int j = 0; j < 16; ++j) M[j] = INT_MIN;
#define CAND(i, j) do { const float sm = hh ? (X[j] + Y[i]) : (X[i] + Y[j]); const int pos = hh ? ((j) * 16 + (i)) : ((i) * 16 + (j)); int key = okey(sm, 255 - pos, 255); if ((i) == (j) && hh) key = INT_MIN; INS16(M, key); } while (0)
        CAND(0, 0); CAND(0, 1); CAND(0, 2); CAND(0, 3); CAND(0, 4); CAND(0, 5); CAND(0, 6); CAND(0, 7); CAND(0, 8); CAND(0, 9); CAND(0, 10); CAND(0, 11); CAND(0, 12); CAND(0, 13); CAND(0, 14); CAND(0, 15);
        CAND(1, 1); CAND(1, 2); CAND(1, 3); CAND(1, 4); CAND(1, 5); CAND(1, 6); CAND(1, 7);
        CAND(2, 2); CAND(2, 3); CAND(2, 4);
        CAND(3, 3);
#undef CAND
        int TK[16];
#pragma unroll
        for (int k = 0; k < 16; ++k) TK[k] = max(M[k], swap32i(M[15 - k]));
        float sv[16]; float mx = -INFINITY;
#pragma unroll
        for (int k = 0; k < 16; ++k) { sv[k] = okey_val(TK[k], 255); mx = fmaxf(mx, sv[k]); }
        float den = 0.f;
#pragma unroll
        for (int k = 0; k < 16; ++k) { sv[k] = __expf(sv[k] - mx); den += sv[k]; }
        const float rden = 1.0f / den;
        LDS_WAIT(); asm volatile("" ::: "memory");
        const LAS unsigned char* ib = idxb + l * 32;
        unsigned* dst = EXPO + (size_t)t * 128 + h * 16 + hh * 8;
        u32x4 o0, o1; unsigned ov[8];
#pragma unroll
        for (int k = 0; k < 8; ++k) { const int pos = 255 - (TK[k] & 255); const unsigned i1 = ib[pos >> 4], i2 = ib[16 + (pos & 15)];
            ov[k] = (__float_as_uint(sv[k] * rden) & ~0x3fffu) | (i1 * 128u + i2); }
        o0 = (u32x4){ov[0], ov[1], ov[2], ov[3]}; o1 = (u32x4){ov[4], ov[5], ov[6], ov[7]};
        *(u32x4*)dst = o0; *(u32x4*)(dst + 4) = o1;
        LDS_WAIT(); asm volatile("" ::: "memory");
    }
}

__device__ __forceinline__ void cvt_rows_fp8(Frame& F, const float* src, unsigned char* dst, float* rscale) {
    const int l = F.lane; const int gw = F.vcu * NWAVES + F.wave, NGW = F.G * NWAVES;
    for (int e = gw; e < 16384; e += NGW) {
        const f32x4* sp = (const f32x4*)(src + (size_t)e * 1024 + 16 * l);
        const f32x4 a = sp[0], b = sp[1], c = sp[2], d = sp[3];
        float m = fmaxf(fmaxf(fmaxf(fabsf(a[0]), fabsf(a[1])), fmaxf(fabsf(a[2]), fabsf(a[3]))), fmaxf(fmaxf(fabsf(b[0]), fabsf(b[1])), fmaxf(fabsf(b[2]), fabsf(b[3]))));
        m = fmaxf(m, fmaxf(fmaxf(fmaxf(fabsf(c[0]), fabsf(c[1])), fmaxf(fabsf(c[2]), fabsf(c[3]))), fmaxf(fmaxf(fabsf(d[0]), fabsf(d[1])), fmaxf(fabsf(d[2]), fabsf(d[3])))));
#pragma unroll
        for (int o = 1; o < 64; o <<= 1) m = fmaxf(m, __shfl_xor(m, o));
        const float t = 448.0f / fmaxf(m, 1e-30f); const float s = __uint_as_float(__float_as_uint(t) & 0x7f800000u);
        u32x4 w; int x;
        x = __builtin_amdgcn_cvt_pk_fp8_f32(a[0] * s, a[1] * s, 0, false); x = __builtin_amdgcn_cvt_pk_fp8_f32(a[2] * s, a[3] * s, x, true); w.x = (unsigned)x;
        x = __builtin_amdgcn_cvt_pk_fp8_f32(b[0] * s, b[1] * s, 0, false); x = __builtin_amdgcn_cvt_pk_fp8_f32(b[2] * s, b[3] * s, x, true); w.y = (unsigned)x;
        x = __builtin_amdgcn_cvt_pk_fp8_f32(c[0] * s, c[1] * s, 0, false); x = __builtin_amdgcn_cvt_pk_fp8_f32(c[2] * s, c[3] * s, x, true); w.z = (unsigned)x;
        x = __builtin_amdgcn_cvt_pk_fp8_f32(d[0] * s, d[1] * s, 0, false); x = __builtin_amdgcn_cvt_pk_fp8_f32(d[2] * s, d[3] * s, x, true); w.w = (unsigned)x;
        *(u32x4*)(dst + (size_t)e * 1024 + 16 * l) = w;
        if (l == 0) rscale[e] = 1.0f / s;
    }
}

__device__ __forceinline__ float gelu_tanh(float x) { const float y = 0.7978845608028654f * (x + 0.044715f * x * x * x); return x * __builtin_amdgcn_rcpf(1.0f + __expf(-2.0f * y)); }
#define FP8_UNPACK16(W, f) do { f32x2 _t; \
    _t = __builtin_amdgcn_cvt_pk_f32_fp8((int)(W).x, false); f[0] = _t[0]; f[1] = _t[1]; _t = __builtin_amdgcn_cvt_pk_f32_fp8((int)(W).x, true); f[2] = _t[0]; f[3] = _t[1]; \
    _t = __builtin_amdgcn_cvt_pk_f32_fp8((int)(W).y, false); f[4] = _t[0]; f[5] = _t[1]; _t = __builtin_amdgcn_cvt_pk_f32_fp8((int)(W).y, true); f[6] = _t[0]; f[7] = _t[1]; \
    _t = __builtin_amdgcn_cvt_pk_f32_fp8((int)(W).z, false); f[8] = _t[0]; f[9] = _t[1]; _t = __builtin_amdgcn_cvt_pk_f32_fp8((int)(W).z, true); f[10] = _t[0]; f[11] = _t[1]; \
    _t = __builtin_amdgcn_cvt_pk_f32_fp8((int)(W).w, false); f[12] = _t[0]; f[13] = _t[1]; _t = __builtin_amdgcn_cvt_pk_f32_fp8((int)(W).w, true); f[14] = _t[0]; f[15] = _t[1]; } while (0)
__device__ __forceinline__ float sum_swap32(float a, float b) { auto r = __builtin_amdgcn_permlane32_swap(__float_as_uint(a), __float_as_uint(b), false, false); return __uint_as_float(r[0]) + __uint_as_float(r[1]); }
__device__ __forceinline__ float sum_swap16(float a, float b) { auto r = __builtin_amdgcn_permlane16_swap(__float_as_uint(a), __float_as_uint(b), false, false); return __uint_as_float(r[0]) + __uint_as_float(r[1]); }
template <int M> __device__ __forceinline__ unsigned sxu(unsigned v, int lane) {
    if constexpr (M == 32) { auto r = __builtin_amdgcn_permlane32_swap(v, v, false, false); return (lane & 32) ? r[0] : r[1]; }
    else return (unsigned)__builtin_amdgcn_ds_swizzle((int)v, (M << 10) | 0x1f);
}
template <int M> __device__ __forceinline__ float sxf(float v, int lane) { return __uint_as_float(sxu<M>(__float_as_uint(v), lane)); }
__device__ __forceinline__ float wave_sum_sx(float v, int lane) { v += sxf<1>(v, lane); v += sxf<2>(v, lane); v += sxf<4>(v, lane); v += sxf<8>(v, lane); v += sxf<16>(v, lane); v += sxf<32>(v, lane); return v; }
#ifndef PG_TOK
#define PG_TOK 4
#endif
template <class Bar>
__device__ __forceinline__ void phase_peer_gather(Frame& F, const Bar& bar, bool use_bar) {
    const unsigned char* UB = WSP(unsigned char, WS_UB8); const unsigned char* VB = WSP(unsigned char, WS_VB8); const float* RSU = WSP(float, WS_RSU); const float* RSV = WSP(float, WS_RSV);
    const unsigned* EXPO = WSP(unsigned, WS_EXP);
    const bf16_t* H1B = WSP(bf16_t, WS_H1); bf16_t* H2B = WSP(bf16_t, WS_H2B); const float* SSQ1 = WSP(float, WS_SSQ1); float* RS3 = WSP(float, WS_RS3); const float* g_ffn = F.in[10];
    const int l = F.lane; const int ntok_wg = T_TOK / F.G;
#pragma unroll 1
    for (int ti = F.wave * PG_TOK; ti < ntok_wg; ti += NWAVES * PG_TOK) {
        if (use_bar && ti >= NWAVES * PG_TOK) xcd_barrier(bar, F.tid); else __syncthreads();
        f32x2 acc[PG_TOK][8];
        LAS unsigned* lent = (LAS unsigned*)(F.lds + RING_OFF + F.wave * (2048 * PG_TOK)); LAS float* lcu = (LAS float*)(lent + 128 * PG_TOK); LAS float* lcv = lcu + 128 * PG_TOK; LAS float* acl = lcv + 128 * PG_TOK;
#if PG_TOK == 2
        LAS f32x4* lx = (LAS f32x4*)(F.lds + RING_OFF + NWAVES * 2048 * PG_TOK + F.wave * (4096 * PG_TOK));
#else
        LAS u32x4* lx = (LAS u32x4*)(F.lds + RING_OFF + NWAVES * 2048 * PG_TOK + F.wave * (2048 * PG_TOK));
#endif
#pragma unroll
        for (int tk = 0; tk < PG_TOK; ++tk) { const int t = F.vcu * ntok_wg + ti + tk;
            const u32x4 xa = *(const u32x4*)(H1B + (size_t)t * 1024 + 16 * l), xb = *(const u32x4*)(H1B + (size_t)t * 1024 + 16 * l + 8);
            const f32x4* gp = (const f32x4*)(g_ffn + 16 * l);
            const f32x4 x0 = (f32x4){bf_lo(xa.x), bf_hi(xa.x), bf_lo(xa.y), bf_hi(xa.y)} * gp[0], x1 = (f32x4){bf_lo(xa.z), bf_hi(xa.z), bf_lo(xa.w), bf_hi(xa.w)} * gp[1];
            const f32x4 x2_ = (f32x4){bf_lo(xb.x), bf_hi(xb.x), bf_lo(xb.y), bf_hi(xb.y)} * gp[2], x3 = (f32x4){bf_lo(xb.z), bf_hi(xb.z), bf_lo(xb.w), bf_hi(xb.w)} * gp[3];
#if PG_TOK == 2
            lx[tk * 256 + l] = x0; lx[tk * 256 + 64 + l] = x1; lx[tk * 256 + 128 + l] = x2_; lx[tk * 256 + 192 + l] = x3;
#else
            lx[tk * 128 + l] = (u32x4){cvtpk(x0[0], x0[1]), cvtpk(x0[2], x0[3]), cvtpk(x1[0], x1[1]), cvtpk(x1[2], x1[3])}; lx[tk * 128 + 64 + l] = (u32x4){cvtpk(x2_[0], x2_[1]), cvtpk(x2_[2], x2_[3]), cvtpk(x3[0], x3[1]), cvtpk(x3[2], x3[3])};
#endif
#pragma unroll
            for (int i = 0; i < 8; ++i) acc[tk][i] = (f32x2){0.f, 0.f}; }
#pragma unroll 1
        for (int tk = 0; tk < PG_TOK; ++tk) { const int t = F.vcu * ntok_wg + ti + tk;
            const f32x4* sp = (const f32x4*)(SSQ1 + (size_t)t * 16); const f32x4 st = (sp[0] + sp[1]) + (sp[2] + sp[3]); const float rstd1 = __builtin_amdgcn_rsqf(((st[0] + st[1]) + (st[2] + st[3])) * (1.0f / 1024.0f) + EPS);
            unsigned a0 = EXPO[(size_t)t * 128 + l], a1 = EXPO[(size_t)t * 128 + 64 + l];
            { unsigned s0 = (a0 << 18) | (a0 >> 14), s1 = (a1 << 18) | (a1 >> 14);
              int ls = l; asm volatile("" : "+v"(ls));
#define BSTEP(K, J) do { const bool up = (ls & (J)) != 0; const unsigned p0 = sxu<J>(s0, ls), p1 = sxu<J>(s1, ls); \
                  const bool asc0 = (ls & (K)) == 0, asc1 = ((ls + 64) & (K)) == 0; \
                  s0 = (up == asc0) ? max(s0, p0) : min(s0, p0); s1 = (up == asc1) ? max(s1, p1) : min(s1, p1); } while (0)
              BSTEP(2, 1);
              BSTEP(4, 2); BSTEP(4, 1);
              BSTEP(8, 4); BSTEP(8, 2); BSTEP(8, 1);
              BSTEP(16, 8); BSTEP(16, 4); BSTEP(16, 2); BSTEP(16, 1);
              BSTEP(32, 16); BSTEP(32, 8); BSTEP(32, 4); BSTEP(32, 2); BSTEP(32, 1);
              BSTEP(64, 32); BSTEP(64, 16); BSTEP(64, 8); BSTEP(64, 4); BSTEP(64, 2); BSTEP(64, 1);
              { const unsigned lo = min(s0, s1), hi = max(s0, s1); s0 = lo; s1 = hi; }
              BSTEP(128, 32); BSTEP(128, 16); BSTEP(128, 8); BSTEP(128, 4); BSTEP(128, 2); BSTEP(128, 1);
#undef BSTEP
              a0 = (s0 >> 18) | (s0 << 14); a1 = (s1 >> 18) | (s1 << 14); }
            lent[tk * 128 + l] = a0; lent[tk * 128 + 64 + l] = a1;
            lcu[tk * 128 + l] = RSU[a0 & 0x3fffu] * rstd1; lcu[tk * 128 + 64 + l] = RSU[a1 & 0x3fffu] * rstd1;
            lcv[tk * 128 + l] = RSV[a0 & 0x3fffu] * __uint_as_float(a0 & ~0x3fffu); lcv[tk * 128 + 64 + l] = RSV[a1 & 0x3fffu] * __uint_as_float(a1 & ~0x3fffu); }
        LDS_WAIT(); asm volatile("" ::: "memory");
        u32x4 buf0[8], buf1[8];
#define ROWS8(BUF, TAB, tk, eb) do { const u32x4 ea_ = *(const LAS u32x4*)(lent + (tk) * 128 + (eb)), eb_ = *(const LAS u32x4*)(lent + (tk) * 128 + (eb) + 4); \
            const unsigned en_[8] = {ea_.x, ea_.y, ea_.z, ea_.w, eb_.x, eb_.y, eb_.z, eb_.w}; \
            _Pragma("unroll") for (int k = 0; k < 8; ++k) BUF[k] = *(const u32x4*)((TAB) + ((en_[k] & 0x3fffu) * 1024u + 16u * (unsigned)l)); } while (0)
#if PG_TOK == 2
#define LX_LOAD(tk) _Pragma("unroll") for (int i = 0; i < 4; ++i) { const f32x4 t_ = lx[(tk) * 256 + 64 * i + l]; x2[2 * i] = (f32x2){t_[0], t_[1]}; x2[2 * i + 1] = (f32x2){t_[2], t_[3]}; }
#else
#define LX_LOAD(tk) _Pragma("unroll") for (int i = 0; i < 2; ++i) { const u32x4 t_ = lx[(tk) * 128 + 64 * i + l]; x2[4 * i] = (f32x2){bf_lo(t_.x), bf_hi(t_.x)}; x2[4 * i + 1] = (f32x2){bf_lo(t_.y), bf_hi(t_.y)}; x2[4 * i + 2] = (f32x2){bf_lo(t_.z), bf_hi(t_.z)}; x2[4 * i + 3] = (f32x2){bf_lo(t_.w), bf_hi(t_.w)}; }
#endif
#define U8(BUF, tk, eb) do { float p[8]; f32x2 x2[8]; \
            LX_LOAD(tk); \
            _Pragma("unroll") for (int k = 0; k < 8; ++k) { const unsigned wq[4] = {BUF[k].x, BUF[k].y, BUF[k].z, BUF[k].w}; f32x2 s2 = (f32x2){0.f, 0.f}; \
                _Pragma("unroll") for (int i = 0; i < 4; ++i) { s2 = __builtin_elementwise_fma(__builtin_amdgcn_cvt_pk_f32_fp8((int)wq[i], false), x2[2 * i], s2); \
                                                                s2 = __builtin_elementwise_fma(__builtin_amdgcn_cvt_pk_f32_fp8((int)wq[i], true), x2[2 * i + 1], s2); } \
                p[k] = s2[0] + s2[1]; if (k & 1) __builtin_amdgcn_sched_barrier(0); } \
            float q4[4], q2[2], q1; \
            _Pragma("unroll") for (int j = 0; j < 4; ++j) q4[j] = sum_swap32(p[j], p[4 + j]); \
            _Pragma("unroll") for (int j = 0; j < 2; ++j) q2[j] = sum_swap16(q4[j], q4[2 + j]); \
            { const bool up = (l & 8) != 0; const float keep = up ? q2[1] : q2[0], send = up ? q2[0] : q2[1]; q1 = keep + sxf<8>(send, l); } \
            q1 += sxf<4>(q1, l); q1 += sxf<2>(q1, l); q1 += sxf<1>(q1, l); \
            const float cu = lcu[(tk) * 128 + (eb) + (l >> 3)], cv = lcv[(tk) * 128 + (eb) + (l >> 3)]; \
            const float a_ = gelu_tanh(q1 * cu) * cv; if ((l & 7) == 0) acl[(tk) * 128 + (eb) + (l >> 3)] = a_; __builtin_amdgcn_sched_barrier(0); } while (0)
#define V8(BUF, tk, eb) do { const float av = acl[(tk) * 128 + (eb) + (l & 7)]; \
            _Pragma("unroll") for (int k = 0; k < 8; ++k) { const float ak = __uint_as_float(__builtin_amdgcn_readlane(__float_as_uint(av), k)); const f32x2 ak2 = (f32x2){ak, ak}; \
                const unsigned wq[4] = {BUF[k].x, BUF[k].y, BUF[k].z, BUF[k].w}; \
                _Pragma("unroll") for (int i = 0; i < 4; ++i) { acc[tk][2 * i] = __builtin_elementwise_fma(__builtin_amdgcn_cvt_pk_f32_fp8((int)wq[i], false), ak2, acc[tk][2 * i]); \
                                                                acc[tk][2 * i + 1] = __builtin_elementwise_fma(__builtin_amdgcn_cvt_pk_f32_fp8((int)wq[i], true), ak2, acc[tk][2 * i + 1]); } \
                if (k & 1) __builtin_amdgcn_sched_barrier(0); } } while (0)
        ROWS8(buf0, UB, 0, 0);
#if PG_TOK == 4
#define TURNS4(CONS, TAB, eb, NEXT) do { ROWS8(buf1, TAB, 1, eb); CONS(buf0, 0, eb); ROWS8(buf0, TAB, 2, eb); CONS(buf1, 1, eb); ROWS8(buf1, TAB, 3, eb); CONS(buf0, 2, eb); NEXT; CONS(buf1, 3, eb); } while (0)
#pragma unroll 1
        for (int eb = 0; eb < 120; eb += 8) TURNS4(U8, UB, eb, ROWS8(buf0, UB, 0, eb + 8));
        TURNS4(U8, UB, 120, ROWS8(buf0, VB, 0, 0));
        LDS_WAIT(); asm volatile("" ::: "memory");
#pragma unroll 1
        for (int eb = 0; eb < 120; eb += 8) TURNS4(V8, VB, eb, ROWS8(buf0, VB, 0, eb + 8));
        TURNS4(V8, VB, 120, (void)0);
#undef TURNS4
#elif PG_TOK == 2
#define TURNS2(CONS, TAB, eb, NEXT) do { ROWS8(buf1, TAB, 1, eb); CONS(buf0, 0, eb); NEXT; CONS(buf1, 1, eb); } while (0)
#pragma unroll 1
        for (int eb = 0; eb < 120; eb += 8) TURNS2(U8, UB, eb, ROWS8(buf0, UB, 0, eb + 8));
        TURNS2(U8, UB, 120, ROWS8(buf0, VB, 0, 0));
        LDS_WAIT(); asm volatile("" ::: "memory");
#pragma unroll 1
        for (int eb = 0; eb < 120; eb += 8) TURNS2(V8, VB, eb, ROWS8(buf0, VB, 0, eb + 8));
        TURNS2(V8, VB, 120, (void)0);
#undef TURNS2
#else
#error PG_TOK must be 2 or 4
#endif
#undef ROWS8
#undef LX_LOAD
#undef U8
#undef V8
#pragma unroll
        for (int tk = 0; tk < PG_TOK; ++tk) { const int t = F.vcu * ntok_wg + ti + tk;
            float ss = 0.f; f32x4 h[4];
#pragma unroll
            for (int q2 = 0; q2 < 2; ++q2) { const u32x4 ha = *(const u32x4*)(H1B + (size_t)t * 1024 + 16 * l + 8 * q2);
                h[2 * q2] = (f32x4){bf_lo(ha.x), bf_hi(ha.x), bf_lo(ha.y), bf_hi(ha.y)}; h[2 * q2 + 1] = (f32x4){bf_lo(ha.z), bf_hi(ha.z), bf_lo(ha.w), bf_hi(ha.w)};
#pragma unroll
                for (int j = 0; j < 4; ++j) { h[2 * q2][j] += acc[tk][4 * q2 + (j >> 1)][j & 1]; h[2 * q2 + 1][j] += acc[tk][4 * q2 + 2 + (j >> 1)][j & 1]; ss += h[2 * q2][j] * h[2 * q2][j] + h[2 * q2 + 1][j] * h[2 * q2 + 1][j]; }
                u32x4 w0; w0.x = cvtpk(h[2 * q2][0], h[2 * q2][1]); w0.y = cvtpk(h[2 * q2][2], h[2 * q2][3]); w0.z = cvtpk(h[2 * q2 + 1][0], h[2 * q2 + 1][1]); w0.w = cvtpk(h[2 * q2 + 1][2], h[2 * q2 + 1][3]);
                if (!F.dry) st_nt<NT_OUT>(w0, (u32x4*)(H2B + (size_t)t * 1024 + 16 * l + 8 * q2)); }
            const float rstd3 = __builtin_amdgcn_rsqf(wave_sum_sx(ss, l) * (1.0f / 1024.0f) + EPS);
            if (!F.dry && l == 0) RS3[t] = rstd3;
            __builtin_amdgcn_sched_barrier(0); }
    }
}

__device__ __forceinline__ void phase_final(Frame& F) {
    const float* SSQ3 = WSP(float, WS_SSQ3); const float* g = F.in[19]; const bf16_t* H3B = WSP(bf16_t, WS_H3B);
    const int l = F.lane; const int gw = F.vcu * NWAVES + F.wave, NGW = F.G * NWAVES;
    for (int t = gw; t < T_TOK; t += NGW) {
        const f32x4* sp = (const f32x4*)(SSQ3 + (size_t)t * 16); const f32x4 st = (sp[0] + sp[1]) + (sp[2] + sp[3]);
        const float rstd = __builtin_amdgcn_rsqf(((st[0] + st[1]) + (st[2] + st[3])) * (1.0f / 1024.0f) + EPS);
        f32x4* row = (f32x4*)(F.out + (size_t)t * 1024);
#pragma unroll
        for (int j = 0; j < 4; ++j) { const u32x2 hv = *((const u32x2*)(H3B + (size_t)t * 1024) + l + 64 * j); const f32x4 gv = *((const f32x4*)g + l + 64 * j);
            const f32x4 h = (f32x4){bf_lo(hv.x), bf_hi(hv.x), bf_lo(hv.y), bf_hi(hv.y)}; row[l + 64 * j] = h * rstd * gv; }
    }
}
#ifndef MK_FUSED
#define MK_FUSED 1
#endif
constexpr int NPHASE = 10;
struct Args { const float* in[20]; float* out; unsigned char* ws; int ph_lo, ph_hi, dry, pad; };
static_assert(sizeof(Args) == 20 * 8 + 8 + 8 + 4 * 4, "Args has no padding");

__global__ void __launch_bounds__(NWAVES * 64, 2) mk_fwd(Args args) {
    extern __shared__ __attribute__((aligned(16))) unsigned char lds_raw[];
    Frame F;
    F.lds = (LAS unsigned char*)lds_raw;
    F.wave = __builtin_amdgcn_readfirstlane(threadIdx.x >> 6); F.lane = lane_id(); F.tid = F.wave * 64 + F.lane;
    F.G = gridDim.x; { const int bx = blockIdx.x; F.vcu = (F.G % 8 == 0) ? (bx % 8) * (F.G / 8) + bx / 8 : bx; }
    F.in = args.in; F.out = args.out; F.ws = args.ws; F.dry = args.dry;
    volatile LAS unsigned* MISC = (volatile LAS unsigned*)(F.lds + MISC_OFF);
    if (F.tid < 64) MISC[F.tid] = 0u;
    __syncthreads();
    const int lo = args.ph_lo, hi = args.ph_hi;
    XcdBarrier bar; bar.bar = (unsigned*)(F.ws + WS_CTL) + CW_BAR; bar.x = 0; bar.st = nullptr;
    if (hi - lo > 1) bar = xcd_barrier_post((unsigned*)(F.ws + WS_CTL) + CW_BAR, MISC + 8, F.tid);
#ifndef PH_MASK
#define PH_MASK 0xFFFFFFFFu
#endif
#define IN(k) (((PH_MASK >> (k)) & 1u) && lo <= (k) && (k) < hi)
#define LAUNDER(p, T) do { unsigned _lo = (unsigned)(unsigned long long)(p), _hi = (unsigned)((unsigned long long)(p) >> 32); asm volatile("" : "+v"(_lo), "+v"(_hi)); \
        _lo = __builtin_amdgcn_readfirstlane(_lo); _hi = __builtin_amdgcn_readfirstlane(_hi); (p) = (T)(((unsigned long long)_hi << 32) | _lo); } while (0)
#define SEAM(k) do { if (IN(k) && IN((k) + 1)) xcd_barrier(bar, F.tid); LAUNDER(F.ws, unsigned char*); LAUNDER(F.out, float*); F.lane = lane_id(); F.tid = F.wave * 64 + F.lane; } while (0)
    const int bx = (int)blockIdx.x;
    LAS unsigned char* ring = F.lds + RING_OFF;

    if (IN(0)) { phase_prologue(F); } SEAM(0);
    if (IN(1)) {
        pg8::Gemm g{WSP(bf16_t, WS_XN1), WSP(bf16_t, WS_WIN), T_TOK, 8192, 1024, 1024, 0, 2, 8}; pg8::StaticOrder S; S.init(T_TOK, 8192, F.G, bx);
        pg8::EpiProj E{WSP(bf16_t, WS_GQ), WSP(bf16_t, WS_GK), WSP(bf16_t, WS_GV), WSP(bf16_t, WS_GR), WSP(bf16_t, WS_SQ), WSP(bf16_t, WS_SK), WSP(bf16_t, WS_SV),
                       (bf16_t*)F.out, (bf16_t*)F.out + (size_t)T_TOK * 1024};
        pg8::gemm_phase<pg8::EpiProj>(ring, g, S, E, F.tid);
    } SEAM(1);
    if (IN(2)) { phase_gla_prep(F); } SEAM(2);
    if (IN(3)) { phase_attn_a(F); } SEAM(3);
    if (IN(4)) { phase_attn_b(F); } SEAM(4);
    if (IN(5)) {
        if (!QCONV) { for (int cu = F.vcu; cu < CVT8_UNITS; cu += F.G) cvt_fp8_unit(F, cu); VM_WAIT(); __syncthreads(); }
        pg8::PairOrder S; S.init(T_TOK, 1024, F.G, bx);
        pg8::Gemm g{WSP(bf16_t, WS_GLAN), WSP(bf16_t, WS_WGA), T_TOK, 1024, 1024, 1024, 0, 0, 0, WSP(bf16_t, WS_SQ), WSP(bf16_t, WS_WSB)};
        pg8::EpiMixPair E{(const bf16_t*)F.out, (const bf16_t*)F.out + (size_t)T_TOK * 1024, WSP(bf16_t, WS_MIX)};
        pg8::gemm_phase<pg8::EpiMixPair, true, true, pg8::PairOrder>(ring, g, S, E, F.tid);
    } SEAM(5);
    if (IN(6)) {
        pg8::Gemm g{WSP(bf16_t, WS_MIX), WSP(bf16_t, WS_WO), T_TOK, 1024, 1024, 1024, 0, 0, 0}; pg8::StaticOrder S; S.init(T_TOK, 1024, F.G, bx);
        pg8::EpiH1 E{F.in[0], WSP(bf16_t, WS_H1), WSP(float, WS_SSQ1)};
        pg8::gemm_phase<pg8::EpiH1>(ring, g, S, E, F.tid);
    } SEAM(6);
    if (IN(7)) {
        pg8::Gemm g{WSP(bf16_t, WS_H1), WSP(bf16_t, WS_WPQ), T_TOK, 2048, 1024, 1024, 0, 0, 0}; pg8::StaticOrder S; S.init(T_TOK, 2048, F.G, bx);
        pg8::EpiQ E{WSP(float, WS_SSQ1), WSP(bf16_t, WS_Q), 2048};
        pg8::gemm_phase<pg8::EpiQ>(ring, g, S, E, F.tid);
    } SEAM(7);
    if (IN(8)) {
        cvt_copy(F, F.in[1], WSP(bf16_t, WS_PB), (size_t)T_TOK * 256);
        phase_peer_retrieve(F);
        VM_WAIT(); __syncthreads();
        phase_peer_gather(F, bar, false);
    } SEAM(8);
    if (IN(9)) {
        pg8::StaticOrder S; S.init(T_TOK, 1024, F.G, bx);
        { pg8::Gemm g{WSP(bf16_t, WS_PB), WSP(bf16_t, WS_WPLE), T_TOK, 1024, 256, 256, 0, 0, 0}; pg8::EpiBf E{WSP(bf16_t, WS_PLE), 1024};
          pg8::gemm_phase<pg8::EpiBf>(ring, g, S, E, F.tid); }
        { pg8::Gemm g{WSP(bf16_t, WS_H2B), WSP(bf16_t, WS_WPG), T_TOK, 1024, 1024, 1024, 0, 0, 0}; pg8::EpiH3L E{WSP(bf16_t, WS_H2B), WSP(bf16_t, WS_PLE), WSP(float, WS_RS3), ring, WSP(float, WS_SSQ3)};
          pg8::gemm_phase<pg8::EpiH3L>(ring, g, S, E, F.tid); }
        { pg8::Unit u; S.next(0, u);
          unsigned* cnt = (unsigned*)(F.ws + WS_CTL) + CW_ROWCNT + 64 * F.dry + u.pm;
          if (F.tid == 0) {
              __builtin_amdgcn_fence(__ATOMIC_RELEASE, "agent");
              __hip_atomic_fetch_add(cnt, 1u, __ATOMIC_RELAXED, __HIP_MEMORY_SCOPE_AGENT);
              unsigned sp = 0; while (__hip_atomic_load(cnt, __ATOMIC_RELAXED, __HIP_MEMORY_SCOPE_AGENT) < 4u && ++sp < (1u << 24)) __builtin_amdgcn_s_sleep(1);
              __builtin_amdgcn_fence(__ATOMIC_ACQUIRE, "agent");
          }
          __syncthreads();
          LAS float* rsl = (LAS float*)(ring + 256 * pg8::H3L_PITCH);
          if (F.tid < 256) { const f32x4* sp = (const f32x4*)(WSP(float, WS_SSQ3) + (size_t)(u.pm * 256 + F.tid) * 16); const f32x4 st = (sp[0] + sp[1]) + (sp[2] + sp[3]);
              rsl[F.tid] = __builtin_amdgcn_rsqf(((st[0] + st[1]) + (st[2] + st[3])) * (1.0f / 1024.0f) + EPS); }
          __syncthreads();
          const int c8 = F.tid & 31, r0 = F.tid >> 5;
          const f32x4 g0 = *(const f32x4*)(F.in[19] + u.pn * 256 + 8 * c8), g1 = *(const f32x4*)(F.in[19] + u.pn * 256 + 8 * c8 + 4);
#pragma unroll 4
          for (int ps = 0; ps < 16; ++ps) { const int lrow = ps * 16 + r0; const u32x4 hv = *(const LAS u32x4*)(ring + lrow * pg8::H3L_PITCH + 16 * c8); const float rstd = rsl[lrow];
              float* op = F.out + (size_t)(u.pm * 256 + lrow) * 1024 + u.pn * 256 + 8 * c8;
              st_nt<NT_OUT>((f32x4){bf_lo(hv.x), bf_hi(hv.x), bf_lo(hv.y), bf_hi(hv.y)} * rstd * g0, (f32x4*)op); st_nt<NT_OUT>((f32x4){bf_lo(hv.z), bf_hi(hv.z), bf_lo(hv.w), bf_hi(hv.w)} * rstd * g1, (f32x4*)(op + 4)); }
        }
    }
#undef IN
#undef SEAM
}

extern "C" void kernel_launch(void* const* d_in, const int* in_sizes, int n_in, void* d_out, int out_size, void* d_ws, size_t ws_size, hipStream_t stream) {
    static int grid = 0;
    if (grid == 0) {
        if (n_in != 20 || in_sizes[0] != T_TOK * 1024 || out_size != T_TOK * 1024 || ws_size < WS_END) {
            fprintf(stderr, "kernel_launch: unexpected shapes (n_in %d, in0 %d, out %d, ws %zu < %zu?); nothing launched\n", n_in, n_in > 0 ? in_sizes[0] : -1, out_size, ws_size, (size_t)WS_END); grid = -1; return; }
        int dev = 0, cus = 0, per_cu = 0;
        if (hipGetDevice(&dev) != hipSuccess || hipDeviceGetAttribute(&cus, hipDeviceAttributeMultiprocessorCount, dev) != hipSuccess) { grid = -1; return; }
        if (hipFuncSetAttribute((const void*)mk_fwd, hipFuncAttributeMaxDynamicSharedMemorySize, LDS_BYTES) != hipSuccess) { fprintf(stderr, "kernel_launch: hipFuncSetAttribute failed\n"); grid = -1; return; }
        if (hipOccupancyMaxActiveBlocksPerMultiprocessor(&per_cu, (const void*)mk_fwd, NWAVES * 64, LDS_BYTES) != hipSuccess || per_cu < 1)
            fprintf(stderr, "kernel_launch: note: occupancy query reports %d workgroups per CU\n", per_cu);
        (void)hipGetLastError();
        grid = cus;
        if (grid != (T_TOK / 256) * 4) { fprintf(stderr, "kernel_launch: the last phase needs one output tile per workgroup (grid %d)\n", grid); grid = -1; return; }
        if (grid != 256) fprintf(stderr, "kernel_launch: note: %d CUs (kernel tuned for 256)\n", grid);
    }
    if (grid < 0) return;
    if (hipMemsetAsync((char*)d_ws + WS_CTL, 0, CTL_ZERO_BYTES, stream) != hipSuccess) { fprintf(stderr, "kernel_launch: hipMemsetAsync failed\n"); return; }
    Args a{};
    for (int i = 0; i < 20; ++i) a.in[i] = (const float*)d_in[i];
    a.out = (float*)d_out; a.ws = (unsigned char*)d_ws;
#if MK_FUSED
    a.ph_lo = 0; a.ph_hi = NPHASE;
    hipLaunchKernelGGL(mk_fwd, dim3(grid), dim3(NWAVES * 64), LDS_BYTES, stream, a);
#else
#ifndef PROBE_PHASE
#define PROBE_PHASE -1
#define PROBE_REPS 0
#endif
    for (int p = 0; p < NPHASE; ++p) { a.ph_lo = p; a.ph_hi = p + 1;
        if (p == PROBE_PHASE) { a.dry = 1; for (int r = 0; r < PROBE_REPS; ++r) hipLaunchKernelGGL(mk_fwd, dim3(grid), dim3(NWAVES * 64), LDS_BYTES, stream, a); a.dry = 0; }
        hipLaunchKernelGGL(mk_fwd, dim3(grid), dim3(NWAVES * 64), LDS_BYTES, stream, a); }
#endif
}
```

```cpp
#include <hip/hip_runtime.h>
#include <cstdio>
#include <cstdint>

#define LAS __attribute__((address_space(3)))
#define GAS __attribute__((address_space(1)))
typedef unsigned short bf16_t;
typedef short bf16x8 __attribute__((ext_vector_type(8)));
typedef short s16x4 __attribute__((ext_vector_type(4)));
typedef float f32x2 __attribute__((ext_vector_type(2)));
typedef float f32x4 __attribute__((ext_vector_type(4)));
typedef float f32x16 __attribute__((ext_vector_type(16)));
typedef unsigned u32x2 __attribute__((ext_vector_type(2)));
typedef unsigned u32x4 __attribute__((ext_vector_type(4)));
typedef __bf16 bf16x2_t __attribute__((ext_vector_type(2)));

__device__ __forceinline__ unsigned cvtpk(float lo, float hi) { f32x2 v = {lo, hi}; bf16x2_t b = __builtin_convertvector(v, bf16x2_t); return __builtin_bit_cast(unsigned, b); }
__device__ __forceinline__ float bf_lo(unsigned u) { return __uint_as_float(u << 16); }
__device__ __forceinline__ float bf_hi(unsigned u) { return __uint_as_float(u & 0xffff0000u); }
__device__ __forceinline__ float bf1(bf16_t u) { return __uint_as_float(((unsigned)u) << 16); }
__device__ __forceinline__ float fast_sigmoid(float x) { return __builtin_amdgcn_rcpf(1.0f + __expf(-x)); }

template <int ON, class T> __device__ __forceinline__ T ld_nt(const T* p) { if constexpr (ON != 0) return __builtin_nontemporal_load(p); else return *p; }
#ifndef NTL_X
#define NTL_X 0
#endif
#ifndef NTL_GATE
#define NTL_GATE 0
#endif
#ifndef NTL_EPI
#define NTL_EPI 0
#endif
#ifndef NTL_GLA
#define NTL_GLA 0
#endif
#ifndef NTL_SB
#define NTL_SB 0
#endif
#ifndef NTL_PEER
#define NTL_PEER 0
#endif
template <int ON, class T> __device__ __forceinline__ void st_nt(T v, T* p) { if constexpr (ON != 0) __builtin_nontemporal_store(v, p); else *p = v; }
#ifndef PROJ_ST
#define PROJ_ST 1
#endif
#ifndef NT_PROJ_T
#define NT_PROJ_T 1
#endif
#ifndef NT_PROJ_MASK
#define NT_PROJ_MASK 0xFFFFFFFFu
#endif
#ifndef NT_Q
#define NT_Q 0
#endif
#ifndef NT_FINAL
#define NT_FINAL 0
#endif
#ifndef NT_TAB
#define NT_TAB 1
#endif
#ifndef NT_EPI
#define NT_EPI 0
#endif
#ifndef NT_PRE
#define NT_PRE 0
#endif
#ifndef NT_ATT
#define NT_ATT 0
#endif
#ifndef NT_OUT
#define NT_OUT 0
#endif

#ifndef PG8_WGM
#define PG8_WGM 8
#endif
namespace pg8 {
constexpr int BM = 256, BK = 64, HALF = 128, HTB = HALF * BK * 2  , STAGE_BYTES = 8 * HTB, NXCD = 8, WGM = PG8_WGM;

__host__ __device__ __forceinline__ int lds_byte(int r, int c) { const int st = (r >> 4) * 2 + (c >> 5), rr = r & 15, cc = c & 31, ob = rr * 64 + cc * 2; return st * 1024 + (ob ^ (((ob >> 9) & 1) << 5)); }
__host__ __device__ __forceinline__ void stage_rc(int b, int& R, int& C) { const int st = b / 1024, sb = b % 1024, swz = sb ^ (((sb >> 9) & 1) << 5); R = (st >> 1) * 16 + swz / 64; C = (st & 1) * 32 + (swz % 64) / 2; }
__host__ __device__ __forceinline__ int perm32(int rho) { const int n = rho >> 4, i = rho & 15; return 8 * (i >> 2) + 4 * n + (i & 3); }

struct Unit { int pm, pn, half; };
struct Gemm { const bf16_t* A; const bf16_t* Bt; int M, N, K, lda, a_pn_cols; int swap_lo, swap_hi; const bf16_t* A2 = nullptr; const bf16_t* Bt2 = nullptr; };

struct StaticOrder {
    int nM, nN, nwg, G, c;
    __host__ __device__ void init(int M, int N, int G_, int c_) { nM = M / BM; nN = N / BM; nwg = nM * nN; G = G_; c = c_; }
    __host__ __device__ bool next(int i, Unit& u) const {
        const long L = (long)i * G + c; if (L >= nwg) return false;
        int wgid = (int)L; { const int q = nwg / NXCD, r = nwg % NXCD, xcd = wgid % NXCD, off = wgid / NXCD; wgid = (xcd < r ? xcd * (q + 1) : r * (q + 1) + (xcd - r) * q) + off; }
        const int nig = WGM * nN, gid = wgid / nig, fm = gid * WGM, gsz = (nM - fm) < WGM ? (nM - fm) : WGM;
        u.pm = fm + ((wgid % nig) % gsz); u.pn = (wgid % nig) / gsz; u.half = 0; return true;
    }
};
struct PairOrder {
    StaticOrder S;
    __host__ __device__ void init(int M, int N, int G_, int c_) { S.init(M, N, G_, c_); }
    __host__ __device__ bool next(int i, Unit& u) const { if (!S.next(i >> 1, u)) return false; u.half = i & 1; return true; }
};

template <class Epi, bool ALIGN_EPI = true, bool SP2 = true, class Order = StaticOrder>
__device__ __forceinline__ void gemm_phase(LAS unsigned char* lds, const Gemm g, const Order& S, const Epi& E, int tid) {
    const int wid = __builtin_amdgcn_readfirstlane(tid >> 6), lane = tid & 63, wr = wid >> 2, wc = wid & 3, fr = lane & 15, fq = lane >> 4;
    const int K = g.K, nt = K / BK, lda = g.lda;
    unsigned voffA[2], voffB[2];
#pragma unroll
    for (int i = 0; i < 2; ++i) { int R, C; stage_rc(tid * 16 + i * 8192, R, C); const int Rb = Epi::PERM ? ((R & ~31) + perm32(R & 31)) : R;
        voffA[i] = (unsigned)(R * lda + C) * 2u; voffB[i] = (unsigned)(Rb * K + C) * 2u; }
    const size_t kstep = (size_t)(BK * 2);
    const size_t hA = (size_t)HALF * lda * 2, hB = (size_t)HALF * K * 2;
    const size_t tA = 2 * hA, tB = 2 * hB;
    const size_t pnA = (size_t)g.a_pn_cols * 2;
    const unsigned ldsw = (unsigned)wid * 1024u;
    const int aoff = lds_byte(wr * 64 + fr, fq * 8), boff = lds_byte(wc * 32 + fr, fq * 8);
#define PG8_SA(b, h) (((b) * 2 + (h)) * HTB)
#define PG8_SB(b, h) ((4 + (b) * 2 + (h)) * HTB)
#define PG8_STAGE(bufoff, gbase, voff) do { _Pragma("unroll") for (int _i = 0; _i < 2; ++_i) \
        __builtin_amdgcn_global_load_lds((const unsigned*)((const char*)(gbase) + (voff)[_i]), (LAS unsigned*)(lds + (bufoff) + ldsw + _i * 8192), 16, 0, 0); } while (0)
#define PG8_LDA(dst, b, h) do { _Pragma("unroll") for (int m = 0; m < 4; ++m) _Pragma("unroll") for (int k = 0; k < 2; ++k) dst[m][k] = *(const LAS bf16x8*)(lds + PG8_SA(b, h) + aoff + m * 2048 + k * 1024); } while (0)
#define PG8_LDB(dst, b, h) do { _Pragma("unroll") for (int n = 0; n < 2; ++n) _Pragma("unroll") for (int k = 0; k < 2; ++k) dst[n][k] = *(const LAS bf16x8*)(lds + PG8_SB(b, h) + boff + n * 2048 + k * 1024); } while (0)
#define PG8_MMA(ai, bj, At, Bt) do { __builtin_amdgcn_s_setprio(1); _Pragma("unroll") for (int m = 0; m < 4; ++m) _Pragma("unroll") for (int n = 0; n < 2; ++n) _Pragma("unroll") for (int k = 0; k < 2; ++k) \
        acc[ai][bj][m][n] = __builtin_amdgcn_mfma_f32_16x16x32_bf16(Bt[n][k], At[m][k], acc[ai][bj][m][n], 0, 0, 0); __builtin_amdgcn_s_setprio(0); } while (0)
#define PG8_WAIT_V(n) asm volatile("s_waitcnt vmcnt(" #n ")" ::: "memory")
#define PG8_WAIT_L(n) asm volatile("s_waitcnt lgkmcnt(" #n ")" ::: "memory")
#define PG8_BAR __builtin_amdgcn_s_barrier()
#define PG8_SCHED __builtin_amdgcn_sched_barrier(0)
    Unit cur, nxt; int ui = 0;
    if (!S.next(0, cur)) return;
    f32x4 acc[2][2][4][2];
#pragma unroll
    for (int a = 0; a < 2; ++a)
#pragma unroll
        for (int b = 0; b < 2; ++b)
#pragma unroll
            for (int m = 0; m < 4; ++m)
#pragma unroll
                for (int n = 0; n < 2; ++n) acc[a][b][m][n] = (f32x4){0.f, 0.f, 0.f, 0.f};
    bf16x8 At[4][2], B0[2][2], B1[2][2];
#define PG8_APTR(u) ((u).half ? (const char*)g.A2 + (size_t)(u).pm * tA : ((u).pn >= g.swap_lo && (u).pn < g.swap_hi) ? (const char*)g.Bt + (size_t)(u).pn * tB : (const char*)g.A + (size_t)(u).pm * tA + (size_t)(u).pn * pnA)
#define PG8_BPTR(u) ((u).half ? (const char*)g.Bt2 + (size_t)(u).pn * tB : ((u).pn >= g.swap_lo && (u).pn < g.swap_hi) ? (const char*)g.A + (size_t)(u).pm * tA : (const char*)g.Bt + (size_t)(u).pn * tB)
    const char* cA = PG8_APTR(cur); const char* cB = PG8_BPTR(cur);
    if constexpr (SP2) {
        PG8_STAGE(PG8_SB(0, 0), cB, voffB); PG8_STAGE(PG8_SB(0, 1), cB + hB, voffB); PG8_STAGE(PG8_SA(0, 0), cA, voffA); PG8_STAGE(PG8_SA(0, 1), cA + hA, voffA);
        if (wr == 1) PG8_BAR;
        PG8_WAIT_V(2); PG8_BAR;
        PG8_STAGE(PG8_SB(1, 0), cB + kstep, voffB); PG8_STAGE(PG8_SA(1, 0), cA + kstep, voffA); PG8_STAGE(PG8_SB(1, 1), cB + hB + kstep, voffB);
        PG8_WAIT_V(6); PG8_BAR;
    } else {
        PG8_STAGE(PG8_SB(0, 0), cB, voffB); PG8_STAGE(PG8_SA(0, 0), cA, voffA); PG8_STAGE(PG8_SB(0, 1), cB + hB, voffB); PG8_STAGE(PG8_SA(0, 1), cA + hA, voffA);
        if (wr == 1) PG8_BAR;
        PG8_WAIT_V(4); PG8_BAR;
        PG8_STAGE(PG8_SB(1, 0), cB + kstep, voffB); PG8_STAGE(PG8_SA(1, 0), cA + kstep, voffA); PG8_STAGE(PG8_SB(1, 1), cB + hB + kstep, voffB);
        PG8_WAIT_V(6); PG8_BAR;
    }
    for (;;) {
        const bool has_next = S.next(ui + 1, nxt);
        const char* nA = has_next ? PG8_APTR(nxt) : cA; const char* nB = has_next ? PG8_BPTR(nxt) : cB;
#pragma unroll 1
        for (int t = 0; t < nt; t += 2) {
            const bool last = (t == nt - 2);
            const char* a1 = cA + (size_t)(t + 1) * kstep;
            const char* a2 = last ? nA : cA + (size_t)(t + 2) * kstep; const char* b2 = last ? nB : cB + (size_t)(t + 2) * kstep;
            const char* a3 = a2 + kstep; const char* b3 = b2 + kstep;
            if constexpr (SP2) {
            PG8_LDB(B0, 0, 0); PG8_LDB(B1, 0, 1); PG8_SCHED; PG8_LDA(At, 0, 0); PG8_STAGE(PG8_SA(1, 1), a1 + hA, voffA);
            PG8_WAIT_V(8); PG8_WAIT_L(0); PG8_BAR; PG8_MMA(0, 0, At, B0); PG8_MMA(0, 1, At, B1); PG8_BAR; PG8_SCHED;
            PG8_LDA(At, 0, 1); PG8_STAGE(PG8_SB(0, 0), b2, voffB); PG8_STAGE(PG8_SB(0, 1), b2 + hB, voffB); PG8_STAGE(PG8_SA(0, 0), a2, voffA);
            PG8_WAIT_V(8); PG8_WAIT_L(0); PG8_BAR; PG8_MMA(1, 0, At, B0); PG8_MMA(1, 1, At, B1); PG8_BAR; PG8_SCHED;
            PG8_LDB(B0, 1, 0); PG8_LDB(B1, 1, 1); PG8_SCHED; PG8_LDA(At, 1, 0); PG8_STAGE(PG8_SA(0, 1), a2 + hA, voffA);
            PG8_WAIT_V(8); PG8_WAIT_L(0); PG8_BAR; PG8_MMA(0, 0, At, B0); PG8_MMA(0, 1, At, B1); PG8_BAR; PG8_SCHED;
            PG8_LDA(At, 1, 1); PG8_STAGE(PG8_SB(1, 0), b3, voffB); PG8_STAGE(PG8_SB(1, 1), b3 + hB, voffB); PG8_STAGE(PG8_SA(1, 0), a3, voffA);
            PG8_WAIT_V(8); PG8_WAIT_L(0); PG8_BAR; PG8_MMA(1, 0, At, B0); PG8_MMA(1, 1, At, B1); PG8_BAR; PG8_SCHED;
            } else {
            PG8_LDB(B0, 0, 0); PG8_SCHED; PG8_LDA(At, 0, 0); PG8_STAGE(PG8_SA(1, 1), a1 + hA, voffA);
            PG8_WAIT_L(8); PG8_BAR; PG8_WAIT_L(0); PG8_MMA(0, 0, At, B0); PG8_BAR; PG8_SCHED;
            PG8_LDB(B1, 0, 1); PG8_STAGE(PG8_SB(0, 0), b2, voffB);
            PG8_BAR; PG8_WAIT_L(0); PG8_MMA(0, 1, At, B1); PG8_BAR;
            PG8_LDA(At, 0, 1); PG8_STAGE(PG8_SA(0, 0), a2, voffA);
            PG8_BAR; PG8_WAIT_L(0); PG8_MMA(1, 0, At, B0); PG8_BAR; PG8_SCHED;
            PG8_STAGE(PG8_SB(0, 1), b2 + hB, voffB);
            PG8_WAIT_V(6); PG8_BAR; PG8_MMA(1, 1, At, B1); PG8_BAR;
            PG8_LDB(B0, 1, 0); PG8_SCHED; PG8_LDA(At, 1, 0); PG8_STAGE(PG8_SA(0, 1), a2 + hA, voffA);
            PG8_WAIT_L(8); PG8_BAR; PG8_WAIT_L(0); PG8_MMA(0, 0, At, B0); PG8_BAR; PG8_SCHED;
            PG8_LDB(B1, 1, 1); PG8_STAGE(PG8_SB(1, 0), b3, voffB);
            PG8_BAR; PG8_WAIT_L(0); PG8_MMA(0, 1, At, B1); PG8_BAR;
            PG8_LDA(At, 1, 1); PG8_STAGE(PG8_SA(1, 0), a3, voffA);
            PG8_BAR; PG8_WAIT_L(0); PG8_MMA(1, 0, At, B0); PG8_BAR; PG8_SCHED;
            PG8_STAGE(PG8_SB(1, 1), b3 + hB, voffB);
            PG8_WAIT_V(6); PG8_BAR; PG8_MMA(1, 1, At, B1); PG8_BAR;
            }
        }
        if constexpr (ALIGN_EPI) { if (wr == 0) PG8_BAR; }
        E(acc, cur, wr, wc, fr, fq);
        if (!has_next) break;
        if (!(Epi::ACCUM && cur.half == 0))
#pragma unroll
        for (int a = 0; a < 2; ++a)
#pragma unroll
            for (int b = 0; b < 2; ++b)
#pragma unroll
                for (int m = 0; m < 4; ++m)
#pragma unroll
                    for (int n = 0; n < 2; ++n) acc[a][b][m][n] = (f32x4){0.f, 0.f, 0.f, 0.f};
        cur = nxt; cA = nA; cB = nB; ++ui;
        if constexpr (ALIGN_EPI) { if (wr == 1) PG8_BAR; }
    }
    PG8_WAIT_V(0);
    if constexpr (!ALIGN_EPI) { if (wr == 0) PG8_BAR; }
    PG8_BAR;
#undef PG8_APTR
#undef PG8_BPTR
#undef PG8_SA
#undef PG8_SB
#undef PG8_STAGE
#undef PG8_LDA
#undef PG8_LDB
#undef PG8_MMA
#undef PG8_WAIT_V
#undef PG8_WAIT_L
#undef PG8_BAR
#undef PG8_SCHED
}
}
constexpr int T_TOK = 16384, DM = 1024, SEQ = 4096, NB = 4;
constexpr float EPS = 1e-6f;
constexpr float LOG2E = 1.4426950408889634f;

namespace pg8 {
struct EpiProj {
    static constexpr bool PERM = true, ACCUM = false;
    bf16_t *GQ, *GK, *GV, *GR, *SQ, *SK, *SV, *SGA, *SGB;
    __device__ __forceinline__ void operator()(const f32x4 (&acc)[2][2][4][2], const Unit& u, int wr, int wc, int fr, int fq) const {
        const int pn = u.pn; bf16_t* base; int ldc = 1024, c0; int act = 0; float sc = 1.f;
        if (pn >= 2 && pn < 8) {
            bf16_t* tb = (pn < 4) ? GK : GV; const int f0 = ((pn < 4) ? (pn - 2) : (pn - 4)) * 256 + wr * 64 + fr, t0 = u.pm * BM + wc * 32 + 8 * fq;
#pragma unroll
            for (int ai = 0; ai < 2; ++ai)
#pragma unroll
                for (int m = 0; m < 4; ++m) { bf16_t* rowp = tb + (size_t)(f0 + ai * HALF + m * 16) * T_TOK + t0;
#pragma unroll
                    for (int bj = 0; bj < 2; ++bj) { const f32x4 v0 = acc[ai][bj][m][0], v1 = acc[ai][bj][m][1];
                        u32x4 w; w.x = cvtpk(v0[0], v0[1]); w.y = cvtpk(v0[2], v0[3]); w.z = cvtpk(v1[0], v1[1]); w.w = cvtpk(v1[2], v1[3]);
                        st_nt<PROJ_ST>(w, (u32x4*)(rowp + bj * HALF)); } }
            return; }
        if (pn < 2) { base = GQ; ldc = 512; c0 = pn * 256; sc = 0.08838834764831845f; }
        else if (pn < 4) { base = GK; ldc = 512; c0 = (pn - 2) * 256; }
        else if (pn < 8) { base = GV; c0 = (pn - 4) * 256; }
        else if (pn < 12) { base = GR; c0 = (pn - 8) * 256; act = 1; }
        else if (pn < 16) { base = SQ; c0 = (pn - 12) * 256; sc = 0.125f * LOG2E; }
        else if (pn < 20) { base = SK; c0 = (pn - 16) * 256; }
        else if (pn < 24) { base = SV; c0 = (pn - 20) * 256; }
        else if (pn < 28) { base = SGA; c0 = (pn - 24) * 256; act = 2; }
        else { base = SGB; c0 = (pn - 28) * 256; act = 2; }
        const int row0 = u.pm * BM + wr * 64 + fr, col0 = c0 + wc * 32 + 8 * fq;
#pragma unroll
        for (int ai = 0; ai < 2; ++ai)
#pragma unroll
            for (int m = 0; m < 4; ++m) { bf16_t* rowp = base + (size_t)(row0 + ai * HALF + m * 16) * ldc + col0;
#pragma unroll
                for (int bj = 0; bj < 2; ++bj) { f32x4 v0 = acc[ai][bj][m][0], v1 = acc[ai][bj][m][1];
                    if (act == 1) {
#pragma unroll
                        for (int j = 0; j < 4; ++j) { v0[j] = v0[j] * fast_sigmoid(v0[j]); v1[j] = v1[j] * fast_sigmoid(v1[j]); } }
                    else if (act == 2) {
#pragma unroll
                        for (int j = 0; j < 4; ++j) { v0[j] = fast_sigmoid(v0[j]); v1[j] = fast_sigmoid(v1[j]); } }
                    else { v0 = v0 * sc; v1 = v1 * sc; }
                    u32x4 w; w.x = cvtpk(v0[0], v0[1]); w.y = cvtpk(v0[2], v0[3]); w.z = cvtpk(v1[0], v1[1]); w.w = cvtpk(v1[2], v1[3]);
                    st_nt<PROJ_ST>(w, (u32x4*)(rowp + bj * HALF)); } }
    }
};
struct EpiMixPair {
    static constexpr bool PERM = true, ACCUM = true;
    const bf16_t* ga; const bf16_t* gb; bf16_t* mixed;
    __device__ __forceinline__ void operator()(f32x4 (&acc)[2][2][4][2], const Unit& u, int wr, int wc, int fr, int fq) const {
        const int row0 = u.pm * BM + wr * 64 + fr, col0 = u.pn * BM + wc * 32 + 8 * fq;
        const float TINY = 8.673617379884035e-19f;
        if (u.half == 0) {
#pragma unroll
            for (int ai = 0; ai < 2; ++ai) {
                u32x4 av[4][2], bv[4][2];
#pragma unroll
                for (int m = 0; m < 4; ++m)
#pragma unroll
                    for (int bj = 0; bj < 2; ++bj) { const size_t off = (size_t)(row0 + ai * HALF + m * 16) * 1024 + col0 + bj * HALF; av[m][bj] = ld_nt<NTL_GATE>((const u32x4*)(ga + off)); bv[m][bj] = ld_nt<NTL_GATE>((const u32x4*)(gb + off)); }
#pragma unroll
                for (int m = 0; m < 4; ++m)
#pragma unroll
                    for (int bj = 0; bj < 2; ++bj) { const u32x4 a4 = av[m][bj], b4 = bv[m][bj];
                        const unsigned aw[4] = {a4.x, a4.y, a4.z, a4.w}, bw[4] = {b4.x, b4.y, b4.z, b4.w};
#pragma unroll
                        for (int j = 0; j < 4; ++j) { const float r0 = bf_lo(aw[j]) * __builtin_amdgcn_rcpf(fmaxf(bf_lo(bw[j]), TINY)), r1 = bf_hi(aw[j]) * __builtin_amdgcn_rcpf(fmaxf(bf_hi(bw[j]), TINY));
                            acc[ai][bj][m][j >> 1][2 * (j & 1)] *= r0; acc[ai][bj][m][j >> 1][2 * (j & 1) + 1] *= r1; } }
            }
        } else {
#pragma unroll
            for (int ai = 0; ai < 2; ++ai) {
                u32x4 bv[4][2];
#pragma unroll
                for (int m = 0; m < 4; ++m)
#pragma unroll
                    for (int bj = 0; bj < 2; ++bj) bv[m][bj] = ld_nt<NTL_GATE>((const u32x4*)(gb + (size_t)(row0 + ai * HALF + m * 16) * 1024 + col0 + bj * HALF));
#pragma unroll
                for (int m = 0; m < 4; ++m)
#pragma unroll
                    for (int bj = 0; bj < 2; ++bj) { const size_t off = (size_t)(row0 + ai * HALF + m * 16) * 1024 + col0 + bj * HALF; const u32x4 b4 = bv[m][bj];
                        const f32x4 a0 = acc[ai][bj][m][0], a1 = acc[ai][bj][m][1];
                        float r[8];
                        r[0] = a0[0] * fmaxf(bf_lo(b4.x), TINY); r[1] = a0[1] * fmaxf(bf_hi(b4.x), TINY); r[2] = a0[2] * fmaxf(bf_lo(b4.y), TINY); r[3] = a0[3] * fmaxf(bf_hi(b4.y), TINY);
                        r[4] = a1[0] * fmaxf(bf_lo(b4.z), TINY); r[5] = a1[1] * fmaxf(bf_hi(b4.z), TINY); r[6] = a1[2] * fmaxf(bf_lo(b4.w), TINY); r[7] = a1[3] * fmaxf(bf_hi(b4.w), TINY);
                        u32x4 w; w.x = cvtpk(r[0], r[1]); w.y = cvtpk(r[2], r[3]); w.z = cvtpk(r[4], r[5]); w.w = cvtpk(r[6], r[7]);
                        st_nt<NT_EPI>(w, (u32x4*)(mixed + off)); }
            }
        }
    }
};
struct EpiH1 {
    static constexpr bool PERM = true, ACCUM = false;
    const float* x; bf16_t* H1B; float* SSQ;
    __device__ __forceinline__ void operator()(const f32x4 (&acc)[2][2][4][2], const Unit& u, int wr, int wc, int fr, int fq) const {
        const int row0 = u.pm * BM + wr * 64 + fr, col0 = u.pn * BM + wc * 32 + 8 * fq;
#pragma unroll
        for (int ai = 0; ai < 2; ++ai) {
            f32x4 xv[4][2][2];
#pragma unroll
            for (int m = 0; m < 4; ++m)
#pragma unroll
                for (int bj = 0; bj < 2; ++bj)
#pragma unroll
                    for (int n = 0; n < 2; ++n) xv[m][bj][n] = ld_nt<NTL_X>((const f32x4*)(x + (size_t)(row0 + ai * HALF + m * 16) * 1024 + col0 + bj * HALF + n * 4));
#pragma unroll
            for (int m = 0; m < 4; ++m) { const int row = row0 + ai * HALF + m * 16; const size_t off = (size_t)row * 1024 + col0; float s = 0.f;
#pragma unroll
                for (int bj = 0; bj < 2; ++bj) { const f32x4 h0 = xv[m][bj][0] + acc[ai][bj][m][0], h1 = xv[m][bj][1] + acc[ai][bj][m][1];
                    s += ((h0[0] * h0[0] + h0[1] * h0[1]) + (h0[2] * h0[2] + h0[3] * h0[3])) + ((h1[0] * h1[0] + h1[1] * h1[1]) + (h1[2] * h1[2] + h1[3] * h1[3]));
                    u32x4 hb; hb.x = cvtpk(h0[0], h0[1]); hb.y = cvtpk(h0[2], h0[3]); hb.z = cvtpk(h1[0], h1[1]); hb.w = cvtpk(h1[2], h1[3]); st_nt<NT_EPI>(hb, (u32x4*)(H1B + off + bj * HALF)); }
                s += __shfl_xor(s, 16); s += __shfl_xor(s, 32);
                if (fq == 0) SSQ[(size_t)row * 16 + u.pn * 4 + wc] = s; }
        }
    }
};
struct EpiQ {
    static constexpr bool PERM = true, ACCUM = false;
    const float* SSQ; bf16_t* Q; int ldc;
    __device__ __forceinline__ void operator()(const f32x4 (&acc)[2][2][4][2], const Unit& u, int wr, int wc, int fr, int fq) const {
        const int row0 = u.pm * BM + wr * 64 + fr, col0 = u.pn * BM + wc * 32 + 8 * fq;
        float rstd[2][4];
#pragma unroll
        for (int ai = 0; ai < 2; ++ai) { f32x4 sq[4][4];
#pragma unroll
            for (int m = 0; m < 4; ++m) { const f32x4* sp = (const f32x4*)(SSQ + (size_t)(row0 + ai * HALF + m * 16) * 16);
#pragma unroll
                for (int j = 0; j < 4; ++j) sq[m][j] = sp[j]; }
#pragma unroll
            for (int m = 0; m < 4; ++m) { const f32x4 st = (sq[m][0] + sq[m][1]) + (sq[m][2] + sq[m][3]);
                rstd[ai][m] = __builtin_amdgcn_rsqf(((st[0] + st[1]) + (st[2] + st[3])) * (1.0f / 1024.0f) + EPS); } }
#pragma unroll
        for (int ai = 0; ai < 2; ++ai)
#pragma unroll
            for (int m = 0; m < 4; ++m) { const int row = row0 + ai * HALF + m * 16;
                bf16_t* rowp = Q + (size_t)row * ldc + col0;
#pragma unroll
                for (int bj = 0; bj < 2; ++bj) { const f32x4 v0 = acc[ai][bj][m][0] * rstd[ai][m], v1 = acc[ai][bj][m][1] * rstd[ai][m];
                    u32x4 w; w.x = cvtpk(v0[0], v0[1]); w.y = cvtpk(v0[2], v0[3]); w.z = cvtpk(v1[0], v1[1]); w.w = cvtpk(v1[2], v1[3]);
                    st_nt<NT_Q>(w, (u32x4*)(rowp + bj * HALF)); } }
    }
};
struct EpiBf {
    static constexpr bool PERM = true, ACCUM = false;
    bf16_t* O; int ldc;
    __device__ __forceinline__ void operator()(const f32x4 (&acc)[2][2][4][2], const Unit& u, int wr, int wc, int fr, int fq) const {
        const int row0 = u.pm * BM + wr * 64 + fr, col0 = u.pn * BM + wc * 32 + 8 * fq;
#pragma unroll
        for (int ai = 0; ai < 2; ++ai)
#pragma unroll
            for (int m = 0; m < 4; ++m) { bf16_t* rowp = O + (size_t)(row0 + ai * HALF + m * 16) * ldc + col0;
#pragma unroll
                for (int bj = 0; bj < 2; ++bj) { const f32x4 v0 = acc[ai][bj][m][0], v1 = acc[ai][bj][m][1];
                    u32x4 w; w.x = cvtpk(v0[0], v0[1]); w.y = cvtpk(v0[2], v0[3]); w.z = cvtpk(v1[0], v1[1]); w.w = cvtpk(v1[2], v1[3]);
                    st_nt<NT_EPI>(w, (u32x4*)(rowp + bj * HALF)); } }
    }
};
constexpr int H3L_PITCH = 544;
struct EpiH3L {
    static constexpr bool PERM = true, ACCUM = false;
    const bf16_t* H2B; const bf16_t* PLE; const float* RS; LAS unsigned char* tile; float* SSQ;
    __device__ __forceinline__ void operator()(const f32x4 (&acc)[2][2][4][2], const Unit& u, int wr, int wc, int fr, int fq) const {
        const int lrow0 = wr * 64 + fr, lcol0 = wc * 32 + 8 * fq, row0 = u.pm * BM + lrow0, col0 = u.pn * BM + lcol0;
        asm volatile("s_waitcnt vmcnt(0)" ::: "memory"); __builtin_amdgcn_s_barrier();
#pragma unroll
        for (int ai = 0; ai < 2; ++ai) {
            u32x4 hv[4][2], pv[4][2]; float rs[4];
#pragma unroll
            for (int m = 0; m < 4; ++m) rs[m] = RS[row0 + ai * HALF + m * 16];
#pragma unroll
            for (int m = 0; m < 4; ++m)
#pragma unroll
                for (int bj = 0; bj < 2; ++bj) { const size_t o2 = (size_t)(row0 + ai * HALF + m * 16) * 1024 + col0 + bj * HALF; hv[m][bj] = ld_nt<NTL_EPI>((const u32x4*)(H2B + o2)); pv[m][bj] = ld_nt<NTL_EPI>((const u32x4*)(PLE + o2)); }
#pragma unroll
            for (int m = 0; m < 4; ++m) { const int lrow = lrow0 + ai * HALF + m * 16; float s = 0.f;
#pragma unroll
                for (int bj = 0; bj < 2; ++bj) { const u32x4 h4 = hv[m][bj], p4 = pv[m][bj];
                    const f32x4 a0 = acc[ai][bj][m][0] * rs[m], a1 = acc[ai][bj][m][1] * rs[m]; float h[8];
                    h[0] = bf_lo(h4.x) + bf_lo(p4.x) * fast_sigmoid(a0[0]); h[1] = bf_hi(h4.x) + bf_hi(p4.x) * fast_sigmoid(a0[1]);
                    h[2] = bf_lo(h4.y) + bf_lo(p4.y) * fast_sigmoid(a0[2]); h[3] = bf_hi(h4.y) + bf_hi(p4.y) * fast_sigmoid(a0[3]);
                    h[4] = bf_lo(h4.z) + bf_lo(p4.z) * fast_sigmoid(a1[0]); h[5] = bf_hi(h4.z) + bf_hi(p4.z) * fast_sigmoid(a1[1]);
                    h[6] = bf_lo(h4.w) + bf_lo(p4.w) * fast_sigmoid(a1[2]); h[7] = bf_hi(h4.w) + bf_hi(p4.w) * fast_sigmoid(a1[3]);
                    u32x4 w; w.x = cvtpk(h[0], h[1]); w.y = cvtpk(h[2], h[3]); w.z = cvtpk(h[4], h[5]); w.w = cvtpk(h[6], h[7]);
                    *(LAS u32x4*)(tile + lrow * H3L_PITCH + (lcol0 + bj * HALF) * 2) = w;
                    s += ((h[0] * h[0] + h[1] * h[1]) + (h[2] * h[2] + h[3] * h[3])) + ((h[4] * h[4] + h[5] * h[5]) + (h[6] * h[6] + h[7] * h[7])); }
                s += __shfl_xor(s, 16); s += __shfl_xor(s, 32);
                if (fq == 0) __hip_atomic_fetch_add(SSQ + (u.pm * BM + lrow), s, __ATOMIC_RELAXED, __HIP_MEMORY_SCOPE_AGENT); }
        }
    }
};
}
constexpr size_t MiB = 1u << 20;
constexpr size_t WS_CTL = 0, CTL_ZERO_BYTES = 256 * 1024;
constexpr size_t WS_SSQ3S = 128 * 1024;
constexpr size_t WS_PEND = 64 * 1024;
constexpr size_t WS_WPLE = 512 * 1024;
constexpr size_t WS_KD = 1 * MiB;
constexpr size_t WS_GLAG = 2 * MiB;
constexpr size_t WS_WIN = 3 * MiB;
constexpr size_t WS_SEND = 4 * MiB;
constexpr size_t WS_EXP = 4 * MiB;
constexpr size_t WS_SSQ1 = 13 * MiB;
constexpr size_t WS_SSQ3 = 14 * MiB;
constexpr size_t WS_RS3 = 15 * MiB;
constexpr size_t WS_RSU = 1536 * 1024, WS_RSV = 1536 * 1024 + 64 * 1024;
constexpr size_t WS_WGA = 20 * MiB, WS_WSB = 22 * MiB, WS_WO = 24 * MiB, WS_WPG = 26 * MiB, WS_WPQ = 28 * MiB;
constexpr size_t WS_A = 32 * MiB;
constexpr size_t WS_GQ = WS_A, WS_GK = WS_A + 16 * MiB, WS_PLE = WS_A;
constexpr size_t WS_B = 64 * MiB;
constexpr size_t WS_GV = WS_B, WS_PB = WS_B;
constexpr size_t WS_C = 96 * MiB;
constexpr size_t WS_GR = WS_C, WS_GLAN = WS_C, WS_H1 = WS_C;
constexpr size_t WS_D = 128 * MiB;
constexpr size_t WS_SQ = WS_D, WS_H2B = WS_D;
constexpr size_t WS_E = 160 * MiB;
constexpr size_t WS_SK = WS_E, WS_MIX = WS_E, WS_Q = WS_E;
constexpr size_t WS_F = 192 * MiB;
constexpr size_t WS_SV = WS_F;
constexpr size_t WS_G = 224 * MiB;
constexpr size_t WS_XN1 = WS_G, WS_UB8 = WS_G, WS_VB8 = WS_G + 16 * MiB;
constexpr size_t WS_ALO = 256 * MiB;
constexpr size_t WS_END = 257 * MiB;

constexpr int NWAVES = 8;
constexpr int RING_OFF = 0, RING_BYTES = 131072;
constexpr int MISC_OFF = 143360;
constexpr int LDS_BYTES = 147456;
constexpr int CW_BAR = 1024;
constexpr int CW_ROWCNT = 512;

typedef GAS unsigned gu32;
#define RLX_AGENT __ATOMIC_RELAXED, __HIP_MEMORY_SCOPE_AGENT
#define LDS_WAIT() asm volatile("s_waitcnt lgkmcnt(0)" ::: "memory")
#define VM_WAIT() asm volatile("s_waitcnt vmcnt(0)" ::: "memory")

#define XB_TMO      128
#define XB_XCNT(j)  (256  + 64 * (j))
#define XB_XSUB(j)  (1280 + 64 * (j))
#define XB_XGEN(j)  (2304 + 64 * (j))
#define XB_TOP      3328
#define XB_TOPGEN   3392
#define XCD_BAR_WORDS 3456
#define XB_SPIN_CAP (1u << 22)
__device__ __forceinline__ unsigned xb_ld(unsigned* p)              { return __hip_atomic_load(p, __ATOMIC_RELAXED, __HIP_MEMORY_SCOPE_AGENT); }
__device__ __forceinline__ unsigned xb_add(unsigned* p, unsigned v) { return __hip_atomic_fetch_add(p, v, __ATOMIC_RELAXED, __HIP_MEMORY_SCOPE_AGENT); }
__device__ __forceinline__ unsigned xb_xcc_id() { return (unsigned)__builtin_amdgcn_s_getreg((3 << 11) | 20) & 0xFu; }
#define XB_SPIN(cond, bar) do { unsigned _sp = 0; while (cond) { __builtin_amdgcn_s_sleep(1); \
    if ((++_sp & 255u) == 0u) { if (xb_ld(&(bar)[XB_TMO])) break; if (_sp > XB_SPIN_CAP) { atomicAdd(&(bar)[XB_TMO], 1u); break; } } } } while (0)
struct XcdBarrier { unsigned* bar; unsigned x; volatile LAS unsigned* st; };
__device__ __forceinline__ XcdBarrier xcd_barrier_post(unsigned* bar, volatile LAS unsigned* st, int tid) {
    XcdBarrier b; b.bar = bar; b.x = xb_xcc_id(); b.st = st;
    if (tid == 0) (void)xb_add(&bar[XB_XCNT(b.x)], 1u);
    return b;
}
__device__ __forceinline__ void xcd_barrier_complete(unsigned* bar, unsigned x, unsigned& nloc, unsigned& nx) {
    const unsigned G = gridDim.x * gridDim.y * gridDim.z;
    unsigned sum, cnt, mine, sp = 0u;
    for (;;) {
        sum = 0u; cnt = 0u; mine = 0u;
#pragma unroll
        for (unsigned j = 0; j < 16; ++j) { const unsigned c = xb_ld(&bar[XB_XCNT(j)]); sum += c; cnt += (c > 0u) ? 1u : 0u; mine = (j == x) ? c : mine; }
        if (sum == G) break;
        __builtin_amdgcn_s_sleep(1);
        if ((++sp & 255u) == 0u) { if (xb_ld(&bar[XB_TMO])) break; if (sp > XB_SPIN_CAP) { atomicAdd(&bar[XB_TMO], 1u); break; } }
    }
    nloc = mine > 0u ? mine : 1u; nx = cnt > 0u ? cnt : 1u;
}
__device__ __forceinline__ void xcd_barrier(const XcdBarrier& b, int tid) {
    asm volatile("s_waitcnt vmcnt(0)" ::: "memory");
    __syncthreads();
    if (tid == 0) {
        unsigned* bar = b.bar;
        __builtin_amdgcn_s_waitcnt(0);
        unsigned nloc = b.st[0], nx = b.st[1];
        if (nloc == 0u) { xcd_barrier_complete(bar, b.x, nloc, nx); b.st[0] = nloc; b.st[1] = nx; }
        const unsigned old = xb_add(&bar[XB_XSUB(b.x)], 1u);
        const unsigned gen = old / nloc;
        if (old + 1u == (gen + 1u) * nloc) {
            __builtin_amdgcn_fence(__ATOMIC_RELEASE, "agent");
            asm volatile("s_waitcnt vmcnt(0)" ::: "memory");
            const unsigned og = xb_add(&bar[XB_TOP], 1u);
            const unsigned tg = og / nx;
            if (og + 1u == (tg + 1u) * nx) xb_add(&bar[XB_TOPGEN], 1u);
            else XB_SPIN(xb_ld(&bar[XB_TOPGEN]) == tg, bar);
            __builtin_amdgcn_fence(__ATOMIC_ACQUIRE, "agent");
            xb_add(&bar[XB_XGEN(b.x)], 1u);
            asm volatile("s_waitcnt vmcnt(0)" ::: "memory");
        } else {
            XB_SPIN(xb_ld(&bar[XB_XGEN(b.x)]) == gen, bar);
            __builtin_amdgcn_fence(__ATOMIC_ACQUIRE, "agent");
            asm volatile("s_waitcnt vmcnt(0)" ::: "memory");
        }
    }
    __syncthreads();
}

struct Frame {
    LAS unsigned char* lds;
    int tid, lane, wave, vcu, G, dry;
    const float* const* in; float* out; unsigned char* ws;
};
__device__ __forceinline__ int lane_id() { int l; asm volatile("v_mbcnt_lo_u32_b32 %0, -1, 0\n\tv_mbcnt_hi_u32_b32 %0, -1, %0" : "=v"(l)); return l; }
#define WSP(T, off) ((T*)(F.ws + (off)))
__device__ __forceinline__ float wave_sum(float v) {
#pragma unroll
    for (int o = 1; o < 64; o <<= 1) v += __shfl_xor(v, o);
    return v;
}
#ifndef NTL_PRE
#define NTL_PRE 1
#endif
template <class RowMap>
__device__ __forceinline__ void p0_transpose_item(const float* W, int K, int N, bf16_t* WT, RowMap rm, LAS float* scr, int item, int lane, const float* gk = nullptr) {
    const int nblk = (N + 31) / 32, kb = item / nblk, nb = item % nblk, k0 = 64 * kb, n0 = 32 * nb;
    { const int kr = lane >> 3, c4 = lane & 7, nl = n0 + 4 * c4; f32x4 v[8];
#pragma unroll
      for (int i = 0; i < 8; ++i) v[i] = (nl < N) ? (NTL_PRE ? __builtin_nontemporal_load((const f32x4*)(W + (size_t)(k0 + 8 * i + kr) * N + nl)) : *(const f32x4*)(W + (size_t)(k0 + 8 * i + kr) * N + nl)) : (f32x4){0.f, 0.f, 0.f, 0.f};
#pragma unroll
      for (int i = 0; i < 8; ++i) { LAS float* d = scr + (8 * i + kr) * 33 + 4 * c4; d[0] = v[i][0]; d[1] = v[i][1]; d[2] = v[i][2]; d[3] = v[i][3]; } }
    LDS_WAIT(); asm volatile("" ::: "memory");
    const int c = lane & 7;
    f32x4 ga = (f32x4){1.f, 1.f, 1.f, 1.f}, gb = ga; if (gk) { ga = *(const f32x4*)(gk + k0 + 8 * c); gb = *(const f32x4*)(gk + k0 + 8 * c + 4); }
#pragma unroll
    for (int j = 0; j < 4; ++j) { const int n = (lane >> 3) + 8 * j; const LAS float* s = scr + (8 * c) * 33 + n;
        u32x4 o; o.x = cvtpk(s[0 * 33] * ga[0], s[1 * 33] * ga[1]); o.y = cvtpk(s[2 * 33] * ga[2], s[3 * 33] * ga[3]); o.z = cvtpk(s[4 * 33] * gb[0], s[5 * 33] * gb[1]); o.w = cvtpk(s[6 * 33] * gb[2], s[7 * 33] * gb[3]);
        if (n0 + n < N) st_nt<NT_PRE>(o, (u32x4*)(WT + (size_t)rm(n0 + n) * K + k0 + 8 * c)); }
    LDS_WAIT(); asm volatile("" ::: "memory");
}
struct RmId { __device__ __forceinline__ int operator()(int n) const { return n; } };
struct RmWin { __device__ __forceinline__ int operator()(int n) const { return n < 3072 ? n : (n < 3088 ? 8192 + (n - 3072) : n - 16); } };

__device__ __forceinline__ void cvt_copy(Frame& F, const float* src, bf16_t* dst, size_t n, int part, int nparts) {
    const size_t nth = (size_t)nparts * 512, n8 = n / 8;
    for (size_t i = (size_t)part * 512 + F.tid; i < n8; i += nth) {
        const f32x4 a = ld_nt<NTL_PRE>((const f32x4*)(src + i * 8)), b = ld_nt<NTL_PRE>((const f32x4*)(src + i * 8 + 4));
        u32x4 o; o.x = cvtpk(a[0], a[1]); o.y = cvtpk(a[2], a[3]); o.z = cvtpk(b[0], b[1]); o.w = cvtpk(b[2], b[3]);
        st_nt<NT_PRE>(o, (u32x4*)(dst + i * 8)); }
}
__device__ __forceinline__ void phase_prologue(Frame& F) {
    LAS float* scr = (LAS float*)(F.lds + RING_OFF + F.wave * 16384);
    const int gw = F.vcu * NWAVES + F.wave, NGW = F.G * NWAVES;
    constexpr int I_IN = 16 * 257, I_SQ = 16 * 32, I_PQ = 16 * 64, I_PLE = 4 * 32;
    constexpr int NITEMS = I_IN + 4 * I_SQ + I_PQ + I_PLE;
    for (int it = gw; it < NITEMS; it += NGW) {
        int r = it;
        if (r < I_IN) { p0_transpose_item<RmWin>(F.in[3], 1024, 8208, WSP(bf16_t, WS_WIN), RmWin(), scr, r, F.lane); continue; } r -= I_IN;
        if (r < I_SQ) { p0_transpose_item(F.in[7], 1024, 1024, WSP(bf16_t, WS_WGA), RmId(), scr, r, F.lane); continue; } r -= I_SQ;
        if (r < I_SQ) { p0_transpose_item(F.in[8], 1024, 1024, WSP(bf16_t, WS_WSB), RmId(), scr, r, F.lane); continue; } r -= I_SQ;
        if (r < I_SQ) { p0_transpose_item(F.in[9], 1024, 1024, WSP(bf16_t, WS_WO), RmId(), scr, r, F.lane); continue; } r -= I_SQ;
        if (r < I_SQ) { p0_transpose_item(F.in[17], 1024, 1024, WSP(bf16_t, WS_WPG), RmId(), scr, r, F.lane, F.in[16]); continue; } r -= I_SQ;
        if (r < I_PQ) { p0_transpose_item(F.in[11], 1024, 2048, WSP(bf16_t, WS_WPQ), RmId(), scr, r, F.lane, F.in[10]); continue; } r -= I_PQ;
        p0_transpose_item(F.in[18], 256, 1024, WSP(bf16_t, WS_WPLE), RmId(), scr, r, F.lane);
    }
    { const float* k1 = F.in[12]; const float* k2 = F.in[13]; bf16_t* KB = WSP(bf16_t, WS_KD);
      for (int i = F.vcu * 512 + F.tid; i < 2 * 8 * 128 * 16; i += F.G * 512) { const int half = i >> 14, rem = i & 16383, h = rem >> 11, r8 = rem & 2047;
          const float* s = (half ? k2 : k1) + (size_t)h * 16384 + (size_t)r8 * 8; const f32x4 a = *(const f32x4*)s, b = *(const f32x4*)(s + 4);
          u32x4 o; o.x = cvtpk(a[0], a[1]); o.y = cvtpk(a[2], a[3]); o.z = cvtpk(b[0], b[1]); o.w = cvtpk(b[2], b[3]);
          *(u32x4*)(KB + (size_t)(h * 2 + half) * 16384 + (size_t)r8 * 8) = o; } }
    f32x4 gmix[4];
#pragma unroll
    for (int j = 0; j < 4; ++j) gmix[j] = *((const f32x4*)F.in[2] + F.lane + 64 * j);
    for (int m = gw; m < T_TOK; m += 4 * NGW) {
        f32x4 v[4][4]; float s[4];
#pragma unroll
        for (int q = 0; q < 4; ++q) { const float* xr = F.in[0] + (size_t)(m + q * NGW) * 1024; s[q] = 0.f;
#pragma unroll
            for (int j = 0; j < 4; ++j) { v[q][j] = NTL_PRE ? __builtin_nontemporal_load((const f32x4*)xr + F.lane + 64 * j) : *((const f32x4*)xr + F.lane + 64 * j); s[q] += (v[q][j][0] * v[q][j][0] + v[q][j][1] * v[q][j][1]) + (v[q][j][2] * v[q][j][2] + v[q][j][3] * v[q][j][3]); } }
#pragma unroll
        for (int o = 1; o < 64; o <<= 1) {
#pragma unroll
            for (int q = 0; q < 4; ++q) s[q] += __shfl_xor(s[q], o); }
#pragma unroll
        for (int q = 0; q < 4; ++q) { const float rstd = __builtin_amdgcn_rsqf(s[q] * (1.f / 1024.f) + EPS); bf16_t* orow = WSP(bf16_t, WS_XN1) + (size_t)(m + q * NGW) * 1024;
#pragma unroll
            for (int j = 0; j < 4; ++j) { const f32x4 o = v[q][j] * rstd * gmix[j];
                u32x2 wq; wq.x = cvtpk(o[0], o[1]); wq.y = cvtpk(o[2], o[3]); st_nt<NT_PRE>(wq, (u32x2*)orow + F.lane + 64 * j); } }
    }
}

__device__ __forceinline__ void alo_unit(Frame& F, int u) {
    LAS float* part = (LAS float*)(F.lds + RING_OFF);
    const bf16_t* XN1 = WSP(bf16_t, WS_XN1); const bf16_t* WGAT = WSP(bf16_t, WS_WIN) + (size_t)8192 * 1024; float* ALO = WSP(float, WS_ALO);
    const int tid = F.tid, lane = F.lane, w = F.wave; const size_t r0 = (size_t)u * 64;
    __syncthreads();
    const bf16_t* bp = WGAT + (size_t)(lane & 15) * 1024 + 8 * (lane >> 4) + 128 * w;
    bf16x8 bq[4], aq[4][4];
#pragma unroll
    for (int s = 0; s < 4; ++s) bq[s] = *(const bf16x8*)(bp + 32 * s);
#pragma unroll
    for (int rt = 0; rt < 4; ++rt) { const bf16_t* ap = XN1 + (r0 + 16 * rt + (lane & 15)) * 1024 + 8 * (lane >> 4) + 128 * w;
#pragma unroll
        for (int s = 0; s < 4; ++s) aq[rt][s] = *(const bf16x8*)(ap + 32 * s); }
#pragma unroll
    for (int rt = 0; rt < 4; ++rt) { f32x4 acc = (f32x4){0.f, 0.f, 0.f, 0.f};
#pragma unroll
        for (int s = 0; s < 4; ++s) acc = __builtin_amdgcn_mfma_f32_16x16x32_bf16(aq[rt][s], bq[s], acc, 0, 0, 0);
#pragma unroll
        for (int r = 0; r < 4; ++r) part[w * 1024 + (16 * rt + 4 * (lane >> 4) + r) * 16 + (lane & 15)] = acc[r]; }
    __syncthreads();
#pragma unroll
    for (int q = 0; q < 2; ++q) { const int e = tid + 512 * q; float s = 0.f;
#pragma unroll
        for (int ww = 0; ww < 8; ++ww) s += part[ww * 1024 + e];
        ALO[r0 * 16 + e] = s; }
    __syncthreads();
}
constexpr int GL_KD = 0, GL_Q = 32768, GL_G = 65536, GL_RED = 65536 + 1024, GL_OT = 65536 + 1024 + 4096, GL_OT_PITCH = 260;
__device__ __forceinline__ int gl_kd_off(int row, int chunk) { return row * 128 + ((chunk ^ ((row >> 1) & 7)) << 4); }
__device__ __forceinline__ int gl_q_off(int row, int chunk16) { return row * 256 + ((chunk16 ^ (row & 15)) << 4); }

struct GlaStage { u32x4 kd[2]; u32x4 q[2]; float g; };
__device__ __forceinline__ void gla_prefetch_vt(Frame& F, bf16x8 (&vtd)[4], int b, int h, int c) {
    const int u = b * 64 + c; const size_t r0 = (size_t)u * 64; const int w = F.wave, lq = F.lane & 31, hh = F.lane >> 5;
    const bf16_t* vt = WSP(bf16_t, WS_GV) + (size_t)(h * 256 + 32 * w + lq) * T_TOK + r0;
#pragma unroll
    for (int ts = 0; ts < 4; ++ts) vtd[ts] = ld_nt<NTL_GLA>((const bf16x8*)(vt + 16 * ts + 8 * hh));
}
template <bool WITH_Q>
__device__ __forceinline__ void gla_prefetch(Frame& F, GlaStage& st, int b, int h, int c) {
    const int u = b * 64 + c; const size_t r0 = (size_t)u * 64; const int tid = F.tid;
    const bf16_t* kd = WSP(bf16_t, WS_GK) + (size_t)(h * 128) * T_TOK + r0;
#pragma unroll
    for (int j = 0; j < 2; ++j) { const int pi = tid + 512 * j; st.kd[j] = ld_nt<NTL_GLA>((const u32x4*)(kd + (size_t)(pi >> 3) * T_TOK + (pi & 7) * 8)); }
    if (WITH_Q) { const bf16_t* gq = WSP(bf16_t, WS_GQ) + r0 * 512 + h * 128;
#pragma unroll
        for (int j = 0; j < 2; ++j) { const int pi = tid + 512 * j; st.q[j] = ld_nt<NTL_GLA>((const u32x4*)(gq + (size_t)(pi >> 4) * 512 + (pi & 15) * 8)); } }
    st.g = (tid < 128) ? WSP(float, WS_GLAG)[((size_t)u * 4 + h) * 128 + tid] : 1.f;
}
template <bool WITH_Q>
__device__ __forceinline__ void gla_stage_write(Frame& F, const GlaStage& st, int buf) {
    LAS unsigned char* lds = F.lds + RING_OFF; const int tid = F.tid;
#pragma unroll
    for (int j = 0; j < 2; ++j) { const int pi = tid + 512 * j; *(LAS u32x4*)(lds + GL_KD + buf * 16384 + gl_kd_off(pi >> 3, pi & 7)) = st.kd[j]; }
    if (WITH_Q) {
#pragma unroll
        for (int j = 0; j < 2; ++j) { const int pi = tid + 512 * j; *(LAS u32x4*)(lds + GL_Q + buf * 16384 + gl_q_off(pi >> 4, pi & 15)) = st.q[j]; } }
    if (tid < 128) *(LAS float*)(lds + GL_G + buf * 512 + tid * 4) = st.g;
}
__device__ __forceinline__ void gla_update(Frame& F, f32x16 (&S)[4], const bf16x8 (&vt)[4], int buf) {
    const LAS unsigned char* lds = F.lds + RING_OFF; const int lq = F.lane & 31, hh = F.lane >> 5;
    const LAS float* G = (const LAS float*)(lds + GL_G + buf * 512);
#pragma unroll
    for (int kt = 0; kt < 4; ++kt)
#pragma unroll
        for (int g4 = 0; g4 < 4; ++g4) { const f32x4 g = *(const LAS f32x4*)(G + 32 * kt + 8 * g4 + 4 * hh);
#pragma unroll
            for (int j = 0; j < 4; ++j) S[kt][4 * g4 + j] *= g[j]; }
    __builtin_amdgcn_s_setprio(1);
#pragma unroll
    for (int ts = 0; ts < 4; ++ts)
#pragma unroll
        for (int kt = 0; kt < 4; ++kt) { const bf16x8 a = *(const LAS bf16x8*)(lds + GL_KD + buf * 16384 + gl_kd_off(32 * kt + lq, 2 * ts + hh));
            S[kt] = __builtin_amdgcn_mfma_f32_32x32x16_bf16(a, vt[ts], S[kt], 0, 0, 0); if (kt == 3 && (ts & 1)) __builtin_amdgcn_sched_barrier(0); }
    __builtin_amdgcn_s_setprio(0);
}
__device__ __forceinline__ void gla_prep_seg(Frame& F, int b, int h, int seg) {
    LAS float* alo = (LAS float*)(F.lds + RING_OFF);
    bf16_t* GKT = WSP(bf16_t, WS_GK); float* GLAG = WSP(float, WS_GLAG); const float* ALO = WSP(float, WS_ALO);
    const float* w_up = F.in[4]; const float* b_a = F.in[5];
    const int tid = F.tid, k = tid & 127, cq = tid >> 7, kk = h * 128 + k;
    const size_t r0s = (size_t)(b * 64 + seg * 8) * 64;
    __syncthreads();
#pragma unroll
    for (int q = 0; q < 4; ++q) { const int idx = tid + 512 * q; *(LAS f32x4*)(alo + 4 * idx) = *(const f32x4*)(ALO + r0s * 16 + 4 * idx); }
    u32x4 kq[2][8];
#pragma unroll
    for (int c2 = 0; c2 < 2; ++c2) { const bf16_t* krow = GKT + (size_t)kk * T_TOK + r0s + 64 * (cq + 4 * c2);
#pragma unroll
        for (int j = 0; j < 8; ++j) kq[c2][j] = *(const u32x4*)(krow + 8 * j); }
    float wv[16];
#pragma unroll
    for (int r = 0; r < 16; ++r) wv[r] = w_up[r * 512 + kk];
    const float bias = b_a[kk];
    __syncthreads();
#pragma unroll
    for (int c2 = 0; c2 < 2; ++c2) { const int cc = cq + 4 * c2; bf16_t* krow = GKT + (size_t)kk * T_TOK + r0s + 64 * cc; const LAS float* al = alo + cc * 1024;
        float suffix = 0.f;
#pragma unroll
        for (int i8 = 7; i8 >= 0; --i8) {
            const unsigned kw[4] = {kq[c2][i8].x, kq[c2][i8].y, kq[c2][i8].z, kq[c2][i8].w};
            float o[8];
#pragma unroll
            for (int j = 7; j >= 0; --j) { const int i = i8 * 8 + j;
                const f32x4 a0 = *(const LAS f32x4*)(al + i * 16), a1 = *(const LAS f32x4*)(al + i * 16 + 4), a2 = *(const LAS f32x4*)(al + i * 16 + 8), a3 = *(const LAS f32x4*)(al + i * 16 + 12);
                float x = bias;
                x += a0[0] * wv[0] + a0[1] * wv[1] + a0[2] * wv[2] + a0[3] * wv[3];
                x += a1[0] * wv[4] + a1[1] * wv[5] + a1[2] * wv[6] + a1[3] * wv[7];
                x += a2[0] * wv[8] + a2[1] * wv[9] + a2[2] * wv[10] + a2[3] * wv[11];
                x += a3[0] * wv[12] + a3[1] * wv[13] + a3[2] * wv[14] + a3[3] * wv[15];
                const float la = (fminf(x, 0.f) - __logf(1.0f + __expf(-fabsf(x)))) * (1.0f / 16.0f);
                const float kvv = (j & 1) ? bf_hi(kw[j >> 1]) : bf_lo(kw[j >> 1]);
                o[j] = kvv * __expf(suffix);
                suffix += la; }
            u32x4 pk; pk.x = cvtpk(o[0], o[1]); pk.y = cvtpk(o[2], o[3]); pk.z = cvtpk(o[4], o[5]); pk.w = cvtpk(o[6], o[7]);
            if (!F.dry) *(u32x4*)(krow + i8 * 8) = pk; }
        GLAG[((size_t)(b * 64 + seg * 8 + cc) * 4 + h) * 128 + k] = __expf(suffix); }
    VM_WAIT(); __syncthreads();
}
constexpr size_t SEND_WAVE_FLOATS = 4 * 4 * 64 * 4;
__device__ __forceinline__ void gla_stage1(Frame& F, int unit) {
    const int bh = unit >> 3, seg = unit & 7, b = bh >> 2, h = bh & 3, w = F.wave, l = F.lane;
    f32x16 S[4];
#pragma unroll
    for (int kt = 0; kt < 4; ++kt)
#pragma unroll
        for (int r = 0; r < 16; ++r) S[kt][r] = 0.f;
    float pend = 1.f;
    gla_prep_seg(F, b, h, seg);
    GlaStage st; bf16x8 vtA[4], vtB[4]; gla_prefetch<false>(F, st, b, h, seg * 8); gla_prefetch_vt(F, vtA, b, h, seg * 8);
#define GLA1_STEP(ci, CUR, NXT) do { gla_stage_write<false>(F, st, (ci) & 1); pend *= st.g; __syncthreads(); \
        if ((ci) < 7) { gla_prefetch<false>(F, st, b, h, seg * 8 + (ci) + 1); gla_prefetch_vt(F, NXT, b, h, seg * 8 + (ci) + 1); } \
        gla_update(F, S, CUR, (ci) & 1); } while (0)
#pragma unroll 1
    for (int ci = 0; ci < 8; ci += 2) { GLA1_STEP(ci, vtA, vtB); GLA1_STEP(ci + 1, vtB, vtA); }
#undef GLA1_STEP
    float* se = WSP(float, WS_SEND) + ((size_t)unit * 8 + w) * SEND_WAVE_FLOATS;
#pragma unroll
    for (int kt = 0; kt < 4; ++kt)
#pragma unroll
        for (int g4 = 0; g4 < 4; ++g4) st_nt<NT_ATT>((f32x4){S[kt][4 * g4], S[kt][4 * g4 + 1], S[kt][4 * g4 + 2], S[kt][4 * g4 + 3]}, (f32x4*)(se + ((kt * 4 + g4) * 64 + l) * 4));
    if (F.tid < 128) WSP(float, WS_PEND)[unit * 128 + F.tid] = pend;
    __syncthreads();
}
__device__ __forceinline__ void gla_stage3(Frame& F, int unit) {
    const int bh = unit >> 3, seg = unit & 7, b = bh >> 2, h = bh & 3, w = F.wave, l = F.lane, lq = l & 31, hh = l >> 5;
    LAS unsigned char* lds = F.lds + RING_OFF;
    const bf16_t* GR = WSP(bf16_t, WS_GR); bf16_t* GLAN = WSP(bf16_t, WS_GLAN); const float* g_o = F.in[6];
    f32x16 S[4];
#pragma unroll
    for (int kt = 0; kt < 4; ++kt)
#pragma unroll
        for (int r = 0; r < 16; ++r) S[kt][r] = 0.f;
    GlaStage st; bf16x8 vtA[4], vtB[4]; gla_prefetch<true>(F, st, b, h, seg * 8); gla_prefetch_vt(F, vtA, b, h, seg * 8);
    for (int sp = 0; sp < seg; ++sp) {
        const int un = bh * 8 + sp; const float* se = WSP(float, WS_SEND) + ((size_t)un * 8 + w) * SEND_WAVE_FLOATS; const float* pe = WSP(float, WS_PEND) + un * 128;
#pragma unroll
        for (int kt = 0; kt < 4; ++kt)
#pragma unroll
            for (int g4 = 0; g4 < 4; ++g4) { const f32x4 p = *(const f32x4*)(pe + 32 * kt + 8 * g4 + 4 * hh); const f32x4 s = ld_nt<NTL_GLA>((const f32x4*)(se + ((kt * 4 + g4) * 64 + l) * 4));
#pragma unroll
                for (int j = 0; j < 4; ++j) S[kt][4 * g4 + j] = S[kt][4 * g4 + j] * p[j] + s[j]; }
    }
    const int tid = F.tid; u32x4 sr[4]; size_t pend_r0 = 0;
#define GLA_LOAD_SR(R0) do { _Pragma("unroll") for (int j = 0; j < 4; ++j) sr[j] = ld_nt<NTL_GLA>((const u32x4*)(GR + ((R0) + (tid >> 3)) * 1024 + h * 256 + 8 * (tid & 7) + 64 * j)); } while (0)
#define GLA_STORE_PASS(R0) do { const LAS float* otr = (const LAS float*)(lds + GL_OT) + (tid >> 3) * GL_OT_PITCH + 8 * (tid & 7); \
        _Pragma("unroll") for (int j = 0; j < 4; ++j) { const f32x4 a0 = *(const LAS f32x4*)(otr + 64 * j), a1 = *(const LAS f32x4*)(otr + 64 * j + 4); const u32x4 s4 = sr[j]; u32x4 wv; \
            wv.x = cvtpk(a0[0] * bf_lo(s4.x), a0[1] * bf_hi(s4.x)); wv.y = cvtpk(a0[2] * bf_lo(s4.y), a0[3] * bf_hi(s4.y)); wv.z = cvtpk(a1[0] * bf_lo(s4.z), a1[1] * bf_hi(s4.z)); wv.w = cvtpk(a1[2] * bf_lo(s4.w), a1[3] * bf_hi(s4.w)); \
            if (!F.dry) st_nt<NT_ATT>(wv, (u32x4*)(GLAN + ((R0) + (tid >> 3)) * 1024 + h * 256 + 8 * (tid & 7) + 64 * j)); } } while (0)
    auto step = [&](const int ci, const bf16x8 (&CUR)[4], bf16x8 (&NXT)[4]) __attribute__((always_inline)) {
        const int c = seg * 8 + ci; const size_t r0 = (size_t)(b * 64 + c) * 64; const int buf = ci & 1;
        gla_stage_write<true>(F, st, buf);
        __syncthreads();
        if (ci > 0) GLA_LOAD_SR(pend_r0);
        if (ci < 7) { gla_prefetch<true>(F, st, b, h, c + 1); gla_prefetch_vt(F, NXT, b, h, c + 1); }
        gla_update(F, S, CUR, buf);
        if (ci > 0) GLA_STORE_PASS(pend_r0);
        f32x16 oT[2];
#pragma unroll
        for (int tt = 0; tt < 2; ++tt) {
#pragma unroll
            for (int r = 0; r < 16; ++r) oT[tt][r] = 0.f;
            const int t = 32 * tt + lq;
#pragma unroll
            for (int kt = 0; kt < 4; ++kt)
#pragma unroll
                for (int s = 0; s < 2; ++s) {
                    u32x4 aw; aw.x = cvtpk(S[kt][8 * s + 0], S[kt][8 * s + 1]); aw.y = cvtpk(S[kt][8 * s + 2], S[kt][8 * s + 3]); aw.z = cvtpk(S[kt][8 * s + 4], S[kt][8 * s + 5]); aw.w = cvtpk(S[kt][8 * s + 6], S[kt][8 * s + 7]);
                    const u32x2 qlo = *(const LAS u32x2*)(lds + GL_Q + buf * 16384 + gl_q_off(t, 4 * kt + 2 * s) + 8 * hh), qhi = *(const LAS u32x2*)(lds + GL_Q + buf * 16384 + gl_q_off(t, 4 * kt + 2 * s + 1) + 8 * hh);
                    const u32x4 bw = (u32x4){qlo.x, qlo.y, qhi.x, qhi.y};
                    oT[tt] = __builtin_amdgcn_mfma_f32_32x32x16_bf16(__builtin_bit_cast(bf16x8, aw), __builtin_bit_cast(bf16x8, bw), oT[tt], 0, 0, 0);
                    if (s == 1 && (kt & 1)) __builtin_amdgcn_sched_barrier(0); }
        }
        LAS float* redc = (LAS float*)(lds + GL_RED) + buf * 512;
#pragma unroll
        for (int tt = 0; tt < 2; ++tt) { float s = 0.f;
#pragma unroll
            for (int r = 0; r < 16; ++r) s += oT[tt][r] * oT[tt][r];
            s += __shfl_xor(s, 32);
            if (hh == 0) redc[w * 64 + 32 * tt + lq] = s; }
        __syncthreads();
        LAS float* ot = (LAS float*)(lds + GL_OT);
#pragma unroll
        for (int tt = 0; tt < 2; ++tt) { float tot = 0.f;
#pragma unroll
            for (int ww = 0; ww < 8; ++ww) tot += redc[ww * 64 + 32 * tt + lq];
            const float rstd = __builtin_amdgcn_rsqf(tot * (1.0f / 256.0f) + EPS);
#pragma unroll
            for (int g4 = 0; g4 < 4; ++g4) { const int vl = 32 * w + 8 * g4 + 4 * hh;
                const f32x4 go = *(const f32x4*)(g_o + h * 256 + vl);
                *(LAS f32x4*)(ot + (32 * tt + lq) * GL_OT_PITCH + vl) = (f32x4){oT[tt][4 * g4 + 0] * rstd * go[0], oT[tt][4 * g4 + 1] * rstd * go[1], oT[tt][4 * g4 + 2] * rstd * go[2], oT[tt][4 * g4 + 3] * rstd * go[3]}; } }
        pend_r0 = r0;
    };
#pragma unroll 1
    for (int ci = 0; ci < 8; ci += 2) { step(ci, vtA, vtB); step(ci + 1, vtB, vtA); }
    GLA_LOAD_SR(pend_r0);
    __syncthreads();
    GLA_STORE_PASS(pend_r0);
    __syncthreads();
#undef GLA_STORE_PASS
#undef GLA_LOAD_SR
}

constexpr int SB_TILE = 16384, SB_FLAG = 7 * SB_TILE;
typedef short v4i16_t __attribute__((ext_vector_type(4)));
__device__ __forceinline__ s16x4 vtr(const LAS unsigned char* p) { return __builtin_bit_cast(s16x4, __builtin_amdgcn_ds_read_tr16_b64_v4i16((LAS v4i16_t*)p)); }
__device__ __forceinline__ float partner32(float x, int hh) { auto rr = __builtin_amdgcn_permlane32_swap(__float_as_uint(x), __float_as_uint(x), false, false); return __uint_as_float(hh ? rr[0] : rr[1]); }
__device__ __forceinline__ int sbk_off(int key, int chunk) { return key * 128 + ((chunk ^ ((key >> 1) & 7)) << 4); }
__device__ __forceinline__ int sbv_off(int key, int chunk) { return 8192 + key * 128 + ((chunk ^ (((key >> 1) & 1) << 2)) << 4); }

template <bool DIAG>
__device__ __forceinline__ void sb_tile_t(const LAS unsigned char* tile, int kt, int qabs, int l, const bf16x8 (&qf)[4], f32x16& o0, f32x16& o1, float& carry) {
    const int lq = l & 31, hh = l >> 5, g1 = (l >> 4) & 1, i = l & 15;
    float run = carry;
#pragma unroll
    for (int half = 1; half >= 0; --half) {
        f32x16 p;
#pragma unroll
        for (int r = 0; r < 16; ++r) p[r] = 0.f;
        { bf16x8 ka_[4];
#pragma unroll
          for (int s = 0; s < 4; ++s) ka_[s] = *(const LAS bf16x8*)(tile + sbk_off(32 * half + lq, 2 * s + hh));
          __builtin_amdgcn_s_setprio(1);
#pragma unroll
          for (int s = 0; s < 4; ++s) p = __builtin_amdgcn_mfma_f32_32x32x16_bf16(ka_[s], qf[s], p, 0, 0, 0);
          __builtin_amdgcn_s_setprio(0); }
        float st[16], be[16];
#pragma unroll
        for (int r = 0; r < 16; ++r) { const float ee = __builtin_amdgcn_exp2f(fminf(p[r], 80.0f)); float s_ = __builtin_amdgcn_rcpf(1.0f + ee); float b_ = ee * s_;
            if (DIAG) { const int key = 64 * kt + 32 * half + (r & 3) + 8 * (r >> 2) + 4 * hh; if (key >= qabs) { s_ = 1.0f; b_ = 0.f; } }
            st[r] = s_; be[r] = b_; }
        float tot[4];
#pragma unroll
        for (int g4 = 0; g4 < 4; ++g4) { float* sg = &st[4 * g4]; float* bg = &be[4 * g4];
            const float a2 = sg[3], a1 = sg[2] * a2, a0 = sg[1] * a1; tot[g4] = sg[0] * a0;
            bg[2] *= a2; bg[1] *= a1; bg[0] *= a0; }
        float E[4];
#pragma unroll
        for (int m = 3; m >= 0; --m) { const float tp = partner32(tot[m], hh); E[m] = hh ? run : run * tp; run *= tot[m] * tp; }
        u32x4 pw[2];
#pragma unroll
        for (int s = 0; s < 2; ++s) { float wv[8];
#pragma unroll
            for (int j = 0; j < 8; ++j) { const int r = 8 * s + j; wv[j] = be[r] * E[r >> 2]; }
            pw[s] = (u32x4){cvtpk(wv[0], wv[1]), cvtpk(wv[2], wv[3]), cvtpk(wv[4], wv[5]), cvtpk(wv[6], wv[7])}; }
#pragma unroll
        for (int s = 0; s < 2; ++s) { const bf16x8 pb = __builtin_bit_cast(bf16x8, pw[s]);
            const int k0 = 32 * half + 16 * s + 4 * hh + (i >> 2), k1 = k0 + 8;
#pragma unroll
            for (int dt = 0; dt < 2; ++dt) { const int ch = 4 * dt + 2 * g1 + ((i & 3) >> 1);
                const s16x4 lo = vtr(tile + sbv_off(k0, ch) + 8 * (i & 1)), hi = vtr(tile + sbv_off(k1, ch) + 8 * (i & 1));
                const bf16x8 a = (bf16x8){lo[0], lo[1], lo[2], lo[3], hi[0], hi[1], hi[2], hi[3]};
                if (dt == 0) o0 = __builtin_amdgcn_mfma_f32_32x32x16_bf16(a, pb, o0, 0, 0, 0); else o1 = __builtin_amdgcn_mfma_f32_32x32x16_bf16(a, pb, o1, 0, 0, 0); } }
        if (half == 1 && __all(run == 0.0f)) break;
    }
    carry = run;
}
__device__ __forceinline__ void sb_tile(const LAS unsigned char* tile, int kt, int q0, int qabs, int l, const bf16x8 (&qf)[4], f32x16& o0, f32x16& o1, float& carry) {
    if (64 * kt + 63 >= q0) sb_tile_t<true>(tile, kt, qabs, l, qf, o0, o1, carry); else sb_tile_t<false>(tile, kt, qabs, l, qf, o0, o1, carry);
}
__device__ __forceinline__ void sb_attn_unit(Frame& F, int uidx) {
    const int bh = uidx >> 4, qb = uidx & 15, b = bh >> 4, h = bh & 15;
    LAS unsigned char* lds = F.lds + RING_OFF;
    volatile LAS unsigned* flags = (volatile LAS unsigned*)(lds + SB_FLAG);
    const int tid = F.tid, w = F.wave, l = F.lane, lq = l & 31, hh = l >> 5;
    bf16_t* SQ = WSP(bf16_t, WS_SQ); const bf16_t* SK = WSP(bf16_t, WS_SK); const bf16_t* SV = WSP(bf16_t, WS_SV);
    const size_t rowbase = (size_t)b * SEQ;
    const int q0 = qb * 256 + 32 * w, qabs = q0 + lq;
    const int kt_hi = qb * 4 + 3, kt_lo = (qb * 4 - 3) > 0 ? (qb * 4 - 3) : 0, nwin = kt_hi - kt_lo + 1;
    const int skey = tid >> 3, sch = tid & 7;
    const bf16_t* kgd = SK + (rowbase + skey) * 1024 + h * 64 + ((sch ^ ((skey >> 1) & 7)) * 8);
    const bf16_t* vgd = SV + (rowbase + skey) * 1024 + h * 64 + ((sch ^ (((skey >> 1) & 1) << 2)) * 8);
    __syncthreads();
#pragma unroll
    for (int j = 0; j < 7; ++j) if (j < nwin) {
        __builtin_amdgcn_global_load_lds((const unsigned*)(kgd + (size_t)(kt_lo + j) * 64 * 1024), (LAS unsigned*)(lds + j * SB_TILE + w * 1024), 16, 0, NTL_SB ? 2 : 0);
        __builtin_amdgcn_global_load_lds((const unsigned*)(vgd + (size_t)(kt_lo + j) * 64 * 1024), (LAS unsigned*)(lds + j * SB_TILE + 8192 + w * 1024), 16, 0, NTL_SB ? 2 : 0); }
    bf16x8 qf[4];
    { const bf16_t* qrow = SQ + (rowbase + qabs) * 1024 + h * 64;
#pragma unroll
      for (int s = 0; s < 4; ++s) qf[s] = ld_nt<NTL_SB>((const bf16x8*)(qrow + 16 * s + 8 * hh)); }
    f32x16 o0, o1;
#pragma unroll
    for (int r = 0; r < 16; ++r) { o0[r] = 0.f; o1[r] = 0.f; }
    float carry = 1.0f;
    VM_WAIT(); __syncthreads();
    bool done = false;
    for (int kt = (q0 + 30) >> 6; kt >= kt_lo; --kt) {
        sb_tile(lds + (kt - kt_lo) * SB_TILE, kt, q0, qabs, l, qf, o0, o1, carry);
        if (__all(carry == 0.0f)) { done = true; break; }
    }
    if (kt_lo == 0) done = true;
    if (l == 0) flags[w] = done ? 1u : 0u;
    __syncthreads();
    bool alld = true;
#pragma unroll
    for (int i = 0; i < 8; ++i) alld = alld && (flags[i] != 0u);
    if (!alld) {
        const bf16_t* kg = SK + (rowbase + skey) * 1024 + h * 64 + sch * 8;
        const bf16_t* vg = SV + (rowbase + skey) * 1024 + h * 64 + sch * 8;
        for (int kt = kt_lo - 1; kt >= 0; --kt) {
            const u32x4 kr = *(const u32x4*)(kg + (size_t)kt * 64 * 1024), vr = *(const u32x4*)(vg + (size_t)kt * 64 * 1024);
            __syncthreads();
            { unsigned a = 1u;
#pragma unroll
              for (int i = 0; i < 8; ++i) a &= flags[i];
              if (a) break; }
            *(LAS u32x4*)(lds + sbk_off(skey, sch)) = kr; *(LAS u32x4*)(lds + sbv_off(skey, sch)) = vr;
            __syncthreads();
            if (!done) { sb_tile(lds, kt, q0, qabs, l, qf, o0, o1, carry); if (__all(carry == 0.0f) || kt == 0) done = true; }
            if (l == 0) flags[w] = done ? 1u : 0u;
        }
    }
    if (!F.dry) { bf16_t* orow = SQ + (rowbase + qabs) * 1024 + h * 64 + 8 * hh;
#pragma unroll
      for (int half = 0; half < 2; ++half)
#pragma unroll
        for (int k = 0; k < 2; ++k) { const f32x16& o = half ? o1 : o0;
            unsigned ax = cvtpk(o[8 * k + 0], o[8 * k + 1]), ay = cvtpk(o[8 * k + 2], o[8 * k + 3]);
            unsigned bx = cvtpk(o[8 * k + 4], o[8 * k + 5]), by = cvtpk(o[8 * k + 6], o[8 * k + 7]);
            { auto r = __builtin_amdgcn_permlane32_swap(ax, bx, false, false); ax = r[0]; bx = r[1]; }
            { auto r = __builtin_amdgcn_permlane32_swap(ay, by, false, false); ay = r[0]; by = r[1]; }
            *(u32x4*)(orow + 32 * half + 16 * k) = (u32x4){ax, ay, bx, by}; } }
}
#define CVT8_PK(V, S, W) do { int _x = __builtin_amdgcn_cvt_pk_fp8_f32((V)[0] * (S), (V)[1] * (S), 0, false); _x = __builtin_amdgcn_cvt_pk_fp8_f32((V)[2] * (S), (V)[3] * (S), _x, true); (W) = (unsigned)_x; } while (0)
__device__ __forceinline__ float absmax4(const f32x4& a) { return fmaxf(fmaxf(fabsf(a[0]), fabsf(a[1])), fmaxf(fabsf(a[2]), fabsf(a[3]))); }
constexpr int CVT8_UNITS = 512;
#ifndef SB_SPLIT
#define SB_SPLIT 256
#endif
#ifndef NTL_CONV
#define NTL_CONV 0
#endif
#ifndef QCONV
#define QCONV 1
#endif
__device__ __forceinline__ void cvt_fp8_unit(Frame& F, int cu) {
    const int l = F.lane, r0 = cu * 64 + F.wave * 8;
    const bool isv = r0 >= 16384; const int e0 = r0 & 16383;
    const float* src = isv ? F.in[15] : F.in[14]; unsigned char* dst = WSP(unsigned char, isv ? WS_VB8 : WS_UB8); float* rscale = WSP(float, isv ? WS_RSV : WS_RSU);
#pragma unroll 1
    for (int it = 0; it < 2; ++it) {
        f32x4 v[4][4]; float m[4];
#pragma unroll
        for (int q = 0; q < 4; ++q) { const f32x4* sp = (const f32x4*)(src + (size_t)(e0 + 4 * it + q) * 1024) + l;
#pragma unroll
            for (int j = 0; j < 4; ++j) v[q][j] = NTL_CONV ? __builtin_nontemporal_load(sp + 64 * j) : sp[64 * j]; }
#pragma unroll
        for (int q = 0; q < 4; ++q) m[q] = fmaxf(fmaxf(absmax4(v[q][0]), absmax4(v[q][1])), fmaxf(absmax4(v[q][2]), absmax4(v[q][3])));
#pragma unroll
        for (int o = 1; o < 64; o <<= 1) {
#pragma unroll
            for (int q = 0; q < 4; ++q) m[q] = fmaxf(m[q], __shfl_xor(m[q], o)); }
#pragma unroll
        for (int q = 0; q < 4; ++q) { const int e = e0 + 4 * it + q;
            const float t = 448.0f / fmaxf(m[q], 1e-30f); const float s = __uint_as_float(__float_as_uint(t) & 0x7f800000u);
            unsigned w[4]; CVT8_PK(v[q][0], s, w[0]); CVT8_PK(v[q][1], s, w[1]); CVT8_PK(v[q][2], s, w[2]); CVT8_PK(v[q][3], s, w[3]);
            if (!F.dry) { unsigned* dp = (unsigned*)(dst + (size_t)e * 1024) + l;
#pragma unroll
                for (int j = 0; j < 4; ++j) st_nt<NT_TAB>(w[j], dp + 64 * j);
                if (l == 0) rscale[e] = 1.0f / s; } }
    }
}
__device__ __forceinline__ void sb_units_dyn(Frame& F, unsigned* ctr, int sb_lo, int nsb, int conv_lo) {
    volatile LAS int* slot = (volatile LAS int*)(F.lds + MISC_OFF + 64);
    const int total = QCONV ? nsb + (nsb >> 1) : nsb;
    __syncthreads();
    if (F.tid == 0) *slot = (int)__hip_atomic_fetch_add(ctr, 1u, __ATOMIC_RELAXED, __HIP_MEMORY_SCOPE_AGENT);
    __syncthreads();
    int i = *slot;
    while (i < total) {
        int nxt = 0;
        if (F.tid == 0) nxt = (int)__hip_atomic_fetch_add(ctr, 1u, __ATOMIC_RELAXED, __HIP_MEMORY_SCOPE_AGENT);
        if (QCONV) { const int g = i / 3, r = i - 3 * g; if (r < 2) sb_attn_unit(F, sb_lo + 2 * g + r); else cvt_fp8_unit(F, conv_lo + g); }
        else sb_attn_unit(F, sb_lo + i);
        __syncthreads();
        if (F.tid == 0) *slot = nxt;
        __syncthreads();
        i = *slot;
    }
}
__device__ __forceinline__ void phase_attn_a(Frame& F) {
    if (F.vcu < 128) gla_stage1(F, F.vcu);
    sb_units_dyn(F, (unsigned*)(F.ws + WS_CTL) + 64 + 16 * F.dry, 0, SB_SPLIT, 0);
    __syncthreads();
}
__device__ __forceinline__ void phase_attn_b(Frame& F) {
    if (F.vcu < 128) gla_stage3(F, F.vcu);
    sb_units_dyn(F, (unsigned*)(F.ws + WS_CTL) + 128 + 16 * F.dry, SB_SPLIT, 1024 - SB_SPLIT, SB_SPLIT / 2);
    __syncthreads();
}
__device__ __forceinline__ int okey(float v, int tag, int mask) { int u = __float_as_int(v); u ^= (u >> 31) & 0x7fffffff; return (u & ~mask) | tag; }
__device__ __forceinline__ float okey_val(int key, int mask) { int u = key & ~mask; u ^= (u >> 31) & 0x7fffffff; return __int_as_float(u); }
#define INS16(Lst, xin) do { int _x = (xin); _Pragma("unroll") for (int _j = 0; _j < 16; ++_j) { const int _h = max(Lst[_j], _x); _x = min(Lst[_j], _x); Lst[_j] = _h; } } while (0)

#define CEX(a, b) do { const int _hi = max(a, b), _lo = min(a, b); a = _hi; b = _lo; } while (0)
#define BITONIC16(K) do { \
    _Pragma("unroll") for (int _i = 0; _i < 8; ++_i) CEX(K[_i], K[_i + 8]); \
    _Pragma("unroll") for (int _b = 0; _b < 16; _b += 8) _Pragma("unroll") for (int _i = 0; _i < 4; ++_i) CEX(K[_b + _i], K[_b + _i + 4]); \
    _Pragma("unroll") for (int _b = 0; _b < 16; _b += 4) _Pragma("unroll") for (int _i = 0; _i < 2; ++_i) CEX(K[_b + _i], K[_b + _i + 2]); \
    _Pragma("unroll") for (int _b = 0; _b < 16; _b += 2) CEX(K[_b], K[_b + 1]); } while (0)
#define CEXD(a, b, d) do { const int _hi = max(a, b), _lo = min(a, b); a = (d) ? _hi : _lo; b = (d) ? _lo : _hi; } while (0)
#define FULLSORT16(K) do { \
    _Pragma("unroll") for (int _k = 2; _k <= 16; _k <<= 1) _Pragma("unroll") for (int _j = _k >> 1; _j >= 1; _j >>= 1) _Pragma("unroll") for (int _i = 0; _i < 16; ++_i) { \
        const int _p = _i ^ _j; if (_p > _i) { const bool _desc = ((_i & _k) == 0); CEXD(K[_i], K[_p], _desc); } } } while (0)
__device__ __forceinline__ int swap32i(int x) { auto r = __builtin_amdgcn_permlane32_swap((unsigned)x, (unsigned)x, false, false); return (int)((__builtin_amdgcn_mbcnt_hi(~0u, __builtin_amdgcn_mbcnt_lo(~0u, 0u)) & 32) ? r[0] : r[1]); }

__device__ __forceinline__ void phase_peer_retrieve(Frame& F) {
    const bf16_t* Q = WSP(bf16_t, WS_Q); const bf16_t* KB = WSP(bf16_t, WS_KD); unsigned* EXPO = WSP(unsigned, WS_EXP);
    LAS unsigned char* idxb = F.lds + RING_OFF + F.wave * 2048;
    const int l = F.lane, lq = l & 31, hh = l >> 5;
    const int ntok_wg = T_TOK / F.G;
    const int nit = (ntok_wg / 32) * 8;
    bf16x8 q0[8], q1[8];
#define QLOAD(DST, it_, half_) do { const int t_ = F.vcu * ntok_wg + ((it_) >> 3) * 32 + lq; const bf16_t* qp = Q + (size_t)t_ * 2048 + ((it_) & 7) * 256 + (half_) * 128 + 8 * hh; \
        _Pragma("unroll") for (int s = 0; s < 8; ++s) DST[s] = ld_nt<NTL_PEER>((const bf16x8*)(qp + 16 * s)); } while (0)
    QLOAD(q0, F.wave, 0);
#pragma unroll 1
    for (int it = F.wave; it < nit; it += NWAVES) {
        const int tg = it >> 3, h = it & 7;
        const int t = F.vcu * ntok_wg + tg * 32 + lq;
        int XY[2][16];
#pragma unroll
        for (int half = 0; half < 2; ++half) {
            const bf16x8 (&qf)[8] = half ? q1 : q0;
            int L[16];
#pragma unroll
            for (int j = 0; j < 16; ++j) L[j] = INT_MIN;
            const bf16_t* kp = KB + (size_t)(h * 2 + half) * 16384 + (size_t)lq * 128 + 8 * hh;
            bf16x8 ka[8], kb[8];
#define KLOAD(DST, tile) do { _Pragma("unroll") for (int s = 0; s < 8; ++s) DST[s] = *(const bf16x8*)(kp + (size_t)(tile) * 32 * 128 + 16 * s); } while (0)
#define KTILE(CUR, tile) do { f32x16 acc; int Tk[16]; \
                _Pragma("unroll") for (int r = 0; r < 16; ++r) acc[r] = 0.f; \
                _Pragma("unroll") for (int s = 0; s < 8; ++s) acc = __builtin_amdgcn_mfma_f32_32x32x16_bf16(CUR[s], qf[s], acc, 0, 0, 0); \
                _Pragma("unroll") for (int r = 0; r < 16; ++r) { const int key = 32 * (tile) + (r & 3) + 8 * (r >> 2) + 4 * hh; Tk[r] = okey(acc[r], 127 - key, 127); } \
                  \
                FULLSORT16(Tk); \
                _Pragma("unroll") for (int k = 0; k < 16; ++k) L[k] = max(L[k], Tk[15 - k]); \
                BITONIC16(L); } while (0)
            KLOAD(ka, 0);
            if (half == 0) QLOAD(q1, it, 1);
#pragma unroll 1
            for (int tp = 0; tp < 2; ++tp) { KLOAD(kb, 2 * tp + 1); KTILE(ka, 2 * tp); KLOAD(ka, 2 * tp + 2 < 4 ? 2 * tp + 2 : 3); KTILE(kb, 2 * tp + 1); }
#undef KLOAD
#undef KTILE
#pragma unroll
            for (int k = 0; k < 8; ++k) { const int a = swap32i(L[15 - k]), b = swap32i(L[k]); L[k] = max(L[k], a); L[15 - k] = max(L[15 - k], b); }
            BITONIC16(L);
#pragma unroll
            for (int j = 0; j < 16; ++j) XY[half][j] = L[j];
        }
        QLOAD(q0, (it + NWAVES < nit ? it + NWAVES : it), 0);
        { u32x4 pk[2];
#pragma unroll
          for (int half = 0; half < 2; ++half) { const int* L = XY[half];
            pk[half].x = (unsigned)(127 - (L[0] & 127)) | ((unsigned)(127 - (L[1] & 127)) << 8) | ((unsigned)(127 - (L[2] & 127)) << 16) | ((unsigned)(127 - (L[3] & 127)) << 24);
            pk[half].y = (unsigned)(127 - (L[4] & 127)) | ((unsigned)(127 - (L[5] & 127)) << 8) | ((unsigned)(127 - (L[6] & 127)) << 16) | ((unsigned)(127 - (L[7] & 127)) << 24);
            pk[half].z = (unsigned)(127 - (L[8] & 127)) | ((unsigned)(127 - (L[9] & 127)) << 8) | ((unsigned)(127 - (L[10] & 127)) << 16) | ((unsigned)(127 - (L[11] & 127)) << 24);
            pk[half].w = (unsigned)(127 - (L[12] & 127)) | ((unsigned)(127 - (L[13] & 127)) << 8) | ((unsigned)(127 - (L[14] & 127)) << 16) | ((unsigned)(127 - (L[15] & 127)) << 24); }
          *(LAS u32x4*)(idxb + l * 32) = pk[0]; *(LAS u32x4*)(idxb + l * 32 + 16) = pk[1]; }
        float X[16], Y[16];
#pragma unroll
        for (int j = 0; j < 16; ++j) { X[j] = okey_val(XY[0][j], 127); Y[j] = okey_val(XY[1][j], 127); }
        int M[16];
        { float A4[4], Bs[16];
#pragma unroll
          for (int j = 0; j < 4; ++j) A4[j] = hh ? Y[j] : X[j];
#pragma unroll
          for (int j = 0; j < 15; ++j) Bs[j] = hh ? X[j + 1] : Y[j];
          Bs[15] = hh ? -INFINITY : Y[15];
#define CKEY(r, k) okey(A4[r] + Bs[(r) + (k)], 255 - (hh ? (16 * ((r) + (k) + 1) + (r)) : (17 * (r) + (k))), 255)
#pragma unroll
          for (int k = 0; k < 16; ++k) M[k] = CKEY(0, k);
          if (hh) M[15] = INT_MIN;
          int T[11];
#pragma unroll
          for (int k = 0; k < 7; ++k) T[k] = CKEY(1, k);
          if (hh) T[6] = INT_MIN;
          T[7] = INT_MIN; T[8] = INT_MIN; T[9] = INT_MIN; T[10] = INT_MIN;
#define INS11(xin) do { int _x = (xin); _Pragma("unroll") for (int _j = 0; _j < 11; ++_j) { const int _h = max(T[_j], _x); _x = min(T[_j], _x); T[_j] = _h; } } while (0)
          { int c20 = CKEY(2, 0), c21 = CKEY(2, 1), c22 = CKEY(2, 2), c30 = CKEY(3, 0);
            if (hh) { c22 = INT_MIN; c30 = INT_MIN; }
            INS11(c20); INS11(c21); INS11(c22); INS11(c30); }
#undef INS11
#undef CKEY
#pragma unroll
          for (int k = 5; k < 16; ++k) M[k] = max(M[k], T[15 - k]);
          BITONIC16(M); }
        int TK[16];
#pragma unroll
        for (int k = 0; k < 16; ++k) TK[k] = max(M[k], swap32i(M[15 - k]));
        float sv[16]; float mx = -INFINITY;
#pragma unroll
        for (int k = 0; k < 16; ++k) { sv[k] = okey_val(TK[k], 255); mx = fmaxf(mx, sv[k]); }
        float den = 0.f;
#pragma unroll
        for (int k = 0; k < 16; ++k) { sv[k] = __expf(sv[k] - mx); den += sv[k]; }
        const float rden = 1.0f / den;
        LDS_WAIT(); asm volatile("" ::: "memory");
        const LAS unsigned char* ib = idxb + l * 32;
        unsigned* dst = EXPO + (size_t)t * 128 + h * 16 + hh * 8;
        u32x4 o0, o1; unsigned ov[8];
#pragma unroll
        for (int k = 0; k < 8; ++k) { const int pos = 255 - (TK[k] & 255); const unsigned i1 = ib[pos >> 4], i2 = ib[16 + (pos & 15)];
            ov[k] = (__float_as_uint(sv[k] * rden) & ~0x3fffu) | (i1 * 128u + i2); }
        o0 = (u32x4){ov[0], ov[1], ov[2], ov[3]}; o1 = (u32x4){ov[4], ov[5], ov[6], ov[7]};
        *(u32x4*)dst = o0; *(u32x4*)(dst + 4) = o1;
        LDS_WAIT(); asm volatile("" ::: "memory");
    }
}

__device__ __forceinline__ float gelu_tanh(float x) { const float y = 0.7978845608028654f * (x + 0.044715f * x * x * x); return x * __builtin_amdgcn_rcpf(1.0f + __expf(-2.0f * y)); }
#define FP8_UNPACK16(W, f) do { f32x2 _t; \
    _t = __builtin_amdgcn_cvt_pk_f32_fp8((int)(W).x, false); f[0] = _t[0]; f[1] = _t[1]; _t = __builtin_amdgcn_cvt_pk_f32_fp8((int)(W).x, true); f[2] = _t[0]; f[3] = _t[1]; \
    _t = __builtin_amdgcn_cvt_pk_f32_fp8((int)(W).y, false); f[4] = _t[0]; f[5] = _t[1]; _t = __builtin_amdgcn_cvt_pk_f32_fp8((int)(W).y, true); f[6] = _t[0]; f[7] = _t[1]; \
    _t = __builtin_amdgcn_cvt_pk_f32_fp8((int)(W).z, false); f[8] = _t[0]; f[9] = _t[1]; _t = __builtin_amdgcn_cvt_pk_f32_fp8((int)(W).z, true); f[10] = _t[0]; f[11] = _t[1]; \
    _t = __builtin_amdgcn_cvt_pk_f32_fp8((int)(W).w, false); f[12] = _t[0]; f[13] = _t[1]; _t = __builtin_amdgcn_cvt_pk_f32_fp8((int)(W).w, true); f[14] = _t[0]; f[15] = _t[1]; } while (0)
__device__ __forceinline__ float sum_swap32(float a, float b) { auto r = __builtin_amdgcn_permlane32_swap(__float_as_uint(a), __float_as_uint(b), false, false); return __uint_as_float(r[0]) + __uint_as_float(r[1]); }
__device__ __forceinline__ float sum_swap16(float a, float b) { auto r = __builtin_amdgcn_permlane16_swap(__float_as_uint(a), __float_as_uint(b), false, false); return __uint_as_float(r[0]) + __uint_as_float(r[1]); }
template <int M> __device__ __forceinline__ unsigned sxu(unsigned v, int lane) {
    if constexpr (M == 32) { auto r = __builtin_amdgcn_permlane32_swap(v, v, false, false); return (lane & 32) ? r[0] : r[1]; }
    else return (unsigned)__builtin_amdgcn_ds_swizzle((int)v, (M << 10) | 0x1f);
}
template <int M> __device__ __forceinline__ float sxf(float v, int lane) { return __uint_as_float(sxu<M>(__float_as_uint(v), lane)); }
__device__ __forceinline__ float wave_sum_sx(float v, int lane) { v += sxf<1>(v, lane); v += sxf<2>(v, lane); v += sxf<4>(v, lane); v += sxf<8>(v, lane); v += sxf<16>(v, lane); v += sxf<32>(v, lane); return v; }
#ifndef PG_TOK
#define PG_TOK 4
#endif
template <class Bar>
__device__ __forceinline__ void phase_peer_gather(Frame& F, const Bar& bar, bool use_bar) {
    const unsigned char* UB = WSP(unsigned char, WS_UB8); const unsigned char* VB = WSP(unsigned char, WS_VB8); const float* RSU = WSP(float, WS_RSU); const float* RSV = WSP(float, WS_RSV);
    const unsigned* EXPO = WSP(unsigned, WS_EXP);
    const bf16_t* H1B = WSP(bf16_t, WS_H1); bf16_t* H2B = WSP(bf16_t, WS_H2B); const float* SSQ1 = WSP(float, WS_SSQ1); float* RS3 = WSP(float, WS_RS3); const float* g_ffn = F.in[10];
    const int l = F.lane; const int ntok_wg = T_TOK / F.G;
#pragma unroll 1
    for (int ti = F.wave * PG_TOK; ti < ntok_wg; ti += NWAVES * PG_TOK) {
        if (use_bar && ti >= NWAVES * PG_TOK) xcd_barrier(bar, F.tid); else __syncthreads();
        f32x2 acc[PG_TOK][8];
        LAS unsigned* lent = (LAS unsigned*)(F.lds + RING_OFF + F.wave * (2048 * PG_TOK)); LAS float* lcu = (LAS float*)(lent + 128 * PG_TOK); LAS float* lcv = lcu + 128 * PG_TOK; LAS float* acl = lcv + 128 * PG_TOK;
#if PG_TOK == 2
        LAS f32x4* lx = (LAS f32x4*)(F.lds + RING_OFF + NWAVES * 2048 * PG_TOK + F.wave * (4096 * PG_TOK));
#else
        LAS u32x4* lx = (LAS u32x4*)(F.lds + RING_OFF + NWAVES * 2048 * PG_TOK + F.wave * (2048 * PG_TOK));
#endif
#pragma unroll
        for (int tk = 0; tk < PG_TOK; ++tk) { const int t = F.vcu * ntok_wg + ti + tk;
            const u32x4 xa = ld_nt<NTL_PEER>((const u32x4*)(H1B + (size_t)t * 1024 + 16 * l)), xb = ld_nt<NTL_PEER>((const u32x4*)(H1B + (size_t)t * 1024 + 16 * l + 8));
            const f32x4* gp = (const f32x4*)(g_ffn + 16 * l);
            const f32x4 x0 = (f32x4){bf_lo(xa.x), bf_hi(xa.x), bf_lo(xa.y), bf_hi(xa.y)} * gp[0], x1 = (f32x4){bf_lo(xa.z), bf_hi(xa.z), bf_lo(xa.w), bf_hi(xa.w)} * gp[1];
            const f32x4 x2_ = (f32x4){bf_lo(xb.x), bf_hi(xb.x), bf_lo(xb.y), bf_hi(xb.y)} * gp[2], x3 = (f32x4){bf_lo(xb.z), bf_hi(xb.z), bf_lo(xb.w), bf_hi(xb.w)} * gp[3];
#if PG_TOK == 2
            lx[tk * 256 + l] = x0; lx[tk * 256 + 64 + l] = x1; lx[tk * 256 + 128 + l] = x2_; lx[tk * 256 + 192 + l] = x3;
#else
            lx[tk * 128 + l] = (u32x4){cvtpk(x0[0], x0[1]), cvtpk(x0[2], x0[3]), cvtpk(x1[0], x1[1]), cvtpk(x1[2], x1[3])}; lx[tk * 128 + 64 + l] = (u32x4){cvtpk(x2_[0], x2_[1]), cvtpk(x2_[2], x2_[3]), cvtpk(x3[0], x3[1]), cvtpk(x3[2], x3[3])};
#endif
            }
#pragma unroll 1
        for (int tk = 0; tk < PG_TOK; ++tk) { const int t = F.vcu * ntok_wg + ti + tk;
            const f32x4* sp = (const f32x4*)(SSQ1 + (size_t)t * 16); const f32x4 st = (sp[0] + sp[1]) + (sp[2] + sp[3]); const float rstd1 = __builtin_amdgcn_rsqf(((st[0] + st[1]) + (st[2] + st[3])) * (1.0f / 1024.0f) + EPS);
            unsigned a0 = EXPO[(size_t)t * 128 + l], a1 = EXPO[(size_t)t * 128 + 64 + l];
            { unsigned s0 = (a0 << 18) | (a0 >> 14), s1 = (a1 << 18) | (a1 >> 14);
              int ls = l; asm volatile("" : "+v"(ls));
#define BSTEP(K, J) do { const bool up = (ls & (J)) != 0; const unsigned p0 = sxu<J>(s0, ls), p1 = sxu<J>(s1, ls); \
                  const bool asc0 = (ls & (K)) == 0, asc1 = ((ls + 64) & (K)) == 0; \
                  s0 = (up == asc0) ? max(s0, p0) : min(s0, p0); s1 = (up == asc1) ? max(s1, p1) : min(s1, p1); } while (0)
              BSTEP(2, 1);
              BSTEP(4, 2); BSTEP(4, 1);
              BSTEP(8, 4); BSTEP(8, 2); BSTEP(8, 1);
              BSTEP(16, 8); BSTEP(16, 4); BSTEP(16, 2); BSTEP(16, 1);
              BSTEP(32, 16); BSTEP(32, 8); BSTEP(32, 4); BSTEP(32, 2); BSTEP(32, 1);
              BSTEP(64, 32); BSTEP(64, 16); BSTEP(64, 8); BSTEP(64, 4); BSTEP(64, 2); BSTEP(64, 1);
              { const unsigned lo = min(s0, s1), hi = max(s0, s1); s0 = lo; s1 = hi; }
              BSTEP(128, 32); BSTEP(128, 16); BSTEP(128, 8); BSTEP(128, 4); BSTEP(128, 2); BSTEP(128, 1);
#undef BSTEP
              a0 = (s0 >> 18) | (s0 << 14); a1 = (s1 >> 18) | (s1 << 14); }
            lent[tk * 128 + l] = (a0 & 0x3fffu) << 10; lent[tk * 128 + 64 + l] = (a1 & 0x3fffu) << 10;
            lcu[tk * 128 + l] = RSU[a0 & 0x3fffu] * rstd1; lcu[tk * 128 + 64 + l] = RSU[a1 & 0x3fffu] * rstd1;
            lcv[tk * 128 + l] = RSV[a0 & 0x3fffu] * __uint_as_float(a0 & ~0x3fffu); lcv[tk * 128 + 64 + l] = RSV[a1 & 0x3fffu] * __uint_as_float(a1 & ~0x3fffu); }
        LDS_WAIT(); asm volatile("" ::: "memory");
        u32x4 buf0[8], buf1[8]; const unsigned l16 = 16u * (unsigned)l;
#define ROWS8(BUF, TAB, tk, eb) do { const u32x4 ea_ = *(const LAS u32x4*)(lent + (tk) * 128 + (eb)), eb_ = *(const LAS u32x4*)(lent + (tk) * 128 + (eb) + 4); \
            const unsigned en_[8] = {ea_.x, ea_.y, ea_.z, ea_.w, eb_.x, eb_.y, eb_.z, eb_.w}; \
            _Pragma("unroll") for (int k = 0; k < 8; ++k) BUF[k] = *(const u32x4*)((TAB) + (en_[k] + l16)); } while (0)
#if PG_TOK == 2
#define LX_LOAD(tk) _Pragma("unroll") for (int i = 0; i < 4; ++i) { const f32x4 t_ = lx[(tk) * 256 + 64 * i + l]; x2[2 * i] = (f32x2){t_[0], t_[1]}; x2[2 * i + 1] = (f32x2){t_[2], t_[3]}; }
#else
#define LX_LOAD(tk) _Pragma("unroll") for (int i = 0; i < 2; ++i) { const u32x4 t_ = lx[(tk) * 128 + 64 * i + l]; x2[4 * i] = (f32x2){bf_lo(t_.x), bf_hi(t_.x)}; x2[4 * i + 1] = (f32x2){bf_lo(t_.y), bf_hi(t_.y)}; x2[4 * i + 2] = (f32x2){bf_lo(t_.z), bf_hi(t_.z)}; x2[4 * i + 3] = (f32x2){bf_lo(t_.w), bf_hi(t_.w)}; }
#endif
#define U8(BUF, tk, eb) do { float p[8]; f32x2 x2[8]; \
            LX_LOAD(tk); \
            _Pragma("unroll") for (int k = 0; k < 8; ++k) { const unsigned wq[4] = {BUF[k].x, BUF[k].y, BUF[k].z, BUF[k].w}; f32x2 s2 = (f32x2){0.f, 0.f}; \
                _Pragma("unroll") for (int i = 0; i < 4; ++i) { s2 = __builtin_elementwise_fma(__builtin_amdgcn_cvt_pk_f32_fp8((int)wq[i], false), x2[2 * i], s2); \
                                                                s2 = __builtin_elementwise_fma(__builtin_amdgcn_cvt_pk_f32_fp8((int)wq[i], true), x2[2 * i + 1], s2); } \
                p[k] = s2[0] + s2[1]; if ((k & 3) == 3) __builtin_amdgcn_sched_barrier(0); } \
            float q4[4], q2[2], q1; \
            _Pragma("unroll") for (int j = 0; j < 4; ++j) q4[j] = sum_swap32(p[j], p[4 + j]); \
            _Pragma("unroll") for (int j = 0; j < 2; ++j) q2[j] = sum_swap16(q4[j], q4[2 + j]); \
            { const bool up = (l & 8) != 0; const float keep = up ? q2[1] : q2[0], send = up ? q2[0] : q2[1]; q1 = keep + sxf<8>(send, l); } \
            q1 += sxf<4>(q1, l); q1 += sxf<2>(q1, l); q1 += sxf<1>(q1, l); \
            const float cu = lcu[(tk) * 128 + (eb) + (l >> 3)], cv = lcv[(tk) * 128 + (eb) + (l >> 3)]; \
            const float a_ = gelu_tanh(q1 * cu) * cv; if ((l & 7) == 0) acl[(tk) * 128 + (eb) + (l >> 3)] = a_; __builtin_amdgcn_sched_barrier(0); } while (0)
#define V8(BUF, tk, eb) do { const float av = acl[(tk) * 128 + (eb) + (l & 7)]; \
            _Pragma("unroll") for (int k = 0; k < 8; ++k) { const float ak = __uint_as_float(__builtin_amdgcn_readlane(__float_as_uint(av), k)); const f32x2 ak2 = (f32x2){ak, ak}; \
                const unsigned wq[4] = {BUF[k].x, BUF[k].y, BUF[k].z, BUF[k].w}; \
                _Pragma("unroll") for (int i = 0; i < 4; ++i) { acc[tk][2 * i] = __builtin_elementwise_fma(__builtin_amdgcn_cvt_pk_f32_fp8((int)wq[i], false), ak2, acc[tk][2 * i]); \
                                                                acc[tk][2 * i + 1] = __builtin_elementwise_fma(__builtin_amdgcn_cvt_pk_f32_fp8((int)wq[i], true), ak2, acc[tk][2 * i + 1]); } \
                if ((k & 3) == 3) __builtin_amdgcn_sched_barrier(0); } } while (0)
        ROWS8(buf0, UB, 0, 0);
#if PG_TOK == 4
#define TURNS4(CONS, TAB, eb, NEXT) do { ROWS8(buf1, TAB, 1, eb); CONS(buf0, 0, eb); ROWS8(buf0, TAB, 2, eb); CONS(buf1, 1, eb); ROWS8(buf1, TAB, 3, eb); CONS(buf0, 2, eb); NEXT; CONS(buf1, 3, eb); } while (0)
        u32x4 buf2[8], buf3[8];
        { ROWS8(buf1, UB, 1, 0); ROWS8(buf2, UB, 2, 0); ROWS8(buf3, UB, 3, 0);
#pragma unroll 1
          for (int eb = 0; eb < 120; eb += 8) { U8(buf0, 0, eb); ROWS8(buf0, UB, 0, eb + 8); U8(buf1, 1, eb); ROWS8(buf1, UB, 1, eb + 8); U8(buf2, 2, eb); ROWS8(buf2, UB, 2, eb + 8); U8(buf3, 3, eb); ROWS8(buf3, UB, 3, eb + 8); }
          U8(buf0, 0, 120); ROWS8(buf0, VB, 0, 0); U8(buf1, 1, 120); ROWS8(buf1, VB, 1, 0); U8(buf2, 2, 120); ROWS8(buf2, VB, 2, 0); U8(buf3, 3, 120); ROWS8(buf3, VB, 3, 0); }
#pragma unroll
        for (int tk = 0; tk < PG_TOK; ++tk)
#pragma unroll
            for (int i = 0; i < 8; ++i) acc[tk][i] = (f32x2){0.f, 0.f};
        LDS_WAIT(); asm volatile("" ::: "memory");
#pragma unroll 1
        for (int eb = 0; eb < 120; eb += 8) { V8(buf0, 0, eb); ROWS8(buf0, VB, 0, eb + 8); V8(buf1, 1, eb); ROWS8(buf1, VB, 1, eb + 8); V8(buf2, 2, eb); ROWS8(buf2, VB, 2, eb + 8); V8(buf3, 3, eb); ROWS8(buf3, VB, 3, eb + 8); }
        V8(buf0, 0, 120); V8(buf1, 1, 120); V8(buf2, 2, 120); V8(buf3, 3, 120);
#undef TURNS4
#elif PG_TOK == 2
#pragma unroll
        for (int tk = 0; tk < PG_TOK; ++tk)
#pragma unroll
            for (int i = 0; i < 8; ++i) acc[tk][i] = (f32x2){0.f, 0.f};
#define TURNS2(CONS, TAB, eb, NEXT) do { ROWS8(buf1, TAB, 1, eb); CONS(buf0, 0, eb); NEXT; CONS(buf1, 1, eb); } while (0)
#pragma unroll 1
        for (int eb = 0; eb < 120; eb += 8) TURNS2(U8, UB, eb, ROWS8(buf0, UB, 0, eb + 8));
        TURNS2(U8, UB, 120, ROWS8(buf0, VB, 0, 0));
        LDS_WAIT(); asm volatile("" ::: "memory");
#pragma unroll 1
        for (int eb = 0; eb < 120; eb += 8) TURNS2(V8, VB, eb, ROWS8(buf0, VB, 0, eb + 8));
        TURNS2(V8, VB, 120, (void)0);
#undef TURNS2
#else
#error PG_TOK must be 2 or 4
#endif
#undef ROWS8
#undef LX_LOAD
#undef U8
#undef V8
#pragma unroll
        for (int tk = 0; tk < PG_TOK; ++tk) { const int t = F.vcu * ntok_wg + ti + tk;
            float ss = 0.f; f32x4 h[4];
#pragma unroll
            for (int q2 = 0; q2 < 2; ++q2) { const u32x4 ha = *(const u32x4*)(H1B + (size_t)t * 1024 + 16 * l + 8 * q2);
                h[2 * q2] = (f32x4){bf_lo(ha.x), bf_hi(ha.x), bf_lo(ha.y), bf_hi(ha.y)}; h[2 * q2 + 1] = (f32x4){bf_lo(ha.z), bf_hi(ha.z), bf_lo(ha.w), bf_hi(ha.w)};
#pragma unroll
                for (int j = 0; j < 4; ++j) { h[2 * q2][j] += acc[tk][4 * q2 + (j >> 1)][j & 1]; h[2 * q2 + 1][j] += acc[tk][4 * q2 + 2 + (j >> 1)][j & 1]; ss += h[2 * q2][j] * h[2 * q2][j] + h[2 * q2 + 1][j] * h[2 * q2 + 1][j]; }
                u32x4 w0; w0.x = cvtpk(h[2 * q2][0], h[2 * q2][1]); w0.y = cvtpk(h[2 * q2][2], h[2 * q2][3]); w0.z = cvtpk(h[2 * q2 + 1][0], h[2 * q2 + 1][1]); w0.w = cvtpk(h[2 * q2 + 1][2], h[2 * q2 + 1][3]);
                if (!F.dry) st_nt<NT_OUT>(w0, (u32x4*)(H2B + (size_t)t * 1024 + 16 * l + 8 * q2)); }
            const float rstd3 = __builtin_amdgcn_rsqf(wave_sum_sx(ss, l) * (1.0f / 1024.0f) + EPS);
            if (!F.dry && l == 0) RS3[t] = rstd3;
            __builtin_amdgcn_sched_barrier(0); }
    }
}

#ifndef MK_FUSED
#define MK_FUSED 1
#endif
constexpr int NPHASE = 10;
struct Args { const float* in[20]; float* out; unsigned char* ws; int ph_lo, ph_hi, dry, pad; };
static_assert(sizeof(Args) == 20 * 8 + 8 + 8 + 4 * 4, "Args has no padding");

__global__ void __launch_bounds__(NWAVES * 64, 2) mk_fwd(Args args) {
    extern __shared__ __attribute__((aligned(16))) unsigned char lds_raw[];
    Frame F;
    F.lds = (LAS unsigned char*)lds_raw;
    F.wave = __builtin_amdgcn_readfirstlane(threadIdx.x >> 6); F.lane = lane_id(); F.tid = F.wave * 64 + F.lane;
    F.G = gridDim.x; { const int bx = blockIdx.x; F.vcu = (F.G % 8 == 0) ? (bx % 8) * (F.G / 8) + bx / 8 : bx; }
    F.in = args.in; F.out = args.out; F.ws = args.ws; F.dry = args.dry;
    volatile LAS unsigned* MISC = (volatile LAS unsigned*)(F.lds + MISC_OFF);
    if (F.tid < 64) MISC[F.tid] = 0u;
    __syncthreads();
    const int lo = args.ph_lo, hi = args.ph_hi;
    XcdBarrier bar; bar.bar = (unsigned*)(F.ws + WS_CTL) + CW_BAR; bar.x = 0; bar.st = nullptr;
    if (hi - lo > 1) bar = xcd_barrier_post((unsigned*)(F.ws + WS_CTL) + CW_BAR, MISC + 8, F.tid);
#ifndef PH_MASK
#define PH_MASK 0xFFFFFFFFu
#endif
#define IN(k) (((PH_MASK >> (k)) & 1u) && lo <= (k) && (k) < hi)
#define LAUNDER(p, T) do { unsigned _lo = (unsigned)(unsigned long long)(p), _hi = (unsigned)((unsigned long long)(p) >> 32); asm volatile("" : "+v"(_lo), "+v"(_hi)); \
        _lo = __builtin_amdgcn_readfirstlane(_lo); _hi = __builtin_amdgcn_readfirstlane(_hi); (p) = (T)(GAS char*)(((unsigned long long)_hi << 32) | _lo); } while (0)
#define SEAM(k) do { if (IN(k) && IN((k) + 1)) xcd_barrier(bar, F.tid); LAUNDER(F.ws, unsigned char*); LAUNDER(F.out, float*); F.lane = lane_id(); F.tid = F.wave * 64 + F.lane; } while (0)
    const int bx = (int)blockIdx.x;
    LAS unsigned char* ring = F.lds + RING_OFF;

    if (IN(0)) { phase_prologue(F); } SEAM(0);
    if (IN(1)) {
        pg8::Gemm g{WSP(bf16_t, WS_XN1), WSP(bf16_t, WS_WIN), T_TOK, 8192, 1024, 1024, 0, 2, 8}; pg8::StaticOrder S; S.init(T_TOK, 8192, F.G, bx);
        pg8::EpiProj E{WSP(bf16_t, WS_GQ), WSP(bf16_t, WS_GK), WSP(bf16_t, WS_GV), WSP(bf16_t, WS_GR), WSP(bf16_t, WS_SQ), WSP(bf16_t, WS_SK), WSP(bf16_t, WS_SV),
                       (bf16_t*)F.out, (bf16_t*)F.out + (size_t)T_TOK * 1024};
        if ((bx >> 3) & 1) { const int k = (bx >> 4) * 8 + (bx & 7); for (int u = k; u < 256; u += F.G / 2) alo_unit(F, u); }
        pg8::gemm_phase<pg8::EpiProj>(ring, g, S, E, F.tid);
    } SEAM(1);
    if (IN(3)) { phase_attn_a(F); } SEAM(3);
    if (IN(4)) { phase_attn_b(F); } SEAM(4);
    if (IN(5)) {
        if ((bx >> 3) & 1) cvt_copy(F, F.in[1], WSP(bf16_t, WS_PB), (size_t)T_TOK * 256, (bx >> 4) * 8 + (bx & 7), F.G / 2);
        pg8::PairOrder S; S.init(T_TOK, 1024, F.G, bx);
        pg8::Gemm g{WSP(bf16_t, WS_GLAN), WSP(bf16_t, WS_WGA), T_TOK, 1024, 1024, 1024, 0, 0, 0, WSP(bf16_t, WS_SQ), WSP(bf16_t, WS_WSB)};
        pg8::EpiMixPair E{(const bf16_t*)F.out, (const bf16_t*)F.out + (size_t)T_TOK * 1024, WSP(bf16_t, WS_MIX)};
        pg8::gemm_phase<pg8::EpiMixPair, true, true, pg8::PairOrder>(ring, g, S, E, F.tid);
    } SEAM(5);
#define PLE_TILE() do { pg8::StaticOrder Sp; Sp.init(T_TOK, 1024, F.G, bx); pg8::Gemm gp{WSP(bf16_t, WS_PB), WSP(bf16_t, WS_WPLE), T_TOK, 1024, 256, 256, 0, 0, 0}; pg8::EpiBf Ep{WSP(bf16_t, WS_PLE), 1024}; \
        pg8::gemm_phase<pg8::EpiBf>(ring, gp, Sp, Ep, F.tid); } while (0)
    if (IN(6)) {
        if ((bx >> 3) & 1) PLE_TILE();
        pg8::Gemm g{WSP(bf16_t, WS_MIX), WSP(bf16_t, WS_WO), T_TOK, 1024, 1024, 1024, 0, 0, 0}; pg8::StaticOrder S; S.init(T_TOK, 1024, F.G, bx);
        pg8::EpiH1 E{F.in[0], WSP(bf16_t, WS_H1), WSP(float, WS_SSQ1)};
        pg8::gemm_phase<pg8::EpiH1>(ring, g, S, E, F.tid);
    } SEAM(6);
    if (IN(7)) {
        if (!((bx >> 3) & 1)) PLE_TILE();
        pg8::Gemm g{WSP(bf16_t, WS_H1), WSP(bf16_t, WS_WPQ), T_TOK, 2048, 1024, 1024, 0, 0, 0}; pg8::StaticOrder S; S.init(T_TOK, 2048, F.G, bx);
        pg8::EpiQ E{WSP(float, WS_SSQ1), WSP(bf16_t, WS_Q), 2048};
        pg8::gemm_phase<pg8::EpiQ>(ring, g, S, E, F.tid);
    } SEAM(7);
    if (IN(8)) {
        phase_peer_retrieve(F);
        VM_WAIT(); __syncthreads();
        phase_peer_gather(F, bar, false);
    } SEAM(8);
    if (IN(9)) {
        pg8::StaticOrder S; S.init(T_TOK, 1024, F.G, bx);
        { pg8::Gemm g{WSP(bf16_t, WS_H2B), WSP(bf16_t, WS_WPG), T_TOK, 1024, 1024, 1024, 0, 0, 0}; pg8::EpiH3L E{WSP(bf16_t, WS_H2B), WSP(bf16_t, WS_PLE), WSP(float, WS_RS3), ring, WSP(float, WS_SSQ3S) + 16384 * F.dry};
          pg8::gemm_phase<pg8::EpiH3L>(ring, g, S, E, F.tid); }
        { pg8::Unit u; S.next(0, u);
          unsigned* cnt = (unsigned*)(F.ws + WS_CTL) + CW_ROWCNT + 64 * F.dry + u.pm;
          if (F.tid == 0) { __hip_atomic_fetch_add(cnt, 1u, __ATOMIC_RELAXED, __HIP_MEMORY_SCOPE_AGENT);
              unsigned sp = 0; while (__hip_atomic_load(cnt, __ATOMIC_RELAXED, __HIP_MEMORY_SCOPE_AGENT) < 4u && ++sp < (1u << 24)) __builtin_amdgcn_s_sleep(1); }
          __syncthreads();
          LAS float* rsl = (LAS float*)(ring + 256 * pg8::H3L_PITCH);
          if (F.tid < 256) { const float st = __hip_atomic_fetch_add(WSP(float, WS_SSQ3S) + 16384 * F.dry + u.pm * 256 + F.tid, 0.0f, __ATOMIC_RELAXED, __HIP_MEMORY_SCOPE_AGENT);
              rsl[F.tid] = __builtin_amdgcn_rsqf(st * (1.0f / 1024.0f) + EPS); }
          __syncthreads();
          const int c8 = F.tid & 31, r0 = F.tid >> 5;
          const f32x4 g0 = *(const f32x4*)(F.in[19] + u.pn * 256 + 8 * c8), g1 = *(const f32x4*)(F.in[19] + u.pn * 256 + 8 * c8 + 4);
#pragma unroll 4
          for (int ps = 0; ps < 16; ++ps) { const int lrow = ps * 16 + r0; const u32x4 hv = *(const LAS u32x4*)(ring + lrow * pg8::H3L_PITCH + 16 * c8); const float rstd = rsl[lrow];
              float* op = F.out + (size_t)(u.pm * 256 + lrow) * 1024 + u.pn * 256 + 8 * c8;
              st_nt<NT_FINAL>((f32x4){bf_lo(hv.x), bf_hi(hv.x), bf_lo(hv.y), bf_hi(hv.y)} * rstd * g0, (f32x4*)op); st_nt<NT_FINAL>((f32x4){bf_lo(hv.z), bf_hi(hv.z), bf_lo(hv.w), bf_hi(hv.w)} * rstd * g1, (f32x4*)(op + 4)); }
        }
    }
#undef IN
#undef SEAM
}

extern "C" void kernel_launch(void* const* d_in, const int* in_sizes, int n_in, void* d_out, int out_size, void* d_ws, size_t ws_size, hipStream_t stream) {
    static int grid = 0;
    if (grid == 0) {
        if (n_in != 20 || in_sizes[0] != T_TOK * 1024 || out_size != T_TOK * 1024 || ws_size < WS_END) {
            fprintf(stderr, "kernel_launch: unexpected shapes (n_in %d, in0 %d, out %d, ws %zu < %zu?); nothing launched\n", n_in, n_in > 0 ? in_sizes[0] : -1, out_size, ws_size, (size_t)WS_END); grid = -1; return; }
        int dev = 0, cus = 0, per_cu = 0;
        if (hipGetDevice(&dev) != hipSuccess || hipDeviceGetAttribute(&cus, hipDeviceAttributeMultiprocessorCount, dev) != hipSuccess) { grid = -1; return; }
        if (hipFuncSetAttribute((const void*)mk_fwd, hipFuncAttributeMaxDynamicSharedMemorySize, LDS_BYTES) != hipSuccess) { fprintf(stderr, "kernel_launch: hipFuncSetAttribute failed\n"); grid = -1; return; }
        if (hipOccupancyMaxActiveBlocksPerMultiprocessor(&per_cu, (const void*)mk_fwd, NWAVES * 64, LDS_BYTES) != hipSuccess || per_cu < 1)
            fprintf(stderr, "kernel_launch: note: occupancy query reports %d workgroups per CU\n", per_cu);
        (void)hipGetLastError();
        grid = cus;
        if (grid != (T_TOK / 256) * 4 || (grid & 15) != 0) { fprintf(stderr, "kernel_launch: the last phase needs one output tile per workgroup (grid %d)\n", grid); grid = -1; return; }
        if (grid != 256) fprintf(stderr, "kernel_launch: note: %d CUs (kernel tuned for 256)\n", grid);
    }
    if (grid < 0) return;
    if (hipMemsetAsync((char*)d_ws + WS_CTL, 0, CTL_ZERO_BYTES, stream) != hipSuccess) { fprintf(stderr, "kernel_launch: hipMemsetAsync failed\n"); return; }
    Args a{};
    for (int i = 0; i < 20; ++i) a.in[i] = (const float*)d_in[i];
    a.out = (float*)d_out; a.ws = (unsigned char*)d_ws;
#if MK_FUSED
    a.ph_lo = 0; a.ph_hi = NPHASE;
    hipLaunchKernelGGL(mk_fwd, dim3(grid), dim3(NWAVES * 64), LDS_BYTES, stream, a);
#else
#ifndef PROBE_PHASE
#define PROBE_PHASE -1
#define PROBE_REPS 0
#endif
    for (int p = 0; p < NPHASE; ++p) { a.ph_lo = p; a.ph_hi = p + 1;
        if (p == PROBE_PHASE) { a.dry = 1; for (int r = 0; r < PROBE_REPS; ++r) hipLaunchKernelGGL(mk_fwd, dim3(grid), dim3(NWAVES * 64), LDS_BYTES, stream, a); a.dry = 0; }
        hipLaunchKernelGGL(mk_fwd, dim3(grid), dim3(NWAVES * 64), LDS_BYTES, stream, a); }
#endif
}
```
